# Optimizing an MI355X kernel written in HIP

```python
import jax
import jax.numpy as jnp
from jax import lax
import numpy as np

D_MODEL = 2048
BATCH = 2
SEQ = 8192
DEPTH = 2

CTX_LEN = 256
GRID_W = 64
NORM_EPS = 1e-6

RW_HEADS = 16
RW_HEAD = 64
RW_WIDTH = RW_HEADS * RW_HEAD
RW_DECAY_LORA = 64
RW_A_LORA = 64
RW_GATE_LORA = 32
N_DIR = 2
RW_GN_EPS = 64e-5

MLA_HEADS = 16
MLA_NOPE = 64
MLA_ROPE = 32
MLA_QK = MLA_NOPE + MLA_ROPE
MLA_V = 64
MLA_WIDTH = MLA_HEADS * MLA_V
MLA_Q_RANK = 512
MLA_KV_RANK = 256
ROPE_BASE = 10000.0
Q_BLOCK = 128

PEER_HEADS = 8
PEER_NKEYS = 128
PEER_EXPERTS = PEER_NKEYS * PEER_NKEYS
PEER_QDIM = 256
PEER_HALF = PEER_QDIM // 2
PEER_TOPK = 16
PEER_BLOCK = 128

N_BRANCH = 2
RW_LORA_COLS = N_DIR * (RW_DECAY_LORA + RW_A_LORA + RW_GATE_LORA)
RW_COLS = 3 * RW_WIDTH + RW_LORA_COLS
MLA_COLS = MLA_Q_RANK + MLA_KV_RANK + MLA_ROPE
GATE_COLS = N_BRANCH * D_MODEL
IN_COLS = RW_COLS + MLA_COLS + GATE_COLS

kernel_name = 'hybrid_rwkv7_mla_peer_dit_block'


def rmsnorm(x, g, eps=NORM_EPS):
    xf = x.astype(jnp.float32)
    y = xf * lax.rsqrt(jnp.mean(xf * xf, -1, keepdims=True) + eps)
    return (y * g.astype(jnp.float32)).astype(x.dtype)


def modulate(h, shift, scale):
    return h * (1.0 + scale) + shift


def axial_rope_tables(n_tok):
    rows = n_tok // GRID_W
    row = jnp.repeat(jnp.arange(rows, dtype=jnp.float32), GRID_W)
    col = jnp.tile(jnp.arange(GRID_W, dtype=jnp.float32), rows)
    n_freq = MLA_ROPE // 4
    freqs = ROPE_BASE ** (-jnp.arange(n_freq, dtype=jnp.float32) / n_freq)
    ang = jnp.concatenate([row[:, None] * freqs, col[:, None] * freqs], -1)
    return jnp.cos(ang), jnp.sin(ang)


def apply_rope(x, cos, sin):
    half = x.shape[-1] // 2
    x1, x2 = x[..., :half], x[..., half:]
    return jnp.concatenate([x1 * cos - x2 * sin, x1 * sin + x2 * cos], -1).astype(x.dtype)


def centred_shift(p):
    prev = jnp.pad(p[:, :-1], ((0, 0), (1, 0), (0, 0)))
    nxt = jnp.pad(p[:, 1:], ((0, 0), (0, 1), (0, 0)))
    return 0.5 * (prev + nxt) - p


def rwkv_features(p, mu, w0, w_up, a0, a_up, g_up, k_k, k_a):
    B, T, _ = p.shape
    f32 = lambda z: z.astype(jnp.float32)
    p = f32(p + centred_shift(p) * mu)
    r = p[..., :RW_WIDTH]
    k = p[..., RW_WIDTH:2 * RW_WIDTH]
    v = p[..., 2 * RW_WIDTH:3 * RW_WIDTH]
    lo = 3 * RW_WIDTH
    wd = p[..., lo:lo + N_DIR * RW_DECAY_LORA].reshape(B, T, N_DIR, RW_DECAY_LORA)
    lo += N_DIR * RW_DECAY_LORA
    ad = p[..., lo:lo + N_DIR * RW_A_LORA].reshape(B, T, N_DIR, RW_A_LORA)
    lo += N_DIR * RW_A_LORA
    gd = p[..., lo:lo + N_DIR * RW_GATE_LORA].reshape(B, T, N_DIR, RW_GATE_LORA)
    w = -jax.nn.softplus(-(f32(w0) + jnp.einsum('btdr,drc->btdc', jnp.tanh(wd), f32(w_up)))) - 0.5
    decay = jnp.exp(-jnp.exp(w))
    a = jax.nn.sigmoid(f32(a0) + jnp.einsum('btdr,drc->btdc', ad, f32(a_up)))
    g = jnp.einsum('btdr,drc->btdc', jax.nn.sigmoid(gd), f32(g_up))
    kk = (k * f32(k_k)).reshape(B, T, RW_HEADS, RW_HEAD)
    kk = kk * lax.rsqrt(jnp.sum(kk * kk, -1, keepdims=True) + 1e-12)
    k_eff = k[:, :, None, :] * (1.0 + (a - 1.0) * f32(k_a))
    heads = lambda z: z.reshape(z.shape[:-1] + (RW_HEADS, RW_HEAD))
    return heads(r), kk, heads(v), heads(decay), heads(a), heads(k_eff), g


def wkv_scan(s0, r, decay, k, v, kk, a, reverse):
    def step(s, xs):
        r_t, w_t, k_t, v_t, kk_t, a_t = xs
        sa = jnp.einsum('bhvk,bhk->bhv', s, -kk_t)
        s = (s * w_t[:, :, None, :]
             + sa[..., None] * (kk_t * a_t)[:, :, None, :]
             + v_t[..., None] * k_t[:, :, None, :])
        return s, jnp.einsum('bhvk,bhk->bhv', s, r_t)
    xs = tuple(jnp.moveaxis(z, 1, 0) for z in (r, decay, k, v, kk, a))
    s_fin, y = lax.scan(step, s0, xs, reverse=reverse)
    return s_fin, jnp.moveaxis(y, 0, 1)


def rwkv_readout(y, r, k_eff, v, g, r_k, ln_w, ln_b, dtype):
    B, T = y.shape[:2]
    mean = jnp.mean(y, -1, keepdims=True)
    var = jnp.mean(jnp.square(y - mean), -1, keepdims=True)
    yn = ((y - mean) * lax.rsqrt(var + RW_GN_EPS)).reshape(B, T, RW_WIDTH)
    yn = yn * ln_w.astype(jnp.float32) + ln_b.astype(jnp.float32)
    bonus = (jnp.sum(r * k_eff * r_k.astype(jnp.float32), -1, keepdims=True) * v).reshape(B, T, RW_WIDTH)
    return ((yn + bonus) * g).astype(dtype)


def rwkv_branch(p_ctx, p_lat, need_ctx, feat_params, readout_params):
    r_c, kk_c, v_c, w_c, a_c, ke_c, g_c = rwkv_features(p_ctx, *feat_params)
    r_l, kk_l, v_l, w_l, a_l, ke_l, g_l = rwkv_features(p_lat, *feat_params)
    B = p_lat.shape[0]
    s0 = jnp.zeros((B, RW_HEADS, RW_HEAD, RW_HEAD), jnp.float32)
    out_ctx, out_lat = [], []
    for d in range(N_DIR):
        rev = d == 1
        s_ctx, y_c = wkv_scan(s0, r_c, w_c[:, :, d], ke_c[:, :, d], v_c, kk_c, a_c[:, :, d], rev)
        _, y_l = wkv_scan(s_ctx, r_l, w_l[:, :, d], ke_l[:, :, d], v_l, kk_l, a_l[:, :, d], rev)
        out_lat.append(rwkv_readout(y_l, r_l, ke_l[:, :, d], v_l, g_l[:, :, d], *readout_params, p_lat.dtype))
        if need_ctx:
            out_ctx.append(rwkv_readout(y_c, r_c, ke_c[:, :, d], v_c, g_c[:, :, d], *readout_params, p_ctx.dtype))
    y_lat = out_lat[0] + out_lat[1]
    y_ctx = out_ctx[0] + out_ctx[1] if need_ctx else None
    return y_ctx, y_lat


def mla_heads(p, q_norm, w_uq, kv_norm, w_ukv):
    B, T, _ = p.shape
    q_c = p[..., :MLA_Q_RANK]
    kv_c = p[..., MLA_Q_RANK:MLA_Q_RANK + MLA_KV_RANK]
    k_rope = p[..., MLA_Q_RANK + MLA_KV_RANK:]
    q = (rmsnorm(q_c, q_norm) @ w_uq).reshape(B, T, MLA_HEADS, MLA_QK)
    kv = (rmsnorm(kv_c, kv_norm) @ w_ukv).reshape(B, T, MLA_HEADS, MLA_NOPE + MLA_V)
    return q[..., :MLA_NOPE], q[..., MLA_NOPE:], kv[..., :MLA_NOPE], kv[..., MLA_NOPE:], k_rope


def join_rope_key(k_nope, k_rope):
    k_rope = jnp.broadcast_to(k_rope[:, :, None, :], k_nope.shape[:-1] + (MLA_ROPE,))
    return jnp.concatenate([k_nope, k_rope], -1)


def attend(q, k, v):
    s = jnp.einsum('bqhd,bkhd->bhqk', q, k).astype(jnp.float32) * (MLA_QK ** -0.5)
    pr = jax.nn.softmax(s, -1).astype(v.dtype)
    return jnp.einsum('bhqk,bkhd->bqhd', pr, v)


def mla_branch(p_ctx, p_lat, need_ctx, cos, sin, q_norm, w_uq, kv_norm, w_ukv):
    qn_c, qr_c, kn_c, v_c, kr_c = mla_heads(p_ctx, q_norm, w_uq, kv_norm, w_ukv)
    qn_l, qr_l, kn_l, v_l, kr_l = mla_heads(p_lat, q_norm, w_uq, kv_norm, w_ukv)
    k_c = join_rope_key(kn_c, kr_c)
    k_l = join_rope_key(kn_l, apply_rope(kr_l, cos, sin))
    q_l = jnp.concatenate([qn_l, apply_rope(qr_l, cos[:, None, :], sin[:, None, :])], -1)
    keys = jnp.concatenate([k_c, k_l], 1)
    vals = jnp.concatenate([v_c, v_l], 1)
    B, L = p_lat.shape[:2]
    nb = L // Q_BLOCK
    qb = jnp.moveaxis(q_l.reshape(B, nb, Q_BLOCK, MLA_HEADS, MLA_QK), 1, 0)
    o = lax.map(lambda qblk: attend(qblk, keys, vals), qb)
    y_lat = jnp.moveaxis(o, 0, 1).reshape(B, L, MLA_WIDTH)
    y_ctx = None
    if need_ctx:
        q_c = jnp.concatenate([qn_c, qr_c], -1)
        y_ctx = attend(q_c, k_c, v_c).reshape(B, p_ctx.shape[1], MLA_WIDTH)
    return y_ctx, y_lat


def gated_merge(y_a, y_b, gate_logits, gate_b, w_branch_a, w_branch_b, w_out):
    B, T, _ = gate_logits.shape
    gl = gate_logits.reshape(B, T, N_BRANCH, D_MODEL) + gate_b
    g_a = jax.nn.sigmoid(gl[:, :, 0])
    g_b = jax.nn.sigmoid(gl[:, :, 1])
    return (g_a * (y_a @ w_branch_a) + g_b * (y_b @ w_branch_b)) @ w_out


def mixer_sublayer(h_ctx, h_lat, need_ctx, cos, sin, w_in, gate_b, rk_mu, rk_w0, rk_w_up, rk_a0, rk_a_up,
                   rk_g_up, rk_k_k, rk_k_a, rk_r_k, rk_ln_w, rk_ln_b, mla_q_norm, mla_w_uq, mla_kv_norm,
                   mla_w_ukv, w_branch_a, w_branch_b, w_out):
    p_lat = h_lat @ w_in
    p_ctx = h_ctx @ w_in
    feat_params = (rk_mu, rk_w0, rk_w_up, rk_a0, rk_a_up, rk_g_up, rk_k_k, rk_k_a)
    readout_params = (rk_r_k, rk_ln_w, rk_ln_b)
    ya_c, ya_l = rwkv_branch(p_ctx[..., :RW_COLS], p_lat[..., :RW_COLS], need_ctx, feat_params, readout_params)
    lo, hi = RW_COLS, RW_COLS + MLA_COLS
    yb_c, yb_l = mla_branch(p_ctx[..., lo:hi], p_lat[..., lo:hi], need_ctx, cos, sin,
                            mla_q_norm, mla_w_uq, mla_kv_norm, mla_w_ukv)
    out_lat = gated_merge(ya_l, yb_l, p_lat[..., hi:], gate_b, w_branch_a, w_branch_b, w_out)
    out_ctx = None
    if need_ctx:
        out_ctx = gated_merge(ya_c, yb_c, p_ctx[..., hi:], gate_b, w_branch_a, w_branch_b, w_out)
    return out_ctx, out_lat


def peer(h, w_q, keys, u_tab, v_tab):
    B, T, D = h.shape
    n = B * T
    hf = h.reshape(n, D)
    q = (hf @ w_q).reshape(n, PEER_HEADS, 2, PEER_HALF)
    s = jnp.einsum('nhpd,hpkd->nhpk', q, keys).astype(jnp.float32)
    v1, i1 = lax.top_k(s[:, :, 0], PEER_TOPK)
    v2, i2 = lax.top_k(s[:, :, 1], PEER_TOPK)
    cand_s = (v1[..., :, None] + v2[..., None, :]).reshape(n, PEER_HEADS, PEER_TOPK * PEER_TOPK)
    cand_i = (i1[..., :, None] * PEER_NKEYS + i2[..., None, :]).reshape(n, PEER_HEADS, PEER_TOPK * PEER_TOPK)
    top_s, pos = lax.top_k(cand_s, PEER_TOPK)
    idx = jnp.take_along_axis(cand_i, pos, -1).reshape(n, PEER_HEADS * PEER_TOPK)
    gates = jax.nn.softmax(top_s, -1).reshape(n, PEER_HEADS * PEER_TOPK).astype(h.dtype)
    nb = n // PEER_BLOCK

    def block(args):
        hb, ib, gb = args
        act = jax.nn.gelu(jnp.einsum('nd,ned->ne', hb, u_tab[ib]), approximate=False)
        return jnp.einsum('ne,ned->nd', gb * act, v_tab[ib])

    out = lax.map(block, (hf.reshape(nb, PEER_BLOCK, D),
                          idx.reshape(nb, PEER_BLOCK, -1),
                          gates.reshape(nb, PEER_BLOCK, -1)))
    return out.reshape(B, T, D)


def setup_inputs(seed: int = 0) -> dict:
    key = jax.random.key(seed)
    ks = iter(jax.random.split(key, 40))
    nrm = lambda shape, scale: scale * jax.random.normal(next(ks), shape, jnp.float32)
    uni = lambda shape, lo, hi: jax.random.uniform(next(ks), shape, jnp.float32, lo, hi)
    D, L = D_MODEL, DEPTH
    return {
        'x': nrm((BATCH, SEQ, D), 1.0),
        'c': nrm((BATCH, D), 1.0),
        'ctx': nrm((BATCH, CTX_LEN, D), 1.0),
        'c_ctx': nrm((D,), 1.0),
        'ada_w': nrm((L, D, 6 * D), 0.5 * D ** -0.5),
        'ada_b': nrm((L, 6 * D), 0.02),
        'norm_mix_g': 1.0 + nrm((L, D), 0.02),
        'w_in': nrm((L, D, IN_COLS), D ** -0.5),
        'gate_b': nrm((L, N_BRANCH, D), 0.02),
        'rk_mu': uni((L, RW_COLS), 0.0, 1.0),
        'rk_w0': uni((L, N_DIR, RW_WIDTH), -6.0, -1.0),
        'rk_w_up': nrm((L, N_DIR, RW_DECAY_LORA, RW_WIDTH), 0.5 * RW_DECAY_LORA ** -0.5),
        'rk_a0': nrm((L, N_DIR, RW_WIDTH), 0.1),
        'rk_a_up': nrm((L, N_DIR, RW_A_LORA, RW_WIDTH), 0.5 * RW_A_LORA ** -0.5),
        'rk_g_up': nrm((L, N_DIR, RW_GATE_LORA, RW_WIDTH), RW_GATE_LORA ** -0.5),
        'rk_k_k': 0.85 + nrm((L, RW_WIDTH), 0.02),
        'rk_k_a': 1.0 + nrm((L, RW_WIDTH), 0.02),
        'rk_r_k': nrm((L, RW_HEADS, RW_HEAD), 0.1),
        'rk_ln_w': 1.0 + nrm((L, RW_WIDTH), 0.02),
        'rk_ln_b': nrm((L, RW_WIDTH), 0.02),
        'mla_q_norm': 1.0 + nrm((L, MLA_Q_RANK), 0.02),
        'mla_w_uq': nrm((L, MLA_Q_RANK, MLA_HEADS * MLA_QK), MLA_Q_RANK ** -0.5),
        'mla_kv_norm': 1.0 + nrm((L, MLA_KV_RANK), 0.02),
        'mla_w_ukv': nrm((L, MLA_KV_RANK, MLA_HEADS * (MLA_NOPE + MLA_V)), MLA_KV_RANK ** -0.5),
        'w_branch_a': nrm((L, RW_WIDTH, D), RW_WIDTH ** -0.5),
        'w_branch_b': nrm((L, MLA_WIDTH, D), MLA_WIDTH ** -0.5),
        'w_out': nrm((L, D, D), D ** -0.5),
        'norm_ffn_g': 1.0 + nrm((L, D), 0.02),
        'peer_w_q': nrm((L, D, PEER_HEADS * PEER_QDIM), D ** -0.5),
        'peer_keys': nrm((L, PEER_HEADS, 2, PEER_NKEYS, PEER_HALF), PEER_HALF ** -0.5),
        'peer_u': nrm((L, PEER_EXPERTS, D), D ** -0.5),
        'peer_v': nrm((L, PEER_EXPERTS, D), 0.25),
        'final_norm_g': 1.0 + nrm((D,), 0.02),
    }


def reference(x, c, ctx, c_ctx, ada_w, ada_b, norm_mix_g, w_in, gate_b, rk_mu, rk_w0, rk_w_up, rk_a0,
              rk_a_up, rk_g_up, rk_k_k, rk_k_a, rk_r_k, rk_ln_w, rk_ln_b, mla_q_norm, mla_w_uq, mla_kv_norm,
              mla_w_ukv, w_branch_a, w_branch_b, w_out, norm_ffn_g, peer_w_q, peer_keys, peer_u, peer_v,
              final_norm_g):
    cos, sin = axial_rope_tables(x.shape[1])
    xc = ctx
    for l in range(DEPTH):
        need_ctx = l < DEPTH - 1
        mod_l = (jax.nn.silu(c) @ ada_w[l] + ada_b[l])[:, None, :]
        mod_c = (jax.nn.silu(c_ctx) @ ada_w[l] + ada_b[l])[None, None, :]
        sh1_l, sc1_l, gt1_l, sh2_l, sc2_l, gt2_l = jnp.split(mod_l, 6, -1)
        sh1_c, sc1_c, gt1_c, sh2_c, sc2_c, gt2_c = jnp.split(mod_c, 6, -1)
        h_l = modulate(rmsnorm(x, norm_mix_g[l]), sh1_l, sc1_l)
        h_c = modulate(rmsnorm(xc, norm_mix_g[l]), sh1_c, sc1_c)
        m_c, m_l = mixer_sublayer(h_c, h_l, need_ctx, cos, sin, w_in[l], gate_b[l], rk_mu[l], rk_w0[l],
                                  rk_w_up[l], rk_a0[l], rk_a_up[l], rk_g_up[l], rk_k_k[l], rk_k_a[l],
                                  rk_r_k[l], rk_ln_w[l], rk_ln_b[l], mla_q_norm[l], mla_w_uq[l],
                                  mla_kv_norm[l], mla_w_ukv[l], w_branch_a[l], w_branch_b[l], w_out[l])
        x = x + gt1_l * m_l
        h_l = modulate(rmsnorm(x, norm_ffn_g[l]), sh2_l, sc2_l)
        x = x + gt2_l * peer(h_l, peer_w_q[l], peer_keys[l], peer_u[l], peer_v[l])
        if need_ctx:
            xc = xc + gt1_c * m_c
            h_c = modulate(rmsnorm(xc, norm_ffn_g[l]), sh2_c, sc2_c)
            xc = xc + gt2_c * peer(h_c, peer_w_q[l], peer_keys[l], peer_u[l], peer_v[l])
    return rmsnorm(x, final_norm_g)
```

```cpp
#include <hip/hip_runtime.h>
#include <cstdio>
#include <cstdint>

#ifndef MK_N_LAUNCHES
#define MK_N_LAUNCHES 23
#endif

#ifndef DBG_SKIP
#define DBG_SKIP 0
#endif
#ifndef DBG_PROBE
#define DBG_PROBE 0
#endif
namespace pg8 {
#define PG8_LAS __attribute__((address_space(3)))
typedef unsigned short bf16_t;
typedef short bf16x8 __attribute__((ext_vector_type(8)));
typedef float f32x4 __attribute__((ext_vector_type(4)));
typedef unsigned u32x4 __attribute__((ext_vector_type(4)));
constexpr int BM = 256, BK = 64, HALF = 128, HTB = HALF * BK * 2  , STAGE_BYTES = 8 * HTB, NXCD = 8, WGM = 8;

__host__ __device__ __forceinline__ int lds_byte(int r, int c) { const int st = (r >> 4) * 2 + (c >> 5), rr = r & 15, cc = c & 31, ob = rr * 64 + cc * 2; return st * 1024 + (ob ^ (((ob >> 9) & 1) << 5)); }
__host__ __device__ __forceinline__ void stage_rc(int b, int& R, int& C) { const int st = b / 1024, sb = b % 1024, swz = sb ^ (((sb >> 9) & 1) << 5); R = (st >> 1) * 16 + swz / 64; C = (st & 1) * 32 + (swz % 64) / 2; }
__host__ __device__ __forceinline__ int perm32(int rho) { const int n = rho >> 4, i = rho & 15; return 8 * (i >> 2) + 4 * n + (i & 3); }

struct Unit { int pm, pn; };
struct Gemm { const bf16_t* A; const bf16_t* Bt; int M, N, K; };

struct StaticOrder {
    int nM, nN, nwg, G, c;
    __host__ __device__ void init(int M, int N, int G_, int c_) { nM = M / BM; nN = N / BM; nwg = nM * nN; G = G_; c = c_; }
    __host__ __device__ bool next(int i, Unit& u) const {
        const long L = (long)i * G + c; if (L >= nwg) return false;
        int wgid = (int)L; { const int q = nwg / NXCD, r = nwg % NXCD, xcd = wgid % NXCD, off = wgid / NXCD; wgid = (xcd < r ? xcd * (q + 1) : r * (q + 1) + (xcd - r) * q) + off; }
        const int nig = WGM * nN, gid = wgid / nig, fm = gid * WGM, gsz = (nM - fm) < WGM ? (nM - fm) : WGM;
        u.pm = fm + ((wgid % nig) % gsz); u.pn = (wgid % nig) / gsz; return true;
    }
    __device__ __forceinline__ void a_ready(const Unit&) const {}
    __device__ __forceinline__ void done(const Unit&) const {}
};
__device__ __forceinline__ int opaque_lane() { int l; asm volatile("v_mbcnt_lo_u32_b32 %0, -1, 0\n\tv_mbcnt_hi_u32_b32 %0, -1, %0" : "=v"(l)); return l; }
__device__ __forceinline__ unsigned cvt_pk_bf16(float lo, float hi) { unsigned r; asm volatile("v_cvt_pk_bf16_f32 %0, %1, %2" : "=v"(r) : "v"(lo), "v"(hi)); return r; }
template <class Epi, class Sched, bool ALIGN_EPI = false, bool SP2 = false>
__device__ __forceinline__ void gemm_phase(PG8_LAS unsigned char* lds, const Gemm g, const Sched& S, const Epi& E, const int wave_s) {
    const int lane_ = opaque_lane();
    const int wid = wave_s, lane = lane_, tid = wid * 64 + lane, wr = wid >> 2, wc = wid & 3, fr = lane & 15, fq = lane >> 4;
    const int K = g.K, nt = K / BK;
    unsigned voffA[2], voffB[2];
#pragma unroll
    for (int i = 0; i < 2; ++i) { int R, C; stage_rc(tid * 16 + i * 8192, R, C); const int Rb = Epi::PERM ? ((R & ~31) + perm32(R & 31)) : R;
        voffA[i] = (unsigned)(R * K + C) * 2u; voffB[i] = (unsigned)(Rb * K + C) * 2u; }
    const size_t kstep = (size_t)(BK * 2);
    const size_t hstep = (size_t)HALF * K * 2;
    const size_t tstep = 2 * hstep;
    const unsigned ldsw = (unsigned)wid * 1024u;
    const int aoff = lds_byte(wr * 64 + fr, fq * 8), boff = lds_byte(wc * 32 + fr, fq * 8);
#define PG8_SA(b, h) (((b) * 2 + (h)) * HTB)
#define PG8_SB(b, h) ((4 + (b) * 2 + (h)) * HTB)
#define PG8_STAGE(bufoff, gbase, voff) do { _Pragma("unroll") for (int _i = 0; _i < 2; ++_i) \
        __builtin_amdgcn_global_load_lds((const unsigned*)((const char*)(gbase) + (voff)[_i]), (PG8_LAS unsigned*)(lds + (bufoff) + ldsw + _i * 8192), 16, 0, 0); } while (0)
#define PG8_LDA(dst, b, h) do { _Pragma("unroll") for (int m = 0; m < 4; ++m) _Pragma("unroll") for (int k = 0; k < 2; ++k) dst[m][k] = *(const PG8_LAS bf16x8*)(lds + PG8_SA(b, h) + aoff + m * 2048 + k * 1024); } while (0)
#define PG8_LDB(dst, b, h) do { _Pragma("unroll") for (int n = 0; n < 2; ++n) _Pragma("unroll") for (int k = 0; k < 2; ++k) dst[n][k] = *(const PG8_LAS bf16x8*)(lds + PG8_SB(b, h) + boff + n * 2048 + k * 1024); } while (0)
#define PG8_MMA(ai, bj, At, Bt) do { __builtin_amdgcn_s_setprio(1); _Pragma("unroll") for (int m = 0; m < 4; ++m) _Pragma("unroll") for (int n = 0; n < 2; ++n) _Pragma("unroll") for (int k = 0; k < 2; ++k) \
        acc[ai][bj][m][n] = __builtin_amdgcn_mfma_f32_16x16x32_bf16(Bt[n][k], At[m][k], acc[ai][bj][m][n], 0, 0, 0); __builtin_amdgcn_s_setprio(0); } while (0)
#define PG8_WAIT_V(n) asm volatile("s_waitcnt vmcnt(" #n ")" ::: "memory")
#define PG8_WAIT_L(n) asm volatile("s_waitcnt lgkmcnt(" #n ")" ::: "memory")
#define PG8_BAR __builtin_amdgcn_s_barrier()
#define PG8_SCHED __builtin_amdgcn_sched_barrier(0)
    Unit cur, nxt; int ui = 0;
    if (!S.next(0, cur)) return;
    f32x4 acc[2][2][4][2];
#pragma unroll
    for (int a = 0; a < 2; ++a)
#pragma unroll
        for (int b = 0; b < 2; ++b)
#pragma unroll
            for (int m = 0; m < 4; ++m)
#pragma unroll
                for (int n = 0; n < 2; ++n) acc[a][b][m][n] = (f32x4){0.f, 0.f, 0.f, 0.f};
    bf16x8 At[4][2], B0[2][2], B1[2][2];
    const char* cA = (const char*)g.A + (size_t)cur.pm * tstep; const char* cB = (const char*)g.Bt + (size_t)cur.pn * tstep;
    S.a_ready(cur);
    if constexpr (SP2) {
        PG8_STAGE(PG8_SB(0, 0), cB, voffB); PG8_STAGE(PG8_SB(0, 1), cB + hstep, voffB); PG8_STAGE(PG8_SA(0, 0), cA, voffA); PG8_STAGE(PG8_SA(0, 1), cA + hstep, voffA);
        if (wr == 1) PG8_BAR;
        PG8_WAIT_V(2); PG8_BAR;
        PG8_STAGE(PG8_SB(1, 0), cB + kstep, voffB); PG8_STAGE(PG8_SA(1, 0), cA + kstep, voffA); PG8_STAGE(PG8_SB(1, 1), cB + hstep + kstep, voffB);
        PG8_WAIT_V(6); PG8_BAR;
    } else {
        PG8_STAGE(PG8_SB(0, 0), cB, voffB); PG8_STAGE(PG8_SA(0, 0), cA, voffA); PG8_STAGE(PG8_SB(0, 1), cB + hstep, voffB); PG8_STAGE(PG8_SA(0, 1), cA + hstep, voffA);
        if (wr == 1) PG8_BAR;
        PG8_WAIT_V(4); PG8_BAR;
        PG8_STAGE(PG8_SB(1, 0), cB + kstep, voffB); PG8_STAGE(PG8_SA(1, 0), cA + kstep, voffA); PG8_STAGE(PG8_SB(1, 1), cB + hstep + kstep, voffB);
        PG8_WAIT_V(6); PG8_BAR;
    }
    for (;;) {
        const bool has_next = S.next(ui + 1, nxt);
        const char* nA = has_next ? (const char*)g.A + (size_t)nxt.pm * tstep : cA; const char* nB = has_next ? (const char*)g.Bt + (size_t)nxt.pn * tstep : cB;
        for (int t = 0; t < nt; t += 2) {
            const bool last = (t == nt - 2);
            const char* a1 = cA + (size_t)(t + 1) * kstep;
            const char* a2 = last ? nA : cA + (size_t)(t + 2) * kstep; const char* b2 = last ? nB : cB + (size_t)(t + 2) * kstep;
            const char* a3 = a2 + kstep; const char* b3 = b2 + kstep;
            if (last && has_next) S.a_ready(nxt);
            if constexpr (SP2) {
            PG8_LDB(B0, 0, 0); PG8_LDB(B1, 0, 1); PG8_SCHED; PG8_LDA(At, 0, 0); PG8_STAGE(PG8_SA(1, 1), a1 + hstep, voffA);
            PG8_WAIT_V(8); PG8_WAIT_L(0); PG8_BAR; PG8_MMA(0, 0, At, B0); PG8_MMA(0, 1, At, B1); PG8_BAR; PG8_SCHED;
            PG8_LDA(At, 0, 1); PG8_STAGE(PG8_SB(0, 0), b2, voffB); PG8_STAGE(PG8_SB(0, 1), b2 + hstep, voffB); PG8_STAGE(PG8_SA(0, 0), a2, voffA);
            PG8_WAIT_V(8); PG8_WAIT_L(0); PG8_BAR; PG8_MMA(1, 0, At, B0); PG8_MMA(1, 1, At, B1); PG8_BAR; PG8_SCHED;
            PG8_LDB(B0, 1, 0); PG8_LDB(B1, 1, 1); PG8_SCHED; PG8_LDA(At, 1, 0); PG8_STAGE(PG8_SA(0, 1), a2 + hstep, voffA);
            PG8_WAIT_V(8); PG8_WAIT_L(0); PG8_BAR; PG8_MMA(0, 0, At, B0); PG8_MMA(0, 1, At, B1); PG8_BAR; PG8_SCHED;
            PG8_LDA(At, 1, 1); PG8_STAGE(PG8_SB(1, 0), b3, voffB); PG8_STAGE(PG8_SB(1, 1), b3 + hstep, voffB); PG8_STAGE(PG8_SA(1, 0), a3, voffA);
            PG8_WAIT_V(8); PG8_WAIT_L(0); PG8_BAR; PG8_MMA(1, 0, At, B0); PG8_MMA(1, 1, At, B1); PG8_BAR; PG8_SCHED;
            } else {
            PG8_LDB(B0, 0, 0); PG8_SCHED; PG8_LDA(At, 0, 0); PG8_STAGE(PG8_SA(1, 1), a1 + hstep, voffA);
            PG8_WAIT_L(8); PG8_BAR; PG8_WAIT_L(0); PG8_MMA(0, 0, At, B0); PG8_BAR; PG8_SCHED;
            PG8_LDB(B1, 0, 1); PG8_STAGE(PG8_SB(0, 0), b2, voffB);
            PG8_BAR; PG8_WAIT_L(0); PG8_MMA(0, 1, At, B1); PG8_BAR;
            PG8_LDA(At, 0, 1); PG8_STAGE(PG8_SA(0, 0), a2, voffA);
            PG8_BAR; PG8_WAIT_L(0); PG8_MMA(1, 0, At, B0); PG8_BAR; PG8_SCHED;
            PG8_STAGE(PG8_SB(0, 1), b2 + hstep, voffB);
            PG8_WAIT_V(6); PG8_BAR; PG8_MMA(1, 1, At, B1); PG8_BAR;
            PG8_LDB(B0, 1, 0); PG8_SCHED; PG8_LDA(At, 1, 0); PG8_STAGE(PG8_SA(0, 1), a2 + hstep, voffA);
            PG8_WAIT_L(8); PG8_BAR; PG8_WAIT_L(0); PG8_MMA(0, 0, At, B0); PG8_BAR; PG8_SCHED;
            PG8_LDB(B1, 1, 1); PG8_STAGE(PG8_SB(1, 0), b3, voffB);
            PG8_BAR; PG8_WAIT_L(0); PG8_MMA(0, 1, At, B1); PG8_BAR;
            PG8_LDA(At, 1, 1); PG8_STAGE(PG8_SA(1, 0), a3, voffA);
            PG8_BAR; PG8_WAIT_L(0); PG8_MMA(1, 0, At, B0); PG8_BAR; PG8_SCHED;
            PG8_STAGE(PG8_SB(1, 1), b3 + hstep, voffB);
            PG8_WAIT_V(6); PG8_BAR; PG8_MMA(1, 1, At, B1); PG8_BAR;
            }
        }
        if constexpr (ALIGN_EPI) { if (wr == 0) PG8_BAR; }
        if constexpr (!Epi::AFTER_DRAIN) { const int le_ = opaque_lane(); E(acc, cur, wr, wc, le_ & 15, le_ >> 4); S.done(cur); }
        if (!has_next) break;
#pragma unroll
        for (int a = 0; a < 2; ++a)
#pragma unroll
            for (int b = 0; b < 2; ++b)
#pragma unroll
                for (int m = 0; m < 4; ++m)
#pragma unroll
                    for (int n = 0; n < 2; ++n) acc[a][b][m][n] = (f32x4){0.f, 0.f, 0.f, 0.f};
        cur = nxt; cA = nA; cB = nB; ++ui;
        if constexpr (ALIGN_EPI) { if (wr == 1) PG8_BAR; }
    }
    PG8_WAIT_V(0);
    if constexpr (!ALIGN_EPI) { if (wr == 0) PG8_BAR; }
    PG8_BAR;
    if constexpr (Epi::AFTER_DRAIN) { E.fused(acc, cur, wr, wc, fr, fq, lds, wid, lane); S.done(cur); }
#undef PG8_SA
#undef PG8_SB
#undef PG8_STAGE
#undef PG8_LDA
#undef PG8_LDB
#undef PG8_MMA
#undef PG8_WAIT_V
#undef PG8_WAIT_L
#undef PG8_BAR
#undef PG8_SCHED
}
}

constexpr int NWAVES = 8;
constexpr int DM = 2048, NBATCH = 2, SEQ = 8192, CTXL = 256, TPB = CTXL + SEQ  , MALL = NBATCH * TPB  ;
constexpr int NLAYER = 2;
constexpr int RW = 1024, NH = 16;
constexpr int RWC = 3392, INA = 4192, INA_P = 4352, INC = 8288;
constexpr int C_WD = 3072, C_AD = 3200, C_GD = 3328, C_QC = 3392, C_KVC = 3904, C_KR = 4160;
constexpr int QKD = 96, NQ = NH * QKD  , NKV = NH * 128  ;
constexpr int NEXP = 16384;
constexpr int RREC = 9 * 64;
constexpr float NORM_EPS = 1e-6f;

constexpr size_t MiB = 1u << 20;
constexpr size_t WS_CTL = 0, CTL_ZERO_BYTES = 1 * MiB;
constexpr size_t CTL_MOD_OFF = 256 * 1024;
constexpr size_t WS_ROPE = 1 * MiB;
constexpr size_t WS_WUP = 3 * MiB, WS_AUP = WS_WUP + 512 * 1024, WS_GUP = 4 * MiB;
constexpr size_t WS_WUQ = 5 * MiB, WS_WUKV = 8 * MiB, WS_WA = 10 * MiB, WS_WB = 18 * MiB, WS_WO = 26 * MiB, WS_WQK = 42 * MiB, WS_WGA = 58 * MiB, WS_WGB = 74 * MiB, WS_WINA = 90 * MiB;
constexpr size_t WS_X = 124 * MiB, WS_H = 256 * MiB, WS_DYN = 322 * MiB;
constexpr size_t WS_PA = WS_DYN;
constexpr size_t WS_RI = 463 * MiB;
constexpr size_t WS_GG = 760 * MiB;
constexpr size_t WS_BON = 826 * MiB;
constexpr size_t WS_QN = 829 * MiB, WS_KVN = 846 * MiB;
constexpr size_t WS_Q = 855 * MiB, WS_K = 905 * MiB, WS_V = 955 * MiB, WS_END = 988 * MiB;
constexpr size_t WS_Y = WS_DYN;
constexpr size_t WS_YA = 388 * MiB, WS_YB = 421 * MiB;
constexpr size_t WS_T1 = 463 * MiB, WS_T2 = 529 * MiB;
constexpr size_t WS_PU = 600 * MiB, WS_PV = 664 * MiB;
constexpr size_t WS_SC = WS_DYN;
static_assert(WS_PA + (size_t)MALL * INA_P * 2 <= WS_RI && WS_RI + (size_t)NBATCH * NH * TPB * RREC * 2 <= WS_GG && WS_GG + (size_t)2 * MALL * RW * 2 <= WS_BON, "ws map 1");
static_assert(WS_BON + (size_t)2 * MALL * 16 * 4 <= WS_QN && WS_QN + (size_t)MALL * 512 * 2 <= WS_KVN && WS_KVN + (size_t)MALL * 256 * 2 <= WS_Q, "ws map 2");
static_assert(WS_Q + (size_t)NBATCH * NH * TPB * QKD * 2 <= WS_K && WS_K + (size_t)NBATCH * NH * TPB * QKD * 2 <= WS_V && WS_V + (size_t)NBATCH * NH * TPB * 64 * 2 <= WS_END, "ws map 3");
static_assert(WS_Y + (size_t)2 * MALL * RW * 2 <= WS_YA && WS_YA + (size_t)MALL * RW * 2 <= WS_YB && WS_YB + (size_t)MALL * RW * 2 <= WS_RI, "ws map 4");
static_assert(WS_T1 + (size_t)MALL * DM * 2 <= WS_T2 && WS_T2 + (size_t)MALL * DM * 2 <= WS_PU && WS_PU + (size_t)NEXP * DM * 2 <= WS_PV && WS_PV + (size_t)NEXP * DM * 2 <= WS_GG, "ws map 5");
static_assert(WS_SC + (size_t)MALL * DM * 4 <= WS_T1 && WS_X + (size_t)MALL * DM * 4 <= WS_H && WS_H + (size_t)MALL * DM * 2 <= WS_DYN, "ws map 6");
static_assert(WS_WINA + (size_t)NLAYER * INA_P * DM * 2 <= WS_X, "ws map 7");
constexpr size_t CTL_PROBE_OFF = 640 * 1024;
constexpr int CW_BAR = 4096;

constexpr int RING_BYTES = 131072;
constexpr int LDSCTL_OFF = RING_BYTES, MISC_OFF = LDSCTL_OFF + 320;
constexpr int LDS_BYTES = 147456;

#define GAS __attribute__((address_space(1)))
#define LAS __attribute__((address_space(3)))
typedef unsigned short bf16;
typedef unsigned v4u __attribute__((ext_vector_type(4)));
typedef unsigned v2u __attribute__((ext_vector_type(2)));
typedef float f32x4 __attribute__((ext_vector_type(4)));
typedef float f32x2 __attribute__((ext_vector_type(2)));
typedef float f32x16 __attribute__((ext_vector_type(16)));
typedef short bf16x8 __attribute__((ext_vector_type(8)));
typedef short s16x4 __attribute__((ext_vector_type(4)));
typedef __bf16 bf16x2v __attribute__((ext_vector_type(2)));
typedef __bf16 bf16x8v __attribute__((ext_vector_type(8)));
typedef GAS unsigned gu32;
#define RLX_AGENT __ATOMIC_RELAXED, __HIP_MEMORY_SCOPE_AGENT
#define LDS_WAIT() asm volatile("s_waitcnt lgkmcnt(0)" ::: "memory")
#define VM_WAIT() asm volatile("s_waitcnt vmcnt(0)" ::: "memory")
__device__ __forceinline__ unsigned f2bf(float f) { unsigned u = __builtin_bit_cast(unsigned, f); return (u + 0x7fffu + ((u >> 16) & 1u)) >> 16; }
__device__ __forceinline__ unsigned pk2(float lo, float hi) { return pg8::cvt_pk_bf16(lo, hi); }
__device__ __forceinline__ float bflo(unsigned w) { return __builtin_bit_cast(float, w << 16); }
__device__ __forceinline__ float bfhi(unsigned w) { return __builtin_bit_cast(float, w & 0xffff0000u); }
__device__ __forceinline__ float bf1(bf16 h) { return __builtin_bit_cast(float, (unsigned)h << 16); }
__device__ __forceinline__ float sigmoidf_(float x) { return 1.0f / (1.0f + __expf(-x)); }
template <int CTRL> __device__ __forceinline__ float dpp_add(float x) {
    return x + __builtin_bit_cast(float, __builtin_amdgcn_update_dpp(0, __builtin_bit_cast(int, x), CTRL, 0xf, 0xf, true));
}
__device__ __forceinline__ float red16(float x) {
    x = dpp_add<0xB1>(x);
    x = dpp_add<0x4E>(x);
    x = dpp_add<0x141>(x);
    x = dpp_add<0x140>(x);
    return x;
}
template <int CTRL, int RM> __device__ __forceinline__ float dpp_max(float x) {
    return fmaxf(x, __builtin_bit_cast(float, __builtin_amdgcn_update_dpp(__builtin_bit_cast(int, x), __builtin_bit_cast(int, x), CTRL, RM, 0xf, false)));
}
template <int CTRL, int RM> __device__ __forceinline__ float dpp_sum(float x) {
    return x + __builtin_bit_cast(float, __builtin_amdgcn_update_dpp(0, __builtin_bit_cast(int, x), CTRL, RM, 0xf, false));
}
__device__ __forceinline__ float wave_max_u(float x) {
    x = dpp_max<0xB1, 0xf>(x); x = dpp_max<0x4E, 0xf>(x); x = dpp_max<0x141, 0xf>(x); x = dpp_max<0x140, 0xf>(x);
    x = dpp_max<0x142, 0xa>(x); x = dpp_max<0x143, 0xc>(x);
    return __builtin_bit_cast(float, __builtin_amdgcn_readlane(__builtin_bit_cast(int, x), 63));
}
__device__ __forceinline__ float wave_sum_u(float x) {
    x = dpp_sum<0xB1, 0xf>(x); x = dpp_sum<0x4E, 0xf>(x); x = dpp_sum<0x141, 0xf>(x); x = dpp_sum<0x140, 0xf>(x);
    x = dpp_sum<0x142, 0xa>(x); x = dpp_sum<0x143, 0xc>(x);
    return __builtin_bit_cast(float, __builtin_amdgcn_readlane(__builtin_bit_cast(int, x), 63));
}
__device__ __forceinline__ float wave_sum(float v) { return wave_sum_u(v); }
__device__ __forceinline__ float bpermf(int srclane, float v) { return __builtin_bit_cast(float, __builtin_amdgcn_ds_bpermute(srclane << 2, __builtin_bit_cast(int, v))); }
__device__ __forceinline__ int bpermi(int srclane, int v) { return __builtin_amdgcn_ds_bpermute(srclane << 2, v); }

#define XB_TMO      128
#define XB_XCNT(j)  (256  + 64 * (j))
#define XB_XSUB(j)  (1280 + 64 * (j))
#define XB_XGEN(j)  (2304 + 64 * (j))
#define XB_TOP      3328
#define XB_TOPGEN   3392
#define XCD_BAR_WORDS 3456
#define XB_SPIN_CAP (1u << 20)

__device__ __forceinline__ unsigned xb_ld(unsigned* p)              { return __hip_atomic_load(p, __ATOMIC_RELAXED, __HIP_MEMORY_SCOPE_AGENT); }
__device__ __forceinline__ unsigned xb_add(unsigned* p, unsigned v) { return __hip_atomic_fetch_add(p, v, __ATOMIC_RELAXED, __HIP_MEMORY_SCOPE_AGENT); }
__device__ __forceinline__ unsigned xb_xcc_id() { return (unsigned)__builtin_amdgcn_s_getreg((3 << 11) | 20) & 0xFu; }
#define XB_SPIN(cond, bar) do { unsigned _sp = 0; while (cond) { __builtin_amdgcn_s_sleep(1); \
    if ((++_sp & 255u) == 0u) { if (xb_ld(&(bar)[XB_TMO])) break; if (_sp > XB_SPIN_CAP) { atomicAdd(&(bar)[XB_TMO], 1u); break; } } } } while (0)

struct XcdBarrier { unsigned* bar; unsigned x; volatile LAS unsigned* st; };

__device__ __forceinline__ XcdBarrier xcd_barrier_post(unsigned* bar, volatile LAS unsigned* st, bool t0) {
    XcdBarrier b; b.bar = bar; b.x = xb_xcc_id(); b.st = st;
    if (t0) (void)xb_add(&bar[XB_XCNT(b.x)], 1u);
    return b;
}
__device__ __forceinline__ void xcd_barrier_complete(unsigned* bar, unsigned x, unsigned& nloc, unsigned& nx) {
    const unsigned G = gridDim.x * gridDim.y * gridDim.z;
    unsigned sum, cnt, mine, sp = 0u;
    for (;;) {
        sum = 0u; cnt = 0u; mine = 0u;
#pragma unroll
        for (unsigned j = 0; j < 16; ++j) { const unsigned c = xb_ld(&bar[XB_XCNT(j)]); sum += c; cnt += (c > 0u) ? 1u : 0u; mine = (j == x) ? c : mine; }
        if (sum == G) break;
        __builtin_amdgcn_s_sleep(1);
        if ((++sp & 255u) == 0u) { if (xb_ld(&bar[XB_TMO])) break; if (sp > XB_SPIN_CAP) { atomicAdd(&bar[XB_TMO], 1u); break; } }
    }
    nloc = mine > 0u ? mine : 1u; nx = cnt > 0u ? cnt : 1u;
}
__device__ __forceinline__ void xcd_barrier(const XcdBarrier& b, bool t0) {
    asm volatile("s_waitcnt vmcnt(0)" ::: "memory");
    __syncthreads();
    if (t0) {
        unsigned* bar = b.bar;
        __builtin_amdgcn_s_waitcnt(0);
        unsigned nloc = b.st[0], nx = b.st[1];
        if (nloc == 0u) { xcd_barrier_complete(bar, b.x, nloc, nx); b.st[0] = nloc; b.st[1] = nx; }
        const unsigned old = xb_add(&bar[XB_XSUB(b.x)], 1u);
        const unsigned gen = old / nloc;
        if (old + 1u == (gen + 1u) * nloc) {
            __builtin_amdgcn_fence(__ATOMIC_RELEASE, "agent");
            asm volatile("s_waitcnt vmcnt(0)" ::: "memory");
            const unsigned og = xb_add(&bar[XB_TOP], 1u);
            const unsigned tg = og / nx;
            if (og + 1u == (tg + 1u) * nx) xb_add(&bar[XB_TOPGEN], 1u);
            else XB_SPIN(xb_ld(&bar[XB_TOPGEN]) == tg, bar);
            __builtin_amdgcn_fence(__ATOMIC_ACQUIRE, "agent");
            xb_add(&bar[XB_XGEN(b.x)], 1u);
            asm volatile("s_waitcnt vmcnt(0)" ::: "memory");
        } else {
            XB_SPIN(xb_ld(&bar[XB_XGEN(b.x)]) == gen, bar);
            __builtin_amdgcn_fence(__ATOMIC_ACQUIRE, "agent");
            asm volatile("s_waitcnt vmcnt(0)" ::: "memory");
        }
    }
    __syncthreads();
}

struct Frame {
    LAS unsigned char* lds;
    unsigned char* ws;
    const float* const* in;
    int tid, lane, wave;
    int vcu, G;
};
struct Args { const float* in[33]; float* out; unsigned char* ws; int ph_lo, ph_hi; };


namespace pg8 {
typedef unsigned u32x4 __attribute__((ext_vector_type(4)));
struct RowOrder : StaticOrder {
    int lat;
    __host__ __device__ void init_rows(int lat_, int N, int G_, int c_) { lat = lat_; init(lat_ ? NBATCH * SEQ : MALL, N, G_, c_); }
    __host__ __device__ bool next(int i, Unit& u) const { if (!StaticOrder::next(i, u)) return false; if (lat) u.pm = 33 * (u.pm >> 5) + 1 + (u.pm & 31); return true; }
};
#define EPI_LOOP_ROWS for (int ai = 0; ai < 2; ++ai) _Pragma("unroll") for (int m = 0; m < 4; ++m)
#define EPI_PIN asm volatile("" ::: "memory")

struct EpiStoreBf16 {
    static constexpr bool PERM = true, AFTER_DRAIN = false;
    bf16_t* O; int ldc;
    __device__ __forceinline__ void operator()(const f32x4 (&acc)[2][2][4][2], const Unit& u, int wr, int wc, int fr, int fq) const {
        const int row0 = u.pm * BM + wr * 64 + fr, col0 = u.pn * BM + wc * 32 + 8 * fq;
#pragma unroll
        EPI_LOOP_ROWS { bf16_t* rowp = O + (size_t)(row0 + ai * HALF + m * 16) * ldc + col0;
#pragma unroll
            for (int bj = 0; bj < 2; ++bj) { const f32x4 v0 = acc[ai][bj][m][0], v1 = acc[ai][bj][m][1];
                u32x4 w; w.x = cvt_pk_bf16(v0[0], v0[1]); w.y = cvt_pk_bf16(v0[2], v0[3]); w.z = cvt_pk_bf16(v1[0], v1[1]); w.w = cvt_pk_bf16(v1[2], v1[3]);
                *(u32x4*)(rowp + bj * HALF) = w; } }
    }
};
struct EpiGate {
    static constexpr bool PERM = true, AFTER_DRAIN = false;
    bf16_t* O; int ldc; const float* bias;
    __device__ __forceinline__ void operator()(const f32x4 (&acc)[2][2][4][2], const Unit& u, int wr, int wc, int fr, int fq) const {
        const int row0 = u.pm * BM + wr * 64 + fr, col0 = u.pn * BM + wc * 32 + 8 * fq;
        f32x4 bv[2][2];
#pragma unroll
        for (int bj = 0; bj < 2; ++bj)
#pragma unroll
            for (int n = 0; n < 2; ++n) bv[bj][n] = *(const f32x4*)(bias + col0 + bj * HALF + 4 * n);
#pragma unroll
        EPI_LOOP_ROWS { EPI_PIN; bf16_t* rowp = O + (size_t)(row0 + ai * HALF + m * 16) * ldc + col0;
#pragma unroll
            for (int bj = 0; bj < 2; ++bj) { f32x4 v0 = acc[ai][bj][m][0] + bv[bj][0], v1 = acc[ai][bj][m][1] + bv[bj][1];
#pragma unroll
                for (int e = 0; e < 4; ++e) { v0[e] = 1.0f / (1.0f + __expf(-v0[e])); v1[e] = 1.0f / (1.0f + __expf(-v1[e])); }
                u32x4 w; w.x = cvt_pk_bf16(v0[0], v0[1]); w.y = cvt_pk_bf16(v0[2], v0[3]); w.z = cvt_pk_bf16(v1[0], v1[1]); w.w = cvt_pk_bf16(v1[2], v1[3]);
                *(u32x4*)(rowp + bj * HALF) = w; } }
    }
};
__device__ __forceinline__ float bf_lo(unsigned w) { return __builtin_bit_cast(float, w << 16); }
__device__ __forceinline__ float bf_hi(unsigned w) { return __builtin_bit_cast(float, w & 0xffff0000u); }
struct EpiMulAdd {
    static constexpr bool PERM = true, AFTER_DRAIN = false;
    bf16_t* O; const bf16_t* Gt; const bf16_t* Ad; int ldc;
    __device__ __forceinline__ void operator()(const f32x4 (&acc)[2][2][4][2], const Unit& u, int wr, int wc, int fr, int fq) const {
        const int row0 = u.pm * BM + wr * 64 + fr, col0 = u.pn * BM + wc * 32 + 8 * fq;
#pragma unroll
        EPI_LOOP_ROWS { EPI_PIN; const size_t ro = (size_t)(row0 + ai * HALF + m * 16) * ldc + col0;
#pragma unroll
            for (int bj = 0; bj < 2; ++bj) { const f32x4 v0 = acc[ai][bj][m][0], v1 = acc[ai][bj][m][1];
                const u32x4 g = *(const u32x4*)(Gt + ro + bj * HALF);
                float o[8];
                o[0] = bf_lo(g.x) * v0[0]; o[1] = bf_hi(g.x) * v0[1]; o[2] = bf_lo(g.y) * v0[2]; o[3] = bf_hi(g.y) * v0[3];
                o[4] = bf_lo(g.z) * v1[0]; o[5] = bf_hi(g.z) * v1[1]; o[6] = bf_lo(g.w) * v1[2]; o[7] = bf_hi(g.w) * v1[3];
                if (Ad) { const u32x4 a = *(const u32x4*)(Ad + ro + bj * HALF);
                    o[0] += bf_lo(a.x); o[1] += bf_hi(a.x); o[2] += bf_lo(a.y); o[3] += bf_hi(a.y); o[4] += bf_lo(a.z); o[5] += bf_hi(a.z); o[6] += bf_lo(a.w); o[7] += bf_hi(a.w); }
                u32x4 w; w.x = cvt_pk_bf16(o[0], o[1]); w.y = cvt_pk_bf16(o[2], o[3]); w.z = cvt_pk_bf16(o[4], o[5]); w.w = cvt_pk_bf16(o[6], o[7]);
                *(u32x4*)(O + ro + bj * HALF) = w; } }
    }
};
struct EpiResid {
    static constexpr bool PERM = false, AFTER_DRAIN = false;
    float* X; const float* gate;
    __device__ __forceinline__ void operator()(const f32x4 (&acc)[2][2][4][2], const Unit& u, int wr, int wc, int fr, int fq) const {
        const int row0 = u.pm * BM + wr * 64 + fr, col0 = u.pn * BM + wc * 32 + 4 * fq;
        const int bb = u.pm / 33, mr = (u.pm - bb * 33 == 0) ? 2 : bb;
        const float* gp = gate + (size_t)mr * 12288 + col0;
        f32x4 gv[2][2];
#pragma unroll
        for (int bj = 0; bj < 2; ++bj)
#pragma unroll
            for (int n = 0; n < 2; ++n) gv[bj][n] = *(const f32x4*)(gp + bj * HALF + n * 16);
#pragma unroll
        EPI_LOOP_ROWS { EPI_PIN; float* rowp = X + (size_t)(row0 + ai * HALF + m * 16) * DM + col0;
#pragma unroll
            for (int bj = 0; bj < 2; ++bj)
#pragma unroll
                for (int n = 0; n < 2; ++n) { f32x4* p = (f32x4*)(rowp + bj * HALF + n * 16); *p = *p + gv[bj][n] * acc[ai][bj][m][n]; } }
    }
};
struct EpiF32 {
    static constexpr bool PERM = false, AFTER_DRAIN = false;
    float* C; int ldc;
    __device__ __forceinline__ void operator()(const f32x4 (&acc)[2][2][4][2], const Unit& u, int wr, int wc, int fr, int fq) const {
        const int row0 = u.pm * BM + wr * 64 + fr, col0 = u.pn * BM + wc * 32 + 4 * fq;
#pragma unroll
        EPI_LOOP_ROWS { float* rowp = C + (size_t)(row0 + ai * HALF + m * 16) * ldc + col0;
#pragma unroll
            for (int bj = 0; bj < 2; ++bj)
#pragma unroll
                for (int n = 0; n < 2; ++n) *(f32x4*)(rowp + bj * HALF + n * 16) = acc[ai][bj][m][n]; }
    }
};
struct EpiQ {
    static constexpr bool PERM = true, AFTER_DRAIN = false;
    bf16_t* Q; const f32x2* rope; float qscale;
    __device__ __forceinline__ void operator()(const f32x4 (&acc)[2][2][4][2], const Unit& u, int wr, int wc, int fr, int fq) const {
        const int bb = u.pm / 33, tp0 = (u.pm - bb * 33) * BM + wr * 64 + fr, col0 = u.pn * BM + wc * 32 + 8 * fq;
#pragma unroll
        for (int bj = 0; bj < 2; ++bj) { const int c = col0 + bj * HALF, hd = c / QKD, d = c - hd * QKD;
#pragma unroll
            EPI_LOOP_ROWS { EPI_PIN; const int tp = tp0 + ai * HALF + m * 16;
                f32x4 v0 = acc[ai][bj][m][0], v1 = acc[ai][bj][m][1];
                if (d >= 64) { const int i0 = (d - 64) >> 1; const f32x2* rp = rope + (size_t)tp * 16 + i0;
                    const f32x2 c0 = rp[0], c1 = rp[1], c2 = rp[2], c3 = rp[3];
                    float a, b;
                    a = v0[0]; b = v0[1]; v0[0] = a * c0.x - b * c0.y; v0[1] = a * c0.y + b * c0.x;
                    a = v0[2]; b = v0[3]; v0[2] = a * c1.x - b * c1.y; v0[3] = a * c1.y + b * c1.x;
                    a = v1[0]; b = v1[1]; v1[0] = a * c2.x - b * c2.y; v1[1] = a * c2.y + b * c2.x;
                    a = v1[2]; b = v1[3]; v1[2] = a * c3.x - b * c3.y; v1[3] = a * c3.y + b * c3.x; }
                v0 = v0 * qscale; v1 = v1 * qscale;
                u32x4 w; w.x = cvt_pk_bf16(v0[0], v0[1]); w.y = cvt_pk_bf16(v0[2], v0[3]); w.z = cvt_pk_bf16(v1[0], v1[1]); w.w = cvt_pk_bf16(v1[2], v1[3]);
                *(u32x4*)(Q + ((size_t)(bb * NH + hd) * TPB + tp) * QKD + d) = w; } }
    }
};
struct EpiKV {
    static constexpr bool PERM = true, AFTER_DRAIN = false;
    bf16_t* K; bf16_t* V;
    __device__ __forceinline__ void operator()(const f32x4 (&acc)[2][2][4][2], const Unit& u, int wr, int wc, int fr, int fq) const {
        const int bb = u.pm / 33, tp0 = (u.pm - bb * 33) * BM + wr * 64 + fr;
        const bool isK = wc < 2;
        bf16_t* base = isK ? K : V; const int pitch = isK ? QKD : 64, doff = 32 * (wc & 1) + 8 * fq;
#pragma unroll
        for (int bj = 0; bj < 2; ++bj) { const int hd = 2 * u.pn + bj;
            bf16_t* hb = base + (size_t)(bb * NH + hd) * TPB * pitch;
#pragma unroll
            EPI_LOOP_ROWS { EPI_PIN; const int tp = tp0 + ai * HALF + m * 16;
                const f32x4 v0 = acc[ai][bj][m][0], v1 = acc[ai][bj][m][1];
                u32x4 w; w.x = cvt_pk_bf16(v0[0], v0[1]); w.y = cvt_pk_bf16(v0[2], v0[3]); w.z = cvt_pk_bf16(v1[0], v1[1]); w.w = cvt_pk_bf16(v1[2], v1[3]);
                *(u32x4*)((char*)hb + (unsigned)((tp * pitch + doff) * 2)) = w; } }
    }
};
}

template <int MAPQ>
__device__ __forceinline__ void p0_transpose_item(const float* W, int K, int ldw, int c0, int N, bf16* WT, LAS float* scr, int item, int lane) {
    const int nblk = N / 32, kb = item / nblk, nb = item % nblk, k0 = 64 * kb, n0 = 32 * nb;
#pragma unroll 8
    for (int i = 0; i < 32; ++i) { const int kk = 2 * i + (lane >> 5); scr[kk * 33 + (lane & 31)] = W[(size_t)(k0 + kk) * ldw + c0 + n0 + (lane & 31)]; }
    LDS_WAIT(); asm volatile("" ::: "memory");
    const int c = lane & 7;
#pragma unroll
    for (int j = 0; j < 4; ++j) { const int n = (lane >> 3) + 8 * j; const LAS float* s = scr + (8 * c) * 33 + n;
        v4u o; o.x = pk2(s[0 * 33], s[1 * 33]); o.y = pk2(s[2 * 33], s[3 * 33]); o.z = pk2(s[4 * 33], s[5 * 33]); o.w = pk2(s[6 * 33], s[7 * 33]);
        int nn = n0 + n;
        if (MAPQ) { const int hd = nn / QKD, d = nn - hd * QKD; if (d >= 64) { const int i = (d - 64) & 15, s2 = (d - 64) >> 4; nn = hd * QKD + 64 + 2 * i + s2; } }
        *(GAS v4u*)(WT + (size_t)nn * K + k0 + 8 * c) = o; }
    LDS_WAIT(); asm volatile("" ::: "memory");
}

__device__ __forceinline__ const float* karg(int i);
__device__ __forceinline__ void p0_prologue(Frame& F) {
    LAS float* scr = (LAS float*)(F.lds + F.wave * 16384);
    const int gw = F.vcu * NWAVES + F.wave, NGW = F.G * NWAVES;
    unsigned char* ws = F.ws;
    for (int l = 0; l < NLAYER; ++l) {
        const float* w_in = karg(7) + (size_t)l * DM * INC; const float* wbra = karg(24); const float* wbrb = karg(25); const float* wout = karg(26); const float* wuq = karg(21); const float* wukv = karg(23); const float* wup = karg(11); const float* aup = karg(13);
        constexpr int I_INA = (DM / 64) * (INA / 32), I_G = (DM / 64) * (DM / 32), I_BR = (RW / 64) * (DM / 32), I_UQ = (512 / 64) * (NQ / 32), I_UKV = (256 / 64) * (NKV / 32), I_LR = 1 * (RW / 32);
        constexpr int NIT = I_INA + 2 * I_G + 2 * I_BR + I_G + I_UQ + I_UKV + 4 * I_LR;
        for (int it = gw; it < NIT; it += NGW) {
            int r = it;
            if (r < I_INA) { p0_transpose_item<0>(w_in, DM, INC, 0, INA, (bf16*)(ws + WS_WINA) + (size_t)l * INA_P * DM, scr, r, F.lane); continue; } r -= I_INA;
            if (r < I_G) { p0_transpose_item<0>(w_in, DM, INC, INA, DM, (bf16*)(ws + WS_WGA) + (size_t)l * DM * DM, scr, r, F.lane); continue; } r -= I_G;
            if (r < I_G) { p0_transpose_item<0>(w_in, DM, INC, INA + DM, DM, (bf16*)(ws + WS_WGB) + (size_t)l * DM * DM, scr, r, F.lane); continue; } r -= I_G;
            if (r < I_BR) { p0_transpose_item<0>(wbra + (size_t)l * RW * DM, RW, DM, 0, DM, (bf16*)(ws + WS_WA) + (size_t)l * DM * RW, scr, r, F.lane); continue; } r -= I_BR;
            if (r < I_BR) { p0_transpose_item<0>(wbrb + (size_t)l * RW * DM, RW, DM, 0, DM, (bf16*)(ws + WS_WB) + (size_t)l * DM * RW, scr, r, F.lane); continue; } r -= I_BR;
            if (r < I_G) { p0_transpose_item<0>(wout + (size_t)l * DM * DM, DM, DM, 0, DM, (bf16*)(ws + WS_WO) + (size_t)l * DM * DM, scr, r, F.lane); continue; } r -= I_G;
            if (r < I_UQ) { p0_transpose_item<1>(wuq + (size_t)l * 512 * NQ, 512, NQ, 0, NQ, (bf16*)(ws + WS_WUQ) + (size_t)l * NQ * 512, scr, r, F.lane); continue; } r -= I_UQ;
            if (r < I_UKV) { p0_transpose_item<0>(wukv + (size_t)l * 256 * NKV, 256, NKV, 0, NKV, (bf16*)(ws + WS_WUKV) + (size_t)l * NKV * 256, scr, r, F.lane); continue; } r -= I_UKV;
            { const int which = r / I_LR, d = which & 1, isa = which >> 1; r -= which * I_LR;
              const float* src = (isa ? aup : wup) + (size_t)(l * 2 + d) * 64 * RW;
              bf16* dst = (bf16*)(ws + (isa ? WS_AUP : WS_WUP)) + (size_t)(l * 2 + d) * RW * 64;
              p0_transpose_item<0>(src, 64, RW, 0, RW, dst, scr, r, F.lane); }
        }
    }
    const int gt = gw * 64 + F.lane, NGT = NGW * 64;
    { const float* gup = karg(14);
    for (int i = gt; i < NLAYER * 2 * 32 * RW; i += NGT) { const int ch = i & 1023, r = (i >> 10) & 31, ld = i >> 15;
        ((bf16*)(ws + WS_GUP))[((size_t)ld * RW + ch) * 32 + r] = (bf16)f2bf(gup[i]); } }
    for (int i = gt; i < NLAYER * (INA_P - INA) * DM / 8; i += NGT) { const int l = i / ((INA_P - INA) * DM / 8), r = i - l * ((INA_P - INA) * DM / 8);
        ((GAS v4u*)((bf16*)(ws + WS_WINA) + ((size_t)l * INA_P + INA) * DM))[r] = (v4u){0u, 0u, 0u, 0u}; }
    { const GAS f32x4* xs = (const GAS f32x4*)karg(0); const GAS f32x4* cs = (const GAS f32x4*)karg(2); GAS f32x4* X = (GAS f32x4*)(ws + WS_X);
      for (int i = gt; i < MALL * (DM / 4); i += NGT) { const int m = i >> 9, c4 = i & 511, b = m / TPB, tp = m - b * TPB;
          X[i] = (tp < CTXL) ? cs[((size_t)(b * CTXL + tp) << 9) + c4] : xs[((size_t)(b * SEQ + tp - CTXL) << 9) + c4]; } }
    { f32x2* rt = (f32x2*)(ws + WS_ROPE);
      for (int i = gt; i < TPB * 16; i += NGT) { const int tp = i >> 4, k = i & 15; f32x2 o = {1.f, 0.f};
          if (tp >= CTXL) { const int t = tp - CTXL, row = t >> 6, col = t & 63, j = k & 7; const float fr = powf(10000.0f, -(float)j / 8.0f);
              const float ang = (float)(k < 8 ? row : col) * fr; o.x = cosf(ang); o.y = sinf(ang); }
          rt[i] = o; } }
    { float* modw = (float*)(ws + WS_CTL + CTL_MOD_OFF); const float* adaw = karg(4); const float* adab = karg(5); const float* cin = karg(1); const float* cctx = karg(3);
      LAS f32x4* part = (LAS f32x4*)F.lds;
      for (int uu = F.vcu; uu < NLAYER * 48; uu += F.G) { const int cb = uu % 48, l = uu / 48;
          const int n0 = cb * 256 + F.lane * 4; const float* aw = adaw + (size_t)l * DM * 12288 + n0;
          f32x4 a0 = {0, 0, 0, 0}, a1 = a0, a2 = a0;
#pragma unroll 8
          for (int k = F.wave * 256; k < F.wave * 256 + 256; ++k) { const f32x4 w = *(const GAS f32x4*)(aw + (size_t)k * 12288);
              const float c0 = cin[k], c1 = cin[DM + k], c2 = cctx[k];
              const float s0 = c0 / (1.f + __expf(-c0)), s1 = c1 / (1.f + __expf(-c1)), s2 = c2 / (1.f + __expf(-c2));
              a0 = a0 + w * s0; a1 = a1 + w * s1; a2 = a2 + w * s2; }
          __syncthreads();
          part[(F.wave * 3 + 0) * 64 + F.lane] = a0; part[(F.wave * 3 + 1) * 64 + F.lane] = a1; part[(F.wave * 3 + 2) * 64 + F.lane] = a2;
          __syncthreads();
          if (F.wave < 3) { f32x4 s = *(const GAS f32x4*)(adab + (size_t)l * 12288 + n0);
#pragma unroll
              for (int w8 = 0; w8 < 8; ++w8) s = s + part[(w8 * 3 + F.wave) * 64 + F.lane];
              *(GAS f32x4*)(modw + ((size_t)l * 3 + F.wave) * 12288 + n0) = s; }
          __syncthreads(); } }
    { LAS float* KEY = (LAS float*)F.lds;
      LAS float* WQT = (LAS float*)(F.lds + 65536);
      const float* pkeys = karg(29); const float* pwq = karg(28);
      __syncthreads();
      for (int uu = F.vcu; uu < NLAYER * 16 * 32; uu += F.G) { const int kb = uu & 31, hp = (uu >> 5) & 15, l = uu >> 9;
          const GAS f32x4* ksrc = (const GAS f32x4*)(pkeys + ((size_t)l * 16 + hp) * 16384);
          for (int i = F.tid; i < 4096; i += 512) ((LAS f32x4*)KEY)[i] = ksrc[i];
          for (int i = F.tid; i < 2048; i += 512) { const int kk = i >> 5, d4 = i & 31;
              *(LAS f32x4*)(WQT + kk * 132 + d4 * 4) = *(const GAS f32x4*)(pwq + ((size_t)l * DM + kb * 64 + kk) * DM + hp * 128 + d4 * 4); }
          __syncthreads();
          const int kk = F.tid & 63, kg = F.tid >> 6;
          float acc[16];
#pragma unroll
          for (int j = 0; j < 16; ++j) acc[j] = 0.f;
          for (int d = 0; d < 128; d += 4) { const f32x4 w = *(LAS f32x4*)(WQT + kk * 132 + d);
#pragma unroll
              for (int j = 0; j < 16; ++j) { const f32x4 q = *(LAS f32x4*)(KEY + (kg * 16 + j) * 128 + d); acc[j] += q.x * w.x + q.y * w.y + q.z * w.z + q.w * w.w; } }
          bf16* dst = (bf16*)(ws + WS_WQK) + ((size_t)l * DM + hp * 128 + kg * 16) * DM + kb * 64 + kk;
#pragma unroll
          for (int j = 0; j < 16; ++j) dst[(size_t)j * DM] = (bf16)f2bf(acc[j]);
          __syncthreads(); } }
}

__device__ __forceinline__ void modnorm_phase(Frame& F, const float* X, const float* g, const float* mod  , int chunk_sh, bf16* H, int skip_ctx) {
    const int gw = F.vcu * NWAVES + F.wave, NGW = F.G * NWAVES;
    for (int m = gw; m < MALL; m += NGW) {
        const int b = m / TPB, tp = m - b * TPB; if (skip_ctx && tp < CTXL) continue;
        const int mr = tp < CTXL ? 2 : b;
        const GAS f32x4* xr = (const GAS f32x4*)(X + (size_t)m * DM) + F.lane;
        f32x4 v[8]; float s = 0.f;
#pragma unroll
        for (int j = 0; j < 8; ++j) { v[j] = xr[64 * j]; s += (v[j].x * v[j].x + v[j].y * v[j].y) + (v[j].z * v[j].z + v[j].w * v[j].w); }
        const float rs = rsqrtf(wave_sum(s) * (1.f / DM) + NORM_EPS);
        const float* sh = mod + (size_t)mr * 12288 + chunk_sh * DM; const float* sc = sh + DM;
        GAS v2u* o8 = (GAS v2u*)(H + (size_t)m * DM) + F.lane;
#pragma unroll
        for (int j = 0; j < 8; ++j) { const int c = (F.lane + 64 * j) * 4;
            const f32x4 gg = *(const GAS f32x4*)(g + c), s1 = *(const GAS f32x4*)(sc + c), s0 = *(const GAS f32x4*)(sh + c);
            f32x4 y = v[j] * rs * gg; y = y * (s1 + 1.0f) + s0;
            v2u o; o.x = pk2(y.x, y.y); o.y = pk2(y.z, y.w); o8[64 * j] = o; }
    }
}

typedef float f32x4v __attribute__((ext_vector_type(4)));
#define MFMA16(a, b, c) __builtin_amdgcn_mfma_f32_16x16x32_bf16((a), (b), (c), 0, 0, 0)
#define MFMA32(a, b, c) __builtin_amdgcn_mfma_f32_32x32x16_bf16((a), (b), (c), 0, 0, 0)

struct FeatP {
    const bf16* PA; const float* mu; const float* w0; const float* a0; const float* k_k; const float* k_a; const float* r_k;
    const bf16* WUP; const bf16* AUP; const bf16* GUP;
    const float* qnorm; const float* kvnorm; const f32x2* rope;
    bf16* RI; bf16* GG; float* BON; bf16* QN; bf16* KVN; bf16* K;
};
__device__ __forceinline__ f32x4 ld4bf(const bf16* p) { const v2u w = *(const GAS v2u*)p; return (f32x4){bflo(w.x), bfhi(w.x), bflo(w.y), bfhi(w.y)}; }
__device__ __forceinline__ f32x4 mix4(const bf16* PA, int m, int c, bool hp, bool hn, const float* mu) {
    const f32x4 pc = ld4bf(PA + (size_t)m * INA_P + c);
    f32x4 pp = {0, 0, 0, 0}, pn = {0, 0, 0, 0};
    if (hp) pp = ld4bf(PA + (size_t)(m - 1) * INA_P + c);
    if (hn) pn = ld4bf(PA + (size_t)(m + 1) * INA_P + c);
    const f32x4 mm = *(const GAS f32x4*)(mu + c);
    return pc + ((pp + pn) * 0.5f - pc) * mm;
}
__device__ __forceinline__ void features_phase(Frame& F, const FeatP& P) {
    constexpr int LAP = 328;
    LAS bf16* LA = (LAS bf16*)F.lds;
    const int lane = F.lane, w = F.wave;
    for (int uu = F.vcu; uu < MALL / 16; uu += F.G) {
        const int m0 = uu * 16;
        __syncthreads();
        { const int tk = F.tid >> 5, l32 = F.tid & 31, m = m0 + tk, tp = m % TPB;
          const bool hp = (tp != 0) && (tp != CTXL), hn = (tp != CTXL - 1) && (tp != TPB - 1);
          const bf16* row = P.PA + (size_t)m * INA_P;
#pragma unroll
          for (int i = 0; i < 10; ++i) { const int c = C_WD + l32 + 32 * i;
              const float pc = bf1(row[c]), pp = hp ? bf1(row[c - INA_P]) : 0.f, pn = hn ? bf1(row[c + INA_P]) : 0.f;
              float v = pc + (0.5f * (pp + pn) - pc) * P.mu[c];
              if (c < C_AD) v = tanhf(v); else if (c >= C_GD) v = sigmoidf_(v);
              LA[tk * LAP + (c - C_WD)] = (bf16)f2bf(v); } }
#pragma unroll
        for (int tt = 0; tt < 2; ++tt) { const int m = m0 + 2 * w + tt, b = m / TPB, tp = m - b * TPB; const bf16* row = P.PA + (size_t)m * INA_P;
            { const v4u q = *(const GAS v4u*)(row + C_QC + lane * 8);
              float x[8] = {bflo(q.x), bfhi(q.x), bflo(q.y), bfhi(q.y), bflo(q.z), bfhi(q.z), bflo(q.w), bfhi(q.w)}; float s = 0.f;
#pragma unroll
              for (int e = 0; e < 8; ++e) s += x[e] * x[e];
              const float rs = rsqrtf(wave_sum(s) * (1.f / 512.f) + NORM_EPS);
#pragma unroll
              for (int e = 0; e < 8; ++e) x[e] = x[e] * rs * P.qnorm[lane * 8 + e];
              v4u o; o.x = pk2(x[0], x[1]); o.y = pk2(x[2], x[3]); o.z = pk2(x[4], x[5]); o.w = pk2(x[6], x[7]);
              *(GAS v4u*)(P.QN + (size_t)m * 512 + lane * 8) = o; }
            { const v2u q = *(const GAS v2u*)(row + C_KVC + lane * 4);
              float x[4] = {bflo(q.x), bfhi(q.x), bflo(q.y), bfhi(q.y)}; float s = 0.f;
#pragma unroll
              for (int e = 0; e < 4; ++e) s += x[e] * x[e];
              const float rs = rsqrtf(wave_sum(s) * (1.f / 256.f) + NORM_EPS);
#pragma unroll
              for (int e = 0; e < 4; ++e) x[e] = x[e] * rs * P.kvnorm[lane * 4 + e];
              v2u o; o.x = pk2(x[0], x[1]); o.y = pk2(x[2], x[3]);
              *(GAS v2u*)(P.KVN + (size_t)m * 256 + lane * 4) = o; }
            if (lane < 16) { const float x1 = bf1(row[C_KR + lane]), x2 = bf1(row[C_KR + 16 + lane]); const f32x2 cs = P.rope[(size_t)tp * 16 + lane];
                const unsigned o = pk2(x1 * cs.x - x2 * cs.y, x1 * cs.y + x2 * cs.x);
#pragma unroll
                for (int hd = 0; hd < NH; ++hd) *(GAS unsigned*)(P.K + ((size_t)(b * NH + hd) * TPB + tp) * QKD + 64 + 2 * lane) = o; } }
        __syncthreads();
        const int tk = lane & 15, q4 = lane >> 4, m = m0 + tk, b = m / TPB, tp = m - b * TPB;
        const bool hp = (tp != 0) && (tp != CTXL), hn = (tp != CTXL - 1) && (tp != TPB - 1);
        bf16x8 bw[2][2], ba[2][2], bg[2];
#pragma unroll
        for (int d = 0; d < 2; ++d) {
#pragma unroll
            for (int ks = 0; ks < 2; ++ks) { bw[d][ks] = *(const LAS bf16x8*)(LA + tk * LAP + d * 64 + ks * 32 + q4 * 8); ba[d][ks] = *(const LAS bf16x8*)(LA + tk * LAP + 128 + d * 64 + ks * 32 + q4 * 8); }
            bg[d] = *(const LAS bf16x8*)(LA + tk * LAP + 256 + d * 32 + q4 * 8); }
#pragma unroll
        for (int hh = 0; hh < 2; ++hh) {
            float rsn;
            { float s = 0.f;
#pragma unroll 1
              for (int ct = 0; ct < 4; ++ct) { const int ch = 128 * w + 64 * hh + 16 * ct + 4 * q4; const f32x4 kx = mix4(P.PA, m, RW + ch, hp, hn, P.mu) * *(const GAS f32x4*)(P.k_k + ch);
                  s += kx.x * kx.x + kx.y * kx.y + kx.z * kx.z + kx.w * kx.w; }
              s += bpermf(lane ^ 16, s); s += bpermf(lane ^ 32, s); rsn = rsqrtf(s + 1e-12f); }
            float bon0 = 0.f, bon1 = 0.f;
            const int hd = 2 * w + hh;
#pragma unroll 1
            for (int c4 = 0; c4 < 4; ++c4) {
                const int cb = 128 * w + 64 * hh + 16 * c4, chA = cb + tk  , ch = cb + 4 * q4  ;
                f32x4 cw[2], ca[2], cg[2];
#pragma unroll
                for (int d = 0; d < 2; ++d) { cw[d] = (f32x4){0, 0, 0, 0}; ca[d] = cw[d]; cg[d] = cw[d];
#pragma unroll
                    for (int ks = 0; ks < 2; ++ks) {
                        const bf16x8 aw = *(const GAS bf16x8*)(P.WUP + ((size_t)d * RW + chA) * 64 + ks * 32 + q4 * 8);
                        const bf16x8 aa = *(const GAS bf16x8*)(P.AUP + ((size_t)d * RW + chA) * 64 + ks * 32 + q4 * 8);
                        cw[d] = MFMA16(aw, bw[d][ks], cw[d]); ca[d] = MFMA16(aa, ba[d][ks], ca[d]); }
                    const bf16x8 ag = *(const GAS bf16x8*)(P.GUP + ((size_t)d * RW + chA) * 32 + q4 * 8);
                    cg[d] = MFMA16(ag, bg[d], cg[d]); }
                const f32x4 r4 = mix4(P.PA, m, ch, hp, hn, P.mu), k4 = mix4(P.PA, m, RW + ch, hp, hn, P.mu), v4 = mix4(P.PA, m, 2 * RW + ch, hp, hn, P.mu);
                const f32x4 kk4 = k4 * *(const GAS f32x4*)(P.k_k + ch) * rsn;
                const f32x4 ka4 = *(const GAS f32x4*)(P.k_a + ch), rk4 = *(const GAS f32x4*)(P.r_k + ch);
                const int c64 = ch & 63;
                bf16* rec = P.RI + ((size_t)(b * NH + hd) * TPB + tp) * RREC + c64;
                { v2u o; o.x = pk2(r4.x, r4.y); o.y = pk2(r4.z, r4.w); *(GAS v2u*)(rec) = o;
                  o.x = pk2(kk4.x, kk4.y); o.y = pk2(kk4.z, kk4.w); *(GAS v2u*)(rec + 64) = o;
                  o.x = pk2(v4.x, v4.y); o.y = pk2(v4.z, v4.w); *(GAS v2u*)(rec + 128) = o; }
#pragma unroll
                for (int d = 0; d < 2; ++d) {
                    const f32x4 w0 = *(const GAS f32x4*)(P.w0 + d * RW + ch), a0 = *(const GAS f32x4*)(P.a0 + d * RW + ch);
                    f32x4 ld, aa, ke, bb; float bs = 0.f;
#pragma unroll
                    for (int e = 0; e < 4; ++e) { ld[e] = -0.60653066f * sigmoidf_(w0[e] + cw[d][e]); aa[e] = sigmoidf_(a0[e] + ca[d][e]);
                        ke[e] = k4[e] * (1.0f + (aa[e] - 1.0f) * ka4[e]); bb[e] = kk4[e] * aa[e]; bs += r4[e] * ke[e] * rk4[e]; }
                    if (d == 0) bon0 += bs; else bon1 += bs;
                    v2u o; o.x = pk2(ld.x, ld.y); o.y = pk2(ld.z, ld.w); *(GAS v2u*)(rec + (3 + 3 * d) * 64) = o;
                    o.x = pk2(bb.x, bb.y); o.y = pk2(bb.z, bb.w); *(GAS v2u*)(rec + (4 + 3 * d) * 64) = o;
                    o.x = pk2(ke.x, ke.y); o.y = pk2(ke.z, ke.w); *(GAS v2u*)(rec + (5 + 3 * d) * 64) = o;
                    o.x = pk2(cg[d].x, cg[d].y); o.y = pk2(cg[d].z, cg[d].w); *(GAS v2u*)(P.GG + ((size_t)d * MALL + m) * RW + ch) = o; }
            }
            bon0 += bpermf(lane ^ 16, bon0); bon0 += bpermf(lane ^ 32, bon0); bon1 += bpermf(lane ^ 16, bon1); bon1 += bpermf(lane ^ 32, bon1);
            if (q4 == 0) { P.BON[((size_t)0 * MALL + m) * 16 + hd] = bon0; P.BON[((size_t)1 * MALL + m) * 16 + hd] = bon1; }
        }
    }
}

constexpr int SCH = 32;
constexpr int SSTEP = 6 * 64;
__device__ __forceinline__ int scan_tp(int dir, int s) { return dir == 0 ? s : (s < CTXL ? (CTXL - 1 - s) : (TPB - 1 - (s - CTXL))); }
__device__ __forceinline__ void scan_stage(LAS float* buf, const bf16* RIh  , int dir, int chunk, int htid) {
#pragma unroll
    for (int i = 0; i < 6; ++i) { const int q = htid + 256 * i, st = q / 48, pc = q - st * 48;
        const int tp = scan_tp(dir, chunk * SCH + st);
        const bf16* rec = RIh + (size_t)tp * RREC;
        int so, slot;
        if (pc < 24) { const int arr = pc >> 3; so = arr * 64 + (pc & 7) * 8; slot = (arr == 0) ? 4 : (arr == 1 ? 0 : 5); }
        else { const int p2 = pc - 24, arr = p2 >> 3; so = (3 + 3 * dir + arr) * 64 + (p2 & 7) * 8; slot = (arr == 0) ? 2 : (arr == 1 ? 1 : 3); }
        const v4u wv = *(const GAS v4u*)(rec + so);
        f32x4 lo = {bflo(wv.x), bfhi(wv.x), bflo(wv.y), bfhi(wv.y)}, hi = {bflo(wv.z), bfhi(wv.z), bflo(wv.w), bfhi(wv.w)};
        if (slot == 2) {
#pragma unroll
            for (int e = 0; e < 4; ++e) { lo[e] = __expf(lo[e]); hi[e] = __expf(hi[e]); } }
        LAS float* d = buf + st * SSTEP + slot * 64 + (pc & 7) * 8;
        *(LAS f32x4*)d = lo; *(LAS f32x4*)(d + 4) = hi; }
}
__device__ __forceinline__ void scan_phase(Frame& F, const bf16* RI, bf16* Y) {
    LAS float* bufs = (LAS float*)F.lds;
    constexpr int NCH = TPB / SCH;
    for (int uu = F.vcu; uu < NBATCH * NH * 2 * 4; uu += F.G) {
        const int rg = uu & 3, dir = (uu >> 2) & 1, hd = (uu >> 3) & 15, b = uu >> 7;
        const bf16* RIh = RI + (size_t)(b * NH + hd) * TPB * RREC;
        __syncthreads();
        if (F.wave >= 4) scan_stage(bufs, RIh, dir, 0, F.tid - 256);
        __syncthreads();
        const int j = F.lane & 15, rowl = F.lane >> 4, row = rg * 16 + (F.wave & 3) * 4 + rowl;
        float S0 = 0.f, S1 = 0.f, S2 = 0.f, S3 = 0.f;
        bf16* yb = Y + ((size_t)dir * MALL + (size_t)b * TPB) * RW + hd * 64 + row;
        for (int c = 0; c < NCH; ++c) {
            LAS float* cur = bufs + (c & 1) * (SCH * SSTEP);
            if (F.wave >= 4) { if (c + 1 < NCH) scan_stage(bufs + ((c + 1) & 1) * (SCH * SSTEP), RIh, dir, c + 1, F.tid - 256); }
            else {
#pragma unroll 4
                for (int st = 0; st < SCH; ++st) {
                    const LAS float* sp = cur + st * SSTEP;
                    const f32x4 kk = *(const LAS f32x4*)(sp + 4 * j), bb = *(const LAS f32x4*)(sp + 64 + 4 * j), ww = *(const LAS f32x4*)(sp + 128 + 4 * j),
                                ke = *(const LAS f32x4*)(sp + 192 + 4 * j), rr = *(const LAS f32x4*)(sp + 256 + 4 * j);
                    const float vv = sp[320 + row];
                    float p = (S0 * kk.x + S1 * kk.y) + (S2 * kk.z + S3 * kk.w);
                    S0 = S0 * ww.x + vv * ke.x; S1 = S1 * ww.y + vv * ke.y; S2 = S2 * ww.z + vv * ke.z; S3 = S3 * ww.w + vv * ke.w;
                    const float sa = -red16(p);
                    S0 += sa * bb.x; S1 += sa * bb.y; S2 += sa * bb.z; S3 += sa * bb.w;
                    float y = (S0 * rr.x + S1 * rr.y) + (S2 * rr.z + S3 * rr.w);
                    y = red16(y);
                    if (j == 0) { const int tp = scan_tp(dir, c * SCH + st); yb[(size_t)tp * RW] = (bf16)f2bf(y); }
                }
            }
            __syncthreads();
        }
    }
}

constexpr int AKP = 208, AVP = 192;
constexpr int ATILE = 64 * AKP + 64 * AVP;
__device__ __forceinline__ bf16x8 pack8(const f32x16& x, int s) {
    v4u p; p.x = pk2(x[8 * s + 0], x[8 * s + 1]); p.y = pk2(x[8 * s + 2], x[8 * s + 3]); p.z = pk2(x[8 * s + 4], x[8 * s + 5]); p.w = pk2(x[8 * s + 6], x[8 * s + 7]);
    return __builtin_bit_cast(bf16x8, p);
}
__device__ __forceinline__ void attn_phase(Frame& F, const bf16* Q, const bf16* K, const bf16* V, bf16* YB, int with_ctx) {
    const int lane = F.lane, half = lane >> 5, l31 = lane & 31, l16 = lane & 15, g1 = (lane >> 4) & 1;
    const int nunits = NBATCH * NH * 32 + (with_ctx ? NBATCH * NH : 0);
    for (int uu = F.vcu; uu < nunits; uu += F.G) {
        int bh, q0, nkt;
        if (uu < NBATCH * NH * 32) { bh = uu >> 5; q0 = CTXL + (uu & 31) * 256; nkt = TPB / 64; } else { bh = uu - NBATCH * NH * 32; q0 = 0; nkt = CTXL / 64; }
        const bf16* Kh = K + (size_t)bh * TPB * QKD; const bf16* Vh = V + (size_t)bh * TPB * 64; const bf16* Qh = Q + (size_t)bh * TPB * QKD;
        const int tq = q0 + F.wave * 32 + l31;
        bf16x8 qf[6];
#pragma unroll
        for (int ks = 0; ks < 6; ++ks) qf[ks] = *(const GAS bf16x8*)(Qh + (size_t)tq * QKD + 16 * ks + 8 * half);
        f32x16 o0, o1;
#pragma unroll
        for (int i = 0; i < 16; ++i) { o0[i] = 0.f; o1[i] = 0.f; }
        float m_run = -1e30f, l_run = 0.f;
        const int kc1 = F.tid + 512; const bool k1ok = kc1 < 768;
        const unsigned kd0 = (unsigned)((F.tid / 12) * AKP + (F.tid % 12) * 16), kd1 = (unsigned)((kc1 / 12) * AKP + (kc1 % 12) * 16), vd = (unsigned)(64 * AKP + (F.tid >> 3) * AVP + (F.tid & 7) * 16);
        v4u kr0, kr1 = {0, 0, 0, 0}, vr;
        kr0 = *(const GAS v4u*)(Kh + (size_t)F.tid * 8); if (k1ok) kr1 = *(const GAS v4u*)(Kh + (size_t)kc1 * 8); vr = *(const GAS v4u*)(Vh + (size_t)F.tid * 8);
        __syncthreads();
        *(LAS v4u*)(F.lds + kd0) = kr0; if (k1ok) *(LAS v4u*)(F.lds + kd1) = kr1; *(LAS v4u*)(F.lds + vd) = vr;
        __syncthreads();
        for (int kt = 0; kt < nkt; ++kt) {
            const bool more = kt + 1 < nkt;
            if (more) { const bf16* kn = Kh + (size_t)(kt + 1) * 64 * QKD; const bf16* vn = Vh + (size_t)(kt + 1) * 64 * 64;
                kr0 = *(const GAS v4u*)(kn + (size_t)F.tid * 8); if (k1ok) kr1 = *(const GAS v4u*)(kn + (size_t)kc1 * 8); vr = *(const GAS v4u*)(vn + (size_t)F.tid * 8); }
            LAS unsigned char* Kb = F.lds + (kt & 1) * ATILE; LAS unsigned char* Vb = Kb + 64 * AKP;
            f32x16 s0, s1;
#pragma unroll
            for (int i = 0; i < 16; ++i) { s0[i] = 0.f; s1[i] = 0.f; }
#pragma unroll
            for (int ks = 0; ks < 6; ++ks) {
                const bf16x8 a0 = *(const LAS bf16x8*)(Kb + l31 * AKP + (16 * ks + 8 * half) * 2), a1 = *(const LAS bf16x8*)(Kb + (32 + l31) * AKP + (16 * ks + 8 * half) * 2);
                s0 = MFMA32(a0, qf[ks], s0); s1 = MFMA32(a1, qf[ks], s1); }
            float mx = s0[0];
#pragma unroll
            for (int i = 1; i < 16; ++i) mx = fmaxf(mx, s0[i]);
#pragma unroll
            for (int i = 0; i < 16; ++i) mx = fmaxf(mx, s1[i]);
            mx = fmaxf(mx, bpermf(lane ^ 32, mx));
            const float m_new = fmaxf(m_run, mx), alpha = __builtin_amdgcn_exp2f(m_run - m_new); m_run = m_new;
            float ps = 0.f;
#pragma unroll
            for (int i = 0; i < 16; ++i) { s0[i] = __builtin_amdgcn_exp2f(s0[i] - m_new); s1[i] = __builtin_amdgcn_exp2f(s1[i] - m_new); ps += s0[i] + s1[i]; }
            l_run = l_run * alpha + ps;
#pragma unroll
            for (int i = 0; i < 16; ++i) { o0[i] *= alpha; o1[i] *= alpha; }
#pragma unroll
            for (int t = 0; t < 2; ++t)
#pragma unroll
                for (int s = 0; s < 2; ++s) {
                    const bf16x8 pf = pack8(t == 0 ? s0 : s1, s);
                    const int kb = 32 * t + 16 * s + 4 * half + (l16 >> 2);
#pragma unroll
                    for (int dvt = 0; dvt < 2; ++dvt) {
                        const LAS unsigned char* vp = Vb + kb * AVP + (32 * dvt + 16 * g1 + 4 * (l16 & 3)) * 2;
                        const s16x4 lo = __builtin_amdgcn_ds_read_tr16_b64_v4i16((LAS s16x4*)vp), hi = __builtin_amdgcn_ds_read_tr16_b64_v4i16((LAS s16x4*)(vp + 8 * AVP));
                        const bf16x8 va = __builtin_shufflevector(lo, hi, 0, 1, 2, 3, 4, 5, 6, 7);
                        if (dvt == 0) o0 = MFMA32(va, pf, o0); else o1 = MFMA32(va, pf, o1); } }
            if (more) { LAS unsigned char* nb = F.lds + ((kt + 1) & 1) * ATILE;
                *(LAS v4u*)(nb + kd0) = kr0; if (k1ok) *(LAS v4u*)(nb + kd1) = kr1; *(LAS v4u*)(nb + vd) = vr; }
            __syncthreads();
        }
        const float linv = (DBG_SKIP & 4) ? 0.f : 1.0f / (l_run + bpermf(lane ^ 32, l_run));
        const int b = bh >> 4, hd = bh & 15;
        bf16* op = YB + ((size_t)b * TPB + tq) * RW + hd * 64 + 4 * half;
#pragma unroll
        for (int g = 0; g < 4; ++g) {
            v2u w; w.x = pk2(o0[4 * g] * linv, o0[4 * g + 1] * linv); w.y = pk2(o0[4 * g + 2] * linv, o0[4 * g + 3] * linv); *(GAS v2u*)(op + 8 * g) = w;
            w.x = pk2(o1[4 * g] * linv, o1[4 * g + 1] * linv); w.y = pk2(o1[4 * g + 2] * linv, o1[4 * g + 3] * linv); *(GAS v2u*)(op + 32 + 8 * g) = w; }
    }
}

__device__ __forceinline__ void readout_phase(Frame& F, const bf16* Y, const bf16* GG, const float* BON, const bf16* RI, const float* ln_w, const float* ln_b, bf16* YA) {
    const int gw = F.vcu * NWAVES + F.wave, NGW = F.G * NWAVES, lane = F.lane, hd = lane >> 2, ch0 = hd * 64 + (lane & 3) * 16;
    for (int m = gw; m < MALL; m += NGW) {
        const int b = m / TPB, tp = m - b * TPB;
        const bf16* rec = RI + ((size_t)(b * NH + hd) * TPB + tp) * RREC + 128 + (lane & 3) * 16;
        float vv[16], out[16];
        { const v4u a = *(const GAS v4u*)rec, c = *(const GAS v4u*)(rec + 8);
          vv[0] = bflo(a.x); vv[1] = bfhi(a.x); vv[2] = bflo(a.y); vv[3] = bfhi(a.y); vv[4] = bflo(a.z); vv[5] = bfhi(a.z); vv[6] = bflo(a.w); vv[7] = bfhi(a.w);
          vv[8] = bflo(c.x); vv[9] = bfhi(c.x); vv[10] = bflo(c.y); vv[11] = bfhi(c.y); vv[12] = bflo(c.z); vv[13] = bfhi(c.z); vv[14] = bflo(c.w); vv[15] = bfhi(c.w); }
#pragma unroll
        for (int e = 0; e < 16; ++e) out[e] = 0.f;
#pragma unroll
        for (int d = 0; d < 2; ++d) {
            const bf16* yp = Y + ((size_t)d * MALL + m) * RW + ch0; const bf16* gp = GG + ((size_t)d * MALL + m) * RW + ch0;
            float y[16], g[16];
            { const v4u a = *(const GAS v4u*)yp, c = *(const GAS v4u*)(yp + 8);
              y[0] = bflo(a.x); y[1] = bfhi(a.x); y[2] = bflo(a.y); y[3] = bfhi(a.y); y[4] = bflo(a.z); y[5] = bfhi(a.z); y[6] = bflo(a.w); y[7] = bfhi(a.w);
              y[8] = bflo(c.x); y[9] = bfhi(c.x); y[10] = bflo(c.y); y[11] = bfhi(c.y); y[12] = bflo(c.z); y[13] = bfhi(c.z); y[14] = bflo(c.w); y[15] = bfhi(c.w); }
            { const v4u a = *(const GAS v4u*)gp, c = *(const GAS v4u*)(gp + 8);
              g[0] = bflo(a.x); g[1] = bfhi(a.x); g[2] = bflo(a.y); g[3] = bfhi(a.y); g[4] = bflo(a.z); g[5] = bfhi(a.z); g[6] = bflo(a.w); g[7] = bfhi(a.w);
              g[8] = bflo(c.x); g[9] = bfhi(c.x); g[10] = bflo(c.y); g[11] = bfhi(c.y); g[12] = bflo(c.z); g[13] = bfhi(c.z); g[14] = bflo(c.w); g[15] = bfhi(c.w); }
            float s = 0.f;
#pragma unroll
            for (int e = 0; e < 16; ++e) s += y[e];
            s = dpp_add<0xB1>(s); s = dpp_add<0x4E>(s);
            const float mean = s * (1.f / 64.f); float q = 0.f;
#pragma unroll
            for (int e = 0; e < 16; ++e) { y[e] -= mean; q += y[e] * y[e]; }
            q = dpp_add<0xB1>(q); q = dpp_add<0x4E>(q);
            const float rstd = rsqrtf(q * (1.f / 64.f) + 64e-5f), bon = BON[((size_t)d * MALL + m) * 16 + hd];
#pragma unroll
            for (int e = 0; e < 16; ++e) out[e] += (y[e] * rstd * ln_w[ch0 + e] + ln_b[ch0 + e] + bon * vv[e]) * g[e];
        }
        if (DBG_SKIP & 2) {
#pragma unroll
            for (int e = 0; e < 16; ++e) out[e] = 0.f; }
        v4u o0, o1;
        o0.x = pk2(out[0], out[1]); o0.y = pk2(out[2], out[3]); o0.z = pk2(out[4], out[5]); o0.w = pk2(out[6], out[7]);
        o1.x = pk2(out[8], out[9]); o1.y = pk2(out[10], out[11]); o1.z = pk2(out[12], out[13]); o1.w = pk2(out[14], out[15]);
        *(GAS v4u*)(YA + (size_t)m * RW + ch0) = o0; *(GAS v4u*)(YA + (size_t)m * RW + ch0 + 8) = o1;
    }
}

__device__ __forceinline__ int first_lane(unsigned long long mask) { return __builtin_ctzll(mask); }
__device__ __forceinline__ void top16_of_128(float a, float b, int lane, float& wv, int& wi) {
    wv = 0.f; wi = 0;
    for (int it = 0; it < 16; ++it) {
        const float m = wave_max_u(fmaxf(a, b));
        const bool ha = (a == m), hb = (b == m);
        const unsigned long long bal = __ballot(ha || hb);
        const int wl = first_lane(bal);
        const int myi = ha ? lane : lane + 64;
        const int idx = __builtin_amdgcn_readlane(myi, wl);
        if (lane == wl) { if (ha) a = -3.0e38f; else b = -3.0e38f; }
        if (lane == it) { wv = m; wi = idx; }
    }
}
struct PeerP { const float* SC; const bf16* H; const bf16* PU; const bf16* PV; float* X; const float* mod;   const float* fin_g; float* out; int last; };
__device__ __forceinline__ void peer_phase(Frame& F, const PeerP& P) {
    const int gw = F.vcu * NWAVES + F.wave, NGW = F.G * NWAVES, lane = F.lane;
    float pr_s2 = 0.f, pr_d2 = 0.f, pr_tg = 0.f, pr_n = 0.f;
    for (int m = gw; m < MALL; m += NGW) {
        const int b = m / TPB, tp = m - b * TPB; if (P.last && tp < CTXL) continue;
        const int mr = tp < CTXL ? 2 : b;
        int eidx[2] = {0, 0}; float egate[2] = {0.f, 0.f};
        const float* srow = P.SC + (size_t)m * DM;
        if (DBG_PROBE) { float s2 = 0.f; for (int i = lane; i < DM; i += 64) s2 += srow[i] * srow[i]; pr_s2 += wave_sum_u(s2) * (1.f / DM); pr_n += 1.f; }
#pragma unroll 1
        for (int hd = 0; hd < 8; ++hd) {
            float w1v, w2v; int w1i, w2i;
            top16_of_128(srow[hd * 256 + lane], srow[hd * 256 + 64 + lane], lane, w1v, w1i);
            top16_of_128(srow[hd * 256 + 128 + lane], srow[hd * 256 + 192 + lane], lane, w2v, w2i);
            const float v1 = bpermf(lane & 15, w1v); const int i1 = bpermi(lane & 15, w1i);
            float cs[4]; int ci[4];
#pragma unroll
            for (int e = 0; e < 4; ++e) { const int j = 4 * (lane >> 4) + e; cs[e] = v1 + bpermf(j, w2v); ci[e] = i1 * 128 + bpermi(j, w2i); }
            float tv = 0.f, tsum = 0.f, m0 = 0.f; int ti = 0;
            for (int it = 0; it < 16; ++it) {
                const float mm = wave_max_u(fmaxf(fmaxf(cs[0], cs[1]), fmaxf(cs[2], cs[3])));
                const int sl = (cs[0] == mm) ? 0 : (cs[1] == mm) ? 1 : (cs[2] == mm) ? 2 : (cs[3] == mm) ? 3 : 4;
                const unsigned long long bal = __ballot(sl < 4);
                const int wl = first_lane(bal);
                const int myi = (sl == 0) ? ci[0] : (sl == 1) ? ci[1] : (sl == 2) ? ci[2] : ci[3];
                const int idx = __builtin_amdgcn_readlane(myi, wl);
                if (lane == wl) { if (sl == 0) cs[0] = -3.0e38f; else if (sl == 1) cs[1] = -3.0e38f; else if (sl == 2) cs[2] = -3.0e38f; else cs[3] = -3.0e38f; }
                if (it == 0) m0 = mm;
                const float ev = __expf(mm - m0); tsum += ev;
                if (lane == it) { tv = ev; ti = idx; }
            }
            const float gt = tv / tsum;
            if (DBG_PROBE) pr_tg += 1.0f / tsum * 0.125f;
            const int src = lane & 15;
            const float gsh = bpermf(src, gt); const int ish = bpermi(src, ti);
            if ((lane >> 4) == (hd & 3)) { if (hd < 4) { egate[0] = gsh; eidx[0] = ish; } else { egate[1] = gsh; eidx[1] = ish; } }
        }
        v4u hp[4];
#pragma unroll
        for (int j = 0; j < 4; ++j) hp[j] = *(const GAS v4u*)(P.H + (size_t)m * DM + j * 512 + lane * 8);
        float coef[2];
#pragma unroll
        for (int sl = 0; sl < 2; ++sl) {
            float mydot = 0.f;
#pragma unroll 1
            for (int e0 = 0; e0 < 64; e0 += 4) {
                v4u u[4][4];
#pragma unroll
                for (int q = 0; q < 4; ++q) { const int ex = __builtin_amdgcn_readlane(eidx[sl], e0 + q); const bf16* ur = P.PU + (size_t)ex * DM + lane * 8;
#pragma unroll
                    for (int j = 0; j < 4; ++j) u[q][j] = *(const GAS v4u*)(ur + j * 512); }
#pragma unroll
                for (int q = 0; q < 4; ++q) { float s = 0.f;
#pragma unroll
                    for (int j = 0; j < 4; ++j) {
                        const bf16x8v hv = __builtin_bit_cast(bf16x8v, hp[j]), uv = __builtin_bit_cast(bf16x8v, u[q][j]);
                        s = __builtin_amdgcn_fdot2_f32_bf16(__builtin_shufflevector(hv, hv, 0, 1), __builtin_shufflevector(uv, uv, 0, 1), s, false);
                        s = __builtin_amdgcn_fdot2_f32_bf16(__builtin_shufflevector(hv, hv, 2, 3), __builtin_shufflevector(uv, uv, 2, 3), s, false);
                        s = __builtin_amdgcn_fdot2_f32_bf16(__builtin_shufflevector(hv, hv, 4, 5), __builtin_shufflevector(uv, uv, 4, 5), s, false);
                        s = __builtin_amdgcn_fdot2_f32_bf16(__builtin_shufflevector(hv, hv, 6, 7), __builtin_shufflevector(uv, uv, 6, 7), s, false); }
                    const float tot = wave_sum_u(s);
                    if (lane == e0 + q) mydot = tot; }
            }
            if (DBG_PROBE) pr_d2 += wave_sum_u(mydot * mydot) * (1.f / 128.f);
            coef[sl] = egate[sl] * 0.5f * mydot * (1.0f + erff(mydot * 0.70710678f));
            if ((DBG_SKIP & 16) && sl == 0) coef[sl] = 0.f;
            if ((DBG_SKIP & 32) && sl == 1) coef[sl] = 0.f;
        }
        float acc[32];
#pragma unroll
        for (int i = 0; i < 32; ++i) acc[i] = 0.f;
#pragma unroll
        for (int sl = 0; sl < 2; ++sl) {
#pragma unroll 1
            for (int e0 = 0; e0 < 64; e0 += 4) {
                v4u u[4][4]; float cf[4];
#pragma unroll
                for (int q = 0; q < 4; ++q) { const int ex = __builtin_amdgcn_readlane(eidx[sl], e0 + q); cf[q] = __builtin_bit_cast(float, __builtin_amdgcn_readlane(__builtin_bit_cast(int, coef[sl]), e0 + q));
                    const bf16* vr = P.PV + (size_t)ex * DM + lane * 8;
#pragma unroll
                    for (int j = 0; j < 4; ++j) u[q][j] = *(const GAS v4u*)(vr + j * 512); }
#pragma unroll
                for (int q = 0; q < 4; ++q)
#pragma unroll
                    for (int j = 0; j < 4; ++j) { const v4u w = u[q][j]; const float c = cf[q];
                        acc[8 * j + 0] += c * bflo(w.x); acc[8 * j + 1] += c * bfhi(w.x); acc[8 * j + 2] += c * bflo(w.y); acc[8 * j + 3] += c * bfhi(w.y);
                        acc[8 * j + 4] += c * bflo(w.z); acc[8 * j + 5] += c * bfhi(w.z); acc[8 * j + 6] += c * bflo(w.w); acc[8 * j + 7] += c * bfhi(w.w); }
            }
        }
        if (DBG_SKIP & 1) {
#pragma unroll
            for (int i = 0; i < 32; ++i) acc[i] = 0.f; }
        if (((DBG_SKIP & 64) && !P.last) || ((DBG_SKIP & 128) && P.last)) {
#pragma unroll
            for (int i = 0; i < 32; ++i) acc[i] = 0.f; }
        if (DBG_SKIP & 8) {
#pragma unroll
            for (int i = 0; i < 32; ++i) acc[i] = -acc[i]; }
        float* xr = P.X + (size_t)m * DM; const float* g2 = P.mod + (size_t)mr * 12288 + 5 * DM;
        float ss = 0.f;
#pragma unroll
        for (int j = 0; j < 4; ++j)
#pragma unroll
            for (int hq = 0; hq < 2; ++hq) { const int c = j * 512 + lane * 8 + hq * 4;
                f32x4 xv = *(const GAS f32x4*)(xr + c); const f32x4 gv = *(const GAS f32x4*)(g2 + c);
#pragma unroll
                for (int e = 0; e < 4; ++e) { xv[e] += gv[e] * acc[8 * j + 4 * hq + e]; ss += xv[e] * xv[e]; acc[8 * j + 4 * hq + e] = xv[e]; }
                if (!P.last) *(GAS f32x4*)(xr + c) = xv; }
        if (P.last) { const float rs = rsqrtf(wave_sum(ss) * (1.f / DM) + NORM_EPS); float* orow = P.out + ((size_t)b * SEQ + (tp - CTXL)) * DM;
#pragma unroll
            for (int j = 0; j < 4; ++j)
#pragma unroll
                for (int hq = 0; hq < 2; ++hq) { const int c = j * 512 + lane * 8 + hq * 4; const f32x4 fg = *(const GAS f32x4*)(P.fin_g + c);
                    f32x4 o;
#pragma unroll
                    for (int e = 0; e < 4; ++e) o[e] = acc[8 * j + 4 * hq + e] * rs * fg[e];
                    *(GAS f32x4*)(orow + c) = o; } }
    }
    if (DBG_PROBE && !P.last && lane == 0) { float* pp = (float*)(F.ws + WS_CTL + CTL_PROBE_OFF) + gw * 4; pp[0] = pr_s2; pp[1] = pr_d2; pp[2] = pr_tg; pp[3] = pr_n; }
}
__device__ __forceinline__ void cvt_tables(Frame& F, const float* pu, const float* pv, bf16* PU, bf16* PV) {
    const size_t gt = (size_t)(F.vcu * NWAVES + F.wave) * 64 + F.lane, NGT = (size_t)F.G * NWAVES * 64, n8 = (size_t)NEXP * DM / 8;
    for (size_t i = gt; i < 2 * n8; i += NGT) { const bool sec = i >= n8; const size_t k = sec ? i - n8 : i;
        const GAS f32x4* s = (const GAS f32x4*)(sec ? pv : pu) + 2 * k; const f32x4 a = s[0], c = s[1];
        v4u o; o.x = pk2(a.x, a.y); o.y = pk2(a.z, a.w); o.z = pk2(c.x, c.y); o.w = pk2(c.z, c.w);
        ((GAS v4u*)(sec ? PV : PU))[k] = o; }
}

constexpr int PH_PER_LAYER = 11, NPHASE = 1 + NLAYER * PH_PER_LAYER;
#ifndef ONLY_PHASE
#define ONLY_PHASE -1
#endif
#define T0() (wave_s == 0 && pg8::opaque_lane() == 0)
#define PH_ON(k) (ONLY_PHASE < 0 || ONLY_PHASE == (k))
#define GEMM_CALL(EPI, SCHED, g, S, E) pg8::gemm_phase<EPI, SCHED, true, true>(F.lds, g, S, E, wave_s)
#define GEMM_CALL_NA(EPI, SCHED, g, S, E) pg8::gemm_phase<EPI, SCHED, false, true>(F.lds, g, S, E, wave_s)

__device__ __forceinline__ const float* karg(int i) {
    asm volatile("" : "+s"(i));
    const __attribute__((address_space(4))) unsigned long long* ka = (const __attribute__((address_space(4))) unsigned long long*)__builtin_amdgcn_kernarg_segment_ptr();
    return (const float*)ka[i];
}
__global__ void __launch_bounds__(NWAVES * 64, 2) mk_fwd(Args args) {
    extern __shared__ __attribute__((aligned(16))) unsigned char lds[];
    Frame F;
    F.lds = (LAS unsigned char*)lds; F.ws = args.ws;
    const int wave_s = __builtin_amdgcn_readfirstlane((int)threadIdx.x >> 6);
    F.tid = threadIdx.x; F.lane = F.tid & 63; F.wave = wave_s;
    F.G = gridDim.x; { const int bx = blockIdx.x; F.vcu = (F.G % 8 == 0) ? (bx % 8) * (F.G / 8) + bx / 8 : bx; }
    unsigned char* ws = args.ws;
    volatile LAS unsigned* MISC = (volatile LAS unsigned*)(F.lds + MISC_OFF);
    for (int u = F.tid; u < (LDS_BYTES - LDSCTL_OFF) / 4; u += NWAVES * 64) ((LAS unsigned*)(F.lds + LDSCTL_OFF))[u] = 0u;
    __syncthreads();
    const int lo = args.ph_lo, hi = args.ph_hi;
    XcdBarrier bar; bar.bar = (unsigned*)(ws + WS_CTL) + CW_BAR; bar.x = 0; bar.st = nullptr;
    if (hi - lo > 1) bar = xcd_barrier_post((unsigned*)(ws + WS_CTL) + CW_BAR, MISC + 8, T0());
#define IN(k) (lo <= (k) && (k) < hi)
#define REFRAME() do { const int lz_ = pg8::opaque_lane(); F.lane = lz_; F.tid = wave_s * 64 + lz_; F.wave = wave_s; ws = (unsigned char*)karg(34); F.ws = ws; { int g_ = (int)gridDim.x, b_ = (int)blockIdx.x; asm volatile("" : "+s"(g_), "+s"(b_)); bx = b_; F.G = g_; F.vcu = ((g_ & 7) == 0) ? (b_ & 7) * (g_ >> 3) + (b_ >> 3) : b_; } } while (0)
#define SEAM(k) do { if (IN((k) + 1)) xcd_barrier(bar, T0()); } while (0)
#define XBUF ((float*)(ws + WS_X))
#define HBUF ((bf16*)(ws + WS_H))
#define MODP ((const float*)(ws + WS_CTL + CTL_MOD_OFF) + (size_t)l * 3 * 12288)
    int bx = (int)blockIdx.x;

    if (PH_ON(100) && IN(0)) { REFRAME(); p0_prologue(F); SEAM(0); }

    for (int l = 0; l < NLAYER; ++l) {
        const int base = 1 + l * PH_PER_LAYER;
        const int last = (l == NLAYER - 1);
        if (PH_ON(0) && IN(base + 0)) { REFRAME(); modnorm_phase(F, XBUF, karg(6) + (size_t)l * DM, MODP, 0, HBUF, 0); SEAM(base + 0); }
        if (PH_ON(1) && IN(base + 1)) { REFRAME();
            pg8::Gemm g{HBUF, (const bf16*)(ws + WS_WINA) + (size_t)l * INA_P * DM, MALL, INA_P, DM}; pg8::RowOrder S; S.init_rows(0, INA_P, F.G, bx);
            pg8::EpiStoreBf16 E{(bf16*)(ws + WS_PA), INA_P};
            GEMM_CALL(pg8::EpiStoreBf16, pg8::RowOrder, g, S, E);
            SEAM(base + 1); }
        if (PH_ON(2) && IN(base + 2)) { REFRAME();
            FeatP P;
            P.PA = (const bf16*)(ws + WS_PA); P.mu = karg(9) + (size_t)l * RWC; P.w0 = karg(10) + (size_t)l * 2 * RW; P.a0 = karg(12) + (size_t)l * 2 * RW;
            P.k_k = karg(15) + (size_t)l * RW; P.k_a = karg(16) + (size_t)l * RW; P.r_k = karg(17) + (size_t)l * RW;
            P.WUP = (const bf16*)(ws + WS_WUP) + (size_t)l * 2 * RW * 64; P.AUP = (const bf16*)(ws + WS_AUP) + (size_t)l * 2 * RW * 64; P.GUP = (const bf16*)(ws + WS_GUP) + (size_t)l * 2 * RW * 32;
            P.qnorm = karg(20) + (size_t)l * 512; P.kvnorm = karg(22) + (size_t)l * 256; P.rope = (const f32x2*)(ws + WS_ROPE);
            P.RI = (bf16*)(ws + WS_RI); P.GG = (bf16*)(ws + WS_GG); P.BON = (float*)(ws + WS_BON); P.QN = (bf16*)(ws + WS_QN); P.KVN = (bf16*)(ws + WS_KVN); P.K = (bf16*)(ws + WS_K);
            features_phase(F, P);
            SEAM(base + 2); }
        if (PH_ON(3) && IN(base + 3)) { REFRAME();
            { pg8::Gemm g{(const bf16*)(ws + WS_QN), (const bf16*)(ws + WS_WUQ) + (size_t)l * NQ * 512, MALL, NQ, 512};
              pg8::EpiQ E{(bf16*)(ws + WS_Q), (const f32x2*)(ws + WS_ROPE), 0.14724444f};
              pg8::RowOrder S; S.init_rows(last, NQ, F.G, bx); GEMM_CALL_NA(pg8::EpiQ, pg8::RowOrder, g, S, E); }
            { pg8::Gemm g{(const bf16*)(ws + WS_KVN), (const bf16*)(ws + WS_WUKV) + (size_t)l * NKV * 256, MALL, NKV, 256}; pg8::RowOrder S; S.init_rows(0, NKV, F.G, bx);
              pg8::EpiKV E{(bf16*)(ws + WS_K), (bf16*)(ws + WS_V)};
              GEMM_CALL_NA(pg8::EpiKV, pg8::RowOrder, g, S, E); }
            SEAM(base + 3); }
        if (PH_ON(4) && IN(base + 4)) { REFRAME(); scan_phase(F, (const bf16*)(ws + WS_RI), (bf16*)(ws + WS_Y)); SEAM(base + 4); }
        if (PH_ON(5) && IN(base + 5)) { REFRAME();
            attn_phase(F, (const bf16*)(ws + WS_Q), (const bf16*)(ws + WS_K), (const bf16*)(ws + WS_V), (bf16*)(ws + WS_YB), !last);
            readout_phase(F, (const bf16*)(ws + WS_Y), (const bf16*)(ws + WS_GG), (const float*)(ws + WS_BON), (const bf16*)(ws + WS_RI), karg(18) + (size_t)l * RW, karg(19) + (size_t)l * RW, (bf16*)(ws + WS_YA));
            SEAM(base + 5); }
        if (PH_ON(6) && IN(base + 6)) { REFRAME();
            bf16* T1 = (bf16*)(ws + WS_T1); bf16* T2 = (bf16*)(ws + WS_T2);
            const pg8::Gemm g1{HBUF, (const bf16*)(ws + WS_WGA) + (size_t)l * DM * DM, MALL, DM, DM}, g2{(const bf16*)(ws + WS_YA), (const bf16*)(ws + WS_WA) + (size_t)l * DM * RW, MALL, DM, RW};
            const pg8::Gemm g3{HBUF, (const bf16*)(ws + WS_WGB) + (size_t)l * DM * DM, MALL, DM, DM}, g4{(const bf16*)(ws + WS_YB), (const bf16*)(ws + WS_WB) + (size_t)l * DM * RW, MALL, DM, RW};
            const pg8::EpiGate E1{T1, DM, karg(8) + (size_t)l * 2 * DM}, E3{T2, DM, karg(8) + (size_t)l * 2 * DM + DM};
            const pg8::EpiMulAdd E2{T1, T1, nullptr, DM}, E4{T1, T2, T1, DM};
            pg8::RowOrder S; S.init_rows(last, DM, F.G, bx);
            GEMM_CALL(pg8::EpiGate, pg8::RowOrder, g1, S, E1); GEMM_CALL(pg8::EpiMulAdd, pg8::RowOrder, g2, S, E2); GEMM_CALL(pg8::EpiGate, pg8::RowOrder, g3, S, E3); GEMM_CALL(pg8::EpiMulAdd, pg8::RowOrder, g4, S, E4);
            SEAM(base + 6); }
        if (PH_ON(7) && IN(base + 7)) { REFRAME();
            const pg8::Gemm g{(const bf16*)(ws + WS_T1), (const bf16*)(ws + WS_WO) + (size_t)l * DM * DM, MALL, DM, DM};
            const pg8::EpiResid E{XBUF, MODP + 2 * DM};
            pg8::RowOrder S; S.init_rows(last, DM, F.G, bx); GEMM_CALL(pg8::EpiResid, pg8::RowOrder, g, S, E);
            SEAM(base + 7); }
        if (PH_ON(8) && IN(base + 8)) { REFRAME();
            modnorm_phase(F, XBUF, karg(27) + (size_t)l * DM, MODP, 3, HBUF, last);
            cvt_tables(F, karg(30) + (size_t)l * NEXP * DM, karg(31) + (size_t)l * NEXP * DM, (bf16*)(ws + WS_PU), (bf16*)(ws + WS_PV));
            SEAM(base + 8); }
        if (PH_ON(9) && IN(base + 9)) { REFRAME();
            const pg8::Gemm g{HBUF, (const bf16*)(ws + WS_WQK) + (size_t)l * DM * DM, MALL, DM, DM};
            const pg8::EpiF32 E{(float*)(ws + WS_SC), DM};
            pg8::RowOrder S; S.init_rows(last, DM, F.G, bx); GEMM_CALL(pg8::EpiF32, pg8::RowOrder, g, S, E);
            SEAM(base + 9); }
        if (PH_ON(10) && IN(base + 10)) { REFRAME();
            PeerP P; P.SC = (const float*)(ws + WS_SC); P.H = HBUF; P.PU = (const bf16*)(ws + WS_PU); P.PV = (const bf16*)(ws + WS_PV); P.X = XBUF; P.mod = MODP; P.fin_g = karg(32); P.out = (float*)karg(33); P.last = last;
            peer_phase(F, P);
            SEAM(base + 10); }
    }
#undef IN
#undef SEAM
#undef XBUF
#undef HBUF
#undef MODP
}

__global__ void __launch_bounds__(512) dbg_fill(const float* pp, float* o) {
    float s0 = 0.f, s1 = 0.f, s2 = 0.f, s3 = 0.f;
    for (int i = 0; i < 2048; ++i) { s0 += pp[4 * i]; s1 += pp[4 * i + 1]; s2 += pp[4 * i + 2]; s3 += pp[4 * i + 3]; }
    const float v = DBG_PROBE == 1 ? 10.f * sqrtf(s0 / s3) : DBG_PROBE == 2 ? 10.f * sqrtf(s1 / s3) : 100.f * s2 / s3;
    for (size_t i = (size_t)blockIdx.x * 512 + threadIdx.x; i < (size_t)NBATCH * SEQ * DM; i += (size_t)gridDim.x * 512) o[i] = v;
}
extern "C" void kernel_launch(void* const* d_in, const int* in_sizes, int n_in, void* d_out, int out_size, void* d_ws, size_t ws_size, hipStream_t stream) {
    static int grid = 0;
    if (grid == 0) {
        if (n_in != 33 || out_size != NBATCH * SEQ * DM || ws_size < WS_END) { fprintf(stderr, "kernel_launch: unexpected shapes (n_in %d out %d ws %zu)\n", n_in, out_size, ws_size); grid = -1; return; }
        int dev = 0, cus = 0, per_cu = 0;
        if (hipGetDevice(&dev) != hipSuccess || hipDeviceGetAttribute(&cus, hipDeviceAttributeMultiprocessorCount, dev) != hipSuccess) { grid = -1; return; }
        if (hipFuncSetAttribute((const void*)mk_fwd, hipFuncAttributeMaxDynamicSharedMemorySize, LDS_BYTES) != hipSuccess) { fprintf(stderr, "kernel_launch: hipFuncSetAttribute failed\n"); grid = -1; return; }
        if (hipOccupancyMaxActiveBlocksPerMultiprocessor(&per_cu, (const void*)mk_fwd, NWAVES * 64, LDS_BYTES) != hipSuccess || per_cu < 1) { fprintf(stderr, "kernel_launch: occupancy query says %d\n", per_cu); (void)hipGetLastError(); grid = -1; return; }
        grid = cus;
    }
    if (grid < 0) return;
    if (hipMemsetAsync((char*)d_ws + WS_CTL, 0, CTL_ZERO_BYTES, stream) != hipSuccess) return;
    Args a{};
    for (int i = 0; i < 33; ++i) a.in[i] = (const float*)d_in[i];
    a.out = (float*)d_out; a.ws = (unsigned char*)d_ws;
#if MK_N_LAUNCHES == 1
    a.ph_lo = 0; a.ph_hi = NPHASE;
    hipLaunchKernelGGL(mk_fwd, dim3(grid), dim3(NWAVES * 64), LDS_BYTES, stream, a);
#else
    for (int p = 0; p < NPHASE; ++p) { a.ph_lo = p; a.ph_hi = p + 1; hipLaunchKernelGGL(mk_fwd, dim3(grid), dim3(NWAVES * 64), LDS_BYTES, stream, a); }
    if (DBG_PROBE) hipLaunchKernelGGL(dbg_fill, dim3(1024), dim3(512), 0, stream, (const float*)((char*)d_ws + WS_CTL + CTL_PROBE_OFF), (float*)d_out);
#endif
}
```

```cpp
#include <hip/hip_runtime.h>
#include <cstdio>
#include <cstdint>

#ifndef MK_N_LAUNCHES
#define MK_N_LAUNCHES 1
#endif

#ifndef DBG_SKIP
#define DBG_SKIP 0
#endif
#ifndef DBG_PROBE
#define DBG_PROBE 0
#endif
namespace pg8 {
#define PG8_LAS __attribute__((address_space(3)))
typedef unsigned short bf16_t;
typedef short bf16x8 __attribute__((ext_vector_type(8)));
typedef float f32x4 __attribute__((ext_vector_type(4)));
typedef unsigned u32x4 __attribute__((ext_vector_type(4)));
constexpr int BM = 256, BK = 64, HALF = 128, HTB = HALF * BK * 2  , STAGE_BYTES = 8 * HTB, NXCD = 8, WGM = 8;

__host__ __device__ __forceinline__ int lds_byte(int r, int c) { const int st = (r >> 4) * 2 + (c >> 5), rr = r & 15, cc = c & 31, ob = rr * 64 + cc * 2; return st * 1024 + (ob ^ (((ob >> 9) & 1) << 5)); }
__host__ __device__ __forceinline__ void stage_rc(int b, int& R, int& C) { const int st = b / 1024, sb = b % 1024, swz = sb ^ (((sb >> 9) & 1) << 5); R = (st >> 1) * 16 + swz / 64; C = (st & 1) * 32 + (swz % 64) / 2; }
__host__ __device__ __forceinline__ int perm32(int rho) { const int n = rho >> 4, i = rho & 15; return 8 * (i >> 2) + 4 * n + (i & 3); }

struct Unit { int pm, pn; };
struct Gemm { const bf16_t* A; const bf16_t* Bt; int M, N, K; };

struct StaticOrder {
    int nM, nN, nwg, G, c;
    __host__ __device__ void init(int M, int N, int G_, int c_) { nM = M / BM; nN = N / BM; nwg = nM * nN; G = G_; c = c_; }
    __host__ __device__ bool next(int i, Unit& u) const {
        const long L = (long)i * G + c; if (L >= nwg) return false;
        int wgid = (int)L; { const int q = nwg / NXCD, r = nwg % NXCD, xcd = wgid % NXCD, off = wgid / NXCD; wgid = (xcd < r ? xcd * (q + 1) : r * (q + 1) + (xcd - r) * q) + off; }
        const int nig = WGM * nN, gid = wgid / nig, fm = gid * WGM, gsz = (nM - fm) < WGM ? (nM - fm) : WGM;
        u.pm = fm + ((wgid % nig) % gsz); u.pn = (wgid % nig) / gsz; return true;
    }
    __device__ __forceinline__ void a_ready(const Unit&) const {}
    __device__ __forceinline__ void done(const Unit&) const {}
};
__device__ __forceinline__ int opaque_lane() { int l; asm volatile("v_mbcnt_lo_u32_b32 %0, -1, 0\n\tv_mbcnt_hi_u32_b32 %0, -1, %0" : "=v"(l)); return l; }
__device__ __forceinline__ unsigned cvt_pk_bf16(float lo, float hi) { unsigned r; asm volatile("v_cvt_pk_bf16_f32 %0, %1, %2" : "=v"(r) : "v"(lo), "v"(hi)); return r; }
template <class Epi, class Sched, bool ALIGN_EPI = false, bool SP2 = false>
__device__ __forceinline__ void gemm_phase(PG8_LAS unsigned char* lds, const Gemm g, const Sched& S, const Epi& E, const int wave_s) {
    const int lane_ = opaque_lane();
    const int wid = wave_s, lane = lane_, tid = wid * 64 + lane, wr = wid >> 2, wc = wid & 3, fr = lane & 15, fq = lane >> 4;
    const int K = g.K, nt = K / BK;
    unsigned voffA[2], voffB[2];
#pragma unroll
    for (int i = 0; i < 2; ++i) { int R, C; stage_rc(tid * 16 + i * 8192, R, C); const int Rb = Epi::PERM ? ((R & ~31) + perm32(R & 31)) : R;
        voffA[i] = (unsigned)(R * K + C) * 2u; voffB[i] = (unsigned)(Rb * K + C) * 2u; }
    const size_t kstep = (size_t)(BK * 2);
    const size_t hstep = (size_t)HALF * K * 2;
    const size_t tstep = 2 * hstep;
    const unsigned ldsw = (unsigned)wid * 1024u;
    const int aoff = lds_byte(wr * 64 + fr, fq * 8), boff = lds_byte(wc * 32 + fr, fq * 8);
#define PG8_SA(b, h) (((b) * 2 + (h)) * HTB)
#define PG8_SB(b, h) ((4 + (b) * 2 + (h)) * HTB)
#define PG8_STAGE(bufoff, gbase, voff) do { _Pragma("unroll") for (int _i = 0; _i < 2; ++_i) \
        __builtin_amdgcn_global_load_lds((const unsigned*)((const char*)(gbase) + (voff)[_i]), (PG8_LAS unsigned*)(lds + (bufoff) + ldsw + _i * 8192), 16, 0, 0); } while (0)
#define PG8_LDA(dst, b, h) do { _Pragma("unroll") for (int m = 0; m < 4; ++m) _Pragma("unroll") for (int k = 0; k < 2; ++k) dst[m][k] = *(const PG8_LAS bf16x8*)(lds + PG8_SA(b, h) + aoff + m * 2048 + k * 1024); } while (0)
#define PG8_LDB(dst, b, h) do { _Pragma("unroll") for (int n = 0; n < 2; ++n) _Pragma("unroll") for (int k = 0; k < 2; ++k) dst[n][k] = *(const PG8_LAS bf16x8*)(lds + PG8_SB(b, h) + boff + n * 2048 + k * 1024); } while (0)
#define PG8_MMA(ai, bj, At, Bt) do { __builtin_amdgcn_s_setprio(1); _Pragma("unroll") for (int m = 0; m < 4; ++m) _Pragma("unroll") for (int n = 0; n < 2; ++n) _Pragma("unroll") for (int k = 0; k < 2; ++k) \
        acc[ai][bj][m][n] = __builtin_amdgcn_mfma_f32_16x16x32_bf16(Bt[n][k], At[m][k], acc[ai][bj][m][n], 0, 0, 0); __builtin_amdgcn_s_setprio(0); } while (0)
#define PG8_WAIT_V(n) asm volatile("s_waitcnt vmcnt(" #n ")" ::: "memory")
#define PG8_WAIT_L(n) asm volatile("s_waitcnt lgkmcnt(" #n ")" ::: "memory")
#define PG8_BAR __builtin_amdgcn_s_barrier()
#define PG8_SCHED __builtin_amdgcn_sched_barrier(0)
    Unit cur, nxt; int ui = 0;
    if (!S.next(0, cur)) return;
    f32x4 acc[2][2][4][2];
#pragma unroll
    for (int a = 0; a < 2; ++a)
#pragma unroll
        for (int b = 0; b < 2; ++b)
#pragma unroll
            for (int m = 0; m < 4; ++m)
#pragma unroll
                for (int n = 0; n < 2; ++n) acc[a][b][m][n] = (f32x4){0.f, 0.f, 0.f, 0.f};
    bf16x8 At[4][2], B0[2][2], B1[2][2];
    const char* cA = (const char*)g.A + (size_t)cur.pm * tstep; const char* cB = (const char*)g.Bt + (size_t)cur.pn * tstep;
    S.a_ready(cur);
    if constexpr (SP2) {
        PG8_STAGE(PG8_SB(0, 0), cB, voffB); PG8_STAGE(PG8_SB(0, 1), cB + hstep, voffB); PG8_STAGE(PG8_SA(0, 0), cA, voffA); PG8_STAGE(PG8_SA(0, 1), cA + hstep, voffA);
        if (wr == 1) PG8_BAR;
        PG8_WAIT_V(2); PG8_BAR;
        PG8_STAGE(PG8_SB(1, 0), cB + kstep, voffB); PG8_STAGE(PG8_SA(1, 0), cA + kstep, voffA); PG8_STAGE(PG8_SB(1, 1), cB + hstep + kstep, voffB);
        PG8_WAIT_V(6); PG8_BAR;
    } else {
        PG8_STAGE(PG8_SB(0, 0), cB, voffB); PG8_STAGE(PG8_SA(0, 0), cA, voffA); PG8_STAGE(PG8_SB(0, 1), cB + hstep, voffB); PG8_STAGE(PG8_SA(0, 1), cA + hstep, voffA);
        if (wr == 1) PG8_BAR;
        PG8_WAIT_V(4); PG8_BAR;
        PG8_STAGE(PG8_SB(1, 0), cB + kstep, voffB); PG8_STAGE(PG8_SA(1, 0), cA + kstep, voffA); PG8_STAGE(PG8_SB(1, 1), cB + hstep + kstep, voffB);
        PG8_WAIT_V(6); PG8_BAR;
    }
    for (;;) {
        const bool has_next = S.next(ui + 1, nxt);
        const char* nA = has_next ? (const char*)g.A + (size_t)nxt.pm * tstep : cA; const char* nB = has_next ? (const char*)g.Bt + (size_t)nxt.pn * tstep : cB;
        for (int t = 0; t < nt; t += 2) {
            const bool last = (t == nt - 2);
            const char* a1 = cA + (size_t)(t + 1) * kstep;
            const char* a2 = last ? nA : cA + (size_t)(t + 2) * kstep; const char* b2 = last ? nB : cB + (size_t)(t + 2) * kstep;
            const char* a3 = a2 + kstep; const char* b3 = b2 + kstep;
            if (last && has_next) S.a_ready(nxt);
            if constexpr (SP2) {
            PG8_LDB(B0, 0, 0); PG8_LDB(B1, 0, 1); PG8_SCHED; PG8_LDA(At, 0, 0); PG8_STAGE(PG8_SA(1, 1), a1 + hstep, voffA);
            PG8_WAIT_V(8); PG8_WAIT_L(0); PG8_BAR; PG8_MMA(0, 0, At, B0); PG8_MMA(0, 1, At, B1); PG8_BAR; PG8_SCHED;
            PG8_LDA(At, 0, 1); PG8_STAGE(PG8_SB(0, 0), b2, voffB); PG8_STAGE(PG8_SB(0, 1), b2 + hstep, voffB); PG8_STAGE(PG8_SA(0, 0), a2, voffA);
            PG8_WAIT_V(8); PG8_WAIT_L(0); PG8_BAR; PG8_MMA(1, 0, At, B0); PG8_MMA(1, 1, At, B1); PG8_BAR; PG8_SCHED;
            PG8_LDB(B0, 1, 0); PG8_LDB(B1, 1, 1); PG8_SCHED; PG8_LDA(At, 1, 0); PG8_STAGE(PG8_SA(0, 1), a2 + hstep, voffA);
            PG8_WAIT_V(8); PG8_WAIT_L(0); PG8_BAR; PG8_MMA(0, 0, At, B0); PG8_MMA(0, 1, At, B1); PG8_BAR; PG8_SCHED;
            PG8_LDA(At, 1, 1); PG8_STAGE(PG8_SB(1, 0), b3, voffB); PG8_STAGE(PG8_SB(1, 1), b3 + hstep, voffB); PG8_STAGE(PG8_SA(1, 0), a3, voffA);
            PG8_WAIT_V(8); PG8_WAIT_L(0); PG8_BAR; PG8_MMA(1, 0, At, B0); PG8_MMA(1, 1, At, B1); PG8_BAR; PG8_SCHED;
            } else {
            PG8_LDB(B0, 0, 0); PG8_SCHED; PG8_LDA(At, 0, 0); PG8_STAGE(PG8_SA(1, 1), a1 + hstep, voffA);
            PG8_WAIT_L(8); PG8_BAR; PG8_WAIT_L(0); PG8_MMA(0, 0, At, B0); PG8_BAR; PG8_SCHED;
            PG8_LDB(B1, 0, 1); PG8_STAGE(PG8_SB(0, 0), b2, voffB);
            PG8_BAR; PG8_WAIT_L(0); PG8_MMA(0, 1, At, B1); PG8_BAR;
            PG8_LDA(At, 0, 1); PG8_STAGE(PG8_SA(0, 0), a2, voffA);
            PG8_BAR; PG8_WAIT_L(0); PG8_MMA(1, 0, At, B0); PG8_BAR; PG8_SCHED;
            PG8_STAGE(PG8_SB(0, 1), b2 + hstep, voffB);
            PG8_WAIT_V(6); PG8_BAR; PG8_MMA(1, 1, At, B1); PG8_BAR;
            PG8_LDB(B0, 1, 0); PG8_SCHED; PG8_LDA(At, 1, 0); PG8_STAGE(PG8_SA(0, 1), a2 + hstep, voffA);
            PG8_WAIT_L(8); PG8_BAR; PG8_WAIT_L(0); PG8_MMA(0, 0, At, B0); PG8_BAR; PG8_SCHED;
            PG8_LDB(B1, 1, 1); PG8_STAGE(PG8_SB(1, 0), b3, voffB);
            PG8_BAR; PG8_WAIT_L(0); PG8_MMA(0, 1, At, B1); PG8_BAR;
            PG8_LDA(At, 1, 1); PG8_STAGE(PG8_SA(1, 0), a3, voffA);
            PG8_BAR; PG8_WAIT_L(0); PG8_MMA(1, 0, At, B0); PG8_BAR; PG8_SCHED;
            PG8_STAGE(PG8_SB(1, 1), b3 + hstep, voffB);
            PG8_WAIT_V(6); PG8_BAR; PG8_MMA(1, 1, At, B1); PG8_BAR;
            }
        }
        if constexpr (ALIGN_EPI) { if (wr == 0) PG8_BAR; }
        if constexpr (!Epi::AFTER_DRAIN) { const int le_ = opaque_lane(); E(acc, cur, wr, wc, le_ & 15, le_ >> 4); S.done(cur); }
        if (!has_next) break;
#pragma unroll
        for (int a = 0; a < 2; ++a)
#pragma unroll
            for (int b = 0; b < 2; ++b)
#pragma unroll
                for (int m = 0; m < 4; ++m)
#pragma unroll
                    for (int n = 0; n < 2; ++n) acc[a][b][m][n] = (f32x4){0.f, 0.f, 0.f, 0.f};
        cur = nxt; cA = nA; cB = nB; ++ui;
        if constexpr (ALIGN_EPI) { if (wr == 1) PG8_BAR; }
    }
    PG8_WAIT_V(0);
    if constexpr (!ALIGN_EPI) { if (wr == 0) PG8_BAR; }
    PG8_BAR;
    if constexpr (Epi::AFTER_DRAIN) { E.fused(acc, cur, wr, wc, fr, fq, lds, wid, lane); S.done(cur); }
#undef PG8_SA
#undef PG8_SB
#undef PG8_STAGE
#undef PG8_LDA
#undef PG8_LDB
#undef PG8_MMA
#undef PG8_WAIT_V
#undef PG8_WAIT_L
#undef PG8_BAR
#undef PG8_SCHED
}
}

constexpr int NWAVES = 8;
constexpr int DM = 2048, NBATCH = 2, SEQ = 8192, CTXL = 256, TPB = CTXL + SEQ  , MALL = NBATCH * TPB  ;
constexpr int NLAYER = 2;
constexpr int RW = 1024, NH = 16;
constexpr int RWC = 3392, INA = 4192, INA_P = 4352, INC = 8288;
constexpr int C_WD = 3072, C_AD = 3200, C_GD = 3328, C_QC = 3392, C_KVC = 3904, C_KR = 4160;
constexpr int QKD = 96, NQ = NH * QKD  , NKV = NH * 128  ;
constexpr int NEXP = 16384;
constexpr int RREC = 9 * 64;
constexpr float NORM_EPS = 1e-6f;

constexpr size_t MiB = 1u << 20;
constexpr size_t WS_CTL = 0, CTL_ZERO_BYTES = 1 * MiB;
constexpr size_t CTL_MOD_OFF = 256 * 1024;
constexpr size_t WS_ROPE = 1 * MiB;
constexpr size_t WS_WUP = 3 * MiB, WS_AUP = WS_WUP + 512 * 1024, WS_GUP = 4 * MiB;
constexpr size_t WS_WUQ = 5 * MiB, WS_WUKV = 8 * MiB, WS_WA = 10 * MiB, WS_WB = 18 * MiB, WS_WO = 26 * MiB, WS_WQK = 42 * MiB, WS_WGA = 58 * MiB, WS_WGB = 74 * MiB, WS_WINA = 90 * MiB;
constexpr size_t WS_X = 124 * MiB, WS_H = 256 * MiB, WS_DYN = 322 * MiB;
constexpr size_t WS_PA = WS_DYN;
constexpr size_t WS_RI = 463 * MiB;
constexpr size_t WS_GG = 760 * MiB;
constexpr size_t WS_BON = 826 * MiB;
constexpr size_t WS_QN = 829 * MiB, WS_KVN = 846 * MiB;
constexpr size_t WS_Q = 855 * MiB, WS_K = 905 * MiB, WS_V = 955 * MiB, WS_END = 988 * MiB;
constexpr size_t WS_Y = WS_DYN;
constexpr size_t WS_YA = 388 * MiB, WS_YB = 421 * MiB;
constexpr size_t WS_T1 = 463 * MiB, WS_T2 = 529 * MiB;
constexpr size_t WS_PU = 600 * MiB, WS_PV = 664 * MiB;
constexpr size_t WS_SC = WS_DYN;
static_assert(WS_PA + (size_t)MALL * INA_P * 2 <= WS_RI && WS_RI + (size_t)NBATCH * NH * TPB * RREC * 2 <= WS_GG && WS_GG + (size_t)2 * MALL * RW * 2 <= WS_BON, "ws map 1");
static_assert(WS_BON + (size_t)2 * MALL * 16 * 4 <= WS_QN && WS_QN + (size_t)MALL * 512 * 2 <= WS_KVN && WS_KVN + (size_t)MALL * 256 * 2 <= WS_Q, "ws map 2");
static_assert(WS_Q + (size_t)NBATCH * NH * TPB * QKD * 2 <= WS_K && WS_K + (size_t)NBATCH * NH * TPB * QKD * 2 <= WS_V && WS_V + (size_t)NBATCH * NH * TPB * 64 * 2 <= WS_END, "ws map 3");
static_assert(WS_Y + (size_t)2 * MALL * RW * 2 <= WS_YA && WS_YA + (size_t)MALL * RW * 2 <= WS_YB && WS_YB + (size_t)MALL * RW * 2 <= WS_RI, "ws map 4");
static_assert(WS_T1 + (size_t)MALL * DM * 2 <= WS_T2 && WS_T2 + (size_t)MALL * DM * 2 <= WS_PU && WS_PU + (size_t)NEXP * DM * 2 <= WS_PV && WS_PV + (size_t)NEXP * DM * 2 <= WS_GG, "ws map 5");
static_assert(WS_SC + (size_t)MALL * DM * 4 <= WS_T1 && WS_X + (size_t)MALL * DM * 4 <= WS_H && WS_H + (size_t)MALL * DM * 2 <= WS_DYN, "ws map 6");
static_assert(WS_WINA + (size_t)NLAYER * INA_P * DM * 2 <= WS_X, "ws map 7");
constexpr size_t CTL_PROBE_OFF = 640 * 1024;
constexpr int CW_BAR = 4096;

constexpr int RING_BYTES = 131072;
constexpr int LDSCTL_OFF = RING_BYTES, MISC_OFF = LDSCTL_OFF + 320;
constexpr int LDS_BYTES = 147456;

#define GAS __attribute__((address_space(1)))
#define LAS __attribute__((address_space(3)))
typedef unsigned short bf16;
typedef unsigned v4u __attribute__((ext_vector_type(4)));
typedef unsigned v2u __attribute__((ext_vector_type(2)));
typedef float f32x4 __attribute__((ext_vector_type(4)));
typedef float f32x2 __attribute__((ext_vector_type(2)));
typedef float f32x16 __attribute__((ext_vector_type(16)));
typedef short bf16x8 __attribute__((ext_vector_type(8)));
typedef short s16x4 __attribute__((ext_vector_type(4)));
typedef __bf16 bf16x2v __attribute__((ext_vector_type(2)));
typedef __bf16 bf16x8v __attribute__((ext_vector_type(8)));
typedef GAS unsigned gu32;
#define RLX_AGENT __ATOMIC_RELAXED, __HIP_MEMORY_SCOPE_AGENT
#define LDS_WAIT() asm volatile("s_waitcnt lgkmcnt(0)" ::: "memory")
#define VM_WAIT() asm volatile("s_waitcnt vmcnt(0)" ::: "memory")
__device__ __forceinline__ unsigned f2bf(float f) { unsigned u = __builtin_bit_cast(unsigned, f); return (u + 0x7fffu + ((u >> 16) & 1u)) >> 16; }
__device__ __forceinline__ unsigned pk2(float lo, float hi) { return pg8::cvt_pk_bf16(lo, hi); }
__device__ __forceinline__ float bflo(unsigned w) { return __builtin_bit_cast(float, w << 16); }
__device__ __forceinline__ float bfhi(unsigned w) { return __builtin_bit_cast(float, w & 0xffff0000u); }
__device__ __forceinline__ float bf1(bf16 h) { return __builtin_bit_cast(float, (unsigned)h << 16); }
__device__ __forceinline__ float sigmoidf_(float x) { return 1.0f / (1.0f + __expf(-x)); }
template <int CTRL> __device__ __forceinline__ float dpp_add(float x) {
    return x + __builtin_bit_cast(float, __builtin_amdgcn_update_dpp(0, __builtin_bit_cast(int, x), CTRL, 0xf, 0xf, true));
}
__device__ __forceinline__ float red16(float x) {
    x = dpp_add<0xB1>(x);
    x = dpp_add<0x4E>(x);
    x = dpp_add<0x141>(x);
    x = dpp_add<0x140>(x);
    return x;
}
template <int CTRL, int RM> __device__ __forceinline__ float dpp_max(float x) {
    return fmaxf(x, __builtin_bit_cast(float, __builtin_amdgcn_update_dpp(__builtin_bit_cast(int, x), __builtin_bit_cast(int, x), CTRL, RM, 0xf, false)));
}
template <int CTRL, int RM> __device__ __forceinline__ float dpp_sum(float x) {
    return x + __builtin_bit_cast(float, __builtin_amdgcn_update_dpp(0, __builtin_bit_cast(int, x), CTRL, RM, 0xf, false));
}
__device__ __forceinline__ float wave_max_u(float x) {
    x = dpp_max<0xB1, 0xf>(x); x = dpp_max<0x4E, 0xf>(x); x = dpp_max<0x141, 0xf>(x); x = dpp_max<0x140, 0xf>(x);
    x = dpp_max<0x142, 0xa>(x); x = dpp_max<0x143, 0xc>(x);
    return __builtin_bit_cast(float, __builtin_amdgcn_readlane(__builtin_bit_cast(int, x), 63));
}
__device__ __forceinline__ float wave_sum_u(float x) {
    x = dpp_sum<0xB1, 0xf>(x); x = dpp_sum<0x4E, 0xf>(x); x = dpp_sum<0x141, 0xf>(x); x = dpp_sum<0x140, 0xf>(x);
    x = dpp_sum<0x142, 0xa>(x); x = dpp_sum<0x143, 0xc>(x);
    return __builtin_bit_cast(float, __builtin_amdgcn_readlane(__builtin_bit_cast(int, x), 63));
}
__device__ __forceinline__ float wave_sum(float v) { return wave_sum_u(v); }
__device__ __forceinline__ float bpermf(int srclane, float v) { return __builtin_bit_cast(float, __builtin_amdgcn_ds_bpermute(srclane << 2, __builtin_bit_cast(int, v))); }
__device__ __forceinline__ int bpermi(int srclane, int v) { return __builtin_amdgcn_ds_bpermute(srclane << 2, v); }

#define XB_TMO      128
#define XB_XCNT(j)  (256  + 64 * (j))
#define XB_XSUB(j)  (1280 + 64 * (j))
#define XB_XGEN(j)  (2304 + 64 * (j))
#define XB_TOP      3328
#define XB_TOPGEN   3392
#define XCD_BAR_WORDS 3456
#define XB_SPIN_CAP (1u << 20)

__device__ __forceinline__ unsigned xb_ld(unsigned* p)              { return __hip_atomic_load(p, __ATOMIC_RELAXED, __HIP_MEMORY_SCOPE_AGENT); }
__device__ __forceinline__ unsigned xb_add(unsigned* p, unsigned v) { return __hip_atomic_fetch_add(p, v, __ATOMIC_RELAXED, __HIP_MEMORY_SCOPE_AGENT); }
__device__ __forceinline__ unsigned xb_xcc_id() { return (unsigned)__builtin_amdgcn_s_getreg((3 << 11) | 20) & 0xFu; }
#define XB_SPIN(cond, bar) do { unsigned _sp = 0; while (cond) { __builtin_amdgcn_s_sleep(1); \
    if ((++_sp & 255u) == 0u) { if (xb_ld(&(bar)[XB_TMO])) break; if (_sp > XB_SPIN_CAP) { atomicAdd(&(bar)[XB_TMO], 1u); break; } } } } while (0)

struct XcdBarrier { unsigned* bar; unsigned x; volatile LAS unsigned* st; };

__device__ __forceinline__ XcdBarrier xcd_barrier_post(unsigned* bar, volatile LAS unsigned* st, bool t0) {
    XcdBarrier b; b.bar = bar; b.x = xb_xcc_id(); b.st = st;
    if (t0) (void)xb_add(&bar[XB_XCNT(b.x)], 1u);
    return b;
}
__device__ __forceinline__ void xcd_barrier_complete(unsigned* bar, unsigned x, unsigned& nloc, unsigned& nx) {
    const unsigned G = gridDim.x * gridDim.y * gridDim.z;
    unsigned sum, cnt, mine, sp = 0u;
    for (;;) {
        sum = 0u; cnt = 0u; mine = 0u;
#pragma unroll
        for (unsigned j = 0; j < 16; ++j) { const unsigned c = xb_ld(&bar[XB_XCNT(j)]); sum += c; cnt += (c > 0u) ? 1u : 0u; mine = (j == x) ? c : mine; }
        if (sum == G) break;
        __builtin_amdgcn_s_sleep(1);
        if ((++sp & 255u) == 0u) { if (xb_ld(&bar[XB_TMO])) break; if (sp > XB_SPIN_CAP) { atomicAdd(&bar[XB_TMO], 1u); break; } }
    }
    nloc = mine > 0u ? mine : 1u; nx = cnt > 0u ? cnt : 1u;
}
__device__ __forceinline__ void xcd_barrier(const XcdBarrier& b, bool t0) {
    asm volatile("s_waitcnt vmcnt(0)" ::: "memory");
    __syncthreads();
    if (t0) {
        unsigned* bar = b.bar;
        __builtin_amdgcn_s_waitcnt(0);
        unsigned nloc = b.st[0], nx = b.st[1];
        if (nloc == 0u) { xcd_barrier_complete(bar, b.x, nloc, nx); b.st[0] = nloc; b.st[1] = nx; }
        const unsigned old = xb_add(&bar[XB_XSUB(b.x)], 1u);
        const unsigned gen = old / nloc;
        if (old + 1u == (gen + 1u) * nloc) {
            __builtin_amdgcn_fence(__ATOMIC_RELEASE, "agent");
            asm volatile("s_waitcnt vmcnt(0)" ::: "memory");
            const unsigned og = xb_add(&bar[XB_TOP], 1u);
            const unsigned tg = og / nx;
            if (og + 1u == (tg + 1u) * nx) xb_add(&bar[XB_TOPGEN], 1u);
            else XB_SPIN(xb_ld(&bar[XB_TOPGEN]) == tg, bar);
            __builtin_amdgcn_fence(__ATOMIC_ACQUIRE, "agent");
            xb_add(&bar[XB_XGEN(b.x)], 1u);
            asm volatile("s_waitcnt vmcnt(0)" ::: "memory");
        } else {
            XB_SPIN(xb_ld(&bar[XB_XGEN(b.x)]) == gen, bar);
            __builtin_amdgcn_fence(__ATOMIC_ACQUIRE, "agent");
            asm volatile("s_waitcnt vmcnt(0)" ::: "memory");
        }
    }
    __syncthreads();
}

struct Frame {
    LAS unsigned char* lds;
    unsigned char* ws;
    const float* const* in;
    int tid, lane, wave;
    int vcu, G;
};
struct Args { const float* in[33]; float* out; unsigned char* ws; int ph_lo, ph_hi; };


namespace pg8 {
typedef unsigned u32x4 __attribute__((ext_vector_type(4)));
struct RowOrder : StaticOrder {
    int lat;
    __host__ __device__ void init_rows(int lat_, int N, int G_, int c_) { lat = lat_; init(lat_ ? NBATCH * SEQ : MALL, N, G_, c_); }
    __host__ __device__ bool next(int i, Unit& u) const { if (!StaticOrder::next(i, u)) return false; if (lat) u.pm = 33 * (u.pm >> 5) + 1 + (u.pm & 31); return true; }
};
#define EPI_LOOP_ROWS for (int ai = 0; ai < 2; ++ai) _Pragma("unroll") for (int m = 0; m < 4; ++m)
#define EPI_PIN asm volatile("" ::: "memory")

struct EpiStoreBf16 {
    static constexpr bool PERM = true, AFTER_DRAIN = false;
    bf16_t* O; int ldc;
    __device__ __forceinline__ void operator()(const f32x4 (&acc)[2][2][4][2], const Unit& u, int wr, int wc, int fr, int fq) const {
        const int row0 = u.pm * BM + wr * 64 + fr, col0 = u.pn * BM + wc * 32 + 8 * fq;
#pragma unroll
        EPI_LOOP_ROWS { bf16_t* rowp = O + (size_t)(row0 + ai * HALF + m * 16) * ldc + col0;
#pragma unroll
            for (int bj = 0; bj < 2; ++bj) { const f32x4 v0 = acc[ai][bj][m][0], v1 = acc[ai][bj][m][1];
                u32x4 w; w.x = cvt_pk_bf16(v0[0], v0[1]); w.y = cvt_pk_bf16(v0[2], v0[3]); w.z = cvt_pk_bf16(v1[0], v1[1]); w.w = cvt_pk_bf16(v1[2], v1[3]);
                *(u32x4*)(rowp + bj * HALF) = w; } }
    }
};
struct EpiGate {
    static constexpr bool PERM = true, AFTER_DRAIN = false;
    bf16_t* O; int ldc; const float* bias;
    __device__ __forceinline__ void operator()(const f32x4 (&acc)[2][2][4][2], const Unit& u, int wr, int wc, int fr, int fq) const {
        const int row0 = u.pm * BM + wr * 64 + fr, col0 = u.pn * BM + wc * 32 + 8 * fq;
        f32x4 bv[2][2];
#pragma unroll
        for (int bj = 0; bj < 2; ++bj)
#pragma unroll
            for (int n = 0; n < 2; ++n) bv[bj][n] = *(const f32x4*)(bias + col0 + bj * HALF + 4 * n);
#pragma unroll
        EPI_LOOP_ROWS { EPI_PIN; bf16_t* rowp = O + (size_t)(row0 + ai * HALF + m * 16) * ldc + col0;
#pragma unroll
            for (int bj = 0; bj < 2; ++bj) { f32x4 v0 = acc[ai][bj][m][0] + bv[bj][0], v1 = acc[ai][bj][m][1] + bv[bj][1];
#pragma unroll
                for (int e = 0; e < 4; ++e) { v0[e] = 1.0f / (1.0f + __expf(-v0[e])); v1[e] = 1.0f / (1.0f + __expf(-v1[e])); }
                u32x4 w; w.x = cvt_pk_bf16(v0[0], v0[1]); w.y = cvt_pk_bf16(v0[2], v0[3]); w.z = cvt_pk_bf16(v1[0], v1[1]); w.w = cvt_pk_bf16(v1[2], v1[3]);
                *(u32x4*)(rowp + bj * HALF) = w; } }
    }
};
__device__ __forceinline__ float bf_lo(unsigned w) { return __builtin_bit_cast(float, w << 16); }
__device__ __forceinline__ float bf_hi(unsigned w) { return __builtin_bit_cast(float, w & 0xffff0000u); }
struct EpiMulAdd {
    static constexpr bool PERM = true, AFTER_DRAIN = false;
    bf16_t* O; const bf16_t* Gt; const bf16_t* Ad; int ldc;
    __device__ __forceinline__ void operator()(const f32x4 (&acc)[2][2][4][2], const Unit& u, int wr, int wc, int fr, int fq) const {
        const int row0 = u.pm * BM + wr * 64 + fr, col0 = u.pn * BM + wc * 32 + 8 * fq;
#pragma unroll
        EPI_LOOP_ROWS { EPI_PIN; const size_t ro = (size_t)(row0 + ai * HALF + m * 16) * ldc + col0;
#pragma unroll
            for (int bj = 0; bj < 2; ++bj) { const f32x4 v0 = acc[ai][bj][m][0], v1 = acc[ai][bj][m][1];
                const u32x4 g = *(const u32x4*)(Gt + ro + bj * HALF);
                float o[8];
                o[0] = bf_lo(g.x) * v0[0]; o[1] = bf_hi(g.x) * v0[1]; o[2] = bf_lo(g.y) * v0[2]; o[3] = bf_hi(g.y) * v0[3];
                o[4] = bf_lo(g.z) * v1[0]; o[5] = bf_hi(g.z) * v1[1]; o[6] = bf_lo(g.w) * v1[2]; o[7] = bf_hi(g.w) * v1[3];
                if (Ad) { const u32x4 a = *(const u32x4*)(Ad + ro + bj * HALF);
                    o[0] += bf_lo(a.x); o[1] += bf_hi(a.x); o[2] += bf_lo(a.y); o[3] += bf_hi(a.y); o[4] += bf_lo(a.z); o[5] += bf_hi(a.z); o[6] += bf_lo(a.w); o[7] += bf_hi(a.w); }
                u32x4 w; w.x = cvt_pk_bf16(o[0], o[1]); w.y = cvt_pk_bf16(o[2], o[3]); w.z = cvt_pk_bf16(o[4], o[5]); w.w = cvt_pk_bf16(o[6], o[7]);
                *(u32x4*)(O + ro + bj * HALF) = w; } }
    }
};
struct EpiResid {
    static constexpr bool PERM = false, AFTER_DRAIN = false;
    float* X; const float* gate;
    __device__ __forceinline__ void operator()(const f32x4 (&acc)[2][2][4][2], const Unit& u, int wr, int wc, int fr, int fq) const {
        const int row0 = u.pm * BM + wr * 64 + fr, col0 = u.pn * BM + wc * 32 + 4 * fq;
        const int bb = u.pm / 33, mr = (u.pm - bb * 33 == 0) ? 2 : bb;
        const float* gp = gate + (size_t)mr * 12288 + col0;
        f32x4 gv[2][2];
#pragma unroll
        for (int bj = 0; bj < 2; ++bj)
#pragma unroll
            for (int n = 0; n < 2; ++n) gv[bj][n] = *(const f32x4*)(gp + bj * HALF + n * 16);
#pragma unroll
        EPI_LOOP_ROWS { EPI_PIN; float* rowp = X + (size_t)(row0 + ai * HALF + m * 16) * DM + col0;
#pragma unroll
            for (int bj = 0; bj < 2; ++bj)
#pragma unroll
                for (int n = 0; n < 2; ++n) { f32x4* p = (f32x4*)(rowp + bj * HALF + n * 16); *p = *p + gv[bj][n] * acc[ai][bj][m][n]; } }
    }
};
struct EpiF32 {
    static constexpr bool PERM = false, AFTER_DRAIN = false;
    float* C; int ldc;
    __device__ __forceinline__ void operator()(const f32x4 (&acc)[2][2][4][2], const Unit& u, int wr, int wc, int fr, int fq) const {
        const int row0 = u.pm * BM + wr * 64 + fr, col0 = u.pn * BM + wc * 32 + 4 * fq;
#pragma unroll
        EPI_LOOP_ROWS { float* rowp = C + (size_t)(row0 + ai * HALF + m * 16) * ldc + col0;
#pragma unroll
            for (int bj = 0; bj < 2; ++bj)
#pragma unroll
                for (int n = 0; n < 2; ++n) *(f32x4*)(rowp + bj * HALF + n * 16) = acc[ai][bj][m][n]; }
    }
};
struct EpiQ {
    static constexpr bool PERM = true, AFTER_DRAIN = false;
    bf16_t* Q; const f32x2* rope; float qscale;
    __device__ __forceinline__ void operator()(const f32x4 (&acc)[2][2][4][2], const Unit& u, int wr, int wc, int fr, int fq) const {
        const int bb = u.pm / 33, tp0 = (u.pm - bb * 33) * BM + wr * 64 + fr, col0 = u.pn * BM + wc * 32 + 8 * fq;
#pragma unroll
        for (int bj = 0; bj < 2; ++bj) { const int c = col0 + bj * HALF, hd = c / QKD, d = c - hd * QKD;
#pragma unroll
            EPI_LOOP_ROWS { EPI_PIN; const int tp = tp0 + ai * HALF + m * 16;
                f32x4 v0 = acc[ai][bj][m][0], v1 = acc[ai][bj][m][1];
                if (d >= 64) { const int i0 = (d - 64) >> 1; const f32x2* rp = rope + (size_t)tp * 16 + i0;
                    const f32x2 c0 = rp[0], c1 = rp[1], c2 = rp[2], c3 = rp[3];
                    float a, b;
                    a = v0[0]; b = v0[1]; v0[0] = a * c0.x - b * c0.y; v0[1] = a * c0.y + b * c0.x;
                    a = v0[2]; b = v0[3]; v0[2] = a * c1.x - b * c1.y; v0[3] = a * c1.y + b * c1.x;
                    a = v1[0]; b = v1[1]; v1[0] = a * c2.x - b * c2.y; v1[1] = a * c2.y + b * c2.x;
                    a = v1[2]; b = v1[3]; v1[2] = a * c3.x - b * c3.y; v1[3] = a * c3.y + b * c3.x; }
                v0 = v0 * qscale; v1 = v1 * qscale;
                u32x4 w; w.x = cvt_pk_bf16(v0[0], v0[1]); w.y = cvt_pk_bf16(v0[2], v0[3]); w.z = cvt_pk_bf16(v1[0], v1[1]); w.w = cvt_pk_bf16(v1[2], v1[3]);
                *(u32x4*)(Q + ((size_t)(bb * NH + hd) * TPB + tp) * QKD + d) = w; } }
    }
};
struct EpiKV {
    static constexpr bool PERM = true, AFTER_DRAIN = false;
    bf16_t* K; bf16_t* V;
    __device__ __forceinline__ void operator()(const f32x4 (&acc)[2][2][4][2], const Unit& u, int wr, int wc, int fr, int fq) const {
        const int bb = u.pm / 33, tp0 = (u.pm - bb * 33) * BM + wr * 64 + fr;
        const bool isK = wc < 2;
        bf16_t* base = isK ? K : V; const int pitch = isK ? QKD : 64, doff = 32 * (wc & 1) + 8 * fq;
#pragma unroll
        for (int bj = 0; bj < 2; ++bj) { const int hd = 2 * u.pn + bj;
            bf16_t* hb = base + (size_t)(bb * NH + hd) * TPB * pitch;
#pragma unroll
            EPI_LOOP_ROWS { EPI_PIN; const int tp = tp0 + ai * HALF + m * 16;
                const f32x4 v0 = acc[ai][bj][m][0], v1 = acc[ai][bj][m][1];
                u32x4 w; w.x = cvt_pk_bf16(v0[0], v0[1]); w.y = cvt_pk_bf16(v0[2], v0[3]); w.z = cvt_pk_bf16(v1[0], v1[1]); w.w = cvt_pk_bf16(v1[2], v1[3]);
                *(u32x4*)((char*)hb + (unsigned)((tp * pitch + doff) * 2)) = w; } }
    }
};
}

template <int MAPQ>
__device__ __forceinline__ void p0_transpose_item(const float* W, int K, int ldw, int c0, int N, bf16* WT, LAS float* scr, int item, int lane) {
    const int nblk = N / 32, kb = item / nblk, nb = item % nblk, k0 = 64 * kb, n0 = 32 * nb;
#pragma unroll 8
    for (int i = 0; i < 32; ++i) { const int kk = 2 * i + (lane >> 5); scr[kk * 33 + (lane & 31)] = W[(size_t)(k0 + kk) * ldw + c0 + n0 + (lane & 31)]; }
    LDS_WAIT(); asm volatile("" ::: "memory");
    const int c = lane & 7;
#pragma unroll
    for (int j = 0; j < 4; ++j) { const int n = (lane >> 3) + 8 * j; const LAS float* s = scr + (8 * c) * 33 + n;
        v4u o; o.x = pk2(s[0 * 33], s[1 * 33]); o.y = pk2(s[2 * 33], s[3 * 33]); o.z = pk2(s[4 * 33], s[5 * 33]); o.w = pk2(s[6 * 33], s[7 * 33]);
        int nn = n0 + n;
        if (MAPQ) { const int hd = nn / QKD, d = nn - hd * QKD; if (d >= 64) { const int i = (d - 64) & 15, s2 = (d - 64) >> 4; nn = hd * QKD + 64 + 2 * i + s2; } }
        *(GAS v4u*)(WT + (size_t)nn * K + k0 + 8 * c) = o; }
    LDS_WAIT(); asm volatile("" ::: "memory");
}

__device__ __forceinline__ const float* karg(int i);
__device__ __forceinline__ void p0_prologue(Frame& F) {
    LAS float* scr = (LAS float*)(F.lds + F.wave * 16384);
    const int gw = F.vcu * NWAVES + F.wave, NGW = F.G * NWAVES;
    unsigned char* ws = F.ws;
    for (int l = 0; l < NLAYER; ++l) {
        const float* w_in = karg(7) + (size_t)l * DM * INC; const float* wbra = karg(24); const float* wbrb = karg(25); const float* wout = karg(26); const float* wuq = karg(21); const float* wukv = karg(23); const float* wup = karg(11); const float* aup = karg(13);
        constexpr int I_INA = (DM / 64) * (INA / 32), I_G = (DM / 64) * (DM / 32), I_BR = (RW / 64) * (DM / 32), I_UQ = (512 / 64) * (NQ / 32), I_UKV = (256 / 64) * (NKV / 32), I_LR = 1 * (RW / 32);
        constexpr int NIT = I_INA + 2 * I_G + 2 * I_BR + I_G + I_UQ + I_UKV + 4 * I_LR;
        for (int it = gw; it < NIT; it += NGW) {
            int r = it;
            if (r < I_INA) { p0_transpose_item<0>(w_in, DM, INC, 0, INA, (bf16*)(ws + WS_WINA) + (size_t)l * INA_P * DM, scr, r, F.lane); continue; } r -= I_INA;
            if (r < I_G) { p0_transpose_item<0>(w_in, DM, INC, INA, DM, (bf16*)(ws + WS_WGA) + (size_t)l * DM * DM, scr, r, F.lane); continue; } r -= I_G;
            if (r < I_G) { p0_transpose_item<0>(w_in, DM, INC, INA + DM, DM, (bf16*)(ws + WS_WGB) + (size_t)l * DM * DM, scr, r, F.lane); continue; } r -= I_G;
            if (r < I_BR) { p0_transpose_item<0>(wbra + (size_t)l * RW * DM, RW, DM, 0, DM, (bf16*)(ws + WS_WA) + (size_t)l * DM * RW, scr, r, F.lane); continue; } r -= I_BR;
            if (r < I_BR) { p0_transpose_item<0>(wbrb + (size_t)l * RW * DM, RW, DM, 0, DM, (bf16*)(ws + WS_WB) + (size_t)l * DM * RW, scr, r, F.lane); continue; } r -= I_BR;
            if (r < I_G) { p0_transpose_item<0>(wout + (size_t)l * DM * DM, DM, DM, 0, DM, (bf16*)(ws + WS_WO) + (size_t)l * DM * DM, scr, r, F.lane); continue; } r -= I_G;
            if (r < I_UQ) { p0_transpose_item<1>(wuq + (size_t)l * 512 * NQ, 512, NQ, 0, NQ, (bf16*)(ws + WS_WUQ) + (size_t)l * NQ * 512, scr, r, F.lane); continue; } r -= I_UQ;
            if (r < I_UKV) { p0_transpose_item<0>(wukv + (size_t)l * 256 * NKV, 256, NKV, 0, NKV, (bf16*)(ws + WS_WUKV) + (size_t)l * NKV * 256, scr, r, F.lane); continue; } r -= I_UKV;
            { const int which = r / I_LR, d = which & 1, isa = which >> 1; r -= which * I_LR;
              const float* src = (isa ? aup : wup) + (size_t)(l * 2 + d) * 64 * RW;
              bf16* dst = (bf16*)(ws + (isa ? WS_AUP : WS_WUP)) + (size_t)(l * 2 + d) * RW * 64;
              p0_transpose_item<0>(src, 64, RW, 0, RW, dst, scr, r, F.lane); }
        }
    }
    const int gt = gw * 64 + F.lane, NGT = NGW * 64;
    { const float* gup = karg(14);
    for (int i = gt; i < NLAYER * 2 * 32 * RW; i += NGT) { const int ch = i & 1023, r = (i >> 10) & 31, ld = i >> 15;
        ((bf16*)(ws + WS_GUP))[((size_t)ld * RW + ch) * 32 + r] = (bf16)f2bf(gup[i]); } }
    for (int i = gt; i < NLAYER * (INA_P - INA) * DM / 8; i += NGT) { const int l = i / ((INA_P - INA) * DM / 8), r = i - l * ((INA_P - INA) * DM / 8);
        ((GAS v4u*)((bf16*)(ws + WS_WINA) + ((size_t)l * INA_P + INA) * DM))[r] = (v4u){0u, 0u, 0u, 0u}; }
    { const GAS f32x4* xs = (const GAS f32x4*)karg(0); const GAS f32x4* cs = (const GAS f32x4*)karg(2); GAS f32x4* X = (GAS f32x4*)(ws + WS_X);
      for (int i = gt; i < MALL * (DM / 4); i += NGT) { const int m = i >> 9, c4 = i & 511, b = m / TPB, tp = m - b * TPB;
          X[i] = (tp < CTXL) ? cs[((size_t)(b * CTXL + tp) << 9) + c4] : xs[((size_t)(b * SEQ + tp - CTXL) << 9) + c4]; } }
    { f32x2* rt = (f32x2*)(ws + WS_ROPE);
      for (int i = gt; i < TPB * 16; i += NGT) { const int tp = i >> 4, k = i & 15; f32x2 o = {1.f, 0.f};
          if (tp >= CTXL) { const int t = tp - CTXL, row = t >> 6, col = t & 63, j = k & 7; const float fr = powf(10000.0f, -(float)j / 8.0f);
              const float ang = (float)(k < 8 ? row : col) * fr; o.x = cosf(ang); o.y = sinf(ang); }
          rt[i] = o; } }
    { float* modw = (float*)(ws + WS_CTL + CTL_MOD_OFF); const float* adaw = karg(4); const float* adab = karg(5); const float* cin = karg(1); const float* cctx = karg(3);
      LAS f32x4* part = (LAS f32x4*)F.lds;
      for (int uu = F.vcu; uu < NLAYER * 48; uu += F.G) { const int cb = uu % 48, l = uu / 48;
          const int n0 = cb * 256 + F.lane * 4; const float* aw = adaw + (size_t)l * DM * 12288 + n0;
          f32x4 a0 = {0, 0, 0, 0}, a1 = a0, a2 = a0;
#pragma unroll 8
          for (int k = F.wave * 256; k < F.wave * 256 + 256; ++k) { const f32x4 w = *(const GAS f32x4*)(aw + (size_t)k * 12288);
              const float c0 = cin[k], c1 = cin[DM + k], c2 = cctx[k];
              const float s0 = c0 / (1.f + __expf(-c0)), s1 = c1 / (1.f + __expf(-c1)), s2 = c2 / (1.f + __expf(-c2));
              a0 = a0 + w * s0; a1 = a1 + w * s1; a2 = a2 + w * s2; }
          __syncthreads();
          part[(F.wave * 3 + 0) * 64 + F.lane] = a0; part[(F.wave * 3 + 1) * 64 + F.lane] = a1; part[(F.wave * 3 + 2) * 64 + F.lane] = a2;
          __syncthreads();
          if (F.wave < 3) { f32x4 s = *(const GAS f32x4*)(adab + (size_t)l * 12288 + n0);
#pragma unroll
              for (int w8 = 0; w8 < 8; ++w8) s = s + part[(w8 * 3 + F.wave) * 64 + F.lane];
              *(GAS f32x4*)(modw + ((size_t)l * 3 + F.wave) * 12288 + n0) = s; }
          __syncthreads(); } }
    { LAS float* KEY = (LAS float*)F.lds;
      LAS float* WQT = (LAS float*)(F.lds + 65536);
      const float* pkeys = karg(29); const float* pwq = karg(28);
      __syncthreads();
      for (int uu = F.vcu; uu < NLAYER * 16 * 32; uu += F.G) { const int kb = uu & 31, hp = (uu >> 5) & 15, l = uu >> 9;
          const GAS f32x4* ksrc = (const GAS f32x4*)(pkeys + ((size_t)l * 16 + hp) * 16384);
          for (int i = F.tid; i < 4096; i += 512) ((LAS f32x4*)KEY)[i] = ksrc[i];
          for (int i = F.tid; i < 2048; i += 512) { const int kk = i >> 5, d4 = i & 31;
              *(LAS f32x4*)(WQT + kk * 132 + d4 * 4) = *(const GAS f32x4*)(pwq + ((size_t)l * DM + kb * 64 + kk) * DM + hp * 128 + d4 * 4); }
          __syncthreads();
          const int kk = F.tid & 63, kg = F.tid >> 6;
          float acc[16];
#pragma unroll
          for (int j = 0; j < 16; ++j) acc[j] = 0.f;
          for (int d = 0; d < 128; d += 4) { const f32x4 w = *(LAS f32x4*)(WQT + kk * 132 + d);
#pragma unroll
              for (int j = 0; j < 16; ++j) { const f32x4 q = *(LAS f32x4*)(KEY + (kg * 16 + j) * 128 + d); acc[j] += q.x * w.x + q.y * w.y + q.z * w.z + q.w * w.w; } }
          bf16* dst = (bf16*)(ws + WS_WQK) + ((size_t)l * DM + hp * 128 + kg * 16) * DM + kb * 64 + kk;
#pragma unroll
          for (int j = 0; j < 16; ++j) dst[(size_t)j * DM] = (bf16)f2bf(acc[j]);
          __syncthreads(); } }
}

__device__ __forceinline__ void modnorm_phase(Frame& F, const float* X, const float* g, const float* mod  , int chunk_sh, bf16* H, int skip_ctx) {
    const int gw = F.vcu * NWAVES + F.wave, NGW = F.G * NWAVES;
    for (int m = gw; m < MALL; m += NGW) {
        const int b = m / TPB, tp = m - b * TPB; if (skip_ctx && tp < CTXL) continue;
        const int mr = tp < CTXL ? 2 : b;
        const GAS f32x4* xr = (const GAS f32x4*)(X + (size_t)m * DM) + F.lane;
        f32x4 v[8]; float s = 0.f;
#pragma unroll
        for (int j = 0; j < 8; ++j) { v[j] = xr[64 * j]; s += (v[j].x * v[j].x + v[j].y * v[j].y) + (v[j].z * v[j].z + v[j].w * v[j].w); }
        const float rs = rsqrtf(wave_sum(s) * (1.f / DM) + NORM_EPS);
        const float* sh = mod + (size_t)mr * 12288 + chunk_sh * DM; const float* sc = sh + DM;
        GAS v2u* o8 = (GAS v2u*)(H + (size_t)m * DM) + F.lane;
#pragma unroll
        for (int j = 0; j < 8; ++j) { const int c = (F.lane + 64 * j) * 4;
            const f32x4 gg = *(const GAS f32x4*)(g + c), s1 = *(const GAS f32x4*)(sc + c), s0 = *(const GAS f32x4*)(sh + c);
            f32x4 y = v[j] * rs * gg; y = y * (s1 + 1.0f) + s0;
            v2u o; o.x = pk2(y.x, y.y); o.y = pk2(y.z, y.w); o8[64 * j] = o; }
    }
}

typedef float f32x4v __attribute__((ext_vector_type(4)));
#define MFMA16(a, b, c) __builtin_amdgcn_mfma_f32_16x16x32_bf16((a), (b), (c), 0, 0, 0)
#define MFMA32(a, b, c) __builtin_amdgcn_mfma_f32_32x32x16_bf16((a), (b), (c), 0, 0, 0)

struct FeatP {
    const bf16* PA; const float* mu; const float* w0; const float* a0; const float* k_k; const float* k_a; const float* r_k;
    const bf16* WUP; const bf16* AUP; const bf16* GUP;
    const float* qnorm; const float* kvnorm; const f32x2* rope;
    bf16* RI; bf16* GG; float* BON; bf16* QN; bf16* KVN; bf16* K;
};
__device__ __forceinline__ f32x4 ld4bf(const bf16* p) { const v2u w = *(const GAS v2u*)p; return (f32x4){bflo(w.x), bfhi(w.x), bflo(w.y), bfhi(w.y)}; }
__device__ __forceinline__ f32x4 mix4(const bf16* PA, int m, int c, bool hp, bool hn, const float* mu) {
    const f32x4 pc = ld4bf(PA + (size_t)m * INA_P + c);
    f32x4 pp = {0, 0, 0, 0}, pn = {0, 0, 0, 0};
    if (hp) pp = ld4bf(PA + (size_t)(m - 1) * INA_P + c);
    if (hn) pn = ld4bf(PA + (size_t)(m + 1) * INA_P + c);
    const f32x4 mm = *(const GAS f32x4*)(mu + c);
    return pc + ((pp + pn) * 0.5f - pc) * mm;
}
__device__ __forceinline__ void features_phase(Frame& F, const FeatP& P) {
    constexpr int LAP = 328;
    LAS bf16* LA = (LAS bf16*)F.lds;
    const int lane = F.lane, w = F.wave;
    for (int uu = F.vcu; uu < MALL / 16; uu += F.G) {
        const int m0 = uu * 16;
        __syncthreads();
        { const int tk = F.tid >> 5, l32 = F.tid & 31, m = m0 + tk, tp = m % TPB;
          const bool hp = (tp != 0) && (tp != CTXL), hn = (tp != CTXL - 1) && (tp != TPB - 1);
          const bf16* row = P.PA + (size_t)m * INA_P;
#pragma unroll
          for (int i = 0; i < 10; ++i) { const int c = C_WD + l32 + 32 * i;
              const float pc = bf1(row[c]), pp = hp ? bf1(row[c - INA_P]) : 0.f, pn = hn ? bf1(row[c + INA_P]) : 0.f;
              float v = pc + (0.5f * (pp + pn) - pc) * P.mu[c];
              if (c < C_AD) v = tanhf(v); else if (c >= C_GD) v = sigmoidf_(v);
              LA[tk * LAP + (c - C_WD)] = (bf16)f2bf(v); } }
#pragma unroll
        for (int tt = 0; tt < 2; ++tt) { const int m = m0 + 2 * w + tt, b = m / TPB, tp = m - b * TPB; const bf16* row = P.PA + (size_t)m * INA_P;
            { const v4u q = *(const GAS v4u*)(row + C_QC + lane * 8);
              float x[8] = {bflo(q.x), bfhi(q.x), bflo(q.y), bfhi(q.y), bflo(q.z), bfhi(q.z), bflo(q.w), bfhi(q.w)}; float s = 0.f;
#pragma unroll
              for (int e = 0; e < 8; ++e) s += x[e] * x[e];
              const float rs = rsqrtf(wave_sum(s) * (1.f / 512.f) + NORM_EPS);
#pragma unroll
              for (int e = 0; e < 8; ++e) x[e] = x[e] * rs * P.qnorm[lane * 8 + e];
              v4u o; o.x = pk2(x[0], x[1]); o.y = pk2(x[2], x[3]); o.z = pk2(x[4], x[5]); o.w = pk2(x[6], x[7]);
              *(GAS v4u*)(P.QN + (size_t)m * 512 + lane * 8) = o; }
            { const v2u q = *(const GAS v2u*)(row + C_KVC + lane * 4);
              float x[4] = {bflo(q.x), bfhi(q.x), bflo(q.y), bfhi(q.y)}; float s = 0.f;
#pragma unroll
              for (int e = 0; e < 4; ++e) s += x[e] * x[e];
              const float rs = rsqrtf(wave_sum(s) * (1.f / 256.f) + NORM_EPS);
#pragma unroll
              for (int e = 0; e < 4; ++e) x[e] = x[e] * rs * P.kvnorm[lane * 4 + e];
              v2u o; o.x = pk2(x[0], x[1]); o.y = pk2(x[2], x[3]);
              *(GAS v2u*)(P.KVN + (size_t)m * 256 + lane * 4) = o; }
            if (lane < 16) { const float x1 = bf1(row[C_KR + lane]), x2 = bf1(row[C_KR + 16 + lane]); const f32x2 cs = P.rope[(size_t)tp * 16 + lane];
                const unsigned o = pk2(x1 * cs.x - x2 * cs.y, x1 * cs.y + x2 * cs.x);
#pragma unroll
                for (int hd = 0; hd < NH; ++hd) *(GAS unsigned*)(P.K + ((size_t)(b * NH + hd) * TPB + tp) * QKD + 64 + 2 * lane) = o; } }
        __syncthreads();
        const int tk = lane & 15, q4 = lane >> 4, m = m0 + tk, b = m / TPB, tp = m - b * TPB;
        const bool hp = (tp != 0) && (tp != CTXL), hn = (tp != CTXL - 1) && (tp != TPB - 1);
        bf16x8 bw[2][2], ba[2][2], bg[2];
#pragma unroll
        for (int d = 0; d < 2; ++d) {
#pragma unroll
            for (int ks = 0; ks < 2; ++ks) { bw[d][ks] = *(const LAS bf16x8*)(LA + tk * LAP + d * 64 + ks * 32 + q4 * 8); ba[d][ks] = *(const LAS bf16x8*)(LA + tk * LAP + 128 + d * 64 + ks * 32 + q4 * 8); }
            bg[d] = *(const LAS bf16x8*)(LA + tk * LAP + 256 + d * 32 + q4 * 8); }
#pragma unroll
        for (int hh = 0; hh < 2; ++hh) {
            float rsn;
            { float s = 0.f;
#pragma unroll 1
              for (int ct = 0; ct < 4; ++ct) { const int ch = 128 * w + 64 * hh + 16 * ct + 4 * q4; const f32x4 kx = mix4(P.PA, m, RW + ch, hp, hn, P.mu) * *(const GAS f32x4*)(P.k_k + ch);
                  s += kx.x * kx.x + kx.y * kx.y + kx.z * kx.z + kx.w * kx.w; }
              s += bpermf(lane ^ 16, s); s += bpermf(lane ^ 32, s); rsn = rsqrtf(s + 1e-12f); }
            float bon0 = 0.f, bon1 = 0.f;
            const int hd = 2 * w + hh;
#pragma unroll 1
            for (int c4 = 0; c4 < 4; ++c4) {
                const int cb = 128 * w + 64 * hh + 16 * c4, chA = cb + tk  , ch = cb + 4 * q4  ;
                f32x4 cw[2], ca[2], cg[2];
#pragma unroll
                for (int d = 0; d < 2; ++d) { cw[d] = (f32x4){0, 0, 0, 0}; ca[d] = cw[d]; cg[d] = cw[d];
#pragma unroll
                    for (int ks = 0; ks < 2; ++ks) {
                        const bf16x8 aw = *(const GAS bf16x8*)(P.WUP + ((size_t)d * RW + chA) * 64 + ks * 32 + q4 * 8);
                        const bf16x8 aa = *(const GAS bf16x8*)(P.AUP + ((size_t)d * RW + chA) * 64 + ks * 32 + q4 * 8);
                        cw[d] = MFMA16(aw, bw[d][ks], cw[d]); ca[d] = MFMA16(aa, ba[d][ks], ca[d]); }
                    const bf16x8 ag = *(const GAS bf16x8*)(P.GUP + ((size_t)d * RW + chA) * 32 + q4 * 8);
                    cg[d] = MFMA16(ag, bg[d], cg[d]); }
                const f32x4 r4 = mix4(P.PA, m, ch, hp, hn, P.mu), k4 = mix4(P.PA, m, RW + ch, hp, hn, P.mu), v4 = mix4(P.PA, m, 2 * RW + ch, hp, hn, P.mu);
                const f32x4 kk4 = k4 * *(const GAS f32x4*)(P.k_k + ch) * rsn;
                const f32x4 ka4 = *(const GAS f32x4*)(P.k_a + ch), rk4 = *(const GAS f32x4*)(P.r_k + ch);
                const int c64 = ch & 63;
                bf16* rec = P.RI + ((size_t)(b * NH + hd) * TPB + tp) * RREC + c64;
                { v2u o; o.x = pk2(r4.x, r4.y); o.y = pk2(r4.z, r4.w); *(GAS v2u*)(rec) = o;
                  o.x = pk2(kk4.x, kk4.y); o.y = pk2(kk4.z, kk4.w); *(GAS v2u*)(rec + 64) = o;
                  o.x = pk2(v4.x, v4.y); o.y = pk2(v4.z, v4.w); *(GAS v2u*)(rec + 128) = o; }
#pragma unroll
                for (int d = 0; d < 2; ++d) {
                    const f32x4 w0 = *(const GAS f32x4*)(P.w0 + d * RW + ch), a0 = *(const GAS f32x4*)(P.a0 + d * RW + ch);
                    f32x4 ld, aa, ke, bb; float bs = 0.f;
#pragma unroll
                    for (int e = 0; e < 4; ++e) { ld[e] = -0.60653066f * sigmoidf_(w0[e] + cw[d][e]); aa[e] = sigmoidf_(a0[e] + ca[d][e]);
                        ke[e] = k4[e] * (1.0f + (aa[e] - 1.0f) * ka4[e]); bb[e] = kk4[e] * aa[e]; bs += r4[e] * ke[e] * rk4[e]; }
                    if (d == 0) bon0 += bs; else bon1 += bs;
                    v2u o; o.x = pk2(ld.x, ld.y); o.y = pk2(ld.z, ld.w); *(GAS v2u*)(rec + (3 + 3 * d) * 64) = o;
                    o.x = pk2(bb.x, bb.y); o.y = pk2(bb.z, bb.w); *(GAS v2u*)(rec + (4 + 3 * d) * 64) = o;
                    o.x = pk2(ke.x, ke.y); o.y = pk2(ke.z, ke.w); *(GAS v2u*)(rec + (5 + 3 * d) * 64) = o;
                    o.x = pk2(cg[d].x, cg[d].y); o.y = pk2(cg[d].z, cg[d].w); *(GAS v2u*)(P.GG + ((size_t)d * MALL + m) * RW + ch) = o; }
            }
            bon0 += bpermf(lane ^ 16, bon0); bon0 += bpermf(lane ^ 32, bon0); bon1 += bpermf(lane ^ 16, bon1); bon1 += bpermf(lane ^ 32, bon1);
            if (q4 == 0) { P.BON[((size_t)0 * MALL + m) * 16 + hd] = bon0; P.BON[((size_t)1 * MALL + m) * 16 + hd] = bon1; }
        }
    }
}

constexpr int SCH = 32;
constexpr int SSTEP = 6 * 64;
__device__ __forceinline__ int scan_tp(int dir, int s) { return dir == 0 ? s : (s < CTXL ? (CTXL - 1 - s) : (TPB - 1 - (s - CTXL))); }
__device__ __forceinline__ void scan_stage(LAS float* buf, const bf16* RIh  , int dir, int chunk, int htid) {
#pragma unroll
    for (int i = 0; i < 6; ++i) { const int q = htid + 256 * i, st = q / 48, pc = q - st * 48;
        const int tp = scan_tp(dir, chunk * SCH + st);
        const bf16* rec = RIh + (size_t)tp * RREC;
        int so, slot;
        if (pc < 24) { const int arr = pc >> 3; so = arr * 64 + (pc & 7) * 8; slot = (arr == 0) ? 4 : (arr == 1 ? 0 : 5); }
        else { const int p2 = pc - 24, arr = p2 >> 3; so = (3 + 3 * dir + arr) * 64 + (p2 & 7) * 8; slot = (arr == 0) ? 2 : (arr == 1 ? 1 : 3); }
        const v4u wv = *(const GAS v4u*)(rec + so);
        f32x4 lo = {bflo(wv.x), bfhi(wv.x), bflo(wv.y), bfhi(wv.y)}, hi = {bflo(wv.z), bfhi(wv.z), bflo(wv.w), bfhi(wv.w)};
        if (slot == 2) {
#pragma unroll
            for (int e = 0; e < 4; ++e) { lo[e] = __expf(lo[e]); hi[e] = __expf(hi[e]); } }
        LAS float* d = buf + st * SSTEP + slot * 64 + (pc & 7) * 8;
        *(LAS f32x4*)d = lo; *(LAS f32x4*)(d + 4) = hi; }
}
__device__ __forceinline__ void scan_phase(Frame& F, const bf16* RI, bf16* Y) {
    LAS float* bufs = (LAS float*)F.lds;
    constexpr int NCH = TPB / SCH;
    for (int uu = F.vcu; uu < NBATCH * NH * 2 * 4; uu += F.G) {
        const int rg = uu & 3, dir = (uu >> 2) & 1, hd = (uu >> 3) & 15, b = uu >> 7;
        const bf16* RIh = RI + (size_t)(b * NH + hd) * TPB * RREC;
        __syncthreads();
        if (F.wave >= 4) scan_stage(bufs, RIh, dir, 0, F.tid - 256);
        __syncthreads();
        const int j = F.lane & 15, rowl = F.lane >> 4, row = rg * 16 + (F.wave & 3) * 4 + rowl;
        float S0 = 0.f, S1 = 0.f, S2 = 0.f, S3 = 0.f;
        bf16* yb = Y + ((size_t)dir * MALL + (size_t)b * TPB) * RW + hd * 64 + row;
        for (int c = 0; c < NCH; ++c) {
            LAS float* cur = bufs + (c & 1) * (SCH * SSTEP);
            if (F.wave >= 4) { if (c + 1 < NCH) scan_stage(bufs + ((c + 1) & 1) * (SCH * SSTEP), RIh, dir, c + 1, F.tid - 256); }
            else {
#pragma unroll 4
                for (int st = 0; st < SCH; ++st) {
                    const LAS float* sp = cur + st * SSTEP;
                    const f32x4 kk = *(const LAS f32x4*)(sp + 4 * j), bb = *(const LAS f32x4*)(sp + 64 + 4 * j), ww = *(const LAS f32x4*)(sp + 128 + 4 * j),
                                ke = *(const LAS f32x4*)(sp + 192 + 4 * j), rr = *(const LAS f32x4*)(sp + 256 + 4 * j);
                    const float vv = sp[320 + row];
                    float p = (S0 * kk.x + S1 * kk.y) + (S2 * kk.z + S3 * kk.w);
                    S0 = S0 * ww.x + vv * ke.x; S1 = S1 * ww.y + vv * ke.y; S2 = S2 * ww.z + vv * ke.z; S3 = S3 * ww.w + vv * ke.w;
                    const float sa = -red16(p);
                    S0 += sa * bb.x; S1 += sa * bb.y; S2 += sa * bb.z; S3 += sa * bb.w;
                    float y = (S0 * rr.x + S1 * rr.y) + (S2 * rr.z + S3 * rr.w);
                    y = red16(y);
                    if (j == 0) { const int tp = scan_tp(dir, c * SCH + st); yb[(size_t)tp * RW] = (bf16)f2bf(y); }
                }
            }
            __syncthreads();
        }
    }
}

constexpr int AKP = 208, AVP = 192;
constexpr int ATILE = 64 * AKP + 64 * AVP;
__device__ __forceinline__ bf16x8 pack8(const f32x16& x, int s) {
    v4u p; p.x = pk2(x[8 * s + 0], x[8 * s + 1]); p.y = pk2(x[8 * s + 2], x[8 * s + 3]); p.z = pk2(x[8 * s + 4], x[8 * s + 5]); p.w = pk2(x[8 * s + 6], x[8 * s + 7]);
    return __builtin_bit_cast(bf16x8, p);
}
__device__ __forceinline__ void attn_phase(Frame& F, const bf16* Q, const bf16* K, const bf16* V, bf16* YB, int with_ctx) {
    const int lane = F.lane, half = lane >> 5, l31 = lane & 31, l16 = lane & 15, g1 = (lane >> 4) & 1;
    const int nunits = NBATCH * NH * 32 + (with_ctx ? NBATCH * NH : 0);
    for (int uu = F.vcu; uu < nunits; uu += F.G) {
        int bh, q0, nkt;
        if (uu < NBATCH * NH * 32) { bh = uu >> 5; q0 = CTXL + (uu & 31) * 256; nkt = TPB / 64; } else { bh = uu - NBATCH * NH * 32; q0 = 0; nkt = CTXL / 64; }
        const bf16* Kh = K + (size_t)bh * TPB * QKD; const bf16* Vh = V + (size_t)bh * TPB * 64; const bf16* Qh = Q + (size_t)bh * TPB * QKD;
        const int tq = q0 + F.wave * 32 + l31;
        bf16x8 qf[6];
#pragma unroll
        for (int ks = 0; ks < 6; ++ks) qf[ks] = *(const GAS bf16x8*)(Qh + (size_t)tq * QKD + 16 * ks + 8 * half);
        f32x16 o0, o1;
#pragma unroll
        for (int i = 0; i < 16; ++i) { o0[i] = 0.f; o1[i] = 0.f; }
        float m_run = -1e30f, l_run = 0.f;
        const int kc1 = F.tid + 512; const bool k1ok = kc1 < 768;
        const unsigned kd0 = (unsigned)((F.tid / 12) * AKP + (F.tid % 12) * 16), kd1 = (unsigned)((kc1 / 12) * AKP + (kc1 % 12) * 16), vd = (unsigned)(64 * AKP + (F.tid >> 3) * AVP + (F.tid & 7) * 16);
        v4u kr0, kr1 = {0, 0, 0, 0}, vr;
        kr0 = *(const GAS v4u*)(Kh + (size_t)F.tid * 8); if (k1ok) kr1 = *(const GAS v4u*)(Kh + (size_t)kc1 * 8); vr = *(const GAS v4u*)(Vh + (size_t)F.tid * 8);
        __syncthreads();
        *(LAS v4u*)(F.lds + kd0) = kr0; if (k1ok) *(LAS v4u*)(F.lds + kd1) = kr1; *(LAS v4u*)(F.lds + vd) = vr;
        __syncthreads();
        for (int kt = 0; kt < nkt; ++kt) {
            const bool more = kt + 1 < nkt;
            if (more) { const bf16* kn = Kh + (size_t)(kt + 1) * 64 * QKD; const bf16* vn = Vh + (size_t)(kt + 1) * 64 * 64;
                kr0 = *(const GAS v4u*)(kn + (size_t)F.tid * 8); if (k1ok) kr1 = *(const GAS v4u*)(kn + (size_t)kc1 * 8); vr = *(const GAS v4u*)(vn + (size_t)F.tid * 8); }
            LAS unsigned char* Kb = F.lds + (kt & 1) * ATILE; LAS unsigned char* Vb = Kb + 64 * AKP;
            f32x16 s0, s1;
#pragma unroll
            for (int i = 0; i < 16; ++i) { s0[i] = 0.f; s1[i] = 0.f; }
#pragma unroll
            for (int ks = 0; ks < 6; ++ks) {
                const bf16x8 a0 = *(const LAS bf16x8*)(Kb + l31 * AKP + (16 * ks + 8 * half) * 2), a1 = *(const LAS bf16x8*)(Kb + (32 + l31) * AKP + (16 * ks + 8 * half) * 2);
                s0 = MFMA32(a0, qf[ks], s0); s1 = MFMA32(a1, qf[ks], s1); }
            float mx = s0[0];
#pragma unroll
            for (int i = 1; i < 16; ++i) mx = fmaxf(mx, s0[i]);
#pragma unroll
            for (int i = 0; i < 16; ++i) mx = fmaxf(mx, s1[i]);
            mx = fmaxf(mx, bpermf(lane ^ 32, mx));
            const float m_new = fmaxf(m_run, mx), alpha = __builtin_amdgcn_exp2f(m_run - m_new); m_run = m_new;
            float ps = 0.f;
#pragma unroll
            for (int i = 0; i < 16; ++i) { s0[i] = __builtin_amdgcn_exp2f(s0[i] - m_new); s1[i] = __builtin_amdgcn_exp2f(s1[i] - m_new); ps += s0[i] + s1[i]; }
            l_run = l_run * alpha + ps;
#pragma unroll
            for (int i = 0; i < 16; ++i) { o0[i] *= alpha; o1[i] *= alpha; }
#pragma unroll
            for (int t = 0; t < 2; ++t)
#pragma unroll
                for (int s = 0; s < 2; ++s) {
                    const bf16x8 pf = pack8(t == 0 ? s0 : s1, s);
                    const int kb = 32 * t + 16 * s + 4 * half + (l16 >> 2);
#pragma unroll
                    for (int dvt = 0; dvt < 2; ++dvt) {
                        const LAS unsigned char* vp = Vb + kb * AVP + (32 * dvt + 16 * g1 + 4 * (l16 & 3)) * 2;
                        const s16x4 lo = __builtin_amdgcn_ds_read_tr16_b64_v4i16((LAS s16x4*)vp), hi = __builtin_amdgcn_ds_read_tr16_b64_v4i16((LAS s16x4*)(vp + 8 * AVP));
                        const bf16x8 va = __builtin_shufflevector(lo, hi, 0, 1, 2, 3, 4, 5, 6, 7);
                        if (dvt == 0) o0 = MFMA32(va, pf, o0); else o1 = MFMA32(va, pf, o1); } }
            if (more) { LAS unsigned char* nb = F.lds + ((kt + 1) & 1) * ATILE;
                *(LAS v4u*)(nb + kd0) = kr0; if (k1ok) *(LAS v4u*)(nb + kd1) = kr1; *(LAS v4u*)(nb + vd) = vr; }
            __syncthreads();
        }
        const float linv = (DBG_SKIP & 4) ? 0.f : 1.0f / (l_run + bpermf(lane ^ 32, l_run));
        const int b = bh >> 4, hd = bh & 15;
        bf16* op = YB + ((size_t)b * TPB + tq) * RW + hd * 64 + 4 * half;
#pragma unroll
        for (int g = 0; g < 4; ++g) {
            v2u w; w.x = pk2(o0[4 * g] * linv, o0[4 * g + 1] * linv); w.y = pk2(o0[4 * g + 2] * linv, o0[4 * g + 3] * linv); *(GAS v2u*)(op + 8 * g) = w;
            w.x = pk2(o1[4 * g] * linv, o1[4 * g + 1] * linv); w.y = pk2(o1[4 * g + 2] * linv, o1[4 * g + 3] * linv); *(GAS v2u*)(op + 32 + 8 * g) = w; }
    }
}

__device__ __forceinline__ void readout_phase(Frame& F, const bf16* Y, const bf16* GG, const float* BON, const bf16* RI, const float* ln_w, const float* ln_b, bf16* YA) {
    const int gw = F.vcu * NWAVES + F.wave, NGW = F.G * NWAVES, lane = F.lane, hd = lane >> 2, ch0 = hd * 64 + (lane & 3) * 16;
    for (int m = gw; m < MALL; m += NGW) {
        const int b = m / TPB, tp = m - b * TPB;
        const bf16* rec = RI + ((size_t)(b * NH + hd) * TPB + tp) * RREC + 128 + (lane & 3) * 16;
        float vv[16], out[16];
        { const v4u a = *(const GAS v4u*)rec, c = *(const GAS v4u*)(rec + 8);
          vv[0] = bflo(a.x); vv[1] = bfhi(a.x); vv[2] = bflo(a.y); vv[3] = bfhi(a.y); vv[4] = bflo(a.z); vv[5] = bfhi(a.z); vv[6] = bflo(a.w); vv[7] = bfhi(a.w);
          vv[8] = bflo(c.x); vv[9] = bfhi(c.x); vv[10] = bflo(c.y); vv[11] = bfhi(c.y); vv[12] = bflo(c.z); vv[13] = bfhi(c.z); vv[14] = bflo(c.w); vv[15] = bfhi(c.w); }
#pragma unroll
        for (int e = 0; e < 16; ++e) out[e] = 0.f;
#pragma unroll
        for (int d = 0; d < 2; ++d) {
            const bf16* yp = Y + ((size_t)d * MALL + m) * RW + ch0; const bf16* gp = GG + ((size_t)d * MALL + m) * RW + ch0;
            float y[16], g[16];
            { const v4u a = *(const GAS v4u*)yp, c = *(const GAS v4u*)(yp + 8);
              y[0] = bflo(a.x); y[1] = bfhi(a.x); y[2] = bflo(a.y); y[3] = bfhi(a.y); y[4] = bflo(a.z); y[5] = bfhi(a.z); y[6] = bflo(a.w); y[7] = bfhi(a.w);
              y[8] = bflo(c.x); y[9] = bfhi(c.x); y[10] = bflo(c.y); y[11] = bfhi(c.y); y[12] = bflo(c.z); y[13] = bfhi(c.z); y[14] = bflo(c.w); y[15] = bfhi(c.w); }
            { const v4u a = *(const GAS v4u*)gp, c = *(const GAS v4u*)(gp + 8);
              g[0] = bflo(a.x); g[1] = bfhi(a.x); g[2] = bflo(a.y); g[3] = bfhi(a.y); g[4] = bflo(a.z); g[5] = bfhi(a.z); g[6] = bflo(a.w); g[7] = bfhi(a.w);
              g[8] = bflo(c.x); g[9] = bfhi(c.x); g[10] = bflo(c.y); g[11] = bfhi(c.y); g[12] = bflo(c.z); g[13] = bfhi(c.z); g[14] = bflo(c.w); g[15] = bfhi(c.w); }
            float s = 0.f;
#pragma unroll
            for (int e = 0; e < 16; ++e) s += y[e];
            s = dpp_add<0xB1>(s); s = dpp_add<0x4E>(s);
            const float mean = s * (1.f / 64.f); float q = 0.f;
#pragma unroll
            for (int e = 0; e < 16; ++e) { y[e] -= mean; q += y[e] * y[e]; }
            q = dpp_add<0xB1>(q); q = dpp_add<0x4E>(q);
            const float rstd = rsqrtf(q * (1.f / 64.f) + 64e-5f), bon = BON[((size_t)d * MALL + m) * 16 + hd];
#pragma unroll
            for (int e = 0; e < 16; ++e) out[e] += (y[e] * rstd * ln_w[ch0 + e] + ln_b[ch0 + e] + bon * vv[e]) * g[e];
        }
        if (DBG_SKIP & 2) {
#pragma unroll
            for (int e = 0; e < 16; ++e) out[e] = 0.f; }
        v4u o0, o1;
        o0.x = pk2(out[0], out[1]); o0.y = pk2(out[2], out[3]); o0.z = pk2(out[4], out[5]); o0.w = pk2(out[6], out[7]);
        o1.x = pk2(out[8], out[9]); o1.y = pk2(out[10], out[11]); o1.z = pk2(out[12], out[13]); o1.w = pk2(out[14], out[15]);
        *(GAS v4u*)(YA + (size_t)m * RW + ch0) = o0; *(GAS v4u*)(YA + (size_t)m * RW + ch0 + 8) = o1;
    }
}

__device__ __forceinline__ int first_lane(unsigned long long mask) { return __builtin_ctzll(mask); }
__device__ __forceinline__ void top16_of_128(float a, float b, int lane, float& wv, int& wi) {
    wv = 0.f; wi = 0;
    for (int it = 0; it < 16; ++it) {
        const float m = wave_max_u(fmaxf(a, b));
        const bool ha = (a == m), hb = (b == m);
        const unsigned long long bal = __ballot(ha || hb);
        const int wl = first_lane(bal);
        const int myi = ha ? lane : lane + 64;
        const int idx = __builtin_amdgcn_readlane(myi, wl);
        if (lane == wl) { if (ha) a = -3.0e38f; else b = -3.0e38f; }
        if (lane == it) { wv = m; wi = idx; }
    }
}
struct PeerP { const float* SC; const bf16* H; const bf16* PU; const bf16* PV; float* X; const float* mod;   const float* fin_g; float* out; int last; };
__device__ __forceinline__ void peer_phase(Frame& F, const PeerP& P) {
    const int gw = F.vcu * NWAVES + F.wave, NGW = F.G * NWAVES, lane = F.lane;
    float pr_s2 = 0.f, pr_d2 = 0.f, pr_tg = 0.f, pr_n = 0.f;
    for (int m = gw; m < MALL; m += NGW) {
        const int b = m / TPB, tp = m - b * TPB; if (P.last && tp < CTXL) continue;
        const int mr = tp < CTXL ? 2 : b;
        int eidx[2] = {0, 0}; float egate[2] = {0.f, 0.f};
        const float* srow = P.SC + (size_t)m * DM;
        if (DBG_PROBE) { float s2 = 0.f; for (int i = lane; i < DM; i += 64) s2 += srow[i] * srow[i]; pr_s2 += wave_sum_u(s2) * (1.f / DM); pr_n += 1.f; }
#pragma unroll 1
        for (int hd = 0; hd < 8; ++hd) {
            float w1v, w2v; int w1i, w2i;
            top16_of_128(srow[hd * 256 + lane], srow[hd * 256 + 64 + lane], lane, w1v, w1i);
            top16_of_128(srow[hd * 256 + 128 + lane], srow[hd * 256 + 192 + lane], lane, w2v, w2i);
            const float v1 = bpermf(lane & 15, w1v); const int i1 = bpermi(lane & 15, w1i);
            float cs[4]; int ci[4];
#pragma unroll
            for (int e = 0; e < 4; ++e) { const int j = 4 * (lane >> 4) + e; cs[e] = v1 + bpermf(j, w2v); ci[e] = i1 * 128 + bpermi(j, w2i); }
            float tv = 0.f, tsum = 0.f, m0 = 0.f; int ti = 0;
            for (int it = 0; it < 16; ++it) {
                const float mm = wave_max_u(fmaxf(fmaxf(cs[0], cs[1]), fmaxf(cs[2], cs[3])));
                const int sl = (cs[0] == mm) ? 0 : (cs[1] == mm) ? 1 : (cs[2] == mm) ? 2 : (cs[3] == mm) ? 3 : 4;
                const unsigned long long bal = __ballot(sl < 4);
                const int wl = first_lane(bal);
                const int myi = (sl == 0) ? ci[0] : (sl == 1) ? ci[1] : (sl == 2) ? ci[2] : ci[3];
                const int idx = __builtin_amdgcn_readlane(myi, wl);
                if (lane == wl) { if (sl == 0) cs[0] = -3.0e38f; else if (sl == 1) cs[1] = -3.0e38f; else if (sl == 2) cs[2] = -3.0e38f; else cs[3] = -3.0e38f; }
                if (it == 0) m0 = mm;
                const float ev = __expf(mm - m0); tsum += ev;
                if (lane == it) { tv = ev; ti = idx; }
            }
            const float gt = tv / tsum;
            if (DBG_PROBE) pr_tg += 1.0f / tsum * 0.125f;
            const int src = lane & 15;
            const float gsh = bpermf(src, gt); const int ish = bpermi(src, ti);
            if ((lane >> 4) == (hd & 3)) { if (hd < 4) { egate[0] = gsh; eidx[0] = ish; } else { egate[1] = gsh; eidx[1] = ish; } }
        }
        v4u hp[4];
#pragma unroll
        for (int j = 0; j < 4; ++j) hp[j] = *(const GAS v4u*)(P.H + (size_t)m * DM + j * 512 + lane * 8);
        float coef[2];
#pragma unroll
        for (int sl = 0; sl < 2; ++sl) {
            float mydot = 0.f;
#pragma unroll 1
            for (int e0 = 0; e0 < 64; e0 += 4) {
                v4u u[4][4];
#pragma unroll
                for (int q = 0; q < 4; ++q) { const int ex = __builtin_amdgcn_readlane(eidx[sl], e0 + q); const bf16* ur = P.PU + (size_t)ex * DM + lane * 8;
#pragma unroll
                    for (int j = 0; j < 4; ++j) u[q][j] = *(const GAS v4u*)(ur + j * 512); }
#pragma unroll
                for (int q = 0; q < 4; ++q) { float s = 0.f;
#pragma unroll
                    for (int j = 0; j < 4; ++j) {
                        const bf16x8v hv = __builtin_bit_cast(bf16x8v, hp[j]), uv = __builtin_bit_cast(bf16x8v, u[q][j]);
                        s = __builtin_amdgcn_fdot2_f32_bf16(__builtin_shufflevector(hv, hv, 0, 1), __builtin_shufflevector(uv, uv, 0, 1), s, false);
                        s = __builtin_amdgcn_fdot2_f32_bf16(__builtin_shufflevector(hv, hv, 2, 3), __builtin_shufflevector(uv, uv, 2, 3), s, false);
                        s = __builtin_amdgcn_fdot2_f32_bf16(__builtin_shufflevector(hv, hv, 4, 5), __builtin_shufflevector(uv, uv, 4, 5), s, false);
                        s = __builtin_amdgcn_fdot2_f32_bf16(__builtin_shufflevector(hv, hv, 6, 7), __builtin_shufflevector(uv, uv, 6, 7), s, false); }
                    const float tot = wave_sum_u(s);
                    if (lane == e0 + q) mydot = tot; }
            }
            if (DBG_PROBE) pr_d2 += wave_sum_u(mydot * mydot) * (1.f / 128.f);
            coef[sl] = egate[sl] * 0.5f * mydot * (1.0f + erff(mydot * 0.70710678f));
            if ((DBG_SKIP & 16) && sl == 0) coef[sl] = 0.f;
            if ((DBG_SKIP & 32) && sl == 1) coef[sl] = 0.f;
        }
        float acc[32];
#pragma unroll
        for (int i = 0; i < 32; ++i) acc[i] = 0.f;
#pragma unroll
        for (int sl = 0; sl < 2; ++sl) {
#pragma unroll 1
            for (int e0 = 0; e0 < 64; e0 += 4) {
                v4u u[4][4]; float cf[4];
#pragma unroll
                for (int q = 0; q < 4; ++q) { const int ex = __builtin_amdgcn_readlane(eidx[sl], e0 + q); cf[q] = __builtin_bit_cast(float, __builtin_amdgcn_readlane(__builtin_bit_cast(int, coef[sl]), e0 + q));
                    const bf16* vr = P.PV + (size_t)ex * DM + lane * 8;
#pragma unroll
                    for (int j = 0; j < 4; ++j) u[q][j] = *(const GAS v4u*)(vr + j * 512); }
#pragma unroll
                for (int q = 0; q < 4; ++q)
#pragma unroll
                    for (int j = 0; j < 4; ++j) { const v4u w = u[q][j]; const float c = cf[q];
                        acc[8 * j + 0] += c * bflo(w.x); acc[8 * j + 1] += c * bfhi(w.x); acc[8 * j + 2] += c * bflo(w.y); acc[8 * j + 3] += c * bfhi(w.y);
                        acc[8 * j + 4] += c * bflo(w.z); acc[8 * j + 5] += c * bfhi(w.z); acc[8 * j + 6] += c * bflo(w.w); acc[8 * j + 7] += c * bfhi(w.w); }
            }
        }
        if (DBG_SKIP & 1) {
#pragma unroll
            for (int i = 0; i < 32; ++i) acc[i] = 0.f; }
        if (((DBG_SKIP & 64) && !P.last) || ((DBG_SKIP & 128) && P.last)) {
#pragma unroll
            for (int i = 0; i < 32; ++i) acc[i] = 0.f; }
        if (DBG_SKIP & 8) {
#pragma unroll
            for (int i = 0; i < 32; ++i) acc[i] = -acc[i]; }
        float* xr = P.X + (size_t)m * DM; const float* g2 = P.mod + (size_t)mr * 12288 + 5 * DM;
        float ss = 0.f;
#pragma unroll
        for (int j = 0; j < 4; ++j)
#pragma unroll
            for (int hq = 0; hq < 2; ++hq) { const int c = j * 512 + lane * 8 + hq * 4;
                f32x4 xv = *(const GAS f32x4*)(xr + c); const f32x4 gv = *(const GAS f32x4*)(g2 + c);
#pragma unroll
                for (int e = 0; e < 4; ++e) { xv[e] += gv[e] * acc[8 * j + 4 * hq + e]; ss += xv[e] * xv[e]; acc[8 * j + 4 * hq + e] = xv[e]; }
                if (!P.last) *(GAS f32x4*)(xr + c) = xv; }
        if (P.last) { const float rs = rsqrtf(wave_sum(ss) * (1.f / DM) + NORM_EPS); float* orow = P.out + ((size_t)b * SEQ + (tp - CTXL)) * DM;
#pragma unroll
            for (int j = 0; j < 4; ++j)
#pragma unroll
                for (int hq = 0; hq < 2; ++hq) { const int c = j * 512 + lane * 8 + hq * 4; const f32x4 fg = *(const GAS f32x4*)(P.fin_g + c);
                    f32x4 o;
#pragma unroll
                    for (int e = 0; e < 4; ++e) o[e] = acc[8 * j + 4 * hq + e] * rs * fg[e];
                    *(GAS f32x4*)(orow + c) = o; } }
    }
    if (DBG_PROBE && !P.last && lane == 0) { float* pp = (float*)(F.ws + WS_CTL + CTL_PROBE_OFF) + gw * 4; pp[0] = pr_s2; pp[1] = pr_d2; pp[2] = pr_tg; pp[3] = pr_n; }
}
__device__ __forceinline__ void cvt_tables(Frame& F, const float* pu, const float* pv, bf16* PU, bf16* PV) {
    const size_t gt = (size_t)(F.vcu * NWAVES + F.wave) * 64 + F.lane, NGT = (size_t)F.G * NWAVES * 64, n8 = (size_t)NEXP * DM / 8;
    for (size_t i = gt; i < 2 * n8; i += NGT) { const bool sec = i >= n8; const size_t k = sec ? i - n8 : i;
        const GAS f32x4* s = (const GAS f32x4*)(sec ? pv : pu) + 2 * k; const f32x4 a = s[0], c = s[1];
        v4u o; o.x = pk2(a.x, a.y); o.y = pk2(a.z, a.w); o.z = pk2(c.x, c.y); o.w = pk2(c.z, c.w);
        ((GAS v4u*)(sec ? PV : PU))[k] = o; }
}

constexpr int PH_PER_LAYER = 11, NPHASE = 1 + NLAYER * PH_PER_LAYER;
#ifndef ONLY_PHASE
#define ONLY_PHASE -1
#endif
#define T0() (wave_s == 0 && pg8::opaque_lane() == 0)
#define PH_ON(k) (ONLY_PHASE < 0 || ONLY_PHASE == (k))
#define GEMM_CALL(EPI, SCHED, g, S, E) pg8::gemm_phase<EPI, SCHED, true, true>(F.lds, g, S, E, wave_s)
#define GEMM_CALL_NA(EPI, SCHED, g, S, E) pg8::gemm_phase<EPI, SCHED, false, true>(F.lds, g, S, E, wave_s)

__device__ __forceinline__ const float* karg(int i) {
    asm volatile("" : "+s"(i));
    const __attribute__((address_space(4))) unsigned long long* ka = (const __attribute__((address_space(4))) unsigned long long*)__builtin_amdgcn_kernarg_segment_ptr();
    return (const float*)ka[i];
}
__global__ void __launch_bounds__(NWAVES * 64, 2) mk_fwd(Args args) {
    extern __shared__ __attribute__((aligned(16))) unsigned char lds[];
    Frame F;
    F.lds = (LAS unsigned char*)lds; F.ws = args.ws;
    const int wave_s = __builtin_amdgcn_readfirstlane((int)threadIdx.x >> 6);
    F.tid = threadIdx.x; F.lane = F.tid & 63; F.wave = wave_s;
    F.G = gridDim.x; { const int bx = blockIdx.x; F.vcu = (F.G % 8 == 0) ? (bx % 8) * (F.G / 8) + bx / 8 : bx; }
    unsigned char* ws = args.ws;
    volatile LAS unsigned* MISC = (volatile LAS unsigned*)(F.lds + MISC_OFF);
    for (int u = F.tid; u < (LDS_BYTES - LDSCTL_OFF) / 4; u += NWAVES * 64) ((LAS unsigned*)(F.lds + LDSCTL_OFF))[u] = 0u;
    __syncthreads();
    const int lo = args.ph_lo, hi = args.ph_hi;
    XcdBarrier bar; bar.bar = (unsigned*)(ws + WS_CTL) + CW_BAR; bar.x = 0; bar.st = nullptr;
    if (hi - lo > 1) bar = xcd_barrier_post((unsigned*)(ws + WS_CTL) + CW_BAR, MISC + 8, T0());
#define IN(k) (lo <= (k) && (k) < hi)
#define REFRAME() do { const int lz_ = pg8::opaque_lane(); F.lane = lz_; F.tid = wave_s * 64 + lz_; F.wave = wave_s; ws = (unsigned char*)karg(34); F.ws = ws; { int g_ = (int)gridDim.x, b_ = (int)blockIdx.x; asm volatile("" : "+s"(g_), "+s"(b_)); bx = b_; F.G = g_; F.vcu = ((g_ & 7) == 0) ? (b_ & 7) * (g_ >> 3) + (b_ >> 3) : b_; } } while (0)
#define SEAM(k) do { if (IN((k) + 1)) xcd_barrier(bar, T0()); } while (0)
#define XBUF ((float*)(ws + WS_X))
#define HBUF ((bf16*)(ws + WS_H))
#define MODP ((const float*)(ws + WS_CTL + CTL_MOD_OFF) + (size_t)l * 3 * 12288)
    int bx = (int)blockIdx.x;

    if (PH_ON(100) && IN(0)) { REFRAME(); p0_prologue(F); SEAM(0); }

    for (int l = 0; l < NLAYER; ++l) {
        const int base = 1 + l * PH_PER_LAYER;
        const int last = (l == NLAYER - 1);
        if (PH_ON(0) && IN(base + 0)) { REFRAME(); modnorm_phase(F, XBUF, karg(6) + (size_t)l * DM, MODP, 0, HBUF, 0); SEAM(base + 0); }
        if (PH_ON(1) && IN(base + 1)) { REFRAME();
            pg8::Gemm g{HBUF, (const bf16*)(ws + WS_WINA) + (size_t)l * INA_P * DM, MALL, INA_P, DM}; pg8::RowOrder S; S.init_rows(0, INA_P, F.G, bx);
            pg8::EpiStoreBf16 E{(bf16*)(ws + WS_PA), INA_P};
            GEMM_CALL(pg8::EpiStoreBf16, pg8::RowOrder, g, S, E);
            SEAM(base + 1); }
        if (PH_ON(2) && IN(base + 2)) { REFRAME();
            FeatP P;
            P.PA = (const bf16*)(ws + WS_PA); P.mu = karg(9) + (size_t)l * RWC; P.w0 = karg(10) + (size_t)l * 2 * RW; P.a0 = karg(12) + (size_t)l * 2 * RW;
            P.k_k = karg(15) + (size_t)l * RW; P.k_a = karg(16) + (size_t)l * RW; P.r_k = karg(17) + (size_t)l * RW;
            P.WUP = (const bf16*)(ws + WS_WUP) + (size_t)l * 2 * RW * 64; P.AUP = (const bf16*)(ws + WS_AUP) + (size_t)l * 2 * RW * 64; P.GUP = (const bf16*)(ws + WS_GUP) + (size_t)l * 2 * RW * 32;
            P.qnorm = karg(20) + (size_t)l * 512; P.kvnorm = karg(22) + (size_t)l * 256; P.rope = (const f32x2*)(ws + WS_ROPE);
            P.RI = (bf16*)(ws + WS_RI); P.GG = (bf16*)(ws + WS_GG); P.BON = (float*)(ws + WS_BON); P.QN = (bf16*)(ws + WS_QN); P.KVN = (bf16*)(ws + WS_KVN); P.K = (bf16*)(ws + WS_K);
            features_phase(F, P);
            SEAM(base + 2); }
        if (PH_ON(3) && IN(base + 3)) { REFRAME();
            { pg8::Gemm g{(const bf16*)(ws + WS_QN), (const bf16*)(ws + WS_WUQ) + (size_t)l * NQ * 512, MALL, NQ, 512};
              pg8::EpiQ E{(bf16*)(ws + WS_Q), (const f32x2*)(ws + WS_ROPE), 0.14724444f};
              pg8::RowOrder S; S.init_rows(last, NQ, F.G, bx); GEMM_CALL_NA(pg8::EpiQ, pg8::RowOrder, g, S, E); }
            { pg8::Gemm g{(const bf16*)(ws + WS_KVN), (const bf16*)(ws + WS_WUKV) + (size_t)l * NKV * 256, MALL, NKV, 256}; pg8::RowOrder S; S.init_rows(0, NKV, F.G, bx);
              pg8::EpiKV E{(bf16*)(ws + WS_K), (bf16*)(ws + WS_V)};
              GEMM_CALL_NA(pg8::EpiKV, pg8::RowOrder, g, S, E); }
            SEAM(base + 3); }
        if (PH_ON(4) && IN(base + 4)) { REFRAME(); scan_phase(F, (const bf16*)(ws + WS_RI), (bf16*)(ws + WS_Y)); SEAM(base + 4); }
        if (PH_ON(5) && IN(base + 5)) { REFRAME();
            attn_phase(F, (const bf16*)(ws + WS_Q), (const bf16*)(ws + WS_K), (const bf16*)(ws + WS_V), (bf16*)(ws + WS_YB), !last);
            readout_phase(F, (const bf16*)(ws + WS_Y), (const bf16*)(ws + WS_GG), (const float*)(ws + WS_BON), (const bf16*)(ws + WS_RI), karg(18) + (size_t)l * RW, karg(19) + (size_t)l * RW, (bf16*)(ws + WS_YA));
            SEAM(base + 5); }
        if (PH_ON(6) && IN(base + 6)) { REFRAME();
            bf16* T1 = (bf16*)(ws + WS_T1); bf16* T2 = (bf16*)(ws + WS_T2);
            const pg8::Gemm g1{HBUF, (const bf16*)(ws + WS_WGA) + (size_t)l * DM * DM, MALL, DM, DM}, g2{(const bf16*)(ws + WS_YA), (const bf16*)(ws + WS_WA) + (size_t)l * DM * RW, MALL, DM, RW};
            const pg8::Gemm g3{HBUF, (const bf16*)(ws + WS_WGB) + (size_t)l * DM * DM, MALL, DM, DM}, g4{(const bf16*)(ws + WS_YB), (const bf16*)(ws + WS_WB) + (size_t)l * DM * RW, MALL, DM, RW};
            const pg8::EpiGate E1{T1, DM, karg(8) + (size_t)l * 2 * DM}, E3{T2, DM, karg(8) + (size_t)l * 2 * DM + DM};
            const pg8::EpiMulAdd E2{T1, T1, nullptr, DM}, E4{T1, T2, T1, DM};
            pg8::RowOrder S; S.init_rows(last, DM, F.G, bx);
            GEMM_CALL(pg8::EpiGate, pg8::RowOrder, g1, S, E1); GEMM_CALL(pg8::EpiMulAdd, pg8::RowOrder, g2, S, E2); GEMM_CALL(pg8::EpiGate, pg8::RowOrder, g3, S, E3); GEMM_CALL(pg8::EpiMulAdd, pg8::RowOrder, g4, S, E4);
            SEAM(base + 6); }
        if (PH_ON(7) && IN(base + 7)) { REFRAME();
            const pg8::Gemm g{(const bf16*)(ws + WS_T1), (const bf16*)(ws + WS_WO) + (size_t)l * DM * DM, MALL, DM, DM};
            const pg8::EpiResid E{XBUF, MODP + 2 * DM};
            pg8::RowOrder S; S.init_rows(last, DM, F.G, bx); GEMM_CALL(pg8::EpiResid, pg8::RowOrder, g, S, E);
            SEAM(base + 7); }
        if (PH_ON(8) && IN(base + 8)) { REFRAME();
            modnorm_phase(F, XBUF, karg(27) + (size_t)l * DM, MODP, 3, HBUF, last);
            cvt_tables(F, karg(30) + (size_t)l * NEXP * DM, karg(31) + (size_t)l * NEXP * DM, (bf16*)(ws + WS_PU), (bf16*)(ws + WS_PV));
            SEAM(base + 8); }
        if (PH_ON(9) && IN(base + 9)) { REFRAME();
            const pg8::Gemm g{HBUF, (const bf16*)(ws + WS_WQK) + (size_t)l * DM * DM, MALL, DM, DM};
            const pg8::EpiF32 E{(float*)(ws + WS_SC), DM};
            pg8::RowOrder S; S.init_rows(last, DM, F.G, bx); GEMM_CALL(pg8::EpiF32, pg8::RowOrder, g, S, E);
            SEAM(base + 9); }
        if (PH_ON(10) && IN(base + 10)) { REFRAME();
            PeerP P; P.SC = (const float*)(ws + WS_SC); P.H = HBUF; P.PU = (const bf16*)(ws + WS_PU); P.PV = (const bf16*)(ws + WS_PV); P.X = XBUF; P.mod = MODP; P.fin_g = karg(32); P.out = (float*)karg(33); P.last = last;
            peer_phase(F, P);
            SEAM(base + 10); }
    }
#undef IN
#undef SEAM
#undef XBUF
#undef HBUF
#undef MODP
}

__global__ void __launch_bounds__(512) dbg_fill(const float* pp, float* o) {
    float s0 = 0.f, s1 = 0.f, s2 = 0.f, s3 = 0.f;
    for (int i = 0; i < 2048; ++i) { s0 += pp[4 * i]; s1 += pp[4 * i + 1]; s2 += pp[4 * i + 2]; s3 += pp[4 * i + 3]; }
    const float v = DBG_PROBE == 1 ? 10.f * sqrtf(s0 / s3) : DBG_PROBE == 2 ? 10.f * sqrtf(s1 / s3) : 100.f * s2 / s3;
    for (size_t i = (size_t)blockIdx.x * 512 + threadIdx.x; i < (size_t)NBATCH * SEQ * DM; i += (size_t)gridDim.x * 512) o[i] = v;
}
extern "C" void kernel_launch(void* const* d_in, const int* in_sizes, int n_in, void* d_out, int out_size, void* d_ws, size_t ws_size, hipStream_t stream) {
    static int grid = 0;
    if (grid == 0) {
        if (n_in != 33 || out_size != NBATCH * SEQ * DM || ws_size < WS_END) { fprintf(stderr, "kernel_launch: unexpected shapes (n_in %d out %d ws %zu)\n", n_in, out_size, ws_size); grid = -1; return; }
        int dev = 0, cus = 0, per_cu = 0;
        if (hipGetDevice(&dev) != hipSuccess || hipDeviceGetAttribute(&cus, hipDeviceAttributeMultiprocessorCount, dev) != hipSuccess) { grid = -1; return; }
        if (hipFuncSetAttribute((const void*)mk_fwd, hipFuncAttributeMaxDynamicSharedMemorySize, LDS_BYTES) != hipSuccess) { fprintf(stderr, "kernel_launch: hipFuncSetAttribute failed\n"); grid = -1; return; }
        if (hipOccupancyMaxActiveBlocksPerMultiprocessor(&per_cu, (const void*)mk_fwd, NWAVES * 64, LDS_BYTES) != hipSuccess || per_cu < 1) { fprintf(stderr, "kernel_launch: occupancy query says %d\n", per_cu); (void)hipGetLastError(); grid = -1; return; }
        grid = cus;
    }
    if (grid < 0) return;
    if (hipMemsetAsync((char*)d_ws + WS_CTL, 0, CTL_ZERO_BYTES, stream) != hipSuccess) return;
    Args a{};
    for (int i = 0; i < 33; ++i) a.in[i] = (const float*)d_in[i];
    a.out = (float*)d_out; a.ws = (unsigned char*)d_ws;
#if MK_N_LAUNCHES == 1
    a.ph_lo = 0; a.ph_hi = NPHASE;
    hipLaunchKernelGGL(mk_fwd, dim3(grid), dim3(NWAVES * 64), LDS_BYTES, stream, a);
#else
    for (int p = 0; p < NPHASE; ++p) { a.ph_lo = p; a.ph_hi = p + 1; hipLaunchKernelGGL(mk_fwd, dim3(grid), dim3(NWAVES * 64), LDS_BYTES, stream, a); }
    if (DBG_PROBE) hipLaunchKernelGGL(dbg_fill, dim3(1024), dim3(512), 0, stream, (const float*)((char*)d_ws + WS_CTL + CTL_PROBE_OFF), (float*)d_out);
#endif
}
```

```cpp
#include <hip/hip_runtime.h>
#include <cstdio>
#include <cstdint>

#ifndef MK_N_LAUNCHES
#define MK_N_LAUNCHES 1
#endif

#ifndef DBG_SKIP
#define DBG_SKIP 0
#endif
#ifndef DBG_PROBE
#define DBG_PROBE 0
#endif
#ifndef DBG_REPEAT
#define DBG_REPEAT -1
#endif
namespace pg8 {
#define PG8_LAS __attribute__((address_space(3)))
typedef unsigned short bf16_t;
typedef short bf16x8 __attribute__((ext_vector_type(8)));
typedef float f32x4 __attribute__((ext_vector_type(4)));
typedef unsigned u32x4 __attribute__((ext_vector_type(4)));
constexpr int BM = 256, BK = 64, HALF = 128, HTB = HALF * BK * 2  , STAGE_BYTES = 8 * HTB, NXCD = 8, WGM = 8;

__host__ __device__ __forceinline__ int lds_byte(int r, int c) { const int st = (r >> 4) * 2 + (c >> 5), rr = r & 15, cc = c & 31, ob = rr * 64 + cc * 2; return st * 1024 + (ob ^ (((ob >> 9) & 1) << 5)); }
__host__ __device__ __forceinline__ void stage_rc(int b, int& R, int& C) { const int st = b / 1024, sb = b % 1024, swz = sb ^ (((sb >> 9) & 1) << 5); R = (st >> 1) * 16 + swz / 64; C = (st & 1) * 32 + (swz % 64) / 2; }
__host__ __device__ __forceinline__ int perm32(int rho) { const int n = rho >> 4, i = rho & 15; return 8 * (i >> 2) + 4 * n + (i & 3); }

struct Unit { int pm, pn; };
struct Gemm { const bf16_t* A; const bf16_t* Bt; int M, N, K; };

struct StaticOrder {
    int nM, nN, nwg, G, c;
    __host__ __device__ void init(int M, int N, int G_, int c_) { nM = M / BM; nN = N / BM; nwg = nM * nN; G = G_; c = c_; }
    __host__ __device__ bool next(int i, Unit& u) const {
        const long L = (long)i * G + c; if (L >= nwg) return false;
        int wgid = (int)L; { const int q = nwg / NXCD, r = nwg % NXCD, xcd = wgid % NXCD, off = wgid / NXCD; wgid = (xcd < r ? xcd * (q + 1) : r * (q + 1) + (xcd - r) * q) + off; }
        const int nig = WGM * nN, gid = wgid / nig, fm = gid * WGM, gsz = (nM - fm) < WGM ? (nM - fm) : WGM;
        u.pm = fm + ((wgid % nig) % gsz); u.pn = (wgid % nig) / gsz; return true;
    }
    __device__ __forceinline__ void a_ready(const Unit&) const {}
    __device__ __forceinline__ void done(const Unit&) const {}
};
__device__ __forceinline__ int opaque_lane() { int l; asm volatile("v_mbcnt_lo_u32_b32 %0, -1, 0\n\tv_mbcnt_hi_u32_b32 %0, -1, %0" : "=v"(l)); return l; }
__device__ __forceinline__ unsigned cvt_pk_bf16(float lo, float hi) { unsigned r; asm volatile("v_cvt_pk_bf16_f32 %0, %1, %2" : "=v"(r) : "v"(lo), "v"(hi)); return r; }
template <class Epi, class Sched, bool ALIGN_EPI = false, bool SP2 = false>
__device__ __forceinline__ void gemm_phase(PG8_LAS unsigned char* lds, const Gemm g, const Sched& S, const Epi& E, const int wave_s) {
    const int lane_ = opaque_lane();
    const int wid = wave_s, lane = lane_, tid = wid * 64 + lane, wr = wid >> 2, wc = wid & 3, fr = lane & 15, fq = lane >> 4;
    const int K = g.K, nt = K / BK;
    unsigned voffA[2], voffB[2];
#pragma unroll
    for (int i = 0; i < 2; ++i) { int R, C; stage_rc(tid * 16 + i * 8192, R, C); const int Rb = Epi::PERM ? ((R & ~31) + perm32(R & 31)) : R;
        voffA[i] = (unsigned)(R * K + C) * 2u; voffB[i] = (unsigned)(Rb * K + C) * 2u; }
    const size_t kstep = (size_t)(BK * 2);
    const size_t hstep = (size_t)HALF * K * 2;
    const size_t tstep = 2 * hstep;
    const unsigned ldsw = (unsigned)wid * 1024u;
    const int aoff = lds_byte(wr * 64 + fr, fq * 8), boff = lds_byte(wc * 32 + fr, fq * 8);
#define PG8_SA(b, h) (((b) * 2 + (h)) * HTB)
#define PG8_SB(b, h) ((4 + (b) * 2 + (h)) * HTB)
#define PG8_STAGE(bufoff, gbase, voff) do { _Pragma("unroll") for (int _i = 0; _i < 2; ++_i) \
        __builtin_amdgcn_global_load_lds((const unsigned*)((const char*)(gbase) + (voff)[_i]), (PG8_LAS unsigned*)(lds + (bufoff) + ldsw + _i * 8192), 16, 0, 0); } while (0)
#define PG8_LDA(dst, b, h) do { _Pragma("unroll") for (int m = 0; m < 4; ++m) _Pragma("unroll") for (int k = 0; k < 2; ++k) dst[m][k] = *(const PG8_LAS bf16x8*)(lds + PG8_SA(b, h) + aoff + m * 2048 + k * 1024); } while (0)
#define PG8_LDB(dst, b, h) do { _Pragma("unroll") for (int n = 0; n < 2; ++n) _Pragma("unroll") for (int k = 0; k < 2; ++k) dst[n][k] = *(const PG8_LAS bf16x8*)(lds + PG8_SB(b, h) + boff + n * 2048 + k * 1024); } while (0)
#define PG8_MMA(ai, bj, At, Bt) do { __builtin_amdgcn_s_setprio(1); _Pragma("unroll") for (int m = 0; m < 4; ++m) _Pragma("unroll") for (int n = 0; n < 2; ++n) _Pragma("unroll") for (int k = 0; k < 2; ++k) \
        acc[ai][bj][m][n] = __builtin_amdgcn_mfma_f32_16x16x32_bf16(Bt[n][k], At[m][k], acc[ai][bj][m][n], 0, 0, 0); __builtin_amdgcn_s_setprio(0); } while (0)
#define PG8_WAIT_V(n) asm volatile("s_waitcnt vmcnt(" #n ")" ::: "memory")
#define PG8_WAIT_L(n) asm volatile("s_waitcnt lgkmcnt(" #n ")" ::: "memory")
#define PG8_BAR __builtin_amdgcn_s_barrier()
#define PG8_SCHED __builtin_amdgcn_sched_barrier(0)
    Unit cur, nxt; int ui = 0;
    if (!S.next(0, cur)) return;
    f32x4 acc[2][2][4][2];
#pragma unroll
    for (int a = 0; a < 2; ++a)
#pragma unroll
        for (int b = 0; b < 2; ++b)
#pragma unroll
            for (int m = 0; m < 4; ++m)
#pragma unroll
                for (int n = 0; n < 2; ++n) acc[a][b][m][n] = (f32x4){0.f, 0.f, 0.f, 0.f};
    bf16x8 At[4][2], B0[2][2], B1[2][2];
    const char* cA = (const char*)g.A + (size_t)cur.pm * tstep; const char* cB = (const char*)g.Bt + (size_t)cur.pn * tstep;
    S.a_ready(cur);
    if constexpr (SP2) {
        PG8_STAGE(PG8_SB(0, 0), cB, voffB); PG8_STAGE(PG8_SB(0, 1), cB + hstep, voffB); PG8_STAGE(PG8_SA(0, 0), cA, voffA); PG8_STAGE(PG8_SA(0, 1), cA + hstep, voffA);
        if (wr == 1) PG8_BAR;
        PG8_WAIT_V(2); PG8_BAR;
        PG8_STAGE(PG8_SB(1, 0), cB + kstep, voffB); PG8_STAGE(PG8_SA(1, 0), cA + kstep, voffA); PG8_STAGE(PG8_SB(1, 1), cB + hstep + kstep, voffB);
        PG8_WAIT_V(6); PG8_BAR;
    } else {
        PG8_STAGE(PG8_SB(0, 0), cB, voffB); PG8_STAGE(PG8_SA(0, 0), cA, voffA); PG8_STAGE(PG8_SB(0, 1), cB + hstep, voffB); PG8_STAGE(PG8_SA(0, 1), cA + hstep, voffA);
        if (wr == 1) PG8_BAR;
        PG8_WAIT_V(4); PG8_BAR;
        PG8_STAGE(PG8_SB(1, 0), cB + kstep, voffB); PG8_STAGE(PG8_SA(1, 0), cA + kstep, voffA); PG8_STAGE(PG8_SB(1, 1), cB + hstep + kstep, voffB);
        PG8_WAIT_V(6); PG8_BAR;
    }
    for (;;) {
        const bool has_next = S.next(ui + 1, nxt);
        const char* nA = has_next ? (const char*)g.A + (size_t)nxt.pm * tstep : cA; const char* nB = has_next ? (const char*)g.Bt + (size_t)nxt.pn * tstep : cB;
        for (int t = 0; t < nt; t += 2) {
            const bool last = (t == nt - 2);
            const char* a1 = cA + (size_t)(t + 1) * kstep;
            const char* a2 = last ? nA : cA + (size_t)(t + 2) * kstep; const char* b2 = last ? nB : cB + (size_t)(t + 2) * kstep;
            const char* a3 = a2 + kstep; const char* b3 = b2 + kstep;
            if (last && has_next) S.a_ready(nxt);
            if constexpr (SP2) {
            PG8_LDB(B0, 0, 0); PG8_LDB(B1, 0, 1); PG8_SCHED; PG8_LDA(At, 0, 0); PG8_STAGE(PG8_SA(1, 1), a1 + hstep, voffA);
            PG8_WAIT_V(8); PG8_WAIT_L(0); PG8_BAR; PG8_MMA(0, 0, At, B0); PG8_MMA(0, 1, At, B1); PG8_BAR; PG8_SCHED;
            PG8_LDA(At, 0, 1); PG8_STAGE(PG8_SB(0, 0), b2, voffB); PG8_STAGE(PG8_SB(0, 1), b2 + hstep, voffB); PG8_STAGE(PG8_SA(0, 0), a2, voffA);
            PG8_WAIT_V(8); PG8_WAIT_L(0); PG8_BAR; PG8_MMA(1, 0, At, B0); PG8_MMA(1, 1, At, B1); PG8_BAR; PG8_SCHED;
            PG8_LDB(B0, 1, 0); PG8_LDB(B1, 1, 1); PG8_SCHED; PG8_LDA(At, 1, 0); PG8_STAGE(PG8_SA(0, 1), a2 + hstep, voffA);
            PG8_WAIT_V(8); PG8_WAIT_L(0); PG8_BAR; PG8_MMA(0, 0, At, B0); PG8_MMA(0, 1, At, B1); PG8_BAR; PG8_SCHED;
            PG8_LDA(At, 1, 1); PG8_STAGE(PG8_SB(1, 0), b3, voffB); PG8_STAGE(PG8_SB(1, 1), b3 + hstep, voffB); PG8_STAGE(PG8_SA(1, 0), a3, voffA);
            PG8_WAIT_V(8); PG8_WAIT_L(0); PG8_BAR; PG8_MMA(1, 0, At, B0); PG8_MMA(1, 1, At, B1); PG8_BAR; PG8_SCHED;
            } else {
            PG8_LDB(B0, 0, 0); PG8_SCHED; PG8_LDA(At, 0, 0); PG8_STAGE(PG8_SA(1, 1), a1 + hstep, voffA);
            PG8_WAIT_L(8); PG8_BAR; PG8_WAIT_L(0); PG8_MMA(0, 0, At, B0); PG8_BAR; PG8_SCHED;
            PG8_LDB(B1, 0, 1); PG8_STAGE(PG8_SB(0, 0), b2, voffB);
            PG8_BAR; PG8_WAIT_L(0); PG8_MMA(0, 1, At, B1); PG8_BAR;
            PG8_LDA(At, 0, 1); PG8_STAGE(PG8_SA(0, 0), a2, voffA);
            PG8_BAR; PG8_WAIT_L(0); PG8_MMA(1, 0, At, B0); PG8_BAR; PG8_SCHED;
            PG8_STAGE(PG8_SB(0, 1), b2 + hstep, voffB);
            PG8_WAIT_V(6); PG8_BAR; PG8_MMA(1, 1, At, B1); PG8_BAR;
            PG8_LDB(B0, 1, 0); PG8_SCHED; PG8_LDA(At, 1, 0); PG8_STAGE(PG8_SA(0, 1), a2 + hstep, voffA);
            PG8_WAIT_L(8); PG8_BAR; PG8_WAIT_L(0); PG8_MMA(0, 0, At, B0); PG8_BAR; PG8_SCHED;
            PG8_LDB(B1, 1, 1); PG8_STAGE(PG8_SB(1, 0), b3, voffB);
            PG8_BAR; PG8_WAIT_L(0); PG8_MMA(0, 1, At, B1); PG8_BAR;
            PG8_LDA(At, 1, 1); PG8_STAGE(PG8_SA(1, 0), a3, voffA);
            PG8_BAR; PG8_WAIT_L(0); PG8_MMA(1, 0, At, B0); PG8_BAR; PG8_SCHED;
            PG8_STAGE(PG8_SB(1, 1), b3 + hstep, voffB);
            PG8_WAIT_V(6); PG8_BAR; PG8_MMA(1, 1, At, B1); PG8_BAR;
            }
        }
        if constexpr (ALIGN_EPI) { if (wr == 0) PG8_BAR; }
        if constexpr (!Epi::AFTER_DRAIN) { const int le_ = opaque_lane(); E(acc, cur, wr, wc, le_ & 15, le_ >> 4); S.done(cur); }
        if (!has_next) break;
#pragma unroll
        for (int a = 0; a < 2; ++a)
#pragma unroll
            for (int b = 0; b < 2; ++b)
#pragma unroll
                for (int m = 0; m < 4; ++m)
#pragma unroll
                    for (int n = 0; n < 2; ++n) acc[a][b][m][n] = (f32x4){0.f, 0.f, 0.f, 0.f};
        cur = nxt; cA = nA; cB = nB; ++ui;
        if constexpr (ALIGN_EPI) { if (wr == 1) PG8_BAR; }
    }
    PG8_WAIT_V(0);
    if constexpr (!ALIGN_EPI) { if (wr == 0) PG8_BAR; }
    PG8_BAR;
    if constexpr (Epi::AFTER_DRAIN) { E.fused(acc, cur, wr, wc, fr, fq, lds, wid, lane); S.done(cur); }
#undef PG8_SA
#undef PG8_SB
#undef PG8_STAGE
#undef PG8_LDA
#undef PG8_LDB
#undef PG8_MMA
#undef PG8_WAIT_V
#undef PG8_WAIT_L
#undef PG8_BAR
#undef PG8_SCHED
}
}

constexpr int NWAVES = 8;
constexpr int DM = 2048, NBATCH = 2, SEQ = 8192, CTXL = 256, TPB = CTXL + SEQ  , MALL = NBATCH * TPB  ;
constexpr int NLAYER = 2;
constexpr int RW = 1024, NH = 16;
constexpr int RWC = 3392, INA = 4192, INA_P = 4352, INC = 8288;
constexpr int C_WD = 3072, C_AD = 3200, C_GD = 3328, C_QC = 3392, C_KVC = 3904, C_KR = 4160;
constexpr int QKD = 96, NQ = NH * QKD  , NKV = NH * 128  ;
constexpr int NEXP = 16384;
constexpr int RREC = 9 * 64;
constexpr float NORM_EPS = 1e-6f;

constexpr size_t MiB = 1u << 20;
constexpr size_t WS_CTL = 0, CTL_ZERO_BYTES = 1 * MiB;
constexpr size_t CTL_MOD_OFF = 256 * 1024;
constexpr size_t WS_ROPE = 1 * MiB;
constexpr size_t WS_WUP = 3 * MiB, WS_AUP = WS_WUP + 512 * 1024, WS_GUP = 4 * MiB;
constexpr size_t WS_WUQ = 5 * MiB, WS_WUKV = 8 * MiB, WS_WA = 10 * MiB, WS_WB = 18 * MiB, WS_WO = 26 * MiB, WS_WQK = 42 * MiB, WS_WGA = 58 * MiB, WS_WGB = 74 * MiB, WS_WINA = 90 * MiB;
constexpr size_t WS_X = 124 * MiB, WS_H = 256 * MiB, WS_DYN = 322 * MiB;
constexpr size_t WS_PA = WS_DYN;
constexpr size_t WS_RI = 463 * MiB;
constexpr size_t WS_GG = 760 * MiB;
constexpr size_t WS_BON = 826 * MiB;
constexpr size_t WS_QN = 829 * MiB, WS_KVN = 846 * MiB;
constexpr size_t WS_Q = 855 * MiB, WS_K = 905 * MiB, WS_V = 955 * MiB, WS_END = 988 * MiB;
constexpr size_t WS_Y = WS_DYN;
constexpr size_t WS_YA = 388 * MiB, WS_YB = 421 * MiB;
constexpr size_t WS_T1 = 463 * MiB, WS_T2 = 529 * MiB;
constexpr size_t WS_PU = 600 * MiB, WS_PV = 664 * MiB;
constexpr size_t WS_SC = WS_DYN;
static_assert(WS_PA + (size_t)MALL * INA_P * 2 <= WS_RI && WS_RI + (size_t)NBATCH * NH * TPB * RREC * 2 <= WS_GG && WS_GG + (size_t)2 * MALL * RW * 2 <= WS_BON, "ws map 1");
static_assert(WS_BON + (size_t)2 * MALL * 16 * 4 <= WS_QN && WS_QN + (size_t)MALL * 512 * 2 <= WS_KVN && WS_KVN + (size_t)MALL * 256 * 2 <= WS_Q, "ws map 2");
static_assert(WS_Q + (size_t)NBATCH * NH * TPB * QKD * 2 <= WS_K && WS_K + (size_t)NBATCH * NH * TPB * QKD * 2 <= WS_V && WS_V + (size_t)NBATCH * NH * TPB * 64 * 2 <= WS_END, "ws map 3");
static_assert(WS_Y + (size_t)2 * MALL * RW * 2 <= WS_YA && WS_YA + (size_t)MALL * RW * 2 <= WS_YB && WS_YB + (size_t)MALL * RW * 2 <= WS_RI, "ws map 4");
static_assert(WS_T1 + (size_t)MALL * DM * 2 <= WS_T2 && WS_T2 + (size_t)MALL * DM * 2 <= WS_PU && WS_PU + (size_t)NEXP * DM * 2 <= WS_PV && WS_PV + (size_t)NEXP * DM * 2 <= WS_GG, "ws map 5");
static_assert(WS_SC + (size_t)MALL * DM * 4 <= WS_T1 && WS_X + (size_t)MALL * DM * 4 <= WS_H && WS_H + (size_t)MALL * DM * 2 <= WS_DYN, "ws map 6");
static_assert(WS_WINA + (size_t)NLAYER * INA_P * DM * 2 <= WS_X, "ws map 7");
constexpr size_t CTL_PROBE_OFF = 640 * 1024;
constexpr int CW_BAR = 4096;

constexpr int RING_BYTES = 131072;
constexpr int LDSCTL_OFF = RING_BYTES, MISC_OFF = LDSCTL_OFF + 320;
constexpr int LDS_BYTES = 147456;

#define GAS __attribute__((address_space(1)))
#define LAS __attribute__((address_space(3)))
typedef unsigned short bf16;
typedef unsigned v4u __attribute__((ext_vector_type(4)));
typedef unsigned v2u __attribute__((ext_vector_type(2)));
typedef float f32x4 __attribute__((ext_vector_type(4)));
typedef float f32x2 __attribute__((ext_vector_type(2)));
typedef float f32x16 __attribute__((ext_vector_type(16)));
typedef short bf16x8 __attribute__((ext_vector_type(8)));
typedef short s16x4 __attribute__((ext_vector_type(4)));
typedef __bf16 bf16x2v __attribute__((ext_vector_type(2)));
typedef __bf16 bf16x8v __attribute__((ext_vector_type(8)));
typedef GAS unsigned gu32;
#define RLX_AGENT __ATOMIC_RELAXED, __HIP_MEMORY_SCOPE_AGENT
#define LDS_WAIT() asm volatile("s_waitcnt lgkmcnt(0)" ::: "memory")
#define VM_WAIT() asm volatile("s_waitcnt vmcnt(0)" ::: "memory")
__device__ __forceinline__ unsigned f2bf(float f) { unsigned u = __builtin_bit_cast(unsigned, f); return (u + 0x7fffu + ((u >> 16) & 1u)) >> 16; }
__device__ __forceinline__ unsigned pk2(float lo, float hi) { return pg8::cvt_pk_bf16(lo, hi); }
__device__ __forceinline__ float bflo(unsigned w) { return __builtin_bit_cast(float, w << 16); }
__device__ __forceinline__ float bfhi(unsigned w) { return __builtin_bit_cast(float, w & 0xffff0000u); }
__device__ __forceinline__ float bf1(bf16 h) { return __builtin_bit_cast(float, (unsigned)h << 16); }
__device__ __forceinline__ float sigmoidf_(float x) { return 1.0f / (1.0f + __expf(-x)); }
template <int CTRL> __device__ __forceinline__ float dpp_add(float x) {
    return x + __builtin_bit_cast(float, __builtin_amdgcn_update_dpp(0, __builtin_bit_cast(int, x), CTRL, 0xf, 0xf, true));
}
__device__ __forceinline__ float red16(float x) {
    x = dpp_add<0xB1>(x);
    x = dpp_add<0x4E>(x);
    x = dpp_add<0x141>(x);
    x = dpp_add<0x140>(x);
    return x;
}
template <int CTRL, int RM> __device__ __forceinline__ float dpp_max(float x) {
    return fmaxf(x, __builtin_bit_cast(float, __builtin_amdgcn_update_dpp(__builtin_bit_cast(int, x), __builtin_bit_cast(int, x), CTRL, RM, 0xf, false)));
}
template <int CTRL, int RM> __device__ __forceinline__ float dpp_sum(float x) {
    return x + __builtin_bit_cast(float, __builtin_amdgcn_update_dpp(0, __builtin_bit_cast(int, x), CTRL, RM, 0xf, false));
}
__device__ __forceinline__ float wave_max_u(float x) {
    x = dpp_max<0xB1, 0xf>(x); x = dpp_max<0x4E, 0xf>(x); x = dpp_max<0x141, 0xf>(x); x = dpp_max<0x140, 0xf>(x);
    x = dpp_max<0x142, 0xa>(x); x = dpp_max<0x143, 0xc>(x);
    return __builtin_bit_cast(float, __builtin_amdgcn_readlane(__builtin_bit_cast(int, x), 63));
}
__device__ __forceinline__ float wave_sum_u(float x) {
    x = dpp_sum<0xB1, 0xf>(x); x = dpp_sum<0x4E, 0xf>(x); x = dpp_sum<0x141, 0xf>(x); x = dpp_sum<0x140, 0xf>(x);
    x = dpp_sum<0x142, 0xa>(x); x = dpp_sum<0x143, 0xc>(x);
    return __builtin_bit_cast(float, __builtin_amdgcn_readlane(__builtin_bit_cast(int, x), 63));
}
__device__ __forceinline__ float wave_sum(float v) { return wave_sum_u(v); }
__device__ __forceinline__ float bpermf(int srclane, float v) { return __builtin_bit_cast(float, __builtin_amdgcn_ds_bpermute(srclane << 2, __builtin_bit_cast(int, v))); }
__device__ __forceinline__ int bpermi(int srclane, int v) { return __builtin_amdgcn_ds_bpermute(srclane << 2, v); }

#define XB_TMO      128
#define XB_XCNT(j)  (256  + 64 * (j))
#define XB_XSUB(j)  (1280 + 64 * (j))
#define XB_XGEN(j)  (2304 + 64 * (j))
#define XB_TOP      3328
#define XB_TOPGEN   3392
#define XCD_BAR_WORDS 3456
#define XB_SPIN_CAP (1u << 20)

__device__ __forceinline__ unsigned xb_ld(unsigned* p)              { return __hip_atomic_load(p, __ATOMIC_RELAXED, __HIP_MEMORY_SCOPE_AGENT); }
__device__ __forceinline__ unsigned xb_add(unsigned* p, unsigned v) { return __hip_atomic_fetch_add(p, v, __ATOMIC_RELAXED, __HIP_MEMORY_SCOPE_AGENT); }
__device__ __forceinline__ unsigned xb_xcc_id() { return (unsigned)__builtin_amdgcn_s_getreg((3 << 11) | 20) & 0xFu; }
#define XB_SPIN(cond, bar) do { unsigned _sp = 0; while (cond) { __builtin_amdgcn_s_sleep(1); \
    if ((++_sp & 255u) == 0u) { if (xb_ld(&(bar)[XB_TMO])) break; if (_sp > XB_SPIN_CAP) { atomicAdd(&(bar)[XB_TMO], 1u); break; } } } } while (0)

struct XcdBarrier { unsigned* bar; unsigned x; volatile LAS unsigned* st; };

__device__ __forceinline__ XcdBarrier xcd_barrier_post(unsigned* bar, volatile LAS unsigned* st, bool t0) {
    XcdBarrier b; b.bar = bar; b.x = xb_xcc_id(); b.st = st;
    if (t0) (void)xb_add(&bar[XB_XCNT(b.x)], 1u);
    return b;
}
__device__ __forceinline__ void xcd_barrier_complete(unsigned* bar, unsigned x, unsigned& nloc, unsigned& nx) {
    const unsigned G = gridDim.x * gridDim.y * gridDim.z;
    unsigned sum, cnt, mine, sp = 0u;
    for (;;) {
        sum = 0u; cnt = 0u; mine = 0u;
#pragma unroll
        for (unsigned j = 0; j < 16; ++j) { const unsigned c = xb_ld(&bar[XB_XCNT(j)]); sum += c; cnt += (c > 0u) ? 1u : 0u; mine = (j == x) ? c : mine; }
        if (sum == G) break;
        __builtin_amdgcn_s_sleep(1);
        if ((++sp & 255u) == 0u) { if (xb_ld(&bar[XB_TMO])) break; if (sp > XB_SPIN_CAP) { atomicAdd(&bar[XB_TMO], 1u); break; } }
    }
    nloc = mine > 0u ? mine : 1u; nx = cnt > 0u ? cnt : 1u;
}
__device__ __forceinline__ void xcd_barrier(const XcdBarrier& b, bool t0) {
    asm volatile("s_waitcnt vmcnt(0)" ::: "memory");
    __syncthreads();
    if (t0) {
        unsigned* bar = b.bar;
        __builtin_amdgcn_s_waitcnt(0);
        unsigned nloc = b.st[0], nx = b.st[1];
        if (nloc == 0u) { xcd_barrier_complete(bar, b.x, nloc, nx); b.st[0] = nloc; b.st[1] = nx; }
        const unsigned old = xb_add(&bar[XB_XSUB(b.x)], 1u);
        const unsigned gen = old / nloc;
        if (old + 1u == (gen + 1u) * nloc) {
            __builtin_amdgcn_fence(__ATOMIC_RELEASE, "agent");
            asm volatile("s_waitcnt vmcnt(0)" ::: "memory");
            const unsigned og = xb_add(&bar[XB_TOP], 1u);
            const unsigned tg = og / nx;
            if (og + 1u == (tg + 1u) * nx) xb_add(&bar[XB_TOPGEN], 1u);
            else XB_SPIN(xb_ld(&bar[XB_TOPGEN]) == tg, bar);
            __builtin_amdgcn_fence(__ATOMIC_ACQUIRE, "agent");
            xb_add(&bar[XB_XGEN(b.x)], 1u);
            asm volatile("s_waitcnt vmcnt(0)" ::: "memory");
        } else {
            XB_SPIN(xb_ld(&bar[XB_XGEN(b.x)]) == gen, bar);
            __builtin_amdgcn_fence(__ATOMIC_ACQUIRE, "agent");
            asm volatile("s_waitcnt vmcnt(0)" ::: "memory");
        }
    }
    __syncthreads();
}

struct Frame {
    LAS unsigned char* lds;
    unsigned char* ws;
    const float* const* in;
    int tid, lane, wave;
    int vcu, G;
};
struct Args { const float* in[33]; float* out; unsigned char* ws; int ph_lo, ph_hi; };


namespace pg8 {
typedef unsigned u32x4 __attribute__((ext_vector_type(4)));
struct RowOrder : StaticOrder {
    int lat;
    __host__ __device__ void init_rows(int lat_, int N, int G_, int c_) { lat = lat_; init(lat_ ? NBATCH * SEQ : MALL, N, G_, c_); }
    __host__ __device__ bool next(int i, Unit& u) const { if (!StaticOrder::next(i, u)) return false; if (lat) u.pm = 33 * (u.pm >> 5) + 1 + (u.pm & 31); return true; }
};
#define EPI_LOOP_ROWS for (int ai = 0; ai < 2; ++ai) _Pragma("unroll") for (int m = 0; m < 4; ++m)
#define EPI_PIN asm volatile("" ::: "memory")

struct EpiStoreBf16 {
    static constexpr bool PERM = true, AFTER_DRAIN = false;
    bf16_t* O; int ldc;
    __device__ __forceinline__ void operator()(const f32x4 (&acc)[2][2][4][2], const Unit& u, int wr, int wc, int fr, int fq) const {
        const int row0 = u.pm * BM + wr * 64 + fr, col0 = u.pn * BM + wc * 32 + 8 * fq;
#pragma unroll
        EPI_LOOP_ROWS { bf16_t* rowp = O + (size_t)(row0 + ai * HALF + m * 16) * ldc + col0;
#pragma unroll
            for (int bj = 0; bj < 2; ++bj) { const f32x4 v0 = acc[ai][bj][m][0], v1 = acc[ai][bj][m][1];
                u32x4 w; w.x = cvt_pk_bf16(v0[0], v0[1]); w.y = cvt_pk_bf16(v0[2], v0[3]); w.z = cvt_pk_bf16(v1[0], v1[1]); w.w = cvt_pk_bf16(v1[2], v1[3]);
                *(u32x4*)(rowp + bj * HALF) = w; } }
    }
};
struct EpiGate {
    static constexpr bool PERM = true, AFTER_DRAIN = false;
    bf16_t* O; int ldc; const float* bias;
    __device__ __forceinline__ void operator()(const f32x4 (&acc)[2][2][4][2], const Unit& u, int wr, int wc, int fr, int fq) const {
        const int row0 = u.pm * BM + wr * 64 + fr, col0 = u.pn * BM + wc * 32 + 8 * fq;
        f32x4 bv[2][2];
#pragma unroll
        for (int bj = 0; bj < 2; ++bj)
#pragma unroll
            for (int n = 0; n < 2; ++n) bv[bj][n] = *(const f32x4*)(bias + col0 + bj * HALF + 4 * n);
#pragma unroll
        EPI_LOOP_ROWS { EPI_PIN; bf16_t* rowp = O + (size_t)(row0 + ai * HALF + m * 16) * ldc + col0;
#pragma unroll
            for (int bj = 0; bj < 2; ++bj) { f32x4 v0 = acc[ai][bj][m][0] + bv[bj][0], v1 = acc[ai][bj][m][1] + bv[bj][1];
#pragma unroll
                for (int e = 0; e < 4; ++e) { v0[e] = 1.0f / (1.0f + __expf(-v0[e])); v1[e] = 1.0f / (1.0f + __expf(-v1[e])); }
                u32x4 w; w.x = cvt_pk_bf16(v0[0], v0[1]); w.y = cvt_pk_bf16(v0[2], v0[3]); w.z = cvt_pk_bf16(v1[0], v1[1]); w.w = cvt_pk_bf16(v1[2], v1[3]);
                *(u32x4*)(rowp + bj * HALF) = w; } }
    }
};
__device__ __forceinline__ float bf_lo(unsigned w) { return __builtin_bit_cast(float, w << 16); }
__device__ __forceinline__ float bf_hi(unsigned w) { return __builtin_bit_cast(float, w & 0xffff0000u); }
struct EpiMulAdd {
    static constexpr bool PERM = true, AFTER_DRAIN = false;
    bf16_t* O; const bf16_t* Gt; const bf16_t* Ad; int ldc;
    __device__ __forceinline__ void operator()(const f32x4 (&acc)[2][2][4][2], const Unit& u, int wr, int wc, int fr, int fq) const {
        const int row0 = u.pm * BM + wr * 64 + fr, col0 = u.pn * BM + wc * 32 + 8 * fq;
#pragma unroll
        EPI_LOOP_ROWS { EPI_PIN; const size_t ro = (size_t)(row0 + ai * HALF + m * 16) * ldc + col0;
#pragma unroll
            for (int bj = 0; bj < 2; ++bj) { const f32x4 v0 = acc[ai][bj][m][0], v1 = acc[ai][bj][m][1];
                const u32x4 g = *(const u32x4*)(Gt + ro + bj * HALF);
                float o[8];
                o[0] = bf_lo(g.x) * v0[0]; o[1] = bf_hi(g.x) * v0[1]; o[2] = bf_lo(g.y) * v0[2]; o[3] = bf_hi(g.y) * v0[3];
                o[4] = bf_lo(g.z) * v1[0]; o[5] = bf_hi(g.z) * v1[1]; o[6] = bf_lo(g.w) * v1[2]; o[7] = bf_hi(g.w) * v1[3];
                if (Ad) { const u32x4 a = *(const u32x4*)(Ad + ro + bj * HALF);
                    o[0] += bf_lo(a.x); o[1] += bf_hi(a.x); o[2] += bf_lo(a.y); o[3] += bf_hi(a.y); o[4] += bf_lo(a.z); o[5] += bf_hi(a.z); o[6] += bf_lo(a.w); o[7] += bf_hi(a.w); }
                u32x4 w; w.x = cvt_pk_bf16(o[0], o[1]); w.y = cvt_pk_bf16(o[2], o[3]); w.z = cvt_pk_bf16(o[4], o[5]); w.w = cvt_pk_bf16(o[6], o[7]);
                *(u32x4*)(O + ro + bj * HALF) = w; } }
    }
};
struct EpiResid {
    static constexpr bool PERM = false, AFTER_DRAIN = false;
    float* X; const float* gate;
    __device__ __forceinline__ void operator()(const f32x4 (&acc)[2][2][4][2], const Unit& u, int wr, int wc, int fr, int fq) const {
        const int row0 = u.pm * BM + wr * 64 + fr, col0 = u.pn * BM + wc * 32 + 4 * fq;
        const int bb = u.pm / 33, mr = (u.pm - bb * 33 == 0) ? 2 : bb;
        const float* gp = gate + (size_t)mr * 12288 + col0;
        f32x4 gv[2][2];
#pragma unroll
        for (int bj = 0; bj < 2; ++bj)
#pragma unroll
            for (int n = 0; n < 2; ++n) gv[bj][n] = *(const f32x4*)(gp + bj * HALF + n * 16);
#pragma unroll
        EPI_LOOP_ROWS { EPI_PIN; float* rowp = X + (size_t)(row0 + ai * HALF + m * 16) * DM + col0;
#pragma unroll
            for (int bj = 0; bj < 2; ++bj)
#pragma unroll
                for (int n = 0; n < 2; ++n) { f32x4* p = (f32x4*)(rowp + bj * HALF + n * 16); *p = *p + gv[bj][n] * acc[ai][bj][m][n]; } }
    }
};
struct EpiF32 {
    static constexpr bool PERM = false, AFTER_DRAIN = false;
    float* C; int ldc;
    __device__ __forceinline__ void operator()(const f32x4 (&acc)[2][2][4][2], const Unit& u, int wr, int wc, int fr, int fq) const {
        const int row0 = u.pm * BM + wr * 64 + fr, col0 = u.pn * BM + wc * 32 + 4 * fq;
#pragma unroll
        EPI_LOOP_ROWS { float* rowp = C + (size_t)(row0 + ai * HALF + m * 16) * ldc + col0;
#pragma unroll
            for (int bj = 0; bj < 2; ++bj)
#pragma unroll
                for (int n = 0; n < 2; ++n) *(f32x4*)(rowp + bj * HALF + n * 16) = acc[ai][bj][m][n]; }
    }
};
struct EpiQ {
    static constexpr bool PERM = true, AFTER_DRAIN = false;
    bf16_t* Q; const f32x2* rope; float qscale;
    __device__ __forceinline__ void operator()(const f32x4 (&acc)[2][2][4][2], const Unit& u, int wr, int wc, int fr, int fq) const {
        const int bb = u.pm / 33, tp0 = (u.pm - bb * 33) * BM + wr * 64 + fr, col0 = u.pn * BM + wc * 32 + 8 * fq;
#pragma unroll
        for (int bj = 0; bj < 2; ++bj) { const int c = col0 + bj * HALF, hd = c / QKD, d = c - hd * QKD;
#pragma unroll
            EPI_LOOP_ROWS { EPI_PIN; const int tp = tp0 + ai * HALF + m * 16;
                f32x4 v0 = acc[ai][bj][m][0], v1 = acc[ai][bj][m][1];
                if (d >= 64) { const int i0 = (d - 64) >> 1; const f32x2* rp = rope + (size_t)tp * 16 + i0;
                    const f32x2 c0 = rp[0], c1 = rp[1], c2 = rp[2], c3 = rp[3];
                    float a, b;
                    a = v0[0]; b = v0[1]; v0[0] = a * c0.x - b * c0.y; v0[1] = a * c0.y + b * c0.x;
                    a = v0[2]; b = v0[3]; v0[2] = a * c1.x - b * c1.y; v0[3] = a * c1.y + b * c1.x;
                    a = v1[0]; b = v1[1]; v1[0] = a * c2.x - b * c2.y; v1[1] = a * c2.y + b * c2.x;
                    a = v1[2]; b = v1[3]; v1[2] = a * c3.x - b * c3.y; v1[3] = a * c3.y + b * c3.x; }
                v0 = v0 * qscale; v1 = v1 * qscale;
                u32x4 w; w.x = cvt_pk_bf16(v0[0], v0[1]); w.y = cvt_pk_bf16(v0[2], v0[3]); w.z = cvt_pk_bf16(v1[0], v1[1]); w.w = cvt_pk_bf16(v1[2], v1[3]);
                *(u32x4*)(Q + ((size_t)(bb * NH + hd) * TPB + tp) * QKD + d) = w; } }
    }
};
struct EpiKV {
    static constexpr bool PERM = true, AFTER_DRAIN = false;
    bf16_t* K; bf16_t* V;
    __device__ __forceinline__ void operator()(const f32x4 (&acc)[2][2][4][2], const Unit& u, int wr, int wc, int fr, int fq) const {
        const int bb = u.pm / 33, tp0 = (u.pm - bb * 33) * BM + wr * 64 + fr;
        const bool isK = wc < 2;
        bf16_t* base = isK ? K : V; const int pitch = isK ? QKD : 64, doff = 32 * (wc & 1) + 8 * fq;
#pragma unroll
        for (int bj = 0; bj < 2; ++bj) { const int hd = 2 * u.pn + bj;
            bf16_t* hb = base + (size_t)(bb * NH + hd) * TPB * pitch;
#pragma unroll
            EPI_LOOP_ROWS { EPI_PIN; const int tp = tp0 + ai * HALF + m * 16;
                const f32x4 v0 = acc[ai][bj][m][0], v1 = acc[ai][bj][m][1];
                u32x4 w; w.x = cvt_pk_bf16(v0[0], v0[1]); w.y = cvt_pk_bf16(v0[2], v0[3]); w.z = cvt_pk_bf16(v1[0], v1[1]); w.w = cvt_pk_bf16(v1[2], v1[3]);
                *(u32x4*)((char*)hb + (unsigned)((tp * pitch + doff) * 2)) = w; } }
    }
};
}

template <int MAPQ>
__device__ __forceinline__ void p0_transpose_item(const float* W, int K, int ldw, int c0, int N, bf16* WT, LAS float* scr, int item, int lane) {
    const int nblk = N / 32, kb = item / nblk, nb = item % nblk, k0 = 64 * kb, n0 = 32 * nb;
#pragma unroll 8
    for (int i = 0; i < 32; ++i) { const int kk = 2 * i + (lane >> 5); scr[kk * 33 + (lane & 31)] = W[(size_t)(k0 + kk) * ldw + c0 + n0 + (lane & 31)]; }
    LDS_WAIT(); asm volatile("" ::: "memory");
    const int c = lane & 7;
#pragma unroll
    for (int j = 0; j < 4; ++j) { const int n = (lane >> 3) + 8 * j; const LAS float* s = scr + (8 * c) * 33 + n;
        v4u o; o.x = pk2(s[0 * 33], s[1 * 33]); o.y = pk2(s[2 * 33], s[3 * 33]); o.z = pk2(s[4 * 33], s[5 * 33]); o.w = pk2(s[6 * 33], s[7 * 33]);
        int nn = n0 + n;
        if (MAPQ) { const int hd = nn / QKD, d = nn - hd * QKD; if (d >= 64) { const int i = (d - 64) & 15, s2 = (d - 64) >> 4; nn = hd * QKD + 64 + 2 * i + s2; } }
        *(GAS v4u*)(WT + (size_t)nn * K + k0 + 8 * c) = o; }
    LDS_WAIT(); asm volatile("" ::: "memory");
}

__device__ __forceinline__ const float* karg(int i);
__device__ __forceinline__ void p0_prologue(Frame& F) {
    LAS float* scr = (LAS float*)(F.lds + F.wave * 16384);
    const int gw = F.vcu * NWAVES + F.wave, NGW = F.G * NWAVES;
    unsigned char* ws = F.ws;
    for (int l = 0; l < NLAYER; ++l) {
        const float* w_in = karg(7) + (size_t)l * DM * INC; const float* wbra = karg(24); const float* wbrb = karg(25); const float* wout = karg(26); const float* wuq = karg(21); const float* wukv = karg(23); const float* wup = karg(11); const float* aup = karg(13);
        constexpr int I_INA = (DM / 64) * (INA / 32), I_G = (DM / 64) * (DM / 32), I_BR = (RW / 64) * (DM / 32), I_UQ = (512 / 64) * (NQ / 32), I_UKV = (256 / 64) * (NKV / 32), I_LR = 1 * (RW / 32);
        constexpr int NIT = I_INA + 2 * I_G + 2 * I_BR + I_G + I_UQ + I_UKV + 4 * I_LR;
        for (int it = gw; it < NIT; it += NGW) {
            int r = it;
            if (r < I_INA) { p0_transpose_item<0>(w_in, DM, INC, 0, INA, (bf16*)(ws + WS_WINA) + (size_t)l * INA_P * DM, scr, r, F.lane); continue; } r -= I_INA;
            if (r < I_G) { p0_transpose_item<0>(w_in, DM, INC, INA, DM, (bf16*)(ws + WS_WGA) + (size_t)l * DM * DM, scr, r, F.lane); continue; } r -= I_G;
            if (r < I_G) { p0_transpose_item<0>(w_in, DM, INC, INA + DM, DM, (bf16*)(ws + WS_WGB) + (size_t)l * DM * DM, scr, r, F.lane); continue; } r -= I_G;
            if (r < I_BR) { p0_transpose_item<0>(wbra + (size_t)l * RW * DM, RW, DM, 0, DM, (bf16*)(ws + WS_WA) + (size_t)l * DM * RW, scr, r, F.lane); continue; } r -= I_BR;
            if (r < I_BR) { p0_transpose_item<0>(wbrb + (size_t)l * RW * DM, RW, DM, 0, DM, (bf16*)(ws + WS_WB) + (size_t)l * DM * RW, scr, r, F.lane); continue; } r -= I_BR;
            if (r < I_G) { p0_transpose_item<0>(wout + (size_t)l * DM * DM, DM, DM, 0, DM, (bf16*)(ws + WS_WO) + (size_t)l * DM * DM, scr, r, F.lane); continue; } r -= I_G;
            if (r < I_UQ) { p0_transpose_item<1>(wuq + (size_t)l * 512 * NQ, 512, NQ, 0, NQ, (bf16*)(ws + WS_WUQ) + (size_t)l * NQ * 512, scr, r, F.lane); continue; } r -= I_UQ;
            if (r < I_UKV) { p0_transpose_item<0>(wukv + (size_t)l * 256 * NKV, 256, NKV, 0, NKV, (bf16*)(ws + WS_WUKV) + (size_t)l * NKV * 256, scr, r, F.lane); continue; } r -= I_UKV;
            { const int which = r / I_LR, d = which & 1, isa = which >> 1; r -= which * I_LR;
              const float* src = (isa ? aup : wup) + (size_t)(l * 2 + d) * 64 * RW;
              bf16* dst = (bf16*)(ws + (isa ? WS_AUP : WS_WUP)) + (size_t)(l * 2 + d) * RW * 64;
              p0_transpose_item<0>(src, 64, RW, 0, RW, dst, scr, r, F.lane); }
        }
    }
    const int gt = gw * 64 + F.lane, NGT = NGW * 64;
    { const float* gup = karg(14);
    for (int i = gt; i < NLAYER * 2 * 32 * RW; i += NGT) { const int ch = i & 1023, r = (i >> 10) & 31, ld = i >> 15;
        ((bf16*)(ws + WS_GUP))[((size_t)ld * RW + ch) * 32 + r] = (bf16)f2bf(gup[i]); } }
    for (int i = gt; i < NLAYER * (INA_P - INA) * DM / 8; i += NGT) { const int l = i / ((INA_P - INA) * DM / 8), r = i - l * ((INA_P - INA) * DM / 8);
        ((GAS v4u*)((bf16*)(ws + WS_WINA) + ((size_t)l * INA_P + INA) * DM))[r] = (v4u){0u, 0u, 0u, 0u}; }
    { const GAS f32x4* xs = (const GAS f32x4*)karg(0); const GAS f32x4* cs = (const GAS f32x4*)karg(2); GAS f32x4* X = (GAS f32x4*)(ws + WS_X);
      for (int i = gt; i < MALL * (DM / 4); i += NGT) { const int m = i >> 9, c4 = i & 511, b = m / TPB, tp = m - b * TPB;
          X[i] = (tp < CTXL) ? cs[((size_t)(b * CTXL + tp) << 9) + c4] : xs[((size_t)(b * SEQ + tp - CTXL) << 9) + c4]; } }
    { f32x2* rt = (f32x2*)(ws + WS_ROPE);
      for (int i = gt; i < TPB * 16; i += NGT) { const int tp = i >> 4, k = i & 15; f32x2 o = {1.f, 0.f};
          if (tp >= CTXL) { const int t = tp - CTXL, row = t >> 6, col = t & 63, j = k & 7; const float fr = powf(10000.0f, -(float)j / 8.0f);
              const float ang = (float)(k < 8 ? row : col) * fr; o.x = cosf(ang); o.y = sinf(ang); }
          rt[i] = o; } }
    { float* modw = (float*)(ws + WS_CTL + CTL_MOD_OFF); const float* adaw = karg(4); const float* adab = karg(5); const float* cin = karg(1); const float* cctx = karg(3);
      LAS f32x4* part = (LAS f32x4*)F.lds;
      for (int uu = F.vcu; uu < NLAYER * 48; uu += F.G) { const int cb = uu % 48, l = uu / 48;
          const int n0 = cb * 256 + F.lane * 4; const float* aw = adaw + (size_t)l * DM * 12288 + n0;
          f32x4 a0 = {0, 0, 0, 0}, a1 = a0, a2 = a0;
#pragma unroll 8
          for (int k = F.wave * 256; k < F.wave * 256 + 256; ++k) { const f32x4 w = *(const GAS f32x4*)(aw + (size_t)k * 12288);
              const float c0 = cin[k], c1 = cin[DM + k], c2 = cctx[k];
              const float s0 = c0 / (1.f + __expf(-c0)), s1 = c1 / (1.f + __expf(-c1)), s2 = c2 / (1.f + __expf(-c2));
              a0 = a0 + w * s0; a1 = a1 + w * s1; a2 = a2 + w * s2; }
          __syncthreads();
          part[(F.wave * 3 + 0) * 64 + F.lane] = a0; part[(F.wave * 3 + 1) * 64 + F.lane] = a1; part[(F.wave * 3 + 2) * 64 + F.lane] = a2;
          __syncthreads();
          if (F.wave < 3) { f32x4 s = *(const GAS f32x4*)(adab + (size_t)l * 12288 + n0);
#pragma unroll
              for (int w8 = 0; w8 < 8; ++w8) s = s + part[(w8 * 3 + F.wave) * 64 + F.lane];
              *(GAS f32x4*)(modw + ((size_t)l * 3 + F.wave) * 12288 + n0) = s; }
          __syncthreads(); } }
    { LAS float* KEY = (LAS float*)F.lds;
      LAS float* WQT = (LAS float*)(F.lds + 65536);
      const float* pkeys = karg(29); const float* pwq = karg(28);
      __syncthreads();
      for (int uu = F.vcu; uu < NLAYER * 16 * 32; uu += F.G) { const int kb = uu & 31, hp = (uu >> 5) & 15, l = uu >> 9;
          const GAS f32x4* ksrc = (const GAS f32x4*)(pkeys + ((size_t)l * 16 + hp) * 16384);
          for (int i = F.tid; i < 4096; i += 512) ((LAS f32x4*)KEY)[i] = ksrc[i];
          for (int i = F.tid; i < 2048; i += 512) { const int kk = i >> 5, d4 = i & 31;
              *(LAS f32x4*)(WQT + kk * 132 + d4 * 4) = *(const GAS f32x4*)(pwq + ((size_t)l * DM + kb * 64 + kk) * DM + hp * 128 + d4 * 4); }
          __syncthreads();
          const int kk = F.tid & 63, kg = F.tid >> 6;
          float acc[16];
#pragma unroll
          for (int j = 0; j < 16; ++j) acc[j] = 0.f;
          for (int d = 0; d < 128; d += 4) { const f32x4 w = *(LAS f32x4*)(WQT + kk * 132 + d);
#pragma unroll
              for (int j = 0; j < 16; ++j) { const f32x4 q = *(LAS f32x4*)(KEY + (kg * 16 + j) * 128 + d); acc[j] += q.x * w.x + q.y * w.y + q.z * w.z + q.w * w.w; } }
          bf16* dst = (bf16*)(ws + WS_WQK) + ((size_t)l * DM + hp * 128 + kg * 16) * DM + kb * 64 + kk;
#pragma unroll
          for (int j = 0; j < 16; ++j) dst[(size_t)j * DM] = (bf16)f2bf(acc[j]);
          __syncthreads(); } }
}

__device__ __forceinline__ void modnorm_phase(Frame& F, const float* X, const float* g, const float* mod  , int chunk_sh, bf16* H, int skip_ctx) {
    const int gw = F.vcu * NWAVES + F.wave, NGW = F.G * NWAVES;
    for (int m = gw; m < MALL; m += NGW) {
        const int b = m / TPB, tp = m - b * TPB; if (skip_ctx && tp < CTXL) continue;
        const int mr = tp < CTXL ? 2 : b;
        const GAS f32x4* xr = (const GAS f32x4*)(X + (size_t)m * DM) + F.lane;
        f32x4 v[8]; float s = 0.f;
#pragma unroll
        for (int j = 0; j < 8; ++j) { v[j] = xr[64 * j]; s += (v[j].x * v[j].x + v[j].y * v[j].y) + (v[j].z * v[j].z + v[j].w * v[j].w); }
        const float rs = rsqrtf(wave_sum(s) * (1.f / DM) + NORM_EPS);
        const float* sh = mod + (size_t)mr * 12288 + chunk_sh * DM; const float* sc = sh + DM;
        GAS v2u* o8 = (GAS v2u*)(H + (size_t)m * DM) + F.lane;
#pragma unroll
        for (int j = 0; j < 8; ++j) { const int c = (F.lane + 64 * j) * 4;
            const f32x4 gg = *(const GAS f32x4*)(g + c), s1 = *(const GAS f32x4*)(sc + c), s0 = *(const GAS f32x4*)(sh + c);
            f32x4 y = v[j] * rs * gg; y = y * (s1 + 1.0f) + s0;
            v2u o; o.x = pk2(y.x, y.y); o.y = pk2(y.z, y.w); o8[64 * j] = o; }
    }
}

typedef float f32x4v __attribute__((ext_vector_type(4)));
#define MFMA16(a, b, c) __builtin_amdgcn_mfma_f32_16x16x32_bf16((a), (b), (c), 0, 0, 0)
#define MFMA32(a, b, c) __builtin_amdgcn_mfma_f32_32x32x16_bf16((a), (b), (c), 0, 0, 0)

struct FeatP {
    const bf16* PA; const float* mu; const float* w0; const float* a0; const float* k_k; const float* k_a; const float* r_k;
    const bf16* WUP; const bf16* AUP; const bf16* GUP;
    const float* qnorm; const float* kvnorm; const f32x2* rope;
    bf16* RI; bf16* GG; float* BON; bf16* QN; bf16* KVN; bf16* K;
};
__device__ __forceinline__ f32x4 ld4bf(const bf16* p) { const v2u w = *(const GAS v2u*)p; return (f32x4){bflo(w.x), bfhi(w.x), bflo(w.y), bfhi(w.y)}; }
__device__ __forceinline__ f32x4 mix4(const bf16* PA, int m, int c, bool hp, bool hn, const float* mu) {
    const f32x4 pc = ld4bf(PA + (size_t)m * INA_P + c);
    f32x4 pp = {0, 0, 0, 0}, pn = {0, 0, 0, 0};
    if (hp) pp = ld4bf(PA + (size_t)(m - 1) * INA_P + c);
    if (hn) pn = ld4bf(PA + (size_t)(m + 1) * INA_P + c);
    const f32x4 mm = *(const GAS f32x4*)(mu + c);
    return pc + ((pp + pn) * 0.5f - pc) * mm;
}
__device__ __forceinline__ void features_phase(Frame& F, const FeatP& P) {
    constexpr int LAP = 328;
    LAS bf16* LA = (LAS bf16*)F.lds;
    const int lane = F.lane, w = F.wave;
    for (int uu = F.vcu; uu < MALL / 16; uu += F.G) {
        const int m0 = uu * 16;
        __syncthreads();
        { const int tk = F.tid >> 5, l32 = F.tid & 31, m = m0 + tk, tp = m % TPB;
          const bool hp = (tp != 0) && (tp != CTXL), hn = (tp != CTXL - 1) && (tp != TPB - 1);
          const bf16* row = P.PA + (size_t)m * INA_P;
#pragma unroll
          for (int i = 0; i < 10; ++i) { const int c = C_WD + l32 + 32 * i;
              const float pc = bf1(row[c]), pp = hp ? bf1(row[c - INA_P]) : 0.f, pn = hn ? bf1(row[c + INA_P]) : 0.f;
              float v = pc + (0.5f * (pp + pn) - pc) * P.mu[c];
              if (c < C_AD) v = tanhf(v); else if (c >= C_GD) v = sigmoidf_(v);
              LA[tk * LAP + (c - C_WD)] = (bf16)f2bf(v); } }
#pragma unroll
        for (int tt = 0; tt < 2; ++tt) { const int m = m0 + 2 * w + tt, b = m / TPB, tp = m - b * TPB; const bf16* row = P.PA + (size_t)m * INA_P;
            { const v4u q = *(const GAS v4u*)(row + C_QC + lane * 8);
              float x[8] = {bflo(q.x), bfhi(q.x), bflo(q.y), bfhi(q.y), bflo(q.z), bfhi(q.z), bflo(q.w), bfhi(q.w)}; float s = 0.f;
#pragma unroll
              for (int e = 0; e < 8; ++e) s += x[e] * x[e];
              const float rs = rsqrtf(wave_sum(s) * (1.f / 512.f) + NORM_EPS);
#pragma unroll
              for (int e = 0; e < 8; ++e) x[e] = x[e] * rs * P.qnorm[lane * 8 + e];
              v4u o; o.x = pk2(x[0], x[1]); o.y = pk2(x[2], x[3]); o.z = pk2(x[4], x[5]); o.w = pk2(x[6], x[7]);
              *(GAS v4u*)(P.QN + (size_t)m * 512 + lane * 8) = o; }
            { const v2u q = *(const GAS v2u*)(row + C_KVC + lane * 4);
              float x[4] = {bflo(q.x), bfhi(q.x), bflo(q.y), bfhi(q.y)}; float s = 0.f;
#pragma unroll
              for (int e = 0; e < 4; ++e) s += x[e] * x[e];
              const float rs = rsqrtf(wave_sum(s) * (1.f / 256.f) + NORM_EPS);
#pragma unroll
              for (int e = 0; e < 4; ++e) x[e] = x[e] * rs * P.kvnorm[lane * 4 + e];
              v2u o; o.x = pk2(x[0], x[1]); o.y = pk2(x[2], x[3]);
              *(GAS v2u*)(P.KVN + (size_t)m * 256 + lane * 4) = o; }
            if (lane < 16) { const float x1 = bf1(row[C_KR + lane]), x2 = bf1(row[C_KR + 16 + lane]); const f32x2 cs = P.rope[(size_t)tp * 16 + lane];
                const unsigned o = pk2(x1 * cs.x - x2 * cs.y, x1 * cs.y + x2 * cs.x);
#pragma unroll
                for (int hd = 0; hd < NH; ++hd) *(GAS unsigned*)(P.K + ((size_t)(b * NH + hd) * TPB + tp) * QKD + 64 + 2 * lane) = o; } }
        __syncthreads();
        const int tk = lane & 15, q4 = lane >> 4, m = m0 + tk, b = m / TPB, tp = m - b * TPB;
        const bool hp = (tp != 0) && (tp != CTXL), hn = (tp != CTXL - 1) && (tp != TPB - 1);
        bf16x8 bw[2][2], ba[2][2], bg[2];
#pragma unroll
        for (int d = 0; d < 2; ++d) {
#pragma unroll
            for (int ks = 0; ks < 2; ++ks) { bw[d][ks] = *(const LAS bf16x8*)(LA + tk * LAP + d * 64 + ks * 32 + q4 * 8); ba[d][ks] = *(const LAS bf16x8*)(LA + tk * LAP + 128 + d * 64 + ks * 32 + q4 * 8); }
            bg[d] = *(const LAS bf16x8*)(LA + tk * LAP + 256 + d * 32 + q4 * 8); }
#pragma unroll
        for (int hh = 0; hh < 2; ++hh) {
            float rsn;
            { float s = 0.f;
#pragma unroll 1
              for (int ct = 0; ct < 4; ++ct) { const int ch = 128 * w + 64 * hh + 16 * ct + 4 * q4; const f32x4 kx = mix4(P.PA, m, RW + ch, hp, hn, P.mu) * *(const GAS f32x4*)(P.k_k + ch);
                  s += kx.x * kx.x + kx.y * kx.y + kx.z * kx.z + kx.w * kx.w; }
              s += bpermf(lane ^ 16, s); s += bpermf(lane ^ 32, s); rsn = rsqrtf(s + 1e-12f); }
            float bon0 = 0.f, bon1 = 0.f;
            const int hd = 2 * w + hh;
#pragma unroll 1
            for (int c4 = 0; c4 < 4; ++c4) {
                const int cb = 128 * w + 64 * hh + 16 * c4, chA = cb + tk  , ch = cb + 4 * q4  ;
                f32x4 cw[2], ca[2], cg[2];
#pragma unroll
                for (int d = 0; d < 2; ++d) { cw[d] = (f32x4){0, 0, 0, 0}; ca[d] = cw[d]; cg[d] = cw[d];
#pragma unroll
                    for (int ks = 0; ks < 2; ++ks) {
                        const bf16x8 aw = *(const GAS bf16x8*)(P.WUP + ((size_t)d * RW + chA) * 64 + ks * 32 + q4 * 8);
                        const bf16x8 aa = *(const GAS bf16x8*)(P.AUP + ((size_t)d * RW + chA) * 64 + ks * 32 + q4 * 8);
                        cw[d] = MFMA16(aw, bw[d][ks], cw[d]); ca[d] = MFMA16(aa, ba[d][ks], ca[d]); }
                    const bf16x8 ag = *(const GAS bf16x8*)(P.GUP + ((size_t)d * RW + chA) * 32 + q4 * 8);
                    cg[d] = MFMA16(ag, bg[d], cg[d]); }
                const f32x4 r4 = mix4(P.PA, m, ch, hp, hn, P.mu), k4 = mix4(P.PA, m, RW + ch, hp, hn, P.mu), v4 = mix4(P.PA, m, 2 * RW + ch, hp, hn, P.mu);
                const f32x4 kk4 = k4 * *(const GAS f32x4*)(P.k_k + ch) * rsn;
                const f32x4 ka4 = *(const GAS f32x4*)(P.k_a + ch), rk4 = *(const GAS f32x4*)(P.r_k + ch);
                const int c64 = ch & 63;
                bf16* rec = P.RI + ((size_t)(b * NH + hd) * TPB + tp) * RREC + c64;
                { v2u o; o.x = pk2(r4.x, r4.y); o.y = pk2(r4.z, r4.w); *(GAS v2u*)(rec) = o;
                  o.x = pk2(kk4.x, kk4.y); o.y = pk2(kk4.z, kk4.w); *(GAS v2u*)(rec + 64) = o;
                  o.x = pk2(v4.x, v4.y); o.y = pk2(v4.z, v4.w); *(GAS v2u*)(rec + 128) = o; }
#pragma unroll
                for (int d = 0; d < 2; ++d) {
                    const f32x4 w0 = *(const GAS f32x4*)(P.w0 + d * RW + ch), a0 = *(const GAS f32x4*)(P.a0 + d * RW + ch);
                    f32x4 ld, aa, ke, bb; float bs = 0.f;
#pragma unroll
                    for (int e = 0; e < 4; ++e) { ld[e] = -0.60653066f * sigmoidf_(w0[e] + cw[d][e]); aa[e] = sigmoidf_(a0[e] + ca[d][e]);
                        ke[e] = k4[e] * (1.0f + (aa[e] - 1.0f) * ka4[e]); bb[e] = kk4[e] * aa[e]; bs += r4[e] * ke[e] * rk4[e]; }
                    if (d == 0) bon0 += bs; else bon1 += bs;
                    v2u o; o.x = pk2(ld.x, ld.y); o.y = pk2(ld.z, ld.w); *(GAS v2u*)(rec + (3 + 3 * d) * 64) = o;
                    o.x = pk2(bb.x, bb.y); o.y = pk2(bb.z, bb.w); *(GAS v2u*)(rec + (4 + 3 * d) * 64) = o;
                    o.x = pk2(ke.x, ke.y); o.y = pk2(ke.z, ke.w); *(GAS v2u*)(rec + (5 + 3 * d) * 64) = o;
                    o.x = pk2(cg[d].x, cg[d].y); o.y = pk2(cg[d].z, cg[d].w); *(GAS v2u*)(P.GG + ((size_t)d * MALL + m) * RW + ch) = o; }
            }
            bon0 += bpermf(lane ^ 16, bon0); bon0 += bpermf(lane ^ 32, bon0); bon1 += bpermf(lane ^ 16, bon1); bon1 += bpermf(lane ^ 32, bon1);
            if (q4 == 0) { P.BON[((size_t)0 * MALL + m) * 16 + hd] = bon0; P.BON[((size_t)1 * MALL + m) * 16 + hd] = bon1; }
        }
    }
}

constexpr int SCH = 32;
constexpr int SSTEP = 6 * 64;
__device__ __forceinline__ int scan_tp(int dir, int s) { return dir == 0 ? s : (s < CTXL ? (CTXL - 1 - s) : (TPB - 1 - (s - CTXL))); }
__device__ __forceinline__ void scan_load(v4u (&rg)[6], const bf16* RIh, int dir, int chunk, int htid) {
    const int tp = scan_tp(dir, chunk * SCH + (htid >> 3));
    const bf16* rec = RIh + (size_t)tp * RREC + (htid & 7) * 8;
#pragma unroll
    for (int i = 0; i < 3; ++i) rg[i] = *(const GAS v4u*)(rec + i * 64);
    rec += (3 + 3 * dir) * 64;
#pragma unroll
    for (int i = 0; i < 3; ++i) rg[3 + i] = *(const GAS v4u*)(rec + i * 64);
}
__device__ __forceinline__ void scan_store(const v4u (&rg)[6], LAS float* buf, int htid) {
    LAS float* d0 = buf + (htid >> 3) * SSTEP + (htid & 7) * 8;
#pragma unroll
    for (int i = 0; i < 6; ++i) { constexpr int SLOT[6] = {4, 0, 5, 2, 1, 3};
        const v4u wv = rg[i];
        f32x4 lo = {bflo(wv.x), bfhi(wv.x), bflo(wv.y), bfhi(wv.y)}, hi = {bflo(wv.z), bfhi(wv.z), bflo(wv.w), bfhi(wv.w)};
        if (i == 3) {
#pragma unroll
            for (int e = 0; e < 4; ++e) { lo[e] = __expf(lo[e]); hi[e] = __expf(hi[e]); } }
        LAS float* d = d0 + SLOT[i] * 64;
        *(LAS f32x4*)d = lo; *(LAS f32x4*)(d + 4) = hi; }
}
__device__ __forceinline__ void scan_phase(Frame& F, const bf16* RI, bf16* Y) {
    LAS float* bufs = (LAS float*)F.lds;
    constexpr int NCH = TPB / SCH;
    for (int uu = F.vcu; uu < NBATCH * NH * 2 * 4; uu += F.G) {
        const int rg = uu & 3, dir = (uu >> 2) & 1, hd = (uu >> 3) & 15, b = uu >> 7;
        const bf16* RIh = RI + (size_t)(b * NH + hd) * TPB * RREC;
        const int htid = F.tid - 256;
        v4u ra[6], rb[6];
        __syncthreads();
        if (F.wave >= 4) { scan_load(rb, RIh, dir, 0, htid); scan_load(ra, RIh, dir, 1, htid); scan_store(rb, bufs, htid); scan_load(rb, RIh, dir, 2, htid); }
        __syncthreads();
        const int j = F.lane & 15, rowl = F.lane >> 4, row = rg * 16 + (F.wave & 3) * 4 + rowl;
        f32x2 S01 = {0.f, 0.f}, S23 = {0.f, 0.f};
        bf16* yb = Y + ((size_t)dir * MALL + (size_t)b * TPB) * RW + hd * 64 + row;
        for (int c = 0; c < NCH; ++c) {
            LAS float* cur = bufs + (c & 1) * (SCH * SSTEP);
            if (F.wave >= 4) {
                if (c + 1 < NCH) {
                    if ((c & 1) == 0) { scan_store(ra, bufs + (SCH * SSTEP), htid); if (c + 3 < NCH) scan_load(ra, RIh, dir, c + 3, htid); }
                    else { scan_store(rb, bufs, htid); if (c + 3 < NCH) scan_load(rb, RIh, dir, c + 3, htid); } } }
            else {
#pragma unroll
                for (int h16 = 0; h16 < 2; ++h16) {
                    const LAS float* sp = cur + (h16 * 16) * SSTEP;
                    f32x4 kk = *(const LAS f32x4*)(sp + 4 * j), bb = *(const LAS f32x4*)(sp + 64 + 4 * j), ww = *(const LAS f32x4*)(sp + 128 + 4 * j),
                          ke = *(const LAS f32x4*)(sp + 192 + 4 * j), rr = *(const LAS f32x4*)(sp + 256 + 4 * j);
                    float vv = sp[320 + row], ykeep = 0.f, ypart = 0.f;
#pragma unroll
                    for (int st = 0; st < 16; ++st) {
                        f32x4 nkk = kk, nbb = bb, nww = ww, nke = ke, nrr = rr; float nvv = vv;
                        if (st + 1 < 16) { const LAS float* sn = sp + (st + 1) * SSTEP;
                            nkk = *(const LAS f32x4*)(sn + 4 * j); nbb = *(const LAS f32x4*)(sn + 64 + 4 * j); nww = *(const LAS f32x4*)(sn + 128 + 4 * j);
                            nke = *(const LAS f32x4*)(sn + 192 + 4 * j); nrr = *(const LAS f32x4*)(sn + 256 + 4 * j); nvv = sn[320 + row]; }
                        f32x2 t2 = S01 * kk.xy; t2 = S23 * kk.zw + t2;
                        const float p = t2.x + t2.y;
                        S01 = S01 * ww.xy + ke.xy * vv; S23 = S23 * ww.zw + ke.zw * vv;
                        const float sa = -red16(p);
                        S01 = bb.xy * sa + S01; S23 = bb.zw * sa + S23;
                        if (st > 0) { const float y = red16(ypart); ykeep = (j == st - 1) ? y : ykeep; }
                        f32x2 u2 = S01 * rr.xy; u2 = S23 * rr.zw + u2;
                        ypart = u2.x + u2.y;
                        kk = nkk; bb = nbb; ww = nww; ke = nke; rr = nrr; vv = nvv;
                        __builtin_amdgcn_sched_barrier(0);
                    }
                    { const float y = red16(ypart); ykeep = (j == 15) ? y : ykeep; }
                    const int tp = scan_tp(dir, c * SCH + h16 * 16 + j);
                    *(GAS bf16*)(yb + (size_t)tp * RW) = (bf16)f2bf(ykeep);
                }
            }
            __syncthreads();
        }
    }
}

constexpr int AKP = 208, AVP = 192;
constexpr int ATILE = 64 * AKP + 64 * AVP;
__device__ __forceinline__ bf16x8 pack8(const f32x16& x, int s) {
    v4u p; p.x = pk2(x[8 * s + 0], x[8 * s + 1]); p.y = pk2(x[8 * s + 2], x[8 * s + 3]); p.z = pk2(x[8 * s + 4], x[8 * s + 5]); p.w = pk2(x[8 * s + 6], x[8 * s + 7]);
    return __builtin_bit_cast(bf16x8, p);
}
__device__ __forceinline__ void attn_phase(Frame& F, const bf16* Q, const bf16* K, const bf16* V, bf16* YB, int with_ctx) {
    const int lane = F.lane, half = lane >> 5, l31 = lane & 31, l16 = lane & 15, g1 = (lane >> 4) & 1;
    const int nunits = NBATCH * NH * 32 + (with_ctx ? NBATCH * NH : 0);
    for (int uu = F.vcu; uu < nunits; uu += F.G) {
        int bh, q0, nkt;
        if (uu < NBATCH * NH * 32) { bh = uu >> 5; q0 = CTXL + (uu & 31) * 256; nkt = TPB / 64; } else { bh = uu - NBATCH * NH * 32; q0 = 0; nkt = CTXL / 64; }
        const bf16* Kh = K + (size_t)bh * TPB * QKD; const bf16* Vh = V + (size_t)bh * TPB * 64; const bf16* Qh = Q + (size_t)bh * TPB * QKD;
        const int tq = q0 + F.wave * 32 + l31;
        bf16x8 qf[6];
#pragma unroll
        for (int ks = 0; ks < 6; ++ks) qf[ks] = *(const GAS bf16x8*)(Qh + (size_t)tq * QKD + 16 * ks + 8 * half);
        f32x16 o0, o1;
#pragma unroll
        for (int i = 0; i < 16; ++i) { o0[i] = 0.f; o1[i] = 0.f; }
        float m_run = -1e30f, l_run = 0.f;
        const int kc1 = F.tid + 512; const bool k1ok = kc1 < 768;
        const unsigned kd0 = (unsigned)((F.tid / 12) * AKP + (F.tid % 12) * 16), kd1 = (unsigned)((kc1 / 12) * AKP + (kc1 % 12) * 16), vd = (unsigned)(64 * AKP + (F.tid >> 3) * AVP + (F.tid & 7) * 16);
        v4u kr0, kr1 = {0, 0, 0, 0}, vr;
        kr0 = *(const GAS v4u*)(Kh + (size_t)F.tid * 8); if (k1ok) kr1 = *(const GAS v4u*)(Kh + (size_t)kc1 * 8); vr = *(const GAS v4u*)(Vh + (size_t)F.tid * 8);
        __syncthreads();
        *(LAS v4u*)(F.lds + kd0) = kr0; if (k1ok) *(LAS v4u*)(F.lds + kd1) = kr1; *(LAS v4u*)(F.lds + vd) = vr;
        __syncthreads();
        for (int kt = 0; kt < nkt; ++kt) {
            const bool more = kt + 1 < nkt;
            if (more) { const bf16* kn = Kh + (size_t)(kt + 1) * 64 * QKD; const bf16* vn = Vh + (size_t)(kt + 1) * 64 * 64;
                kr0 = *(const GAS v4u*)(kn + (size_t)F.tid * 8); if (k1ok) kr1 = *(const GAS v4u*)(kn + (size_t)kc1 * 8); vr = *(const GAS v4u*)(vn + (size_t)F.tid * 8); }
            LAS unsigned char* Kb = F.lds + (kt & 1) * ATILE; LAS unsigned char* Vb = Kb + 64 * AKP;
            f32x16 s0, s1;
#pragma unroll
            for (int i = 0; i < 16; ++i) { s0[i] = 0.f; s1[i] = 0.f; }
#pragma unroll
            for (int ks = 0; ks < 6; ++ks) {
                const bf16x8 a0 = *(const LAS bf16x8*)(Kb + l31 * AKP + (16 * ks + 8 * half) * 2), a1 = *(const LAS bf16x8*)(Kb + (32 + l31) * AKP + (16 * ks + 8 * half) * 2);
                s0 = MFMA32(a0, qf[ks], s0); s1 = MFMA32(a1, qf[ks], s1); }
            float mx = s0[0];
#pragma unroll
            for (int i = 1; i < 16; ++i) mx = fmaxf(mx, s0[i]);
#pragma unroll
            for (int i = 0; i < 16; ++i) mx = fmaxf(mx, s1[i]);
            mx = fmaxf(mx, bpermf(lane ^ 32, mx));
            const float m_new = fmaxf(m_run, mx), alpha = __builtin_amdgcn_exp2f(m_run - m_new); m_run = m_new;
            float ps = 0.f;
#pragma unroll
            for (int i = 0; i < 16; ++i) { s0[i] = __builtin_amdgcn_exp2f(s0[i] - m_new); s1[i] = __builtin_amdgcn_exp2f(s1[i] - m_new); ps += s0[i] + s1[i]; }
            l_run = l_run * alpha + ps;
#pragma unroll
            for (int i = 0; i < 16; ++i) { o0[i] *= alpha; o1[i] *= alpha; }
#pragma unroll
            for (int t = 0; t < 2; ++t)
#pragma unroll
                for (int s = 0; s < 2; ++s) {
                    const bf16x8 pf = pack8(t == 0 ? s0 : s1, s);
                    const int kb = 32 * t + 16 * s + 4 * half + (l16 >> 2);
#pragma unroll
                    for (int dvt = 0; dvt < 2; ++dvt) {
                        const LAS unsigned char* vp = Vb + kb * AVP + (32 * dvt + 16 * g1 + 4 * (l16 & 3)) * 2;
                        const s16x4 lo = __builtin_amdgcn_ds_read_tr16_b64_v4i16((LAS s16x4*)vp), hi = __builtin_amdgcn_ds_read_tr16_b64_v4i16((LAS s16x4*)(vp + 8 * AVP));
                        const bf16x8 va = __builtin_shufflevector(lo, hi, 0, 1, 2, 3, 4, 5, 6, 7);
                        if (dvt == 0) o0 = MFMA32(va, pf, o0); else o1 = MFMA32(va, pf, o1); } }
            if (more) { LAS unsigned char* nb = F.lds + ((kt + 1) & 1) * ATILE;
                *(LAS v4u*)(nb + kd0) = kr0; if (k1ok) *(LAS v4u*)(nb + kd1) = kr1; *(LAS v4u*)(nb + vd) = vr; }
            __syncthreads();
        }
        const float linv = (DBG_SKIP & 4) ? 0.f : 1.0f / (l_run + bpermf(lane ^ 32, l_run));
        const int b = bh >> 4, hd = bh & 15;
        bf16* op = YB + ((size_t)b * TPB + tq) * RW + hd * 64 + 4 * half;
#pragma unroll
        for (int g = 0; g < 4; ++g) {
            v2u w; w.x = pk2(o0[4 * g] * linv, o0[4 * g + 1] * linv); w.y = pk2(o0[4 * g + 2] * linv, o0[4 * g + 3] * linv); *(GAS v2u*)(op + 8 * g) = w;
            w.x = pk2(o1[4 * g] * linv, o1[4 * g + 1] * linv); w.y = pk2(o1[4 * g + 2] * linv, o1[4 * g + 3] * linv); *(GAS v2u*)(op + 32 + 8 * g) = w; }
    }
}

__device__ __forceinline__ void readout_phase(Frame& F, const bf16* Y, const bf16* GG, const float* BON, const bf16* RI, const float* ln_w, const float* ln_b, bf16* YA) {
    const int gw = F.vcu * NWAVES + F.wave, NGW = F.G * NWAVES, lane = F.lane, hd = lane >> 2, ch0 = hd * 64 + (lane & 3) * 16;
    for (int m = gw; m < MALL; m += NGW) {
        const int b = m / TPB, tp = m - b * TPB;
        const bf16* rec = RI + ((size_t)(b * NH + hd) * TPB + tp) * RREC + 128 + (lane & 3) * 16;
        float vv[16], out[16];
        { const v4u a = *(const GAS v4u*)rec, c = *(const GAS v4u*)(rec + 8);
          vv[0] = bflo(a.x); vv[1] = bfhi(a.x); vv[2] = bflo(a.y); vv[3] = bfhi(a.y); vv[4] = bflo(a.z); vv[5] = bfhi(a.z); vv[6] = bflo(a.w); vv[7] = bfhi(a.w);
          vv[8] = bflo(c.x); vv[9] = bfhi(c.x); vv[10] = bflo(c.y); vv[11] = bfhi(c.y); vv[12] = bflo(c.z); vv[13] = bfhi(c.z); vv[14] = bflo(c.w); vv[15] = bfhi(c.w); }
#pragma unroll
        for (int e = 0; e < 16; ++e) out[e] = 0.f;
#pragma unroll
        for (int d = 0; d < 2; ++d) {
            const bf16* yp = Y + ((size_t)d * MALL + m) * RW + ch0; const bf16* gp = GG + ((size_t)d * MALL + m) * RW + ch0;
            float y[16], g[16];
            { const v4u a = *(const GAS v4u*)yp, c = *(const GAS v4u*)(yp + 8);
              y[0] = bflo(a.x); y[1] = bfhi(a.x); y[2] = bflo(a.y); y[3] = bfhi(a.y); y[4] = bflo(a.z); y[5] = bfhi(a.z); y[6] = bflo(a.w); y[7] = bfhi(a.w);
              y[8] = bflo(c.x); y[9] = bfhi(c.x); y[10] = bflo(c.y); y[11] = bfhi(c.y); y[12] = bflo(c.z); y[13] = bfhi(c.z); y[14] = bflo(c.w); y[15] = bfhi(c.w); }
            { const v4u a = *(const GAS v4u*)gp, c = *(const GAS v4u*)(gp + 8);
              g[0] = bflo(a.x); g[1] = bfhi(a.x); g[2] = bflo(a.y); g[3] = bfhi(a.y); g[4] = bflo(a.z); g[5] = bfhi(a.z); g[6] = bflo(a.w); g[7] = bfhi(a.w);
              g[8] = bflo(c.x); g[9] = bfhi(c.x); g[10] = bflo(c.y); g[11] = bfhi(c.y); g[12] = bflo(c.z); g[13] = bfhi(c.z); g[14] = bflo(c.w); g[15] = bfhi(c.w); }
            float s = 0.f;
#pragma unroll
            for (int e = 0; e < 16; ++e) s += y[e];
            s = dpp_add<0xB1>(s); s = dpp_add<0x4E>(s);
            const float mean = s * (1.f / 64.f); float q = 0.f;
#pragma unroll
            for (int e = 0; e < 16; ++e) { y[e] -= mean; q += y[e] * y[e]; }
            q = dpp_add<0xB1>(q); q = dpp_add<0x4E>(q);
            const float rstd = rsqrtf(q * (1.f / 64.f) + 64e-5f), bon = BON[((size_t)d * MALL + m) * 16 + hd];
#pragma unroll
            for (int e = 0; e < 16; ++e) out[e] += (y[e] * rstd * ln_w[ch0 + e] + ln_b[ch0 + e] + bon * vv[e]) * g[e];
        }
        if (DBG_SKIP & 2) {
#pragma unroll
            for (int e = 0; e < 16; ++e) out[e] = 0.f; }
        v4u o0, o1;
        o0.x = pk2(out[0], out[1]); o0.y = pk2(out[2], out[3]); o0.z = pk2(out[4], out[5]); o0.w = pk2(out[6], out[7]);
        o1.x = pk2(out[8], out[9]); o1.y = pk2(out[10], out[11]); o1.z = pk2(out[12], out[13]); o1.w = pk2(out[14], out[15]);
        *(GAS v4u*)(YA + (size_t)m * RW + ch0) = o0; *(GAS v4u*)(YA + (size_t)m * RW + ch0 + 8) = o1;
    }
}

__device__ __forceinline__ int first_lane(unsigned long long mask) { return __builtin_ctzll(mask); }
__device__ __forceinline__ void top16_of_128(float a, float b, int lane, float& wv, int& wi) {
    wv = 0.f; wi = 0;
    for (int it = 0; it < 16; ++it) {
        const float m = wave_max_u(fmaxf(a, b));
        const bool ha = (a == m), hb = (b == m);
        const unsigned long long bal = __ballot(ha || hb);
        const int wl = first_lane(bal);
        const int myi = ha ? lane : lane + 64;
        const int idx = __builtin_amdgcn_readlane(myi, wl);
        if (lane == wl) { if (ha) a = -3.0e38f; else b = -3.0e38f; }
        if (lane == it) { wv = m; wi = idx; }
    }
}
struct PeerP { const float* SC; const bf16* H; const unsigned char* PU; const unsigned char* PV; const float* SU; const float* SV; float* X; const float* mod;   const float* fin_g; float* out; int last; };
__device__ __forceinline__ void peer_phase(Frame& F, const PeerP& P) {
    const int gw = F.vcu * NWAVES + F.wave, NGW = F.G * NWAVES, lane = F.lane;
    float pr_s2 = 0.f, pr_d2 = 0.f, pr_tg = 0.f, pr_n = 0.f;
    for (int m = gw; m < MALL; m += NGW) {
        const int b = m / TPB, tp = m - b * TPB; if (P.last && tp < CTXL) continue;
        const int mr = tp < CTXL ? 2 : b;
        int eidx[2] = {0, 0}; float egate[2] = {0.f, 0.f};
        const float* srow = P.SC + (size_t)m * DM;
        if (DBG_PROBE) { float s2 = 0.f; for (int i = lane; i < DM; i += 64) s2 += srow[i] * srow[i]; pr_s2 += wave_sum_u(s2) * (1.f / DM); pr_n += 1.f; }
#pragma unroll 1
        for (int hd = 0; hd < 8; ++hd) {
            float w1v, w2v; int w1i, w2i;
            top16_of_128(srow[hd * 256 + lane], srow[hd * 256 + 64 + lane], lane, w1v, w1i);
            top16_of_128(srow[hd * 256 + 128 + lane], srow[hd * 256 + 192 + lane], lane, w2v, w2i);
            const float v1 = bpermf(lane & 15, w1v); const int i1 = bpermi(lane & 15, w1i);
            float cs[4]; int ci[4];
#pragma unroll
            for (int e = 0; e < 4; ++e) { const int j = 4 * (lane >> 4) + e; cs[e] = v1 + bpermf(j, w2v); ci[e] = i1 * 128 + bpermi(j, w2i); }
            float tv = 0.f, tsum = 0.f, m0 = 0.f; int ti = 0;
            for (int it = 0; it < 16; ++it) {
                const float mm = wave_max_u(fmaxf(fmaxf(cs[0], cs[1]), fmaxf(cs[2], cs[3])));
                const int sl = (cs[0] == mm) ? 0 : (cs[1] == mm) ? 1 : (cs[2] == mm) ? 2 : (cs[3] == mm) ? 3 : 4;
                const unsigned long long bal = __ballot(sl < 4);
                const int wl = first_lane(bal);
                const int myi = (sl == 0) ? ci[0] : (sl == 1) ? ci[1] : (sl == 2) ? ci[2] : ci[3];
                const int idx = __builtin_amdgcn_readlane(myi, wl);
                if (lane == wl) { if (sl == 0) cs[0] = -3.0e38f; else if (sl == 1) cs[1] = -3.0e38f; else if (sl == 2) cs[2] = -3.0e38f; else cs[3] = -3.0e38f; }
                if (it == 0) m0 = mm;
                const float ev = __expf(mm - m0); tsum += ev;
                if (lane == it) { tv = ev; ti = idx; }
            }
            const float gt = tv / tsum;
            if (DBG_PROBE) pr_tg += 1.0f / tsum * 0.125f;
            const int src = lane & 15;
            const float gsh = bpermf(src, gt); const int ish = bpermi(src, ti);
            if ((lane >> 4) == (hd & 3)) { if (hd < 4) { egate[0] = gsh; eidx[0] = ish; } else { egate[1] = gsh; eidx[1] = ish; } }
        }
        f32x2 hf[16];
#pragma unroll
        for (int j = 0; j < 2; ++j) { const v4u a = *(const GAS v4u*)(P.H + (size_t)m * DM + j * 1024 + lane * 16), c = *(const GAS v4u*)(P.H + (size_t)m * DM + j * 1024 + lane * 16 + 8);
            hf[8 * j + 0] = (f32x2){bflo(a.x), bfhi(a.x)}; hf[8 * j + 1] = (f32x2){bflo(a.y), bfhi(a.y)}; hf[8 * j + 2] = (f32x2){bflo(a.z), bfhi(a.z)}; hf[8 * j + 3] = (f32x2){bflo(a.w), bfhi(a.w)};
            hf[8 * j + 4] = (f32x2){bflo(c.x), bfhi(c.x)}; hf[8 * j + 5] = (f32x2){bflo(c.y), bfhi(c.y)}; hf[8 * j + 6] = (f32x2){bflo(c.z), bfhi(c.z)}; hf[8 * j + 7] = (f32x2){bflo(c.w), bfhi(c.w)}; }
        float coef[2];
#pragma unroll
        for (int sl = 0; sl < 2; ++sl) {
            float mydot = 0.f;
#pragma unroll 1
            for (int e0 = 0; e0 < 64; e0 += 8) {
                v4u u[8][2]; float rsc[8];
#pragma unroll
                for (int q = 0; q < 8; ++q) { const int ex = __builtin_amdgcn_readlane(eidx[sl], e0 + q); const unsigned char* ur = P.PU + (size_t)ex * DM + lane * 16;
                    u[q][0] = *(const GAS v4u*)ur; u[q][1] = *(const GAS v4u*)(ur + 1024); rsc[q] = P.SU[ex]; }
#pragma unroll
                for (int q = 0; q < 8; ++q) { f32x2 s2 = {0.f, 0.f};
#pragma unroll
                    for (int j = 0; j < 2; ++j)
#pragma unroll
                        for (int d = 0; d < 4; ++d) { const int w = (int)u[q][j][d];
                            s2 = __builtin_amdgcn_cvt_pk_f32_fp8(w, false) * hf[8 * j + 2 * d] + s2; s2 = __builtin_amdgcn_cvt_pk_f32_fp8(w, true) * hf[8 * j + 2 * d + 1] + s2; }
                    const float tot = wave_sum_u(s2.x + s2.y) * rsc[q];
                    if (lane == e0 + q) mydot = tot; }
            }
            if (DBG_PROBE) pr_d2 += wave_sum_u(mydot * mydot) * (1.f / 128.f);
            coef[sl] = egate[sl] * 0.5f * mydot * (1.0f + erff(mydot * 0.70710678f));
            if ((DBG_SKIP & 16) && sl == 0) coef[sl] = 0.f;
            if ((DBG_SKIP & 32) && sl == 1) coef[sl] = 0.f;
        }
        f32x2 acc2[16];
#pragma unroll
        for (int i = 0; i < 16; ++i) acc2[i] = (f32x2){0.f, 0.f};
#pragma unroll
        for (int sl = 0; sl < 2; ++sl) {
#pragma unroll 1
            for (int e0 = 0; e0 < 64; e0 += 8) {
                v4u u[8][2]; float cf[8];
#pragma unroll
                for (int q = 0; q < 8; ++q) { const int ex = __builtin_amdgcn_readlane(eidx[sl], e0 + q); const unsigned char* vr = P.PV + (size_t)ex * DM + lane * 16;
                    u[q][0] = *(const GAS v4u*)vr; u[q][1] = *(const GAS v4u*)(vr + 1024);
                    cf[q] = __builtin_bit_cast(float, __builtin_amdgcn_readlane(__builtin_bit_cast(int, coef[sl]), e0 + q)) * P.SV[ex]; }
#pragma unroll
                for (int q = 0; q < 8; ++q)
#pragma unroll
                    for (int j = 0; j < 2; ++j)
#pragma unroll
                        for (int d = 0; d < 4; ++d) { const int w = (int)u[q][j][d];
                            acc2[8 * j + 2 * d] = __builtin_amdgcn_cvt_pk_f32_fp8(w, false) * cf[q] + acc2[8 * j + 2 * d];
                            acc2[8 * j + 2 * d + 1] = __builtin_amdgcn_cvt_pk_f32_fp8(w, true) * cf[q] + acc2[8 * j + 2 * d + 1]; }
            }
        }
        float acc[32];
#pragma unroll
        for (int i = 0; i < 16; ++i) { acc[2 * i] = acc2[i].x; acc[2 * i + 1] = acc2[i].y; }
        if (DBG_SKIP & 1) {
#pragma unroll
            for (int i = 0; i < 32; ++i) acc[i] = 0.f; }
        if (((DBG_SKIP & 64) && !P.last) || ((DBG_SKIP & 128) && P.last)) {
#pragma unroll
            for (int i = 0; i < 32; ++i) acc[i] = 0.f; }
        if (DBG_SKIP & 8) {
#pragma unroll
            for (int i = 0; i < 32; ++i) acc[i] = -acc[i]; }
        float* xr = P.X + (size_t)m * DM; const float* g2 = P.mod + (size_t)mr * 12288 + 5 * DM;
        float ss = 0.f;
#pragma unroll
        for (int j = 0; j < 2; ++j)
#pragma unroll
            for (int hq = 0; hq < 4; ++hq) { const int c = j * 1024 + lane * 16 + hq * 4;
                f32x4 xv = *(const GAS f32x4*)(xr + c); const f32x4 gv = *(const GAS f32x4*)(g2 + c);
#pragma unroll
                for (int e = 0; e < 4; ++e) { xv[e] += gv[e] * acc[16 * j + 4 * hq + e]; ss += xv[e] * xv[e]; acc[16 * j + 4 * hq + e] = xv[e]; }
                if (!P.last) *(GAS f32x4*)(xr + c) = xv; }
        if (P.last) { const float rs = rsqrtf(wave_sum(ss) * (1.f / DM) + NORM_EPS); float* orow = P.out + ((size_t)b * SEQ + (tp - CTXL)) * DM;
#pragma unroll
            for (int j = 0; j < 2; ++j)
#pragma unroll
                for (int hq = 0; hq < 4; ++hq) { const int c = j * 1024 + lane * 16 + hq * 4; const f32x4 fg = *(const GAS f32x4*)(P.fin_g + c);
                    f32x4 o;
#pragma unroll
                    for (int e = 0; e < 4; ++e) o[e] = acc[16 * j + 4 * hq + e] * rs * fg[e];
                    *(GAS f32x4*)(orow + c) = o; } }
    }
    if (DBG_PROBE && !P.last && lane == 0) { float* pp = (float*)(F.ws + WS_CTL + CTL_PROBE_OFF) + gw * 4; pp[0] = pr_s2; pp[1] = pr_d2; pp[2] = pr_tg; pp[3] = pr_n; }
}
__device__ __forceinline__ void cvt_tables(Frame& F, const float* pu, const float* pv, unsigned char* PU8, unsigned char* PV8, float* SU, float* SV) {
    const int gw = F.vcu * NWAVES + F.wave, NGW = F.G * NWAVES, lane = F.lane;
    for (int r = gw; r < 2 * NEXP; r += NGW) { const bool sec = r >= NEXP; const int row = sec ? r - NEXP : r;
        const float* src = (sec ? pv : pu) + (size_t)row * DM + lane * 16;
        f32x4 x[2][4]; float am = 0.f;
#pragma unroll
        for (int j = 0; j < 2; ++j)
#pragma unroll
            for (int q = 0; q < 4; ++q) { x[j][q] = *(const GAS f32x4*)(src + j * 1024 + q * 4);
                am = fmaxf(am, fmaxf(fmaxf(fabsf(x[j][q].x), fabsf(x[j][q].y)), fmaxf(fabsf(x[j][q].z), fabsf(x[j][q].w)))); }
        am = wave_max_u(am);
        int ex = 0; (void)frexpf(fmaxf(am, 1e-30f), &ex);
        const float sc = ldexpf(1.0f, 8 - ex), inv = ldexpf(1.0f, ex - 8);
        unsigned char* dst = (sec ? PV8 : PU8) + (size_t)row * DM + lane * 16;
#pragma unroll
        for (int j = 0; j < 2; ++j) { v4u o;
#pragma unroll
            for (int q = 0; q < 4; ++q) { int w = 0;
                w = __builtin_amdgcn_cvt_pk_fp8_f32(x[j][q].x * sc, x[j][q].y * sc, w, false);
                w = __builtin_amdgcn_cvt_pk_fp8_f32(x[j][q].z * sc, x[j][q].w * sc, w, true);
                o[q] = (unsigned)w; }
            *(GAS v4u*)(dst + j * 1024) = o; }
        if (lane == 0) (sec ? SV : SU)[row] = inv;
    }
}

constexpr int PH_PER_LAYER = 11, NPHASE = 1 + NLAYER * PH_PER_LAYER;
#ifndef ONLY_PHASE
#define ONLY_PHASE -1
#endif
#define T0() (wave_s == 0 && pg8::opaque_lane() == 0)
#define PH_ON(k) (ONLY_PHASE < 0 || ONLY_PHASE == (k))
#define GEMM_CALL(EPI, SCHED, g, S, E) pg8::gemm_phase<EPI, SCHED, true, true>(F.lds, g, S, E, wave_s)
#define GEMM_CALL_NA(EPI, SCHED, g, S, E) pg8::gemm_phase<EPI, SCHED, false, true>(F.lds, g, S, E, wave_s)

__device__ __forceinline__ const float* karg(int i) {
    asm volatile("" : "+s"(i));
    const __attribute__((address_space(4))) unsigned long long* ka = (const __attribute__((address_space(4))) unsigned long long*)__builtin_amdgcn_kernarg_segment_ptr();
    return (const float*)ka[i];
}
__global__ void __launch_bounds__(NWAVES * 64, 2) mk_fwd(Args args) {
    extern __shared__ __attribute__((aligned(16))) unsigned char lds[];
    Frame F;
    F.lds = (LAS unsigned char*)lds; F.ws = args.ws;
    const int wave_s = __builtin_amdgcn_readfirstlane((int)threadIdx.x >> 6);
    F.tid = threadIdx.x; F.lane = F.tid & 63; F.wave = wave_s;
    F.G = gridDim.x; { const int bx = blockIdx.x; F.vcu = (F.G % 8 == 0) ? (bx % 8) * (F.G / 8) + bx / 8 : bx; }
    unsigned char* ws = args.ws;
    volatile LAS unsigned* MISC = (volatile LAS unsigned*)(F.lds + MISC_OFF);
    for (int u = F.tid; u < (LDS_BYTES - LDSCTL_OFF) / 4; u += NWAVES * 64) ((LAS unsigned*)(F.lds + LDSCTL_OFF))[u] = 0u;
    __syncthreads();
    const int lo = args.ph_lo, hi = args.ph_hi;
    XcdBarrier bar; bar.bar = (unsigned*)(ws + WS_CTL) + CW_BAR; bar.x = 0; bar.st = nullptr;
    if (hi - lo > 1) bar = xcd_barrier_post((unsigned*)(ws + WS_CTL) + CW_BAR, MISC + 8, T0());
#define IN(k) (lo <= (k) && (k) < hi)
#define REFRAME() do { const int lz_ = pg8::opaque_lane(); F.lane = lz_; F.tid = wave_s * 64 + lz_; F.wave = wave_s; ws = (unsigned char*)karg(34); F.ws = ws; { int g_ = (int)gridDim.x, b_ = (int)blockIdx.x; asm volatile("" : "+s"(g_), "+s"(b_)); bx = b_; F.G = g_; F.vcu = ((g_ & 7) == 0) ? (b_ & 7) * (g_ >> 3) + (b_ >> 3) : b_; } } while (0)
#define SEAM(k) do { if (IN((k) + 1)) xcd_barrier(bar, T0()); } while (0)
#define XBUF ((float*)(ws + WS_X))
#define HBUF ((bf16*)(ws + WS_H))
#define MODP ((const float*)(ws + WS_CTL + CTL_MOD_OFF) + (size_t)l * 3 * 12288)
    int bx = (int)blockIdx.x;

    if (PH_ON(100) && IN(0)) { REFRAME(); p0_prologue(F); SEAM(0); }

    for (int l = 0; l < NLAYER; ++l) {
        const int base = 1 + l * PH_PER_LAYER;
        const int last = (l == NLAYER - 1);
        for (int rep_ = 0; rep_ < ((DBG_REPEAT == 0) ? 2 : 1); ++rep_) if (PH_ON(0) && IN(base + 0)) { REFRAME(); if (rep_) xcd_barrier(bar, T0()); modnorm_phase(F, XBUF, karg(6) + (size_t)l * DM, MODP, 0, HBUF, 0); SEAM(base + 0); }
        for (int rep_ = 0; rep_ < ((DBG_REPEAT == 1) ? 2 : 1); ++rep_) if (PH_ON(1) && IN(base + 1)) { REFRAME(); if (rep_) xcd_barrier(bar, T0());
            pg8::Gemm g{HBUF, (const bf16*)(ws + WS_WINA) + (size_t)l * INA_P * DM, MALL, INA_P, DM}; pg8::RowOrder S; S.init_rows(0, INA_P, F.G, bx);
            pg8::EpiStoreBf16 E{(bf16*)(ws + WS_PA), INA_P};
            GEMM_CALL(pg8::EpiStoreBf16, pg8::RowOrder, g, S, E);
            SEAM(base + 1); }
        for (int rep_ = 0; rep_ < ((DBG_REPEAT == 2) ? 2 : 1); ++rep_) if (PH_ON(2) && IN(base + 2)) { REFRAME(); if (rep_) xcd_barrier(bar, T0());
            FeatP P;
            P.PA = (const bf16*)(ws + WS_PA); P.mu = karg(9) + (size_t)l * RWC; P.w0 = karg(10) + (size_t)l * 2 * RW; P.a0 = karg(12) + (size_t)l * 2 * RW;
            P.k_k = karg(15) + (size_t)l * RW; P.k_a = karg(16) + (size_t)l * RW; P.r_k = karg(17) + (size_t)l * RW;
            P.WUP = (const bf16*)(ws + WS_WUP) + (size_t)l * 2 * RW * 64; P.AUP = (const bf16*)(ws + WS_AUP) + (size_t)l * 2 * RW * 64; P.GUP = (const bf16*)(ws + WS_GUP) + (size_t)l * 2 * RW * 32;
            P.qnorm = karg(20) + (size_t)l * 512; P.kvnorm = karg(22) + (size_t)l * 256; P.rope = (const f32x2*)(ws + WS_ROPE);
            P.RI = (bf16*)(ws + WS_RI); P.GG = (bf16*)(ws + WS_GG); P.BON = (float*)(ws + WS_BON); P.QN = (bf16*)(ws + WS_QN); P.KVN = (bf16*)(ws + WS_KVN); P.K = (bf16*)(ws + WS_K);
            features_phase(F, P);
            SEAM(base + 2); }
        for (int rep_ = 0; rep_ < ((DBG_REPEAT == 3) ? 2 : 1); ++rep_) if (PH_ON(3) && IN(base + 3)) { REFRAME(); if (rep_) xcd_barrier(bar, T0());
            { pg8::Gemm g{(const bf16*)(ws + WS_QN), (const bf16*)(ws + WS_WUQ) + (size_t)l * NQ * 512, MALL, NQ, 512};
              pg8::EpiQ E{(bf16*)(ws + WS_Q), (const f32x2*)(ws + WS_ROPE), 0.14724444f};
              pg8::RowOrder S; S.init_rows(last, NQ, F.G, bx); GEMM_CALL_NA(pg8::EpiQ, pg8::RowOrder, g, S, E); }
            { pg8::Gemm g{(const bf16*)(ws + WS_KVN), (const bf16*)(ws + WS_WUKV) + (size_t)l * NKV * 256, MALL, NKV, 256}; pg8::RowOrder S; S.init_rows(0, NKV, F.G, bx);
              pg8::EpiKV E{(bf16*)(ws + WS_K), (bf16*)(ws + WS_V)};
              GEMM_CALL_NA(pg8::EpiKV, pg8::RowOrder, g, S, E); }
            SEAM(base + 3); }
        for (int rep_ = 0; rep_ < ((DBG_REPEAT == 4) ? 2 : 1); ++rep_) if (PH_ON(4) && IN(base + 4)) { REFRAME(); if (rep_) xcd_barrier(bar, T0()); scan_phase(F, (const bf16*)(ws + WS_RI), (bf16*)(ws + WS_Y)); SEAM(base + 4); }
        for (int rep_ = 0; rep_ < ((DBG_REPEAT == 5) ? 2 : 1); ++rep_) if (PH_ON(5) && IN(base + 5)) { REFRAME(); if (rep_) xcd_barrier(bar, T0());
            attn_phase(F, (const bf16*)(ws + WS_Q), (const bf16*)(ws + WS_K), (const bf16*)(ws + WS_V), (bf16*)(ws + WS_YB), !last);
            readout_phase(F, (const bf16*)(ws + WS_Y), (const bf16*)(ws + WS_GG), (const float*)(ws + WS_BON), (const bf16*)(ws + WS_RI), karg(18) + (size_t)l * RW, karg(19) + (size_t)l * RW, (bf16*)(ws + WS_YA));
            SEAM(base + 5); }
        for (int rep_ = 0; rep_ < ((DBG_REPEAT == 6) ? 2 : 1); ++rep_) if (PH_ON(6) && IN(base + 6)) { REFRAME(); if (rep_) xcd_barrier(bar, T0());
            bf16* T1 = (bf16*)(ws + WS_T1); bf16* T2 = (bf16*)(ws + WS_T2);
            const pg8::Gemm g1{HBUF, (const bf16*)(ws + WS_WGA) + (size_t)l * DM * DM, MALL, DM, DM}, g2{(const bf16*)(ws + WS_YA), (const bf16*)(ws + WS_WA) + (size_t)l * DM * RW, MALL, DM, RW};
            const pg8::Gemm g3{HBUF, (const bf16*)(ws + WS_WGB) + (size_t)l * DM * DM, MALL, DM, DM}, g4{(const bf16*)(ws + WS_YB), (const bf16*)(ws + WS_WB) + (size_t)l * DM * RW, MALL, DM, RW};
            const pg8::EpiGate E1{T1, DM, karg(8) + (size_t)l * 2 * DM}, E3{T2, DM, karg(8) + (size_t)l * 2 * DM + DM};
            const pg8::EpiMulAdd E2{T1, T1, nullptr, DM}, E4{T1, T2, T1, DM};
            pg8::RowOrder S; S.init_rows(last, DM, F.G, bx);
            GEMM_CALL(pg8::EpiGate, pg8::RowOrder, g1, S, E1); GEMM_CALL(pg8::EpiMulAdd, pg8::RowOrder, g2, S, E2); GEMM_CALL(pg8::EpiGate, pg8::RowOrder, g3, S, E3); GEMM_CALL(pg8::EpiMulAdd, pg8::RowOrder, g4, S, E4);
            SEAM(base + 6); }
        for (int rep_ = 0; rep_ < ((DBG_REPEAT == 7) ? 2 : 1); ++rep_) if (PH_ON(7) && IN(base + 7)) { REFRAME(); if (rep_) xcd_barrier(bar, T0());
            const pg8::Gemm g{(const bf16*)(ws + WS_T1), (const bf16*)(ws + WS_WO) + (size_t)l * DM * DM, MALL, DM, DM};
            const pg8::EpiResid E{XBUF, MODP + 2 * DM};
            pg8::RowOrder S; S.init_rows(last, DM, F.G, bx); GEMM_CALL(pg8::EpiResid, pg8::RowOrder, g, S, E);
            SEAM(base + 7); }
        for (int rep_ = 0; rep_ < ((DBG_REPEAT == 8) ? 2 : 1); ++rep_) if (PH_ON(8) && IN(base + 8)) { REFRAME(); if (rep_) xcd_barrier(bar, T0());
            modnorm_phase(F, XBUF, karg(27) + (size_t)l * DM, MODP, 3, HBUF, last);
            cvt_tables(F, karg(30) + (size_t)l * NEXP * DM, karg(31) + (size_t)l * NEXP * DM, ws + WS_PU, ws + WS_PU + (size_t)NEXP * DM, (float*)(ws + WS_PV), (float*)(ws + WS_PV) + NEXP);
            SEAM(base + 8); }
        for (int rep_ = 0; rep_ < ((DBG_REPEAT == 9) ? 2 : 1); ++rep_) if (PH_ON(9) && IN(base + 9)) { REFRAME(); if (rep_) xcd_barrier(bar, T0());
            const pg8::Gemm g{HBUF, (const bf16*)(ws + WS_WQK) + (size_t)l * DM * DM, MALL, DM, DM};
            const pg8::EpiF32 E{(float*)(ws + WS_SC), DM};
            pg8::RowOrder S; S.init_rows(last, DM, F.G, bx); GEMM_CALL(pg8::EpiF32, pg8::RowOrder, g, S, E);
            SEAM(base + 9); }
        for (int rep_ = 0; rep_ < ((DBG_REPEAT == 10) ? 2 : 1); ++rep_) if (PH_ON(10) && IN(base + 10)) { REFRAME(); if (rep_) xcd_barrier(bar, T0());
            PeerP P; P.SC = (const float*)(ws + WS_SC); P.H = HBUF; P.PU = ws + WS_PU; P.PV = ws + WS_PU + (size_t)NEXP * DM; P.SU = (const float*)(ws + WS_PV); P.SV = (const float*)(ws + WS_PV) + NEXP; P.X = XBUF; P.mod = MODP; P.fin_g = karg(32); P.out = (float*)karg(33); P.last = last;
            peer_phase(F, P);
            SEAM(base + 10); }
    }
#undef IN
#undef SEAM
#undef XBUF
#undef HBUF
#undef MODP
}

__global__ void __launch_bounds__(512) dbg_fill(const float* pp, float* o) {
    float s0 = 0.f, s1 = 0.f, s2 = 0.f, s3 = 0.f;
    for (int i = 0; i < 2048; ++i) { s0 += pp[4 * i]; s1 += pp[4 * i + 1]; s2 += pp[4 * i + 2]; s3 += pp[4 * i + 3]; }
    const float v = DBG_PROBE == 1 ? 10.f * sqrtf(s0 / s3) : DBG_PROBE == 2 ? 10.f * sqrtf(s1 / s3) : 100.f * s2 / s3;
    for (size_t i = (size_t)blockIdx.x * 512 + threadIdx.x; i < (size_t)NBATCH * SEQ * DM; i += (size_t)gridDim.x * 512) o[i] = v;
}
extern "C" void kernel_launch(void* const* d_in, const int* in_sizes, int n_in, void* d_out, int out_size, void* d_ws, size_t ws_size, hipStream_t stream) {
    static int grid = 0;
    if (grid == 0) {
        if (n_in != 33 || out_size != NBATCH * SEQ * DM || ws_size < WS_END) { fprintf(stderr, "kernel_launch: unexpected shapes (n_in %d out %d ws %zu)\n", n_in, out_size, ws_size); grid = -1; return; }
        int dev = 0, cus = 0, per_cu = 0;
        if (hipGetDevice(&dev) != hipSuccess || hipDeviceGetAttribute(&cus, hipDeviceAttributeMultiprocessorCount, dev) != hipSuccess) { grid = -1; return; }
        if (hipFuncSetAttribute((const void*)mk_fwd, hipFuncAttributeMaxDynamicSharedMemorySize, LDS_BYTES) != hipSuccess) { fprintf(stderr, "kernel_launch: hipFuncSetAttribute failed\n"); grid = -1; return; }
        if (hipOccupancyMaxActiveBlocksPerMultiprocessor(&per_cu, (const void*)mk_fwd, NWAVES * 64, LDS_BYTES) != hipSuccess || per_cu < 1) { fprintf(stderr, "kernel_launch: occupancy query says %d\n", per_cu); (void)hipGetLastError(); grid = -1; return; }
        grid = cus;
    }
    if (grid < 0) return;
    if (hipMemsetAsync((char*)d_ws + WS_CTL, 0, CTL_ZERO_BYTES, stream) != hipSuccess) return;
    Args a{};
    for (int i = 0; i < 33; ++i) a.in[i] = (const float*)d_in[i];
    a.out = (float*)d_out; a.ws = (unsigned char*)d_ws;
#if MK_N_LAUNCHES == 1
    a.ph_lo = 0; a.ph_hi = NPHASE;
    hipLaunchKernelGGL(mk_fwd, dim3(grid), dim3(NWAVES * 64), LDS_BYTES, stream, a);
#else
    for (int p = 0; p < NPHASE; ++p) { a.ph_lo = p; a.ph_hi = p + 1; hipLaunchKernelGGL(mk_fwd, dim3(grid), dim3(NWAVES * 64), LDS_BYTES, stream, a); }
    if (DBG_PROBE) hipLaunchKernelGGL(dbg_fill, dim3(1024), dim3(512), 0, stream, (const float*)((char*)d_ws + WS_CTL + CTL_PROBE_OFF), (float*)d_out);
#endif
}
```

```cpp
#include <hip/hip_runtime.h>
#include <cstdio>
#include <cstdint>

#ifndef MK_N_LAUNCHES
#define MK_N_LAUNCHES 1
#endif

#ifndef DBG_SKIP
#define DBG_SKIP 0
#endif
#ifndef DBG_PROBE
#define DBG_PROBE 0
#endif
#ifndef DBG_REPEAT
#define DBG_REPEAT -1
#endif
namespace pg8 {
#define PG8_LAS __attribute__((address_space(3)))
typedef unsigned short bf16_t;
typedef short bf16x8 __attribute__((ext_vector_type(8)));
typedef float f32x4 __attribute__((ext_vector_type(4)));
typedef unsigned u32x4 __attribute__((ext_vector_type(4)));
constexpr int BM = 256, BK = 64, HALF = 128, HTB = HALF * BK * 2  , STAGE_BYTES = 8 * HTB, NXCD = 8, WGM = 8;

__host__ __device__ __forceinline__ int lds_byte(int r, int c) { const int st = (r >> 4) * 2 + (c >> 5), rr = r & 15, cc = c & 31, ob = rr * 64 + cc * 2; return st * 1024 + (ob ^ (((ob >> 9) & 1) << 5)); }
__host__ __device__ __forceinline__ void stage_rc(int b, int& R, int& C) { const int st = b / 1024, sb = b % 1024, swz = sb ^ (((sb >> 9) & 1) << 5); R = (st >> 1) * 16 + swz / 64; C = (st & 1) * 32 + (swz % 64) / 2; }
__host__ __device__ __forceinline__ int perm32(int rho) { const int n = rho >> 4, i = rho & 15; return 8 * (i >> 2) + 4 * n + (i & 3); }

struct Unit { int pm, pn; };
struct Gemm { const bf16_t* A; const bf16_t* Bt; int M, N, K; };

struct StaticOrder {
    int nM, nN, nwg, G, c;
    __host__ __device__ void init(int M, int N, int G_, int c_) { nM = M / BM; nN = N / BM; nwg = nM * nN; G = G_; c = c_; }
    __host__ __device__ bool next(int i, Unit& u) const {
        const long L = (long)i * G + c; if (L >= nwg) return false;
        int wgid = (int)L; { const int q = nwg / NXCD, r = nwg % NXCD, xcd = wgid % NXCD, off = wgid / NXCD; wgid = (xcd < r ? xcd * (q + 1) : r * (q + 1) + (xcd - r) * q) + off; }
        const int nig = WGM * nN, gid = wgid / nig, fm = gid * WGM, gsz = (nM - fm) < WGM ? (nM - fm) : WGM;
        u.pm = fm + ((wgid % nig) % gsz); u.pn = (wgid % nig) / gsz; return true;
    }
    __device__ __forceinline__ void a_ready(const Unit&) const {}
    __device__ __forceinline__ void done(const Unit&) const {}
};
__device__ __forceinline__ int opaque_lane() { int l; asm volatile("v_mbcnt_lo_u32_b32 %0, -1, 0\n\tv_mbcnt_hi_u32_b32 %0, -1, %0" : "=v"(l)); return l; }
__device__ __forceinline__ unsigned cvt_pk_bf16(float lo, float hi) { unsigned r; asm volatile("v_cvt_pk_bf16_f32 %0, %1, %2" : "=v"(r) : "v"(lo), "v"(hi)); return r; }
template <class Epi, class Sched, bool ALIGN_EPI = false, bool SP2 = false>
__device__ __forceinline__ void gemm_phase(PG8_LAS unsigned char* lds, const Gemm g, const Sched& S, const Epi& E, const int wave_s) {
    const int lane_ = opaque_lane();
    const int wid = wave_s, lane = lane_, tid = wid * 64 + lane, wr = wid >> 2, wc = wid & 3, fr = lane & 15, fq = lane >> 4;
    const int K = g.K, nt = K / BK;
    unsigned voffA[2], voffB[2];
#pragma unroll
    for (int i = 0; i < 2; ++i) { int R, C; stage_rc(tid * 16 + i * 8192, R, C); const int Rb = Epi::PERM ? ((R & ~31) + perm32(R & 31)) : R;
        voffA[i] = (unsigned)(R * K + C) * 2u; voffB[i] = (unsigned)(Rb * K + C) * 2u; }
    const size_t kstep = (size_t)(BK * 2);
    const size_t hstep = (size_t)HALF * K * 2;
    const size_t tstep = 2 * hstep;
    const unsigned ldsw = (unsigned)wid * 1024u;
    const int aoff = lds_byte(wr * 64 + fr, fq * 8), boff = lds_byte(wc * 32 + fr, fq * 8);
#define PG8_SA(b, h) (((b) * 2 + (h)) * HTB)
#define PG8_SB(b, h) ((4 + (b) * 2 + (h)) * HTB)
#define PG8_STAGE(bufoff, gbase, voff) do { _Pragma("unroll") for (int _i = 0; _i < 2; ++_i) \
        __builtin_amdgcn_global_load_lds((const unsigned*)((const char*)(gbase) + (voff)[_i]), (PG8_LAS unsigned*)(lds + (bufoff) + ldsw + _i * 8192), 16, 0, 0); } while (0)
#define PG8_LDA(dst, b, h) do { _Pragma("unroll") for (int m = 0; m < 4; ++m) _Pragma("unroll") for (int k = 0; k < 2; ++k) dst[m][k] = *(const PG8_LAS bf16x8*)(lds + PG8_SA(b, h) + aoff + m * 2048 + k * 1024); } while (0)
#define PG8_LDB(dst, b, h) do { _Pragma("unroll") for (int n = 0; n < 2; ++n) _Pragma("unroll") for (int k = 0; k < 2; ++k) dst[n][k] = *(const PG8_LAS bf16x8*)(lds + PG8_SB(b, h) + boff + n * 2048 + k * 1024); } while (0)
#define PG8_MMA(ai, bj, At, Bt) do { __builtin_amdgcn_s_setprio(1); _Pragma("unroll") for (int m = 0; m < 4; ++m) _Pragma("unroll") for (int n = 0; n < 2; ++n) _Pragma("unroll") for (int k = 0; k < 2; ++k) \
        acc[ai][bj][m][n] = __builtin_amdgcn_mfma_f32_16x16x32_bf16(Bt[n][k], At[m][k], acc[ai][bj][m][n], 0, 0, 0); __builtin_amdgcn_s_setprio(0); } while (0)
#define PG8_WAIT_V(n) asm volatile("s_waitcnt vmcnt(" #n ")" ::: "memory")
#define PG8_WAIT_L(n) asm volatile("s_waitcnt lgkmcnt(" #n ")" ::: "memory")
#define PG8_BAR __builtin_amdgcn_s_barrier()
#define PG8_SCHED __builtin_amdgcn_sched_barrier(0)
    Unit cur, nxt; int ui = 0;
    if (!S.next(0, cur)) return;
    f32x4 acc[2][2][4][2];
#pragma unroll
    for (int a = 0; a < 2; ++a)
#pragma unroll
        for (int b = 0; b < 2; ++b)
#pragma unroll
            for (int m = 0; m < 4; ++m)
#pragma unroll
                for (int n = 0; n < 2; ++n) acc[a][b][m][n] = (f32x4){0.f, 0.f, 0.f, 0.f};
    bf16x8 At[4][2], B0[2][2], B1[2][2];
    const char* cA = (const char*)g.A + (size_t)cur.pm * tstep; const char* cB = (const char*)g.Bt + (size_t)cur.pn * tstep;
    S.a_ready(cur);
    if constexpr (SP2) {
        PG8_STAGE(PG8_SB(0, 0), cB, voffB); PG8_STAGE(PG8_SB(0, 1), cB + hstep, voffB); PG8_STAGE(PG8_SA(0, 0), cA, voffA); PG8_STAGE(PG8_SA(0, 1), cA + hstep, voffA);
        if (wr == 1) PG8_BAR;
        PG8_WAIT_V(2); PG8_BAR;
        PG8_STAGE(PG8_SB(1, 0), cB + kstep, voffB); PG8_STAGE(PG8_SA(1, 0), cA + kstep, voffA); PG8_STAGE(PG8_SB(1, 1), cB + hstep + kstep, voffB);
        PG8_WAIT_V(6); PG8_BAR;
    } else {
        PG8_STAGE(PG8_SB(0, 0), cB, voffB); PG8_STAGE(PG8_SA(0, 0), cA, voffA); PG8_STAGE(PG8_SB(0, 1), cB + hstep, voffB); PG8_STAGE(PG8_SA(0, 1), cA + hstep, voffA);
        if (wr == 1) PG8_BAR;
        PG8_WAIT_V(4); PG8_BAR;
        PG8_STAGE(PG8_SB(1, 0), cB + kstep, voffB); PG8_STAGE(PG8_SA(1, 0), cA + kstep, voffA); PG8_STAGE(PG8_SB(1, 1), cB + hstep + kstep, voffB);
        PG8_WAIT_V(6); PG8_BAR;
    }
    for (;;) {
        const bool has_next = S.next(ui + 1, nxt);
        const char* nA = has_next ? (const char*)g.A + (size_t)nxt.pm * tstep : cA; const char* nB = has_next ? (const char*)g.Bt + (size_t)nxt.pn * tstep : cB;
        for (int t = 0; t < nt; t += 2) {
            const bool last = (t == nt - 2);
            const char* a1 = cA + (size_t)(t + 1) * kstep;
            const char* a2 = last ? nA : cA + (size_t)(t + 2) * kstep; const char* b2 = last ? nB : cB + (size_t)(t + 2) * kstep;
            const char* a3 = a2 + kstep; const char* b3 = b2 + kstep;
            if (last && has_next) S.a_ready(nxt);
            if constexpr (SP2) {
            PG8_LDB(B0, 0, 0); PG8_LDB(B1, 0, 1); PG8_SCHED; PG8_LDA(At, 0, 0); PG8_STAGE(PG8_SA(1, 1), a1 + hstep, voffA);
            PG8_WAIT_V(8); PG8_WAIT_L(0); PG8_BAR; PG8_MMA(0, 0, At, B0); PG8_MMA(0, 1, At, B1); PG8_BAR; PG8_SCHED;
            PG8_LDA(At, 0, 1); PG8_STAGE(PG8_SB(0, 0), b2, voffB); PG8_STAGE(PG8_SB(0, 1), b2 + hstep, voffB); PG8_STAGE(PG8_SA(0, 0), a2, voffA);
            PG8_WAIT_V(8); PG8_WAIT_L(0); PG8_BAR; PG8_MMA(1, 0, At, B0); PG8_MMA(1, 1, At, B1); PG8_BAR; PG8_SCHED;
            PG8_LDB(B0, 1, 0); PG8_LDB(B1, 1, 1); PG8_SCHED; PG8_LDA(At, 1, 0); PG8_STAGE(PG8_SA(0, 1), a2 + hstep, voffA);
            PG8_WAIT_V(8); PG8_WAIT_L(0); PG8_BAR; PG8_MMA(0, 0, At, B0); PG8_MMA(0, 1, At, B1); PG8_BAR; PG8_SCHED;
            PG8_LDA(At, 1, 1); PG8_STAGE(PG8_SB(1, 0), b3, voffB); PG8_STAGE(PG8_SB(1, 1), b3 + hstep, voffB); PG8_STAGE(PG8_SA(1, 0), a3, voffA);
            PG8_WAIT_V(8); PG8_WAIT_L(0); PG8_BAR; PG8_MMA(1, 0, At, B0); PG8_MMA(1, 1, At, B1); PG8_BAR; PG8_SCHED;
            } else {
            PG8_LDB(B0, 0, 0); PG8_SCHED; PG8_LDA(At, 0, 0); PG8_STAGE(PG8_SA(1, 1), a1 + hstep, voffA);
            PG8_WAIT_L(8); PG8_BAR; PG8_WAIT_L(0); PG8_MMA(0, 0, At, B0); PG8_BAR; PG8_SCHED;
            PG8_LDB(B1, 0, 1); PG8_STAGE(PG8_SB(0, 0), b2, voffB);
            PG8_BAR; PG8_WAIT_L(0); PG8_MMA(0, 1, At, B1); PG8_BAR;
            PG8_LDA(At, 0, 1); PG8_STAGE(PG8_SA(0, 0), a2, voffA);
            PG8_BAR; PG8_WAIT_L(0); PG8_MMA(1, 0, At, B0); PG8_BAR; PG8_SCHED;
            PG8_STAGE(PG8_SB(0, 1), b2 + hstep, voffB);
            PG8_WAIT_V(6); PG8_BAR; PG8_MMA(1, 1, At, B1); PG8_BAR;
            PG8_LDB(B0, 1, 0); PG8_SCHED; PG8_LDA(At, 1, 0); PG8_STAGE(PG8_SA(0, 1), a2 + hstep, voffA);
            PG8_WAIT_L(8); PG8_BAR; PG8_WAIT_L(0); PG8_MMA(0, 0, At, B0); PG8_BAR; PG8_SCHED;
            PG8_LDB(B1, 1, 1); PG8_STAGE(PG8_SB(1, 0), b3, voffB);
            PG8_BAR; PG8_WAIT_L(0); PG8_MMA(0, 1, At, B1); PG8_BAR;
            PG8_LDA(At, 1, 1); PG8_STAGE(PG8_SA(1, 0), a3, voffA);
            PG8_BAR; PG8_WAIT_L(0); PG8_MMA(1, 0, At, B0); PG8_BAR; PG8_SCHED;
            PG8_STAGE(PG8_SB(1, 1), b3 + hstep, voffB);
            PG8_WAIT_V(6); PG8_BAR; PG8_MMA(1, 1, At, B1); PG8_BAR;
            }
        }
        if constexpr (ALIGN_EPI) { if (wr == 0) PG8_BAR; }
        if constexpr (!Epi::AFTER_DRAIN) { const int le_ = opaque_lane(); E(acc, cur, wr, wc, le_ & 15, le_ >> 4); S.done(cur); }
        if (!has_next) break;
#pragma unroll
        for (int a = 0; a < 2; ++a)
#pragma unroll
            for (int b = 0; b < 2; ++b)
#pragma unroll
                for (int m = 0; m < 4; ++m)
#pragma unroll
                    for (int n = 0; n < 2; ++n) acc[a][b][m][n] = (f32x4){0.f, 0.f, 0.f, 0.f};
        cur = nxt; cA = nA; cB = nB; ++ui;
        if constexpr (ALIGN_EPI) { if (wr == 1) PG8_BAR; }
    }
    PG8_WAIT_V(0);
    if constexpr (!ALIGN_EPI) { if (wr == 0) PG8_BAR; }
    PG8_BAR;
    if constexpr (Epi::AFTER_DRAIN) { E.fused(acc, cur, wr, wc, fr, fq, lds, wid, lane); S.done(cur); }
#undef PG8_SA
#undef PG8_SB
#undef PG8_STAGE
#undef PG8_LDA
#undef PG8_LDB
#undef PG8_MMA
#undef PG8_WAIT_V
#undef PG8_WAIT_L
#undef PG8_BAR
#undef PG8_SCHED
}
}

constexpr int NWAVES = 8;
constexpr int DM = 2048, NBATCH = 2, SEQ = 8192, CTXL = 256, TPB = CTXL + SEQ  , MALL = NBATCH * TPB  ;
constexpr int NLAYER = 2;
constexpr int RW = 1024, NH = 16;
constexpr int RWC = 3392, INA = 4192, INA_P = 4352, INC = 8288;
constexpr int C_WD = 3072, C_AD = 3200, C_GD = 3328, C_QC = 3392, C_KVC = 3904, C_KR = 4160;
constexpr int QKD = 96, NQ = NH * QKD  , NKV = NH * 128  ;
constexpr int NEXP = 16384;
constexpr int RREC = 9 * 64;
constexpr float NORM_EPS = 1e-6f;

constexpr size_t MiB = 1u << 20;
constexpr size_t WS_CTL = 0, CTL_ZERO_BYTES = 1 * MiB;
constexpr size_t CTL_MOD_OFF = 256 * 1024;
constexpr size_t WS_ROPE = 1 * MiB;
constexpr size_t WS_WUP = 3 * MiB, WS_AUP = WS_WUP + 512 * 1024, WS_GUP = 4 * MiB;
constexpr size_t WS_WUQ = 5 * MiB, WS_WUKV = 8 * MiB, WS_WA = 10 * MiB, WS_WB = 18 * MiB, WS_WO = 26 * MiB, WS_WQK = 42 * MiB, WS_WGA = 58 * MiB, WS_WGB = 74 * MiB, WS_WINA = 90 * MiB;
constexpr size_t WS_X = 124 * MiB, WS_H = 256 * MiB, WS_DYN = 322 * MiB;
constexpr size_t WS_PA = WS_DYN;
constexpr size_t WS_RI = 463 * MiB;
constexpr size_t WS_GG = 760 * MiB;
constexpr size_t WS_BON = 826 * MiB;
constexpr size_t WS_QN = 831 * MiB, WS_KVN = 848 * MiB;
constexpr size_t WS_Q = 857 * MiB, WS_K = 907 * MiB, WS_V = 957 * MiB, WS_END = 990 * MiB;
constexpr size_t WS_Y = WS_DYN;
constexpr size_t WS_YA = 388 * MiB, WS_YB = 421 * MiB;
constexpr size_t WS_T1 = 463 * MiB, WS_T2 = 529 * MiB;
constexpr size_t WS_PU = 600 * MiB, WS_PV = 664 * MiB;
constexpr size_t WS_SC = WS_DYN;
static_assert(WS_PA + (size_t)MALL * INA_P * 2 <= WS_RI && WS_RI + (size_t)NBATCH * NH * TPB * RREC * 2 <= WS_GG && WS_GG + (size_t)2 * MALL * RW * 2 <= WS_BON, "ws map 1");
static_assert(WS_BON + (size_t)2 * MALL * 32 * 4 <= WS_QN && WS_QN + (size_t)MALL * 512 * 2 <= WS_KVN && WS_KVN + (size_t)MALL * 256 * 2 <= WS_Q, "ws map 2");
static_assert(WS_Q + (size_t)NBATCH * NH * TPB * QKD * 2 <= WS_K && WS_K + (size_t)NBATCH * NH * TPB * QKD * 2 <= WS_V && WS_V + (size_t)NBATCH * NH * TPB * 64 * 2 <= WS_END, "ws map 3");
static_assert(WS_Y + (size_t)2 * MALL * RW * 2 <= WS_YA && WS_YA + (size_t)MALL * RW * 2 <= WS_YB && WS_YB + (size_t)MALL * RW * 2 <= WS_RI, "ws map 4");
static_assert(WS_T1 + (size_t)MALL * DM * 2 <= WS_T2 && WS_T2 + (size_t)MALL * DM * 2 <= WS_PU && WS_PU + (size_t)NEXP * DM * 2 <= WS_PV && WS_PV + (size_t)NEXP * DM * 2 <= WS_GG, "ws map 5");
static_assert(WS_SC + (size_t)MALL * DM * 4 <= WS_T1 && WS_X + (size_t)MALL * DM * 4 <= WS_H && WS_H + (size_t)MALL * DM * 2 <= WS_DYN, "ws map 6");
static_assert(WS_WINA + (size_t)NLAYER * INA_P * DM * 2 <= WS_X, "ws map 7");
constexpr size_t CTL_PROBE_OFF = 640 * 1024;
constexpr int CW_BAR = 4096;

constexpr int RING_BYTES = 131072;
constexpr int LDSCTL_OFF = RING_BYTES, MISC_OFF = LDSCTL_OFF + 320;
constexpr int LDS_BYTES = 147456;

#define GAS __attribute__((address_space(1)))
#define LAS __attribute__((address_space(3)))
typedef unsigned short bf16;
typedef unsigned v4u __attribute__((ext_vector_type(4)));
typedef unsigned v2u __attribute__((ext_vector_type(2)));
typedef float f32x4 __attribute__((ext_vector_type(4)));
typedef float f32x2 __attribute__((ext_vector_type(2)));
typedef float f32x16 __attribute__((ext_vector_type(16)));
typedef short bf16x8 __attribute__((ext_vector_type(8)));
typedef short s16x4 __attribute__((ext_vector_type(4)));
typedef __bf16 bf16x2v __attribute__((ext_vector_type(2)));
typedef __bf16 bf16x8v __attribute__((ext_vector_type(8)));
typedef GAS unsigned gu32;
#define RLX_AGENT __ATOMIC_RELAXED, __HIP_MEMORY_SCOPE_AGENT
#define LDS_WAIT() asm volatile("s_waitcnt lgkmcnt(0)" ::: "memory")
#define VM_WAIT() asm volatile("s_waitcnt vmcnt(0)" ::: "memory")
__device__ __forceinline__ unsigned f2bf(float f) { unsigned u = __builtin_bit_cast(unsigned, f); return (u + 0x7fffu + ((u >> 16) & 1u)) >> 16; }
__device__ __forceinline__ unsigned pk2(float lo, float hi) { return pg8::cvt_pk_bf16(lo, hi); }
__device__ __forceinline__ float bflo(unsigned w) { return __builtin_bit_cast(float, w << 16); }
__device__ __forceinline__ float bfhi(unsigned w) { return __builtin_bit_cast(float, w & 0xffff0000u); }
__device__ __forceinline__ float bf1(bf16 h) { return __builtin_bit_cast(float, (unsigned)h << 16); }
__device__ __forceinline__ float sigmoidf_(float x) { return 1.0f / (1.0f + __expf(-x)); }
template <int CTRL> __device__ __forceinline__ float dpp_add(float x) {
    return x + __builtin_bit_cast(float, __builtin_amdgcn_update_dpp(0, __builtin_bit_cast(int, x), CTRL, 0xf, 0xf, true));
}
__device__ __forceinline__ float red16(float x) {
    x = dpp_add<0xB1>(x);
    x = dpp_add<0x4E>(x);
    x = dpp_add<0x141>(x);
    x = dpp_add<0x140>(x);
    return x;
}
template <int CTRL, int RM> __device__ __forceinline__ float dpp_max(float x) {
    return fmaxf(x, __builtin_bit_cast(float, __builtin_amdgcn_update_dpp(__builtin_bit_cast(int, x), __builtin_bit_cast(int, x), CTRL, RM, 0xf, false)));
}
template <int CTRL, int RM> __device__ __forceinline__ float dpp_sum(float x) {
    return x + __builtin_bit_cast(float, __builtin_amdgcn_update_dpp(0, __builtin_bit_cast(int, x), CTRL, RM, 0xf, false));
}
__device__ __forceinline__ float wave_max_u(float x) {
    x = dpp_max<0xB1, 0xf>(x); x = dpp_max<0x4E, 0xf>(x); x = dpp_max<0x141, 0xf>(x); x = dpp_max<0x140, 0xf>(x);
    x = dpp_max<0x142, 0xa>(x); x = dpp_max<0x143, 0xc>(x);
    return __builtin_bit_cast(float, __builtin_amdgcn_readlane(__builtin_bit_cast(int, x), 63));
}
__device__ __forceinline__ float wave_sum_u(float x) {
    x = dpp_sum<0xB1, 0xf>(x); x = dpp_sum<0x4E, 0xf>(x); x = dpp_sum<0x141, 0xf>(x); x = dpp_sum<0x140, 0xf>(x);
    x = dpp_sum<0x142, 0xa>(x); x = dpp_sum<0x143, 0xc>(x);
    return __builtin_bit_cast(float, __builtin_amdgcn_readlane(__builtin_bit_cast(int, x), 63));
}
__device__ __forceinline__ float wave_sum(float v) { return wave_sum_u(v); }
__device__ __forceinline__ float bpermf(int srclane, float v) { return __builtin_bit_cast(float, __builtin_amdgcn_ds_bpermute(srclane << 2, __builtin_bit_cast(int, v))); }
__device__ __forceinline__ int bpermi(int srclane, int v) { return __builtin_amdgcn_ds_bpermute(srclane << 2, v); }

#define XB_TMO      128
#define XB_XCNT(j)  (256  + 64 * (j))
#define XB_XSUB(j)  (1280 + 64 * (j))
#define XB_XGEN(j)  (2304 + 64 * (j))
#define XB_TOP      3328
#define XB_TOPGEN   3392
#define XCD_BAR_WORDS 3456
#define XB_SPIN_CAP (1u << 20)

__device__ __forceinline__ unsigned xb_ld(unsigned* p)              { return __hip_atomic_load(p, __ATOMIC_RELAXED, __HIP_MEMORY_SCOPE_AGENT); }
__device__ __forceinline__ unsigned xb_add(unsigned* p, unsigned v) { return __hip_atomic_fetch_add(p, v, __ATOMIC_RELAXED, __HIP_MEMORY_SCOPE_AGENT); }
__device__ __forceinline__ unsigned xb_xcc_id() { return (unsigned)__builtin_amdgcn_s_getreg((3 << 11) | 20) & 0xFu; }
#define XB_SPIN(cond, bar) do { unsigned _sp = 0; while (cond) { __builtin_amdgcn_s_sleep(1); \
    if ((++_sp & 255u) == 0u) { if (xb_ld(&(bar)[XB_TMO])) break; if (_sp > XB_SPIN_CAP) { atomicAdd(&(bar)[XB_TMO], 1u); break; } } } } while (0)

struct XcdBarrier { unsigned* bar; unsigned x; volatile LAS unsigned* st; };

__device__ __forceinline__ XcdBarrier xcd_barrier_post(unsigned* bar, volatile LAS unsigned* st, bool t0) {
    XcdBarrier b; b.bar = bar; b.x = xb_xcc_id(); b.st = st;
    if (t0) (void)xb_add(&bar[XB_XCNT(b.x)], 1u);
    return b;
}
__device__ __forceinline__ void xcd_barrier_complete(unsigned* bar, unsigned x, unsigned& nloc, unsigned& nx) {
    const unsigned G = gridDim.x * gridDim.y * gridDim.z;
    unsigned sum, cnt, mine, sp = 0u;
    for (;;) {
        sum = 0u; cnt = 0u; mine = 0u;
#pragma unroll
        for (unsigned j = 0; j < 16; ++j) { const unsigned c = xb_ld(&bar[XB_XCNT(j)]); sum += c; cnt += (c > 0u) ? 1u : 0u; mine = (j == x) ? c : mine; }
        if (sum == G) break;
        __builtin_amdgcn_s_sleep(1);
        if ((++sp & 255u) == 0u) { if (xb_ld(&bar[XB_TMO])) break; if (sp > XB_SPIN_CAP) { atomicAdd(&bar[XB_TMO], 1u); break; } }
    }
    nloc = mine > 0u ? mine : 1u; nx = cnt > 0u ? cnt : 1u;
}
__device__ __forceinline__ void xcd_barrier(const XcdBarrier& b, bool t0) {
    asm volatile("s_waitcnt vmcnt(0)" ::: "memory");
    __syncthreads();
    if (t0) {
        unsigned* bar = b.bar;
        __builtin_amdgcn_s_waitcnt(0);
        unsigned nloc = b.st[0], nx = b.st[1];
        if (nloc == 0u) { xcd_barrier_complete(bar, b.x, nloc, nx); b.st[0] = nloc; b.st[1] = nx; }
        const unsigned old = xb_add(&bar[XB_XSUB(b.x)], 1u);
        const unsigned gen = old / nloc;
        if (old + 1u == (gen + 1u) * nloc) {
            __builtin_amdgcn_fence(__ATOMIC_RELEASE, "agent");
            asm volatile("s_waitcnt vmcnt(0)" ::: "memory");
            const unsigned og = xb_add(&bar[XB_TOP], 1u);
            const unsigned tg = og / nx;
            if (og + 1u == (tg + 1u) * nx) xb_add(&bar[XB_TOPGEN], 1u);
            else XB_SPIN(xb_ld(&bar[XB_TOPGEN]) == tg, bar);
            __builtin_amdgcn_fence(__ATOMIC_ACQUIRE, "agent");
            xb_add(&bar[XB_XGEN(b.x)], 1u);
            asm volatile("s_waitcnt vmcnt(0)" ::: "memory");
        } else {
            XB_SPIN(xb_ld(&bar[XB_XGEN(b.x)]) == gen, bar);
            __builtin_amdgcn_fence(__ATOMIC_ACQUIRE, "agent");
            asm volatile("s_waitcnt vmcnt(0)" ::: "memory");
        }
    }
    __syncthreads();
}

struct Frame {
    LAS unsigned char* lds;
    unsigned char* ws;
    const float* const* in;
    int tid, lane, wave;
    int vcu, G;
};
struct Args { const float* in[33]; float* out; unsigned char* ws; int ph_lo, ph_hi; };


namespace pg8 {
typedef unsigned u32x4 __attribute__((ext_vector_type(4)));
struct RowOrder : StaticOrder {
    int lat;
    __host__ __device__ void init_rows(int lat_, int N, int G_, int c_) { lat = lat_; init(lat_ ? NBATCH * SEQ : MALL, N, G_, c_); }
    __host__ __device__ bool next(int i, Unit& u) const { if (!StaticOrder::next(i, u)) return false; if (lat) u.pm = 33 * (u.pm >> 5) + 1 + (u.pm & 31); return true; }
};
#define EPI_LOOP_ROWS for (int ai = 0; ai < 2; ++ai) _Pragma("unroll") for (int m = 0; m < 4; ++m)
#define EPI_PIN asm volatile("" ::: "memory")

struct EpiStoreBf16 {
    static constexpr bool PERM = true, AFTER_DRAIN = false;
    bf16_t* O; int ldc;
    __device__ __forceinline__ void operator()(const f32x4 (&acc)[2][2][4][2], const Unit& u, int wr, int wc, int fr, int fq) const {
        const int row0 = u.pm * BM + wr * 64 + fr, col0 = u.pn * BM + wc * 32 + 8 * fq;
#pragma unroll
        EPI_LOOP_ROWS { bf16_t* rowp = O + (size_t)(row0 + ai * HALF + m * 16) * ldc + col0;
#pragma unroll
            for (int bj = 0; bj < 2; ++bj) { const f32x4 v0 = acc[ai][bj][m][0], v1 = acc[ai][bj][m][1];
                u32x4 w; w.x = cvt_pk_bf16(v0[0], v0[1]); w.y = cvt_pk_bf16(v0[2], v0[3]); w.z = cvt_pk_bf16(v1[0], v1[1]); w.w = cvt_pk_bf16(v1[2], v1[3]);
                *(u32x4*)(rowp + bj * HALF) = w; } }
    }
};
struct EpiGate {
    static constexpr bool PERM = true, AFTER_DRAIN = false;
    bf16_t* O; int ldc; const float* bias;
    __device__ __forceinline__ void operator()(const f32x4 (&acc)[2][2][4][2], const Unit& u, int wr, int wc, int fr, int fq) const {
        const int row0 = u.pm * BM + wr * 64 + fr, col0 = u.pn * BM + wc * 32 + 8 * fq;
        f32x4 bv[2][2];
#pragma unroll
        for (int bj = 0; bj < 2; ++bj)
#pragma unroll
            for (int n = 0; n < 2; ++n) bv[bj][n] = *(const f32x4*)(bias + col0 + bj * HALF + 4 * n);
#pragma unroll
        EPI_LOOP_ROWS { EPI_PIN; bf16_t* rowp = O + (size_t)(row0 + ai * HALF + m * 16) * ldc + col0;
#pragma unroll
            for (int bj = 0; bj < 2; ++bj) { f32x4 v0 = acc[ai][bj][m][0] + bv[bj][0], v1 = acc[ai][bj][m][1] + bv[bj][1];
#pragma unroll
                for (int e = 0; e < 4; ++e) { v0[e] = 1.0f / (1.0f + __expf(-v0[e])); v1[e] = 1.0f / (1.0f + __expf(-v1[e])); }
                u32x4 w; w.x = cvt_pk_bf16(v0[0], v0[1]); w.y = cvt_pk_bf16(v0[2], v0[3]); w.z = cvt_pk_bf16(v1[0], v1[1]); w.w = cvt_pk_bf16(v1[2], v1[3]);
                *(u32x4*)(rowp + bj * HALF) = w; } }
    }
};
__device__ __forceinline__ float bf_lo(unsigned w) { return __builtin_bit_cast(float, w << 16); }
__device__ __forceinline__ float bf_hi(unsigned w) { return __builtin_bit_cast(float, w & 0xffff0000u); }
struct EpiMulAdd {
    static constexpr bool PERM = true, AFTER_DRAIN = false;
    bf16_t* O; const bf16_t* Gt; const bf16_t* Ad; int ldc;
    __device__ __forceinline__ void operator()(const f32x4 (&acc)[2][2][4][2], const Unit& u, int wr, int wc, int fr, int fq) const {
        const int row0 = u.pm * BM + wr * 64 + fr, col0 = u.pn * BM + wc * 32 + 8 * fq;
#pragma unroll
        EPI_LOOP_ROWS { EPI_PIN; const size_t ro = (size_t)(row0 + ai * HALF + m * 16) * ldc + col0;
#pragma unroll
            for (int bj = 0; bj < 2; ++bj) { const f32x4 v0 = acc[ai][bj][m][0], v1 = acc[ai][bj][m][1];
                const u32x4 g = *(const u32x4*)(Gt + ro + bj * HALF);
                float o[8];
                o[0] = bf_lo(g.x) * v0[0]; o[1] = bf_hi(g.x) * v0[1]; o[2] = bf_lo(g.y) * v0[2]; o[3] = bf_hi(g.y) * v0[3];
                o[4] = bf_lo(g.z) * v1[0]; o[5] = bf_hi(g.z) * v1[1]; o[6] = bf_lo(g.w) * v1[2]; o[7] = bf_hi(g.w) * v1[3];
                if (Ad) { const u32x4 a = *(const u32x4*)(Ad + ro + bj * HALF);
                    o[0] += bf_lo(a.x); o[1] += bf_hi(a.x); o[2] += bf_lo(a.y); o[3] += bf_hi(a.y); o[4] += bf_lo(a.z); o[5] += bf_hi(a.z); o[6] += bf_lo(a.w); o[7] += bf_hi(a.w); }
                u32x4 w; w.x = cvt_pk_bf16(o[0], o[1]); w.y = cvt_pk_bf16(o[2], o[3]); w.z = cvt_pk_bf16(o[4], o[5]); w.w = cvt_pk_bf16(o[6], o[7]);
                *(u32x4*)(O + ro + bj * HALF) = w; } }
    }
};
struct EpiResid {
    static constexpr bool PERM = false, AFTER_DRAIN = false;
    float* X; const float* gate;
    __device__ __forceinline__ void operator()(const f32x4 (&acc)[2][2][4][2], const Unit& u, int wr, int wc, int fr, int fq) const {
        const int row0 = u.pm * BM + wr * 64 + fr, col0 = u.pn * BM + wc * 32 + 4 * fq;
        const int bb = u.pm / 33, mr = (u.pm - bb * 33 == 0) ? 2 : bb;
        const float* gp = gate + (size_t)mr * 12288 + col0;
        f32x4 gv[2][2];
#pragma unroll
        for (int bj = 0; bj < 2; ++bj)
#pragma unroll
            for (int n = 0; n < 2; ++n) gv[bj][n] = *(const f32x4*)(gp + bj * HALF + n * 16);
#pragma unroll
        EPI_LOOP_ROWS { EPI_PIN; float* rowp = X + (size_t)(row0 + ai * HALF + m * 16) * DM + col0;
#pragma unroll
            for (int bj = 0; bj < 2; ++bj)
#pragma unroll
                for (int n = 0; n < 2; ++n) { f32x4* p = (f32x4*)(rowp + bj * HALF + n * 16); *p = *p + gv[bj][n] * acc[ai][bj][m][n]; } }
    }
};
struct EpiF32 {
    static constexpr bool PERM = false, AFTER_DRAIN = false;
    float* C; int ldc;
    __device__ __forceinline__ void operator()(const f32x4 (&acc)[2][2][4][2], const Unit& u, int wr, int wc, int fr, int fq) const {
        const int row0 = u.pm * BM + wr * 64 + fr, col0 = u.pn * BM + wc * 32 + 4 * fq;
#pragma unroll
        EPI_LOOP_ROWS { float* rowp = C + (size_t)(row0 + ai * HALF + m * 16) * ldc + col0;
#pragma unroll
            for (int bj = 0; bj < 2; ++bj)
#pragma unroll
                for (int n = 0; n < 2; ++n) *(f32x4*)(rowp + bj * HALF + n * 16) = acc[ai][bj][m][n]; }
    }
};
struct EpiQ {
    static constexpr bool PERM = true, AFTER_DRAIN = false;
    bf16_t* Q; const f32x2* rope; float qscale;
    __device__ __forceinline__ void operator()(const f32x4 (&acc)[2][2][4][2], const Unit& u, int wr, int wc, int fr, int fq) const {
        const int bb = u.pm / 33, tp0 = (u.pm - bb * 33) * BM + wr * 64 + fr, col0 = u.pn * BM + wc * 32 + 8 * fq;
#pragma unroll
        for (int bj = 0; bj < 2; ++bj) { const int c = col0 + bj * HALF, hd = c / QKD, d = c - hd * QKD;
#pragma unroll
            EPI_LOOP_ROWS { EPI_PIN; const int tp = tp0 + ai * HALF + m * 16;
                f32x4 v0 = acc[ai][bj][m][0], v1 = acc[ai][bj][m][1];
                if (d >= 64) { const int i0 = (d - 64) >> 1; const f32x2* rp = rope + (size_t)tp * 16 + i0;
                    const f32x2 c0 = rp[0], c1 = rp[1], c2 = rp[2], c3 = rp[3];
                    float a, b;
                    a = v0[0]; b = v0[1]; v0[0] = a * c0.x - b * c0.y; v0[1] = a * c0.y + b * c0.x;
                    a = v0[2]; b = v0[3]; v0[2] = a * c1.x - b * c1.y; v0[3] = a * c1.y + b * c1.x;
                    a = v1[0]; b = v1[1]; v1[0] = a * c2.x - b * c2.y; v1[1] = a * c2.y + b * c2.x;
                    a = v1[2]; b = v1[3]; v1[2] = a * c3.x - b * c3.y; v1[3] = a * c3.y + b * c3.x; }
                v0 = v0 * qscale; v1 = v1 * qscale;
                u32x4 w; w.x = cvt_pk_bf16(v0[0], v0[1]); w.y = cvt_pk_bf16(v0[2], v0[3]); w.z = cvt_pk_bf16(v1[0], v1[1]); w.w = cvt_pk_bf16(v1[2], v1[3]);
                *(u32x4*)(Q + ((size_t)(bb * NH + hd) * TPB + tp) * QKD + d) = w; } }
    }
};
struct EpiKV {
    static constexpr bool PERM = true, AFTER_DRAIN = false;
    bf16_t* K; bf16_t* V;
    __device__ __forceinline__ void operator()(const f32x4 (&acc)[2][2][4][2], const Unit& u, int wr, int wc, int fr, int fq) const {
        const int bb = u.pm / 33, tp0 = (u.pm - bb * 33) * BM + wr * 64 + fr;
        const bool isK = wc < 2;
        bf16_t* base = isK ? K : V; const int pitch = isK ? QKD : 64, doff = 32 * (wc & 1) + 8 * fq;
#pragma unroll
        for (int bj = 0; bj < 2; ++bj) { const int hd = 2 * u.pn + bj;
            bf16_t* hb = base + (size_t)(bb * NH + hd) * TPB * pitch;
#pragma unroll
            EPI_LOOP_ROWS { EPI_PIN; const int tp = tp0 + ai * HALF + m * 16;
                const f32x4 v0 = acc[ai][bj][m][0], v1 = acc[ai][bj][m][1];
                u32x4 w; w.x = cvt_pk_bf16(v0[0], v0[1]); w.y = cvt_pk_bf16(v0[2], v0[3]); w.z = cvt_pk_bf16(v1[0], v1[1]); w.w = cvt_pk_bf16(v1[2], v1[3]);
                *(u32x4*)((char*)hb + (unsigned)((tp * pitch + doff) * 2)) = w; } }
    }
};
}

template <int MAPQ>
__device__ __forceinline__ void p0_transpose_item(const float* W, int K, int ldw, int c0, int N, bf16* WT, LAS float* scr, int item, int lane) {
    const int nblk = N / 32, kb = item / nblk, nb = item % nblk, k0 = 64 * kb, n0 = 32 * nb;
#pragma unroll 8
    for (int i = 0; i < 32; ++i) { const int kk = 2 * i + (lane >> 5); scr[kk * 33 + (lane & 31)] = W[(size_t)(k0 + kk) * ldw + c0 + n0 + (lane & 31)]; }
    LDS_WAIT(); asm volatile("" ::: "memory");
    const int c = lane & 7;
#pragma unroll
    for (int j = 0; j < 4; ++j) { const int n = (lane >> 3) + 8 * j; const LAS float* s = scr + (8 * c) * 33 + n;
        v4u o; o.x = pk2(s[0 * 33], s[1 * 33]); o.y = pk2(s[2 * 33], s[3 * 33]); o.z = pk2(s[4 * 33], s[5 * 33]); o.w = pk2(s[6 * 33], s[7 * 33]);
        int nn = n0 + n;
        if (MAPQ) { const int hd = nn / QKD, d = nn - hd * QKD; if (d >= 64) { const int i = (d - 64) & 15, s2 = (d - 64) >> 4; nn = hd * QKD + 64 + 2 * i + s2; } }
        *(GAS v4u*)(WT + (size_t)nn * K + k0 + 8 * c) = o; }
    LDS_WAIT(); asm volatile("" ::: "memory");
}

__device__ __forceinline__ const float* karg(int i);
__device__ __forceinline__ void p0_prologue(Frame& F) {
    LAS float* scr = (LAS float*)(F.lds + F.wave * 16384);
    const int gw = F.vcu * NWAVES + F.wave, NGW = F.G * NWAVES;
    unsigned char* ws = F.ws;
    for (int l = 0; l < NLAYER; ++l) {
        const float* w_in = karg(7) + (size_t)l * DM * INC; const float* wbra = karg(24); const float* wbrb = karg(25); const float* wout = karg(26); const float* wuq = karg(21); const float* wukv = karg(23); const float* wup = karg(11); const float* aup = karg(13);
        constexpr int I_INA = (DM / 64) * (INA / 32), I_G = (DM / 64) * (DM / 32), I_BR = (RW / 64) * (DM / 32), I_UQ = (512 / 64) * (NQ / 32), I_UKV = (256 / 64) * (NKV / 32), I_LR = 1 * (RW / 32);
        constexpr int NIT = I_INA + 2 * I_G + 2 * I_BR + I_G + I_UQ + I_UKV + 4 * I_LR;
        for (int it = gw; it < NIT; it += NGW) {
            int r = it;
            if (r < I_INA) { p0_transpose_item<0>(w_in, DM, INC, 0, INA, (bf16*)(ws + WS_WINA) + (size_t)l * INA_P * DM, scr, r, F.lane); continue; } r -= I_INA;
            if (r < I_G) { p0_transpose_item<0>(w_in, DM, INC, INA, DM, (bf16*)(ws + WS_WGA) + (size_t)l * DM * DM, scr, r, F.lane); continue; } r -= I_G;
            if (r < I_G) { p0_transpose_item<0>(w_in, DM, INC, INA + DM, DM, (bf16*)(ws + WS_WGB) + (size_t)l * DM * DM, scr, r, F.lane); continue; } r -= I_G;
            if (r < I_BR) { p0_transpose_item<0>(wbra + (size_t)l * RW * DM, RW, DM, 0, DM, (bf16*)(ws + WS_WA) + (size_t)l * DM * RW, scr, r, F.lane); continue; } r -= I_BR;
            if (r < I_BR) { p0_transpose_item<0>(wbrb + (size_t)l * RW * DM, RW, DM, 0, DM, (bf16*)(ws + WS_WB) + (size_t)l * DM * RW, scr, r, F.lane); continue; } r -= I_BR;
            if (r < I_G) { p0_transpose_item<0>(wout + (size_t)l * DM * DM, DM, DM, 0, DM, (bf16*)(ws + WS_WO) + (size_t)l * DM * DM, scr, r, F.lane); continue; } r -= I_G;
            if (r < I_UQ) { p0_transpose_item<1>(wuq + (size_t)l * 512 * NQ, 512, NQ, 0, NQ, (bf16*)(ws + WS_WUQ) + (size_t)l * NQ * 512, scr, r, F.lane); continue; } r -= I_UQ;
            if (r < I_UKV) { p0_transpose_item<0>(wukv + (size_t)l * 256 * NKV, 256, NKV, 0, NKV, (bf16*)(ws + WS_WUKV) + (size_t)l * NKV * 256, scr, r, F.lane); continue; } r -= I_UKV;
            { const int which = r / I_LR, d = which & 1, isa = which >> 1; r -= which * I_LR;
              const float* src = (isa ? aup : wup) + (size_t)(l * 2 + d) * 64 * RW;
              bf16* dst = (bf16*)(ws + (isa ? WS_AUP : WS_WUP)) + (size_t)(l * 2 + d) * RW * 64;
              p0_transpose_item<0>(src, 64, RW, 0, RW, dst, scr, r, F.lane); }
        }
    }
    const int gt = gw * 64 + F.lane, NGT = NGW * 64;
    { const float* gup = karg(14);
    for (int i = gt; i < NLAYER * 2 * 32 * RW; i += NGT) { const int ch = i & 1023, r = (i >> 10) & 31, ld = i >> 15;
        ((bf16*)(ws + WS_GUP))[((size_t)ld * RW + ch) * 32 + r] = (bf16)f2bf(gup[i]); } }
    for (int i = gt; i < NLAYER * (INA_P - INA) * DM / 8; i += NGT) { const int l = i / ((INA_P - INA) * DM / 8), r = i - l * ((INA_P - INA) * DM / 8);
        ((GAS v4u*)((bf16*)(ws + WS_WINA) + ((size_t)l * INA_P + INA) * DM))[r] = (v4u){0u, 0u, 0u, 0u}; }
    { const GAS f32x4* xs = (const GAS f32x4*)karg(0); const GAS f32x4* cs = (const GAS f32x4*)karg(2); GAS f32x4* X = (GAS f32x4*)(ws + WS_X);
      for (int i = gt; i < MALL * (DM / 4); i += NGT) { const int m = i >> 9, c4 = i & 511, b = m / TPB, tp = m - b * TPB;
          X[i] = (tp < CTXL) ? cs[((size_t)(b * CTXL + tp) << 9) + c4] : xs[((size_t)(b * SEQ + tp - CTXL) << 9) + c4]; } }
    { f32x2* rt = (f32x2*)(ws + WS_ROPE);
      for (int i = gt; i < TPB * 16; i += NGT) { const int tp = i >> 4, k = i & 15; f32x2 o = {1.f, 0.f};
          if (tp >= CTXL) { const int t = tp - CTXL, row = t >> 6, col = t & 63, j = k & 7; const float fr = powf(10000.0f, -(float)j / 8.0f);
              const float ang = (float)(k < 8 ? row : col) * fr; o.x = cosf(ang); o.y = sinf(ang); }
          rt[i] = o; } }
    { float* modw = (float*)(ws + WS_CTL + CTL_MOD_OFF); const float* adaw = karg(4); const float* adab = karg(5); const float* cin = karg(1); const float* cctx = karg(3);
      LAS f32x4* part = (LAS f32x4*)F.lds;
      for (int uu = F.vcu; uu < NLAYER * 48; uu += F.G) { const int cb = uu % 48, l = uu / 48;
          const int n0 = cb * 256 + F.lane * 4; const float* aw = adaw + (size_t)l * DM * 12288 + n0;
          f32x4 a0 = {0, 0, 0, 0}, a1 = a0, a2 = a0;
#pragma unroll 8
          for (int k = F.wave * 256; k < F.wave * 256 + 256; ++k) { const f32x4 w = *(const GAS f32x4*)(aw + (size_t)k * 12288);
              const float c0 = cin[k], c1 = cin[DM + k], c2 = cctx[k];
              const float s0 = c0 / (1.f + __expf(-c0)), s1 = c1 / (1.f + __expf(-c1)), s2 = c2 / (1.f + __expf(-c2));
              a0 = a0 + w * s0; a1 = a1 + w * s1; a2 = a2 + w * s2; }
          __syncthreads();
          part[(F.wave * 3 + 0) * 64 + F.lane] = a0; part[(F.wave * 3 + 1) * 64 + F.lane] = a1; part[(F.wave * 3 + 2) * 64 + F.lane] = a2;
          __syncthreads();
          if (F.wave < 3) { f32x4 s = *(const GAS f32x4*)(adab + (size_t)l * 12288 + n0);
#pragma unroll
              for (int w8 = 0; w8 < 8; ++w8) s = s + part[(w8 * 3 + F.wave) * 64 + F.lane];
              *(GAS f32x4*)(modw + ((size_t)l * 3 + F.wave) * 12288 + n0) = s; }
          __syncthreads(); } }
    { LAS float* KEY = (LAS float*)F.lds;
      LAS float* WQT = (LAS float*)(F.lds + 65536);
      const float* pkeys = karg(29); const float* pwq = karg(28);
      __syncthreads();
      for (int uu = F.vcu; uu < NLAYER * 16 * 32; uu += F.G) { const int kb = uu & 31, hp = (uu >> 5) & 15, l = uu >> 9;
          const GAS f32x4* ksrc = (const GAS f32x4*)(pkeys + ((size_t)l * 16 + hp) * 16384);
          for (int i = F.tid; i < 4096; i += 512) ((LAS f32x4*)KEY)[i] = ksrc[i];
          for (int i = F.tid; i < 2048; i += 512) { const int kk = i >> 5, d4 = i & 31;
              *(LAS f32x4*)(WQT + kk * 132 + d4 * 4) = *(const GAS f32x4*)(pwq + ((size_t)l * DM + kb * 64 + kk) * DM + hp * 128 + d4 * 4); }
          __syncthreads();
          const int kk = F.tid & 63, kg = F.tid >> 6;
          float acc[16];
#pragma unroll
          for (int j = 0; j < 16; ++j) acc[j] = 0.f;
          for (int d = 0; d < 128; d += 4) { const f32x4 w = *(LAS f32x4*)(WQT + kk * 132 + d);
#pragma unroll
              for (int j = 0; j < 16; ++j) { const f32x4 q = *(LAS f32x4*)(KEY + (kg * 16 + j) * 128 + d); acc[j] += q.x * w.x + q.y * w.y + q.z * w.z + q.w * w.w; } }
          bf16* dst = (bf16*)(ws + WS_WQK) + ((size_t)l * DM + hp * 128 + kg * 16) * DM + kb * 64 + kk;
#pragma unroll
          for (int j = 0; j < 16; ++j) dst[(size_t)j * DM] = (bf16)f2bf(acc[j]);
          __syncthreads(); } }
}

__device__ __forceinline__ void modnorm_phase(Frame& F, const float* X, const float* g, const float* mod  , int chunk_sh, bf16* H, int skip_ctx) {
    const int gw = F.vcu * NWAVES + F.wave, NGW = F.G * NWAVES;
    for (int m = gw; m < MALL; m += NGW) {
        const int b = m / TPB, tp = m - b * TPB; if (skip_ctx && tp < CTXL) continue;
        const int mr = tp < CTXL ? 2 : b;
        const GAS f32x4* xr = (const GAS f32x4*)(X + (size_t)m * DM) + F.lane;
        f32x4 v[8]; float s = 0.f;
#pragma unroll
        for (int j = 0; j < 8; ++j) { v[j] = xr[64 * j]; s += (v[j].x * v[j].x + v[j].y * v[j].y) + (v[j].z * v[j].z + v[j].w * v[j].w); }
        const float rs = rsqrtf(wave_sum(s) * (1.f / DM) + NORM_EPS);
        const float* sh = mod + (size_t)mr * 12288 + chunk_sh * DM; const float* sc = sh + DM;
        GAS v2u* o8 = (GAS v2u*)(H + (size_t)m * DM) + F.lane;
#pragma unroll
        for (int j = 0; j < 8; ++j) { const int c = (F.lane + 64 * j) * 4;
            const f32x4 gg = *(const GAS f32x4*)(g + c), s1 = *(const GAS f32x4*)(sc + c), s0 = *(const GAS f32x4*)(sh + c);
            f32x4 y = v[j] * rs * gg; y = y * (s1 + 1.0f) + s0;
            v2u o; o.x = pk2(y.x, y.y); o.y = pk2(y.z, y.w); o8[64 * j] = o; }
    }
}

typedef float f32x4v __attribute__((ext_vector_type(4)));
#define MFMA16(a, b, c) __builtin_amdgcn_mfma_f32_16x16x32_bf16((a), (b), (c), 0, 0, 0)
#define MFMA32(a, b, c) __builtin_amdgcn_mfma_f32_32x32x16_bf16((a), (b), (c), 0, 0, 0)

struct FeatP {
    const bf16* PA; const float* mu; const float* w0; const float* a0; const float* k_k; const float* k_a; const float* r_k;
    const bf16* WUP; const bf16* AUP; const bf16* GUP;
    const float* qnorm; const float* kvnorm; const f32x2* rope;
    bf16* RI; bf16* GG; float* BON; bf16* QN; bf16* KVN; bf16* K;
};
__device__ __forceinline__ f32x4 ld4bf(const bf16* p) { const v2u w = *(const GAS v2u*)p; return (f32x4){bflo(w.x), bfhi(w.x), bflo(w.y), bfhi(w.y)}; }
__device__ __forceinline__ f32x4 mix4(const bf16* PA, int m, int c, bool hp, bool hn, const float* mu) {
    const f32x4 pc = ld4bf(PA + (size_t)m * INA_P + c);
    f32x4 pp = {0, 0, 0, 0}, pn = {0, 0, 0, 0};
    if (hp) pp = ld4bf(PA + (size_t)(m - 1) * INA_P + c);
    if (hn) pn = ld4bf(PA + (size_t)(m + 1) * INA_P + c);
    const f32x4 mm = *(const GAS f32x4*)(mu + c);
    return pc + ((pp + pn) * 0.5f - pc) * mm;
}
__device__ __forceinline__ void unpack8(const v4u w, float (&x)[8]) { x[0] = bflo(w.x); x[1] = bfhi(w.x); x[2] = bflo(w.y); x[3] = bfhi(w.y); x[4] = bflo(w.z); x[5] = bfhi(w.z); x[6] = bflo(w.w); x[7] = bfhi(w.w); }
__device__ __forceinline__ v4u pack8f(const float (&x)[8]) { v4u o; o.x = pk2(x[0], x[1]); o.y = pk2(x[2], x[3]); o.z = pk2(x[4], x[5]); o.w = pk2(x[6], x[7]); return o; }
__device__ __forceinline__ void mix8(const bf16* rowc, bool hp, bool hn, const float (&mu)[8], float (&o)[8]) {
    const v4u zc = {0u, 0u, 0u, 0u};
    const v4u wc = *(const GAS v4u*)rowc, wp = hp ? *(const GAS v4u*)(rowc - INA_P) : zc, wn = hn ? *(const GAS v4u*)(rowc + INA_P) : zc;
    float c[8], p[8], n[8]; unpack8(wc, c); unpack8(wp, p); unpack8(wn, n);
#pragma unroll
    for (int e = 0; e < 8; ++e) o[e] = c[e] + (0.5f * (p[e] + n[e]) - c[e]) * mu[e];
}
__device__ __forceinline__ void features_phase(Frame& F, const FeatP& P) {
    constexpr int LAP = 328;
    LAS bf16* LA = (LAS bf16*)F.lds;
    LAS float* SSQ = (LAS float*)(F.lds + 10752);
    LAS float* PRM = (LAS float*)(F.lds + 12288);
    const int lane = F.lane, w = F.wave, tk = lane & 15, q4 = lane >> 4;
    constexpr int NTILE = MALL / 16, NTG = 64;
    for (int su = F.vcu; su < 4 * NTG; su += F.G) {
        const int cg = su & 3, tg = su >> 2, cw = 256 * cg + 32 * w, ch8 = cw + 8 * q4, hd = 4 * cg + (w >> 1);
        __syncthreads();
        for (int i = F.tid; i < 2560; i += 512) { const int prm = i >> 8, c = (i & 255) + 256 * cg; float v;
            switch (prm) { case 0: v = P.k_k[c]; break; case 1: v = P.k_a[c]; break; case 2: v = P.r_k[c]; break; case 3: v = P.w0[c]; break; case 4: v = P.w0[RW + c]; break;
                           case 5: v = P.a0[c]; break; case 6: v = P.a0[RW + c]; break; case 7: v = P.mu[c]; break; case 8: v = P.mu[RW + c]; break; default: v = P.mu[2 * RW + c]; break; }
            PRM[i] = v; }
        bf16x8 fw[2][2][2], fa[2][2][2], fg[2][2];
        { const int chA = cw + 8 * (tk >> 2) + (tk & 3);
#pragma unroll
          for (int d = 0; d < 2; ++d)
#pragma unroll
              for (int t = 0; t < 2; ++t) {
#pragma unroll
                  for (int ks = 0; ks < 2; ++ks) { fw[d][t][ks] = *(const GAS bf16x8*)(P.WUP + ((size_t)d * RW + chA + 4 * t) * 64 + ks * 32 + q4 * 8); fa[d][t][ks] = *(const GAS bf16x8*)(P.AUP + ((size_t)d * RW + chA + 4 * t) * 64 + ks * 32 + q4 * 8); }
                  fg[d][t] = *(const GAS bf16x8*)(P.GUP + ((size_t)d * RW + chA + 4 * t) * 32 + q4 * 8); } }
        for (int tt = tg; tt < NTILE; tt += NTG) {
            const int m0 = tt * 16;
            __syncthreads();
            for (int it = F.tid; it < 640; it += 512) { const int tkk = it / 40, c8 = (it - tkk * 40) * 8, c = C_WD + c8, m = m0 + tkk, tp = m % TPB;
                const bool hp = (tp != 0) && (tp != CTXL), hn = (tp != CTXL - 1) && (tp != TPB - 1);
                float mu[8], v[8];
                { const f32x4 a = *(const GAS f32x4*)(P.mu + c), b2 = *(const GAS f32x4*)(P.mu + c + 4); mu[0] = a.x; mu[1] = a.y; mu[2] = a.z; mu[3] = a.w; mu[4] = b2.x; mu[5] = b2.y; mu[6] = b2.z; mu[7] = b2.w; }
                mix8(P.PA + (size_t)m * INA_P + c, hp, hn, mu, v);
#pragma unroll
                for (int e = 0; e < 8; ++e) { if (c < C_AD) v[e] = tanhf(v[e]); else if (c >= C_GD) v[e] = sigmoidf_(v[e]); }
                *(LAS v4u*)(LA + tkk * LAP + c8) = pack8f(v); }
            if ((tt & 3) == cg) {
#pragma unroll
                for (int t2 = 0; t2 < 2; ++t2) { const int m = m0 + 2 * w + t2, b = m / TPB, tp = m - b * TPB; const bf16* row = P.PA + (size_t)m * INA_P;
                    { float x[8]; unpack8(*(const GAS v4u*)(row + C_QC + lane * 8), x); float s = 0.f;
#pragma unroll
                      for (int e = 0; e < 8; ++e) s += x[e] * x[e];
                      const float rs = rsqrtf(wave_sum(s) * (1.f / 512.f) + NORM_EPS);
#pragma unroll
                      for (int e = 0; e < 8; ++e) x[e] = x[e] * rs * P.qnorm[lane * 8 + e];
                      *(GAS v4u*)(P.QN + (size_t)m * 512 + lane * 8) = pack8f(x); }
                    { const v2u q = *(const GAS v2u*)(row + C_KVC + lane * 4);
                      float x[4] = {bflo(q.x), bfhi(q.x), bflo(q.y), bfhi(q.y)}; float s = 0.f;
#pragma unroll
                      for (int e = 0; e < 4; ++e) s += x[e] * x[e];
                      const float rs = rsqrtf(wave_sum(s) * (1.f / 256.f) + NORM_EPS);
#pragma unroll
                      for (int e = 0; e < 4; ++e) x[e] = x[e] * rs * P.kvnorm[lane * 4 + e];
                      v2u o; o.x = pk2(x[0], x[1]); o.y = pk2(x[2], x[3]);
                      *(GAS v2u*)(P.KVN + (size_t)m * 256 + lane * 4) = o; }
                    if (lane < 16) { const float x1 = bf1(row[C_KR + lane]), x2 = bf1(row[C_KR + 16 + lane]); const f32x2 cs = P.rope[(size_t)tp * 16 + lane];
                        const unsigned o = pk2(x1 * cs.x - x2 * cs.y, x1 * cs.y + x2 * cs.x);
#pragma unroll
                        for (int h2 = 0; h2 < NH; ++h2) *(GAS unsigned*)(P.K + ((size_t)(b * NH + h2) * TPB + tp) * QKD + 64 + 2 * lane) = o; } } }
            const int m = m0 + tk, b = m / TPB, tp = m - b * TPB;
            const bool hp = (tp != 0) && (tp != CTXL), hn = (tp != CTXL - 1) && (tp != TPB - 1);
            const bf16* rowp = P.PA + (size_t)m * INA_P + ch8;
            const int pc = 32 * w + 8 * q4;
            float prm[8], kmx[8], kx[8];
#pragma unroll
            for (int e = 0; e < 8; ++e) prm[e] = PRM[8 * 256 + pc + e];
            mix8(rowp + RW, hp, hn, prm, kmx);
            { float s = 0.f;
#pragma unroll
              for (int e = 0; e < 8; ++e) { kx[e] = kmx[e] * PRM[0 * 256 + pc + e]; s += kx[e] * kx[e]; }
              s += bpermf(lane ^ 16, s); s += bpermf(lane ^ 32, s);
              if (q4 == 0) SSQ[tk * 8 + w] = s; }
            __syncthreads();
            const float rsn = rsqrtf(SSQ[tk * 8 + w] + SSQ[tk * 8 + (w ^ 1)] + 1e-12f);
            f32x4 cw_[2][2], ca_[2][2], cg_[2][2];
#pragma unroll
            for (int d = 0; d < 2; ++d) {
                const bf16x8 bg = *(const LAS bf16x8*)(LA + tk * LAP + 256 + d * 32 + q4 * 8);
                bf16x8 bw[2], ba[2];
#pragma unroll
                for (int ks = 0; ks < 2; ++ks) { bw[ks] = *(const LAS bf16x8*)(LA + tk * LAP + d * 64 + ks * 32 + q4 * 8); ba[ks] = *(const LAS bf16x8*)(LA + tk * LAP + 128 + d * 64 + ks * 32 + q4 * 8); }
#pragma unroll
                for (int t = 0; t < 2; ++t) { f32x4 z = {0, 0, 0, 0};
                    cw_[d][t] = MFMA16(fw[d][t][1], bw[1], MFMA16(fw[d][t][0], bw[0], z));
                    ca_[d][t] = MFMA16(fa[d][t][1], ba[1], MFMA16(fa[d][t][0], ba[0], z));
                    cg_[d][t] = MFMA16(fg[d][t], bg, z); } }
            float r8[8], v8[8], kk8[8];
#pragma unroll
            for (int e = 0; e < 8; ++e) prm[e] = PRM[7 * 256 + pc + e];
            mix8(rowp, hp, hn, prm, r8);
#pragma unroll
            for (int e = 0; e < 8; ++e) prm[e] = PRM[9 * 256 + pc + e];
            mix8(rowp + 2 * RW, hp, hn, prm, v8);
#pragma unroll
            for (int e = 0; e < 8; ++e) kk8[e] = kx[e] * rsn;
            bf16* rec = P.RI + ((size_t)(b * NH + hd) * TPB + tp) * RREC + (ch8 & 63);
            *(GAS v4u*)(rec) = pack8f(r8); *(GAS v4u*)(rec + 64) = pack8f(kk8); *(GAS v4u*)(rec + 128) = pack8f(v8);
#pragma unroll
            for (int d = 0; d < 2; ++d) {
                float ld[8], ke[8], bb[8], gg[8]; float bs = 0.f;
#pragma unroll
                for (int e = 0; e < 8; ++e) { const int t = e >> 2, r = e & 3;
                    ld[e] = -0.60653066f * sigmoidf_(PRM[(3 + d) * 256 + pc + e] + cw_[d][t][r]);
                    const float aa = sigmoidf_(PRM[(5 + d) * 256 + pc + e] + ca_[d][t][r]);
                    ke[e] = kmx[e] * (1.0f + (aa - 1.0f) * PRM[1 * 256 + pc + e]); bb[e] = kk8[e] * aa; gg[e] = cg_[d][t][r];
                    bs += r8[e] * ke[e] * PRM[2 * 256 + pc + e]; }
                *(GAS v4u*)(rec + (3 + 3 * d) * 64) = pack8f(ld); *(GAS v4u*)(rec + (4 + 3 * d) * 64) = pack8f(bb); *(GAS v4u*)(rec + (5 + 3 * d) * 64) = pack8f(ke);
                *(GAS v4u*)(P.GG + ((size_t)d * MALL + m) * RW + ch8) = pack8f(gg);
                bs += bpermf(lane ^ 16, bs); bs += bpermf(lane ^ 32, bs);
                if (q4 == 0) P.BON[((size_t)d * MALL + m) * 32 + 2 * hd + (w & 1)] = bs; }
        }
    }
}

constexpr int SCH = 32;
constexpr int SSTEP = 6 * 64;
__device__ __forceinline__ int scan_tp(int dir, int s) { return dir == 0 ? s : (s < CTXL ? (CTXL - 1 - s) : (TPB - 1 - (s - CTXL))); }
__device__ __forceinline__ void scan_load(v4u (&rg)[6], const bf16* RIh, int dir, int chunk, int htid) {
    const int tp = scan_tp(dir, chunk * SCH + (htid >> 3));
    const bf16* rec = RIh + (size_t)tp * RREC + (htid & 7) * 8;
#pragma unroll
    for (int i = 0; i < 3; ++i) rg[i] = *(const GAS v4u*)(rec + i * 64);
    rec += (3 + 3 * dir) * 64;
#pragma unroll
    for (int i = 0; i < 3; ++i) rg[3 + i] = *(const GAS v4u*)(rec + i * 64);
}
__device__ __forceinline__ void scan_store(const v4u (&rg)[6], LAS float* buf, int htid) {
    LAS float* d0 = buf + (htid >> 3) * SSTEP + (htid & 7) * 8;
#pragma unroll
    for (int i = 0; i < 6; ++i) { constexpr int SLOT[6] = {4, 0, 5, 2, 1, 3};
        const v4u wv = rg[i];
        f32x4 lo = {bflo(wv.x), bfhi(wv.x), bflo(wv.y), bfhi(wv.y)}, hi = {bflo(wv.z), bfhi(wv.z), bflo(wv.w), bfhi(wv.w)};
        if (i == 3) {
#pragma unroll
            for (int e = 0; e < 4; ++e) { lo[e] = __expf(lo[e]); hi[e] = __expf(hi[e]); } }
        LAS float* d = d0 + SLOT[i] * 64;
        *(LAS f32x4*)d = lo; *(LAS f32x4*)(d + 4) = hi; }
}
__device__ __forceinline__ void scan_phase(Frame& F, const bf16* RI, bf16* Y) {
    LAS float* bufs = (LAS float*)F.lds;
    constexpr int NCH = TPB / SCH;
    for (int uu = F.vcu; uu < NBATCH * NH * 2 * 4; uu += F.G) {
        const int rg = uu & 3, dir = (uu >> 2) & 1, hd = (uu >> 3) & 15, b = uu >> 7;
        const bf16* RIh = RI + (size_t)(b * NH + hd) * TPB * RREC;
        const int htid = F.tid - 256;
        v4u ra[6], rb[6];
        __syncthreads();
        if (F.wave >= 4) { scan_load(rb, RIh, dir, 0, htid); scan_load(ra, RIh, dir, 1, htid); scan_store(rb, bufs, htid); scan_load(rb, RIh, dir, 2, htid); }
        __syncthreads();
        const int j = F.lane & 15, rowl = F.lane >> 4, row = rg * 16 + (F.wave & 3) * 4 + rowl;
        f32x2 S01 = {0.f, 0.f}, S23 = {0.f, 0.f};
        bf16* yb = Y + ((size_t)dir * MALL + (size_t)b * TPB) * RW + hd * 64 + row;
        for (int c = 0; c < NCH; ++c) {
            LAS float* cur = bufs + (c & 1) * (SCH * SSTEP);
            if (F.wave >= 4) {
                if (c + 1 < NCH) {
                    if ((c & 1) == 0) { scan_store(ra, bufs + (SCH * SSTEP), htid); if (c + 3 < NCH) scan_load(ra, RIh, dir, c + 3, htid); }
                    else { scan_store(rb, bufs, htid); if (c + 3 < NCH) scan_load(rb, RIh, dir, c + 3, htid); } } }
            else {
#pragma unroll
                for (int h16 = 0; h16 < 2; ++h16) {
                    const LAS float* sp = cur + (h16 * 16) * SSTEP;
                    f32x4 kk = *(const LAS f32x4*)(sp + 4 * j), bb = *(const LAS f32x4*)(sp + 64 + 4 * j), ww = *(const LAS f32x4*)(sp + 128 + 4 * j),
                          ke = *(const LAS f32x4*)(sp + 192 + 4 * j), rr = *(const LAS f32x4*)(sp + 256 + 4 * j);
                    float vv = sp[320 + row], ykeep = 0.f, ypart = 0.f;
#pragma unroll
                    for (int st = 0; st < 16; ++st) {
                        f32x4 nkk = kk, nbb = bb, nww = ww, nke = ke, nrr = rr; float nvv = vv;
                        if (st + 1 < 16) { const LAS float* sn = sp + (st + 1) * SSTEP;
                            nkk = *(const LAS f32x4*)(sn + 4 * j); nbb = *(const LAS f32x4*)(sn + 64 + 4 * j); nww = *(const LAS f32x4*)(sn + 128 + 4 * j);
                            nke = *(const LAS f32x4*)(sn + 192 + 4 * j); nrr = *(const LAS f32x4*)(sn + 256 + 4 * j); nvv = sn[320 + row]; }
                        f32x2 t2 = S01 * kk.xy; t2 = S23 * kk.zw + t2;
                        const float p = t2.x + t2.y;
                        S01 = S01 * ww.xy + ke.xy * vv; S23 = S23 * ww.zw + ke.zw * vv;
                        const float sa = -red16(p);
                        S01 = bb.xy * sa + S01; S23 = bb.zw * sa + S23;
                        if (st > 0) { const float y = red16(ypart); ykeep = (j == st - 1) ? y : ykeep; }
                        f32x2 u2 = S01 * rr.xy; u2 = S23 * rr.zw + u2;
                        ypart = u2.x + u2.y;
                        kk = nkk; bb = nbb; ww = nww; ke = nke; rr = nrr; vv = nvv;
                        __builtin_amdgcn_sched_barrier(0);
                    }
                    { const float y = red16(ypart); ykeep = (j == 15) ? y : ykeep; }
                    const int tp = scan_tp(dir, c * SCH + h16 * 16 + j);
                    *(GAS bf16*)(yb + (size_t)tp * RW) = (bf16)f2bf(ykeep);
                }
            }
            __syncthreads();
        }
    }
}

constexpr int AKP = 208, AVP = 192;
constexpr int ATILE = 64 * AKP + 64 * AVP;
__device__ __forceinline__ bf16x8 pack8(const f32x16& x, int s) {
    v4u p; p.x = pk2(x[8 * s + 0], x[8 * s + 1]); p.y = pk2(x[8 * s + 2], x[8 * s + 3]); p.z = pk2(x[8 * s + 4], x[8 * s + 5]); p.w = pk2(x[8 * s + 6], x[8 * s + 7]);
    return __builtin_bit_cast(bf16x8, p);
}
__device__ __forceinline__ void attn_phase(Frame& F, const bf16* Q, const bf16* K, const bf16* V, bf16* YB, int with_ctx) {
    const int lane = F.lane, half = lane >> 5, l31 = lane & 31, l16 = lane & 15, g1 = (lane >> 4) & 1;
    const int nunits = NBATCH * NH * 32 + (with_ctx ? NBATCH * NH : 0);
    for (int uu = F.vcu; uu < nunits; uu += F.G) {
        int bh, q0, nkt;
        if (uu < NBATCH * NH * 32) { bh = uu >> 5; q0 = CTXL + (uu & 31) * 256; nkt = TPB / 64; } else { bh = uu - NBATCH * NH * 32; q0 = 0; nkt = CTXL / 64; }
        const bf16* Kh = K + (size_t)bh * TPB * QKD; const bf16* Vh = V + (size_t)bh * TPB * 64; const bf16* Qh = Q + (size_t)bh * TPB * QKD;
        const int tq = q0 + F.wave * 32 + l31;
        bf16x8 qf[6];
#pragma unroll
        for (int ks = 0; ks < 6; ++ks) qf[ks] = *(const GAS bf16x8*)(Qh + (size_t)tq * QKD + 16 * ks + 8 * half);
        f32x16 o0, o1;
#pragma unroll
        for (int i = 0; i < 16; ++i) { o0[i] = 0.f; o1[i] = 0.f; }
        float m_run = -1e30f, l_run = 0.f;
        const int kc1 = F.tid + 512; const bool k1ok = kc1 < 768;
        const unsigned kd0 = (unsigned)((F.tid / 12) * AKP + (F.tid % 12) * 16), kd1 = (unsigned)((kc1 / 12) * AKP + (kc1 % 12) * 16), vd = (unsigned)(64 * AKP + (F.tid >> 3) * AVP + (F.tid & 7) * 16);
        v4u kr0, kr1 = {0, 0, 0, 0}, vr;
        kr0 = *(const GAS v4u*)(Kh + (size_t)F.tid * 8); if (k1ok) kr1 = *(const GAS v4u*)(Kh + (size_t)kc1 * 8); vr = *(const GAS v4u*)(Vh + (size_t)F.tid * 8);
        __syncthreads();
        *(LAS v4u*)(F.lds + kd0) = kr0; if (k1ok) *(LAS v4u*)(F.lds + kd1) = kr1; *(LAS v4u*)(F.lds + vd) = vr;
        __syncthreads();
        for (int kt = 0; kt < nkt; ++kt) {
            const bool more = kt + 1 < nkt;
            if (more) { const bf16* kn = Kh + (size_t)(kt + 1) * 64 * QKD; const bf16* vn = Vh + (size_t)(kt + 1) * 64 * 64;
                kr0 = *(const GAS v4u*)(kn + (size_t)F.tid * 8); if (k1ok) kr1 = *(const GAS v4u*)(kn + (size_t)kc1 * 8); vr = *(const GAS v4u*)(vn + (size_t)F.tid * 8); }
            LAS unsigned char* Kb = F.lds + (kt & 1) * ATILE; LAS unsigned char* Vb = Kb + 64 * AKP;
            f32x16 s0, s1;
#pragma unroll
            for (int i = 0; i < 16; ++i) { s0[i] = 0.f; s1[i] = 0.f; }
#pragma unroll
            for (int ks = 0; ks < 6; ++ks) {
                const bf16x8 a0 = *(const LAS bf16x8*)(Kb + l31 * AKP + (16 * ks + 8 * half) * 2), a1 = *(const LAS bf16x8*)(Kb + (32 + l31) * AKP + (16 * ks + 8 * half) * 2);
                s0 = MFMA32(a0, qf[ks], s0); s1 = MFMA32(a1, qf[ks], s1); }
            float mx = s0[0];
#pragma unroll
            for (int i = 1; i < 16; ++i) mx = fmaxf(mx, s0[i]);
#pragma unroll
            for (int i = 0; i < 16; ++i) mx = fmaxf(mx, s1[i]);
            mx = fmaxf(mx, bpermf(lane ^ 32, mx));
            const float m_new = fmaxf(m_run, mx), alpha = __builtin_amdgcn_exp2f(m_run - m_new); m_run = m_new;
            float ps = 0.f;
#pragma unroll
            for (int i = 0; i < 16; ++i) { s0[i] = __builtin_amdgcn_exp2f(s0[i] - m_new); s1[i] = __builtin_amdgcn_exp2f(s1[i] - m_new); ps += s0[i] + s1[i]; }
            l_run = l_run * alpha + ps;
#pragma unroll
            for (int i = 0; i < 16; ++i) { o0[i] *= alpha; o1[i] *= alpha; }
#pragma unroll
            for (int t = 0; t < 2; ++t)
#pragma unroll
                for (int s = 0; s < 2; ++s) {
                    const bf16x8 pf = pack8(t == 0 ? s0 : s1, s);
                    const int kb = 32 * t + 16 * s + 4 * half + (l16 >> 2);
#pragma unroll
                    for (int dvt = 0; dvt < 2; ++dvt) {
                        const LAS unsigned char* vp = Vb + kb * AVP + (32 * dvt + 16 * g1 + 4 * (l16 & 3)) * 2;
                        const s16x4 lo = __builtin_amdgcn_ds_read_tr16_b64_v4i16((LAS s16x4*)vp), hi = __builtin_amdgcn_ds_read_tr16_b64_v4i16((LAS s16x4*)(vp + 8 * AVP));
                        const bf16x8 va = __builtin_shufflevector(lo, hi, 0, 1, 2, 3, 4, 5, 6, 7);
                        if (dvt == 0) o0 = MFMA32(va, pf, o0); else o1 = MFMA32(va, pf, o1); } }
            if (more) { LAS unsigned char* nb = F.lds + ((kt + 1) & 1) * ATILE;
                *(LAS v4u*)(nb + kd0) = kr0; if (k1ok) *(LAS v4u*)(nb + kd1) = kr1; *(LAS v4u*)(nb + vd) = vr; }
            __syncthreads();
        }
        const float linv = (DBG_SKIP & 4) ? 0.f : 1.0f / (l_run + bpermf(lane ^ 32, l_run));
        const int b = bh >> 4, hd = bh & 15;
        bf16* op = YB + ((size_t)b * TPB + tq) * RW + hd * 64 + 4 * half;
#pragma unroll
        for (int g = 0; g < 4; ++g) {
            v2u w; w.x = pk2(o0[4 * g] * linv, o0[4 * g + 1] * linv); w.y = pk2(o0[4 * g + 2] * linv, o0[4 * g + 3] * linv); *(GAS v2u*)(op + 8 * g) = w;
            w.x = pk2(o1[4 * g] * linv, o1[4 * g + 1] * linv); w.y = pk2(o1[4 * g + 2] * linv, o1[4 * g + 3] * linv); *(GAS v2u*)(op + 32 + 8 * g) = w; }
    }
}

__device__ __forceinline__ void readout_phase(Frame& F, const bf16* Y, const bf16* GG, const float* BON, const bf16* RI, const float* ln_w, const float* ln_b, bf16* YA) {
    const int gw = F.vcu * NWAVES + F.wave, NGW = F.G * NWAVES, lane = F.lane, hd = lane >> 2, ch0 = hd * 64 + (lane & 3) * 16;
    for (int m = gw; m < MALL; m += NGW) {
        const int b = m / TPB, tp = m - b * TPB;
        const bf16* rec = RI + ((size_t)(b * NH + hd) * TPB + tp) * RREC + 128 + (lane & 3) * 16;
        float vv[16], out[16];
        { const v4u a = *(const GAS v4u*)rec, c = *(const GAS v4u*)(rec + 8);
          vv[0] = bflo(a.x); vv[1] = bfhi(a.x); vv[2] = bflo(a.y); vv[3] = bfhi(a.y); vv[4] = bflo(a.z); vv[5] = bfhi(a.z); vv[6] = bflo(a.w); vv[7] = bfhi(a.w);
          vv[8] = bflo(c.x); vv[9] = bfhi(c.x); vv[10] = bflo(c.y); vv[11] = bfhi(c.y); vv[12] = bflo(c.z); vv[13] = bfhi(c.z); vv[14] = bflo(c.w); vv[15] = bfhi(c.w); }
#pragma unroll
        for (int e = 0; e < 16; ++e) out[e] = 0.f;
#pragma unroll
        for (int d = 0; d < 2; ++d) {
            const bf16* yp = Y + ((size_t)d * MALL + m) * RW + ch0; const bf16* gp = GG + ((size_t)d * MALL + m) * RW + ch0;
            float y[16], g[16];
            { const v4u a = *(const GAS v4u*)yp, c = *(const GAS v4u*)(yp + 8);
              y[0] = bflo(a.x); y[1] = bfhi(a.x); y[2] = bflo(a.y); y[3] = bfhi(a.y); y[4] = bflo(a.z); y[5] = bfhi(a.z); y[6] = bflo(a.w); y[7] = bfhi(a.w);
              y[8] = bflo(c.x); y[9] = bfhi(c.x); y[10] = bflo(c.y); y[11] = bfhi(c.y); y[12] = bflo(c.z); y[13] = bfhi(c.z); y[14] = bflo(c.w); y[15] = bfhi(c.w); }
            { const v4u a = *(const GAS v4u*)gp, c = *(const GAS v4u*)(gp + 8);
              g[0] = bflo(a.x); g[1] = bfhi(a.x); g[2] = bflo(a.y); g[3] = bfhi(a.y); g[4] = bflo(a.z); g[5] = bfhi(a.z); g[6] = bflo(a.w); g[7] = bfhi(a.w);
              g[8] = bflo(c.x); g[9] = bfhi(c.x); g[10] = bflo(c.y); g[11] = bfhi(c.y); g[12] = bflo(c.z); g[13] = bfhi(c.z); g[14] = bflo(c.w); g[15] = bfhi(c.w); }
            float s = 0.f;
#pragma unroll
            for (int e = 0; e < 16; ++e) s += y[e];
            s = dpp_add<0xB1>(s); s = dpp_add<0x4E>(s);
            const float mean = s * (1.f / 64.f); float q = 0.f;
#pragma unroll
            for (int e = 0; e < 16; ++e) { y[e] -= mean; q += y[e] * y[e]; }
            q = dpp_add<0xB1>(q); q = dpp_add<0x4E>(q);
            const float rstd = rsqrtf(q * (1.f / 64.f) + 64e-5f), bon = BON[((size_t)d * MALL + m) * 32 + 2 * hd] + BON[((size_t)d * MALL + m) * 32 + 2 * hd + 1];
#pragma unroll
            for (int e = 0; e < 16; ++e) out[e] += (y[e] * rstd * ln_w[ch0 + e] + ln_b[ch0 + e] + bon * vv[e]) * g[e];
        }
        if (DBG_SKIP & 2) {
#pragma unroll
            for (int e = 0; e < 16; ++e) out[e] = 0.f; }
        v4u o0, o1;
        o0.x = pk2(out[0], out[1]); o0.y = pk2(out[2], out[3]); o0.z = pk2(out[4], out[5]); o0.w = pk2(out[6], out[7]);
        o1.x = pk2(out[8], out[9]); o1.y = pk2(out[10], out[11]); o1.z = pk2(out[12], out[13]); o1.w = pk2(out[14], out[15]);
        *(GAS v4u*)(YA + (size_t)m * RW + ch0) = o0; *(GAS v4u*)(YA + (size_t)m * RW + ch0 + 8) = o1;
    }
}

__device__ __forceinline__ unsigned f2key(float f) { const unsigned u = __builtin_bit_cast(unsigned, f); return (u & 0x80000000u) ? ~u : (u | 0x80000000u); }
__device__ __forceinline__ float key2f(unsigned k) { const unsigned u = (k & 0x80000000u) ? (k & 0x7fffffffu) : ~k; return __builtin_bit_cast(float, u); }
template <int CTRL, int RM> __device__ __forceinline__ unsigned dpp_umax(unsigned x) {
    const unsigned y = (unsigned)__builtin_amdgcn_update_dpp((int)x, (int)x, CTRL, RM, 0xf, false); return x > y ? x : y; }
__device__ __forceinline__ void half_max(unsigned x, unsigned& m0, unsigned& m1) {
    x = dpp_umax<0xB1, 0xf>(x); x = dpp_umax<0x4E, 0xf>(x); x = dpp_umax<0x141, 0xf>(x); x = dpp_umax<0x140, 0xf>(x); x = dpp_umax<0x142, 0xa>(x);
    m0 = (unsigned)__builtin_amdgcn_readlane((int)x, 31); m1 = (unsigned)__builtin_amdgcn_readlane((int)x, 63);
}
__device__ __forceinline__ unsigned top16_lists(const float* sh  , int lane) {
    const int half = lane >> 5, l5 = lane & 31;
    unsigned k0, k1, k2, k3, rec = 0u;
    { const float* p = sh + half * 128 + l5;
      k0 = (f2key(p[0]) & ~127u) | (unsigned)l5; k1 = (f2key(p[32]) & ~127u) | (unsigned)(l5 + 32); k2 = (f2key(p[64]) & ~127u) | (unsigned)(l5 + 64); k3 = (f2key(p[96]) & ~127u) | (unsigned)(l5 + 96); }
#pragma unroll 4
    for (int it = 0; it < 16; ++it) {
        unsigned a = k0 > k1 ? k0 : k1, b = k2 > k3 ? k2 : k3; a = a > b ? a : b;
        unsigned m0, m1; half_max(a, m0, m1);
        const unsigned mh = half ? m1 : m0;
        k0 = (k0 == mh) ? 0u : k0; k1 = (k1 == mh) ? 0u : k1; k2 = (k2 == mh) ? 0u : k2; k3 = (k3 == mh) ? 0u : k3;
        rec = (l5 == it) ? mh : rec;
    }
    return rec;
}
struct SelP { const float* SC; int* ESEL; float* EGATE; const float* pu; const float* pv; unsigned char* PU8; unsigned char* PV8; float* SU; float* SV; int last; };
__device__ __forceinline__ void cvt_row_load(f32x4 (&x)[2][4], const float* src) {
#pragma unroll
    for (int j = 0; j < 2; ++j)
#pragma unroll
        for (int q = 0; q < 4; ++q) x[j][q] = *(const GAS f32x4*)(src + j * 1024 + q * 4);
}
__device__ __forceinline__ void cvt_row_store(const f32x4 (&x)[2][4], unsigned char* dst, float* scale_slot, int lane) {
    float am = 0.f;
#pragma unroll
    for (int j = 0; j < 2; ++j)
#pragma unroll
        for (int q = 0; q < 4; ++q) am = fmaxf(am, fmaxf(fmaxf(fabsf(x[j][q].x), fabsf(x[j][q].y)), fmaxf(fabsf(x[j][q].z), fabsf(x[j][q].w))));
    am = wave_max_u(am);
    int ex = 0; (void)frexpf(fmaxf(am, 1e-30f), &ex);
    const float sc = ldexpf(1.0f, 8 - ex), inv = ldexpf(1.0f, ex - 8);
#pragma unroll
    for (int j = 0; j < 2; ++j) { v4u o;
#pragma unroll
        for (int q = 0; q < 4; ++q) { int w = 0;
            w = __builtin_amdgcn_cvt_pk_fp8_f32(x[j][q].x * sc, x[j][q].y * sc, w, false);
            w = __builtin_amdgcn_cvt_pk_fp8_f32(x[j][q].z * sc, x[j][q].w * sc, w, true);
            o[q] = (unsigned)w; }
        *(GAS v4u*)(dst + j * 1024) = o; }
    if (lane == 0) *scale_slot = inv;
}
__device__ __forceinline__ void select_phase(Frame& F, const SelP& P) {
    const int gw = F.vcu * NWAVES + F.wave, NGW = F.G * NWAVES, lane = F.lane, half = lane >> 5, l5 = lane & 31;
    int crow = gw;
    for (int m = gw; m < MALL || crow < 2 * NEXP; m += NGW) {
        f32x4 xa[2][4], xb[2][4];
        const int r0 = crow, r1 = crow + NGW; const bool c0 = r0 < 2 * NEXP, c1 = r1 < 2 * NEXP; crow += 2 * NGW;
        if (c0) cvt_row_load(xa, ((r0 >= NEXP) ? P.pv + (size_t)(r0 - NEXP) * DM : P.pu + (size_t)r0 * DM) + lane * 16);
        if (c1) cvt_row_load(xb, ((r1 >= NEXP) ? P.pv + (size_t)(r1 - NEXP) * DM : P.pu + (size_t)r1 * DM) + lane * 16);
        bool tok = m < MALL; int tp = 0; if (tok) { tp = m % TPB; if (P.last && tp < CTXL) tok = false; }
        if (tok) {
            const float* srow = P.SC + (size_t)m * DM;
#pragma unroll 1
            for (int hp = 0; hp < 4; ++hp) {
                const unsigned recA = top16_lists(srow + (2 * hp) * 256, lane), recB = top16_lists(srow + (2 * hp + 1) * 256, lane);
                const float vA = key2f(recA & ~127u), vB = key2f(recB & ~127u);
                const float v1a = bpermf(l5 & 15, vA), v1b = bpermf(l5 & 15, vB); const float v1 = half ? v1b : v1a;
                unsigned ck[8];
#pragma unroll
                for (int e = 0; e < 8; ++e) { const int src = 32 + 8 * (l5 >> 4) + e; const float v2a = bpermf(src, vA), v2b = bpermf(src, vB);
                    ck[e] = (f2key(v1 + (half ? v2b : v2a)) & ~255u) | (unsigned)(l5 | (e << 5)); }
                unsigned rec = 0u;
#pragma unroll 2
                for (int it = 0; it < 16; ++it) {
                    unsigned a = ck[0] > ck[1] ? ck[0] : ck[1], b = ck[2] > ck[3] ? ck[2] : ck[3], c = ck[4] > ck[5] ? ck[4] : ck[5], d = ck[6] > ck[7] ? ck[6] : ck[7];
                    a = a > b ? a : b; c = c > d ? c : d; a = a > c ? a : c;
                    unsigned m0, m1; half_max(a, m0, m1);
                    const unsigned mh = half ? m1 : m0;
#pragma unroll
                    for (int e = 0; e < 8; ++e) ck[e] = (ck[e] == mh) ? 0u : ck[e];
                    rec = (l5 == it) ? mh : rec;
                }
                const float ts = key2f(rec & ~255u), tmax = half ? bpermf(32, ts) : bpermf(0, ts);
                float ev = (l5 < 16) ? __expf(ts - tmax) : 0.f;
                const float esum = red16(ev);
                const int cid = (int)(rec & 255u), ci = cid & 15, cj = ((cid >> 4) & 1) * 8 + (cid >> 5);
                const int i1a = bpermi(ci, (int)(recA & 127u)), i1b = bpermi(ci, (int)(recB & 127u)), i2a = bpermi(32 + cj, (int)(recA & 127u)), i2b = bpermi(32 + cj, (int)(recB & 127u));
                const int expert = (half ? i1b : i1a) * 128 + (half ? i2b : i2a);
                if (l5 < 16) { const int slot = (2 * hp + half) * 16 + l5; P.ESEL[(size_t)m * 128 + slot] = expert; P.EGATE[(size_t)m * 128 + slot] = ev / esum; }
            }
        }
        if (c0) cvt_row_store(xa, ((r0 >= NEXP) ? P.PV8 + (size_t)(r0 - NEXP) * DM : P.PU8 + (size_t)r0 * DM) + lane * 16, (r0 >= NEXP) ? P.SV + (r0 - NEXP) : P.SU + r0, lane);
        if (c1) cvt_row_store(xb, ((r1 >= NEXP) ? P.PV8 + (size_t)(r1 - NEXP) * DM : P.PU8 + (size_t)r1 * DM) + lane * 16, (r1 >= NEXP) ? P.SV + (r1 - NEXP) : P.SU + r1, lane);
    }
}
struct PeerP { const int* ESEL; const float* EGATE; const bf16* H; const unsigned char* PU; const unsigned char* PV; const float* SU; const float* SV; float* X; const float* mod;   const float* fin_g; float* out; int last; };
__device__ __forceinline__ void peer_phase(Frame& F, const PeerP& P) {
    const int gw = F.vcu * NWAVES + F.wave, NGW = F.G * NWAVES, lane = F.lane;
    float pr_s2 = 0.f, pr_d2 = 0.f, pr_tg = 0.f, pr_n = 0.f;
    for (int m = gw; m < MALL; m += NGW) {
        const int b = m / TPB, tp = m - b * TPB; if (P.last && tp < CTXL) continue;
        const int mr = tp < CTXL ? 2 : b;
        const int eidx[2] = {P.ESEL[(size_t)m * 128 + lane], P.ESEL[(size_t)m * 128 + 64 + lane]}; const float egate[2] = {P.EGATE[(size_t)m * 128 + lane], P.EGATE[(size_t)m * 128 + 64 + lane]};
        f32x2 hf[16];
#pragma unroll
        for (int j = 0; j < 2; ++j) { const v4u a = *(const GAS v4u*)(P.H + (size_t)m * DM + j * 1024 + lane * 16), c = *(const GAS v4u*)(P.H + (size_t)m * DM + j * 1024 + lane * 16 + 8);
            hf[8 * j + 0] = (f32x2){bflo(a.x), bfhi(a.x)}; hf[8 * j + 1] = (f32x2){bflo(a.y), bfhi(a.y)}; hf[8 * j + 2] = (f32x2){bflo(a.z), bfhi(a.z)}; hf[8 * j + 3] = (f32x2){bflo(a.w), bfhi(a.w)};
            hf[8 * j + 4] = (f32x2){bflo(c.x), bfhi(c.x)}; hf[8 * j + 5] = (f32x2){bflo(c.y), bfhi(c.y)}; hf[8 * j + 6] = (f32x2){bflo(c.z), bfhi(c.z)}; hf[8 * j + 7] = (f32x2){bflo(c.w), bfhi(c.w)}; }
        float coef[2];
#pragma unroll
        for (int sl = 0; sl < 2; ++sl) {
            float mydot = 0.f;
#pragma unroll 1
            for (int e0 = 0; e0 < 64; e0 += 8) {
                v4u u[8][2]; float rsc[8];
#pragma unroll
                for (int q = 0; q < 8; ++q) { const int ex = __builtin_amdgcn_readlane(eidx[sl], e0 + q); const unsigned char* ur = P.PU + (size_t)ex * DM + lane * 16;
                    u[q][0] = *(const GAS v4u*)ur; u[q][1] = *(const GAS v4u*)(ur + 1024); rsc[q] = P.SU[ex]; }
#pragma unroll
                for (int q = 0; q < 8; ++q) { f32x2 s2 = {0.f, 0.f};
#pragma unroll
                    for (int j = 0; j < 2; ++j)
#pragma unroll
                        for (int d = 0; d < 4; ++d) { const int w = (int)u[q][j][d];
                            s2 = __builtin_amdgcn_cvt_pk_f32_fp8(w, false) * hf[8 * j + 2 * d] + s2; s2 = __builtin_amdgcn_cvt_pk_f32_fp8(w, true) * hf[8 * j + 2 * d + 1] + s2; }
                    const float tot = wave_sum_u(s2.x + s2.y) * rsc[q];
                    if (lane == e0 + q) mydot = tot; }
            }
            if (DBG_PROBE) pr_d2 += wave_sum_u(mydot * mydot) * (1.f / 128.f);
            coef[sl] = egate[sl] * 0.5f * mydot * (1.0f + erff(mydot * 0.70710678f));
            if ((DBG_SKIP & 16) && sl == 0) coef[sl] = 0.f;
            if ((DBG_SKIP & 32) && sl == 1) coef[sl] = 0.f;
        }
        f32x2 acc2[16];
#pragma unroll
        for (int i = 0; i < 16; ++i) acc2[i] = (f32x2){0.f, 0.f};
#pragma unroll
        for (int sl = 0; sl < 2; ++sl) {
#pragma unroll 1
            for (int e0 = 0; e0 < 64; e0 += 8) {
                v4u u[8][2]; float cf[8];
#pragma unroll
                for (int q = 0; q < 8; ++q) { const int ex = __builtin_amdgcn_readlane(eidx[sl], e0 + q); const unsigned char* vr = P.PV + (size_t)ex * DM + lane * 16;
                    u[q][0] = *(const GAS v4u*)vr; u[q][1] = *(const GAS v4u*)(vr + 1024);
                    cf[q] = __builtin_bit_cast(float, __builtin_amdgcn_readlane(__builtin_bit_cast(int, coef[sl]), e0 + q)) * P.SV[ex]; }
#pragma unroll
                for (int q = 0; q < 8; ++q)
#pragma unroll
                    for (int j = 0; j < 2; ++j)
#pragma unroll
                        for (int d = 0; d < 4; ++d) { const int w = (int)u[q][j][d];
                            acc2[8 * j + 2 * d] = __builtin_amdgcn_cvt_pk_f32_fp8(w, false) * cf[q] + acc2[8 * j + 2 * d];
                            acc2[8 * j + 2 * d + 1] = __builtin_amdgcn_cvt_pk_f32_fp8(w, true) * cf[q] + acc2[8 * j + 2 * d + 1]; }
            }
        }
        float acc[32];
#pragma unroll
        for (int i = 0; i < 16; ++i) { acc[2 * i] = acc2[i].x; acc[2 * i + 1] = acc2[i].y; }
        if (DBG_SKIP & 1) {
#pragma unroll
            for (int i = 0; i < 32; ++i) acc[i] = 0.f; }
        if (((DBG_SKIP & 64) && !P.last) || ((DBG_SKIP & 128) && P.last)) {
#pragma unroll
            for (int i = 0; i < 32; ++i) acc[i] = 0.f; }
        if (DBG_SKIP & 8) {
#pragma unroll
            for (int i = 0; i < 32; ++i) acc[i] = -acc[i]; }
        float* xr = P.X + (size_t)m * DM; const float* g2 = P.mod + (size_t)mr * 12288 + 5 * DM;
        float ss = 0.f;
#pragma unroll
        for (int j = 0; j < 2; ++j)
#pragma unroll
            for (int hq = 0; hq < 4; ++hq) { const int c = j * 1024 + lane * 16 + hq * 4;
                f32x4 xv = *(const GAS f32x4*)(xr + c); const f32x4 gv = *(const GAS f32x4*)(g2 + c);
#pragma unroll
                for (int e = 0; e < 4; ++e) { xv[e] += gv[e] * acc[16 * j + 4 * hq + e]; ss += xv[e] * xv[e]; acc[16 * j + 4 * hq + e] = xv[e]; }
                if (!P.last) *(GAS f32x4*)(xr + c) = xv; }
        if (P.last) { const float rs = rsqrtf(wave_sum(ss) * (1.f / DM) + NORM_EPS); float* orow = P.out + ((size_t)b * SEQ + (tp - CTXL)) * DM;
#pragma unroll
            for (int j = 0; j < 2; ++j)
#pragma unroll
                for (int hq = 0; hq < 4; ++hq) { const int c = j * 1024 + lane * 16 + hq * 4; const f32x4 fg = *(const GAS f32x4*)(P.fin_g + c);
                    f32x4 o;
#pragma unroll
                    for (int e = 0; e < 4; ++e) o[e] = acc[16 * j + 4 * hq + e] * rs * fg[e];
                    *(GAS f32x4*)(orow + c) = o; } }
    }
    if (DBG_PROBE && !P.last && lane == 0) { float* pp = (float*)(F.ws + WS_CTL + CTL_PROBE_OFF) + gw * 4; pp[0] = pr_s2; pp[1] = pr_d2; pp[2] = pr_tg; pp[3] = pr_n; }
}

constexpr int PH_PER_LAYER = 12, NPHASE = 1 + NLAYER * PH_PER_LAYER;
#ifndef ONLY_PHASE
#define ONLY_PHASE -1
#endif
#define T0() (wave_s == 0 && pg8::opaque_lane() == 0)
#define PH_ON(k) (ONLY_PHASE < 0 || ONLY_PHASE == (k))
#define GEMM_CALL(EPI, SCHED, g, S, E) pg8::gemm_phase<EPI, SCHED, true, true>(F.lds, g, S, E, wave_s)
#define GEMM_CALL_NA(EPI, SCHED, g, S, E) pg8::gemm_phase<EPI, SCHED, false, true>(F.lds, g, S, E, wave_s)

__device__ __forceinline__ const float* karg(int i) {
    asm volatile("" : "+s"(i));
    const __attribute__((address_space(4))) unsigned long long* ka = (const __attribute__((address_space(4))) unsigned long long*)__builtin_amdgcn_kernarg_segment_ptr();
    return (const float*)ka[i];
}
__global__ void __launch_bounds__(NWAVES * 64, 2) mk_fwd(Args args) {
    extern __shared__ __attribute__((aligned(16))) unsigned char lds[];
    Frame F;
    F.lds = (LAS unsigned char*)lds; F.ws = args.ws;
    const int wave_s = __builtin_amdgcn_readfirstlane((int)threadIdx.x >> 6);
    F.tid = threadIdx.x; F.lane = F.tid & 63; F.wave = wave_s;
    F.G = gridDim.x; { const int bx = blockIdx.x; F.vcu = (F.G % 8 == 0) ? (bx % 8) * (F.G / 8) + bx / 8 : bx; }
    unsigned char* ws = args.ws;
    volatile LAS unsigned* MISC = (volatile LAS unsigned*)(F.lds + MISC_OFF);
    for (int u = F.tid; u < (LDS_BYTES - LDSCTL_OFF) / 4; u += NWAVES * 64) ((LAS unsigned*)(F.lds + LDSCTL_OFF))[u] = 0u;
    __syncthreads();
    const int lo = args.ph_lo, hi = args.ph_hi;
    XcdBarrier bar; bar.bar = (unsigned*)(ws + WS_CTL) + CW_BAR; bar.x = 0; bar.st = nullptr;
    if (hi - lo > 1) bar = xcd_barrier_post((unsigned*)(ws + WS_CTL) + CW_BAR, MISC + 8, T0());
#define IN(k) (lo <= (k) && (k) < hi)
#define REFRAME() do { const int lz_ = pg8::opaque_lane(); F.lane = lz_; F.tid = wave_s * 64 + lz_; F.wave = wave_s; ws = (unsigned char*)karg(34); F.ws = ws; { int g_ = (int)gridDim.x, b_ = (int)blockIdx.x; asm volatile("" : "+s"(g_), "+s"(b_)); bx = b_; F.G = g_; F.vcu = ((g_ & 7) == 0) ? (b_ & 7) * (g_ >> 3) + (b_ >> 3) : b_; } } while (0)
#define SEAM(k) do { if (IN((k) + 1)) xcd_barrier(bar, T0()); } while (0)
#define XBUF ((float*)(ws + WS_X))
#define HBUF ((bf16*)(ws + WS_H))
#define MODP ((const float*)(ws + WS_CTL + CTL_MOD_OFF) + (size_t)l * 3 * 12288)
    int bx = (int)blockIdx.x;

    if (PH_ON(100) && IN(0)) { REFRAME(); p0_prologue(F); SEAM(0); }

    for (int l = 0; l < NLAYER; ++l) {
        const int base = 1 + l * PH_PER_LAYER;
        const int last = (l == NLAYER - 1);
        for (int rep_ = 0; rep_ < ((DBG_REPEAT == 0) ? 2 : 1); ++rep_) if (PH_ON(0) && IN(base + 0)) { REFRAME(); if (rep_) xcd_barrier(bar, T0()); modnorm_phase(F, XBUF, karg(6) + (size_t)l * DM, MODP, 0, HBUF, 0); SEAM(base + 0); }
        for (int rep_ = 0; rep_ < ((DBG_REPEAT == 1) ? 2 : 1); ++rep_) if (PH_ON(1) && IN(base + 1)) { REFRAME(); if (rep_) xcd_barrier(bar, T0());
            pg8::Gemm g{HBUF, (const bf16*)(ws + WS_WINA) + (size_t)l * INA_P * DM, MALL, INA_P, DM}; pg8::RowOrder S; S.init_rows(0, INA_P, F.G, bx);
            pg8::EpiStoreBf16 E{(bf16*)(ws + WS_PA), INA_P};
            GEMM_CALL(pg8::EpiStoreBf16, pg8::RowOrder, g, S, E);
            SEAM(base + 1); }
        for (int rep_ = 0; rep_ < ((DBG_REPEAT == 2) ? 2 : 1); ++rep_) if (PH_ON(2) && IN(base + 2)) { REFRAME(); if (rep_) xcd_barrier(bar, T0());
            FeatP P;
            P.PA = (const bf16*)(ws + WS_PA); P.mu = karg(9) + (size_t)l * RWC; P.w0 = karg(10) + (size_t)l * 2 * RW; P.a0 = karg(12) + (size_t)l * 2 * RW;
            P.k_k = karg(15) + (size_t)l * RW; P.k_a = karg(16) + (size_t)l * RW; P.r_k = karg(17) + (size_t)l * RW;
            P.WUP = (const bf16*)(ws + WS_WUP) + (size_t)l * 2 * RW * 64; P.AUP = (const bf16*)(ws + WS_AUP) + (size_t)l * 2 * RW * 64; P.GUP = (const bf16*)(ws + WS_GUP) + (size_t)l * 2 * RW * 32;
            P.qnorm = karg(20) + (size_t)l * 512; P.kvnorm = karg(22) + (size_t)l * 256; P.rope = (const f32x2*)(ws + WS_ROPE);
            P.RI = (bf16*)(ws + WS_RI); P.GG = (bf16*)(ws + WS_GG); P.BON = (float*)(ws + WS_BON); P.QN = (bf16*)(ws + WS_QN); P.KVN = (bf16*)(ws + WS_KVN); P.K = (bf16*)(ws + WS_K);
            features_phase(F, P);
            SEAM(base + 2); }
        for (int rep_ = 0; rep_ < ((DBG_REPEAT == 3) ? 2 : 1); ++rep_) if (PH_ON(3) && IN(base + 3)) { REFRAME(); if (rep_) xcd_barrier(bar, T0());
            { pg8::Gemm g{(const bf16*)(ws + WS_QN), (const bf16*)(ws + WS_WUQ) + (size_t)l * NQ * 512, MALL, NQ, 512};
              pg8::EpiQ E{(bf16*)(ws + WS_Q), (const f32x2*)(ws + WS_ROPE), 0.14724444f};
              pg8::RowOrder S; S.init_rows(last, NQ, F.G, bx); GEMM_CALL_NA(pg8::EpiQ, pg8::RowOrder, g, S, E); }
            { pg8::Gemm g{(const bf16*)(ws + WS_KVN), (const bf16*)(ws + WS_WUKV) + (size_t)l * NKV * 256, MALL, NKV, 256}; pg8::RowOrder S; S.init_rows(0, NKV, F.G, bx);
              pg8::EpiKV E{(bf16*)(ws + WS_K), (bf16*)(ws + WS_V)};
              GEMM_CALL_NA(pg8::EpiKV, pg8::RowOrder, g, S, E); }
            SEAM(base + 3); }
        for (int rep_ = 0; rep_ < ((DBG_REPEAT == 4) ? 2 : 1); ++rep_) if (PH_ON(4) && IN(base + 4)) { REFRAME(); if (rep_) xcd_barrier(bar, T0()); scan_phase(F, (const bf16*)(ws + WS_RI), (bf16*)(ws + WS_Y)); SEAM(base + 4); }
        for (int rep_ = 0; rep_ < ((DBG_REPEAT == 5) ? 2 : 1); ++rep_) if (PH_ON(5) && IN(base + 5)) { REFRAME(); if (rep_) xcd_barrier(bar, T0());
            attn_phase(F, (const bf16*)(ws + WS_Q), (const bf16*)(ws + WS_K), (const bf16*)(ws + WS_V), (bf16*)(ws + WS_YB), !last);
            readout_phase(F, (const bf16*)(ws + WS_Y), (const bf16*)(ws + WS_GG), (const float*)(ws + WS_BON), (const bf16*)(ws + WS_RI), karg(18) + (size_t)l * RW, karg(19) + (size_t)l * RW, (bf16*)(ws + WS_YA));
            SEAM(base + 5); }
        for (int rep_ = 0; rep_ < ((DBG_REPEAT == 6) ? 2 : 1); ++rep_) if (PH_ON(6) && IN(base + 6)) { REFRAME(); if (rep_) xcd_barrier(bar, T0());
            bf16* T1 = (bf16*)(ws + WS_T1); bf16* T2 = (bf16*)(ws + WS_T2);
            const pg8::Gemm g1{HBUF, (const bf16*)(ws + WS_WGA) + (size_t)l * DM * DM, MALL, DM, DM}, g2{(const bf16*)(ws + WS_YA), (const bf16*)(ws + WS_WA) + (size_t)l * DM * RW, MALL, DM, RW};
            const pg8::Gemm g3{HBUF, (const bf16*)(ws + WS_WGB) + (size_t)l * DM * DM, MALL, DM, DM}, g4{(const bf16*)(ws + WS_YB), (const bf16*)(ws + WS_WB) + (size_t)l * DM * RW, MALL, DM, RW};
            const pg8::EpiGate E1{T1, DM, karg(8) + (size_t)l * 2 * DM}, E3{T2, DM, karg(8) + (size_t)l * 2 * DM + DM};
            const pg8::EpiMulAdd E2{T1, T1, nullptr, DM}, E4{T1, T2, T1, DM};
            pg8::RowOrder S; S.init_rows(last, DM, F.G, bx);
            GEMM_CALL(pg8::EpiGate, pg8::RowOrder, g1, S, E1); GEMM_CALL(pg8::EpiMulAdd, pg8::RowOrder, g2, S, E2); GEMM_CALL(pg8::EpiGate, pg8::RowOrder, g3, S, E3); GEMM_CALL(pg8::EpiMulAdd, pg8::RowOrder, g4, S, E4);
            SEAM(base + 6); }
        for (int rep_ = 0; rep_ < ((DBG_REPEAT == 7) ? 2 : 1); ++rep_) if (PH_ON(7) && IN(base + 7)) { REFRAME(); if (rep_) xcd_barrier(bar, T0());
            const pg8::Gemm g{(const bf16*)(ws + WS_T1), (const bf16*)(ws + WS_WO) + (size_t)l * DM * DM, MALL, DM, DM};
            const pg8::EpiResid E{XBUF, MODP + 2 * DM};
            pg8::RowOrder S; S.init_rows(last, DM, F.G, bx); GEMM_CALL(pg8::EpiResid, pg8::RowOrder, g, S, E);
            SEAM(base + 7); }
        for (int rep_ = 0; rep_ < ((DBG_REPEAT == 8) ? 2 : 1); ++rep_) if (PH_ON(8) && IN(base + 8)) { REFRAME(); if (rep_) xcd_barrier(bar, T0());
            modnorm_phase(F, XBUF, karg(27) + (size_t)l * DM, MODP, 3, HBUF, last);
            SEAM(base + 8); }
        for (int rep_ = 0; rep_ < ((DBG_REPEAT == 9) ? 2 : 1); ++rep_) if (PH_ON(9) && IN(base + 9)) { REFRAME(); if (rep_) xcd_barrier(bar, T0());
            const pg8::Gemm g{HBUF, (const bf16*)(ws + WS_WQK) + (size_t)l * DM * DM, MALL, DM, DM};
            const pg8::EpiF32 E{(float*)(ws + WS_SC), DM};
            pg8::RowOrder S; S.init_rows(last, DM, F.G, bx); GEMM_CALL(pg8::EpiF32, pg8::RowOrder, g, S, E);
            SEAM(base + 9); }
        for (int rep_ = 0; rep_ < ((DBG_REPEAT == 10) ? 2 : 1); ++rep_) if (PH_ON(10) && IN(base + 10)) { REFRAME(); if (rep_) xcd_barrier(bar, T0());
            SelP P; P.SC = (const float*)(ws + WS_SC); P.ESEL = (int*)(ws + WS_T1); P.EGATE = (float*)(ws + WS_T1 + 16 * MiB);
            P.pu = karg(30) + (size_t)l * NEXP * DM; P.pv = karg(31) + (size_t)l * NEXP * DM; P.PU8 = ws + WS_PU; P.PV8 = ws + WS_PU + (size_t)NEXP * DM; P.SU = (float*)(ws + WS_PV); P.SV = (float*)(ws + WS_PV) + NEXP; P.last = last;
            select_phase(F, P);
            SEAM(base + 10); }
        for (int rep_ = 0; rep_ < ((DBG_REPEAT == 11) ? 2 : 1); ++rep_) if (PH_ON(11) && IN(base + 11)) { REFRAME(); if (rep_) xcd_barrier(bar, T0());
            PeerP P; P.ESEL = (const int*)(ws + WS_T1); P.EGATE = (const float*)(ws + WS_T1 + 16 * MiB); P.H = HBUF; P.PU = ws + WS_PU; P.PV = ws + WS_PU + (size_t)NEXP * DM; P.SU = (const float*)(ws + WS_PV); P.SV = (const float*)(ws + WS_PV) + NEXP; P.X = XBUF; P.mod = MODP; P.fin_g = karg(32); P.out = (float*)karg(33); P.last = last;
            peer_phase(F, P);
            SEAM(base + 11); }
    }
#undef IN
#undef SEAM
#undef XBUF
#undef HBUF
#undef MODP
}

__global__ void __launch_bounds__(512) dbg_fill(const float* pp, float* o) {
    float s0 = 0.f, s1 = 0.f, s2 = 0.f, s3 = 0.f;
    for (int i = 0; i < 2048; ++i) { s0 += pp[4 * i]; s1 += pp[4 * i + 1]; s2 += pp[4 * i + 2]; s3 += pp[4 * i + 3]; }
    const float v = DBG_PROBE == 1 ? 10.f * sqrtf(s0 / s3) : DBG_PROBE == 2 ? 10.f * sqrtf(s1 / s3) : 100.f * s2 / s3;
    for (size_t i = (size_t)blockIdx.x * 512 + threadIdx.x; i < (size_t)NBATCH * SEQ * DM; i += (size_t)gridDim.x * 512) o[i] = v;
}
extern "C" void kernel_launch(void* const* d_in, const int* in_sizes, int n_in, void* d_out, int out_size, void* d_ws, size_t ws_size, hipStream_t stream) {
    static int grid = 0;
    if (grid == 0) {
        if (n_in != 33 || out_size != NBATCH * SEQ * DM || ws_size < WS_END) { fprintf(stderr, "kernel_launch: unexpected shapes (n_in %d out %d ws %zu)\n", n_in, out_size, ws_size); grid = -1; return; }
        int dev = 0, cus = 0, per_cu = 0;
        if (hipGetDevice(&dev) != hipSuccess || hipDeviceGetAttribute(&cus, hipDeviceAttributeMultiprocessorCount, dev) != hipSuccess) { grid = -1; return; }
        if (hipFuncSetAttribute((const void*)mk_fwd, hipFuncAttributeMaxDynamicSharedMemorySize, LDS_BYTES) != hipSuccess) { fprintf(stderr, "kernel_launch: hipFuncSetAttribute failed\n"); grid = -1; return; }
        if (hipOccupancyMaxActiveBlocksPerMultiprocessor(&per_cu, (const void*)mk_fwd, NWAVES * 64, LDS_BYTES) != hipSuccess || per_cu < 1) { fprintf(stderr, "kernel_launch: occupancy query says %d\n", per_cu); (void)hipGetLastError(); grid = -1; return; }
        grid = cus;
    }
    if (grid < 0) return;
    if (hipMemsetAsync((char*)d_ws + WS_CTL, 0, CTL_ZERO_BYTES, stream) != hipSuccess) return;
    Args a{};
    for (int i = 0; i < 33; ++i) a.in[i] = (const float*)d_in[i];
    a.out = (float*)d_out; a.ws = (unsigned char*)d_ws;
#if MK_N_LAUNCHES == 1
    a.ph_lo = 0; a.ph_hi = NPHASE;
    hipLaunchKernelGGL(mk_fwd, dim3(grid), dim3(NWAVES * 64), LDS_BYTES, stream, a);
#else
    for (int p = 0; p < NPHASE; ++p) { a.ph_lo = p; a.ph_hi = p + 1; hipLaunchKernelGGL(mk_fwd, dim3(grid), dim3(NWAVES * 64), LDS_BYTES, stream, a); }
    if (DBG_PROBE) hipLaunchKernelGGL(dbg_fill, dim3(1024), dim3(512), 0, stream, (const float*)((char*)d_ws + WS_CTL + CTL_PROBE_OFF), (float*)d_out);
#endif
}
```

```cpp
#include <hip/hip_runtime.h>
#include <cstdio>
#include <cstdint>

#ifndef MK_N_LAUNCHES
#define MK_N_LAUNCHES 1
#endif

#ifndef DBG_SKIP
#define DBG_SKIP 0
#endif
#ifndef DBG_PROBE
#define DBG_PROBE 0
#endif
#ifndef DBG_REPEAT
#define DBG_REPEAT -1
#endif
namespace pg8 {
#define PG8_LAS __attribute__((address_space(3)))
typedef unsigned short bf16_t;
typedef short bf16x8 __attribute__((ext_vector_type(8)));
typedef float f32x4 __attribute__((ext_vector_type(4)));
typedef unsigned u32x4 __attribute__((ext_vector_type(4)));
constexpr int BM = 256, BK = 64, HALF = 128, HTB = HALF * BK * 2  , STAGE_BYTES = 8 * HTB, NXCD = 8, WGM = 8;

__host__ __device__ __forceinline__ int lds_byte(int r, int c) { const int st = (r >> 4) * 2 + (c >> 5), rr = r & 15, cc = c & 31, ob = rr * 64 + cc * 2; return st * 1024 + (ob ^ (((ob >> 9) & 1) << 5)); }
__host__ __device__ __forceinline__ void stage_rc(int b, int& R, int& C) { const int st = b / 1024, sb = b % 1024, swz = sb ^ (((sb >> 9) & 1) << 5); R = (st >> 1) * 16 + swz / 64; C = (st & 1) * 32 + (swz % 64) / 2; }
__host__ __device__ __forceinline__ int perm32(int rho) { const int n = rho >> 4, i = rho & 15; return 8 * (i >> 2) + 4 * n + (i & 3); }

struct Unit { int pm, pn; };
struct Gemm { const bf16_t* A; const bf16_t* Bt; int M, N, K; };

struct StaticOrder {
    int nM, nN, nwg, G, c;
    __host__ __device__ void init(int M, int N, int G_, int c_) { nM = M / BM; nN = N / BM; nwg = nM * nN; G = G_; c = c_; }
    __host__ __device__ bool next(int i, Unit& u) const {
        const long L = (long)i * G + c; if (L >= nwg) return false;
        int wgid = (int)L; { const int q = nwg / NXCD, r = nwg % NXCD, xcd = wgid % NXCD, off = wgid / NXCD; wgid = (xcd < r ? xcd * (q + 1) : r * (q + 1) + (xcd - r) * q) + off; }
        const int nig = WGM * nN, gid = wgid / nig, fm = gid * WGM, gsz = (nM - fm) < WGM ? (nM - fm) : WGM;
        u.pm = fm + ((wgid % nig) % gsz); u.pn = (wgid % nig) / gsz; return true;
    }
    __device__ __forceinline__ void a_ready(const Unit&) const {}
    __device__ __forceinline__ void done(const Unit&) const {}
};
__device__ __forceinline__ int opaque_lane() { int l; asm volatile("v_mbcnt_lo_u32_b32 %0, -1, 0\n\tv_mbcnt_hi_u32_b32 %0, -1, %0" : "=v"(l)); return l; }
typedef __bf16 bf16x2c __attribute__((ext_vector_type(2)));
__device__ __forceinline__ unsigned cvt_pk_bf16(float lo, float hi) { const bf16x2c v = {(__bf16)lo, (__bf16)hi}; return __builtin_bit_cast(unsigned, v); }
template <class Epi, class Sched, bool ALIGN_EPI = false, bool SP2 = false>
__device__ __forceinline__ void gemm_phase(PG8_LAS unsigned char* lds, const Gemm g, const Sched& S, const Epi& E, const int wave_s) {
    const int lane_ = opaque_lane();
    const int wid = wave_s, lane = lane_, tid = wid * 64 + lane, wr = wid >> 2, wc = wid & 3, fr = lane & 15, fq = lane >> 4;
    const int K = g.K, nt = K / BK;
    unsigned voffA[2], voffB[2];
#pragma unroll
    for (int i = 0; i < 2; ++i) { int R, C; stage_rc(tid * 16 + i * 8192, R, C); const int Rb = Epi::PERM ? ((R & ~31) + perm32(R & 31)) : R;
        voffA[i] = (unsigned)(R * K + C) * 2u; voffB[i] = (unsigned)(Rb * K + C) * 2u; }
    const size_t kstep = (size_t)(BK * 2);
    const size_t hstep = (size_t)HALF * K * 2;
    const size_t tstep = 2 * hstep;
    const unsigned ldsw = (unsigned)wid * 1024u;
    const int aoff = lds_byte(wr * 64 + fr, fq * 8), boff = lds_byte(wc * 32 + fr, fq * 8);
#define PG8_SA(b, h) (((b) * 2 + (h)) * HTB)
#define PG8_SB(b, h) ((4 + (b) * 2 + (h)) * HTB)
#define PG8_STAGE(bufoff, gbase, voff) do { _Pragma("unroll") for (int _i = 0; _i < 2; ++_i) \
        __builtin_amdgcn_global_load_lds((const unsigned*)((const char*)(gbase) + (voff)[_i]), (PG8_LAS unsigned*)(lds + (bufoff) + ldsw + _i * 8192), 16, 0, 0); } while (0)
#define PG8_LDA(dst, b, h) do { _Pragma("unroll") for (int m = 0; m < 4; ++m) _Pragma("unroll") for (int k = 0; k < 2; ++k) dst[m][k] = *(const PG8_LAS bf16x8*)(lds + PG8_SA(b, h) + aoff + m * 2048 + k * 1024); } while (0)
#define PG8_LDB(dst, b, h) do { _Pragma("unroll") for (int n = 0; n < 2; ++n) _Pragma("unroll") for (int k = 0; k < 2; ++k) dst[n][k] = *(const PG8_LAS bf16x8*)(lds + PG8_SB(b, h) + boff + n * 2048 + k * 1024); } while (0)
#define PG8_MMA(ai, bj, At, Bt) do { __builtin_amdgcn_s_setprio(1); _Pragma("unroll") for (int m = 0; m < 4; ++m) _Pragma("unroll") for (int n = 0; n < 2; ++n) _Pragma("unroll") for (int k = 0; k < 2; ++k) \
        acc[ai][bj][m][n] = __builtin_amdgcn_mfma_f32_16x16x32_bf16(Bt[n][k], At[m][k], acc[ai][bj][m][n], 0, 0, 0); __builtin_amdgcn_s_setprio(0); } while (0)
#define PG8_WAIT_V(n) asm volatile("s_waitcnt vmcnt(" #n ")" ::: "memory")
#define PG8_WAIT_L(n) asm volatile("s_waitcnt lgkmcnt(" #n ")" ::: "memory")
#define PG8_BAR __builtin_amdgcn_s_barrier()
#define PG8_SCHED __builtin_amdgcn_sched_barrier(0)
    Unit cur, nxt; int ui = 0;
    if (!S.next(0, cur)) return;
    f32x4 acc[2][2][4][2];
#pragma unroll
    for (int a = 0; a < 2; ++a)
#pragma unroll
        for (int b = 0; b < 2; ++b)
#pragma unroll
            for (int m = 0; m < 4; ++m)
#pragma unroll
                for (int n = 0; n < 2; ++n) acc[a][b][m][n] = (f32x4){0.f, 0.f, 0.f, 0.f};
    bf16x8 At[4][2], B0[2][2], B1[2][2];
    const char* cA = (const char*)g.A + (size_t)cur.pm * tstep; const char* cB = (const char*)g.Bt + (size_t)cur.pn * tstep;
    S.a_ready(cur);
    if constexpr (SP2) {
        PG8_STAGE(PG8_SB(0, 0), cB, voffB); PG8_STAGE(PG8_SB(0, 1), cB + hstep, voffB); PG8_STAGE(PG8_SA(0, 0), cA, voffA); PG8_STAGE(PG8_SA(0, 1), cA + hstep, voffA);
        if (wr == 1) PG8_BAR;
        PG8_WAIT_V(2); PG8_BAR;
        PG8_STAGE(PG8_SB(1, 0), cB + kstep, voffB); PG8_STAGE(PG8_SA(1, 0), cA + kstep, voffA); PG8_STAGE(PG8_SB(1, 1), cB + hstep + kstep, voffB);
        PG8_WAIT_V(6); PG8_BAR;
    } else {
        PG8_STAGE(PG8_SB(0, 0), cB, voffB); PG8_STAGE(PG8_SA(0, 0), cA, voffA); PG8_STAGE(PG8_SB(0, 1), cB + hstep, voffB); PG8_STAGE(PG8_SA(0, 1), cA + hstep, voffA);
        if (wr == 1) PG8_BAR;
        PG8_WAIT_V(4); PG8_BAR;
        PG8_STAGE(PG8_SB(1, 0), cB + kstep, voffB); PG8_STAGE(PG8_SA(1, 0), cA + kstep, voffA); PG8_STAGE(PG8_SB(1, 1), cB + hstep + kstep, voffB);
        PG8_WAIT_V(6); PG8_BAR;
    }
    for (;;) {
        const bool has_next = S.next(ui + 1, nxt);
        const char* nA = has_next ? (const char*)g.A + (size_t)nxt.pm * tstep : cA; const char* nB = has_next ? (const char*)g.Bt + (size_t)nxt.pn * tstep : cB;
        for (int t = 0; t < nt; t += 2) {
            const bool last = (t == nt - 2);
            const char* a1 = cA + (size_t)(t + 1) * kstep;
            const char* a2 = last ? nA : cA + (size_t)(t + 2) * kstep; const char* b2 = last ? nB : cB + (size_t)(t + 2) * kstep;
            const char* a3 = a2 + kstep; const char* b3 = b2 + kstep;
            if (last && has_next) S.a_ready(nxt);
            if constexpr (SP2) {
            PG8_LDB(B0, 0, 0); PG8_LDB(B1, 0, 1); PG8_SCHED; PG8_LDA(At, 0, 0); PG8_STAGE(PG8_SA(1, 1), a1 + hstep, voffA);
            PG8_WAIT_V(8); PG8_WAIT_L(0); PG8_BAR; PG8_MMA(0, 0, At, B0); PG8_MMA(0, 1, At, B1); PG8_BAR; PG8_SCHED;
            PG8_LDA(At, 0, 1); PG8_STAGE(PG8_SB(0, 0), b2, voffB); PG8_STAGE(PG8_SB(0, 1), b2 + hstep, voffB); PG8_STAGE(PG8_SA(0, 0), a2, voffA);
            PG8_WAIT_V(8); PG8_WAIT_L(0); PG8_BAR; PG8_MMA(1, 0, At, B0); PG8_MMA(1, 1, At, B1); PG8_BAR; PG8_SCHED;
            PG8_LDB(B0, 1, 0); PG8_LDB(B1, 1, 1); PG8_SCHED; PG8_LDA(At, 1, 0); PG8_STAGE(PG8_SA(0, 1), a2 + hstep, voffA);
            PG8_WAIT_V(8); PG8_WAIT_L(0); PG8_BAR; PG8_MMA(0, 0, At, B0); PG8_MMA(0, 1, At, B1); PG8_BAR; PG8_SCHED;
            PG8_LDA(At, 1, 1); PG8_STAGE(PG8_SB(1, 0), b3, voffB); PG8_STAGE(PG8_SB(1, 1), b3 + hstep, voffB); PG8_STAGE(PG8_SA(1, 0), a3, voffA);
            PG8_WAIT_V(8); PG8_WAIT_L(0); PG8_BAR; PG8_MMA(1, 0, At, B0); PG8_MMA(1, 1, At, B1); PG8_BAR; PG8_SCHED;
            } else {
            PG8_LDB(B0, 0, 0); PG8_SCHED; PG8_LDA(At, 0, 0); PG8_STAGE(PG8_SA(1, 1), a1 + hstep, voffA);
            PG8_WAIT_L(8); PG8_BAR; PG8_WAIT_L(0); PG8_MMA(0, 0, At, B0); PG8_BAR; PG8_SCHED;
            PG8_LDB(B1, 0, 1); PG8_STAGE(PG8_SB(0, 0), b2, voffB);
            PG8_BAR; PG8_WAIT_L(0); PG8_MMA(0, 1, At, B1); PG8_BAR;
            PG8_LDA(At, 0, 1); PG8_STAGE(PG8_SA(0, 0), a2, voffA);
            PG8_BAR; PG8_WAIT_L(0); PG8_MMA(1, 0, At, B0); PG8_BAR; PG8_SCHED;
            PG8_STAGE(PG8_SB(0, 1), b2 + hstep, voffB);
            PG8_WAIT_V(6); PG8_BAR; PG8_MMA(1, 1, At, B1); PG8_BAR;
            PG8_LDB(B0, 1, 0); PG8_SCHED; PG8_LDA(At, 1, 0); PG8_STAGE(PG8_SA(0, 1), a2 + hstep, voffA);
            PG8_WAIT_L(8); PG8_BAR; PG8_WAIT_L(0); PG8_MMA(0, 0, At, B0); PG8_BAR; PG8_SCHED;
            PG8_LDB(B1, 1, 1); PG8_STAGE(PG8_SB(1, 0), b3, voffB);
            PG8_BAR; PG8_WAIT_L(0); PG8_MMA(0, 1, At, B1); PG8_BAR;
            PG8_LDA(At, 1, 1); PG8_STAGE(PG8_SA(1, 0), a3, voffA);
            PG8_BAR; PG8_WAIT_L(0); PG8_MMA(1, 0, At, B0); PG8_BAR; PG8_SCHED;
            PG8_STAGE(PG8_SB(1, 1), b3 + hstep, voffB);
            PG8_WAIT_V(6); PG8_BAR; PG8_MMA(1, 1, At, B1); PG8_BAR;
            }
        }
        if constexpr (ALIGN_EPI) { if (wr == 0) PG8_BAR; }
        if constexpr (!Epi::AFTER_DRAIN) { const int le_ = opaque_lane(); E(acc, cur, wr, wc, le_ & 15, le_ >> 4); S.done(cur); }
        if (!has_next) break;
#pragma unroll
        for (int a = 0; a < 2; ++a)
#pragma unroll
            for (int b = 0; b < 2; ++b)
#pragma unroll
                for (int m = 0; m < 4; ++m)
#pragma unroll
                    for (int n = 0; n < 2; ++n) acc[a][b][m][n] = (f32x4){0.f, 0.f, 0.f, 0.f};
        cur = nxt; cA = nA; cB = nB; ++ui;
        if constexpr (ALIGN_EPI) { if (wr == 1) PG8_BAR; }
    }
    PG8_WAIT_V(0);
    if constexpr (!ALIGN_EPI) { if (wr == 0) PG8_BAR; }
    PG8_BAR;
    if constexpr (Epi::AFTER_DRAIN) { E.fused(acc, cur, wr, wc, fr, fq, lds, wid, lane); S.done(cur); }
#undef PG8_SA
#undef PG8_SB
#undef PG8_STAGE
#undef PG8_LDA
#undef PG8_LDB
#undef PG8_MMA
#undef PG8_WAIT_V
#undef PG8_WAIT_L
#undef PG8_BAR
#undef PG8_SCHED
}
}

constexpr int NWAVES = 8;
constexpr int DM = 2048, NBATCH = 2, SEQ = 8192, CTXL = 256, TPB = CTXL + SEQ  , MALL = NBATCH * TPB  ;
constexpr int NLAYER = 2;
constexpr int RW = 1024, NH = 16;
constexpr int RWC = 3392, INA = 4192, INA_P = 4352, INC = 8288;
constexpr int C_WD = 3072, C_AD = 3200, C_GD = 3328, C_QC = 3392, C_KVC = 3904, C_KR = 4160;
constexpr int QKD = 96, NQ = NH * QKD  , NKV = NH * 128  ;
constexpr int NEXP = 16384;
constexpr int RREC = 9 * 64;
constexpr float NORM_EPS = 1e-6f;

constexpr size_t MiB = 1u << 20;
constexpr size_t WS_CTL = 0, CTL_ZERO_BYTES = 1 * MiB;
constexpr size_t CTL_MOD_OFF = 256 * 1024;
constexpr size_t WS_ROPE = 1 * MiB;
constexpr size_t WS_WUP = 3 * MiB, WS_AUP = WS_WUP + 512 * 1024, WS_GUP = 4 * MiB;
constexpr size_t WS_WUQ = 5 * MiB, WS_WUKV = 8 * MiB, WS_WA = 10 * MiB, WS_WB = 18 * MiB, WS_WO = 26 * MiB, WS_WQK = 42 * MiB, WS_WGA = 58 * MiB, WS_WGB = 74 * MiB, WS_WINA = 90 * MiB;
constexpr size_t WS_X = 124 * MiB, WS_H = 256 * MiB, WS_DYN = 322 * MiB;
constexpr size_t WS_PA = WS_DYN;
constexpr size_t WS_RI = 463 * MiB;
constexpr size_t WS_GG = 760 * MiB;
constexpr size_t WS_BON = 826 * MiB;
constexpr size_t WS_QN = 831 * MiB, WS_KVN = 848 * MiB;
constexpr size_t WS_Q = 857 * MiB, WS_K = 907 * MiB, WS_V = 957 * MiB, WS_END = 990 * MiB;
constexpr size_t WS_Y = WS_DYN;
constexpr size_t WS_YA = 388 * MiB, WS_YB = 421 * MiB;
constexpr size_t WS_T1 = 463 * MiB, WS_T2 = 529 * MiB;
constexpr size_t WS_PU = 600 * MiB, WS_PV = 664 * MiB;
constexpr size_t WS_SC = WS_DYN;
static_assert(WS_PA + (size_t)MALL * INA_P * 2 <= WS_RI && WS_RI + (size_t)NBATCH * NH * TPB * RREC * 2 <= WS_GG && WS_GG + (size_t)2 * MALL * RW * 2 <= WS_BON, "ws map 1");
static_assert(WS_BON + (size_t)2 * MALL * 32 * 4 <= WS_QN && WS_QN + (size_t)MALL * 512 * 2 <= WS_KVN && WS_KVN + (size_t)MALL * 256 * 2 <= WS_Q, "ws map 2");
static_assert(WS_Q + (size_t)NBATCH * NH * TPB * QKD * 2 <= WS_K && WS_K + (size_t)NBATCH * NH * TPB * QKD * 2 <= WS_V && WS_V + (size_t)NBATCH * NH * TPB * 64 * 2 <= WS_END, "ws map 3");
static_assert(WS_Y + (size_t)2 * MALL * RW * 2 <= WS_YA && WS_YA + (size_t)MALL * RW * 2 <= WS_YB && WS_YB + (size_t)MALL * RW * 2 <= WS_RI, "ws map 4");
static_assert(WS_T1 + (size_t)MALL * DM * 2 <= WS_T2 && WS_T2 + (size_t)MALL * DM * 2 <= WS_PU && WS_PU + (size_t)NEXP * DM * 2 <= WS_PV && WS_PV + (size_t)NEXP * DM * 2 <= WS_GG, "ws map 5");
static_assert(WS_SC + (size_t)MALL * DM * 4 <= WS_T1 && WS_X + (size_t)MALL * DM * 4 <= WS_H && WS_H + (size_t)MALL * DM * 2 <= WS_DYN, "ws map 6");
static_assert(WS_WINA + (size_t)NLAYER * INA_P * DM * 2 <= WS_X, "ws map 7");
constexpr size_t CTL_PROBE_OFF = 640 * 1024;
constexpr int CW_BAR = 4096;

constexpr int RING_BYTES = 131072;
constexpr int LDSCTL_OFF = RING_BYTES, MISC_OFF = LDSCTL_OFF + 320;
constexpr int LDS_BYTES = 147456;

#define GAS __attribute__((address_space(1)))
#define LAS __attribute__((address_space(3)))
typedef unsigned short bf16;
typedef unsigned v4u __attribute__((ext_vector_type(4)));
typedef unsigned v2u __attribute__((ext_vector_type(2)));
typedef float f32x4 __attribute__((ext_vector_type(4)));
typedef float f32x2 __attribute__((ext_vector_type(2)));
typedef float f32x16 __attribute__((ext_vector_type(16)));
typedef short bf16x8 __attribute__((ext_vector_type(8)));
typedef short s16x4 __attribute__((ext_vector_type(4)));
typedef __bf16 bf16x2v __attribute__((ext_vector_type(2)));
typedef __bf16 bf16x8v __attribute__((ext_vector_type(8)));
typedef GAS unsigned gu32;
#define RLX_AGENT __ATOMIC_RELAXED, __HIP_MEMORY_SCOPE_AGENT
#define LDS_WAIT() asm volatile("s_waitcnt lgkmcnt(0)" ::: "memory")
#define VM_WAIT() asm volatile("s_waitcnt vmcnt(0)" ::: "memory")
__device__ __forceinline__ unsigned f2bf(float f) { unsigned u = __builtin_bit_cast(unsigned, f); return (u + 0x7fffu + ((u >> 16) & 1u)) >> 16; }
__device__ __forceinline__ unsigned pk2(float lo, float hi) { return pg8::cvt_pk_bf16(lo, hi); }
__device__ __forceinline__ float bflo(unsigned w) { return __builtin_bit_cast(float, w << 16); }
__device__ __forceinline__ float bfhi(unsigned w) { return __builtin_bit_cast(float, w & 0xffff0000u); }
__device__ __forceinline__ float bf1(bf16 h) { return __builtin_bit_cast(float, (unsigned)h << 16); }
__device__ __forceinline__ float sigmoidf_(float x) { return 1.0f / (1.0f + __expf(-x)); }
template <int CTRL> __device__ __forceinline__ float dpp_add(float x) {
    return x + __builtin_bit_cast(float, __builtin_amdgcn_update_dpp(0, __builtin_bit_cast(int, x), CTRL, 0xf, 0xf, true));
}
__device__ __forceinline__ float red16(float x) {
    x = dpp_add<0xB1>(x);
    x = dpp_add<0x4E>(x);
    x = dpp_add<0x141>(x);
    x = dpp_add<0x140>(x);
    return x;
}
template <int CTRL, int RM> __device__ __forceinline__ float dpp_max(float x) {
    return fmaxf(x, __builtin_bit_cast(float, __builtin_amdgcn_update_dpp(__builtin_bit_cast(int, x), __builtin_bit_cast(int, x), CTRL, RM, 0xf, false)));
}
template <int CTRL, int RM> __device__ __forceinline__ float dpp_sum(float x) {
    return x + __builtin_bit_cast(float, __builtin_amdgcn_update_dpp(0, __builtin_bit_cast(int, x), CTRL, RM, 0xf, false));
}
__device__ __forceinline__ float wave_max_u(float x) {
    x = dpp_max<0xB1, 0xf>(x); x = dpp_max<0x4E, 0xf>(x); x = dpp_max<0x141, 0xf>(x); x = dpp_max<0x140, 0xf>(x);
    x = dpp_max<0x142, 0xa>(x); x = dpp_max<0x143, 0xc>(x);
    return __builtin_bit_cast(float, __builtin_amdgcn_readlane(__builtin_bit_cast(int, x), 63));
}
__device__ __forceinline__ float wave_sum_u(float x) {
    x = dpp_sum<0xB1, 0xf>(x); x = dpp_sum<0x4E, 0xf>(x); x = dpp_sum<0x141, 0xf>(x); x = dpp_sum<0x140, 0xf>(x);
    x = dpp_sum<0x142, 0xa>(x); x = dpp_sum<0x143, 0xc>(x);
    return __builtin_bit_cast(float, __builtin_amdgcn_readlane(__builtin_bit_cast(int, x), 63));
}
__device__ __forceinline__ float wave_sum(float v) { return wave_sum_u(v); }
__device__ __forceinline__ float bpermf(int srclane, float v) { return __builtin_bit_cast(float, __builtin_amdgcn_ds_bpermute(srclane << 2, __builtin_bit_cast(int, v))); }
__device__ __forceinline__ int bpermi(int srclane, int v) { return __builtin_amdgcn_ds_bpermute(srclane << 2, v); }

#define XB_TMO      128
#define XB_XCNT(j)  (256  + 64 * (j))
#define XB_XSUB(j)  (1280 + 64 * (j))
#define XB_XGEN(j)  (2304 + 64 * (j))
#define XB_TOP      3328
#define XB_TOPGEN   3392
#define XCD_BAR_WORDS 3456
#define XB_SPIN_CAP (1u << 20)

__device__ __forceinline__ unsigned xb_ld(unsigned* p)              { return __hip_atomic_load(p, __ATOMIC_RELAXED, __HIP_MEMORY_SCOPE_AGENT); }
__device__ __forceinline__ unsigned xb_add(unsigned* p, unsigned v) { return __hip_atomic_fetch_add(p, v, __ATOMIC_RELAXED, __HIP_MEMORY_SCOPE_AGENT); }
__device__ __forceinline__ unsigned xb_xcc_id() { return (unsigned)__builtin_amdgcn_s_getreg((3 << 11) | 20) & 0xFu; }
#define XB_SPIN(cond, bar) do { unsigned _sp = 0; while (cond) { __builtin_amdgcn_s_sleep(1); \
    if ((++_sp & 255u) == 0u) { if (xb_ld(&(bar)[XB_TMO])) break; if (_sp > XB_SPIN_CAP) { atomicAdd(&(bar)[XB_TMO], 1u); break; } } } } while (0)

struct XcdBarrier { unsigned* bar; unsigned x; volatile LAS unsigned* st; };

__device__ __forceinline__ XcdBarrier xcd_barrier_post(unsigned* bar, volatile LAS unsigned* st, bool t0) {
    XcdBarrier b; b.bar = bar; b.x = xb_xcc_id(); b.st = st;
    if (t0) (void)xb_add(&bar[XB_XCNT(b.x)], 1u);
    return b;
}
__device__ __forceinline__ void xcd_barrier_complete(unsigned* bar, unsigned x, unsigned& nloc, unsigned& nx) {
    const unsigned G = gridDim.x * gridDim.y * gridDim.z;
    unsigned sum, cnt, mine, sp = 0u;
    for (;;) {
        sum = 0u; cnt = 0u; mine = 0u;
#pragma unroll
        for (unsigned j = 0; j < 16; ++j) { const unsigned c = xb_ld(&bar[XB_XCNT(j)]); sum += c; cnt += (c > 0u) ? 1u : 0u; mine = (j == x) ? c : mine; }
        if (sum == G) break;
        __builtin_amdgcn_s_sleep(1);
        if ((++sp & 255u) == 0u) { if (xb_ld(&bar[XB_TMO])) break; if (sp > XB_SPIN_CAP) { atomicAdd(&bar[XB_TMO], 1u); break; } }
    }
    nloc = mine > 0u ? mine : 1u; nx = cnt > 0u ? cnt : 1u;
}
__device__ __forceinline__ void xcd_barrier(const XcdBarrier& b, bool t0) {
    asm volatile("s_waitcnt vmcnt(0)" ::: "memory");
    __syncthreads();
    if (t0) {
        unsigned* bar = b.bar;
        __builtin_amdgcn_s_waitcnt(0);
        unsigned nloc = b.st[0], nx = b.st[1];
        if (nloc == 0u) { xcd_barrier_complete(bar, b.x, nloc, nx); b.st[0] = nloc; b.st[1] = nx; }
        const unsigned old = xb_add(&bar[XB_XSUB(b.x)], 1u);
        const unsigned gen = old / nloc;
        if (old + 1u == (gen + 1u) * nloc) {
            __builtin_amdgcn_fence(__ATOMIC_RELEASE, "agent");
            asm volatile("s_waitcnt vmcnt(0)" ::: "memory");
            const unsigned og = xb_add(&bar[XB_TOP], 1u);
            const unsigned tg = og / nx;
            if (og + 1u == (tg + 1u) * nx) xb_add(&bar[XB_TOPGEN], 1u);
            else XB_SPIN(xb_ld(&bar[XB_TOPGEN]) == tg, bar);
            __builtin_amdgcn_fence(__ATOMIC_ACQUIRE, "agent");
            xb_add(&bar[XB_XGEN(b.x)], 1u);
            asm volatile("s_waitcnt vmcnt(0)" ::: "memory");
        } else {
            XB_SPIN(xb_ld(&bar[XB_XGEN(b.x)]) == gen, bar);
            __builtin_amdgcn_fence(__ATOMIC_ACQUIRE, "agent");
            asm volatile("s_waitcnt vmcnt(0)" ::: "memory");
        }
    }
    __syncthreads();
}

struct Frame {
    LAS unsigned char* lds;
    unsigned char* ws;
    const float* const* in;
    int tid, lane, wave;
    int vcu, G;
};
struct Args { const float* in[33]; float* out; unsigned char* ws; int ph_lo, ph_hi; };


namespace pg8 {
typedef unsigned u32x4 __attribute__((ext_vector_type(4)));
struct RowOrder : StaticOrder {
    int lat;
    __host__ __device__ void init_rows(int lat_, int N, int G_, int c_) { lat = lat_; init(lat_ ? NBATCH * SEQ : MALL, N, G_, c_); }
    __host__ __device__ bool next(int i, Unit& u) const { if (!StaticOrder::next(i, u)) return false; if (lat) u.pm = 33 * (u.pm >> 5) + 1 + (u.pm & 31); return true; }
};
#define EPI_LOOP_ROWS for (int ai = 0; ai < 2; ++ai) _Pragma("unroll") for (int m = 0; m < 4; ++m)
#define EPI_PIN asm volatile("" ::: "memory")

struct EpiStoreBf16 {
    static constexpr bool PERM = true, AFTER_DRAIN = false;
    bf16_t* O; int ldc;
    __device__ __forceinline__ void operator()(const f32x4 (&acc)[2][2][4][2], const Unit& u, int wr, int wc, int fr, int fq) const {
        const int row0 = u.pm * BM + wr * 64 + fr, col0 = u.pn * BM + wc * 32 + 8 * fq;
#pragma unroll
        EPI_LOOP_ROWS { bf16_t* rowp = O + (size_t)(row0 + ai * HALF + m * 16) * ldc + col0;
#pragma unroll
            for (int bj = 0; bj < 2; ++bj) { const f32x4 v0 = acc[ai][bj][m][0], v1 = acc[ai][bj][m][1];
                u32x4 w; w.x = cvt_pk_bf16(v0[0], v0[1]); w.y = cvt_pk_bf16(v0[2], v0[3]); w.z = cvt_pk_bf16(v1[0], v1[1]); w.w = cvt_pk_bf16(v1[2], v1[3]);
                *(u32x4*)(rowp + bj * HALF) = w; } }
    }
};
struct EpiGate {
    static constexpr bool PERM = true, AFTER_DRAIN = false;
    bf16_t* O; int ldc; const float* bias;
    __device__ __forceinline__ void operator()(const f32x4 (&acc)[2][2][4][2], const Unit& u, int wr, int wc, int fr, int fq) const {
        const int row0 = u.pm * BM + wr * 64 + fr, col0 = u.pn * BM + wc * 32 + 8 * fq;
        f32x4 bv[2][2];
#pragma unroll
        for (int bj = 0; bj < 2; ++bj)
#pragma unroll
            for (int n = 0; n < 2; ++n) bv[bj][n] = *(const f32x4*)(bias + col0 + bj * HALF + 4 * n);
#pragma unroll
        EPI_LOOP_ROWS { EPI_PIN; bf16_t* rowp = O + (size_t)(row0 + ai * HALF + m * 16) * ldc + col0;
#pragma unroll
            for (int bj = 0; bj < 2; ++bj) { f32x4 v0 = acc[ai][bj][m][0] + bv[bj][0], v1 = acc[ai][bj][m][1] + bv[bj][1];
#pragma unroll
                for (int e = 0; e < 4; ++e) { v0[e] = 1.0f / (1.0f + __expf(-v0[e])); v1[e] = 1.0f / (1.0f + __expf(-v1[e])); }
                u32x4 w; w.x = cvt_pk_bf16(v0[0], v0[1]); w.y = cvt_pk_bf16(v0[2], v0[3]); w.z = cvt_pk_bf16(v1[0], v1[1]); w.w = cvt_pk_bf16(v1[2], v1[3]);
                *(u32x4*)(rowp + bj * HALF) = w; } }
    }
};
__device__ __forceinline__ float bf_lo(unsigned w) { return __builtin_bit_cast(float, w << 16); }
__device__ __forceinline__ float bf_hi(unsigned w) { return __builtin_bit_cast(float, w & 0xffff0000u); }
struct EpiMulAdd {
    static constexpr bool PERM = true, AFTER_DRAIN = false;
    bf16_t* O; const bf16_t* Gt; const bf16_t* Ad; int ldc;
    __device__ __forceinline__ void operator()(const f32x4 (&acc)[2][2][4][2], const Unit& u, int wr, int wc, int fr, int fq) const {
        const int row0 = u.pm * BM + wr * 64 + fr, col0 = u.pn * BM + wc * 32 + 8 * fq;
#pragma unroll
        EPI_LOOP_ROWS { EPI_PIN; const size_t ro = (size_t)(row0 + ai * HALF + m * 16) * ldc + col0;
#pragma unroll
            for (int bj = 0; bj < 2; ++bj) { const f32x4 v0 = acc[ai][bj][m][0], v1 = acc[ai][bj][m][1];
                const u32x4 g = *(const u32x4*)(Gt + ro + bj * HALF);
                float o[8];
                o[0] = bf_lo(g.x) * v0[0]; o[1] = bf_hi(g.x) * v0[1]; o[2] = bf_lo(g.y) * v0[2]; o[3] = bf_hi(g.y) * v0[3];
                o[4] = bf_lo(g.z) * v1[0]; o[5] = bf_hi(g.z) * v1[1]; o[6] = bf_lo(g.w) * v1[2]; o[7] = bf_hi(g.w) * v1[3];
                if (Ad) { const u32x4 a = *(const u32x4*)(Ad + ro + bj * HALF);
                    o[0] += bf_lo(a.x); o[1] += bf_hi(a.x); o[2] += bf_lo(a.y); o[3] += bf_hi(a.y); o[4] += bf_lo(a.z); o[5] += bf_hi(a.z); o[6] += bf_lo(a.w); o[7] += bf_hi(a.w); }
                u32x4 w; w.x = cvt_pk_bf16(o[0], o[1]); w.y = cvt_pk_bf16(o[2], o[3]); w.z = cvt_pk_bf16(o[4], o[5]); w.w = cvt_pk_bf16(o[6], o[7]);
                *(u32x4*)(O + ro + bj * HALF) = w; } }
    }
};
struct EpiResid {
    static constexpr bool PERM = false, AFTER_DRAIN = false;
    float* X; const float* gate;
    __device__ __forceinline__ void operator()(const f32x4 (&acc)[2][2][4][2], const Unit& u, int wr, int wc, int fr, int fq) const {
        const int row0 = u.pm * BM + wr * 64 + fr, col0 = u.pn * BM + wc * 32 + 4 * fq;
        const int bb = u.pm / 33, mr = (u.pm - bb * 33 == 0) ? 2 : bb;
        const float* gp = gate + (size_t)mr * 12288 + col0;
        f32x4 gv[2][2];
#pragma unroll
        for (int bj = 0; bj < 2; ++bj)
#pragma unroll
            for (int n = 0; n < 2; ++n) gv[bj][n] = *(const f32x4*)(gp + bj * HALF + n * 16);
#pragma unroll
        EPI_LOOP_ROWS { EPI_PIN; float* rowp = X + (size_t)(row0 + ai * HALF + m * 16) * DM + col0;
#pragma unroll
            for (int bj = 0; bj < 2; ++bj)
#pragma unroll
                for (int n = 0; n < 2; ++n) { f32x4* p = (f32x4*)(rowp + bj * HALF + n * 16); *p = *p + gv[bj][n] * acc[ai][bj][m][n]; } }
    }
};
struct EpiF32 {
    static constexpr bool PERM = false, AFTER_DRAIN = false;
    float* C; int ldc;
    __device__ __forceinline__ void operator()(const f32x4 (&acc)[2][2][4][2], const Unit& u, int wr, int wc, int fr, int fq) const {
        const int row0 = u.pm * BM + wr * 64 + fr, col0 = u.pn * BM + wc * 32 + 4 * fq;
#pragma unroll
        EPI_LOOP_ROWS { float* rowp = C + (size_t)(row0 + ai * HALF + m * 16) * ldc + col0;
#pragma unroll
            for (int bj = 0; bj < 2; ++bj)
#pragma unroll
                for (int n = 0; n < 2; ++n) *(f32x4*)(rowp + bj * HALF + n * 16) = acc[ai][bj][m][n]; }
    }
};
struct EpiQ {
    static constexpr bool PERM = true, AFTER_DRAIN = false;
    bf16_t* Q; const f32x2* rope; float qscale;
    __device__ __forceinline__ void operator()(const f32x4 (&acc)[2][2][4][2], const Unit& u, int wr, int wc, int fr, int fq) const {
        const int bb = u.pm / 33, tp0 = (u.pm - bb * 33) * BM + wr * 64 + fr, col0 = u.pn * BM + wc * 32 + 8 * fq;
#pragma unroll
        for (int bj = 0; bj < 2; ++bj) { const int c = col0 + bj * HALF, hd = c / QKD, d = c - hd * QKD;
#pragma unroll
            EPI_LOOP_ROWS { EPI_PIN; const int tp = tp0 + ai * HALF + m * 16;
                f32x4 v0 = acc[ai][bj][m][0], v1 = acc[ai][bj][m][1];
                if (d >= 64) { const int i0 = (d - 64) >> 1; const f32x2* rp = rope + (size_t)tp * 16 + i0;
                    const f32x2 c0 = rp[0], c1 = rp[1], c2 = rp[2], c3 = rp[3];
                    float a, b;
                    a = v0[0]; b = v0[1]; v0[0] = a * c0.x - b * c0.y; v0[1] = a * c0.y + b * c0.x;
                    a = v0[2]; b = v0[3]; v0[2] = a * c1.x - b * c1.y; v0[3] = a * c1.y + b * c1.x;
                    a = v1[0]; b = v1[1]; v1[0] = a * c2.x - b * c2.y; v1[1] = a * c2.y + b * c2.x;
                    a = v1[2]; b = v1[3]; v1[2] = a * c3.x - b * c3.y; v1[3] = a * c3.y + b * c3.x; }
                v0 = v0 * qscale; v1 = v1 * qscale;
                u32x4 w; w.x = cvt_pk_bf16(v0[0], v0[1]); w.y = cvt_pk_bf16(v0[2], v0[3]); w.z = cvt_pk_bf16(v1[0], v1[1]); w.w = cvt_pk_bf16(v1[2], v1[3]);
                *(u32x4*)(Q + ((size_t)(bb * NH + hd) * TPB + tp) * QKD + d) = w; } }
    }
};
struct EpiKV {
    static constexpr bool PERM = true, AFTER_DRAIN = false;
    bf16_t* K; bf16_t* V;
    __device__ __forceinline__ void operator()(const f32x4 (&acc)[2][2][4][2], const Unit& u, int wr, int wc, int fr, int fq) const {
        const int bb = u.pm / 33, tp0 = (u.pm - bb * 33) * BM + wr * 64 + fr;
        const bool isK = wc < 2;
        bf16_t* base = isK ? K : V; const int pitch = isK ? QKD : 64, doff = 32 * (wc & 1) + 8 * fq;
#pragma unroll
        for (int bj = 0; bj < 2; ++bj) { const int hd = 2 * u.pn + bj;
            bf16_t* hb = base + (size_t)(bb * NH + hd) * TPB * pitch;
#pragma unroll
            EPI_LOOP_ROWS { EPI_PIN; const int tp = tp0 + ai * HALF + m * 16;
                const f32x4 v0 = acc[ai][bj][m][0], v1 = acc[ai][bj][m][1];
                u32x4 w; w.x = cvt_pk_bf16(v0[0], v0[1]); w.y = cvt_pk_bf16(v0[2], v0[3]); w.z = cvt_pk_bf16(v1[0], v1[1]); w.w = cvt_pk_bf16(v1[2], v1[3]);
                *(u32x4*)((char*)hb + (unsigned)((tp * pitch + doff) * 2)) = w; } }
    }
};
}

template <int MAPQ>
__device__ __forceinline__ void p0_transpose_item(const float* W, int K, int ldw, int c0, int N, bf16* WT, LAS float* scr, int item, int lane) {
    const int nblk = N / 32, kb = item / nblk, nb = item % nblk, k0 = 64 * kb, n0 = 32 * nb;
#pragma unroll 8
    for (int i = 0; i < 32; ++i) { const int kk = 2 * i + (lane >> 5); scr[kk * 33 + (lane & 31)] = W[(size_t)(k0 + kk) * ldw + c0 + n0 + (lane & 31)]; }
    LDS_WAIT(); asm volatile("" ::: "memory");
    const int c = lane & 7;
#pragma unroll
    for (int j = 0; j < 4; ++j) { const int n = (lane >> 3) + 8 * j; const LAS float* s = scr + (8 * c) * 33 + n;
        v4u o; o.x = pk2(s[0 * 33], s[1 * 33]); o.y = pk2(s[2 * 33], s[3 * 33]); o.z = pk2(s[4 * 33], s[5 * 33]); o.w = pk2(s[6 * 33], s[7 * 33]);
        int nn = n0 + n;
        if (MAPQ) { const int hd = nn / QKD, d = nn - hd * QKD; if (d >= 64) { const int i = (d - 64) & 15, s2 = (d - 64) >> 4; nn = hd * QKD + 64 + 2 * i + s2; } }
        *(GAS v4u*)(WT + (size_t)nn * K + k0 + 8 * c) = o; }
    LDS_WAIT(); asm volatile("" ::: "memory");
}

__device__ __forceinline__ const float* karg(int i);
__device__ __forceinline__ void p0_prologue(Frame& F) {
    LAS float* scr = (LAS float*)(F.lds + F.wave * 16384);
    const int gw = F.vcu * NWAVES + F.wave, NGW = F.G * NWAVES;
    unsigned char* ws = F.ws;
    for (int l = 0; l < NLAYER; ++l) {
        const float* w_in = karg(7) + (size_t)l * DM * INC; const float* wbra = karg(24); const float* wbrb = karg(25); const float* wout = karg(26); const float* wuq = karg(21); const float* wukv = karg(23); const float* wup = karg(11); const float* aup = karg(13);
        constexpr int I_INA = (DM / 64) * (INA / 32), I_G = (DM / 64) * (DM / 32), I_BR = (RW / 64) * (DM / 32), I_UQ = (512 / 64) * (NQ / 32), I_UKV = (256 / 64) * (NKV / 32), I_LR = 1 * (RW / 32);
        constexpr int NIT = I_INA + 2 * I_G + 2 * I_BR + I_G + I_UQ + I_UKV + 4 * I_LR;
        for (int it = gw; it < NIT; it += NGW) {
            int r = it;
            if (r < I_INA) { p0_transpose_item<0>(w_in, DM, INC, 0, INA, (bf16*)(ws + WS_WINA) + (size_t)l * INA_P * DM, scr, r, F.lane); continue; } r -= I_INA;
            if (r < I_G) { p0_transpose_item<0>(w_in, DM, INC, INA, DM, (bf16*)(ws + WS_WGA) + (size_t)l * DM * DM, scr, r, F.lane); continue; } r -= I_G;
            if (r < I_G) { p0_transpose_item<0>(w_in, DM, INC, INA + DM, DM, (bf16*)(ws + WS_WGB) + (size_t)l * DM * DM, scr, r, F.lane); continue; } r -= I_G;
            if (r < I_BR) { p0_transpose_item<0>(wbra + (size_t)l * RW * DM, RW, DM, 0, DM, (bf16*)(ws + WS_WA) + (size_t)l * DM * RW, scr, r, F.lane); continue; } r -= I_BR;
            if (r < I_BR) { p0_transpose_item<0>(wbrb + (size_t)l * RW * DM, RW, DM, 0, DM, (bf16*)(ws + WS_WB) + (size_t)l * DM * RW, scr, r, F.lane); continue; } r -= I_BR;
            if (r < I_G) { p0_transpose_item<0>(wout + (size_t)l * DM * DM, DM, DM, 0, DM, (bf16*)(ws + WS_WO) + (size_t)l * DM * DM, scr, r, F.lane); continue; } r -= I_G;
            if (r < I_UQ) { p0_transpose_item<1>(wuq + (size_t)l * 512 * NQ, 512, NQ, 0, NQ, (bf16*)(ws + WS_WUQ) + (size_t)l * NQ * 512, scr, r, F.lane); continue; } r -= I_UQ;
            if (r < I_UKV) { p0_transpose_item<0>(wukv + (size_t)l * 256 * NKV, 256, NKV, 0, NKV, (bf16*)(ws + WS_WUKV) + (size_t)l * NKV * 256, scr, r, F.lane); continue; } r -= I_UKV;
            { const int which = r / I_LR, d = which & 1, isa = which >> 1; r -= which * I_LR;
              const float* src = (isa ? aup : wup) + (size_t)(l * 2 + d) * 64 * RW;
              bf16* dst = (bf16*)(ws + (isa ? WS_AUP : WS_WUP)) + (size_t)(l * 2 + d) * RW * 64;
              p0_transpose_item<0>(src, 64, RW, 0, RW, dst, scr, r, F.lane); }
        }
    }
    const int gt = gw * 64 + F.lane, NGT = NGW * 64;
    { const float* gup = karg(14);
    for (int i = gt; i < NLAYER * 2 * 32 * RW; i += NGT) { const int ch = i & 1023, r = (i >> 10) & 31, ld = i >> 15;
        ((bf16*)(ws + WS_GUP))[((size_t)ld * RW + ch) * 32 + r] = (bf16)f2bf(gup[i]); } }
    for (int i = gt; i < NLAYER * (INA_P - INA) * DM / 8; i += NGT) { const int l = i / ((INA_P - INA) * DM / 8), r = i - l * ((INA_P - INA) * DM / 8);
        ((GAS v4u*)((bf16*)(ws + WS_WINA) + ((size_t)l * INA_P + INA) * DM))[r] = (v4u){0u, 0u, 0u, 0u}; }
    { const GAS f32x4* xs = (const GAS f32x4*)karg(0); const GAS f32x4* cs = (const GAS f32x4*)karg(2); GAS f32x4* X = (GAS f32x4*)(ws + WS_X);
      for (int i = gt; i < MALL * (DM / 4); i += NGT) { const int m = i >> 9, c4 = i & 511, b = m / TPB, tp = m - b * TPB;
          X[i] = (tp < CTXL) ? cs[((size_t)(b * CTXL + tp) << 9) + c4] : xs[((size_t)(b * SEQ + tp - CTXL) << 9) + c4]; } }
    { f32x2* rt = (f32x2*)(ws + WS_ROPE);
      for (int i = gt; i < TPB * 16; i += NGT) { const int tp = i >> 4, k = i & 15; f32x2 o = {1.f, 0.f};
          if (tp >= CTXL) { const int t = tp - CTXL, row = t >> 6, col = t & 63, j = k & 7; const float fr = powf(10000.0f, -(float)j / 8.0f);
              const float ang = (float)(k < 8 ? row : col) * fr; o.x = cosf(ang); o.y = sinf(ang); }
          rt[i] = o; } }
    { float* modw = (float*)(ws + WS_CTL + CTL_MOD_OFF); const float* adaw = karg(4); const float* adab = karg(5); const float* cin = karg(1); const float* cctx = karg(3);
      LAS f32x4* part = (LAS f32x4*)F.lds;
      for (int uu = F.vcu; uu < NLAYER * 48; uu += F.G) { const int cb = uu % 48, l = uu / 48;
          const int n0 = cb * 256 + F.lane * 4; const float* aw = adaw + (size_t)l * DM * 12288 + n0;
          f32x4 a0 = {0, 0, 0, 0}, a1 = a0, a2 = a0;
#pragma unroll 8
          for (int k = F.wave * 256; k < F.wave * 256 + 256; ++k) { const f32x4 w = *(const GAS f32x4*)(aw + (size_t)k * 12288);
              const float c0 = cin[k], c1 = cin[DM + k], c2 = cctx[k];
              const float s0 = c0 / (1.f + __expf(-c0)), s1 = c1 / (1.f + __expf(-c1)), s2 = c2 / (1.f + __expf(-c2));
              a0 = a0 + w * s0; a1 = a1 + w * s1; a2 = a2 + w * s2; }
          __syncthreads();
          part[(F.wave * 3 + 0) * 64 + F.lane] = a0; part[(F.wave * 3 + 1) * 64 + F.lane] = a1; part[(F.wave * 3 + 2) * 64 + F.lane] = a2;
          __syncthreads();
          if (F.wave < 3) { f32x4 s = *(const GAS f32x4*)(adab + (size_t)l * 12288 + n0);
#pragma unroll
              for (int w8 = 0; w8 < 8; ++w8) s = s + part[(w8 * 3 + F.wave) * 64 + F.lane];
              *(GAS f32x4*)(modw + ((size_t)l * 3 + F.wave) * 12288 + n0) = s; }
          __syncthreads(); } }
    { LAS float* KEY = (LAS float*)F.lds;
      LAS float* WQT = (LAS float*)(F.lds + 65536);
      const float* pkeys = karg(29); const float* pwq = karg(28);
      __syncthreads();
      for (int uu = F.vcu; uu < NLAYER * 16 * 32; uu += F.G) { const int kb = uu & 31, hp = (uu >> 5) & 15, l = uu >> 9;
          const GAS f32x4* ksrc = (const GAS f32x4*)(pkeys + ((size_t)l * 16 + hp) * 16384);
          for (int i = F.tid; i < 4096; i += 512) ((LAS f32x4*)KEY)[i] = ksrc[i];
          for (int i = F.tid; i < 2048; i += 512) { const int kk = i >> 5, d4 = i & 31;
              *(LAS f32x4*)(WQT + kk * 132 + d4 * 4) = *(const GAS f32x4*)(pwq + ((size_t)l * DM + kb * 64 + kk) * DM + hp * 128 + d4 * 4); }
          __syncthreads();
          const int kk = F.tid & 63, kg = F.tid >> 6;
          float acc[16];
#pragma unroll
          for (int j = 0; j < 16; ++j) acc[j] = 0.f;
          for (int d = 0; d < 128; d += 4) { const f32x4 w = *(LAS f32x4*)(WQT + kk * 132 + d);
#pragma unroll
              for (int j = 0; j < 16; ++j) { const f32x4 q = *(LAS f32x4*)(KEY + (kg * 16 + j) * 128 + d); acc[j] += q.x * w.x + q.y * w.y + q.z * w.z + q.w * w.w; } }
          bf16* dst = (bf16*)(ws + WS_WQK) + ((size_t)l * DM + hp * 128 + kg * 16) * DM + kb * 64 + kk;
#pragma unroll
          for (int j = 0; j < 16; ++j) dst[(size_t)j * DM] = (bf16)f2bf(acc[j]);
          __syncthreads(); } }
}

__device__ __forceinline__ void modnorm_phase(Frame& F, const float* X, const float* g, const float* mod  , int chunk_sh, bf16* H, int skip_ctx) {
    const int gw = F.vcu * NWAVES + F.wave, NGW = F.G * NWAVES;
    for (int m = gw; m < MALL; m += NGW) {
        const int b = m / TPB, tp = m - b * TPB; if (skip_ctx && tp < CTXL) continue;
        const int mr = tp < CTXL ? 2 : b;
        const GAS f32x4* xr = (const GAS f32x4*)(X + (size_t)m * DM) + F.lane;
        f32x4 v[8]; float s = 0.f;
#pragma unroll
        for (int j = 0; j < 8; ++j) { v[j] = xr[64 * j]; s += (v[j].x * v[j].x + v[j].y * v[j].y) + (v[j].z * v[j].z + v[j].w * v[j].w); }
        const float rs = rsqrtf(wave_sum(s) * (1.f / DM) + NORM_EPS);
        const float* sh = mod + (size_t)mr * 12288 + chunk_sh * DM; const float* sc = sh + DM;
        GAS v2u* o8 = (GAS v2u*)(H + (size_t)m * DM) + F.lane;
#pragma unroll
        for (int j = 0; j < 8; ++j) { const int c = (F.lane + 64 * j) * 4;
            const f32x4 gg = *(const GAS f32x4*)(g + c), s1 = *(const GAS f32x4*)(sc + c), s0 = *(const GAS f32x4*)(sh + c);
            f32x4 y = v[j] * rs * gg; y = y * (s1 + 1.0f) + s0;
            v2u o; o.x = pk2(y.x, y.y); o.y = pk2(y.z, y.w); o8[64 * j] = o; }
    }
}

typedef float f32x4v __attribute__((ext_vector_type(4)));
#define MFMA16(a, b, c) __builtin_amdgcn_mfma_f32_16x16x32_bf16((a), (b), (c), 0, 0, 0)
#define MFMA32(a, b, c) __builtin_amdgcn_mfma_f32_32x32x16_bf16((a), (b), (c), 0, 0, 0)

struct FeatP {
    const bf16* PA; const float* mu; const float* w0; const float* a0; const float* k_k; const float* k_a; const float* r_k;
    const bf16* WUP; const bf16* AUP; const bf16* GUP;
    const float* qnorm; const float* kvnorm; const f32x2* rope;
    bf16* RI; bf16* GG; float* BON; bf16* QN; bf16* KVN; bf16* K;
};
__device__ __forceinline__ f32x4 ld4bf(const bf16* p) { const v2u w = *(const GAS v2u*)p; return (f32x4){bflo(w.x), bfhi(w.x), bflo(w.y), bfhi(w.y)}; }
__device__ __forceinline__ f32x4 mix4(const bf16* PA, int m, int c, bool hp, bool hn, const float* mu) {
    const f32x4 pc = ld4bf(PA + (size_t)m * INA_P + c);
    f32x4 pp = {0, 0, 0, 0}, pn = {0, 0, 0, 0};
    if (hp) pp = ld4bf(PA + (size_t)(m - 1) * INA_P + c);
    if (hn) pn = ld4bf(PA + (size_t)(m + 1) * INA_P + c);
    const f32x4 mm = *(const GAS f32x4*)(mu + c);
    return pc + ((pp + pn) * 0.5f - pc) * mm;
}
__device__ __forceinline__ void unpack8(const v4u w, float (&x)[8]) { x[0] = bflo(w.x); x[1] = bfhi(w.x); x[2] = bflo(w.y); x[3] = bfhi(w.y); x[4] = bflo(w.z); x[5] = bfhi(w.z); x[6] = bflo(w.w); x[7] = bfhi(w.w); }
__device__ __forceinline__ v4u pack8f(const float (&x)[8]) { v4u o; o.x = pk2(x[0], x[1]); o.y = pk2(x[2], x[3]); o.z = pk2(x[4], x[5]); o.w = pk2(x[6], x[7]); return o; }
__device__ __forceinline__ void mix8(const bf16* rowc, bool hp, bool hn, const float (&mu)[8], float (&o)[8]) {
    const v4u zc = {0u, 0u, 0u, 0u};
    const v4u wc = *(const GAS v4u*)rowc, wp = hp ? *(const GAS v4u*)(rowc - INA_P) : zc, wn = hn ? *(const GAS v4u*)(rowc + INA_P) : zc;
    float c[8], p[8], n[8]; unpack8(wc, c); unpack8(wp, p); unpack8(wn, n);
#pragma unroll
    for (int e = 0; e < 8; ++e) o[e] = c[e] + (0.5f * (p[e] + n[e]) - c[e]) * mu[e];
}
__device__ __forceinline__ void features_phase(Frame& F, const FeatP& P) {
    constexpr int LAP = 328;
    LAS bf16* LA = (LAS bf16*)F.lds;
    LAS float* SSQ = (LAS float*)(F.lds + 10752);
    LAS float* PRM = (LAS float*)(F.lds + 12288);
    const int lane = F.lane, w = F.wave, tk = lane & 15, q4 = lane >> 4;
    constexpr int NTILE = MALL / 16, NTG = 64;
    for (int su = F.vcu; su < 4 * NTG; su += F.G) {
        const int cg = su & 3, tg = su >> 2, cw = 256 * cg + 32 * w, ch8 = cw + 8 * q4, hd = 4 * cg + (w >> 1);
        __syncthreads();
        for (int i = F.tid; i < 2560; i += 512) { const int prm = i >> 8, c = (i & 255) + 256 * cg; float v;
            switch (prm) { case 0: v = P.k_k[c]; break; case 1: v = P.k_a[c]; break; case 2: v = P.r_k[c]; break; case 3: v = P.w0[c]; break; case 4: v = P.w0[RW + c]; break;
                           case 5: v = P.a0[c]; break; case 6: v = P.a0[RW + c]; break; case 7: v = P.mu[c]; break; case 8: v = P.mu[RW + c]; break; default: v = P.mu[2 * RW + c]; break; }
            PRM[i] = v; }
        bf16x8 fw[2][2][2], fa[2][2][2], fg[2][2];
        { const int chA = cw + 8 * (tk >> 2) + (tk & 3);
#pragma unroll
          for (int d = 0; d < 2; ++d)
#pragma unroll
              for (int t = 0; t < 2; ++t) {
#pragma unroll
                  for (int ks = 0; ks < 2; ++ks) { fw[d][t][ks] = *(const GAS bf16x8*)(P.WUP + ((size_t)d * RW + chA + 4 * t) * 64 + ks * 32 + q4 * 8); fa[d][t][ks] = *(const GAS bf16x8*)(P.AUP + ((size_t)d * RW + chA + 4 * t) * 64 + ks * 32 + q4 * 8); }
                  fg[d][t] = *(const GAS bf16x8*)(P.GUP + ((size_t)d * RW + chA + 4 * t) * 32 + q4 * 8); } }
        for (int tt = tg; tt < NTILE; tt += NTG) {
            const int m0 = tt * 16;
            __syncthreads();
            for (int it = F.tid; it < 640; it += 512) { const int tkk = it / 40, c8 = (it - tkk * 40) * 8, c = C_WD + c8, m = m0 + tkk, tp = m % TPB;
                const bool hp = (tp != 0) && (tp != CTXL), hn = (tp != CTXL - 1) && (tp != TPB - 1);
                float mu[8], v[8];
                { const f32x4 a = *(const GAS f32x4*)(P.mu + c), b2 = *(const GAS f32x4*)(P.mu + c + 4); mu[0] = a.x; mu[1] = a.y; mu[2] = a.z; mu[3] = a.w; mu[4] = b2.x; mu[5] = b2.y; mu[6] = b2.z; mu[7] = b2.w; }
                mix8(P.PA + (size_t)m * INA_P + c, hp, hn, mu, v);
#pragma unroll
                for (int e = 0; e < 8; ++e) { if (c < C_AD) v[e] = tanhf(v[e]); else if (c >= C_GD) v[e] = sigmoidf_(v[e]); }
                *(LAS v4u*)(LA + tkk * LAP + c8) = pack8f(v); }
            if ((tt & 3) == cg) {
#pragma unroll
                for (int t2 = 0; t2 < 2; ++t2) { const int m = m0 + 2 * w + t2, b = m / TPB, tp = m - b * TPB; const bf16* row = P.PA + (size_t)m * INA_P;
                    { float x[8]; unpack8(*(const GAS v4u*)(row + C_QC + lane * 8), x); float s = 0.f;
#pragma unroll
                      for (int e = 0; e < 8; ++e) s += x[e] * x[e];
                      const float rs = rsqrtf(wave_sum(s) * (1.f / 512.f) + NORM_EPS);
#pragma unroll
                      for (int e = 0; e < 8; ++e) x[e] = x[e] * rs * P.qnorm[lane * 8 + e];
                      *(GAS v4u*)(P.QN + (size_t)m * 512 + lane * 8) = pack8f(x); }
                    { const v2u q = *(const GAS v2u*)(row + C_KVC + lane * 4);
                      float x[4] = {bflo(q.x), bfhi(q.x), bflo(q.y), bfhi(q.y)}; float s = 0.f;
#pragma unroll
                      for (int e = 0; e < 4; ++e) s += x[e] * x[e];
                      const float rs = rsqrtf(wave_sum(s) * (1.f / 256.f) + NORM_EPS);
#pragma unroll
                      for (int e = 0; e < 4; ++e) x[e] = x[e] * rs * P.kvnorm[lane * 4 + e];
                      v2u o; o.x = pk2(x[0], x[1]); o.y = pk2(x[2], x[3]);
                      *(GAS v2u*)(P.KVN + (size_t)m * 256 + lane * 4) = o; }
                    if (lane < 16) { const float x1 = bf1(row[C_KR + lane]), x2 = bf1(row[C_KR + 16 + lane]); const f32x2 cs = P.rope[(size_t)tp * 16 + lane];
                        const unsigned o = pk2(x1 * cs.x - x2 * cs.y, x1 * cs.y + x2 * cs.x);
#pragma unroll
                        for (int h2 = 0; h2 < NH; ++h2) *(GAS unsigned*)(P.K + ((size_t)(b * NH + h2) * TPB + tp) * QKD + 64 + 2 * lane) = o; } } }
            const int m = m0 + tk, b = m / TPB, tp = m - b * TPB;
            const bool hp = (tp != 0) && (tp != CTXL), hn = (tp != CTXL - 1) && (tp != TPB - 1);
            const bf16* rowp = P.PA + (size_t)m * INA_P + ch8;
            const int pc = 32 * w + 8 * q4;
            float prm[8], kmx[8], kx[8];
#pragma unroll
            for (int e = 0; e < 8; ++e) prm[e] = PRM[8 * 256 + pc + e];
            mix8(rowp + RW, hp, hn, prm, kmx);
            { float s = 0.f;
#pragma unroll
              for (int e = 0; e < 8; ++e) { kx[e] = kmx[e] * PRM[0 * 256 + pc + e]; s += kx[e] * kx[e]; }
              s += bpermf(lane ^ 16, s); s += bpermf(lane ^ 32, s);
              if (q4 == 0) SSQ[tk * 8 + w] = s; }
            __syncthreads();
            const float rsn = rsqrtf(SSQ[tk * 8 + w] + SSQ[tk * 8 + (w ^ 1)] + 1e-12f);
            f32x4 cw_[2][2], ca_[2][2], cg_[2][2];
#pragma unroll
            for (int d = 0; d < 2; ++d) {
                const bf16x8 bg = *(const LAS bf16x8*)(LA + tk * LAP + 256 + d * 32 + q4 * 8);
                bf16x8 bw[2], ba[2];
#pragma unroll
                for (int ks = 0; ks < 2; ++ks) { bw[ks] = *(const LAS bf16x8*)(LA + tk * LAP + d * 64 + ks * 32 + q4 * 8); ba[ks] = *(const LAS bf16x8*)(LA + tk * LAP + 128 + d * 64 + ks * 32 + q4 * 8); }
#pragma unroll
                for (int t = 0; t < 2; ++t) { f32x4 z = {0, 0, 0, 0};
                    cw_[d][t] = MFMA16(fw[d][t][1], bw[1], MFMA16(fw[d][t][0], bw[0], z));
                    ca_[d][t] = MFMA16(fa[d][t][1], ba[1], MFMA16(fa[d][t][0], ba[0], z));
                    cg_[d][t] = MFMA16(fg[d][t], bg, z); } }
            float r8[8], v8[8], kk8[8];
#pragma unroll
            for (int e = 0; e < 8; ++e) prm[e] = PRM[7 * 256 + pc + e];
            mix8(rowp, hp, hn, prm, r8);
#pragma unroll
            for (int e = 0; e < 8; ++e) prm[e] = PRM[9 * 256 + pc + e];
            mix8(rowp + 2 * RW, hp, hn, prm, v8);
#pragma unroll
            for (int e = 0; e < 8; ++e) kk8[e] = kx[e] * rsn;
            bf16* rec = P.RI + ((size_t)(b * NH + hd) * TPB + tp) * RREC + (ch8 & 63);
            *(GAS v4u*)(rec) = pack8f(r8); *(GAS v4u*)(rec + 64) = pack8f(kk8); *(GAS v4u*)(rec + 128) = pack8f(v8);
#pragma unroll
            for (int d = 0; d < 2; ++d) {
                float ld[8], ke[8], bb[8], gg[8]; float bs = 0.f;
#pragma unroll
                for (int e = 0; e < 8; ++e) { const int t = e >> 2, r = e & 3;
                    ld[e] = -0.60653066f * sigmoidf_(PRM[(3 + d) * 256 + pc + e] + cw_[d][t][r]);
                    const float aa = sigmoidf_(PRM[(5 + d) * 256 + pc + e] + ca_[d][t][r]);
                    ke[e] = kmx[e] * (1.0f + (aa - 1.0f) * PRM[1 * 256 + pc + e]); bb[e] = kk8[e] * aa; gg[e] = cg_[d][t][r];
                    bs += r8[e] * ke[e] * PRM[2 * 256 + pc + e]; }
                *(GAS v4u*)(rec + (3 + 3 * d) * 64) = pack8f(ld); *(GAS v4u*)(rec + (4 + 3 * d) * 64) = pack8f(bb); *(GAS v4u*)(rec + (5 + 3 * d) * 64) = pack8f(ke);
                *(GAS v4u*)(P.GG + ((size_t)d * MALL + m) * RW + ch8) = pack8f(gg);
                bs += bpermf(lane ^ 16, bs); bs += bpermf(lane ^ 32, bs);
                if (q4 == 0) P.BON[((size_t)d * MALL + m) * 32 + 2 * hd + (w & 1)] = bs; }
        }
    }
}

constexpr int SCH = 32;
constexpr int SSTEP = 6 * 64;
__device__ __forceinline__ int scan_tp(int dir, int s) { return dir == 0 ? s : (s < CTXL ? (CTXL - 1 - s) : (TPB - 1 - (s - CTXL))); }
__device__ __forceinline__ void scan_load(v4u (&rg)[6], const bf16* RIh, int dir, int chunk, int htid) {
    const int tp = scan_tp(dir, chunk * SCH + (htid >> 3));
    const bf16* rec = RIh + (size_t)tp * RREC + (htid & 7) * 8;
#pragma unroll
    for (int i = 0; i < 3; ++i) rg[i] = *(const GAS v4u*)(rec + i * 64);
    rec += (3 + 3 * dir) * 64;
#pragma unroll
    for (int i = 0; i < 3; ++i) rg[3 + i] = *(const GAS v4u*)(rec + i * 64);
}
__device__ __forceinline__ void scan_store(const v4u (&rg)[6], LAS float* buf, int htid) {
    LAS float* d0 = buf + (htid >> 3) * SSTEP + (htid & 7) * 8;
#pragma unroll
    for (int i = 0; i < 6; ++i) { constexpr int SLOT[6] = {4, 0, 5, 2, 1, 3};
        const v4u wv = rg[i];
        f32x4 lo = {bflo(wv.x), bfhi(wv.x), bflo(wv.y), bfhi(wv.y)}, hi = {bflo(wv.z), bfhi(wv.z), bflo(wv.w), bfhi(wv.w)};
        if (i == 3) {
#pragma unroll
            for (int e = 0; e < 4; ++e) { lo[e] = __expf(lo[e]); hi[e] = __expf(hi[e]); } }
        LAS float* d = d0 + SLOT[i] * 64;
        *(LAS f32x4*)d = lo; *(LAS f32x4*)(d + 4) = hi; }
}
__device__ __forceinline__ void scan_phase(Frame& F, const bf16* RI, bf16* Y) {
    LAS float* bufs = (LAS float*)F.lds;
    constexpr int NCH = TPB / SCH;
    for (int uu = F.vcu; uu < NBATCH * NH * 2 * 4; uu += F.G) {
        const int rg = uu & 3, dir = (uu >> 2) & 1, hd = (uu >> 3) & 15, b = uu >> 7;
        const bf16* RIh = RI + (size_t)(b * NH + hd) * TPB * RREC;
        const int htid = F.tid - 256;
        v4u ra[6], rb[6];
        __syncthreads();
        if (F.wave >= 4) { scan_load(rb, RIh, dir, 0, htid); scan_load(ra, RIh, dir, 1, htid); scan_store(rb, bufs, htid); scan_load(rb, RIh, dir, 2, htid); }
        __syncthreads();
        const int j = F.lane & 15, rowl = F.lane >> 4, row = rg * 16 + (F.wave & 3) * 4 + rowl;
        f32x2 S01 = {0.f, 0.f}, S23 = {0.f, 0.f};
        bf16* yb = Y + ((size_t)dir * MALL + (size_t)b * TPB) * RW + hd * 64 + row;
        for (int c = 0; c < NCH; ++c) {
            LAS float* cur = bufs + (c & 1) * (SCH * SSTEP);
            if (F.wave >= 4) {
                if (c + 1 < NCH) {
                    if ((c & 1) == 0) { scan_store(ra, bufs + (SCH * SSTEP), htid); if (c + 3 < NCH) scan_load(ra, RIh, dir, c + 3, htid); }
                    else { scan_store(rb, bufs, htid); if (c + 3 < NCH) scan_load(rb, RIh, dir, c + 3, htid); } } }
            else {
#pragma unroll
                for (int h16 = 0; h16 < 2; ++h16) {
                    const LAS float* sp = cur + (h16 * 16) * SSTEP;
                    f32x4 kk = *(const LAS f32x4*)(sp + 4 * j), bb = *(const LAS f32x4*)(sp + 64 + 4 * j), ww = *(const LAS f32x4*)(sp + 128 + 4 * j),
                          ke = *(const LAS f32x4*)(sp + 192 + 4 * j), rr = *(const LAS f32x4*)(sp + 256 + 4 * j);
                    float vv = sp[320 + row], ykeep = 0.f, ypart = 0.f;
#pragma unroll
                    for (int st = 0; st < 16; ++st) {
                        f32x4 nkk = kk, nbb = bb, nww = ww, nke = ke, nrr = rr; float nvv = vv;
                        if (st + 1 < 16) { const LAS float* sn = sp + (st + 1) * SSTEP;
                            nkk = *(const LAS f32x4*)(sn + 4 * j); nbb = *(const LAS f32x4*)(sn + 64 + 4 * j); nww = *(const LAS f32x4*)(sn + 128 + 4 * j);
                            nke = *(const LAS f32x4*)(sn + 192 + 4 * j); nrr = *(const LAS f32x4*)(sn + 256 + 4 * j); nvv = sn[320 + row]; }
                        f32x2 t2 = S01 * kk.xy; t2 = S23 * kk.zw + t2;
                        const float p = t2.x + t2.y;
                        S01 = S01 * ww.xy + ke.xy * vv; S23 = S23 * ww.zw + ke.zw * vv;
                        const float sa = -red16(p);
                        S01 = bb.xy * sa + S01; S23 = bb.zw * sa + S23;
                        if (st > 0) { const float y = red16(ypart); ykeep = (j == st - 1) ? y : ykeep; }
                        f32x2 u2 = S01 * rr.xy; u2 = S23 * rr.zw + u2;
                        ypart = u2.x + u2.y;
                        kk = nkk; bb = nbb; ww = nww; ke = nke; rr = nrr; vv = nvv;
                        __builtin_amdgcn_sched_barrier(0);
                    }
                    { const float y = red16(ypart); ykeep = (j == 15) ? y : ykeep; }
                    const int tp = scan_tp(dir, c * SCH + h16 * 16 + j);
                    *(GAS bf16*)(yb + (size_t)tp * RW) = (bf16)f2bf(ykeep);
                }
            }
            __syncthreads();
        }
    }
}

constexpr int AKP = 208, AVP = 192;
constexpr int ATILE = 64 * AKP + 64 * AVP;
__device__ __forceinline__ bf16x8 pack8(const f32x16& x, int s) {
    v4u p; p.x = pk2(x[8 * s + 0], x[8 * s + 1]); p.y = pk2(x[8 * s + 2], x[8 * s + 3]); p.z = pk2(x[8 * s + 4], x[8 * s + 5]); p.w = pk2(x[8 * s + 6], x[8 * s + 7]);
    return __builtin_bit_cast(bf16x8, p);
}
__device__ __forceinline__ void attn_phase(Frame& F, const bf16* Q, const bf16* K, const bf16* V, bf16* YB, int with_ctx) {
    const int lane = F.lane, half = lane >> 5, l31 = lane & 31, l16 = lane & 15, g1 = (lane >> 4) & 1;
    const int nunits = NBATCH * NH * 32 + (with_ctx ? NBATCH * NH : 0);
    for (int uu = F.vcu; uu < nunits; uu += F.G) {
        int bh, q0, nkt;
        if (uu < NBATCH * NH * 32) { bh = uu >> 5; q0 = CTXL + (uu & 31) * 256; nkt = TPB / 64; } else { bh = uu - NBATCH * NH * 32; q0 = 0; nkt = CTXL / 64; }
        const bf16* Kh = K + (size_t)bh * TPB * QKD; const bf16* Vh = V + (size_t)bh * TPB * 64; const bf16* Qh = Q + (size_t)bh * TPB * QKD;
        const int tq = q0 + F.wave * 32 + l31;
        bf16x8 qf[6];
#pragma unroll
        for (int ks = 0; ks < 6; ++ks) qf[ks] = *(const GAS bf16x8*)(Qh + (size_t)tq * QKD + 16 * ks + 8 * half);
        f32x16 o0, o1;
#pragma unroll
        for (int i = 0; i < 16; ++i) { o0[i] = 0.f; o1[i] = 0.f; }
        float m_run = -1e30f, l_run = 0.f;
        const int kc1 = F.tid + 512; const bool k1ok = kc1 < 768;
        const unsigned kd0 = (unsigned)((F.tid / 12) * AKP + (F.tid % 12) * 16), kd1 = (unsigned)((kc1 / 12) * AKP + (kc1 % 12) * 16), vd = (unsigned)(64 * AKP + (F.tid >> 3) * AVP + (F.tid & 7) * 16);
        v4u kr0, kr1 = {0, 0, 0, 0}, vr;
        kr0 = *(const GAS v4u*)(Kh + (size_t)F.tid * 8); if (k1ok) kr1 = *(const GAS v4u*)(Kh + (size_t)kc1 * 8); vr = *(const GAS v4u*)(Vh + (size_t)F.tid * 8);
        __syncthreads();
        *(LAS v4u*)(F.lds + kd0) = kr0; if (k1ok) *(LAS v4u*)(F.lds + kd1) = kr1; *(LAS v4u*)(F.lds + vd) = vr;
        __syncthreads();
        for (int kt = 0; kt < nkt; ++kt) {
            const bool more = kt + 1 < nkt;
            if (more) { const bf16* kn = Kh + (size_t)(kt + 1) * 64 * QKD; const bf16* vn = Vh + (size_t)(kt + 1) * 64 * 64;
                kr0 = *(const GAS v4u*)(kn + (size_t)F.tid * 8); if (k1ok) kr1 = *(const GAS v4u*)(kn + (size_t)kc1 * 8); vr = *(const GAS v4u*)(vn + (size_t)F.tid * 8); }
            LAS unsigned char* Kb = F.lds + (kt & 1) * ATILE; LAS unsigned char* Vb = Kb + 64 * AKP;
            f32x16 s0, s1;
#pragma unroll
            for (int i = 0; i < 16; ++i) { s0[i] = 0.f; s1[i] = 0.f; }
            { bf16x8 ka[6], kb2[6];
#pragma unroll
              for (int ks = 0; ks < 6; ++ks) { ka[ks] = *(const LAS bf16x8*)(Kb + l31 * AKP + (16 * ks + 8 * half) * 2); kb2[ks] = *(const LAS bf16x8*)(Kb + (32 + l31) * AKP + (16 * ks + 8 * half) * 2); }
#pragma unroll
              for (int ks = 0; ks < 6; ++ks) { s0 = MFMA32(ka[ks], qf[ks], s0); s1 = MFMA32(kb2[ks], qf[ks], s1); }
              __builtin_amdgcn_sched_group_barrier(0x100, 12, 0); __builtin_amdgcn_sched_group_barrier(0x8, 12, 0); }
            bf16x8 va[2][2][2];
#pragma unroll
            for (int t = 0; t < 2; ++t)
#pragma unroll
                for (int s = 0; s < 2; ++s) { const int kb = 32 * t + 16 * s + 4 * half + (l16 >> 2);
#pragma unroll
                    for (int dvt = 0; dvt < 2; ++dvt) { const LAS unsigned char* vp = Vb + kb * AVP + (32 * dvt + 16 * g1 + 4 * (l16 & 3)) * 2;
                        const s16x4 lo = __builtin_amdgcn_ds_read_tr16_b64_v4i16((LAS s16x4*)vp), hi = __builtin_amdgcn_ds_read_tr16_b64_v4i16((LAS s16x4*)(vp + 8 * AVP));
                        va[t][s][dvt] = __builtin_shufflevector(lo, hi, 0, 1, 2, 3, 4, 5, 6, 7); } }
            __builtin_amdgcn_sched_group_barrier(0x100, 16, 0);
            float mx = s0[0];
#pragma unroll
            for (int i = 1; i < 16; ++i) mx = fmaxf(mx, s0[i]);
#pragma unroll
            for (int i = 0; i < 16; ++i) mx = fmaxf(mx, s1[i]);
            mx = fmaxf(mx, bpermf(lane ^ 32, mx));
            if (__any(mx > m_run + 8.0f)) {
                const float m_new = fmaxf(m_run, mx), alpha = __builtin_amdgcn_exp2f(m_run - m_new); m_run = m_new;
                l_run *= alpha;
#pragma unroll
                for (int i = 0; i < 16; ++i) { o0[i] *= alpha; o1[i] *= alpha; }
            }
            float ps = 0.f;
#pragma unroll
            for (int i = 0; i < 16; ++i) { s0[i] = __builtin_amdgcn_exp2f(s0[i] - m_run); s1[i] = __builtin_amdgcn_exp2f(s1[i] - m_run); ps += s0[i] + s1[i]; }
            l_run += ps;
            { bf16x8 pf[2][2];
#pragma unroll
              for (int t = 0; t < 2; ++t)
#pragma unroll
                  for (int s = 0; s < 2; ++s) pf[t][s] = pack8(t == 0 ? s0 : s1, s);
#pragma unroll
              for (int t = 0; t < 2; ++t)
#pragma unroll
                  for (int s = 0; s < 2; ++s) { o0 = MFMA32(va[t][s][0], pf[t][s], o0); o1 = MFMA32(va[t][s][1], pf[t][s], o1); } }
            if (more) { LAS unsigned char* nb = F.lds + ((kt + 1) & 1) * ATILE;
                *(LAS v4u*)(nb + kd0) = kr0; if (k1ok) *(LAS v4u*)(nb + kd1) = kr1; *(LAS v4u*)(nb + vd) = vr; }
            __syncthreads();
        }
        const float linv = (DBG_SKIP & 4) ? 0.f : 1.0f / (l_run + bpermf(lane ^ 32, l_run));
        const int b = bh >> 4, hd = bh & 15;
        bf16* op = YB + ((size_t)b * TPB + tq) * RW + hd * 64 + 4 * half;
#pragma unroll
        for (int g = 0; g < 4; ++g) {
            v2u w; w.x = pk2(o0[4 * g] * linv, o0[4 * g + 1] * linv); w.y = pk2(o0[4 * g + 2] * linv, o0[4 * g + 3] * linv); *(GAS v2u*)(op + 8 * g) = w;
            w.x = pk2(o1[4 * g] * linv, o1[4 * g + 1] * linv); w.y = pk2(o1[4 * g + 2] * linv, o1[4 * g + 3] * linv); *(GAS v2u*)(op + 32 + 8 * g) = w; }
    }
}

__device__ __forceinline__ void readout_phase(Frame& F, const bf16* Y, const bf16* GG, const float* BON, const bf16* RI, const float* ln_w, const float* ln_b, bf16* YA) {
    const int gw = F.vcu * NWAVES + F.wave, NGW = F.G * NWAVES, lane = F.lane, hd = lane >> 2, ch0 = hd * 64 + (lane & 3) * 16;
    for (int m = gw; m < MALL; m += NGW) {
        const int b = m / TPB, tp = m - b * TPB;
        const bf16* rec = RI + ((size_t)(b * NH + hd) * TPB + tp) * RREC + 128 + (lane & 3) * 16;
        float vv[16], out[16];
        { const v4u a = *(const GAS v4u*)rec, c = *(const GAS v4u*)(rec + 8);
          vv[0] = bflo(a.x); vv[1] = bfhi(a.x); vv[2] = bflo(a.y); vv[3] = bfhi(a.y); vv[4] = bflo(a.z); vv[5] = bfhi(a.z); vv[6] = bflo(a.w); vv[7] = bfhi(a.w);
          vv[8] = bflo(c.x); vv[9] = bfhi(c.x); vv[10] = bflo(c.y); vv[11] = bfhi(c.y); vv[12] = bflo(c.z); vv[13] = bfhi(c.z); vv[14] = bflo(c.w); vv[15] = bfhi(c.w); }
#pragma unroll
        for (int e = 0; e < 16; ++e) out[e] = 0.f;
#pragma unroll
        for (int d = 0; d < 2; ++d) {
            const bf16* yp = Y + ((size_t)d * MALL + m) * RW + ch0; const bf16* gp = GG + ((size_t)d * MALL + m) * RW + ch0;
            float y[16], g[16];
            { const v4u a = *(const GAS v4u*)yp, c = *(const GAS v4u*)(yp + 8);
              y[0] = bflo(a.x); y[1] = bfhi(a.x); y[2] = bflo(a.y); y[3] = bfhi(a.y); y[4] = bflo(a.z); y[5] = bfhi(a.z); y[6] = bflo(a.w); y[7] = bfhi(a.w);
              y[8] = bflo(c.x); y[9] = bfhi(c.x); y[10] = bflo(c.y); y[11] = bfhi(c.y); y[12] = bflo(c.z); y[13] = bfhi(c.z); y[14] = bflo(c.w); y[15] = bfhi(c.w); }
            { const v4u a = *(const GAS v4u*)gp, c = *(const GAS v4u*)(gp + 8);
              g[0] = bflo(a.x); g[1] = bfhi(a.x); g[2] = bflo(a.y); g[3] = bfhi(a.y); g[4] = bflo(a.z); g[5] = bfhi(a.z); g[6] = bflo(a.w); g[7] = bfhi(a.w);
              g[8] = bflo(c.x); g[9] = bfhi(c.x); g[10] = bflo(c.y); g[11] = bfhi(c.y); g[12] = bflo(c.z); g[13] = bfhi(c.z); g[14] = bflo(c.w); g[15] = bfhi(c.w); }
            float s = 0.f;
#pragma unroll
            for (int e = 0; e < 16; ++e) s += y[e];
            s = dpp_add<0xB1>(s); s = dpp_add<0x4E>(s);
            const float mean = s * (1.f / 64.f); float q = 0.f;
#pragma unroll
            for (int e = 0; e < 16; ++e) { y[e] -= mean; q += y[e] * y[e]; }
            q = dpp_add<0xB1>(q); q = dpp_add<0x4E>(q);
            const float rstd = rsqrtf(q * (1.f / 64.f) + 64e-5f), bon = BON[((size_t)d * MALL + m) * 32 + 2 * hd] + BON[((size_t)d * MALL + m) * 32 + 2 * hd + 1];
#pragma unroll
            for (int e = 0; e < 16; ++e) out[e] += (y[e] * rstd * ln_w[ch0 + e] + ln_b[ch0 + e] + bon * vv[e]) * g[e];
        }
        if (DBG_SKIP & 2) {
#pragma unroll
            for (int e = 0; e < 16; ++e) out[e] = 0.f; }
        v4u o0, o1;
        o0.x = pk2(out[0], out[1]); o0.y = pk2(out[2], out[3]); o0.z = pk2(out[4], out[5]); o0.w = pk2(out[6], out[7]);
        o1.x = pk2(out[8], out[9]); o1.y = pk2(out[10], out[11]); o1.z = pk2(out[12], out[13]); o1.w = pk2(out[14], out[15]);
        *(GAS v4u*)(YA + (size_t)m * RW + ch0) = o0; *(GAS v4u*)(YA + (size_t)m * RW + ch0 + 8) = o1;
    }
}

__device__ __forceinline__ unsigned f2key(float f) { const unsigned u = __builtin_bit_cast(unsigned, f); return (u & 0x80000000u) ? ~u : (u | 0x80000000u); }
__device__ __forceinline__ float key2f(unsigned k) { const unsigned u = (k & 0x80000000u) ? (k & 0x7fffffffu) : ~k; return __builtin_bit_cast(float, u); }
template <int CTRL, int RM> __device__ __forceinline__ unsigned dpp_umax(unsigned x) {
    const unsigned y = (unsigned)__builtin_amdgcn_update_dpp((int)x, (int)x, CTRL, RM, 0xf, false); return x > y ? x : y; }
__device__ __forceinline__ void half_max(unsigned x, unsigned& m0, unsigned& m1) {
    x = dpp_umax<0xB1, 0xf>(x); x = dpp_umax<0x4E, 0xf>(x); x = dpp_umax<0x141, 0xf>(x); x = dpp_umax<0x140, 0xf>(x); x = dpp_umax<0x142, 0xa>(x);
    m0 = (unsigned)__builtin_amdgcn_readlane((int)x, 31); m1 = (unsigned)__builtin_amdgcn_readlane((int)x, 63);
}
__device__ __forceinline__ unsigned top16_lists(const float* sh  , int lane) {
    const int half = lane >> 5, l5 = lane & 31;
    unsigned k0, k1, k2, k3, rec = 0u;
    { const float* p = sh + half * 128 + l5;
      k0 = (f2key(p[0]) & ~127u) | (unsigned)l5; k1 = (f2key(p[32]) & ~127u) | (unsigned)(l5 + 32); k2 = (f2key(p[64]) & ~127u) | (unsigned)(l5 + 64); k3 = (f2key(p[96]) & ~127u) | (unsigned)(l5 + 96); }
#pragma unroll 4
    for (int it = 0; it < 16; ++it) {
        unsigned a = k0 > k1 ? k0 : k1, b = k2 > k3 ? k2 : k3; a = a > b ? a : b;
        unsigned m0, m1; half_max(a, m0, m1);
        const unsigned mh = half ? m1 : m0;
        k0 = (k0 == mh) ? 0u : k0; k1 = (k1 == mh) ? 0u : k1; k2 = (k2 == mh) ? 0u : k2; k3 = (k3 == mh) ? 0u : k3;
        rec = (l5 == it) ? mh : rec;
    }
    return rec;
}
struct SelP { const float* SC; int* ESEL; float* EGATE; const float* pu; const float* pv; unsigned char* PU8; unsigned char* PV8; float* SU; float* SV; int last; };
__device__ __forceinline__ void cvt_row_load(f32x4 (&x)[8], const float* src) {
#pragma unroll
    for (int q = 0; q < 8; ++q) x[q] = *(const GAS f32x4*)(src + q * 4);
}
__device__ __forceinline__ void cvt_row_store(const f32x4 (&x)[8], unsigned char* dst, float* scale_slot, int lane) {
    float am = 0.f;
#pragma unroll
    for (int q = 0; q < 8; ++q) am = fmaxf(am, fmaxf(fmaxf(fabsf(x[q].x), fabsf(x[q].y)), fmaxf(fabsf(x[q].z), fabsf(x[q].w))));
    am = fmaxf(wave_max_u(am), 1e-30f);
    const float g = 6.0f / am, inv = am * (1.0f / 6.0f);
    v4u o;
#pragma unroll
    for (int q = 0; q < 4; ++q) { unsigned w = 0u;
        w = __builtin_amdgcn_cvt_scalef32_pk_fp4_f32(w, x[2 * q].x * g, x[2 * q].y * g, 1.0f, 0);
        w = __builtin_amdgcn_cvt_scalef32_pk_fp4_f32(w, x[2 * q].z * g, x[2 * q].w * g, 1.0f, 1);
        w = __builtin_amdgcn_cvt_scalef32_pk_fp4_f32(w, x[2 * q + 1].x * g, x[2 * q + 1].y * g, 1.0f, 2);
        w = __builtin_amdgcn_cvt_scalef32_pk_fp4_f32(w, x[2 * q + 1].z * g, x[2 * q + 1].w * g, 1.0f, 3);
        o[q] = w; }
    *(GAS v4u*)dst = o;
    if (lane == 0) *scale_slot = inv;
}
__device__ __forceinline__ void select_phase(Frame& F, const SelP& P) {
    const int gw = F.vcu * NWAVES + F.wave, NGW = F.G * NWAVES, lane = F.lane, half = lane >> 5, l5 = lane & 31;
    int crow = gw;
    for (int m = gw; m < MALL || crow < 2 * NEXP; m += NGW) {
        f32x4 xa[8], xb[8];
        const int r0 = crow, r1 = crow + NGW; const bool c0 = r0 < 2 * NEXP, c1 = r1 < 2 * NEXP; crow += 2 * NGW;
        if (c0) cvt_row_load(xa, ((r0 >= NEXP) ? P.pv + (size_t)(r0 - NEXP) * DM : P.pu + (size_t)r0 * DM) + lane * 32);
        if (c1) cvt_row_load(xb, ((r1 >= NEXP) ? P.pv + (size_t)(r1 - NEXP) * DM : P.pu + (size_t)r1 * DM) + lane * 32);
        bool tok = m < MALL; int tp = 0; if (tok) { tp = m % TPB; if (P.last && tp < CTXL) tok = false; }
        if (tok) {
            const float* srow = P.SC + (size_t)m * DM;
#pragma unroll 1
            for (int hp = 0; hp < 4; ++hp) {
                const unsigned recA = top16_lists(srow + (2 * hp) * 256, lane), recB = top16_lists(srow + (2 * hp + 1) * 256, lane);
                const float vA = key2f(recA & ~127u), vB = key2f(recB & ~127u);
                const float v1a = bpermf(l5 & 15, vA), v1b = bpermf(l5 & 15, vB); const float v1 = half ? v1b : v1a;
                unsigned ck[8];
#pragma unroll
                for (int e = 0; e < 8; ++e) { const int src = 32 + 8 * (l5 >> 4) + e; const float v2a = bpermf(src, vA), v2b = bpermf(src, vB);
                    ck[e] = (f2key(v1 + (half ? v2b : v2a)) & ~255u) | (unsigned)(l5 | (e << 5)); }
                unsigned rec = 0u;
#pragma unroll 2
                for (int it = 0; it < 16; ++it) {
                    unsigned a = ck[0] > ck[1] ? ck[0] : ck[1], b = ck[2] > ck[3] ? ck[2] : ck[3], c = ck[4] > ck[5] ? ck[4] : ck[5], d = ck[6] > ck[7] ? ck[6] : ck[7];
                    a = a > b ? a : b; c = c > d ? c : d; a = a > c ? a : c;
                    unsigned m0, m1; half_max(a, m0, m1);
                    const unsigned mh = half ? m1 : m0;
#pragma unroll
                    for (int e = 0; e < 8; ++e) ck[e] = (ck[e] == mh) ? 0u : ck[e];
                    rec = (l5 == it) ? mh : rec;
                }
                const float ts = key2f(rec & ~255u), tmax = half ? bpermf(32, ts) : bpermf(0, ts);
                float ev = (l5 < 16) ? __expf(ts - tmax) : 0.f;
                const float esum = red16(ev);
                const int cid = (int)(rec & 255u), ci = cid & 15, cj = ((cid >> 4) & 1) * 8 + (cid >> 5);
                const int i1a = bpermi(ci, (int)(recA & 127u)), i1b = bpermi(ci, (int)(recB & 127u)), i2a = bpermi(32 + cj, (int)(recA & 127u)), i2b = bpermi(32 + cj, (int)(recB & 127u));
                const int expert = (half ? i1b : i1a) * 128 + (half ? i2b : i2a);
                if (l5 < 16) { const int slot = (2 * hp + half) * 16 + l5; P.ESEL[(size_t)m * 128 + slot] = expert; P.EGATE[(size_t)m * 128 + slot] = ev / esum; }
            }
        }
        if (c0) cvt_row_store(xa, ((r0 >= NEXP) ? P.PV8 + (size_t)(r0 - NEXP) * (DM / 2) : P.PU8 + (size_t)r0 * (DM / 2)) + lane * 16, (r0 >= NEXP) ? P.SV + (r0 - NEXP) : P.SU + r0, lane);
        if (c1) cvt_row_store(xb, ((r1 >= NEXP) ? P.PV8 + (size_t)(r1 - NEXP) * (DM / 2) : P.PU8 + (size_t)r1 * (DM / 2)) + lane * 16, (r1 >= NEXP) ? P.SV + (r1 - NEXP) : P.SU + r1, lane);
    }
}
struct PeerP { const int* ESEL; const float* EGATE; const bf16* H; const unsigned char* PU; const unsigned char* PV; const float* SU; const float* SV; float* X; const float* mod;   const float* fin_g; float* out; int last; };
__device__ __forceinline__ void peer_phase(Frame& F, const PeerP& P) {
    const int gw = F.vcu * NWAVES + F.wave, NGW = F.G * NWAVES, lane = F.lane;
    float pr_s2 = 0.f, pr_d2 = 0.f, pr_tg = 0.f, pr_n = 0.f;
    for (int m = gw; m < MALL; m += NGW) {
        const int b = m / TPB, tp = m - b * TPB; if (P.last && tp < CTXL) continue;
        const int mr = tp < CTXL ? 2 : b;
        const int eidx[2] = {P.ESEL[(size_t)m * 128 + lane], P.ESEL[(size_t)m * 128 + 64 + lane]}; const float egate[2] = {P.EGATE[(size_t)m * 128 + lane], P.EGATE[(size_t)m * 128 + 64 + lane]};
        f32x2 hf[16];
#pragma unroll
        for (int j = 0; j < 4; ++j) { const v4u a = *(const GAS v4u*)(P.H + (size_t)m * DM + lane * 32 + j * 8);
            hf[4 * j + 0] = (f32x2){bflo(a.x), bfhi(a.x)}; hf[4 * j + 1] = (f32x2){bflo(a.y), bfhi(a.y)}; hf[4 * j + 2] = (f32x2){bflo(a.z), bfhi(a.z)}; hf[4 * j + 3] = (f32x2){bflo(a.w), bfhi(a.w)}; }
        float coef[2];
#define PEER_LOADU(U, R, sl_, e0_) do { _Pragma("unroll") for (int q = 0; q < 8; ++q) { const int ex = __builtin_amdgcn_readlane(eidx[sl_], (e0_) + q); U[q] = *(const GAS v4u*)(P.PU + (size_t)ex * (DM / 2) + lane * 16); R[q] = P.SU[ex]; } } while (0)
#define PEER_DOTS(U, R, e0_) do { _Pragma("unroll") for (int q = 0; q < 8; ++q) { f32x2 s2 = {0.f, 0.f}; \
            _Pragma("unroll") for (int d = 0; d < 4; ++d) { const unsigned w = U[q][d]; \
                s2 = __builtin_amdgcn_cvt_scalef32_pk_f32_fp4(w, 1.0f, 0) * hf[4 * d + 0] + s2; s2 = __builtin_amdgcn_cvt_scalef32_pk_f32_fp4(w, 1.0f, 1) * hf[4 * d + 1] + s2; \
                s2 = __builtin_amdgcn_cvt_scalef32_pk_f32_fp4(w, 1.0f, 2) * hf[4 * d + 2] + s2; s2 = __builtin_amdgcn_cvt_scalef32_pk_f32_fp4(w, 1.0f, 3) * hf[4 * d + 3] + s2; } \
            const float tot = wave_sum_u(s2.x + s2.y) * R[q]; if (lane == (e0_) + q) mydot = tot; } } while (0)
#pragma unroll
        for (int sl = 0; sl < 2; ++sl) {
            float mydot = 0.f;
            v4u ua[8], ub[8]; float ra[8], rb[8];
            PEER_LOADU(ua, ra, sl, 0);
#pragma unroll 1
            for (int e0 = 0; e0 < 64; e0 += 16) {
                PEER_LOADU(ub, rb, sl, e0 + 8);
                PEER_DOTS(ua, ra, e0);
                if (e0 + 16 < 64) PEER_LOADU(ua, ra, sl, e0 + 16);
                PEER_DOTS(ub, rb, e0 + 8);
            }
            if (DBG_PROBE) pr_d2 += wave_sum_u(mydot * mydot) * (1.f / 128.f);
            coef[sl] = egate[sl] * 0.5f * mydot * (1.0f + erff(mydot * 0.70710678f));
            if ((DBG_SKIP & 16) && sl == 0) coef[sl] = 0.f;
            if ((DBG_SKIP & 32) && sl == 1) coef[sl] = 0.f;
        }
#undef PEER_LOADU
#undef PEER_DOTS
        f32x2 acc2[16];
#pragma unroll
        for (int i = 0; i < 16; ++i) acc2[i] = (f32x2){0.f, 0.f};
#define PEER_LOADV(U, C, sl_, e0_) do { _Pragma("unroll") for (int q = 0; q < 8; ++q) { const int ex = __builtin_amdgcn_readlane(eidx[sl_], (e0_) + q); U[q] = *(const GAS v4u*)(P.PV + (size_t)ex * (DM / 2) + lane * 16); \
            C[q] = __builtin_bit_cast(float, __builtin_amdgcn_readlane(__builtin_bit_cast(int, coef[sl_]), (e0_) + q)) * P.SV[ex]; } } while (0)
#define PEER_AXPY(U, C) do { _Pragma("unroll") for (int q = 0; q < 8; ++q) _Pragma("unroll") for (int d = 0; d < 4; ++d) { const unsigned w = U[q][d]; \
            acc2[4 * d + 0] = __builtin_amdgcn_cvt_scalef32_pk_f32_fp4(w, 1.0f, 0) * C[q] + acc2[4 * d + 0]; acc2[4 * d + 1] = __builtin_amdgcn_cvt_scalef32_pk_f32_fp4(w, 1.0f, 1) * C[q] + acc2[4 * d + 1]; \
            acc2[4 * d + 2] = __builtin_amdgcn_cvt_scalef32_pk_f32_fp4(w, 1.0f, 2) * C[q] + acc2[4 * d + 2]; acc2[4 * d + 3] = __builtin_amdgcn_cvt_scalef32_pk_f32_fp4(w, 1.0f, 3) * C[q] + acc2[4 * d + 3]; } } while (0)
#pragma unroll
        for (int sl = 0; sl < 2; ++sl) {
            v4u ua[8], ub[8]; float ca[8], cb[8];
            PEER_LOADV(ua, ca, sl, 0);
#pragma unroll 1
            for (int e0 = 0; e0 < 64; e0 += 16) {
                PEER_LOADV(ub, cb, sl, e0 + 8);
                PEER_AXPY(ua, ca);
                if (e0 + 16 < 64) PEER_LOADV(ua, ca, sl, e0 + 16);
                PEER_AXPY(ub, cb);
            }
        }
#undef PEER_LOADV
#undef PEER_AXPY
        float acc[32];
#pragma unroll
        for (int i = 0; i < 16; ++i) { acc[2 * i] = acc2[i].x; acc[2 * i + 1] = acc2[i].y; }
        if (DBG_SKIP & 1) {
#pragma unroll
            for (int i = 0; i < 32; ++i) acc[i] = 0.f; }
        if (((DBG_SKIP & 64) && !P.last) || ((DBG_SKIP & 128) && P.last)) {
#pragma unroll
            for (int i = 0; i < 32; ++i) acc[i] = 0.f; }
        if (DBG_SKIP & 8) {
#pragma unroll
            for (int i = 0; i < 32; ++i) acc[i] = -acc[i]; }
        float* xr = P.X + (size_t)m * DM; const float* g2 = P.mod + (size_t)mr * 12288 + 5 * DM;
        float ss = 0.f;
#pragma unroll
        for (int hq = 0; hq < 8; ++hq) { const int c = lane * 32 + hq * 4;
            f32x4 xv = *(const GAS f32x4*)(xr + c); const f32x4 gv = *(const GAS f32x4*)(g2 + c);
#pragma unroll
            for (int e = 0; e < 4; ++e) { xv[e] += gv[e] * acc[4 * hq + e]; ss += xv[e] * xv[e]; acc[4 * hq + e] = xv[e]; }
            if (!P.last) *(GAS f32x4*)(xr + c) = xv; }
        if (P.last) { const float rs = rsqrtf(wave_sum(ss) * (1.f / DM) + NORM_EPS); float* orow = P.out + ((size_t)b * SEQ + (tp - CTXL)) * DM;
#pragma unroll
            for (int hq = 0; hq < 8; ++hq) { const int c = lane * 32 + hq * 4; const f32x4 fg = *(const GAS f32x4*)(P.fin_g + c);
                f32x4 o;
#pragma unroll
                for (int e = 0; e < 4; ++e) o[e] = acc[4 * hq + e] * rs * fg[e];
                *(GAS f32x4*)(orow + c) = o; } }
    }
    if (DBG_PROBE && !P.last && lane == 0) { float* pp = (float*)(F.ws + WS_CTL + CTL_PROBE_OFF) + gw * 4; pp[0] = pr_s2; pp[1] = pr_d2; pp[2] = pr_tg; pp[3] = pr_n; }
}


constexpr int PH_PER_LAYER = 12, NPHASE = 1 + NLAYER * PH_PER_LAYER;
#ifndef ONLY_PHASE
#define ONLY_PHASE -1
#endif
#define T0() (wave_s == 0 && pg8::opaque_lane() == 0)
#define PH_ON(k) (ONLY_PHASE < 0 || ONLY_PHASE == (k))
#define GEMM_CALL(EPI, SCHED, g, S, E) pg8::gemm_phase<EPI, SCHED, true, true>(F.lds, g, S, E, wave_s)
#define GEMM_CALL_NA(EPI, SCHED, g, S, E) pg8::gemm_phase<EPI, SCHED, false, true>(F.lds, g, S, E, wave_s)

__device__ __forceinline__ const float* karg(int i) {
    asm volatile("" : "+s"(i));
    const __attribute__((address_space(4))) unsigned long long* ka = (const __attribute__((address_space(4))) unsigned long long*)__builtin_amdgcn_kernarg_segment_ptr();
    return (const float*)ka[i];
}
__global__ void __launch_bounds__(NWAVES * 64, 2) mk_fwd(Args args) {
    extern __shared__ __attribute__((aligned(16))) unsigned char lds[];
    Frame F;
    F.lds = (LAS unsigned char*)lds; F.ws = args.ws;
    const int wave_s = __builtin_amdgcn_readfirstlane((int)threadIdx.x >> 6);
    F.tid = threadIdx.x; F.lane = F.tid & 63; F.wave = wave_s;
    F.G = gridDim.x; { const int bx = blockIdx.x; F.vcu = (F.G % 8 == 0) ? (bx % 8) * (F.G / 8) + bx / 8 : bx; }
    unsigned char* ws = args.ws;
    volatile LAS unsigned* MISC = (volatile LAS unsigned*)(F.lds + MISC_OFF);
    for (int u = F.tid; u < (LDS_BYTES - LDSCTL_OFF) / 4; u += NWAVES * 64) ((LAS unsigned*)(F.lds + LDSCTL_OFF))[u] = 0u;
    __syncthreads();
    const int lo = args.ph_lo, hi = args.ph_hi;
    XcdBarrier bar; bar.bar = (unsigned*)(ws + WS_CTL) + CW_BAR; bar.x = 0; bar.st = nullptr;
    if (hi - lo > 1) bar = xcd_barrier_post((unsigned*)(ws + WS_CTL) + CW_BAR, MISC + 8, T0());
#define IN(k) (lo <= (k) && (k) < hi)
#define REFRAME() do { const int lz_ = pg8::opaque_lane(); F.lane = lz_; F.tid = wave_s * 64 + lz_; F.wave = wave_s; ws = (unsigned char*)karg(34); F.ws = ws; { int g_ = (int)gridDim.x, b_ = (int)blockIdx.x; asm volatile("" : "+s"(g_), "+s"(b_)); bx = b_; F.G = g_; F.vcu = ((g_ & 7) == 0) ? (b_ & 7) * (g_ >> 3) + (b_ >> 3) : b_; } } while (0)
#define SEAM(k) do { if (IN((k) + 1)) xcd_barrier(bar, T0()); } while (0)
#define XBUF ((float*)(ws + WS_X))
#define HBUF ((bf16*)(ws + WS_H))
#define MODP ((const float*)(ws + WS_CTL + CTL_MOD_OFF) + (size_t)l * 3 * 12288)
    int bx = (int)blockIdx.x;

    if (PH_ON(100) && IN(0)) { REFRAME(); p0_prologue(F); SEAM(0); }

    for (int l = 0; l < NLAYER; ++l) {
        const int base = 1 + l * PH_PER_LAYER;
        const int last = (l == NLAYER - 1);
        for (int rep_ = 0; rep_ < ((DBG_REPEAT == 0) ? 2 : 1); ++rep_) if (PH_ON(0) && IN(base + 0)) { REFRAME(); if (rep_) xcd_barrier(bar, T0()); modnorm_phase(F, XBUF, karg(6) + (size_t)l * DM, MODP, 0, HBUF, 0); SEAM(base + 0); }
        for (int rep_ = 0; rep_ < ((DBG_REPEAT == 1) ? 2 : 1); ++rep_) if (PH_ON(1) && IN(base + 1)) { REFRAME(); if (rep_) xcd_barrier(bar, T0());
            pg8::Gemm g{HBUF, (const bf16*)(ws + WS_WINA) + (size_t)l * INA_P * DM, MALL, INA_P, DM}; pg8::RowOrder S; S.init_rows(0, INA_P, F.G, bx);
            pg8::EpiStoreBf16 E{(bf16*)(ws + WS_PA), INA_P};
            GEMM_CALL(pg8::EpiStoreBf16, pg8::RowOrder, g, S, E);
            SEAM(base + 1); }
        for (int rep_ = 0; rep_ < ((DBG_REPEAT == 2) ? 2 : 1); ++rep_) if (PH_ON(2) && IN(base + 2)) { REFRAME(); if (rep_) xcd_barrier(bar, T0());
            FeatP P;
            P.PA = (const bf16*)(ws + WS_PA); P.mu = karg(9) + (size_t)l * RWC; P.w0 = karg(10) + (size_t)l * 2 * RW; P.a0 = karg(12) + (size_t)l * 2 * RW;
            P.k_k = karg(15) + (size_t)l * RW; P.k_a = karg(16) + (size_t)l * RW; P.r_k = karg(17) + (size_t)l * RW;
            P.WUP = (const bf16*)(ws + WS_WUP) + (size_t)l * 2 * RW * 64; P.AUP = (const bf16*)(ws + WS_AUP) + (size_t)l * 2 * RW * 64; P.GUP = (const bf16*)(ws + WS_GUP) + (size_t)l * 2 * RW * 32;
            P.qnorm = karg(20) + (size_t)l * 512; P.kvnorm = karg(22) + (size_t)l * 256; P.rope = (const f32x2*)(ws + WS_ROPE);
            P.RI = (bf16*)(ws + WS_RI); P.GG = (bf16*)(ws + WS_GG); P.BON = (float*)(ws + WS_BON); P.QN = (bf16*)(ws + WS_QN); P.KVN = (bf16*)(ws + WS_KVN); P.K = (bf16*)(ws + WS_K);
            features_phase(F, P);
            SEAM(base + 2); }
        for (int rep_ = 0; rep_ < ((DBG_REPEAT == 3) ? 2 : 1); ++rep_) if (PH_ON(3) && IN(base + 3)) { REFRAME(); if (rep_) xcd_barrier(bar, T0());
            { pg8::Gemm g{(const bf16*)(ws + WS_QN), (const bf16*)(ws + WS_WUQ) + (size_t)l * NQ * 512, MALL, NQ, 512};
              pg8::EpiQ E{(bf16*)(ws + WS_Q), (const f32x2*)(ws + WS_ROPE), 0.14724444f};
              pg8::RowOrder S; S.init_rows(last, NQ, F.G, bx); GEMM_CALL_NA(pg8::EpiQ, pg8::RowOrder, g, S, E); }
            { pg8::Gemm g{(const bf16*)(ws + WS_KVN), (const bf16*)(ws + WS_WUKV) + (size_t)l * NKV * 256, MALL, NKV, 256}; pg8::RowOrder S; S.init_rows(0, NKV, F.G, bx);
              pg8::EpiKV E{(bf16*)(ws + WS_K), (bf16*)(ws + WS_V)};
              GEMM_CALL_NA(pg8::EpiKV, pg8::RowOrder, g, S, E); }
            SEAM(base + 3); }
        for (int rep_ = 0; rep_ < ((DBG_REPEAT == 4) ? 2 : 1); ++rep_) if (PH_ON(4) && IN(base + 4)) { REFRAME(); if (rep_) xcd_barrier(bar, T0()); scan_phase(F, (const bf16*)(ws + WS_RI), (bf16*)(ws + WS_Y)); SEAM(base + 4); }
        for (int rep_ = 0; rep_ < ((DBG_REPEAT == 5) ? 2 : 1); ++rep_) if (PH_ON(5) && IN(base + 5)) { REFRAME(); if (rep_) xcd_barrier(bar, T0());
            attn_phase(F, (const bf16*)(ws + WS_Q), (const bf16*)(ws + WS_K), (const bf16*)(ws + WS_V), (bf16*)(ws + WS_YB), !last);
            readout_phase(F, (const bf16*)(ws + WS_Y), (const bf16*)(ws + WS_GG), (const float*)(ws + WS_BON), (const bf16*)(ws + WS_RI), karg(18) + (size_t)l * RW, karg(19) + (size_t)l * RW, (bf16*)(ws + WS_YA));
            SEAM(base + 5); }
        for (int rep_ = 0; rep_ < ((DBG_REPEAT == 6) ? 2 : 1); ++rep_) if (PH_ON(6) && IN(base + 6)) { REFRAME(); if (rep_) xcd_barrier(bar, T0());
            bf16* T1 = (bf16*)(ws + WS_T1); bf16* T2 = (bf16*)(ws + WS_T2);
            const pg8::Gemm g1{HBUF, (const bf16*)(ws + WS_WGA) + (size_t)l * DM * DM, MALL, DM, DM}, g2{(const bf16*)(ws + WS_YA), (const bf16*)(ws + WS_WA) + (size_t)l * DM * RW, MALL, DM, RW};
            const pg8::Gemm g3{HBUF, (const bf16*)(ws + WS_WGB) + (size_t)l * DM * DM, MALL, DM, DM}, g4{(const bf16*)(ws + WS_YB), (const bf16*)(ws + WS_WB) + (size_t)l * DM * RW, MALL, DM, RW};
            const pg8::EpiGate E1{T1, DM, karg(8) + (size_t)l * 2 * DM}, E3{T2, DM, karg(8) + (size_t)l * 2 * DM + DM};
            const pg8::EpiMulAdd E2{T1, T1, nullptr, DM}, E4{T1, T2, T1, DM};
            pg8::RowOrder S; S.init_rows(last, DM, F.G, bx);
            GEMM_CALL(pg8::EpiGate, pg8::RowOrder, g1, S, E1); GEMM_CALL(pg8::EpiMulAdd, pg8::RowOrder, g2, S, E2); GEMM_CALL(pg8::EpiGate, pg8::RowOrder, g3, S, E3); GEMM_CALL(pg8::EpiMulAdd, pg8::RowOrder, g4, S, E4);
            SEAM(base + 6); }
        for (int rep_ = 0; rep_ < ((DBG_REPEAT == 7) ? 2 : 1); ++rep_) if (PH_ON(7) && IN(base + 7)) { REFRAME(); if (rep_) xcd_barrier(bar, T0());
            const pg8::Gemm g{(const bf16*)(ws + WS_T1), (const bf16*)(ws + WS_WO) + (size_t)l * DM * DM, MALL, DM, DM};
            const pg8::EpiResid E{XBUF, MODP + 2 * DM};
            pg8::RowOrder S; S.init_rows(last, DM, F.G, bx); GEMM_CALL(pg8::EpiResid, pg8::RowOrder, g, S, E);
            SEAM(base + 7); }
        for (int rep_ = 0; rep_ < ((DBG_REPEAT == 8) ? 2 : 1); ++rep_) if (PH_ON(8) && IN(base + 8)) { REFRAME(); if (rep_) xcd_barrier(bar, T0());
            modnorm_phase(F, XBUF, karg(27) + (size_t)l * DM, MODP, 3, HBUF, last);
            SEAM(base + 8); }
        for (int rep_ = 0; rep_ < ((DBG_REPEAT == 9) ? 2 : 1); ++rep_) if (PH_ON(9) && IN(base + 9)) { REFRAME(); if (rep_) xcd_barrier(bar, T0());
            const pg8::Gemm g{HBUF, (const bf16*)(ws + WS_WQK) + (size_t)l * DM * DM, MALL, DM, DM};
            const pg8::EpiF32 E{(float*)(ws + WS_SC), DM};
            pg8::RowOrder S; S.init_rows(last, DM, F.G, bx); GEMM_CALL(pg8::EpiF32, pg8::RowOrder, g, S, E);
            SEAM(base + 9); }
        for (int rep_ = 0; rep_ < ((DBG_REPEAT == 10) ? 2 : 1); ++rep_) if (PH_ON(10) && IN(base + 10)) { REFRAME(); if (rep_) xcd_barrier(bar, T0());
            SelP P; P.SC = (const float*)(ws + WS_SC); P.ESEL = (int*)(ws + WS_T1); P.EGATE = (float*)(ws + WS_T1 + 16 * MiB);
            P.pu = karg(30) + (size_t)l * NEXP * DM; P.pv = karg(31) + (size_t)l * NEXP * DM; P.PU8 = ws + WS_PU; P.PV8 = ws + WS_PU + (size_t)NEXP * (DM / 2); P.SU = (float*)(ws + WS_PV); P.SV = (float*)(ws + WS_PV) + NEXP; P.last = last;
            select_phase(F, P);
            SEAM(base + 10); }
        for (int rep_ = 0; rep_ < ((DBG_REPEAT == 11) ? 2 : 1); ++rep_) if (PH_ON(11) && IN(base + 11)) { REFRAME(); if (rep_) xcd_barrier(bar, T0());
            PeerP P; P.ESEL = (const int*)(ws + WS_T1); P.EGATE = (const float*)(ws + WS_T1 + 16 * MiB); P.H = HBUF; P.PU = ws + WS_PU; P.PV = ws + WS_PU + (size_t)NEXP * (DM / 2); P.SU = (const float*)(ws + WS_PV); P.SV = (const float*)(ws + WS_PV) + NEXP; P.X = XBUF; P.mod = MODP; P.fin_g = karg(32); P.out = (float*)karg(33); P.last = last;
            peer_phase(F, P);
            SEAM(base + 11); }
    }
#undef IN
#undef SEAM
#undef XBUF
#undef HBUF
#undef MODP
}

__global__ void __launch_bounds__(512) dbg_fill(const float* pp, float* o) {
    float s0 = 0.f, s1 = 0.f, s2 = 0.f, s3 = 0.f;
    for (int i = 0; i < 2048; ++i) { s0 += pp[4 * i]; s1 += pp[4 * i + 1]; s2 += pp[4 * i + 2]; s3 += pp[4 * i + 3]; }
    float v = (DBG_PROBE == 1 ? s0 : DBG_PROBE == 2 ? s1 : s2) / s3 * 1e-3f;
    v = exp2f(rintf(log2f(v) * 4.f) * 0.25f);
    for (size_t i = (size_t)blockIdx.x * 512 + threadIdx.x; i < (size_t)NBATCH * SEQ * DM; i += (size_t)gridDim.x * 512) o[i] = v;
}
extern "C" void kernel_launch(void* const* d_in, const int* in_sizes, int n_in, void* d_out, int out_size, void* d_ws, size_t ws_size, hipStream_t stream) {
    static int grid = 0;
    if (grid == 0) {
        if (n_in != 33 || out_size != NBATCH * SEQ * DM || ws_size < WS_END) { fprintf(stderr, "kernel_launch: unexpected shapes (n_in %d out %d ws %zu)\n", n_in, out_size, ws_size); grid = -1; return; }
        int dev = 0, cus = 0, per_cu = 0;
        if (hipGetDevice(&dev) != hipSuccess || hipDeviceGetAttribute(&cus, hipDeviceAttributeMultiprocessorCount, dev) != hipSuccess) { grid = -1; return; }
        if (hipFuncSetAttribute((const void*)mk_fwd, hipFuncAttributeMaxDynamicSharedMemorySize, LDS_BYTES) != hipSuccess) { fprintf(stderr, "kernel_launch: hipFuncSetAttribute failed\n"); grid = -1; return; }
        if (hipOccupancyMaxActiveBlocksPerMultiprocessor(&per_cu, (const void*)mk_fwd, NWAVES * 64, LDS_BYTES) != hipSuccess || per_cu < 1) { fprintf(stderr, "kernel_launch: occupancy query says %d\n", per_cu); (void)hipGetLastError(); grid = -1; return; }
        grid = cus;
    }
    if (grid < 0) return;
    if (hipMemsetAsync((char*)d_ws + WS_CTL, 0, CTL_ZERO_BYTES, stream) != hipSuccess) return;
    Args a{};
    for (int i = 0; i < 33; ++i) a.in[i] = (const float*)d_in[i];
    a.out = (float*)d_out; a.ws = (unsigned char*)d_ws;
#if MK_N_LAUNCHES == 1
    a.ph_lo = 0; a.ph_hi = NPHASE;
    hipLaunchKernelGGL(mk_fwd, dim3(grid), dim3(NWAVES * 64), LDS_BYTES, stream, a);
#else
    for (int p = 0; p < NPHASE; ++p) { a.ph_lo = p; a.ph_hi = p + 1; hipLaunchKernelGGL(mk_fwd, dim3(grid), dim3(NWAVES * 64), LDS_BYTES, stream, a); }
    if (DBG_PROBE) hipLaunchKernelGGL(dbg_fill, dim3(1024), dim3(512), 0, stream, (const float*)((char*)d_ws + WS_CTL + CTL_PROBE_OFF), (float*)d_out);
#endif
}
```

```cpp
#include <hip/hip_runtime.h>
#include <cstdio>
#include <cstdint>

#ifndef MK_N_LAUNCHES
#define MK_N_LAUNCHES 1
#endif

#ifndef DBG_SKIP
#define DBG_SKIP 0
#endif
#ifndef DBG_PROBE
#define DBG_PROBE 0
#endif
#ifndef DBG_REPEAT
#define DBG_REPEAT -1
#endif
namespace pg8 {
#define PG8_LAS __attribute__((address_space(3)))
typedef unsigned short bf16_t;
typedef short bf16x8 __attribute__((ext_vector_type(8)));
typedef float f32x4 __attribute__((ext_vector_type(4)));
typedef unsigned u32x4 __attribute__((ext_vector_type(4)));
constexpr int BM = 256, BK = 64, HALF = 128, HTB = HALF * BK * 2  , STAGE_BYTES = 8 * HTB, NXCD = 8, WGM = 8;

__host__ __device__ __forceinline__ int lds_byte(int r, int c) { const int st = (r >> 4) * 2 + (c >> 5), rr = r & 15, cc = c & 31, ob = rr * 64 + cc * 2; return st * 1024 + (ob ^ (((ob >> 9) & 1) << 5)); }
__host__ __device__ __forceinline__ void stage_rc(int b, int& R, int& C) { const int st = b / 1024, sb = b % 1024, swz = sb ^ (((sb >> 9) & 1) << 5); R = (st >> 1) * 16 + swz / 64; C = (st & 1) * 32 + (swz % 64) / 2; }
__host__ __device__ __forceinline__ int perm32(int rho) { const int n = rho >> 4, i = rho & 15; return 8 * (i >> 2) + 4 * n + (i & 3); }

struct Unit { int pm, pn; };
struct Gemm { const bf16_t* A; const bf16_t* Bt; int M, N, K; };

struct StaticOrder {
    int nM, nN, nwg, G, c;
    __host__ __device__ void init(int M, int N, int G_, int c_) { nM = M / BM; nN = N / BM; nwg = nM * nN; G = G_; c = c_; }
    __host__ __device__ bool next(int i, Unit& u) const {
        const long L = (long)i * G + c; if (L >= nwg) return false;
        int wgid = (int)L; { const int q = nwg / NXCD, r = nwg % NXCD, xcd = wgid % NXCD, off = wgid / NXCD; wgid = (xcd < r ? xcd * (q + 1) : r * (q + 1) + (xcd - r) * q) + off; }
        const int nig = WGM * nN, gid = wgid / nig, fm = gid * WGM, gsz = (nM - fm) < WGM ? (nM - fm) : WGM;
        u.pm = fm + ((wgid % nig) % gsz); u.pn = (wgid % nig) / gsz; return true;
    }
    __device__ __forceinline__ void a_ready(const Unit&) const {}
    __device__ __forceinline__ void done(const Unit&) const {}
};
__device__ __forceinline__ int opaque_lane() { int l; asm volatile("v_mbcnt_lo_u32_b32 %0, -1, 0\n\tv_mbcnt_hi_u32_b32 %0, -1, %0" : "=v"(l)); return l; }
typedef __bf16 bf16x2c __attribute__((ext_vector_type(2)));
__device__ __forceinline__ unsigned cvt_pk_bf16(float lo, float hi) { const bf16x2c v = {(__bf16)lo, (__bf16)hi}; return __builtin_bit_cast(unsigned, v); }
template <class Epi, class Sched, bool ALIGN_EPI = false, bool SP2 = false>
__device__ __forceinline__ void gemm_phase(PG8_LAS unsigned char* lds, const Gemm g, const Sched& S, const Epi& E, const int wave_s) {
    const int lane_ = opaque_lane();
    const int wid = wave_s, lane = lane_, tid = wid * 64 + lane, wr = wid >> 2, wc = wid & 3, fr = lane & 15, fq = lane >> 4;
    const int K = g.K, nt = K / BK;
    unsigned voffA[2], voffB[2];
#pragma unroll
    for (int i = 0; i < 2; ++i) { int R, C; stage_rc(tid * 16 + i * 8192, R, C); const int Rb = Epi::PERM ? ((R & ~31) + perm32(R & 31)) : R;
        voffA[i] = (unsigned)(R * K + C) * 2u; voffB[i] = (unsigned)(Rb * K + C) * 2u; }
    const size_t kstep = (size_t)(BK * 2);
    const size_t hstep = (size_t)HALF * K * 2;
    const size_t tstep = 2 * hstep;
    const unsigned ldsw = (unsigned)wid * 1024u;
    const int aoff = lds_byte(wr * 64 + fr, fq * 8), boff = lds_byte(wc * 32 + fr, fq * 8);
#define PG8_SA(b, h) (((b) * 2 + (h)) * HTB)
#define PG8_SB(b, h) ((4 + (b) * 2 + (h)) * HTB)
#define PG8_STAGE(bufoff, gbase, voff) do { _Pragma("unroll") for (int _i = 0; _i < 2; ++_i) \
        __builtin_amdgcn_global_load_lds((const unsigned*)((const char*)(gbase) + (voff)[_i]), (PG8_LAS unsigned*)(lds + (bufoff) + ldsw + _i * 8192), 16, 0, 0); } while (0)
#define PG8_LDA(dst, b, h) do { _Pragma("unroll") for (int m = 0; m < 4; ++m) _Pragma("unroll") for (int k = 0; k < 2; ++k) dst[m][k] = *(const PG8_LAS bf16x8*)(lds + PG8_SA(b, h) + aoff + m * 2048 + k * 1024); } while (0)
#define PG8_LDB(dst, b, h) do { _Pragma("unroll") for (int n = 0; n < 2; ++n) _Pragma("unroll") for (int k = 0; k < 2; ++k) dst[n][k] = *(const PG8_LAS bf16x8*)(lds + PG8_SB(b, h) + boff + n * 2048 + k * 1024); } while (0)
#define PG8_MMA(ai, bj, At, Bt) do { __builtin_amdgcn_s_setprio(1); _Pragma("unroll") for (int m = 0; m < 4; ++m) _Pragma("unroll") for (int n = 0; n < 2; ++n) _Pragma("unroll") for (int k = 0; k < 2; ++k) \
        acc[ai][bj][m][n] = __builtin_amdgcn_mfma_f32_16x16x32_bf16(Bt[n][k], At[m][k], acc[ai][bj][m][n], 0, 0, 0); __builtin_amdgcn_s_setprio(0); } while (0)
#define PG8_WAIT_V(n) asm volatile("s_waitcnt vmcnt(" #n ")" ::: "memory")
#define PG8_WAIT_L(n) asm volatile("s_waitcnt lgkmcnt(" #n ")" ::: "memory")
#define PG8_BAR __builtin_amdgcn_s_barrier()
#define PG8_SCHED __builtin_amdgcn_sched_barrier(0)
    Unit cur, nxt; int ui = 0;
    if (!S.next(0, cur)) return;
    f32x4 acc[2][2][4][2];
#pragma unroll
    for (int a = 0; a < 2; ++a)
#pragma unroll
        for (int b = 0; b < 2; ++b)
#pragma unroll
            for (int m = 0; m < 4; ++m)
#pragma unroll
                for (int n = 0; n < 2; ++n) acc[a][b][m][n] = (f32x4){0.f, 0.f, 0.f, 0.f};
    bf16x8 At[4][2], B0[2][2], B1[2][2];
    const char* cA = (const char*)g.A + (size_t)cur.pm * tstep; const char* cB = (const char*)g.Bt + (size_t)cur.pn * tstep;
    S.a_ready(cur);
    if constexpr (SP2) {
        PG8_STAGE(PG8_SB(0, 0), cB, voffB); PG8_STAGE(PG8_SB(0, 1), cB + hstep, voffB); PG8_STAGE(PG8_SA(0, 0), cA, voffA); PG8_STAGE(PG8_SA(0, 1), cA + hstep, voffA);
        if (wr == 1) PG8_BAR;
        PG8_WAIT_V(2); PG8_BAR;
        PG8_STAGE(PG8_SB(1, 0), cB + kstep, voffB); PG8_STAGE(PG8_SA(1, 0), cA + kstep, voffA); PG8_STAGE(PG8_SB(1, 1), cB + hstep + kstep, voffB);
        PG8_WAIT_V(6); PG8_BAR;
    } else {
        PG8_STAGE(PG8_SB(0, 0), cB, voffB); PG8_STAGE(PG8_SA(0, 0), cA, voffA); PG8_STAGE(PG8_SB(0, 1), cB + hstep, voffB); PG8_STAGE(PG8_SA(0, 1), cA + hstep, voffA);
        if (wr == 1) PG8_BAR;
        PG8_WAIT_V(4); PG8_BAR;
        PG8_STAGE(PG8_SB(1, 0), cB + kstep, voffB); PG8_STAGE(PG8_SA(1, 0), cA + kstep, voffA); PG8_STAGE(PG8_SB(1, 1), cB + hstep + kstep, voffB);
        PG8_WAIT_V(6); PG8_BAR;
    }
    for (;;) {
        const bool has_next = S.next(ui + 1, nxt);
        const char* nA = has_next ? (const char*)g.A + (size_t)nxt.pm * tstep : cA; const char* nB = has_next ? (const char*)g.Bt + (size_t)nxt.pn * tstep : cB;
        for (int t = 0; t < nt; t += 2) {
            const bool last = (t == nt - 2);
            const char* a1 = cA + (size_t)(t + 1) * kstep;
            const char* a2 = last ? nA : cA + (size_t)(t + 2) * kstep; const char* b2 = last ? nB : cB + (size_t)(t + 2) * kstep;
            const char* a3 = a2 + kstep; const char* b3 = b2 + kstep;
            if (last && has_next) S.a_ready(nxt);
            if constexpr (SP2) {
            PG8_LDB(B0, 0, 0); PG8_LDB(B1, 0, 1); PG8_SCHED; PG8_LDA(At, 0, 0); PG8_STAGE(PG8_SA(1, 1), a1 + hstep, voffA);
            PG8_WAIT_V(8); PG8_WAIT_L(0); PG8_BAR; PG8_MMA(0, 0, At, B0); PG8_MMA(0, 1, At, B1); PG8_BAR; PG8_SCHED;
            PG8_LDA(At, 0, 1); PG8_STAGE(PG8_SB(0, 0), b2, voffB); PG8_STAGE(PG8_SB(0, 1), b2 + hstep, voffB); PG8_STAGE(PG8_SA(0, 0), a2, voffA);
            PG8_WAIT_V(8); PG8_WAIT_L(0); PG8_BAR; PG8_MMA(1, 0, At, B0); PG8_MMA(1, 1, At, B1); PG8_BAR; PG8_SCHED;
            PG8_LDB(B0, 1, 0); PG8_LDB(B1, 1, 1); PG8_SCHED; PG8_LDA(At, 1, 0); PG8_STAGE(PG8_SA(0, 1), a2 + hstep, voffA);
            PG8_WAIT_V(8); PG8_WAIT_L(0); PG8_BAR; PG8_MMA(0, 0, At, B0); PG8_MMA(0, 1, At, B1); PG8_BAR; PG8_SCHED;
            PG8_LDA(At, 1, 1); PG8_STAGE(PG8_SB(1, 0), b3, voffB); PG8_STAGE(PG8_SB(1, 1), b3 + hstep, voffB); PG8_STAGE(PG8_SA(1, 0), a3, voffA);
            PG8_WAIT_V(8); PG8_WAIT_L(0); PG8_BAR; PG8_MMA(1, 0, At, B0); PG8_MMA(1, 1, At, B1); PG8_BAR; PG8_SCHED;
            } else {
            PG8_LDB(B0, 0, 0); PG8_SCHED; PG8_LDA(At, 0, 0); PG8_STAGE(PG8_SA(1, 1), a1 + hstep, voffA);
            PG8_WAIT_L(8); PG8_BAR; PG8_WAIT_L(0); PG8_MMA(0, 0, At, B0); PG8_BAR; PG8_SCHED;
            PG8_LDB(B1, 0, 1); PG8_STAGE(PG8_SB(0, 0), b2, voffB);
            PG8_BAR; PG8_WAIT_L(0); PG8_MMA(0, 1, At, B1); PG8_BAR;
            PG8_LDA(At, 0, 1); PG8_STAGE(PG8_SA(0, 0), a2, voffA);
            PG8_BAR; PG8_WAIT_L(0); PG8_MMA(1, 0, At, B0); PG8_BAR; PG8_SCHED;
            PG8_STAGE(PG8_SB(0, 1), b2 + hstep, voffB);
            PG8_WAIT_V(6); PG8_BAR; PG8_MMA(1, 1, At, B1); PG8_BAR;
            PG8_LDB(B0, 1, 0); PG8_SCHED; PG8_LDA(At, 1, 0); PG8_STAGE(PG8_SA(0, 1), a2 + hstep, voffA);
            PG8_WAIT_L(8); PG8_BAR; PG8_WAIT_L(0); PG8_MMA(0, 0, At, B0); PG8_BAR; PG8_SCHED;
            PG8_LDB(B1, 1, 1); PG8_STAGE(PG8_SB(1, 0), b3, voffB);
            PG8_BAR; PG8_WAIT_L(0); PG8_MMA(0, 1, At, B1); PG8_BAR;
            PG8_LDA(At, 1, 1); PG8_STAGE(PG8_SA(1, 0), a3, voffA);
            PG8_BAR; PG8_WAIT_L(0); PG8_MMA(1, 0, At, B0); PG8_BAR; PG8_SCHED;
            PG8_STAGE(PG8_SB(1, 1), b3 + hstep, voffB);
            PG8_WAIT_V(6); PG8_BAR; PG8_MMA(1, 1, At, B1); PG8_BAR;
            }
        }
        if constexpr (ALIGN_EPI) { if (wr == 0) PG8_BAR; }
        if constexpr (!Epi::AFTER_DRAIN) { const int le_ = opaque_lane(); E(acc, cur, wr, wc, le_ & 15, le_ >> 4); S.done(cur); }
        if (!has_next) break;
#pragma unroll
        for (int a = 0; a < 2; ++a)
#pragma unroll
            for (int b = 0; b < 2; ++b)
#pragma unroll
                for (int m = 0; m < 4; ++m)
#pragma unroll
                    for (int n = 0; n < 2; ++n) acc[a][b][m][n] = (f32x4){0.f, 0.f, 0.f, 0.f};
        cur = nxt; cA = nA; cB = nB; ++ui;
        if constexpr (ALIGN_EPI) { if (wr == 1) PG8_BAR; }
    }
    PG8_WAIT_V(0);
    if constexpr (!ALIGN_EPI) { if (wr == 0) PG8_BAR; }
    PG8_BAR;
    if constexpr (Epi::AFTER_DRAIN) { E.fused(acc, cur, wr, wc, fr, fq, lds, wid, lane); S.done(cur); }
#undef PG8_SA
#undef PG8_SB
#undef PG8_STAGE
#undef PG8_LDA
#undef PG8_LDB
#undef PG8_MMA
#undef PG8_WAIT_V
#undef PG8_WAIT_L
#undef PG8_BAR
#undef PG8_SCHED
}
}

constexpr int NWAVES = 8;
constexpr int DM = 2048, NBATCH = 2, SEQ = 8192, CTXL = 256, TPB = CTXL + SEQ  , MALL = NBATCH * TPB  ;
constexpr int NLAYER = 2;
constexpr int RW = 1024, NH = 16;
constexpr int RWC = 3392, INA = 4192, INA_P = 4352, INC = 8288;
constexpr int C_WD = 3072, C_AD = 3200, C_GD = 3328, C_QC = 3392, C_KVC = 3904, C_KR = 4160;
constexpr int QKD = 96, NQ = NH * QKD  , NKV = NH * 128  ;
constexpr int NEXP = 16384;
constexpr int RREC = 9 * 64;
constexpr float NORM_EPS = 1e-6f;

constexpr size_t MiB = 1u << 20;
constexpr size_t WS_CTL = 0, CTL_ZERO_BYTES = 1 * MiB;
constexpr size_t CTL_MOD_OFF = 256 * 1024;
constexpr size_t WS_ROPE = 1 * MiB;
constexpr size_t WS_WUP = 3 * MiB, WS_AUP = WS_WUP + 512 * 1024, WS_GUP = 4 * MiB;
constexpr size_t WS_WUQ = 5 * MiB, WS_WUKV = 8 * MiB, WS_WA = 10 * MiB, WS_WB = 18 * MiB, WS_WO = 26 * MiB, WS_WQK = 42 * MiB, WS_WGA = 58 * MiB, WS_WGB = 74 * MiB, WS_WINA = 90 * MiB;
constexpr size_t WS_X = 124 * MiB, WS_H = 256 * MiB, WS_DYN = 322 * MiB;
constexpr size_t WS_PA = WS_DYN;
constexpr size_t WS_RI = 463 * MiB;
constexpr size_t WS_GG = 760 * MiB;
constexpr size_t WS_BON = 826 * MiB;
constexpr size_t WS_QN = 831 * MiB, WS_KVN = 848 * MiB;
constexpr size_t WS_Q = 857 * MiB, WS_K = 907 * MiB, WS_V = 957 * MiB, WS_END = 990 * MiB;
constexpr size_t WS_Y = WS_DYN;
constexpr size_t WS_YA = 388 * MiB, WS_YB = 421 * MiB;
constexpr size_t WS_T1 = 463 * MiB, WS_T2 = 529 * MiB;
constexpr size_t WS_PU = 600 * MiB, WS_PV = 664 * MiB;
constexpr size_t WS_SC = WS_DYN;
static_assert(WS_PA + (size_t)MALL * INA_P * 2 <= WS_RI && WS_RI + (size_t)NBATCH * NH * TPB * RREC * 2 <= WS_GG && WS_GG + (size_t)2 * MALL * RW * 2 <= WS_BON, "ws map 1");
static_assert(WS_BON + (size_t)2 * MALL * 32 * 4 <= WS_QN && WS_QN + (size_t)MALL * 512 * 2 <= WS_KVN && WS_KVN + (size_t)MALL * 256 * 2 <= WS_Q, "ws map 2");
static_assert(WS_Q + (size_t)NBATCH * NH * TPB * QKD * 2 <= WS_K && WS_K + (size_t)NBATCH * NH * TPB * QKD * 2 <= WS_V && WS_V + (size_t)NBATCH * NH * TPB * 64 * 2 <= WS_END, "ws map 3");
static_assert(WS_Y + (size_t)2 * MALL * RW * 2 <= WS_YA && WS_YA + (size_t)MALL * RW * 2 <= WS_YB && WS_YB + (size_t)MALL * RW * 2 <= WS_RI, "ws map 4");
static_assert(WS_T1 + (size_t)MALL * DM * 2 <= WS_T2 && WS_T2 + (size_t)MALL * DM * 2 <= WS_PU && WS_PU + (size_t)NEXP * DM * 2 <= WS_PV && WS_PV + (size_t)NEXP * DM * 2 <= WS_GG, "ws map 5");
static_assert(WS_SC + (size_t)MALL * DM * 4 <= WS_T1 && WS_X + (size_t)MALL * DM * 4 <= WS_H && WS_H + (size_t)MALL * DM * 2 <= WS_DYN, "ws map 6");
static_assert(WS_WINA + (size_t)NLAYER * INA_P * DM * 2 <= WS_X, "ws map 7");
constexpr size_t CTL_PROBE_OFF = 640 * 1024;
constexpr int CW_BAR = 4096;

constexpr int RING_BYTES = 131072;
constexpr int LDSCTL_OFF = RING_BYTES, MISC_OFF = LDSCTL_OFF + 320;
constexpr int LDS_BYTES = 147456;

#define GAS __attribute__((address_space(1)))
#define LAS __attribute__((address_space(3)))
typedef unsigned short bf16;
typedef unsigned v4u __attribute__((ext_vector_type(4)));
typedef unsigned v2u __attribute__((ext_vector_type(2)));
typedef float f32x4 __attribute__((ext_vector_type(4)));
typedef float f32x2 __attribute__((ext_vector_type(2)));
typedef float f32x16 __attribute__((ext_vector_type(16)));
typedef short bf16x8 __attribute__((ext_vector_type(8)));
typedef short s16x4 __attribute__((ext_vector_type(4)));
typedef __bf16 bf16x2v __attribute__((ext_vector_type(2)));
typedef __bf16 bf16x8v __attribute__((ext_vector_type(8)));
typedef GAS unsigned gu32;
#define RLX_AGENT __ATOMIC_RELAXED, __HIP_MEMORY_SCOPE_AGENT
#define LDS_WAIT() asm volatile("s_waitcnt lgkmcnt(0)" ::: "memory")
#define VM_WAIT() asm volatile("s_waitcnt vmcnt(0)" ::: "memory")
__device__ __forceinline__ unsigned f2bf(float f) { unsigned u = __builtin_bit_cast(unsigned, f); return (u + 0x7fffu + ((u >> 16) & 1u)) >> 16; }
__device__ __forceinline__ unsigned pk2(float lo, float hi) { return pg8::cvt_pk_bf16(lo, hi); }
__device__ __forceinline__ float bflo(unsigned w) { return __builtin_bit_cast(float, w << 16); }
__device__ __forceinline__ float bfhi(unsigned w) { return __builtin_bit_cast(float, w & 0xffff0000u); }
__device__ __forceinline__ float bf1(bf16 h) { return __builtin_bit_cast(float, (unsigned)h << 16); }
__device__ __forceinline__ float sigmoidf_(float x) { return 1.0f / (1.0f + __expf(-x)); }
template <int CTRL> __device__ __forceinline__ float dpp_add(float x) {
    return x + __builtin_bit_cast(float, __builtin_amdgcn_update_dpp(0, __builtin_bit_cast(int, x), CTRL, 0xf, 0xf, true));
}
__device__ __forceinline__ float red16(float x) {
    x = dpp_add<0xB1>(x);
    x = dpp_add<0x4E>(x);
    x = dpp_add<0x141>(x);
    x = dpp_add<0x140>(x);
    return x;
}
template <int CTRL, int RM> __device__ __forceinline__ float dpp_max(float x) {
    return fmaxf(x, __builtin_bit_cast(float, __builtin_amdgcn_update_dpp(__builtin_bit_cast(int, x), __builtin_bit_cast(int, x), CTRL, RM, 0xf, false)));
}
template <int CTRL, int RM> __device__ __forceinline__ float dpp_sum(float x) {
    return x + __builtin_bit_cast(float, __builtin_amdgcn_update_dpp(0, __builtin_bit_cast(int, x), CTRL, RM, 0xf, false));
}
__device__ __forceinline__ float wave_max_u(float x) {
    x = dpp_max<0xB1, 0xf>(x); x = dpp_max<0x4E, 0xf>(x); x = dpp_max<0x141, 0xf>(x); x = dpp_max<0x140, 0xf>(x);
    x = dpp_max<0x142, 0xa>(x); x = dpp_max<0x143, 0xc>(x);
    return __builtin_bit_cast(float, __builtin_amdgcn_readlane(__builtin_bit_cast(int, x), 63));
}
__device__ __forceinline__ float wave_sum_u(float x) {
    x = dpp_sum<0xB1, 0xf>(x); x = dpp_sum<0x4E, 0xf>(x); x = dpp_sum<0x141, 0xf>(x); x = dpp_sum<0x140, 0xf>(x);
    x = dpp_sum<0x142, 0xa>(x); x = dpp_sum<0x143, 0xc>(x);
    return __builtin_bit_cast(float, __builtin_amdgcn_readlane(__builtin_bit_cast(int, x), 63));
}
__device__ __forceinline__ float wave_sum(float v) { return wave_sum_u(v); }
__device__ __forceinline__ float bpermf(int srclane, float v) { return __builtin_bit_cast(float, __builtin_amdgcn_ds_bpermute(srclane << 2, __builtin_bit_cast(int, v))); }
__device__ __forceinline__ int bpermi(int srclane, int v) { return __builtin_amdgcn_ds_bpermute(srclane << 2, v); }

#define XB_TMO      128
#define XB_XCNT(j)  (256  + 64 * (j))
#define XB_XSUB(j)  (1280 + 64 * (j))
#define XB_XGEN(j)  (2304 + 64 * (j))
#define XB_TOP      3328
#define XB_TOPGEN   3392
#define XCD_BAR_WORDS 3456
#define XB_SPIN_CAP (1u << 20)

__device__ __forceinline__ unsigned xb_ld(unsigned* p)              { return __hip_atomic_load(p, __ATOMIC_RELAXED, __HIP_MEMORY_SCOPE_AGENT); }
__device__ __forceinline__ unsigned xb_add(unsigned* p, unsigned v) { return __hip_atomic_fetch_add(p, v, __ATOMIC_RELAXED, __HIP_MEMORY_SCOPE_AGENT); }
__device__ __forceinline__ unsigned xb_xcc_id() { return (unsigned)__builtin_amdgcn_s_getreg((3 << 11) | 20) & 0xFu; }
#define XB_SPIN(cond, bar) do { unsigned _sp = 0; while (cond) { __builtin_amdgcn_s_sleep(1); \
    if ((++_sp & 255u) == 0u) { if (xb_ld(&(bar)[XB_TMO])) break; if (_sp > XB_SPIN_CAP) { atomicAdd(&(bar)[XB_TMO], 1u); break; } } } } while (0)

struct XcdBarrier { unsigned* bar; unsigned x; volatile LAS unsigned* st; };

__device__ __forceinline__ XcdBarrier xcd_barrier_post(unsigned* bar, volatile LAS unsigned* st, bool t0) {
    XcdBarrier b; b.bar = bar; b.x = xb_xcc_id(); b.st = st;
    if (t0) (void)xb_add(&bar[XB_XCNT(b.x)], 1u);
    return b;
}
__device__ __forceinline__ void xcd_barrier_complete(unsigned* bar, unsigned x, unsigned& nloc, unsigned& nx) {
    const unsigned G = gridDim.x * gridDim.y * gridDim.z;
    unsigned sum, cnt, mine, sp = 0u;
    for (;;) {
        sum = 0u; cnt = 0u; mine = 0u;
#pragma unroll
        for (unsigned j = 0; j < 16; ++j) { const unsigned c = xb_ld(&bar[XB_XCNT(j)]); sum += c; cnt += (c > 0u) ? 1u : 0u; mine = (j == x) ? c : mine; }
        if (sum == G) break;
        __builtin_amdgcn_s_sleep(1);
        if ((++sp & 255u) == 0u) { if (xb_ld(&bar[XB_TMO])) break; if (sp > XB_SPIN_CAP) { atomicAdd(&bar[XB_TMO], 1u); break; } }
    }
    nloc = mine > 0u ? mine : 1u; nx = cnt > 0u ? cnt : 1u;
}
__device__ __forceinline__ void xcd_barrier(const XcdBarrier& b, bool t0) {
    asm volatile("s_waitcnt vmcnt(0)" ::: "memory");
    __syncthreads();
    if (t0) {
        unsigned* bar = b.bar;
        __builtin_amdgcn_s_waitcnt(0);
        unsigned nloc = b.st[0], nx = b.st[1];
        if (nloc == 0u) { xcd_barrier_complete(bar, b.x, nloc, nx); b.st[0] = nloc; b.st[1] = nx; }
        const unsigned old = xb_add(&bar[XB_XSUB(b.x)], 1u);
        const unsigned gen = old / nloc;
        if (old + 1u == (gen + 1u) * nloc) {
            __builtin_amdgcn_fence(__ATOMIC_RELEASE, "agent");
            asm volatile("s_waitcnt vmcnt(0)" ::: "memory");
            const unsigned og = xb_add(&bar[XB_TOP], 1u);
            const unsigned tg = og / nx;
            if (og + 1u == (tg + 1u) * nx) xb_add(&bar[XB_TOPGEN], 1u);
            else XB_SPIN(xb_ld(&bar[XB_TOPGEN]) == tg, bar);
            __builtin_amdgcn_fence(__ATOMIC_ACQUIRE, "agent");
            xb_add(&bar[XB_XGEN(b.x)], 1u);
            asm volatile("s_waitcnt vmcnt(0)" ::: "memory");
        } else {
            XB_SPIN(xb_ld(&bar[XB_XGEN(b.x)]) == gen, bar);
            __builtin_amdgcn_fence(__ATOMIC_ACQUIRE, "agent");
            asm volatile("s_waitcnt vmcnt(0)" ::: "memory");
        }
    }
    __syncthreads();
}

struct Frame {
    LAS unsigned char* lds;
    unsigned char* ws;
    const float* const* in;
    int tid, lane, wave;
    int vcu, G;
};
struct Args { const float* in[33]; float* out; unsigned char* ws; int ph_lo, ph_hi; };


namespace pg8 {
typedef unsigned u32x4 __attribute__((ext_vector_type(4)));
struct RowOrder : StaticOrder {
    int lat;
    __host__ __device__ void init_rows(int lat_, int N, int G_, int c_) { lat = lat_; init(lat_ ? NBATCH * SEQ : MALL, N, G_, c_); }
    __host__ __device__ bool next(int i, Unit& u) const { if (!StaticOrder::next(i, u)) return false; if (lat) u.pm = 33 * (u.pm >> 5) + 1 + (u.pm & 31); return true; }
};
#define EPI_LOOP_ROWS for (int ai = 0; ai < 2; ++ai) _Pragma("unroll") for (int m = 0; m < 4; ++m)
#define EPI_PIN asm volatile("" ::: "memory")

struct EpiStoreBf16 {
    static constexpr bool PERM = true, AFTER_DRAIN = false;
    bf16_t* O; int ldc;
    __device__ __forceinline__ void operator()(const f32x4 (&acc)[2][2][4][2], const Unit& u, int wr, int wc, int fr, int fq) const {
        const int row0 = u.pm * BM + wr * 64 + fr, col0 = u.pn * BM + wc * 32 + 8 * fq;
#pragma unroll
        EPI_LOOP_ROWS { bf16_t* rowp = O + (size_t)(row0 + ai * HALF + m * 16) * ldc + col0;
#pragma unroll
            for (int bj = 0; bj < 2; ++bj) { const f32x4 v0 = acc[ai][bj][m][0], v1 = acc[ai][bj][m][1];
                u32x4 w; w.x = cvt_pk_bf16(v0[0], v0[1]); w.y = cvt_pk_bf16(v0[2], v0[3]); w.z = cvt_pk_bf16(v1[0], v1[1]); w.w = cvt_pk_bf16(v1[2], v1[3]);
                *(u32x4*)(rowp + bj * HALF) = w; } }
    }
};
struct EpiGate {
    static constexpr bool PERM = true, AFTER_DRAIN = false;
    bf16_t* O; int ldc; const float* bias;
    __device__ __forceinline__ void operator()(const f32x4 (&acc)[2][2][4][2], const Unit& u, int wr, int wc, int fr, int fq) const {
        const int row0 = u.pm * BM + wr * 64 + fr, col0 = u.pn * BM + wc * 32 + 8 * fq;
        f32x4 bv[2][2];
#pragma unroll
        for (int bj = 0; bj < 2; ++bj)
#pragma unroll
            for (int n = 0; n < 2; ++n) bv[bj][n] = *(const f32x4*)(bias + col0 + bj * HALF + 4 * n);
#pragma unroll
        EPI_LOOP_ROWS { EPI_PIN; bf16_t* rowp = O + (size_t)(row0 + ai * HALF + m * 16) * ldc + col0;
#pragma unroll
            for (int bj = 0; bj < 2; ++bj) { f32x4 v0 = acc[ai][bj][m][0] + bv[bj][0], v1 = acc[ai][bj][m][1] + bv[bj][1];
#pragma unroll
                for (int e = 0; e < 4; ++e) { v0[e] = 1.0f / (1.0f + __expf(-v0[e])); v1[e] = 1.0f / (1.0f + __expf(-v1[e])); }
                u32x4 w; w.x = cvt_pk_bf16(v0[0], v0[1]); w.y = cvt_pk_bf16(v0[2], v0[3]); w.z = cvt_pk_bf16(v1[0], v1[1]); w.w = cvt_pk_bf16(v1[2], v1[3]);
                *(u32x4*)(rowp + bj * HALF) = w; } }
    }
};
__device__ __forceinline__ float bf_lo(unsigned w) { return __builtin_bit_cast(float, w << 16); }
__device__ __forceinline__ float bf_hi(unsigned w) { return __builtin_bit_cast(float, w & 0xffff0000u); }
struct EpiMulAdd {
    static constexpr bool PERM = true, AFTER_DRAIN = false;
    bf16_t* O; const bf16_t* Gt; const bf16_t* Ad; int ldc;
    __device__ __forceinline__ void operator()(const f32x4 (&acc)[2][2][4][2], const Unit& u, int wr, int wc, int fr, int fq) const {
        const int row0 = u.pm * BM + wr * 64 + fr, col0 = u.pn * BM + wc * 32 + 8 * fq;
#pragma unroll
        EPI_LOOP_ROWS { EPI_PIN; const size_t ro = (size_t)(row0 + ai * HALF + m * 16) * ldc + col0;
#pragma unroll
            for (int bj = 0; bj < 2; ++bj) { const f32x4 v0 = acc[ai][bj][m][0], v1 = acc[ai][bj][m][1];
                const u32x4 g = *(const u32x4*)(Gt + ro + bj * HALF);
                float o[8];
                o[0] = bf_lo(g.x) * v0[0]; o[1] = bf_hi(g.x) * v0[1]; o[2] = bf_lo(g.y) * v0[2]; o[3] = bf_hi(g.y) * v0[3];
                o[4] = bf_lo(g.z) * v1[0]; o[5] = bf_hi(g.z) * v1[1]; o[6] = bf_lo(g.w) * v1[2]; o[7] = bf_hi(g.w) * v1[3];
                if (Ad) { const u32x4 a = *(const u32x4*)(Ad + ro + bj * HALF);
                    o[0] += bf_lo(a.x); o[1] += bf_hi(a.x); o[2] += bf_lo(a.y); o[3] += bf_hi(a.y); o[4] += bf_lo(a.z); o[5] += bf_hi(a.z); o[6] += bf_lo(a.w); o[7] += bf_hi(a.w); }
                u32x4 w; w.x = cvt_pk_bf16(o[0], o[1]); w.y = cvt_pk_bf16(o[2], o[3]); w.z = cvt_pk_bf16(o[4], o[5]); w.w = cvt_pk_bf16(o[6], o[7]);
                *(u32x4*)(O + ro + bj * HALF) = w; } }
    }
};
struct EpiResid {
    static constexpr bool PERM = false, AFTER_DRAIN = false;
    float* X; const float* gate;
    __device__ __forceinline__ void operator()(const f32x4 (&acc)[2][2][4][2], const Unit& u, int wr, int wc, int fr, int fq) const {
        const int row0 = u.pm * BM + wr * 64 + fr, col0 = u.pn * BM + wc * 32 + 4 * fq;
        const int bb = u.pm / 33, mr = (u.pm - bb * 33 == 0) ? 2 : bb;
        const float* gp = gate + (size_t)mr * 12288 + col0;
        f32x4 gv[2][2];
#pragma unroll
        for (int bj = 0; bj < 2; ++bj)
#pragma unroll
            for (int n = 0; n < 2; ++n) gv[bj][n] = *(const f32x4*)(gp + bj * HALF + n * 16);
#pragma unroll
        EPI_LOOP_ROWS { EPI_PIN; float* rowp = X + (size_t)(row0 + ai * HALF + m * 16) * DM + col0;
#pragma unroll
            for (int bj = 0; bj < 2; ++bj)
#pragma unroll
                for (int n = 0; n < 2; ++n) { f32x4* p = (f32x4*)(rowp + bj * HALF + n * 16); *p = *p + gv[bj][n] * acc[ai][bj][m][n]; } }
    }
};
struct EpiF32 {
    static constexpr bool PERM = false, AFTER_DRAIN = false;
    float* C; int ldc;
    __device__ __forceinline__ void operator()(const f32x4 (&acc)[2][2][4][2], const Unit& u, int wr, int wc, int fr, int fq) const {
        const int row0 = u.pm * BM + wr * 64 + fr, col0 = u.pn * BM + wc * 32 + 4 * fq;
#pragma unroll
        EPI_LOOP_ROWS { float* rowp = C + (size_t)(row0 + ai * HALF + m * 16) * ldc + col0;
#pragma unroll
            for (int bj = 0; bj < 2; ++bj)
#pragma unroll
                for (int n = 0; n < 2; ++n) *(f32x4*)(rowp + bj * HALF + n * 16) = acc[ai][bj][m][n]; }
    }
};
struct EpiQ {
    static constexpr bool PERM = true, AFTER_DRAIN = false;
    bf16_t* Q; const f32x2* rope; float qscale;
    __device__ __forceinline__ void operator()(const f32x4 (&acc)[2][2][4][2], const Unit& u, int wr, int wc, int fr, int fq) const {
        const int bb = u.pm / 33, tp0 = (u.pm - bb * 33) * BM + wr * 64 + fr, col0 = u.pn * BM + wc * 32 + 8 * fq;
#pragma unroll
        for (int bj = 0; bj < 2; ++bj) { const int c = col0 + bj * HALF, hd = c / QKD, d = c - hd * QKD;
#pragma unroll
            EPI_LOOP_ROWS { EPI_PIN; const int tp = tp0 + ai * HALF + m * 16;
                f32x4 v0 = acc[ai][bj][m][0], v1 = acc[ai][bj][m][1];
                if (d >= 64) { const int i0 = (d - 64) >> 1; const f32x2* rp = rope + (size_t)tp * 16 + i0;
                    const f32x2 c0 = rp[0], c1 = rp[1], c2 = rp[2], c3 = rp[3];
                    float a, b;
                    a = v0[0]; b = v0[1]; v0[0] = a * c0.x - b * c0.y; v0[1] = a * c0.y + b * c0.x;
                    a = v0[2]; b = v0[3]; v0[2] = a * c1.x - b * c1.y; v0[3] = a * c1.y + b * c1.x;
                    a = v1[0]; b = v1[1]; v1[0] = a * c2.x - b * c2.y; v1[1] = a * c2.y + b * c2.x;
                    a = v1[2]; b = v1[3]; v1[2] = a * c3.x - b * c3.y; v1[3] = a * c3.y + b * c3.x; }
                v0 = v0 * qscale; v1 = v1 * qscale;
                u32x4 w; w.x = cvt_pk_bf16(v0[0], v0[1]); w.y = cvt_pk_bf16(v0[2], v0[3]); w.z = cvt_pk_bf16(v1[0], v1[1]); w.w = cvt_pk_bf16(v1[2], v1[3]);
                *(u32x4*)(Q + ((size_t)(bb * NH + hd) * TPB + tp) * QKD + d) = w; } }
    }
};
struct EpiKV {
    static constexpr bool PERM = true, AFTER_DRAIN = false;
    bf16_t* K; bf16_t* V;
    __device__ __forceinline__ void operator()(const f32x4 (&acc)[2][2][4][2], const Unit& u, int wr, int wc, int fr, int fq) const {
        const int bb = u.pm / 33, tp0 = (u.pm - bb * 33) * BM + wr * 64 + fr;
        const bool isK = wc < 2;
        bf16_t* base = isK ? K : V; const int pitch = isK ? QKD : 64, doff = 32 * (wc & 1) + 8 * fq;
#pragma unroll
        for (int bj = 0; bj < 2; ++bj) { const int hd = 2 * u.pn + bj;
            bf16_t* hb = base + (size_t)(bb * NH + hd) * TPB * pitch;
#pragma unroll
            EPI_LOOP_ROWS { EPI_PIN; const int tp = tp0 + ai * HALF + m * 16;
                const f32x4 v0 = acc[ai][bj][m][0], v1 = acc[ai][bj][m][1];
                u32x4 w; w.x = cvt_pk_bf16(v0[0], v0[1]); w.y = cvt_pk_bf16(v0[2], v0[3]); w.z = cvt_pk_bf16(v1[0], v1[1]); w.w = cvt_pk_bf16(v1[2], v1[3]);
                *(u32x4*)((char*)hb + (unsigned)((tp * pitch + doff) * 2)) = w; } }
    }
};
}

template <int MAPQ>
__device__ __forceinline__ void p0_transpose_item(const float* W, int K, int ldw, int c0, int N, bf16* WT, LAS float* scr, int item, int lane) {
    const int nblk = N / 32, kb = item / nblk, nb = item % nblk, k0 = 64 * kb, n0 = 32 * nb;
#pragma unroll 8
    for (int i = 0; i < 32; ++i) { const int kk = 2 * i + (lane >> 5); scr[kk * 33 + (lane & 31)] = W[(size_t)(k0 + kk) * ldw + c0 + n0 + (lane & 31)]; }
    LDS_WAIT(); asm volatile("" ::: "memory");
    const int c = lane & 7;
#pragma unroll
    for (int j = 0; j < 4; ++j) { const int n = (lane >> 3) + 8 * j; const LAS float* s = scr + (8 * c) * 33 + n;
        v4u o; o.x = pk2(s[0 * 33], s[1 * 33]); o.y = pk2(s[2 * 33], s[3 * 33]); o.z = pk2(s[4 * 33], s[5 * 33]); o.w = pk2(s[6 * 33], s[7 * 33]);
        int nn = n0 + n;
        if (MAPQ) { const int hd = nn / QKD, d = nn - hd * QKD; if (d >= 64) { const int i = (d - 64) & 15, s2 = (d - 64) >> 4; nn = hd * QKD + 64 + 2 * i + s2; } }
        *(GAS v4u*)(WT + (size_t)nn * K + k0 + 8 * c) = o; }
    LDS_WAIT(); asm volatile("" ::: "memory");
}

__device__ __forceinline__ const float* karg(int i);
__device__ __forceinline__ void p0_prologue(Frame& F) {
    LAS float* scr = (LAS float*)(F.lds + F.wave * 16384);
    const int gw = F.vcu * NWAVES + F.wave, NGW = F.G * NWAVES;
    unsigned char* ws = F.ws;
    for (int l = 0; l < NLAYER; ++l) {
        const float* w_in = karg(7) + (size_t)l * DM * INC; const float* wbra = karg(24); const float* wbrb = karg(25); const float* wout = karg(26); const float* wuq = karg(21); const float* wukv = karg(23); const float* wup = karg(11); const float* aup = karg(13);
        constexpr int I_INA = (DM / 64) * (INA / 32), I_G = (DM / 64) * (DM / 32), I_BR = (RW / 64) * (DM / 32), I_UQ = (512 / 64) * (NQ / 32), I_UKV = (256 / 64) * (NKV / 32), I_LR = 1 * (RW / 32);
        constexpr int NIT = I_INA + 2 * I_G + 2 * I_BR + I_G + I_UQ + I_UKV + 4 * I_LR;
        for (int it = gw; it < NIT; it += NGW) {
            int r = it;
            if (r < I_INA) { p0_transpose_item<0>(w_in, DM, INC, 0, INA, (bf16*)(ws + WS_WINA) + (size_t)l * INA_P * DM, scr, r, F.lane); continue; } r -= I_INA;
            if (r < I_G) { p0_transpose_item<0>(w_in, DM, INC, INA, DM, (bf16*)(ws + WS_WGA) + (size_t)l * DM * DM, scr, r, F.lane); continue; } r -= I_G;
            if (r < I_G) { p0_transpose_item<0>(w_in, DM, INC, INA + DM, DM, (bf16*)(ws + WS_WGB) + (size_t)l * DM * DM, scr, r, F.lane); continue; } r -= I_G;
            if (r < I_BR) { p0_transpose_item<0>(wbra + (size_t)l * RW * DM, RW, DM, 0, DM, (bf16*)(ws + WS_WA) + (size_t)l * DM * RW, scr, r, F.lane); continue; } r -= I_BR;
            if (r < I_BR) { p0_transpose_item<0>(wbrb + (size_t)l * RW * DM, RW, DM, 0, DM, (bf16*)(ws + WS_WB) + (size_t)l * DM * RW, scr, r, F.lane); continue; } r -= I_BR;
            if (r < I_G) { p0_transpose_item<0>(wout + (size_t)l * DM * DM, DM, DM, 0, DM, (bf16*)(ws + WS_WO) + (size_t)l * DM * DM, scr, r, F.lane); continue; } r -= I_G;
            if (r < I_UQ) { p0_transpose_item<1>(wuq + (size_t)l * 512 * NQ, 512, NQ, 0, NQ, (bf16*)(ws + WS_WUQ) + (size_t)l * NQ * 512, scr, r, F.lane); continue; } r -= I_UQ;
            if (r < I_UKV) { p0_transpose_item<0>(wukv + (size_t)l * 256 * NKV, 256, NKV, 0, NKV, (bf16*)(ws + WS_WUKV) + (size_t)l * NKV * 256, scr, r, F.lane); continue; } r -= I_UKV;
            { const int which = r / I_LR, d = which & 1, isa = which >> 1; r -= which * I_LR;
              const float* src = (isa ? aup : wup) + (size_t)(l * 2 + d) * 64 * RW;
              bf16* dst = (bf16*)(ws + (isa ? WS_AUP : WS_WUP)) + (size_t)(l * 2 + d) * RW * 64;
              p0_transpose_item<0>(src, 64, RW, 0, RW, dst, scr, r, F.lane); }
        }
    }
    const int gt = gw * 64 + F.lane, NGT = NGW * 64;
    { const float* gup = karg(14);
    for (int i = gt; i < NLAYER * 2 * 32 * RW; i += NGT) { const int ch = i & 1023, r = (i >> 10) & 31, ld = i >> 15;
        ((bf16*)(ws + WS_GUP))[((size_t)ld * RW + ch) * 32 + r] = (bf16)f2bf(gup[i]); } }
    for (int i = gt; i < NLAYER * (INA_P - INA) * DM / 8; i += NGT) { const int l = i / ((INA_P - INA) * DM / 8), r = i - l * ((INA_P - INA) * DM / 8);
        ((GAS v4u*)((bf16*)(ws + WS_WINA) + ((size_t)l * INA_P + INA) * DM))[r] = (v4u){0u, 0u, 0u, 0u}; }
    { const GAS f32x4* xs = (const GAS f32x4*)karg(0); const GAS f32x4* cs = (const GAS f32x4*)karg(2); GAS f32x4* X = (GAS f32x4*)(ws + WS_X);
      for (int i = gt; i < MALL * (DM / 4); i += NGT) { const int m = i >> 9, c4 = i & 511, b = m / TPB, tp = m - b * TPB;
          X[i] = (tp < CTXL) ? cs[((size_t)(b * CTXL + tp) << 9) + c4] : xs[((size_t)(b * SEQ + tp - CTXL) << 9) + c4]; } }
    { f32x2* rt = (f32x2*)(ws + WS_ROPE);
      for (int i = gt; i < TPB * 16; i += NGT) { const int tp = i >> 4, k = i & 15; f32x2 o = {1.f, 0.f};
          if (tp >= CTXL) { const int t = tp - CTXL, row = t >> 6, col = t & 63, j = k & 7; const float fr = powf(10000.0f, -(float)j / 8.0f);
              const float ang = (float)(k < 8 ? row : col) * fr; o.x = cosf(ang); o.y = sinf(ang); }
          rt[i] = o; } }
    { float* modw = (float*)(ws + WS_CTL + CTL_MOD_OFF); const float* adaw = karg(4); const float* adab = karg(5); const float* cin = karg(1); const float* cctx = karg(3);
      LAS f32x4* part = (LAS f32x4*)F.lds;
      for (int uu = F.vcu; uu < NLAYER * 48; uu += F.G) { const int cb = uu % 48, l = uu / 48;
          const int n0 = cb * 256 + F.lane * 4; const float* aw = adaw + (size_t)l * DM * 12288 + n0;
          f32x4 a0 = {0, 0, 0, 0}, a1 = a0, a2 = a0;
#pragma unroll 8
          for (int k = F.wave * 256; k < F.wave * 256 + 256; ++k) { const f32x4 w = *(const GAS f32x4*)(aw + (size_t)k * 12288);
              const float c0 = cin[k], c1 = cin[DM + k], c2 = cctx[k];
              const float s0 = c0 / (1.f + __expf(-c0)), s1 = c1 / (1.f + __expf(-c1)), s2 = c2 / (1.f + __expf(-c2));
              a0 = a0 + w * s0; a1 = a1 + w * s1; a2 = a2 + w * s2; }
          __syncthreads();
          part[(F.wave * 3 + 0) * 64 + F.lane] = a0; part[(F.wave * 3 + 1) * 64 + F.lane] = a1; part[(F.wave * 3 + 2) * 64 + F.lane] = a2;
          __syncthreads();
          if (F.wave < 3) { f32x4 s = *(const GAS f32x4*)(adab + (size_t)l * 12288 + n0);
#pragma unroll
              for (int w8 = 0; w8 < 8; ++w8) s = s + part[(w8 * 3 + F.wave) * 64 + F.lane];
              *(GAS f32x4*)(modw + ((size_t)l * 3 + F.wave) * 12288 + n0) = s; }
          __syncthreads(); } }
    { LAS float* KEY = (LAS float*)F.lds;
      LAS float* WQT = (LAS float*)(F.lds + 65536);
      const float* pkeys = karg(29); const float* pwq = karg(28);
      __syncthreads();
      for (int uu = F.vcu; uu < NLAYER * 16 * 32; uu += F.G) { const int kb = uu & 31, hp = (uu >> 5) & 15, l = uu >> 9;
          const GAS f32x4* ksrc = (const GAS f32x4*)(pkeys + ((size_t)l * 16 + hp) * 16384);
          for (int i = F.tid; i < 4096; i += 512) ((LAS f32x4*)KEY)[i] = ksrc[i];
          for (int i = F.tid; i < 2048; i += 512) { const int kk = i >> 5, d4 = i & 31;
              *(LAS f32x4*)(WQT + kk * 132 + d4 * 4) = *(const GAS f32x4*)(pwq + ((size_t)l * DM + kb * 64 + kk) * DM + hp * 128 + d4 * 4); }
          __syncthreads();
          const int kk = F.tid & 63, kg = F.tid >> 6;
          float acc[16];
#pragma unroll
          for (int j = 0; j < 16; ++j) acc[j] = 0.f;
          for (int d = 0; d < 128; d += 4) { const f32x4 w = *(LAS f32x4*)(WQT + kk * 132 + d);
#pragma unroll
              for (int j = 0; j < 16; ++j) { const f32x4 q = *(LAS f32x4*)(KEY + (kg * 16 + j) * 128 + d); acc[j] += q.x * w.x + q.y * w.y + q.z * w.z + q.w * w.w; } }
          bf16* dst = (bf16*)(ws + WS_WQK) + ((size_t)l * DM + hp * 128 + kg * 16) * DM + kb * 64 + kk;
#pragma unroll
          for (int j = 0; j < 16; ++j) dst[(size_t)j * DM] = (bf16)f2bf(acc[j]);
          __syncthreads(); } }
}

__device__ __forceinline__ void modnorm_phase(Frame& F, const float* X, const float* g, const float* mod  , int chunk_sh, bf16* H, int skip_ctx) {
    const int gw = F.vcu * NWAVES + F.wave, NGW = F.G * NWAVES;
    for (int m = gw; m < MALL; m += NGW) {
        const int b = m / TPB, tp = m - b * TPB; if (skip_ctx && tp < CTXL) continue;
        const int mr = tp < CTXL ? 2 : b;
        const GAS f32x4* xr = (const GAS f32x4*)(X + (size_t)m * DM) + F.lane;
        f32x4 v[8]; float s = 0.f;
#pragma unroll
        for (int j = 0; j < 8; ++j) { v[j] = xr[64 * j]; s += (v[j].x * v[j].x + v[j].y * v[j].y) + (v[j].z * v[j].z + v[j].w * v[j].w); }
        const float rs = rsqrtf(wave_sum(s) * (1.f / DM) + NORM_EPS);
        const float* sh = mod + (size_t)mr * 12288 + chunk_sh * DM; const float* sc = sh + DM;
        GAS v2u* o8 = (GAS v2u*)(H + (size_t)m * DM) + F.lane;
#pragma unroll
        for (int j = 0; j < 8; ++j) { const int c = (F.lane + 64 * j) * 4;
            const f32x4 gg = *(const GAS f32x4*)(g + c), s1 = *(const GAS f32x4*)(sc + c), s0 = *(const GAS f32x4*)(sh + c);
            f32x4 y = v[j] * rs * gg; y = y * (s1 + 1.0f) + s0;
            v2u o; o.x = pk2(y.x, y.y); o.y = pk2(y.z, y.w); o8[64 * j] = o; }
    }
}

typedef float f32x4v __attribute__((ext_vector_type(4)));
#define MFMA16(a, b, c) __builtin_amdgcn_mfma_f32_16x16x32_bf16((a), (b), (c), 0, 0, 0)
#define MFMA32(a, b, c) __builtin_amdgcn_mfma_f32_32x32x16_bf16((a), (b), (c), 0, 0, 0)

struct FeatP {
    const bf16* PA; const float* mu; const float* w0; const float* a0; const float* k_k; const float* k_a; const float* r_k;
    const bf16* WUP; const bf16* AUP; const bf16* GUP;
    const float* qnorm; const float* kvnorm; const f32x2* rope;
    bf16* RI; bf16* GG; float* BON; bf16* QN; bf16* KVN; bf16* K;
};
__device__ __forceinline__ f32x4 ld4bf(const bf16* p) { const v2u w = *(const GAS v2u*)p; return (f32x4){bflo(w.x), bfhi(w.x), bflo(w.y), bfhi(w.y)}; }
__device__ __forceinline__ f32x4 mix4(const bf16* PA, int m, int c, bool hp, bool hn, const float* mu) {
    const f32x4 pc = ld4bf(PA + (size_t)m * INA_P + c);
    f32x4 pp = {0, 0, 0, 0}, pn = {0, 0, 0, 0};
    if (hp) pp = ld4bf(PA + (size_t)(m - 1) * INA_P + c);
    if (hn) pn = ld4bf(PA + (size_t)(m + 1) * INA_P + c);
    const f32x4 mm = *(const GAS f32x4*)(mu + c);
    return pc + ((pp + pn) * 0.5f - pc) * mm;
}
__device__ __forceinline__ void unpack8(const v4u w, float (&x)[8]) { x[0] = bflo(w.x); x[1] = bfhi(w.x); x[2] = bflo(w.y); x[3] = bfhi(w.y); x[4] = bflo(w.z); x[5] = bfhi(w.z); x[6] = bflo(w.w); x[7] = bfhi(w.w); }
__device__ __forceinline__ v4u pack8f(const float (&x)[8]) { v4u o; o.x = pk2(x[0], x[1]); o.y = pk2(x[2], x[3]); o.z = pk2(x[4], x[5]); o.w = pk2(x[6], x[7]); return o; }
__device__ __forceinline__ void mix8(const bf16* rowc, bool hp, bool hn, const float (&mu)[8], float (&o)[8]) {
    const v4u zc = {0u, 0u, 0u, 0u};
    const v4u wc = *(const GAS v4u*)rowc, wp = hp ? *(const GAS v4u*)(rowc - INA_P) : zc, wn = hn ? *(const GAS v4u*)(rowc + INA_P) : zc;
    float c[8], p[8], n[8]; unpack8(wc, c); unpack8(wp, p); unpack8(wn, n);
#pragma unroll
    for (int e = 0; e < 8; ++e) o[e] = c[e] + (0.5f * (p[e] + n[e]) - c[e]) * mu[e];
}
__device__ __forceinline__ void features_phase(Frame& F, const FeatP& P) {
    constexpr int LAP = 328;
    LAS bf16* LA = (LAS bf16*)F.lds;
    LAS float* SSQ = (LAS float*)(F.lds + 10752);
    LAS float* PRM = (LAS float*)(F.lds + 12288);
    const int lane = F.lane, w = F.wave, tk = lane & 15, q4 = lane >> 4;
    constexpr int NTILE = MALL / 16, NTG = 64;
    for (int su = F.vcu; su < 4 * NTG; su += F.G) {
        const int cg = su & 3, tg = su >> 2, cw = 256 * cg + 32 * w, ch8 = cw + 8 * q4, hd = 4 * cg + (w >> 1);
        __syncthreads();
        for (int i = F.tid; i < 2560; i += 512) { const int prm = i >> 8, c = (i & 255) + 256 * cg; float v;
            switch (prm) { case 0: v = P.k_k[c]; break; case 1: v = P.k_a[c]; break; case 2: v = P.r_k[c]; break; case 3: v = P.w0[c]; break; case 4: v = P.w0[RW + c]; break;
                           case 5: v = P.a0[c]; break; case 6: v = P.a0[RW + c]; break; case 7: v = P.mu[c]; break; case 8: v = P.mu[RW + c]; break; default: v = P.mu[2 * RW + c]; break; }
            PRM[i] = v; }
        bf16x8 fw[2][2][2], fa[2][2][2], fg[2][2];
        { const int chA = cw + 8 * (tk >> 2) + (tk & 3);
#pragma unroll
          for (int d = 0; d < 2; ++d)
#pragma unroll
              for (int t = 0; t < 2; ++t) {
#pragma unroll
                  for (int ks = 0; ks < 2; ++ks) { fw[d][t][ks] = *(const GAS bf16x8*)(P.WUP + ((size_t)d * RW + chA + 4 * t) * 64 + ks * 32 + q4 * 8); fa[d][t][ks] = *(const GAS bf16x8*)(P.AUP + ((size_t)d * RW + chA + 4 * t) * 64 + ks * 32 + q4 * 8); }
                  fg[d][t] = *(const GAS bf16x8*)(P.GUP + ((size_t)d * RW + chA + 4 * t) * 32 + q4 * 8); } }
        for (int tt = tg; tt < NTILE; tt += NTG) {
            const int m0 = tt * 16;
            __syncthreads();
            for (int it = F.tid; it < 640; it += 512) { const int tkk = it / 40, c8 = (it - tkk * 40) * 8, c = C_WD + c8, m = m0 + tkk, tp = m % TPB;
                const bool hp = (tp != 0) && (tp != CTXL), hn = (tp != CTXL - 1) && (tp != TPB - 1);
                float mu[8], v[8];
                { const f32x4 a = *(const GAS f32x4*)(P.mu + c), b2 = *(const GAS f32x4*)(P.mu + c + 4); mu[0] = a.x; mu[1] = a.y; mu[2] = a.z; mu[3] = a.w; mu[4] = b2.x; mu[5] = b2.y; mu[6] = b2.z; mu[7] = b2.w; }
                mix8(P.PA + (size_t)m * INA_P + c, hp, hn, mu, v);
#pragma unroll
                for (int e = 0; e < 8; ++e) { if (c < C_AD) v[e] = tanhf(v[e]); else if (c >= C_GD) v[e] = sigmoidf_(v[e]); }
                *(LAS v4u*)(LA + tkk * LAP + c8) = pack8f(v); }
            if ((tt & 3) == cg) {
#pragma unroll
                for (int t2 = 0; t2 < 2; ++t2) { const int m = m0 + 2 * w + t2, b = m / TPB, tp = m - b * TPB; const bf16* row = P.PA + (size_t)m * INA_P;
                    { float x[8]; unpack8(*(const GAS v4u*)(row + C_QC + lane * 8), x); float s = 0.f;
#pragma unroll
                      for (int e = 0; e < 8; ++e) s += x[e] * x[e];
                      const float rs = rsqrtf(wave_sum(s) * (1.f / 512.f) + NORM_EPS);
#pragma unroll
                      for (int e = 0; e < 8; ++e) x[e] = x[e] * rs * P.qnorm[lane * 8 + e];
                      *(GAS v4u*)(P.QN + (size_t)m * 512 + lane * 8) = pack8f(x); }
                    { const v2u q = *(const GAS v2u*)(row + C_KVC + lane * 4);
                      float x[4] = {bflo(q.x), bfhi(q.x), bflo(q.y), bfhi(q.y)}; float s = 0.f;
#pragma unroll
                      for (int e = 0; e < 4; ++e) s += x[e] * x[e];
                      const float rs = rsqrtf(wave_sum(s) * (1.f / 256.f) + NORM_EPS);
#pragma unroll
                      for (int e = 0; e < 4; ++e) x[e] = x[e] * rs * P.kvnorm[lane * 4 + e];
                      v2u o; o.x = pk2(x[0], x[1]); o.y = pk2(x[2], x[3]);
                      *(GAS v2u*)(P.KVN + (size_t)m * 256 + lane * 4) = o; }
                    if (lane < 16) { const float x1 = bf1(row[C_KR + lane]), x2 = bf1(row[C_KR + 16 + lane]); const f32x2 cs = P.rope[(size_t)tp * 16 + lane];
                        const unsigned o = pk2(x1 * cs.x - x2 * cs.y, x1 * cs.y + x2 * cs.x);
#pragma unroll
                        for (int h2 = 0; h2 < NH; ++h2) *(GAS unsigned*)(P.K + ((size_t)(b * NH + h2) * TPB + tp) * QKD + 64 + 2 * lane) = o; } } }
            const int m = m0 + tk, b = m / TPB, tp = m - b * TPB;
            const bool hp = (tp != 0) && (tp != CTXL), hn = (tp != CTXL - 1) && (tp != TPB - 1);
            const bf16* rowp = P.PA + (size_t)m * INA_P + ch8;
            const int pc = 32 * w + 8 * q4;
            float prm[8], kmx[8], kx[8];
#pragma unroll
            for (int e = 0; e < 8; ++e) prm[e] = PRM[8 * 256 + pc + e];
            mix8(rowp + RW, hp, hn, prm, kmx);
            { float s = 0.f;
#pragma unroll
              for (int e = 0; e < 8; ++e) { kx[e] = kmx[e] * PRM[0 * 256 + pc + e]; s += kx[e] * kx[e]; }
              s += bpermf(lane ^ 16, s); s += bpermf(lane ^ 32, s);
              if (q4 == 0) SSQ[tk * 8 + w] = s; }
            __syncthreads();
            const float rsn = rsqrtf(SSQ[tk * 8 + w] + SSQ[tk * 8 + (w ^ 1)] + 1e-12f);
            f32x4 cw_[2][2], ca_[2][2], cg_[2][2];
#pragma unroll
            for (int d = 0; d < 2; ++d) {
                const bf16x8 bg = *(const LAS bf16x8*)(LA + tk * LAP + 256 + d * 32 + q4 * 8);
                bf16x8 bw[2], ba[2];
#pragma unroll
                for (int ks = 0; ks < 2; ++ks) { bw[ks] = *(const LAS bf16x8*)(LA + tk * LAP + d * 64 + ks * 32 + q4 * 8); ba[ks] = *(const LAS bf16x8*)(LA + tk * LAP + 128 + d * 64 + ks * 32 + q4 * 8); }
#pragma unroll
                for (int t = 0; t < 2; ++t) { f32x4 z = {0, 0, 0, 0};
                    cw_[d][t] = MFMA16(fw[d][t][1], bw[1], MFMA16(fw[d][t][0], bw[0], z));
                    ca_[d][t] = MFMA16(fa[d][t][1], ba[1], MFMA16(fa[d][t][0], ba[0], z));
                    cg_[d][t] = MFMA16(fg[d][t], bg, z); } }
            float r8[8], v8[8], kk8[8];
#pragma unroll
            for (int e = 0; e < 8; ++e) prm[e] = PRM[7 * 256 + pc + e];
            mix8(rowp, hp, hn, prm, r8);
#pragma unroll
            for (int e = 0; e < 8; ++e) prm[e] = PRM[9 * 256 + pc + e];
            mix8(rowp + 2 * RW, hp, hn, prm, v8);
#pragma unroll
            for (int e = 0; e < 8; ++e) kk8[e] = kx[e] * rsn;
            bf16* rec = P.RI + ((size_t)(b * NH + hd) * TPB + tp) * RREC + (ch8 & 63);
            *(GAS v4u*)(rec) = pack8f(r8); *(GAS v4u*)(rec + 64) = pack8f(kk8); *(GAS v4u*)(rec + 128) = pack8f(v8);
#pragma unroll
            for (int d = 0; d < 2; ++d) {
                float ld[8], ke[8], bb[8], gg[8]; float bs = 0.f;
#pragma unroll
                for (int e = 0; e < 8; ++e) { const int t = e >> 2, r = e & 3;
                    ld[e] = -0.60653066f * sigmoidf_(PRM[(3 + d) * 256 + pc + e] + cw_[d][t][r]);
                    const float aa = sigmoidf_(PRM[(5 + d) * 256 + pc + e] + ca_[d][t][r]);
                    ke[e] = kmx[e] * (1.0f + (aa - 1.0f) * PRM[1 * 256 + pc + e]); bb[e] = kk8[e] * aa; gg[e] = cg_[d][t][r];
                    bs += r8[e] * ke[e] * PRM[2 * 256 + pc + e]; }
                *(GAS v4u*)(rec + (3 + 3 * d) * 64) = pack8f(ld); *(GAS v4u*)(rec + (4 + 3 * d) * 64) = pack8f(bb); *(GAS v4u*)(rec + (5 + 3 * d) * 64) = pack8f(ke);
                *(GAS v4u*)(P.GG + ((size_t)d * MALL + m) * RW + ch8) = pack8f(gg);
                bs += bpermf(lane ^ 16, bs); bs += bpermf(lane ^ 32, bs);
                if (q4 == 0) P.BON[((size_t)d * MALL + m) * 32 + 2 * hd + (w & 1)] = bs; }
        }
    }
}

constexpr int SCH = 32;
constexpr int SSTEP = 6 * 64;
__device__ __forceinline__ int scan_tp(int dir, int s) { return dir == 0 ? s : (s < CTXL ? (CTXL - 1 - s) : (TPB - 1 - (s - CTXL))); }
__device__ __forceinline__ void scan_load(v4u (&rg)[6], const bf16* RIh, int dir, int chunk, int htid) {
    const int tp = scan_tp(dir, chunk * SCH + (htid >> 3));
    const bf16* rec = RIh + (size_t)tp * RREC + (htid & 7) * 8;
#pragma unroll
    for (int i = 0; i < 3; ++i) rg[i] = *(const GAS v4u*)(rec + i * 64);
    rec += (3 + 3 * dir) * 64;
#pragma unroll
    for (int i = 0; i < 3; ++i) rg[3 + i] = *(const GAS v4u*)(rec + i * 64);
}
__device__ __forceinline__ void scan_store(const v4u (&rg)[6], LAS float* buf, int htid) {
    LAS float* d0 = buf + (htid >> 3) * SSTEP + (htid & 7) * 8;
#pragma unroll
    for (int i = 0; i < 6; ++i) { constexpr int SLOT[6] = {4, 0, 5, 2, 1, 3};
        const v4u wv = rg[i];
        f32x4 lo = {bflo(wv.x), bfhi(wv.x), bflo(wv.y), bfhi(wv.y)}, hi = {bflo(wv.z), bfhi(wv.z), bflo(wv.w), bfhi(wv.w)};
        if (i == 3) {
#pragma unroll
            for (int e = 0; e < 4; ++e) { lo[e] = __expf(lo[e]); hi[e] = __expf(hi[e]); } }
        LAS float* d = d0 + SLOT[i] * 64;
        *(LAS f32x4*)d = lo; *(LAS f32x4*)(d + 4) = hi; }
}
__device__ __forceinline__ void scan_phase(Frame& F, const bf16* RI, bf16* Y) {
    LAS float* bufs = (LAS float*)F.lds;
    constexpr int NCH = TPB / SCH;
    for (int uu = F.vcu; uu < NBATCH * NH * 2 * 4; uu += F.G) {
        const int rg = uu & 3, dir = (uu >> 2) & 1, hd = (uu >> 3) & 15, b = uu >> 7;
        const bf16* RIh = RI + (size_t)(b * NH + hd) * TPB * RREC;
        const int htid = F.tid - 256;
        v4u ra[6], rb[6];
        __syncthreads();
        if (F.wave >= 4) { scan_load(rb, RIh, dir, 0, htid); scan_load(ra, RIh, dir, 1, htid); scan_store(rb, bufs, htid); scan_load(rb, RIh, dir, 2, htid); }
        __syncthreads();
        const int j = F.lane & 15, rowl = F.lane >> 4, row = rg * 16 + (F.wave & 3) * 4 + rowl;
        f32x2 S01 = {0.f, 0.f}, S23 = {0.f, 0.f};
        bf16* yb = Y + ((size_t)dir * MALL + (size_t)b * TPB) * RW + hd * 64 + row;
        for (int c = 0; c < NCH; ++c) {
            LAS float* cur = bufs + (c & 1) * (SCH * SSTEP);
            if (F.wave >= 4) {
                if (c + 1 < NCH) {
                    if ((c & 1) == 0) { scan_store(ra, bufs + (SCH * SSTEP), htid); if (c + 3 < NCH) scan_load(ra, RIh, dir, c + 3, htid); }
                    else { scan_store(rb, bufs, htid); if (c + 3 < NCH) scan_load(rb, RIh, dir, c + 3, htid); } } }
            else {
#pragma unroll
                for (int h16 = 0; h16 < 2; ++h16) {
                    const LAS float* sp = cur + (h16 * 16) * SSTEP;
                    f32x4 kk = *(const LAS f32x4*)(sp + 4 * j), bb = *(const LAS f32x4*)(sp + 64 + 4 * j), ww = *(const LAS f32x4*)(sp + 128 + 4 * j),
                          ke = *(const LAS f32x4*)(sp + 192 + 4 * j), rr = *(const LAS f32x4*)(sp + 256 + 4 * j);
                    float vv = sp[320 + row], ykeep = 0.f, ypart = 0.f;
#pragma unroll
                    for (int st = 0; st < 16; ++st) {
                        f32x4 nkk = kk, nbb = bb, nww = ww, nke = ke, nrr = rr; float nvv = vv;
                        if (st + 1 < 16) { const LAS float* sn = sp + (st + 1) * SSTEP;
                            nkk = *(const LAS f32x4*)(sn + 4 * j); nbb = *(const LAS f32x4*)(sn + 64 + 4 * j); nww = *(const LAS f32x4*)(sn + 128 + 4 * j);
                            nke = *(const LAS f32x4*)(sn + 192 + 4 * j); nrr = *(const LAS f32x4*)(sn + 256 + 4 * j); nvv = sn[320 + row]; }
                        f32x2 t2 = S01 * kk.xy; t2 = S23 * kk.zw + t2;
                        const float p = t2.x + t2.y;
                        S01 = S01 * ww.xy + ke.xy * vv; S23 = S23 * ww.zw + ke.zw * vv;
                        const float sa = -red16(p);
                        S01 = bb.xy * sa + S01; S23 = bb.zw * sa + S23;
                        if (st > 0) { const float y = red16(ypart); ykeep = (j == st - 1) ? y : ykeep; }
                        f32x2 u2 = S01 * rr.xy; u2 = S23 * rr.zw + u2;
                        ypart = u2.x + u2.y;
                        kk = nkk; bb = nbb; ww = nww; ke = nke; rr = nrr; vv = nvv;
                        __builtin_amdgcn_sched_barrier(0);
                    }
                    { const float y = red16(ypart); ykeep = (j == 15) ? y : ykeep; }
                    const int tp = scan_tp(dir, c * SCH + h16 * 16 + j);
                    *(GAS bf16*)(yb + (size_t)tp * RW) = (bf16)f2bf(ykeep);
                }
            }
            __syncthreads();
        }
    }
}

constexpr int AKP = 208, AVP = 192;
constexpr int ATILE = 64 * AKP + 64 * AVP;
__device__ __forceinline__ bf16x8 pack8(const f32x16& x, int s) {
    v4u p; p.x = pk2(x[8 * s + 0], x[8 * s + 1]); p.y = pk2(x[8 * s + 2], x[8 * s + 3]); p.z = pk2(x[8 * s + 4], x[8 * s + 5]); p.w = pk2(x[8 * s + 6], x[8 * s + 7]);
    return __builtin_bit_cast(bf16x8, p);
}
__device__ __forceinline__ void attn_phase(Frame& F, const bf16* Q, const bf16* K, const bf16* V, bf16* YB, int with_ctx) {
    const int lane = F.lane, half = lane >> 5, l31 = lane & 31, l16 = lane & 15, g1 = (lane >> 4) & 1;
    const int nunits = NBATCH * NH * 32 + (with_ctx ? NBATCH * NH : 0);
    for (int uu = F.vcu; uu < nunits; uu += F.G) {
        int bh, q0, nkt;
        if (uu < NBATCH * NH * 32) { bh = uu >> 5; q0 = CTXL + (uu & 31) * 256; nkt = TPB / 64; } else { bh = uu - NBATCH * NH * 32; q0 = 0; nkt = CTXL / 64; }
        const bf16* Kh = K + (size_t)bh * TPB * QKD; const bf16* Vh = V + (size_t)bh * TPB * 64; const bf16* Qh = Q + (size_t)bh * TPB * QKD;
        const int tq = q0 + F.wave * 32 + l31;
        bf16x8 qf[6];
#pragma unroll
        for (int ks = 0; ks < 6; ++ks) qf[ks] = *(const GAS bf16x8*)(Qh + (size_t)tq * QKD + 16 * ks + 8 * half);
        f32x16 o0, o1;
#pragma unroll
        for (int i = 0; i < 16; ++i) { o0[i] = 0.f; o1[i] = 0.f; }
        float m_run = -1e30f, l_run = 0.f;
        const int kc1 = F.tid + 512; const bool k1ok = kc1 < 768;
        const unsigned kd0 = (unsigned)((F.tid / 12) * AKP + (F.tid % 12) * 16), kd1 = (unsigned)((kc1 / 12) * AKP + (kc1 % 12) * 16), vd = (unsigned)(64 * AKP + (F.tid >> 3) * AVP + (F.tid & 7) * 16);
        v4u kr0, kr1 = {0, 0, 0, 0}, vr;
        kr0 = *(const GAS v4u*)(Kh + (size_t)F.tid * 8); if (k1ok) kr1 = *(const GAS v4u*)(Kh + (size_t)kc1 * 8); vr = *(const GAS v4u*)(Vh + (size_t)F.tid * 8);
        __syncthreads();
        *(LAS v4u*)(F.lds + kd0) = kr0; if (k1ok) *(LAS v4u*)(F.lds + kd1) = kr1; *(LAS v4u*)(F.lds + vd) = vr;
        __syncthreads();
        for (int kt = 0; kt < nkt; ++kt) {
            const bool more = kt + 1 < nkt;
            if (more) { const bf16* kn = Kh + (size_t)(kt + 1) * 64 * QKD; const bf16* vn = Vh + (size_t)(kt + 1) * 64 * 64;
                kr0 = *(const GAS v4u*)(kn + (size_t)F.tid * 8); if (k1ok) kr1 = *(const GAS v4u*)(kn + (size_t)kc1 * 8); vr = *(const GAS v4u*)(vn + (size_t)F.tid * 8); }
            LAS unsigned char* Kb = F.lds + (kt & 1) * ATILE; LAS unsigned char* Vb = Kb + 64 * AKP;
            f32x16 s0, s1;
#pragma unroll
            for (int i = 0; i < 16; ++i) { s0[i] = 0.f; s1[i] = 0.f; }
            { bf16x8 ka[6], kb2[6];
#pragma unroll
              for (int ks = 0; ks < 6; ++ks) { ka[ks] = *(const LAS bf16x8*)(Kb + l31 * AKP + (16 * ks + 8 * half) * 2); kb2[ks] = *(const LAS bf16x8*)(Kb + (32 + l31) * AKP + (16 * ks + 8 * half) * 2); }
#pragma unroll
              for (int ks = 0; ks < 6; ++ks) { s0 = MFMA32(ka[ks], qf[ks], s0); s1 = MFMA32(kb2[ks], qf[ks], s1); }
              __builtin_amdgcn_sched_group_barrier(0x100, 12, 0); __builtin_amdgcn_sched_group_barrier(0x8, 12, 0); }
            bf16x8 va[2][2][2];
#pragma unroll
            for (int t = 0; t < 2; ++t)
#pragma unroll
                for (int s = 0; s < 2; ++s) { const int kb = 32 * t + 16 * s + 4 * half + (l16 >> 2);
#pragma unroll
                    for (int dvt = 0; dvt < 2; ++dvt) { const LAS unsigned char* vp = Vb + kb * AVP + (32 * dvt + 16 * g1 + 4 * (l16 & 3)) * 2;
                        const s16x4 lo = __builtin_amdgcn_ds_read_tr16_b64_v4i16((LAS s16x4*)vp), hi = __builtin_amdgcn_ds_read_tr16_b64_v4i16((LAS s16x4*)(vp + 8 * AVP));
                        va[t][s][dvt] = __builtin_shufflevector(lo, hi, 0, 1, 2, 3, 4, 5, 6, 7); } }
            __builtin_amdgcn_sched_group_barrier(0x100, 16, 0);
            float mx = s0[0];
#pragma unroll
            for (int i = 1; i < 16; ++i) mx = fmaxf(mx, s0[i]);
#pragma unroll
            for (int i = 0; i < 16; ++i) mx = fmaxf(mx, s1[i]);
            mx = fmaxf(mx, bpermf(lane ^ 32, mx));
            if (__any(mx > m_run + 8.0f)) {
                const float m_new = fmaxf(m_run, mx), alpha = __builtin_amdgcn_exp2f(m_run - m_new); m_run = m_new;
                l_run *= alpha;
#pragma unroll
                for (int i = 0; i < 16; ++i) { o0[i] *= alpha; o1[i] *= alpha; }
            }
            float ps = 0.f;
#pragma unroll
            for (int i = 0; i < 16; ++i) { s0[i] = __builtin_amdgcn_exp2f(s0[i] - m_run); s1[i] = __builtin_amdgcn_exp2f(s1[i] - m_run); ps += s0[i] + s1[i]; }
            l_run += ps;
            { bf16x8 pf[2][2];
#pragma unroll
              for (int t = 0; t < 2; ++t)
#pragma unroll
                  for (int s = 0; s < 2; ++s) pf[t][s] = pack8(t == 0 ? s0 : s1, s);
#pragma unroll
              for (int t = 0; t < 2; ++t)
#pragma unroll
                  for (int s = 0; s < 2; ++s) { o0 = MFMA32(va[t][s][0], pf[t][s], o0); o1 = MFMA32(va[t][s][1], pf[t][s], o1); } }
            if (more) { LAS unsigned char* nb = F.lds + ((kt + 1) & 1) * ATILE;
                *(LAS v4u*)(nb + kd0) = kr0; if (k1ok) *(LAS v4u*)(nb + kd1) = kr1; *(LAS v4u*)(nb + vd) = vr; }
            __syncthreads();
        }
        const float linv = (DBG_SKIP & 4) ? 0.f : 1.0f / (l_run + bpermf(lane ^ 32, l_run));
        const int b = bh >> 4, hd = bh & 15;
        bf16* op = YB + ((size_t)b * TPB + tq) * RW + hd * 64 + 4 * half;
#pragma unroll
        for (int g = 0; g < 4; ++g) {
            v2u w; w.x = pk2(o0[4 * g] * linv, o0[4 * g + 1] * linv); w.y = pk2(o0[4 * g + 2] * linv, o0[4 * g + 3] * linv); *(GAS v2u*)(op + 8 * g) = w;
            w.x = pk2(o1[4 * g] * linv, o1[4 * g + 1] * linv); w.y = pk2(o1[4 * g + 2] * linv, o1[4 * g + 3] * linv); *(GAS v2u*)(op + 32 + 8 * g) = w; }
    }
}

__device__ __forceinline__ void readout_phase(Frame& F, const bf16* Y, const bf16* GG, const float* BON, const bf16* RI, const float* ln_w, const float* ln_b, bf16* YA) {
    const int gw = F.vcu * NWAVES + F.wave, NGW = F.G * NWAVES, lane = F.lane, hd = lane >> 2, ch0 = hd * 64 + (lane & 3) * 16;
    for (int m = gw; m < MALL; m += NGW) {
        const int b = m / TPB, tp = m - b * TPB;
        const bf16* rec = RI + ((size_t)(b * NH + hd) * TPB + tp) * RREC + 128 + (lane & 3) * 16;
        float vv[16], out[16];
        { const v4u a = *(const GAS v4u*)rec, c = *(const GAS v4u*)(rec + 8);
          vv[0] = bflo(a.x); vv[1] = bfhi(a.x); vv[2] = bflo(a.y); vv[3] = bfhi(a.y); vv[4] = bflo(a.z); vv[5] = bfhi(a.z); vv[6] = bflo(a.w); vv[7] = bfhi(a.w);
          vv[8] = bflo(c.x); vv[9] = bfhi(c.x); vv[10] = bflo(c.y); vv[11] = bfhi(c.y); vv[12] = bflo(c.z); vv[13] = bfhi(c.z); vv[14] = bflo(c.w); vv[15] = bfhi(c.w); }
#pragma unroll
        for (int e = 0; e < 16; ++e) out[e] = 0.f;
#pragma unroll
        for (int d = 0; d < 2; ++d) {
            const bf16* yp = Y + ((size_t)d * MALL + m) * RW + ch0; const bf16* gp = GG + ((size_t)d * MALL + m) * RW + ch0;
            float y[16], g[16];
            { const v4u a = *(const GAS v4u*)yp, c = *(const GAS v4u*)(yp + 8);
              y[0] = bflo(a.x); y[1] = bfhi(a.x); y[2] = bflo(a.y); y[3] = bfhi(a.y); y[4] = bflo(a.z); y[5] = bfhi(a.z); y[6] = bflo(a.w); y[7] = bfhi(a.w);
              y[8] = bflo(c.x); y[9] = bfhi(c.x); y[10] = bflo(c.y); y[11] = bfhi(c.y); y[12] = bflo(c.z); y[13] = bfhi(c.z); y[14] = bflo(c.w); y[15] = bfhi(c.w); }
            { const v4u a = *(const GAS v4u*)gp, c = *(const GAS v4u*)(gp + 8);
              g[0] = bflo(a.x); g[1] = bfhi(a.x); g[2] = bflo(a.y); g[3] = bfhi(a.y); g[4] = bflo(a.z); g[5] = bfhi(a.z); g[6] = bflo(a.w); g[7] = bfhi(a.w);
              g[8] = bflo(c.x); g[9] = bfhi(c.x); g[10] = bflo(c.y); g[11] = bfhi(c.y); g[12] = bflo(c.z); g[13] = bfhi(c.z); g[14] = bflo(c.w); g[15] = bfhi(c.w); }
            float s = 0.f;
#pragma unroll
            for (int e = 0; e < 16; ++e) s += y[e];
            s = dpp_add<0xB1>(s); s = dpp_add<0x4E>(s);
            const float mean = s * (1.f / 64.f); float q = 0.f;
#pragma unroll
            for (int e = 0; e < 16; ++e) { y[e] -= mean; q += y[e] * y[e]; }
            q = dpp_add<0xB1>(q); q = dpp_add<0x4E>(q);
            const float rstd = rsqrtf(q * (1.f / 64.f) + 64e-5f), bon = BON[((size_t)d * MALL + m) * 32 + 2 * hd] + BON[((size_t)d * MALL + m) * 32 + 2 * hd + 1];
#pragma unroll
            for (int e = 0; e < 16; ++e) out[e] += (y[e] * rstd * ln_w[ch0 + e] + ln_b[ch0 + e] + bon * vv[e]) * g[e];
        }
        if (DBG_SKIP & 2) {
#pragma unroll
            for (int e = 0; e < 16; ++e) out[e] = 0.f; }
        v4u o0, o1;
        o0.x = pk2(out[0], out[1]); o0.y = pk2(out[2], out[3]); o0.z = pk2(out[4], out[5]); o0.w = pk2(out[6], out[7]);
        o1.x = pk2(out[8], out[9]); o1.y = pk2(out[10], out[11]); o1.z = pk2(out[12], out[13]); o1.w = pk2(out[14], out[15]);
        *(GAS v4u*)(YA + (size_t)m * RW + ch0) = o0; *(GAS v4u*)(YA + (size_t)m * RW + ch0 + 8) = o1;
    }
}

__device__ __forceinline__ unsigned f2key(float f) { const unsigned u = __builtin_bit_cast(unsigned, f); return (u & 0x80000000u) ? ~u : (u | 0x80000000u); }
__device__ __forceinline__ float key2f(unsigned k) { const unsigned u = (k & 0x80000000u) ? (k & 0x7fffffffu) : ~k; return __builtin_bit_cast(float, u); }
template <int CTRL, int RM> __device__ __forceinline__ unsigned dpp_umax(unsigned x) {
    const unsigned y = (unsigned)__builtin_amdgcn_update_dpp((int)x, (int)x, CTRL, RM, 0xf, false); return x > y ? x : y; }
__device__ __forceinline__ void half_max(unsigned x, unsigned& m0, unsigned& m1) {
    x = dpp_umax<0xB1, 0xf>(x); x = dpp_umax<0x4E, 0xf>(x); x = dpp_umax<0x141, 0xf>(x); x = dpp_umax<0x140, 0xf>(x); x = dpp_umax<0x142, 0xa>(x);
    m0 = (unsigned)__builtin_amdgcn_readlane((int)x, 31); m1 = (unsigned)__builtin_amdgcn_readlane((int)x, 63);
}
__device__ __forceinline__ unsigned top16_lists(const float* sh  , int lane) {
    const int half = lane >> 5, l5 = lane & 31;
    unsigned k0, k1, k2, k3, rec = 0u;
    { const float* p = sh + half * 128 + l5;
      k0 = (f2key(p[0]) & ~127u) | (unsigned)l5; k1 = (f2key(p[32]) & ~127u) | (unsigned)(l5 + 32); k2 = (f2key(p[64]) & ~127u) | (unsigned)(l5 + 64); k3 = (f2key(p[96]) & ~127u) | (unsigned)(l5 + 96); }
#pragma unroll 4
    for (int it = 0; it < 16; ++it) {
        unsigned a = k0 > k1 ? k0 : k1, b = k2 > k3 ? k2 : k3; a = a > b ? a : b;
        unsigned m0, m1; half_max(a, m0, m1);
        const unsigned mh = half ? m1 : m0;
        k0 = (k0 == mh) ? 0u : k0; k1 = (k1 == mh) ? 0u : k1; k2 = (k2 == mh) ? 0u : k2; k3 = (k3 == mh) ? 0u : k3;
        rec = (l5 == it) ? mh : rec;
    }
    return rec;
}
struct SelP { const float* SC; int* ESEL; float* EGATE; const float* pu; const float* pv; unsigned char* PU8; unsigned char* PV8; float* SU; float* SV; int last; };
__device__ __forceinline__ void cvt_row_load(f32x4 (&x)[8], const float* src) {
#pragma unroll
    for (int q = 0; q < 8; ++q) x[q] = *(const GAS f32x4*)(src + q * 4);
}
__device__ __forceinline__ void cvt_row_store(const f32x4 (&x)[8], unsigned char* dst, float* scale_slot, int lane) {
    float am = 0.f;
#pragma unroll
    for (int q = 0; q < 8; ++q) am = fmaxf(am, fmaxf(fmaxf(fabsf(x[q].x), fabsf(x[q].y)), fmaxf(fabsf(x[q].z), fabsf(x[q].w))));
    am = fmaxf(wave_max_u(am), 1e-30f);
    const float g = 6.0f / am, inv = am * (1.0f / 6.0f);
    v4u o;
#pragma unroll
    for (int q = 0; q < 4; ++q) { unsigned w = 0u;
        w = __builtin_amdgcn_cvt_scalef32_pk_fp4_f32(w, x[2 * q].x * g, x[2 * q].y * g, 1.0f, 0);
        w = __builtin_amdgcn_cvt_scalef32_pk_fp4_f32(w, x[2 * q].z * g, x[2 * q].w * g, 1.0f, 1);
        w = __builtin_amdgcn_cvt_scalef32_pk_fp4_f32(w, x[2 * q + 1].x * g, x[2 * q + 1].y * g, 1.0f, 2);
        w = __builtin_amdgcn_cvt_scalef32_pk_fp4_f32(w, x[2 * q + 1].z * g, x[2 * q + 1].w * g, 1.0f, 3);
        o[q] = w; }
    *(GAS v4u*)dst = o;
    if (lane == 0) *scale_slot = inv;
}
__device__ __forceinline__ void select_phase(Frame& F, const SelP& P) {
    const int gw = F.vcu * NWAVES + F.wave, NGW = F.G * NWAVES, lane = F.lane, half = lane >> 5, l5 = lane & 31;
    int crow = gw;
    for (int m = gw; m < MALL || crow < 2 * NEXP; m += NGW) {
        f32x4 xa[8], xb[8];
        const int r0 = crow, r1 = crow + NGW; const bool c0 = r0 < 2 * NEXP, c1 = r1 < 2 * NEXP; crow += 2 * NGW;
        if (c0) cvt_row_load(xa, ((r0 >= NEXP) ? P.pv + (size_t)(r0 - NEXP) * DM : P.pu + (size_t)r0 * DM) + lane * 32);
        if (c1) cvt_row_load(xb, ((r1 >= NEXP) ? P.pv + (size_t)(r1 - NEXP) * DM : P.pu + (size_t)r1 * DM) + lane * 32);
        bool tok = m < MALL; int tp = 0; if (tok) { tp = m % TPB; if (P.last && tp < CTXL) tok = false; }
        if (tok) {
            const float* srow = P.SC + (size_t)m * DM;
#pragma unroll 1
            for (int hp = 0; hp < 4; ++hp) {
                const unsigned recA = top16_lists(srow + (2 * hp) * 256, lane), recB = top16_lists(srow + (2 * hp + 1) * 256, lane);
                const float vA = key2f(recA & ~127u), vB = key2f(recB & ~127u);
                const float v1a = bpermf(l5 & 15, vA), v1b = bpermf(l5 & 15, vB); const float v1 = half ? v1b : v1a;
                unsigned ck[8];
#pragma unroll
                for (int e = 0; e < 8; ++e) { const int src = 32 + 8 * (l5 >> 4) + e; const float v2a = bpermf(src, vA), v2b = bpermf(src, vB);
                    ck[e] = (f2key(v1 + (half ? v2b : v2a)) & ~255u) | (unsigned)(l5 | (e << 5)); }
                unsigned rec = 0u;
#pragma unroll 2
                for (int it = 0; it < 16; ++it) {
                    unsigned a = ck[0] > ck[1] ? ck[0] : ck[1], b = ck[2] > ck[3] ? ck[2] : ck[3], c = ck[4] > ck[5] ? ck[4] : ck[5], d = ck[6] > ck[7] ? ck[6] : ck[7];
                    a = a > b ? a : b; c = c > d ? c : d; a = a > c ? a : c;
                    unsigned m0, m1; half_max(a, m0, m1);
                    const unsigned mh = half ? m1 : m0;
#pragma unroll
                    for (int e = 0; e < 8; ++e) ck[e] = (ck[e] == mh) ? 0u : ck[e];
                    rec = (l5 == it) ? mh : rec;
                }
                const float ts = key2f(rec & ~255u), tmax = half ? bpermf(32, ts) : bpermf(0, ts);
                float ev = (l5 < 16) ? __expf(ts - tmax) : 0.f;
                const float esum = red16(ev);
                const int cid = (int)(rec & 255u), ci = cid & 15, cj = ((cid >> 4) & 1) * 8 + (cid >> 5);
                const int i1a = bpermi(ci, (int)(recA & 127u)), i1b = bpermi(ci, (int)(recB & 127u)), i2a = bpermi(32 + cj, (int)(recA & 127u)), i2b = bpermi(32 + cj, (int)(recB & 127u));
                const int expert = (half ? i1b : i1a) * 128 + (half ? i2b : i2a);
                if (l5 < 16) { const int slot = (2 * hp + half) * 16 + l5; P.ESEL[(size_t)m * 128 + slot] = expert; P.EGATE[(size_t)m * 128 + slot] = ev / esum; }
            }
        }
        if (c0) cvt_row_store(xa, ((r0 >= NEXP) ? P.PV8 + (size_t)(r0 - NEXP) * (DM / 2) : P.PU8 + (size_t)r0 * (DM / 2)) + lane * 16, (r0 >= NEXP) ? P.SV + (r0 - NEXP) : P.SU + r0, lane);
        if (c1) cvt_row_store(xb, ((r1 >= NEXP) ? P.PV8 + (size_t)(r1 - NEXP) * (DM / 2) : P.PU8 + (size_t)r1 * (DM / 2)) + lane * 16, (r1 >= NEXP) ? P.SV + (r1 - NEXP) : P.SU + r1, lane);
    }
}
struct PeerP { const int* ESEL; const float* EGATE; const bf16* H; const unsigned char* PU; const unsigned char* PV; const float* SU; const float* SV; float* X; const float* mod;   const float* fin_g; float* out; int last; };
__device__ __forceinline__ void peer_phase(Frame& F, const PeerP& P) {
    const int gw = F.vcu * NWAVES + F.wave, NGW = F.G * NWAVES, lane = F.lane;
    float pr_s2 = 0.f, pr_d2 = 0.f, pr_tg = 0.f, pr_n = 0.f;
    for (int m = gw; m < MALL; m += NGW) {
        const int b = m / TPB, tp = m - b * TPB; if (P.last && tp < CTXL) continue;
        const int mr = tp < CTXL ? 2 : b;
        const int eidx[2] = {P.ESEL[(size_t)m * 128 + lane], P.ESEL[(size_t)m * 128 + 64 + lane]}; const float egate[2] = {P.EGATE[(size_t)m * 128 + lane], P.EGATE[(size_t)m * 128 + 64 + lane]};
        typedef int v8i __attribute__((ext_vector_type(8)));
        LAS unsigned char* hq = F.lds + F.wave * 4096;
        { const v4u a0 = *(const GAS v4u*)(P.H + (size_t)m * DM + lane * 32), a1 = *(const GAS v4u*)(P.H + (size_t)m * DM + lane * 32 + 8), a2 = *(const GAS v4u*)(P.H + (size_t)m * DM + lane * 32 + 16), a3 = *(const GAS v4u*)(P.H + (size_t)m * DM + lane * 32 + 24);
          const v4u hv[4] = {a0, a1, a2, a3}; v4u o[2];
#pragma unroll
          for (int j = 0; j < 4; ++j) { int w0 = 0, w1 = 0;
              w0 = __builtin_amdgcn_cvt_pk_fp8_f32(bflo(hv[j].x), bfhi(hv[j].x), w0, false); w0 = __builtin_amdgcn_cvt_pk_fp8_f32(bflo(hv[j].y), bfhi(hv[j].y), w0, true);
              w1 = __builtin_amdgcn_cvt_pk_fp8_f32(bflo(hv[j].z), bfhi(hv[j].z), w1, false); w1 = __builtin_amdgcn_cvt_pk_fp8_f32(bflo(hv[j].w), bfhi(hv[j].w), w1, true);
              o[j >> 1][2 * (j & 1)] = (unsigned)w0; o[j >> 1][2 * (j & 1) + 1] = (unsigned)w1; }
          *(LAS v4u*)(hq + lane * 32) = o[0]; *(LAS v4u*)(hq + lane * 32 + 16) = o[1];
          unsigned z_ = 0u; asm volatile("" : "+v"(z_));
          if (lane < 2) *(LAS v4u*)(hq + 2048 + lane * 16) = (v4u){z_, z_, z_, z_}; }
        const int li = lane & 15, kb = lane >> 4;
        int rowoff[8];
#pragma unroll
        for (int g = 0; g < 8; ++g) rowoff[g] = bpermi(16 * (g & 3) + li, eidx[g >> 2]) * (DM / 2) + 16 * kb;
        f32x4 dacc[8];
#pragma unroll
        for (int g = 0; g < 8; ++g) dacc[g] = (f32x4){0.f, 0.f, 0.f, 0.f};
        const unsigned hb = (li == 0) ? (unsigned)(16 * kb) : 2048u;
        const unsigned hb2 = (li == 0) ? 64u : 16u;
        const unsigned hstep = (li == 0) ? 128u : 0u;
        v4u ua[8], ub[8];
#pragma unroll
        for (int g = 0; g < 8; ++g) ua[g] = *(const GAS v4u*)(P.PU + (unsigned)rowoff[g]);
#pragma unroll 1
        for (int s = 0; s < 16; s += 2) {
#pragma unroll
            for (int g = 0; g < 8; ++g) ub[g] = *(const GAS v4u*)(P.PU + (unsigned)(rowoff[g] + 64 * (s + 1)));
            { const v4u b0 = *(const LAS v4u*)(hq + hb + hstep * s), b1 = *(const LAS v4u*)(hq + hb + hstep * s + hb2);
              const v8i bf = {(int)b0.x, (int)b0.y, (int)b0.z, (int)b0.w, (int)b1.x, (int)b1.y, (int)b1.z, (int)b1.w};
#pragma unroll
              for (int g = 0; g < 8; ++g) { const v8i af = {(int)ua[g].x, (int)ua[g].y, (int)ua[g].z, (int)ua[g].w, 0, 0, 0, 0};
                  dacc[g] = __builtin_amdgcn_mfma_scale_f32_16x16x128_f8f6f4(af, bf, dacc[g], 4, 0, 0, 0x7f7f7f7f, 0, 0x7f7f7f7f); } }
            if (s + 2 < 16) {
#pragma unroll
                for (int g = 0; g < 8; ++g) ua[g] = *(const GAS v4u*)(P.PU + (unsigned)(rowoff[g] + 64 * (s + 2))); }
            { const v4u b0 = *(const LAS v4u*)(hq + hb + hstep * (s + 1)), b1 = *(const LAS v4u*)(hq + hb + hstep * (s + 1) + hb2);
              const v8i bf = {(int)b0.x, (int)b0.y, (int)b0.z, (int)b0.w, (int)b1.x, (int)b1.y, (int)b1.z, (int)b1.w};
#pragma unroll
              for (int g = 0; g < 8; ++g) { const v8i af = {(int)ub[g].x, (int)ub[g].y, (int)ub[g].z, (int)ub[g].w, 0, 0, 0, 0};
                  dacc[g] = __builtin_amdgcn_mfma_scale_f32_16x16x128_f8f6f4(af, bf, dacc[g], 4, 0, 0, 0x7f7f7f7f, 0, 0x7f7f7f7f); } }
        }
        float coef[2];
#pragma unroll
        for (int sl = 0; sl < 2; ++sl) { float mydot = 0.f;
#pragma unroll
            for (int g4 = 0; g4 < 4; ++g4)
#pragma unroll
                for (int r = 0; r < 4; ++r) { const float t = bpermf(16 * ((lane >> 2) & 3), dacc[4 * sl + g4][r]); if ((lane >> 4) == g4 && (lane & 3) == r) mydot = t; }
            mydot *= P.SU[eidx[sl]];
            if (DBG_PROBE == 4) {
                float ref = 0.f;
                for (int e = 0; e < 64; ++e) { const int ex = __builtin_amdgcn_readlane(eidx[sl], e); const v4u uu = *(const GAS v4u*)(P.PU + (size_t)ex * (DM / 2) + lane * 16); float s1 = 0.f;
                    const v4u hv2[4] = {*(const GAS v4u*)(P.H + (size_t)m * DM + lane * 32), *(const GAS v4u*)(P.H + (size_t)m * DM + lane * 32 + 8), *(const GAS v4u*)(P.H + (size_t)m * DM + lane * 32 + 16), *(const GAS v4u*)(P.H + (size_t)m * DM + lane * 32 + 24)};
#pragma unroll
                    for (int d = 0; d < 4; ++d) { const unsigned w = uu[d]; const unsigned hw[4] = {hv2[d].x, hv2[d].y, hv2[d].z, hv2[d].w};
                        f32x2 x = __builtin_amdgcn_cvt_scalef32_pk_f32_fp4(w, 1.0f, 0); s1 += x.x * bflo(hw[0]) + x.y * bfhi(hw[0]); x = __builtin_amdgcn_cvt_scalef32_pk_f32_fp4(w, 1.0f, 1); s1 += x.x * bflo(hw[1]) + x.y * bfhi(hw[1]);
                        x = __builtin_amdgcn_cvt_scalef32_pk_f32_fp4(w, 1.0f, 2); s1 += x.x * bflo(hw[2]) + x.y * bfhi(hw[2]); x = __builtin_amdgcn_cvt_scalef32_pk_f32_fp4(w, 1.0f, 3); s1 += x.x * bflo(hw[3]) + x.y * bfhi(hw[3]); }
                    const float tot = wave_sum_u(s1) * P.SU[ex]; if (lane == e) ref = tot; }
                pr_s2 = fmaxf(pr_s2, wave_max_u(fabsf(mydot - ref) / (fabsf(ref) + 0.25f))); pr_n = 1.f; }
            coef[sl] = egate[sl] * 0.5f * mydot * (1.0f + erff(mydot * 0.70710678f));
            if ((DBG_SKIP & 16) && sl == 0) coef[sl] = 0.f;
            if ((DBG_SKIP & 32) && sl == 1) coef[sl] = 0.f;
        }
        f32x2 acc2[16];
#pragma unroll
        for (int i = 0; i < 16; ++i) acc2[i] = (f32x2){0.f, 0.f};
#define PEER_LOADV(U, C, sl_, e0_) do { _Pragma("unroll") for (int q = 0; q < 8; ++q) { const int ex = __builtin_amdgcn_readlane(eidx[sl_], (e0_) + q); U[q] = *(const GAS v4u*)(P.PV + (size_t)ex * (DM / 2) + lane * 16); \
            C[q] = __builtin_bit_cast(float, __builtin_amdgcn_readlane(__builtin_bit_cast(int, coef[sl_]), (e0_) + q)) * P.SV[ex]; } } while (0)
#define PEER_AXPY(U, C) do { _Pragma("unroll") for (int q = 0; q < 8; ++q) _Pragma("unroll") for (int d = 0; d < 4; ++d) { const unsigned w = U[q][d]; \
            acc2[4 * d + 0] = __builtin_amdgcn_cvt_scalef32_pk_f32_fp4(w, 1.0f, 0) * C[q] + acc2[4 * d + 0]; acc2[4 * d + 1] = __builtin_amdgcn_cvt_scalef32_pk_f32_fp4(w, 1.0f, 1) * C[q] + acc2[4 * d + 1]; \
            acc2[4 * d + 2] = __builtin_amdgcn_cvt_scalef32_pk_f32_fp4(w, 1.0f, 2) * C[q] + acc2[4 * d + 2]; acc2[4 * d + 3] = __builtin_amdgcn_cvt_scalef32_pk_f32_fp4(w, 1.0f, 3) * C[q] + acc2[4 * d + 3]; } } while (0)
#pragma unroll
        for (int sl = 0; sl < 2; ++sl) {
            v4u ua[8], ub[8]; float ca[8], cb[8];
            PEER_LOADV(ua, ca, sl, 0);
#pragma unroll 1
            for (int e0 = 0; e0 < 64; e0 += 16) {
                PEER_LOADV(ub, cb, sl, e0 + 8);
                PEER_AXPY(ua, ca);
                if (e0 + 16 < 64) PEER_LOADV(ua, ca, sl, e0 + 16);
                PEER_AXPY(ub, cb);
            }
        }
#undef PEER_LOADV
#undef PEER_AXPY
        float acc[32];
#pragma unroll
        for (int i = 0; i < 16; ++i) { acc[2 * i] = acc2[i].x; acc[2 * i + 1] = acc2[i].y; }
        if (DBG_SKIP & 1) {
#pragma unroll
            for (int i = 0; i < 32; ++i) acc[i] = 0.f; }
        if (((DBG_SKIP & 64) && !P.last) || ((DBG_SKIP & 128) && P.last)) {
#pragma unroll
            for (int i = 0; i < 32; ++i) acc[i] = 0.f; }
        if (DBG_SKIP & 8) {
#pragma unroll
            for (int i = 0; i < 32; ++i) acc[i] = -acc[i]; }
        float* xr = P.X + (size_t)m * DM; const float* g2 = P.mod + (size_t)mr * 12288 + 5 * DM;
        float ss = 0.f;
#pragma unroll
        for (int hq = 0; hq < 8; ++hq) { const int c = lane * 32 + hq * 4;
            f32x4 xv = *(const GAS f32x4*)(xr + c); const f32x4 gv = *(const GAS f32x4*)(g2 + c);
#pragma unroll
            for (int e = 0; e < 4; ++e) { xv[e] += gv[e] * acc[4 * hq + e]; ss += xv[e] * xv[e]; acc[4 * hq + e] = xv[e]; }
            if (!P.last) *(GAS f32x4*)(xr + c) = xv; }
        if (P.last) { const float rs = rsqrtf(wave_sum(ss) * (1.f / DM) + NORM_EPS); float* orow = P.out + ((size_t)b * SEQ + (tp - CTXL)) * DM;
#pragma unroll
            for (int hq = 0; hq < 8; ++hq) { const int c = lane * 32 + hq * 4; const f32x4 fg = *(const GAS f32x4*)(P.fin_g + c);
                f32x4 o;
#pragma unroll
                for (int e = 0; e < 4; ++e) o[e] = acc[4 * hq + e] * rs * fg[e];
                *(GAS f32x4*)(orow + c) = o; } }
    }
    if (DBG_PROBE && DBG_PROBE != 5 && !P.last && lane == 0) { float* pp = (float*)(F.ws + WS_CTL + CTL_PROBE_OFF) + gw * 4; pp[0] = pr_s2; pp[1] = pr_d2; pp[2] = pr_tg; pp[3] = pr_n; }
}


constexpr int PH_PER_LAYER = 12, NPHASE = 1 + NLAYER * PH_PER_LAYER;
#ifndef ONLY_PHASE
#define ONLY_PHASE -1
#endif
#define T0() (wave_s == 0 && pg8::opaque_lane() == 0)
#define PH_ON(k) (ONLY_PHASE < 0 || ONLY_PHASE == (k))
#define GEMM_CALL(EPI, SCHED, g, S, E) pg8::gemm_phase<EPI, SCHED, true, true>(F.lds, g, S, E, wave_s)
#define GEMM_CALL_NA(EPI, SCHED, g, S, E) pg8::gemm_phase<EPI, SCHED, false, true>(F.lds, g, S, E, wave_s)

__device__ __forceinline__ const float* karg(int i) {
    asm volatile("" : "+s"(i));
    const __attribute__((address_space(4))) unsigned long long* ka = (const __attribute__((address_space(4))) unsigned long long*)__builtin_amdgcn_kernarg_segment_ptr();
    return (const float*)ka[i];
}
__global__ void __launch_bounds__(NWAVES * 64, 2) mk_fwd(Args args) {
    extern __shared__ __attribute__((aligned(16))) unsigned char lds[];
    Frame F;
    F.lds = (LAS unsigned char*)lds; F.ws = args.ws;
    const int wave_s = __builtin_amdgcn_readfirstlane((int)threadIdx.x >> 6);
    F.tid = threadIdx.x; F.lane = F.tid & 63; F.wave = wave_s;
    F.G = gridDim.x; { const int bx = blockIdx.x; F.vcu = (F.G % 8 == 0) ? (bx % 8) * (F.G / 8) + bx / 8 : bx; }
    unsigned char* ws = args.ws;
    volatile LAS unsigned* MISC = (volatile LAS unsigned*)(F.lds + MISC_OFF);
    for (int u = F.tid; u < (LDS_BYTES - LDSCTL_OFF) / 4; u += NWAVES * 64) ((LAS unsigned*)(F.lds + LDSCTL_OFF))[u] = 0u;
    __syncthreads();
    const int lo = args.ph_lo, hi = args.ph_hi;
    XcdBarrier bar; bar.bar = (unsigned*)(ws + WS_CTL) + CW_BAR; bar.x = 0; bar.st = nullptr;
    if (hi - lo > 1) bar = xcd_barrier_post((unsigned*)(ws + WS_CTL) + CW_BAR, MISC + 8, T0());
#define IN(k) (lo <= (k) && (k) < hi)
#define REFRAME() do { const int lz_ = pg8::opaque_lane(); F.lane = lz_; F.tid = wave_s * 64 + lz_; F.wave = wave_s; ws = (unsigned char*)karg(34); F.ws = ws; { int g_ = (int)gridDim.x, b_ = (int)blockIdx.x; asm volatile("" : "+s"(g_), "+s"(b_)); bx = b_; F.G = g_; F.vcu = ((g_ & 7) == 0) ? (b_ & 7) * (g_ >> 3) + (b_ >> 3) : b_; } } while (0)
#define SEAM(k) do { if (IN((k) + 1)) xcd_barrier(bar, T0()); } while (0)
#define XBUF ((float*)(ws + WS_X))
#define HBUF ((bf16*)(ws + WS_H))
#define MODP ((const float*)(ws + WS_CTL + CTL_MOD_OFF) + (size_t)l * 3 * 12288)
    int bx = (int)blockIdx.x;

    if (PH_ON(100) && IN(0)) { REFRAME(); p0_prologue(F); SEAM(0); }

    for (int l = 0; l < NLAYER; ++l) {
        const int base = 1 + l * PH_PER_LAYER;
        const int last = (l == NLAYER - 1);
        for (int rep_ = 0; rep_ < ((DBG_REPEAT == 0) ? 2 : 1); ++rep_) if (PH_ON(0) && IN(base + 0)) { REFRAME(); if (rep_) xcd_barrier(bar, T0()); modnorm_phase(F, XBUF, karg(6) + (size_t)l * DM, MODP, 0, HBUF, 0); SEAM(base + 0); }
        for (int rep_ = 0; rep_ < ((DBG_REPEAT == 1) ? 2 : 1); ++rep_) if (PH_ON(1) && IN(base + 1)) { REFRAME(); if (rep_) xcd_barrier(bar, T0());
            pg8::Gemm g{HBUF, (const bf16*)(ws + WS_WINA) + (size_t)l * INA_P * DM, MALL, INA_P, DM}; pg8::RowOrder S; S.init_rows(0, INA_P, F.G, bx);
            pg8::EpiStoreBf16 E{(bf16*)(ws + WS_PA), INA_P};
            GEMM_CALL(pg8::EpiStoreBf16, pg8::RowOrder, g, S, E);
            SEAM(base + 1); }
        for (int rep_ = 0; rep_ < ((DBG_REPEAT == 2) ? 2 : 1); ++rep_) if (PH_ON(2) && IN(base + 2)) { REFRAME(); if (rep_) xcd_barrier(bar, T0());
            FeatP P;
            P.PA = (const bf16*)(ws + WS_PA); P.mu = karg(9) + (size_t)l * RWC; P.w0 = karg(10) + (size_t)l * 2 * RW; P.a0 = karg(12) + (size_t)l * 2 * RW;
            P.k_k = karg(15) + (size_t)l * RW; P.k_a = karg(16) + (size_t)l * RW; P.r_k = karg(17) + (size_t)l * RW;
            P.WUP = (const bf16*)(ws + WS_WUP) + (size_t)l * 2 * RW * 64; P.AUP = (const bf16*)(ws + WS_AUP) + (size_t)l * 2 * RW * 64; P.GUP = (const bf16*)(ws + WS_GUP) + (size_t)l * 2 * RW * 32;
            P.qnorm = karg(20) + (size_t)l * 512; P.kvnorm = karg(22) + (size_t)l * 256; P.rope = (const f32x2*)(ws + WS_ROPE);
            P.RI = (bf16*)(ws + WS_RI); P.GG = (bf16*)(ws + WS_GG); P.BON = (float*)(ws + WS_BON); P.QN = (bf16*)(ws + WS_QN); P.KVN = (bf16*)(ws + WS_KVN); P.K = (bf16*)(ws + WS_K);
            features_phase(F, P);
            SEAM(base + 2); }
        for (int rep_ = 0; rep_ < ((DBG_REPEAT == 3) ? 2 : 1); ++rep_) if (PH_ON(3) && IN(base + 3)) { REFRAME(); if (rep_) xcd_barrier(bar, T0());
            { pg8::Gemm g{(const bf16*)(ws + WS_QN), (const bf16*)(ws + WS_WUQ) + (size_t)l * NQ * 512, MALL, NQ, 512};
              pg8::EpiQ E{(bf16*)(ws + WS_Q), (const f32x2*)(ws + WS_ROPE), 0.14724444f};
              pg8::RowOrder S; S.init_rows(last, NQ, F.G, bx); GEMM_CALL_NA(pg8::EpiQ, pg8::RowOrder, g, S, E); }
            { pg8::Gemm g{(const bf16*)(ws + WS_KVN), (const bf16*)(ws + WS_WUKV) + (size_t)l * NKV * 256, MALL, NKV, 256}; pg8::RowOrder S; S.init_rows(0, NKV, F.G, bx);
              pg8::EpiKV E{(bf16*)(ws + WS_K), (bf16*)(ws + WS_V)};
              GEMM_CALL_NA(pg8::EpiKV, pg8::RowOrder, g, S, E); }
            SEAM(base + 3); }
        for (int rep_ = 0; rep_ < ((DBG_REPEAT == 4) ? 2 : 1); ++rep_) if (PH_ON(4) && IN(base + 4)) { REFRAME(); if (rep_) xcd_barrier(bar, T0()); scan_phase(F, (const bf16*)(ws + WS_RI), (bf16*)(ws + WS_Y)); SEAM(base + 4); }
        for (int rep_ = 0; rep_ < ((DBG_REPEAT == 5) ? 2 : 1); ++rep_) if (PH_ON(5) && IN(base + 5)) { REFRAME(); if (rep_) xcd_barrier(bar, T0());
            attn_phase(F, (const bf16*)(ws + WS_Q), (const bf16*)(ws + WS_K), (const bf16*)(ws + WS_V), (bf16*)(ws + WS_YB), !last);
            readout_phase(F, (const bf16*)(ws + WS_Y), (const bf16*)(ws + WS_GG), (const float*)(ws + WS_BON), (const bf16*)(ws + WS_RI), karg(18) + (size_t)l * RW, karg(19) + (size_t)l * RW, (bf16*)(ws + WS_YA));
            SEAM(base + 5); }
        for (int rep_ = 0; rep_ < ((DBG_REPEAT == 6) ? 2 : 1); ++rep_) if (PH_ON(6) && IN(base + 6)) { REFRAME(); if (rep_) xcd_barrier(bar, T0());
            bf16* T1 = (bf16*)(ws + WS_T1); bf16* T2 = (bf16*)(ws + WS_T2);
            const pg8::Gemm g1{HBUF, (const bf16*)(ws + WS_WGA) + (size_t)l * DM * DM, MALL, DM, DM}, g2{(const bf16*)(ws + WS_YA), (const bf16*)(ws + WS_WA) + (size_t)l * DM * RW, MALL, DM, RW};
            const pg8::Gemm g3{HBUF, (const bf16*)(ws + WS_WGB) + (size_t)l * DM * DM, MALL, DM, DM}, g4{(const bf16*)(ws + WS_YB), (const bf16*)(ws + WS_WB) + (size_t)l * DM * RW, MALL, DM, RW};
            const pg8::EpiGate E1{T1, DM, karg(8) + (size_t)l * 2 * DM}, E3{T2, DM, karg(8) + (size_t)l * 2 * DM + DM};
            const pg8::EpiMulAdd E2{T1, T1, nullptr, DM}, E4{T1, T2, T1, DM};
            pg8::RowOrder S; S.init_rows(last, DM, F.G, bx);
            GEMM_CALL(pg8::EpiGate, pg8::RowOrder, g1, S, E1); GEMM_CALL(pg8::EpiMulAdd, pg8::RowOrder, g2, S, E2); GEMM_CALL(pg8::EpiGate, pg8::RowOrder, g3, S, E3); GEMM_CALL(pg8::EpiMulAdd, pg8::RowOrder, g4, S, E4);
            SEAM(base + 6); }
        for (int rep_ = 0; rep_ < ((DBG_REPEAT == 7) ? 2 : 1); ++rep_) if (PH_ON(7) && IN(base + 7)) { REFRAME(); if (rep_) xcd_barrier(bar, T0());
            const pg8::Gemm g{(const bf16*)(ws + WS_T1), (const bf16*)(ws + WS_WO) + (size_t)l * DM * DM, MALL, DM, DM};
            const pg8::EpiResid E{XBUF, MODP + 2 * DM};
            pg8::RowOrder S; S.init_rows(last, DM, F.G, bx); GEMM_CALL(pg8::EpiResid, pg8::RowOrder, g, S, E);
            SEAM(base + 7); }
        for (int rep_ = 0; rep_ < ((DBG_REPEAT == 8) ? 2 : 1); ++rep_) if (PH_ON(8) && IN(base + 8)) { REFRAME(); if (rep_) xcd_barrier(bar, T0());
            modnorm_phase(F, XBUF, karg(27) + (size_t)l * DM, MODP, 3, HBUF, last);
            SEAM(base + 8); }
        for (int rep_ = 0; rep_ < ((DBG_REPEAT == 9) ? 2 : 1); ++rep_) if (PH_ON(9) && IN(base + 9)) { REFRAME(); if (rep_) xcd_barrier(bar, T0());
            const pg8::Gemm g{HBUF, (const bf16*)(ws + WS_WQK) + (size_t)l * DM * DM, MALL, DM, DM};
            const pg8::EpiF32 E{(float*)(ws + WS_SC), DM};
            pg8::RowOrder S; S.init_rows(last, DM, F.G, bx); GEMM_CALL(pg8::EpiF32, pg8::RowOrder, g, S, E);
            SEAM(base + 9); }
        for (int rep_ = 0; rep_ < ((DBG_REPEAT == 10) ? 2 : 1); ++rep_) if (PH_ON(10) && IN(base + 10)) { REFRAME(); if (rep_) xcd_barrier(bar, T0());
            SelP P; P.SC = (const float*)(ws + WS_SC); P.ESEL = (int*)(ws + WS_T1); P.EGATE = (float*)(ws + WS_T1 + 16 * MiB);
            P.pu = karg(30) + (size_t)l * NEXP * DM; P.pv = karg(31) + (size_t)l * NEXP * DM; P.PU8 = ws + WS_PU; P.PV8 = ws + WS_PU + (size_t)NEXP * (DM / 2); P.SU = (float*)(ws + WS_PV); P.SV = (float*)(ws + WS_PV) + NEXP; P.last = last;
            select_phase(F, P);
            SEAM(base + 10); }
        for (int rep_ = 0; rep_ < ((DBG_REPEAT == 11) ? 2 : 1); ++rep_) if (PH_ON(11) && IN(base + 11)) { REFRAME(); if (rep_) xcd_barrier(bar, T0());
            PeerP P; P.ESEL = (const int*)(ws + WS_T1); P.EGATE = (const float*)(ws + WS_T1 + 16 * MiB); P.H = HBUF; P.PU = ws + WS_PU; P.PV = ws + WS_PU + (size_t)NEXP * (DM / 2); P.SU = (const float*)(ws + WS_PV); P.SV = (const float*)(ws + WS_PV) + NEXP; P.X = XBUF; P.mod = MODP; P.fin_g = karg(32); P.out = (float*)karg(33); P.last = last;
            peer_phase(F, P);
            SEAM(base + 11); }
    }
#undef IN
#undef SEAM
#undef XBUF
#undef HBUF
#undef MODP
}

__device__ __forceinline__ float mx_a_val(int i, int k) { const int c = (i * 131 + k * 17 + (k >> 3) * 5) & 15; const float mag[8] = {0.f, .5f, 1.f, 1.5f, 2.f, 3.f, 4.f, 6.f}; return (c & 8) ? -mag[c & 7] : mag[c & 7]; }
__device__ __forceinline__ int mx_a_code(int i, int k) { return (i * 131 + k * 17 + (k >> 3) * 5) & 15; }
__device__ __forceinline__ float mx_b_val(int k, int j) { return (float)(((k * 7 + j * 13 + (k >> 4)) % 9) - 4); }
__device__ __forceinline__ int mx_kmap(int hyp, int kb, int e) { const int h = hyp % 3; return h == 0 ? 32 * kb + e : h == 1 ? 32 * (e >> 3) + 8 * kb + (e & 7) : 64 * (e >> 4) + 16 * kb + (e & 15); }
__global__ void __launch_bounds__(512) dbg_fill(const float* pp, float* o) {
    __shared__ float vsh;
    float v = 0.f;
    if (DBG_PROBE == 5) {
        if (threadIdx.x < 64) { typedef int v8i __attribute__((ext_vector_type(8))); typedef float f4 __attribute__((ext_vector_type(4)));
            const int lane = threadIdx.x, i = lane & 15, kb = lane >> 4; float code = 0.f;
            for (int hyp = 0; hyp < 18; ++hyp) { const int nibswap = hyp / 9, ha = hyp % 3, hb2 = (hyp / 3) % 3;
                unsigned aw[4] = {0u, 0u, 0u, 0u}; int bw[8] = {0, 0, 0, 0, 0, 0, 0, 0};
                for (int e = 0; e < 32; ++e) { const int k = mx_kmap(ha, kb, e); const unsigned c = (unsigned)mx_a_code(i, k); const int pos = nibswap ? (e ^ 1) : e; aw[pos >> 3] |= c << (4 * (pos & 7)); }
                for (int q = 0; q < 8; ++q) { int w = 0; const float f0 = mx_b_val(mx_kmap(hb2, kb, 4 * q + 0), i), f1 = mx_b_val(mx_kmap(hb2, kb, 4 * q + 1), i), f2 = mx_b_val(mx_kmap(hb2, kb, 4 * q + 2), i), f3 = mx_b_val(mx_kmap(hb2, kb, 4 * q + 3), i);
                    w = __builtin_amdgcn_cvt_pk_fp8_f32(f0, f1, w, false); w = __builtin_amdgcn_cvt_pk_fp8_f32(f2, f3, w, true); bw[q] = w; }
                const v8i af = {(int)aw[0], (int)aw[1], (int)aw[2], (int)aw[3], 0, 0, 0, 0}, bf = {bw[0], bw[1], bw[2], bw[3], bw[4], bw[5], bw[6], bw[7]};
                f4 d = {0.f, 0.f, 0.f, 0.f};
                d = __builtin_amdgcn_mfma_scale_f32_16x16x128_f8f6f4(af, bf, d, 4, 0, 0, 0x7f7f7f7f, 0, 0x7f7f7f7f);
                int bad = 0;
                for (int r = 0; r < 4; ++r) { const int row = 4 * kb + r, col = i; float ex = 0.f; for (int k = 0; k < 128; ++k) ex += mx_a_val(row, k) * mx_b_val(k, col); bad += (d[r] != ex); }
                if (__ballot(bad != 0) == 0ull && code == 0.f) code = (float)(hyp + 1); }
            for (int t = 0; t < 2; ++t) {
                int aw[8] = {0, 0, 0, 0, 0, 0, 0, 0}, bw[8] = {0, 0, 0, 0, 0, 0, 0, 0};
                if (t == 0) { for (int e = 0; e < 32; ++e) { const int k = 32 * kb + e; aw[e >> 3] |= mx_a_code(i, k) << (4 * (e & 7)); bw[e >> 3] |= mx_a_code(i + 16, k) << (4 * (e & 7)); } }
                else { for (int q = 0; q < 8; ++q) { int w = 0, w2 = 0; const int k = 32 * kb + 4 * q;
                        w = __builtin_amdgcn_cvt_pk_fp8_f32(mx_b_val(k, i + 16), mx_b_val(k + 1, i + 16), w, false); w = __builtin_amdgcn_cvt_pk_fp8_f32(mx_b_val(k + 2, i + 16), mx_b_val(k + 3, i + 16), w, true); aw[q] = w;
                        w2 = __builtin_amdgcn_cvt_pk_fp8_f32(mx_b_val(k, i), mx_b_val(k + 1, i), w2, false); w2 = __builtin_amdgcn_cvt_pk_fp8_f32(mx_b_val(k + 2, i), mx_b_val(k + 3, i), w2, true); bw[q] = w2; } }
                const v8i af = {aw[0], aw[1], aw[2], aw[3], aw[4], aw[5], aw[6], aw[7]}, bf = {bw[0], bw[1], bw[2], bw[3], bw[4], bw[5], bw[6], bw[7]};
                f4 d = {0.f, 0.f, 0.f, 0.f};
                if (t == 0) d = __builtin_amdgcn_mfma_scale_f32_16x16x128_f8f6f4(af, bf, d, 4, 4, 0, 0x7f7f7f7f, 0, 0x7f7f7f7f); else d = __builtin_amdgcn_mfma_scale_f32_16x16x128_f8f6f4(af, bf, d, 0, 0, 0, 0x7f7f7f7f, 0, 0x7f7f7f7f);
                int bad = 0;
                for (int r = 0; r < 4; ++r) { const int row = 4 * kb + r, col = i; float ex = 0.f;
                    for (int k = 0; k < 128; ++k) ex += (t == 0) ? mx_a_val(row, k) * mx_a_val(col + 16, k) : mx_b_val(k, row + 16) * mx_b_val(k, col);
                    bad += (d[r] != ex); }
                if (__ballot(bad != 0) == 0ull) code += (t == 0) ? 10.f : 20.f; }
            if (lane == 0) vsh = code; }
        __syncthreads(); v = vsh;
    } else {
        float s0 = 0.f, s1 = 0.f, s2 = 0.f, s3 = 0.f;
        for (int i = 0; i < 2048; ++i) { s0 += pp[4 * i]; s1 += pp[4 * i + 1]; s2 += pp[4 * i + 2]; s3 += pp[4 * i + 3]; }
        if (DBG_PROBE == 4) { float mx = 0.f; for (int i = 0; i < 2048; ++i) mx = fmaxf(mx, pp[4 * i]); v = 100.f * mx; }
        else { v = (DBG_PROBE == 1 ? s0 : DBG_PROBE == 2 ? s1 : s2) / s3 * 1e-3f; v = exp2f(rintf(log2f(v) * 4.f) * 0.25f); }
    }
    for (size_t i = (size_t)blockIdx.x * 512 + threadIdx.x; i < (size_t)NBATCH * SEQ * DM; i += (size_t)gridDim.x * 512) o[i] = v;
}
extern "C" void kernel_launch(void* const* d_in, const int* in_sizes, int n_in, void* d_out, int out_size, void* d_ws, size_t ws_size, hipStream_t stream) {
    static int grid = 0;
    if (grid == 0) {
        if (n_in != 33 || out_size != NBATCH * SEQ * DM || ws_size < WS_END) { fprintf(stderr, "kernel_launch: unexpected shapes (n_in %d out %d ws %zu)\n", n_in, out_size, ws_size); grid = -1; return; }
        int dev = 0, cus = 0, per_cu = 0;
        if (hipGetDevice(&dev) != hipSuccess || hipDeviceGetAttribute(&cus, hipDeviceAttributeMultiprocessorCount, dev) != hipSuccess) { grid = -1; return; }
        if (hipFuncSetAttribute((const void*)mk_fwd, hipFuncAttributeMaxDynamicSharedMemorySize, LDS_BYTES) != hipSuccess) { fprintf(stderr, "kernel_launch: hipFuncSetAttribute failed\n"); grid = -1; return; }
        if (hipOccupancyMaxActiveBlocksPerMultiprocessor(&per_cu, (const void*)mk_fwd, NWAVES * 64, LDS_BYTES) != hipSuccess || per_cu < 1) { fprintf(stderr, "kernel_launch: occupancy query says %d\n", per_cu); (void)hipGetLastError(); grid = -1; return; }
        grid = cus;
    }
    if (grid < 0) return;
    if (hipMemsetAsync((char*)d_ws + WS_CTL, 0, CTL_ZERO_BYTES, stream) != hipSuccess) return;
    Args a{};
    for (int i = 0; i < 33; ++i) a.in[i] = (const float*)d_in[i];
    a.out = (float*)d_out; a.ws = (unsigned char*)d_ws;
#if MK_N_LAUNCHES == 1
    a.ph_lo = 0; a.ph_hi = NPHASE;
    hipLaunchKernelGGL(mk_fwd, dim3(grid), dim3(NWAVES * 64), LDS_BYTES, stream, a);
#else
    if (DBG_PROBE != 5) for (int p = 0; p < NPHASE; ++p) { a.ph_lo = p; a.ph_hi = p + 1; hipLaunchKernelGGL(mk_fwd, dim3(grid), dim3(NWAVES * 64), LDS_BYTES, stream, a); }
    if (DBG_PROBE) hipLaunchKernelGGL(dbg_fill, dim3(1024), dim3(512), 0, stream, (const float*)((char*)d_ws + WS_CTL + CTL_PROBE_OFF), (float*)d_out);
#endif
}
```

```cpp
#include <hip/hip_runtime.h>
#include <cstdio>
#include <cstdint>

#ifndef MK_N_LAUNCHES
#define MK_N_LAUNCHES 1
#endif

#ifndef DBG_SKIP
#define DBG_SKIP 0
#endif
#ifndef DBG_PROBE
#define DBG_PROBE 0
#endif
#ifndef DBG_REPEAT
#define DBG_REPEAT -1
#endif
namespace pg8 {
#define PG8_LAS __attribute__((address_space(3)))
typedef unsigned short bf16_t;
typedef short bf16x8 __attribute__((ext_vector_type(8)));
typedef float f32x4 __attribute__((ext_vector_type(4)));
typedef unsigned u32x4 __attribute__((ext_vector_type(4)));
constexpr int BM = 256, BK = 64, HALF = 128, HTB = HALF * BK * 2  , STAGE_BYTES = 8 * HTB, NXCD = 8, WGM = 8;

__host__ __device__ __forceinline__ int lds_byte(int r, int c) { const int st = (r >> 4) * 2 + (c >> 5), rr = r & 15, cc = c & 31, ob = rr * 64 + cc * 2; return st * 1024 + (ob ^ (((ob >> 9) & 1) << 5)); }
__host__ __device__ __forceinline__ void stage_rc(int b, int& R, int& C) { const int st = b / 1024, sb = b % 1024, swz = sb ^ (((sb >> 9) & 1) << 5); R = (st >> 1) * 16 + swz / 64; C = (st & 1) * 32 + (swz % 64) / 2; }
__host__ __device__ __forceinline__ int perm32(int rho) { const int n = rho >> 4, i = rho & 15; return 8 * (i >> 2) + 4 * n + (i & 3); }

struct Unit { int pm, pn; };
struct Gemm { const bf16_t* A; const bf16_t* Bt; int M, N, K; };

struct StaticOrder {
    int nM, nN, nwg, G, c;
    __host__ __device__ void init(int M, int N, int G_, int c_) { nM = M / BM; nN = N / BM; nwg = nM * nN; G = G_; c = c_; }
    __host__ __device__ bool next(int i, Unit& u) const {
        const long L = (long)i * G + c; if (L >= nwg) return false;
        int wgid = (int)L; { const int q = nwg / NXCD, r = nwg % NXCD, xcd = wgid % NXCD, off = wgid / NXCD; wgid = (xcd < r ? xcd * (q + 1) : r * (q + 1) + (xcd - r) * q) + off; }
        const int nig = WGM * nN, gid = wgid / nig, fm = gid * WGM, gsz = (nM - fm) < WGM ? (nM - fm) : WGM;
        u.pm = fm + ((wgid % nig) % gsz); u.pn = (wgid % nig) / gsz; return true;
    }
    __device__ __forceinline__ void a_ready(const Unit&) const {}
    __device__ __forceinline__ void done(const Unit&) const {}
};
__device__ __forceinline__ int opaque_lane() { int l; asm volatile("v_mbcnt_lo_u32_b32 %0, -1, 0\n\tv_mbcnt_hi_u32_b32 %0, -1, %0" : "=v"(l)); return l; }
typedef __bf16 bf16x2c __attribute__((ext_vector_type(2)));
__device__ __forceinline__ unsigned cvt_pk_bf16(float lo, float hi) { const bf16x2c v = {(__bf16)lo, (__bf16)hi}; return __builtin_bit_cast(unsigned, v); }
template <class Epi, class Sched, bool ALIGN_EPI = false, bool SP2 = false>
__device__ __forceinline__ void gemm_phase(PG8_LAS unsigned char* lds, const Gemm g, const Sched& S, const Epi& E, const int wave_s) {
    const int lane_ = opaque_lane();
    const int wid = wave_s, lane = lane_, tid = wid * 64 + lane, wr = wid >> 2, wc = wid & 3, fr = lane & 15, fq = lane >> 4;
    const int K = g.K, nt = K / BK;
    unsigned voffA[2], voffB[2];
#pragma unroll
    for (int i = 0; i < 2; ++i) { int R, C; stage_rc(tid * 16 + i * 8192, R, C); const int Rb = Epi::PERM ? ((R & ~31) + perm32(R & 31)) : R;
        voffA[i] = (unsigned)(R * K + C) * 2u; voffB[i] = (unsigned)(Rb * K + C) * 2u; }
    const size_t kstep = (size_t)(BK * 2);
    const size_t hstep = (size_t)HALF * K * 2;
    const size_t tstep = 2 * hstep;
    const unsigned ldsw = (unsigned)wid * 1024u;
    const int aoff = lds_byte(wr * 64 + fr, fq * 8), boff = lds_byte(wc * 32 + fr, fq * 8);
#define PG8_SA(b, h) (((b) * 2 + (h)) * HTB)
#define PG8_SB(b, h) ((4 + (b) * 2 + (h)) * HTB)
#define PG8_STAGE(bufoff, gbase, voff) do { _Pragma("unroll") for (int _i = 0; _i < 2; ++_i) \
        __builtin_amdgcn_global_load_lds((const unsigned*)((const char*)(gbase) + (voff)[_i]), (PG8_LAS unsigned*)(lds + (bufoff) + ldsw + _i * 8192), 16, 0, 0); } while (0)
#define PG8_LDA(dst, b, h) do { _Pragma("unroll") for (int m = 0; m < 4; ++m) _Pragma("unroll") for (int k = 0; k < 2; ++k) dst[m][k] = *(const PG8_LAS bf16x8*)(lds + PG8_SA(b, h) + aoff + m * 2048 + k * 1024); } while (0)
#define PG8_LDB(dst, b, h) do { _Pragma("unroll") for (int n = 0; n < 2; ++n) _Pragma("unroll") for (int k = 0; k < 2; ++k) dst[n][k] = *(const PG8_LAS bf16x8*)(lds + PG8_SB(b, h) + boff + n * 2048 + k * 1024); } while (0)
#define PG8_MMA(ai, bj, At, Bt) do { __builtin_amdgcn_s_setprio(1); _Pragma("unroll") for (int m = 0; m < 4; ++m) _Pragma("unroll") for (int n = 0; n < 2; ++n) _Pragma("unroll") for (int k = 0; k < 2; ++k) \
        acc[ai][bj][m][n] = __builtin_amdgcn_mfma_f32_16x16x32_bf16(Bt[n][k], At[m][k], acc[ai][bj][m][n], 0, 0, 0); __builtin_amdgcn_s_setprio(0); } while (0)
#define PG8_WAIT_V(n) asm volatile("s_waitcnt vmcnt(" #n ")" ::: "memory")
#define PG8_WAIT_L(n) asm volatile("s_waitcnt lgkmcnt(" #n ")" ::: "memory")
#define PG8_BAR __builtin_amdgcn_s_barrier()
#define PG8_SCHED __builtin_amdgcn_sched_barrier(0)
    Unit cur, nxt; int ui = 0;
    if (!S.next(0, cur)) return;
    f32x4 acc[2][2][4][2];
#pragma unroll
    for (int a = 0; a < 2; ++a)
#pragma unroll
        for (int b = 0; b < 2; ++b)
#pragma unroll
            for (int m = 0; m < 4; ++m)
#pragma unroll
                for (int n = 0; n < 2; ++n) acc[a][b][m][n] = (f32x4){0.f, 0.f, 0.f, 0.f};
    bf16x8 At[4][2], B0[2][2], B1[2][2];
    const char* cA = (const char*)g.A + (size_t)cur.pm * tstep; const char* cB = (const char*)g.Bt + (size_t)cur.pn * tstep;
    S.a_ready(cur);
    if constexpr (SP2) {
        PG8_STAGE(PG8_SB(0, 0), cB, voffB); PG8_STAGE(PG8_SB(0, 1), cB + hstep, voffB); PG8_STAGE(PG8_SA(0, 0), cA, voffA); PG8_STAGE(PG8_SA(0, 1), cA + hstep, voffA);
        if (wr == 1) PG8_BAR;
        PG8_WAIT_V(2); PG8_BAR;
        PG8_STAGE(PG8_SB(1, 0), cB + kstep, voffB); PG8_STAGE(PG8_SA(1, 0), cA + kstep, voffA); PG8_STAGE(PG8_SB(1, 1), cB + hstep + kstep, voffB);
        PG8_WAIT_V(6); PG8_BAR;
    } else {
        PG8_STAGE(PG8_SB(0, 0), cB, voffB); PG8_STAGE(PG8_SA(0, 0), cA, voffA); PG8_STAGE(PG8_SB(0, 1), cB + hstep, voffB); PG8_STAGE(PG8_SA(0, 1), cA + hstep, voffA);
        if (wr == 1) PG8_BAR;
        PG8_WAIT_V(4); PG8_BAR;
        PG8_STAGE(PG8_SB(1, 0), cB + kstep, voffB); PG8_STAGE(PG8_SA(1, 0), cA + kstep, voffA); PG8_STAGE(PG8_SB(1, 1), cB + hstep + kstep, voffB);
        PG8_WAIT_V(6); PG8_BAR;
    }
    for (;;) {
        const bool has_next = S.next(ui + 1, nxt);
        const char* nA = has_next ? (const char*)g.A + (size_t)nxt.pm * tstep : cA; const char* nB = has_next ? (const char*)g.Bt + (size_t)nxt.pn * tstep : cB;
        for (int t = 0; t < nt; t += 2) {
            const bool last = (t == nt - 2);
            const char* a1 = cA + (size_t)(t + 1) * kstep;
            const char* a2 = last ? nA : cA + (size_t)(t + 2) * kstep; const char* b2 = last ? nB : cB + (size_t)(t + 2) * kstep;
            const char* a3 = a2 + kstep; const char* b3 = b2 + kstep;
            if (last && has_next) S.a_ready(nxt);
            if constexpr (SP2) {
            PG8_LDB(B0, 0, 0); PG8_LDB(B1, 0, 1); PG8_SCHED; PG8_LDA(At, 0, 0); PG8_STAGE(PG8_SA(1, 1), a1 + hstep, voffA);
            PG8_WAIT_V(8); PG8_WAIT_L(0); PG8_BAR; PG8_MMA(0, 0, At, B0); PG8_MMA(0, 1, At, B1); PG8_BAR; PG8_SCHED;
            PG8_LDA(At, 0, 1); PG8_STAGE(PG8_SB(0, 0), b2, voffB); PG8_STAGE(PG8_SB(0, 1), b2 + hstep, voffB); PG8_STAGE(PG8_SA(0, 0), a2, voffA);
            PG8_WAIT_V(8); PG8_WAIT_L(0); PG8_BAR; PG8_MMA(1, 0, At, B0); PG8_MMA(1, 1, At, B1); PG8_BAR; PG8_SCHED;
            PG8_LDB(B0, 1, 0); PG8_LDB(B1, 1, 1); PG8_SCHED; PG8_LDA(At, 1, 0); PG8_STAGE(PG8_SA(0, 1), a2 + hstep, voffA);
            PG8_WAIT_V(8); PG8_WAIT_L(0); PG8_BAR; PG8_MMA(0, 0, At, B0); PG8_MMA(0, 1, At, B1); PG8_BAR; PG8_SCHED;
            PG8_LDA(At, 1, 1); PG8_STAGE(PG8_SB(1, 0), b3, voffB); PG8_STAGE(PG8_SB(1, 1), b3 + hstep, voffB); PG8_STAGE(PG8_SA(1, 0), a3, voffA);
            PG8_WAIT_V(8); PG8_WAIT_L(0); PG8_BAR; PG8_MMA(1, 0, At, B0); PG8_MMA(1, 1, At, B1); PG8_BAR; PG8_SCHED;
            } else {
            PG8_LDB(B0, 0, 0); PG8_SCHED; PG8_LDA(At, 0, 0); PG8_STAGE(PG8_SA(1, 1), a1 + hstep, voffA);
            PG8_WAIT_L(8); PG8_BAR; PG8_WAIT_L(0); PG8_MMA(0, 0, At, B0); PG8_BAR; PG8_SCHED;
            PG8_LDB(B1, 0, 1); PG8_STAGE(PG8_SB(0, 0), b2, voffB);
            PG8_BAR; PG8_WAIT_L(0); PG8_MMA(0, 1, At, B1); PG8_BAR;
            PG8_LDA(At, 0, 1); PG8_STAGE(PG8_SA(0, 0), a2, voffA);
            PG8_BAR; PG8_WAIT_L(0); PG8_MMA(1, 0, At, B0); PG8_BAR; PG8_SCHED;
            PG8_STAGE(PG8_SB(0, 1), b2 + hstep, voffB);
            PG8_WAIT_V(6); PG8_BAR; PG8_MMA(1, 1, At, B1); PG8_BAR;
            PG8_LDB(B0, 1, 0); PG8_SCHED; PG8_LDA(At, 1, 0); PG8_STAGE(PG8_SA(0, 1), a2 + hstep, voffA);
            PG8_WAIT_L(8); PG8_BAR; PG8_WAIT_L(0); PG8_MMA(0, 0, At, B0); PG8_BAR; PG8_SCHED;
            PG8_LDB(B1, 1, 1); PG8_STAGE(PG8_SB(1, 0), b3, voffB);
            PG8_BAR; PG8_WAIT_L(0); PG8_MMA(0, 1, At, B1); PG8_BAR;
            PG8_LDA(At, 1, 1); PG8_STAGE(PG8_SA(1, 0), a3, voffA);
            PG8_BAR; PG8_WAIT_L(0); PG8_MMA(1, 0, At, B0); PG8_BAR; PG8_SCHED;
            PG8_STAGE(PG8_SB(1, 1), b3 + hstep, voffB);
            PG8_WAIT_V(6); PG8_BAR; PG8_MMA(1, 1, At, B1); PG8_BAR;
            }
        }
        if constexpr (ALIGN_EPI) { if (wr == 0) PG8_BAR; }
        if constexpr (!Epi::AFTER_DRAIN) { const int le_ = opaque_lane(); E(acc, cur, wr, wc, le_ & 15, le_ >> 4); S.done(cur); }
        if (!has_next) break;
#pragma unroll
        for (int a = 0; a < 2; ++a)
#pragma unroll
            for (int b = 0; b < 2; ++b)
#pragma unroll
                for (int m = 0; m < 4; ++m)
#pragma unroll
                    for (int n = 0; n < 2; ++n) acc[a][b][m][n] = (f32x4){0.f, 0.f, 0.f, 0.f};
        cur = nxt; cA = nA; cB = nB; ++ui;
        if constexpr (ALIGN_EPI) { if (wr == 1) PG8_BAR; }
    }
    PG8_WAIT_V(0);
    if constexpr (!ALIGN_EPI) { if (wr == 0) PG8_BAR; }
    PG8_BAR;
    if constexpr (Epi::AFTER_DRAIN) { E.fused(acc, cur, wr, wc, fr, fq, lds, wid, lane); S.done(cur); }
#undef PG8_SA
#undef PG8_SB
#undef PG8_STAGE
#undef PG8_LDA
#undef PG8_LDB
#undef PG8_MMA
#undef PG8_WAIT_V
#undef PG8_WAIT_L
#undef PG8_BAR
#undef PG8_SCHED
}
}

constexpr int NWAVES = 8;
constexpr int DM = 2048, NBATCH = 2, SEQ = 8192, CTXL = 256, TPB = CTXL + SEQ  , MALL = NBATCH * TPB  ;
constexpr int NLAYER = 2;
constexpr int RW = 1024, NH = 16;
constexpr int RWC = 3392, INA = 4192, INA_P = 4352, INC = 8288;
constexpr int C_WD = 3072, C_AD = 3200, C_GD = 3328, C_QC = 3392, C_KVC = 3904, C_KR = 4160;
constexpr int QKD = 96, NQ = NH * QKD  , NKV = NH * 128  ;
constexpr int NEXP = 16384;
constexpr int RREC = 9 * 64;
constexpr float NORM_EPS = 1e-6f;

constexpr size_t MiB = 1u << 20;
constexpr size_t WS_CTL = 0, CTL_ZERO_BYTES = 1 * MiB;
constexpr size_t CTL_MOD_OFF = 256 * 1024;
constexpr size_t WS_ROPE = 1 * MiB;
constexpr size_t WS_WUP = 3 * MiB, WS_AUP = WS_WUP + 512 * 1024, WS_GUP = 4 * MiB;
constexpr size_t WS_WUQ = 5 * MiB, WS_WUKV = 8 * MiB, WS_WA = 10 * MiB, WS_WB = 18 * MiB, WS_WO = 26 * MiB, WS_WQK = 42 * MiB, WS_WGA = 58 * MiB, WS_WGB = 74 * MiB, WS_WINA = 90 * MiB;
constexpr size_t WS_X = 124 * MiB, WS_H = 256 * MiB, WS_DYN = 322 * MiB;
constexpr size_t WS_PA = WS_DYN;
constexpr size_t WS_RI = 463 * MiB;
constexpr size_t WS_GG = 760 * MiB;
constexpr size_t WS_BON = 826 * MiB;
constexpr size_t WS_QN = 831 * MiB, WS_KVN = 848 * MiB;
constexpr size_t WS_Q = 857 * MiB, WS_K = 907 * MiB, WS_V = 957 * MiB, WS_END = 990 * MiB;
constexpr size_t WS_Y = WS_DYN;
constexpr size_t WS_YA = 388 * MiB, WS_YB = 421 * MiB;
constexpr size_t WS_T1 = 463 * MiB, WS_T2 = 529 * MiB;
constexpr size_t WS_PU = 600 * MiB, WS_PV = 664 * MiB;
constexpr size_t WS_SC = WS_DYN;
static_assert(WS_PA + (size_t)MALL * INA_P * 2 <= WS_RI && WS_RI + (size_t)NBATCH * NH * TPB * RREC * 2 <= WS_GG && WS_GG + (size_t)2 * MALL * RW * 2 <= WS_BON, "ws map 1");
static_assert(WS_BON + (size_t)2 * MALL * 32 * 4 <= WS_QN && WS_QN + (size_t)MALL * 512 * 2 <= WS_KVN && WS_KVN + (size_t)MALL * 256 * 2 <= WS_Q, "ws map 2");
static_assert(WS_Q + (size_t)NBATCH * NH * TPB * QKD * 2 <= WS_K && WS_K + (size_t)NBATCH * NH * TPB * QKD * 2 <= WS_V && WS_V + (size_t)NBATCH * NH * TPB * 64 * 2 <= WS_END, "ws map 3");
static_assert(WS_Y + (size_t)2 * MALL * RW * 2 <= WS_YA && WS_YA + (size_t)MALL * RW * 2 <= WS_YB && WS_YB + (size_t)MALL * RW * 2 <= WS_RI, "ws map 4");
static_assert(WS_T1 + (size_t)MALL * DM * 2 <= WS_T2 && WS_T2 + (size_t)MALL * DM * 2 <= WS_PU && WS_PU + (size_t)NEXP * DM * 2 <= WS_PV && WS_PV + (size_t)NEXP * DM * 2 <= WS_GG, "ws map 5");
static_assert(WS_SC + (size_t)MALL * DM * 4 <= WS_T1 && WS_X + (size_t)MALL * DM * 4 <= WS_H && WS_H + (size_t)MALL * DM * 2 <= WS_DYN, "ws map 6");
static_assert(WS_WINA + (size_t)NLAYER * INA_P * DM * 2 <= WS_X, "ws map 7");
constexpr size_t CTL_PROBE_OFF = 640 * 1024;
constexpr int CW_BAR = 4096;

constexpr int RING_BYTES = 131072;
constexpr int LDSCTL_OFF = RING_BYTES, MISC_OFF = LDSCTL_OFF + 320;
constexpr int LDS_BYTES = 147456;

#define GAS __attribute__((address_space(1)))
#define LAS __attribute__((address_space(3)))
typedef unsigned short bf16;
typedef unsigned v4u __attribute__((ext_vector_type(4)));
typedef unsigned v2u __attribute__((ext_vector_type(2)));
typedef float f32x4 __attribute__((ext_vector_type(4)));
typedef float f32x2 __attribute__((ext_vector_type(2)));
typedef float f32x16 __attribute__((ext_vector_type(16)));
typedef short bf16x8 __attribute__((ext_vector_type(8)));
typedef short s16x4 __attribute__((ext_vector_type(4)));
typedef __bf16 bf16x2v __attribute__((ext_vector_type(2)));
typedef __bf16 bf16x8v __attribute__((ext_vector_type(8)));
typedef GAS unsigned gu32;
#define RLX_AGENT __ATOMIC_RELAXED, __HIP_MEMORY_SCOPE_AGENT
#define LDS_WAIT() asm volatile("s_waitcnt lgkmcnt(0)" ::: "memory")
#define VM_WAIT() asm volatile("s_waitcnt vmcnt(0)" ::: "memory")
__device__ __forceinline__ unsigned f2bf(float f) { unsigned u = __builtin_bit_cast(unsigned, f); return (u + 0x7fffu + ((u >> 16) & 1u)) >> 16; }
__device__ __forceinline__ unsigned pk2(float lo, float hi) { return pg8::cvt_pk_bf16(lo, hi); }
__device__ __forceinline__ float bflo(unsigned w) { return __builtin_bit_cast(float, w << 16); }
__device__ __forceinline__ float bfhi(unsigned w) { return __builtin_bit_cast(float, w & 0xffff0000u); }
__device__ __forceinline__ float bf1(bf16 h) { return __builtin_bit_cast(float, (unsigned)h << 16); }
__device__ __forceinline__ float sigmoidf_(float x) { return 1.0f / (1.0f + __expf(-x)); }
template <int CTRL> __device__ __forceinline__ float dpp_add(float x) {
    return x + __builtin_bit_cast(float, __builtin_amdgcn_update_dpp(0, __builtin_bit_cast(int, x), CTRL, 0xf, 0xf, true));
}
__device__ __forceinline__ float red16(float x) {
    x = dpp_add<0xB1>(x);
    x = dpp_add<0x4E>(x);
    x = dpp_add<0x141>(x);
    x = dpp_add<0x140>(x);
    return x;
}
template <int CTRL, int RM> __device__ __forceinline__ float dpp_max(float x) {
    return fmaxf(x, __builtin_bit_cast(float, __builtin_amdgcn_update_dpp(__builtin_bit_cast(int, x), __builtin_bit_cast(int, x), CTRL, RM, 0xf, false)));
}
template <int CTRL, int RM> __device__ __forceinline__ float dpp_sum(float x) {
    return x + __builtin_bit_cast(float, __builtin_amdgcn_update_dpp(0, __builtin_bit_cast(int, x), CTRL, RM, 0xf, false));
}
__device__ __forceinline__ float wave_max_u(float x) {
    x = dpp_max<0xB1, 0xf>(x); x = dpp_max<0x4E, 0xf>(x); x = dpp_max<0x141, 0xf>(x); x = dpp_max<0x140, 0xf>(x);
    x = dpp_max<0x142, 0xa>(x); x = dpp_max<0x143, 0xc>(x);
    return __builtin_bit_cast(float, __builtin_amdgcn_readlane(__builtin_bit_cast(int, x), 63));
}
__device__ __forceinline__ float wave_sum_u(float x) {
    x = dpp_sum<0xB1, 0xf>(x); x = dpp_sum<0x4E, 0xf>(x); x = dpp_sum<0x141, 0xf>(x); x = dpp_sum<0x140, 0xf>(x);
    x = dpp_sum<0x142, 0xa>(x); x = dpp_sum<0x143, 0xc>(x);
    return __builtin_bit_cast(float, __builtin_amdgcn_readlane(__builtin_bit_cast(int, x), 63));
}
__device__ __forceinline__ float wave_sum(float v) { return wave_sum_u(v); }
__device__ __forceinline__ float bpermf(int srclane, float v) { return __builtin_bit_cast(float, __builtin_amdgcn_ds_bpermute(srclane << 2, __builtin_bit_cast(int, v))); }
__device__ __forceinline__ int bpermi(int srclane, int v) { return __builtin_amdgcn_ds_bpermute(srclane << 2, v); }

#define XB_TMO      128
#define XB_XCNT(j)  (256  + 64 * (j))
#define XB_XSUB(j)  (1280 + 64 * (j))
#define XB_XGEN(j)  (2304 + 64 * (j))
#define XB_TOP      3328
#define XB_TOPGEN   3392
#define XCD_BAR_WORDS 3456
#define XB_SPIN_CAP (1u << 20)

__device__ __forceinline__ unsigned xb_ld(unsigned* p)              { return __hip_atomic_load(p, __ATOMIC_RELAXED, __HIP_MEMORY_SCOPE_AGENT); }
__device__ __forceinline__ unsigned xb_add(unsigned* p, unsigned v) { return __hip_atomic_fetch_add(p, v, __ATOMIC_RELAXED, __HIP_MEMORY_SCOPE_AGENT); }
__device__ __forceinline__ unsigned xb_xcc_id() { return (unsigned)__builtin_amdgcn_s_getreg((3 << 11) | 20) & 0xFu; }
#define XB_SPIN(cond, bar) do { unsigned _sp = 0; while (cond) { __builtin_amdgcn_s_sleep(1); \
    if ((++_sp & 255u) == 0u) { if (xb_ld(&(bar)[XB_TMO])) break; if (_sp > XB_SPIN_CAP) { atomicAdd(&(bar)[XB_TMO], 1u); break; } } } } while (0)

struct XcdBarrier { unsigned* bar; unsigned x; volatile LAS unsigned* st; };

__device__ __forceinline__ XcdBarrier xcd_barrier_post(unsigned* bar, volatile LAS unsigned* st, bool t0) {
    XcdBarrier b; b.bar = bar; b.x = xb_xcc_id(); b.st = st;
    if (t0) (void)xb_add(&bar[XB_XCNT(b.x)], 1u);
    return b;
}
__device__ __forceinline__ void xcd_barrier_complete(unsigned* bar, unsigned x, unsigned& nloc, unsigned& nx) {
    const unsigned G = gridDim.x * gridDim.y * gridDim.z;
    unsigned sum, cnt, mine, sp = 0u;
    for (;;) {
        sum = 0u; cnt = 0u; mine = 0u;
#pragma unroll
        for (unsigned j = 0; j < 16; ++j) { const unsigned c = xb_ld(&bar[XB_XCNT(j)]); sum += c; cnt += (c > 0u) ? 1u : 0u; mine = (j == x) ? c : mine; }
        if (sum == G) break;
        __builtin_amdgcn_s_sleep(1);
        if ((++sp & 255u) == 0u) { if (xb_ld(&bar[XB_TMO])) break; if (sp > XB_SPIN_CAP) { atomicAdd(&bar[XB_TMO], 1u); break; } }
    }
    nloc = mine > 0u ? mine : 1u; nx = cnt > 0u ? cnt : 1u;
}
__device__ __forceinline__ void xcd_barrier(const XcdBarrier& b, bool t0) {
    asm volatile("s_waitcnt vmcnt(0)" ::: "memory");
    __syncthreads();
    if (t0) {
        unsigned* bar = b.bar;
        __builtin_amdgcn_s_waitcnt(0);
        unsigned nloc = b.st[0], nx = b.st[1];
        if (nloc == 0u) { xcd_barrier_complete(bar, b.x, nloc, nx); b.st[0] = nloc; b.st[1] = nx; }
        const unsigned old = xb_add(&bar[XB_XSUB(b.x)], 1u);
        const unsigned gen = old / nloc;
        if (old + 1u == (gen + 1u) * nloc) {
            __builtin_amdgcn_fence(__ATOMIC_RELEASE, "agent");
            asm volatile("s_waitcnt vmcnt(0)" ::: "memory");
            const unsigned og = xb_add(&bar[XB_TOP], 1u);
            const unsigned tg = og / nx;
            if (og + 1u == (tg + 1u) * nx) xb_add(&bar[XB_TOPGEN], 1u);
            else XB_SPIN(xb_ld(&bar[XB_TOPGEN]) == tg, bar);
            __builtin_amdgcn_fence(__ATOMIC_ACQUIRE, "agent");
            xb_add(&bar[XB_XGEN(b.x)], 1u);
            asm volatile("s_waitcnt vmcnt(0)" ::: "memory");
        } else {
            XB_SPIN(xb_ld(&bar[XB_XGEN(b.x)]) == gen, bar);
            __builtin_amdgcn_fence(__ATOMIC_ACQUIRE, "agent");
            asm volatile("s_waitcnt vmcnt(0)" ::: "memory");
        }
    }
    __syncthreads();
}

struct Frame {
    LAS unsigned char* lds;
    unsigned char* ws;
    const float* const* in;
    int tid, lane, wave;
    int vcu, G;
};
struct Args { const float* in[33]; float* out; unsigned char* ws; int ph_lo, ph_hi; };


namespace pg8 {
typedef unsigned u32x4 __attribute__((ext_vector_type(4)));
struct RowOrder : StaticOrder {
    int lat;
    __host__ __device__ void init_rows(int lat_, int N, int G_, int c_) { lat = lat_; init(lat_ ? NBATCH * SEQ : MALL, N, G_, c_); }
    __host__ __device__ bool next(int i, Unit& u) const { if (!StaticOrder::next(i, u)) return false; if (lat) u.pm = 33 * (u.pm >> 5) + 1 + (u.pm & 31); return true; }
};
#define EPI_LOOP_ROWS for (int ai = 0; ai < 2; ++ai) _Pragma("unroll") for (int m = 0; m < 4; ++m)
#define EPI_PIN asm volatile("" ::: "memory")

struct EpiStoreBf16 {
    static constexpr bool PERM = true, AFTER_DRAIN = false;
    bf16_t* O; int ldc;
    __device__ __forceinline__ void operator()(const f32x4 (&acc)[2][2][4][2], const Unit& u, int wr, int wc, int fr, int fq) const {
        const int row0 = u.pm * BM + wr * 64 + fr, col0 = u.pn * BM + wc * 32 + 8 * fq;
#pragma unroll
        EPI_LOOP_ROWS { bf16_t* rowp = O + (size_t)(row0 + ai * HALF + m * 16) * ldc + col0;
#pragma unroll
            for (int bj = 0; bj < 2; ++bj) { const f32x4 v0 = acc[ai][bj][m][0], v1 = acc[ai][bj][m][1];
                u32x4 w; w.x = cvt_pk_bf16(v0[0], v0[1]); w.y = cvt_pk_bf16(v0[2], v0[3]); w.z = cvt_pk_bf16(v1[0], v1[1]); w.w = cvt_pk_bf16(v1[2], v1[3]);
                *(u32x4*)(rowp + bj * HALF) = w; } }
    }
};
struct EpiGate {
    static constexpr bool PERM = true, AFTER_DRAIN = false;
    bf16_t* O; int ldc; const float* bias;
    __device__ __forceinline__ void operator()(const f32x4 (&acc)[2][2][4][2], const Unit& u, int wr, int wc, int fr, int fq) const {
        const int row0 = u.pm * BM + wr * 64 + fr, col0 = u.pn * BM + wc * 32 + 8 * fq;
        f32x4 bv[2][2];
#pragma unroll
        for (int bj = 0; bj < 2; ++bj)
#pragma unroll
            for (int n = 0; n < 2; ++n) bv[bj][n] = *(const f32x4*)(bias + col0 + bj * HALF + 4 * n);
#pragma unroll
        EPI_LOOP_ROWS { EPI_PIN; bf16_t* rowp = O + (size_t)(row0 + ai * HALF + m * 16) * ldc + col0;
#pragma unroll
            for (int bj = 0; bj < 2; ++bj) { f32x4 v0 = acc[ai][bj][m][0] + bv[bj][0], v1 = acc[ai][bj][m][1] + bv[bj][1];
#pragma unroll
                for (int e = 0; e < 4; ++e) { v0[e] = 1.0f / (1.0f + __expf(-v0[e])); v1[e] = 1.0f / (1.0f + __expf(-v1[e])); }
                u32x4 w; w.x = cvt_pk_bf16(v0[0], v0[1]); w.y = cvt_pk_bf16(v0[2], v0[3]); w.z = cvt_pk_bf16(v1[0], v1[1]); w.w = cvt_pk_bf16(v1[2], v1[3]);
                *(u32x4*)(rowp + bj * HALF) = w; } }
    }
};
__device__ __forceinline__ float bf_lo(unsigned w) { return __builtin_bit_cast(float, w << 16); }
__device__ __forceinline__ float bf_hi(unsigned w) { return __builtin_bit_cast(float, w & 0xffff0000u); }
struct EpiMulAdd {
    static constexpr bool PERM = true, AFTER_DRAIN = false;
    bf16_t* O; const bf16_t* Gt; const bf16_t* Ad; int ldc;
    __device__ __forceinline__ void operator()(const f32x4 (&acc)[2][2][4][2], const Unit& u, int wr, int wc, int fr, int fq) const {
        const int row0 = u.pm * BM + wr * 64 + fr, col0 = u.pn * BM + wc * 32 + 8 * fq;
#pragma unroll
        EPI_LOOP_ROWS { EPI_PIN; const size_t ro = (size_t)(row0 + ai * HALF + m * 16) * ldc + col0;
#pragma unroll
            for (int bj = 0; bj < 2; ++bj) { const f32x4 v0 = acc[ai][bj][m][0], v1 = acc[ai][bj][m][1];
                const u32x4 g = *(const u32x4*)(Gt + ro + bj * HALF);
                float o[8];
                o[0] = bf_lo(g.x) * v0[0]; o[1] = bf_hi(g.x) * v0[1]; o[2] = bf_lo(g.y) * v0[2]; o[3] = bf_hi(g.y) * v0[3];
                o[4] = bf_lo(g.z) * v1[0]; o[5] = bf_hi(g.z) * v1[1]; o[6] = bf_lo(g.w) * v1[2]; o[7] = bf_hi(g.w) * v1[3];
                if (Ad) { const u32x4 a = *(const u32x4*)(Ad + ro + bj * HALF);
                    o[0] += bf_lo(a.x); o[1] += bf_hi(a.x); o[2] += bf_lo(a.y); o[3] += bf_hi(a.y); o[4] += bf_lo(a.z); o[5] += bf_hi(a.z); o[6] += bf_lo(a.w); o[7] += bf_hi(a.w); }
                u32x4 w; w.x = cvt_pk_bf16(o[0], o[1]); w.y = cvt_pk_bf16(o[2], o[3]); w.z = cvt_pk_bf16(o[4], o[5]); w.w = cvt_pk_bf16(o[6], o[7]);
                *(u32x4*)(O + ro + bj * HALF) = w; } }
    }
};
struct EpiResid {
    static constexpr bool PERM = false, AFTER_DRAIN = false;
    float* X; const float* gate;
    const float* xin; const float* cin;
    __device__ __forceinline__ void operator()(const f32x4 (&acc)[2][2][4][2], const Unit& u, int wr, int wc, int fr, int fq) const {
        const int row0 = u.pm * BM + wr * 64 + fr, col0 = u.pn * BM + wc * 32 + 4 * fq;
        const int bb = u.pm / 33, pt = u.pm - bb * 33, mr = (pt == 0) ? 2 : bb;
        const float* gp = gate + (size_t)mr * 12288 + col0;
        const float* sbase = xin ? (pt == 0 ? cin + (size_t)bb * CTXL * DM : xin + ((size_t)bb * SEQ + (size_t)(pt - 1) * BM) * DM) : X + (size_t)u.pm * BM * DM;
        f32x4 gv[2][2];
#pragma unroll
        for (int bj = 0; bj < 2; ++bj)
#pragma unroll
            for (int n = 0; n < 2; ++n) gv[bj][n] = *(const f32x4*)(gp + bj * HALF + n * 16);
#pragma unroll
        EPI_LOOP_ROWS { EPI_PIN; const int rl = wr * 64 + fr + ai * HALF + m * 16; float* rowp = X + (size_t)(u.pm * BM + rl) * DM + col0; const float* srow = sbase + (size_t)rl * DM + col0;
#pragma unroll
            for (int bj = 0; bj < 2; ++bj)
#pragma unroll
                for (int n = 0; n < 2; ++n) *(f32x4*)(rowp + bj * HALF + n * 16) = *(const f32x4*)(srow + bj * HALF + n * 16) + gv[bj][n] * acc[ai][bj][m][n]; }
    }
};
struct EpiF32 {
    static constexpr bool PERM = false, AFTER_DRAIN = false;
    float* C; int ldc;
    __device__ __forceinline__ void operator()(const f32x4 (&acc)[2][2][4][2], const Unit& u, int wr, int wc, int fr, int fq) const {
        const int row0 = u.pm * BM + wr * 64 + fr, col0 = u.pn * BM + wc * 32 + 4 * fq;
#pragma unroll
        EPI_LOOP_ROWS { float* rowp = C + (size_t)(row0 + ai * HALF + m * 16) * ldc + col0;
#pragma unroll
            for (int bj = 0; bj < 2; ++bj)
#pragma unroll
                for (int n = 0; n < 2; ++n) *(f32x4*)(rowp + bj * HALF + n * 16) = acc[ai][bj][m][n]; }
    }
};
struct EpiQ {
    static constexpr bool PERM = true, AFTER_DRAIN = false;
    bf16_t* Q; const f32x2* rope; float qscale;
    __device__ __forceinline__ void operator()(const f32x4 (&acc)[2][2][4][2], const Unit& u, int wr, int wc, int fr, int fq) const {
        const int bb = u.pm / 33, tp0 = (u.pm - bb * 33) * BM + wr * 64 + fr, col0 = u.pn * BM + wc * 32 + 8 * fq;
#pragma unroll
        for (int bj = 0; bj < 2; ++bj) { const int c = col0 + bj * HALF, hd = c / QKD, d = c - hd * QKD;
#pragma unroll
            EPI_LOOP_ROWS { EPI_PIN; const int tp = tp0 + ai * HALF + m * 16;
                f32x4 v0 = acc[ai][bj][m][0], v1 = acc[ai][bj][m][1];
                if (d >= 64) { const int i0 = (d - 64) >> 1; const f32x2* rp = rope + (size_t)tp * 16 + i0;
                    const f32x2 c0 = rp[0], c1 = rp[1], c2 = rp[2], c3 = rp[3];
                    float a, b;
                    a = v0[0]; b = v0[1]; v0[0] = a * c0.x - b * c0.y; v0[1] = a * c0.y + b * c0.x;
                    a = v0[2]; b = v0[3]; v0[2] = a * c1.x - b * c1.y; v0[3] = a * c1.y + b * c1.x;
                    a = v1[0]; b = v1[1]; v1[0] = a * c2.x - b * c2.y; v1[1] = a * c2.y + b * c2.x;
                    a = v1[2]; b = v1[3]; v1[2] = a * c3.x - b * c3.y; v1[3] = a * c3.y + b * c3.x; }
                v0 = v0 * qscale; v1 = v1 * qscale;
                u32x4 w; w.x = cvt_pk_bf16(v0[0], v0[1]); w.y = cvt_pk_bf16(v0[2], v0[3]); w.z = cvt_pk_bf16(v1[0], v1[1]); w.w = cvt_pk_bf16(v1[2], v1[3]);
                *(u32x4*)(Q + ((size_t)(bb * NH + hd) * TPB + tp) * QKD + d) = w; } }
    }
};
struct EpiKV {
    static constexpr bool PERM = true, AFTER_DRAIN = false;
    bf16_t* K; bf16_t* V;
    __device__ __forceinline__ void operator()(const f32x4 (&acc)[2][2][4][2], const Unit& u, int wr, int wc, int fr, int fq) const {
        const int bb = u.pm / 33, tp0 = (u.pm - bb * 33) * BM + wr * 64 + fr;
        const bool isK = wc < 2;
        bf16_t* base = isK ? K : V; const int pitch = isK ? QKD : 64, doff = 32 * (wc & 1) + 8 * fq;
#pragma unroll
        for (int bj = 0; bj < 2; ++bj) { const int hd = 2 * u.pn + bj;
            bf16_t* hb = base + (size_t)(bb * NH + hd) * TPB * pitch;
#pragma unroll
            EPI_LOOP_ROWS { EPI_PIN; const int tp = tp0 + ai * HALF + m * 16;
                const f32x4 v0 = acc[ai][bj][m][0], v1 = acc[ai][bj][m][1];
                u32x4 w; w.x = cvt_pk_bf16(v0[0], v0[1]); w.y = cvt_pk_bf16(v0[2], v0[3]); w.z = cvt_pk_bf16(v1[0], v1[1]); w.w = cvt_pk_bf16(v1[2], v1[3]);
                *(u32x4*)((char*)hb + (unsigned)((tp * pitch + doff) * 2)) = w; } }
    }
};
}

struct TItem { const float* W; bf16* WT; int K, ldw, c0, N, mapq, item; };
__device__ __forceinline__ void p0_item_load(const TItem& T, int lane, f32x4 (&x)[8]) {
    const int nblk = T.N / 32, kb = T.item / nblk, nb = T.item - kb * nblk, k0 = 64 * kb, n0 = 32 * nb;
    const float* p = T.W + (size_t)(k0 + (lane >> 3)) * T.ldw + T.c0 + n0 + (lane & 7) * 4;
#pragma unroll
    for (int i = 0; i < 8; ++i) x[i] = *(const GAS f32x4*)(p + (size_t)(8 * i) * T.ldw);
}
__device__ __forceinline__ void p0_item_finish(const TItem& T, const f32x4 (&x)[8], LAS float* scr, int lane) {
    const int nblk = T.N / 32, kb = T.item / nblk, nb = T.item - kb * nblk, k0 = 64 * kb, n0 = 32 * nb;
#pragma unroll
    for (int i = 0; i < 8; ++i) { LAS float* d = scr + (8 * i + (lane >> 3)) * 33 + (lane & 7) * 4; d[0] = x[i].x; d[1] = x[i].y; d[2] = x[i].z; d[3] = x[i].w; }
    LDS_WAIT(); asm volatile("" ::: "memory");
    const int c = lane & 7;
#pragma unroll
    for (int j = 0; j < 4; ++j) { const int n = (lane >> 3) + 8 * j; const LAS float* s = scr + (8 * c) * 33 + n;
        v4u o; o.x = pk2(s[0 * 33], s[1 * 33]); o.y = pk2(s[2 * 33], s[3 * 33]); o.z = pk2(s[4 * 33], s[5 * 33]); o.w = pk2(s[6 * 33], s[7 * 33]);
        int nn = n0 + n;
        if (T.mapq) { const int hd = nn / QKD, d = nn - hd * QKD; if (d >= 64) { const int i = (d - 64) & 15, s2 = (d - 64) >> 4; nn = hd * QKD + 64 + 2 * i + s2; } }
        *(GAS v4u*)(T.WT + (size_t)nn * T.K + k0 + 8 * c) = o; }
    LDS_WAIT(); asm volatile("" ::: "memory");
}

__device__ __forceinline__ const float* karg(int i);
constexpr int TB_INA = (DM / 128) * ((INA + 127) / 128), TB_G = (DM / 128) * (DM / 128), TB_BR = (RW / 128) * (DM / 128), TB_UQ = (512 / 128) * (NQ / 128), TB_UKV = (256 / 128) * (NKV / 128);
constexpr int TB_N = TB_INA + 2 * TB_G + 2 * TB_BR + TB_G + TB_UQ + TB_UKV;
constexpr int TI_LR = 1 * (RW / 32), TI_N = 4 * TI_LR;
__device__ __forceinline__ TItem p0_resolve_big(unsigned char* ws, int git) {
    const int l = git / TB_N; int r = git - l * TB_N; TItem T; T.mapq = 0; T.c0 = 0;
    if (r < TB_INA) { T.W = karg(7) + (size_t)l * DM * INC; T.K = DM; T.ldw = INC; T.N = INA; T.WT = (bf16*)(ws + WS_WINA) + (size_t)l * INA_P * DM; T.item = r; return T; } r -= TB_INA;
    if (r < TB_G) { T.W = karg(7) + (size_t)l * DM * INC; T.K = DM; T.ldw = INC; T.c0 = INA; T.N = DM; T.WT = (bf16*)(ws + WS_WGA) + (size_t)l * DM * DM; T.item = r; return T; } r -= TB_G;
    if (r < TB_G) { T.W = karg(7) + (size_t)l * DM * INC; T.K = DM; T.ldw = INC; T.c0 = INA + DM; T.N = DM; T.WT = (bf16*)(ws + WS_WGB) + (size_t)l * DM * DM; T.item = r; return T; } r -= TB_G;
    if (r < TB_BR) { T.W = karg(24) + (size_t)l * RW * DM; T.K = RW; T.ldw = DM; T.N = DM; T.WT = (bf16*)(ws + WS_WA) + (size_t)l * DM * RW; T.item = r; return T; } r -= TB_BR;
    if (r < TB_BR) { T.W = karg(25) + (size_t)l * RW * DM; T.K = RW; T.ldw = DM; T.N = DM; T.WT = (bf16*)(ws + WS_WB) + (size_t)l * DM * RW; T.item = r; return T; } r -= TB_BR;
    if (r < TB_G) { T.W = karg(26) + (size_t)l * DM * DM; T.K = DM; T.ldw = DM; T.N = DM; T.WT = (bf16*)(ws + WS_WO) + (size_t)l * DM * DM; T.item = r; return T; } r -= TB_G;
    if (r < TB_UQ) { T.W = karg(21) + (size_t)l * 512 * NQ; T.K = 512; T.ldw = NQ; T.N = NQ; T.WT = (bf16*)(ws + WS_WUQ) + (size_t)l * NQ * 512; T.item = r; T.mapq = 1; return T; } r -= TB_UQ;
    { T.W = karg(23) + (size_t)l * 256 * NKV; T.K = 256; T.ldw = NKV; T.N = NKV; T.WT = (bf16*)(ws + WS_WUKV) + (size_t)l * NKV * 256; T.item = r; return T; }
}
__device__ __forceinline__ void p0_big_load(const TItem& T, int tid, f32x4 (&x)[8]) {
    const int nblk = (T.N + 127) / 128, kb = T.item / nblk, nb = T.item - kb * nblk, k0 = 128 * kb, col = 128 * nb + (tid & 31) * 4;
    const float* p = T.W + (size_t)(k0 + (tid >> 5)) * T.ldw + T.c0 + col; const bool ok = col < T.N;
#pragma unroll
    for (int i = 0; i < 8; ++i) x[i] = ok ? *(const GAS f32x4*)(p + (size_t)(16 * i) * T.ldw) : (f32x4){0.f, 0.f, 0.f, 0.f};
}
__device__ __forceinline__ void p0_big_finish(const TItem& T, const f32x4 (&x)[8], LAS float* tile, int tid) {
    const int nblk = (T.N + 127) / 128, kb = T.item / nblk, nb = T.item - kb * nblk, k0 = 128 * kb, n0 = 128 * nb;
    __syncthreads();
#pragma unroll
    for (int i = 0; i < 8; ++i) *(LAS f32x4*)(tile + ((tid >> 5) + 16 * i) * 132 + (tid & 31) * 4) = x[i];
    __syncthreads();
    const int n = tid & 127, cg = tid >> 7; int nn = n0 + n;
    if (nn < T.N) {
        if (T.mapq) { const int hd = nn / QKD, d = nn - hd * QKD; if (d >= 64) { const int i = (d - 64) & 15, s2 = (d - 64) >> 4; nn = hd * QKD + 64 + 2 * i + s2; } }
#pragma unroll
        for (int c = 0; c < 4; ++c) { const LAS float* s = tile + (32 * cg + 8 * c) * 132 + n;
            v4u o; o.x = pk2(s[0 * 132], s[1 * 132]); o.y = pk2(s[2 * 132], s[3 * 132]); o.z = pk2(s[4 * 132], s[5 * 132]); o.w = pk2(s[6 * 132], s[7 * 132]);
            *(GAS v4u*)(T.WT + (size_t)nn * T.K + k0 + 32 * cg + 8 * c) = o; } }
}
__device__ __forceinline__ TItem p0_resolve(unsigned char* ws, int git) {
    const int l = git / TI_N; int r = git - l * TI_N; TItem T; T.mapq = 0; T.c0 = 0;
    const int which = r / TI_LR, d = which & 1, isa = which >> 1; r -= which * TI_LR;
    T.W = (isa ? karg(13) : karg(11)) + (size_t)(l * 2 + d) * 64 * RW; T.K = 64; T.ldw = RW; T.N = RW; T.WT = (bf16*)(ws + (isa ? WS_AUP : WS_WUP)) + (size_t)(l * 2 + d) * RW * 64; T.item = r; return T;
}
__device__ __forceinline__ void p0_prologue(Frame& F) {
    LAS float* scr = (LAS float*)(F.lds + F.wave * 16384);
    const int gw = F.vcu * NWAVES + F.wave, NGW = F.G * NWAVES;
    unsigned char* ws = F.ws;
    for (int rp_ = 0; rp_ < (DBG_REPEAT == 102 ? 2 : 1); ++rp_)
    { float* modw = (float*)(ws + WS_CTL + CTL_MOD_OFF); const float* adaw = karg(4); const float* adab = karg(5); const float* cin = karg(1); const float* cctx = karg(3);
      LAS float* SIL = (LAS float*)F.lds;
      LAS f32x2* part = (LAS f32x2*)(F.lds + 32768);
      if (F.vcu < NLAYER * 96) {
          for (int i = F.tid; i < 3 * DM; i += 512) { const int r = i >> 11, k = i & 2047; const float c = r < 2 ? cin[r * DM + k] : cctx[k]; SIL[i] = c / (1.f + __expf(-c)); }
          __syncthreads(); }
      for (int uu = F.vcu; uu < NLAYER * 96; uu += F.G) { const int cb = uu % 96, l = uu / 96;
          const int n0 = cb * 128 + F.lane * 2; const float* aw = adaw + (size_t)l * DM * 12288 + n0;
          f32x2 a0 = {0, 0}, a1 = a0, a2 = a0;
#pragma unroll 1
          for (int k0 = F.wave * 256; k0 < F.wave * 256 + 256; k0 += 16) { f32x2 w[16];
#pragma unroll
              for (int j = 0; j < 16; ++j) w[j] = *(const GAS f32x2*)(aw + (size_t)(k0 + j) * 12288);
#pragma unroll
              for (int j = 0; j < 16; ++j) { a0 = a0 + w[j] * SIL[k0 + j]; a1 = a1 + w[j] * SIL[DM + k0 + j]; a2 = a2 + w[j] * SIL[2 * DM + k0 + j]; } }
          __syncthreads();
          part[(F.wave * 3 + 0) * 64 + F.lane] = a0; part[(F.wave * 3 + 1) * 64 + F.lane] = a1; part[(F.wave * 3 + 2) * 64 + F.lane] = a2;
          __syncthreads();
          if (F.wave < 3) { f32x2 s = *(const GAS f32x2*)(adab + (size_t)l * 12288 + n0);
#pragma unroll
              for (int w8 = 0; w8 < 8; ++w8) s = s + part[(w8 * 3 + F.wave) * 64 + F.lane];
              *(GAS f32x2*)(modw + ((size_t)l * 3 + F.wave) * 12288 + n0) = s; }
          __syncthreads(); } }
    for (int rp_ = 0; rp_ < (DBG_REPEAT == 101 ? 2 : 1); ++rp_)
    { unsigned* ctr = (unsigned*)(ws + WS_CTL) + 2048 + 64 * rp_; LAS float* tile = (LAS float*)F.lds; LAS int* slot = (LAS int*)(F.lds + 128 * 132 * 4);
#define P0_GRAB(dst) do { __syncthreads(); if (F.tid == 0) *slot = (int)__hip_atomic_fetch_add(ctr, 1u, __ATOMIC_RELAXED, __HIP_MEMORY_SCOPE_AGENT); __syncthreads(); dst = *slot; } while (0)
      int it; P0_GRAB(it); f32x4 xa[8], xb[8]; TItem T, Tn;
      if (it < NLAYER * TB_N) { T = p0_resolve_big(ws, it); p0_big_load(T, F.tid, xa); }
      while (it < NLAYER * TB_N) { int itn; P0_GRAB(itn); const bool more = itn < NLAYER * TB_N;
          if (more) { Tn = p0_resolve_big(ws, itn); p0_big_load(Tn, F.tid, xb); }
          p0_big_finish(T, xa, tile, F.tid);
          if (more) { T = Tn;
#pragma unroll
              for (int i = 0; i < 8; ++i) xa[i] = xb[i]; }
          it = itn; }
#undef P0_GRAB
      __syncthreads();
      for (int itw = gw; itw < NLAYER * TI_N; itw += NGW) { f32x4 xw[8]; const TItem Tw = p0_resolve(ws, itw); p0_item_load(Tw, F.lane, xw); p0_item_finish(Tw, xw, scr, F.lane); }
    }
    const int gt = gw * 64 + F.lane, NGT = NGW * 64;
    { const float* gup = karg(14);
    for (int i = gt; i < NLAYER * 2 * 32 * RW; i += NGT) { const int ch = i & 1023, r = (i >> 10) & 31, ld = i >> 15;
        ((bf16*)(ws + WS_GUP))[((size_t)ld * RW + ch) * 32 + r] = (bf16)f2bf(gup[i]); } }
    for (int i = gt; i < NLAYER * (INA_P - INA) * DM / 8; i += NGT) { const int l = i / ((INA_P - INA) * DM / 8), r = i - l * ((INA_P - INA) * DM / 8);
        ((GAS v4u*)((bf16*)(ws + WS_WINA) + ((size_t)l * INA_P + INA) * DM))[r] = (v4u){0u, 0u, 0u, 0u}; }
    { f32x2* rt = (f32x2*)(ws + WS_ROPE);
      for (int i = gt; i < TPB * 16; i += NGT) { const int tp = i >> 4, k = i & 15; f32x2 o = {1.f, 0.f};
          if (tp >= CTXL) { const int t = tp - CTXL, row = t >> 6, col = t & 63, j = k & 7; const float fr = powf(10000.0f, -(float)j / 8.0f);
              const float ang = (float)(k < 8 ? row : col) * fr; o.x = cosf(ang); o.y = sinf(ang); }
          rt[i] = o; } }
    for (int rp_ = 0; rp_ < (DBG_REPEAT == 103 ? 2 : 1); ++rp_)
    { LAS float* KEY = (LAS float*)F.lds;
      LAS float* WQT = (LAS float*)(F.lds + 65536);
      const float* pkeys = karg(29); const float* pwq = karg(28);
      __syncthreads();
      for (int uu = F.vcu; uu < NLAYER * 16 * 32; uu += F.G) { const int kb = uu & 31, hp = (uu >> 5) & 15, l = uu >> 9;
          const GAS f32x4* ksrc = (const GAS f32x4*)(pkeys + ((size_t)l * 16 + hp) * 16384);
          for (int i = F.tid; i < 4096; i += 512) ((LAS f32x4*)KEY)[i] = ksrc[i];
          for (int i = F.tid; i < 2048; i += 512) { const int kk = i >> 5, d4 = i & 31;
              *(LAS f32x4*)(WQT + kk * 132 + d4 * 4) = *(const GAS f32x4*)(pwq + ((size_t)l * DM + kb * 64 + kk) * DM + hp * 128 + d4 * 4); }
          __syncthreads();
          const int kq = F.tid & 15, keyq = F.tid >> 4;
          float acc[4][4];
#pragma unroll
          for (int j = 0; j < 4; ++j)
#pragma unroll
              for (int i = 0; i < 4; ++i) acc[j][i] = 0.f;
          for (int d = 0; d < 128; d += 4) { f32x4 w[4], q[4];
#pragma unroll
              for (int i = 0; i < 4; ++i) w[i] = *(LAS f32x4*)(WQT + (kq + 16 * i) * 132 + d);
#pragma unroll
              for (int j = 0; j < 4; ++j) q[j] = *(LAS f32x4*)(KEY + (4 * keyq + j) * 128 + d);
#pragma unroll
              for (int j = 0; j < 4; ++j)
#pragma unroll
                  for (int i = 0; i < 4; ++i) acc[j][i] += q[j].x * w[i].x + q[j].y * w[i].y + q[j].z * w[i].z + q[j].w * w[i].w; }
          bf16* dst = (bf16*)(ws + WS_WQK) + ((size_t)l * DM + hp * 128 + 4 * keyq) * DM + kb * 64 + kq;
#pragma unroll
          for (int j = 0; j < 4; ++j)
#pragma unroll
              for (int i = 0; i < 4; ++i) dst[(size_t)j * DM + 16 * i] = (bf16)f2bf(acc[j][i]);
          __syncthreads(); } }
}

__device__ __forceinline__ void modnorm_phase(Frame& F, const float* X, const float* g, const float* mod  , int chunk_sh, bf16* H, int skip_ctx, const float* xin = nullptr, const float* cin = nullptr) {
    const int gw = F.vcu * NWAVES + F.wave, NGW = F.G * NWAVES;
    for (int m = gw; m < MALL; m += NGW) {
        const int b = m / TPB, tp = m - b * TPB; if (skip_ctx && tp < CTXL) continue;
        const int mr = tp < CTXL ? 2 : b;
        const float* srow = xin ? (tp < CTXL ? cin + ((size_t)b * CTXL + tp) * DM : xin + ((size_t)b * SEQ + (tp - CTXL)) * DM) : X + (size_t)m * DM;
        const GAS f32x4* xr = (const GAS f32x4*)srow + F.lane;
        f32x4 v[8]; float s = 0.f;
#pragma unroll
        for (int j = 0; j < 8; ++j) { v[j] = xr[64 * j]; s += (v[j].x * v[j].x + v[j].y * v[j].y) + (v[j].z * v[j].z + v[j].w * v[j].w); }
        const float rs = rsqrtf(wave_sum(s) * (1.f / DM) + NORM_EPS);
        const float* sh = mod + (size_t)mr * 12288 + chunk_sh * DM; const float* sc = sh + DM;
        GAS v2u* o8 = (GAS v2u*)(H + (size_t)m * DM) + F.lane;
#pragma unroll
        for (int j = 0; j < 8; ++j) { const int c = (F.lane + 64 * j) * 4;
            const f32x4 gg = *(const GAS f32x4*)(g + c), s1 = *(const GAS f32x4*)(sc + c), s0 = *(const GAS f32x4*)(sh + c);
            f32x4 y = v[j] * rs * gg; y = y * (s1 + 1.0f) + s0;
            v2u o; o.x = pk2(y.x, y.y); o.y = pk2(y.z, y.w); o8[64 * j] = o; }
    }
}

typedef float f32x4v __attribute__((ext_vector_type(4)));
#define MFMA16(a, b, c) __builtin_amdgcn_mfma_f32_16x16x32_bf16((a), (b), (c), 0, 0, 0)
#define MFMA32(a, b, c) __builtin_amdgcn_mfma_f32_32x32x16_bf16((a), (b), (c), 0, 0, 0)

struct FeatP {
    const bf16* PA; const float* mu; const float* w0; const float* a0; const float* k_k; const float* k_a; const float* r_k;
    const bf16* WUP; const bf16* AUP; const bf16* GUP;
    const float* qnorm; const float* kvnorm; const f32x2* rope;
    bf16* RI; bf16* GG; float* BON; bf16* QN; bf16* KVN; bf16* K;
};
__device__ __forceinline__ f32x4 ld4bf(const bf16* p) { const v2u w = *(const GAS v2u*)p; return (f32x4){bflo(w.x), bfhi(w.x), bflo(w.y), bfhi(w.y)}; }
__device__ __forceinline__ f32x4 mix4(const bf16* PA, int m, int c, bool hp, bool hn, const float* mu) {
    const f32x4 pc = ld4bf(PA + (size_t)m * INA_P + c);
    f32x4 pp = {0, 0, 0, 0}, pn = {0, 0, 0, 0};
    if (hp) pp = ld4bf(PA + (size_t)(m - 1) * INA_P + c);
    if (hn) pn = ld4bf(PA + (size_t)(m + 1) * INA_P + c);
    const f32x4 mm = *(const GAS f32x4*)(mu + c);
    return pc + ((pp + pn) * 0.5f - pc) * mm;
}
__device__ __forceinline__ void unpack8(const v4u w, float (&x)[8]) { x[0] = bflo(w.x); x[1] = bfhi(w.x); x[2] = bflo(w.y); x[3] = bfhi(w.y); x[4] = bflo(w.z); x[5] = bfhi(w.z); x[6] = bflo(w.w); x[7] = bfhi(w.w); }
__device__ __forceinline__ v4u pack8f(const float (&x)[8]) { v4u o; o.x = pk2(x[0], x[1]); o.y = pk2(x[2], x[3]); o.z = pk2(x[4], x[5]); o.w = pk2(x[6], x[7]); return o; }
__device__ __forceinline__ void mix8(const bf16* rowc, bool hp, bool hn, const float (&mu)[8], float (&o)[8]) {
    const v4u zc = {0u, 0u, 0u, 0u};
    const v4u wc = *(const GAS v4u*)rowc, wp = hp ? *(const GAS v4u*)(rowc - INA_P) : zc, wn = hn ? *(const GAS v4u*)(rowc + INA_P) : zc;
    float c[8], p[8], n[8]; unpack8(wc, c); unpack8(wp, p); unpack8(wn, n);
#pragma unroll
    for (int e = 0; e < 8; ++e) o[e] = c[e] + (0.5f * (p[e] + n[e]) - c[e]) * mu[e];
}
struct Raw3 { v4u c, p, n; };
__device__ __forceinline__ Raw3 load3(const bf16* rowc, bool hp, bool hn) { const v4u zc = {0u, 0u, 0u, 0u}; Raw3 r; r.c = *(const GAS v4u*)rowc; r.p = hp ? *(const GAS v4u*)(rowc - INA_P) : zc; r.n = hn ? *(const GAS v4u*)(rowc + INA_P) : zc; return r; }
__device__ __forceinline__ void mix8r(const Raw3& w, const float (&mu)[8], float (&o)[8]) {
    float c[8], p[8], n[8]; unpack8(w.c, c); unpack8(w.p, p); unpack8(w.n, n);
#pragma unroll
    for (int e = 0; e < 8; ++e) o[e] = c[e] + (0.5f * (p[e] + n[e]) - c[e]) * mu[e];
}
__device__ __forceinline__ void features_phase(Frame& F, const FeatP& P) {
    constexpr int LAP = 328;
    LAS bf16* LA = (LAS bf16*)F.lds;
    LAS float* SSQ = (LAS float*)(F.lds + 10752);
    LAS float* PRM = (LAS float*)(F.lds + 12288);
    const int lane = F.lane, w = F.wave, tk = lane & 15, q4 = lane >> 4;
    constexpr int NTILE = MALL / 16, NTG = 64;
    for (int su = F.vcu; su < 4 * NTG; su += F.G) {
        const int cg = su & 3, tg = su >> 2, cw = 256 * cg + 32 * w, ch8 = cw + 8 * q4, hd = 4 * cg + (w >> 1);
        __syncthreads();
        for (int i = F.tid; i < 2560; i += 512) { const int prm = i >> 8, c = (i & 255) + 256 * cg; float v;
            switch (prm) { case 0: v = P.k_k[c]; break; case 1: v = P.k_a[c]; break; case 2: v = P.r_k[c]; break; case 3: v = P.w0[c]; break; case 4: v = P.w0[RW + c]; break;
                           case 5: v = P.a0[c]; break; case 6: v = P.a0[RW + c]; break; case 7: v = P.mu[c]; break; case 8: v = P.mu[RW + c]; break; default: v = P.mu[2 * RW + c]; break; }
            PRM[i] = v; }
        bf16x8 fw[2][2][2], fa[2][2][2], fg[2][2];
        { const int chA = cw + 8 * (tk >> 2) + (tk & 3);
#pragma unroll
          for (int d = 0; d < 2; ++d)
#pragma unroll
              for (int t = 0; t < 2; ++t) {
#pragma unroll
                  for (int ks = 0; ks < 2; ++ks) { fw[d][t][ks] = *(const GAS bf16x8*)(P.WUP + ((size_t)d * RW + chA + 4 * t) * 64 + ks * 32 + q4 * 8); fa[d][t][ks] = *(const GAS bf16x8*)(P.AUP + ((size_t)d * RW + chA + 4 * t) * 64 + ks * 32 + q4 * 8); }
                  fg[d][t] = *(const GAS bf16x8*)(P.GUP + ((size_t)d * RW + chA + 4 * t) * 32 + q4 * 8); } }
        for (int tt = tg; tt < NTILE; tt += NTG) {
            const int m0 = tt * 16;
            __syncthreads();
            for (int it = F.tid; it < 640; it += 512) { const int tkk = it / 40, c8 = (it - tkk * 40) * 8, c = C_WD + c8, m = m0 + tkk, tp = m % TPB;
                const bool hp = (tp != 0) && (tp != CTXL), hn = (tp != CTXL - 1) && (tp != TPB - 1);
                float mu[8], v[8];
                { const f32x4 a = *(const GAS f32x4*)(P.mu + c), b2 = *(const GAS f32x4*)(P.mu + c + 4); mu[0] = a.x; mu[1] = a.y; mu[2] = a.z; mu[3] = a.w; mu[4] = b2.x; mu[5] = b2.y; mu[6] = b2.z; mu[7] = b2.w; }
                mix8(P.PA + (size_t)m * INA_P + c, hp, hn, mu, v);
#pragma unroll
                for (int e = 0; e < 8; ++e) { if (c < C_AD) v[e] = tanhf(v[e]); else if (c >= C_GD) v[e] = sigmoidf_(v[e]); }
                *(LAS v4u*)(LA + tkk * LAP + c8) = pack8f(v); }
            if ((tt & 3) == cg) {
#pragma unroll
                for (int t2 = 0; t2 < 2; ++t2) { const int m = m0 + 2 * w + t2, b = m / TPB, tp = m - b * TPB; const bf16* row = P.PA + (size_t)m * INA_P;
                    { float x[8]; unpack8(*(const GAS v4u*)(row + C_QC + lane * 8), x); float s = 0.f;
#pragma unroll
                      for (int e = 0; e < 8; ++e) s += x[e] * x[e];
                      const float rs = rsqrtf(wave_sum(s) * (1.f / 512.f) + NORM_EPS);
#pragma unroll
                      for (int e = 0; e < 8; ++e) x[e] = x[e] * rs * P.qnorm[lane * 8 + e];
                      *(GAS v4u*)(P.QN + (size_t)m * 512 + lane * 8) = pack8f(x); }
                    { const v2u q = *(const GAS v2u*)(row + C_KVC + lane * 4);
                      float x[4] = {bflo(q.x), bfhi(q.x), bflo(q.y), bfhi(q.y)}; float s = 0.f;
#pragma unroll
                      for (int e = 0; e < 4; ++e) s += x[e] * x[e];
                      const float rs = rsqrtf(wave_sum(s) * (1.f / 256.f) + NORM_EPS);
#pragma unroll
                      for (int e = 0; e < 4; ++e) x[e] = x[e] * rs * P.kvnorm[lane * 4 + e];
                      v2u o; o.x = pk2(x[0], x[1]); o.y = pk2(x[2], x[3]);
                      *(GAS v2u*)(P.KVN + (size_t)m * 256 + lane * 4) = o; }
                    if (lane < 16) { const float x1 = bf1(row[C_KR + lane]), x2 = bf1(row[C_KR + 16 + lane]); const f32x2 cs = P.rope[(size_t)tp * 16 + lane];
                        const unsigned o = pk2(x1 * cs.x - x2 * cs.y, x1 * cs.y + x2 * cs.x);
#pragma unroll
                        for (int h2 = 0; h2 < NH; ++h2) *(GAS unsigned*)(P.K + ((size_t)(b * NH + h2) * TPB + tp) * QKD + 64 + 2 * lane) = o; } } }
            const int m = m0 + tk, b = m / TPB, tp = m - b * TPB;
            const bool hp = (tp != 0) && (tp != CTXL), hn = (tp != CTXL - 1) && (tp != TPB - 1);
            const bf16* rowp = P.PA + (size_t)m * INA_P + ch8;
            const int pc = 32 * w + 8 * q4;
            float prm[8], kmx[8], kx[8];
#pragma unroll
            for (int e = 0; e < 8; ++e) prm[e] = PRM[8 * 256 + pc + e];
            mix8(rowp + RW, hp, hn, prm, kmx);
            const Raw3 rawr = load3(rowp, hp, hn), rawv = load3(rowp + 2 * RW, hp, hn);
            { float s = 0.f;
#pragma unroll
              for (int e = 0; e < 8; ++e) { kx[e] = kmx[e] * PRM[0 * 256 + pc + e]; s += kx[e] * kx[e]; }
              s += bpermf(lane ^ 16, s); s += bpermf(lane ^ 32, s);
              if (q4 == 0) SSQ[tk * 8 + w] = s; }
            __syncthreads();
            const float rsn = rsqrtf(SSQ[tk * 8 + w] + SSQ[tk * 8 + (w ^ 1)] + 1e-12f);
            f32x4 cw_[2][2], ca_[2][2], cg_[2][2];
#pragma unroll
            for (int d = 0; d < 2; ++d) {
                const bf16x8 bg = *(const LAS bf16x8*)(LA + tk * LAP + 256 + d * 32 + q4 * 8);
                bf16x8 bw[2], ba[2];
#pragma unroll
                for (int ks = 0; ks < 2; ++ks) { bw[ks] = *(const LAS bf16x8*)(LA + tk * LAP + d * 64 + ks * 32 + q4 * 8); ba[ks] = *(const LAS bf16x8*)(LA + tk * LAP + 128 + d * 64 + ks * 32 + q4 * 8); }
#pragma unroll
                for (int t = 0; t < 2; ++t) { f32x4 z = {0, 0, 0, 0};
                    cw_[d][t] = MFMA16(fw[d][t][1], bw[1], MFMA16(fw[d][t][0], bw[0], z));
                    ca_[d][t] = MFMA16(fa[d][t][1], ba[1], MFMA16(fa[d][t][0], ba[0], z));
                    cg_[d][t] = MFMA16(fg[d][t], bg, z); } }
            float r8[8], v8[8], kk8[8];
#pragma unroll
            for (int e = 0; e < 8; ++e) prm[e] = PRM[7 * 256 + pc + e];
            mix8r(rawr, prm, r8);
#pragma unroll
            for (int e = 0; e < 8; ++e) prm[e] = PRM[9 * 256 + pc + e];
            mix8r(rawv, prm, v8);
#pragma unroll
            for (int e = 0; e < 8; ++e) kk8[e] = kx[e] * rsn;
            bf16* rec = P.RI + ((size_t)(b * NH + hd) * TPB + tp) * RREC + (ch8 & 63);
            *(GAS v4u*)(rec) = pack8f(r8); *(GAS v4u*)(rec + 64) = pack8f(kk8); *(GAS v4u*)(rec + 128) = pack8f(v8);
#pragma unroll
            for (int d = 0; d < 2; ++d) {
                float ld[8], ke[8], bb[8], gg[8]; float bs = 0.f;
#pragma unroll
                for (int e = 0; e < 8; ++e) { const int t = e >> 2, r = e & 3;
                    ld[e] = -0.60653066f * sigmoidf_(PRM[(3 + d) * 256 + pc + e] + cw_[d][t][r]);
                    const float aa = sigmoidf_(PRM[(5 + d) * 256 + pc + e] + ca_[d][t][r]);
                    ke[e] = kmx[e] * (1.0f + (aa - 1.0f) * PRM[1 * 256 + pc + e]); bb[e] = kk8[e] * aa; gg[e] = cg_[d][t][r];
                    bs += r8[e] * ke[e] * PRM[2 * 256 + pc + e]; }
                *(GAS v4u*)(rec + (3 + 3 * d) * 64) = pack8f(ld); *(GAS v4u*)(rec + (4 + 3 * d) * 64) = pack8f(bb); *(GAS v4u*)(rec + (5 + 3 * d) * 64) = pack8f(ke);
                *(GAS v4u*)(P.GG + ((size_t)d * MALL + m) * RW + ch8) = pack8f(gg);
                bs += bpermf(lane ^ 16, bs); bs += bpermf(lane ^ 32, bs);
                if (q4 == 0) P.BON[((size_t)d * MALL + m) * 32 + 2 * hd + (w & 1)] = bs; }
        }
    }
}

constexpr int SCH = 32;
constexpr int SSTEP = 6 * 64;
__device__ __forceinline__ int scan_tp(int dir, int s) { return dir == 0 ? s : (s < CTXL ? (CTXL - 1 - s) : (TPB - 1 - (s - CTXL))); }
__device__ __forceinline__ void scan_load(v4u (&rg)[6], const bf16* RIh, int dir, int chunk, int htid) {
    const int tp = scan_tp(dir, chunk * SCH + (htid >> 3));
    const bf16* rec = RIh + (size_t)tp * RREC + (htid & 7) * 8;
#pragma unroll
    for (int i = 0; i < 3; ++i) rg[i] = *(const GAS v4u*)(rec + i * 64);
    rec += (3 + 3 * dir) * 64;
#pragma unroll
    for (int i = 0; i < 3; ++i) rg[3 + i] = *(const GAS v4u*)(rec + i * 64);
}
__device__ __forceinline__ void scan_store(const v4u (&rg)[6], LAS float* buf, int htid) {
    LAS float* d0 = buf + (htid >> 3) * SSTEP + (htid & 7) * 8;
#pragma unroll
    for (int i = 0; i < 6; ++i) { constexpr int SLOT[6] = {4, 0, 5, 2, 1, 3};
        const v4u wv = rg[i];
        f32x4 lo = {bflo(wv.x), bfhi(wv.x), bflo(wv.y), bfhi(wv.y)}, hi = {bflo(wv.z), bfhi(wv.z), bflo(wv.w), bfhi(wv.w)};
        if (i == 3) {
#pragma unroll
            for (int e = 0; e < 4; ++e) { lo[e] = __expf(lo[e]); hi[e] = __expf(hi[e]); } }
        LAS float* d = d0 + SLOT[i] * 64;
        *(LAS f32x4*)d = lo; *(LAS f32x4*)(d + 4) = hi; }
}
__device__ __forceinline__ void scan_phase(Frame& F, const bf16* RI, bf16* Y) {
    LAS float* bufs = (LAS float*)F.lds;
    constexpr int NCH = TPB / SCH;
    for (int uu = F.vcu; uu < NBATCH * NH * 2 * 4; uu += F.G) {
        const int rg = uu & 3, dir = (uu >> 2) & 1, hd = (uu >> 3) & 15, b = uu >> 7;
        const bf16* RIh = RI + (size_t)(b * NH + hd) * TPB * RREC;
        const int htid = F.tid - 256;
        v4u ra[6], rb[6];
        __syncthreads();
        if (F.wave >= 4) { scan_load(rb, RIh, dir, 0, htid); scan_load(ra, RIh, dir, 1, htid); scan_store(rb, bufs, htid); scan_load(rb, RIh, dir, 2, htid); }
        __syncthreads();
        const int j = F.lane & 15, rowl = F.lane >> 4, row = rg * 16 + (F.wave & 3) * 4 + rowl;
        f32x2 S01 = {0.f, 0.f}, S23 = {0.f, 0.f};
        bf16* yb = Y + ((size_t)dir * MALL + (size_t)b * TPB) * RW + hd * 64 + row;
        for (int c = 0; c < NCH; ++c) {
            LAS float* cur = bufs + (c & 1) * (SCH * SSTEP);
            if (F.wave >= 4) {
                if (c + 1 < NCH) {
                    if ((c & 1) == 0) { scan_store(ra, bufs + (SCH * SSTEP), htid); if (c + 3 < NCH) scan_load(ra, RIh, dir, c + 3, htid); }
                    else { scan_store(rb, bufs, htid); if (c + 3 < NCH) scan_load(rb, RIh, dir, c + 3, htid); } } }
            else {
#pragma unroll
                for (int h16 = 0; h16 < 2; ++h16) {
                    const LAS float* sp = cur + (h16 * 16) * SSTEP;
                    f32x4 kk = *(const LAS f32x4*)(sp + 4 * j), bb = *(const LAS f32x4*)(sp + 64 + 4 * j), ww = *(const LAS f32x4*)(sp + 128 + 4 * j),
                          ke = *(const LAS f32x4*)(sp + 192 + 4 * j), rr = *(const LAS f32x4*)(sp + 256 + 4 * j);
                    float vv = sp[320 + row], ykeep = 0.f, ypart = 0.f;
#pragma unroll
                    for (int st = 0; st < 16; ++st) {
                        f32x4 nkk = kk, nbb = bb, nww = ww, nke = ke, nrr = rr; float nvv = vv;
                        if (st + 1 < 16) { const LAS float* sn = sp + (st + 1) * SSTEP;
                            nkk = *(const LAS f32x4*)(sn + 4 * j); nbb = *(const LAS f32x4*)(sn + 64 + 4 * j); nww = *(const LAS f32x4*)(sn + 128 + 4 * j);
                            nke = *(const LAS f32x4*)(sn + 192 + 4 * j); nrr = *(const LAS f32x4*)(sn + 256 + 4 * j); nvv = sn[320 + row]; }
                        f32x2 t2 = S01 * kk.xy; t2 = S23 * kk.zw + t2;
                        const float p = t2.x + t2.y;
                        S01 = S01 * ww.xy + ke.xy * vv; S23 = S23 * ww.zw + ke.zw * vv;
                        const float sa = -red16(p);
                        S01 = bb.xy * sa + S01; S23 = bb.zw * sa + S23;
                        if (st > 0) { const float y = red16(ypart); ykeep = (j == st - 1) ? y : ykeep; }
                        f32x2 u2 = S01 * rr.xy; u2 = S23 * rr.zw + u2;
                        ypart = u2.x + u2.y;
                        kk = nkk; bb = nbb; ww = nww; ke = nke; rr = nrr; vv = nvv;
                        __builtin_amdgcn_sched_barrier(0);
                    }
                    { const float y = red16(ypart); ykeep = (j == 15) ? y : ykeep; }
                    const int tp = scan_tp(dir, c * SCH + h16 * 16 + j);
                    *(GAS bf16*)(yb + (size_t)tp * RW) = (bf16)f2bf(ykeep);
                }
            }
            __syncthreads();
        }
    }
}

constexpr int AKP = 208, AVP = 192;
constexpr int ATILE = 64 * AKP + 64 * AVP;
__device__ __forceinline__ bf16x8 pack8(const f32x16& x, int s) {
    v4u p; p.x = pk2(x[8 * s + 0], x[8 * s + 1]); p.y = pk2(x[8 * s + 2], x[8 * s + 3]); p.z = pk2(x[8 * s + 4], x[8 * s + 5]); p.w = pk2(x[8 * s + 6], x[8 * s + 7]);
    return __builtin_bit_cast(bf16x8, p);
}
__device__ __forceinline__ void attn_phase(Frame& F, const bf16* Q, const bf16* K, const bf16* V, bf16* YB, int with_ctx) {
    const int lane = F.lane, half = lane >> 5, l31 = lane & 31, l16 = lane & 15, g1 = (lane >> 4) & 1;
    const int nunits = NBATCH * NH * 32 + (with_ctx ? NBATCH * NH : 0);
    for (int uu = F.vcu; uu < nunits; uu += F.G) {
        int bh, q0, nkt;
        if (uu < NBATCH * NH * 32) { bh = uu >> 5; q0 = CTXL + (uu & 31) * 256; nkt = TPB / 64; } else { bh = uu - NBATCH * NH * 32; q0 = 0; nkt = CTXL / 64; }
        const bf16* Kh = K + (size_t)bh * TPB * QKD; const bf16* Vh = V + (size_t)bh * TPB * 64; const bf16* Qh = Q + (size_t)bh * TPB * QKD;
        const int tq = q0 + F.wave * 32 + l31;
        bf16x8 qf[6];
#pragma unroll
        for (int ks = 0; ks < 6; ++ks) qf[ks] = *(const GAS bf16x8*)(Qh + (size_t)tq * QKD + 16 * ks + 8 * half);
        f32x16 o0, o1;
#pragma unroll
        for (int i = 0; i < 16; ++i) { o0[i] = 0.f; o1[i] = 0.f; }
        float m_run = -1e30f, l_run = 0.f;
        const int kc1 = F.tid + 512; const bool k1ok = kc1 < 768;
        const unsigned kd0 = (unsigned)((F.tid / 12) * AKP + (F.tid % 12) * 16), kd1 = (unsigned)((kc1 / 12) * AKP + (kc1 % 12) * 16), vd = (unsigned)(64 * AKP + (F.tid >> 3) * AVP + (F.tid & 7) * 16);
        v4u kr0, kr1 = {0, 0, 0, 0}, vr;
        kr0 = *(const GAS v4u*)(Kh + (size_t)F.tid * 8); if (k1ok) kr1 = *(const GAS v4u*)(Kh + (size_t)kc1 * 8); vr = *(const GAS v4u*)(Vh + (size_t)F.tid * 8);
        __syncthreads();
        *(LAS v4u*)(F.lds + kd0) = kr0; if (k1ok) *(LAS v4u*)(F.lds + kd1) = kr1; *(LAS v4u*)(F.lds + vd) = vr;
        __syncthreads();
        for (int kt = 0; kt < nkt; ++kt) {
            const bool more = kt + 1 < nkt;
            if (more) { const bf16* kn = Kh + (size_t)(kt + 1) * 64 * QKD; const bf16* vn = Vh + (size_t)(kt + 1) * 64 * 64;
                kr0 = *(const GAS v4u*)(kn + (size_t)F.tid * 8); if (k1ok) kr1 = *(const GAS v4u*)(kn + (size_t)kc1 * 8); vr = *(const GAS v4u*)(vn + (size_t)F.tid * 8); }
            LAS unsigned char* Kb = F.lds + (kt & 1) * ATILE; LAS unsigned char* Vb = Kb + 64 * AKP;
            f32x16 s0, s1;
#pragma unroll
            for (int i = 0; i < 16; ++i) { s0[i] = 0.f; s1[i] = 0.f; }
            { bf16x8 ka[6], kb2[6];
#pragma unroll
              for (int ks = 0; ks < 6; ++ks) { ka[ks] = *(const LAS bf16x8*)(Kb + l31 * AKP + (16 * ks + 8 * half) * 2); kb2[ks] = *(const LAS bf16x8*)(Kb + (32 + l31) * AKP + (16 * ks + 8 * half) * 2); }
#pragma unroll
              for (int ks = 0; ks < 6; ++ks) { s0 = MFMA32(ka[ks], qf[ks], s0); s1 = MFMA32(kb2[ks], qf[ks], s1); }
              __builtin_amdgcn_sched_group_barrier(0x100, 12, 0); __builtin_amdgcn_sched_group_barrier(0x8, 12, 0); }
            bf16x8 va[2][2][2];
#pragma unroll
            for (int t = 0; t < 2; ++t)
#pragma unroll
                for (int s = 0; s < 2; ++s) { const int kb = 32 * t + 16 * s + 4 * half + (l16 >> 2);
#pragma unroll
                    for (int dvt = 0; dvt < 2; ++dvt) { const LAS unsigned char* vp = Vb + kb * AVP + (32 * dvt + 16 * g1 + 4 * (l16 & 3)) * 2;
                        const s16x4 lo = __builtin_amdgcn_ds_read_tr16_b64_v4i16((LAS s16x4*)vp), hi = __builtin_amdgcn_ds_read_tr16_b64_v4i16((LAS s16x4*)(vp + 8 * AVP));
                        va[t][s][dvt] = __builtin_shufflevector(lo, hi, 0, 1, 2, 3, 4, 5, 6, 7); } }
            __builtin_amdgcn_sched_group_barrier(0x100, 16, 0);
            float mx = s0[0];
#pragma unroll
            for (int i = 1; i < 16; ++i) mx = fmaxf(mx, s0[i]);
#pragma unroll
            for (int i = 0; i < 16; ++i) mx = fmaxf(mx, s1[i]);
            mx = fmaxf(mx, bpermf(lane ^ 32, mx));
            if (__any(mx > m_run + 8.0f)) {
                const float m_new = fmaxf(m_run, mx), alpha = __builtin_amdgcn_exp2f(m_run - m_new); m_run = m_new;
                l_run *= alpha;
#pragma unroll
                for (int i = 0; i < 16; ++i) { o0[i] *= alpha; o1[i] *= alpha; }
            }
            float ps = 0.f;
#pragma unroll
            for (int i = 0; i < 16; ++i) { s0[i] = __builtin_amdgcn_exp2f(s0[i] - m_run); s1[i] = __builtin_amdgcn_exp2f(s1[i] - m_run); ps += s0[i] + s1[i]; }
            l_run += ps;
            { bf16x8 pf[2][2];
#pragma unroll
              for (int t = 0; t < 2; ++t)
#pragma unroll
                  for (int s = 0; s < 2; ++s) pf[t][s] = pack8(t == 0 ? s0 : s1, s);
#pragma unroll
              for (int t = 0; t < 2; ++t)
#pragma unroll
                  for (int s = 0; s < 2; ++s) { o0 = MFMA32(va[t][s][0], pf[t][s], o0); o1 = MFMA32(va[t][s][1], pf[t][s], o1); } }
            if (more) { LAS unsigned char* nb = F.lds + ((kt + 1) & 1) * ATILE;
                *(LAS v4u*)(nb + kd0) = kr0; if (k1ok) *(LAS v4u*)(nb + kd1) = kr1; *(LAS v4u*)(nb + vd) = vr; }
            __syncthreads();
        }
        const float linv = (DBG_SKIP & 4) ? 0.f : 1.0f / (l_run + bpermf(lane ^ 32, l_run));
        const int b = bh >> 4, hd = bh & 15;
        bf16* op = YB + ((size_t)b * TPB + tq) * RW + hd * 64 + 4 * half;
#pragma unroll
        for (int g = 0; g < 4; ++g) {
            v2u w; w.x = pk2(o0[4 * g] * linv, o0[4 * g + 1] * linv); w.y = pk2(o0[4 * g + 2] * linv, o0[4 * g + 3] * linv); *(GAS v2u*)(op + 8 * g) = w;
            w.x = pk2(o1[4 * g] * linv, o1[4 * g + 1] * linv); w.y = pk2(o1[4 * g + 2] * linv, o1[4 * g + 3] * linv); *(GAS v2u*)(op + 32 + 8 * g) = w; }
    }
}

__device__ __forceinline__ void readout_phase(Frame& F, const bf16* Y, const bf16* GG, const float* BON, const bf16* RI, const float* ln_w, const float* ln_b, bf16* YA) {
    const int gw = F.vcu * NWAVES + F.wave, NGW = F.G * NWAVES, lane = F.lane, hd = lane >> 2, ch0 = hd * 64 + (lane & 3) * 16;
    for (int m = gw; m < MALL; m += NGW) {
        const int b = m / TPB, tp = m - b * TPB;
        const bf16* rec = RI + ((size_t)(b * NH + hd) * TPB + tp) * RREC + 128 + (lane & 3) * 16;
        float vv[16], out[16];
        { const v4u a = *(const GAS v4u*)rec, c = *(const GAS v4u*)(rec + 8);
          vv[0] = bflo(a.x); vv[1] = bfhi(a.x); vv[2] = bflo(a.y); vv[3] = bfhi(a.y); vv[4] = bflo(a.z); vv[5] = bfhi(a.z); vv[6] = bflo(a.w); vv[7] = bfhi(a.w);
          vv[8] = bflo(c.x); vv[9] = bfhi(c.x); vv[10] = bflo(c.y); vv[11] = bfhi(c.y); vv[12] = bflo(c.z); vv[13] = bfhi(c.z); vv[14] = bflo(c.w); vv[15] = bfhi(c.w); }
#pragma unroll
        for (int e = 0; e < 16; ++e) out[e] = 0.f;
#pragma unroll
        for (int d = 0; d < 2; ++d) {
            const bf16* yp = Y + ((size_t)d * MALL + m) * RW + ch0; const bf16* gp = GG + ((size_t)d * MALL + m) * RW + ch0;
            float y[16], g[16];
            { const v4u a = *(const GAS v4u*)yp, c = *(const GAS v4u*)(yp + 8);
              y[0] = bflo(a.x); y[1] = bfhi(a.x); y[2] = bflo(a.y); y[3] = bfhi(a.y); y[4] = bflo(a.z); y[5] = bfhi(a.z); y[6] = bflo(a.w); y[7] = bfhi(a.w);
              y[8] = bflo(c.x); y[9] = bfhi(c.x); y[10] = bflo(c.y); y[11] = bfhi(c.y); y[12] = bflo(c.z); y[13] = bfhi(c.z); y[14] = bflo(c.w); y[15] = bfhi(c.w); }
            { const v4u a = *(const GAS v4u*)gp, c = *(const GAS v4u*)(gp + 8);
              g[0] = bflo(a.x); g[1] = bfhi(a.x); g[2] = bflo(a.y); g[3] = bfhi(a.y); g[4] = bflo(a.z); g[5] = bfhi(a.z); g[6] = bflo(a.w); g[7] = bfhi(a.w);
              g[8] = bflo(c.x); g[9] = bfhi(c.x); g[10] = bflo(c.y); g[11] = bfhi(c.y); g[12] = bflo(c.z); g[13] = bfhi(c.z); g[14] = bflo(c.w); g[15] = bfhi(c.w); }
            float s = 0.f;
#pragma unroll
            for (int e = 0; e < 16; ++e) s += y[e];
            s = dpp_add<0xB1>(s); s = dpp_add<0x4E>(s);
            const float mean = s * (1.f / 64.f); float q = 0.f;
#pragma unroll
            for (int e = 0; e < 16; ++e) { y[e] -= mean; q += y[e] * y[e]; }
            q = dpp_add<0xB1>(q); q = dpp_add<0x4E>(q);
            const float rstd = rsqrtf(q * (1.f / 64.f) + 64e-5f), bon = BON[((size_t)d * MALL + m) * 32 + 2 * hd] + BON[((size_t)d * MALL + m) * 32 + 2 * hd + 1];
#pragma unroll
            for (int e = 0; e < 16; ++e) out[e] += (y[e] * rstd * ln_w[ch0 + e] + ln_b[ch0 + e] + bon * vv[e]) * g[e];
        }
        if (DBG_SKIP & 2) {
#pragma unroll
            for (int e = 0; e < 16; ++e) out[e] = 0.f; }
        v4u o0, o1;
        o0.x = pk2(out[0], out[1]); o0.y = pk2(out[2], out[3]); o0.z = pk2(out[4], out[5]); o0.w = pk2(out[6], out[7]);
        o1.x = pk2(out[8], out[9]); o1.y = pk2(out[10], out[11]); o1.z = pk2(out[12], out[13]); o1.w = pk2(out[14], out[15]);
        *(GAS v4u*)(YA + (size_t)m * RW + ch0) = o0; *(GAS v4u*)(YA + (size_t)m * RW + ch0 + 8) = o1;
    }
}

__device__ __forceinline__ unsigned f2key(float f) { const unsigned u = __builtin_bit_cast(unsigned, f); return (u & 0x80000000u) ? ~u : (u | 0x80000000u); }
__device__ __forceinline__ float key2f(unsigned k) { const unsigned u = (k & 0x80000000u) ? (k & 0x7fffffffu) : ~k; return __builtin_bit_cast(float, u); }
template <int CTRL, int RM> __device__ __forceinline__ unsigned dpp_umax(unsigned x) {
    const unsigned y = (unsigned)__builtin_amdgcn_update_dpp(0, (int)x, CTRL, RM, 0xf, false); return x > y ? x : y; }
__device__ __forceinline__ void half_max(unsigned x, unsigned& m0, unsigned& m1) {
    x = dpp_umax<0xB1, 0xf>(x); x = dpp_umax<0x4E, 0xf>(x); x = dpp_umax<0x141, 0xf>(x); x = dpp_umax<0x140, 0xf>(x); x = dpp_umax<0x142, 0xa>(x);
    m0 = (unsigned)__builtin_amdgcn_readlane((int)x, 31); m1 = (unsigned)__builtin_amdgcn_readlane((int)x, 63);
}
__device__ __forceinline__ unsigned top16_lists(const float* sh  , int lane) {
    const int half = lane >> 5, l5 = lane & 31;
    unsigned k0, k1, k2, k3, rec = 0u;
    { const float* p = sh + half * 128 + l5;
      k0 = (f2key(p[0]) & ~127u) | (unsigned)l5; k1 = (f2key(p[32]) & ~127u) | (unsigned)(l5 + 32); k2 = (f2key(p[64]) & ~127u) | (unsigned)(l5 + 64); k3 = (f2key(p[96]) & ~127u) | (unsigned)(l5 + 96); }
#pragma unroll 4
    for (int it = 0; it < 16; ++it) {
        unsigned a = k0 > k1 ? k0 : k1, b = k2 > k3 ? k2 : k3; a = a > b ? a : b;
        unsigned m0, m1; half_max(a, m0, m1);
        const unsigned mh = half ? m1 : m0;
        k0 = (k0 == mh) ? 0u : k0; k1 = (k1 == mh) ? 0u : k1; k2 = (k2 == mh) ? 0u : k2; k3 = (k3 == mh) ? 0u : k3;
        rec = (l5 == it) ? mh : rec;
    }
    return rec;
}
struct SelP { const float* SC; int* ESEL; float* EGATE; const float* pu; const float* pv; unsigned char* PU8; unsigned char* PV8; float* SU; float* SV; int last; };
__device__ __forceinline__ void cvt_row_load(f32x4 (&x)[8], const float* src) {
#pragma unroll
    for (int q = 0; q < 8; ++q) x[q] = *(const GAS f32x4*)(src + q * 4);
}
__device__ __forceinline__ void cvt_row_store(const f32x4 (&x)[8], unsigned char* dst, float* scale_slot, int lane) {
    float am = 0.f;
#pragma unroll
    for (int q = 0; q < 8; ++q) am = fmaxf(am, fmaxf(fmaxf(fabsf(x[q].x), fabsf(x[q].y)), fmaxf(fabsf(x[q].z), fabsf(x[q].w))));
    am = fmaxf(wave_max_u(am), 1e-30f);
    const float g = 6.0f / am, inv = am * (1.0f / 6.0f);
    v4u o;
#pragma unroll
    for (int q = 0; q < 4; ++q) { unsigned w = 0u;
        w = __builtin_amdgcn_cvt_scalef32_pk_fp4_f32(w, x[2 * q].x * g, x[2 * q].y * g, 1.0f, 0);
        w = __builtin_amdgcn_cvt_scalef32_pk_fp4_f32(w, x[2 * q].z * g, x[2 * q].w * g, 1.0f, 1);
        w = __builtin_amdgcn_cvt_scalef32_pk_fp4_f32(w, x[2 * q + 1].x * g, x[2 * q + 1].y * g, 1.0f, 2);
        w = __builtin_amdgcn_cvt_scalef32_pk_fp4_f32(w, x[2 * q + 1].z * g, x[2 * q + 1].w * g, 1.0f, 3);
        o[q] = w; }
    *(GAS v4u*)dst = o;
    if (lane == 0) *scale_slot = inv;
}
__device__ __forceinline__ void select_phase(Frame& F, const SelP& P) {
    const int gw = F.vcu * NWAVES + F.wave, NGW = F.G * NWAVES, lane = F.lane, half = lane >> 5, l5 = lane & 31;
    int crow = gw;
    for (int m = gw; m < MALL || crow < 2 * NEXP; m += NGW) {
        f32x4 xa[8], xb[8];
        const int r0 = crow, r1 = crow + NGW; const bool c0 = r0 < 2 * NEXP, c1 = r1 < 2 * NEXP; crow += 2 * NGW;
        if (c0) cvt_row_load(xa, ((r0 >= NEXP) ? P.pv + (size_t)(r0 - NEXP) * DM : P.pu + (size_t)r0 * DM) + lane * 32);
        if (c1) cvt_row_load(xb, ((r1 >= NEXP) ? P.pv + (size_t)(r1 - NEXP) * DM : P.pu + (size_t)r1 * DM) + lane * 32);
        bool tok = m < MALL; int tp = 0; if (tok) { tp = m % TPB; if (P.last && tp < CTXL) tok = false; }
        if (tok) {
            const float* srow = P.SC + (size_t)m * DM;
#pragma unroll 1
            for (int hp = 0; hp < 4; ++hp) {
                const unsigned recA = top16_lists(srow + (2 * hp) * 256, lane), recB = top16_lists(srow + (2 * hp + 1) * 256, lane);
                const float vA = key2f(recA & ~127u), vB = key2f(recB & ~127u);
                const float v1a = bpermf(l5 & 15, vA), v1b = bpermf(l5 & 15, vB); const float v1 = half ? v1b : v1a;
                unsigned ck[8];
#pragma unroll
                for (int e = 0; e < 8; ++e) { const int src = 32 + 8 * (l5 >> 4) + e; const float v2a = bpermf(src, vA), v2b = bpermf(src, vB);
                    ck[e] = (f2key(v1 + (half ? v2b : v2a)) & ~255u) | (unsigned)(l5 | (e << 5)); }
                unsigned rec = 0u;
#pragma unroll 2
                for (int it = 0; it < 16; ++it) {
                    unsigned a = ck[0] > ck[1] ? ck[0] : ck[1], b = ck[2] > ck[3] ? ck[2] : ck[3], c = ck[4] > ck[5] ? ck[4] : ck[5], d = ck[6] > ck[7] ? ck[6] : ck[7];
                    a = a > b ? a : b; c = c > d ? c : d; a = a > c ? a : c;
                    unsigned m0, m1; half_max(a, m0, m1);
                    const unsigned mh = half ? m1 : m0;
#pragma unroll
                    for (int e = 0; e < 8; ++e) ck[e] = (ck[e] == mh) ? 0u : ck[e];
                    rec = (l5 == it) ? mh : rec;
                }
                const float ts = key2f(rec & ~255u), tmax = half ? bpermf(32, ts) : bpermf(0, ts);
                float ev = (l5 < 16) ? __expf(ts - tmax) : 0.f;
                const float esum = red16(ev);
                const int cid = (int)(rec & 255u), ci = cid & 15, cj = ((cid >> 4) & 1) * 8 + (cid >> 5);
                const int i1a = bpermi(ci, (int)(recA & 127u)), i1b = bpermi(ci, (int)(recB & 127u)), i2a = bpermi(32 + cj, (int)(recA & 127u)), i2b = bpermi(32 + cj, (int)(recB & 127u));
                const int expert = (half ? i1b : i1a) * 128 + (half ? i2b : i2a);
                if (l5 < 16) { const int slot = (2 * hp + half) * 16 + l5; P.ESEL[(size_t)m * 128 + slot] = expert; P.EGATE[(size_t)m * 128 + slot] = ev / esum; }
            }
        }
        if (c0) cvt_row_store(xa, ((r0 >= NEXP) ? P.PV8 + (size_t)(r0 - NEXP) * (DM / 2) : P.PU8 + (size_t)r0 * (DM / 2)) + lane * 16, (r0 >= NEXP) ? P.SV + (r0 - NEXP) : P.SU + r0, lane);
        if (c1) cvt_row_store(xb, ((r1 >= NEXP) ? P.PV8 + (size_t)(r1 - NEXP) * (DM / 2) : P.PU8 + (size_t)r1 * (DM / 2)) + lane * 16, (r1 >= NEXP) ? P.SV + (r1 - NEXP) : P.SU + r1, lane);
    }
}
struct PeerP { const float* nmod; const float* ng; bf16* Hout;   const int* ESEL; const float* EGATE; const bf16* H; const unsigned char* PU; const unsigned char* PV; const float* SU; const float* SV; float* X; const float* mod;   const float* fin_g; float* out; int last; };
__device__ __forceinline__ void peer_phase(Frame& F, const PeerP& P) {
    const int gw = F.vcu * NWAVES + F.wave, NGW = F.G * NWAVES, lane = F.lane;
    float pr_s2 = 0.f, pr_d2 = 0.f, pr_tg = 0.f, pr_n = 0.f;
    for (int m = gw; m < MALL; m += NGW) {
        const int b = m / TPB, tp = m - b * TPB; if (P.last && tp < CTXL) continue;
        const int mr = tp < CTXL ? 2 : b;
        const int eidx[2] = {P.ESEL[(size_t)m * 128 + lane], P.ESEL[(size_t)m * 128 + 64 + lane]}; const float egate[2] = {P.EGATE[(size_t)m * 128 + lane], P.EGATE[(size_t)m * 128 + 64 + lane]};
        typedef int v8i __attribute__((ext_vector_type(8)));
        LAS unsigned char* hq = F.lds + F.wave * 4096;
        { const v4u a0 = *(const GAS v4u*)(P.H + (size_t)m * DM + lane * 32), a1 = *(const GAS v4u*)(P.H + (size_t)m * DM + lane * 32 + 8), a2 = *(const GAS v4u*)(P.H + (size_t)m * DM + lane * 32 + 16), a3 = *(const GAS v4u*)(P.H + (size_t)m * DM + lane * 32 + 24);
          const v4u hv[4] = {a0, a1, a2, a3}; v4u o[2];
#pragma unroll
          for (int j = 0; j < 4; ++j) { int w0 = 0, w1 = 0;
              w0 = __builtin_amdgcn_cvt_pk_fp8_f32(bflo(hv[j].x), bfhi(hv[j].x), w0, false); w0 = __builtin_amdgcn_cvt_pk_fp8_f32(bflo(hv[j].y), bfhi(hv[j].y), w0, true);
              w1 = __builtin_amdgcn_cvt_pk_fp8_f32(bflo(hv[j].z), bfhi(hv[j].z), w1, false); w1 = __builtin_amdgcn_cvt_pk_fp8_f32(bflo(hv[j].w), bfhi(hv[j].w), w1, true);
              o[j >> 1][2 * (j & 1)] = (unsigned)w0; o[j >> 1][2 * (j & 1) + 1] = (unsigned)w1; }
          *(LAS v4u*)(hq + lane * 32) = o[0]; *(LAS v4u*)(hq + lane * 32 + 16) = o[1];
          unsigned z_ = 0u; asm volatile("" : "+v"(z_));
          if (lane < 2) *(LAS v4u*)(hq + 2048 + lane * 16) = (v4u){z_, z_, z_, z_}; }
        const int li = lane & 15, kb = lane >> 4;
        int rowoff[8];
#pragma unroll
        for (int g = 0; g < 8; ++g) rowoff[g] = bpermi(16 * (g & 3) + li, eidx[g >> 2]) * (DM / 2) + 16 * kb;
        f32x4 dacc[8];
#pragma unroll
        for (int g = 0; g < 8; ++g) dacc[g] = (f32x4){0.f, 0.f, 0.f, 0.f};
        const unsigned hb = (li == 0) ? (unsigned)(16 * kb) : 2048u;
        const unsigned hb2 = (li == 0) ? 64u : 16u;
        const unsigned hstep = (li == 0) ? 128u : 0u;
        v4u ua[8], ub[8];
#pragma unroll
        for (int g = 0; g < 8; ++g) ua[g] = *(const GAS v4u*)(P.PU + (unsigned)rowoff[g]);
#pragma unroll 1
        for (int s = 0; s < 16; s += 2) {
#pragma unroll
            for (int g = 0; g < 8; ++g) ub[g] = *(const GAS v4u*)(P.PU + (unsigned)(rowoff[g] + 64 * (s + 1)));
            { const v4u b0 = *(const LAS v4u*)(hq + hb + hstep * s), b1 = *(const LAS v4u*)(hq + hb + hstep * s + hb2);
              const v8i bf = {(int)b0.x, (int)b0.y, (int)b0.z, (int)b0.w, (int)b1.x, (int)b1.y, (int)b1.z, (int)b1.w};
#pragma unroll
              for (int g = 0; g < 8; ++g) { const v8i af = {(int)ua[g].x, (int)ua[g].y, (int)ua[g].z, (int)ua[g].w, 0, 0, 0, 0};
                  dacc[g] = __builtin_amdgcn_mfma_scale_f32_16x16x128_f8f6f4(af, bf, dacc[g], 4, 0, 0, 0x7f7f7f7f, 0, 0x7f7f7f7f); } }
            if (s + 2 < 16) {
#pragma unroll
                for (int g = 0; g < 8; ++g) ua[g] = *(const GAS v4u*)(P.PU + (unsigned)(rowoff[g] + 64 * (s + 2))); }
            { const v4u b0 = *(const LAS v4u*)(hq + hb + hstep * (s + 1)), b1 = *(const LAS v4u*)(hq + hb + hstep * (s + 1) + hb2);
              const v8i bf = {(int)b0.x, (int)b0.y, (int)b0.z, (int)b0.w, (int)b1.x, (int)b1.y, (int)b1.z, (int)b1.w};
#pragma unroll
              for (int g = 0; g < 8; ++g) { const v8i af = {(int)ub[g].x, (int)ub[g].y, (int)ub[g].z, (int)ub[g].w, 0, 0, 0, 0};
                  dacc[g] = __builtin_amdgcn_mfma_scale_f32_16x16x128_f8f6f4(af, bf, dacc[g], 4, 0, 0, 0x7f7f7f7f, 0, 0x7f7f7f7f); } }
        }
        float coef[2];
#pragma unroll
        for (int sl = 0; sl < 2; ++sl) { float mydot = 0.f;
#pragma unroll
            for (int g4 = 0; g4 < 4; ++g4)
#pragma unroll
                for (int r = 0; r < 4; ++r) { const float t = bpermf(16 * ((lane >> 2) & 3), dacc[4 * sl + g4][r]); if ((lane >> 4) == g4 && (lane & 3) == r) mydot = t; }
            mydot *= P.SU[eidx[sl]];
            if (DBG_PROBE == 4) {
                float ref = 0.f;
                for (int e = 0; e < 64; ++e) { const int ex = __builtin_amdgcn_readlane(eidx[sl], e); const v4u uu = *(const GAS v4u*)(P.PU + (size_t)ex * (DM / 2) + lane * 16); float s1 = 0.f;
                    const v4u hv2[4] = {*(const GAS v4u*)(P.H + (size_t)m * DM + lane * 32), *(const GAS v4u*)(P.H + (size_t)m * DM + lane * 32 + 8), *(const GAS v4u*)(P.H + (size_t)m * DM + lane * 32 + 16), *(const GAS v4u*)(P.H + (size_t)m * DM + lane * 32 + 24)};
#pragma unroll
                    for (int d = 0; d < 4; ++d) { const unsigned w = uu[d]; const unsigned hw[4] = {hv2[d].x, hv2[d].y, hv2[d].z, hv2[d].w};
                        f32x2 x = __builtin_amdgcn_cvt_scalef32_pk_f32_fp4(w, 1.0f, 0); s1 += x.x * bflo(hw[0]) + x.y * bfhi(hw[0]); x = __builtin_amdgcn_cvt_scalef32_pk_f32_fp4(w, 1.0f, 1); s1 += x.x * bflo(hw[1]) + x.y * bfhi(hw[1]);
                        x = __builtin_amdgcn_cvt_scalef32_pk_f32_fp4(w, 1.0f, 2); s1 += x.x * bflo(hw[2]) + x.y * bfhi(hw[2]); x = __builtin_amdgcn_cvt_scalef32_pk_f32_fp4(w, 1.0f, 3); s1 += x.x * bflo(hw[3]) + x.y * bfhi(hw[3]); }
                    const float tot = wave_sum_u(s1) * P.SU[ex]; if (lane == e) ref = tot; }
                pr_s2 = fmaxf(pr_s2, wave_max_u(fabsf(mydot - ref) / (fabsf(ref) + 0.25f))); pr_n = 1.f; }
            coef[sl] = egate[sl] * 0.5f * mydot * (1.0f + erff(mydot * 0.70710678f));
            if ((DBG_SKIP & 16) && sl == 0) coef[sl] = 0.f;
            if ((DBG_SKIP & 32) && sl == 1) coef[sl] = 0.f;
        }
        f32x2 acc2[16];
#pragma unroll
        for (int i = 0; i < 16; ++i) acc2[i] = (f32x2){0.f, 0.f};
#define PEER_LOADV(U, C, sl_, e0_) do { _Pragma("unroll") for (int q = 0; q < 8; ++q) { const int ex = __builtin_amdgcn_readlane(eidx[sl_], (e0_) + q); U[q] = *(const GAS v4u*)(P.PV + (size_t)ex * (DM / 2) + lane * 16); \
            C[q] = __builtin_bit_cast(float, __builtin_amdgcn_readlane(__builtin_bit_cast(int, coef[sl_]), (e0_) + q)) * P.SV[ex]; } } while (0)
#define PEER_AXPY(U, C) do { _Pragma("unroll") for (int q = 0; q < 8; ++q) _Pragma("unroll") for (int d = 0; d < 4; ++d) { const unsigned w = U[q][d]; \
            acc2[4 * d + 0] = __builtin_amdgcn_cvt_scalef32_pk_f32_fp4(w, 1.0f, 0) * C[q] + acc2[4 * d + 0]; acc2[4 * d + 1] = __builtin_amdgcn_cvt_scalef32_pk_f32_fp4(w, 1.0f, 1) * C[q] + acc2[4 * d + 1]; \
            acc2[4 * d + 2] = __builtin_amdgcn_cvt_scalef32_pk_f32_fp4(w, 1.0f, 2) * C[q] + acc2[4 * d + 2]; acc2[4 * d + 3] = __builtin_amdgcn_cvt_scalef32_pk_f32_fp4(w, 1.0f, 3) * C[q] + acc2[4 * d + 3]; } } while (0)
#pragma unroll
        for (int sl = 0; sl < 2; ++sl) {
            v4u ua[8], ub[8]; float ca[8], cb[8];
            PEER_LOADV(ua, ca, sl, 0);
#pragma unroll 1
            for (int e0 = 0; e0 < 64; e0 += 16) {
                PEER_LOADV(ub, cb, sl, e0 + 8);
                PEER_AXPY(ua, ca);
                if (e0 + 16 < 64) PEER_LOADV(ua, ca, sl, e0 + 16);
                PEER_AXPY(ub, cb);
            }
        }
#undef PEER_LOADV
#undef PEER_AXPY
        float acc[32];
#pragma unroll
        for (int i = 0; i < 16; ++i) { acc[2 * i] = acc2[i].x; acc[2 * i + 1] = acc2[i].y; }
        if (DBG_SKIP & 1) {
#pragma unroll
            for (int i = 0; i < 32; ++i) acc[i] = 0.f; }
        if (((DBG_SKIP & 64) && !P.last) || ((DBG_SKIP & 128) && P.last)) {
#pragma unroll
            for (int i = 0; i < 32; ++i) acc[i] = 0.f; }
        if (DBG_SKIP & 8) {
#pragma unroll
            for (int i = 0; i < 32; ++i) acc[i] = -acc[i]; }
        float* xr = P.X + (size_t)m * DM; const float* g2 = P.mod + (size_t)mr * 12288 + 5 * DM;
        float ss = 0.f;
#pragma unroll
        for (int hq = 0; hq < 8; ++hq) { const int c = lane * 32 + hq * 4;
            f32x4 xv = *(const GAS f32x4*)(xr + c); const f32x4 gv = *(const GAS f32x4*)(g2 + c);
#pragma unroll
            for (int e = 0; e < 4; ++e) { xv[e] += gv[e] * acc[4 * hq + e]; ss += xv[e] * xv[e]; acc[4 * hq + e] = xv[e]; }
            if (!P.last) *(GAS f32x4*)(xr + c) = xv; }
        if (!P.last) {
            const float rs = rsqrtf(wave_sum(ss) * (1.f / DM) + NORM_EPS); const float* sh = P.nmod + (size_t)mr * 12288; const float* sc = sh + DM;
#pragma unroll
            for (int hq = 0; hq < 4; ++hq) { const int c = lane * 32 + hq * 8; float y[8];
#pragma unroll
                for (int e = 0; e < 8; ++e) y[e] = acc[8 * hq + e] * rs * P.ng[c + e] * (1.0f + sc[c + e]) + sh[c + e];
                *(GAS v4u*)(P.Hout + (size_t)m * DM + c) = pack8f(y); } }
        if (P.last) { const float rs = rsqrtf(wave_sum(ss) * (1.f / DM) + NORM_EPS); float* orow = P.out + ((size_t)b * SEQ + (tp - CTXL)) * DM;
#pragma unroll
            for (int hq = 0; hq < 8; ++hq) { const int c = lane * 32 + hq * 4; const f32x4 fg = *(const GAS f32x4*)(P.fin_g + c);
                f32x4 o;
#pragma unroll
                for (int e = 0; e < 4; ++e) o[e] = acc[4 * hq + e] * rs * fg[e];
                *(GAS f32x4*)(orow + c) = o; } }
    }
    if (DBG_PROBE && DBG_PROBE != 5 && !P.last && lane == 0) { float* pp = (float*)(F.ws + WS_CTL + CTL_PROBE_OFF) + gw * 4; pp[0] = pr_s2; pp[1] = pr_d2; pp[2] = pr_tg; pp[3] = pr_n; }
}


constexpr int PH_PER_LAYER = 12, NPHASE = 1 + NLAYER * PH_PER_LAYER;
#ifndef ONLY_PHASE
#define ONLY_PHASE -1
#endif
#define T0() (wave_s == 0 && pg8::opaque_lane() == 0)
#define PH_ON(k) (ONLY_PHASE < 0 || ONLY_PHASE == (k))
#define GEMM_CALL(EPI, SCHED, g, S, E) pg8::gemm_phase<EPI, SCHED, true, true>(F.lds, g, S, E, wave_s)
#define GEMM_CALL_NA(EPI, SCHED, g, S, E) pg8::gemm_phase<EPI, SCHED, false, true>(F.lds, g, S, E, wave_s)

__device__ __forceinline__ const float* karg(int i) {
    asm volatile("" : "+s"(i));
    const __attribute__((address_space(4))) unsigned long long* ka = (const __attribute__((address_space(4))) unsigned long long*)__builtin_amdgcn_kernarg_segment_ptr();
    return (const float*)ka[i];
}
__global__ void __launch_bounds__(NWAVES * 64, 2) mk_fwd(Args args) {
    extern __shared__ __attribute__((aligned(16))) unsigned char lds[];
    Frame F;
    F.lds = (LAS unsigned char*)lds; F.ws = args.ws;
    const int wave_s = __builtin_amdgcn_readfirstlane((int)threadIdx.x >> 6);
    F.tid = threadIdx.x; F.lane = F.tid & 63; F.wave = wave_s;
    F.G = gridDim.x; { const int bx = blockIdx.x; F.vcu = (F.G % 8 == 0) ? (bx % 8) * (F.G / 8) + bx / 8 : bx; }
    unsigned char* ws = args.ws;
    volatile LAS unsigned* MISC = (volatile LAS unsigned*)(F.lds + MISC_OFF);
    for (int u = F.tid; u < (LDS_BYTES - LDSCTL_OFF) / 4; u += NWAVES * 64) ((LAS unsigned*)(F.lds + LDSCTL_OFF))[u] = 0u;
    __syncthreads();
    const int lo = args.ph_lo, hi = args.ph_hi;
    XcdBarrier bar; bar.bar = (unsigned*)(ws + WS_CTL) + CW_BAR; bar.x = 0; bar.st = nullptr;
    if (hi - lo > 1) bar = xcd_barrier_post((unsigned*)(ws + WS_CTL) + CW_BAR, MISC + 8, T0());
#define IN(k) (lo <= (k) && (k) < hi)
#define REFRAME() do { const int lz_ = pg8::opaque_lane(); F.lane = lz_; F.tid = wave_s * 64 + lz_; F.wave = wave_s; ws = (unsigned char*)karg(34); F.ws = ws; { int g_ = (int)gridDim.x, b_ = (int)blockIdx.x; asm volatile("" : "+s"(g_), "+s"(b_)); bx = b_; F.G = g_; F.vcu = ((g_ & 7) == 0) ? (b_ & 7) * (g_ >> 3) + (b_ >> 3) : b_; } } while (0)
#define SEAM(k) do { if (IN((k) + 1)) xcd_barrier(bar, T0()); } while (0)
#define XBUF ((float*)(ws + WS_X))
#define HBUF ((bf16*)(ws + WS_H))
#define MODP ((const float*)(ws + WS_CTL + CTL_MOD_OFF) + (size_t)l * 3 * 12288)
    int bx = (int)blockIdx.x;

    for (int rep_ = 0; rep_ < ((DBG_REPEAT == 100) ? 2 : 1); ++rep_) if (PH_ON(100) && IN(0)) { REFRAME(); if (rep_) xcd_barrier(bar, T0()); p0_prologue(F); SEAM(0); }

    for (int l = 0; l < NLAYER; ++l) {
        const int base = 1 + l * PH_PER_LAYER;
        const int last = (l == NLAYER - 1);
        for (int rep_ = 0; rep_ < ((DBG_REPEAT == 0) ? 2 : 1); ++rep_) if (PH_ON(0) && IN(base + 0) && l == 0) { REFRAME(); if (rep_) xcd_barrier(bar, T0()); modnorm_phase(F, XBUF, karg(6) + (size_t)l * DM, MODP, 0, HBUF, 0, l == 0 ? karg(0) : nullptr, l == 0 ? karg(2) : nullptr); SEAM(base + 0); }
        for (int rep_ = 0; rep_ < ((DBG_REPEAT == 1) ? 2 : 1); ++rep_) if (PH_ON(1) && IN(base + 1)) { REFRAME(); if (rep_) xcd_barrier(bar, T0());
            pg8::Gemm g{HBUF, (const bf16*)(ws + WS_WINA) + (size_t)l * INA_P * DM, MALL, INA_P, DM}; pg8::RowOrder S; S.init_rows(0, INA_P, F.G, bx);
            pg8::EpiStoreBf16 E{(bf16*)(ws + WS_PA), INA_P};
            GEMM_CALL(pg8::EpiStoreBf16, pg8::RowOrder, g, S, E);
            SEAM(base + 1); }
        for (int rep_ = 0; rep_ < ((DBG_REPEAT == 2) ? 2 : 1); ++rep_) if (PH_ON(2) && IN(base + 2)) { REFRAME(); if (rep_) xcd_barrier(bar, T0());
            FeatP P;
            P.PA = (const bf16*)(ws + WS_PA); P.mu = karg(9) + (size_t)l * RWC; P.w0 = karg(10) + (size_t)l * 2 * RW; P.a0 = karg(12) + (size_t)l * 2 * RW;
            P.k_k = karg(15) + (size_t)l * RW; P.k_a = karg(16) + (size_t)l * RW; P.r_k = karg(17) + (size_t)l * RW;
            P.WUP = (const bf16*)(ws + WS_WUP) + (size_t)l * 2 * RW * 64; P.AUP = (const bf16*)(ws + WS_AUP) + (size_t)l * 2 * RW * 64; P.GUP = (const bf16*)(ws + WS_GUP) + (size_t)l * 2 * RW * 32;
            P.qnorm = karg(20) + (size_t)l * 512; P.kvnorm = karg(22) + (size_t)l * 256; P.rope = (const f32x2*)(ws + WS_ROPE);
            P.RI = (bf16*)(ws + WS_RI); P.GG = (bf16*)(ws + WS_GG); P.BON = (float*)(ws + WS_BON); P.QN = (bf16*)(ws + WS_QN); P.KVN = (bf16*)(ws + WS_KVN); P.K = (bf16*)(ws + WS_K);
            features_phase(F, P);
            SEAM(base + 2); }
        for (int rep_ = 0; rep_ < ((DBG_REPEAT == 3) ? 2 : 1); ++rep_) if (PH_ON(3) && IN(base + 3)) { REFRAME(); if (rep_) xcd_barrier(bar, T0());
            { pg8::Gemm g{(const bf16*)(ws + WS_QN), (const bf16*)(ws + WS_WUQ) + (size_t)l * NQ * 512, MALL, NQ, 512};
              pg8::EpiQ E{(bf16*)(ws + WS_Q), (const f32x2*)(ws + WS_ROPE), 0.14724444f};
              pg8::RowOrder S; S.init_rows(last, NQ, F.G, bx); GEMM_CALL_NA(pg8::EpiQ, pg8::RowOrder, g, S, E); }
            { pg8::Gemm g{(const bf16*)(ws + WS_KVN), (const bf16*)(ws + WS_WUKV) + (size_t)l * NKV * 256, MALL, NKV, 256}; pg8::RowOrder S; S.init_rows(0, NKV, F.G, bx);
              pg8::EpiKV E{(bf16*)(ws + WS_K), (bf16*)(ws + WS_V)};
              GEMM_CALL_NA(pg8::EpiKV, pg8::RowOrder, g, S, E); }
            SEAM(base + 3); }
        for (int rep_ = 0; rep_ < ((DBG_REPEAT == 4) ? 2 : 1); ++rep_) if (PH_ON(4) && IN(base + 4)) { REFRAME(); if (rep_) xcd_barrier(bar, T0()); scan_phase(F, (const bf16*)(ws + WS_RI), (bf16*)(ws + WS_Y)); SEAM(base + 4); }
        for (int rep_ = 0; rep_ < ((DBG_REPEAT == 5) ? 2 : 1); ++rep_) if (PH_ON(5) && IN(base + 5)) { REFRAME(); if (rep_) xcd_barrier(bar, T0());
            attn_phase(F, (const bf16*)(ws + WS_Q), (const bf16*)(ws + WS_K), (const bf16*)(ws + WS_V), (bf16*)(ws + WS_YB), !last);
            readout_phase(F, (const bf16*)(ws + WS_Y), (const bf16*)(ws + WS_GG), (const float*)(ws + WS_BON), (const bf16*)(ws + WS_RI), karg(18) + (size_t)l * RW, karg(19) + (size_t)l * RW, (bf16*)(ws + WS_YA));
            SEAM(base + 5); }
        for (int rep_ = 0; rep_ < ((DBG_REPEAT == 6) ? 2 : 1); ++rep_) if (PH_ON(6) && IN(base + 6)) { REFRAME(); if (rep_) xcd_barrier(bar, T0());
            bf16* T1 = (bf16*)(ws + WS_T1); bf16* T2 = (bf16*)(ws + WS_T2);
            const pg8::Gemm g1{HBUF, (const bf16*)(ws + WS_WGA) + (size_t)l * DM * DM, MALL, DM, DM}, g2{(const bf16*)(ws + WS_YA), (const bf16*)(ws + WS_WA) + (size_t)l * DM * RW, MALL, DM, RW};
            const pg8::Gemm g3{HBUF, (const bf16*)(ws + WS_WGB) + (size_t)l * DM * DM, MALL, DM, DM}, g4{(const bf16*)(ws + WS_YB), (const bf16*)(ws + WS_WB) + (size_t)l * DM * RW, MALL, DM, RW};
            const pg8::EpiGate E1{T1, DM, karg(8) + (size_t)l * 2 * DM}, E3{T2, DM, karg(8) + (size_t)l * 2 * DM + DM};
            const pg8::EpiMulAdd E2{T1, T1, nullptr, DM}, E4{T1, T2, T1, DM};
            pg8::RowOrder S; S.init_rows(last, DM, F.G, bx);
            GEMM_CALL(pg8::EpiGate, pg8::RowOrder, g1, S, E1); GEMM_CALL(pg8::EpiMulAdd, pg8::RowOrder, g2, S, E2); GEMM_CALL(pg8::EpiGate, pg8::RowOrder, g3, S, E3); GEMM_CALL(pg8::EpiMulAdd, pg8::RowOrder, g4, S, E4);
            SEAM(base + 6); }
        for (int rep_ = 0; rep_ < ((DBG_REPEAT == 7) ? 2 : 1); ++rep_) if (PH_ON(7) && IN(base + 7)) { REFRAME(); if (rep_) xcd_barrier(bar, T0());
            const pg8::Gemm g{(const bf16*)(ws + WS_T1), (const bf16*)(ws + WS_WO) + (size_t)l * DM * DM, MALL, DM, DM};
            const pg8::EpiResid E{XBUF, MODP + 2 * DM, l == 0 ? karg(0) : nullptr, l == 0 ? karg(2) : nullptr};
            pg8::RowOrder S; S.init_rows(last, DM, F.G, bx); GEMM_CALL(pg8::EpiResid, pg8::RowOrder, g, S, E);
            SEAM(base + 7); }
        for (int rep_ = 0; rep_ < ((DBG_REPEAT == 8) ? 2 : 1); ++rep_) if (PH_ON(8) && IN(base + 8)) { REFRAME(); if (rep_) xcd_barrier(bar, T0());
            modnorm_phase(F, XBUF, karg(27) + (size_t)l * DM, MODP, 3, HBUF, last);
            SEAM(base + 8); }
        for (int rep_ = 0; rep_ < ((DBG_REPEAT == 9) ? 2 : 1); ++rep_) if (PH_ON(9) && IN(base + 9)) { REFRAME(); if (rep_) xcd_barrier(bar, T0());
            const pg8::Gemm g{HBUF, (const bf16*)(ws + WS_WQK) + (size_t)l * DM * DM, MALL, DM, DM};
            const pg8::EpiF32 E{(float*)(ws + WS_SC), DM};
            pg8::RowOrder S; S.init_rows(last, DM, F.G, bx); GEMM_CALL(pg8::EpiF32, pg8::RowOrder, g, S, E);
            SEAM(base + 9); }
        for (int rep_ = 0; rep_ < ((DBG_REPEAT == 10) ? 2 : 1); ++rep_) if (PH_ON(10) && IN(base + 10)) { REFRAME(); if (rep_) xcd_barrier(bar, T0());
            SelP P; P.SC = (const float*)(ws + WS_SC); P.ESEL = (int*)(ws + WS_T1); P.EGATE = (float*)(ws + WS_T1 + 16 * MiB);
            P.pu = karg(30) + (size_t)l * NEXP * DM; P.pv = karg(31) + (size_t)l * NEXP * DM; P.PU8 = ws + WS_PU; P.PV8 = ws + WS_PU + (size_t)NEXP * (DM / 2); P.SU = (float*)(ws + WS_PV); P.SV = (float*)(ws + WS_PV) + NEXP; P.last = last;
            select_phase(F, P);
            SEAM(base + 10); }
        for (int rep_ = 0; rep_ < ((DBG_REPEAT == 11) ? 2 : 1); ++rep_) if (PH_ON(11) && IN(base + 11)) { REFRAME(); if (rep_) xcd_barrier(bar, T0());
            PeerP P; P.nmod = MODP + 3 * 12288; P.ng = karg(6) + (size_t)(l + 1) * DM; P.Hout = HBUF; P.ESEL = (const int*)(ws + WS_T1); P.EGATE = (const float*)(ws + WS_T1 + 16 * MiB); P.H = HBUF; P.PU = ws + WS_PU; P.PV = ws + WS_PU + (size_t)NEXP * (DM / 2); P.SU = (const float*)(ws + WS_PV); P.SV = (const float*)(ws + WS_PV) + NEXP; P.X = XBUF; P.mod = MODP; P.fin_g = karg(32); P.out = (float*)karg(33); P.last = last;
            peer_phase(F, P);
            SEAM(base + 11); }
    }
#undef IN
#undef SEAM
#undef XBUF
#undef HBUF
#undef MODP
}

__device__ __forceinline__ float mx_a_val(int i, int k) { const int c = (i * 131 + k * 17 + (k >> 3) * 5) & 15; const float mag[8] = {0.f, .5f, 1.f, 1.5f, 2.f, 3.f, 4.f, 6.f}; return (c & 8) ? -mag[c & 7] : mag[c & 7]; }
__device__ __forceinline__ int mx_a_code(int i, int k) { return (i * 131 + k * 17 + (k >> 3) * 5) & 15; }
__device__ __forceinline__ float mx_b_val(int k, int j) { return (float)(((k * 7 + j * 13 + (k >> 4)) % 9) - 4); }
__device__ __forceinline__ int mx_kmap(int hyp, int kb, int e) { const int h = hyp % 3; return h == 0 ? 32 * kb + e : h == 1 ? 32 * (e >> 3) + 8 * kb + (e & 7) : 64 * (e >> 4) + 16 * kb + (e & 15); }
__global__ void __launch_bounds__(512) dbg_fill(const float* pp, float* o) {
    __shared__ float vsh;
    float v = 0.f;
    if (DBG_PROBE == 5) {
        if (threadIdx.x < 64) { typedef int v8i __attribute__((ext_vector_type(8))); typedef float f4 __attribute__((ext_vector_type(4)));
            const int lane = threadIdx.x, i = lane & 15, kb = lane >> 4; float code = 0.f;
            for (int hyp = 0; hyp < 18; ++hyp) { const int nibswap = hyp / 9, ha = hyp % 3, hb2 = (hyp / 3) % 3;
                unsigned aw[4] = {0u, 0u, 0u, 0u}; int bw[8] = {0, 0, 0, 0, 0, 0, 0, 0};
                for (int e = 0; e < 32; ++e) { const int k = mx_kmap(ha, kb, e); const unsigned c = (unsigned)mx_a_code(i, k); const int pos = nibswap ? (e ^ 1) : e; aw[pos >> 3] |= c << (4 * (pos & 7)); }
                for (int q = 0; q < 8; ++q) { int w = 0; const float f0 = mx_b_val(mx_kmap(hb2, kb, 4 * q + 0), i), f1 = mx_b_val(mx_kmap(hb2, kb, 4 * q + 1), i), f2 = mx_b_val(mx_kmap(hb2, kb, 4 * q + 2), i), f3 = mx_b_val(mx_kmap(hb2, kb, 4 * q + 3), i);
                    w = __builtin_amdgcn_cvt_pk_fp8_f32(f0, f1, w, false); w = __builtin_amdgcn_cvt_pk_fp8_f32(f2, f3, w, true); bw[q] = w; }
                const v8i af = {(int)aw[0], (int)aw[1], (int)aw[2], (int)aw[3], 0, 0, 0, 0}, bf = {bw[0], bw[1], bw[2], bw[3], bw[4], bw[5], bw[6], bw[7]};
                f4 d = {0.f, 0.f, 0.f, 0.f};
                d = __builtin_amdgcn_mfma_scale_f32_16x16x128_f8f6f4(af, bf, d, 4, 0, 0, 0x7f7f7f7f, 0, 0x7f7f7f7f);
                int bad = 0;
                for (int r = 0; r < 4; ++r) { const int row = 4 * kb + r, col = i; float ex = 0.f; for (int k = 0; k < 128; ++k) ex += mx_a_val(row, k) * mx_b_val(k, col); bad += (d[r] != ex); }
                if (__ballot(bad != 0) == 0ull && code == 0.f) code = (float)(hyp + 1); }
            for (int t = 0; t < 2; ++t) {
                int aw[8] = {0, 0, 0, 0, 0, 0, 0, 0}, bw[8] = {0, 0, 0, 0, 0, 0, 0, 0};
                if (t == 0) { for (int e = 0; e < 32; ++e) { const int k = 32 * kb + e; aw[e >> 3] |= mx_a_code(i, k) << (4 * (e & 7)); bw[e >> 3] |= mx_a_code(i + 16, k) << (4 * (e & 7)); } }
                else { for (int q = 0; q < 8; ++q) { int w = 0, w2 = 0; const int k = 32 * kb + 4 * q;
                        w = __builtin_amdgcn_cvt_pk_fp8_f32(mx_b_val(k, i + 16), mx_b_val(k + 1, i + 16), w, false); w = __builtin_amdgcn_cvt_pk_fp8_f32(mx_b_val(k + 2, i + 16), mx_b_val(k + 3, i + 16), w, true); aw[q] = w;
                        w2 = __builtin_amdgcn_cvt_pk_fp8_f32(mx_b_val(k, i), mx_b_val(k + 1, i), w2, false); w2 = __builtin_amdgcn_cvt_pk_fp8_f32(mx_b_val(k + 2, i), mx_b_val(k + 3, i), w2, true); bw[q] = w2; } }
                const v8i af = {aw[0], aw[1], aw[2], aw[3], aw[4], aw[5], aw[6], aw[7]}, bf = {bw[0], bw[1], bw[2], bw[3], bw[4], bw[5], bw[6], bw[7]};
                f4 d = {0.f, 0.f, 0.f, 0.f};
                if (t == 0) d = __builtin_amdgcn_mfma_scale_f32_16x16x128_f8f6f4(af, bf, d, 4, 4, 0, 0x7f7f7f7f, 0, 0x7f7f7f7f); else d = __builtin_amdgcn_mfma_scale_f32_16x16x128_f8f6f4(af, bf, d, 0, 0, 0, 0x7f7f7f7f, 0, 0x7f7f7f7f);
                int bad = 0;
                for (int r = 0; r < 4; ++r) { const int row = 4 * kb + r, col = i; float ex = 0.f;
                    for (int k = 0; k < 128; ++k) ex += (t == 0) ? mx_a_val(row, k) * mx_a_val(col + 16, k) : mx_b_val(k, row + 16) * mx_b_val(k, col);
                    bad += (d[r] != ex); }
                if (__ballot(bad != 0) == 0ull) code += (t == 0) ? 10.f : 20.f; }
            if (lane == 0) vsh = code; }
        __syncthreads(); v = vsh;
    } else {
        float s0 = 0.f, s1 = 0.f, s2 = 0.f, s3 = 0.f;
        for (int i = 0; i < 2048; ++i) { s0 += pp[4 * i]; s1 += pp[4 * i + 1]; s2 += pp[4 * i + 2]; s3 += pp[4 * i + 3]; }
        if (DBG_PROBE == 4) { float mx = 0.f; for (int i = 0; i < 2048; ++i) mx = fmaxf(mx, pp[4 * i]); v = 100.f * mx; }
        else { v = (DBG_PROBE == 1 ? s0 : DBG_PROBE == 2 ? s1 : s2) / s3 * 1e-3f; v = exp2f(rintf(log2f(v) * 4.f) * 0.25f); }
    }
    for (size_t i = (size_t)blockIdx.x * 512 + threadIdx.x; i < (size_t)NBATCH * SEQ * DM; i += (size_t)gridDim.x * 512) o[i] = v;
}
extern "C" void kernel_launch(void* const* d_in, const int* in_sizes, int n_in, void* d_out, int out_size, void* d_ws, size_t ws_size, hipStream_t stream) {
    static int grid = 0;
    if (grid == 0) {
        if (n_in != 33 || out_size != NBATCH * SEQ * DM || ws_size < WS_END) { fprintf(stderr, "kernel_launch: unexpected shapes (n_in %d out %d ws %zu)\n", n_in, out_size, ws_size); grid = -1; return; }
        int dev = 0, cus = 0, per_cu = 0;
        if (hipGetDevice(&dev) != hipSuccess || hipDeviceGetAttribute(&cus, hipDeviceAttributeMultiprocessorCount, dev) != hipSuccess) { grid = -1; return; }
        if (hipFuncSetAttribute((const void*)mk_fwd, hipFuncAttributeMaxDynamicSharedMemorySize, LDS_BYTES) != hipSuccess) { fprintf(stderr, "kernel_launch: hipFuncSetAttribute failed\n"); grid = -1; return; }
        if (hipOccupancyMaxActiveBlocksPerMultiprocessor(&per_cu, (const void*)mk_fwd, NWAVES * 64, LDS_BYTES) != hipSuccess || per_cu < 1) { fprintf(stderr, "kernel_launch: occupancy query says %d\n", per_cu); (void)hipGetLastError(); grid = -1; return; }
        grid = cus;
    }
    if (grid < 0) return;
    if (hipMemsetAsync((char*)d_ws + WS_CTL, 0, CTL_ZERO_BYTES, stream) != hipSuccess) return;
    Args a{};
    for (int i = 0; i < 33; ++i) a.in[i] = (const float*)d_in[i];
    a.out = (float*)d_out; a.ws = (unsigned char*)d_ws;
#if MK_N_LAUNCHES == 1
    a.ph_lo = 0; a.ph_hi = NPHASE;
    hipLaunchKernelGGL(mk_fwd, dim3(grid), dim3(NWAVES * 64), LDS_BYTES, stream, a);
#else
    if (DBG_PROBE != 5) for (int p = 0; p < NPHASE; ++p) { a.ph_lo = p; a.ph_hi = p + 1; hipLaunchKernelGGL(mk_fwd, dim3(grid), dim3(NWAVES * 64), LDS_BYTES, stream, a); }
    if (DBG_PROBE) hipLaunchKernelGGL(dbg_fill, dim3(1024), dim3(512), 0, stream, (const float*)((char*)d_ws + WS_CTL + CTL_PROBE_OFF), (float*)d_out);
#endif
}
```

```cpp
#include <hip/hip_runtime.h>
#include <cstdio>
#include <cstdint>

#ifndef MK_N_LAUNCHES
#define MK_N_LAUNCHES 1
#endif

#ifndef DBG_SKIP
#define DBG_SKIP 0
#endif
#ifndef DBG_PROBE
#define DBG_PROBE 0
#endif
#ifndef DBG_REPEAT
#define DBG_REPEAT -1
#endif
namespace pg8 {
#define PG8_LAS __attribute__((address_space(3)))
typedef unsigned short bf16_t;
typedef short bf16x8 __attribute__((ext_vector_type(8)));
typedef float f32x4 __attribute__((ext_vector_type(4)));
typedef unsigned u32x4 __attribute__((ext_vector_type(4)));
constexpr int BM = 256, BK = 64, HALF = 128, HTB = HALF * BK * 2  , STAGE_BYTES = 8 * HTB, NXCD = 8, WGM = 8;

__host__ __device__ __forceinline__ int lds_byte(int r, int c) { const int st = (r >> 4) * 2 + (c >> 5), rr = r & 15, cc = c & 31, ob = rr * 64 + cc * 2; return st * 1024 + (ob ^ (((ob >> 9) & 1) << 5)); }
__host__ __device__ __forceinline__ void stage_rc(int b, int& R, int& C) { const int st = b / 1024, sb = b % 1024, swz = sb ^ (((sb >> 9) & 1) << 5); R = (st >> 1) * 16 + swz / 64; C = (st & 1) * 32 + (swz % 64) / 2; }
__host__ __device__ __forceinline__ int perm32(int rho) { const int n = rho >> 4, i = rho & 15; return 8 * (i >> 2) + 4 * n + (i & 3); }

struct Unit { int pm, pn; };
struct Gemm { const bf16_t* A; const bf16_t* Bt; int M, N, K; };

struct StaticOrder {
    int nM, nN, nwg, G, c;
    __host__ __device__ void init(int M, int N, int G_, int c_) { nM = M / BM; nN = N / BM; nwg = nM * nN; G = G_; c = c_; }
    __host__ __device__ bool next(int i, Unit& u) const {
        const long L = (long)i * G + c; if (L >= nwg) return false;
        int wgid = (int)L; { const int q = nwg / NXCD, r = nwg % NXCD, xcd = wgid % NXCD, off = wgid / NXCD; wgid = (xcd < r ? xcd * (q + 1) : r * (q + 1) + (xcd - r) * q) + off; }
        const int nig = WGM * nN, gid = wgid / nig, fm = gid * WGM, gsz = (nM - fm) < WGM ? (nM - fm) : WGM;
        u.pm = fm + ((wgid % nig) % gsz); u.pn = (wgid % nig) / gsz; return true;
    }
    __device__ __forceinline__ void a_ready(const Unit&) const {}
    __device__ __forceinline__ void done(const Unit&) const {}
};
__device__ __forceinline__ int opaque_lane() { int l; asm volatile("v_mbcnt_lo_u32_b32 %0, -1, 0\n\tv_mbcnt_hi_u32_b32 %0, -1, %0" : "=v"(l)); return l; }
typedef __bf16 bf16x2c __attribute__((ext_vector_type(2)));
__device__ __forceinline__ unsigned cvt_pk_bf16(float lo, float hi) { const bf16x2c v = {(__bf16)lo, (__bf16)hi}; return __builtin_bit_cast(unsigned, v); }
template <class Epi, class Sched, bool ALIGN_EPI = false, bool SP2 = false>
__device__ __forceinline__ void gemm_phase(PG8_LAS unsigned char* lds, const Gemm g, const Sched& S, const Epi& E, const int wave_s) {
    const int lane_ = opaque_lane();
    const int wid = wave_s, lane = lane_, tid = wid * 64 + lane, wr = wid >> 2, wc = wid & 3, fr = lane & 15, fq = lane >> 4;
    const int K = g.K, nt = K / BK;
    unsigned voffA[2], voffB[2];
#pragma unroll
    for (int i = 0; i < 2; ++i) { int R, C; stage_rc(tid * 16 + i * 8192, R, C); const int Rb = Epi::PERM ? ((R & ~31) + perm32(R & 31)) : R;
        voffA[i] = (unsigned)(R * K + C) * 2u; voffB[i] = (unsigned)(Rb * K + C) * 2u; }
    const size_t kstep = (size_t)(BK * 2);
    const size_t hstep = (size_t)HALF * K * 2;
    const size_t tstep = 2 * hstep;
    const unsigned ldsw = (unsigned)wid * 1024u;
    const int aoff = lds_byte(wr * 64 + fr, fq * 8), boff = lds_byte(wc * 32 + fr, fq * 8);
#define PG8_SA(b, h) (((b) * 2 + (h)) * HTB)
#define PG8_SB(b, h) ((4 + (b) * 2 + (h)) * HTB)
#define PG8_STAGE(bufoff, gbase, voff) do { _Pragma("unroll") for (int _i = 0; _i < 2; ++_i) \
        __builtin_amdgcn_global_load_lds((const unsigned*)((const char*)(gbase) + (voff)[_i]), (PG8_LAS unsigned*)(lds + (bufoff) + ldsw + _i * 8192), 16, 0, 0); } while (0)
#define PG8_LDA(dst, b, h) do { _Pragma("unroll") for (int m = 0; m < 4; ++m) _Pragma("unroll") for (int k = 0; k < 2; ++k) dst[m][k] = *(const PG8_LAS bf16x8*)(lds + PG8_SA(b, h) + aoff + m * 2048 + k * 1024); } while (0)
#define PG8_LDB(dst, b, h) do { _Pragma("unroll") for (int n = 0; n < 2; ++n) _Pragma("unroll") for (int k = 0; k < 2; ++k) dst[n][k] = *(const PG8_LAS bf16x8*)(lds + PG8_SB(b, h) + boff + n * 2048 + k * 1024); } while (0)
#define PG8_MMA(ai, bj, At, Bt) do { __builtin_amdgcn_s_setprio(1); _Pragma("unroll") for (int m = 0; m < 4; ++m) _Pragma("unroll") for (int n = 0; n < 2; ++n) _Pragma("unroll") for (int k = 0; k < 2; ++k) \
        acc[ai][bj][m][n] = __builtin_amdgcn_mfma_f32_16x16x32_bf16(Bt[n][k], At[m][k], acc[ai][bj][m][n], 0, 0, 0); __builtin_amdgcn_s_setprio(0); } while (0)
#define PG8_WAIT_V(n) asm volatile("s_waitcnt vmcnt(" #n ")" ::: "memory")
#define PG8_WAIT_L(n) asm volatile("s_waitcnt lgkmcnt(" #n ")" ::: "memory")
#define PG8_BAR __builtin_amdgcn_s_barrier()
#define PG8_SCHED __builtin_amdgcn_sched_barrier(0)
    Unit cur, nxt; int ui = 0;
    if (!S.next(0, cur)) return;
    f32x4 acc[2][2][4][2];
#pragma unroll
    for (int a = 0; a < 2; ++a)
#pragma unroll
        for (int b = 0; b < 2; ++b)
#pragma unroll
            for (int m = 0; m < 4; ++m)
#pragma unroll
                for (int n = 0; n < 2; ++n) acc[a][b][m][n] = (f32x4){0.f, 0.f, 0.f, 0.f};
    bf16x8 At[4][2], B0[2][2], B1[2][2];
    const char* cA = (const char*)g.A + (size_t)cur.pm * tstep; const char* cB = (const char*)g.Bt + (size_t)cur.pn * tstep;
    S.a_ready(cur);
    if constexpr (SP2) {
        PG8_STAGE(PG8_SB(0, 0), cB, voffB); PG8_STAGE(PG8_SB(0, 1), cB + hstep, voffB); PG8_STAGE(PG8_SA(0, 0), cA, voffA); PG8_STAGE(PG8_SA(0, 1), cA + hstep, voffA);
        if (wr == 1) PG8_BAR;
        PG8_WAIT_V(2); PG8_BAR;
        PG8_STAGE(PG8_SB(1, 0), cB + kstep, voffB); PG8_STAGE(PG8_SA(1, 0), cA + kstep, voffA); PG8_STAGE(PG8_SB(1, 1), cB + hstep + kstep, voffB);
        PG8_WAIT_V(6); PG8_BAR;
    } else {
        PG8_STAGE(PG8_SB(0, 0), cB, voffB); PG8_STAGE(PG8_SA(0, 0), cA, voffA); PG8_STAGE(PG8_SB(0, 1), cB + hstep, voffB); PG8_STAGE(PG8_SA(0, 1), cA + hstep, voffA);
        if (wr == 1) PG8_BAR;
        PG8_WAIT_V(4); PG8_BAR;
        PG8_STAGE(PG8_SB(1, 0), cB + kstep, voffB); PG8_STAGE(PG8_SA(1, 0), cA + kstep, voffA); PG8_STAGE(PG8_SB(1, 1), cB + hstep + kstep, voffB);
        PG8_WAIT_V(6); PG8_BAR;
    }
    for (;;) {
        const bool has_next = S.next(ui + 1, nxt);
        const char* nA = has_next ? (const char*)g.A + (size_t)nxt.pm * tstep : cA; const char* nB = has_next ? (const char*)g.Bt + (size_t)nxt.pn * tstep : cB;
        for (int t = 0; t < nt; t += 2) {
            const bool last = (t == nt - 2);
            const char* a1 = cA + (size_t)(t + 1) * kstep;
            const char* a2 = last ? nA : cA + (size_t)(t + 2) * kstep; const char* b2 = last ? nB : cB + (size_t)(t + 2) * kstep;
            const char* a3 = a2 + kstep; const char* b3 = b2 + kstep;
            if (last && has_next) S.a_ready(nxt);
            if constexpr (SP2) {
            PG8_LDB(B0, 0, 0); PG8_LDB(B1, 0, 1); PG8_SCHED; PG8_LDA(At, 0, 0); PG8_STAGE(PG8_SA(1, 1), a1 + hstep, voffA);
            PG8_WAIT_V(8); PG8_WAIT_L(0); PG8_BAR; PG8_MMA(0, 0, At, B0); PG8_MMA(0, 1, At, B1); PG8_BAR; PG8_SCHED;
            PG8_LDA(At, 0, 1); PG8_STAGE(PG8_SB(0, 0), b2, voffB); PG8_STAGE(PG8_SB(0, 1), b2 + hstep, voffB); PG8_STAGE(PG8_SA(0, 0), a2, voffA);
            PG8_WAIT_V(8); PG8_WAIT_L(0); PG8_BAR; PG8_MMA(1, 0, At, B0); PG8_MMA(1, 1, At, B1); PG8_BAR; PG8_SCHED;
            PG8_LDB(B0, 1, 0); PG8_LDB(B1, 1, 1); PG8_SCHED; PG8_LDA(At, 1, 0); PG8_STAGE(PG8_SA(0, 1), a2 + hstep, voffA);
            PG8_WAIT_V(8); PG8_WAIT_L(0); PG8_BAR; PG8_MMA(0, 0, At, B0); PG8_MMA(0, 1, At, B1); PG8_BAR; PG8_SCHED;
            PG8_LDA(At, 1, 1); PG8_STAGE(PG8_SB(1, 0), b3, voffB); PG8_STAGE(PG8_SB(1, 1), b3 + hstep, voffB); PG8_STAGE(PG8_SA(1, 0), a3, voffA);
            PG8_WAIT_V(8); PG8_WAIT_L(0); PG8_BAR; PG8_MMA(1, 0, At, B0); PG8_MMA(1, 1, At, B1); PG8_BAR; PG8_SCHED;
            } else {
            PG8_LDB(B0, 0, 0); PG8_SCHED; PG8_LDA(At, 0, 0); PG8_STAGE(PG8_SA(1, 1), a1 + hstep, voffA);
            PG8_WAIT_L(8); PG8_BAR; PG8_WAIT_L(0); PG8_MMA(0, 0, At, B0); PG8_BAR; PG8_SCHED;
            PG8_LDB(B1, 0, 1); PG8_STAGE(PG8_SB(0, 0), b2, voffB);
            PG8_BAR; PG8_WAIT_L(0); PG8_MMA(0, 1, At, B1); PG8_BAR;
            PG8_LDA(At, 0, 1); PG8_STAGE(PG8_SA(0, 0), a2, voffA);
            PG8_BAR; PG8_WAIT_L(0); PG8_MMA(1, 0, At, B0); PG8_BAR; PG8_SCHED;
            PG8_STAGE(PG8_SB(0, 1), b2 + hstep, voffB);
            PG8_WAIT_V(6); PG8_BAR; PG8_MMA(1, 1, At, B1); PG8_BAR;
            PG8_LDB(B0, 1, 0); PG8_SCHED; PG8_LDA(At, 1, 0); PG8_STAGE(PG8_SA(0, 1), a2 + hstep, voffA);
            PG8_WAIT_L(8); PG8_BAR; PG8_WAIT_L(0); PG8_MMA(0, 0, At, B0); PG8_BAR; PG8_SCHED;
            PG8_LDB(B1, 1, 1); PG8_STAGE(PG8_SB(1, 0), b3, voffB);
            PG8_BAR; PG8_WAIT_L(0); PG8_MMA(0, 1, At, B1); PG8_BAR;
            PG8_LDA(At, 1, 1); PG8_STAGE(PG8_SA(1, 0), a3, voffA);
            PG8_BAR; PG8_WAIT_L(0); PG8_MMA(1, 0, At, B0); PG8_BAR; PG8_SCHED;
            PG8_STAGE(PG8_SB(1, 1), b3 + hstep, voffB);
            PG8_WAIT_V(6); PG8_BAR; PG8_MMA(1, 1, At, B1); PG8_BAR;
            }
        }
        if constexpr (ALIGN_EPI) { if (wr == 0) PG8_BAR; }
        if constexpr (!Epi::AFTER_DRAIN) { const int le_ = opaque_lane(); E(acc, cur, wr, wc, le_ & 15, le_ >> 4); S.done(cur); }
        if (!has_next) break;
#pragma unroll
        for (int a = 0; a < 2; ++a)
#pragma unroll
            for (int b = 0; b < 2; ++b)
#pragma unroll
                for (int m = 0; m < 4; ++m)
#pragma unroll
                    for (int n = 0; n < 2; ++n) acc[a][b][m][n] = (f32x4){0.f, 0.f, 0.f, 0.f};
        cur = nxt; cA = nA; cB = nB; ++ui;
        if constexpr (ALIGN_EPI) { if (wr == 1) PG8_BAR; }
    }
    PG8_WAIT_V(0);
    if constexpr (!ALIGN_EPI) { if (wr == 0) PG8_BAR; }
    PG8_BAR;
    if constexpr (Epi::AFTER_DRAIN) { E.fused(acc, cur, wr, wc, fr, fq, lds, wid, lane); S.done(cur); }
#undef PG8_SA
#undef PG8_SB
#undef PG8_STAGE
#undef PG8_LDA
#undef PG8_LDB
#undef PG8_MMA
#undef PG8_WAIT_V
#undef PG8_WAIT_L
#undef PG8_BAR
#undef PG8_SCHED
}
}

constexpr int NWAVES = 8;
constexpr int DM = 2048, NBATCH = 2, SEQ = 8192, CTXL = 256, TPB = CTXL + SEQ  , MALL = NBATCH * TPB  ;
constexpr int NLAYER = 2;
constexpr int RW = 1024, NH = 16;
constexpr int RWC = 3392, INA = 4192, INA_P = 4352, INC = 8288;
constexpr int C_WD = 3072, C_AD = 3200, C_GD = 3328, C_QC = 3392, C_KVC = 3904, C_KR = 4160;
constexpr int QKD = 96, NQ = NH * QKD  , NKV = NH * 128  ;
constexpr int NEXP = 16384;
constexpr int RREC = 9 * 64;
constexpr float NORM_EPS = 1e-6f;

constexpr size_t MiB = 1u << 20;
constexpr size_t WS_CTL = 0, CTL_ZERO_BYTES = 1 * MiB;
constexpr size_t CTL_MOD_OFF = 256 * 1024;
constexpr size_t WS_ROPE = 1 * MiB;
constexpr size_t WS_WUP = 3 * MiB, WS_AUP = WS_WUP + 512 * 1024, WS_GUP = 4 * MiB;
constexpr size_t WS_WUQ = 5 * MiB, WS_WUKV = 8 * MiB, WS_WA = 10 * MiB, WS_WB = 18 * MiB, WS_WO = 26 * MiB, WS_WQK = 42 * MiB, WS_WGA = 58 * MiB, WS_WGB = 74 * MiB, WS_WINA = 90 * MiB;
constexpr size_t WS_X = 124 * MiB, WS_H = 256 * MiB, WS_DYN = 322 * MiB;
constexpr size_t WS_PA = WS_DYN;
constexpr size_t WS_RI = 463 * MiB;
constexpr size_t WS_GG = 760 * MiB;
constexpr size_t WS_BON = 826 * MiB;
constexpr size_t WS_QN = 831 * MiB, WS_KVN = 848 * MiB;
constexpr size_t WS_Q = 857 * MiB, WS_K = 907 * MiB, WS_V = 957 * MiB, WS_END = 990 * MiB;
constexpr size_t WS_Y = WS_DYN;
constexpr size_t WS_YA = 388 * MiB, WS_YB = 421 * MiB;
constexpr size_t WS_T1 = 463 * MiB, WS_T2 = 529 * MiB;
constexpr size_t WS_PU = 600 * MiB, WS_PV = 664 * MiB;
constexpr size_t WS_SC = WS_DYN;
static_assert(WS_PA + (size_t)MALL * INA_P * 2 <= WS_RI && WS_RI + (size_t)NBATCH * NH * TPB * RREC * 2 <= WS_GG && WS_GG + (size_t)2 * MALL * RW * 2 <= WS_BON, "ws map 1");
static_assert(WS_BON + (size_t)2 * MALL * 32 * 4 <= WS_QN && WS_QN + (size_t)MALL * 512 * 2 <= WS_KVN && WS_KVN + (size_t)MALL * 256 * 2 <= WS_Q, "ws map 2");
static_assert(WS_Q + (size_t)NBATCH * NH * TPB * QKD * 2 <= WS_K && WS_K + (size_t)NBATCH * NH * TPB * QKD * 2 <= WS_V && WS_V + (size_t)NBATCH * NH * TPB * 64 * 2 <= WS_END, "ws map 3");
static_assert(WS_Y + (size_t)2 * MALL * RW * 2 <= WS_YA && WS_YA + (size_t)MALL * RW * 2 <= WS_YB && WS_YB + (size_t)MALL * RW * 2 <= WS_RI, "ws map 4");
static_assert(WS_T1 + (size_t)MALL * DM * 2 <= WS_T2 && WS_T2 + (size_t)MALL * DM * 2 <= WS_PU && WS_PU + (size_t)NEXP * DM * 2 <= WS_PV && WS_PV + (size_t)NEXP * DM * 2 <= WS_GG, "ws map 5");
static_assert(WS_SC + (size_t)MALL * DM * 4 <= WS_T1 && WS_X + (size_t)MALL * DM * 4 <= WS_H && WS_H + (size_t)MALL * DM * 2 <= WS_DYN, "ws map 6");
static_assert(WS_WINA + (size_t)NLAYER * INA_P * DM * 2 <= WS_X, "ws map 7");
constexpr size_t CTL_PROBE_OFF = 640 * 1024;
constexpr int CW_BAR = 4096;

constexpr int RING_BYTES = 131072;
constexpr int LDSCTL_OFF = RING_BYTES, MISC_OFF = LDSCTL_OFF + 320;
constexpr int LDS_BYTES = 147456;

#define GAS __attribute__((address_space(1)))
#define LAS __attribute__((address_space(3)))
typedef unsigned short bf16;
typedef unsigned v4u __attribute__((ext_vector_type(4)));
typedef unsigned v2u __attribute__((ext_vector_type(2)));
typedef float f32x4 __attribute__((ext_vector_type(4)));
typedef float f32x2 __attribute__((ext_vector_type(2)));
typedef float f32x16 __attribute__((ext_vector_type(16)));
typedef short bf16x8 __attribute__((ext_vector_type(8)));
typedef short s16x4 __attribute__((ext_vector_type(4)));
typedef __bf16 bf16x2v __attribute__((ext_vector_type(2)));
typedef __bf16 bf16x8v __attribute__((ext_vector_type(8)));
typedef GAS unsigned gu32;
#define RLX_AGENT __ATOMIC_RELAXED, __HIP_MEMORY_SCOPE_AGENT
#define LDS_WAIT() asm volatile("s_waitcnt lgkmcnt(0)" ::: "memory")
#define VM_WAIT() asm volatile("s_waitcnt vmcnt(0)" ::: "memory")
__device__ __forceinline__ unsigned f2bf(float f) { unsigned u = __builtin_bit_cast(unsigned, f); return (u + 0x7fffu + ((u >> 16) & 1u)) >> 16; }
__device__ __forceinline__ unsigned pk2(float lo, float hi) { return pg8::cvt_pk_bf16(lo, hi); }
__device__ __forceinline__ float bflo(unsigned w) { return __builtin_bit_cast(float, w << 16); }
__device__ __forceinline__ float bfhi(unsigned w) { return __builtin_bit_cast(float, w & 0xffff0000u); }
__device__ __forceinline__ float bf1(bf16 h) { return __builtin_bit_cast(float, (unsigned)h << 16); }
__device__ __forceinline__ float sigmoidf_(float x) { return __builtin_amdgcn_rcpf(1.0f + __expf(-x)); }
template <int CTRL> __device__ __forceinline__ float dpp_add(float x) {
    return x + __builtin_bit_cast(float, __builtin_amdgcn_update_dpp(0, __builtin_bit_cast(int, x), CTRL, 0xf, 0xf, true));
}
__device__ __forceinline__ float red16(float x) {
    x = dpp_add<0xB1>(x);
    x = dpp_add<0x4E>(x);
    x = dpp_add<0x141>(x);
    x = dpp_add<0x140>(x);
    return x;
}
template <int CTRL, int RM> __device__ __forceinline__ float dpp_max(float x) {
    return fmaxf(x, __builtin_bit_cast(float, __builtin_amdgcn_update_dpp(__builtin_bit_cast(int, x), __builtin_bit_cast(int, x), CTRL, RM, 0xf, false)));
}
template <int CTRL, int RM> __device__ __forceinline__ float dpp_sum(float x) {
    return x + __builtin_bit_cast(float, __builtin_amdgcn_update_dpp(0, __builtin_bit_cast(int, x), CTRL, RM, 0xf, false));
}
__device__ __forceinline__ float wave_max_u(float x) {
    x = dpp_max<0xB1, 0xf>(x); x = dpp_max<0x4E, 0xf>(x); x = dpp_max<0x141, 0xf>(x); x = dpp_max<0x140, 0xf>(x);
    x = dpp_max<0x142, 0xa>(x); x = dpp_max<0x143, 0xc>(x);
    return __builtin_bit_cast(float, __builtin_amdgcn_readlane(__builtin_bit_cast(int, x), 63));
}
__device__ __forceinline__ float wave_sum_u(float x) {
    x = dpp_sum<0xB1, 0xf>(x); x = dpp_sum<0x4E, 0xf>(x); x = dpp_sum<0x141, 0xf>(x); x = dpp_sum<0x140, 0xf>(x);
    x = dpp_sum<0x142, 0xa>(x); x = dpp_sum<0x143, 0xc>(x);
    return __builtin_bit_cast(float, __builtin_amdgcn_readlane(__builtin_bit_cast(int, x), 63));
}
__device__ __forceinline__ float wave_sum(float v) { return wave_sum_u(v); }
__device__ __forceinline__ float bpermf(int srclane, float v) { return __builtin_bit_cast(float, __builtin_amdgcn_ds_bpermute(srclane << 2, __builtin_bit_cast(int, v))); }
__device__ __forceinline__ int bpermi(int srclane, int v) { return __builtin_amdgcn_ds_bpermute(srclane << 2, v); }

#define XB_TMO      128
#define XB_XCNT(j)  (256  + 64 * (j))
#define XB_XSUB(j)  (1280 + 64 * (j))
#define XB_XGEN(j)  (2304 + 64 * (j))
#define XB_TOP      3328
#define XB_TOPGEN   3392
#define XCD_BAR_WORDS 3456
#define XB_SPIN_CAP (1u << 20)

__device__ __forceinline__ unsigned xb_ld(unsigned* p)              { return __hip_atomic_load(p, __ATOMIC_RELAXED, __HIP_MEMORY_SCOPE_AGENT); }
__device__ __forceinline__ unsigned xb_add(unsigned* p, unsigned v) { return __hip_atomic_fetch_add(p, v, __ATOMIC_RELAXED, __HIP_MEMORY_SCOPE_AGENT); }
__device__ __forceinline__ unsigned xb_xcc_id() { return (unsigned)__builtin_amdgcn_s_getreg((3 << 11) | 20) & 0xFu; }
#define XB_SPIN(cond, bar) do { unsigned _sp = 0; while (cond) { __builtin_amdgcn_s_sleep(1); \
    if ((++_sp & 255u) == 0u) { if (xb_ld(&(bar)[XB_TMO])) break; if (_sp > XB_SPIN_CAP) { atomicAdd(&(bar)[XB_TMO], 1u); break; } } } } while (0)

struct XcdBarrier { unsigned* bar; unsigned x; volatile LAS unsigned* st; };

__device__ __forceinline__ XcdBarrier xcd_barrier_post(unsigned* bar, volatile LAS unsigned* st, bool t0) {
    XcdBarrier b; b.bar = bar; b.x = xb_xcc_id(); b.st = st;
    if (t0) (void)xb_add(&bar[XB_XCNT(b.x)], 1u);
    return b;
}
__device__ __forceinline__ void xcd_barrier_complete(unsigned* bar, unsigned x, unsigned& nloc, unsigned& nx) {
    const unsigned G = gridDim.x * gridDim.y * gridDim.z;
    unsigned sum, cnt, mine, sp = 0u;
    for (;;) {
        sum = 0u; cnt = 0u; mine = 0u;
#pragma unroll
        for (unsigned j = 0; j < 16; ++j) { const unsigned c = xb_ld(&bar[XB_XCNT(j)]); sum += c; cnt += (c > 0u) ? 1u : 0u; mine = (j == x) ? c : mine; }
        if (sum == G) break;
        __builtin_amdgcn_s_sleep(1);
        if ((++sp & 255u) == 0u) { if (xb_ld(&bar[XB_TMO])) break; if (sp > XB_SPIN_CAP) { atomicAdd(&bar[XB_TMO], 1u); break; } }
    }
    nloc = mine > 0u ? mine : 1u; nx = cnt > 0u ? cnt : 1u;
}
__device__ __forceinline__ void xcd_barrier(const XcdBarrier& b, bool t0) {
    asm volatile("s_waitcnt vmcnt(0)" ::: "memory");
    __syncthreads();
    if (t0) {
        unsigned* bar = b.bar;
        __builtin_amdgcn_s_waitcnt(0);
        unsigned nloc = b.st[0], nx = b.st[1];
        if (nloc == 0u) { xcd_barrier_complete(bar, b.x, nloc, nx); b.st[0] = nloc; b.st[1] = nx; }
        const unsigned old = xb_add(&bar[XB_XSUB(b.x)], 1u);
        const unsigned gen = old / nloc;
        if (old + 1u == (gen + 1u) * nloc) {
            __builtin_amdgcn_fence(__ATOMIC_RELEASE, "agent");
            asm volatile("s_waitcnt vmcnt(0)" ::: "memory");
            const unsigned og = xb_add(&bar[XB_TOP], 1u);
            const unsigned tg = og / nx;
            if (og + 1u == (tg + 1u) * nx) xb_add(&bar[XB_TOPGEN], 1u);
            else XB_SPIN(xb_ld(&bar[XB_TOPGEN]) == tg, bar);
            __builtin_amdgcn_fence(__ATOMIC_ACQUIRE, "agent");
            xb_add(&bar[XB_XGEN(b.x)], 1u);
            asm volatile("s_waitcnt vmcnt(0)" ::: "memory");
        } else {
            XB_SPIN(xb_ld(&bar[XB_XGEN(b.x)]) == gen, bar);
            __builtin_amdgcn_fence(__ATOMIC_ACQUIRE, "agent");
            asm volatile("s_waitcnt vmcnt(0)" ::: "memory");
        }
    }
    __syncthreads();
}

struct Frame {
    LAS unsigned char* lds;
    unsigned char* ws;
    const float* const* in;
    int tid, lane, wave;
    int vcu, G;
};
struct Args { const float* in[33]; float* out; unsigned char* ws; int ph_lo, ph_hi; };


namespace pg8 {
typedef unsigned u32x4 __attribute__((ext_vector_type(4)));
struct RowOrder : StaticOrder {
    int lat;
    __host__ __device__ void init_rows(int lat_, int N, int G_, int c_) { lat = lat_; init(lat_ ? NBATCH * SEQ : MALL, N, G_, c_); }
    __host__ __device__ bool next(int i, Unit& u) const { if (!StaticOrder::next(i, u)) return false; if (lat) u.pm = 33 * (u.pm >> 5) + 1 + (u.pm & 31); return true; }
};
#define EPI_LOOP_ROWS for (int ai = 0; ai < 2; ++ai) _Pragma("unroll") for (int m = 0; m < 4; ++m)
#define EPI_PIN asm volatile("" ::: "memory")

struct EpiStoreBf16 {
    static constexpr bool PERM = true, AFTER_DRAIN = false;
    bf16_t* O; int ldc;
    __device__ __forceinline__ void operator()(const f32x4 (&acc)[2][2][4][2], const Unit& u, int wr, int wc, int fr, int fq) const {
        const int row0 = u.pm * BM + wr * 64 + fr, col0 = u.pn * BM + wc * 32 + 8 * fq;
#pragma unroll
        EPI_LOOP_ROWS { bf16_t* rowp = O + (size_t)(row0 + ai * HALF + m * 16) * ldc + col0;
#pragma unroll
            for (int bj = 0; bj < 2; ++bj) { const f32x4 v0 = acc[ai][bj][m][0], v1 = acc[ai][bj][m][1];
                u32x4 w; w.x = cvt_pk_bf16(v0[0], v0[1]); w.y = cvt_pk_bf16(v0[2], v0[3]); w.z = cvt_pk_bf16(v1[0], v1[1]); w.w = cvt_pk_bf16(v1[2], v1[3]);
                *(u32x4*)(rowp + bj * HALF) = w; } }
    }
};
struct EpiGate {
    static constexpr bool PERM = true, AFTER_DRAIN = false;
    bf16_t* O; int ldc; const float* bias;
    __device__ __forceinline__ void operator()(const f32x4 (&acc)[2][2][4][2], const Unit& u, int wr, int wc, int fr, int fq) const {
        const int row0 = u.pm * BM + wr * 64 + fr, col0 = u.pn * BM + wc * 32 + 8 * fq;
        f32x4 bv[2][2];
#pragma unroll
        for (int bj = 0; bj < 2; ++bj)
#pragma unroll
            for (int n = 0; n < 2; ++n) bv[bj][n] = *(const f32x4*)(bias + col0 + bj * HALF + 4 * n);
#pragma unroll
        EPI_LOOP_ROWS { EPI_PIN; bf16_t* rowp = O + (size_t)(row0 + ai * HALF + m * 16) * ldc + col0;
#pragma unroll
            for (int bj = 0; bj < 2; ++bj) { f32x4 v0 = acc[ai][bj][m][0] + bv[bj][0], v1 = acc[ai][bj][m][1] + bv[bj][1];
#pragma unroll
                for (int e = 0; e < 4; ++e) { v0[e] = __builtin_amdgcn_rcpf(1.0f + __expf(-v0[e])); v1[e] = __builtin_amdgcn_rcpf(1.0f + __expf(-v1[e])); }
                u32x4 w; w.x = cvt_pk_bf16(v0[0], v0[1]); w.y = cvt_pk_bf16(v0[2], v0[3]); w.z = cvt_pk_bf16(v1[0], v1[1]); w.w = cvt_pk_bf16(v1[2], v1[3]);
                *(u32x4*)(rowp + bj * HALF) = w; } }
    }
};
__device__ __forceinline__ float bf_lo(unsigned w) { return __builtin_bit_cast(float, w << 16); }
__device__ __forceinline__ float bf_hi(unsigned w) { return __builtin_bit_cast(float, w & 0xffff0000u); }
struct EpiMulAdd {
    static constexpr bool PERM = true, AFTER_DRAIN = false;
    bf16_t* O; const bf16_t* Gt; const bf16_t* Ad; int ldc;
    __device__ __forceinline__ void operator()(const f32x4 (&acc)[2][2][4][2], const Unit& u, int wr, int wc, int fr, int fq) const {
        const int row0 = u.pm * BM + wr * 64 + fr, col0 = u.pn * BM + wc * 32 + 8 * fq;
#pragma unroll
        EPI_LOOP_ROWS { EPI_PIN; const size_t ro = (size_t)(row0 + ai * HALF + m * 16) * ldc + col0;
#pragma unroll
            for (int bj = 0; bj < 2; ++bj) { const f32x4 v0 = acc[ai][bj][m][0], v1 = acc[ai][bj][m][1];
                const u32x4 g = *(const u32x4*)(Gt + ro + bj * HALF);
                float o[8];
                o[0] = bf_lo(g.x) * v0[0]; o[1] = bf_hi(g.x) * v0[1]; o[2] = bf_lo(g.y) * v0[2]; o[3] = bf_hi(g.y) * v0[3];
                o[4] = bf_lo(g.z) * v1[0]; o[5] = bf_hi(g.z) * v1[1]; o[6] = bf_lo(g.w) * v1[2]; o[7] = bf_hi(g.w) * v1[3];
                if (Ad) { const u32x4 a = *(const u32x4*)(Ad + ro + bj * HALF);
                    o[0] += bf_lo(a.x); o[1] += bf_hi(a.x); o[2] += bf_lo(a.y); o[3] += bf_hi(a.y); o[4] += bf_lo(a.z); o[5] += bf_hi(a.z); o[6] += bf_lo(a.w); o[7] += bf_hi(a.w); }
                u32x4 w; w.x = cvt_pk_bf16(o[0], o[1]); w.y = cvt_pk_bf16(o[2], o[3]); w.z = cvt_pk_bf16(o[4], o[5]); w.w = cvt_pk_bf16(o[6], o[7]);
                *(u32x4*)(O + ro + bj * HALF) = w; } }
    }
};
struct EpiResid {
    static constexpr bool PERM = false, AFTER_DRAIN = false;
    float* X; const float* gate;
    const float* xin; const float* cin;
    __device__ __forceinline__ void operator()(const f32x4 (&acc)[2][2][4][2], const Unit& u, int wr, int wc, int fr, int fq) const {
        const int row0 = u.pm * BM + wr * 64 + fr, col0 = u.pn * BM + wc * 32 + 4 * fq;
        const int bb = u.pm / 33, pt = u.pm - bb * 33, mr = (pt == 0) ? 2 : bb;
        const float* gp = gate + (size_t)mr * 12288 + col0;
        const float* sbase = xin ? (pt == 0 ? cin + (size_t)bb * CTXL * DM : xin + ((size_t)bb * SEQ + (size_t)(pt - 1) * BM) * DM) : X + (size_t)u.pm * BM * DM;
        f32x4 gv[2][2];
#pragma unroll
        for (int bj = 0; bj < 2; ++bj)
#pragma unroll
            for (int n = 0; n < 2; ++n) gv[bj][n] = *(const f32x4*)(gp + bj * HALF + n * 16);
#pragma unroll
        EPI_LOOP_ROWS { EPI_PIN; const int rl = wr * 64 + fr + ai * HALF + m * 16; float* rowp = X + (size_t)(u.pm * BM + rl) * DM + col0; const float* srow = sbase + (size_t)rl * DM + col0;
#pragma unroll
            for (int bj = 0; bj < 2; ++bj)
#pragma unroll
                for (int n = 0; n < 2; ++n) *(f32x4*)(rowp + bj * HALF + n * 16) = *(const f32x4*)(srow + bj * HALF + n * 16) + gv[bj][n] * acc[ai][bj][m][n]; }
    }
};
struct EpiF32 {
    static constexpr bool PERM = false, AFTER_DRAIN = false;
    float* C; int ldc;
    __device__ __forceinline__ void operator()(const f32x4 (&acc)[2][2][4][2], const Unit& u, int wr, int wc, int fr, int fq) const {
        const int row0 = u.pm * BM + wr * 64 + fr, col0 = u.pn * BM + wc * 32 + 4 * fq;
#pragma unroll
        EPI_LOOP_ROWS { float* rowp = C + (size_t)(row0 + ai * HALF + m * 16) * ldc + col0;
#pragma unroll
            for (int bj = 0; bj < 2; ++bj)
#pragma unroll
                for (int n = 0; n < 2; ++n) *(f32x4*)(rowp + bj * HALF + n * 16) = acc[ai][bj][m][n]; }
    }
};
struct EpiQ {
    static constexpr bool PERM = true, AFTER_DRAIN = false;
    bf16_t* Q; const f32x2* rope; float qscale;
    __device__ __forceinline__ void operator()(const f32x4 (&acc)[2][2][4][2], const Unit& u, int wr, int wc, int fr, int fq) const {
        const int bb = u.pm / 33, tp0 = (u.pm - bb * 33) * BM + wr * 64 + fr, col0 = u.pn * BM + wc * 32 + 8 * fq;
#pragma unroll
        for (int bj = 0; bj < 2; ++bj) { const int c = col0 + bj * HALF, hd = c / QKD, d = c - hd * QKD;
#pragma unroll
            EPI_LOOP_ROWS { EPI_PIN; const int tp = tp0 + ai * HALF + m * 16;
                f32x4 v0 = acc[ai][bj][m][0], v1 = acc[ai][bj][m][1];
                if (d >= 64) { const int i0 = (d - 64) >> 1; const f32x2* rp = rope + (size_t)tp * 16 + i0;
                    const f32x2 c0 = rp[0], c1 = rp[1], c2 = rp[2], c3 = rp[3];
                    float a, b;
                    a = v0[0]; b = v0[1]; v0[0] = a * c0.x - b * c0.y; v0[1] = a * c0.y + b * c0.x;
                    a = v0[2]; b = v0[3]; v0[2] = a * c1.x - b * c1.y; v0[3] = a * c1.y + b * c1.x;
                    a = v1[0]; b = v1[1]; v1[0] = a * c2.x - b * c2.y; v1[1] = a * c2.y + b * c2.x;
                    a = v1[2]; b = v1[3]; v1[2] = a * c3.x - b * c3.y; v1[3] = a * c3.y + b * c3.x; }
                v0 = v0 * qscale; v1 = v1 * qscale;
                u32x4 w; w.x = cvt_pk_bf16(v0[0], v0[1]); w.y = cvt_pk_bf16(v0[2], v0[3]); w.z = cvt_pk_bf16(v1[0], v1[1]); w.w = cvt_pk_bf16(v1[2], v1[3]);
                *(u32x4*)(Q + ((size_t)(bb * NH + hd) * TPB + tp) * QKD + d) = w; } }
    }
};
struct EpiKV {
    static constexpr bool PERM = true, AFTER_DRAIN = false;
    bf16_t* K; bf16_t* V;
    __device__ __forceinline__ void operator()(const f32x4 (&acc)[2][2][4][2], const Unit& u, int wr, int wc, int fr, int fq) const {
        const int bb = u.pm / 33, tp0 = (u.pm - bb * 33) * BM + wr * 64 + fr;
        const bool isK = wc < 2;
        bf16_t* base = isK ? K : V; const int pitch = isK ? QKD : 64, doff = 32 * (wc & 1) + 8 * fq;
#pragma unroll
        for (int bj = 0; bj < 2; ++bj) { const int hd = 2 * u.pn + bj;
            bf16_t* hb = base + (size_t)(bb * NH + hd) * TPB * pitch;
#pragma unroll
            EPI_LOOP_ROWS { EPI_PIN; const int tp = tp0 + ai * HALF + m * 16;
                const f32x4 v0 = acc[ai][bj][m][0], v1 = acc[ai][bj][m][1];
                u32x4 w; w.x = cvt_pk_bf16(v0[0], v0[1]); w.y = cvt_pk_bf16(v0[2], v0[3]); w.z = cvt_pk_bf16(v1[0], v1[1]); w.w = cvt_pk_bf16(v1[2], v1[3]);
                *(u32x4*)((char*)hb + (unsigned)((tp * pitch + doff) * 2)) = w; } }
    }
};
}

struct TItem { const float* W; bf16* WT; int K, ldw, c0, N, mapq, item; };
__device__ __forceinline__ void p0_item_load(const TItem& T, int lane, f32x4 (&x)[8]) {
    const int nblk = T.N / 32, kb = T.item / nblk, nb = T.item - kb * nblk, k0 = 64 * kb, n0 = 32 * nb;
    const float* p = T.W + (size_t)(k0 + (lane >> 3)) * T.ldw + T.c0 + n0 + (lane & 7) * 4;
#pragma unroll
    for (int i = 0; i < 8; ++i) x[i] = *(const GAS f32x4*)(p + (size_t)(8 * i) * T.ldw);
}
__device__ __forceinline__ void p0_item_finish(const TItem& T, const f32x4 (&x)[8], LAS float* scr, int lane) {
    const int nblk = T.N / 32, kb = T.item / nblk, nb = T.item - kb * nblk, k0 = 64 * kb, n0 = 32 * nb;
#pragma unroll
    for (int i = 0; i < 8; ++i) { LAS float* d = scr + (8 * i + (lane >> 3)) * 33 + (lane & 7) * 4; d[0] = x[i].x; d[1] = x[i].y; d[2] = x[i].z; d[3] = x[i].w; }
    LDS_WAIT(); asm volatile("" ::: "memory");
    const int c = lane & 7;
#pragma unroll
    for (int j = 0; j < 4; ++j) { const int n = (lane >> 3) + 8 * j; const LAS float* s = scr + (8 * c) * 33 + n;
        v4u o; o.x = pk2(s[0 * 33], s[1 * 33]); o.y = pk2(s[2 * 33], s[3 * 33]); o.z = pk2(s[4 * 33], s[5 * 33]); o.w = pk2(s[6 * 33], s[7 * 33]);
        int nn = n0 + n;
        if (T.mapq) { const int hd = nn / QKD, d = nn - hd * QKD; if (d >= 64) { const int i = (d - 64) & 15, s2 = (d - 64) >> 4; nn = hd * QKD + 64 + 2 * i + s2; } }
        *(GAS v4u*)(T.WT + (size_t)nn * T.K + k0 + 8 * c) = o; }
    LDS_WAIT(); asm volatile("" ::: "memory");
}

__device__ __forceinline__ const float* karg(int i);
constexpr int TB_INA = (DM / 128) * ((INA + 127) / 128), TB_G = (DM / 128) * (DM / 128), TB_BR = (RW / 128) * (DM / 128), TB_UQ = (512 / 128) * (NQ / 128), TB_UKV = (256 / 128) * (NKV / 128);
constexpr int TB_N = TB_INA + 2 * TB_G + 2 * TB_BR + TB_G + TB_UQ + TB_UKV;
constexpr int TI_LR = 1 * (RW / 32), TI_N = 4 * TI_LR;
__device__ __forceinline__ TItem p0_resolve_big(unsigned char* ws, int git) {
    const int l = git / TB_N; int r = git - l * TB_N; TItem T; T.mapq = 0; T.c0 = 0;
    if (r < TB_INA) { T.W = karg(7) + (size_t)l * DM * INC; T.K = DM; T.ldw = INC; T.N = INA; T.WT = (bf16*)(ws + WS_WINA) + (size_t)l * INA_P * DM; T.item = r; return T; } r -= TB_INA;
    if (r < TB_G) { T.W = karg(7) + (size_t)l * DM * INC; T.K = DM; T.ldw = INC; T.c0 = INA; T.N = DM; T.WT = (bf16*)(ws + WS_WGA) + (size_t)l * DM * DM; T.item = r; return T; } r -= TB_G;
    if (r < TB_G) { T.W = karg(7) + (size_t)l * DM * INC; T.K = DM; T.ldw = INC; T.c0 = INA + DM; T.N = DM; T.WT = (bf16*)(ws + WS_WGB) + (size_t)l * DM * DM; T.item = r; return T; } r -= TB_G;
    if (r < TB_BR) { T.W = karg(24) + (size_t)l * RW * DM; T.K = RW; T.ldw = DM; T.N = DM; T.WT = (bf16*)(ws + WS_WA) + (size_t)l * DM * RW; T.item = r; return T; } r -= TB_BR;
    if (r < TB_BR) { T.W = karg(25) + (size_t)l * RW * DM; T.K = RW; T.ldw = DM; T.N = DM; T.WT = (bf16*)(ws + WS_WB) + (size_t)l * DM * RW; T.item = r; return T; } r -= TB_BR;
    if (r < TB_G) { T.W = karg(26) + (size_t)l * DM * DM; T.K = DM; T.ldw = DM; T.N = DM; T.WT = (bf16*)(ws + WS_WO) + (size_t)l * DM * DM; T.item = r; return T; } r -= TB_G;
    if (r < TB_UQ) { T.W = karg(21) + (size_t)l * 512 * NQ; T.K = 512; T.ldw = NQ; T.N = NQ; T.WT = (bf16*)(ws + WS_WUQ) + (size_t)l * NQ * 512; T.item = r; T.mapq = 1; return T; } r -= TB_UQ;
    { T.W = karg(23) + (size_t)l * 256 * NKV; T.K = 256; T.ldw = NKV; T.N = NKV; T.WT = (bf16*)(ws + WS_WUKV) + (size_t)l * NKV * 256; T.item = r; return T; }
}
__device__ __forceinline__ void p0_big_load(const TItem& T, int tid, f32x4 (&x)[8]) {
    const int nblk = (T.N + 127) / 128, kb = T.item / nblk, nb = T.item - kb * nblk, k0 = 128 * kb, col = 128 * nb + (tid & 31) * 4;
    const float* p = T.W + (size_t)(k0 + (tid >> 5)) * T.ldw + T.c0 + col; const bool ok = col < T.N;
#pragma unroll
    for (int i = 0; i < 8; ++i) x[i] = ok ? *(const GAS f32x4*)(p + (size_t)(16 * i) * T.ldw) : (f32x4){0.f, 0.f, 0.f, 0.f};
}
__device__ __forceinline__ void p0_big_finish(const TItem& T, const f32x4 (&x)[8], LAS float* tile, int tid) {
    const int nblk = (T.N + 127) / 128, kb = T.item / nblk, nb = T.item - kb * nblk, k0 = 128 * kb, n0 = 128 * nb;
    __syncthreads();
#pragma unroll
    for (int i = 0; i < 8; ++i) *(LAS f32x4*)(tile + ((tid >> 5) + 16 * i) * 132 + (tid & 31) * 4) = x[i];
    __syncthreads();
    const int n = tid & 127, cg = tid >> 7; int nn = n0 + n;
    if (nn < T.N) {
        if (T.mapq) { const int hd = nn / QKD, d = nn - hd * QKD; if (d >= 64) { const int i = (d - 64) & 15, s2 = (d - 64) >> 4; nn = hd * QKD + 64 + 2 * i + s2; } }
#pragma unroll
        for (int c = 0; c < 4; ++c) { const LAS float* s = tile + (32 * cg + 8 * c) * 132 + n;
            v4u o; o.x = pk2(s[0 * 132], s[1 * 132]); o.y = pk2(s[2 * 132], s[3 * 132]); o.z = pk2(s[4 * 132], s[5 * 132]); o.w = pk2(s[6 * 132], s[7 * 132]);
            *(GAS v4u*)(T.WT + (size_t)nn * T.K + k0 + 32 * cg + 8 * c) = o; } }
}
__device__ __forceinline__ TItem p0_resolve(unsigned char* ws, int git) {
    const int l = git / TI_N; int r = git - l * TI_N; TItem T; T.mapq = 0; T.c0 = 0;
    const int which = r / TI_LR, d = which & 1, isa = which >> 1; r -= which * TI_LR;
    T.W = (isa ? karg(13) : karg(11)) + (size_t)(l * 2 + d) * 64 * RW; T.K = 64; T.ldw = RW; T.N = RW; T.WT = (bf16*)(ws + (isa ? WS_AUP : WS_WUP)) + (size_t)(l * 2 + d) * RW * 64; T.item = r; return T;
}
__device__ __forceinline__ void p0_prologue(Frame& F) {
    LAS float* scr = (LAS float*)(F.lds + F.wave * 16384);
    const int gw = F.vcu * NWAVES + F.wave, NGW = F.G * NWAVES;
    unsigned char* ws = F.ws;
    for (int rp_ = 0; rp_ < (DBG_REPEAT == 102 ? 2 : 1); ++rp_)
    { float* modw = (float*)(ws + WS_CTL + CTL_MOD_OFF); const float* adaw = karg(4); const float* adab = karg(5); const float* cin = karg(1); const float* cctx = karg(3);
      LAS float* SIL = (LAS float*)F.lds;
      LAS f32x2* part = (LAS f32x2*)(F.lds + 32768);
      if (F.vcu < NLAYER * 96) {
          for (int i = F.tid; i < 3 * DM; i += 512) { const int r = i >> 11, k = i & 2047; const float c = r < 2 ? cin[r * DM + k] : cctx[k]; SIL[i] = c / (1.f + __expf(-c)); }
          __syncthreads(); }
      for (int uu = F.vcu; uu < NLAYER * 96; uu += F.G) { const int cb = uu % 96, l = uu / 96;
          const int n0 = cb * 128 + F.lane * 2; const float* aw = adaw + (size_t)l * DM * 12288 + n0;
          f32x2 a0 = {0, 0}, a1 = a0, a2 = a0;
#pragma unroll 1
          for (int k0 = F.wave * 256; k0 < F.wave * 256 + 256; k0 += 16) { f32x2 w[16];
#pragma unroll
              for (int j = 0; j < 16; ++j) w[j] = *(const GAS f32x2*)(aw + (size_t)(k0 + j) * 12288);
#pragma unroll
              for (int j = 0; j < 16; ++j) { a0 = a0 + w[j] * SIL[k0 + j]; a1 = a1 + w[j] * SIL[DM + k0 + j]; a2 = a2 + w[j] * SIL[2 * DM + k0 + j]; } }
          __syncthreads();
          part[(F.wave * 3 + 0) * 64 + F.lane] = a0; part[(F.wave * 3 + 1) * 64 + F.lane] = a1; part[(F.wave * 3 + 2) * 64 + F.lane] = a2;
          __syncthreads();
          if (F.wave < 3) { f32x2 s = *(const GAS f32x2*)(adab + (size_t)l * 12288 + n0);
#pragma unroll
              for (int w8 = 0; w8 < 8; ++w8) s = s + part[(w8 * 3 + F.wave) * 64 + F.lane];
              *(GAS f32x2*)(modw + ((size_t)l * 3 + F.wave) * 12288 + n0) = s; }
          __syncthreads(); } }
    for (int rp_ = 0; rp_ < (DBG_REPEAT == 101 ? 2 : 1); ++rp_)
    { unsigned* ctr = (unsigned*)(ws + WS_CTL) + 2048 + 64 * rp_; LAS float* tile = (LAS float*)F.lds; LAS int* slot = (LAS int*)(F.lds + 128 * 132 * 4);
#define P0_GRAB(dst) do { __syncthreads(); if (F.tid == 0) *slot = (int)__hip_atomic_fetch_add(ctr, 1u, __ATOMIC_RELAXED, __HIP_MEMORY_SCOPE_AGENT); __syncthreads(); dst = *slot; } while (0)
      int it; P0_GRAB(it); f32x4 xa[8], xb[8]; TItem T, Tn;
      if (it < NLAYER * TB_N) { T = p0_resolve_big(ws, it); p0_big_load(T, F.tid, xa); }
      while (it < NLAYER * TB_N) { int itn; P0_GRAB(itn); const bool more = itn < NLAYER * TB_N;
          if (more) { Tn = p0_resolve_big(ws, itn); p0_big_load(Tn, F.tid, xb); }
          p0_big_finish(T, xa, tile, F.tid);
          if (more) { T = Tn;
#pragma unroll
              for (int i = 0; i < 8; ++i) xa[i] = xb[i]; }
          it = itn; }
#undef P0_GRAB
      __syncthreads();
      for (int itw = gw; itw < NLAYER * TI_N; itw += NGW) { f32x4 xw[8]; const TItem Tw = p0_resolve(ws, itw); p0_item_load(Tw, F.lane, xw); p0_item_finish(Tw, xw, scr, F.lane); }
    }
    const int gt = gw * 64 + F.lane, NGT = NGW * 64;
    { const float* gup = karg(14);
    for (int i = gt; i < NLAYER * 2 * 32 * RW; i += NGT) { const int ch = i & 1023, r = (i >> 10) & 31, ld = i >> 15;
        ((bf16*)(ws + WS_GUP))[((size_t)ld * RW + ch) * 32 + r] = (bf16)f2bf(gup[i]); } }
    for (int i = gt; i < NLAYER * (INA_P - INA) * DM / 8; i += NGT) { const int l = i / ((INA_P - INA) * DM / 8), r = i - l * ((INA_P - INA) * DM / 8);
        ((GAS v4u*)((bf16*)(ws + WS_WINA) + ((size_t)l * INA_P + INA) * DM))[r] = (v4u){0u, 0u, 0u, 0u}; }
    { f32x2* rt = (f32x2*)(ws + WS_ROPE);
      for (int i = gt; i < TPB * 16; i += NGT) { const int tp = i >> 4, k = i & 15; f32x2 o = {1.f, 0.f};
          if (tp >= CTXL) { const int t = tp - CTXL, row = t >> 6, col = t & 63, j = k & 7; const float fr = powf(10000.0f, -(float)j / 8.0f);
              const float ang = (float)(k < 8 ? row : col) * fr; o.x = cosf(ang); o.y = sinf(ang); }
          rt[i] = o; } }
    for (int rp_ = 0; rp_ < (DBG_REPEAT == 103 ? 2 : 1); ++rp_)
    { LAS float* KEY = (LAS float*)F.lds;
      LAS float* WQT = (LAS float*)(F.lds + 65536);
      const float* pkeys = karg(29); const float* pwq = karg(28);
      __syncthreads();
      for (int uu = F.vcu; uu < NLAYER * 16 * 32; uu += F.G) { const int kb = uu & 31, hp = (uu >> 5) & 15, l = uu >> 9;
          const GAS f32x4* ksrc = (const GAS f32x4*)(pkeys + ((size_t)l * 16 + hp) * 16384);
          for (int i = F.tid; i < 4096; i += 512) ((LAS f32x4*)KEY)[i] = ksrc[i];
          for (int i = F.tid; i < 2048; i += 512) { const int kk = i >> 5, d4 = i & 31;
              *(LAS f32x4*)(WQT + kk * 132 + d4 * 4) = *(const GAS f32x4*)(pwq + ((size_t)l * DM + kb * 64 + kk) * DM + hp * 128 + d4 * 4); }
          __syncthreads();
          const int kq = F.tid & 15, keyq = F.tid >> 4;
          float acc[4][4];
#pragma unroll
          for (int j = 0; j < 4; ++j)
#pragma unroll
              for (int i = 0; i < 4; ++i) acc[j][i] = 0.f;
          for (int d = 0; d < 128; d += 4) { f32x4 w[4], q[4];
#pragma unroll
              for (int i = 0; i < 4; ++i) w[i] = *(LAS f32x4*)(WQT + (kq + 16 * i) * 132 + d);
#pragma unroll
              for (int j = 0; j < 4; ++j) q[j] = *(LAS f32x4*)(KEY + (4 * keyq + j) * 128 + d);
#pragma unroll
              for (int j = 0; j < 4; ++j)
#pragma unroll
                  for (int i = 0; i < 4; ++i) acc[j][i] += q[j].x * w[i].x + q[j].y * w[i].y + q[j].z * w[i].z + q[j].w * w[i].w; }
          bf16* dst = (bf16*)(ws + WS_WQK) + ((size_t)l * DM + hp * 128 + 4 * keyq) * DM + kb * 64 + kq;
#pragma unroll
          for (int j = 0; j < 4; ++j)
#pragma unroll
              for (int i = 0; i < 4; ++i) dst[(size_t)j * DM + 16 * i] = (bf16)f2bf(acc[j][i]);
          __syncthreads(); } }
}

__device__ __forceinline__ void modnorm_phase(Frame& F, const float* X, const float* g, const float* mod  , int chunk_sh, bf16* H, int skip_ctx, const float* xin = nullptr, const float* cin = nullptr) {
    const int gw = F.vcu * NWAVES + F.wave, NGW = F.G * NWAVES;
    for (int m = gw; m < MALL; m += NGW) {
        const int b = m / TPB, tp = m - b * TPB; if (skip_ctx && tp < CTXL) continue;
        const int mr = tp < CTXL ? 2 : b;
        const float* srow = xin ? (tp < CTXL ? cin + ((size_t)b * CTXL + tp) * DM : xin + ((size_t)b * SEQ + (tp - CTXL)) * DM) : X + (size_t)m * DM;
        const GAS f32x4* xr = (const GAS f32x4*)srow + F.lane;
        f32x4 v[8]; float s = 0.f;
#pragma unroll
        for (int j = 0; j < 8; ++j) { v[j] = xr[64 * j]; s += (v[j].x * v[j].x + v[j].y * v[j].y) + (v[j].z * v[j].z + v[j].w * v[j].w); }
        const float rs = rsqrtf(wave_sum(s) * (1.f / DM) + NORM_EPS);
        const float* sh = mod + (size_t)mr * 12288 + chunk_sh * DM; const float* sc = sh + DM;
        GAS v2u* o8 = (GAS v2u*)(H + (size_t)m * DM) + F.lane;
#pragma unroll
        for (int j = 0; j < 8; ++j) { const int c = (F.lane + 64 * j) * 4;
            const f32x4 gg = *(const GAS f32x4*)(g + c), s1 = *(const GAS f32x4*)(sc + c), s0 = *(const GAS f32x4*)(sh + c);
            f32x4 y = v[j] * rs * gg; y = y * (s1 + 1.0f) + s0;
            v2u o; o.x = pk2(y.x, y.y); o.y = pk2(y.z, y.w); o8[64 * j] = o; }
    }
}

typedef float f32x4v __attribute__((ext_vector_type(4)));
#define MFMA16(a, b, c) __builtin_amdgcn_mfma_f32_16x16x32_bf16((a), (b), (c), 0, 0, 0)
#define MFMA32(a, b, c) __builtin_amdgcn_mfma_f32_32x32x16_bf16((a), (b), (c), 0, 0, 0)

struct FeatP {
    const bf16* PA; const float* mu; const float* w0; const float* a0; const float* k_k; const float* k_a; const float* r_k;
    const bf16* WUP; const bf16* AUP; const bf16* GUP;
    const float* qnorm; const float* kvnorm; const f32x2* rope;
    bf16* RI; bf16* GG; float* BON; bf16* QN; bf16* KVN; bf16* K;
};
__device__ __forceinline__ f32x4 ld4bf(const bf16* p) { const v2u w = *(const GAS v2u*)p; return (f32x4){bflo(w.x), bfhi(w.x), bflo(w.y), bfhi(w.y)}; }
__device__ __forceinline__ f32x4 mix4(const bf16* PA, int m, int c, bool hp, bool hn, const float* mu) {
    const f32x4 pc = ld4bf(PA + (size_t)m * INA_P + c);
    f32x4 pp = {0, 0, 0, 0}, pn = {0, 0, 0, 0};
    if (hp) pp = ld4bf(PA + (size_t)(m - 1) * INA_P + c);
    if (hn) pn = ld4bf(PA + (size_t)(m + 1) * INA_P + c);
    const f32x4 mm = *(const GAS f32x4*)(mu + c);
    return pc + ((pp + pn) * 0.5f - pc) * mm;
}
__device__ __forceinline__ void unpack8(const v4u w, float (&x)[8]) { x[0] = bflo(w.x); x[1] = bfhi(w.x); x[2] = bflo(w.y); x[3] = bfhi(w.y); x[4] = bflo(w.z); x[5] = bfhi(w.z); x[6] = bflo(w.w); x[7] = bfhi(w.w); }
__device__ __forceinline__ v4u pack8f(const float (&x)[8]) { v4u o; o.x = pk2(x[0], x[1]); o.y = pk2(x[2], x[3]); o.z = pk2(x[4], x[5]); o.w = pk2(x[6], x[7]); return o; }
__device__ __forceinline__ void mix8(const bf16* rowc, bool hp, bool hn, const float (&mu)[8], float (&o)[8]) {
    const v4u zc = {0u, 0u, 0u, 0u};
    const v4u wc = *(const GAS v4u*)rowc, wp = hp ? *(const GAS v4u*)(rowc - INA_P) : zc, wn = hn ? *(const GAS v4u*)(rowc + INA_P) : zc;
    float c[8], p[8], n[8]; unpack8(wc, c); unpack8(wp, p); unpack8(wn, n);
#pragma unroll
    for (int e = 0; e < 8; ++e) o[e] = c[e] + (0.5f * (p[e] + n[e]) - c[e]) * mu[e];
}
struct Raw3 { v4u c, p, n; };
__device__ __forceinline__ Raw3 load3(const bf16* rowc, bool hp, bool hn) { const v4u zc = {0u, 0u, 0u, 0u}; Raw3 r; r.c = *(const GAS v4u*)rowc; r.p = hp ? *(const GAS v4u*)(rowc - INA_P) : zc; r.n = hn ? *(const GAS v4u*)(rowc + INA_P) : zc; return r; }
__device__ __forceinline__ void mix8r(const Raw3& w, const float (&mu)[8], float (&o)[8]) {
    float c[8], p[8], n[8]; unpack8(w.c, c); unpack8(w.p, p); unpack8(w.n, n);
#pragma unroll
    for (int e = 0; e < 8; ++e) o[e] = c[e] + (0.5f * (p[e] + n[e]) - c[e]) * mu[e];
}
__device__ __forceinline__ void features_phase(Frame& F, const FeatP& P) {
    constexpr int LAP = 328;
    LAS bf16* LA = (LAS bf16*)F.lds;
    LAS float* SSQ = (LAS float*)(F.lds + 10752);
    LAS float* PRM = (LAS float*)(F.lds + 12288);
    const int lane = F.lane, w = F.wave, tk = lane & 15, q4 = lane >> 4;
    constexpr int NTILE = MALL / 16, NTG = 64;
    for (int su = F.vcu; su < 4 * NTG; su += F.G) {
        const int cg = su & 3, tg = su >> 2, cw = 256 * cg + 32 * w, ch8 = cw + 8 * q4, hd = 4 * cg + (w >> 1);
        __syncthreads();
        for (int i = F.tid; i < 2560; i += 512) { const int prm = i >> 8, c = (i & 255) + 256 * cg; float v;
            switch (prm) { case 0: v = P.k_k[c]; break; case 1: v = P.k_a[c]; break; case 2: v = P.r_k[c]; break; case 3: v = P.w0[c]; break; case 4: v = P.w0[RW + c]; break;
                           case 5: v = P.a0[c]; break; case 6: v = P.a0[RW + c]; break; case 7: v = P.mu[c]; break; case 8: v = P.mu[RW + c]; break; default: v = P.mu[2 * RW + c]; break; }
            PRM[i] = v; }
        bf16x8 fw[2][2][2], fa[2][2][2], fg[2][2];
        { const int chA = cw + 8 * (tk >> 2) + (tk & 3);
#pragma unroll
          for (int d = 0; d < 2; ++d)
#pragma unroll
              for (int t = 0; t < 2; ++t) {
#pragma unroll
                  for (int ks = 0; ks < 2; ++ks) { fw[d][t][ks] = *(const GAS bf16x8*)(P.WUP + ((size_t)d * RW + chA + 4 * t) * 64 + ks * 32 + q4 * 8); fa[d][t][ks] = *(const GAS bf16x8*)(P.AUP + ((size_t)d * RW + chA + 4 * t) * 64 + ks * 32 + q4 * 8); }
                  fg[d][t] = *(const GAS bf16x8*)(P.GUP + ((size_t)d * RW + chA + 4 * t) * 32 + q4 * 8); } }
        for (int tt = tg; tt < NTILE; tt += NTG) {
            const int m0 = tt * 16;
            const int m = m0 + tk, b = m / TPB, tp = m - b * TPB;
            const bool hp = (tp != 0) && (tp != CTXL), hn = (tp != CTXL - 1) && (tp != TPB - 1);
            const bf16* rowp = P.PA + (size_t)m * INA_P + ch8;
            const Raw3 rawk = load3(rowp + RW, hp, hn), rawr = load3(rowp, hp, hn), rawv = load3(rowp + 2 * RW, hp, hn);
            __syncthreads();
            for (int it = F.tid; it < 640; it += 512) { const int tkk = it / 40, c8 = (it - tkk * 40) * 8, c = C_WD + c8, m = m0 + tkk, tp = m % TPB;
                const bool hp = (tp != 0) && (tp != CTXL), hn = (tp != CTXL - 1) && (tp != TPB - 1);
                float mu[8], v[8];
                { const f32x4 a = *(const GAS f32x4*)(P.mu + c), b2 = *(const GAS f32x4*)(P.mu + c + 4); mu[0] = a.x; mu[1] = a.y; mu[2] = a.z; mu[3] = a.w; mu[4] = b2.x; mu[5] = b2.y; mu[6] = b2.z; mu[7] = b2.w; }
                mix8(P.PA + (size_t)m * INA_P + c, hp, hn, mu, v);
#pragma unroll
                for (int e = 0; e < 8; ++e) { if (c < C_AD) v[e] = 1.0f - 2.0f * __builtin_amdgcn_rcpf(1.0f + __expf(2.0f * v[e])); else if (c >= C_GD) v[e] = sigmoidf_(v[e]); }
                *(LAS v4u*)(LA + tkk * LAP + c8) = pack8f(v); }
            if ((tt & 3) == cg) {
#pragma unroll
                for (int t2 = 0; t2 < 2; ++t2) { const int m = m0 + 2 * w + t2, b = m / TPB, tp = m - b * TPB; const bf16* row = P.PA + (size_t)m * INA_P;
                    { float x[8]; unpack8(*(const GAS v4u*)(row + C_QC + lane * 8), x); float s = 0.f;
#pragma unroll
                      for (int e = 0; e < 8; ++e) s += x[e] * x[e];
                      const float rs = rsqrtf(wave_sum(s) * (1.f / 512.f) + NORM_EPS);
#pragma unroll
                      for (int e = 0; e < 8; ++e) x[e] = x[e] * rs * P.qnorm[lane * 8 + e];
                      *(GAS v4u*)(P.QN + (size_t)m * 512 + lane * 8) = pack8f(x); }
                    { const v2u q = *(const GAS v2u*)(row + C_KVC + lane * 4);
                      float x[4] = {bflo(q.x), bfhi(q.x), bflo(q.y), bfhi(q.y)}; float s = 0.f;
#pragma unroll
                      for (int e = 0; e < 4; ++e) s += x[e] * x[e];
                      const float rs = rsqrtf(wave_sum(s) * (1.f / 256.f) + NORM_EPS);
#pragma unroll
                      for (int e = 0; e < 4; ++e) x[e] = x[e] * rs * P.kvnorm[lane * 4 + e];
                      v2u o; o.x = pk2(x[0], x[1]); o.y = pk2(x[2], x[3]);
                      *(GAS v2u*)(P.KVN + (size_t)m * 256 + lane * 4) = o; }
                    if (lane < 16) { const float x1 = bf1(row[C_KR + lane]), x2 = bf1(row[C_KR + 16 + lane]); const f32x2 cs = P.rope[(size_t)tp * 16 + lane];
                        const unsigned o = pk2(x1 * cs.x - x2 * cs.y, x1 * cs.y + x2 * cs.x);
#pragma unroll
                        for (int h2 = 0; h2 < NH; ++h2) *(GAS unsigned*)(P.K + ((size_t)(b * NH + h2) * TPB + tp) * QKD + 64 + 2 * lane) = o; } } }
            const int pc = 32 * w + 8 * q4;
            float prm[8], kmx[8], kx[8];
#pragma unroll
            for (int e = 0; e < 8; ++e) prm[e] = PRM[8 * 256 + pc + e];
            mix8r(rawk, prm, kmx);
            { float s = 0.f;
#pragma unroll
              for (int e = 0; e < 8; ++e) { kx[e] = kmx[e] * PRM[0 * 256 + pc + e]; s += kx[e] * kx[e]; }
              s += bpermf(lane ^ 16, s); s += bpermf(lane ^ 32, s);
              if (q4 == 0) SSQ[tk * 8 + w] = s; }
            __syncthreads();
            const float rsn = rsqrtf(SSQ[tk * 8 + w] + SSQ[tk * 8 + (w ^ 1)] + 1e-12f);
            f32x4 cw_[2][2], ca_[2][2], cg_[2][2];
#pragma unroll
            for (int d = 0; d < 2; ++d) {
                const bf16x8 bg = *(const LAS bf16x8*)(LA + tk * LAP + 256 + d * 32 + q4 * 8);
                bf16x8 bw[2], ba[2];
#pragma unroll
                for (int ks = 0; ks < 2; ++ks) { bw[ks] = *(const LAS bf16x8*)(LA + tk * LAP + d * 64 + ks * 32 + q4 * 8); ba[ks] = *(const LAS bf16x8*)(LA + tk * LAP + 128 + d * 64 + ks * 32 + q4 * 8); }
#pragma unroll
                for (int t = 0; t < 2; ++t) { f32x4 z = {0, 0, 0, 0};
                    cw_[d][t] = MFMA16(fw[d][t][1], bw[1], MFMA16(fw[d][t][0], bw[0], z));
                    ca_[d][t] = MFMA16(fa[d][t][1], ba[1], MFMA16(fa[d][t][0], ba[0], z));
                    cg_[d][t] = MFMA16(fg[d][t], bg, z); } }
            float r8[8], v8[8], kk8[8];
#pragma unroll
            for (int e = 0; e < 8; ++e) prm[e] = PRM[7 * 256 + pc + e];
            mix8r(rawr, prm, r8);
#pragma unroll
            for (int e = 0; e < 8; ++e) prm[e] = PRM[9 * 256 + pc + e];
            mix8r(rawv, prm, v8);
#pragma unroll
            for (int e = 0; e < 8; ++e) kk8[e] = kx[e] * rsn;
            bf16* rec = P.RI + ((size_t)(b * NH + hd) * TPB + tp) * RREC + (ch8 & 63);
            *(GAS v4u*)(rec) = pack8f(r8); *(GAS v4u*)(rec + 64) = pack8f(kk8); *(GAS v4u*)(rec + 128) = pack8f(v8);
#pragma unroll
            for (int d = 0; d < 2; ++d) {
                float ld[8], ke[8], bb[8], gg[8]; float bs = 0.f;
#pragma unroll
                for (int e = 0; e < 8; ++e) { const int t = e >> 2, r = e & 3;
                    ld[e] = -0.60653066f * sigmoidf_(PRM[(3 + d) * 256 + pc + e] + cw_[d][t][r]);
                    const float aa = sigmoidf_(PRM[(5 + d) * 256 + pc + e] + ca_[d][t][r]);
                    ke[e] = kmx[e] * (1.0f + (aa - 1.0f) * PRM[1 * 256 + pc + e]); bb[e] = kk8[e] * aa; gg[e] = cg_[d][t][r];
                    bs += r8[e] * ke[e] * PRM[2 * 256 + pc + e]; }
                *(GAS v4u*)(rec + (3 + 3 * d) * 64) = pack8f(ld); *(GAS v4u*)(rec + (4 + 3 * d) * 64) = pack8f(bb); *(GAS v4u*)(rec + (5 + 3 * d) * 64) = pack8f(ke);
                *(GAS v4u*)(P.GG + ((size_t)d * MALL + m) * RW + ch8) = pack8f(gg);
                bs += bpermf(lane ^ 16, bs); bs += bpermf(lane ^ 32, bs);
                if (q4 == 0) P.BON[((size_t)d * MALL + m) * 32 + 2 * hd + (w & 1)] = bs; }
        }
    }
}

constexpr int SCH = 32;
constexpr int SSTEP = 6 * 64;
__device__ __forceinline__ int scan_tp(int dir, int s) { return dir == 0 ? s : (s < CTXL ? (CTXL - 1 - s) : (TPB - 1 - (s - CTXL))); }
__device__ __forceinline__ void scan_load(v4u (&rg)[6], const bf16* RIh, int dir, int chunk, int htid) {
    const int tp = scan_tp(dir, chunk * SCH + (htid >> 3));
    const bf16* rec = RIh + (size_t)tp * RREC + (htid & 7) * 8;
#pragma unroll
    for (int i = 0; i < 3; ++i) rg[i] = *(const GAS v4u*)(rec + i * 64);
    rec += (3 + 3 * dir) * 64;
#pragma unroll
    for (int i = 0; i < 3; ++i) rg[3 + i] = *(const GAS v4u*)(rec + i * 64);
}
__device__ __forceinline__ void scan_store(const v4u (&rg)[6], LAS float* buf, int htid) {
    LAS float* d0 = buf + (htid >> 3) * SSTEP + (htid & 7) * 8;
#pragma unroll
    for (int i = 0; i < 6; ++i) { constexpr int SLOT[6] = {4, 0, 5, 2, 1, 3};
        const v4u wv = rg[i];
        f32x4 lo = {bflo(wv.x), bfhi(wv.x), bflo(wv.y), bfhi(wv.y)}, hi = {bflo(wv.z), bfhi(wv.z), bflo(wv.w), bfhi(wv.w)};
        if (i == 3) {
#pragma unroll
            for (int e = 0; e < 4; ++e) { lo[e] = __expf(lo[e]); hi[e] = __expf(hi[e]); } }
        LAS float* d = d0 + SLOT[i] * 64;
        *(LAS f32x4*)d = lo; *(LAS f32x4*)(d + 4) = hi; }
}
__device__ __forceinline__ void scan_phase(Frame& F, const bf16* RI, bf16* Y) {
    LAS float* bufs = (LAS float*)F.lds;
    constexpr int NCH = TPB / SCH;
    for (int uu = F.vcu; uu < NBATCH * NH * 2 * 4; uu += F.G) {
        const int rg = uu & 3, dir = (uu >> 2) & 1, hd = (uu >> 3) & 15, b = uu >> 7;
        const bf16* RIh = RI + (size_t)(b * NH + hd) * TPB * RREC;
        const int htid = F.tid - 256;
        v4u ra[6], rb[6];
        __syncthreads();
        if (F.wave >= 4) { scan_load(rb, RIh, dir, 0, htid); scan_load(ra, RIh, dir, 1, htid); scan_store(rb, bufs, htid); scan_load(rb, RIh, dir, 2, htid); }
        __syncthreads();
        const int j = F.lane & 15, rowl = F.lane >> 4, row = rg * 16 + (F.wave & 3) * 4 + rowl;
        f32x2 S01 = {0.f, 0.f}, S23 = {0.f, 0.f};
        bf16* yb = Y + ((size_t)dir * MALL + (size_t)b * TPB) * RW + hd * 64 + row;
        for (int c = 0; c < NCH; ++c) {
            LAS float* cur = bufs + (c & 1) * (SCH * SSTEP);
            if (F.wave >= 4) {
                if (c + 1 < NCH) {
                    if ((c & 1) == 0) { scan_store(ra, bufs + (SCH * SSTEP), htid); if (c + 3 < NCH) scan_load(ra, RIh, dir, c + 3, htid); }
                    else { scan_store(rb, bufs, htid); if (c + 3 < NCH) scan_load(rb, RIh, dir, c + 3, htid); } } }
            else {
#pragma unroll
                for (int h16 = 0; h16 < 2; ++h16) {
                    const LAS float* sp = cur + (h16 * 16) * SSTEP;
                    f32x4 kk = *(const LAS f32x4*)(sp + 4 * j), bb = *(const LAS f32x4*)(sp + 64 + 4 * j), ww = *(const LAS f32x4*)(sp + 128 + 4 * j),
                          ke = *(const LAS f32x4*)(sp + 192 + 4 * j), rr = *(const LAS f32x4*)(sp + 256 + 4 * j);
                    float vv = sp[320 + row], ykeep = 0.f, ypart = 0.f;
#pragma unroll
                    for (int st = 0; st < 16; ++st) {
                        f32x4 nkk = kk, nbb = bb, nww = ww, nke = ke, nrr = rr; float nvv = vv;
                        if (st + 1 < 16) { const LAS float* sn = sp + (st + 1) * SSTEP;
                            nkk = *(const LAS f32x4*)(sn + 4 * j); nbb = *(const LAS f32x4*)(sn + 64 + 4 * j); nww = *(const LAS f32x4*)(sn + 128 + 4 * j);
                            nke = *(const LAS f32x4*)(sn + 192 + 4 * j); nrr = *(const LAS f32x4*)(sn + 256 + 4 * j); nvv = sn[320 + row]; }
                        f32x2 t2 = S01 * kk.xy; t2 = S23 * kk.zw + t2;
                        const float p = t2.x + t2.y;
                        S01 = S01 * ww.xy + ke.xy * vv; S23 = S23 * ww.zw + ke.zw * vv;
                        const float sa = -red16(p);
                        S01 = bb.xy * sa + S01; S23 = bb.zw * sa + S23;
                        if (st > 0) { const float y = red16(ypart); ykeep = (j == st - 1) ? y : ykeep; }
                        f32x2 u2 = S01 * rr.xy; u2 = S23 * rr.zw + u2;
                        ypart = u2.x + u2.y;
                        kk = nkk; bb = nbb; ww = nww; ke = nke; rr = nrr; vv = nvv;
                        __builtin_amdgcn_sched_barrier(0);
                    }
                    { const float y = red16(ypart); ykeep = (j == 15) ? y : ykeep; }
                    const int tp = scan_tp(dir, c * SCH + h16 * 16 + j);
                    *(GAS bf16*)(yb + (size_t)tp * RW) = (bf16)f2bf(ykeep);
                }
            }
            __syncthreads();
        }
    }
}

constexpr int AKP = 208, AVP = 192;
constexpr int ATILE = 64 * AKP + 64 * AVP;
__device__ __forceinline__ bf16x8 pack8(const f32x16& x, int s) {
    v4u p; p.x = pk2(x[8 * s + 0], x[8 * s + 1]); p.y = pk2(x[8 * s + 2], x[8 * s + 3]); p.z = pk2(x[8 * s + 4], x[8 * s + 5]); p.w = pk2(x[8 * s + 6], x[8 * s + 7]);
    return __builtin_bit_cast(bf16x8, p);
}
__device__ __forceinline__ void attn_phase(Frame& F, const bf16* Q, const bf16* K, const bf16* V, bf16* YB, int with_ctx) {
    const int lane = F.lane, half = lane >> 5, l31 = lane & 31, l16 = lane & 15, g1 = (lane >> 4) & 1;
    const int nunits = NBATCH * NH * 32 + (with_ctx ? NBATCH * NH : 0);
    for (int uu = F.vcu; uu < nunits; uu += F.G) {
        int bh, q0, nkt;
        if (uu < NBATCH * NH * 32) { bh = uu >> 5; q0 = CTXL + (uu & 31) * 256; nkt = TPB / 64; } else { bh = uu - NBATCH * NH * 32; q0 = 0; nkt = CTXL / 64; }
        const bf16* Kh = K + (size_t)bh * TPB * QKD; const bf16* Vh = V + (size_t)bh * TPB * 64; const bf16* Qh = Q + (size_t)bh * TPB * QKD;
        const int tq = q0 + F.wave * 32 + l31;
        bf16x8 qf[6];
#pragma unroll
        for (int ks = 0; ks < 6; ++ks) qf[ks] = *(const GAS bf16x8*)(Qh + (size_t)tq * QKD + 16 * ks + 8 * half);
        f32x16 o0, o1;
#pragma unroll
        for (int i = 0; i < 16; ++i) { o0[i] = 0.f; o1[i] = 0.f; }
        float m_run = -1e30f, l_run = 0.f;
        const int kc1 = F.tid + 512; const bool k1ok = kc1 < 768;
        const unsigned kd0 = (unsigned)((F.tid / 12) * AKP + (F.tid % 12) * 16), kd1 = (unsigned)((kc1 / 12) * AKP + (kc1 % 12) * 16), vd = (unsigned)(64 * AKP + (F.tid >> 3) * AVP + (F.tid & 7) * 16);
        v4u kr0, kr1 = {0, 0, 0, 0}, vr;
        kr0 = *(const GAS v4u*)(Kh + (size_t)F.tid * 8); if (k1ok) kr1 = *(const GAS v4u*)(Kh + (size_t)kc1 * 8); vr = *(const GAS v4u*)(Vh + (size_t)F.tid * 8);
        __syncthreads();
        *(LAS v4u*)(F.lds + kd0) = kr0; if (k1ok) *(LAS v4u*)(F.lds + kd1) = kr1; *(LAS v4u*)(F.lds + vd) = vr;
        __syncthreads();
        for (int kt = 0; kt < nkt; ++kt) {
            const bool more = kt + 1 < nkt;
            if (more) { const bf16* kn = Kh + (size_t)(kt + 1) * 64 * QKD; const bf16* vn = Vh + (size_t)(kt + 1) * 64 * 64;
                kr0 = *(const GAS v4u*)(kn + (size_t)F.tid * 8); if (k1ok) kr1 = *(const GAS v4u*)(kn + (size_t)kc1 * 8); vr = *(const GAS v4u*)(vn + (size_t)F.tid * 8); }
            LAS unsigned char* Kb = F.lds + (kt & 1) * ATILE; LAS unsigned char* Vb = Kb + 64 * AKP;
            f32x16 s0, s1;
#pragma unroll
            for (int i = 0; i < 16; ++i) { s0[i] = 0.f; s1[i] = 0.f; }
            { bf16x8 ka[6], kb2[6];
#pragma unroll
              for (int ks = 0; ks < 6; ++ks) { ka[ks] = *(const LAS bf16x8*)(Kb + l31 * AKP + (16 * ks + 8 * half) * 2); kb2[ks] = *(const LAS bf16x8*)(Kb + (32 + l31) * AKP + (16 * ks + 8 * half) * 2); }
#pragma unroll
              for (int ks = 0; ks < 6; ++ks) { s0 = MFMA32(ka[ks], qf[ks], s0); s1 = MFMA32(kb2[ks], qf[ks], s1); }
              __builtin_amdgcn_sched_group_barrier(0x100, 12, 0); __builtin_amdgcn_sched_group_barrier(0x8, 12, 0); }
            bf16x8 va[2][2][2];
#pragma unroll
            for (int t = 0; t < 2; ++t)
#pragma unroll
                for (int s = 0; s < 2; ++s) { const int kb = 32 * t + 16 * s + 4 * half + (l16 >> 2);
#pragma unroll
                    for (int dvt = 0; dvt < 2; ++dvt) { const LAS unsigned char* vp = Vb + kb * AVP + (32 * dvt + 16 * g1 + 4 * (l16 & 3)) * 2;
                        const s16x4 lo = __builtin_amdgcn_ds_read_tr16_b64_v4i16((LAS s16x4*)vp), hi = __builtin_amdgcn_ds_read_tr16_b64_v4i16((LAS s16x4*)(vp + 8 * AVP));
                        va[t][s][dvt] = __builtin_shufflevector(lo, hi, 0, 1, 2, 3, 4, 5, 6, 7); } }
            __builtin_amdgcn_sched_group_barrier(0x100, 16, 0);
            float mx = s0[0];
#pragma unroll
            for (int i = 1; i < 16; ++i) mx = fmaxf(mx, s0[i]);
#pragma unroll
            for (int i = 0; i < 16; ++i) mx = fmaxf(mx, s1[i]);
            mx = fmaxf(mx, bpermf(lane ^ 32, mx));
            if (__any(mx > m_run + 8.0f)) {
                const float m_new = fmaxf(m_run, mx), alpha = __builtin_amdgcn_exp2f(m_run - m_new); m_run = m_new;
                l_run *= alpha;
#pragma unroll
                for (int i = 0; i < 16; ++i) { o0[i] *= alpha; o1[i] *= alpha; }
            }
            float ps = 0.f;
#pragma unroll
            for (int i = 0; i < 16; ++i) { s0[i] = __builtin_amdgcn_exp2f(s0[i] - m_run); s1[i] = __builtin_amdgcn_exp2f(s1[i] - m_run); ps += s0[i] + s1[i]; }
            l_run += ps;
            { bf16x8 pf[2][2];
#pragma unroll
              for (int t = 0; t < 2; ++t)
#pragma unroll
                  for (int s = 0; s < 2; ++s) pf[t][s] = pack8(t == 0 ? s0 : s1, s);
#pragma unroll
              for (int t = 0; t < 2; ++t)
#pragma unroll
                  for (int s = 0; s < 2; ++s) { o0 = MFMA32(va[t][s][0], pf[t][s], o0); o1 = MFMA32(va[t][s][1], pf[t][s], o1); } }
            if (more) { LAS unsigned char* nb = F.lds + ((kt + 1) & 1) * ATILE;
                *(LAS v4u*)(nb + kd0) = kr0; if (k1ok) *(LAS v4u*)(nb + kd1) = kr1; *(LAS v4u*)(nb + vd) = vr; }
            __syncthreads();
        }
        const float linv = (DBG_SKIP & 4) ? 0.f : 1.0f / (l_run + bpermf(lane ^ 32, l_run));
        const int b = bh >> 4, hd = bh & 15;
        bf16* op = YB + ((size_t)b * TPB + tq) * RW + hd * 64 + 4 * half;
#pragma unroll
        for (int g = 0; g < 4; ++g) {
            v2u w; w.x = pk2(o0[4 * g] * linv, o0[4 * g + 1] * linv); w.y = pk2(o0[4 * g + 2] * linv, o0[4 * g + 3] * linv); *(GAS v2u*)(op + 8 * g) = w;
            w.x = pk2(o1[4 * g] * linv, o1[4 * g + 1] * linv); w.y = pk2(o1[4 * g + 2] * linv, o1[4 * g + 3] * linv); *(GAS v2u*)(op + 32 + 8 * g) = w; }
    }
}

__device__ __forceinline__ void readout_phase(Frame& F, const bf16* Y, const bf16* GG, const float* BON, const bf16* RI, const float* ln_w, const float* ln_b, bf16* YA) {
    const int gw = F.vcu * NWAVES + F.wave, NGW = F.G * NWAVES, lane = F.lane, hd = lane >> 2, ch0 = hd * 64 + (lane & 3) * 16;
    for (int m = gw; m < MALL; m += NGW) {
        const int b = m / TPB, tp = m - b * TPB;
        const bf16* rec = RI + ((size_t)(b * NH + hd) * TPB + tp) * RREC + 128 + (lane & 3) * 16;
        float vv[16], out[16];
        { const v4u a = *(const GAS v4u*)rec, c = *(const GAS v4u*)(rec + 8);
          vv[0] = bflo(a.x); vv[1] = bfhi(a.x); vv[2] = bflo(a.y); vv[3] = bfhi(a.y); vv[4] = bflo(a.z); vv[5] = bfhi(a.z); vv[6] = bflo(a.w); vv[7] = bfhi(a.w);
          vv[8] = bflo(c.x); vv[9] = bfhi(c.x); vv[10] = bflo(c.y); vv[11] = bfhi(c.y); vv[12] = bflo(c.z); vv[13] = bfhi(c.z); vv[14] = bflo(c.w); vv[15] = bfhi(c.w); }
#pragma unroll
        for (int e = 0; e < 16; ++e) out[e] = 0.f;
#pragma unroll
        for (int d = 0; d < 2; ++d) {
            const bf16* yp = Y + ((size_t)d * MALL + m) * RW + ch0; const bf16* gp = GG + ((size_t)d * MALL + m) * RW + ch0;
            float y[16], g[16];
            { const v4u a = *(const GAS v4u*)yp, c = *(const GAS v4u*)(yp + 8);
              y[0] = bflo(a.x); y[1] = bfhi(a.x); y[2] = bflo(a.y); y[3] = bfhi(a.y); y[4] = bflo(a.z); y[5] = bfhi(a.z); y[6] = bflo(a.w); y[7] = bfhi(a.w);
              y[8] = bflo(c.x); y[9] = bfhi(c.x); y[10] = bflo(c.y); y[11] = bfhi(c.y); y[12] = bflo(c.z); y[13] = bfhi(c.z); y[14] = bflo(c.w); y[15] = bfhi(c.w); }
            { const v4u a = *(const GAS v4u*)gp, c = *(const GAS v4u*)(gp + 8);
              g[0] = bflo(a.x); g[1] = bfhi(a.x); g[2] = bflo(a.y); g[3] = bfhi(a.y); g[4] = bflo(a.z); g[5] = bfhi(a.z); g[6] = bflo(a.w); g[7] = bfhi(a.w);
              g[8] = bflo(c.x); g[9] = bfhi(c.x); g[10] = bflo(c.y); g[11] = bfhi(c.y); g[12] = bflo(c.z); g[13] = bfhi(c.z); g[14] = bflo(c.w); g[15] = bfhi(c.w); }
            float s = 0.f;
#pragma unroll
            for (int e = 0; e < 16; ++e) s += y[e];
            s = dpp_add<0xB1>(s); s = dpp_add<0x4E>(s);
            const float mean = s * (1.f / 64.f); float q = 0.f;
#pragma unroll
            for (int e = 0; e < 16; ++e) { y[e] -= mean; q += y[e] * y[e]; }
            q = dpp_add<0xB1>(q); q = dpp_add<0x4E>(q);
            const float rstd = rsqrtf(q * (1.f / 64.f) + 64e-5f), bon = BON[((size_t)d * MALL + m) * 32 + 2 * hd] + BON[((size_t)d * MALL + m) * 32 + 2 * hd + 1];
#pragma unroll
            for (int e = 0; e < 16; ++e) out[e] += (y[e] * rstd * ln_w[ch0 + e] + ln_b[ch0 + e] + bon * vv[e]) * g[e];
        }
        if (DBG_SKIP & 2) {
#pragma unroll
            for (int e = 0; e < 16; ++e) out[e] = 0.f; }
        v4u o0, o1;
        o0.x = pk2(out[0], out[1]); o0.y = pk2(out[2], out[3]); o0.z = pk2(out[4], out[5]); o0.w = pk2(out[6], out[7]);
        o1.x = pk2(out[8], out[9]); o1.y = pk2(out[10], out[11]); o1.z = pk2(out[12], out[13]); o1.w = pk2(out[14], out[15]);
        *(GAS v4u*)(YA + (size_t)m * RW + ch0) = o0; *(GAS v4u*)(YA + (size_t)m * RW + ch0 + 8) = o1;
    }
}

__device__ __forceinline__ unsigned f2key(float f) { const unsigned u = __builtin_bit_cast(unsigned, f); return (u & 0x80000000u) ? ~u : (u | 0x80000000u); }
__device__ __forceinline__ float key2f(unsigned k) { const unsigned u = (k & 0x80000000u) ? (k & 0x7fffffffu) : ~k; return __builtin_bit_cast(float, u); }
template <int CTRL, int RM> __device__ __forceinline__ unsigned dpp_umax(unsigned x) {
    const unsigned y = (unsigned)__builtin_amdgcn_update_dpp(0, (int)x, CTRL, RM, 0xf, false); return x > y ? x : y; }
__device__ __forceinline__ void half_max(unsigned x, unsigned& m0, unsigned& m1) {
    x = dpp_umax<0xB1, 0xf>(x); x = dpp_umax<0x4E, 0xf>(x); x = dpp_umax<0x141, 0xf>(x); x = dpp_umax<0x140, 0xf>(x); x = dpp_umax<0x142, 0xa>(x);
    m0 = (unsigned)__builtin_amdgcn_readlane((int)x, 31); m1 = (unsigned)__builtin_amdgcn_readlane((int)x, 63);
}
__device__ __forceinline__ unsigned top16_lists(const float* sh  , int lane) {
    const int half = lane >> 5, l5 = lane & 31;
    unsigned k0, k1, k2, k3, rec = 0u;
    { const float* p = sh + half * 128 + l5;
      k0 = (f2key(p[0]) & ~127u) | (unsigned)l5; k1 = (f2key(p[32]) & ~127u) | (unsigned)(l5 + 32); k2 = (f2key(p[64]) & ~127u) | (unsigned)(l5 + 64); k3 = (f2key(p[96]) & ~127u) | (unsigned)(l5 + 96); }
#pragma unroll 4
    for (int it = 0; it < 16; ++it) {
        unsigned a = k0 > k1 ? k0 : k1, b = k2 > k3 ? k2 : k3; a = a > b ? a : b;
        unsigned m0, m1; half_max(a, m0, m1);
        const unsigned mh = half ? m1 : m0;
        k0 = (k0 == mh) ? 0u : k0; k1 = (k1 == mh) ? 0u : k1; k2 = (k2 == mh) ? 0u : k2; k3 = (k3 == mh) ? 0u : k3;
        rec = (l5 == it) ? mh : rec;
    }
    return rec;
}
struct SelP { const float* SC; int* ESEL; float* EGATE; const float* pu; const float* pv; unsigned char* PU8; unsigned char* PV8; float* SU; float* SV; int last; };
__device__ __forceinline__ void cvt_row_load(f32x4 (&x)[8], const float* src) {
#pragma unroll
    for (int q = 0; q < 8; ++q) x[q] = *(const GAS f32x4*)(src + q * 4);
}
__device__ __forceinline__ void cvt_row_store(const f32x4 (&x)[8], unsigned char* dst, float* scale_slot, int lane) {
    float am = 0.f;
#pragma unroll
    for (int q = 0; q < 8; ++q) am = fmaxf(am, fmaxf(fmaxf(fabsf(x[q].x), fabsf(x[q].y)), fmaxf(fabsf(x[q].z), fabsf(x[q].w))));
    am = fmaxf(wave_max_u(am), 1e-30f);
    const float g = 6.0f / am, inv = am * (1.0f / 6.0f);
    v4u o;
#pragma unroll
    for (int q = 0; q < 4; ++q) { unsigned w = 0u;
        w = __builtin_amdgcn_cvt_scalef32_pk_fp4_f32(w, x[2 * q].x * g, x[2 * q].y * g, 1.0f, 0);
        w = __builtin_amdgcn_cvt_scalef32_pk_fp4_f32(w, x[2 * q].z * g, x[2 * q].w * g, 1.0f, 1);
        w = __builtin_amdgcn_cvt_scalef32_pk_fp4_f32(w, x[2 * q + 1].x * g, x[2 * q + 1].y * g, 1.0f, 2);
        w = __builtin_amdgcn_cvt_scalef32_pk_fp4_f32(w, x[2 * q + 1].z * g, x[2 * q + 1].w * g, 1.0f, 3);
        o[q] = w; }
    *(GAS v4u*)dst = o;
    if (lane == 0) *scale_slot = inv;
}
__device__ __forceinline__ void select_phase(Frame& F, const SelP& P) {
    const int gw = F.vcu * NWAVES + F.wave, NGW = F.G * NWAVES, lane = F.lane, half = lane >> 5, l5 = lane & 31;
    int crow = gw;
    for (int m = gw; m < MALL || crow < 2 * NEXP; m += NGW) {
        f32x4 xa[8], xb[8];
        const int r0 = crow, r1 = crow + NGW; const bool c0 = r0 < 2 * NEXP, c1 = r1 < 2 * NEXP; crow += 2 * NGW;
        if (c0) cvt_row_load(xa, ((r0 >= NEXP) ? P.pv + (size_t)(r0 - NEXP) * DM : P.pu + (size_t)r0 * DM) + lane * 32);
        if (c1) cvt_row_load(xb, ((r1 >= NEXP) ? P.pv + (size_t)(r1 - NEXP) * DM : P.pu + (size_t)r1 * DM) + lane * 32);
        bool tok = m < MALL; int tp = 0; if (tok) { tp = m % TPB; if (P.last && tp < CTXL) tok = false; }
        if (tok) {
            const float* srow = P.SC + (size_t)m * DM;
#pragma unroll 1
            for (int hp = 0; hp < 4; ++hp) {
                const unsigned recA = top16_lists(srow + (2 * hp) * 256, lane), recB = top16_lists(srow + (2 * hp + 1) * 256, lane);
                const float vA = key2f(recA & ~127u), vB = key2f(recB & ~127u);
                const float v1a = bpermf(l5 & 15, vA), v1b = bpermf(l5 & 15, vB); const float v1 = half ? v1b : v1a;
                unsigned ck[8];
#pragma unroll
                for (int e = 0; e < 8; ++e) { const int src = 32 + 8 * (l5 >> 4) + e; const float v2a = bpermf(src, vA), v2b = bpermf(src, vB);
                    ck[e] = (f2key(v1 + (half ? v2b : v2a)) & ~255u) | (unsigned)(l5 | (e << 5)); }
                unsigned rec = 0u;
#pragma unroll 2
                for (int it = 0; it < 16; ++it) {
                    unsigned a = ck[0] > ck[1] ? ck[0] : ck[1], b = ck[2] > ck[3] ? ck[2] : ck[3], c = ck[4] > ck[5] ? ck[4] : ck[5], d = ck[6] > ck[7] ? ck[6] : ck[7];
                    a = a > b ? a : b; c = c > d ? c : d; a = a > c ? a : c;
                    unsigned m0, m1; half_max(a, m0, m1);
                    const unsigned mh = half ? m1 : m0;
#pragma unroll
                    for (int e = 0; e < 8; ++e) ck[e] = (ck[e] == mh) ? 0u : ck[e];
                    rec = (l5 == it) ? mh : rec;
                }
                const float ts = key2f(rec & ~255u), tmax = half ? bpermf(32, ts) : bpermf(0, ts);
                float ev = (l5 < 16) ? __expf(ts - tmax) : 0.f;
                const float esum = red16(ev);
                const int cid = (int)(rec & 255u), ci = cid & 15, cj = ((cid >> 4) & 1) * 8 + (cid >> 5);
                const int i1a = bpermi(ci, (int)(recA & 127u)), i1b = bpermi(ci, (int)(recB & 127u)), i2a = bpermi(32 + cj, (int)(recA & 127u)), i2b = bpermi(32 + cj, (int)(recB & 127u));
                const int expert = (half ? i1b : i1a) * 128 + (half ? i2b : i2a);
                if (l5 < 16) { const int slot = (2 * hp + half) * 16 + l5; P.ESEL[(size_t)m * 128 + slot] = expert; P.EGATE[(size_t)m * 128 + slot] = ev / esum; }
            }
        }
        if (c0) cvt_row_store(xa, ((r0 >= NEXP) ? P.PV8 + (size_t)(r0 - NEXP) * (DM / 2) : P.PU8 + (size_t)r0 * (DM / 2)) + lane * 16, (r0 >= NEXP) ? P.SV + (r0 - NEXP) : P.SU + r0, lane);
        if (c1) cvt_row_store(xb, ((r1 >= NEXP) ? P.PV8 + (size_t)(r1 - NEXP) * (DM / 2) : P.PU8 + (size_t)r1 * (DM / 2)) + lane * 16, (r1 >= NEXP) ? P.SV + (r1 - NEXP) : P.SU + r1, lane);
    }
}
struct PeerP { const float* nmod; const float* ng; bf16* Hout;   const int* ESEL; const float* EGATE; const bf16* H; const unsigned char* PU; const unsigned char* PV; const float* SU; const float* SV; float* X; const float* mod;   const float* fin_g; float* out; int last; };
__device__ __forceinline__ void peer_phase(Frame& F, const PeerP& P) {
    const int gw = F.vcu * NWAVES + F.wave, NGW = F.G * NWAVES, lane = F.lane;
    float pr_s2 = 0.f, pr_d2 = 0.f, pr_tg = 0.f, pr_n = 0.f;
    for (int m = gw; m < MALL; m += NGW) {
        const int b = m / TPB, tp = m - b * TPB; if (P.last && tp < CTXL) continue;
        const int mr = tp < CTXL ? 2 : b;
        const int eidx[2] = {P.ESEL[(size_t)m * 128 + lane], P.ESEL[(size_t)m * 128 + 64 + lane]}; const float egate[2] = {P.EGATE[(size_t)m * 128 + lane], P.EGATE[(size_t)m * 128 + 64 + lane]};
        typedef int v8i __attribute__((ext_vector_type(8)));
        LAS unsigned char* hq = F.lds + F.wave * 4096;
        { const v4u a0 = *(const GAS v4u*)(P.H + (size_t)m * DM + lane * 32), a1 = *(const GAS v4u*)(P.H + (size_t)m * DM + lane * 32 + 8), a2 = *(const GAS v4u*)(P.H + (size_t)m * DM + lane * 32 + 16), a3 = *(const GAS v4u*)(P.H + (size_t)m * DM + lane * 32 + 24);
          const v4u hv[4] = {a0, a1, a2, a3}; v4u o[2];
#pragma unroll
          for (int j = 0; j < 4; ++j) { int w0 = 0, w1 = 0;
              w0 = __builtin_amdgcn_cvt_pk_fp8_f32(bflo(hv[j].x), bfhi(hv[j].x), w0, false); w0 = __builtin_amdgcn_cvt_pk_fp8_f32(bflo(hv[j].y), bfhi(hv[j].y), w0, true);
              w1 = __builtin_amdgcn_cvt_pk_fp8_f32(bflo(hv[j].z), bfhi(hv[j].z), w1, false); w1 = __builtin_amdgcn_cvt_pk_fp8_f32(bflo(hv[j].w), bfhi(hv[j].w), w1, true);
              o[j >> 1][2 * (j & 1)] = (unsigned)w0; o[j >> 1][2 * (j & 1) + 1] = (unsigned)w1; }
          *(LAS v4u*)(hq + lane * 32) = o[0]; *(LAS v4u*)(hq + lane * 32 + 16) = o[1];
          unsigned z_ = 0u; asm volatile("" : "+v"(z_));
          if (lane < 2) *(LAS v4u*)(hq + 2048 + lane * 16) = (v4u){z_, z_, z_, z_}; }
        const int li = lane & 15, kb = lane >> 4;
        int rowoff[8];
#pragma unroll
        for (int g = 0; g < 8; ++g) rowoff[g] = bpermi(16 * (g & 3) + li, eidx[g >> 2]) * (DM / 2) + 16 * kb;
        f32x4 dacc[8];
#pragma unroll
        for (int g = 0; g < 8; ++g) dacc[g] = (f32x4){0.f, 0.f, 0.f, 0.f};
        const unsigned hb = (li == 0) ? (unsigned)(16 * kb) : 2048u;
        const unsigned hb2 = (li == 0) ? 64u : 16u;
        const unsigned hstep = (li == 0) ? 128u : 0u;
        v4u ua[8], ub[8];
#pragma unroll
        for (int g = 0; g < 8; ++g) ua[g] = *(const GAS v4u*)(P.PU + (unsigned)rowoff[g]);
#pragma unroll 1
        for (int s = 0; s < 16; s += 2) {
#pragma unroll
            for (int g = 0; g < 8; ++g) ub[g] = *(const GAS v4u*)(P.PU + (unsigned)(rowoff[g] + 64 * (s + 1)));
            { const v4u b0 = *(const LAS v4u*)(hq + hb + hstep * s), b1 = *(const LAS v4u*)(hq + hb + hstep * s + hb2);
              const v8i bf = {(int)b0.x, (int)b0.y, (int)b0.z, (int)b0.w, (int)b1.x, (int)b1.y, (int)b1.z, (int)b1.w};
#pragma unroll
              for (int g = 0; g < 8; ++g) { const v8i af = {(int)ua[g].x, (int)ua[g].y, (int)ua[g].z, (int)ua[g].w, 0, 0, 0, 0};
                  dacc[g] = __builtin_amdgcn_mfma_scale_f32_16x16x128_f8f6f4(af, bf, dacc[g], 4, 0, 0, 0x7f7f7f7f, 0, 0x7f7f7f7f); } }
            if (s + 2 < 16) {
#pragma unroll
                for (int g = 0; g < 8; ++g) ua[g] = *(const GAS v4u*)(P.PU + (unsigned)(rowoff[g] + 64 * (s + 2))); }
            { const v4u b0 = *(const LAS v4u*)(hq + hb + hstep * (s + 1)), b1 = *(const LAS v4u*)(hq + hb + hstep * (s + 1) + hb2);
              const v8i bf = {(int)b0.x, (int)b0.y, (int)b0.z, (int)b0.w, (int)b1.x, (int)b1.y, (int)b1.z, (int)b1.w};
#pragma unroll
              for (int g = 0; g < 8; ++g) { const v8i af = {(int)ub[g].x, (int)ub[g].y, (int)ub[g].z, (int)ub[g].w, 0, 0, 0, 0};
                  dacc[g] = __builtin_amdgcn_mfma_scale_f32_16x16x128_f8f6f4(af, bf, dacc[g], 4, 0, 0, 0x7f7f7f7f, 0, 0x7f7f7f7f); } }
        }
        float coef[2];
#pragma unroll
        for (int sl = 0; sl < 2; ++sl) { float mydot = 0.f;
#pragma unroll
            for (int g4 = 0; g4 < 4; ++g4)
#pragma unroll
                for (int r = 0; r < 4; ++r) { const float t = bpermf(16 * ((lane >> 2) & 3), dacc[4 * sl + g4][r]); if ((lane >> 4) == g4 && (lane & 3) == r) mydot = t; }
            mydot *= P.SU[eidx[sl]];
            if (DBG_PROBE == 4) {
                float ref = 0.f;
                for (int e = 0; e < 64; ++e) { const int ex = __builtin_amdgcn_readlane(eidx[sl], e); const v4u uu = *(const GAS v4u*)(P.PU + (size_t)ex * (DM / 2) + lane * 16); float s1 = 0.f;
                    const v4u hv2[4] = {*(const GAS v4u*)(P.H + (size_t)m * DM + lane * 32), *(const GAS v4u*)(P.H + (size_t)m * DM + lane * 32 + 8), *(const GAS v4u*)(P.H + (size_t)m * DM + lane * 32 + 16), *(const GAS v4u*)(P.H + (size_t)m * DM + lane * 32 + 24)};
#pragma unroll
                    for (int d = 0; d < 4; ++d) { const unsigned w = uu[d]; const unsigned hw[4] = {hv2[d].x, hv2[d].y, hv2[d].z, hv2[d].w};
                        f32x2 x = __builtin_amdgcn_cvt_scalef32_pk_f32_fp4(w, 1.0f, 0); s1 += x.x * bflo(hw[0]) + x.y * bfhi(hw[0]); x = __builtin_amdgcn_cvt_scalef32_pk_f32_fp4(w, 1.0f, 1); s1 += x.x * bflo(hw[1]) + x.y * bfhi(hw[1]);
                        x = __builtin_amdgcn_cvt_scalef32_pk_f32_fp4(w, 1.0f, 2); s1 += x.x * bflo(hw[2]) + x.y * bfhi(hw[2]); x = __builtin_amdgcn_cvt_scalef32_pk_f32_fp4(w, 1.0f, 3); s1 += x.x * bflo(hw[3]) + x.y * bfhi(hw[3]); }
                    const float tot = wave_sum_u(s1) * P.SU[ex]; if (lane == e) ref = tot; }
                pr_s2 = fmaxf(pr_s2, wave_max_u(fabsf(mydot - ref) / (fabsf(ref) + 0.25f))); pr_n = 1.f; }
            coef[sl] = egate[sl] * 0.5f * mydot * (1.0f + erff(mydot * 0.70710678f));
            if ((DBG_SKIP & 16) && sl == 0) coef[sl] = 0.f;
            if ((DBG_SKIP & 32) && sl == 1) coef[sl] = 0.f;
        }
        f32x2 acc2[16];
#pragma unroll
        for (int i = 0; i < 16; ++i) acc2[i] = (f32x2){0.f, 0.f};
#define PEER_LOADV(U, C, sl_, e0_) do { _Pragma("unroll") for (int q = 0; q < 8; ++q) { const int ex = __builtin_amdgcn_readlane(eidx[sl_], (e0_) + q); U[q] = *(const GAS v4u*)(P.PV + (size_t)ex * (DM / 2) + lane * 16); \
            C[q] = __builtin_bit_cast(float, __builtin_amdgcn_readlane(__builtin_bit_cast(int, coef[sl_]), (e0_) + q)) * P.SV[ex]; } } while (0)
#define PEER_AXPY(U, C) do { _Pragma("unroll") for (int q = 0; q < 8; ++q) _Pragma("unroll") for (int d = 0; d < 4; ++d) { const unsigned w = U[q][d]; \
            acc2[4 * d + 0] = __builtin_amdgcn_cvt_scalef32_pk_f32_fp4(w, 1.0f, 0) * C[q] + acc2[4 * d + 0]; acc2[4 * d + 1] = __builtin_amdgcn_cvt_scalef32_pk_f32_fp4(w, 1.0f, 1) * C[q] + acc2[4 * d + 1]; \
            acc2[4 * d + 2] = __builtin_amdgcn_cvt_scalef32_pk_f32_fp4(w, 1.0f, 2) * C[q] + acc2[4 * d + 2]; acc2[4 * d + 3] = __builtin_amdgcn_cvt_scalef32_pk_f32_fp4(w, 1.0f, 3) * C[q] + acc2[4 * d + 3]; } } while (0)
#pragma unroll
        for (int sl = 0; sl < 2; ++sl) {
            v4u ua[8], ub[8]; float ca[8], cb[8];
            PEER_LOADV(ua, ca, sl, 0);
#pragma unroll 1
            for (int e0 = 0; e0 < 64; e0 += 16) {
                PEER_LOADV(ub, cb, sl, e0 + 8);
                PEER_AXPY(ua, ca);
                if (e0 + 16 < 64) PEER_LOADV(ua, ca, sl, e0 + 16);
                PEER_AXPY(ub, cb);
            }
        }
#undef PEER_LOADV
#undef PEER_AXPY
        float acc[32];
#pragma unroll
        for (int i = 0; i < 16; ++i) { acc[2 * i] = acc2[i].x; acc[2 * i + 1] = acc2[i].y; }
        if (DBG_SKIP & 1) {
#pragma unroll
            for (int i = 0; i < 32; ++i) acc[i] = 0.f; }
        if (((DBG_SKIP & 64) && !P.last) || ((DBG_SKIP & 128) && P.last)) {
#pragma unroll
            for (int i = 0; i < 32; ++i) acc[i] = 0.f; }
        if (DBG_SKIP & 8) {
#pragma unroll
            for (int i = 0; i < 32; ++i) acc[i] = -acc[i]; }
        float* xr = P.X + (size_t)m * DM; const float* g2 = P.mod + (size_t)mr * 12288 + 5 * DM;
        float ss = 0.f;
#pragma unroll
        for (int hq = 0; hq < 8; ++hq) { const int c = lane * 32 + hq * 4;
            f32x4 xv = *(const GAS f32x4*)(xr + c); const f32x4 gv = *(const GAS f32x4*)(g2 + c);
#pragma unroll
            for (int e = 0; e < 4; ++e) { xv[e] += gv[e] * acc[4 * hq + e]; ss += xv[e] * xv[e]; acc[4 * hq + e] = xv[e]; }
            if (!P.last) *(GAS f32x4*)(xr + c) = xv; }
        if (!P.last) {
            const float rs = rsqrtf(wave_sum(ss) * (1.f / DM) + NORM_EPS); const float* sh = P.nmod + (size_t)mr * 12288; const float* sc = sh + DM;
#pragma unroll
            for (int hq = 0; hq < 4; ++hq) { const int c = lane * 32 + hq * 8; float y[8];
#pragma unroll
                for (int e = 0; e < 8; ++e) y[e] = acc[8 * hq + e] * rs * P.ng[c + e] * (1.0f + sc[c + e]) + sh[c + e];
                *(GAS v4u*)(P.Hout + (size_t)m * DM + c) = pack8f(y); } }
        if (P.last) { const float rs = rsqrtf(wave_sum(ss) * (1.f / DM) + NORM_EPS); float* orow = P.out + ((size_t)b * SEQ + (tp - CTXL)) * DM;
#pragma unroll
            for (int hq = 0; hq < 8; ++hq) { const int c = lane * 32 + hq * 4; const f32x4 fg = *(const GAS f32x4*)(P.fin_g + c);
                f32x4 o;
#pragma unroll
                for (int e = 0; e < 4; ++e) o[e] = acc[4 * hq + e] * rs * fg[e];
                *(GAS f32x4*)(orow + c) = o; } }
    }
    if (DBG_PROBE && DBG_PROBE != 5 && !P.last && lane == 0) { float* pp = (float*)(F.ws + WS_CTL + CTL_PROBE_OFF) + gw * 4; pp[0] = pr_s2; pp[1] = pr_d2; pp[2] = pr_tg; pp[3] = pr_n; }
}


constexpr int PH_PER_LAYER = 12, NPHASE = 1 + NLAYER * PH_PER_LAYER;
#ifndef ONLY_PHASE
#define ONLY_PHASE -1
#endif
#define T0() (wave_s == 0 && pg8::opaque_lane() == 0)
#define PH_ON(k) (ONLY_PHASE < 0 || ONLY_PHASE == (k))
#define GEMM_CALL(EPI, SCHED, g, S, E) pg8::gemm_phase<EPI, SCHED, true, true>(F.lds, g, S, E, wave_s)
#define GEMM_CALL_NA(EPI, SCHED, g, S, E) pg8::gemm_phase<EPI, SCHED, false, true>(F.lds, g, S, E, wave_s)

__device__ __forceinline__ const float* karg(int i) {
    asm volatile("" : "+s"(i));
    const __attribute__((address_space(4))) unsigned long long* ka = (const __attribute__((address_space(4))) unsigned long long*)__builtin_amdgcn_kernarg_segment_ptr();
    return (const float*)ka[i];
}
__global__ void __launch_bounds__(NWAVES * 64, 2) mk_fwd(Args args) {
    extern __shared__ __attribute__((aligned(16))) unsigned char lds[];
    Frame F;
    F.lds = (LAS unsigned char*)lds; F.ws = args.ws;
    const int wave_s = __builtin_amdgcn_readfirstlane((int)threadIdx.x >> 6);
    F.tid = threadIdx.x; F.lane = F.tid & 63; F.wave = wave_s;
    F.G = gridDim.x; { const int bx = blockIdx.x; F.vcu = (F.G % 8 == 0) ? (bx % 8) * (F.G / 8) + bx / 8 : bx; }
    unsigned char* ws = args.ws;
    volatile LAS unsigned* MISC = (volatile LAS unsigned*)(F.lds + MISC_OFF);
    for (int u = F.tid; u < (LDS_BYTES - LDSCTL_OFF) / 4; u += NWAVES * 64) ((LAS unsigned*)(F.lds + LDSCTL_OFF))[u] = 0u;
    __syncthreads();
    const int lo = args.ph_lo, hi = args.ph_hi;
    XcdBarrier bar; bar.bar = (unsigned*)(ws + WS_CTL) + CW_BAR; bar.x = 0; bar.st = nullptr;
    if (hi - lo > 1) bar = xcd_barrier_post((unsigned*)(ws + WS_CTL) + CW_BAR, MISC + 8, T0());
#define IN(k) (lo <= (k) && (k) < hi)
#define REFRAME() do { const int lz_ = pg8::opaque_lane(); F.lane = lz_; F.tid = wave_s * 64 + lz_; F.wave = wave_s; ws = (unsigned char*)karg(34); F.ws = ws; { int g_ = (int)gridDim.x, b_ = (int)blockIdx.x; asm volatile("" : "+s"(g_), "+s"(b_)); bx = b_; F.G = g_; F.vcu = ((g_ & 7) == 0) ? (b_ & 7) * (g_ >> 3) + (b_ >> 3) : b_; } } while (0)
#define SEAM(k) do { if (IN((k) + 1)) xcd_barrier(bar, T0()); } while (0)
#define XBUF ((float*)(ws + WS_X))
#define HBUF ((bf16*)(ws + WS_H))
#define MODP ((const float*)(ws + WS_CTL + CTL_MOD_OFF) + (size_t)l * 3 * 12288)
    int bx = (int)blockIdx.x;

    for (int rep_ = 0; rep_ < ((DBG_REPEAT == 100) ? 2 : 1); ++rep_) if (PH_ON(100) && IN(0)) { REFRAME(); if (rep_) xcd_barrier(bar, T0()); p0_prologue(F); SEAM(0); }

    for (int l = 0; l < NLAYER; ++l) {
        const int base = 1 + l * PH_PER_LAYER;
        const int last = (l == NLAYER - 1);
        for (int rep_ = 0; rep_ < ((DBG_REPEAT == 0) ? 2 : 1); ++rep_) if (PH_ON(0) && IN(base + 0) && l == 0) { REFRAME(); if (rep_) xcd_barrier(bar, T0()); modnorm_phase(F, XBUF, karg(6) + (size_t)l * DM, MODP, 0, HBUF, 0, l == 0 ? karg(0) : nullptr, l == 0 ? karg(2) : nullptr); SEAM(base + 0); }
        for (int rep_ = 0; rep_ < ((DBG_REPEAT == 1) ? 2 : 1); ++rep_) if (PH_ON(1) && IN(base + 1)) { REFRAME(); if (rep_) xcd_barrier(bar, T0());
            pg8::Gemm g{HBUF, (const bf16*)(ws + WS_WINA) + (size_t)l * INA_P * DM, MALL, INA_P, DM}; pg8::RowOrder S; S.init_rows(0, INA_P, F.G, bx);
            pg8::EpiStoreBf16 E{(bf16*)(ws + WS_PA), INA_P};
            GEMM_CALL(pg8::EpiStoreBf16, pg8::RowOrder, g, S, E);
            SEAM(base + 1); }
        for (int rep_ = 0; rep_ < ((DBG_REPEAT == 2) ? 2 : 1); ++rep_) if (PH_ON(2) && IN(base + 2)) { REFRAME(); if (rep_) xcd_barrier(bar, T0());
            FeatP P;
            P.PA = (const bf16*)(ws + WS_PA); P.mu = karg(9) + (size_t)l * RWC; P.w0 = karg(10) + (size_t)l * 2 * RW; P.a0 = karg(12) + (size_t)l * 2 * RW;
            P.k_k = karg(15) + (size_t)l * RW; P.k_a = karg(16) + (size_t)l * RW; P.r_k = karg(17) + (size_t)l * RW;
            P.WUP = (const bf16*)(ws + WS_WUP) + (size_t)l * 2 * RW * 64; P.AUP = (const bf16*)(ws + WS_AUP) + (size_t)l * 2 * RW * 64; P.GUP = (const bf16*)(ws + WS_GUP) + (size_t)l * 2 * RW * 32;
            P.qnorm = karg(20) + (size_t)l * 512; P.kvnorm = karg(22) + (size_t)l * 256; P.rope = (const f32x2*)(ws + WS_ROPE);
            P.RI = (bf16*)(ws + WS_RI); P.GG = (bf16*)(ws + WS_GG); P.BON = (float*)(ws + WS_BON); P.QN = (bf16*)(ws + WS_QN); P.KVN = (bf16*)(ws + WS_KVN); P.K = (bf16*)(ws + WS_K);
            features_phase(F, P);
            SEAM(base + 2); }
        for (int rep_ = 0; rep_ < ((DBG_REPEAT == 3) ? 2 : 1); ++rep_) if (PH_ON(3) && IN(base + 3)) { REFRAME(); if (rep_) xcd_barrier(bar, T0());
            { pg8::Gemm g{(const bf16*)(ws + WS_QN), (const bf16*)(ws + WS_WUQ) + (size_t)l * NQ * 512, MALL, NQ, 512};
              pg8::EpiQ E{(bf16*)(ws + WS_Q), (const f32x2*)(ws + WS_ROPE), 0.14724444f};
              pg8::RowOrder S; S.init_rows(last, NQ, F.G, bx); GEMM_CALL_NA(pg8::EpiQ, pg8::RowOrder, g, S, E); }
            { pg8::Gemm g{(const bf16*)(ws + WS_KVN), (const bf16*)(ws + WS_WUKV) + (size_t)l * NKV * 256, MALL, NKV, 256}; pg8::RowOrder S; S.init_rows(0, NKV, F.G, bx);
              pg8::EpiKV E{(bf16*)(ws + WS_K), (bf16*)(ws + WS_V)};
              GEMM_CALL_NA(pg8::EpiKV, pg8::RowOrder, g, S, E); }
            SEAM(base + 3); }
        for (int rep_ = 0; rep_ < ((DBG_REPEAT == 4) ? 2 : 1); ++rep_) if (PH_ON(4) && IN(base + 4)) { REFRAME(); if (rep_) xcd_barrier(bar, T0()); scan_phase(F, (const bf16*)(ws + WS_RI), (bf16*)(ws + WS_Y)); SEAM(base + 4); }
        for (int rep_ = 0; rep_ < ((DBG_REPEAT == 5) ? 2 : 1); ++rep_) if (PH_ON(5) && IN(base + 5)) { REFRAME(); if (rep_) xcd_barrier(bar, T0());
            attn_phase(F, (const bf16*)(ws + WS_Q), (const bf16*)(ws + WS_K), (const bf16*)(ws + WS_V), (bf16*)(ws + WS_YB), !last);
            readout_phase(F, (const bf16*)(ws + WS_Y), (const bf16*)(ws + WS_GG), (const float*)(ws + WS_BON), (const bf16*)(ws + WS_RI), karg(18) + (size_t)l * RW, karg(19) + (size_t)l * RW, (bf16*)(ws + WS_YA));
            SEAM(base + 5); }
        for (int rep_ = 0; rep_ < ((DBG_REPEAT == 6) ? 2 : 1); ++rep_) if (PH_ON(6) && IN(base + 6)) { REFRAME(); if (rep_) xcd_barrier(bar, T0());
            bf16* T1 = (bf16*)(ws + WS_T1); bf16* T2 = (bf16*)(ws + WS_T2);
            const pg8::Gemm g1{HBUF, (const bf16*)(ws + WS_WGA) + (size_t)l * DM * DM, MALL, DM, DM}, g2{(const bf16*)(ws + WS_YA), (const bf16*)(ws + WS_WA) + (size_t)l * DM * RW, MALL, DM, RW};
            const pg8::Gemm g3{HBUF, (const bf16*)(ws + WS_WGB) + (size_t)l * DM * DM, MALL, DM, DM}, g4{(const bf16*)(ws + WS_YB), (const bf16*)(ws + WS_WB) + (size_t)l * DM * RW, MALL, DM, RW};
            const pg8::EpiGate E1{T1, DM, karg(8) + (size_t)l * 2 * DM}, E3{T2, DM, karg(8) + (size_t)l * 2 * DM + DM};
            const pg8::EpiMulAdd E2{T1, T1, nullptr, DM}, E4{T1, T2, T1, DM};
            pg8::RowOrder S; S.init_rows(last, DM, F.G, bx);
            GEMM_CALL(pg8::EpiGate, pg8::RowOrder, g1, S, E1); GEMM_CALL(pg8::EpiMulAdd, pg8::RowOrder, g2, S, E2); GEMM_CALL(pg8::EpiGate, pg8::RowOrder, g3, S, E3); GEMM_CALL(pg8::EpiMulAdd, pg8::RowOrder, g4, S, E4);
            SEAM(base + 6); }
        for (int rep_ = 0; rep_ < ((DBG_REPEAT == 7) ? 2 : 1); ++rep_) if (PH_ON(7) && IN(base + 7)) { REFRAME(); if (rep_) xcd_barrier(bar, T0());
            const pg8::Gemm g{(const bf16*)(ws + WS_T1), (const bf16*)(ws + WS_WO) + (size_t)l * DM * DM, MALL, DM, DM};
            const pg8::EpiResid E{XBUF, MODP + 2 * DM, l == 0 ? karg(0) : nullptr, l == 0 ? karg(2) : nullptr};
            pg8::RowOrder S; S.init_rows(last, DM, F.G, bx); GEMM_CALL(pg8::EpiResid, pg8::RowOrder, g, S, E);
            SEAM(base + 7); }
        for (int rep_ = 0; rep_ < ((DBG_REPEAT == 8) ? 2 : 1); ++rep_) if (PH_ON(8) && IN(base + 8)) { REFRAME(); if (rep_) xcd_barrier(bar, T0());
            modnorm_phase(F, XBUF, karg(27) + (size_t)l * DM, MODP, 3, HBUF, last);
            SEAM(base + 8); }
        for (int rep_ = 0; rep_ < ((DBG_REPEAT == 9) ? 2 : 1); ++rep_) if (PH_ON(9) && IN(base + 9)) { REFRAME(); if (rep_) xcd_barrier(bar, T0());
            const pg8::Gemm g{HBUF, (const bf16*)(ws + WS_WQK) + (size_t)l * DM * DM, MALL, DM, DM};
            const pg8::EpiF32 E{(float*)(ws + WS_SC), DM};
            pg8::RowOrder S; S.init_rows(last, DM, F.G, bx); GEMM_CALL(pg8::EpiF32, pg8::RowOrder, g, S, E);
            SEAM(base + 9); }
        for (int rep_ = 0; rep_ < ((DBG_REPEAT == 10) ? 2 : 1); ++rep_) if (PH_ON(10) && IN(base + 10)) { REFRAME(); if (rep_) xcd_barrier(bar, T0());
            SelP P; P.SC = (const float*)(ws + WS_SC); P.ESEL = (int*)(ws + WS_T1); P.EGATE = (float*)(ws + WS_T1 + 16 * MiB);
            P.pu = karg(30) + (size_t)l * NEXP * DM; P.pv = karg(31) + (size_t)l * NEXP * DM; P.PU8 = ws + WS_PU; P.PV8 = ws + WS_PU + (size_t)NEXP * (DM / 2); P.SU = (float*)(ws + WS_PV); P.SV = (float*)(ws + WS_PV) + NEXP; P.last = last;
            select_phase(F, P);
            SEAM(base + 10); }
        for (int rep_ = 0; rep_ < ((DBG_REPEAT == 11) ? 2 : 1); ++rep_) if (PH_ON(11) && IN(base + 11)) { REFRAME(); if (rep_) xcd_barrier(bar, T0());
            PeerP P; P.nmod = MODP + 3 * 12288; P.ng = karg(6) + (size_t)(l + 1) * DM; P.Hout = HBUF; P.ESEL = (const int*)(ws + WS_T1); P.EGATE = (const float*)(ws + WS_T1 + 16 * MiB); P.H = HBUF; P.PU = ws + WS_PU; P.PV = ws + WS_PU + (size_t)NEXP * (DM / 2); P.SU = (const float*)(ws + WS_PV); P.SV = (const float*)(ws + WS_PV) + NEXP; P.X = XBUF; P.mod = MODP; P.fin_g = karg(32); P.out = (float*)karg(33); P.last = last;
            peer_phase(F, P);
            SEAM(base + 11); }
    }
#undef IN
#undef SEAM
#undef XBUF
#undef HBUF
#undef MODP
}

__device__ __forceinline__ float mx_a_val(int i, int k) { const int c = (i * 131 + k * 17 + (k >> 3) * 5) & 15; const float mag[8] = {0.f, .5f, 1.f, 1.5f, 2.f, 3.f, 4.f, 6.f}; return (c & 8) ? -mag[c & 7] : mag[c & 7]; }
__device__ __forceinline__ int mx_a_code(int i, int k) { return (i * 131 + k * 17 + (k >> 3) * 5) & 15; }
__device__ __forceinline__ float mx_b_val(int k, int j) { return (float)(((k * 7 + j * 13 + (k >> 4)) % 9) - 4); }
__device__ __forceinline__ int mx_kmap(int hyp, int kb, int e) { const int h = hyp % 3; return h == 0 ? 32 * kb + e : h == 1 ? 32 * (e >> 3) + 8 * kb + (e & 7) : 64 * (e >> 4) + 16 * kb + (e & 15); }
__global__ void __launch_bounds__(512) dbg_fill(const float* pp, float* o) {
    __shared__ float vsh;
    float v = 0.f;
    if (DBG_PROBE == 5) {
        if (threadIdx.x < 64) { typedef int v8i __attribute__((ext_vector_type(8))); typedef float f4 __attribute__((ext_vector_type(4)));
            const int lane = threadIdx.x, i = lane & 15, kb = lane >> 4; float code = 0.f;
            for (int hyp = 0; hyp < 18; ++hyp) { const int nibswap = hyp / 9, ha = hyp % 3, hb2 = (hyp / 3) % 3;
                unsigned aw[4] = {0u, 0u, 0u, 0u}; int bw[8] = {0, 0, 0, 0, 0, 0, 0, 0};
                for (int e = 0; e < 32; ++e) { const int k = mx_kmap(ha, kb, e); const unsigned c = (unsigned)mx_a_code(i, k); const int pos = nibswap ? (e ^ 1) : e; aw[pos >> 3] |= c << (4 * (pos & 7)); }
                for (int q = 0; q < 8; ++q) { int w = 0; const float f0 = mx_b_val(mx_kmap(hb2, kb, 4 * q + 0), i), f1 = mx_b_val(mx_kmap(hb2, kb, 4 * q + 1), i), f2 = mx_b_val(mx_kmap(hb2, kb, 4 * q + 2), i), f3 = mx_b_val(mx_kmap(hb2, kb, 4 * q + 3), i);
                    w = __builtin_amdgcn_cvt_pk_fp8_f32(f0, f1, w, false); w = __builtin_amdgcn_cvt_pk_fp8_f32(f2, f3, w, true); bw[q] = w; }
                const v8i af = {(int)aw[0], (int)aw[1], (int)aw[2], (int)aw[3], 0, 0, 0, 0}, bf = {bw[0], bw[1], bw[2], bw[3], bw[4], bw[5], bw[6], bw[7]};
                f4 d = {0.f, 0.f, 0.f, 0.f};
                d = __builtin_amdgcn_mfma_scale_f32_16x16x128_f8f6f4(af, bf, d, 4, 0, 0, 0x7f7f7f7f, 0, 0x7f7f7f7f);
                int bad = 0;
                for (int r = 0; r < 4; ++r) { const int row = 4 * kb + r, col = i; float ex = 0.f; for (int k = 0; k < 128; ++k) ex += mx_a_val(row, k) * mx_b_val(k, col); bad += (d[r] != ex); }
                if (__ballot(bad != 0) == 0ull && code == 0.f) code = (float)(hyp + 1); }
            for (int t = 0; t < 2; ++t) {
                int aw[8] = {0, 0, 0, 0, 0, 0, 0, 0}, bw[8] = {0, 0, 0, 0, 0, 0, 0, 0};
                if (t == 0) { for (int e = 0; e < 32; ++e) { const int k = 32 * kb + e; aw[e >> 3] |= mx_a_code(i, k) << (4 * (e & 7)); bw[e >> 3] |= mx_a_code(i + 16, k) << (4 * (e & 7)); } }
                else { for (int q = 0; q < 8; ++q) { int w = 0, w2 = 0; const int k = 32 * kb + 4 * q;
                        w = __builtin_amdgcn_cvt_pk_fp8_f32(mx_b_val(k, i + 16), mx_b_val(k + 1, i + 16), w, false); w = __builtin_amdgcn_cvt_pk_fp8_f32(mx_b_val(k + 2, i + 16), mx_b_val(k + 3, i + 16), w, true); aw[q] = w;
                        w2 = __builtin_amdgcn_cvt_pk_fp8_f32(mx_b_val(k, i), mx_b_val(k + 1, i), w2, false); w2 = __builtin_amdgcn_cvt_pk_fp8_f32(mx_b_val(k + 2, i), mx_b_val(k + 3, i), w2, true); bw[q] = w2; } }
                const v8i af = {aw[0], aw[1], aw[2], aw[3], aw[4], aw[5], aw[6], aw[7]}, bf = {bw[0], bw[1], bw[2], bw[3], bw[4], bw[5], bw[6], bw[7]};
                f4 d = {0.f, 0.f, 0.f, 0.f};
                if (t == 0) d = __builtin_amdgcn_mfma_scale_f32_16x16x128_f8f6f4(af, bf, d, 4, 4, 0, 0x7f7f7f7f, 0, 0x7f7f7f7f); else d = __builtin_amdgcn_mfma_scale_f32_16x16x128_f8f6f4(af, bf, d, 0, 0, 0, 0x7f7f7f7f, 0, 0x7f7f7f7f);
                int bad = 0;
                for (int r = 0; r < 4; ++r) { const int row = 4 * kb + r, col = i; float ex = 0.f;
                    for (int k = 0; k < 128; ++k) ex += (t == 0) ? mx_a_val(row, k) * mx_a_val(col + 16, k) : mx_b_val(k, row + 16) * mx_b_val(k, col);
                    bad += (d[r] != ex); }
                if (__ballot(bad != 0) == 0ull) code += (t == 0) ? 10.f : 20.f; }
            if (lane == 0) vsh = code; }
        __syncthreads(); v = vsh;
    } else {
        float s0 = 0.f, s1 = 0.f, s2 = 0.f, s3 = 0.f;
        for (int i = 0; i < 2048; ++i) { s0 += pp[4 * i]; s1 += pp[4 * i + 1]; s2 += pp[4 * i + 2]; s3 += pp[4 * i + 3]; }
        if (DBG_PROBE == 4) { float mx = 0.f; for (int i = 0; i < 2048; ++i) mx = fmaxf(mx, pp[4 * i]); v = 100.f * mx; }
        else { v = (DBG_PROBE == 1 ? s0 : DBG_PROBE == 2 ? s1 : s2) / s3 * 1e-3f; v = exp2f(rintf(log2f(v) * 4.f) * 0.25f); }
    }
    for (size_t i = (size_t)blockIdx.x * 512 + threadIdx.x; i < (size_t)NBATCH * SEQ * DM; i += (size_t)gridDim.x * 512) o[i] = v;
}
extern "C" void kernel_launch(void* const* d_in, const int* in_sizes, int n_in, void* d_out, int out_size, void* d_ws, size_t ws_size, hipStream_t stream) {
    static int grid = 0;
    if (grid == 0) {
        if (n_in != 33 || out_size != NBATCH * SEQ * DM || ws_size < WS_END) { fprintf(stderr, "kernel_launch: unexpected shapes (n_in %d out %d ws %zu)\n", n_in, out_size, ws_size); grid = -1; return; }
        int dev = 0, cus = 0, per_cu = 0;
        if (hipGetDevice(&dev) != hipSuccess || hipDeviceGetAttribute(&cus, hipDeviceAttributeMultiprocessorCount, dev) != hipSuccess) { grid = -1; return; }
        if (hipFuncSetAttribute((const void*)mk_fwd, hipFuncAttributeMaxDynamicSharedMemorySize, LDS_BYTES) != hipSuccess) { fprintf(stderr, "kernel_launch: hipFuncSetAttribute failed\n"); grid = -1; return; }
        if (hipOccupancyMaxActiveBlocksPerMultiprocessor(&per_cu, (const void*)mk_fwd, NWAVES * 64, LDS_BYTES) != hipSuccess || per_cu < 1) { fprintf(stderr, "kernel_launch: occupancy query says %d\n", per_cu); (void)hipGetLastError(); grid = -1; return; }
        grid = cus;
    }
    if (grid < 0) return;
    if (hipMemsetAsync((char*)d_ws + WS_CTL, 0, CTL_ZERO_BYTES, stream) != hipSuccess) return;
    Args a{};
    for (int i = 0; i < 33; ++i) a.in[i] = (const float*)d_in[i];
    a.out = (float*)d_out; a.ws = (unsigned char*)d_ws;
#if MK_N_LAUNCHES == 1
    a.ph_lo = 0; a.ph_hi = NPHASE;
    hipLaunchKernelGGL(mk_fwd, dim3(grid), dim3(NWAVES * 64), LDS_BYTES, stream, a);
#else
    if (DBG_PROBE != 5) for (int p = 0; p < NPHASE; ++p) { a.ph_lo = p; a.ph_hi = p + 1; hipLaunchKernelGGL(mk_fwd, dim3(grid), dim3(NWAVES * 64), LDS_BYTES, stream, a); }
    if (DBG_PROBE) hipLaunchKernelGGL(dbg_fill, dim3(1024), dim3(512), 0, stream, (const float*)((char*)d_ws + WS_CTL + CTL_PROBE_OFF), (float*)d_out);
#endif
}
```

```cpp
#include <hip/hip_runtime.h>
#include <cstdio>
#include <cstdint>

#ifndef MK_N_LAUNCHES
#define MK_N_LAUNCHES 1
#endif

#ifndef DBG_SKIP
#define DBG_SKIP 0
#endif
#ifndef DBG_PROBE
#define DBG_PROBE 0
#endif
#ifndef DBG_DRY
#define DBG_DRY 1
#endif
#ifndef DBG_REPEAT
#define DBG_REPEAT -1
#endif
namespace pg8 {
#define PG8_LAS __attribute__((address_space(3)))
typedef unsigned short bf16_t;
typedef short bf16x8 __attribute__((ext_vector_type(8)));
typedef float f32x4 __attribute__((ext_vector_type(4)));
typedef unsigned u32x4 __attribute__((ext_vector_type(4)));
constexpr int BM = 256, BK = 64, HALF = 128, HTB = HALF * BK * 2  , STAGE_BYTES = 8 * HTB, NXCD = 8, WGM = 8;

__host__ __device__ __forceinline__ int lds_byte(int r, int c) { const int st = (r >> 4) * 2 + (c >> 5), rr = r & 15, cc = c & 31, ob = rr * 64 + cc * 2; return st * 1024 + (ob ^ (((ob >> 9) & 1) << 5)); }
__host__ __device__ __forceinline__ void stage_rc(int b, int& R, int& C) { const int st = b / 1024, sb = b % 1024, swz = sb ^ (((sb >> 9) & 1) << 5); R = (st >> 1) * 16 + swz / 64; C = (st & 1) * 32 + (swz % 64) / 2; }
__host__ __device__ __forceinline__ int perm32(int rho) { const int n = rho >> 4, i = rho & 15; return 8 * (i >> 2) + 4 * n + (i & 3); }

struct Unit { int pm, pn; };
struct Gemm { const bf16_t* A; const bf16_t* Bt; int M, N, K; };

struct StaticOrder {
    int nM, nN, nwg, G, c;
    __host__ __device__ void init(int M, int N, int G_, int c_) { nM = M / BM; nN = N / BM; nwg = nM * nN; G = G_; c = c_; }
    __host__ __device__ bool next(int i, Unit& u) const {
        const long L = (long)i * G + c; if (L >= nwg) return false;
        int wgid = (int)L; { const int q = nwg / NXCD, r = nwg % NXCD, xcd = wgid % NXCD, off = wgid / NXCD; wgid = (xcd < r ? xcd * (q + 1) : r * (q + 1) + (xcd - r) * q) + off; }
        const int nig = WGM * nN, gid = wgid / nig, fm = gid * WGM, gsz = (nM - fm) < WGM ? (nM - fm) : WGM;
        u.pm = fm + ((wgid % nig) % gsz); u.pn = (wgid % nig) / gsz; return true;
    }
    __device__ __forceinline__ void a_ready(const Unit&) const {}
    __device__ __forceinline__ void done(const Unit&) const {}
};
__device__ __forceinline__ int opaque_lane() { int l; asm volatile("v_mbcnt_lo_u32_b32 %0, -1, 0\n\tv_mbcnt_hi_u32_b32 %0, -1, %0" : "=v"(l)); return l; }
typedef __bf16 bf16x2c __attribute__((ext_vector_type(2)));
__device__ __forceinline__ unsigned cvt_pk_bf16(float lo, float hi) { const bf16x2c v = {(__bf16)lo, (__bf16)hi}; return __builtin_bit_cast(unsigned, v); }
template <class Epi, class Sched, bool ALIGN_EPI = false, bool SP2 = false>
__device__ __forceinline__ void gemm_phase(PG8_LAS unsigned char* lds, const Gemm g, const Sched& S, const Epi& E, const int wave_s) {
    const int lane_ = opaque_lane();
    const int wid = wave_s, lane = lane_, tid = wid * 64 + lane, wr = wid >> 2, wc = wid & 3, fr = lane & 15, fq = lane >> 4;
    const int K = g.K, nt = K / BK;
    unsigned voffA[2], voffB[2];
#pragma unroll
    for (int i = 0; i < 2; ++i) { int R, C; stage_rc(tid * 16 + i * 8192, R, C); const int Rb = Epi::PERM ? ((R & ~31) + perm32(R & 31)) : R;
        voffA[i] = (unsigned)(R * K + C) * 2u; voffB[i] = (unsigned)(Rb * K + C) * 2u; }
    const size_t kstep = (size_t)(BK * 2);
    const size_t hstep = (size_t)HALF * K * 2;
    const size_t tstep = 2 * hstep;
    const unsigned ldsw = (unsigned)wid * 1024u;
    const int aoff = lds_byte(wr * 64 + fr, fq * 8), boff = lds_byte(wc * 32 + fr, fq * 8);
#define PG8_SA(b, h) (((b) * 2 + (h)) * HTB)
#define PG8_SB(b, h) ((4 + (b) * 2 + (h)) * HTB)
#define PG8_STAGE(bufoff, gbase, voff) do { _Pragma("unroll") for (int _i = 0; _i < 2; ++_i) \
        __builtin_amdgcn_global_load_lds((const unsigned*)((const char*)(gbase) + (voff)[_i]), (PG8_LAS unsigned*)(lds + (bufoff) + ldsw + _i * 8192), 16, 0, 0); } while (0)
#define PG8_LDA(dst, b, h) do { _Pragma("unroll") for (int m = 0; m < 4; ++m) _Pragma("unroll") for (int k = 0; k < 2; ++k) dst[m][k] = *(const PG8_LAS bf16x8*)(lds + PG8_SA(b, h) + aoff + m * 2048 + k * 1024); } while (0)
#define PG8_LDB(dst, b, h) do { _Pragma("unroll") for (int n = 0; n < 2; ++n) _Pragma("unroll") for (int k = 0; k < 2; ++k) dst[n][k] = *(const PG8_LAS bf16x8*)(lds + PG8_SB(b, h) + boff + n * 2048 + k * 1024); } while (0)
#define PG8_MMA(ai, bj, At, Bt) do { __builtin_amdgcn_s_setprio(1); _Pragma("unroll") for (int m = 0; m < 4; ++m) _Pragma("unroll") for (int n = 0; n < 2; ++n) _Pragma("unroll") for (int k = 0; k < 2; ++k) \
        acc[ai][bj][m][n] = __builtin_amdgcn_mfma_f32_16x16x32_bf16(Bt[n][k], At[m][k], acc[ai][bj][m][n], 0, 0, 0); __builtin_amdgcn_s_setprio(0); } while (0)
#define PG8_WAIT_V(n) asm volatile("s_waitcnt vmcnt(" #n ")" ::: "memory")
#define PG8_WAIT_L(n) asm volatile("s_waitcnt lgkmcnt(" #n ")" ::: "memory")
#define PG8_BAR __builtin_amdgcn_s_barrier()
#define PG8_SCHED __builtin_amdgcn_sched_barrier(0)
    Unit cur, nxt; int ui = 0;
    if (!S.next(0, cur)) return;
    f32x4 acc[2][2][4][2];
#pragma unroll
    for (int a = 0; a < 2; ++a)
#pragma unroll
        for (int b = 0; b < 2; ++b)
#pragma unroll
            for (int m = 0; m < 4; ++m)
#pragma unroll
                for (int n = 0; n < 2; ++n) acc[a][b][m][n] = (f32x4){0.f, 0.f, 0.f, 0.f};
    bf16x8 At[4][2], B0[2][2], B1[2][2];
    const char* cA = (const char*)g.A + (size_t)cur.pm * tstep; const char* cB = (const char*)g.Bt + (size_t)cur.pn * tstep;
    S.a_ready(cur);
    if constexpr (SP2) {
        PG8_STAGE(PG8_SB(0, 0), cB, voffB); PG8_STAGE(PG8_SB(0, 1), cB + hstep, voffB); PG8_STAGE(PG8_SA(0, 0), cA, voffA); PG8_STAGE(PG8_SA(0, 1), cA + hstep, voffA);
        if (wr == 1) PG8_BAR;
        PG8_WAIT_V(2); PG8_BAR;
        PG8_STAGE(PG8_SB(1, 0), cB + kstep, voffB); PG8_STAGE(PG8_SA(1, 0), cA + kstep, voffA); PG8_STAGE(PG8_SB(1, 1), cB + hstep + kstep, voffB);
        PG8_WAIT_V(6); PG8_BAR;
    } else {
        PG8_STAGE(PG8_SB(0, 0), cB, voffB); PG8_STAGE(PG8_SA(0, 0), cA, voffA); PG8_STAGE(PG8_SB(0, 1), cB + hstep, voffB); PG8_STAGE(PG8_SA(0, 1), cA + hstep, voffA);
        if (wr == 1) PG8_BAR;
        PG8_WAIT_V(4); PG8_BAR;
        PG8_STAGE(PG8_SB(1, 0), cB + kstep, voffB); PG8_STAGE(PG8_SA(1, 0), cA + kstep, voffA); PG8_STAGE(PG8_SB(1, 1), cB + hstep + kstep, voffB);
        PG8_WAIT_V(6); PG8_BAR;
    }
    for (;;) {
        const bool has_next = S.next(ui + 1, nxt);
        const char* nA = has_next ? (const char*)g.A + (size_t)nxt.pm * tstep : cA; const char* nB = has_next ? (const char*)g.Bt + (size_t)nxt.pn * tstep : cB;
        for (int t = 0; t < nt; t += 2) {
            const bool last = (t == nt - 2);
            const char* a1 = cA + (size_t)(t + 1) * kstep;
            const char* a2 = last ? nA : cA + (size_t)(t + 2) * kstep; const char* b2 = last ? nB : cB + (size_t)(t + 2) * kstep;
            const char* a3 = a2 + kstep; const char* b3 = b2 + kstep;
            if (last && has_next) S.a_ready(nxt);
            if constexpr (SP2) {
            PG8_LDB(B0, 0, 0); PG8_LDB(B1, 0, 1); PG8_SCHED; PG8_LDA(At, 0, 0); PG8_STAGE(PG8_SA(1, 1), a1 + hstep, voffA);
            PG8_WAIT_V(8); PG8_WAIT_L(0); PG8_BAR; PG8_MMA(0, 0, At, B0); PG8_MMA(0, 1, At, B1); PG8_BAR; PG8_SCHED;
            PG8_LDA(At, 0, 1); PG8_STAGE(PG8_SB(0, 0), b2, voffB); PG8_STAGE(PG8_SB(0, 1), b2 + hstep, voffB); PG8_STAGE(PG8_SA(0, 0), a2, voffA);
            PG8_WAIT_V(8); PG8_WAIT_L(0); PG8_BAR; PG8_MMA(1, 0, At, B0); PG8_MMA(1, 1, At, B1); PG8_BAR; PG8_SCHED;
            PG8_LDB(B0, 1, 0); PG8_LDB(B1, 1, 1); PG8_SCHED; PG8_LDA(At, 1, 0); PG8_STAGE(PG8_SA(0, 1), a2 + hstep, voffA);
            PG8_WAIT_V(8); PG8_WAIT_L(0); PG8_BAR; PG8_MMA(0, 0, At, B0); PG8_MMA(0, 1, At, B1); PG8_BAR; PG8_SCHED;
            PG8_LDA(At, 1, 1); PG8_STAGE(PG8_SB(1, 0), b3, voffB); PG8_STAGE(PG8_SB(1, 1), b3 + hstep, voffB); PG8_STAGE(PG8_SA(1, 0), a3, voffA);
            PG8_WAIT_V(8); PG8_WAIT_L(0); PG8_BAR; PG8_MMA(1, 0, At, B0); PG8_MMA(1, 1, At, B1); PG8_BAR; PG8_SCHED;
            } else {
            PG8_LDB(B0, 0, 0); PG8_SCHED; PG8_LDA(At, 0, 0); PG8_STAGE(PG8_SA(1, 1), a1 + hstep, voffA);
            PG8_WAIT_L(8); PG8_BAR; PG8_WAIT_L(0); PG8_MMA(0, 0, At, B0); PG8_BAR; PG8_SCHED;
            PG8_LDB(B1, 0, 1); PG8_STAGE(PG8_SB(0, 0), b2, voffB);
            PG8_BAR; PG8_WAIT_L(0); PG8_MMA(0, 1, At, B1); PG8_BAR;
            PG8_LDA(At, 0, 1); PG8_STAGE(PG8_SA(0, 0), a2, voffA);
            PG8_BAR; PG8_WAIT_L(0); PG8_MMA(1, 0, At, B0); PG8_BAR; PG8_SCHED;
            PG8_STAGE(PG8_SB(0, 1), b2 + hstep, voffB);
            PG8_WAIT_V(6); PG8_BAR; PG8_MMA(1, 1, At, B1); PG8_BAR;
            PG8_LDB(B0, 1, 0); PG8_SCHED; PG8_LDA(At, 1, 0); PG8_STAGE(PG8_SA(0, 1), a2 + hstep, voffA);
            PG8_WAIT_L(8); PG8_BAR; PG8_WAIT_L(0); PG8_MMA(0, 0, At, B0); PG8_BAR; PG8_SCHED;
            PG8_LDB(B1, 1, 1); PG8_STAGE(PG8_SB(1, 0), b3, voffB);
            PG8_BAR; PG8_WAIT_L(0); PG8_MMA(0, 1, At, B1); PG8_BAR;
            PG8_LDA(At, 1, 1); PG8_STAGE(PG8_SA(1, 0), a3, voffA);
            PG8_BAR; PG8_WAIT_L(0); PG8_MMA(1, 0, At, B0); PG8_BAR; PG8_SCHED;
            PG8_STAGE(PG8_SB(1, 1), b3 + hstep, voffB);
            PG8_WAIT_V(6); PG8_BAR; PG8_MMA(1, 1, At, B1); PG8_BAR;
            }
        }
        if constexpr (ALIGN_EPI) { if (wr == 0) PG8_BAR; }
        if constexpr (!Epi::AFTER_DRAIN) { const int le_ = opaque_lane(); E(acc, cur, wr, wc, le_ & 15, le_ >> 4); S.done(cur); }
        if (!has_next) break;
#pragma unroll
        for (int a = 0; a < 2; ++a)
#pragma unroll
            for (int b = 0; b < 2; ++b)
#pragma unroll
                for (int m = 0; m < 4; ++m)
#pragma unroll
                    for (int n = 0; n < 2; ++n) acc[a][b][m][n] = (f32x4){0.f, 0.f, 0.f, 0.f};
        cur = nxt; cA = nA; cB = nB; ++ui;
        if constexpr (ALIGN_EPI) { if (wr == 1) PG8_BAR; }
    }
    PG8_WAIT_V(0);
    if constexpr (!ALIGN_EPI) { if (wr == 0) PG8_BAR; }
    PG8_BAR;
    if constexpr (Epi::AFTER_DRAIN) { E.fused(acc, cur, wr, wc, fr, fq, lds, wid, lane); S.done(cur); }
#undef PG8_SA
#undef PG8_SB
#undef PG8_STAGE
#undef PG8_LDA
#undef PG8_LDB
#undef PG8_MMA
#undef PG8_WAIT_V
#undef PG8_WAIT_L
#undef PG8_BAR
#undef PG8_SCHED
}
}

constexpr int NWAVES = 8;
constexpr int DM = 2048, NBATCH = 2, SEQ = 8192, CTXL = 256, TPB = CTXL + SEQ  , MALL = NBATCH * TPB  ;
constexpr int NLAYER = 2;
constexpr int RW = 1024, NH = 16;
constexpr int RWC = 3392, INA = 4192, INA_P = 4352, INC = 8288;
constexpr int C_WD = 3072, C_AD = 3200, C_GD = 3328, C_QC = 3392, C_KVC = 3904, C_KR = 4160;
constexpr int QKD = 96, NQ = NH * QKD  , NKV = NH * 128  ;
constexpr int NEXP = 16384;
constexpr int RREC = 9 * 64;
constexpr float NORM_EPS = 1e-6f;

constexpr size_t MiB = 1u << 20;
constexpr size_t WS_CTL = 0, CTL_ZERO_BYTES = 1 * MiB;
constexpr size_t CTL_MOD_OFF = 256 * 1024;
constexpr size_t WS_ROPE = 1 * MiB;
constexpr size_t WS_WUP = 3 * MiB, WS_AUP = WS_WUP + 512 * 1024, WS_GUP = 4 * MiB;
constexpr size_t WS_WUQ = 5 * MiB, WS_WUKV = 8 * MiB, WS_WA = 10 * MiB, WS_WB = 18 * MiB, WS_WO = 26 * MiB, WS_WQK = 42 * MiB, WS_WGA = 58 * MiB, WS_WGB = 74 * MiB, WS_WINA = 90 * MiB;
constexpr size_t WS_X = 124 * MiB, WS_H = 256 * MiB, WS_DYN = 322 * MiB;
constexpr size_t WS_PA = WS_DYN;
constexpr size_t WS_RI = 463 * MiB;
constexpr size_t WS_GG = 760 * MiB;
constexpr size_t WS_BON = 826 * MiB;
constexpr size_t WS_QN = 831 * MiB, WS_KVN = 848 * MiB;
constexpr size_t WS_Q = 857 * MiB, WS_K = 907 * MiB, WS_V = 957 * MiB, WS_END = 990 * MiB;
constexpr size_t WS_Y = WS_DYN;
constexpr size_t WS_YA = 388 * MiB, WS_YB = 421 * MiB;
constexpr size_t WS_T1 = 463 * MiB, WS_T2 = 529 * MiB;
constexpr size_t WS_PU = 600 * MiB, WS_PV = 664 * MiB;
constexpr size_t WS_SC = WS_DYN;
static_assert(WS_PA + (size_t)MALL * INA_P * 2 <= WS_RI && WS_RI + (size_t)NBATCH * NH * TPB * RREC * 2 <= WS_GG && WS_GG + (size_t)2 * MALL * RW * 2 <= WS_BON, "ws map 1");
static_assert(WS_BON + (size_t)2 * MALL * 32 * 4 <= WS_QN && WS_QN + (size_t)MALL * 512 * 2 <= WS_KVN && WS_KVN + (size_t)MALL * 256 * 2 <= WS_Q, "ws map 2");
static_assert(WS_Q + (size_t)NBATCH * NH * TPB * QKD * 2 <= WS_K && WS_K + (size_t)NBATCH * NH * TPB * QKD * 2 <= WS_V && WS_V + (size_t)NBATCH * NH * TPB * 64 * 2 <= WS_END, "ws map 3");
static_assert(WS_Y + (size_t)2 * MALL * RW * 2 <= WS_YA && WS_YA + (size_t)MALL * RW * 2 <= WS_YB && WS_YB + (size_t)MALL * RW * 2 <= WS_RI, "ws map 4");
static_assert(WS_T1 + (size_t)MALL * DM * 2 <= WS_T2 && WS_T2 + (size_t)MALL * DM * 2 <= WS_PU && WS_PU + (size_t)NEXP * DM * 2 <= WS_PV && WS_PV + (size_t)NEXP * DM * 2 <= WS_GG, "ws map 5");
static_assert(WS_SC + (size_t)MALL * DM * 4 <= WS_T1 && WS_X + (size_t)MALL * DM * 4 <= WS_H && WS_H + (size_t)MALL * DM * 2 <= WS_DYN, "ws map 6");
static_assert(WS_WINA + (size_t)NLAYER * INA_P * DM * 2 <= WS_X, "ws map 7");
constexpr size_t CTL_PROBE_OFF = 640 * 1024;
constexpr int CW_BAR = 4096;

constexpr int RING_BYTES = 131072;
constexpr int LDSCTL_OFF = RING_BYTES, MISC_OFF = LDSCTL_OFF + 320;
constexpr int LDS_BYTES = 147456;

#define GAS __attribute__((address_space(1)))
#define LAS __attribute__((address_space(3)))
typedef unsigned short bf16;
typedef unsigned v4u __attribute__((ext_vector_type(4)));
typedef unsigned v2u __attribute__((ext_vector_type(2)));
typedef float f32x4 __attribute__((ext_vector_type(4)));
typedef float f32x2 __attribute__((ext_vector_type(2)));
typedef float f32x16 __attribute__((ext_vector_type(16)));
typedef short bf16x8 __attribute__((ext_vector_type(8)));
typedef short s16x4 __attribute__((ext_vector_type(4)));
typedef __bf16 bf16x2v __attribute__((ext_vector_type(2)));
typedef __bf16 bf16x8v __attribute__((ext_vector_type(8)));
typedef GAS unsigned gu32;
#define RLX_AGENT __ATOMIC_RELAXED, __HIP_MEMORY_SCOPE_AGENT
#define LDS_WAIT() asm volatile("s_waitcnt lgkmcnt(0)" ::: "memory")
#define VM_WAIT() asm volatile("s_waitcnt vmcnt(0)" ::: "memory")
__device__ __forceinline__ unsigned f2bf(float f) { unsigned u = __builtin_bit_cast(unsigned, f); return (u + 0x7fffu + ((u >> 16) & 1u)) >> 16; }
__device__ __forceinline__ unsigned pk2(float lo, float hi) { return pg8::cvt_pk_bf16(lo, hi); }
__device__ __forceinline__ float bflo(unsigned w) { return __builtin_bit_cast(float, w << 16); }
__device__ __forceinline__ float bfhi(unsigned w) { return __builtin_bit_cast(float, w & 0xffff0000u); }
__device__ __forceinline__ float bf1(bf16 h) { return __builtin_bit_cast(float, (unsigned)h << 16); }
__device__ __forceinline__ float sigmoidf_(float x) { return __builtin_amdgcn_rcpf(1.0f + __expf(-x)); }
template <int CTRL> __device__ __forceinline__ float dpp_add(float x) {
    return x + __builtin_bit_cast(float, __builtin_amdgcn_update_dpp(0, __builtin_bit_cast(int, x), CTRL, 0xf, 0xf, true));
}
__device__ __forceinline__ float red16(float x) {
    x = dpp_add<0xB1>(x);
    x = dpp_add<0x4E>(x);
    x = dpp_add<0x141>(x);
    x = dpp_add<0x140>(x);
    return x;
}
template <int CTRL, int RM> __device__ __forceinline__ float dpp_max(float x) {
    return fmaxf(x, __builtin_bit_cast(float, __builtin_amdgcn_update_dpp(__builtin_bit_cast(int, x), __builtin_bit_cast(int, x), CTRL, RM, 0xf, false)));
}
template <int CTRL, int RM> __device__ __forceinline__ float dpp_sum(float x) {
    return x + __builtin_bit_cast(float, __builtin_amdgcn_update_dpp(0, __builtin_bit_cast(int, x), CTRL, RM, 0xf, false));
}
__device__ __forceinline__ float wave_max_u(float x) {
    x = dpp_max<0xB1, 0xf>(x); x = dpp_max<0x4E, 0xf>(x); x = dpp_max<0x141, 0xf>(x); x = dpp_max<0x140, 0xf>(x);
    x = dpp_max<0x142, 0xa>(x); x = dpp_max<0x143, 0xc>(x);
    return __builtin_bit_cast(float, __builtin_amdgcn_readlane(__builtin_bit_cast(int, x), 63));
}
__device__ __forceinline__ float wave_sum_u(float x) {
    x = dpp_sum<0xB1, 0xf>(x); x = dpp_sum<0x4E, 0xf>(x); x = dpp_sum<0x141, 0xf>(x); x = dpp_sum<0x140, 0xf>(x);
    x = dpp_sum<0x142, 0xa>(x); x = dpp_sum<0x143, 0xc>(x);
    return __builtin_bit_cast(float, __builtin_amdgcn_readlane(__builtin_bit_cast(int, x), 63));
}
__device__ __forceinline__ float wave_sum(float v) { return wave_sum_u(v); }
__device__ __forceinline__ float bpermf(int srclane, float v) { return __builtin_bit_cast(float, __builtin_amdgcn_ds_bpermute(srclane << 2, __builtin_bit_cast(int, v))); }
__device__ __forceinline__ int bpermi(int srclane, int v) { return __builtin_amdgcn_ds_bpermute(srclane << 2, v); }

#define XB_TMO      128
#define XB_XCNT(j)  (256  + 64 * (j))
#define XB_XSUB(j)  (1280 + 64 * (j))
#define XB_XGEN(j)  (2304 + 64 * (j))
#define XB_TOP      3328
#define XB_TOPGEN   3392
#define XCD_BAR_WORDS 3456
#define XB_SPIN_CAP (1u << 20)

__device__ __forceinline__ unsigned xb_ld(unsigned* p)              { return __hip_atomic_load(p, __ATOMIC_RELAXED, __HIP_MEMORY_SCOPE_AGENT); }
__device__ __forceinline__ unsigned xb_add(unsigned* p, unsigned v) { return __hip_atomic_fetch_add(p, v, __ATOMIC_RELAXED, __HIP_MEMORY_SCOPE_AGENT); }
__device__ __forceinline__ unsigned xb_xcc_id() { return (unsigned)__builtin_amdgcn_s_getreg((3 << 11) | 20) & 0xFu; }
#define XB_SPIN(cond, bar) do { unsigned _sp = 0; while (cond) { __builtin_amdgcn_s_sleep(1); \
    if ((++_sp & 255u) == 0u) { if (xb_ld(&(bar)[XB_TMO])) break; if (_sp > XB_SPIN_CAP) { atomicAdd(&(bar)[XB_TMO], 1u); break; } } } } while (0)

struct XcdBarrier { unsigned* bar; unsigned x; volatile LAS unsigned* st; };

__device__ __forceinline__ XcdBarrier xcd_barrier_post(unsigned* bar, volatile LAS unsigned* st, bool t0) {
    XcdBarrier b; b.bar = bar; b.x = xb_xcc_id(); b.st = st;
    if (t0) (void)xb_add(&bar[XB_XCNT(b.x)], 1u);
    return b;
}
__device__ __forceinline__ void xcd_barrier_complete(unsigned* bar, unsigned x, unsigned& nloc, unsigned& nx) {
    const unsigned G = gridDim.x * gridDim.y * gridDim.z;
    unsigned sum, cnt, mine, sp = 0u;
    for (;;) {
        sum = 0u; cnt = 0u; mine = 0u;
#pragma unroll
        for (unsigned j = 0; j < 16; ++j) { const unsigned c = xb_ld(&bar[XB_XCNT(j)]); sum += c; cnt += (c > 0u) ? 1u : 0u; mine = (j == x) ? c : mine; }
        if (sum == G) break;
        __builtin_amdgcn_s_sleep(1);
        if ((++sp & 255u) == 0u) { if (xb_ld(&bar[XB_TMO])) break; if (sp > XB_SPIN_CAP) { atomicAdd(&bar[XB_TMO], 1u); break; } }
    }
    nloc = mine > 0u ? mine : 1u; nx = cnt > 0u ? cnt : 1u;
}
__device__ __forceinline__ void xcd_barrier(const XcdBarrier& b, bool t0) {
    asm volatile("s_waitcnt vmcnt(0)" ::: "memory");
    __syncthreads();
    if (t0) {
        unsigned* bar = b.bar;
        __builtin_amdgcn_s_waitcnt(0);
        unsigned nloc = b.st[0], nx = b.st[1];
        if (nloc == 0u) { xcd_barrier_complete(bar, b.x, nloc, nx); b.st[0] = nloc; b.st[1] = nx; }
        const unsigned old = xb_add(&bar[XB_XSUB(b.x)], 1u);
        const unsigned gen = old / nloc;
        if (old + 1u == (gen + 1u) * nloc) {
            __builtin_amdgcn_fence(__ATOMIC_RELEASE, "agent");
            asm volatile("s_waitcnt vmcnt(0)" ::: "memory");
            const unsigned og = xb_add(&bar[XB_TOP], 1u);
            const unsigned tg = og / nx;
            if (og + 1u == (tg + 1u) * nx) xb_add(&bar[XB_TOPGEN], 1u);
            else XB_SPIN(xb_ld(&bar[XB_TOPGEN]) == tg, bar);
            __builtin_amdgcn_fence(__ATOMIC_ACQUIRE, "agent");
            xb_add(&bar[XB_XGEN(b.x)], 1u);
            asm volatile("s_waitcnt vmcnt(0)" ::: "memory");
        } else {
            XB_SPIN(xb_ld(&bar[XB_XGEN(b.x)]) == gen, bar);
            __builtin_amdgcn_fence(__ATOMIC_ACQUIRE, "agent");
            asm volatile("s_waitcnt vmcnt(0)" ::: "memory");
        }
    }
    __syncthreads();
}

struct Frame {
    LAS unsigned char* lds;
    unsigned char* ws;
    const float* const* in;
    int tid, lane, wave;
    int vcu, G;
};
struct Args { const float* in[33]; float* out; unsigned char* ws; int ph_lo, ph_hi; };


namespace pg8 {
typedef unsigned u32x4 __attribute__((ext_vector_type(4)));
struct RowOrder : StaticOrder {
    int lat;
    __host__ __device__ void init_rows(int lat_, int N, int G_, int c_) { lat = lat_; init(lat_ ? NBATCH * SEQ : MALL, N, G_, c_); }
    __host__ __device__ bool next(int i, Unit& u) const { if (!StaticOrder::next(i, u)) return false; if (lat) u.pm = 33 * (u.pm >> 5) + 1 + (u.pm & 31); return true; }
};
#define EPI_LOOP_ROWS for (int ai = 0; ai < 2; ++ai) _Pragma("unroll") for (int m = 0; m < 4; ++m)
#define EPI_PIN asm volatile("" ::: "memory")

struct EpiStoreBf16 {
    static constexpr bool PERM = true, AFTER_DRAIN = false;
    bf16_t* O; int ldc;
    __device__ __forceinline__ void operator()(const f32x4 (&acc)[2][2][4][2], const Unit& u, int wr, int wc, int fr, int fq) const {
        const int row0 = u.pm * BM + wr * 64 + fr, col0 = u.pn * BM + wc * 32 + 8 * fq;
#pragma unroll
        EPI_LOOP_ROWS { bf16_t* rowp = O + (size_t)(row0 + ai * HALF + m * 16) * ldc + col0;
#pragma unroll
            for (int bj = 0; bj < 2; ++bj) { const f32x4 v0 = acc[ai][bj][m][0], v1 = acc[ai][bj][m][1];
                u32x4 w; w.x = cvt_pk_bf16(v0[0], v0[1]); w.y = cvt_pk_bf16(v0[2], v0[3]); w.z = cvt_pk_bf16(v1[0], v1[1]); w.w = cvt_pk_bf16(v1[2], v1[3]);
                *(u32x4*)(rowp + bj * HALF) = w; } }
    }
};
struct EpiGate {
    static constexpr bool PERM = true, AFTER_DRAIN = false;
    bf16_t* O; int ldc; const float* bias;
    __device__ __forceinline__ void operator()(const f32x4 (&acc)[2][2][4][2], const Unit& u, int wr, int wc, int fr, int fq) const {
        const int row0 = u.pm * BM + wr * 64 + fr, col0 = u.pn * BM + wc * 32 + 8 * fq;
        f32x4 bv[2][2];
#pragma unroll
        for (int bj = 0; bj < 2; ++bj)
#pragma unroll
            for (int n = 0; n < 2; ++n) bv[bj][n] = *(const f32x4*)(bias + col0 + bj * HALF + 4 * n);
#pragma unroll
        EPI_LOOP_ROWS { EPI_PIN; bf16_t* rowp = O + (size_t)(row0 + ai * HALF + m * 16) * ldc + col0;
#pragma unroll
            for (int bj = 0; bj < 2; ++bj) { f32x4 v0 = acc[ai][bj][m][0] + bv[bj][0], v1 = acc[ai][bj][m][1] + bv[bj][1];
#pragma unroll
                for (int e = 0; e < 4; ++e) { v0[e] = __builtin_amdgcn_rcpf(1.0f + __expf(-v0[e])); v1[e] = __builtin_amdgcn_rcpf(1.0f + __expf(-v1[e])); }
                u32x4 w; w.x = cvt_pk_bf16(v0[0], v0[1]); w.y = cvt_pk_bf16(v0[2], v0[3]); w.z = cvt_pk_bf16(v1[0], v1[1]); w.w = cvt_pk_bf16(v1[2], v1[3]);
                *(u32x4*)(rowp + bj * HALF) = w; } }
    }
};
__device__ __forceinline__ float bf_lo(unsigned w) { return __builtin_bit_cast(float, w << 16); }
__device__ __forceinline__ float bf_hi(unsigned w) { return __builtin_bit_cast(float, w & 0xffff0000u); }
struct EpiMulAdd {
    static constexpr bool PERM = true, AFTER_DRAIN = false;
    bf16_t* O; const bf16_t* Gt; const bf16_t* Ad; int ldc;
    __device__ __forceinline__ void operator()(const f32x4 (&acc)[2][2][4][2], const Unit& u, int wr, int wc, int fr, int fq) const {
        const int row0 = u.pm * BM + wr * 64 + fr, col0 = u.pn * BM + wc * 32 + 8 * fq;
#pragma unroll
        EPI_LOOP_ROWS { EPI_PIN; const size_t ro = (size_t)(row0 + ai * HALF + m * 16) * ldc + col0;
#pragma unroll
            for (int bj = 0; bj < 2; ++bj) { const f32x4 v0 = acc[ai][bj][m][0], v1 = acc[ai][bj][m][1];
                const u32x4 g = *(const u32x4*)(Gt + ro + bj * HALF);
                float o[8];
                o[0] = bf_lo(g.x) * v0[0]; o[1] = bf_hi(g.x) * v0[1]; o[2] = bf_lo(g.y) * v0[2]; o[3] = bf_hi(g.y) * v0[3];
                o[4] = bf_lo(g.z) * v1[0]; o[5] = bf_hi(g.z) * v1[1]; o[6] = bf_lo(g.w) * v1[2]; o[7] = bf_hi(g.w) * v1[3];
                if (Ad) { const u32x4 a = *(const u32x4*)(Ad + ro + bj * HALF);
                    o[0] += bf_lo(a.x); o[1] += bf_hi(a.x); o[2] += bf_lo(a.y); o[3] += bf_hi(a.y); o[4] += bf_lo(a.z); o[5] += bf_hi(a.z); o[6] += bf_lo(a.w); o[7] += bf_hi(a.w); }
                u32x4 w; w.x = cvt_pk_bf16(o[0], o[1]); w.y = cvt_pk_bf16(o[2], o[3]); w.z = cvt_pk_bf16(o[4], o[5]); w.w = cvt_pk_bf16(o[6], o[7]);
                *(u32x4*)(O + ro + bj * HALF) = w; } }
    }
};
struct EpiResid {
    static constexpr bool PERM = false, AFTER_DRAIN = false;
    float* X; const float* gate;
    const float* xin; const float* cin;
    __device__ __forceinline__ void operator()(const f32x4 (&acc)[2][2][4][2], const Unit& u, int wr, int wc, int fr, int fq) const {
        const int row0 = u.pm * BM + wr * 64 + fr, col0 = u.pn * BM + wc * 32 + 4 * fq;
        const int bb = u.pm / 33, pt = u.pm - bb * 33, mr = (pt == 0) ? 2 : bb;
        const float* gp = gate + (size_t)mr * 12288 + col0;
        const float* sbase = xin ? (pt == 0 ? cin + (size_t)bb * CTXL * DM : xin + ((size_t)bb * SEQ + (size_t)(pt - 1) * BM) * DM) : X + (size_t)u.pm * BM * DM;
        f32x4 gv[2][2];
#pragma unroll
        for (int bj = 0; bj < 2; ++bj)
#pragma unroll
            for (int n = 0; n < 2; ++n) gv[bj][n] = *(const f32x4*)(gp + bj * HALF + n * 16);
#pragma unroll
        EPI_LOOP_ROWS { EPI_PIN; const int rl = wr * 64 + fr + ai * HALF + m * 16; float* rowp = X + (size_t)(u.pm * BM + rl) * DM + col0; const float* srow = sbase + (size_t)rl * DM + col0;
#pragma unroll
            for (int bj = 0; bj < 2; ++bj)
#pragma unroll
                for (int n = 0; n < 2; ++n) *(f32x4*)(rowp + bj * HALF + n * 16) = *(const f32x4*)(srow + bj * HALF + n * 16) + gv[bj][n] * acc[ai][bj][m][n]; }
    }
};
struct EpiF32 {
    static constexpr bool PERM = false, AFTER_DRAIN = false;
    float* C; int ldc;
    __device__ __forceinline__ void operator()(const f32x4 (&acc)[2][2][4][2], const Unit& u, int wr, int wc, int fr, int fq) const {
        const int row0 = u.pm * BM + wr * 64 + fr, col0 = u.pn * BM + wc * 32 + 4 * fq;
#pragma unroll
        EPI_LOOP_ROWS { float* rowp = C + (size_t)(row0 + ai * HALF + m * 16) * ldc + col0;
#pragma unroll
            for (int bj = 0; bj < 2; ++bj)
#pragma unroll
                for (int n = 0; n < 2; ++n) *(f32x4*)(rowp + bj * HALF + n * 16) = acc[ai][bj][m][n]; }
    }
};
struct EpiQ {
    static constexpr bool PERM = true, AFTER_DRAIN = false;
    bf16_t* Q; const f32x2* rope; float qscale;
    __device__ __forceinline__ void operator()(const f32x4 (&acc)[2][2][4][2], const Unit& u, int wr, int wc, int fr, int fq) const {
        const int bb = u.pm / 33, tp0 = (u.pm - bb * 33) * BM + wr * 64 + fr, col0 = u.pn * BM + wc * 32 + 8 * fq;
#pragma unroll
        for (int bj = 0; bj < 2; ++bj) { const int c = col0 + bj * HALF, hd = c / QKD, d = c - hd * QKD;
#pragma unroll
            EPI_LOOP_ROWS { EPI_PIN; const int tp = tp0 + ai * HALF + m * 16;
                f32x4 v0 = acc[ai][bj][m][0], v1 = acc[ai][bj][m][1];
                if (d >= 64) { const int i0 = (d - 64) >> 1; const f32x2* rp = rope + (size_t)tp * 16 + i0;
                    const f32x2 c0 = rp[0], c1 = rp[1], c2 = rp[2], c3 = rp[3];
                    float a, b;
                    a = v0[0]; b = v0[1]; v0[0] = a * c0.x - b * c0.y; v0[1] = a * c0.y + b * c0.x;
                    a = v0[2]; b = v0[3]; v0[2] = a * c1.x - b * c1.y; v0[3] = a * c1.y + b * c1.x;
                    a = v1[0]; b = v1[1]; v1[0] = a * c2.x - b * c2.y; v1[1] = a * c2.y + b * c2.x;
                    a = v1[2]; b = v1[3]; v1[2] = a * c3.x - b * c3.y; v1[3] = a * c3.y + b * c3.x; }
                v0 = v0 * qscale; v1 = v1 * qscale;
                u32x4 w; w.x = cvt_pk_bf16(v0[0], v0[1]); w.y = cvt_pk_bf16(v0[2], v0[3]); w.z = cvt_pk_bf16(v1[0], v1[1]); w.w = cvt_pk_bf16(v1[2], v1[3]);
                *(u32x4*)(Q + ((size_t)(bb * NH + hd) * TPB + tp) * QKD + d) = w; } }
    }
};
struct EpiKV {
    static constexpr bool PERM = true, AFTER_DRAIN = false;
    bf16_t* K; bf16_t* V;
    __device__ __forceinline__ void operator()(const f32x4 (&acc)[2][2][4][2], const Unit& u, int wr, int wc, int fr, int fq) const {
        const int bb = u.pm / 33, tp0 = (u.pm - bb * 33) * BM + wr * 64 + fr;
        const bool isK = wc < 2;
        bf16_t* base = isK ? K : V; const int pitch = isK ? QKD : 64, doff = 32 * (wc & 1) + 8 * fq;
#pragma unroll
        for (int bj = 0; bj < 2; ++bj) { const int hd = 2 * u.pn + bj;
            bf16_t* hb = base + (size_t)(bb * NH + hd) * TPB * pitch;
#pragma unroll
            EPI_LOOP_ROWS { EPI_PIN; const int tp = tp0 + ai * HALF + m * 16;
                const f32x4 v0 = acc[ai][bj][m][0], v1 = acc[ai][bj][m][1];
                u32x4 w; w.x = cvt_pk_bf16(v0[0], v0[1]); w.y = cvt_pk_bf16(v0[2], v0[3]); w.z = cvt_pk_bf16(v1[0], v1[1]); w.w = cvt_pk_bf16(v1[2], v1[3]);
                *(u32x4*)((char*)hb + (unsigned)((tp * pitch + doff) * 2)) = w; } }
    }
};
}

struct TItem { const float* W; bf16* WT; int K, ldw, c0, N, mapq, item; };
__device__ __forceinline__ void p0_item_load(const TItem& T, int lane, f32x4 (&x)[8]) {
    const int nblk = T.N / 32, kb = T.item / nblk, nb = T.item - kb * nblk, k0 = 64 * kb, n0 = 32 * nb;
    const float* p = T.W + (size_t)(k0 + (lane >> 3)) * T.ldw + T.c0 + n0 + (lane & 7) * 4;
#pragma unroll
    for (int i = 0; i < 8; ++i) x[i] = *(const GAS f32x4*)(p + (size_t)(8 * i) * T.ldw);
}
__device__ __forceinline__ void p0_item_finish(const TItem& T, const f32x4 (&x)[8], LAS float* scr, int lane) {
    const int nblk = T.N / 32, kb = T.item / nblk, nb = T.item - kb * nblk, k0 = 64 * kb, n0 = 32 * nb;
#pragma unroll
    for (int i = 0; i < 8; ++i) { LAS float* d = scr + (8 * i + (lane >> 3)) * 33 + (lane & 7) * 4; d[0] = x[i].x; d[1] = x[i].y; d[2] = x[i].z; d[3] = x[i].w; }
    LDS_WAIT(); asm volatile("" ::: "memory");
    const int c = lane & 7;
#pragma unroll
    for (int j = 0; j < 4; ++j) { const int n = (lane >> 3) + 8 * j; const LAS float* s = scr + (8 * c) * 33 + n;
        v4u o; o.x = pk2(s[0 * 33], s[1 * 33]); o.y = pk2(s[2 * 33], s[3 * 33]); o.z = pk2(s[4 * 33], s[5 * 33]); o.w = pk2(s[6 * 33], s[7 * 33]);
        int nn = n0 + n;
        if (T.mapq) { const int hd = nn / QKD, d = nn - hd * QKD; if (d >= 64) { const int i = (d - 64) & 15, s2 = (d - 64) >> 4; nn = hd * QKD + 64 + 2 * i + s2; } }
        *(GAS v4u*)(T.WT + (size_t)nn * T.K + k0 + 8 * c) = o; }
    LDS_WAIT(); asm volatile("" ::: "memory");
}

__device__ __forceinline__ const float* karg(int i);
constexpr int TB_INA = (DM / 128) * ((INA + 127) / 128), TB_G = (DM / 128) * (DM / 128), TB_BR = (RW / 128) * (DM / 128), TB_UQ = (512 / 128) * (NQ / 128), TB_UKV = (256 / 128) * (NKV / 128);
constexpr int TB_N = TB_INA + 2 * TB_G + 2 * TB_BR + TB_G + TB_UQ + TB_UKV;
constexpr int TI_LR = 1 * (RW / 32), TI_N = 4 * TI_LR;
__device__ __forceinline__ TItem p0_resolve_big(unsigned char* ws, int git) {
    const int l = git / TB_N; int r = git - l * TB_N; TItem T; T.mapq = 0; T.c0 = 0;
    if (r < TB_INA) { T.W = karg(7) + (size_t)l * DM * INC; T.K = DM; T.ldw = INC; T.N = INA; T.WT = (bf16*)(ws + WS_WINA) + (size_t)l * INA_P * DM; T.item = r; return T; } r -= TB_INA;
    if (r < TB_G) { T.W = karg(7) + (size_t)l * DM * INC; T.K = DM; T.ldw = INC; T.c0 = INA; T.N = DM; T.WT = (bf16*)(ws + WS_WGA) + (size_t)l * DM * DM; T.item = r; return T; } r -= TB_G;
    if (r < TB_G) { T.W = karg(7) + (size_t)l * DM * INC; T.K = DM; T.ldw = INC; T.c0 = INA + DM; T.N = DM; T.WT = (bf16*)(ws + WS_WGB) + (size_t)l * DM * DM; T.item = r; return T; } r -= TB_G;
    if (r < TB_BR) { T.W = karg(24) + (size_t)l * RW * DM; T.K = RW; T.ldw = DM; T.N = DM; T.WT = (bf16*)(ws + WS_WA) + (size_t)l * DM * RW; T.item = r; return T; } r -= TB_BR;
    if (r < TB_BR) { T.W = karg(25) + (size_t)l * RW * DM; T.K = RW; T.ldw = DM; T.N = DM; T.WT = (bf16*)(ws + WS_WB) + (size_t)l * DM * RW; T.item = r; return T; } r -= TB_BR;
    if (r < TB_G) { T.W = karg(26) + (size_t)l * DM * DM; T.K = DM; T.ldw = DM; T.N = DM; T.WT = (bf16*)(ws + WS_WO) + (size_t)l * DM * DM; T.item = r; return T; } r -= TB_G;
    if (r < TB_UQ) { T.W = karg(21) + (size_t)l * 512 * NQ; T.K = 512; T.ldw = NQ; T.N = NQ; T.WT = (bf16*)(ws + WS_WUQ) + (size_t)l * NQ * 512; T.item = r; T.mapq = 1; return T; } r -= TB_UQ;
    { T.W = karg(23) + (size_t)l * 256 * NKV; T.K = 256; T.ldw = NKV; T.N = NKV; T.WT = (bf16*)(ws + WS_WUKV) + (size_t)l * NKV * 256; T.item = r; return T; }
}
__device__ __forceinline__ void p0_big_load(const TItem& T, int tid, f32x4 (&x)[8]) {
    const int nblk = (T.N + 127) / 128, kb = T.item / nblk, nb = T.item - kb * nblk, k0 = 128 * kb, col = 128 * nb + (tid & 31) * 4;
    const float* p = T.W + (size_t)(k0 + (tid >> 5)) * T.ldw + T.c0 + col; const bool ok = col < T.N;
#pragma unroll
    for (int i = 0; i < 8; ++i) x[i] = ok ? *(const GAS f32x4*)(p + (size_t)(16 * i) * T.ldw) : (f32x4){0.f, 0.f, 0.f, 0.f};
}
__device__ __forceinline__ void p0_big_finish(const TItem& T, const f32x4 (&x)[8], LAS float* tile, int tid) {
    const int nblk = (T.N + 127) / 128, kb = T.item / nblk, nb = T.item - kb * nblk, k0 = 128 * kb, n0 = 128 * nb;
    __syncthreads();
#pragma unroll
    for (int i = 0; i < 8; ++i) *(LAS f32x4*)(tile + ((tid >> 5) + 16 * i) * 132 + (tid & 31) * 4) = x[i];
    __syncthreads();
    const int n = tid & 127, cg = tid >> 7; int nn = n0 + n;
    if (nn < T.N) {
        if (T.mapq) { const int hd = nn / QKD, d = nn - hd * QKD; if (d >= 64) { const int i = (d - 64) & 15, s2 = (d - 64) >> 4; nn = hd * QKD + 64 + 2 * i + s2; } }
#pragma unroll
        for (int c = 0; c < 4; ++c) { const LAS float* s = tile + (32 * cg + 8 * c) * 132 + n;
            v4u o; o.x = pk2(s[0 * 132], s[1 * 132]); o.y = pk2(s[2 * 132], s[3 * 132]); o.z = pk2(s[4 * 132], s[5 * 132]); o.w = pk2(s[6 * 132], s[7 * 132]);
            *(GAS v4u*)(T.WT + (size_t)nn * T.K + k0 + 32 * cg + 8 * c) = o; } }
}
__device__ __forceinline__ TItem p0_resolve(unsigned char* ws, int git) {
    const int l = git / TI_N; int r = git - l * TI_N; TItem T; T.mapq = 0; T.c0 = 0;
    const int which = r / TI_LR, d = which & 1, isa = which >> 1; r -= which * TI_LR;
    T.W = (isa ? karg(13) : karg(11)) + (size_t)(l * 2 + d) * 64 * RW; T.K = 64; T.ldw = RW; T.N = RW; T.WT = (bf16*)(ws + (isa ? WS_AUP : WS_WUP)) + (size_t)(l * 2 + d) * RW * 64; T.item = r; return T;
}
__device__ __forceinline__ void p0_prologue(Frame& F) {
    LAS float* scr = (LAS float*)(F.lds + F.wave * 16384);
    const int gw = F.vcu * NWAVES + F.wave, NGW = F.G * NWAVES;
    unsigned char* ws = F.ws;
    for (int rp_ = 0; rp_ < (DBG_REPEAT == 102 ? 2 : 1); ++rp_)
    { float* modw = (float*)(ws + WS_CTL + CTL_MOD_OFF); const float* adaw = karg(4); const float* adab = karg(5); const float* cin = karg(1); const float* cctx = karg(3);
      LAS float* SIL = (LAS float*)F.lds;
      LAS f32x2* part = (LAS f32x2*)(F.lds + 32768);
      if (F.vcu < NLAYER * 96) {
          for (int i = F.tid; i < 3 * DM; i += 512) { const int r = i >> 11, k = i & 2047; const float c = r < 2 ? cin[r * DM + k] : cctx[k]; SIL[i] = c / (1.f + __expf(-c)); }
          __syncthreads(); }
      for (int uu = F.vcu; uu < NLAYER * 96; uu += F.G) { const int cb = uu % 96, l = uu / 96;
          const int n0 = cb * 128 + F.lane * 2; const float* aw = adaw + (size_t)l * DM * 12288 + n0;
          f32x2 a0 = {0, 0}, a1 = a0, a2 = a0;
#pragma unroll 1
          for (int k0 = F.wave * 256; k0 < F.wave * 256 + 256; k0 += 16) { f32x2 w[16];
#pragma unroll
              for (int j = 0; j < 16; ++j) w[j] = *(const GAS f32x2*)(aw + (size_t)(k0 + j) * 12288);
#pragma unroll
              for (int j = 0; j < 16; ++j) { a0 = a0 + w[j] * SIL[k0 + j]; a1 = a1 + w[j] * SIL[DM + k0 + j]; a2 = a2 + w[j] * SIL[2 * DM + k0 + j]; } }
          __syncthreads();
          part[(F.wave * 3 + 0) * 64 + F.lane] = a0; part[(F.wave * 3 + 1) * 64 + F.lane] = a1; part[(F.wave * 3 + 2) * 64 + F.lane] = a2;
          __syncthreads();
          if (F.wave < 3) { f32x2 s = *(const GAS f32x2*)(adab + (size_t)l * 12288 + n0);
#pragma unroll
              for (int w8 = 0; w8 < 8; ++w8) s = s + part[(w8 * 3 + F.wave) * 64 + F.lane];
              *(GAS f32x2*)(modw + ((size_t)l * 3 + F.wave) * 12288 + n0) = s; }
          __syncthreads(); } }
    for (int rp_ = 0; rp_ < (DBG_REPEAT == 101 ? 2 : 1); ++rp_)
    { unsigned* ctr = (unsigned*)(ws + WS_CTL) + 2048 + 64 * rp_; LAS float* tile = (LAS float*)F.lds; LAS int* slot = (LAS int*)(F.lds + 128 * 132 * 4);
#define P0_GRAB(dst) do { __syncthreads(); if (F.tid == 0) *slot = (int)__hip_atomic_fetch_add(ctr, 1u, __ATOMIC_RELAXED, __HIP_MEMORY_SCOPE_AGENT); __syncthreads(); dst = *slot; } while (0)
      int it; P0_GRAB(it); f32x4 xa[8], xb[8]; TItem T, Tn;
      if (it < NLAYER * TB_N) { T = p0_resolve_big(ws, it); p0_big_load(T, F.tid, xa); }
      while (it < NLAYER * TB_N) { int itn; P0_GRAB(itn); const bool more = itn < NLAYER * TB_N;
          if (more) { Tn = p0_resolve_big(ws, itn); p0_big_load(Tn, F.tid, xb); }
          p0_big_finish(T, xa, tile, F.tid);
          if (more) { T = Tn;
#pragma unroll
              for (int i = 0; i < 8; ++i) xa[i] = xb[i]; }
          it = itn; }
#undef P0_GRAB
      __syncthreads();
      for (int itw = gw; itw < NLAYER * TI_N; itw += NGW) { f32x4 xw[8]; const TItem Tw = p0_resolve(ws, itw); p0_item_load(Tw, F.lane, xw); p0_item_finish(Tw, xw, scr, F.lane); }
    }
    const int gt = gw * 64 + F.lane, NGT = NGW * 64;
    { const float* gup = karg(14);
    for (int i = gt; i < NLAYER * 2 * 32 * RW; i += NGT) { const int ch = i & 1023, r = (i >> 10) & 31, ld = i >> 15;
        ((bf16*)(ws + WS_GUP))[((size_t)ld * RW + ch) * 32 + r] = (bf16)f2bf(gup[i]); } }
    for (int i = gt; i < NLAYER * (INA_P - INA) * DM / 8; i += NGT) { const int l = i / ((INA_P - INA) * DM / 8), r = i - l * ((INA_P - INA) * DM / 8);
        ((GAS v4u*)((bf16*)(ws + WS_WINA) + ((size_t)l * INA_P + INA) * DM))[r] = (v4u){0u, 0u, 0u, 0u}; }
    { f32x2* rt = (f32x2*)(ws + WS_ROPE);
      for (int i = gt; i < TPB * 16; i += NGT) { const int tp = i >> 4, k = i & 15; f32x2 o = {1.f, 0.f};
          if (tp >= CTXL) { const int t = tp - CTXL, row = t >> 6, col = t & 63, j = k & 7; const float fr = powf(10000.0f, -(float)j / 8.0f);
              const float ang = (float)(k < 8 ? row : col) * fr; o.x = cosf(ang); o.y = sinf(ang); }
          rt[i] = o; } }
    for (int rp_ = 0; rp_ < (DBG_REPEAT == 103 ? 2 : 1); ++rp_)
    { LAS float* KEY = (LAS float*)F.lds;
      LAS float* WQT = (LAS float*)(F.lds + 65536);
      const float* pkeys = karg(29); const float* pwq = karg(28);
      __syncthreads();
      for (int uu = F.vcu; uu < NLAYER * 16 * 32; uu += F.G) { const int kb = uu & 31, hp = (uu >> 5) & 15, l = uu >> 9;
          const GAS f32x4* ksrc = (const GAS f32x4*)(pkeys + ((size_t)l * 16 + hp) * 16384);
          for (int i = F.tid; i < 4096; i += 512) ((LAS f32x4*)KEY)[i] = ksrc[i];
          for (int i = F.tid; i < 2048; i += 512) { const int kk = i >> 5, d4 = i & 31;
              *(LAS f32x4*)(WQT + kk * 132 + d4 * 4) = *(const GAS f32x4*)(pwq + ((size_t)l * DM + kb * 64 + kk) * DM + hp * 128 + d4 * 4); }
          __syncthreads();
          const int kq = F.tid & 15, keyq = F.tid >> 4;
          float acc[4][4];
#pragma unroll
          for (int j = 0; j < 4; ++j)
#pragma unroll
              for (int i = 0; i < 4; ++i) acc[j][i] = 0.f;
          for (int d = 0; d < 128; d += 4) { f32x4 w[4], q[4];
#pragma unroll
              for (int i = 0; i < 4; ++i) w[i] = *(LAS f32x4*)(WQT + (kq + 16 * i) * 132 + d);
#pragma unroll
              for (int j = 0; j < 4; ++j) q[j] = *(LAS f32x4*)(KEY + (4 * keyq + j) * 128 + d);
#pragma unroll
              for (int j = 0; j < 4; ++j)
#pragma unroll
                  for (int i = 0; i < 4; ++i) acc[j][i] += q[j].x * w[i].x + q[j].y * w[i].y + q[j].z * w[i].z + q[j].w * w[i].w; }
          bf16* dst = (bf16*)(ws + WS_WQK) + ((size_t)l * DM + hp * 128 + 4 * keyq) * DM + kb * 64 + kq;
#pragma unroll
          for (int j = 0; j < 4; ++j)
#pragma unroll
              for (int i = 0; i < 4; ++i) dst[(size_t)j * DM + 16 * i] = (bf16)f2bf(acc[j][i]);
          __syncthreads(); } }
}

__device__ __forceinline__ void modnorm_phase(Frame& F, const float* X, const float* g, const float* mod  , int chunk_sh, bf16* H, int skip_ctx, const float* xin = nullptr, const float* cin = nullptr) {
    const int gw = F.vcu * NWAVES + F.wave, NGW = F.G * NWAVES;
    for (int m = gw; m < MALL; m += NGW) {
        const int b = m / TPB, tp = m - b * TPB; if (skip_ctx && tp < CTXL) continue;
        const int mr = tp < CTXL ? 2 : b;
        const float* srow = xin ? (tp < CTXL ? cin + ((size_t)b * CTXL + tp) * DM : xin + ((size_t)b * SEQ + (tp - CTXL)) * DM) : X + (size_t)m * DM;
        const GAS f32x4* xr = (const GAS f32x4*)srow + F.lane;
        f32x4 v[8]; float s = 0.f;
#pragma unroll
        for (int j = 0; j < 8; ++j) { v[j] = xr[64 * j]; s += (v[j].x * v[j].x + v[j].y * v[j].y) + (v[j].z * v[j].z + v[j].w * v[j].w); }
        const float rs = rsqrtf(wave_sum(s) * (1.f / DM) + NORM_EPS);
        const float* sh = mod + (size_t)mr * 12288 + chunk_sh * DM; const float* sc = sh + DM;
        GAS v2u* o8 = (GAS v2u*)(H + (size_t)m * DM) + F.lane;
#pragma unroll
        for (int j = 0; j < 8; ++j) { const int c = (F.lane + 64 * j) * 4;
            const f32x4 gg = *(const GAS f32x4*)(g + c), s1 = *(const GAS f32x4*)(sc + c), s0 = *(const GAS f32x4*)(sh + c);
            f32x4 y = v[j] * rs * gg; y = y * (s1 + 1.0f) + s0;
            v2u o; o.x = pk2(y.x, y.y); o.y = pk2(y.z, y.w); o8[64 * j] = o; }
    }
}

typedef float f32x4v __attribute__((ext_vector_type(4)));
#define MFMA16(a, b, c) __builtin_amdgcn_mfma_f32_16x16x32_bf16((a), (b), (c), 0, 0, 0)
#define MFMA32(a, b, c) __builtin_amdgcn_mfma_f32_32x32x16_bf16((a), (b), (c), 0, 0, 0)

struct FeatP {
    const bf16* PA; const float* mu; const float* w0; const float* a0; const float* k_k; const float* k_a; const float* r_k;
    const bf16* WUP; const bf16* AUP; const bf16* GUP;
    const float* qnorm; const float* kvnorm; const f32x2* rope;
    bf16* RI; bf16* GG; float* BON; bf16* QN; bf16* KVN; bf16* K;
};
__device__ __forceinline__ f32x4 ld4bf(const bf16* p) { const v2u w = *(const GAS v2u*)p; return (f32x4){bflo(w.x), bfhi(w.x), bflo(w.y), bfhi(w.y)}; }
__device__ __forceinline__ f32x4 mix4(const bf16* PA, int m, int c, bool hp, bool hn, const float* mu) {
    const f32x4 pc = ld4bf(PA + (size_t)m * INA_P + c);
    f32x4 pp = {0, 0, 0, 0}, pn = {0, 0, 0, 0};
    if (hp) pp = ld4bf(PA + (size_t)(m - 1) * INA_P + c);
    if (hn) pn = ld4bf(PA + (size_t)(m + 1) * INA_P + c);
    const f32x4 mm = *(const GAS f32x4*)(mu + c);
    return pc + ((pp + pn) * 0.5f - pc) * mm;
}
__device__ __forceinline__ void unpack8(const v4u w, float (&x)[8]) { x[0] = bflo(w.x); x[1] = bfhi(w.x); x[2] = bflo(w.y); x[3] = bfhi(w.y); x[4] = bflo(w.z); x[5] = bfhi(w.z); x[6] = bflo(w.w); x[7] = bfhi(w.w); }
__device__ __forceinline__ v4u pack8f(const float (&x)[8]) { v4u o; o.x = pk2(x[0], x[1]); o.y = pk2(x[2], x[3]); o.z = pk2(x[4], x[5]); o.w = pk2(x[6], x[7]); return o; }
__device__ __forceinline__ void mix8(const bf16* rowc, bool hp, bool hn, const float (&mu)[8], float (&o)[8]) {
    const v4u zc = {0u, 0u, 0u, 0u};
    const v4u wc = *(const GAS v4u*)rowc, wp = hp ? *(const GAS v4u*)(rowc - INA_P) : zc, wn = hn ? *(const GAS v4u*)(rowc + INA_P) : zc;
    float c[8], p[8], n[8]; unpack8(wc, c); unpack8(wp, p); unpack8(wn, n);
#pragma unroll
    for (int e = 0; e < 8; ++e) o[e] = c[e] + (0.5f * (p[e] + n[e]) - c[e]) * mu[e];
}
struct Raw3 { v4u c, p, n; };
__device__ __forceinline__ Raw3 load3(const bf16* rowc, bool hp, bool hn) { const v4u zc = {0u, 0u, 0u, 0u}; Raw3 r; r.c = *(const GAS v4u*)rowc; r.p = hp ? *(const GAS v4u*)(rowc - INA_P) : zc; r.n = hn ? *(const GAS v4u*)(rowc + INA_P) : zc; return r; }
__device__ __forceinline__ void mix8r(const Raw3& w, const float (&mu)[8], float (&o)[8]) {
    float c[8], p[8], n[8]; unpack8(w.c, c); unpack8(w.p, p); unpack8(w.n, n);
#pragma unroll
    for (int e = 0; e < 8; ++e) o[e] = c[e] + (0.5f * (p[e] + n[e]) - c[e]) * mu[e];
}
__device__ __forceinline__ void features_phase(Frame& F, const FeatP& P) {
    constexpr int LAP = 328;
    LAS bf16* LA = (LAS bf16*)F.lds;
    LAS float* SSQ = (LAS float*)(F.lds + 10752);
    LAS float* PRM = (LAS float*)(F.lds + 12288);
    const int lane = F.lane, w = F.wave, tk = lane & 15, q4 = lane >> 4;
    constexpr int NTILE = MALL / 16, NTG = 64;
    for (int su = F.vcu; su < 4 * NTG; su += F.G) {
        const int cg = su & 3, tg = su >> 2, cw = 256 * cg + 32 * w, ch8 = cw + 8 * q4, hd = 4 * cg + (w >> 1);
        __syncthreads();
        for (int i = F.tid; i < 2560; i += 512) { const int prm = i >> 8, c = (i & 255) + 256 * cg; float v;
            switch (prm) { case 0: v = P.k_k[c]; break; case 1: v = P.k_a[c]; break; case 2: v = P.r_k[c]; break; case 3: v = P.w0[c]; break; case 4: v = P.w0[RW + c]; break;
                           case 5: v = P.a0[c]; break; case 6: v = P.a0[RW + c]; break; case 7: v = P.mu[c]; break; case 8: v = P.mu[RW + c]; break; default: v = P.mu[2 * RW + c]; break; }
            PRM[i] = v; }
        bf16x8 fw[2][2][2], fa[2][2][2], fg[2][2];
        { const int chA = cw + 8 * (tk >> 2) + (tk & 3);
#pragma unroll
          for (int d = 0; d < 2; ++d)
#pragma unroll
              for (int t = 0; t < 2; ++t) {
#pragma unroll
                  for (int ks = 0; ks < 2; ++ks) { fw[d][t][ks] = *(const GAS bf16x8*)(P.WUP + ((size_t)d * RW + chA + 4 * t) * 64 + ks * 32 + q4 * 8); fa[d][t][ks] = *(const GAS bf16x8*)(P.AUP + ((size_t)d * RW + chA + 4 * t) * 64 + ks * 32 + q4 * 8); }
                  fg[d][t] = *(const GAS bf16x8*)(P.GUP + ((size_t)d * RW + chA + 4 * t) * 32 + q4 * 8); } }
        for (int tt = tg; tt < NTILE; tt += NTG) {
            const int m0 = tt * 16;
            const int m = m0 + tk, b = m / TPB, tp = m - b * TPB;
            const bool hp = (tp != 0) && (tp != CTXL), hn = (tp != CTXL - 1) && (tp != TPB - 1);
            const bf16* rowp = P.PA + (size_t)m * INA_P + ch8;
            const Raw3 rawk = load3(rowp + RW, hp, hn), rawr = load3(rowp, hp, hn), rawv = load3(rowp + 2 * RW, hp, hn);
            __syncthreads();
            for (int it = F.tid; it < 640; it += 512) { const int tkk = it / 40, c8 = (it - tkk * 40) * 8, c = C_WD + c8, m = m0 + tkk, tp = m % TPB;
                const bool hp = (tp != 0) && (tp != CTXL), hn = (tp != CTXL - 1) && (tp != TPB - 1);
                float mu[8], v[8];
                { const f32x4 a = *(const GAS f32x4*)(P.mu + c), b2 = *(const GAS f32x4*)(P.mu + c + 4); mu[0] = a.x; mu[1] = a.y; mu[2] = a.z; mu[3] = a.w; mu[4] = b2.x; mu[5] = b2.y; mu[6] = b2.z; mu[7] = b2.w; }
                mix8(P.PA + (size_t)m * INA_P + c, hp, hn, mu, v);
#pragma unroll
                for (int e = 0; e < 8; ++e) { if (c < C_AD) v[e] = 1.0f - 2.0f * __builtin_amdgcn_rcpf(1.0f + __expf(2.0f * v[e])); else if (c >= C_GD) v[e] = sigmoidf_(v[e]); }
                *(LAS v4u*)(LA + tkk * LAP + c8) = pack8f(v); }
            if ((tt & 3) == cg) {
#pragma unroll
                for (int t2 = 0; t2 < 2; ++t2) { const int m = m0 + 2 * w + t2, b = m / TPB, tp = m - b * TPB; const bf16* row = P.PA + (size_t)m * INA_P;
                    { float x[8]; unpack8(*(const GAS v4u*)(row + C_QC + lane * 8), x); float s = 0.f;
#pragma unroll
                      for (int e = 0; e < 8; ++e) s += x[e] * x[e];
                      const float rs = rsqrtf(wave_sum(s) * (1.f / 512.f) + NORM_EPS);
#pragma unroll
                      for (int e = 0; e < 8; ++e) x[e] = x[e] * rs * P.qnorm[lane * 8 + e];
                      *(GAS v4u*)(P.QN + (size_t)m * 512 + lane * 8) = pack8f(x); }
                    { const v2u q = *(const GAS v2u*)(row + C_KVC + lane * 4);
                      float x[4] = {bflo(q.x), bfhi(q.x), bflo(q.y), bfhi(q.y)}; float s = 0.f;
#pragma unroll
                      for (int e = 0; e < 4; ++e) s += x[e] * x[e];
                      const float rs = rsqrtf(wave_sum(s) * (1.f / 256.f) + NORM_EPS);
#pragma unroll
                      for (int e = 0; e < 4; ++e) x[e] = x[e] * rs * P.kvnorm[lane * 4 + e];
                      v2u o; o.x = pk2(x[0], x[1]); o.y = pk2(x[2], x[3]);
                      *(GAS v2u*)(P.KVN + (size_t)m * 256 + lane * 4) = o; }
                    if (lane < 16) { const float x1 = bf1(row[C_KR + lane]), x2 = bf1(row[C_KR + 16 + lane]); const f32x2 cs = P.rope[(size_t)tp * 16 + lane];
                        const unsigned o = pk2(x1 * cs.x - x2 * cs.y, x1 * cs.y + x2 * cs.x);
#pragma unroll
                        for (int h2 = 0; h2 < NH; ++h2) *(GAS unsigned*)(P.K + ((size_t)(b * NH + h2) * TPB + tp) * QKD + 64 + 2 * lane) = o; } } }
            const int pc = 32 * w + 8 * q4;
            float prm[8], kmx[8], kx[8];
#pragma unroll
            for (int e = 0; e < 8; ++e) prm[e] = PRM[8 * 256 + pc + e];
            mix8r(rawk, prm, kmx);
            { float s = 0.f;
#pragma unroll
              for (int e = 0; e < 8; ++e) { kx[e] = kmx[e] * PRM[0 * 256 + pc + e]; s += kx[e] * kx[e]; }
              s += bpermf(lane ^ 16, s); s += bpermf(lane ^ 32, s);
              if (q4 == 0) SSQ[tk * 8 + w] = s; }
            __syncthreads();
            const float rsn = rsqrtf(SSQ[tk * 8 + w] + SSQ[tk * 8 + (w ^ 1)] + 1e-12f);
            f32x4 cw_[2][2], ca_[2][2], cg_[2][2];
#pragma unroll
            for (int d = 0; d < 2; ++d) {
                const bf16x8 bg = *(const LAS bf16x8*)(LA + tk * LAP + 256 + d * 32 + q4 * 8);
                bf16x8 bw[2], ba[2];
#pragma unroll
                for (int ks = 0; ks < 2; ++ks) { bw[ks] = *(const LAS bf16x8*)(LA + tk * LAP + d * 64 + ks * 32 + q4 * 8); ba[ks] = *(const LAS bf16x8*)(LA + tk * LAP + 128 + d * 64 + ks * 32 + q4 * 8); }
#pragma unroll
                for (int t = 0; t < 2; ++t) { f32x4 z = {0, 0, 0, 0};
                    cw_[d][t] = MFMA16(fw[d][t][1], bw[1], MFMA16(fw[d][t][0], bw[0], z));
                    ca_[d][t] = MFMA16(fa[d][t][1], ba[1], MFMA16(fa[d][t][0], ba[0], z));
                    cg_[d][t] = MFMA16(fg[d][t], bg, z); } }
            float r8[8], v8[8], kk8[8];
#pragma unroll
            for (int e = 0; e < 8; ++e) prm[e] = PRM[7 * 256 + pc + e];
            mix8r(rawr, prm, r8);
#pragma unroll
            for (int e = 0; e < 8; ++e) prm[e] = PRM[9 * 256 + pc + e];
            mix8r(rawv, prm, v8);
#pragma unroll
            for (int e = 0; e < 8; ++e) kk8[e] = kx[e] * rsn;
            bf16* rec = P.RI + ((size_t)(b * NH + hd) * TPB + tp) * RREC + (ch8 & 63);
            *(GAS v4u*)(rec) = pack8f(r8); *(GAS v4u*)(rec + 64) = pack8f(kk8); *(GAS v4u*)(rec + 128) = pack8f(v8);
#pragma unroll
            for (int d = 0; d < 2; ++d) {
                float ld[8], ke[8], bb[8], gg[8]; float bs = 0.f;
#pragma unroll
                for (int e = 0; e < 8; ++e) { const int t = e >> 2, r = e & 3;
                    ld[e] = -0.60653066f * sigmoidf_(PRM[(3 + d) * 256 + pc + e] + cw_[d][t][r]);
                    const float aa = sigmoidf_(PRM[(5 + d) * 256 + pc + e] + ca_[d][t][r]);
                    ke[e] = kmx[e] * (1.0f + (aa - 1.0f) * PRM[1 * 256 + pc + e]); bb[e] = kk8[e] * aa; gg[e] = cg_[d][t][r];
                    bs += r8[e] * ke[e] * PRM[2 * 256 + pc + e]; }
                *(GAS v4u*)(rec + (3 + 3 * d) * 64) = pack8f(ld); *(GAS v4u*)(rec + (4 + 3 * d) * 64) = pack8f(bb); *(GAS v4u*)(rec + (5 + 3 * d) * 64) = pack8f(ke);
                *(GAS v4u*)(P.GG + ((size_t)d * MALL + m) * RW + ch8) = pack8f(gg);
                bs += bpermf(lane ^ 16, bs); bs += bpermf(lane ^ 32, bs);
                if (q4 == 0) P.BON[((size_t)d * MALL + m) * 32 + 2 * hd + (w & 1)] = bs; }
        }
    }
}

constexpr int SCH = 32;
constexpr int SSTEP = 6 * 64;
__device__ __forceinline__ int scan_tp(int dir, int s) { return dir == 0 ? s : (s < CTXL ? (CTXL - 1 - s) : (TPB - 1 - (s - CTXL))); }
__device__ __forceinline__ void scan_load(v4u (&rg)[6], const bf16* RIh, int dir, int chunk, int htid) {
    const int tp = scan_tp(dir, chunk * SCH + (htid >> 3));
    const bf16* rec = RIh + (size_t)tp * RREC + (htid & 7) * 8;
#pragma unroll
    for (int i = 0; i < 3; ++i) rg[i] = *(const GAS v4u*)(rec + i * 64);
    rec += (3 + 3 * dir) * 64;
#pragma unroll
    for (int i = 0; i < 3; ++i) rg[3 + i] = *(const GAS v4u*)(rec + i * 64);
}
__device__ __forceinline__ void scan_store(const v4u (&rg)[6], LAS float* buf, int htid) {
    LAS float* d0 = buf + (htid >> 3) * SSTEP + (htid & 7) * 8;
#pragma unroll
    for (int i = 0; i < 6; ++i) { constexpr int SLOT[6] = {4, 0, 5, 2, 1, 3};
        const v4u wv = rg[i];
        f32x4 lo = {bflo(wv.x), bfhi(wv.x), bflo(wv.y), bfhi(wv.y)}, hi = {bflo(wv.z), bfhi(wv.z), bflo(wv.w), bfhi(wv.w)};
        if (i == 3) {
#pragma unroll
            for (int e = 0; e < 4; ++e) { lo[e] = __expf(lo[e]); hi[e] = __expf(hi[e]); } }
        LAS float* d = d0 + SLOT[i] * 64;
        *(LAS f32x4*)d = lo; *(LAS f32x4*)(d + 4) = hi; }
}
__device__ __forceinline__ void scan_phase(Frame& F, const bf16* RI, bf16* Y) {
    LAS float* bufs = (LAS float*)F.lds;
    constexpr int NCH = TPB / SCH;
    for (int uu = F.vcu; uu < NBATCH * NH * 2 * 4; uu += F.G) {
        const int rg = uu & 3, dir = (uu >> 2) & 1, hd = (uu >> 3) & 15, b = uu >> 7;
        const bf16* RIh = RI + (size_t)(b * NH + hd) * TPB * RREC;
        const int htid = F.tid - 256;
        v4u ra[6], rb[6];
        __syncthreads();
        if (F.wave >= 4) { scan_load(rb, RIh, dir, 0, htid); scan_load(ra, RIh, dir, 1, htid); scan_store(rb, bufs, htid); scan_load(rb, RIh, dir, 2, htid); }
        __syncthreads();
        const int j = F.lane & 15, rowl = F.lane >> 4, row = rg * 16 + (F.wave & 3) * 4 + rowl;
        f32x2 S01 = {0.f, 0.f}, S23 = {0.f, 0.f};
        bf16* yb = Y + ((size_t)dir * MALL + (size_t)b * TPB) * RW + hd * 64 + row;
        for (int c = 0; c < NCH; ++c) {
            LAS float* cur = bufs + (c & 1) * (SCH * SSTEP);
            if (F.wave >= 4) {
                if (c + 1 < NCH) {
                    if ((c & 1) == 0) { scan_store(ra, bufs + (SCH * SSTEP), htid); if (c + 3 < NCH) scan_load(ra, RIh, dir, c + 3, htid); }
                    else { scan_store(rb, bufs, htid); if (c + 3 < NCH) scan_load(rb, RIh, dir, c + 3, htid); } } }
            else {
#pragma unroll
                for (int h16 = 0; h16 < 2; ++h16) {
                    const LAS float* sp = cur + (h16 * 16) * SSTEP;
                    f32x4 kk = *(const LAS f32x4*)(sp + 4 * j), bb = *(const LAS f32x4*)(sp + 64 + 4 * j), ww = *(const LAS f32x4*)(sp + 128 + 4 * j),
                          ke = *(const LAS f32x4*)(sp + 192 + 4 * j), rr = *(const LAS f32x4*)(sp + 256 + 4 * j);
                    float vv = sp[320 + row], ykeep = 0.f, ypart = 0.f;
#pragma unroll
                    for (int st = 0; st < 16; ++st) {
                        f32x4 nkk = kk, nbb = bb, nww = ww, nke = ke, nrr = rr; float nvv = vv;
                        if (st + 1 < 16) { const LAS float* sn = sp + (st + 1) * SSTEP;
                            nkk = *(const LAS f32x4*)(sn + 4 * j); nbb = *(const LAS f32x4*)(sn + 64 + 4 * j); nww = *(const LAS f32x4*)(sn + 128 + 4 * j);
                            nke = *(const LAS f32x4*)(sn + 192 + 4 * j); nrr = *(const LAS f32x4*)(sn + 256 + 4 * j); nvv = sn[320 + row]; }
                        f32x2 t2 = S01 * kk.xy; t2 = S23 * kk.zw + t2;
                        const float p = t2.x + t2.y;
                        S01 = S01 * ww.xy + ke.xy * vv; S23 = S23 * ww.zw + ke.zw * vv;
                        const float sa = -red16(p);
                        S01 = bb.xy * sa + S01; S23 = bb.zw * sa + S23;
                        if (st > 0) { const float y = red16(ypart); ykeep = (j == st - 1) ? y : ykeep; }
                        f32x2 u2 = S01 * rr.xy; u2 = S23 * rr.zw + u2;
                        ypart = u2.x + u2.y;
                        kk = nkk; bb = nbb; ww = nww; ke = nke; rr = nrr; vv = nvv;
                        __builtin_amdgcn_sched_barrier(0);
                    }
                    { const float y = red16(ypart); ykeep = (j == 15) ? y : ykeep; }
                    const int tp = scan_tp(dir, c * SCH + h16 * 16 + j);
                    *(GAS bf16*)(yb + (size_t)tp * RW) = (bf16)f2bf(ykeep);
                }
            }
            __syncthreads();
        }
    }
}

constexpr int AKP = 208, AVP = 192;
constexpr int ATILE = 64 * AKP + 64 * AVP;
__device__ __forceinline__ bf16x8 pack8(const f32x16& x, int s) {
    v4u p; p.x = pk2(x[8 * s + 0], x[8 * s + 1]); p.y = pk2(x[8 * s + 2], x[8 * s + 3]); p.z = pk2(x[8 * s + 4], x[8 * s + 5]); p.w = pk2(x[8 * s + 6], x[8 * s + 7]);
    return __builtin_bit_cast(bf16x8, p);
}
__device__ __forceinline__ void attn_phase(Frame& F, const bf16* Q, const bf16* K, const bf16* V, bf16* YB, int with_ctx) {
    const int lane = F.lane, half = lane >> 5, l31 = lane & 31, l16 = lane & 15, g1 = (lane >> 4) & 1;
    const int nunits = NBATCH * NH * 32 + (with_ctx ? NBATCH * NH : 0);
    for (int uu = F.vcu; uu < nunits; uu += F.G) {
        int bh, q0, nkt;
        if (uu < NBATCH * NH * 32) { bh = uu >> 5; q0 = CTXL + (uu & 31) * 256; nkt = TPB / 64; } else { bh = uu - NBATCH * NH * 32; q0 = 0; nkt = CTXL / 64; }
        const bf16* Kh = K + (size_t)bh * TPB * QKD; const bf16* Vh = V + (size_t)bh * TPB * 64; const bf16* Qh = Q + (size_t)bh * TPB * QKD;
        const int tq = q0 + F.wave * 32 + l31;
        bf16x8 qf[6];
#pragma unroll
        for (int ks = 0; ks < 6; ++ks) qf[ks] = *(const GAS bf16x8*)(Qh + (size_t)tq * QKD + 16 * ks + 8 * half);
        f32x16 o0, o1;
#pragma unroll
        for (int i = 0; i < 16; ++i) { o0[i] = 0.f; o1[i] = 0.f; }
        float m_run = -1e30f, l_run = 0.f;
        const int kc1 = F.tid + 512; const bool k1ok = kc1 < 768;
        const unsigned kd0 = (unsigned)((F.tid / 12) * AKP + (F.tid % 12) * 16), kd1 = (unsigned)((kc1 / 12) * AKP + (kc1 % 12) * 16), vd = (unsigned)(64 * AKP + (F.tid >> 3) * AVP + (F.tid & 7) * 16);
        v4u kr0, kr1 = {0, 0, 0, 0}, vr;
        kr0 = *(const GAS v4u*)(Kh + (size_t)F.tid * 8); if (k1ok) kr1 = *(const GAS v4u*)(Kh + (size_t)kc1 * 8); vr = *(const GAS v4u*)(Vh + (size_t)F.tid * 8);
        __syncthreads();
        *(LAS v4u*)(F.lds + kd0) = kr0; if (k1ok) *(LAS v4u*)(F.lds + kd1) = kr1; *(LAS v4u*)(F.lds + vd) = vr;
        __syncthreads();
        for (int kt = 0; kt < nkt; ++kt) {
            const bool more = kt + 1 < nkt;
            if (more) { const bf16* kn = Kh + (size_t)(kt + 1) * 64 * QKD; const bf16* vn = Vh + (size_t)(kt + 1) * 64 * 64;
                kr0 = *(const GAS v4u*)(kn + (size_t)F.tid * 8); if (k1ok) kr1 = *(const GAS v4u*)(kn + (size_t)kc1 * 8); vr = *(const GAS v4u*)(vn + (size_t)F.tid * 8); }
            LAS unsigned char* Kb = F.lds + (kt & 1) * ATILE; LAS unsigned char* Vb = Kb + 64 * AKP;
            f32x16 s0, s1;
#pragma unroll
            for (int i = 0; i < 16; ++i) { s0[i] = 0.f; s1[i] = 0.f; }
            { bf16x8 ka[6], kb2[6];
#pragma unroll
              for (int ks = 0; ks < 6; ++ks) { ka[ks] = *(const LAS bf16x8*)(Kb + l31 * AKP + (16 * ks + 8 * half) * 2); kb2[ks] = *(const LAS bf16x8*)(Kb + (32 + l31) * AKP + (16 * ks + 8 * half) * 2); }
#pragma unroll
              for (int ks = 0; ks < 6; ++ks) { s0 = MFMA32(ka[ks], qf[ks], s0); s1 = MFMA32(kb2[ks], qf[ks], s1); }
              __builtin_amdgcn_sched_group_barrier(0x100, 12, 0); __builtin_amdgcn_sched_group_barrier(0x8, 12, 0); }
            bf16x8 va[2][2][2];
#pragma unroll
            for (int t = 0; t < 2; ++t)
#pragma unroll
                for (int s = 0; s < 2; ++s) { const int kb = 32 * t + 16 * s + 4 * half + (l16 >> 2);
#pragma unroll
                    for (int dvt = 0; dvt < 2; ++dvt) { const LAS unsigned char* vp = Vb + kb * AVP + (32 * dvt + 16 * g1 + 4 * (l16 & 3)) * 2;
                        const s16x4 lo = __builtin_amdgcn_ds_read_tr16_b64_v4i16((LAS s16x4*)vp), hi = __builtin_amdgcn_ds_read_tr16_b64_v4i16((LAS s16x4*)(vp + 8 * AVP));
                        va[t][s][dvt] = __builtin_shufflevector(lo, hi, 0, 1, 2, 3, 4, 5, 6, 7); } }
            __builtin_amdgcn_sched_group_barrier(0x100, 16, 0);
            float mx = s0[0];
#pragma unroll
            for (int i = 1; i < 16; ++i) mx = fmaxf(mx, s0[i]);
#pragma unroll
            for (int i = 0; i < 16; ++i) mx = fmaxf(mx, s1[i]);
            mx = fmaxf(mx, bpermf(lane ^ 32, mx));
            if (__any(mx > m_run + 8.0f)) {
                const float m_new = fmaxf(m_run, mx), alpha = __builtin_amdgcn_exp2f(m_run - m_new); m_run = m_new;
                l_run *= alpha;
#pragma unroll
                for (int i = 0; i < 16; ++i) { o0[i] *= alpha; o1[i] *= alpha; }
            }
            float ps = 0.f;
#pragma unroll
            for (int i = 0; i < 16; ++i) { s0[i] = __builtin_amdgcn_exp2f(s0[i] - m_run); s1[i] = __builtin_amdgcn_exp2f(s1[i] - m_run); ps += s0[i] + s1[i]; }
            l_run += ps;
            { bf16x8 pf[2][2];
#pragma unroll
              for (int t = 0; t < 2; ++t)
#pragma unroll
                  for (int s = 0; s < 2; ++s) pf[t][s] = pack8(t == 0 ? s0 : s1, s);
#pragma unroll
              for (int t = 0; t < 2; ++t)
#pragma unroll
                  for (int s = 0; s < 2; ++s) { o0 = MFMA32(va[t][s][0], pf[t][s], o0); o1 = MFMA32(va[t][s][1], pf[t][s], o1); } }
            if (more) { LAS unsigned char* nb = F.lds + ((kt + 1) & 1) * ATILE;
                *(LAS v4u*)(nb + kd0) = kr0; if (k1ok) *(LAS v4u*)(nb + kd1) = kr1; *(LAS v4u*)(nb + vd) = vr; }
            __syncthreads();
        }
        const float linv = (DBG_SKIP & 4) ? 0.f : 1.0f / (l_run + bpermf(lane ^ 32, l_run));
        const int b = bh >> 4, hd = bh & 15;
        bf16* op = YB + ((size_t)b * TPB + tq) * RW + hd * 64 + 4 * half;
#pragma unroll
        for (int g = 0; g < 4; ++g) {
            v2u w; w.x = pk2(o0[4 * g] * linv, o0[4 * g + 1] * linv); w.y = pk2(o0[4 * g + 2] * linv, o0[4 * g + 3] * linv); *(GAS v2u*)(op + 8 * g) = w;
            w.x = pk2(o1[4 * g] * linv, o1[4 * g + 1] * linv); w.y = pk2(o1[4 * g + 2] * linv, o1[4 * g + 3] * linv); *(GAS v2u*)(op + 32 + 8 * g) = w; }
    }
}

__device__ __forceinline__ void readout_phase(Frame& F, const bf16* Y, const bf16* GG, const float* BON, const bf16* RI, const float* ln_w, const float* ln_b, bf16* YA) {
    const int gw = F.vcu * NWAVES + F.wave, NGW = F.G * NWAVES, lane = F.lane, hd = lane >> 2, ch0 = hd * 64 + (lane & 3) * 16;
    for (int m = gw; m < MALL; m += NGW) {
        const int b = m / TPB, tp = m - b * TPB;
        const bf16* rec = RI + ((size_t)(b * NH + hd) * TPB + tp) * RREC + 128 + (lane & 3) * 16;
        float vv[16], out[16];
        { const v4u a = *(const GAS v4u*)rec, c = *(const GAS v4u*)(rec + 8);
          vv[0] = bflo(a.x); vv[1] = bfhi(a.x); vv[2] = bflo(a.y); vv[3] = bfhi(a.y); vv[4] = bflo(a.z); vv[5] = bfhi(a.z); vv[6] = bflo(a.w); vv[7] = bfhi(a.w);
          vv[8] = bflo(c.x); vv[9] = bfhi(c.x); vv[10] = bflo(c.y); vv[11] = bfhi(c.y); vv[12] = bflo(c.z); vv[13] = bfhi(c.z); vv[14] = bflo(c.w); vv[15] = bfhi(c.w); }
#pragma unroll
        for (int e = 0; e < 16; ++e) out[e] = 0.f;
#pragma unroll
        for (int d = 0; d < 2; ++d) {
            const bf16* yp = Y + ((size_t)d * MALL + m) * RW + ch0; const bf16* gp = GG + ((size_t)d * MALL + m) * RW + ch0;
            float y[16], g[16];
            { const v4u a = *(const GAS v4u*)yp, c = *(const GAS v4u*)(yp + 8);
              y[0] = bflo(a.x); y[1] = bfhi(a.x); y[2] = bflo(a.y); y[3] = bfhi(a.y); y[4] = bflo(a.z); y[5] = bfhi(a.z); y[6] = bflo(a.w); y[7] = bfhi(a.w);
              y[8] = bflo(c.x); y[9] = bfhi(c.x); y[10] = bflo(c.y); y[11] = bfhi(c.y); y[12] = bflo(c.z); y[13] = bfhi(c.z); y[14] = bflo(c.w); y[15] = bfhi(c.w); }
            { const v4u a = *(const GAS v4u*)gp, c = *(const GAS v4u*)(gp + 8);
              g[0] = bflo(a.x); g[1] = bfhi(a.x); g[2] = bflo(a.y); g[3] = bfhi(a.y); g[4] = bflo(a.z); g[5] = bfhi(a.z); g[6] = bflo(a.w); g[7] = bfhi(a.w);
              g[8] = bflo(c.x); g[9] = bfhi(c.x); g[10] = bflo(c.y); g[11] = bfhi(c.y); g[12] = bflo(c.z); g[13] = bfhi(c.z); g[14] = bflo(c.w); g[15] = bfhi(c.w); }
            float s = 0.f;
#pragma unroll
            for (int e = 0; e < 16; ++e) s += y[e];
            s = dpp_add<0xB1>(s); s = dpp_add<0x4E>(s);
            const float mean = s * (1.f / 64.f); float q = 0.f;
#pragma unroll
            for (int e = 0; e < 16; ++e) { y[e] -= mean; q += y[e] * y[e]; }
            q = dpp_add<0xB1>(q); q = dpp_add<0x4E>(q);
            const float rstd = rsqrtf(q * (1.f / 64.f) + 64e-5f), bon = BON[((size_t)d * MALL + m) * 32 + 2 * hd] + BON[((size_t)d * MALL + m) * 32 + 2 * hd + 1];
#pragma unroll
            for (int e = 0; e < 16; ++e) out[e] += (y[e] * rstd * ln_w[ch0 + e] + ln_b[ch0 + e] + bon * vv[e]) * g[e];
        }
        if (DBG_SKIP & 2) {
#pragma unroll
            for (int e = 0; e < 16; ++e) out[e] = 0.f; }
        v4u o0, o1;
        o0.x = pk2(out[0], out[1]); o0.y = pk2(out[2], out[3]); o0.z = pk2(out[4], out[5]); o0.w = pk2(out[6], out[7]);
        o1.x = pk2(out[8], out[9]); o1.y = pk2(out[10], out[11]); o1.z = pk2(out[12], out[13]); o1.w = pk2(out[14], out[15]);
        *(GAS v4u*)(YA + (size_t)m * RW + ch0) = o0; *(GAS v4u*)(YA + (size_t)m * RW + ch0 + 8) = o1;
    }
}


__device__ __forceinline__ unsigned f2key(float f) { const unsigned u = __builtin_bit_cast(unsigned, f); return (u & 0x80000000u) ? ~u : (u | 0x80000000u); }
__device__ __forceinline__ float key2f(unsigned k) { const unsigned u = (k & 0x80000000u) ? (k & 0x7fffffffu) : ~k; return __builtin_bit_cast(float, u); }
template <int CTRL, int RM> __device__ __forceinline__ unsigned dpp_umax(unsigned x) {
    const unsigned y = (unsigned)__builtin_amdgcn_update_dpp(0, (int)x, CTRL, RM, 0xf, false); return x > y ? x : y; }
__device__ __forceinline__ void half_max(unsigned x, unsigned& m0, unsigned& m1) {
    x = dpp_umax<0xB1, 0xf>(x); x = dpp_umax<0x4E, 0xf>(x); x = dpp_umax<0x141, 0xf>(x); x = dpp_umax<0x140, 0xf>(x); x = dpp_umax<0x142, 0xa>(x);
    m0 = (unsigned)__builtin_amdgcn_readlane((int)x, 31); m1 = (unsigned)__builtin_amdgcn_readlane((int)x, 63);
}
__device__ __forceinline__ unsigned top16_lists(const float* sh  , int lane) {
    const int half = lane >> 5, l5 = lane & 31;
    unsigned k0, k1, k2, k3, rec = 0u;
    { const float* p = sh + half * 128 + l5;
      k0 = (f2key(p[0]) & ~127u) | (unsigned)l5; k1 = (f2key(p[32]) & ~127u) | (unsigned)(l5 + 32); k2 = (f2key(p[64]) & ~127u) | (unsigned)(l5 + 64); k3 = (f2key(p[96]) & ~127u) | (unsigned)(l5 + 96); }
#pragma unroll 4
    for (int it = 0; it < 16; ++it) {
        unsigned a = k0 > k1 ? k0 : k1, b = k2 > k3 ? k2 : k3; a = a > b ? a : b;
        unsigned m0, m1; half_max(a, m0, m1);
        const unsigned mh = half ? m1 : m0;
        k0 = (k0 == mh) ? 0u : k0; k1 = (k1 == mh) ? 0u : k1; k2 = (k2 == mh) ? 0u : k2; k3 = (k3 == mh) ? 0u : k3;
        rec = (l5 == it) ? mh : rec;
    }
    return rec;
}
struct SelP { const float* SC; int* ESEL; float* EGATE; const float* pu; const float* pv; unsigned char* PU8; unsigned char* PV8; float* SU; float* SV; int last; };
__device__ __forceinline__ void cvt_row_load(f32x4 (&x)[8], const float* src) {
#pragma unroll
    for (int q = 0; q < 8; ++q) x[q] = *(const GAS f32x4*)(src + q * 4);
}
__device__ __forceinline__ void cvt_row_store(const f32x4 (&x)[8], unsigned char* dst, float* scale_slot, int lane) {
    float am = 0.f;
#pragma unroll
    for (int q = 0; q < 8; ++q) am = fmaxf(am, fmaxf(fmaxf(fabsf(x[q].x), fabsf(x[q].y)), fmaxf(fabsf(x[q].z), fabsf(x[q].w))));
    am = fmaxf(wave_max_u(am), 1e-30f);
    const float g = 6.0f / am, inv = am * (1.0f / 6.0f);
    v4u o;
#pragma unroll
    for (int q = 0; q < 4; ++q) { unsigned w = 0u;
        w = __builtin_amdgcn_cvt_scalef32_pk_fp4_f32(w, x[2 * q].x * g, x[2 * q].y * g, 1.0f, 0);
        w = __builtin_amdgcn_cvt_scalef32_pk_fp4_f32(w, x[2 * q].z * g, x[2 * q].w * g, 1.0f, 1);
        w = __builtin_amdgcn_cvt_scalef32_pk_fp4_f32(w, x[2 * q + 1].x * g, x[2 * q + 1].y * g, 1.0f, 2);
        w = __builtin_amdgcn_cvt_scalef32_pk_fp4_f32(w, x[2 * q + 1].z * g, x[2 * q + 1].w * g, 1.0f, 3);
        o[q] = w; }
    *(GAS v4u*)dst = o;
    if (lane == 0) *scale_slot = inv;
}
__device__ __forceinline__ void select_phase(Frame& F, const SelP& P) {
    const int gw = F.vcu * NWAVES + F.wave, NGW = F.G * NWAVES, lane = F.lane, half = lane >> 5, l5 = lane & 31;
    int crow = gw;
    for (int m = gw; m < MALL || crow < 2 * NEXP; m += NGW) {
        f32x4 xa[8], xb[8];
        const int r0 = crow, r1 = crow + NGW; const bool c0 = r0 < 2 * NEXP, c1 = r1 < 2 * NEXP; crow += 2 * NGW;
        if (c0) cvt_row_load(xa, ((r0 >= NEXP) ? P.pv + (size_t)(r0 - NEXP) * DM : P.pu + (size_t)r0 * DM) + lane * 32);
        if (c1) cvt_row_load(xb, ((r1 >= NEXP) ? P.pv + (size_t)(r1 - NEXP) * DM : P.pu + (size_t)r1 * DM) + lane * 32);
        bool tok = m < MALL; int tp = 0; if (tok) { tp = m % TPB; if (P.last && tp < CTXL) tok = false; }
        if (tok) {
            const float* srow = P.SC + (size_t)m * DM;
#pragma unroll 1
            for (int hp = 0; hp < 4; ++hp) {
                const unsigned recA = top16_lists(srow + (2 * hp) * 256, lane), recB = top16_lists(srow + (2 * hp + 1) * 256, lane);
                const float vA = key2f(recA & ~127u), vB = key2f(recB & ~127u);
                const float v1a = bpermf(l5 & 15, vA), v1b = bpermf(l5 & 15, vB); const float v1 = half ? v1b : v1a;
                unsigned ck[8];
#pragma unroll
                for (int e = 0; e < 8; ++e) { const int src = 32 + 8 * (l5 >> 4) + e; const float v2a = bpermf(src, vA), v2b = bpermf(src, vB);
                    ck[e] = (f2key(v1 + (half ? v2b : v2a)) & ~255u) | (unsigned)(l5 | (e << 5)); }
                unsigned rec = 0u;
#pragma unroll 2
                for (int it = 0; it < 16; ++it) {
                    unsigned a = ck[0] > ck[1] ? ck[0] : ck[1], b = ck[2] > ck[3] ? ck[2] : ck[3], c = ck[4] > ck[5] ? ck[4] : ck[5], d = ck[6] > ck[7] ? ck[6] : ck[7];
                    a = a > b ? a : b; c = c > d ? c : d; a = a > c ? a : c;
                    unsigned m0, m1; half_max(a, m0, m1);
                    const unsigned mh = half ? m1 : m0;
#pragma unroll
                    for (int e = 0; e < 8; ++e) ck[e] = (ck[e] == mh) ? 0u : ck[e];
                    rec = (l5 == it) ? mh : rec;
                }
                const float ts = key2f(rec & ~255u), tmax = half ? bpermf(32, ts) : bpermf(0, ts);
                float ev = (l5 < 16) ? __expf(ts - tmax) : 0.f;
                const float esum = red16(ev);
                const int cid = (int)(rec & 255u), ci = cid & 15, cj = ((cid >> 4) & 1) * 8 + (cid >> 5);
                const int i1a = bpermi(ci, (int)(recA & 127u)), i1b = bpermi(ci, (int)(recB & 127u)), i2a = bpermi(32 + cj, (int)(recA & 127u)), i2b = bpermi(32 + cj, (int)(recB & 127u));
                const int expert = (half ? i1b : i1a) * 128 + (half ? i2b : i2a);
                if (l5 < 16) { const int slot = (2 * hp + half) * 16 + l5; P.ESEL[(size_t)m * 128 + slot] = expert; P.EGATE[(size_t)m * 128 + slot] = ev / esum; }
            }
        }
        if (c0) cvt_row_store(xa, ((r0 >= NEXP) ? P.PV8 + (size_t)(r0 - NEXP) * (DM / 2) : P.PU8 + (size_t)r0 * (DM / 2)) + lane * 16, (r0 >= NEXP) ? P.SV + (r0 - NEXP) : P.SU + r0, lane);
        if (c1) cvt_row_store(xb, ((r1 >= NEXP) ? P.PV8 + (size_t)(r1 - NEXP) * (DM / 2) : P.PU8 + (size_t)r1 * (DM / 2)) + lane * 16, (r1 >= NEXP) ? P.SV + (r1 - NEXP) : P.SU + r1, lane);
    }
}
struct PeerP { const float* nmod; const float* ng; bf16* Hout;   const int* ESEL; const float* EGATE; const bf16* H; const unsigned char* PU; const unsigned char* PV; const float* SU; const float* SV; float* X; const float* mod;   const float* fin_g; float* out; int last; int dry; };
__device__ __forceinline__ void peer_phase(Frame& F, const PeerP& P) {
    const int gw = F.vcu * NWAVES + F.wave, NGW = F.G * NWAVES, lane = F.lane;
    float pr_s2 = 0.f, pr_d2 = 0.f, pr_tg = 0.f, pr_n = 0.f;
    for (int m = gw; m < MALL; m += NGW) {
        const int b = m / TPB, tp = m - b * TPB; if (P.last && tp < CTXL) continue;
        const int mr = tp < CTXL ? 2 : b;
        const int emask_ = (P.dry & 2) ? 1023 : 0x7fffffff;
        const int eidx[2] = {P.ESEL[(size_t)m * 128 + lane] & emask_, P.ESEL[(size_t)m * 128 + 64 + lane] & emask_}; const float egate[2] = {P.EGATE[(size_t)m * 128 + lane], P.EGATE[(size_t)m * 128 + 64 + lane]};
        typedef int v8i __attribute__((ext_vector_type(8)));
        LAS unsigned char* hq = F.lds + F.wave * 4096;
        { const v4u a0 = *(const GAS v4u*)(P.H + (size_t)m * DM + lane * 32), a1 = *(const GAS v4u*)(P.H + (size_t)m * DM + lane * 32 + 8), a2 = *(const GAS v4u*)(P.H + (size_t)m * DM + lane * 32 + 16), a3 = *(const GAS v4u*)(P.H + (size_t)m * DM + lane * 32 + 24);
          const v4u hv[4] = {a0, a1, a2, a3}; v4u o[2];
#pragma unroll
          for (int j = 0; j < 4; ++j) { int w0 = 0, w1 = 0;
              w0 = __builtin_amdgcn_cvt_pk_fp8_f32(bflo(hv[j].x), bfhi(hv[j].x), w0, false); w0 = __builtin_amdgcn_cvt_pk_fp8_f32(bflo(hv[j].y), bfhi(hv[j].y), w0, true);
              w1 = __builtin_amdgcn_cvt_pk_fp8_f32(bflo(hv[j].z), bfhi(hv[j].z), w1, false); w1 = __builtin_amdgcn_cvt_pk_fp8_f32(bflo(hv[j].w), bfhi(hv[j].w), w1, true);
              o[j >> 1][2 * (j & 1)] = (unsigned)w0; o[j >> 1][2 * (j & 1) + 1] = (unsigned)w1; }
          *(LAS v4u*)(hq + lane * 32) = o[0]; *(LAS v4u*)(hq + lane * 32 + 16) = o[1];
          unsigned z_ = 0u; asm volatile("" : "+v"(z_));
          if (lane < 2) *(LAS v4u*)(hq + 2048 + lane * 16) = (v4u){z_, z_, z_, z_}; }
        const int li = lane & 15, kb = lane >> 4;
        int rowoff[8];
#pragma unroll
        for (int g = 0; g < 8; ++g) rowoff[g] = bpermi(16 * (g & 3) + li, eidx[g >> 2]) * (DM / 2) + 16 * kb;
        f32x4 dacc[8];
#pragma unroll
        for (int g = 0; g < 8; ++g) dacc[g] = (f32x4){0.f, 0.f, 0.f, 0.f};
        const unsigned hb = (li == 0) ? (unsigned)(16 * kb) : 2048u;
        const unsigned hb2 = (li == 0) ? 64u : 16u;
        const unsigned hstep = (li == 0) ? 128u : 0u;
        v4u ua[8], ub[8];
#pragma unroll
        for (int g = 0; g < 8; ++g) ua[g] = *(const GAS v4u*)(P.PU + (unsigned)rowoff[g]);
#pragma unroll 1
        for (int s = 0; s < ((P.dry & 4) ? 2 : 16); s += 2) {
#pragma unroll
            for (int g = 0; g < 8; ++g) ub[g] = *(const GAS v4u*)(P.PU + (unsigned)(rowoff[g] + 64 * (s + 1)));
            { const v4u b0 = *(const LAS v4u*)(hq + hb + hstep * s), b1 = *(const LAS v4u*)(hq + hb + hstep * s + hb2);
              const v8i bf = {(int)b0.x, (int)b0.y, (int)b0.z, (int)b0.w, (int)b1.x, (int)b1.y, (int)b1.z, (int)b1.w};
#pragma unroll
              for (int g = 0; g < 8; ++g) { const v8i af = {(int)ua[g].x, (int)ua[g].y, (int)ua[g].z, (int)ua[g].w, 0, 0, 0, 0};
                  dacc[g] = __builtin_amdgcn_mfma_scale_f32_16x16x128_f8f6f4(af, bf, dacc[g], 4, 0, 0, 0x7f7f7f7f, 0, 0x7f7f7f7f); } }
            if (s + 2 < 16) {
#pragma unroll
                for (int g = 0; g < 8; ++g) ua[g] = *(const GAS v4u*)(P.PU + (unsigned)(rowoff[g] + 64 * (s + 2))); }
            { const v4u b0 = *(const LAS v4u*)(hq + hb + hstep * (s + 1)), b1 = *(const LAS v4u*)(hq + hb + hstep * (s + 1) + hb2);
              const v8i bf = {(int)b0.x, (int)b0.y, (int)b0.z, (int)b0.w, (int)b1.x, (int)b1.y, (int)b1.z, (int)b1.w};
#pragma unroll
              for (int g = 0; g < 8; ++g) { const v8i af = {(int)ub[g].x, (int)ub[g].y, (int)ub[g].z, (int)ub[g].w, 0, 0, 0, 0};
                  dacc[g] = __builtin_amdgcn_mfma_scale_f32_16x16x128_f8f6f4(af, bf, dacc[g], 4, 0, 0, 0x7f7f7f7f, 0, 0x7f7f7f7f); } }
        }
        float coef[2];
#pragma unroll
        for (int sl = 0; sl < 2; ++sl) { float mydot = 0.f;
#pragma unroll
            for (int g4 = 0; g4 < 4; ++g4)
#pragma unroll
                for (int r = 0; r < 4; ++r) { const float t = bpermf(16 * ((lane >> 2) & 3), dacc[4 * sl + g4][r]); if ((lane >> 4) == g4 && (lane & 3) == r) mydot = t; }
            mydot *= P.SU[eidx[sl]];
            if (DBG_PROBE == 4) {
                float ref = 0.f;
                for (int e = 0; e < 64; ++e) { const int ex = __builtin_amdgcn_readlane(eidx[sl], e); const v4u uu = *(const GAS v4u*)(P.PU + (size_t)ex * (DM / 2) + lane * 16); float s1 = 0.f;
                    const v4u hv2[4] = {*(const GAS v4u*)(P.H + (size_t)m * DM + lane * 32), *(const GAS v4u*)(P.H + (size_t)m * DM + lane * 32 + 8), *(const GAS v4u*)(P.H + (size_t)m * DM + lane * 32 + 16), *(const GAS v4u*)(P.H + (size_t)m * DM + lane * 32 + 24)};
#pragma unroll
                    for (int d = 0; d < 4; ++d) { const unsigned w = uu[d]; const unsigned hw[4] = {hv2[d].x, hv2[d].y, hv2[d].z, hv2[d].w};
                        f32x2 x = __builtin_amdgcn_cvt_scalef32_pk_f32_fp4(w, 1.0f, 0); s1 += x.x * bflo(hw[0]) + x.y * bfhi(hw[0]); x = __builtin_amdgcn_cvt_scalef32_pk_f32_fp4(w, 1.0f, 1); s1 += x.x * bflo(hw[1]) + x.y * bfhi(hw[1]);
                        x = __builtin_amdgcn_cvt_scalef32_pk_f32_fp4(w, 1.0f, 2); s1 += x.x * bflo(hw[2]) + x.y * bfhi(hw[2]); x = __builtin_amdgcn_cvt_scalef32_pk_f32_fp4(w, 1.0f, 3); s1 += x.x * bflo(hw[3]) + x.y * bfhi(hw[3]); }
                    const float tot = wave_sum_u(s1) * P.SU[ex]; if (lane == e) ref = tot; }
                pr_s2 = fmaxf(pr_s2, wave_max_u(fabsf(mydot - ref) / (fabsf(ref) + 0.25f))); pr_n = 1.f; }
            coef[sl] = egate[sl] * 0.5f * mydot * (1.0f + erff(mydot * 0.70710678f));
            if ((DBG_SKIP & 16) && sl == 0) coef[sl] = 0.f;
            if ((DBG_SKIP & 32) && sl == 1) coef[sl] = 0.f;
        }
        const float coefs[2] = {coef[0] * P.SV[eidx[0]], coef[1] * P.SV[eidx[1]]};
        f32x2 acc2[16];
#pragma unroll
        for (int i = 0; i < 16; ++i) acc2[i] = (f32x2){0.f, 0.f};
#define PEER_LOADV(U, C, e0_) do { const int e1_ = (e0_); const int ev_ = (e1_ & 64) ? eidx[1] : eidx[0]; const int cv_ = __builtin_bit_cast(int, (e1_ & 64) ? coefs[1] : coefs[0]); \
            _Pragma("unroll") for (int q = 0; q < 8; ++q) { const int ex = __builtin_amdgcn_readlane(ev_, (e1_ & 63) + q); U[q] = *(const GAS v4u*)(P.PV + (size_t)ex * (DM / 2) + lane * 16); \
            C[q] = __builtin_bit_cast(float, __builtin_amdgcn_readlane(cv_, (e1_ & 63) + q)); } } while (0)
#define PEER_AXPY(U, C) do { _Pragma("unroll") for (int q = 0; q < 8; ++q) _Pragma("unroll") for (int d = 0; d < 4; ++d) { const unsigned w = U[q][d]; \
            acc2[4 * d + 0] = __builtin_amdgcn_cvt_scalef32_pk_f32_fp4(w, 1.0f, 0) * C[q] + acc2[4 * d + 0]; acc2[4 * d + 1] = __builtin_amdgcn_cvt_scalef32_pk_f32_fp4(w, 1.0f, 1) * C[q] + acc2[4 * d + 1]; \
            acc2[4 * d + 2] = __builtin_amdgcn_cvt_scalef32_pk_f32_fp4(w, 1.0f, 2) * C[q] + acc2[4 * d + 2]; acc2[4 * d + 3] = __builtin_amdgcn_cvt_scalef32_pk_f32_fp4(w, 1.0f, 3) * C[q] + acc2[4 * d + 3]; } } while (0)
        f32x4 xpre[8];
        { const float* xr0 = P.X + (size_t)m * DM + lane * 32;
#pragma unroll
          for (int hq = 0; hq < 8; ++hq) xpre[hq] = *(const GAS f32x4*)(xr0 + hq * 4); }
        {
            v4u ua[8], ub[8]; float ca[8], cb[8];
            PEER_LOADV(ua, ca, 0);
#pragma unroll 1
            for (int it = 0; it < ((P.dry & 8) ? 2 : 8); ++it) {
                PEER_LOADV(ub, cb, 16 * it + 8); PEER_AXPY(ua, ca);
                if (it < 7) PEER_LOADV(ua, ca, 16 * it + 16);
                PEER_AXPY(ub, cb);
            }
        }
#undef PEER_LOADV
#undef PEER_AXPY
        float acc[32];
#pragma unroll
        for (int i = 0; i < 16; ++i) { acc[2 * i] = acc2[i].x; acc[2 * i + 1] = acc2[i].y; }
        if (P.dry) { float sm_ = 0.f;
#pragma unroll
            for (int i = 0; i < 32; ++i) sm_ += acc[i];
            if (sm_ == 1.2345e-30f) P.X[lane] = sm_;
            if (!(P.dry & 16)) continue; }
        if (DBG_SKIP & 1) {
#pragma unroll
            for (int i = 0; i < 32; ++i) acc[i] = 0.f; }
        if (((DBG_SKIP & 64) && !P.last) || ((DBG_SKIP & 128) && P.last)) {
#pragma unroll
            for (int i = 0; i < 32; ++i) acc[i] = 0.f; }
        if (DBG_SKIP & 8) {
#pragma unroll
            for (int i = 0; i < 32; ++i) acc[i] = -acc[i]; }
        int m_l = m, lane_l = lane; asm volatile("" : "+v"(m_l), "+v"(lane_l));
        const int b_l = m_l / TPB, tp_l = m_l - b_l * TPB, mr_l = tp_l < CTXL ? 2 : b_l;
        float* xr = P.X + (size_t)m_l * DM + lane_l * 32; const float* g2 = P.mod + (size_t)mr_l * 12288 + 5 * DM + lane_l * 32;
        float ss = 0.f;
#pragma unroll
        for (int hq = 0; hq < 8; ++hq) { const int c = hq * 4;
            f32x4 xv = xpre[hq]; const f32x4 gv = *(const GAS f32x4*)(g2 + c);
#pragma unroll
            for (int e = 0; e < 4; ++e) { xv[e] += gv[e] * acc[4 * hq + e]; ss += xv[e] * xv[e]; acc[4 * hq + e] = xv[e]; }
            if (!P.last) *(GAS f32x4*)((P.dry ? (float*)(F.ws + 760 * MiB) + (size_t)m_l * DM + lane_l * 32 : xr) + c) = xv; }
        if (!P.last) {
            const float rs = rsqrtf(wave_sum(ss) * (1.f / DM) + NORM_EPS); const float* sh = P.nmod + (size_t)mr_l * 12288 + lane_l * 32; const float* sc = sh + DM; const float* ngp = P.ng + lane_l * 32;
            bf16* ho = (P.dry ? (bf16*)(F.ws + 892 * MiB) : P.Hout) + (size_t)m_l * DM + lane_l * 32;
#pragma unroll
            for (int hq = 0; hq < 4; ++hq) { const int c = hq * 8; float y[8];
                const f32x4 n0 = *(const GAS f32x4*)(ngp + c), n1 = *(const GAS f32x4*)(ngp + c + 4), s0 = *(const GAS f32x4*)(sc + c), s1 = *(const GAS f32x4*)(sc + c + 4), h0 = *(const GAS f32x4*)(sh + c), h1 = *(const GAS f32x4*)(sh + c + 4);
#pragma unroll
                for (int e = 0; e < 4; ++e) { y[e] = acc[8 * hq + e] * rs * n0[e] * (1.0f + s0[e]) + h0[e]; y[4 + e] = acc[8 * hq + 4 + e] * rs * n1[e] * (1.0f + s1[e]) + h1[e]; }
                *(GAS v4u*)(ho + c) = pack8f(y); } }
        if (P.last) { const float rs = rsqrtf(wave_sum(ss) * (1.f / DM) + NORM_EPS); float* orow = P.out + ((size_t)b_l * SEQ + (tp_l - CTXL)) * DM + lane_l * 32; const float* fgp = P.fin_g + lane_l * 32;
#pragma unroll
            for (int hq = 0; hq < 8; ++hq) { const int c = hq * 4; const f32x4 fg = *(const GAS f32x4*)(fgp + c);
                f32x4 o;
#pragma unroll
                for (int e = 0; e < 4; ++e) o[e] = acc[4 * hq + e] * rs * fg[e];
                *(GAS f32x4*)(orow + c) = o; } }
    }
    if (DBG_PROBE && DBG_PROBE != 5 && !P.last && lane == 0) { float* pp = (float*)(F.ws + WS_CTL + CTL_PROBE_OFF) + gw * 4; pp[0] = pr_s2; pp[1] = pr_d2; pp[2] = pr_tg; pp[3] = pr_n; }
}


constexpr int PH_PER_LAYER = 12, NPHASE = 1 + NLAYER * PH_PER_LAYER;
#ifndef ONLY_PHASE
#define ONLY_PHASE -1
#endif
#define T0() (wave_s == 0 && pg8::opaque_lane() == 0)
#define PH_ON(k) (ONLY_PHASE < 0 || ONLY_PHASE == (k))
#define GEMM_CALL(EPI, SCHED, g, S, E) pg8::gemm_phase<EPI, SCHED, true, true>(F.lds, g, S, E, wave_s)
#define GEMM_CALL_NA(EPI, SCHED, g, S, E) pg8::gemm_phase<EPI, SCHED, false, true>(F.lds, g, S, E, wave_s)

__device__ __forceinline__ const float* karg(int i) {
    asm volatile("" : "+s"(i));
    const __attribute__((address_space(4))) unsigned long long* ka = (const __attribute__((address_space(4))) unsigned long long*)__builtin_amdgcn_kernarg_segment_ptr();
    return (const float*)ka[i];
}
__global__ void __launch_bounds__(NWAVES * 64, 2) mk_fwd(Args args) {
    extern __shared__ __attribute__((aligned(16))) unsigned char lds[];
    Frame F;
    F.lds = (LAS unsigned char*)lds; F.ws = args.ws;
    const int wave_s = __builtin_amdgcn_readfirstlane((int)threadIdx.x >> 6);
    F.tid = threadIdx.x; F.lane = F.tid & 63; F.wave = wave_s;
    F.G = gridDim.x; { const int bx = blockIdx.x; F.vcu = (F.G % 8 == 0) ? (bx % 8) * (F.G / 8) + bx / 8 : bx; }
    unsigned char* ws = args.ws;
    volatile LAS unsigned* MISC = (volatile LAS unsigned*)(F.lds + MISC_OFF);
    for (int u = F.tid; u < (LDS_BYTES - LDSCTL_OFF) / 4; u += NWAVES * 64) ((LAS unsigned*)(F.lds + LDSCTL_OFF))[u] = 0u;
    __syncthreads();
    const int lo = args.ph_lo, hi = args.ph_hi;
    XcdBarrier bar; bar.bar = (unsigned*)(ws + WS_CTL) + CW_BAR; bar.x = 0; bar.st = nullptr;
    if (hi - lo > 1) bar = xcd_barrier_post((unsigned*)(ws + WS_CTL) + CW_BAR, MISC + 8, T0());
#define IN(k) (lo <= (k) && (k) < hi)
#define REFRAME() do { const int lz_ = pg8::opaque_lane(); F.lane = lz_; F.tid = wave_s * 64 + lz_; F.wave = wave_s; ws = (unsigned char*)karg(34); F.ws = ws; { int g_ = (int)gridDim.x, b_ = (int)blockIdx.x; asm volatile("" : "+s"(g_), "+s"(b_)); bx = b_; F.G = g_; F.vcu = ((g_ & 7) == 0) ? (b_ & 7) * (g_ >> 3) + (b_ >> 3) : b_; } } while (0)
#define SEAM(k) do { if (IN((k) + 1)) xcd_barrier(bar, T0()); } while (0)
#define XBUF ((float*)(ws + WS_X))
#define HBUF ((bf16*)(ws + WS_H))
#define MODP ((const float*)(ws + WS_CTL + CTL_MOD_OFF) + (size_t)l * 3 * 12288)
    int bx = (int)blockIdx.x;

    for (int rep_ = 0; rep_ < ((DBG_REPEAT == 100) ? 2 : 1); ++rep_) if (PH_ON(100) && IN(0)) { REFRAME(); if (rep_) xcd_barrier(bar, T0()); p0_prologue(F); SEAM(0); }

    for (int l = 0; l < NLAYER; ++l) {
        const int base = 1 + l * PH_PER_LAYER;
        const int last = (l == NLAYER - 1);
        for (int rep_ = 0; rep_ < ((DBG_REPEAT == 0) ? 2 : 1); ++rep_) if (PH_ON(0) && IN(base + 0) && l == 0) { REFRAME(); if (rep_) xcd_barrier(bar, T0()); modnorm_phase(F, XBUF, karg(6) + (size_t)l * DM, MODP, 0, HBUF, 0, l == 0 ? karg(0) : nullptr, l == 0 ? karg(2) : nullptr); SEAM(base + 0); }
        for (int rep_ = 0; rep_ < ((DBG_REPEAT == 1) ? 2 : 1); ++rep_) if (PH_ON(1) && IN(base + 1)) { REFRAME(); if (rep_) xcd_barrier(bar, T0());
            pg8::Gemm g{HBUF, (const bf16*)(ws + WS_WINA) + (size_t)l * INA_P * DM, MALL, INA_P, DM}; pg8::RowOrder S; S.init_rows(0, INA_P, F.G, bx);
            pg8::EpiStoreBf16 E{(bf16*)(ws + WS_PA), INA_P};
            GEMM_CALL(pg8::EpiStoreBf16, pg8::RowOrder, g, S, E);
            SEAM(base + 1); }
        for (int rep_ = 0; rep_ < ((DBG_REPEAT == 2) ? 2 : 1); ++rep_) if (PH_ON(2) && IN(base + 2)) { REFRAME(); if (rep_) xcd_barrier(bar, T0());
            FeatP P;
            P.PA = (const bf16*)(ws + WS_PA); P.mu = karg(9) + (size_t)l * RWC; P.w0 = karg(10) + (size_t)l * 2 * RW; P.a0 = karg(12) + (size_t)l * 2 * RW;
            P.k_k = karg(15) + (size_t)l * RW; P.k_a = karg(16) + (size_t)l * RW; P.r_k = karg(17) + (size_t)l * RW;
            P.WUP = (const bf16*)(ws + WS_WUP) + (size_t)l * 2 * RW * 64; P.AUP = (const bf16*)(ws + WS_AUP) + (size_t)l * 2 * RW * 64; P.GUP = (const bf16*)(ws + WS_GUP) + (size_t)l * 2 * RW * 32;
            P.qnorm = karg(20) + (size_t)l * 512; P.kvnorm = karg(22) + (size_t)l * 256; P.rope = (const f32x2*)(ws + WS_ROPE);
            P.RI = (bf16*)(ws + WS_RI); P.GG = (bf16*)(ws + WS_GG); P.BON = (float*)(ws + WS_BON); P.QN = (bf16*)(ws + WS_QN); P.KVN = (bf16*)(ws + WS_KVN); P.K = (bf16*)(ws + WS_K);
            features_phase(F, P);
            SEAM(base + 2); }
        for (int rep_ = 0; rep_ < ((DBG_REPEAT == 3) ? 2 : 1); ++rep_) if (PH_ON(3) && IN(base + 3)) { REFRAME(); if (rep_) xcd_barrier(bar, T0());
            { pg8::Gemm g{(const bf16*)(ws + WS_QN), (const bf16*)(ws + WS_WUQ) + (size_t)l * NQ * 512, MALL, NQ, 512};
              pg8::EpiQ E{(bf16*)(ws + WS_Q), (const f32x2*)(ws + WS_ROPE), 0.14724444f};
              pg8::RowOrder S; S.init_rows(last, NQ, F.G, bx); GEMM_CALL_NA(pg8::EpiQ, pg8::RowOrder, g, S, E); }
            { pg8::Gemm g{(const bf16*)(ws + WS_KVN), (const bf16*)(ws + WS_WUKV) + (size_t)l * NKV * 256, MALL, NKV, 256}; pg8::RowOrder S; S.init_rows(0, NKV, F.G, bx);
              pg8::EpiKV E{(bf16*)(ws + WS_K), (bf16*)(ws + WS_V)};
              GEMM_CALL_NA(pg8::EpiKV, pg8::RowOrder, g, S, E); }
            SEAM(base + 3); }
        for (int rep_ = 0; rep_ < ((DBG_REPEAT == 4) ? 2 : 1); ++rep_) if (PH_ON(4) && IN(base + 4)) { REFRAME(); if (rep_) xcd_barrier(bar, T0()); scan_phase(F, (const bf16*)(ws + WS_RI), (bf16*)(ws + WS_Y)); SEAM(base + 4); }
        for (int rep_ = 0; rep_ < ((DBG_REPEAT == 5) ? 2 : 1); ++rep_) if (PH_ON(5) && IN(base + 5)) { REFRAME(); if (rep_) xcd_barrier(bar, T0());
            attn_phase(F, (const bf16*)(ws + WS_Q), (const bf16*)(ws + WS_K), (const bf16*)(ws + WS_V), (bf16*)(ws + WS_YB), !last);
            readout_phase(F, (const bf16*)(ws + WS_Y), (const bf16*)(ws + WS_GG), (const float*)(ws + WS_BON), (const bf16*)(ws + WS_RI), karg(18) + (size_t)l * RW, karg(19) + (size_t)l * RW, (bf16*)(ws + WS_YA));
            SEAM(base + 5); }
        for (int rep_ = 0; rep_ < ((DBG_REPEAT == 6) ? 2 : 1); ++rep_) if (PH_ON(6) && IN(base + 6)) { REFRAME(); if (rep_) xcd_barrier(bar, T0());
            bf16* T1 = (bf16*)(ws + WS_T1); bf16* T2 = (bf16*)(ws + WS_T2);
            const pg8::Gemm g1{HBUF, (const bf16*)(ws + WS_WGA) + (size_t)l * DM * DM, MALL, DM, DM}, g2{(const bf16*)(ws + WS_YA), (const bf16*)(ws + WS_WA) + (size_t)l * DM * RW, MALL, DM, RW};
            const pg8::Gemm g3{HBUF, (const bf16*)(ws + WS_WGB) + (size_t)l * DM * DM, MALL, DM, DM}, g4{(const bf16*)(ws + WS_YB), (const bf16*)(ws + WS_WB) + (size_t)l * DM * RW, MALL, DM, RW};
            const pg8::EpiGate E1{T1, DM, karg(8) + (size_t)l * 2 * DM}, E3{T2, DM, karg(8) + (size_t)l * 2 * DM + DM};
            const pg8::EpiMulAdd E2{T1, T1, nullptr, DM}, E4{T1, T2, T1, DM};
            pg8::RowOrder S; S.init_rows(last, DM, F.G, bx);
            GEMM_CALL(pg8::EpiGate, pg8::RowOrder, g1, S, E1); GEMM_CALL(pg8::EpiMulAdd, pg8::RowOrder, g2, S, E2); GEMM_CALL(pg8::EpiGate, pg8::RowOrder, g3, S, E3); GEMM_CALL(pg8::EpiMulAdd, pg8::RowOrder, g4, S, E4);
            SEAM(base + 6); }
        for (int rep_ = 0; rep_ < ((DBG_REPEAT == 7) ? 2 : 1); ++rep_) if (PH_ON(7) && IN(base + 7)) { REFRAME(); if (rep_) xcd_barrier(bar, T0());
            const pg8::Gemm g{(const bf16*)(ws + WS_T1), (const bf16*)(ws + WS_WO) + (size_t)l * DM * DM, MALL, DM, DM};
            const pg8::EpiResid E{XBUF, MODP + 2 * DM, l == 0 ? karg(0) : nullptr, l == 0 ? karg(2) : nullptr};
            pg8::RowOrder S; S.init_rows(last, DM, F.G, bx); GEMM_CALL(pg8::EpiResid, pg8::RowOrder, g, S, E);
            SEAM(base + 7); }
        for (int rep_ = 0; rep_ < ((DBG_REPEAT == 8) ? 2 : 1); ++rep_) if (PH_ON(8) && IN(base + 8)) { REFRAME(); if (rep_) xcd_barrier(bar, T0());
            modnorm_phase(F, XBUF, karg(27) + (size_t)l * DM, MODP, 3, HBUF, last);
            SEAM(base + 8); }
        for (int rep_ = 0; rep_ < ((DBG_REPEAT == 9) ? 2 : 1); ++rep_) if (PH_ON(9) && IN(base + 9)) { REFRAME(); if (rep_) xcd_barrier(bar, T0());
            const pg8::Gemm g{HBUF, (const bf16*)(ws + WS_WQK) + (size_t)l * DM * DM, MALL, DM, DM};
            const pg8::EpiF32 E{(float*)(ws + WS_SC), DM};
            pg8::RowOrder S; S.init_rows(last, DM, F.G, bx); GEMM_CALL(pg8::EpiF32, pg8::RowOrder, g, S, E);
            SEAM(base + 9); }
        for (int rep_ = 0; rep_ < ((DBG_REPEAT == 10) ? 2 : 1); ++rep_) if (PH_ON(10) && IN(base + 10)) { REFRAME(); if (rep_) xcd_barrier(bar, T0());
            SelP P; P.SC = (const float*)(ws + WS_SC); P.ESEL = (int*)(ws + WS_T1); P.EGATE = (float*)(ws + WS_T1 + 16 * MiB);
            P.pu = karg(30) + (size_t)l * NEXP * DM; P.pv = karg(31) + (size_t)l * NEXP * DM; P.PU8 = ws + WS_PU; P.PV8 = ws + WS_PU + (size_t)NEXP * (DM / 2); P.SU = (float*)(ws + WS_PV); P.SV = (float*)(ws + WS_PV) + NEXP; P.last = last;
            select_phase(F, P);
            SEAM(base + 10); }
        for (int rep_ = 0; rep_ < ((DBG_REPEAT == 11) ? 2 : 1); ++rep_) if (PH_ON(11) && IN(base + 11)) { REFRAME(); if (rep_) xcd_barrier(bar, T0());
            PeerP P; P.nmod = MODP + 3 * 12288; P.ng = karg(6) + (size_t)(l + 1) * DM; P.Hout = HBUF; P.ESEL = (const int*)(ws + WS_T1); P.EGATE = (const float*)(ws + WS_T1 + 16 * MiB); P.H = HBUF; P.PU = ws + WS_PU; P.PV = ws + WS_PU + (size_t)NEXP * (DM / 2); P.SU = (const float*)(ws + WS_PV); P.SV = (const float*)(ws + WS_PV) + NEXP; P.X = XBUF; P.mod = MODP; P.fin_g = karg(32); P.out = (float*)karg(33); P.last = last; P.dry = (DBG_REPEAT == 11 && rep_ == 0) ? DBG_DRY : 0;
            peer_phase(F, P);
            SEAM(base + 11); }
    }
#undef IN
#undef SEAM
#undef XBUF
#undef HBUF
#undef MODP
}

__device__ __forceinline__ float mx_a_val(int i, int k) { const int c = (i * 131 + k * 17 + (k >> 3) * 5) & 15; const float mag[8] = {0.f, .5f, 1.f, 1.5f, 2.f, 3.f, 4.f, 6.f}; return (c & 8) ? -mag[c & 7] : mag[c & 7]; }
__device__ __forceinline__ int mx_a_code(int i, int k) { return (i * 131 + k * 17 + (k >> 3) * 5) & 15; }
__device__ __forceinline__ float mx_b_val(int k, int j) { return (float)(((k * 7 + j * 13 + (k >> 4)) % 9) - 4); }
__device__ __forceinline__ int mx_kmap(int hyp, int kb, int e) { const int h = hyp % 3; return h == 0 ? 32 * kb + e : h == 1 ? 32 * (e >> 3) + 8 * kb + (e & 7) : 64 * (e >> 4) + 16 * kb + (e & 15); }
__global__ void __launch_bounds__(512) dbg_fill(const float* pp, float* o) {
    __shared__ float vsh;
    float v = 0.f;
    if (DBG_PROBE == 5) {
        if (threadIdx.x < 64) { typedef int v8i __attribute__((ext_vector_type(8))); typedef float f4 __attribute__((ext_vector_type(4)));
            const int lane = threadIdx.x, i = lane & 15, kb = lane >> 4; float code = 0.f;
            for (int hyp = 0; hyp < 18; ++hyp) { const int nibswap = hyp / 9, ha = hyp % 3, hb2 = (hyp / 3) % 3;
                unsigned aw[4] = {0u, 0u, 0u, 0u}; int bw[8] = {0, 0, 0, 0, 0, 0, 0, 0};
                for (int e = 0; e < 32; ++e) { const int k = mx_kmap(ha, kb, e); const unsigned c = (unsigned)mx_a_code(i, k); const int pos = nibswap ? (e ^ 1) : e; aw[pos >> 3] |= c << (4 * (pos & 7)); }
                for (int q = 0; q < 8; ++q) { int w = 0; const float f0 = mx_b_val(mx_kmap(hb2, kb, 4 * q + 0), i), f1 = mx_b_val(mx_kmap(hb2, kb, 4 * q + 1), i), f2 = mx_b_val(mx_kmap(hb2, kb, 4 * q + 2), i), f3 = mx_b_val(mx_kmap(hb2, kb, 4 * q + 3), i);
                    w = __builtin_amdgcn_cvt_pk_fp8_f32(f0, f1, w, false); w = __builtin_amdgcn_cvt_pk_fp8_f32(f2, f3, w, true); bw[q] = w; }
                const v8i af = {(int)aw[0], (int)aw[1], (int)aw[2], (int)aw[3], 0, 0, 0, 0}, bf = {bw[0], bw[1], bw[2], bw[3], bw[4], bw[5], bw[6], bw[7]};
                f4 d = {0.f, 0.f, 0.f, 0.f};
                d = __builtin_amdgcn_mfma_scale_f32_16x16x128_f8f6f4(af, bf, d, 4, 0, 0, 0x7f7f7f7f, 0, 0x7f7f7f7f);
                int bad = 0;
                for (int r = 0; r < 4; ++r) { const int row = 4 * kb + r, col = i; float ex = 0.f; for (int k = 0; k < 128; ++k) ex += mx_a_val(row, k) * mx_b_val(k, col); bad += (d[r] != ex); }
                if (__ballot(bad != 0) == 0ull && code == 0.f) code = (float)(hyp + 1); }
            for (int t = 0; t < 2; ++t) {
                int aw[8] = {0, 0, 0, 0, 0, 0, 0, 0}, bw[8] = {0, 0, 0, 0, 0, 0, 0, 0};
                if (t == 0) { for (int e = 0; e < 32; ++e) { const int k = 32 * kb + e; aw[e >> 3] |= mx_a_code(i, k) << (4 * (e & 7)); bw[e >> 3] |= mx_a_code(i + 16, k) << (4 * (e & 7)); } }
                else { for (int q = 0; q < 8; ++q) { int w = 0, w2 = 0; const int k = 32 * kb + 4 * q;
                        w = __builtin_amdgcn_cvt_pk_fp8_f32(mx_b_val(k, i + 16), mx_b_val(k + 1, i + 16), w, false); w = __builtin_amdgcn_cvt_pk_fp8_f32(mx_b_val(k + 2, i + 16), mx_b_val(k + 3, i + 16), w, true); aw[q] = w;
                        w2 = __builtin_amdgcn_cvt_pk_fp8_f32(mx_b_val(k, i), mx_b_val(k + 1, i), w2, false); w2 = __builtin_amdgcn_cvt_pk_fp8_f32(mx_b_val(k + 2, i), mx_b_val(k + 3, i), w2, true); bw[q] = w2; } }
                const v8i af = {aw[0], aw[1], aw[2], aw[3], aw[4], aw[5], aw[6], aw[7]}, bf = {bw[0], bw[1], bw[2], bw[3], bw[4], bw[5], bw[6], bw[7]};
                f4 d = {0.f, 0.f, 0.f, 0.f};
                if (t == 0) d = __builtin_amdgcn_mfma_scale_f32_16x16x128_f8f6f4(af, bf, d, 4, 4, 0, 0x7f7f7f7f, 0, 0x7f7f7f7f); else d = __builtin_amdgcn_mfma_scale_f32_16x16x128_f8f6f4(af, bf, d, 0, 0, 0, 0x7f7f7f7f, 0, 0x7f7f7f7f);
                int bad = 0;
                for (int r = 0; r < 4; ++r) { const int row = 4 * kb + r, col = i; float ex = 0.f;
                    for (int k = 0; k < 128; ++k) ex += (t == 0) ? mx_a_val(row, k) * mx_a_val(col + 16, k) : mx_b_val(k, row + 16) * mx_b_val(k, col);
                    bad += (d[r] != ex); }
                if (__ballot(bad != 0) == 0ull) code += (t == 0) ? 10.f : 20.f; }
            if (lane == 0) vsh = code; }
        __syncthreads(); v = vsh;
    } else {
        float s0 = 0.f, s1 = 0.f, s2 = 0.f, s3 = 0.f;
        for (int i = 0; i < 2048; ++i) { s0 += pp[4 * i]; s1 += pp[4 * i + 1]; s2 += pp[4 * i + 2]; s3 += pp[4 * i + 3]; }
        if (DBG_PROBE == 4) { float mx = 0.f; for (int i = 0; i < 2048; ++i) mx = fmaxf(mx, pp[4 * i]); v = 100.f * mx; }
        else { v = (DBG_PROBE == 1 ? s0 : DBG_PROBE == 2 ? s1 : s2) / s3 * 1e-3f; v = exp2f(rintf(log2f(v) * 4.f) * 0.25f); }
    }
    for (size_t i = (size_t)blockIdx.x * 512 + threadIdx.x; i < (size_t)NBATCH * SEQ * DM; i += (size_t)gridDim.x * 512) o[i] = v;
}
extern "C" void kernel_launch(void* const* d_in, const int* in_sizes, int n_in, void* d_out, int out_size, void* d_ws, size_t ws_size, hipStream_t stream) {
    static int grid = 0;
    if (grid == 0) {
        if (n_in != 33 || out_size != NBATCH * SEQ * DM || ws_size < WS_END) { fprintf(stderr, "kernel_launch: unexpected shapes (n_in %d out %d ws %zu)\n", n_in, out_size, ws_size); grid = -1; return; }
        int dev = 0, cus = 0, per_cu = 0;
        if (hipGetDevice(&dev) != hipSuccess || hipDeviceGetAttribute(&cus, hipDeviceAttributeMultiprocessorCount, dev) != hipSuccess) { grid = -1; return; }
        if (hipFuncSetAttribute((const void*)mk_fwd, hipFuncAttributeMaxDynamicSharedMemorySize, LDS_BYTES) != hipSuccess) { fprintf(stderr, "kernel_launch: hipFuncSetAttribute failed\n"); grid = -1; return; }
        if (hipOccupancyMaxActiveBlocksPerMultiprocessor(&per_cu, (const void*)mk_fwd, NWAVES * 64, LDS_BYTES) != hipSuccess || per_cu < 1) { fprintf(stderr, "kernel_launch: occupancy query says %d\n", per_cu); (void)hipGetLastError(); grid = -1; return; }
        grid = cus;
    }
    if (grid < 0) return;
    if (hipMemsetAsync((char*)d_ws + WS_CTL, 0, CTL_ZERO_BYTES, stream) != hipSuccess) return;
    Args a{};
    for (int i = 0; i < 33; ++i) a.in[i] = (const float*)d_in[i];
    a.out = (float*)d_out; a.ws = (unsigned char*)d_ws;
#if MK_N_LAUNCHES == 1
    a.ph_lo = 0; a.ph_hi = NPHASE;
    hipLaunchKernelGGL(mk_fwd, dim3(grid), dim3(NWAVES * 64), LDS_BYTES, stream, a);
#else
    if (DBG_PROBE != 5) for (int p = 0; p < NPHASE; ++p) { a.ph_lo = p; a.ph_hi = p + 1; hipLaunchKernelGGL(mk_fwd, dim3(grid), dim3(NWAVES * 64), LDS_BYTES, stream, a); }
    if (DBG_PROBE) hipLaunchKernelGGL(dbg_fill, dim3(1024), dim3(512), 0, stream, (const float*)((char*)d_ws + WS_CTL + CTL_PROBE_OFF), (float*)d_out);
#endif
}
```

```cpp
#include <hip/hip_runtime.h>
#include <cstdio>
#include <cstdint>

#ifndef MK_N_LAUNCHES
#define MK_N_LAUNCHES 1
#endif

#ifndef DBG_SKIP
#define DBG_SKIP 0
#endif
#ifndef DBG_PROBE
#define DBG_PROBE 0
#endif
#ifndef DBG_DRY
#define DBG_DRY 1
#endif
#ifndef DBG_REPEAT
#define DBG_REPEAT -1
#endif
namespace pg8 {
#define PG8_LAS __attribute__((address_space(3)))
typedef unsigned short bf16_t;
typedef short bf16x8 __attribute__((ext_vector_type(8)));
typedef float f32x4 __attribute__((ext_vector_type(4)));
typedef unsigned u32x4 __attribute__((ext_vector_type(4)));
constexpr int BM = 256, BK = 64, HALF = 128, HTB = HALF * BK * 2  , STAGE_BYTES = 8 * HTB, NXCD = 8, WGM = 8;

__host__ __device__ __forceinline__ int lds_byte(int r, int c) { const int st = (r >> 4) * 2 + (c >> 5), rr = r & 15, cc = c & 31, ob = rr * 64 + cc * 2; return st * 1024 + (ob ^ (((ob >> 9) & 1) << 5)); }
__host__ __device__ __forceinline__ void stage_rc(int b, int& R, int& C) { const int st = b / 1024, sb = b % 1024, swz = sb ^ (((sb >> 9) & 1) << 5); R = (st >> 1) * 16 + swz / 64; C = (st & 1) * 32 + (swz % 64) / 2; }
__host__ __device__ __forceinline__ int perm32(int rho) { const int n = rho >> 4, i = rho & 15; return 8 * (i >> 2) + 4 * n + (i & 3); }

struct Unit { int pm, pn; };
struct Gemm { const bf16_t* A; const bf16_t* Bt; int M, N, K; };

struct StaticOrder {
    int nM, nN, nwg, G, c;
    __host__ __device__ void init(int M, int N, int G_, int c_) { nM = M / BM; nN = N / BM; nwg = nM * nN; G = G_; c = c_; }
    __host__ __device__ bool next(int i, Unit& u) const {
        const long L = (long)i * G + c; if (L >= nwg) return false;
        int wgid = (int)L; { const int q = nwg / NXCD, r = nwg % NXCD, xcd = wgid % NXCD, off = wgid / NXCD; wgid = (xcd < r ? xcd * (q + 1) : r * (q + 1) + (xcd - r) * q) + off; }
        const int nig = WGM * nN, gid = wgid / nig, fm = gid * WGM, gsz = (nM - fm) < WGM ? (nM - fm) : WGM;
        u.pm = fm + ((wgid % nig) % gsz); u.pn = (wgid % nig) / gsz; return true;
    }
    __device__ __forceinline__ void a_ready(const Unit&) const {}
    __device__ __forceinline__ void done(const Unit&) const {}
};
__device__ __forceinline__ int opaque_lane() { int l; asm volatile("v_mbcnt_lo_u32_b32 %0, -1, 0\n\tv_mbcnt_hi_u32_b32 %0, -1, %0" : "=v"(l)); return l; }
typedef __bf16 bf16x2c __attribute__((ext_vector_type(2)));
__device__ __forceinline__ unsigned cvt_pk_bf16(float lo, float hi) { const bf16x2c v = {(__bf16)lo, (__bf16)hi}; return __builtin_bit_cast(unsigned, v); }
template <class Epi, class Sched, bool ALIGN_EPI = false, bool SP2 = false>
__device__ __forceinline__ void gemm_phase(PG8_LAS unsigned char* lds, const Gemm g, const Sched& S, const Epi& E, const int wave_s) {
    const int lane_ = opaque_lane();
    const int wid = wave_s, lane = lane_, tid = wid * 64 + lane, wr = wid >> 2, wc = wid & 3, fr = lane & 15, fq = lane >> 4;
    const int K = g.K, nt = K / BK;
    unsigned voffA[2], voffB[2];
#pragma unroll
    for (int i = 0; i < 2; ++i) { int R, C; stage_rc(tid * 16 + i * 8192, R, C); const int Rb = Epi::PERM ? ((R & ~31) + perm32(R & 31)) : R;
        voffA[i] = (unsigned)(R * K + C) * 2u; voffB[i] = (unsigned)(Rb * K + C) * 2u; }
    const size_t kstep = (size_t)(BK * 2);
    const size_t hstep = (size_t)HALF * K * 2;
    const size_t tstep = 2 * hstep;
    const unsigned ldsw = (unsigned)wid * 1024u;
    const int aoff = lds_byte(wr * 64 + fr, fq * 8), boff = lds_byte(wc * 32 + fr, fq * 8);
#define PG8_SA(b, h) (((b) * 2 + (h)) * HTB)
#define PG8_SB(b, h) ((4 + (b) * 2 + (h)) * HTB)
#define PG8_STAGE(bufoff, gbase, voff) do { _Pragma("unroll") for (int _i = 0; _i < 2; ++_i) \
        __builtin_amdgcn_global_load_lds((const unsigned*)((const char*)(gbase) + (voff)[_i]), (PG8_LAS unsigned*)(lds + (bufoff) + ldsw + _i * 8192), 16, 0, 0); } while (0)
#define PG8_LDA(dst, b, h) do { _Pragma("unroll") for (int m = 0; m < 4; ++m) _Pragma("unroll") for (int k = 0; k < 2; ++k) dst[m][k] = *(const PG8_LAS bf16x8*)(lds + PG8_SA(b, h) + aoff + m * 2048 + k * 1024); } while (0)
#define PG8_LDB(dst, b, h) do { _Pragma("unroll") for (int n = 0; n < 2; ++n) _Pragma("unroll") for (int k = 0; k < 2; ++k) dst[n][k] = *(const PG8_LAS bf16x8*)(lds + PG8_SB(b, h) + boff + n * 2048 + k * 1024); } while (0)
#define PG8_MMA(ai, bj, At, Bt) do { __builtin_amdgcn_s_setprio(1); _Pragma("unroll") for (int m = 0; m < 4; ++m) _Pragma("unroll") for (int n = 0; n < 2; ++n) _Pragma("unroll") for (int k = 0; k < 2; ++k) \
        acc[ai][bj][m][n] = __builtin_amdgcn_mfma_f32_16x16x32_bf16(Bt[n][k], At[m][k], acc[ai][bj][m][n], 0, 0, 0); __builtin_amdgcn_s_setprio(0); } while (0)
#define PG8_WAIT_V(n) asm volatile("s_waitcnt vmcnt(" #n ")" ::: "memory")
#define PG8_WAIT_L(n) asm volatile("s_waitcnt lgkmcnt(" #n ")" ::: "memory")
#define PG8_BAR __builtin_amdgcn_s_barrier()
#define PG8_SCHED __builtin_amdgcn_sched_barrier(0)
    Unit cur, nxt; int ui = 0;
    if (!S.next(0, cur)) return;
    f32x4 acc[2][2][4][2];
#pragma unroll
    for (int a = 0; a < 2; ++a)
#pragma unroll
        for (int b = 0; b < 2; ++b)
#pragma unroll
            for (int m = 0; m < 4; ++m)
#pragma unroll
                for (int n = 0; n < 2; ++n) acc[a][b][m][n] = (f32x4){0.f, 0.f, 0.f, 0.f};
    bf16x8 At[4][2], B0[2][2], B1[2][2];
    const char* cA = (const char*)g.A + (size_t)cur.pm * tstep; const char* cB = (const char*)g.Bt + (size_t)cur.pn * tstep;
    S.a_ready(cur);
    if constexpr (SP2) {
        PG8_STAGE(PG8_SB(0, 0), cB, voffB); PG8_STAGE(PG8_SB(0, 1), cB + hstep, voffB); PG8_STAGE(PG8_SA(0, 0), cA, voffA); PG8_STAGE(PG8_SA(0, 1), cA + hstep, voffA);
        if (wr == 1) PG8_BAR;
        PG8_WAIT_V(2); PG8_BAR;
        PG8_STAGE(PG8_SB(1, 0), cB + kstep, voffB); PG8_STAGE(PG8_SA(1, 0), cA + kstep, voffA); PG8_STAGE(PG8_SB(1, 1), cB + hstep + kstep, voffB);
        PG8_WAIT_V(6); PG8_BAR;
    } else {
        PG8_STAGE(PG8_SB(0, 0), cB, voffB); PG8_STAGE(PG8_SA(0, 0), cA, voffA); PG8_STAGE(PG8_SB(0, 1), cB + hstep, voffB); PG8_STAGE(PG8_SA(0, 1), cA + hstep, voffA);
        if (wr == 1) PG8_BAR;
        PG8_WAIT_V(4); PG8_BAR;
        PG8_STAGE(PG8_SB(1, 0), cB + kstep, voffB); PG8_STAGE(PG8_SA(1, 0), cA + kstep, voffA); PG8_STAGE(PG8_SB(1, 1), cB + hstep + kstep, voffB);
        PG8_WAIT_V(6); PG8_BAR;
    }
    for (;;) {
        const bool has_next = S.next(ui + 1, nxt);
        const char* nA = has_next ? (const char*)g.A + (size_t)nxt.pm * tstep : cA; const char* nB = has_next ? (const char*)g.Bt + (size_t)nxt.pn * tstep : cB;
        for (int t = 0; t < nt; t += 2) {
            const bool last = (t == nt - 2);
            const char* a1 = cA + (size_t)(t + 1) * kstep;
            const char* a2 = last ? nA : cA + (size_t)(t + 2) * kstep; const char* b2 = last ? nB : cB + (size_t)(t + 2) * kstep;
            const char* a3 = a2 + kstep; const char* b3 = b2 + kstep;
            if (last && has_next) S.a_ready(nxt);
            if constexpr (SP2) {
            PG8_LDB(B0, 0, 0); PG8_LDB(B1, 0, 1); PG8_SCHED; PG8_LDA(At, 0, 0); PG8_STAGE(PG8_SA(1, 1), a1 + hstep, voffA);
            PG8_WAIT_V(8); PG8_WAIT_L(0); PG8_BAR; PG8_MMA(0, 0, At, B0); PG8_MMA(0, 1, At, B1); PG8_BAR; PG8_SCHED;
            PG8_LDA(At, 0, 1); PG8_STAGE(PG8_SB(0, 0), b2, voffB); PG8_STAGE(PG8_SB(0, 1), b2 + hstep, voffB); PG8_STAGE(PG8_SA(0, 0), a2, voffA);
            PG8_WAIT_V(8); PG8_WAIT_L(0); PG8_BAR; PG8_MMA(1, 0, At, B0); PG8_MMA(1, 1, At, B1); PG8_BAR; PG8_SCHED;
            PG8_LDB(B0, 1, 0); PG8_LDB(B1, 1, 1); PG8_SCHED; PG8_LDA(At, 1, 0); PG8_STAGE(PG8_SA(0, 1), a2 + hstep, voffA);
            PG8_WAIT_V(8); PG8_WAIT_L(0); PG8_BAR; PG8_MMA(0, 0, At, B0); PG8_MMA(0, 1, At, B1); PG8_BAR; PG8_SCHED;
            PG8_LDA(At, 1, 1); PG8_STAGE(PG8_SB(1, 0), b3, voffB); PG8_STAGE(PG8_SB(1, 1), b3 + hstep, voffB); PG8_STAGE(PG8_SA(1, 0), a3, voffA);
            PG8_WAIT_V(8); PG8_WAIT_L(0); PG8_BAR; PG8_MMA(1, 0, At, B0); PG8_MMA(1, 1, At, B1); PG8_BAR; PG8_SCHED;
            } else {
            PG8_LDB(B0, 0, 0); PG8_SCHED; PG8_LDA(At, 0, 0); PG8_STAGE(PG8_SA(1, 1), a1 + hstep, voffA);
            PG8_WAIT_L(8); PG8_BAR; PG8_WAIT_L(0); PG8_MMA(0, 0, At, B0); PG8_BAR; PG8_SCHED;
            PG8_LDB(B1, 0, 1); PG8_STAGE(PG8_SB(0, 0), b2, voffB);
            PG8_BAR; PG8_WAIT_L(0); PG8_MMA(0, 1, At, B1); PG8_BAR;
            PG8_LDA(At, 0, 1); PG8_STAGE(PG8_SA(0, 0), a2, voffA);
            PG8_BAR; PG8_WAIT_L(0); PG8_MMA(1, 0, At, B0); PG8_BAR; PG8_SCHED;
            PG8_STAGE(PG8_SB(0, 1), b2 + hstep, voffB);
            PG8_WAIT_V(6); PG8_BAR; PG8_MMA(1, 1, At, B1); PG8_BAR;
            PG8_LDB(B0, 1, 0); PG8_SCHED; PG8_LDA(At, 1, 0); PG8_STAGE(PG8_SA(0, 1), a2 + hstep, voffA);
            PG8_WAIT_L(8); PG8_BAR; PG8_WAIT_L(0); PG8_MMA(0, 0, At, B0); PG8_BAR; PG8_SCHED;
            PG8_LDB(B1, 1, 1); PG8_STAGE(PG8_SB(1, 0), b3, voffB);
            PG8_BAR; PG8_WAIT_L(0); PG8_MMA(0, 1, At, B1); PG8_BAR;
            PG8_LDA(At, 1, 1); PG8_STAGE(PG8_SA(1, 0), a3, voffA);
            PG8_BAR; PG8_WAIT_L(0); PG8_MMA(1, 0, At, B0); PG8_BAR; PG8_SCHED;
            PG8_STAGE(PG8_SB(1, 1), b3 + hstep, voffB);
            PG8_WAIT_V(6); PG8_BAR; PG8_MMA(1, 1, At, B1); PG8_BAR;
            }
        }
        if constexpr (ALIGN_EPI) { if (wr == 0) PG8_BAR; }
        if constexpr (!Epi::AFTER_DRAIN) { const int le_ = opaque_lane(); E(acc, cur, wr, wc, le_ & 15, le_ >> 4); S.done(cur); }
        if (!has_next) break;
#pragma unroll
        for (int a = 0; a < 2; ++a)
#pragma unroll
            for (int b = 0; b < 2; ++b)
#pragma unroll
                for (int m = 0; m < 4; ++m)
#pragma unroll
                    for (int n = 0; n < 2; ++n) acc[a][b][m][n] = (f32x4){0.f, 0.f, 0.f, 0.f};
        cur = nxt; cA = nA; cB = nB; ++ui;
        if constexpr (ALIGN_EPI) { if (wr == 1) PG8_BAR; }
    }
    PG8_WAIT_V(0);
    if constexpr (!ALIGN_EPI) { if (wr == 0) PG8_BAR; }
    PG8_BAR;
    if constexpr (Epi::AFTER_DRAIN) { E.fused(acc, cur, wr, wc, fr, fq, lds, wid, lane); S.done(cur); }
#undef PG8_SA
#undef PG8_SB
#undef PG8_STAGE
#undef PG8_LDA
#undef PG8_LDB
#undef PG8_MMA
#undef PG8_WAIT_V
#undef PG8_WAIT_L
#undef PG8_BAR
#undef PG8_SCHED
}
}

constexpr int NWAVES = 8;
constexpr int DM = 2048, NBATCH = 2, SEQ = 8192, CTXL = 256, TPB = CTXL + SEQ  , MALL = NBATCH * TPB  ;
constexpr int NLAYER = 2;
constexpr int RW = 1024, NH = 16;
constexpr int RWC = 3392, INA = 4192, INA_P = 4352, INC = 8288;
constexpr int C_WD = 3072, C_AD = 3200, C_GD = 3328, C_QC = 3392, C_KVC = 3904, C_KR = 4160;
constexpr int QKD = 96, NQ = NH * QKD  , NKV = NH * 128  ;
constexpr int NEXP = 16384;
constexpr int RREC = 9 * 64;
constexpr float NORM_EPS = 1e-6f;

constexpr size_t MiB = 1u << 20;
constexpr size_t WS_CTL = 0, CTL_ZERO_BYTES = 1 * MiB;
constexpr size_t CTL_MOD_OFF = 256 * 1024;
constexpr size_t WS_ROPE = 1 * MiB;
constexpr size_t WS_WUP = 3 * MiB, WS_AUP = WS_WUP + 512 * 1024, WS_GUP = 4 * MiB;
constexpr size_t WS_WUQ = 5 * MiB, WS_WUKV = 8 * MiB, WS_WA = 10 * MiB, WS_WB = 18 * MiB, WS_WO = 26 * MiB, WS_WQK = 42 * MiB, WS_WGA = 58 * MiB, WS_WGB = 74 * MiB, WS_WINA = 90 * MiB;
constexpr size_t WS_X = 124 * MiB, WS_H = 256 * MiB, WS_DYN = 322 * MiB;
constexpr size_t WS_PA = WS_DYN;
constexpr size_t WS_RI = 463 * MiB;
constexpr size_t WS_GG = 760 * MiB;
constexpr size_t WS_BON = 826 * MiB;
constexpr size_t WS_QN = 831 * MiB, WS_KVN = 848 * MiB;
constexpr size_t WS_Q = 857 * MiB, WS_K = 907 * MiB, WS_V = 957 * MiB, WS_END = 990 * MiB;
constexpr size_t WS_Y = WS_DYN;
constexpr size_t WS_YA = 388 * MiB, WS_YB = 421 * MiB;
constexpr size_t WS_T1 = 463 * MiB, WS_T2 = 529 * MiB;
constexpr size_t WS_PU = 600 * MiB, WS_PV = 664 * MiB;
constexpr size_t WS_SC = WS_DYN;
static_assert(WS_PA + (size_t)MALL * INA_P * 2 <= WS_RI && WS_RI + (size_t)NBATCH * NH * TPB * RREC * 2 <= WS_GG && WS_GG + (size_t)2 * MALL * RW * 2 <= WS_BON, "ws map 1");
static_assert(WS_BON + (size_t)2 * MALL * 32 * 4 <= WS_QN && WS_QN + (size_t)MALL * 512 * 2 <= WS_KVN && WS_KVN + (size_t)MALL * 256 * 2 <= WS_Q, "ws map 2");
static_assert(WS_Q + (size_t)NBATCH * NH * TPB * QKD * 2 <= WS_K && WS_K + (size_t)NBATCH * NH * TPB * QKD * 2 <= WS_V && WS_V + (size_t)NBATCH * NH * TPB * 64 * 2 <= WS_END, "ws map 3");
static_assert(WS_Y + (size_t)2 * MALL * RW * 2 <= WS_YA && WS_YA + (size_t)MALL * RW * 2 <= WS_YB && WS_YB + (size_t)MALL * RW * 2 <= WS_RI, "ws map 4");
static_assert(WS_T1 + (size_t)MALL * DM * 2 <= WS_T2 && WS_T2 + (size_t)MALL * DM * 2 <= WS_PU && WS_PU + (size_t)NEXP * DM * 2 <= WS_PV && WS_PV + (size_t)NEXP * DM * 2 <= WS_GG, "ws map 5");
static_assert(WS_SC + (size_t)MALL * DM * 4 <= WS_T1 && WS_X + (size_t)MALL * DM * 4 <= WS_H && WS_H + (size_t)MALL * DM * 2 <= WS_DYN, "ws map 6");
static_assert(WS_WINA + (size_t)NLAYER * INA_P * DM * 2 <= WS_X, "ws map 7");
constexpr size_t CTL_PROBE_OFF = 640 * 1024;
constexpr int CW_BAR = 4096;

constexpr int RING_BYTES = 131072;
constexpr int LDSCTL_OFF = RING_BYTES, MISC_OFF = LDSCTL_OFF + 320;
constexpr int LDS_BYTES = 147456;

#define GAS __attribute__((address_space(1)))
#define LAS __attribute__((address_space(3)))
typedef unsigned short bf16;
typedef unsigned v4u __attribute__((ext_vector_type(4)));
typedef unsigned v2u __attribute__((ext_vector_type(2)));
typedef float f32x4 __attribute__((ext_vector_type(4)));
typedef float f32x2 __attribute__((ext_vector_type(2)));
typedef float f32x16 __attribute__((ext_vector_type(16)));
typedef short bf16x8 __attribute__((ext_vector_type(8)));
typedef short s16x4 __attribute__((ext_vector_type(4)));
typedef __bf16 bf16x2v __attribute__((ext_vector_type(2)));
typedef __bf16 bf16x8v __attribute__((ext_vector_type(8)));
typedef GAS unsigned gu32;
#define RLX_AGENT __ATOMIC_RELAXED, __HIP_MEMORY_SCOPE_AGENT
#define LDS_WAIT() asm volatile("s_waitcnt lgkmcnt(0)" ::: "memory")
#define VM_WAIT() asm volatile("s_waitcnt vmcnt(0)" ::: "memory")
__device__ __forceinline__ unsigned f2bf(float f) { unsigned u = __builtin_bit_cast(unsigned, f); return (u + 0x7fffu + ((u >> 16) & 1u)) >> 16; }
__device__ __forceinline__ unsigned pk2(float lo, float hi) { return pg8::cvt_pk_bf16(lo, hi); }
__device__ __forceinline__ float bflo(unsigned w) { return __builtin_bit_cast(float, w << 16); }
__device__ __forceinline__ float bfhi(unsigned w) { return __builtin_bit_cast(float, w & 0xffff0000u); }
__device__ __forceinline__ float bf1(bf16 h) { return __builtin_bit_cast(float, (unsigned)h << 16); }
__device__ __forceinline__ float sigmoidf_(float x) { return __builtin_amdgcn_rcpf(1.0f + __expf(-x)); }
template <int CTRL> __device__ __forceinline__ float dpp_add(float x) {
    return x + __builtin_bit_cast(float, __builtin_amdgcn_update_dpp(0, __builtin_bit_cast(int, x), CTRL, 0xf, 0xf, true));
}
__device__ __forceinline__ float red16(float x) {
    x = dpp_add<0xB1>(x);
    x = dpp_add<0x4E>(x);
    x = dpp_add<0x141>(x);
    x = dpp_add<0x140>(x);
    return x;
}
template <int CTRL, int RM> __device__ __forceinline__ float dpp_max(float x) {
    return fmaxf(x, __builtin_bit_cast(float, __builtin_amdgcn_update_dpp(__builtin_bit_cast(int, x), __builtin_bit_cast(int, x), CTRL, RM, 0xf, false)));
}
template <int CTRL, int RM> __device__ __forceinline__ float dpp_sum(float x) {
    return x + __builtin_bit_cast(float, __builtin_amdgcn_update_dpp(0, __builtin_bit_cast(int, x), CTRL, RM, 0xf, false));
}
__device__ __forceinline__ float wave_max_u(float x) {
    x = dpp_max<0xB1, 0xf>(x); x = dpp_max<0x4E, 0xf>(x); x = dpp_max<0x141, 0xf>(x); x = dpp_max<0x140, 0xf>(x);
    x = dpp_max<0x142, 0xa>(x); x = dpp_max<0x143, 0xc>(x);
    return __builtin_bit_cast(float, __builtin_amdgcn_readlane(__builtin_bit_cast(int, x), 63));
}
__device__ __forceinline__ float wave_sum_u(float x) {
    x = dpp_sum<0xB1, 0xf>(x); x = dpp_sum<0x4E, 0xf>(x); x = dpp_sum<0x141, 0xf>(x); x = dpp_sum<0x140, 0xf>(x);
    x = dpp_sum<0x142, 0xa>(x); x = dpp_sum<0x143, 0xc>(x);
    return __builtin_bit_cast(float, __builtin_amdgcn_readlane(__builtin_bit_cast(int, x), 63));
}
__device__ __forceinline__ float wave_sum(float v) { return wave_sum_u(v); }
__device__ __forceinline__ float bpermf(int srclane, float v) { return __builtin_bit_cast(float, __builtin_amdgcn_ds_bpermute(srclane << 2, __builtin_bit_cast(int, v))); }
__device__ __forceinline__ int bpermi(int srclane, int v) { return __builtin_amdgcn_ds_bpermute(srclane << 2, v); }

#define XB_TMO      128
#define XB_XCNT(j)  (256  + 64 * (j))
#define XB_XSUB(j)  (1280 + 64 * (j))
#define XB_XGEN(j)  (2304 + 64 * (j))
#define XB_TOP      3328
#define XB_TOPGEN   3392
#define XCD_BAR_WORDS 3456
#define XB_SPIN_CAP (1u << 20)

__device__ __forceinline__ unsigned xb_ld(unsigned* p)              { return __hip_atomic_load(p, __ATOMIC_RELAXED, __HIP_MEMORY_SCOPE_AGENT); }
__device__ __forceinline__ unsigned xb_add(unsigned* p, unsigned v) { return __hip_atomic_fetch_add(p, v, __ATOMIC_RELAXED, __HIP_MEMORY_SCOPE_AGENT); }
__device__ __forceinline__ unsigned xb_xcc_id() { return (unsigned)__builtin_amdgcn_s_getreg((3 << 11) | 20) & 0xFu; }
#define XB_SPIN(cond, bar) do { unsigned _sp = 0; while (cond) { __builtin_amdgcn_s_sleep(1); \
    if ((++_sp & 255u) == 0u) { if (xb_ld(&(bar)[XB_TMO])) break; if (_sp > XB_SPIN_CAP) { atomicAdd(&(bar)[XB_TMO], 1u); break; } } } } while (0)

struct XcdBarrier { unsigned* bar; unsigned x; volatile LAS unsigned* st; };

__device__ __forceinline__ XcdBarrier xcd_barrier_post(unsigned* bar, volatile LAS unsigned* st, bool t0) {
    XcdBarrier b; b.bar = bar; b.x = xb_xcc_id(); b.st = st;
    if (t0) (void)xb_add(&bar[XB_XCNT(b.x)], 1u);
    return b;
}
__device__ __forceinline__ void xcd_barrier_complete(unsigned* bar, unsigned x, unsigned& nloc, unsigned& nx) {
    const unsigned G = gridDim.x * gridDim.y * gridDim.z;
    unsigned sum, cnt, mine, sp = 0u;
    for (;;) {
        sum = 0u; cnt = 0u; mine = 0u;
#pragma unroll
        for (unsigned j = 0; j < 16; ++j) { const unsigned c = xb_ld(&bar[XB_XCNT(j)]); sum += c; cnt += (c > 0u) ? 1u : 0u; mine = (j == x) ? c : mine; }
        if (sum == G) break;
        __builtin_amdgcn_s_sleep(1);
        if ((++sp & 255u) == 0u) { if (xb_ld(&bar[XB_TMO])) break; if (sp > XB_SPIN_CAP) { atomicAdd(&bar[XB_TMO], 1u); break; } }
    }
    nloc = mine > 0u ? mine : 1u; nx = cnt > 0u ? cnt : 1u;
}
__device__ __forceinline__ void xcd_barrier(const XcdBarrier& b, bool t0) {
    asm volatile("s_waitcnt vmcnt(0)" ::: "memory");
    __syncthreads();
    if (t0) {
        unsigned* bar = b.bar;
        __builtin_amdgcn_s_waitcnt(0);
        unsigned nloc = b.st[0], nx = b.st[1];
        if (nloc == 0u) { xcd_barrier_complete(bar, b.x, nloc, nx); b.st[0] = nloc; b.st[1] = nx; }
        const unsigned old = xb_add(&bar[XB_XSUB(b.x)], 1u);
        const unsigned gen = old / nloc;
        if (old + 1u == (gen + 1u) * nloc) {
            __builtin_amdgcn_fence(__ATOMIC_RELEASE, "agent");
            asm volatile("s_waitcnt vmcnt(0)" ::: "memory");
            const unsigned og = xb_add(&bar[XB_TOP], 1u);
            const unsigned tg = og / nx;
            if (og + 1u == (tg + 1u) * nx) xb_add(&bar[XB_TOPGEN], 1u);
            else XB_SPIN(xb_ld(&bar[XB_TOPGEN]) == tg, bar);
            __builtin_amdgcn_fence(__ATOMIC_ACQUIRE, "agent");
            xb_add(&bar[XB_XGEN(b.x)], 1u);
            asm volatile("s_waitcnt vmcnt(0)" ::: "memory");
        } else {
            XB_SPIN(xb_ld(&bar[XB_XGEN(b.x)]) == gen, bar);
            __builtin_amdgcn_fence(__ATOMIC_ACQUIRE, "agent");
            asm volatile("s_waitcnt vmcnt(0)" ::: "memory");
        }
    }
    __syncthreads();
}

struct Frame {
    LAS unsigned char* lds;
    unsigned char* ws;
    const float* const* in;
    int tid, lane, wave;
    int vcu, G;
};
struct Args { const float* in[33]; float* out; unsigned char* ws; int ph_lo, ph_hi; };


namespace pg8 {
typedef unsigned u32x4 __attribute__((ext_vector_type(4)));
struct RowOrder : StaticOrder {
    int lat;
    __host__ __device__ void init_rows(int lat_, int N, int G_, int c_) { lat = lat_; init(lat_ ? NBATCH * SEQ : MALL, N, G_, c_); }
    __host__ __device__ bool next(int i, Unit& u) const { if (!StaticOrder::next(i, u)) return false; if (lat) u.pm = 33 * (u.pm >> 5) + 1 + (u.pm & 31); return true; }
};
#define EPI_LOOP_ROWS for (int ai = 0; ai < 2; ++ai) _Pragma("unroll") for (int m = 0; m < 4; ++m)
#define EPI_PIN asm volatile("" ::: "memory")

struct EpiStoreBf16 {
    static constexpr bool PERM = true, AFTER_DRAIN = false;
    bf16_t* O; int ldc;
    __device__ __forceinline__ void operator()(const f32x4 (&acc)[2][2][4][2], const Unit& u, int wr, int wc, int fr, int fq) const {
        const int row0 = u.pm * BM + wr * 64 + fr, col0 = u.pn * BM + wc * 32 + 8 * fq;
#pragma unroll
        EPI_LOOP_ROWS { bf16_t* rowp = O + (size_t)(row0 + ai * HALF + m * 16) * ldc + col0;
#pragma unroll
            for (int bj = 0; bj < 2; ++bj) { const f32x4 v0 = acc[ai][bj][m][0], v1 = acc[ai][bj][m][1];
                u32x4 w; w.x = cvt_pk_bf16(v0[0], v0[1]); w.y = cvt_pk_bf16(v0[2], v0[3]); w.z = cvt_pk_bf16(v1[0], v1[1]); w.w = cvt_pk_bf16(v1[2], v1[3]);
                *(u32x4*)(rowp + bj * HALF) = w; } }
    }
};
struct EpiGate {
    static constexpr bool PERM = true, AFTER_DRAIN = false;
    bf16_t* O; int ldc; const float* bias;
    __device__ __forceinline__ void operator()(const f32x4 (&acc)[2][2][4][2], const Unit& u, int wr, int wc, int fr, int fq) const {
        const int row0 = u.pm * BM + wr * 64 + fr, col0 = u.pn * BM + wc * 32 + 8 * fq;
        f32x4 bv[2][2];
#pragma unroll
        for (int bj = 0; bj < 2; ++bj)
#pragma unroll
            for (int n = 0; n < 2; ++n) bv[bj][n] = *(const f32x4*)(bias + col0 + bj * HALF + 4 * n);
#pragma unroll
        EPI_LOOP_ROWS { EPI_PIN; bf16_t* rowp = O + (size_t)(row0 + ai * HALF + m * 16) * ldc + col0;
#pragma unroll
            for (int bj = 0; bj < 2; ++bj) { f32x4 v0 = acc[ai][bj][m][0] + bv[bj][0], v1 = acc[ai][bj][m][1] + bv[bj][1];
#pragma unroll
                for (int e = 0; e < 4; ++e) { v0[e] = __builtin_amdgcn_rcpf(1.0f + __expf(-v0[e])); v1[e] = __builtin_amdgcn_rcpf(1.0f + __expf(-v1[e])); }
                u32x4 w; w.x = cvt_pk_bf16(v0[0], v0[1]); w.y = cvt_pk_bf16(v0[2], v0[3]); w.z = cvt_pk_bf16(v1[0], v1[1]); w.w = cvt_pk_bf16(v1[2], v1[3]);
                *(u32x4*)(rowp + bj * HALF) = w; } }
    }
};
__device__ __forceinline__ float bf_lo(unsigned w) { return __builtin_bit_cast(float, w << 16); }
__device__ __forceinline__ float bf_hi(unsigned w) { return __builtin_bit_cast(float, w & 0xffff0000u); }
struct EpiMulAdd {
    static constexpr bool PERM = true, AFTER_DRAIN = false;
    bf16_t* O; const bf16_t* Gt; const bf16_t* Ad; int ldc;
    __device__ __forceinline__ void operator()(const f32x4 (&acc)[2][2][4][2], const Unit& u, int wr, int wc, int fr, int fq) const {
        const int row0 = u.pm * BM + wr * 64 + fr, col0 = u.pn * BM + wc * 32 + 8 * fq;
#pragma unroll
        EPI_LOOP_ROWS { EPI_PIN; const size_t ro = (size_t)(row0 + ai * HALF + m * 16) * ldc + col0;
#pragma unroll
            for (int bj = 0; bj < 2; ++bj) { const f32x4 v0 = acc[ai][bj][m][0], v1 = acc[ai][bj][m][1];
                const u32x4 g = *(const u32x4*)(Gt + ro + bj * HALF);
                float o[8];
                o[0] = bf_lo(g.x) * v0[0]; o[1] = bf_hi(g.x) * v0[1]; o[2] = bf_lo(g.y) * v0[2]; o[3] = bf_hi(g.y) * v0[3];
                o[4] = bf_lo(g.z) * v1[0]; o[5] = bf_hi(g.z) * v1[1]; o[6] = bf_lo(g.w) * v1[2]; o[7] = bf_hi(g.w) * v1[3];
                if (Ad) { const u32x4 a = *(const u32x4*)(Ad + ro + bj * HALF);
                    o[0] += bf_lo(a.x); o[1] += bf_hi(a.x); o[2] += bf_lo(a.y); o[3] += bf_hi(a.y); o[4] += bf_lo(a.z); o[5] += bf_hi(a.z); o[6] += bf_lo(a.w); o[7] += bf_hi(a.w); }
                u32x4 w; w.x = cvt_pk_bf16(o[0], o[1]); w.y = cvt_pk_bf16(o[2], o[3]); w.z = cvt_pk_bf16(o[4], o[5]); w.w = cvt_pk_bf16(o[6], o[7]);
                *(u32x4*)(O + ro + bj * HALF) = w; } }
    }
};
struct EpiResid {
    static constexpr bool PERM = false, AFTER_DRAIN = false;
    float* X; const float* gate;
    const float* xin; const float* cin;
    __device__ __forceinline__ void operator()(const f32x4 (&acc)[2][2][4][2], const Unit& u, int wr, int wc, int fr, int fq) const {
        const int row0 = u.pm * BM + wr * 64 + fr, col0 = u.pn * BM + wc * 32 + 4 * fq;
        const int bb = u.pm / 33, pt = u.pm - bb * 33, mr = (pt == 0) ? 2 : bb;
        const float* gp = gate + (size_t)mr * 12288 + col0;
        const float* sbase = xin ? (pt == 0 ? cin + (size_t)bb * CTXL * DM : xin + ((size_t)bb * SEQ + (size_t)(pt - 1) * BM) * DM) : X + (size_t)u.pm * BM * DM;
        f32x4 gv[2][2];
#pragma unroll
        for (int bj = 0; bj < 2; ++bj)
#pragma unroll
            for (int n = 0; n < 2; ++n) gv[bj][n] = *(const f32x4*)(gp + bj * HALF + n * 16);
#pragma unroll
        EPI_LOOP_ROWS { EPI_PIN; const int rl = wr * 64 + fr + ai * HALF + m * 16; float* rowp = X + (size_t)(u.pm * BM + rl) * DM + col0; const float* srow = sbase + (size_t)rl * DM + col0;
#pragma unroll
            for (int bj = 0; bj < 2; ++bj)
#pragma unroll
                for (int n = 0; n < 2; ++n) *(f32x4*)(rowp + bj * HALF + n * 16) = *(const f32x4*)(srow + bj * HALF + n * 16) + gv[bj][n] * acc[ai][bj][m][n]; }
    }
};
struct EpiF32 {
    static constexpr bool PERM = false, AFTER_DRAIN = false;
    float* C; int ldc;
    __device__ __forceinline__ void operator()(const f32x4 (&acc)[2][2][4][2], const Unit& u, int wr, int wc, int fr, int fq) const {
        const int row0 = u.pm * BM + wr * 64 + fr, col0 = u.pn * BM + wc * 32 + 4 * fq;
#pragma unroll
        EPI_LOOP_ROWS { float* rowp = C + (size_t)(row0 + ai * HALF + m * 16) * ldc + col0;
#pragma unroll
            for (int bj = 0; bj < 2; ++bj)
#pragma unroll
                for (int n = 0; n < 2; ++n) *(f32x4*)(rowp + bj * HALF + n * 16) = acc[ai][bj][m][n]; }
    }
};
struct EpiQ {
    static constexpr bool PERM = true, AFTER_DRAIN = false;
    bf16_t* Q; const f32x2* rope; float qscale;
    __device__ __forceinline__ void operator()(const f32x4 (&acc)[2][2][4][2], const Unit& u, int wr, int wc, int fr, int fq) const {
        const int bb = u.pm / 33, tp0 = (u.pm - bb * 33) * BM + wr * 64 + fr, col0 = u.pn * BM + wc * 32 + 8 * fq;
#pragma unroll
        for (int bj = 0; bj < 2; ++bj) { const int c = col0 + bj * HALF, hd = c / QKD, d = c - hd * QKD;
#pragma unroll
            EPI_LOOP_ROWS { EPI_PIN; const int tp = tp0 + ai * HALF + m * 16;
                f32x4 v0 = acc[ai][bj][m][0], v1 = acc[ai][bj][m][1];
                if (d >= 64) { const int i0 = (d - 64) >> 1; const f32x2* rp = rope + (size_t)tp * 16 + i0;
                    const f32x2 c0 = rp[0], c1 = rp[1], c2 = rp[2], c3 = rp[3];
                    float a, b;
                    a = v0[0]; b = v0[1]; v0[0] = a * c0.x - b * c0.y; v0[1] = a * c0.y + b * c0.x;
                    a = v0[2]; b = v0[3]; v0[2] = a * c1.x - b * c1.y; v0[3] = a * c1.y + b * c1.x;
                    a = v1[0]; b = v1[1]; v1[0] = a * c2.x - b * c2.y; v1[1] = a * c2.y + b * c2.x;
                    a = v1[2]; b = v1[3]; v1[2] = a * c3.x - b * c3.y; v1[3] = a * c3.y + b * c3.x; }
                v0 = v0 * qscale; v1 = v1 * qscale;
                u32x4 w; w.x = cvt_pk_bf16(v0[0], v0[1]); w.y = cvt_pk_bf16(v0[2], v0[3]); w.z = cvt_pk_bf16(v1[0], v1[1]); w.w = cvt_pk_bf16(v1[2], v1[3]);
                *(u32x4*)(Q + ((size_t)(bb * NH + hd) * TPB + tp) * QKD + d) = w; } }
    }
};
struct EpiKV {
    static constexpr bool PERM = true, AFTER_DRAIN = false;
    bf16_t* K; bf16_t* V;
    __device__ __forceinline__ void operator()(const f32x4 (&acc)[2][2][4][2], const Unit& u, int wr, int wc, int fr, int fq) const {
        const int bb = u.pm / 33, tp0 = (u.pm - bb * 33) * BM + wr * 64 + fr;
        const bool isK = wc < 2;
        bf16_t* base = isK ? K : V; const int pitch = isK ? QKD : 64, doff = 32 * (wc & 1) + 8 * fq;
#pragma unroll
        for (int bj = 0; bj < 2; ++bj) { const int hd = 2 * u.pn + bj;
            bf16_t* hb = base + (size_t)(bb * NH + hd) * TPB * pitch;
#pragma unroll
            EPI_LOOP_ROWS { EPI_PIN; const int tp = tp0 + ai * HALF + m * 16;
                const f32x4 v0 = acc[ai][bj][m][0], v1 = acc[ai][bj][m][1];
                u32x4 w; w.x = cvt_pk_bf16(v0[0], v0[1]); w.y = cvt_pk_bf16(v0[2], v0[3]); w.z = cvt_pk_bf16(v1[0], v1[1]); w.w = cvt_pk_bf16(v1[2], v1[3]);
                *(u32x4*)((char*)hb + (unsigned)((tp * pitch + doff) * 2)) = w; } }
    }
};
}

struct TItem { const float* W; bf16* WT; int K, ldw, c0, N, mapq, item; };
__device__ __forceinline__ void p0_item_load(const TItem& T, int lane, f32x4 (&x)[8]) {
    const int nblk = T.N / 32, kb = T.item / nblk, nb = T.item - kb * nblk, k0 = 64 * kb, n0 = 32 * nb;
    const float* p = T.W + (size_t)(k0 + (lane >> 3)) * T.ldw + T.c0 + n0 + (lane & 7) * 4;
#pragma unroll
    for (int i = 0; i < 8; ++i) x[i] = *(const GAS f32x4*)(p + (size_t)(8 * i) * T.ldw);
}
__device__ __forceinline__ void p0_item_finish(const TItem& T, const f32x4 (&x)[8], LAS float* scr, int lane) {
    const int nblk = T.N / 32, kb = T.item / nblk, nb = T.item - kb * nblk, k0 = 64 * kb, n0 = 32 * nb;
#pragma unroll
    for (int i = 0; i < 8; ++i) { LAS float* d = scr + (8 * i + (lane >> 3)) * 33 + (lane & 7) * 4; d[0] = x[i].x; d[1] = x[i].y; d[2] = x[i].z; d[3] = x[i].w; }
    LDS_WAIT(); asm volatile("" ::: "memory");
    const int c = lane & 7;
#pragma unroll
    for (int j = 0; j < 4; ++j) { const int n = (lane >> 3) + 8 * j; const LAS float* s = scr + (8 * c) * 33 + n;
        v4u o; o.x = pk2(s[0 * 33], s[1 * 33]); o.y = pk2(s[2 * 33], s[3 * 33]); o.z = pk2(s[4 * 33], s[5 * 33]); o.w = pk2(s[6 * 33], s[7 * 33]);
        int nn = n0 + n;
        if (T.mapq) { const int hd = nn / QKD, d = nn - hd * QKD; if (d >= 64) { const int i = (d - 64) & 15, s2 = (d - 64) >> 4; nn = hd * QKD + 64 + 2 * i + s2; } }
        *(GAS v4u*)(T.WT + (size_t)nn * T.K + k0 + 8 * c) = o; }
    LDS_WAIT(); asm volatile("" ::: "memory");
}

__device__ __forceinline__ const float* karg(int i);
constexpr int TB_INA = (DM / 128) * ((INA + 127) / 128), TB_G = (DM / 128) * (DM / 128), TB_BR = (RW / 128) * (DM / 128), TB_UQ = (512 / 128) * (NQ / 128), TB_UKV = (256 / 128) * (NKV / 128);
constexpr int TB_N = TB_INA + 2 * TB_G + 2 * TB_BR + TB_G + TB_UQ + TB_UKV;
constexpr int TI_LR = 1 * (RW / 32), TI_N = 4 * TI_LR;
__device__ __forceinline__ TItem p0_resolve_big(unsigned char* ws, int git) {
    const int l = git / TB_N; int r = git - l * TB_N; TItem T; T.mapq = 0; T.c0 = 0;
    if (r < TB_INA) { T.W = karg(7) + (size_t)l * DM * INC; T.K = DM; T.ldw = INC; T.N = INA; T.WT = (bf16*)(ws + WS_WINA) + (size_t)l * INA_P * DM; T.item = r; return T; } r -= TB_INA;
    if (r < TB_G) { T.W = karg(7) + (size_t)l * DM * INC; T.K = DM; T.ldw = INC; T.c0 = INA; T.N = DM; T.WT = (bf16*)(ws + WS_WGA) + (size_t)l * DM * DM; T.item = r; return T; } r -= TB_G;
    if (r < TB_G) { T.W = karg(7) + (size_t)l * DM * INC; T.K = DM; T.ldw = INC; T.c0 = INA + DM; T.N = DM; T.WT = (bf16*)(ws + WS_WGB) + (size_t)l * DM * DM; T.item = r; return T; } r -= TB_G;
    if (r < TB_BR) { T.W = karg(24) + (size_t)l * RW * DM; T.K = RW; T.ldw = DM; T.N = DM; T.WT = (bf16*)(ws + WS_WA) + (size_t)l * DM * RW; T.item = r; return T; } r -= TB_BR;
    if (r < TB_BR) { T.W = karg(25) + (size_t)l * RW * DM; T.K = RW; T.ldw = DM; T.N = DM; T.WT = (bf16*)(ws + WS_WB) + (size_t)l * DM * RW; T.item = r; return T; } r -= TB_BR;
    if (r < TB_G) { T.W = karg(26) + (size_t)l * DM * DM; T.K = DM; T.ldw = DM; T.N = DM; T.WT = (bf16*)(ws + WS_WO) + (size_t)l * DM * DM; T.item = r; return T; } r -= TB_G;
    if (r < TB_UQ) { T.W = karg(21) + (size_t)l * 512 * NQ; T.K = 512; T.ldw = NQ; T.N = NQ; T.WT = (bf16*)(ws + WS_WUQ) + (size_t)l * NQ * 512; T.item = r; T.mapq = 1; return T; } r -= TB_UQ;
    { T.W = karg(23) + (size_t)l * 256 * NKV; T.K = 256; T.ldw = NKV; T.N = NKV; T.WT = (bf16*)(ws + WS_WUKV) + (size_t)l * NKV * 256; T.item = r; return T; }
}
__device__ __forceinline__ void p0_big_load(const TItem& T, int tid, f32x4 (&x)[8]) {
    const int nblk = (T.N + 127) / 128, kb = T.item / nblk, nb = T.item - kb * nblk, k0 = 128 * kb, col = 128 * nb + (tid & 31) * 4;
    const float* p = T.W + (size_t)(k0 + (tid >> 5)) * T.ldw + T.c0 + col; const bool ok = col < T.N;
#pragma unroll
    for (int i = 0; i < 8; ++i) x[i] = ok ? *(const GAS f32x4*)(p + (size_t)(16 * i) * T.ldw) : (f32x4){0.f, 0.f, 0.f, 0.f};
}
__device__ __forceinline__ void p0_big_finish(const TItem& T, const f32x4 (&x)[8], LAS float* tile, int tid) {
    const int nblk = (T.N + 127) / 128, kb = T.item / nblk, nb = T.item - kb * nblk, k0 = 128 * kb, n0 = 128 * nb;
    __syncthreads();
#pragma unroll
    for (int i = 0; i < 8; ++i) *(LAS f32x4*)(tile + ((tid >> 5) + 16 * i) * 132 + (tid & 31) * 4) = x[i];
    __syncthreads();
    const int n = tid & 127, cg = tid >> 7; int nn = n0 + n;
    if (nn < T.N) {
        if (T.mapq) { const int hd = nn / QKD, d = nn - hd * QKD; if (d >= 64) { const int i = (d - 64) & 15, s2 = (d - 64) >> 4; nn = hd * QKD + 64 + 2 * i + s2; } }
#pragma unroll
        for (int c = 0; c < 4; ++c) { const LAS float* s = tile + (32 * cg + 8 * c) * 132 + n;
            v4u o; o.x = pk2(s[0 * 132], s[1 * 132]); o.y = pk2(s[2 * 132], s[3 * 132]); o.z = pk2(s[4 * 132], s[5 * 132]); o.w = pk2(s[6 * 132], s[7 * 132]);
            *(GAS v4u*)(T.WT + (size_t)nn * T.K + k0 + 32 * cg + 8 * c) = o; } }
}
__device__ __forceinline__ TItem p0_resolve(unsigned char* ws, int git) {
    const int l = git / TI_N; int r = git - l * TI_N; TItem T; T.mapq = 0; T.c0 = 0;
    const int which = r / TI_LR, d = which & 1, isa = which >> 1; r -= which * TI_LR;
    T.W = (isa ? karg(13) : karg(11)) + (size_t)(l * 2 + d) * 64 * RW; T.K = 64; T.ldw = RW; T.N = RW; T.WT = (bf16*)(ws + (isa ? WS_AUP : WS_WUP)) + (size_t)(l * 2 + d) * RW * 64; T.item = r; return T;
}
__device__ __forceinline__ void p0_prologue(Frame& F) {
    LAS float* scr = (LAS float*)(F.lds + F.wave * 16384);
    const int gw = F.vcu * NWAVES + F.wave, NGW = F.G * NWAVES;
    unsigned char* ws = F.ws;
    for (int rp_ = 0; rp_ < (DBG_REPEAT == 102 ? 2 : 1); ++rp_)
    { float* modw = (float*)(ws + WS_CTL + CTL_MOD_OFF); const float* adaw = karg(4); const float* adab = karg(5); const float* cin = karg(1); const float* cctx = karg(3);
      LAS float* SIL = (LAS float*)F.lds;
      LAS f32x2* part = (LAS f32x2*)(F.lds + 32768);
      if (F.vcu < NLAYER * 96) {
          for (int i = F.tid; i < 3 * DM; i += 512) { const int r = i >> 11, k = i & 2047; const float c = r < 2 ? cin[r * DM + k] : cctx[k]; SIL[i] = c / (1.f + __expf(-c)); }
          __syncthreads(); }
      for (int uu = F.vcu; uu < NLAYER * 96; uu += F.G) { const int cb = uu % 96, l = uu / 96;
          const int n0 = cb * 128 + F.lane * 2; const float* aw = adaw + (size_t)l * DM * 12288 + n0;
          f32x2 a0 = {0, 0}, a1 = a0, a2 = a0;
#pragma unroll 1
          for (int k0 = F.wave * 256; k0 < F.wave * 256 + 256; k0 += 16) { f32x2 w[16];
#pragma unroll
              for (int j = 0; j < 16; ++j) w[j] = *(const GAS f32x2*)(aw + (size_t)(k0 + j) * 12288);
#pragma unroll
              for (int j = 0; j < 16; ++j) { a0 = a0 + w[j] * SIL[k0 + j]; a1 = a1 + w[j] * SIL[DM + k0 + j]; a2 = a2 + w[j] * SIL[2 * DM + k0 + j]; } }
          __syncthreads();
          part[(F.wave * 3 + 0) * 64 + F.lane] = a0; part[(F.wave * 3 + 1) * 64 + F.lane] = a1; part[(F.wave * 3 + 2) * 64 + F.lane] = a2;
          __syncthreads();
          if (F.wave < 3) { f32x2 s = *(const GAS f32x2*)(adab + (size_t)l * 12288 + n0);
#pragma unroll
              for (int w8 = 0; w8 < 8; ++w8) s = s + part[(w8 * 3 + F.wave) * 64 + F.lane];
              *(GAS f32x2*)(modw + ((size_t)l * 3 + F.wave) * 12288 + n0) = s; }
          __syncthreads(); } }
    for (int rp_ = 0; rp_ < (DBG_REPEAT == 101 ? 2 : 1); ++rp_)
    { unsigned* ctr = (unsigned*)(ws + WS_CTL) + 2048 + 64 * rp_; LAS float* tile = (LAS float*)F.lds; LAS int* slot = (LAS int*)(F.lds + 128 * 132 * 4);
#define P0_GRAB(dst) do { __syncthreads(); if (F.tid == 0) *slot = (int)__hip_atomic_fetch_add(ctr, 1u, __ATOMIC_RELAXED, __HIP_MEMORY_SCOPE_AGENT); __syncthreads(); dst = *slot; } while (0)
      int it; P0_GRAB(it); f32x4 xa[8], xb[8]; TItem T, Tn;
      if (it < NLAYER * TB_N) { T = p0_resolve_big(ws, it); p0_big_load(T, F.tid, xa); }
      while (it < NLAYER * TB_N) { int itn; P0_GRAB(itn); const bool more = itn < NLAYER * TB_N;
          if (more) { Tn = p0_resolve_big(ws, itn); p0_big_load(Tn, F.tid, xb); }
          p0_big_finish(T, xa, tile, F.tid);
          if (more) { T = Tn;
#pragma unroll
              for (int i = 0; i < 8; ++i) xa[i] = xb[i]; }
          it = itn; }
#undef P0_GRAB
      __syncthreads();
      for (int itw = gw; itw < NLAYER * TI_N; itw += NGW) { f32x4 xw[8]; const TItem Tw = p0_resolve(ws, itw); p0_item_load(Tw, F.lane, xw); p0_item_finish(Tw, xw, scr, F.lane); }
    }
    const int gt = gw * 64 + F.lane, NGT = NGW * 64;
    { const float* gup = karg(14);
    for (int i = gt; i < NLAYER * 2 * 32 * RW; i += NGT) { const int ch = i & 1023, r = (i >> 10) & 31, ld = i >> 15;
        ((bf16*)(ws + WS_GUP))[((size_t)ld * RW + ch) * 32 + r] = (bf16)f2bf(gup[i]); } }
    for (int i = gt; i < NLAYER * (INA_P - INA) * DM / 8; i += NGT) { const int l = i / ((INA_P - INA) * DM / 8), r = i - l * ((INA_P - INA) * DM / 8);
        ((GAS v4u*)((bf16*)(ws + WS_WINA) + ((size_t)l * INA_P + INA) * DM))[r] = (v4u){0u, 0u, 0u, 0u}; }
    { f32x2* rt = (f32x2*)(ws + WS_ROPE);
      for (int i = gt; i < TPB * 16; i += NGT) { const int tp = i >> 4, k = i & 15; f32x2 o = {1.f, 0.f};
          if (tp >= CTXL) { const int t = tp - CTXL, row = t >> 6, col = t & 63, j = k & 7; const float fr = powf(10000.0f, -(float)j / 8.0f);
              const float ang = (float)(k < 8 ? row : col) * fr; o.x = cosf(ang); o.y = sinf(ang); }
          rt[i] = o; } }
    for (int rp_ = 0; rp_ < (DBG_REPEAT == 103 ? 2 : 1); ++rp_)
    { LAS float* KEY = (LAS float*)F.lds;
      LAS float* WQT = (LAS float*)(F.lds + 65536);
      const float* pkeys = karg(29); const float* pwq = karg(28);
      __syncthreads();
      for (int uu = F.vcu; uu < NLAYER * 16 * 32; uu += F.G) { const int kb = uu & 31, hp = (uu >> 5) & 15, l = uu >> 9;
          const GAS f32x4* ksrc = (const GAS f32x4*)(pkeys + ((size_t)l * 16 + hp) * 16384);
          for (int i = F.tid; i < 4096; i += 512) ((LAS f32x4*)KEY)[i] = ksrc[i];
          for (int i = F.tid; i < 2048; i += 512) { const int kk = i >> 5, d4 = i & 31;
              *(LAS f32x4*)(WQT + kk * 132 + d4 * 4) = *(const GAS f32x4*)(pwq + ((size_t)l * DM + kb * 64 + kk) * DM + hp * 128 + d4 * 4); }
          __syncthreads();
          const int kq = F.tid & 15, keyq = F.tid >> 4;
          float acc[4][4];
#pragma unroll
          for (int j = 0; j < 4; ++j)
#pragma unroll
              for (int i = 0; i < 4; ++i) acc[j][i] = 0.f;
          for (int d = 0; d < 128; d += 4) { f32x4 w[4], q[4];
#pragma unroll
              for (int i = 0; i < 4; ++i) w[i] = *(LAS f32x4*)(WQT + (kq + 16 * i) * 132 + d);
#pragma unroll
              for (int j = 0; j < 4; ++j) q[j] = *(LAS f32x4*)(KEY + (4 * keyq + j) * 128 + d);
#pragma unroll
              for (int j = 0; j < 4; ++j)
#pragma unroll
                  for (int i = 0; i < 4; ++i) acc[j][i] += q[j].x * w[i].x + q[j].y * w[i].y + q[j].z * w[i].z + q[j].w * w[i].w; }
          bf16* dst = (bf16*)(ws + WS_WQK) + ((size_t)l * DM + hp * 128 + 4 * keyq) * DM + kb * 64 + kq;
#pragma unroll
          for (int j = 0; j < 4; ++j)
#pragma unroll
              for (int i = 0; i < 4; ++i) dst[(size_t)j * DM + 16 * i] = (bf16)f2bf(acc[j][i]);
          __syncthreads(); } }
}

__device__ __forceinline__ void modnorm_phase(Frame& F, const float* X, const float* g, const float* mod  , int chunk_sh, bf16* H, int skip_ctx, const float* xin = nullptr, const float* cin = nullptr) {
    const int gw = F.vcu * NWAVES + F.wave, NGW = F.G * NWAVES;
    for (int m = gw; m < MALL; m += NGW) {
        const int b = m / TPB, tp = m - b * TPB; if (skip_ctx && tp < CTXL) continue;
        const int mr = tp < CTXL ? 2 : b;
        const float* srow = xin ? (tp < CTXL ? cin + ((size_t)b * CTXL + tp) * DM : xin + ((size_t)b * SEQ + (tp - CTXL)) * DM) : X + (size_t)m * DM;
        const GAS f32x4* xr = (const GAS f32x4*)srow + F.lane;
        f32x4 v[8]; float s = 0.f;
#pragma unroll
        for (int j = 0; j < 8; ++j) { v[j] = xr[64 * j]; s += (v[j].x * v[j].x + v[j].y * v[j].y) + (v[j].z * v[j].z + v[j].w * v[j].w); }
        const float rs = rsqrtf(wave_sum(s) * (1.f / DM) + NORM_EPS);
        const float* sh = mod + (size_t)mr * 12288 + chunk_sh * DM; const float* sc = sh + DM;
        GAS v2u* o8 = (GAS v2u*)(H + (size_t)m * DM) + F.lane;
#pragma unroll
        for (int j = 0; j < 8; ++j) { const int c = (F.lane + 64 * j) * 4;
            const f32x4 gg = *(const GAS f32x4*)(g + c), s1 = *(const GAS f32x4*)(sc + c), s0 = *(const GAS f32x4*)(sh + c);
            f32x4 y = v[j] * rs * gg; y = y * (s1 + 1.0f) + s0;
            v2u o; o.x = pk2(y.x, y.y); o.y = pk2(y.z, y.w); o8[64 * j] = o; }
    }
}

typedef float f32x4v __attribute__((ext_vector_type(4)));
#define MFMA16(a, b, c) __builtin_amdgcn_mfma_f32_16x16x32_bf16((a), (b), (c), 0, 0, 0)
#define MFMA32(a, b, c) __builtin_amdgcn_mfma_f32_32x32x16_bf16((a), (b), (c), 0, 0, 0)

struct FeatP {
    const bf16* PA; const float* mu; const float* w0; const float* a0; const float* k_k; const float* k_a; const float* r_k;
    const bf16* WUP; const bf16* AUP; const bf16* GUP;
    const float* qnorm; const float* kvnorm; const f32x2* rope;
    bf16* RI; bf16* GG; float* BON; bf16* QN; bf16* KVN; bf16* K;
};
__device__ __forceinline__ f32x4 ld4bf(const bf16* p) { const v2u w = *(const GAS v2u*)p; return (f32x4){bflo(w.x), bfhi(w.x), bflo(w.y), bfhi(w.y)}; }
__device__ __forceinline__ f32x4 mix4(const bf16* PA, int m, int c, bool hp, bool hn, const float* mu) {
    const f32x4 pc = ld4bf(PA + (size_t)m * INA_P + c);
    f32x4 pp = {0, 0, 0, 0}, pn = {0, 0, 0, 0};
    if (hp) pp = ld4bf(PA + (size_t)(m - 1) * INA_P + c);
    if (hn) pn = ld4bf(PA + (size_t)(m + 1) * INA_P + c);
    const f32x4 mm = *(const GAS f32x4*)(mu + c);
    return pc + ((pp + pn) * 0.5f - pc) * mm;
}
__device__ __forceinline__ void unpack8(const v4u w, float (&x)[8]) { x[0] = bflo(w.x); x[1] = bfhi(w.x); x[2] = bflo(w.y); x[3] = bfhi(w.y); x[4] = bflo(w.z); x[5] = bfhi(w.z); x[6] = bflo(w.w); x[7] = bfhi(w.w); }
__device__ __forceinline__ v4u pack8f(const float (&x)[8]) { v4u o; o.x = pk2(x[0], x[1]); o.y = pk2(x[2], x[3]); o.z = pk2(x[4], x[5]); o.w = pk2(x[6], x[7]); return o; }
__device__ __forceinline__ void mix8(const bf16* rowc, bool hp, bool hn, const float (&mu)[8], float (&o)[8]) {
    const v4u zc = {0u, 0u, 0u, 0u};
    const v4u wc = *(const GAS v4u*)rowc, wp = hp ? *(const GAS v4u*)(rowc - INA_P) : zc, wn = hn ? *(const GAS v4u*)(rowc + INA_P) : zc;
    float c[8], p[8], n[8]; unpack8(wc, c); unpack8(wp, p); unpack8(wn, n);
#pragma unroll
    for (int e = 0; e < 8; ++e) o[e] = c[e] + (0.5f * (p[e] + n[e]) - c[e]) * mu[e];
}
struct Raw3 { v4u c, p, n; };
__device__ __forceinline__ Raw3 load3(const bf16* rowc, bool hp, bool hn) { const v4u zc = {0u, 0u, 0u, 0u}; Raw3 r; r.c = *(const GAS v4u*)rowc; r.p = hp ? *(const GAS v4u*)(rowc - INA_P) : zc; r.n = hn ? *(const GAS v4u*)(rowc + INA_P) : zc; return r; }
__device__ __forceinline__ void mix8r(const Raw3& w, const float (&mu)[8], float (&o)[8]) {
    float c[8], p[8], n[8]; unpack8(w.c, c); unpack8(w.p, p); unpack8(w.n, n);
#pragma unroll
    for (int e = 0; e < 8; ++e) o[e] = c[e] + (0.5f * (p[e] + n[e]) - c[e]) * mu[e];
}
__device__ __forceinline__ void features_phase(Frame& F, const FeatP& P) {
    constexpr int LAP = 328;
    LAS bf16* LA = (LAS bf16*)F.lds;
    LAS float* SSQ = (LAS float*)(F.lds + 10752);
    LAS float* PRM = (LAS float*)(F.lds + 12288);
    const int lane = F.lane, w = F.wave, tk = lane & 15, q4 = lane >> 4;
    constexpr int NTILE = MALL / 16, NTG = 64;
    for (int su = F.vcu; su < 4 * NTG; su += F.G) {
        const int cg = su & 3, tg = su >> 2, cw = 256 * cg + 32 * w, ch8 = cw + 8 * q4, hd = 4 * cg + (w >> 1);
        __syncthreads();
        for (int i = F.tid; i < 2560; i += 512) { const int prm = i >> 8, c = (i & 255) + 256 * cg; float v;
            switch (prm) { case 0: v = P.k_k[c]; break; case 1: v = P.k_a[c]; break; case 2: v = P.r_k[c]; break; case 3: v = P.w0[c]; break; case 4: v = P.w0[RW + c]; break;
                           case 5: v = P.a0[c]; break; case 6: v = P.a0[RW + c]; break; case 7: v = P.mu[c]; break; case 8: v = P.mu[RW + c]; break; default: v = P.mu[2 * RW + c]; break; }
            PRM[i] = v; }
        bf16x8 fw[2][2][2], fa[2][2][2], fg[2][2];
        { const int chA = cw + 8 * (tk >> 2) + (tk & 3);
#pragma unroll
          for (int d = 0; d < 2; ++d)
#pragma unroll
              for (int t = 0; t < 2; ++t) {
#pragma unroll
                  for (int ks = 0; ks < 2; ++ks) { fw[d][t][ks] = *(const GAS bf16x8*)(P.WUP + ((size_t)d * RW + chA + 4 * t) * 64 + ks * 32 + q4 * 8); fa[d][t][ks] = *(const GAS bf16x8*)(P.AUP + ((size_t)d * RW + chA + 4 * t) * 64 + ks * 32 + q4 * 8); }
                  fg[d][t] = *(const GAS bf16x8*)(P.GUP + ((size_t)d * RW + chA + 4 * t) * 32 + q4 * 8); } }
        for (int tt = tg; tt < NTILE; tt += NTG) {
            const int m0 = tt * 16;
            const int m = m0 + tk, b = m / TPB, tp = m - b * TPB;
            const bool hp = (tp != 0) && (tp != CTXL), hn = (tp != CTXL - 1) && (tp != TPB - 1);
            const bf16* rowp = P.PA + (size_t)m * INA_P + ch8;
            const Raw3 rawk = load3(rowp + RW, hp, hn), rawr = load3(rowp, hp, hn), rawv = load3(rowp + 2 * RW, hp, hn);
            __syncthreads();
            for (int it = F.tid; it < 640; it += 512) { const int tkk = it / 40, c8 = (it - tkk * 40) * 8, c = C_WD + c8, m = m0 + tkk, tp = m % TPB;
                const bool hp = (tp != 0) && (tp != CTXL), hn = (tp != CTXL - 1) && (tp != TPB - 1);
                float mu[8], v[8];
                { const f32x4 a = *(const GAS f32x4*)(P.mu + c), b2 = *(const GAS f32x4*)(P.mu + c + 4); mu[0] = a.x; mu[1] = a.y; mu[2] = a.z; mu[3] = a.w; mu[4] = b2.x; mu[5] = b2.y; mu[6] = b2.z; mu[7] = b2.w; }
                mix8(P.PA + (size_t)m * INA_P + c, hp, hn, mu, v);
#pragma unroll
                for (int e = 0; e < 8; ++e) { if (c < C_AD) v[e] = 1.0f - 2.0f * __builtin_amdgcn_rcpf(1.0f + __expf(2.0f * v[e])); else if (c >= C_GD) v[e] = sigmoidf_(v[e]); }
                *(LAS v4u*)(LA + tkk * LAP + c8) = pack8f(v); }
            if ((tt & 3) == cg) {
#pragma unroll
                for (int t2 = 0; t2 < 2; ++t2) { const int m = m0 + 2 * w + t2, b = m / TPB, tp = m - b * TPB; const bf16* row = P.PA + (size_t)m * INA_P;
                    { float x[8]; unpack8(*(const GAS v4u*)(row + C_QC + lane * 8), x); float s = 0.f;
#pragma unroll
                      for (int e = 0; e < 8; ++e) s += x[e] * x[e];
                      const float rs = rsqrtf(wave_sum(s) * (1.f / 512.f) + NORM_EPS);
#pragma unroll
                      for (int e = 0; e < 8; ++e) x[e] = x[e] * rs * P.qnorm[lane * 8 + e];
                      *(GAS v4u*)(P.QN + (size_t)m * 512 + lane * 8) = pack8f(x); }
                    { const v2u q = *(const GAS v2u*)(row + C_KVC + lane * 4);
                      float x[4] = {bflo(q.x), bfhi(q.x), bflo(q.y), bfhi(q.y)}; float s = 0.f;
#pragma unroll
                      for (int e = 0; e < 4; ++e) s += x[e] * x[e];
                      const float rs = rsqrtf(wave_sum(s) * (1.f / 256.f) + NORM_EPS);
#pragma unroll
                      for (int e = 0; e < 4; ++e) x[e] = x[e] * rs * P.kvnorm[lane * 4 + e];
                      v2u o; o.x = pk2(x[0], x[1]); o.y = pk2(x[2], x[3]);
                      *(GAS v2u*)(P.KVN + (size_t)m * 256 + lane * 4) = o; }
                    if (lane < 16) { const float x1 = bf1(row[C_KR + lane]), x2 = bf1(row[C_KR + 16 + lane]); const f32x2 cs = P.rope[(size_t)tp * 16 + lane];
                        const unsigned o = pk2(x1 * cs.x - x2 * cs.y, x1 * cs.y + x2 * cs.x);
#pragma unroll
                        for (int h2 = 0; h2 < NH; ++h2) *(GAS unsigned*)(P.K + ((size_t)(b * NH + h2) * TPB + tp) * QKD + 64 + 2 * lane) = o; } } }
            const int pc = 32 * w + 8 * q4;
            float prm[8], kmx[8], kx[8];
#pragma unroll
            for (int e = 0; e < 8; ++e) prm[e] = PRM[8 * 256 + pc + e];
            mix8r(rawk, prm, kmx);
            { float s = 0.f;
#pragma unroll
              for (int e = 0; e < 8; ++e) { kx[e] = kmx[e] * PRM[0 * 256 + pc + e]; s += kx[e] * kx[e]; }
              s += bpermf(lane ^ 16, s); s += bpermf(lane ^ 32, s);
              if (q4 == 0) SSQ[tk * 8 + w] = s; }
            __syncthreads();
            const float rsn = rsqrtf(SSQ[tk * 8 + w] + SSQ[tk * 8 + (w ^ 1)] + 1e-12f);
            f32x4 cw_[2][2], ca_[2][2], cg_[2][2];
#pragma unroll
            for (int d = 0; d < 2; ++d) {
                const bf16x8 bg = *(const LAS bf16x8*)(LA + tk * LAP + 256 + d * 32 + q4 * 8);
                bf16x8 bw[2], ba[2];
#pragma unroll
                for (int ks = 0; ks < 2; ++ks) { bw[ks] = *(const LAS bf16x8*)(LA + tk * LAP + d * 64 + ks * 32 + q4 * 8); ba[ks] = *(const LAS bf16x8*)(LA + tk * LAP + 128 + d * 64 + ks * 32 + q4 * 8); }
#pragma unroll
                for (int t = 0; t < 2; ++t) { f32x4 z = {0, 0, 0, 0};
                    cw_[d][t] = MFMA16(fw[d][t][1], bw[1], MFMA16(fw[d][t][0], bw[0], z));
                    ca_[d][t] = MFMA16(fa[d][t][1], ba[1], MFMA16(fa[d][t][0], ba[0], z));
                    cg_[d][t] = MFMA16(fg[d][t], bg, z); } }
            float r8[8], v8[8], kk8[8];
#pragma unroll
            for (int e = 0; e < 8; ++e) prm[e] = PRM[7 * 256 + pc + e];
            mix8r(rawr, prm, r8);
#pragma unroll
            for (int e = 0; e < 8; ++e) prm[e] = PRM[9 * 256 + pc + e];
            mix8r(rawv, prm, v8);
#pragma unroll
            for (int e = 0; e < 8; ++e) kk8[e] = kx[e] * rsn;
            bf16* rec = P.RI + ((size_t)(b * NH + hd) * TPB + tp) * RREC + (ch8 & 63);
            *(GAS v4u*)(rec) = pack8f(r8); *(GAS v4u*)(rec + 64) = pack8f(kk8); *(GAS v4u*)(rec + 128) = pack8f(v8);
#pragma unroll
            for (int d = 0; d < 2; ++d) {
                float ld[8], ke[8], bb[8], gg[8]; float bs = 0.f;
#pragma unroll
                for (int e = 0; e < 8; ++e) { const int t = e >> 2, r = e & 3;
                    ld[e] = -0.60653066f * sigmoidf_(PRM[(3 + d) * 256 + pc + e] + cw_[d][t][r]);
                    const float aa = sigmoidf_(PRM[(5 + d) * 256 + pc + e] + ca_[d][t][r]);
                    ke[e] = kmx[e] * (1.0f + (aa - 1.0f) * PRM[1 * 256 + pc + e]); bb[e] = kk8[e] * aa; gg[e] = cg_[d][t][r];
                    bs += r8[e] * ke[e] * PRM[2 * 256 + pc + e]; }
                *(GAS v4u*)(rec + (3 + 3 * d) * 64) = pack8f(ld); *(GAS v4u*)(rec + (4 + 3 * d) * 64) = pack8f(bb); *(GAS v4u*)(rec + (5 + 3 * d) * 64) = pack8f(ke);
                *(GAS v4u*)(P.GG + ((size_t)d * MALL + m) * RW + ch8) = pack8f(gg);
                bs += bpermf(lane ^ 16, bs); bs += bpermf(lane ^ 32, bs);
                if (q4 == 0) P.BON[((size_t)d * MALL + m) * 32 + 2 * hd + (w & 1)] = bs; }
        }
    }
}

constexpr int SCH = 32;
constexpr int SSTEP = 6 * 64;
__device__ __forceinline__ int scan_tp(int dir, int s) { return dir == 0 ? s : (s < CTXL ? (CTXL - 1 - s) : (TPB - 1 - (s - CTXL))); }
__device__ __forceinline__ void scan_load(v4u (&rg)[6], const bf16* RIh, int dir, int chunk, int htid) {
    const int tp = scan_tp(dir, chunk * SCH + (htid >> 3));
    const bf16* rec = RIh + (size_t)tp * RREC + (htid & 7) * 8;
#pragma unroll
    for (int i = 0; i < 3; ++i) rg[i] = *(const GAS v4u*)(rec + i * 64);
    rec += (3 + 3 * dir) * 64;
#pragma unroll
    for (int i = 0; i < 3; ++i) rg[3 + i] = *(const GAS v4u*)(rec + i * 64);
}
__device__ __forceinline__ void scan_store(const v4u (&rg)[6], LAS float* buf, int htid) {
    LAS float* d0 = buf + (htid >> 3) * SSTEP + (htid & 7) * 8;
#pragma unroll
    for (int i = 0; i < 6; ++i) { constexpr int SLOT[6] = {4, 0, 5, 2, 1, 3};
        const v4u wv = rg[i];
        f32x4 lo = {bflo(wv.x), bfhi(wv.x), bflo(wv.y), bfhi(wv.y)}, hi = {bflo(wv.z), bfhi(wv.z), bflo(wv.w), bfhi(wv.w)};
        if (i == 3) {
#pragma unroll
            for (int e = 0; e < 4; ++e) { lo[e] = __expf(lo[e]); hi[e] = __expf(hi[e]); } }
        LAS float* d = d0 + SLOT[i] * 64;
        *(LAS f32x4*)d = lo; *(LAS f32x4*)(d + 4) = hi; }
}
__device__ __forceinline__ void scan_phase(Frame& F, const bf16* RI, bf16* Y) {
    LAS float* bufs = (LAS float*)F.lds;
    constexpr int NCH = TPB / SCH;
    for (int uu = F.vcu; uu < NBATCH * NH * 2 * 4; uu += F.G) {
        const int rg = uu & 3, dir = (uu >> 2) & 1, hd = (uu >> 3) & 15, b = uu >> 7;
        const bf16* RIh = RI + (size_t)(b * NH + hd) * TPB * RREC;
        const int htid = F.tid - 256;
        v4u ra[6], rb[6];
        __syncthreads();
        if (F.wave >= 4) { scan_load(rb, RIh, dir, 0, htid); scan_load(ra, RIh, dir, 1, htid); scan_store(rb, bufs, htid); scan_load(rb, RIh, dir, 2, htid); }
        __syncthreads();
        const int j = F.lane & 15, rowl = F.lane >> 4, row = rg * 16 + (F.wave & 3) * 4 + rowl;
        f32x2 S01 = {0.f, 0.f}, S23 = {0.f, 0.f};
        bf16* yb = Y + ((size_t)dir * MALL + (size_t)b * TPB) * RW + hd * 64 + row;
        for (int c = 0; c < NCH; ++c) {
            LAS float* cur = bufs + (c & 1) * (SCH * SSTEP);
            if (F.wave >= 4) {
                if (c + 1 < NCH) {
                    if ((c & 1) == 0) { scan_store(ra, bufs + (SCH * SSTEP), htid); if (c + 3 < NCH) scan_load(ra, RIh, dir, c + 3, htid); }
                    else { scan_store(rb, bufs, htid); if (c + 3 < NCH) scan_load(rb, RIh, dir, c + 3, htid); } } }
            else {
#pragma unroll
                for (int h16 = 0; h16 < 2; ++h16) {
                    const LAS float* sp = cur + (h16 * 16) * SSTEP;
                    f32x4 kk = *(const LAS f32x4*)(sp + 4 * j), bb = *(const LAS f32x4*)(sp + 64 + 4 * j), ww = *(const LAS f32x4*)(sp + 128 + 4 * j),
                          ke = *(const LAS f32x4*)(sp + 192 + 4 * j), rr = *(const LAS f32x4*)(sp + 256 + 4 * j);
                    float vv = sp[320 + row], ykeep = 0.f, ypart = 0.f;
#pragma unroll
                    for (int st = 0; st < 16; ++st) {
                        f32x4 nkk = kk, nbb = bb, nww = ww, nke = ke, nrr = rr; float nvv = vv;
                        if (st + 1 < 16) { const LAS float* sn = sp + (st + 1) * SSTEP;
                            nkk = *(const LAS f32x4*)(sn + 4 * j); nbb = *(const LAS f32x4*)(sn + 64 + 4 * j); nww = *(const LAS f32x4*)(sn + 128 + 4 * j);
                            nke = *(const LAS f32x4*)(sn + 192 + 4 * j); nrr = *(const LAS f32x4*)(sn + 256 + 4 * j); nvv = sn[320 + row]; }
                        f32x2 t2 = S01 * kk.xy; t2 = S23 * kk.zw + t2;
                        const float p = t2.x + t2.y;
                        S01 = S01 * ww.xy + ke.xy * vv; S23 = S23 * ww.zw + ke.zw * vv;
                        const float sa = -red16(p);
                        S01 = bb.xy * sa + S01; S23 = bb.zw * sa + S23;
                        if (st > 0) { const float y = red16(ypart); ykeep = (j == st - 1) ? y : ykeep; }
                        f32x2 u2 = S01 * rr.xy; u2 = S23 * rr.zw + u2;
                        ypart = u2.x + u2.y;
                        kk = nkk; bb = nbb; ww = nww; ke = nke; rr = nrr; vv = nvv;
                        __builtin_amdgcn_sched_barrier(0);
                    }
                    { const float y = red16(ypart); ykeep = (j == 15) ? y : ykeep; }
                    const int tp = scan_tp(dir, c * SCH + h16 * 16 + j);
                    *(GAS bf16*)(yb + (size_t)tp * RW) = (bf16)f2bf(ykeep);
                }
            }
            __syncthreads();
        }
    }
}

constexpr int AKP = 208, AVP = 192;
constexpr int ATILE = 64 * AKP + 64 * AVP;
__device__ __forceinline__ bf16x8 pack8(const f32x16& x, int s) {
    v4u p; p.x = pk2(x[8 * s + 0], x[8 * s + 1]); p.y = pk2(x[8 * s + 2], x[8 * s + 3]); p.z = pk2(x[8 * s + 4], x[8 * s + 5]); p.w = pk2(x[8 * s + 6], x[8 * s + 7]);
    return __builtin_bit_cast(bf16x8, p);
}
__device__ __forceinline__ void attn_phase(Frame& F, const bf16* Q, const bf16* K, const bf16* V, bf16* YB, int with_ctx) {
    const int lane = F.lane, half = lane >> 5, l31 = lane & 31, l16 = lane & 15, g1 = (lane >> 4) & 1;
    const int nunits = NBATCH * NH * 32 + (with_ctx ? NBATCH * NH : 0);
    for (int uu = F.vcu; uu < nunits; uu += F.G) {
        int bh, q0, nkt;
        if (uu < NBATCH * NH * 32) { bh = uu >> 5; q0 = CTXL + (uu & 31) * 256; nkt = TPB / 64; } else { bh = uu - NBATCH * NH * 32; q0 = 0; nkt = CTXL / 64; }
        const bf16* Kh = K + (size_t)bh * TPB * QKD; const bf16* Vh = V + (size_t)bh * TPB * 64; const bf16* Qh = Q + (size_t)bh * TPB * QKD;
        const int tq = q0 + F.wave * 32 + l31;
        bf16x8 qf[6];
#pragma unroll
        for (int ks = 0; ks < 6; ++ks) qf[ks] = *(const GAS bf16x8*)(Qh + (size_t)tq * QKD + 16 * ks + 8 * half);
        f32x16 o0, o1;
#pragma unroll
        for (int i = 0; i < 16; ++i) { o0[i] = 0.f; o1[i] = 0.f; }
        float m_run = -1e30f, l_run = 0.f;
        const int kc1 = F.tid + 512; const bool k1ok = kc1 < 768;
        const unsigned kd0 = (unsigned)((F.tid / 12) * AKP + (F.tid % 12) * 16), kd1 = (unsigned)((kc1 / 12) * AKP + (kc1 % 12) * 16), vd = (unsigned)(64 * AKP + (F.tid >> 3) * AVP + (F.tid & 7) * 16);
        v4u kr0, kr1 = {0, 0, 0, 0}, vr;
        kr0 = *(const GAS v4u*)(Kh + (size_t)F.tid * 8); if (k1ok) kr1 = *(const GAS v4u*)(Kh + (size_t)kc1 * 8); vr = *(const GAS v4u*)(Vh + (size_t)F.tid * 8);
        __syncthreads();
        *(LAS v4u*)(F.lds + kd0) = kr0; if (k1ok) *(LAS v4u*)(F.lds + kd1) = kr1; *(LAS v4u*)(F.lds + vd) = vr;
        __syncthreads();
        for (int kt = 0; kt < nkt; ++kt) {
            const bool more = kt + 1 < nkt;
            if (more) { const bf16* kn = Kh + (size_t)(kt + 1) * 64 * QKD; const bf16* vn = Vh + (size_t)(kt + 1) * 64 * 64;
                kr0 = *(const GAS v4u*)(kn + (size_t)F.tid * 8); if (k1ok) kr1 = *(const GAS v4u*)(kn + (size_t)kc1 * 8); vr = *(const GAS v4u*)(vn + (size_t)F.tid * 8); }
            LAS unsigned char* Kb = F.lds + (kt & 1) * ATILE; LAS unsigned char* Vb = Kb + 64 * AKP;
            f32x16 s0, s1;
#pragma unroll
            for (int i = 0; i < 16; ++i) { s0[i] = 0.f; s1[i] = 0.f; }
            { bf16x8 ka[6], kb2[6];
#pragma unroll
              for (int ks = 0; ks < 6; ++ks) { ka[ks] = *(const LAS bf16x8*)(Kb + l31 * AKP + (16 * ks + 8 * half) * 2); kb2[ks] = *(const LAS bf16x8*)(Kb + (32 + l31) * AKP + (16 * ks + 8 * half) * 2); }
#pragma unroll
              for (int ks = 0; ks < 6; ++ks) { s0 = MFMA32(ka[ks], qf[ks], s0); s1 = MFMA32(kb2[ks], qf[ks], s1); }
              __builtin_amdgcn_sched_group_barrier(0x100, 12, 0); __builtin_amdgcn_sched_group_barrier(0x8, 12, 0); }
            bf16x8 va[2][2][2];
#pragma unroll
            for (int t = 0; t < 2; ++t)
#pragma unroll
                for (int s = 0; s < 2; ++s) { const int kb = 32 * t + 16 * s + 4 * half + (l16 >> 2);
#pragma unroll
                    for (int dvt = 0; dvt < 2; ++dvt) { const LAS unsigned char* vp = Vb + kb * AVP + (32 * dvt + 16 * g1 + 4 * (l16 & 3)) * 2;
                        const s16x4 lo = __builtin_amdgcn_ds_read_tr16_b64_v4i16((LAS s16x4*)vp), hi = __builtin_amdgcn_ds_read_tr16_b64_v4i16((LAS s16x4*)(vp + 8 * AVP));
                        va[t][s][dvt] = __builtin_shufflevector(lo, hi, 0, 1, 2, 3, 4, 5, 6, 7); } }
            __builtin_amdgcn_sched_group_barrier(0x100, 16, 0);
            float mx = s0[0];
#pragma unroll
            for (int i = 1; i < 16; ++i) mx = fmaxf(mx, s0[i]);
#pragma unroll
            for (int i = 0; i < 16; ++i) mx = fmaxf(mx, s1[i]);
            mx = fmaxf(mx, bpermf(lane ^ 32, mx));
            if (__any(mx > m_run + 8.0f)) {
                const float m_new = fmaxf(m_run, mx), alpha = __builtin_amdgcn_exp2f(m_run - m_new); m_run = m_new;
                l_run *= alpha;
#pragma unroll
                for (int i = 0; i < 16; ++i) { o0[i] *= alpha; o1[i] *= alpha; }
            }
            float ps = 0.f;
#pragma unroll
            for (int i = 0; i < 16; ++i) { s0[i] = __builtin_amdgcn_exp2f(s0[i] - m_run); s1[i] = __builtin_amdgcn_exp2f(s1[i] - m_run); ps += s0[i] + s1[i]; }
            l_run += ps;
            { bf16x8 pf[2][2];
#pragma unroll
              for (int t = 0; t < 2; ++t)
#pragma unroll
                  for (int s = 0; s < 2; ++s) pf[t][s] = pack8(t == 0 ? s0 : s1, s);
#pragma unroll
              for (int t = 0; t < 2; ++t)
#pragma unroll
                  for (int s = 0; s < 2; ++s) { o0 = MFMA32(va[t][s][0], pf[t][s], o0); o1 = MFMA32(va[t][s][1], pf[t][s], o1); } }
            if (more) { LAS unsigned char* nb = F.lds + ((kt + 1) & 1) * ATILE;
                *(LAS v4u*)(nb + kd0) = kr0; if (k1ok) *(LAS v4u*)(nb + kd1) = kr1; *(LAS v4u*)(nb + vd) = vr; }
            __syncthreads();
        }
        const float linv = (DBG_SKIP & 4) ? 0.f : 1.0f / (l_run + bpermf(lane ^ 32, l_run));
        const int b = bh >> 4, hd = bh & 15;
        bf16* op = YB + ((size_t)b * TPB + tq) * RW + hd * 64 + 4 * half;
#pragma unroll
        for (int g = 0; g < 4; ++g) {
            v2u w; w.x = pk2(o0[4 * g] * linv, o0[4 * g + 1] * linv); w.y = pk2(o0[4 * g + 2] * linv, o0[4 * g + 3] * linv); *(GAS v2u*)(op + 8 * g) = w;
            w.x = pk2(o1[4 * g] * linv, o1[4 * g + 1] * linv); w.y = pk2(o1[4 * g + 2] * linv, o1[4 * g + 3] * linv); *(GAS v2u*)(op + 32 + 8 * g) = w; }
    }
}

__device__ __forceinline__ void readout_phase(Frame& F, const bf16* Y, const bf16* GG, const float* BON, const bf16* RI, const float* ln_w, const float* ln_b, bf16* YA) {
    const int gw = F.vcu * NWAVES + F.wave, NGW = F.G * NWAVES, lane = F.lane, hd = lane >> 2, ch0 = hd * 64 + (lane & 3) * 16;
    for (int m = gw; m < MALL; m += NGW) {
        const int b = m / TPB, tp = m - b * TPB;
        const bf16* rec = RI + ((size_t)(b * NH + hd) * TPB + tp) * RREC + 128 + (lane & 3) * 16;
        float vv[16], out[16];
        { const v4u a = *(const GAS v4u*)rec, c = *(const GAS v4u*)(rec + 8);
          vv[0] = bflo(a.x); vv[1] = bfhi(a.x); vv[2] = bflo(a.y); vv[3] = bfhi(a.y); vv[4] = bflo(a.z); vv[5] = bfhi(a.z); vv[6] = bflo(a.w); vv[7] = bfhi(a.w);
          vv[8] = bflo(c.x); vv[9] = bfhi(c.x); vv[10] = bflo(c.y); vv[11] = bfhi(c.y); vv[12] = bflo(c.z); vv[13] = bfhi(c.z); vv[14] = bflo(c.w); vv[15] = bfhi(c.w); }
#pragma unroll
        for (int e = 0; e < 16; ++e) out[e] = 0.f;
#pragma unroll
        for (int d = 0; d < 2; ++d) {
            const bf16* yp = Y + ((size_t)d * MALL + m) * RW + ch0; const bf16* gp = GG + ((size_t)d * MALL + m) * RW + ch0;
            float y[16], g[16];
            { const v4u a = *(const GAS v4u*)yp, c = *(const GAS v4u*)(yp + 8);
              y[0] = bflo(a.x); y[1] = bfhi(a.x); y[2] = bflo(a.y); y[3] = bfhi(a.y); y[4] = bflo(a.z); y[5] = bfhi(a.z); y[6] = bflo(a.w); y[7] = bfhi(a.w);
              y[8] = bflo(c.x); y[9] = bfhi(c.x); y[10] = bflo(c.y); y[11] = bfhi(c.y); y[12] = bflo(c.z); y[13] = bfhi(c.z); y[14] = bflo(c.w); y[15] = bfhi(c.w); }
            { const v4u a = *(const GAS v4u*)gp, c = *(const GAS v4u*)(gp + 8);
              g[0] = bflo(a.x); g[1] = bfhi(a.x); g[2] = bflo(a.y); g[3] = bfhi(a.y); g[4] = bflo(a.z); g[5] = bfhi(a.z); g[6] = bflo(a.w); g[7] = bfhi(a.w);
              g[8] = bflo(c.x); g[9] = bfhi(c.x); g[10] = bflo(c.y); g[11] = bfhi(c.y); g[12] = bflo(c.z); g[13] = bfhi(c.z); g[14] = bflo(c.w); g[15] = bfhi(c.w); }
            float s = 0.f;
#pragma unroll
            for (int e = 0; e < 16; ++e) s += y[e];
            s = dpp_add<0xB1>(s); s = dpp_add<0x4E>(s);
            const float mean = s * (1.f / 64.f); float q = 0.f;
#pragma unroll
            for (int e = 0; e < 16; ++e) { y[e] -= mean; q += y[e] * y[e]; }
            q = dpp_add<0xB1>(q); q = dpp_add<0x4E>(q);
            const float rstd = rsqrtf(q * (1.f / 64.f) + 64e-5f), bon = BON[((size_t)d * MALL + m) * 32 + 2 * hd] + BON[((size_t)d * MALL + m) * 32 + 2 * hd + 1];
#pragma unroll
            for (int e = 0; e < 16; ++e) out[e] += (y[e] * rstd * ln_w[ch0 + e] + ln_b[ch0 + e] + bon * vv[e]) * g[e];
        }
        if (DBG_SKIP & 2) {
#pragma unroll
            for (int e = 0; e < 16; ++e) out[e] = 0.f; }
        v4u o0, o1;
        o0.x = pk2(out[0], out[1]); o0.y = pk2(out[2], out[3]); o0.z = pk2(out[4], out[5]); o0.w = pk2(out[6], out[7]);
        o1.x = pk2(out[8], out[9]); o1.y = pk2(out[10], out[11]); o1.z = pk2(out[12], out[13]); o1.w = pk2(out[14], out[15]);
        *(GAS v4u*)(YA + (size_t)m * RW + ch0) = o0; *(GAS v4u*)(YA + (size_t)m * RW + ch0 + 8) = o1;
    }
}


__device__ __forceinline__ unsigned f2key(float f) { const unsigned u = __builtin_bit_cast(unsigned, f); return (u & 0x80000000u) ? ~u : (u | 0x80000000u); }
__device__ __forceinline__ float key2f(unsigned k) { const unsigned u = (k & 0x80000000u) ? (k & 0x7fffffffu) : ~k; return __builtin_bit_cast(float, u); }
template <int CTRL, int RM> __device__ __forceinline__ unsigned dpp_umax(unsigned x) {
    const unsigned y = (unsigned)__builtin_amdgcn_update_dpp(0, (int)x, CTRL, RM, 0xf, false); return x > y ? x : y; }
__device__ __forceinline__ unsigned row_umax(unsigned x) { x = dpp_umax<0xB1, 0xf>(x); x = dpp_umax<0x4E, 0xf>(x); x = dpp_umax<0x141, 0xf>(x); x = dpp_umax<0x140, 0xf>(x); return x; }
#define SEL_CE(a_, b_) do { const unsigned hi_ = (a_) > (b_) ? (a_) : (b_), lo_ = (a_) > (b_) ? (b_) : (a_); (a_) = hi_; (b_) = lo_; } while (0)
__device__ __forceinline__ void sel_keys8(unsigned (&k)[8], const float* p, int id0) {
    const f32x4 v0 = *(const GAS f32x4*)p, v1 = *(const GAS f32x4*)(p + 4);
    k[0] = (f2key(v0.x) & ~127u) | (unsigned)(id0 + 0); k[1] = (f2key(v0.y) & ~127u) | (unsigned)(id0 + 1); k[2] = (f2key(v0.z) & ~127u) | (unsigned)(id0 + 2); k[3] = (f2key(v0.w) & ~127u) | (unsigned)(id0 + 3);
    k[4] = (f2key(v1.x) & ~127u) | (unsigned)(id0 + 4); k[5] = (f2key(v1.y) & ~127u) | (unsigned)(id0 + 5); k[6] = (f2key(v1.z) & ~127u) | (unsigned)(id0 + 6); k[7] = (f2key(v1.w) & ~127u) | (unsigned)(id0 + 7);
    SEL_CE(k[0], k[1]); SEL_CE(k[2], k[3]); SEL_CE(k[4], k[5]); SEL_CE(k[6], k[7]); SEL_CE(k[0], k[2]); SEL_CE(k[1], k[3]); SEL_CE(k[4], k[6]); SEL_CE(k[5], k[7]); SEL_CE(k[1], k[2]); SEL_CE(k[5], k[6]);
    SEL_CE(k[0], k[4]); SEL_CE(k[1], k[5]); SEL_CE(k[2], k[6]); SEL_CE(k[3], k[7]); SEL_CE(k[2], k[4]); SEL_CE(k[3], k[5]); SEL_CE(k[1], k[2]); SEL_CE(k[3], k[4]); SEL_CE(k[5], k[6]);
}
__device__ __forceinline__ void top16_rows2(const float* pa, const float* pb, int l16, unsigned& ra, unsigned& rb) {
    unsigned ka[8], kb[8]; sel_keys8(ka, pa + 8 * l16, 8 * l16); sel_keys8(kb, pb + 8 * l16, 8 * l16);
    ra = 0u; rb = 0u;
#pragma unroll
    for (int it = 0; it < 16; ++it) {
        const unsigned ma = row_umax(ka[0]), mb = row_umax(kb[0]); const bool oa = ka[0] == ma, ob = kb[0] == mb;
#pragma unroll
        for (int e = 0; e < 7; ++e) { ka[e] = oa ? ka[e + 1] : ka[e]; kb[e] = ob ? kb[e + 1] : kb[e]; }
        ka[7] = oa ? 0u : ka[7]; kb[7] = ob ? 0u : kb[7];
        ra = (l16 == it) ? ma : ra; rb = (l16 == it) ? mb : rb;
    }
}
struct SelP { const float* SC; int* ESEL; float* EGATE; const float* pu; const float* pv; unsigned char* PU8; unsigned char* PV8; float* SU; float* SV; int last; int dry; };
__device__ __forceinline__ void cvt_row_load(f32x4 (&x)[8], const float* src) {
#pragma unroll
    for (int q = 0; q < 8; ++q) x[q] = *(const GAS f32x4*)(src + q * 4);
}
__device__ __forceinline__ void cvt_row_store(const f32x4 (&x)[8], unsigned char* dst, float* scale_slot, int lane) {
    float am = 0.f;
#pragma unroll
    for (int q = 0; q < 8; ++q) am = fmaxf(am, fmaxf(fmaxf(fabsf(x[q].x), fabsf(x[q].y)), fmaxf(fabsf(x[q].z), fabsf(x[q].w))));
    am = fmaxf(wave_max_u(am), 1e-30f);
    const float g = 6.0f / am, inv = am * (1.0f / 6.0f);
    v4u o;
#pragma unroll
    for (int q = 0; q < 4; ++q) { unsigned w = 0u;
        w = __builtin_amdgcn_cvt_scalef32_pk_fp4_f32(w, x[2 * q].x * g, x[2 * q].y * g, 1.0f, 0);
        w = __builtin_amdgcn_cvt_scalef32_pk_fp4_f32(w, x[2 * q].z * g, x[2 * q].w * g, 1.0f, 1);
        w = __builtin_amdgcn_cvt_scalef32_pk_fp4_f32(w, x[2 * q + 1].x * g, x[2 * q + 1].y * g, 1.0f, 2);
        w = __builtin_amdgcn_cvt_scalef32_pk_fp4_f32(w, x[2 * q + 1].z * g, x[2 * q + 1].w * g, 1.0f, 3);
        o[q] = w; }
    *(GAS v4u*)dst = o;
    if (lane == 0) *scale_slot = inv;
}
__device__ __forceinline__ void select_phase(Frame& F, const SelP& P) {
    const int gw = F.vcu * NWAVES + F.wave, NGW = F.G * NWAVES, lane = F.lane, row = lane >> 4, l16 = lane & 15, rbase = lane & 48;
    const int i1 = (int)((0x3332222211111111ull >> (4 * l16)) & 15ull), j1 = (int)((0x2104321076543210ull >> (4 * l16)) & 15ull), i2 = (int)((0xdcba987766554443ull >> (4 * l16)) & 15ull), j2 = (int)((0x0000001010102103ull >> (4 * l16)) & 15ull);
    int crow = gw;
    for (int m = gw; m < MALL || crow < 2 * NEXP; m += NGW) {
        f32x4 xa[8], xb[8];
        const int r0 = crow, r1 = crow + NGW; const bool c0 = r0 < 2 * NEXP && !(P.dry & 2), c1 = r1 < 2 * NEXP && !(P.dry & 2); crow += 2 * NGW;
        if (c0) cvt_row_load(xa, ((r0 >= NEXP) ? P.pv + (size_t)(r0 - NEXP) * DM : P.pu + (size_t)r0 * DM) + lane * 32);
        if (c1) cvt_row_load(xb, ((r1 >= NEXP) ? P.pv + (size_t)(r1 - NEXP) * DM : P.pu + (size_t)r1 * DM) + lane * 32);
        bool tok = m < MALL && !(P.dry & 4); int tp = 0; if (tok) { tp = m % TPB; if (P.last && tp < CTXL) tok = false; }
        if (tok) {
            const float* srow = P.SC + (size_t)m * DM;
#pragma unroll 1
            for (int G = 0; G < 2; ++G) {
                const float* hrow = srow + (4 * G + row) * 256;
                unsigned recA, recB; top16_rows2(hrow, hrow + 128, l16, recA, recB);
                const float va = key2f(recA & ~127u), vb = key2f(recB & ~127u);
                const float a0 = bpermf(rbase, va), a1 = bpermf(rbase + i1, va), b1 = bpermf(rbase + j1, vb), a2 = bpermf(rbase + i2, va), b2 = bpermf(rbase + j2, vb), a3 = bpermf(rbase + 14 + (l16 & 1), va), b0 = bpermf(rbase, vb);
                unsigned ck[4];
                ck[0] = (f2key(a0 + vb) & ~255u) | (unsigned)l16; ck[1] = (f2key(a1 + b1) & ~255u) | (unsigned)(16 * i1 + j1); ck[2] = (f2key(a2 + b2) & ~255u) | (unsigned)(16 * i2 + j2);
                ck[3] = (l16 < 2) ? ((f2key(a3 + b0) & ~255u) | (unsigned)(16 * (14 + l16))) : 0u;
                SEL_CE(ck[0], ck[1]); SEL_CE(ck[2], ck[3]); SEL_CE(ck[0], ck[2]); SEL_CE(ck[1], ck[3]); SEL_CE(ck[1], ck[2]);
                unsigned rec = 0u;
#pragma unroll
                for (int it = 0; it < 16; ++it) {
                    const unsigned mh = row_umax(ck[0]); const bool own = ck[0] == mh;
                    ck[0] = own ? ck[1] : ck[0]; ck[1] = own ? ck[2] : ck[1]; ck[2] = own ? ck[3] : ck[2]; ck[3] = own ? 0u : ck[3];
                    rec = (l16 == it) ? mh : rec;
                }
                const float ts = key2f(rec & ~255u), tmax = bpermf(rbase, ts);
                const float ev = __expf(ts - tmax), esum = red16(ev);
                const int ci = (int)((rec >> 4) & 15u), cj = (int)(rec & 15u);
                const int expert = bpermi(rbase + ci, (int)(recA & 127u)) * 128 + bpermi(rbase + cj, (int)(recB & 127u));
                const int slot = (4 * G + row) * 16 + l16; P.ESEL[(size_t)m * 128 + slot] = expert; P.EGATE[(size_t)m * 128 + slot] = ev / esum;
            }
        }
        if (c0) cvt_row_store(xa, ((r0 >= NEXP) ? P.PV8 + (size_t)(r0 - NEXP) * (DM / 2) : P.PU8 + (size_t)r0 * (DM / 2)) + lane * 16, (r0 >= NEXP) ? P.SV + (r0 - NEXP) : P.SU + r0, lane);
        if (c1) cvt_row_store(xb, ((r1 >= NEXP) ? P.PV8 + (size_t)(r1 - NEXP) * (DM / 2) : P.PU8 + (size_t)r1 * (DM / 2)) + lane * 16, (r1 >= NEXP) ? P.SV + (r1 - NEXP) : P.SU + r1, lane);
    }
}
struct PeerP { const float* nmod; const float* ng; bf16* Hout;   const int* ESEL; const float* EGATE; const bf16* H; const unsigned char* PU; const unsigned char* PV; const float* SU; const float* SV; float* X; const float* mod;   const float* fin_g; float* out; int last; int dry; };
__device__ __forceinline__ void peer_phase(Frame& F, const PeerP& P) {
    const int gw = F.vcu * NWAVES + F.wave, NGW = F.G * NWAVES, lane = F.lane;
    float pr_s2 = 0.f, pr_d2 = 0.f, pr_tg = 0.f, pr_n = 0.f;
    for (int m = gw; m < MALL; m += NGW) {
        const int b = m / TPB, tp = m - b * TPB; if (P.last && tp < CTXL) continue;
        const int mr = tp < CTXL ? 2 : b;
        const int emask_ = (P.dry & 2) ? 1023 : 0x7fffffff;
        const int eidx[2] = {P.ESEL[(size_t)m * 128 + lane] & emask_, P.ESEL[(size_t)m * 128 + 64 + lane] & emask_}; const float egate[2] = {P.EGATE[(size_t)m * 128 + lane], P.EGATE[(size_t)m * 128 + 64 + lane]};
        typedef int v8i __attribute__((ext_vector_type(8)));
        LAS unsigned char* hq = F.lds + F.wave * 4096;
        { const v4u a0 = *(const GAS v4u*)(P.H + (size_t)m * DM + lane * 32), a1 = *(const GAS v4u*)(P.H + (size_t)m * DM + lane * 32 + 8), a2 = *(const GAS v4u*)(P.H + (size_t)m * DM + lane * 32 + 16), a3 = *(const GAS v4u*)(P.H + (size_t)m * DM + lane * 32 + 24);
          const v4u hv[4] = {a0, a1, a2, a3}; v4u o[2];
#pragma unroll
          for (int j = 0; j < 4; ++j) { int w0 = 0, w1 = 0;
              w0 = __builtin_amdgcn_cvt_pk_fp8_f32(bflo(hv[j].x), bfhi(hv[j].x), w0, false); w0 = __builtin_amdgcn_cvt_pk_fp8_f32(bflo(hv[j].y), bfhi(hv[j].y), w0, true);
              w1 = __builtin_amdgcn_cvt_pk_fp8_f32(bflo(hv[j].z), bfhi(hv[j].z), w1, false); w1 = __builtin_amdgcn_cvt_pk_fp8_f32(bflo(hv[j].w), bfhi(hv[j].w), w1, true);
              o[j >> 1][2 * (j & 1)] = (unsigned)w0; o[j >> 1][2 * (j & 1) + 1] = (unsigned)w1; }
          *(LAS v4u*)(hq + lane * 32) = o[0]; *(LAS v4u*)(hq + lane * 32 + 16) = o[1];
          unsigned z_ = 0u; asm volatile("" : "+v"(z_));
          if (lane < 2) *(LAS v4u*)(hq + 2048 + lane * 16) = (v4u){z_, z_, z_, z_}; }
        const int li = lane & 15, kb = lane >> 4;
        int rowoff[8];
#pragma unroll
        for (int g = 0; g < 8; ++g) rowoff[g] = bpermi(16 * (g & 3) + li, eidx[g >> 2]) * (DM / 2) + 16 * kb;
        f32x4 dacc[8];
#pragma unroll
        for (int g = 0; g < 8; ++g) dacc[g] = (f32x4){0.f, 0.f, 0.f, 0.f};
        const unsigned hb = (li == 0) ? (unsigned)(16 * kb) : 2048u;
        const unsigned hb2 = (li == 0) ? 64u : 16u;
        const unsigned hstep = (li == 0) ? 128u : 0u;
        v4u ua[8], ub[8];
#pragma unroll
        for (int g = 0; g < 8; ++g) ua[g] = *(const GAS v4u*)(P.PU + (unsigned)rowoff[g]);
#pragma unroll 1
        for (int s = 0; s < ((P.dry & 4) ? 2 : 16); s += 2) {
#pragma unroll
            for (int g = 0; g < 8; ++g) ub[g] = *(const GAS v4u*)(P.PU + (unsigned)(rowoff[g] + 64 * (s + 1)));
            { const v4u b0 = *(const LAS v4u*)(hq + hb + hstep * s), b1 = *(const LAS v4u*)(hq + hb + hstep * s + hb2);
              const v8i bf = {(int)b0.x, (int)b0.y, (int)b0.z, (int)b0.w, (int)b1.x, (int)b1.y, (int)b1.z, (int)b1.w};
#pragma unroll
              for (int g = 0; g < 8; ++g) { const v8i af = {(int)ua[g].x, (int)ua[g].y, (int)ua[g].z, (int)ua[g].w, 0, 0, 0, 0};
                  dacc[g] = __builtin_amdgcn_mfma_scale_f32_16x16x128_f8f6f4(af, bf, dacc[g], 4, 0, 0, 0x7f7f7f7f, 0, 0x7f7f7f7f); } }
            if (s + 2 < 16) {
#pragma unroll
                for (int g = 0; g < 8; ++g) ua[g] = *(const GAS v4u*)(P.PU + (unsigned)(rowoff[g] + 64 * (s + 2))); }
            { const v4u b0 = *(const LAS v4u*)(hq + hb + hstep * (s + 1)), b1 = *(const LAS v4u*)(hq + hb + hstep * (s + 1) + hb2);
              const v8i bf = {(int)b0.x, (int)b0.y, (int)b0.z, (int)b0.w, (int)b1.x, (int)b1.y, (int)b1.z, (int)b1.w};
#pragma unroll
              for (int g = 0; g < 8; ++g) { const v8i af = {(int)ub[g].x, (int)ub[g].y, (int)ub[g].z, (int)ub[g].w, 0, 0, 0, 0};
                  dacc[g] = __builtin_amdgcn_mfma_scale_f32_16x16x128_f8f6f4(af, bf, dacc[g], 4, 0, 0, 0x7f7f7f7f, 0, 0x7f7f7f7f); } }
        }
        float coef[2];
#pragma unroll
        for (int sl = 0; sl < 2; ++sl) { float mydot = 0.f;
#pragma unroll
            for (int g4 = 0; g4 < 4; ++g4)
#pragma unroll
                for (int r = 0; r < 4; ++r) { const float t = bpermf(16 * ((lane >> 2) & 3), dacc[4 * sl + g4][r]); if ((lane >> 4) == g4 && (lane & 3) == r) mydot = t; }
            mydot *= P.SU[eidx[sl]];
            if (DBG_PROBE == 4) {
                float ref = 0.f;
                for (int e = 0; e < 64; ++e) { const int ex = __builtin_amdgcn_readlane(eidx[sl], e); const v4u uu = *(const GAS v4u*)(P.PU + (size_t)ex * (DM / 2) + lane * 16); float s1 = 0.f;
                    const v4u hv2[4] = {*(const GAS v4u*)(P.H + (size_t)m * DM + lane * 32), *(const GAS v4u*)(P.H + (size_t)m * DM + lane * 32 + 8), *(const GAS v4u*)(P.H + (size_t)m * DM + lane * 32 + 16), *(const GAS v4u*)(P.H + (size_t)m * DM + lane * 32 + 24)};
#pragma unroll
                    for (int d = 0; d < 4; ++d) { const unsigned w = uu[d]; const unsigned hw[4] = {hv2[d].x, hv2[d].y, hv2[d].z, hv2[d].w};
                        f32x2 x = __builtin_amdgcn_cvt_scalef32_pk_f32_fp4(w, 1.0f, 0); s1 += x.x * bflo(hw[0]) + x.y * bfhi(hw[0]); x = __builtin_amdgcn_cvt_scalef32_pk_f32_fp4(w, 1.0f, 1); s1 += x.x * bflo(hw[1]) + x.y * bfhi(hw[1]);
                        x = __builtin_amdgcn_cvt_scalef32_pk_f32_fp4(w, 1.0f, 2); s1 += x.x * bflo(hw[2]) + x.y * bfhi(hw[2]); x = __builtin_amdgcn_cvt_scalef32_pk_f32_fp4(w, 1.0f, 3); s1 += x.x * bflo(hw[3]) + x.y * bfhi(hw[3]); }
                    const float tot = wave_sum_u(s1) * P.SU[ex]; if (lane == e) ref = tot; }
                pr_s2 = fmaxf(pr_s2, wave_max_u(fabsf(mydot - ref) / (fabsf(ref) + 0.25f))); pr_n = 1.f; }
            coef[sl] = egate[sl] * 0.5f * mydot * (1.0f + erff(mydot * 0.70710678f));
            if ((DBG_SKIP & 16) && sl == 0) coef[sl] = 0.f;
            if ((DBG_SKIP & 32) && sl == 1) coef[sl] = 0.f;
        }
        const float coefs[2] = {coef[0] * P.SV[eidx[0]], coef[1] * P.SV[eidx[1]]};
        f32x2 acc2[16];
#pragma unroll
        for (int i = 0; i < 16; ++i) acc2[i] = (f32x2){0.f, 0.f};
#define PEER_LOADV(U, C, e0_) do { const int e1_ = (e0_); const int ev_ = (e1_ & 64) ? eidx[1] : eidx[0]; const int cv_ = __builtin_bit_cast(int, (e1_ & 64) ? coefs[1] : coefs[0]); \
            _Pragma("unroll") for (int q = 0; q < 8; ++q) { const int ex = __builtin_amdgcn_readlane(ev_, (e1_ & 63) + q); U[q] = *(const GAS v4u*)(P.PV + (size_t)ex * (DM / 2) + lane * 16); \
            C[q] = __builtin_bit_cast(float, __builtin_amdgcn_readlane(cv_, (e1_ & 63) + q)); } } while (0)
#define PEER_AXPY(U, C) do { _Pragma("unroll") for (int q = 0; q < 8; ++q) _Pragma("unroll") for (int d = 0; d < 4; ++d) { const unsigned w = U[q][d]; \
            acc2[4 * d + 0] = __builtin_amdgcn_cvt_scalef32_pk_f32_fp4(w, 1.0f, 0) * C[q] + acc2[4 * d + 0]; acc2[4 * d + 1] = __builtin_amdgcn_cvt_scalef32_pk_f32_fp4(w, 1.0f, 1) * C[q] + acc2[4 * d + 1]; \
            acc2[4 * d + 2] = __builtin_amdgcn_cvt_scalef32_pk_f32_fp4(w, 1.0f, 2) * C[q] + acc2[4 * d + 2]; acc2[4 * d + 3] = __builtin_amdgcn_cvt_scalef32_pk_f32_fp4(w, 1.0f, 3) * C[q] + acc2[4 * d + 3]; } } while (0)
        f32x4 xpre[8];
        { const float* xr0 = P.X + (size_t)m * DM + lane * 32;
#pragma unroll
          for (int hq = 0; hq < 8; ++hq) xpre[hq] = *(const GAS f32x4*)(xr0 + hq * 4); }
        {
            v4u ua[8], ub[8]; float ca[8], cb[8];
            PEER_LOADV(ua, ca, 0);
#pragma unroll 1
            for (int it = 0; it < ((P.dry & 8) ? 2 : 8); ++it) {
                PEER_LOADV(ub, cb, 16 * it + 8); PEER_AXPY(ua, ca);
                if (it < 7) PEER_LOADV(ua, ca, 16 * it + 16);
                PEER_AXPY(ub, cb);
            }
        }
#undef PEER_LOADV
#undef PEER_AXPY
        float acc[32];
#pragma unroll
        for (int i = 0; i < 16; ++i) { acc[2 * i] = acc2[i].x; acc[2 * i + 1] = acc2[i].y; }
        if (P.dry) { float sm_ = 0.f;
#pragma unroll
            for (int i = 0; i < 32; ++i) sm_ += acc[i];
            if (sm_ == 1.2345e-30f) P.X[lane] = sm_;
            if (!(P.dry & 16)) continue; }
        if (DBG_SKIP & 1) {
#pragma unroll
            for (int i = 0; i < 32; ++i) acc[i] = 0.f; }
        if (((DBG_SKIP & 64) && !P.last) || ((DBG_SKIP & 128) && P.last)) {
#pragma unroll
            for (int i = 0; i < 32; ++i) acc[i] = 0.f; }
        if (DBG_SKIP & 8) {
#pragma unroll
            for (int i = 0; i < 32; ++i) acc[i] = -acc[i]; }
        int m_l = m, lane_l = lane; asm volatile("" : "+v"(m_l), "+v"(lane_l));
        const int b_l = m_l / TPB, tp_l = m_l - b_l * TPB, mr_l = tp_l < CTXL ? 2 : b_l;
        float* xr = P.X + (size_t)m_l * DM + lane_l * 32; const float* g2 = P.mod + (size_t)mr_l * 12288 + 5 * DM + lane_l * 32;
        float ss = 0.f;
#pragma unroll
        for (int hq = 0; hq < 8; ++hq) { const int c = hq * 4;
            f32x4 xv = xpre[hq]; const f32x4 gv = *(const GAS f32x4*)(g2 + c);
#pragma unroll
            for (int e = 0; e < 4; ++e) { xv[e] += gv[e] * acc[4 * hq + e]; ss += xv[e] * xv[e]; acc[4 * hq + e] = xv[e]; }
            if (!P.last) *(GAS f32x4*)((P.dry ? (float*)(F.ws + 760 * MiB) + (size_t)m_l * DM + lane_l * 32 : xr) + c) = xv; }
        if (!P.last) {
            const float rs = rsqrtf(wave_sum(ss) * (1.f / DM) + NORM_EPS); const float* sh = P.nmod + (size_t)mr_l * 12288 + lane_l * 32; const float* sc = sh + DM; const float* ngp = P.ng + lane_l * 32;
            bf16* ho = (P.dry ? (bf16*)(F.ws + 892 * MiB) : P.Hout) + (size_t)m_l * DM + lane_l * 32;
#pragma unroll
            for (int hq = 0; hq < 4; ++hq) { const int c = hq * 8; float y[8];
                const f32x4 n0 = *(const GAS f32x4*)(ngp + c), n1 = *(const GAS f32x4*)(ngp + c + 4), s0 = *(const GAS f32x4*)(sc + c), s1 = *(const GAS f32x4*)(sc + c + 4), h0 = *(const GAS f32x4*)(sh + c), h1 = *(const GAS f32x4*)(sh + c + 4);
#pragma unroll
                for (int e = 0; e < 4; ++e) { y[e] = acc[8 * hq + e] * rs * n0[e] * (1.0f + s0[e]) + h0[e]; y[4 + e] = acc[8 * hq + 4 + e] * rs * n1[e] * (1.0f + s1[e]) + h1[e]; }
                *(GAS v4u*)(ho + c) = pack8f(y); } }
        if (P.last) { const float rs = rsqrtf(wave_sum(ss) * (1.f / DM) + NORM_EPS); float* orow = P.out + ((size_t)b_l * SEQ + (tp_l - CTXL)) * DM + lane_l * 32; const float* fgp = P.fin_g + lane_l * 32;
#pragma unroll
            for (int hq = 0; hq < 8; ++hq) { const int c = hq * 4; const f32x4 fg = *(const GAS f32x4*)(fgp + c);
                f32x4 o;
#pragma unroll
                for (int e = 0; e < 4; ++e) o[e] = acc[4 * hq + e] * rs * fg[e];
                *(GAS f32x4*)(orow + c) = o; } }
    }
    if (DBG_PROBE && DBG_PROBE != 5 && !P.last && lane == 0) { float* pp = (float*)(F.ws + WS_CTL + CTL_PROBE_OFF) + gw * 4; pp[0] = pr_s2; pp[1] = pr_d2; pp[2] = pr_tg; pp[3] = pr_n; }
}


constexpr int PH_PER_LAYER = 12, NPHASE = 1 + NLAYER * PH_PER_LAYER;
#ifndef ONLY_PHASE
#define ONLY_PHASE -1
#endif
#define T0() (wave_s == 0 && pg8::opaque_lane() == 0)
#define PH_ON(k) (ONLY_PHASE < 0 || ONLY_PHASE == (k))
#define GEMM_CALL(EPI, SCHED, g, S, E) pg8::gemm_phase<EPI, SCHED, true, true>(F.lds, g, S, E, wave_s)
#define GEMM_CALL_NA(EPI, SCHED, g, S, E) pg8::gemm_phase<EPI, SCHED, false, true>(F.lds, g, S, E, wave_s)

__device__ __forceinline__ const float* karg(int i) {
    asm volatile("" : "+s"(i));
    const __attribute__((address_space(4))) unsigned long long* ka = (const __attribute__((address_space(4))) unsigned long long*)__builtin_amdgcn_kernarg_segment_ptr();
    return (const float*)ka[i];
}
__global__ void __launch_bounds__(NWAVES * 64, 2) mk_fwd(Args args) {
    extern __shared__ __attribute__((aligned(16))) unsigned char lds[];
    Frame F;
    F.lds = (LAS unsigned char*)lds; F.ws = args.ws;
    const int wave_s = __builtin_amdgcn_readfirstlane((int)threadIdx.x >> 6);
    F.tid = threadIdx.x; F.lane = F.tid & 63; F.wave = wave_s;
    F.G = gridDim.x; { const int bx = blockIdx.x; F.vcu = (F.G % 8 == 0) ? (bx % 8) * (F.G / 8) + bx / 8 : bx; }
    unsigned char* ws = args.ws;
    volatile LAS unsigned* MISC = (volatile LAS unsigned*)(F.lds + MISC_OFF);
    for (int u = F.tid; u < (LDS_BYTES - LDSCTL_OFF) / 4; u += NWAVES * 64) ((LAS unsigned*)(F.lds + LDSCTL_OFF))[u] = 0u;
    __syncthreads();
    const int lo = args.ph_lo, hi = args.ph_hi;
    XcdBarrier bar; bar.bar = (unsigned*)(ws + WS_CTL) + CW_BAR; bar.x = 0; bar.st = nullptr;
    if (hi - lo > 1) bar = xcd_barrier_post((unsigned*)(ws + WS_CTL) + CW_BAR, MISC + 8, T0());
#define IN(k) (lo <= (k) && (k) < hi)
#define REFRAME() do { const int lz_ = pg8::opaque_lane(); F.lane = lz_; F.tid = wave_s * 64 + lz_; F.wave = wave_s; ws = (unsigned char*)karg(34); F.ws = ws; { int g_ = (int)gridDim.x, b_ = (int)blockIdx.x; asm volatile("" : "+s"(g_), "+s"(b_)); bx = b_; F.G = g_; F.vcu = ((g_ & 7) == 0) ? (b_ & 7) * (g_ >> 3) + (b_ >> 3) : b_; } } while (0)
#define SEAM(k) do { if (IN((k) + 1)) xcd_barrier(bar, T0()); } while (0)
#define XBUF ((float*)(ws + WS_X))
#define HBUF ((bf16*)(ws + WS_H))
#define MODP ((const float*)(ws + WS_CTL + CTL_MOD_OFF) + (size_t)l * 3 * 12288)
    int bx = (int)blockIdx.x;

    for (int rep_ = 0; rep_ < ((DBG_REPEAT == 100) ? 2 : 1); ++rep_) if (PH_ON(100) && IN(0)) { REFRAME(); if (rep_) xcd_barrier(bar, T0()); p0_prologue(F); SEAM(0); if (DBG_REPEAT == 200) { for (int i_ = 0; i_ < 32; ++i_) xcd_barrier(bar, T0()); } }

    for (int l = 0; l < NLAYER; ++l) {
        const int base = 1 + l * PH_PER_LAYER;
        const int last = (l == NLAYER - 1);
        for (int rep_ = 0; rep_ < ((DBG_REPEAT == 0) ? 2 : 1); ++rep_) if (PH_ON(0) && IN(base + 0) && l == 0) { REFRAME(); if (rep_) xcd_barrier(bar, T0()); modnorm_phase(F, XBUF, karg(6) + (size_t)l * DM, MODP, 0, HBUF, 0, l == 0 ? karg(0) : nullptr, l == 0 ? karg(2) : nullptr); SEAM(base + 0); }
        for (int rep_ = 0; rep_ < ((DBG_REPEAT == 1) ? 2 : 1); ++rep_) if (PH_ON(1) && IN(base + 1)) { REFRAME(); if (rep_) xcd_barrier(bar, T0());
            pg8::Gemm g{HBUF, (const bf16*)(ws + WS_WINA) + (size_t)l * INA_P * DM, MALL, INA_P, DM}; pg8::RowOrder S; S.init_rows(0, INA_P, F.G, bx);
            pg8::EpiStoreBf16 E{(bf16*)(ws + WS_PA), INA_P};
            GEMM_CALL(pg8::EpiStoreBf16, pg8::RowOrder, g, S, E);
            SEAM(base + 1); }
        for (int rep_ = 0; rep_ < ((DBG_REPEAT == 2) ? 2 : 1); ++rep_) if (PH_ON(2) && IN(base + 2)) { REFRAME(); if (rep_) xcd_barrier(bar, T0());
            FeatP P;
            P.PA = (const bf16*)(ws + WS_PA); P.mu = karg(9) + (size_t)l * RWC; P.w0 = karg(10) + (size_t)l * 2 * RW; P.a0 = karg(12) + (size_t)l * 2 * RW;
            P.k_k = karg(15) + (size_t)l * RW; P.k_a = karg(16) + (size_t)l * RW; P.r_k = karg(17) + (size_t)l * RW;
            P.WUP = (const bf16*)(ws + WS_WUP) + (size_t)l * 2 * RW * 64; P.AUP = (const bf16*)(ws + WS_AUP) + (size_t)l * 2 * RW * 64; P.GUP = (const bf16*)(ws + WS_GUP) + (size_t)l * 2 * RW * 32;
            P.qnorm = karg(20) + (size_t)l * 512; P.kvnorm = karg(22) + (size_t)l * 256; P.rope = (const f32x2*)(ws + WS_ROPE);
            P.RI = (bf16*)(ws + WS_RI); P.GG = (bf16*)(ws + WS_GG); P.BON = (float*)(ws + WS_BON); P.QN = (bf16*)(ws + WS_QN); P.KVN = (bf16*)(ws + WS_KVN); P.K = (bf16*)(ws + WS_K);
            features_phase(F, P);
            SEAM(base + 2); }
        for (int rep_ = 0; rep_ < ((DBG_REPEAT == 3) ? 2 : 1); ++rep_) if (PH_ON(3) && IN(base + 3)) { REFRAME(); if (rep_) xcd_barrier(bar, T0());
            { pg8::Gemm g{(const bf16*)(ws + WS_QN), (const bf16*)(ws + WS_WUQ) + (size_t)l * NQ * 512, MALL, NQ, 512};
              pg8::EpiQ E{(bf16*)(ws + WS_Q), (const f32x2*)(ws + WS_ROPE), 0.14724444f};
              pg8::RowOrder S; S.init_rows(last, NQ, F.G, bx); GEMM_CALL_NA(pg8::EpiQ, pg8::RowOrder, g, S, E); }
            { pg8::Gemm g{(const bf16*)(ws + WS_KVN), (const bf16*)(ws + WS_WUKV) + (size_t)l * NKV * 256, MALL, NKV, 256}; pg8::RowOrder S; S.init_rows(0, NKV, F.G, bx);
              pg8::EpiKV E{(bf16*)(ws + WS_K), (bf16*)(ws + WS_V)};
              GEMM_CALL_NA(pg8::EpiKV, pg8::RowOrder, g, S, E); }
            SEAM(base + 3); }
        for (int rep_ = 0; rep_ < ((DBG_REPEAT == 4) ? 2 : 1); ++rep_) if (PH_ON(4) && IN(base + 4)) { REFRAME(); if (rep_) xcd_barrier(bar, T0()); scan_phase(F, (const bf16*)(ws + WS_RI), (bf16*)(ws + WS_Y)); SEAM(base + 4); }
        for (int rep_ = 0; rep_ < ((DBG_REPEAT == 5) ? 2 : 1); ++rep_) if (PH_ON(5) && IN(base + 5)) { REFRAME(); if (rep_) xcd_barrier(bar, T0());
            attn_phase(F, (const bf16*)(ws + WS_Q), (const bf16*)(ws + WS_K), (const bf16*)(ws + WS_V), (bf16*)(ws + WS_YB), !last);
            readout_phase(F, (const bf16*)(ws + WS_Y), (const bf16*)(ws + WS_GG), (const float*)(ws + WS_BON), (const bf16*)(ws + WS_RI), karg(18) + (size_t)l * RW, karg(19) + (size_t)l * RW, (bf16*)(ws + WS_YA));
            SEAM(base + 5); }
        for (int rep_ = 0; rep_ < ((DBG_REPEAT == 6) ? 2 : 1); ++rep_) if (PH_ON(6) && IN(base + 6)) { REFRAME(); if (rep_) xcd_barrier(bar, T0());
            bf16* T1 = (bf16*)(ws + WS_T1); bf16* T2 = (bf16*)(ws + WS_T2);
            const pg8::Gemm g1{HBUF, (const bf16*)(ws + WS_WGA) + (size_t)l * DM * DM, MALL, DM, DM}, g2{(const bf16*)(ws + WS_YA), (const bf16*)(ws + WS_WA) + (size_t)l * DM * RW, MALL, DM, RW};
            const pg8::Gemm g3{HBUF, (const bf16*)(ws + WS_WGB) + (size_t)l * DM * DM, MALL, DM, DM}, g4{(const bf16*)(ws + WS_YB), (const bf16*)(ws + WS_WB) + (size_t)l * DM * RW, MALL, DM, RW};
            const pg8::EpiGate E1{T1, DM, karg(8) + (size_t)l * 2 * DM}, E3{T2, DM, karg(8) + (size_t)l * 2 * DM + DM};
            const pg8::EpiMulAdd E2{T1, T1, nullptr, DM}, E4{T1, T2, T1, DM};
            pg8::RowOrder S; S.init_rows(last, DM, F.G, bx);
            GEMM_CALL(pg8::EpiGate, pg8::RowOrder, g1, S, E1); GEMM_CALL(pg8::EpiMulAdd, pg8::RowOrder, g2, S, E2); GEMM_CALL(pg8::EpiGate, pg8::RowOrder, g3, S, E3); GEMM_CALL(pg8::EpiMulAdd, pg8::RowOrder, g4, S, E4);
            SEAM(base + 6); }
        for (int rep_ = 0; rep_ < ((DBG_REPEAT == 7) ? 2 : 1); ++rep_) if (PH_ON(7) && IN(base + 7)) { REFRAME(); if (rep_) xcd_barrier(bar, T0());
            const pg8::Gemm g{(const bf16*)(ws + WS_T1), (const bf16*)(ws + WS_WO) + (size_t)l * DM * DM, MALL, DM, DM};
            const pg8::EpiResid E{XBUF, MODP + 2 * DM, l == 0 ? karg(0) : nullptr, l == 0 ? karg(2) : nullptr};
            pg8::RowOrder S; S.init_rows(last, DM, F.G, bx); GEMM_CALL(pg8::EpiResid, pg8::RowOrder, g, S, E);
            SEAM(base + 7); }
        for (int rep_ = 0; rep_ < ((DBG_REPEAT == 8) ? 2 : 1); ++rep_) if (PH_ON(8) && IN(base + 8)) { REFRAME(); if (rep_) xcd_barrier(bar, T0());
            modnorm_phase(F, XBUF, karg(27) + (size_t)l * DM, MODP, 3, HBUF, last);
            SEAM(base + 8); }
        for (int rep_ = 0; rep_ < ((DBG_REPEAT == 9) ? 2 : 1); ++rep_) if (PH_ON(9) && IN(base + 9)) { REFRAME(); if (rep_) xcd_barrier(bar, T0());
            const pg8::Gemm g{HBUF, (const bf16*)(ws + WS_WQK) + (size_t)l * DM * DM, MALL, DM, DM};
            const pg8::EpiF32 E{(float*)(ws + WS_SC), DM};
            pg8::RowOrder S; S.init_rows(last, DM, F.G, bx); GEMM_CALL(pg8::EpiF32, pg8::RowOrder, g, S, E);
            SEAM(base + 9); }
        for (int rep_ = 0; rep_ < ((DBG_REPEAT == 10) ? 2 : 1); ++rep_) if (PH_ON(10) && IN(base + 10)) { REFRAME(); if (rep_) xcd_barrier(bar, T0());
            SelP P; P.SC = (const float*)(ws + WS_SC); P.ESEL = (int*)(ws + WS_T1); P.EGATE = (float*)(ws + WS_T1 + 16 * MiB);
            P.pu = karg(30) + (size_t)l * NEXP * DM; P.pv = karg(31) + (size_t)l * NEXP * DM; P.PU8 = ws + WS_PU; P.PV8 = ws + WS_PU + (size_t)NEXP * (DM / 2); P.SU = (float*)(ws + WS_PV); P.SV = (float*)(ws + WS_PV) + NEXP; P.last = last; P.dry = (DBG_REPEAT == 10 && rep_ == 0) ? DBG_DRY : 0;
            select_phase(F, P);
            SEAM(base + 10); }
        for (int rep_ = 0; rep_ < ((DBG_REPEAT == 11) ? 2 : 1); ++rep_) if (PH_ON(11) && IN(base + 11)) { REFRAME(); if (rep_) xcd_barrier(bar, T0());
            PeerP P; P.nmod = MODP + 3 * 12288; P.ng = karg(6) + (size_t)(l + 1) * DM; P.Hout = HBUF; P.ESEL = (const int*)(ws + WS_T1); P.EGATE = (const float*)(ws + WS_T1 + 16 * MiB); P.H = HBUF; P.PU = ws + WS_PU; P.PV = ws + WS_PU + (size_t)NEXP * (DM / 2); P.SU = (const float*)(ws + WS_PV); P.SV = (const float*)(ws + WS_PV) + NEXP; P.X = XBUF; P.mod = MODP; P.fin_g = karg(32); P.out = (float*)karg(33); P.last = last; P.dry = (DBG_REPEAT == 11 && rep_ == 0) ? DBG_DRY : 0;
            peer_phase(F, P);
            SEAM(base + 11); }
    }
#undef IN
#undef SEAM
#undef XBUF
#undef HBUF
#undef MODP
}

__device__ __forceinline__ float mx_a_val(int i, int k) { const int c = (i * 131 + k * 17 + (k >> 3) * 5) & 15; const float mag[8] = {0.f, .5f, 1.f, 1.5f, 2.f, 3.f, 4.f, 6.f}; return (c & 8) ? -mag[c & 7] : mag[c & 7]; }
__device__ __forceinline__ int mx_a_code(int i, int k) { return (i * 131 + k * 17 + (k >> 3) * 5) & 15; }
__device__ __forceinline__ float mx_b_val(int k, int j) { return (float)(((k * 7 + j * 13 + (k >> 4)) % 9) - 4); }
__device__ __forceinline__ int mx_kmap(int hyp, int kb, int e) { const int h = hyp % 3; return h == 0 ? 32 * kb + e : h == 1 ? 32 * (e >> 3) + 8 * kb + (e & 7) : 64 * (e >> 4) + 16 * kb + (e & 15); }
__global__ void __launch_bounds__(512) dbg_fill(const float* pp, float* o) {
    __shared__ float vsh;
    float v = 0.f;
    if (DBG_PROBE == 5) {
        if (threadIdx.x < 64) { typedef int v8i __attribute__((ext_vector_type(8))); typedef float f4 __attribute__((ext_vector_type(4)));
            const int lane = threadIdx.x, i = lane & 15, kb = lane >> 4; float code = 0.f;
            for (int hyp = 0; hyp < 18; ++hyp) { const int nibswap = hyp / 9, ha = hyp % 3, hb2 = (hyp / 3) % 3;
                unsigned aw[4] = {0u, 0u, 0u, 0u}; int bw[8] = {0, 0, 0, 0, 0, 0, 0, 0};
                for (int e = 0; e < 32; ++e) { const int k = mx_kmap(ha, kb, e); const unsigned c = (unsigned)mx_a_code(i, k); const int pos = nibswap ? (e ^ 1) : e; aw[pos >> 3] |= c << (4 * (pos & 7)); }
                for (int q = 0; q < 8; ++q) { int w = 0; const float f0 = mx_b_val(mx_kmap(hb2, kb, 4 * q + 0), i), f1 = mx_b_val(mx_kmap(hb2, kb, 4 * q + 1), i), f2 = mx_b_val(mx_kmap(hb2, kb, 4 * q + 2), i), f3 = mx_b_val(mx_kmap(hb2, kb, 4 * q + 3), i);
                    w = __builtin_amdgcn_cvt_pk_fp8_f32(f0, f1, w, false); w = __builtin_amdgcn_cvt_pk_fp8_f32(f2, f3, w, true); bw[q] = w; }
                const v8i af = {(int)aw[0], (int)aw[1], (int)aw[2], (int)aw[3], 0, 0, 0, 0}, bf = {bw[0], bw[1], bw[2], bw[3], bw[4], bw[5], bw[6], bw[7]};
                f4 d = {0.f, 0.f, 0.f, 0.f};
                d = __builtin_amdgcn_mfma_scale_f32_16x16x128_f8f6f4(af, bf, d, 4, 0, 0, 0x7f7f7f7f, 0, 0x7f7f7f7f);
                int bad = 0;
                for (int r = 0; r < 4; ++r) { const int row = 4 * kb + r, col = i; float ex = 0.f; for (int k = 0; k < 128; ++k) ex += mx_a_val(row, k) * mx_b_val(k, col); bad += (d[r] != ex); }
                if (__ballot(bad != 0) == 0ull && code == 0.f) code = (float)(hyp + 1); }
            for (int t = 0; t < 2; ++t) {
                int aw[8] = {0, 0, 0, 0, 0, 0, 0, 0}, bw[8] = {0, 0, 0, 0, 0, 0, 0, 0};
                if (t == 0) { for (int e = 0; e < 32; ++e) { const int k = 32 * kb + e; aw[e >> 3] |= mx_a_code(i, k) << (4 * (e & 7)); bw[e >> 3] |= mx_a_code(i + 16, k) << (4 * (e & 7)); } }
                else { for (int q = 0; q < 8; ++q) { int w = 0, w2 = 0; const int k = 32 * kb + 4 * q;
                        w = __builtin_amdgcn_cvt_pk_fp8_f32(mx_b_val(k, i + 16), mx_b_val(k + 1, i + 16), w, false); w = __builtin_amdgcn_cvt_pk_fp8_f32(mx_b_val(k + 2, i + 16), mx_b_val(k + 3, i + 16), w, true); aw[q] = w;
                        w2 = __builtin_amdgcn_cvt_pk_fp8_f32(mx_b_val(k, i), mx_b_val(k + 1, i), w2, false); w2 = __builtin_amdgcn_cvt_pk_fp8_f32(mx_b_val(k + 2, i), mx_b_val(k + 3, i), w2, true); bw[q] = w2; } }
                const v8i af = {aw[0], aw[1], aw[2], aw[3], aw[4], aw[5], aw[6], aw[7]}, bf = {bw[0], bw[1], bw[2], bw[3], bw[4], bw[5], bw[6], bw[7]};
                f4 d = {0.f, 0.f, 0.f, 0.f};
                if (t == 0) d = __builtin_amdgcn_mfma_scale_f32_16x16x128_f8f6f4(af, bf, d, 4, 4, 0, 0x7f7f7f7f, 0, 0x7f7f7f7f); else d = __builtin_amdgcn_mfma_scale_f32_16x16x128_f8f6f4(af, bf, d, 0, 0, 0, 0x7f7f7f7f, 0, 0x7f7f7f7f);
                int bad = 0;
                for (int r = 0; r < 4; ++r) { const int row = 4 * kb + r, col = i; float ex = 0.f;
                    for (int k = 0; k < 128; ++k) ex += (t == 0) ? mx_a_val(row, k) * mx_a_val(col + 16, k) : mx_b_val(k, row + 16) * mx_b_val(k, col);
                    bad += (d[r] != ex); }
                if (__ballot(bad != 0) == 0ull) code += (t == 0) ? 10.f : 20.f; }
            if (lane == 0) vsh = code; }
        __syncthreads(); v = vsh;
    } else {
        float s0 = 0.f, s1 = 0.f, s2 = 0.f, s3 = 0.f;
        for (int i = 0; i < 2048; ++i) { s0 += pp[4 * i]; s1 += pp[4 * i + 1]; s2 += pp[4 * i + 2]; s3 += pp[4 * i + 3]; }
        if (DBG_PROBE == 4) { float mx = 0.f; for (int i = 0; i < 2048; ++i) mx = fmaxf(mx, pp[4 * i]); v = 100.f * mx; }
        else { v = (DBG_PROBE == 1 ? s0 : DBG_PROBE == 2 ? s1 : s2) / s3 * 1e-3f; v = exp2f(rintf(log2f(v) * 4.f) * 0.25f); }
    }
    for (size_t i = (size_t)blockIdx.x * 512 + threadIdx.x; i < (size_t)NBATCH * SEQ * DM; i += (size_t)gridDim.x * 512) o[i] = v;
}
extern "C" void kernel_launch(void* const* d_in, const int* in_sizes, int n_in, void* d_out, int out_size, void* d_ws, size_t ws_size, hipStream_t stream) {
    static int grid = 0;
    if (grid == 0) {
        if (n_in != 33 || out_size != NBATCH * SEQ * DM || ws_size < WS_END) { fprintf(stderr, "kernel_launch: unexpected shapes (n_in %d out %d ws %zu)\n", n_in, out_size, ws_size); grid = -1; return; }
        int dev = 0, cus = 0, per_cu = 0;
        if (hipGetDevice(&dev) != hipSuccess || hipDeviceGetAttribute(&cus, hipDeviceAttributeMultiprocessorCount, dev) != hipSuccess) { grid = -1; return; }
        if (hipFuncSetAttribute((const void*)mk_fwd, hipFuncAttributeMaxDynamicSharedMemorySize, LDS_BYTES) != hipSuccess) { fprintf(stderr, "kernel_launch: hipFuncSetAttribute failed\n"); grid = -1; return; }
        if (hipOccupancyMaxActiveBlocksPerMultiprocessor(&per_cu, (const void*)mk_fwd, NWAVES * 64, LDS_BYTES) != hipSuccess || per_cu < 1) { fprintf(stderr, "kernel_launch: occupancy query says %d\n", per_cu); (void)hipGetLastError(); grid = -1; return; }
        grid = cus;
    }
    if (grid < 0) return;
    if (hipMemsetAsync((char*)d_ws + WS_CTL, 0, CTL_ZERO_BYTES, stream) != hipSuccess) return;
    Args a{};
    for (int i = 0; i < 33; ++i) a.in[i] = (const float*)d_in[i];
    a.out = (float*)d_out; a.ws = (unsigned char*)d_ws;
#if MK_N_LAUNCHES == 1
    a.ph_lo = 0; a.ph_hi = NPHASE;
    hipLaunchKernelGGL(mk_fwd, dim3(grid), dim3(NWAVES * 64), LDS_BYTES, stream, a);
#else
    if (DBG_PROBE != 5) for (int p = 0; p < NPHASE; ++p) { a.ph_lo = p; a.ph_hi = p + 1; hipLaunchKernelGGL(mk_fwd, dim3(grid), dim3(NWAVES * 64), LDS_BYTES, stream, a); }
    if (DBG_PROBE) hipLaunchKernelGGL(dbg_fill, dim3(1024), dim3(512), 0, stream, (const float*)((char*)d_ws + WS_CTL + CTL_PROBE_OFF), (float*)d_out);
#endif
}
```

```cpp
#include <hip/hip_runtime.h>
#include <cstdio>
#include <cstdint>

#ifndef MK_N_LAUNCHES
#define MK_N_LAUNCHES 1
#endif

#ifndef DBG_SKIP
#define DBG_SKIP 0
#endif
#ifndef DBG_PROBE
#define DBG_PROBE 0
#endif
#ifndef DBG_DRY
#define DBG_DRY 1
#endif
#ifndef DBG_REPEAT
#define DBG_REPEAT -1
#endif
namespace pg8 {
#define PG8_LAS __attribute__((address_space(3)))
typedef unsigned short bf16_t;
typedef short bf16x8 __attribute__((ext_vector_type(8)));
typedef float f32x4 __attribute__((ext_vector_type(4)));
typedef unsigned u32x4 __attribute__((ext_vector_type(4)));
constexpr int BM = 256, BK = 64, HALF = 128, HTB = HALF * BK * 2  , STAGE_BYTES = 8 * HTB, NXCD = 8, WGM = 8;

__host__ __device__ __forceinline__ int lds_byte(int r, int c) { const int st = (r >> 4) * 2 + (c >> 5), rr = r & 15, cc = c & 31, ob = rr * 64 + cc * 2; return st * 1024 + (ob ^ (((ob >> 9) & 1) << 5)); }
__host__ __device__ __forceinline__ void stage_rc(int b, int& R, int& C) { const int st = b / 1024, sb = b % 1024, swz = sb ^ (((sb >> 9) & 1) << 5); R = (st >> 1) * 16 + swz / 64; C = (st & 1) * 32 + (swz % 64) / 2; }
__host__ __device__ __forceinline__ int perm32(int rho) { const int n = rho >> 4, i = rho & 15; return 8 * (i >> 2) + 4 * n + (i & 3); }

struct Unit { int pm, pn; };
struct Gemm { const bf16_t* A; const bf16_t* Bt; int M, N, K; };

struct StaticOrder {
    int nM, nN, nwg, G, c;
    __host__ __device__ void init(int M, int N, int G_, int c_) { nM = M / BM; nN = N / BM; nwg = nM * nN; G = G_; c = c_; }
    __host__ __device__ bool next(int i, Unit& u) const {
        const long L = (long)i * G + c; if (L >= nwg) return false;
        int wgid = (int)L; { const int q = nwg / NXCD, r = nwg % NXCD, xcd = wgid % NXCD, off = wgid / NXCD; wgid = (xcd < r ? xcd * (q + 1) : r * (q + 1) + (xcd - r) * q) + off; }
        const int nig = WGM * nN, gid = wgid / nig, fm = gid * WGM, gsz = (nM - fm) < WGM ? (nM - fm) : WGM;
        u.pm = fm + ((wgid % nig) % gsz); u.pn = (wgid % nig) / gsz; return true;
    }
    __device__ __forceinline__ void a_ready(const Unit&) const {}
    __device__ __forceinline__ void done(const Unit&) const {}
};
__device__ __forceinline__ int opaque_lane() { int l; asm volatile("v_mbcnt_lo_u32_b32 %0, -1, 0\n\tv_mbcnt_hi_u32_b32 %0, -1, %0" : "=v"(l)); return l; }
typedef __bf16 bf16x2c __attribute__((ext_vector_type(2)));
__device__ __forceinline__ unsigned cvt_pk_bf16(float lo, float hi) { const bf16x2c v = {(__bf16)lo, (__bf16)hi}; return __builtin_bit_cast(unsigned, v); }
template <class Epi, class Sched, bool ALIGN_EPI = false, bool SP2 = false>
__device__ __forceinline__ void gemm_phase(PG8_LAS unsigned char* lds, const Gemm g, const Sched& S, const Epi& E, const int wave_s) {
    const int lane_ = opaque_lane();
    const int wid = wave_s, lane = lane_, tid = wid * 64 + lane, wr = wid >> 2, wc = wid & 3, fr = lane & 15, fq = lane >> 4;
    const int K = g.K, nt = K / BK;
    unsigned voffA[2], voffB[2];
#pragma unroll
    for (int i = 0; i < 2; ++i) { int R, C; stage_rc(tid * 16 + i * 8192, R, C); const int Rb = Epi::PERM ? ((R & ~31) + perm32(R & 31)) : R;
        voffA[i] = (unsigned)(R * K + C) * 2u; voffB[i] = (unsigned)(Rb * K + C) * 2u; }
    const size_t kstep = (size_t)(BK * 2);
    const size_t hstep = (size_t)HALF * K * 2;
    const size_t tstep = 2 * hstep;
    const unsigned ldsw = (unsigned)wid * 1024u;
    const int aoff = lds_byte(wr * 64 + fr, fq * 8), boff = lds_byte(wc * 32 + fr, fq * 8);
#define PG8_SA(b, h) (((b) * 2 + (h)) * HTB)
#define PG8_SB(b, h) ((4 + (b) * 2 + (h)) * HTB)
#define PG8_STAGE(bufoff, gbase, voff) do { _Pragma("unroll") for (int _i = 0; _i < 2; ++_i) \
        __builtin_amdgcn_global_load_lds((const unsigned*)((const char*)(gbase) + (voff)[_i]), (PG8_LAS unsigned*)(lds + (bufoff) + ldsw + _i * 8192), 16, 0, 0); } while (0)
#define PG8_LDA(dst, b, h) do { _Pragma("unroll") for (int m = 0; m < 4; ++m) _Pragma("unroll") for (int k = 0; k < 2; ++k) dst[m][k] = *(const PG8_LAS bf16x8*)(lds + PG8_SA(b, h) + aoff + m * 2048 + k * 1024); } while (0)
#define PG8_LDB(dst, b, h) do { _Pragma("unroll") for (int n = 0; n < 2; ++n) _Pragma("unroll") for (int k = 0; k < 2; ++k) dst[n][k] = *(const PG8_LAS bf16x8*)(lds + PG8_SB(b, h) + boff + n * 2048 + k * 1024); } while (0)
#define PG8_MMA(ai, bj, At, Bt) do { __builtin_amdgcn_s_setprio(1); _Pragma("unroll") for (int m = 0; m < 4; ++m) _Pragma("unroll") for (int n = 0; n < 2; ++n) _Pragma("unroll") for (int k = 0; k < 2; ++k) \
        acc[ai][bj][m][n] = __builtin_amdgcn_mfma_f32_16x16x32_bf16(Bt[n][k], At[m][k], acc[ai][bj][m][n], 0, 0, 0); __builtin_amdgcn_s_setprio(0); } while (0)
#define PG8_WAIT_V(n) asm volatile("s_waitcnt vmcnt(" #n ")" ::: "memory")
#define PG8_WAIT_L(n) asm volatile("s_waitcnt lgkmcnt(" #n ")" ::: "memory")
#define PG8_BAR __builtin_amdgcn_s_barrier()
#define PG8_SCHED __builtin_amdgcn_sched_barrier(0)
    Unit cur, nxt; int ui = 0;
    if (!S.next(0, cur)) return;
    f32x4 acc[2][2][4][2];
#pragma unroll
    for (int a = 0; a < 2; ++a)
#pragma unroll
        for (int b = 0; b < 2; ++b)
#pragma unroll
            for (int m = 0; m < 4; ++m)
#pragma unroll
                for (int n = 0; n < 2; ++n) acc[a][b][m][n] = (f32x4){0.f, 0.f, 0.f, 0.f};
    bf16x8 At[4][2], B0[2][2], B1[2][2];
    const char* cA = (const char*)g.A + (size_t)cur.pm * tstep; const char* cB = (const char*)g.Bt + (size_t)cur.pn * tstep;
    S.a_ready(cur);
    if constexpr (SP2) {
        PG8_STAGE(PG8_SB(0, 0), cB, voffB); PG8_STAGE(PG8_SB(0, 1), cB + hstep, voffB); PG8_STAGE(PG8_SA(0, 0), cA, voffA); PG8_STAGE(PG8_SA(0, 1), cA + hstep, voffA);
        if (wr == 1) PG8_BAR;
        PG8_WAIT_V(2); PG8_BAR;
        PG8_STAGE(PG8_SB(1, 0), cB + kstep, voffB); PG8_STAGE(PG8_SA(1, 0), cA + kstep, voffA); PG8_STAGE(PG8_SB(1, 1), cB + hstep + kstep, voffB);
        PG8_WAIT_V(6); PG8_BAR;
    } else {
        PG8_STAGE(PG8_SB(0, 0), cB, voffB); PG8_STAGE(PG8_SA(0, 0), cA, voffA); PG8_STAGE(PG8_SB(0, 1), cB + hstep, voffB); PG8_STAGE(PG8_SA(0, 1), cA + hstep, voffA);
        if (wr == 1) PG8_BAR;
        PG8_WAIT_V(4); PG8_BAR;
        PG8_STAGE(PG8_SB(1, 0), cB + kstep, voffB); PG8_STAGE(PG8_SA(1, 0), cA + kstep, voffA); PG8_STAGE(PG8_SB(1, 1), cB + hstep + kstep, voffB);
        PG8_WAIT_V(6); PG8_BAR;
    }
    for (;;) {
        const bool has_next = S.next(ui + 1, nxt);
        const char* nA = has_next ? (const char*)g.A + (size_t)nxt.pm * tstep : cA; const char* nB = has_next ? (const char*)g.Bt + (size_t)nxt.pn * tstep : cB;
        for (int t = 0; t < nt; t += 2) {
            const bool last = (t == nt - 2);
            const char* a1 = cA + (size_t)(t + 1) * kstep;
            const char* a2 = last ? nA : cA + (size_t)(t + 2) * kstep; const char* b2 = last ? nB : cB + (size_t)(t + 2) * kstep;
            const char* a3 = a2 + kstep; const char* b3 = b2 + kstep;
            if (last && has_next) S.a_ready(nxt);
            if constexpr (SP2) {
            PG8_LDB(B0, 0, 0); PG8_LDB(B1, 0, 1); PG8_SCHED; PG8_LDA(At, 0, 0); PG8_STAGE(PG8_SA(1, 1), a1 + hstep, voffA);
            PG8_WAIT_V(8); PG8_WAIT_L(0); PG8_BAR; PG8_MMA(0, 0, At, B0); PG8_MMA(0, 1, At, B1); PG8_BAR; PG8_SCHED;
            PG8_LDA(At, 0, 1); PG8_STAGE(PG8_SB(0, 0), b2, voffB); PG8_STAGE(PG8_SB(0, 1), b2 + hstep, voffB); PG8_STAGE(PG8_SA(0, 0), a2, voffA);
            PG8_WAIT_V(8); PG8_WAIT_L(0); PG8_BAR; PG8_MMA(1, 0, At, B0); PG8_MMA(1, 1, At, B1); PG8_BAR; PG8_SCHED;
            PG8_LDB(B0, 1, 0); PG8_LDB(B1, 1, 1); PG8_SCHED; PG8_LDA(At, 1, 0); PG8_STAGE(PG8_SA(0, 1), a2 + hstep, voffA);
            PG8_WAIT_V(8); PG8_WAIT_L(0); PG8_BAR; PG8_MMA(0, 0, At, B0); PG8_MMA(0, 1, At, B1); PG8_BAR; PG8_SCHED;
            PG8_LDA(At, 1, 1); PG8_STAGE(PG8_SB(1, 0), b3, voffB); PG8_STAGE(PG8_SB(1, 1), b3 + hstep, voffB); PG8_STAGE(PG8_SA(1, 0), a3, voffA);
            PG8_WAIT_V(8); PG8_WAIT_L(0); PG8_BAR; PG8_MMA(1, 0, At, B0); PG8_MMA(1, 1, At, B1); PG8_BAR; PG8_SCHED;
            } else {
            PG8_LDB(B0, 0, 0); PG8_SCHED; PG8_LDA(At, 0, 0); PG8_STAGE(PG8_SA(1, 1), a1 + hstep, voffA);
            PG8_WAIT_L(8); PG8_BAR; PG8_WAIT_L(0); PG8_MMA(0, 0, At, B0); PG8_BAR; PG8_SCHED;
            PG8_LDB(B1, 0, 1); PG8_STAGE(PG8_SB(0, 0), b2, voffB);
            PG8_BAR; PG8_WAIT_L(0); PG8_MMA(0, 1, At, B1); PG8_BAR;
            PG8_LDA(At, 0, 1); PG8_STAGE(PG8_SA(0, 0), a2, voffA);
            PG8_BAR; PG8_WAIT_L(0); PG8_MMA(1, 0, At, B0); PG8_BAR; PG8_SCHED;
            PG8_STAGE(PG8_SB(0, 1), b2 + hstep, voffB);
            PG8_WAIT_V(6); PG8_BAR; PG8_MMA(1, 1, At, B1); PG8_BAR;
            PG8_LDB(B0, 1, 0); PG8_SCHED; PG8_LDA(At, 1, 0); PG8_STAGE(PG8_SA(0, 1), a2 + hstep, voffA);
            PG8_WAIT_L(8); PG8_BAR; PG8_WAIT_L(0); PG8_MMA(0, 0, At, B0); PG8_BAR; PG8_SCHED;
            PG8_LDB(B1, 1, 1); PG8_STAGE(PG8_SB(1, 0), b3, voffB);
            PG8_BAR; PG8_WAIT_L(0); PG8_MMA(0, 1, At, B1); PG8_BAR;
            PG8_LDA(At, 1, 1); PG8_STAGE(PG8_SA(1, 0), a3, voffA);
            PG8_BAR; PG8_WAIT_L(0); PG8_MMA(1, 0, At, B0); PG8_BAR; PG8_SCHED;
            PG8_STAGE(PG8_SB(1, 1), b3 + hstep, voffB);
            PG8_WAIT_V(6); PG8_BAR; PG8_MMA(1, 1, At, B1); PG8_BAR;
            }
        }
        if constexpr (ALIGN_EPI) { if (wr == 0) PG8_BAR; }
        if constexpr (!Epi::AFTER_DRAIN) { const int le_ = opaque_lane(); E(acc, cur, wr, wc, le_ & 15, le_ >> 4); S.done(cur); }
        if (!has_next) break;
#pragma unroll
        for (int a = 0; a < 2; ++a)
#pragma unroll
            for (int b = 0; b < 2; ++b)
#pragma unroll
                for (int m = 0; m < 4; ++m)
#pragma unroll
                    for (int n = 0; n < 2; ++n) acc[a][b][m][n] = (f32x4){0.f, 0.f, 0.f, 0.f};
        cur = nxt; cA = nA; cB = nB; ++ui;
        if constexpr (ALIGN_EPI) { if (wr == 1) PG8_BAR; }
    }
    PG8_WAIT_V(0);
    if constexpr (!ALIGN_EPI) { if (wr == 0) PG8_BAR; }
    PG8_BAR;
    if constexpr (Epi::AFTER_DRAIN) { E.fused(acc, cur, wr, wc, fr, fq, lds, wid, lane); S.done(cur); }
#undef PG8_SA
#undef PG8_SB
#undef PG8_STAGE
#undef PG8_LDA
#undef PG8_LDB
#undef PG8_MMA
#undef PG8_WAIT_V
#undef PG8_WAIT_L
#undef PG8_BAR
#undef PG8_SCHED
}
}

constexpr int NWAVES = 8;
constexpr int DM = 2048, NBATCH = 2, SEQ = 8192, CTXL = 256, TPB = CTXL + SEQ  , MALL = NBATCH * TPB  ;
constexpr int NLAYER = 2;
constexpr int RW = 1024, NH = 16;
constexpr int RWC = 3392, INA = 4192, INA_P = 4352, INC = 8288;
constexpr int C_WD = 3072, C_AD = 3200, C_GD = 3328, C_QC = 3392, C_KVC = 3904, C_KR = 4160;
constexpr int QKD = 96, NQ = NH * QKD  , NKV = NH * 128  ;
constexpr int NEXP = 16384;
constexpr int RREC = 9 * 64;
constexpr float NORM_EPS = 1e-6f;

constexpr size_t MiB = 1u << 20;
constexpr size_t WS_CTL = 0, CTL_ZERO_BYTES = 1 * MiB;
constexpr size_t CTL_MOD_OFF = 256 * 1024;
constexpr size_t WS_ROPE = 1 * MiB;
constexpr size_t WS_WUP = 3 * MiB, WS_AUP = WS_WUP + 512 * 1024, WS_GUP = 4 * MiB;
constexpr size_t WS_WUQ = 5 * MiB, WS_WUKV = 8 * MiB, WS_WA = 10 * MiB, WS_WB = 18 * MiB, WS_WO = 26 * MiB, WS_WQK = 42 * MiB, WS_WGA = 58 * MiB, WS_WGB = 74 * MiB, WS_WINA = 90 * MiB;
constexpr size_t WS_X = 124 * MiB, WS_H = 256 * MiB, WS_DYN = 322 * MiB;
constexpr size_t WS_PA = WS_DYN;
constexpr size_t WS_RI = 463 * MiB;
constexpr size_t WS_GG = 760 * MiB;
constexpr size_t WS_BON = 826 * MiB;
constexpr size_t WS_QN = 831 * MiB, WS_KVN = 848 * MiB;
constexpr size_t WS_Q = 857 * MiB, WS_K = 907 * MiB, WS_V = 957 * MiB, WS_END = 990 * MiB;
constexpr size_t WS_Y = WS_DYN;
constexpr size_t WS_YA = 388 * MiB, WS_YB = 421 * MiB;
constexpr size_t WS_T1 = 463 * MiB, WS_T2 = 529 * MiB;
constexpr size_t WS_PU = 600 * MiB, WS_PV = 664 * MiB;
constexpr size_t WS_P4 = 990 * MiB, WS_P4S = 1022 * MiB, WS_END2 = 1023 * MiB;
constexpr size_t WS_SC = WS_DYN;
static_assert(WS_PA + (size_t)MALL * INA_P * 2 <= WS_RI && WS_RI + (size_t)NBATCH * NH * TPB * RREC * 2 <= WS_GG && WS_GG + (size_t)2 * MALL * RW * 2 <= WS_BON, "ws map 1");
static_assert(WS_BON + (size_t)2 * MALL * 32 * 4 <= WS_QN && WS_QN + (size_t)MALL * 512 * 2 <= WS_KVN && WS_KVN + (size_t)MALL * 256 * 2 <= WS_Q, "ws map 2");
static_assert(WS_Q + (size_t)NBATCH * NH * TPB * QKD * 2 <= WS_K && WS_K + (size_t)NBATCH * NH * TPB * QKD * 2 <= WS_V && WS_V + (size_t)NBATCH * NH * TPB * 64 * 2 <= WS_END, "ws map 3");
static_assert(WS_Y + (size_t)2 * MALL * RW * 2 <= WS_YA && WS_YA + (size_t)MALL * RW * 2 <= WS_YB && WS_YB + (size_t)MALL * RW * 2 <= WS_RI, "ws map 4");
static_assert(WS_T1 + (size_t)MALL * DM * 2 <= WS_T2 && WS_T2 + (size_t)MALL * DM * 2 <= WS_PU && WS_PU + (size_t)NEXP * DM * 2 <= WS_PV && WS_PV + (size_t)NEXP * DM * 2 <= WS_GG, "ws map 5");
static_assert(WS_SC + (size_t)MALL * DM * 4 <= WS_T1 && WS_X + (size_t)MALL * DM * 4 <= WS_H && WS_H + (size_t)MALL * DM * 2 <= WS_DYN, "ws map 6");
static_assert(WS_WINA + (size_t)NLAYER * INA_P * DM * 2 <= WS_X, "ws map 7");
constexpr size_t CTL_PROBE_OFF = 640 * 1024;
constexpr int CW_BAR = 4096;

constexpr int RING_BYTES = 131072;
constexpr int LDSCTL_OFF = RING_BYTES, MISC_OFF = LDSCTL_OFF + 320;
constexpr int LDS_BYTES = 147456;

#define GAS __attribute__((address_space(1)))
#define LAS __attribute__((address_space(3)))
typedef unsigned short bf16;
typedef unsigned v4u __attribute__((ext_vector_type(4)));
typedef unsigned v2u __attribute__((ext_vector_type(2)));
typedef float f32x4 __attribute__((ext_vector_type(4)));
typedef float f32x2 __attribute__((ext_vector_type(2)));
typedef float f32x16 __attribute__((ext_vector_type(16)));
typedef short bf16x8 __attribute__((ext_vector_type(8)));
typedef short s16x4 __attribute__((ext_vector_type(4)));
typedef __bf16 bf16x2v __attribute__((ext_vector_type(2)));
typedef __bf16 bf16x8v __attribute__((ext_vector_type(8)));
typedef GAS unsigned gu32;
#define RLX_AGENT __ATOMIC_RELAXED, __HIP_MEMORY_SCOPE_AGENT
#define LDS_WAIT() asm volatile("s_waitcnt lgkmcnt(0)" ::: "memory")
#define VM_WAIT() asm volatile("s_waitcnt vmcnt(0)" ::: "memory")
__device__ __forceinline__ unsigned f2bf(float f) { unsigned u = __builtin_bit_cast(unsigned, f); return (u + 0x7fffu + ((u >> 16) & 1u)) >> 16; }
__device__ __forceinline__ unsigned pk2(float lo, float hi) { return pg8::cvt_pk_bf16(lo, hi); }
__device__ __forceinline__ float bflo(unsigned w) { return __builtin_bit_cast(float, w << 16); }
__device__ __forceinline__ float bfhi(unsigned w) { return __builtin_bit_cast(float, w & 0xffff0000u); }
__device__ __forceinline__ float bf1(bf16 h) { return __builtin_bit_cast(float, (unsigned)h << 16); }
__device__ __forceinline__ float sigmoidf_(float x) { return __builtin_amdgcn_rcpf(1.0f + __expf(-x)); }
template <int CTRL> __device__ __forceinline__ float dpp_add(float x) {
    return x + __builtin_bit_cast(float, __builtin_amdgcn_update_dpp(0, __builtin_bit_cast(int, x), CTRL, 0xf, 0xf, true));
}
__device__ __forceinline__ float red16(float x) {
    x = dpp_add<0xB1>(x);
    x = dpp_add<0x4E>(x);
    x = dpp_add<0x141>(x);
    x = dpp_add<0x140>(x);
    return x;
}
template <int CTRL, int RM> __device__ __forceinline__ float dpp_max(float x) {
    return fmaxf(x, __builtin_bit_cast(float, __builtin_amdgcn_update_dpp(__builtin_bit_cast(int, x), __builtin_bit_cast(int, x), CTRL, RM, 0xf, false)));
}
template <int CTRL, int RM> __device__ __forceinline__ float dpp_sum(float x) {
    return x + __builtin_bit_cast(float, __builtin_amdgcn_update_dpp(0, __builtin_bit_cast(int, x), CTRL, RM, 0xf, false));
}
__device__ __forceinline__ float wave_max_u(float x) {
    x = dpp_max<0xB1, 0xf>(x); x = dpp_max<0x4E, 0xf>(x); x = dpp_max<0x141, 0xf>(x); x = dpp_max<0x140, 0xf>(x);
    x = dpp_max<0x142, 0xa>(x); x = dpp_max<0x143, 0xc>(x);
    return __builtin_bit_cast(float, __builtin_amdgcn_readlane(__builtin_bit_cast(int, x), 63));
}
__device__ __forceinline__ float wave_sum_u(float x) {
    x = dpp_sum<0xB1, 0xf>(x); x = dpp_sum<0x4E, 0xf>(x); x = dpp_sum<0x141, 0xf>(x); x = dpp_sum<0x140, 0xf>(x);
    x = dpp_sum<0x142, 0xa>(x); x = dpp_sum<0x143, 0xc>(x);
    return __builtin_bit_cast(float, __builtin_amdgcn_readlane(__builtin_bit_cast(int, x), 63));
}
__device__ __forceinline__ float wave_sum(float v) { return wave_sum_u(v); }
__device__ __forceinline__ float bpermf(int srclane, float v) { return __builtin_bit_cast(float, __builtin_amdgcn_ds_bpermute(srclane << 2, __builtin_bit_cast(int, v))); }
__device__ __forceinline__ int bpermi(int srclane, int v) { return __builtin_amdgcn_ds_bpermute(srclane << 2, v); }

#define XB_TMO      128
#define XB_XCNT(j)  (256  + 64 * (j))
#define XB_XSUB(j)  (1280 + 64 * (j))
#define XB_XGEN(j)  (2304 + 64 * (j))
#define XB_TOP      3328
#define XB_TOPGEN   3392
#define XCD_BAR_WORDS 3456
#define XB_SPIN_CAP (1u << 20)

__device__ __forceinline__ unsigned xb_ld(unsigned* p)              { return __hip_atomic_load(p, __ATOMIC_RELAXED, __HIP_MEMORY_SCOPE_AGENT); }
__device__ __forceinline__ unsigned xb_add(unsigned* p, unsigned v) { return __hip_atomic_fetch_add(p, v, __ATOMIC_RELAXED, __HIP_MEMORY_SCOPE_AGENT); }
__device__ __forceinline__ unsigned xb_xcc_id() { return (unsigned)__builtin_amdgcn_s_getreg((3 << 11) | 20) & 0xFu; }
#define XB_SPIN(cond, bar) do { unsigned _sp = 0; while (cond) { __builtin_amdgcn_s_sleep(1); \
    if ((++_sp & 255u) == 0u) { if (xb_ld(&(bar)[XB_TMO])) break; if (_sp > XB_SPIN_CAP) { atomicAdd(&(bar)[XB_TMO], 1u); break; } } } } while (0)

struct XcdBarrier { unsigned* bar; unsigned x; volatile LAS unsigned* st; };

__device__ __forceinline__ XcdBarrier xcd_barrier_post(unsigned* bar, volatile LAS unsigned* st, bool t0) {
    XcdBarrier b; b.bar = bar; b.x = xb_xcc_id(); b.st = st;
    if (t0) (void)xb_add(&bar[XB_XCNT(b.x)], 1u);
    return b;
}
__device__ __forceinline__ void xcd_barrier_complete(unsigned* bar, unsigned x, unsigned& nloc, unsigned& nx) {
    const unsigned G = gridDim.x * gridDim.y * gridDim.z;
    unsigned sum, cnt, mine, sp = 0u;
    for (;;) {
        sum = 0u; cnt = 0u; mine = 0u;
#pragma unroll
        for (unsigned j = 0; j < 16; ++j) { const unsigned c = xb_ld(&bar[XB_XCNT(j)]); sum += c; cnt += (c > 0u) ? 1u : 0u; mine = (j == x) ? c : mine; }
        if (sum == G) break;
        __builtin_amdgcn_s_sleep(1);
        if ((++sp & 255u) == 0u) { if (xb_ld(&bar[XB_TMO])) break; if (sp > XB_SPIN_CAP) { atomicAdd(&bar[XB_TMO], 1u); break; } }
    }
    nloc = mine > 0u ? mine : 1u; nx = cnt > 0u ? cnt : 1u;
}
__device__ __forceinline__ void xcd_barrier(const XcdBarrier& b, bool t0) {
    asm volatile("s_waitcnt vmcnt(0)" ::: "memory");
    __syncthreads();
    if (t0) {
        unsigned* bar = b.bar;
        __builtin_amdgcn_s_waitcnt(0);
        unsigned nloc = b.st[0], nx = b.st[1];
        if (nloc == 0u) { xcd_barrier_complete(bar, b.x, nloc, nx); b.st[0] = nloc; b.st[1] = nx; }
        const unsigned old = xb_add(&bar[XB_XSUB(b.x)], 1u);
        const unsigned gen = old / nloc;
        if (old + 1u == (gen + 1u) * nloc) {
            __builtin_amdgcn_fence(__ATOMIC_RELEASE, "agent");
            asm volatile("s_waitcnt vmcnt(0)" ::: "memory");
            const unsigned og = xb_add(&bar[XB_TOP], 1u);
            const unsigned tg = og / nx;
            if (og + 1u == (tg + 1u) * nx) xb_add(&bar[XB_TOPGEN], 1u);
            else XB_SPIN(xb_ld(&bar[XB_TOPGEN]) == tg, bar);
            __builtin_amdgcn_fence(__ATOMIC_ACQUIRE, "agent");
            xb_add(&bar[XB_XGEN(b.x)], 1u);
            asm volatile("s_waitcnt vmcnt(0)" ::: "memory");
        } else {
            XB_SPIN(xb_ld(&bar[XB_XGEN(b.x)]) == gen, bar);
            __builtin_amdgcn_fence(__ATOMIC_ACQUIRE, "agent");
            asm volatile("s_waitcnt vmcnt(0)" ::: "memory");
        }
    }
    __syncthreads();
}

struct Frame {
    LAS unsigned char* lds;
    unsigned char* ws;
    const float* const* in;
    int tid, lane, wave;
    int vcu, G;
};
struct Args { const float* in[33]; float* out; unsigned char* ws; int ph_lo, ph_hi; };


namespace pg8 {
typedef unsigned u32x4 __attribute__((ext_vector_type(4)));
struct RowOrder : StaticOrder {
    int lat;
    __host__ __device__ void init_rows(int lat_, int N, int G_, int c_) { lat = lat_; init(lat_ ? NBATCH * SEQ : MALL, N, G_, c_); }
    __host__ __device__ bool next(int i, Unit& u) const { if (!StaticOrder::next(i, u)) return false; if (lat) u.pm = 33 * (u.pm >> 5) + 1 + (u.pm & 31); return true; }
};
#define EPI_LOOP_ROWS for (int ai = 0; ai < 2; ++ai) _Pragma("unroll") for (int m = 0; m < 4; ++m)
#define EPI_PIN asm volatile("" ::: "memory")

struct EpiStoreBf16 {
    static constexpr bool PERM = true, AFTER_DRAIN = false;
    bf16_t* O; int ldc;
    __device__ __forceinline__ void operator()(const f32x4 (&acc)[2][2][4][2], const Unit& u, int wr, int wc, int fr, int fq) const {
        const int row0 = u.pm * BM + wr * 64 + fr, col0 = u.pn * BM + wc * 32 + 8 * fq;
#pragma unroll
        EPI_LOOP_ROWS { bf16_t* rowp = O + (size_t)(row0 + ai * HALF + m * 16) * ldc + col0;
#pragma unroll
            for (int bj = 0; bj < 2; ++bj) { const f32x4 v0 = acc[ai][bj][m][0], v1 = acc[ai][bj][m][1];
                u32x4 w; w.x = cvt_pk_bf16(v0[0], v0[1]); w.y = cvt_pk_bf16(v0[2], v0[3]); w.z = cvt_pk_bf16(v1[0], v1[1]); w.w = cvt_pk_bf16(v1[2], v1[3]);
                *(u32x4*)(rowp + bj * HALF) = w; } }
    }
};
struct EpiGate {
    static constexpr bool PERM = true, AFTER_DRAIN = false;
    bf16_t* O; int ldc; const float* bias;
    __device__ __forceinline__ void operator()(const f32x4 (&acc)[2][2][4][2], const Unit& u, int wr, int wc, int fr, int fq) const {
        const int row0 = u.pm * BM + wr * 64 + fr, col0 = u.pn * BM + wc * 32 + 8 * fq;
        f32x4 bv[2][2];
#pragma unroll
        for (int bj = 0; bj < 2; ++bj)
#pragma unroll
            for (int n = 0; n < 2; ++n) bv[bj][n] = *(const f32x4*)(bias + col0 + bj * HALF + 4 * n);
#pragma unroll
        EPI_LOOP_ROWS { EPI_PIN; bf16_t* rowp = O + (size_t)(row0 + ai * HALF + m * 16) * ldc + col0;
#pragma unroll
            for (int bj = 0; bj < 2; ++bj) { f32x4 v0 = acc[ai][bj][m][0] + bv[bj][0], v1 = acc[ai][bj][m][1] + bv[bj][1];
#pragma unroll
                for (int e = 0; e < 4; ++e) { v0[e] = __builtin_amdgcn_rcpf(1.0f + __expf(-v0[e])); v1[e] = __builtin_amdgcn_rcpf(1.0f + __expf(-v1[e])); }
                u32x4 w; w.x = cvt_pk_bf16(v0[0], v0[1]); w.y = cvt_pk_bf16(v0[2], v0[3]); w.z = cvt_pk_bf16(v1[0], v1[1]); w.w = cvt_pk_bf16(v1[2], v1[3]);
                *(u32x4*)(rowp + bj * HALF) = w; } }
    }
};
__device__ __forceinline__ float bf_lo(unsigned w) { return __builtin_bit_cast(float, w << 16); }
__device__ __forceinline__ float bf_hi(unsigned w) { return __builtin_bit_cast(float, w & 0xffff0000u); }
struct EpiMulAdd {
    static constexpr bool PERM = true, AFTER_DRAIN = false;
    bf16_t* O; const bf16_t* Gt; const bf16_t* Ad; int ldc;
    __device__ __forceinline__ void operator()(const f32x4 (&acc)[2][2][4][2], const Unit& u, int wr, int wc, int fr, int fq) const {
        const int row0 = u.pm * BM + wr * 64 + fr, col0 = u.pn * BM + wc * 32 + 8 * fq;
#pragma unroll
        EPI_LOOP_ROWS { EPI_PIN; const size_t ro = (size_t)(row0 + ai * HALF + m * 16) * ldc + col0;
#pragma unroll
            for (int bj = 0; bj < 2; ++bj) { const f32x4 v0 = acc[ai][bj][m][0], v1 = acc[ai][bj][m][1];
                const u32x4 g = *(const u32x4*)(Gt + ro + bj * HALF);
                float o[8];
                o[0] = bf_lo(g.x) * v0[0]; o[1] = bf_hi(g.x) * v0[1]; o[2] = bf_lo(g.y) * v0[2]; o[3] = bf_hi(g.y) * v0[3];
                o[4] = bf_lo(g.z) * v1[0]; o[5] = bf_hi(g.z) * v1[1]; o[6] = bf_lo(g.w) * v1[2]; o[7] = bf_hi(g.w) * v1[3];
                if (Ad) { const u32x4 a = *(const u32x4*)(Ad + ro + bj * HALF);
                    o[0] += bf_lo(a.x); o[1] += bf_hi(a.x); o[2] += bf_lo(a.y); o[3] += bf_hi(a.y); o[4] += bf_lo(a.z); o[5] += bf_hi(a.z); o[6] += bf_lo(a.w); o[7] += bf_hi(a.w); }
                u32x4 w; w.x = cvt_pk_bf16(o[0], o[1]); w.y = cvt_pk_bf16(o[2], o[3]); w.z = cvt_pk_bf16(o[4], o[5]); w.w = cvt_pk_bf16(o[6], o[7]);
                *(u32x4*)(O + ro + bj * HALF) = w; } }
    }
};
struct EpiResid {
    static constexpr bool PERM = false, AFTER_DRAIN = false;
    float* X; const float* gate;
    const float* xin; const float* cin;
    __device__ __forceinline__ void operator()(const f32x4 (&acc)[2][2][4][2], const Unit& u, int wr, int wc, int fr, int fq) const {
        const int row0 = u.pm * BM + wr * 64 + fr, col0 = u.pn * BM + wc * 32 + 4 * fq;
        const int bb = u.pm / 33, pt = u.pm - bb * 33, mr = (pt == 0) ? 2 : bb;
        const float* gp = gate + (size_t)mr * 12288 + col0;
        const float* sbase = xin ? (pt == 0 ? cin + (size_t)bb * CTXL * DM : xin + ((size_t)bb * SEQ + (size_t)(pt - 1) * BM) * DM) : X + (size_t)u.pm * BM * DM;
        f32x4 gv[2][2];
#pragma unroll
        for (int bj = 0; bj < 2; ++bj)
#pragma unroll
            for (int n = 0; n < 2; ++n) gv[bj][n] = *(const f32x4*)(gp + bj * HALF + n * 16);
#pragma unroll
        EPI_LOOP_ROWS { EPI_PIN; const int rl = wr * 64 + fr + ai * HALF + m * 16; float* rowp = X + (size_t)(u.pm * BM + rl) * DM + col0; const float* srow = sbase + (size_t)rl * DM + col0;
#pragma unroll
            for (int bj = 0; bj < 2; ++bj)
#pragma unroll
                for (int n = 0; n < 2; ++n) *(f32x4*)(rowp + bj * HALF + n * 16) = *(const f32x4*)(srow + bj * HALF + n * 16) + gv[bj][n] * acc[ai][bj][m][n]; }
    }
};
struct EpiF32 {
    static constexpr bool PERM = false, AFTER_DRAIN = false;
    float* C; int ldc;
    __device__ __forceinline__ void operator()(const f32x4 (&acc)[2][2][4][2], const Unit& u, int wr, int wc, int fr, int fq) const {
        const int row0 = u.pm * BM + wr * 64 + fr, col0 = u.pn * BM + wc * 32 + 4 * fq;
#pragma unroll
        EPI_LOOP_ROWS { float* rowp = C + (size_t)(row0 + ai * HALF + m * 16) * ldc + col0;
#pragma unroll
            for (int bj = 0; bj < 2; ++bj)
#pragma unroll
                for (int n = 0; n < 2; ++n) *(f32x4*)(rowp + bj * HALF + n * 16) = acc[ai][bj][m][n]; }
    }
};
struct EpiQ {
    static constexpr bool PERM = true, AFTER_DRAIN = false;
    bf16_t* Q; const f32x2* rope; float qscale;
    __device__ __forceinline__ void operator()(const f32x4 (&acc)[2][2][4][2], const Unit& u, int wr, int wc, int fr, int fq) const {
        const int bb = u.pm / 33, tp0 = (u.pm - bb * 33) * BM + wr * 64 + fr, col0 = u.pn * BM + wc * 32 + 8 * fq;
#pragma unroll
        for (int bj = 0; bj < 2; ++bj) { const int c = col0 + bj * HALF, hd = c / QKD, d = c - hd * QKD;
#pragma unroll
            EPI_LOOP_ROWS { EPI_PIN; const int tp = tp0 + ai * HALF + m * 16;
                f32x4 v0 = acc[ai][bj][m][0], v1 = acc[ai][bj][m][1];
                if (d >= 64) { const int i0 = (d - 64) >> 1; const f32x2* rp = rope + (size_t)tp * 16 + i0;
                    const f32x2 c0 = rp[0], c1 = rp[1], c2 = rp[2], c3 = rp[3];
                    float a, b;
                    a = v0[0]; b = v0[1]; v0[0] = a * c0.x - b * c0.y; v0[1] = a * c0.y + b * c0.x;
                    a = v0[2]; b = v0[3]; v0[2] = a * c1.x - b * c1.y; v0[3] = a * c1.y + b * c1.x;
                    a = v1[0]; b = v1[1]; v1[0] = a * c2.x - b * c2.y; v1[1] = a * c2.y + b * c2.x;
                    a = v1[2]; b = v1[3]; v1[2] = a * c3.x - b * c3.y; v1[3] = a * c3.y + b * c3.x; }
                v0 = v0 * qscale; v1 = v1 * qscale;
                u32x4 w; w.x = cvt_pk_bf16(v0[0], v0[1]); w.y = cvt_pk_bf16(v0[2], v0[3]); w.z = cvt_pk_bf16(v1[0], v1[1]); w.w = cvt_pk_bf16(v1[2], v1[3]);
                *(u32x4*)(Q + ((size_t)(bb * NH + hd) * TPB + tp) * QKD + d) = w; } }
    }
};
struct EpiKV {
    static constexpr bool PERM = true, AFTER_DRAIN = false;
    bf16_t* K; bf16_t* V;
    __device__ __forceinline__ void operator()(const f32x4 (&acc)[2][2][4][2], const Unit& u, int wr, int wc, int fr, int fq) const {
        const int bb = u.pm / 33, tp0 = (u.pm - bb * 33) * BM + wr * 64 + fr;
        const bool isK = wc < 2;
        bf16_t* base = isK ? K : V; const int pitch = isK ? QKD : 64, doff = 32 * (wc & 1) + 8 * fq;
#pragma unroll
        for (int bj = 0; bj < 2; ++bj) { const int hd = 2 * u.pn + bj;
            bf16_t* hb = base + (size_t)(bb * NH + hd) * TPB * pitch;
#pragma unroll
            EPI_LOOP_ROWS { EPI_PIN; const int tp = tp0 + ai * HALF + m * 16;
                const f32x4 v0 = acc[ai][bj][m][0], v1 = acc[ai][bj][m][1];
                u32x4 w; w.x = cvt_pk_bf16(v0[0], v0[1]); w.y = cvt_pk_bf16(v0[2], v0[3]); w.z = cvt_pk_bf16(v1[0], v1[1]); w.w = cvt_pk_bf16(v1[2], v1[3]);
                *(u32x4*)((char*)hb + (unsigned)((tp * pitch + doff) * 2)) = w; } }
    }
};
}

struct TItem { const float* W; bf16* WT; int K, ldw, c0, N, mapq, item; };
__device__ __forceinline__ void p0_item_load(const TItem& T, int lane, f32x4 (&x)[8]) {
    const int nblk = T.N / 32, kb = T.item / nblk, nb = T.item - kb * nblk, k0 = 64 * kb, n0 = 32 * nb;
    const float* p = T.W + (size_t)(k0 + (lane >> 3)) * T.ldw + T.c0 + n0 + (lane & 7) * 4;
#pragma unroll
    for (int i = 0; i < 8; ++i) x[i] = *(const GAS f32x4*)(p + (size_t)(8 * i) * T.ldw);
}
__device__ __forceinline__ void p0_item_finish(const TItem& T, const f32x4 (&x)[8], LAS float* scr, int lane) {
    const int nblk = T.N / 32, kb = T.item / nblk, nb = T.item - kb * nblk, k0 = 64 * kb, n0 = 32 * nb;
#pragma unroll
    for (int i = 0; i < 8; ++i) { LAS float* d = scr + (8 * i + (lane >> 3)) * 33 + (lane & 7) * 4; d[0] = x[i].x; d[1] = x[i].y; d[2] = x[i].z; d[3] = x[i].w; }
    LDS_WAIT(); asm volatile("" ::: "memory");
    const int c = lane & 7;
#pragma unroll
    for (int j = 0; j < 4; ++j) { const int n = (lane >> 3) + 8 * j; const LAS float* s = scr + (8 * c) * 33 + n;
        v4u o; o.x = pk2(s[0 * 33], s[1 * 33]); o.y = pk2(s[2 * 33], s[3 * 33]); o.z = pk2(s[4 * 33], s[5 * 33]); o.w = pk2(s[6 * 33], s[7 * 33]);
        int nn = n0 + n;
        if (T.mapq) { const int hd = nn / QKD, d = nn - hd * QKD; if (d >= 64) { const int i = (d - 64) & 15, s2 = (d - 64) >> 4; nn = hd * QKD + 64 + 2 * i + s2; } }
        *(GAS v4u*)(T.WT + (size_t)nn * T.K + k0 + 8 * c) = o; }
    LDS_WAIT(); asm volatile("" ::: "memory");
}

__device__ __forceinline__ const float* karg(int i);
constexpr int TB_INA = (DM / 128) * ((INA + 127) / 128), TB_G = (DM / 128) * (DM / 128), TB_BR = (RW / 128) * (DM / 128), TB_UQ = (512 / 128) * (NQ / 128), TB_UKV = (256 / 128) * (NKV / 128);
constexpr int TB_N = TB_INA + 2 * TB_G + 2 * TB_BR + TB_G + TB_UQ + TB_UKV;
constexpr int TI_LR = 1 * (RW / 32), TI_N = 4 * TI_LR;
__device__ __forceinline__ TItem p0_resolve_big(unsigned char* ws, int git) {
    const int l = git / TB_N; int r = git - l * TB_N; TItem T; T.mapq = 0; T.c0 = 0;
    if (r < TB_INA) { T.W = karg(7) + (size_t)l * DM * INC; T.K = DM; T.ldw = INC; T.N = INA; T.WT = (bf16*)(ws + WS_WINA) + (size_t)l * INA_P * DM; T.item = r; return T; } r -= TB_INA;
    if (r < TB_G) { T.W = karg(7) + (size_t)l * DM * INC; T.K = DM; T.ldw = INC; T.c0 = INA; T.N = DM; T.WT = (bf16*)(ws + WS_WGA) + (size_t)l * DM * DM; T.item = r; return T; } r -= TB_G;
    if (r < TB_G) { T.W = karg(7) + (size_t)l * DM * INC; T.K = DM; T.ldw = INC; T.c0 = INA + DM; T.N = DM; T.WT = (bf16*)(ws + WS_WGB) + (size_t)l * DM * DM; T.item = r; return T; } r -= TB_G;
    if (r < TB_BR) { T.W = karg(24) + (size_t)l * RW * DM; T.K = RW; T.ldw = DM; T.N = DM; T.WT = (bf16*)(ws + WS_WA) + (size_t)l * DM * RW; T.item = r; return T; } r -= TB_BR;
    if (r < TB_BR) { T.W = karg(25) + (size_t)l * RW * DM; T.K = RW; T.ldw = DM; T.N = DM; T.WT = (bf16*)(ws + WS_WB) + (size_t)l * DM * RW; T.item = r; return T; } r -= TB_BR;
    if (r < TB_G) { T.W = karg(26) + (size_t)l * DM * DM; T.K = DM; T.ldw = DM; T.N = DM; T.WT = (bf16*)(ws + WS_WO) + (size_t)l * DM * DM; T.item = r; return T; } r -= TB_G;
    if (r < TB_UQ) { T.W = karg(21) + (size_t)l * 512 * NQ; T.K = 512; T.ldw = NQ; T.N = NQ; T.WT = (bf16*)(ws + WS_WUQ) + (size_t)l * NQ * 512; T.item = r; T.mapq = 1; return T; } r -= TB_UQ;
    { T.W = karg(23) + (size_t)l * 256 * NKV; T.K = 256; T.ldw = NKV; T.N = NKV; T.WT = (bf16*)(ws + WS_WUKV) + (size_t)l * NKV * 256; T.item = r; return T; }
}
__device__ __forceinline__ void p0_big_load(const TItem& T, int tid, f32x4 (&x)[8]) {
    const int nblk = (T.N + 127) / 128, kb = T.item / nblk, nb = T.item - kb * nblk, k0 = 128 * kb, col = 128 * nb + (tid & 31) * 4;
    const float* p = T.W + (size_t)(k0 + (tid >> 5)) * T.ldw + T.c0 + col; const bool ok = col < T.N;
#pragma unroll
    for (int i = 0; i < 8; ++i) x[i] = ok ? *(const GAS f32x4*)(p + (size_t)(16 * i) * T.ldw) : (f32x4){0.f, 0.f, 0.f, 0.f};
}
__device__ __forceinline__ void p0_big_finish(const TItem& T, const f32x4 (&x)[8], LAS float* tile, int tid) {
    const int nblk = (T.N + 127) / 128, kb = T.item / nblk, nb = T.item - kb * nblk, k0 = 128 * kb, n0 = 128 * nb;
    __syncthreads();
#pragma unroll
    for (int i = 0; i < 8; ++i) *(LAS f32x4*)(tile + ((tid >> 5) + 16 * i) * 132 + (tid & 31) * 4) = x[i];
    __syncthreads();
    const int n = tid & 127, cg = tid >> 7; int nn = n0 + n;
    if (nn < T.N) {
        if (T.mapq) { const int hd = nn / QKD, d = nn - hd * QKD; if (d >= 64) { const int i = (d - 64) & 15, s2 = (d - 64) >> 4; nn = hd * QKD + 64 + 2 * i + s2; } }
#pragma unroll
        for (int c = 0; c < 4; ++c) { const LAS float* s = tile + (32 * cg + 8 * c) * 132 + n;
            v4u o; o.x = pk2(s[0 * 132], s[1 * 132]); o.y = pk2(s[2 * 132], s[3 * 132]); o.z = pk2(s[4 * 132], s[5 * 132]); o.w = pk2(s[6 * 132], s[7 * 132]);
            *(GAS v4u*)(T.WT + (size_t)nn * T.K + k0 + 32 * cg + 8 * c) = o; } }
}
__device__ __forceinline__ TItem p0_resolve(unsigned char* ws, int git) {
    const int l = git / TI_N; int r = git - l * TI_N; TItem T; T.mapq = 0; T.c0 = 0;
    const int which = r / TI_LR, d = which & 1, isa = which >> 1; r -= which * TI_LR;
    T.W = (isa ? karg(13) : karg(11)) + (size_t)(l * 2 + d) * 64 * RW; T.K = 64; T.ldw = RW; T.N = RW; T.WT = (bf16*)(ws + (isa ? WS_AUP : WS_WUP)) + (size_t)(l * 2 + d) * RW * 64; T.item = r; return T;
}
__device__ __forceinline__ void p0_prologue(Frame& F) {
    LAS float* scr = (LAS float*)(F.lds + F.wave * 16384);
    const int gw = F.vcu * NWAVES + F.wave, NGW = F.G * NWAVES;
    unsigned char* ws = F.ws;
    for (int rp_ = 0; rp_ < (DBG_REPEAT == 102 ? 2 : 1); ++rp_)
    { float* modw = (float*)(ws + WS_CTL + CTL_MOD_OFF); const float* adaw = karg(4); const float* adab = karg(5); const float* cin = karg(1); const float* cctx = karg(3);
      LAS float* SIL = (LAS float*)F.lds;
      LAS f32x2* part = (LAS f32x2*)(F.lds + 32768);
      if (F.vcu < NLAYER * 96) {
          for (int i = F.tid; i < 3 * DM; i += 512) { const int r = i >> 11, k = i & 2047; const float c = r < 2 ? cin[r * DM + k] : cctx[k]; SIL[i] = c / (1.f + __expf(-c)); }
          __syncthreads(); }
      for (int uu = F.vcu; uu < NLAYER * 96; uu += F.G) { const int cb = uu % 96, l = uu / 96;
          const int n0 = cb * 128 + F.lane * 2; const float* aw = adaw + (size_t)l * DM * 12288 + n0;
          f32x2 a0 = {0, 0}, a1 = a0, a2 = a0;
#pragma unroll 1
          for (int k0 = F.wave * 256; k0 < F.wave * 256 + 256; k0 += 16) { f32x2 w[16];
#pragma unroll
              for (int j = 0; j < 16; ++j) w[j] = *(const GAS f32x2*)(aw + (size_t)(k0 + j) * 12288);
#pragma unroll
              for (int j = 0; j < 16; ++j) { a0 = a0 + w[j] * SIL[k0 + j]; a1 = a1 + w[j] * SIL[DM + k0 + j]; a2 = a2 + w[j] * SIL[2 * DM + k0 + j]; } }
          __syncthreads();
          part[(F.wave * 3 + 0) * 64 + F.lane] = a0; part[(F.wave * 3 + 1) * 64 + F.lane] = a1; part[(F.wave * 3 + 2) * 64 + F.lane] = a2;
          __syncthreads();
          if (F.wave < 3) { f32x2 s = *(const GAS f32x2*)(adab + (size_t)l * 12288 + n0);
#pragma unroll
              for (int w8 = 0; w8 < 8; ++w8) s = s + part[(w8 * 3 + F.wave) * 64 + F.lane];
              *(GAS f32x2*)(modw + ((size_t)l * 3 + F.wave) * 12288 + n0) = s; }
          __syncthreads(); } }
    for (int rp_ = 0; rp_ < (DBG_REPEAT == 101 ? 2 : 1); ++rp_)
    { unsigned* ctr = (unsigned*)(ws + WS_CTL) + 2048 + 64 * rp_; LAS float* tile = (LAS float*)F.lds; LAS int* slot = (LAS int*)(F.lds + 128 * 132 * 4);
#define P0_GRAB(dst) do { __syncthreads(); if (F.tid == 0) *slot = (int)__hip_atomic_fetch_add(ctr, 1u, __ATOMIC_RELAXED, __HIP_MEMORY_SCOPE_AGENT); __syncthreads(); dst = *slot; } while (0)
      int it; P0_GRAB(it); f32x4 xa[8], xb[8]; TItem T, Tn;
      if (it < NLAYER * TB_N) { T = p0_resolve_big(ws, it); p0_big_load(T, F.tid, xa); }
      while (it < NLAYER * TB_N) { int itn; P0_GRAB(itn); const bool more = itn < NLAYER * TB_N;
          if (more) { Tn = p0_resolve_big(ws, itn); p0_big_load(Tn, F.tid, xb); }
          p0_big_finish(T, xa, tile, F.tid);
          if (more) { T = Tn;
#pragma unroll
              for (int i = 0; i < 8; ++i) xa[i] = xb[i]; }
          it = itn; }
#undef P0_GRAB
      __syncthreads();
      for (int itw = gw; itw < NLAYER * TI_N; itw += NGW) { f32x4 xw[8]; const TItem Tw = p0_resolve(ws, itw); p0_item_load(Tw, F.lane, xw); p0_item_finish(Tw, xw, scr, F.lane); }
    }
    const int gt = gw * 64 + F.lane, NGT = NGW * 64;
    { const float* gup = karg(14);
    for (int i = gt; i < NLAYER * 2 * 32 * RW; i += NGT) { const int ch = i & 1023, r = (i >> 10) & 31, ld = i >> 15;
        ((bf16*)(ws + WS_GUP))[((size_t)ld * RW + ch) * 32 + r] = (bf16)f2bf(gup[i]); } }
    for (int i = gt; i < NLAYER * (INA_P - INA) * DM / 8; i += NGT) { const int l = i / ((INA_P - INA) * DM / 8), r = i - l * ((INA_P - INA) * DM / 8);
        ((GAS v4u*)((bf16*)(ws + WS_WINA) + ((size_t)l * INA_P + INA) * DM))[r] = (v4u){0u, 0u, 0u, 0u}; }
    { f32x2* rt = (f32x2*)(ws + WS_ROPE);
      for (int i = gt; i < TPB * 16; i += NGT) { const int tp = i >> 4, k = i & 15; f32x2 o = {1.f, 0.f};
          if (tp >= CTXL) { const int t = tp - CTXL, row = t >> 6, col = t & 63, j = k & 7; const float fr = powf(10000.0f, -(float)j / 8.0f);
              const float ang = (float)(k < 8 ? row : col) * fr; o.x = cosf(ang); o.y = sinf(ang); }
          rt[i] = o; } }
    for (int rp_ = 0; rp_ < (DBG_REPEAT == 103 ? 2 : 1); ++rp_)
    { LAS float* KEY = (LAS float*)F.lds;
      LAS float* WQT = (LAS float*)(F.lds + 65536);
      const float* pkeys = karg(29); const float* pwq = karg(28);
      __syncthreads();
      for (int uu = F.vcu; uu < NLAYER * 16 * 32; uu += F.G) { const int kb = uu & 31, hp = (uu >> 5) & 15, l = uu >> 9;
          const GAS f32x4* ksrc = (const GAS f32x4*)(pkeys + ((size_t)l * 16 + hp) * 16384);
          for (int i = F.tid; i < 4096; i += 512) ((LAS f32x4*)KEY)[i] = ksrc[i];
          for (int i = F.tid; i < 2048; i += 512) { const int kk = i >> 5, d4 = i & 31;
              *(LAS f32x4*)(WQT + kk * 132 + d4 * 4) = *(const GAS f32x4*)(pwq + ((size_t)l * DM + kb * 64 + kk) * DM + hp * 128 + d4 * 4); }
          __syncthreads();
          const int kq = F.tid & 15, keyq = F.tid >> 4;
          float acc[4][4];
#pragma unroll
          for (int j = 0; j < 4; ++j)
#pragma unroll
              for (int i = 0; i < 4; ++i) acc[j][i] = 0.f;
          for (int d = 0; d < 128; d += 4) { f32x4 w[4], q[4];
#pragma unroll
              for (int i = 0; i < 4; ++i) w[i] = *(LAS f32x4*)(WQT + (kq + 16 * i) * 132 + d);
#pragma unroll
              for (int j = 0; j < 4; ++j) q[j] = *(LAS f32x4*)(KEY + (4 * keyq + j) * 128 + d);
#pragma unroll
              for (int j = 0; j < 4; ++j)
#pragma unroll
                  for (int i = 0; i < 4; ++i) acc[j][i] += q[j].x * w[i].x + q[j].y * w[i].y + q[j].z * w[i].z + q[j].w * w[i].w; }
          bf16* dst = (bf16*)(ws + WS_WQK) + ((size_t)l * DM + hp * 128 + 4 * keyq) * DM + kb * 64 + kq;
#pragma unroll
          for (int j = 0; j < 4; ++j)
#pragma unroll
              for (int i = 0; i < 4; ++i) dst[(size_t)j * DM + 16 * i] = (bf16)f2bf(acc[j][i]);
          __syncthreads(); } }
}

__device__ __forceinline__ void modnorm_phase(Frame& F, const float* X, const float* g, const float* mod  , int chunk_sh, bf16* H, int skip_ctx, const float* xin = nullptr, const float* cin = nullptr) {
    const int gw = F.vcu * NWAVES + F.wave, NGW = F.G * NWAVES;
    for (int m = gw; m < MALL; m += NGW) {
        const int b = m / TPB, tp = m - b * TPB; if (skip_ctx && tp < CTXL) continue;
        const int mr = tp < CTXL ? 2 : b;
        const float* srow = xin ? (tp < CTXL ? cin + ((size_t)b * CTXL + tp) * DM : xin + ((size_t)b * SEQ + (tp - CTXL)) * DM) : X + (size_t)m * DM;
        const GAS f32x4* xr = (const GAS f32x4*)srow + F.lane;
        f32x4 v[8]; float s = 0.f;
#pragma unroll
        for (int j = 0; j < 8; ++j) { v[j] = xr[64 * j]; s += (v[j].x * v[j].x + v[j].y * v[j].y) + (v[j].z * v[j].z + v[j].w * v[j].w); }
        const float rs = rsqrtf(wave_sum(s) * (1.f / DM) + NORM_EPS);
        const float* sh = mod + (size_t)mr * 12288 + chunk_sh * DM; const float* sc = sh + DM;
        GAS v2u* o8 = (GAS v2u*)(H + (size_t)m * DM) + F.lane;
#pragma unroll
        for (int j = 0; j < 8; ++j) { const int c = (F.lane + 64 * j) * 4;
            const f32x4 gg = *(const GAS f32x4*)(g + c), s1 = *(const GAS f32x4*)(sc + c), s0 = *(const GAS f32x4*)(sh + c);
            f32x4 y = v[j] * rs * gg; y = y * (s1 + 1.0f) + s0;
            v2u o; o.x = pk2(y.x, y.y); o.y = pk2(y.z, y.w); o8[64 * j] = o; }
    }
}

typedef float f32x4v __attribute__((ext_vector_type(4)));
#define MFMA16(a, b, c) __builtin_amdgcn_mfma_f32_16x16x32_bf16((a), (b), (c), 0, 0, 0)
#define MFMA32(a, b, c) __builtin_amdgcn_mfma_f32_32x32x16_bf16((a), (b), (c), 0, 0, 0)

struct FeatP {
    const bf16* PA; const float* mu; const float* w0; const float* a0; const float* k_k; const float* k_a; const float* r_k;
    const bf16* WUP; const bf16* AUP; const bf16* GUP;
    const float* qnorm; const float* kvnorm; const f32x2* rope;
    bf16* RI; bf16* GG; float* BON; bf16* QN; bf16* KVN; bf16* K;
};
__device__ __forceinline__ f32x4 ld4bf(const bf16* p) { const v2u w = *(const GAS v2u*)p; return (f32x4){bflo(w.x), bfhi(w.x), bflo(w.y), bfhi(w.y)}; }
__device__ __forceinline__ f32x4 mix4(const bf16* PA, int m, int c, bool hp, bool hn, const float* mu) {
    const f32x4 pc = ld4bf(PA + (size_t)m * INA_P + c);
    f32x4 pp = {0, 0, 0, 0}, pn = {0, 0, 0, 0};
    if (hp) pp = ld4bf(PA + (size_t)(m - 1) * INA_P + c);
    if (hn) pn = ld4bf(PA + (size_t)(m + 1) * INA_P + c);
    const f32x4 mm = *(const GAS f32x4*)(mu + c);
    return pc + ((pp + pn) * 0.5f - pc) * mm;
}
__device__ __forceinline__ void unpack8(const v4u w, float (&x)[8]) { x[0] = bflo(w.x); x[1] = bfhi(w.x); x[2] = bflo(w.y); x[3] = bfhi(w.y); x[4] = bflo(w.z); x[5] = bfhi(w.z); x[6] = bflo(w.w); x[7] = bfhi(w.w); }
__device__ __forceinline__ v4u pack8f(const float (&x)[8]) { v4u o; o.x = pk2(x[0], x[1]); o.y = pk2(x[2], x[3]); o.z = pk2(x[4], x[5]); o.w = pk2(x[6], x[7]); return o; }
__device__ __forceinline__ void mix8(const bf16* rowc, bool hp, bool hn, const float (&mu)[8], float (&o)[8]) {
    const v4u zc = {0u, 0u, 0u, 0u};
    const v4u wc = *(const GAS v4u*)rowc, wp = hp ? *(const GAS v4u*)(rowc - INA_P) : zc, wn = hn ? *(const GAS v4u*)(rowc + INA_P) : zc;
    float c[8], p[8], n[8]; unpack8(wc, c); unpack8(wp, p); unpack8(wn, n);
#pragma unroll
    for (int e = 0; e < 8; ++e) o[e] = c[e] + (0.5f * (p[e] + n[e]) - c[e]) * mu[e];
}
struct Raw3 { v4u c, p, n; };
__device__ __forceinline__ Raw3 load3(const bf16* rowc, bool hp, bool hn) { const v4u zc = {0u, 0u, 0u, 0u}; Raw3 r; r.c = *(const GAS v4u*)rowc; r.p = hp ? *(const GAS v4u*)(rowc - INA_P) : zc; r.n = hn ? *(const GAS v4u*)(rowc + INA_P) : zc; return r; }
__device__ __forceinline__ void mix8r(const Raw3& w, const float (&mu)[8], float (&o)[8]) {
    float c[8], p[8], n[8]; unpack8(w.c, c); unpack8(w.p, p); unpack8(w.n, n);
#pragma unroll
    for (int e = 0; e < 8; ++e) o[e] = c[e] + (0.5f * (p[e] + n[e]) - c[e]) * mu[e];
}
__device__ __forceinline__ void features_phase(Frame& F, const FeatP& P) {
    constexpr int LAP = 328;
    LAS bf16* LA = (LAS bf16*)F.lds;
    LAS float* SSQ = (LAS float*)(F.lds + 10752);
    LAS float* PRM = (LAS float*)(F.lds + 12288);
    const int lane = F.lane, w = F.wave, tk = lane & 15, q4 = lane >> 4;
    constexpr int NTILE = MALL / 16, NTG = 64;
    for (int su = F.vcu; su < 4 * NTG; su += F.G) {
        const int cg = su & 3, tg = su >> 2, cw = 256 * cg + 32 * w, ch8 = cw + 8 * q4, hd = 4 * cg + (w >> 1);
        __syncthreads();
        for (int i = F.tid; i < 2560; i += 512) { const int prm = i >> 8, c = (i & 255) + 256 * cg; float v;
            switch (prm) { case 0: v = P.k_k[c]; break; case 1: v = P.k_a[c]; break; case 2: v = P.r_k[c]; break; case 3: v = P.w0[c]; break; case 4: v = P.w0[RW + c]; break;
                           case 5: v = P.a0[c]; break; case 6: v = P.a0[RW + c]; break; case 7: v = P.mu[c]; break; case 8: v = P.mu[RW + c]; break; default: v = P.mu[2 * RW + c]; break; }
            PRM[i] = v; }
        bf16x8 fw[2][2][2], fa[2][2][2], fg[2][2];
        { const int chA = cw + 8 * (tk >> 2) + (tk & 3);
#pragma unroll
          for (int d = 0; d < 2; ++d)
#pragma unroll
              for (int t = 0; t < 2; ++t) {
#pragma unroll
                  for (int ks = 0; ks < 2; ++ks) { fw[d][t][ks] = *(const GAS bf16x8*)(P.WUP + ((size_t)d * RW + chA + 4 * t) * 64 + ks * 32 + q4 * 8); fa[d][t][ks] = *(const GAS bf16x8*)(P.AUP + ((size_t)d * RW + chA + 4 * t) * 64 + ks * 32 + q4 * 8); }
                  fg[d][t] = *(const GAS bf16x8*)(P.GUP + ((size_t)d * RW + chA + 4 * t) * 32 + q4 * 8); } }
        for (int tt = tg; tt < NTILE; tt += NTG) {
            const int m0 = tt * 16;
            const int m = m0 + tk, b = m / TPB, tp = m - b * TPB;
            const bool hp = (tp != 0) && (tp != CTXL), hn = (tp != CTXL - 1) && (tp != TPB - 1);
            const bf16* rowp = P.PA + (size_t)m * INA_P + ch8;
            const Raw3 rawk = load3(rowp + RW, hp, hn), rawr = load3(rowp, hp, hn), rawv = load3(rowp + 2 * RW, hp, hn);
            __syncthreads();
            for (int it = F.tid; it < 640; it += 512) { const int tkk = it / 40, c8 = (it - tkk * 40) * 8, c = C_WD + c8, m = m0 + tkk, tp = m % TPB;
                const bool hp = (tp != 0) && (tp != CTXL), hn = (tp != CTXL - 1) && (tp != TPB - 1);
                float mu[8], v[8];
                { const f32x4 a = *(const GAS f32x4*)(P.mu + c), b2 = *(const GAS f32x4*)(P.mu + c + 4); mu[0] = a.x; mu[1] = a.y; mu[2] = a.z; mu[3] = a.w; mu[4] = b2.x; mu[5] = b2.y; mu[6] = b2.z; mu[7] = b2.w; }
                mix8(P.PA + (size_t)m * INA_P + c, hp, hn, mu, v);
#pragma unroll
                for (int e = 0; e < 8; ++e) { if (c < C_AD) v[e] = 1.0f - 2.0f * __builtin_amdgcn_rcpf(1.0f + __expf(2.0f * v[e])); else if (c >= C_GD) v[e] = sigmoidf_(v[e]); }
                *(LAS v4u*)(LA + tkk * LAP + c8) = pack8f(v); }
            if ((tt & 3) == cg) {
#pragma unroll
                for (int t2 = 0; t2 < 2; ++t2) { const int m = m0 + 2 * w + t2, b = m / TPB, tp = m - b * TPB; const bf16* row = P.PA + (size_t)m * INA_P;
                    { float x[8]; unpack8(*(const GAS v4u*)(row + C_QC + lane * 8), x); float s = 0.f;
#pragma unroll
                      for (int e = 0; e < 8; ++e) s += x[e] * x[e];
                      const float rs = rsqrtf(wave_sum(s) * (1.f / 512.f) + NORM_EPS);
#pragma unroll
                      for (int e = 0; e < 8; ++e) x[e] = x[e] * rs * P.qnorm[lane * 8 + e];
                      *(GAS v4u*)(P.QN + (size_t)m * 512 + lane * 8) = pack8f(x); }
                    { const v2u q = *(const GAS v2u*)(row + C_KVC + lane * 4);
                      float x[4] = {bflo(q.x), bfhi(q.x), bflo(q.y), bfhi(q.y)}; float s = 0.f;
#pragma unroll
                      for (int e = 0; e < 4; ++e) s += x[e] * x[e];
                      const float rs = rsqrtf(wave_sum(s) * (1.f / 256.f) + NORM_EPS);
#pragma unroll
                      for (int e = 0; e < 4; ++e) x[e] = x[e] * rs * P.kvnorm[lane * 4 + e];
                      v2u o; o.x = pk2(x[0], x[1]); o.y = pk2(x[2], x[3]);
                      *(GAS v2u*)(P.KVN + (size_t)m * 256 + lane * 4) = o; }
                    if (lane < 16) { const float x1 = bf1(row[C_KR + lane]), x2 = bf1(row[C_KR + 16 + lane]); const f32x2 cs = P.rope[(size_t)tp * 16 + lane];
                        const unsigned o = pk2(x1 * cs.x - x2 * cs.y, x1 * cs.y + x2 * cs.x);
#pragma unroll
                        for (int h2 = 0; h2 < NH; ++h2) *(GAS unsigned*)(P.K + ((size_t)(b * NH + h2) * TPB + tp) * QKD + 64 + 2 * lane) = o; } } }
            const int pc = 32 * w + 8 * q4;
            float prm[8], kmx[8], kx[8];
#pragma unroll
            for (int e = 0; e < 8; ++e) prm[e] = PRM[8 * 256 + pc + e];
            mix8r(rawk, prm, kmx);
            { float s = 0.f;
#pragma unroll
              for (int e = 0; e < 8; ++e) { kx[e] = kmx[e] * PRM[0 * 256 + pc + e]; s += kx[e] * kx[e]; }
              s += bpermf(lane ^ 16, s); s += bpermf(lane ^ 32, s);
              if (q4 == 0) SSQ[tk * 8 + w] = s; }
            __syncthreads();
            const float rsn = rsqrtf(SSQ[tk * 8 + w] + SSQ[tk * 8 + (w ^ 1)] + 1e-12f);
            f32x4 cw_[2][2], ca_[2][2], cg_[2][2];
#pragma unroll
            for (int d = 0; d < 2; ++d) {
                const bf16x8 bg = *(const LAS bf16x8*)(LA + tk * LAP + 256 + d * 32 + q4 * 8);
                bf16x8 bw[2], ba[2];
#pragma unroll
                for (int ks = 0; ks < 2; ++ks) { bw[ks] = *(const LAS bf16x8*)(LA + tk * LAP + d * 64 + ks * 32 + q4 * 8); ba[ks] = *(const LAS bf16x8*)(LA + tk * LAP + 128 + d * 64 + ks * 32 + q4 * 8); }
#pragma unroll
                for (int t = 0; t < 2; ++t) { f32x4 z = {0, 0, 0, 0};
                    cw_[d][t] = MFMA16(fw[d][t][1], bw[1], MFMA16(fw[d][t][0], bw[0], z));
                    ca_[d][t] = MFMA16(fa[d][t][1], ba[1], MFMA16(fa[d][t][0], ba[0], z));
                    cg_[d][t] = MFMA16(fg[d][t], bg, z); } }
            float r8[8], v8[8], kk8[8];
#pragma unroll
            for (int e = 0; e < 8; ++e) prm[e] = PRM[7 * 256 + pc + e];
            mix8r(rawr, prm, r8);
#pragma unroll
            for (int e = 0; e < 8; ++e) prm[e] = PRM[9 * 256 + pc + e];
            mix8r(rawv, prm, v8);
#pragma unroll
            for (int e = 0; e < 8; ++e) kk8[e] = kx[e] * rsn;
            bf16* rec = P.RI + ((size_t)(b * NH + hd) * TPB + tp) * RREC + (ch8 & 63);
            *(GAS v4u*)(rec) = pack8f(r8); *(GAS v4u*)(rec + 64) = pack8f(kk8); *(GAS v4u*)(rec + 128) = pack8f(v8);
#pragma unroll
            for (int d = 0; d < 2; ++d) {
                float ld[8], ke[8], bb[8], gg[8]; float bs = 0.f;
#pragma unroll
                for (int e = 0; e < 8; ++e) { const int t = e >> 2, r = e & 3;
                    ld[e] = -0.60653066f * sigmoidf_(PRM[(3 + d) * 256 + pc + e] + cw_[d][t][r]);
                    const float aa = sigmoidf_(PRM[(5 + d) * 256 + pc + e] + ca_[d][t][r]);
                    ke[e] = kmx[e] * (1.0f + (aa - 1.0f) * PRM[1 * 256 + pc + e]); bb[e] = kk8[e] * aa; gg[e] = cg_[d][t][r];
                    bs += r8[e] * ke[e] * PRM[2 * 256 + pc + e]; }
                *(GAS v4u*)(rec + (3 + 3 * d) * 64) = pack8f(ld); *(GAS v4u*)(rec + (4 + 3 * d) * 64) = pack8f(bb); *(GAS v4u*)(rec + (5 + 3 * d) * 64) = pack8f(ke);
                *(GAS v4u*)(P.GG + ((size_t)d * MALL + m) * RW + ch8) = pack8f(gg);
                bs += bpermf(lane ^ 16, bs); bs += bpermf(lane ^ 32, bs);
                if (q4 == 0) P.BON[((size_t)d * MALL + m) * 32 + 2 * hd + (w & 1)] = bs; }
        }
    }
}

__device__ __forceinline__ void cvt_row_load(f32x4 (&x)[8], const float* src) {
#pragma unroll
    for (int q = 0; q < 8; ++q) x[q] = *(const GAS f32x4*)(src + q * 4);
}
__device__ __forceinline__ void cvt_row_store(const f32x4 (&x)[8], unsigned char* dst, float* scale_slot, int lane) {
    float am = 0.f;
#pragma unroll
    for (int q = 0; q < 8; ++q) am = fmaxf(am, fmaxf(fmaxf(fabsf(x[q].x), fabsf(x[q].y)), fmaxf(fabsf(x[q].z), fabsf(x[q].w))));
    am = fmaxf(wave_max_u(am), 1e-30f);
    const float g = 6.0f / am, inv = am * (1.0f / 6.0f);
    v4u o;
#pragma unroll
    for (int q = 0; q < 4; ++q) { unsigned w = 0u;
        w = __builtin_amdgcn_cvt_scalef32_pk_fp4_f32(w, x[2 * q].x * g, x[2 * q].y * g, 1.0f, 0);
        w = __builtin_amdgcn_cvt_scalef32_pk_fp4_f32(w, x[2 * q].z * g, x[2 * q].w * g, 1.0f, 1);
        w = __builtin_amdgcn_cvt_scalef32_pk_fp4_f32(w, x[2 * q + 1].x * g, x[2 * q + 1].y * g, 1.0f, 2);
        w = __builtin_amdgcn_cvt_scalef32_pk_fp4_f32(w, x[2 * q + 1].z * g, x[2 * q + 1].w * g, 1.0f, 3);
        o[q] = w; }
    *(GAS v4u*)dst = o;
    if (lane == 0) *scale_slot = inv;
}
struct ScanCvt { const float* pu; const float* pv; unsigned char* PU8; unsigned char* PV8; float* SU; float* SV; };
constexpr int SCH = 32;
constexpr int SSTEP = 6 * 64;
__device__ __forceinline__ int scan_tp(int dir, int s) { return dir == 0 ? s : (s < CTXL ? (CTXL - 1 - s) : (TPB - 1 - (s - CTXL))); }
__device__ __forceinline__ void scan_load(v4u (&rg)[6], const bf16* RIh, int dir, int chunk, int htid) {
    const int tp = scan_tp(dir, chunk * SCH + (htid >> 3));
    const bf16* rec = RIh + (size_t)tp * RREC + (htid & 7) * 8;
#pragma unroll
    for (int i = 0; i < 3; ++i) rg[i] = *(const GAS v4u*)(rec + i * 64);
    rec += (3 + 3 * dir) * 64;
#pragma unroll
    for (int i = 0; i < 3; ++i) rg[3 + i] = *(const GAS v4u*)(rec + i * 64);
}
__device__ __forceinline__ void scan_store(const v4u (&rg)[6], LAS float* buf, int htid) {
    LAS float* d0 = buf + (htid >> 3) * SSTEP + (htid & 7) * 8;
#pragma unroll
    for (int i = 0; i < 6; ++i) { constexpr int SLOT[6] = {4, 0, 5, 2, 1, 3};
        const v4u wv = rg[i];
        f32x4 lo = {bflo(wv.x), bfhi(wv.x), bflo(wv.y), bfhi(wv.y)}, hi = {bflo(wv.z), bfhi(wv.z), bflo(wv.w), bfhi(wv.w)};
        if (i == 3) {
#pragma unroll
            for (int e = 0; e < 4; ++e) { lo[e] = __expf(lo[e]); hi[e] = __expf(hi[e]); } }
        LAS float* d = d0 + SLOT[i] * 64;
        *(LAS f32x4*)d = lo; *(LAS f32x4*)(d + 4) = hi; }
}
__device__ __forceinline__ void scan_phase(Frame& F, const bf16* RI, bf16* Y, const ScanCvt& C) {
    LAS float* bufs = (LAS float*)F.lds;
    constexpr int NCH = TPB / SCH;
    for (int uu = F.vcu; uu < NBATCH * NH * 2 * 4; uu += F.G) {
        const int rg = uu & 3, dir = (uu >> 2) & 1, hd = (uu >> 3) & 15, b = uu >> 7;
        const bf16* RIh = RI + (size_t)(b * NH + hd) * TPB * RREC;
        const int htid = F.tid - 256;
        v4u ra[6], rb[6];
        f32x4 xc[8];
        __syncthreads();
        if (F.wave >= 4) { scan_load(rb, RIh, dir, 0, htid); scan_load(ra, RIh, dir, 1, htid); scan_store(rb, bufs, htid); scan_load(rb, RIh, dir, 2, htid); }
        __syncthreads();
        const int j = F.lane & 15, rowl = F.lane >> 4, row = rg * 16 + (F.wave & 3) * 4 + rowl;
        f32x2 S01 = {0.f, 0.f}, S23 = {0.f, 0.f};
        bf16* yb = Y + ((size_t)dir * MALL + (size_t)b * TPB) * RW + hd * 64 + row;
        for (int c = 0; c < NCH; ++c) {
            LAS float* cur = bufs + (c & 1) * (SCH * SSTEP);
            if (F.wave >= 4) {
                if (c + 1 < NCH) {
                    if ((c & 1) == 0) { scan_store(ra, bufs + (SCH * SSTEP), htid); if (c + 3 < NCH) scan_load(ra, RIh, dir, c + 3, htid); }
                    else { scan_store(rb, bufs, htid); if (c + 3 < NCH) scan_load(rb, RIh, dir, c + 3, htid); }  }
                if ((c & 3) == 0 && (c >> 3) < 32) { const int r = uu * 4 + (F.wave - 4) + 1024 * (c >> 3);
                    if ((c & 7) == 0) cvt_row_load(xc, ((r >= NEXP) ? C.pv + (size_t)(r - NEXP) * DM : C.pu + (size_t)r * DM) + F.lane * 32);
                    else cvt_row_store(xc, ((r >= NEXP) ? C.PV8 + (size_t)(r - NEXP) * (DM / 2) : C.PU8 + (size_t)r * (DM / 2)) + F.lane * 16, (r >= NEXP) ? C.SV + (r - NEXP) : C.SU + r, F.lane); } }
            else {
#pragma unroll
                for (int h16 = 0; h16 < 2; ++h16) {
                    const LAS float* sp = cur + (h16 * 16) * SSTEP;
                    f32x4 kk = *(const LAS f32x4*)(sp + 4 * j), bb = *(const LAS f32x4*)(sp + 64 + 4 * j), ww = *(const LAS f32x4*)(sp + 128 + 4 * j),
                          ke = *(const LAS f32x4*)(sp + 192 + 4 * j), rr = *(const LAS f32x4*)(sp + 256 + 4 * j);
                    float vv = sp[320 + row], ykeep = 0.f, ypart = 0.f;
#pragma unroll
                    for (int st = 0; st < 16; ++st) {
                        f32x4 nkk = kk, nbb = bb, nww = ww, nke = ke, nrr = rr; float nvv = vv;
                        if (st + 1 < 16) { const LAS float* sn = sp + (st + 1) * SSTEP;
                            nkk = *(const LAS f32x4*)(sn + 4 * j); nbb = *(const LAS f32x4*)(sn + 64 + 4 * j); nww = *(const LAS f32x4*)(sn + 128 + 4 * j);
                            nke = *(const LAS f32x4*)(sn + 192 + 4 * j); nrr = *(const LAS f32x4*)(sn + 256 + 4 * j); nvv = sn[320 + row]; }
                        f32x2 t2 = S01 * kk.xy; t2 = S23 * kk.zw + t2;
                        const float p = t2.x + t2.y;
                        S01 = S01 * ww.xy + ke.xy * vv; S23 = S23 * ww.zw + ke.zw * vv;
                        const float sa = -red16(p);
                        S01 = bb.xy * sa + S01; S23 = bb.zw * sa + S23;
                        if (st > 0) { const float y = red16(ypart); ykeep = (j == st - 1) ? y : ykeep; }
                        f32x2 u2 = S01 * rr.xy; u2 = S23 * rr.zw + u2;
                        ypart = u2.x + u2.y;
                        kk = nkk; bb = nbb; ww = nww; ke = nke; rr = nrr; vv = nvv;
                        __builtin_amdgcn_sched_barrier(0);
                    }
                    { const float y = red16(ypart); ykeep = (j == 15) ? y : ykeep; }
                    const int tp = scan_tp(dir, c * SCH + h16 * 16 + j);
                    *(GAS bf16*)(yb + (size_t)tp * RW) = (bf16)f2bf(ykeep);
                }
            }
            __syncthreads();
        }
    }
}

constexpr int AKP = 208, AVP = 192;
constexpr int ATILE = 64 * AKP + 64 * AVP;
__device__ __forceinline__ bf16x8 pack8(const f32x16& x, int s) {
    v4u p; p.x = pk2(x[8 * s + 0], x[8 * s + 1]); p.y = pk2(x[8 * s + 2], x[8 * s + 3]); p.z = pk2(x[8 * s + 4], x[8 * s + 5]); p.w = pk2(x[8 * s + 6], x[8 * s + 7]);
    return __builtin_bit_cast(bf16x8, p);
}
__device__ __forceinline__ void attn_phase(Frame& F, const bf16* Q, const bf16* K, const bf16* V, bf16* YB, int with_ctx) {
    const int lane = F.lane, half = lane >> 5, l31 = lane & 31, l16 = lane & 15, g1 = (lane >> 4) & 1;
    const int nunits = NBATCH * NH * 32 + (with_ctx ? NBATCH * NH : 0);
    for (int uu = F.vcu; uu < nunits; uu += F.G) {
        int bh, q0, nkt;
        if (uu < NBATCH * NH * 32) { bh = uu >> 5; q0 = CTXL + (uu & 31) * 256; nkt = TPB / 64; } else { bh = uu - NBATCH * NH * 32; q0 = 0; nkt = CTXL / 64; }
        const bf16* Kh = K + (size_t)bh * TPB * QKD; const bf16* Vh = V + (size_t)bh * TPB * 64; const bf16* Qh = Q + (size_t)bh * TPB * QKD;
        const int tq = q0 + F.wave * 32 + l31;
        bf16x8 qf[6];
#pragma unroll
        for (int ks = 0; ks < 6; ++ks) qf[ks] = *(const GAS bf16x8*)(Qh + (size_t)tq * QKD + 16 * ks + 8 * half);
        f32x16 o0, o1;
#pragma unroll
        for (int i = 0; i < 16; ++i) { o0[i] = 0.f; o1[i] = 0.f; }
        float l_run = 0.f;
        f32x16 cinit;
#pragma unroll
        for (int i = 0; i < 16; ++i) cinit[i] = 0.f;
        asm volatile("" : "+v"(cinit));
        const int kc1 = F.tid + 512; const bool k1ok = kc1 < 768;
        const unsigned kd0 = (unsigned)((F.tid / 12) * AKP + (F.tid % 12) * 16), kd1 = (unsigned)((kc1 / 12) * AKP + (kc1 % 12) * 16), vd = (unsigned)(64 * AKP + (F.tid >> 3) * AVP + (F.tid & 7) * 16);
        v4u kr0, kr1 = {0, 0, 0, 0}, vr;
        kr0 = *(const GAS v4u*)(Kh + (size_t)F.tid * 8); if (k1ok) kr1 = *(const GAS v4u*)(Kh + (size_t)kc1 * 8); vr = *(const GAS v4u*)(Vh + (size_t)F.tid * 8);
        __syncthreads();
        *(LAS v4u*)(F.lds + kd0) = kr0; if (k1ok) *(LAS v4u*)(F.lds + kd1) = kr1; *(LAS v4u*)(F.lds + vd) = vr;
        __syncthreads();
        for (int kt = 0; kt < nkt; ++kt) {
            const bool more = kt + 1 < nkt;
            if (more) { const bf16* kn = Kh + (size_t)(kt + 1) * 64 * QKD; const bf16* vn = Vh + (size_t)(kt + 1) * 64 * 64;
                kr0 = *(const GAS v4u*)(kn + (size_t)F.tid * 8); if (k1ok) kr1 = *(const GAS v4u*)(kn + (size_t)kc1 * 8); vr = *(const GAS v4u*)(vn + (size_t)F.tid * 8); }
            LAS unsigned char* Kb = F.lds + (kt & 1) * ATILE; LAS unsigned char* Vb = Kb + 64 * AKP;
            f32x16 s0, s1;
            { bf16x8 ka[6], kb2[6];
#pragma unroll
              for (int ks = 0; ks < 6; ++ks) { ka[ks] = *(const LAS bf16x8*)(Kb + l31 * AKP + (16 * ks + 8 * half) * 2); kb2[ks] = *(const LAS bf16x8*)(Kb + (32 + l31) * AKP + (16 * ks + 8 * half) * 2); }
              s0 = MFMA32(ka[0], qf[0], cinit); s1 = MFMA32(kb2[0], qf[0], cinit);
#pragma unroll
              for (int ks = 1; ks < 6; ++ks) { s0 = MFMA32(ka[ks], qf[ks], s0); s1 = MFMA32(kb2[ks], qf[ks], s1); }
              __builtin_amdgcn_sched_group_barrier(0x100, 12, 0); __builtin_amdgcn_sched_group_barrier(0x8, 12, 0); }
            bf16x8 va[2][2][2];
#pragma unroll
            for (int t = 0; t < 2; ++t)
#pragma unroll
                for (int s = 0; s < 2; ++s) { const int kb = 32 * t + 16 * s + 4 * half + (l16 >> 2);
#pragma unroll
                    for (int dvt = 0; dvt < 2; ++dvt) { const LAS unsigned char* vp = Vb + kb * AVP + (32 * dvt + 16 * g1 + 4 * (l16 & 3)) * 2;
                        const s16x4 lo = __builtin_amdgcn_ds_read_tr16_b64_v4i16((LAS s16x4*)vp), hi = __builtin_amdgcn_ds_read_tr16_b64_v4i16((LAS s16x4*)(vp + 8 * AVP));
                        va[t][s][dvt] = __builtin_shufflevector(lo, hi, 0, 1, 2, 3, 4, 5, 6, 7); } }
            __builtin_amdgcn_sched_group_barrier(0x100, 16, 0);
            float mx = s0[0];
#pragma unroll
            for (int i = 1; i < 16; ++i) mx = fmaxf(mx, s0[i]);
#pragma unroll
            for (int i = 0; i < 16; ++i) mx = fmaxf(mx, s1[i]);
            mx = fmaxf(mx, bpermf(lane ^ 32, mx));
            if (kt == 0 || __any(mx > 8.0f)) {
                const float d = (kt == 0) ? mx : fmaxf(mx, 0.f), alpha = (kt == 0) ? 1.0f : __builtin_amdgcn_exp2f(-d);
                l_run *= alpha;
#pragma unroll
                for (int i = 0; i < 16; ++i) { o0[i] *= alpha; o1[i] *= alpha; s0[i] -= d; s1[i] -= d; cinit[i] -= d; }
                asm volatile("" : "+v"(cinit));
            }
#pragma unroll
            for (int i = 0; i < 16; ++i) { s0[i] = __builtin_amdgcn_exp2f(s0[i]); s1[i] = __builtin_amdgcn_exp2f(s1[i]); }
            float ps = 0.f;
#pragma unroll
            for (int i = 0; i < 16; ++i) ps += s0[i] + s1[i];
            l_run += ps;
            { bf16x8 pf[2][2];
#pragma unroll
              for (int t = 0; t < 2; ++t)
#pragma unroll
                  for (int s = 0; s < 2; ++s) pf[t][s] = pack8(t == 0 ? s0 : s1, s);
#pragma unroll
              for (int t = 0; t < 2; ++t)
#pragma unroll
                  for (int s = 0; s < 2; ++s) { o0 = MFMA32(va[t][s][0], pf[t][s], o0); o1 = MFMA32(va[t][s][1], pf[t][s], o1); } }
            if (more) { LAS unsigned char* nb = F.lds + ((kt + 1) & 1) * ATILE;
                *(LAS v4u*)(nb + kd0) = kr0; if (k1ok) *(LAS v4u*)(nb + kd1) = kr1; *(LAS v4u*)(nb + vd) = vr; }
            __syncthreads();
        }
        const float linv = (DBG_SKIP & 4) ? 0.f : 1.0f / (l_run + bpermf(lane ^ 32, l_run));
        const int b = bh >> 4, hd = bh & 15;
        bf16* op = YB + ((size_t)b * TPB + tq) * RW + hd * 64 + 4 * half;
#pragma unroll
        for (int g = 0; g < 4; ++g) {
            v2u w; w.x = pk2(o0[4 * g] * linv, o0[4 * g + 1] * linv); w.y = pk2(o0[4 * g + 2] * linv, o0[4 * g + 3] * linv); *(GAS v2u*)(op + 8 * g) = w;
            w.x = pk2(o1[4 * g] * linv, o1[4 * g + 1] * linv); w.y = pk2(o1[4 * g + 2] * linv, o1[4 * g + 3] * linv); *(GAS v2u*)(op + 32 + 8 * g) = w; }
    }
}

__device__ __forceinline__ void readout_phase(Frame& F, const bf16* Y, const bf16* GG, const float* BON, const bf16* RI, const float* ln_w, const float* ln_b, bf16* YA) {
    const int gw = F.vcu * NWAVES + F.wave, NGW = F.G * NWAVES, lane = F.lane, hd = lane >> 2, ch0 = hd * 64 + (lane & 3) * 16;
    for (int m = gw; m < MALL; m += NGW) {
        const int b = m / TPB, tp = m - b * TPB;
        const bf16* rec = RI + ((size_t)(b * NH + hd) * TPB + tp) * RREC + 128 + (lane & 3) * 16;
        float vv[16], out[16];
        { const v4u a = *(const GAS v4u*)rec, c = *(const GAS v4u*)(rec + 8);
          vv[0] = bflo(a.x); vv[1] = bfhi(a.x); vv[2] = bflo(a.y); vv[3] = bfhi(a.y); vv[4] = bflo(a.z); vv[5] = bfhi(a.z); vv[6] = bflo(a.w); vv[7] = bfhi(a.w);
          vv[8] = bflo(c.x); vv[9] = bfhi(c.x); vv[10] = bflo(c.y); vv[11] = bfhi(c.y); vv[12] = bflo(c.z); vv[13] = bfhi(c.z); vv[14] = bflo(c.w); vv[15] = bfhi(c.w); }
#pragma unroll
        for (int e = 0; e < 16; ++e) out[e] = 0.f;
#pragma unroll
        for (int d = 0; d < 2; ++d) {
            const bf16* yp = Y + ((size_t)d * MALL + m) * RW + ch0; const bf16* gp = GG + ((size_t)d * MALL + m) * RW + ch0;
            float y[16], g[16];
            { const v4u a = *(const GAS v4u*)yp, c = *(const GAS v4u*)(yp + 8);
              y[0] = bflo(a.x); y[1] = bfhi(a.x); y[2] = bflo(a.y); y[3] = bfhi(a.y); y[4] = bflo(a.z); y[5] = bfhi(a.z); y[6] = bflo(a.w); y[7] = bfhi(a.w);
              y[8] = bflo(c.x); y[9] = bfhi(c.x); y[10] = bflo(c.y); y[11] = bfhi(c.y); y[12] = bflo(c.z); y[13] = bfhi(c.z); y[14] = bflo(c.w); y[15] = bfhi(c.w); }
            { const v4u a = *(const GAS v4u*)gp, c = *(const GAS v4u*)(gp + 8);
              g[0] = bflo(a.x); g[1] = bfhi(a.x); g[2] = bflo(a.y); g[3] = bfhi(a.y); g[4] = bflo(a.z); g[5] = bfhi(a.z); g[6] = bflo(a.w); g[7] = bfhi(a.w);
              g[8] = bflo(c.x); g[9] = bfhi(c.x); g[10] = bflo(c.y); g[11] = bfhi(c.y); g[12] = bflo(c.z); g[13] = bfhi(c.z); g[14] = bflo(c.w); g[15] = bfhi(c.w); }
            float s = 0.f;
#pragma unroll
            for (int e = 0; e < 16; ++e) s += y[e];
            s = dpp_add<0xB1>(s); s = dpp_add<0x4E>(s);
            const float mean = s * (1.f / 64.f); float q = 0.f;
#pragma unroll
            for (int e = 0; e < 16; ++e) { y[e] -= mean; q += y[e] * y[e]; }
            q = dpp_add<0xB1>(q); q = dpp_add<0x4E>(q);
            const float rstd = rsqrtf(q * (1.f / 64.f) + 64e-5f), bon = BON[((size_t)d * MALL + m) * 32 + 2 * hd] + BON[((size_t)d * MALL + m) * 32 + 2 * hd + 1];
#pragma unroll
            for (int e = 0; e < 16; ++e) out[e] += (y[e] * rstd * ln_w[ch0 + e] + ln_b[ch0 + e] + bon * vv[e]) * g[e];
        }
        if (DBG_SKIP & 2) {
#pragma unroll
            for (int e = 0; e < 16; ++e) out[e] = 0.f; }
        v4u o0, o1;
        o0.x = pk2(out[0], out[1]); o0.y = pk2(out[2], out[3]); o0.z = pk2(out[4], out[5]); o0.w = pk2(out[6], out[7]);
        o1.x = pk2(out[8], out[9]); o1.y = pk2(out[10], out[11]); o1.z = pk2(out[12], out[13]); o1.w = pk2(out[14], out[15]);
        *(GAS v4u*)(YA + (size_t)m * RW + ch0) = o0; *(GAS v4u*)(YA + (size_t)m * RW + ch0 + 8) = o1;
    }
}


__device__ __forceinline__ unsigned f2key(float f) { const unsigned u = __builtin_bit_cast(unsigned, f); return (u & 0x80000000u) ? ~u : (u | 0x80000000u); }
__device__ __forceinline__ float key2f(unsigned k) { const unsigned u = (k & 0x80000000u) ? (k & 0x7fffffffu) : ~k; return __builtin_bit_cast(float, u); }
template <int CTRL, int RM> __device__ __forceinline__ unsigned dpp_umax(unsigned x) {
    const unsigned y = (unsigned)__builtin_amdgcn_update_dpp(0, (int)x, CTRL, RM, 0xf, false); return x > y ? x : y; }
__device__ __forceinline__ unsigned row_umax(unsigned x) { x = dpp_umax<0xB1, 0xf>(x); x = dpp_umax<0x4E, 0xf>(x); x = dpp_umax<0x141, 0xf>(x); x = dpp_umax<0x140, 0xf>(x); return x; }
#define SEL_CE(a_, b_) do { const unsigned hi_ = (a_) > (b_) ? (a_) : (b_), lo_ = (a_) > (b_) ? (b_) : (a_); (a_) = hi_; (b_) = lo_; } while (0)
__device__ __forceinline__ void sel_keys8(unsigned (&k)[8], const float* p, int id0) {
    const f32x4 v0 = *(const GAS f32x4*)p, v1 = *(const GAS f32x4*)(p + 4);
    k[0] = (f2key(v0.x) & ~127u) | (unsigned)(id0 + 0); k[1] = (f2key(v0.y) & ~127u) | (unsigned)(id0 + 1); k[2] = (f2key(v0.z) & ~127u) | (unsigned)(id0 + 2); k[3] = (f2key(v0.w) & ~127u) | (unsigned)(id0 + 3);
    k[4] = (f2key(v1.x) & ~127u) | (unsigned)(id0 + 4); k[5] = (f2key(v1.y) & ~127u) | (unsigned)(id0 + 5); k[6] = (f2key(v1.z) & ~127u) | (unsigned)(id0 + 6); k[7] = (f2key(v1.w) & ~127u) | (unsigned)(id0 + 7);
    SEL_CE(k[0], k[1]); SEL_CE(k[2], k[3]); SEL_CE(k[4], k[5]); SEL_CE(k[6], k[7]); SEL_CE(k[0], k[2]); SEL_CE(k[1], k[3]); SEL_CE(k[4], k[6]); SEL_CE(k[5], k[7]); SEL_CE(k[1], k[2]); SEL_CE(k[5], k[6]);
    SEL_CE(k[0], k[4]); SEL_CE(k[1], k[5]); SEL_CE(k[2], k[6]); SEL_CE(k[3], k[7]); SEL_CE(k[2], k[4]); SEL_CE(k[3], k[5]); SEL_CE(k[1], k[2]); SEL_CE(k[3], k[4]); SEL_CE(k[5], k[6]);
}
__device__ __forceinline__ void top16_rows2(const float* pa, const float* pb, int l16, unsigned& ra, unsigned& rb) {
    unsigned ka[8], kb[8]; sel_keys8(ka, pa + 8 * l16, 8 * l16); sel_keys8(kb, pb + 8 * l16, 8 * l16);
    ra = 0u; rb = 0u;
#pragma unroll
    for (int it = 0; it < 16; ++it) {
        const unsigned ma = row_umax(ka[0]), mb = row_umax(kb[0]); const bool oa = ka[0] == ma, ob = kb[0] == mb;
#pragma unroll
        for (int e = 0; e < 7; ++e) { ka[e] = oa ? ka[e + 1] : ka[e]; kb[e] = ob ? kb[e + 1] : kb[e]; }
        ka[7] = oa ? 0u : ka[7]; kb[7] = ob ? 0u : kb[7];
        ra = (l16 == it) ? ma : ra; rb = (l16 == it) ? mb : rb;
    }
}
struct SelP { const float* SC; int* ESEL; float* EGATE; int last; };
__device__ __forceinline__ void select_phase(Frame& F, const SelP& P) {
    const int gw = F.vcu * NWAVES + F.wave, NGW = F.G * NWAVES, lane = F.lane, row = lane >> 4, l16 = lane & 15, rbase = lane & 48;
    const int i1 = (int)((0x3332222211111111ull >> (4 * l16)) & 15ull), j1 = (int)((0x2104321076543210ull >> (4 * l16)) & 15ull), i2 = (int)((0xdcba987766554443ull >> (4 * l16)) & 15ull), j2 = (int)((0x0000001010102103ull >> (4 * l16)) & 15ull);
    for (int m = gw; m < MALL; m += NGW) {
        bool tok = true; int tp = 0; if (tok) { tp = m % TPB; if (P.last && tp < CTXL) tok = false; }
        if (tok) {
            const float* srow = P.SC + (size_t)m * DM;
#pragma unroll 1
            for (int G = 0; G < 2; ++G) {
                const float* hrow = srow + (4 * G + row) * 256;
                unsigned recA, recB; top16_rows2(hrow, hrow + 128, l16, recA, recB);
                const float va = key2f(recA & ~127u), vb = key2f(recB & ~127u);
                const float a0 = bpermf(rbase, va), a1 = bpermf(rbase + i1, va), b1 = bpermf(rbase + j1, vb), a2 = bpermf(rbase + i2, va), b2 = bpermf(rbase + j2, vb), a3 = bpermf(rbase + 14 + (l16 & 1), va), b0 = bpermf(rbase, vb);
                unsigned ck[4];
                ck[0] = (f2key(a0 + vb) & ~255u) | (unsigned)l16; ck[1] = (f2key(a1 + b1) & ~255u) | (unsigned)(16 * i1 + j1); ck[2] = (f2key(a2 + b2) & ~255u) | (unsigned)(16 * i2 + j2);
                ck[3] = (l16 < 2) ? ((f2key(a3 + b0) & ~255u) | (unsigned)(16 * (14 + l16))) : 0u;
                SEL_CE(ck[0], ck[1]); SEL_CE(ck[2], ck[3]); SEL_CE(ck[0], ck[2]); SEL_CE(ck[1], ck[3]); SEL_CE(ck[1], ck[2]);
                unsigned rec = 0u;
#pragma unroll
                for (int it = 0; it < 16; ++it) {
                    const unsigned mh = row_umax(ck[0]); const bool own = ck[0] == mh;
                    ck[0] = own ? ck[1] : ck[0]; ck[1] = own ? ck[2] : ck[1]; ck[2] = own ? ck[3] : ck[2]; ck[3] = own ? 0u : ck[3];
                    rec = (l16 == it) ? mh : rec;
                }
                const float ts = key2f(rec & ~255u), tmax = bpermf(rbase, ts);
                const float ev = __expf(ts - tmax), esum = red16(ev);
                const int ci = (int)((rec >> 4) & 15u), cj = (int)(rec & 15u);
                const int expert = bpermi(rbase + ci, (int)(recA & 127u)) * 128 + bpermi(rbase + cj, (int)(recB & 127u));
                const int slot = (4 * G + row) * 16 + l16; P.ESEL[(size_t)m * 128 + slot] = expert; P.EGATE[(size_t)m * 128 + slot] = ev / esum;
            }
        }
    }
}
struct PeerP { const float* nmod; const float* ng; bf16* Hout;   const int* ESEL; const float* EGATE; const bf16* H; const unsigned char* PU; const unsigned char* PV; const float* SU; const float* SV; float* X; const float* mod;   const float* fin_g; float* out; int last; int dry; };
__device__ __forceinline__ void peer_phase(Frame& F, const PeerP& P) {
    const int gw = F.vcu * NWAVES + F.wave, NGW = F.G * NWAVES, lane = F.lane;
    float pr_s2 = 0.f, pr_d2 = 0.f, pr_tg = 0.f, pr_n = 0.f;
    for (int m = gw; m < MALL; m += NGW) {
        const int b = m / TPB, tp = m - b * TPB; if (P.last && tp < CTXL) continue;
        const int mr = tp < CTXL ? 2 : b;
        const int emask_ = (P.dry & 2) ? 1023 : 0x7fffffff;
        const int eidx[2] = {P.ESEL[(size_t)m * 128 + lane] & emask_, P.ESEL[(size_t)m * 128 + 64 + lane] & emask_}; const float egate[2] = {P.EGATE[(size_t)m * 128 + lane], P.EGATE[(size_t)m * 128 + 64 + lane]};
        typedef int v8i __attribute__((ext_vector_type(8)));
        LAS unsigned char* hq = F.lds + F.wave * 4096;
        { const v4u a0 = *(const GAS v4u*)(P.H + (size_t)m * DM + lane * 32), a1 = *(const GAS v4u*)(P.H + (size_t)m * DM + lane * 32 + 8), a2 = *(const GAS v4u*)(P.H + (size_t)m * DM + lane * 32 + 16), a3 = *(const GAS v4u*)(P.H + (size_t)m * DM + lane * 32 + 24);
          const v4u hv[4] = {a0, a1, a2, a3}; v4u o[2];
#pragma unroll
          for (int j = 0; j < 4; ++j) { int w0 = 0, w1 = 0;
              w0 = __builtin_amdgcn_cvt_pk_fp8_f32(bflo(hv[j].x), bfhi(hv[j].x), w0, false); w0 = __builtin_amdgcn_cvt_pk_fp8_f32(bflo(hv[j].y), bfhi(hv[j].y), w0, true);
              w1 = __builtin_amdgcn_cvt_pk_fp8_f32(bflo(hv[j].z), bfhi(hv[j].z), w1, false); w1 = __builtin_amdgcn_cvt_pk_fp8_f32(bflo(hv[j].w), bfhi(hv[j].w), w1, true);
              o[j >> 1][2 * (j & 1)] = (unsigned)w0; o[j >> 1][2 * (j & 1) + 1] = (unsigned)w1; }
          *(LAS v4u*)(hq + lane * 32) = o[0]; *(LAS v4u*)(hq + lane * 32 + 16) = o[1];
          unsigned z_ = 0u; asm volatile("" : "+v"(z_));
          if (lane < 2) *(LAS v4u*)(hq + 2048 + lane * 16) = (v4u){z_, z_, z_, z_}; }
        const int li = lane & 15, kb = lane >> 4;
        int rowoff[8];
#pragma unroll
        for (int g = 0; g < 8; ++g) rowoff[g] = bpermi(16 * (g & 3) + li, eidx[g >> 2]) * (DM / 2) + 16 * kb;
        f32x4 dacc[8];
#pragma unroll
        for (int g = 0; g < 8; ++g) dacc[g] = (f32x4){0.f, 0.f, 0.f, 0.f};
        const unsigned hb = (li == 0) ? (unsigned)(16 * kb) : 2048u;
        const unsigned hb2 = (li == 0) ? 64u : 16u;
        const unsigned hstep = (li == 0) ? 128u : 0u;
        v4u ua[8], ub[8];
#pragma unroll
        for (int g = 0; g < 8; ++g) ua[g] = *(const GAS v4u*)(P.PU + (unsigned)rowoff[g]);
#pragma unroll 1
        for (int s = 0; s < ((P.dry & 4) ? 2 : 16); s += 2) {
#pragma unroll
            for (int g = 0; g < 8; ++g) ub[g] = *(const GAS v4u*)(P.PU + (unsigned)(rowoff[g] + 64 * (s + 1)));
            { const v4u b0 = *(const LAS v4u*)(hq + hb + hstep * s), b1 = *(const LAS v4u*)(hq + hb + hstep * s + hb2);
              const v8i bf = {(int)b0.x, (int)b0.y, (int)b0.z, (int)b0.w, (int)b1.x, (int)b1.y, (int)b1.z, (int)b1.w};
#pragma unroll
              for (int g = 0; g < 8; ++g) { const v8i af = {(int)ua[g].x, (int)ua[g].y, (int)ua[g].z, (int)ua[g].w, 0, 0, 0, 0};
                  dacc[g] = __builtin_amdgcn_mfma_scale_f32_16x16x128_f8f6f4(af, bf, dacc[g], 4, 0, 0, 0x7f7f7f7f, 0, 0x7f7f7f7f); } }
            if (s + 2 < 16) {
#pragma unroll
                for (int g = 0; g < 8; ++g) ua[g] = *(const GAS v4u*)(P.PU + (unsigned)(rowoff[g] + 64 * (s + 2))); }
            { const v4u b0 = *(const LAS v4u*)(hq + hb + hstep * (s + 1)), b1 = *(const LAS v4u*)(hq + hb + hstep * (s + 1) + hb2);
              const v8i bf = {(int)b0.x, (int)b0.y, (int)b0.z, (int)b0.w, (int)b1.x, (int)b1.y, (int)b1.z, (int)b1.w};
#pragma unroll
              for (int g = 0; g < 8; ++g) { const v8i af = {(int)ub[g].x, (int)ub[g].y, (int)ub[g].z, (int)ub[g].w, 0, 0, 0, 0};
                  dacc[g] = __builtin_amdgcn_mfma_scale_f32_16x16x128_f8f6f4(af, bf, dacc[g], 4, 0, 0, 0x7f7f7f7f, 0, 0x7f7f7f7f); } }
        }
        float coef[2];
#pragma unroll
        for (int sl = 0; sl < 2; ++sl) { float mydot = 0.f;
#pragma unroll
            for (int g4 = 0; g4 < 4; ++g4)
#pragma unroll
                for (int r = 0; r < 4; ++r) { const float t = bpermf(16 * ((lane >> 2) & 3), dacc[4 * sl + g4][r]); if ((lane >> 4) == g4 && (lane & 3) == r) mydot = t; }
            mydot *= P.SU[eidx[sl]];
            if (DBG_PROBE == 4) {
                float ref = 0.f;
                for (int e = 0; e < 64; ++e) { const int ex = __builtin_amdgcn_readlane(eidx[sl], e); const v4u uu = *(const GAS v4u*)(P.PU + (size_t)ex * (DM / 2) + lane * 16); float s1 = 0.f;
                    const v4u hv2[4] = {*(const GAS v4u*)(P.H + (size_t)m * DM + lane * 32), *(const GAS v4u*)(P.H + (size_t)m * DM + lane * 32 + 8), *(const GAS v4u*)(P.H + (size_t)m * DM + lane * 32 + 16), *(const GAS v4u*)(P.H + (size_t)m * DM + lane * 32 + 24)};
#pragma unroll
                    for (int d = 0; d < 4; ++d) { const unsigned w = uu[d]; const unsigned hw[4] = {hv2[d].x, hv2[d].y, hv2[d].z, hv2[d].w};
                        f32x2 x = __builtin_amdgcn_cvt_scalef32_pk_f32_fp4(w, 1.0f, 0); s1 += x.x * bflo(hw[0]) + x.y * bfhi(hw[0]); x = __builtin_amdgcn_cvt_scalef32_pk_f32_fp4(w, 1.0f, 1); s1 += x.x * bflo(hw[1]) + x.y * bfhi(hw[1]);
                        x = __builtin_amdgcn_cvt_scalef32_pk_f32_fp4(w, 1.0f, 2); s1 += x.x * bflo(hw[2]) + x.y * bfhi(hw[2]); x = __builtin_amdgcn_cvt_scalef32_pk_f32_fp4(w, 1.0f, 3); s1 += x.x * bflo(hw[3]) + x.y * bfhi(hw[3]); }
                    const float tot = wave_sum_u(s1) * P.SU[ex]; if (lane == e) ref = tot; }
                pr_s2 = fmaxf(pr_s2, wave_max_u(fabsf(mydot - ref) / (fabsf(ref) + 0.25f))); pr_n = 1.f; }
            coef[sl] = egate[sl] * 0.5f * mydot * (1.0f + erff(mydot * 0.70710678f));
            if ((DBG_SKIP & 16) && sl == 0) coef[sl] = 0.f;
            if ((DBG_SKIP & 32) && sl == 1) coef[sl] = 0.f;
        }
        const float coefs[2] = {coef[0] * P.SV[eidx[0]], coef[1] * P.SV[eidx[1]]};
        f32x2 acc2[16];
#pragma unroll
        for (int i = 0; i < 16; ++i) acc2[i] = (f32x2){0.f, 0.f};
#define PEER_LOADV(U, C, e0_) do { const int e1_ = (e0_); const int ev_ = (e1_ & 64) ? eidx[1] : eidx[0]; const int cv_ = __builtin_bit_cast(int, (e1_ & 64) ? coefs[1] : coefs[0]); \
            _Pragma("unroll") for (int q = 0; q < 8; ++q) { const int ex = __builtin_amdgcn_readlane(ev_, (e1_ & 63) + q); U[q] = *(const GAS v4u*)(P.PV + (size_t)ex * (DM / 2) + lane * 16); \
            C[q] = __builtin_bit_cast(float, __builtin_amdgcn_readlane(cv_, (e1_ & 63) + q)); } } while (0)
#define PEER_AXPY(U, C) do { _Pragma("unroll") for (int q = 0; q < 8; ++q) _Pragma("unroll") for (int d = 0; d < 4; ++d) { const unsigned w = U[q][d]; \
            acc2[4 * d + 0] = __builtin_amdgcn_cvt_scalef32_pk_f32_fp4(w, 1.0f, 0) * C[q] + acc2[4 * d + 0]; acc2[4 * d + 1] = __builtin_amdgcn_cvt_scalef32_pk_f32_fp4(w, 1.0f, 1) * C[q] + acc2[4 * d + 1]; \
            acc2[4 * d + 2] = __builtin_amdgcn_cvt_scalef32_pk_f32_fp4(w, 1.0f, 2) * C[q] + acc2[4 * d + 2]; acc2[4 * d + 3] = __builtin_amdgcn_cvt_scalef32_pk_f32_fp4(w, 1.0f, 3) * C[q] + acc2[4 * d + 3]; } } while (0)
        f32x4 xpre[8];
        { const float* xr0 = P.X + (size_t)m * DM + lane * 32;
#pragma unroll
          for (int hq = 0; hq < 8; ++hq) xpre[hq] = *(const GAS f32x4*)(xr0 + hq * 4); }
        {
            v4u ua[8], ub[8]; float ca[8], cb[8];
            PEER_LOADV(ua, ca, 0);
#pragma unroll 1
            for (int it = 0; it < ((P.dry & 8) ? 2 : 8); ++it) {
                PEER_LOADV(ub, cb, 16 * it + 8); PEER_AXPY(ua, ca);
                if (it < 7) PEER_LOADV(ua, ca, 16 * it + 16);
                PEER_AXPY(ub, cb);
            }
        }
#undef PEER_LOADV
#undef PEER_AXPY
        float acc[32];
#pragma unroll
        for (int i = 0; i < 16; ++i) { acc[2 * i] = acc2[i].x; acc[2 * i + 1] = acc2[i].y; }
        if (P.dry) { float sm_ = 0.f;
#pragma unroll
            for (int i = 0; i < 32; ++i) sm_ += acc[i];
            if (sm_ == 1.2345e-30f) P.X[lane] = sm_;
            if (!(P.dry & 16)) continue; }
        if (DBG_SKIP & 1) {
#pragma unroll
            for (int i = 0; i < 32; ++i) acc[i] = 0.f; }
        if (((DBG_SKIP & 64) && !P.last) || ((DBG_SKIP & 128) && P.last)) {
#pragma unroll
            for (int i = 0; i < 32; ++i) acc[i] = 0.f; }
        if (DBG_SKIP & 8) {
#pragma unroll
            for (int i = 0; i < 32; ++i) acc[i] = -acc[i]; }
        int m_l = m, lane_l = lane; asm volatile("" : "+v"(m_l), "+v"(lane_l));
        const int b_l = m_l / TPB, tp_l = m_l - b_l * TPB, mr_l = tp_l < CTXL ? 2 : b_l;
        float* xr = P.X + (size_t)m_l * DM + lane_l * 32; const float* g2 = P.mod + (size_t)mr_l * 12288 + 5 * DM + lane_l * 32;
        float ss = 0.f;
#pragma unroll
        for (int hq = 0; hq < 8; ++hq) { const int c = hq * 4;
            f32x4 xv = xpre[hq]; const f32x4 gv = *(const GAS f32x4*)(g2 + c);
#pragma unroll
            for (int e = 0; e < 4; ++e) { xv[e] += gv[e] * acc[4 * hq + e]; ss += xv[e] * xv[e]; acc[4 * hq + e] = xv[e]; }
            if (!P.last) *(GAS f32x4*)((P.dry ? (float*)(F.ws + 760 * MiB) + (size_t)m_l * DM + lane_l * 32 : xr) + c) = xv; }
        if (!P.last) {
            const float rs = rsqrtf(wave_sum(ss) * (1.f / DM) + NORM_EPS); const float* sh = P.nmod + (size_t)mr_l * 12288 + lane_l * 32; const float* sc = sh + DM; const float* ngp = P.ng + lane_l * 32;
            bf16* ho = (P.dry ? (bf16*)(F.ws + 892 * MiB) : P.Hout) + (size_t)m_l * DM + lane_l * 32;
#pragma unroll
            for (int hq = 0; hq < 4; ++hq) { const int c = hq * 8; float y[8];
                const f32x4 n0 = *(const GAS f32x4*)(ngp + c), n1 = *(const GAS f32x4*)(ngp + c + 4), s0 = *(const GAS f32x4*)(sc + c), s1 = *(const GAS f32x4*)(sc + c + 4), h0 = *(const GAS f32x4*)(sh + c), h1 = *(const GAS f32x4*)(sh + c + 4);
#pragma unroll
                for (int e = 0; e < 4; ++e) { y[e] = acc[8 * hq + e] * rs * n0[e] * (1.0f + s0[e]) + h0[e]; y[4 + e] = acc[8 * hq + 4 + e] * rs * n1[e] * (1.0f + s1[e]) + h1[e]; }
                *(GAS v4u*)(ho + c) = pack8f(y); } }
        if (P.last) { const float rs = rsqrtf(wave_sum(ss) * (1.f / DM) + NORM_EPS); float* orow = P.out + ((size_t)b_l * SEQ + (tp_l - CTXL)) * DM + lane_l * 32; const float* fgp = P.fin_g + lane_l * 32;
#pragma unroll
            for (int hq = 0; hq < 8; ++hq) { const int c = hq * 4; const f32x4 fg = *(const GAS f32x4*)(fgp + c);
                f32x4 o;
#pragma unroll
                for (int e = 0; e < 4; ++e) o[e] = acc[4 * hq + e] * rs * fg[e];
                *(GAS f32x4*)(orow + c) = o; } }
    }
    if (DBG_PROBE && DBG_PROBE != 5 && !P.last && lane == 0) { float* pp = (float*)(F.ws + WS_CTL + CTL_PROBE_OFF) + gw * 4; pp[0] = pr_s2; pp[1] = pr_d2; pp[2] = pr_tg; pp[3] = pr_n; }
}


constexpr int PH_PER_LAYER = 12, NPHASE = 1 + NLAYER * PH_PER_LAYER;
#ifndef ONLY_PHASE
#define ONLY_PHASE -1
#endif
#define T0() (wave_s == 0 && pg8::opaque_lane() == 0)
#define PH_ON(k) (ONLY_PHASE < 0 || ONLY_PHASE == (k))
#define GEMM_CALL(EPI, SCHED, g, S, E) pg8::gemm_phase<EPI, SCHED, true, true>(F.lds, g, S, E, wave_s)
#define GEMM_CALL_NA(EPI, SCHED, g, S, E) pg8::gemm_phase<EPI, SCHED, false, true>(F.lds, g, S, E, wave_s)

__device__ __forceinline__ const float* karg(int i) {
    asm volatile("" : "+s"(i));
    const __attribute__((address_space(4))) unsigned long long* ka = (const __attribute__((address_space(4))) unsigned long long*)__builtin_amdgcn_kernarg_segment_ptr();
    return (const float*)ka[i];
}
__global__ void __launch_bounds__(NWAVES * 64, 2) mk_fwd(Args args) {
    extern __shared__ __attribute__((aligned(16))) unsigned char lds[];
    Frame F;
    F.lds = (LAS unsigned char*)lds; F.ws = args.ws;
    const int wave_s = __builtin_amdgcn_readfirstlane((int)threadIdx.x >> 6);
    F.tid = threadIdx.x; F.lane = F.tid & 63; F.wave = wave_s;
    F.G = gridDim.x; { const int bx = blockIdx.x; F.vcu = (F.G % 8 == 0) ? (bx % 8) * (F.G / 8) + bx / 8 : bx; }
    unsigned char* ws = args.ws;
    volatile LAS unsigned* MISC = (volatile LAS unsigned*)(F.lds + MISC_OFF);
    for (int u = F.tid; u < (LDS_BYTES - LDSCTL_OFF) / 4; u += NWAVES * 64) ((LAS unsigned*)(F.lds + LDSCTL_OFF))[u] = 0u;
    __syncthreads();
    const int lo = args.ph_lo, hi = args.ph_hi;
    XcdBarrier bar; bar.bar = (unsigned*)(ws + WS_CTL) + CW_BAR; bar.x = 0; bar.st = nullptr;
    if (hi - lo > 1) bar = xcd_barrier_post((unsigned*)(ws + WS_CTL) + CW_BAR, MISC + 8, T0());
#define IN(k) (lo <= (k) && (k) < hi)
#define REFRAME() do { const int lz_ = pg8::opaque_lane(); F.lane = lz_; F.tid = wave_s * 64 + lz_; F.wave = wave_s; ws = (unsigned char*)karg(34); F.ws = ws; { int g_ = (int)gridDim.x, b_ = (int)blockIdx.x; asm volatile("" : "+s"(g_), "+s"(b_)); bx = b_; F.G = g_; F.vcu = ((g_ & 7) == 0) ? (b_ & 7) * (g_ >> 3) + (b_ >> 3) : b_; } } while (0)
#define SEAM(k) do { if (IN((k) + 1)) xcd_barrier(bar, T0()); } while (0)
#define XBUF ((float*)(ws + WS_X))
#define HBUF ((bf16*)(ws + WS_H))
#define MODP ((const float*)(ws + WS_CTL + CTL_MOD_OFF) + (size_t)l * 3 * 12288)
    int bx = (int)blockIdx.x;

    for (int rep_ = 0; rep_ < ((DBG_REPEAT == 100) ? 2 : 1); ++rep_) if (PH_ON(100) && IN(0)) { REFRAME(); if (rep_) xcd_barrier(bar, T0()); p0_prologue(F); SEAM(0); if (DBG_REPEAT == 200) { for (int i_ = 0; i_ < 32; ++i_) xcd_barrier(bar, T0()); } }

    for (int l = 0; l < NLAYER; ++l) {
        const int base = 1 + l * PH_PER_LAYER;
        const int last = (l == NLAYER - 1);
        for (int rep_ = 0; rep_ < ((DBG_REPEAT == 0) ? 2 : 1); ++rep_) if (PH_ON(0) && IN(base + 0) && l == 0) { REFRAME(); if (rep_) xcd_barrier(bar, T0()); modnorm_phase(F, XBUF, karg(6) + (size_t)l * DM, MODP, 0, HBUF, 0, l == 0 ? karg(0) : nullptr, l == 0 ? karg(2) : nullptr); SEAM(base + 0); }
        for (int rep_ = 0; rep_ < ((DBG_REPEAT == 1) ? 2 : 1); ++rep_) if (PH_ON(1) && IN(base + 1)) { REFRAME(); if (rep_) xcd_barrier(bar, T0());
            pg8::Gemm g{HBUF, (const bf16*)(ws + WS_WINA) + (size_t)l * INA_P * DM, MALL, INA_P, DM}; pg8::RowOrder S; S.init_rows(0, INA_P, F.G, bx);
            pg8::EpiStoreBf16 E{(bf16*)(ws + WS_PA), INA_P};
            GEMM_CALL(pg8::EpiStoreBf16, pg8::RowOrder, g, S, E);
            SEAM(base + 1); }
        for (int rep_ = 0; rep_ < ((DBG_REPEAT == 2) ? 2 : 1); ++rep_) if (PH_ON(2) && IN(base + 2)) { REFRAME(); if (rep_) xcd_barrier(bar, T0());
            FeatP P;
            P.PA = (const bf16*)(ws + WS_PA); P.mu = karg(9) + (size_t)l * RWC; P.w0 = karg(10) + (size_t)l * 2 * RW; P.a0 = karg(12) + (size_t)l * 2 * RW;
            P.k_k = karg(15) + (size_t)l * RW; P.k_a = karg(16) + (size_t)l * RW; P.r_k = karg(17) + (size_t)l * RW;
            P.WUP = (const bf16*)(ws + WS_WUP) + (size_t)l * 2 * RW * 64; P.AUP = (const bf16*)(ws + WS_AUP) + (size_t)l * 2 * RW * 64; P.GUP = (const bf16*)(ws + WS_GUP) + (size_t)l * 2 * RW * 32;
            P.qnorm = karg(20) + (size_t)l * 512; P.kvnorm = karg(22) + (size_t)l * 256; P.rope = (const f32x2*)(ws + WS_ROPE);
            P.RI = (bf16*)(ws + WS_RI); P.GG = (bf16*)(ws + WS_GG); P.BON = (float*)(ws + WS_BON); P.QN = (bf16*)(ws + WS_QN); P.KVN = (bf16*)(ws + WS_KVN); P.K = (bf16*)(ws + WS_K);
            features_phase(F, P);
            SEAM(base + 2); }
        for (int rep_ = 0; rep_ < ((DBG_REPEAT == 3) ? 2 : 1); ++rep_) if (PH_ON(3) && IN(base + 3)) { REFRAME(); if (rep_) xcd_barrier(bar, T0());
            { pg8::Gemm g{(const bf16*)(ws + WS_QN), (const bf16*)(ws + WS_WUQ) + (size_t)l * NQ * 512, MALL, NQ, 512};
              pg8::EpiQ E{(bf16*)(ws + WS_Q), (const f32x2*)(ws + WS_ROPE), 0.14724444f};
              pg8::RowOrder S; S.init_rows(last, NQ, F.G, bx); GEMM_CALL_NA(pg8::EpiQ, pg8::RowOrder, g, S, E); }
            { pg8::Gemm g{(const bf16*)(ws + WS_KVN), (const bf16*)(ws + WS_WUKV) + (size_t)l * NKV * 256, MALL, NKV, 256}; pg8::RowOrder S; S.init_rows(0, NKV, F.G, bx);
              pg8::EpiKV E{(bf16*)(ws + WS_K), (bf16*)(ws + WS_V)};
              GEMM_CALL_NA(pg8::EpiKV, pg8::RowOrder, g, S, E); }
            SEAM(base + 3); }
        for (int rep_ = 0; rep_ < ((DBG_REPEAT == 4) ? 2 : 1); ++rep_) if (PH_ON(4) && IN(base + 4)) { REFRAME(); if (rep_) xcd_barrier(bar, T0());
            ScanCvt C; C.pu = karg(30) + (size_t)l * NEXP * DM; C.pv = karg(31) + (size_t)l * NEXP * DM; C.PU8 = ws + WS_P4; C.PV8 = ws + WS_P4 + (size_t)NEXP * (DM / 2); C.SU = (float*)(ws + WS_P4S); C.SV = (float*)(ws + WS_P4S) + NEXP;
            scan_phase(F, (const bf16*)(ws + WS_RI), (bf16*)(ws + WS_Y), C); SEAM(base + 4); }
        for (int rep_ = 0; rep_ < ((DBG_REPEAT == 5) ? 2 : 1); ++rep_) if (PH_ON(5) && IN(base + 5)) { REFRAME(); if (rep_) xcd_barrier(bar, T0());
            attn_phase(F, (const bf16*)(ws + WS_Q), (const bf16*)(ws + WS_K), (const bf16*)(ws + WS_V), (bf16*)(ws + WS_YB), !last);
            readout_phase(F, (const bf16*)(ws + WS_Y), (const bf16*)(ws + WS_GG), (const float*)(ws + WS_BON), (const bf16*)(ws + WS_RI), karg(18) + (size_t)l * RW, karg(19) + (size_t)l * RW, (bf16*)(ws + WS_YA));
            SEAM(base + 5); }
        for (int rep_ = 0; rep_ < ((DBG_REPEAT == 6) ? 2 : 1); ++rep_) if (PH_ON(6) && IN(base + 6)) { REFRAME(); if (rep_) xcd_barrier(bar, T0());
            bf16* T1 = (bf16*)(ws + WS_T1); bf16* T2 = (bf16*)(ws + WS_T2);
            const pg8::Gemm g1{HBUF, (const bf16*)(ws + WS_WGA) + (size_t)l * DM * DM, MALL, DM, DM}, g2{(const bf16*)(ws + WS_YA), (const bf16*)(ws + WS_WA) + (size_t)l * DM * RW, MALL, DM, RW};
            const pg8::Gemm g3{HBUF, (const bf16*)(ws + WS_WGB) + (size_t)l * DM * DM, MALL, DM, DM}, g4{(const bf16*)(ws + WS_YB), (const bf16*)(ws + WS_WB) + (size_t)l * DM * RW, MALL, DM, RW};
            const pg8::EpiGate E1{T1, DM, karg(8) + (size_t)l * 2 * DM}, E3{T2, DM, karg(8) + (size_t)l * 2 * DM + DM};
            const pg8::EpiMulAdd E2{T1, T1, nullptr, DM}, E4{T1, T2, T1, DM};
            pg8::RowOrder S; S.init_rows(last, DM, F.G, bx);
            GEMM_CALL(pg8::EpiGate, pg8::RowOrder, g1, S, E1); GEMM_CALL(pg8::EpiMulAdd, pg8::RowOrder, g2, S, E2); GEMM_CALL(pg8::EpiGate, pg8::RowOrder, g3, S, E3); GEMM_CALL(pg8::EpiMulAdd, pg8::RowOrder, g4, S, E4);
            SEAM(base + 6); }
        for (int rep_ = 0; rep_ < ((DBG_REPEAT == 7) ? 2 : 1); ++rep_) if (PH_ON(7) && IN(base + 7)) { REFRAME(); if (rep_) xcd_barrier(bar, T0());
            const pg8::Gemm g{(const bf16*)(ws + WS_T1), (const bf16*)(ws + WS_WO) + (size_t)l * DM * DM, MALL, DM, DM};
            const pg8::EpiResid E{XBUF, MODP + 2 * DM, l == 0 ? karg(0) : nullptr, l == 0 ? karg(2) : nullptr};
            pg8::RowOrder S; S.init_rows(last, DM, F.G, bx); GEMM_CALL(pg8::EpiResid, pg8::RowOrder, g, S, E);
            SEAM(base + 7); }
        for (int rep_ = 0; rep_ < ((DBG_REPEAT == 8) ? 2 : 1); ++rep_) if (PH_ON(8) && IN(base + 8)) { REFRAME(); if (rep_) xcd_barrier(bar, T0());
            modnorm_phase(F, XBUF, karg(27) + (size_t)l * DM, MODP, 3, HBUF, last);
            SEAM(base + 8); }
        for (int rep_ = 0; rep_ < ((DBG_REPEAT == 9) ? 2 : 1); ++rep_) if (PH_ON(9) && IN(base + 9)) { REFRAME(); if (rep_) xcd_barrier(bar, T0());
            const pg8::Gemm g{HBUF, (const bf16*)(ws + WS_WQK) + (size_t)l * DM * DM, MALL, DM, DM};
            const pg8::EpiF32 E{(float*)(ws + WS_SC), DM};
            pg8::RowOrder S; S.init_rows(last, DM, F.G, bx); GEMM_CALL(pg8::EpiF32, pg8::RowOrder, g, S, E);
            SEAM(base + 9); }
        for (int rep_ = 0; rep_ < ((DBG_REPEAT == 10) ? 2 : 1); ++rep_) if (PH_ON(10) && IN(base + 10)) { REFRAME(); if (rep_) xcd_barrier(bar, T0());
            SelP P; P.SC = (const float*)(ws + WS_SC); P.ESEL = (int*)(ws + WS_T1); P.EGATE = (float*)(ws + WS_T1 + 16 * MiB);
            P.last = last;
            select_phase(F, P);
            SEAM(base + 10); }
        for (int rep_ = 0; rep_ < ((DBG_REPEAT == 11) ? 2 : 1); ++rep_) if (PH_ON(11) && IN(base + 11)) { REFRAME(); if (rep_) xcd_barrier(bar, T0());
            PeerP P; P.nmod = MODP + 3 * 12288; P.ng = karg(6) + (size_t)(l + 1) * DM; P.Hout = HBUF; P.ESEL = (const int*)(ws + WS_T1); P.EGATE = (const float*)(ws + WS_T1 + 16 * MiB); P.H = HBUF; P.PU = ws + WS_P4; P.PV = ws + WS_P4 + (size_t)NEXP * (DM / 2); P.SU = (const float*)(ws + WS_P4S); P.SV = (const float*)(ws + WS_P4S) + NEXP; P.X = XBUF; P.mod = MODP; P.fin_g = karg(32); P.out = (float*)karg(33); P.last = last; P.dry = (DBG_REPEAT == 11 && rep_ == 0) ? DBG_DRY : 0;
            peer_phase(F, P);
            SEAM(base + 11); }
    }
#undef IN
#undef SEAM
#undef XBUF
#undef HBUF
#undef MODP
}

__device__ __forceinline__ float mx_a_val(int i, int k) { const int c = (i * 131 + k * 17 + (k >> 3) * 5) & 15; const float mag[8] = {0.f, .5f, 1.f, 1.5f, 2.f, 3.f, 4.f, 6.f}; return (c & 8) ? -mag[c & 7] : mag[c & 7]; }
__device__ __forceinline__ int mx_a_code(int i, int k) { return (i * 131 + k * 17 + (k >> 3) * 5) & 15; }
__device__ __forceinline__ float mx_b_val(int k, int j) { return (float)(((k * 7 + j * 13 + (k >> 4)) % 9) - 4); }
__device__ __forceinline__ int mx_kmap(int hyp, int kb, int e) { const int h = hyp % 3; return h == 0 ? 32 * kb + e : h == 1 ? 32 * (e >> 3) + 8 * kb + (e & 7) : 64 * (e >> 4) + 16 * kb + (e & 15); }
__global__ void __launch_bounds__(512) dbg_fill(const float* pp, float* o) {
    __shared__ float vsh;
    float v = 0.f;
    if (DBG_PROBE == 5) {
        if (threadIdx.x < 64) { typedef int v8i __attribute__((ext_vector_type(8))); typedef float f4 __attribute__((ext_vector_type(4)));
            const int lane = threadIdx.x, i = lane & 15, kb = lane >> 4; float code = 0.f;
            for (int hyp = 0; hyp < 18; ++hyp) { const int nibswap = hyp / 9, ha = hyp % 3, hb2 = (hyp / 3) % 3;
                unsigned aw[4] = {0u, 0u, 0u, 0u}; int bw[8] = {0, 0, 0, 0, 0, 0, 0, 0};
                for (int e = 0; e < 32; ++e) { const int k = mx_kmap(ha, kb, e); const unsigned c = (unsigned)mx_a_code(i, k); const int pos = nibswap ? (e ^ 1) : e; aw[pos >> 3] |= c << (4 * (pos & 7)); }
                for (int q = 0; q < 8; ++q) { int w = 0; const float f0 = mx_b_val(mx_kmap(hb2, kb, 4 * q + 0), i), f1 = mx_b_val(mx_kmap(hb2, kb, 4 * q + 1), i), f2 = mx_b_val(mx_kmap(hb2, kb, 4 * q + 2), i), f3 = mx_b_val(mx_kmap(hb2, kb, 4 * q + 3), i);
                    w = __builtin_amdgcn_cvt_pk_fp8_f32(f0, f1, w, false); w = __builtin_amdgcn_cvt_pk_fp8_f32(f2, f3, w, true); bw[q] = w; }
                const v8i af = {(int)aw[0], (int)aw[1], (int)aw[2], (int)aw[3], 0, 0, 0, 0}, bf = {bw[0], bw[1], bw[2], bw[3], bw[4], bw[5], bw[6], bw[7]};
                f4 d = {0.f, 0.f, 0.f, 0.f};
                d = __builtin_amdgcn_mfma_scale_f32_16x16x128_f8f6f4(af, bf, d, 4, 0, 0, 0x7f7f7f7f, 0, 0x7f7f7f7f);
                int bad = 0;
                for (int r = 0; r < 4; ++r) { const int row = 4 * kb + r, col = i; float ex = 0.f; for (int k = 0; k < 128; ++k) ex += mx_a_val(row, k) * mx_b_val(k, col); bad += (d[r] != ex); }
                if (__ballot(bad != 0) == 0ull && code == 0.f) code = (float)(hyp + 1); }
            for (int t = 0; t < 2; ++t) {
                int aw[8] = {0, 0, 0, 0, 0, 0, 0, 0}, bw[8] = {0, 0, 0, 0, 0, 0, 0, 0};
                if (t == 0) { for (int e = 0; e < 32; ++e) { const int k = 32 * kb + e; aw[e >> 3] |= mx_a_code(i, k) << (4 * (e & 7)); bw[e >> 3] |= mx_a_code(i + 16, k) << (4 * (e & 7)); } }
                else { for (int q = 0; q < 8; ++q) { int w = 0, w2 = 0; const int k = 32 * kb + 4 * q;
                        w = __builtin_amdgcn_cvt_pk_fp8_f32(mx_b_val(k, i + 16), mx_b_val(k + 1, i + 16), w, false); w = __builtin_amdgcn_cvt_pk_fp8_f32(mx_b_val(k + 2, i + 16), mx_b_val(k + 3, i + 16), w, true); aw[q] = w;
                        w2 = __builtin_amdgcn_cvt_pk_fp8_f32(mx_b_val(k, i), mx_b_val(k + 1, i), w2, false); w2 = __builtin_amdgcn_cvt_pk_fp8_f32(mx_b_val(k + 2, i), mx_b_val(k + 3, i), w2, true); bw[q] = w2; } }
                const v8i af = {aw[0], aw[1], aw[2], aw[3], aw[4], aw[5], aw[6], aw[7]}, bf = {bw[0], bw[1], bw[2], bw[3], bw[4], bw[5], bw[6], bw[7]};
                f4 d = {0.f, 0.f, 0.f, 0.f};
                if (t == 0) d = __builtin_amdgcn_mfma_scale_f32_16x16x128_f8f6f4(af, bf, d, 4, 4, 0, 0x7f7f7f7f, 0, 0x7f7f7f7f); else d = __builtin_amdgcn_mfma_scale_f32_16x16x128_f8f6f4(af, bf, d, 0, 0, 0, 0x7f7f7f7f, 0, 0x7f7f7f7f);
                int bad = 0;
                for (int r = 0; r < 4; ++r) { const int row = 4 * kb + r, col = i; float ex = 0.f;
                    for (int k = 0; k < 128; ++k) ex += (t == 0) ? mx_a_val(row, k) * mx_a_val(col + 16, k) : mx_b_val(k, row + 16) * mx_b_val(k, col);
                    bad += (d[r] != ex); }
                if (__ballot(bad != 0) == 0ull) code += (t == 0) ? 10.f : 20.f; }
            if (lane == 0) vsh = code; }
        __syncthreads(); v = vsh;
    } else {
        float s0 = 0.f, s1 = 0.f, s2 = 0.f, s3 = 0.f;
        for (int i = 0; i < 2048; ++i) { s0 += pp[4 * i]; s1 += pp[4 * i + 1]; s2 += pp[4 * i + 2]; s3 += pp[4 * i + 3]; }
        if (DBG_PROBE == 4) { float mx = 0.f; for (int i = 0; i < 2048; ++i) mx = fmaxf(mx, pp[4 * i]); v = 100.f * mx; }
        else { v = (DBG_PROBE == 1 ? s0 : DBG_PROBE == 2 ? s1 : s2) / s3 * 1e-3f; v = exp2f(rintf(log2f(v) * 4.f) * 0.25f); }
    }
    for (size_t i = (size_t)blockIdx.x * 512 + threadIdx.x; i < (size_t)NBATCH * SEQ * DM; i += (size_t)gridDim.x * 512) o[i] = v;
}
extern "C" void kernel_launch(void* const* d_in, const int* in_sizes, int n_in, void* d_out, int out_size, void* d_ws, size_t ws_size, hipStream_t stream) {
    static int grid = 0;
    if (grid == 0) {
        if (n_in != 33 || out_size != NBATCH * SEQ * DM || ws_size < WS_END2) { fprintf(stderr, "kernel_launch: unexpected shapes (n_in %d out %d ws %zu)\n", n_in, out_size, ws_size); grid = -1; return; }
        int dev = 0, cus = 0, per_cu = 0;
        if (hipGetDevice(&dev) != hipSuccess || hipDeviceGetAttribute(&cus, hipDeviceAttributeMultiprocessorCount, dev) != hipSuccess) { grid = -1; return; }
        if (hipFuncSetAttribute((const void*)mk_fwd, hipFuncAttributeMaxDynamicSharedMemorySize, LDS_BYTES) != hipSuccess) { fprintf(stderr, "kernel_launch: hipFuncSetAttribute failed\n"); grid = -1; return; }
        if (hipOccupancyMaxActiveBlocksPerMultiprocessor(&per_cu, (const void*)mk_fwd, NWAVES * 64, LDS_BYTES) != hipSuccess || per_cu < 1) { fprintf(stderr, "kernel_launch: occupancy query says %d\n", per_cu); (void)hipGetLastError(); grid = -1; return; }
        grid = cus;
    }
    if (grid < 0) return;
    if (hipMemsetAsync((char*)d_ws + WS_CTL, 0, CTL_ZERO_BYTES, stream) != hipSuccess) return;
    Args a{};
    for (int i = 0; i < 33; ++i) a.in[i] = (const float*)d_in[i];
    a.out = (float*)d_out; a.ws = (unsigned char*)d_ws;
#if MK_N_LAUNCHES == 1
    a.ph_lo = 0; a.ph_hi = NPHASE;
    hipLaunchKernelGGL(mk_fwd, dim3(grid), dim3(NWAVES * 64), LDS_BYTES, stream, a);
#else
    if (DBG_PROBE != 5) for (int p = 0; p < NPHASE; ++p) { a.ph_lo = p; a.ph_hi = p + 1; hipLaunchKernelGGL(mk_fwd, dim3(grid), dim3(NWAVES * 64), LDS_BYTES, stream, a); }
    if (DBG_PROBE) hipLaunchKernelGGL(dbg_fill, dim3(1024), dim3(512), 0, stream, (const float*)((char*)d_ws + WS_CTL + CTL_PROBE_OFF), (float*)d_out);
#endif
}
```

```cpp
#include <hip/hip_runtime.h>
#include <cstdio>
#include <cstdint>

#ifndef MK_N_LAUNCHES
#define MK_N_LAUNCHES 1
#endif

#ifndef DBG_SKIP
#define DBG_SKIP 0
#endif
#ifndef DBG_PROBE
#define DBG_PROBE 0
#endif
#ifndef DBG_DRY
#define DBG_DRY 1
#endif
#ifndef DBG_REPEAT
#define DBG_REPEAT -1
#endif
namespace pg8 {
#define PG8_LAS __attribute__((address_space(3)))
typedef unsigned short bf16_t;
typedef short bf16x8 __attribute__((ext_vector_type(8)));
typedef float f32x4 __attribute__((ext_vector_type(4)));
typedef unsigned u32x4 __attribute__((ext_vector_type(4)));
constexpr int BM = 256, BK = 64, HALF = 128, HTB = HALF * BK * 2  , STAGE_BYTES = 8 * HTB, NXCD = 8, WGM = 8;

__host__ __device__ __forceinline__ int lds_byte(int r, int c) { const int st = (r >> 4) * 2 + (c >> 5), rr = r & 15, cc = c & 31, ob = rr * 64 + cc * 2; return st * 1024 + (ob ^ (((ob >> 9) & 1) << 5)); }
__host__ __device__ __forceinline__ void stage_rc(int b, int& R, int& C) { const int st = b / 1024, sb = b % 1024, swz = sb ^ (((sb >> 9) & 1) << 5); R = (st >> 1) * 16 + swz / 64; C = (st & 1) * 32 + (swz % 64) / 2; }
__host__ __device__ __forceinline__ int perm32(int rho) { const int n = rho >> 4, i = rho & 15; return 8 * (i >> 2) + 4 * n + (i & 3); }

struct Unit { int pm, pn; };
struct Gemm { const bf16_t* A; const bf16_t* Bt; int M, N, K; };

struct StaticOrder {
    int nM, nN, nwg, G, c;
    __host__ __device__ void init(int M, int N, int G_, int c_) { nM = M / BM; nN = N / BM; nwg = nM * nN; G = G_; c = c_; }
    __host__ __device__ bool next(int i, Unit& u) const {
        const long L = (long)i * G + c; if (L >= nwg) return false;
        int wgid = (int)L; { const int q = nwg / NXCD, r = nwg % NXCD, xcd = wgid % NXCD, off = wgid / NXCD; wgid = (xcd < r ? xcd * (q + 1) : r * (q + 1) + (xcd - r) * q) + off; }
        const int nig = WGM * nN, gid = wgid / nig, fm = gid * WGM, gsz = (nM - fm) < WGM ? (nM - fm) : WGM;
        u.pm = fm + ((wgid % nig) % gsz); u.pn = (wgid % nig) / gsz; return true;
    }
    __device__ __forceinline__ void a_ready(const Unit&) const {}
    __device__ __forceinline__ void done(const Unit&) const {}
};
__device__ __forceinline__ int opaque_lane() { int l; asm volatile("v_mbcnt_lo_u32_b32 %0, -1, 0\n\tv_mbcnt_hi_u32_b32 %0, -1, %0" : "=v"(l)); return l; }
typedef __bf16 bf16x2c __attribute__((ext_vector_type(2)));
__device__ __forceinline__ unsigned cvt_pk_bf16(float lo, float hi) { const bf16x2c v = {(__bf16)lo, (__bf16)hi}; return __builtin_bit_cast(unsigned, v); }
template <class Epi, class Sched, bool ALIGN_EPI = false, bool SP2 = false>
__device__ __forceinline__ void gemm_phase(PG8_LAS unsigned char* lds, const Gemm g, const Sched& S, const Epi& E, const int wave_s) {
    const int lane_ = opaque_lane();
    const int wid = wave_s, lane = lane_, tid = wid * 64 + lane, wr = wid >> 2, wc = wid & 3, fr = lane & 15, fq = lane >> 4;
    const int K = g.K, nt = K / BK;
    unsigned voffA[2], voffB[2];
#pragma unroll
    for (int i = 0; i < 2; ++i) { int R, C; stage_rc(tid * 16 + i * 8192, R, C); const int Rb = Epi::PERM ? ((R & ~31) + perm32(R & 31)) : R;
        voffA[i] = (unsigned)(R * K + C) * 2u; voffB[i] = (unsigned)(Rb * K + C) * 2u; }
    const size_t kstep = (size_t)(BK * 2);
    const size_t hstep = (size_t)HALF * K * 2;
    const size_t tstep = 2 * hstep;
    const unsigned ldsw = (unsigned)wid * 1024u;
    const int aoff = lds_byte(wr * 64 + fr, fq * 8), boff = lds_byte(wc * 32 + fr, fq * 8);
#define PG8_SA(b, h) (((b) * 2 + (h)) * HTB)
#define PG8_SB(b, h) ((4 + (b) * 2 + (h)) * HTB)
#define PG8_STAGE(bufoff, gbase, voff) do { _Pragma("unroll") for (int _i = 0; _i < 2; ++_i) \
        __builtin_amdgcn_global_load_lds((const unsigned*)((const char*)(gbase) + (voff)[_i]), (PG8_LAS unsigned*)(lds + (bufoff) + ldsw + _i * 8192), 16, 0, 0); } while (0)
#define PG8_LDA(dst, b, h) do { _Pragma("unroll") for (int m = 0; m < 4; ++m) _Pragma("unroll") for (int k = 0; k < 2; ++k) dst[m][k] = *(const PG8_LAS bf16x8*)(lds + PG8_SA(b, h) + aoff + m * 2048 + k * 1024); } while (0)
#define PG8_LDB(dst, b, h) do { _Pragma("unroll") for (int n = 0; n < 2; ++n) _Pragma("unroll") for (int k = 0; k < 2; ++k) dst[n][k] = *(const PG8_LAS bf16x8*)(lds + PG8_SB(b, h) + boff + n * 2048 + k * 1024); } while (0)
#define PG8_MMA(ai, bj, At, Bt) do { __builtin_amdgcn_s_setprio(1); _Pragma("unroll") for (int m = 0; m < 4; ++m) _Pragma("unroll") for (int n = 0; n < 2; ++n) _Pragma("unroll") for (int k = 0; k < 2; ++k) \
        acc[ai][bj][m][n] = __builtin_amdgcn_mfma_f32_16x16x32_bf16(Bt[n][k], At[m][k], acc[ai][bj][m][n], 0, 0, 0); __builtin_amdgcn_s_setprio(0); } while (0)
#define PG8_WAIT_V(n) asm volatile("s_waitcnt vmcnt(" #n ")" ::: "memory")
#define PG8_WAIT_L(n) asm volatile("s_waitcnt lgkmcnt(" #n ")" ::: "memory")
#define PG8_BAR __builtin_amdgcn_s_barrier()
#define PG8_SCHED __builtin_amdgcn_sched_barrier(0)
    Unit cur, nxt; int ui = 0;
    if (!S.next(0, cur)) return;
    f32x4 acc[2][2][4][2];
#pragma unroll
    for (int a = 0; a < 2; ++a)
#pragma unroll
        for (int b = 0; b < 2; ++b)
#pragma unroll
            for (int m = 0; m < 4; ++m)
#pragma unroll
                for (int n = 0; n < 2; ++n) acc[a][b][m][n] = (f32x4){0.f, 0.f, 0.f, 0.f};
    bf16x8 At[4][2], B0[2][2], B1[2][2];
    const char* cA = (const char*)g.A + (size_t)cur.pm * tstep; const char* cB = (const char*)g.Bt + (size_t)cur.pn * tstep;
    S.a_ready(cur);
    if constexpr (SP2) {
        PG8_STAGE(PG8_SB(0, 0), cB, voffB); PG8_STAGE(PG8_SB(0, 1), cB + hstep, voffB); PG8_STAGE(PG8_SA(0, 0), cA, voffA); PG8_STAGE(PG8_SA(0, 1), cA + hstep, voffA);
        if (wr == 1) PG8_BAR;
        PG8_WAIT_V(2); PG8_BAR;
        PG8_STAGE(PG8_SB(1, 0), cB + kstep, voffB); PG8_STAGE(PG8_SA(1, 0), cA + kstep, voffA); PG8_STAGE(PG8_SB(1, 1), cB + hstep + kstep, voffB);
        PG8_WAIT_V(6); PG8_BAR;
    } else {
        PG8_STAGE(PG8_SB(0, 0), cB, voffB); PG8_STAGE(PG8_SA(0, 0), cA, voffA); PG8_STAGE(PG8_SB(0, 1), cB + hstep, voffB); PG8_STAGE(PG8_SA(0, 1), cA + hstep, voffA);
        if (wr == 1) PG8_BAR;
        PG8_WAIT_V(4); PG8_BAR;
        PG8_STAGE(PG8_SB(1, 0), cB + kstep, voffB); PG8_STAGE(PG8_SA(1, 0), cA + kstep, voffA); PG8_STAGE(PG8_SB(1, 1), cB + hstep + kstep, voffB);
        PG8_WAIT_V(6); PG8_BAR;
    }
    for (;;) {
        const bool has_next = S.next(ui + 1, nxt);
        const char* nA = has_next ? (const char*)g.A + (size_t)nxt.pm * tstep : cA; const char* nB = has_next ? (const char*)g.Bt + (size_t)nxt.pn * tstep : cB;
        for (int t = 0; t < nt; t += 2) {
            const bool last = (t == nt - 2);
            const char* a1 = cA + (size_t)(t + 1) * kstep;
            const char* a2 = last ? nA : cA + (size_t)(t + 2) * kstep; const char* b2 = last ? nB : cB + (size_t)(t + 2) * kstep;
            const char* a3 = a2 + kstep; const char* b3 = b2 + kstep;
            if (last && has_next) S.a_ready(nxt);
            if constexpr (SP2) {
            PG8_LDB(B0, 0, 0); PG8_LDB(B1, 0, 1); PG8_SCHED; PG8_LDA(At, 0, 0); PG8_STAGE(PG8_SA(1, 1), a1 + hstep, voffA);
            PG8_WAIT_V(8); PG8_WAIT_L(0); PG8_BAR; PG8_MMA(0, 0, At, B0); PG8_MMA(0, 1, At, B1); PG8_BAR; PG8_SCHED;
            PG8_LDA(At, 0, 1); PG8_STAGE(PG8_SB(0, 0), b2, voffB); PG8_STAGE(PG8_SB(0, 1), b2 + hstep, voffB); PG8_STAGE(PG8_SA(0, 0), a2, voffA);
            PG8_WAIT_V(8); PG8_WAIT_L(0); PG8_BAR; PG8_MMA(1, 0, At, B0); PG8_MMA(1, 1, At, B1); PG8_BAR; PG8_SCHED;
            PG8_LDB(B0, 1, 0); PG8_LDB(B1, 1, 1); PG8_SCHED; PG8_LDA(At, 1, 0); PG8_STAGE(PG8_SA(0, 1), a2 + hstep, voffA);
            PG8_WAIT_V(8); PG8_WAIT_L(0); PG8_BAR; PG8_MMA(0, 0, At, B0); PG8_MMA(0, 1, At, B1); PG8_BAR; PG8_SCHED;
            PG8_LDA(At, 1, 1); PG8_STAGE(PG8_SB(1, 0), b3, voffB); PG8_STAGE(PG8_SB(1, 1), b3 + hstep, voffB); PG8_STAGE(PG8_SA(1, 0), a3, voffA);
            PG8_WAIT_V(8); PG8_WAIT_L(0); PG8_BAR; PG8_MMA(1, 0, At, B0); PG8_MMA(1, 1, At, B1); PG8_BAR; PG8_SCHED;
            } else {
            PG8_LDB(B0, 0, 0); PG8_SCHED; PG8_LDA(At, 0, 0); PG8_STAGE(PG8_SA(1, 1), a1 + hstep, voffA);
            PG8_WAIT_L(8); PG8_BAR; PG8_WAIT_L(0); PG8_MMA(0, 0, At, B0); PG8_BAR; PG8_SCHED;
            PG8_LDB(B1, 0, 1); PG8_STAGE(PG8_SB(0, 0), b2, voffB);
            PG8_BAR; PG8_WAIT_L(0); PG8_MMA(0, 1, At, B1); PG8_BAR;
            PG8_LDA(At, 0, 1); PG8_STAGE(PG8_SA(0, 0), a2, voffA);
            PG8_BAR; PG8_WAIT_L(0); PG8_MMA(1, 0, At, B0); PG8_BAR; PG8_SCHED;
            PG8_STAGE(PG8_SB(0, 1), b2 + hstep, voffB);
            PG8_WAIT_V(6); PG8_BAR; PG8_MMA(1, 1, At, B1); PG8_BAR;
            PG8_LDB(B0, 1, 0); PG8_SCHED; PG8_LDA(At, 1, 0); PG8_STAGE(PG8_SA(0, 1), a2 + hstep, voffA);
            PG8_WAIT_L(8); PG8_BAR; PG8_WAIT_L(0); PG8_MMA(0, 0, At, B0); PG8_BAR; PG8_SCHED;
            PG8_LDB(B1, 1, 1); PG8_STAGE(PG8_SB(1, 0), b3, voffB);
            PG8_BAR; PG8_WAIT_L(0); PG8_MMA(0, 1, At, B1); PG8_BAR;
            PG8_LDA(At, 1, 1); PG8_STAGE(PG8_SA(1, 0), a3, voffA);
            PG8_BAR; PG8_WAIT_L(0); PG8_MMA(1, 0, At, B0); PG8_BAR; PG8_SCHED;
            PG8_STAGE(PG8_SB(1, 1), b3 + hstep, voffB);
            PG8_WAIT_V(6); PG8_BAR; PG8_MMA(1, 1, At, B1); PG8_BAR;
            }
        }
        if constexpr (ALIGN_EPI) { if (wr == 0) PG8_BAR; }
        if constexpr (!Epi::AFTER_DRAIN) { const int le_ = opaque_lane(); E(acc, cur, wr, wc, le_ & 15, le_ >> 4); S.done(cur); }
        if (!has_next) break;
#pragma unroll
        for (int a = 0; a < 2; ++a)
#pragma unroll
            for (int b = 0; b < 2; ++b)
#pragma unroll
                for (int m = 0; m < 4; ++m)
#pragma unroll
                    for (int n = 0; n < 2; ++n) acc[a][b][m][n] = (f32x4){0.f, 0.f, 0.f, 0.f};
        cur = nxt; cA = nA; cB = nB; ++ui;
        if constexpr (ALIGN_EPI) { if (wr == 1) PG8_BAR; }
    }
    PG8_WAIT_V(0);
    if constexpr (!ALIGN_EPI) { if (wr == 0) PG8_BAR; }
    PG8_BAR;
    if constexpr (Epi::AFTER_DRAIN) { E.fused(acc, cur, wr, wc, fr, fq, lds, wid, lane); S.done(cur); }
#undef PG8_SA
#undef PG8_SB
#undef PG8_STAGE
#undef PG8_LDA
#undef PG8_LDB
#undef PG8_MMA
#undef PG8_WAIT_V
#undef PG8_WAIT_L
#undef PG8_BAR
#undef PG8_SCHED
}
}

constexpr int NWAVES = 8;
constexpr int DM = 2048, NBATCH = 2, SEQ = 8192, CTXL = 256, TPB = CTXL + SEQ  , MALL = NBATCH * TPB  ;
constexpr int NLAYER = 2;
constexpr int RW = 1024, NH = 16;
constexpr int RWC = 3392, INA = 4192, INA_P = 4352, INC = 8288;
constexpr int C_WD = 3072, C_AD = 3200, C_GD = 3328, C_QC = 3392, C_KVC = 3904, C_KR = 4160;
constexpr int QKD = 96, NQ = NH * QKD  , NKV = NH * 128  ;
constexpr int NEXP = 16384;
constexpr int RREC = 9 * 64;
constexpr float NORM_EPS = 1e-6f;

constexpr size_t MiB = 1u << 20;
constexpr size_t WS_CTL = 0, CTL_ZERO_BYTES = 1 * MiB;
constexpr size_t CTL_MOD_OFF = 256 * 1024;
constexpr size_t WS_ROPE = 1 * MiB;
constexpr size_t WS_WUP = 3 * MiB, WS_AUP = WS_WUP + 512 * 1024, WS_GUP = 4 * MiB;
constexpr size_t WS_WUQ = 5 * MiB, WS_WUKV = 8 * MiB, WS_WA = 10 * MiB, WS_WB = 18 * MiB, WS_WO = 26 * MiB, WS_WQK = 42 * MiB, WS_WGA = 58 * MiB, WS_WGB = 74 * MiB, WS_WINA = 90 * MiB;
constexpr size_t WS_X = 124 * MiB, WS_H = 256 * MiB, WS_DYN = 322 * MiB;
constexpr size_t WS_PA = WS_DYN;
constexpr size_t WS_RI = 463 * MiB;
constexpr size_t WS_GG = 760 * MiB;
constexpr size_t WS_BON = 826 * MiB;
constexpr size_t WS_QN = 831 * MiB, WS_KVN = 848 * MiB;
constexpr size_t WS_Q = 857 * MiB, WS_K = 907 * MiB, WS_V = 957 * MiB, WS_END = 990 * MiB;
constexpr size_t WS_Y = WS_DYN;
constexpr size_t WS_YA = 388 * MiB, WS_YB = 421 * MiB;
constexpr size_t WS_T1 = 463 * MiB, WS_T2 = 529 * MiB;
constexpr size_t WS_PU = 600 * MiB, WS_PV = 664 * MiB;
constexpr size_t WS_P4 = 990 * MiB, WS_P4S = 1022 * MiB, WS_END2 = 1023 * MiB;
constexpr size_t WS_SC = WS_DYN;
static_assert(WS_PA + (size_t)MALL * INA_P * 2 <= WS_RI && WS_RI + (size_t)NBATCH * NH * TPB * RREC * 2 <= WS_GG && WS_GG + (size_t)2 * MALL * RW * 2 <= WS_BON, "ws map 1");
static_assert(WS_BON + (size_t)2 * MALL * 32 * 4 <= WS_QN && WS_QN + (size_t)MALL * 512 * 2 <= WS_KVN && WS_KVN + (size_t)MALL * 256 * 2 <= WS_Q, "ws map 2");
static_assert(WS_Q + (size_t)NBATCH * NH * TPB * QKD * 2 <= WS_K && WS_K + (size_t)NBATCH * NH * TPB * QKD * 2 <= WS_V && WS_V + (size_t)NBATCH * NH * TPB * 64 * 2 <= WS_END, "ws map 3");
static_assert(WS_Y + (size_t)2 * MALL * RW * 2 <= WS_YA && WS_YA + (size_t)MALL * RW * 2 <= WS_YB && WS_YB + (size_t)MALL * RW * 2 <= WS_RI, "ws map 4");
static_assert(WS_T1 + (size_t)MALL * DM * 2 <= WS_T2 && WS_T2 + (size_t)MALL * DM * 2 <= WS_PU && WS_PU + (size_t)NEXP * DM * 2 <= WS_PV && WS_PV + (size_t)NEXP * DM * 2 <= WS_GG, "ws map 5");
static_assert(WS_SC + (size_t)MALL * DM * 4 <= WS_T1 && WS_X + (size_t)MALL * DM * 4 <= WS_H && WS_H + (size_t)MALL * DM * 2 <= WS_DYN, "ws map 6");
static_assert(WS_WINA + (size_t)NLAYER * INA_P * DM * 2 <= WS_X, "ws map 7");
constexpr size_t CTL_PROBE_OFF = 640 * 1024;
constexpr int CW_BAR = 4096;

constexpr int RING_BYTES = 131072;
constexpr int LDSCTL_OFF = RING_BYTES, MISC_OFF = LDSCTL_OFF + 320;
constexpr int LDS_BYTES = 147456;

#define GAS __attribute__((address_space(1)))
#define LAS __attribute__((address_space(3)))
typedef unsigned short bf16;
typedef unsigned v4u __attribute__((ext_vector_type(4)));
typedef unsigned v2u __attribute__((ext_vector_type(2)));
typedef float f32x4 __attribute__((ext_vector_type(4)));
typedef float f32x2 __attribute__((ext_vector_type(2)));
typedef float f32x16 __attribute__((ext_vector_type(16)));
typedef short bf16x8 __attribute__((ext_vector_type(8)));
typedef short s16x4 __attribute__((ext_vector_type(4)));
typedef __bf16 bf16x2v __attribute__((ext_vector_type(2)));
typedef __bf16 bf16x8v __attribute__((ext_vector_type(8)));
typedef GAS unsigned gu32;
#define RLX_AGENT __ATOMIC_RELAXED, __HIP_MEMORY_SCOPE_AGENT
#define LDS_WAIT() asm volatile("s_waitcnt lgkmcnt(0)" ::: "memory")
#define VM_WAIT() asm volatile("s_waitcnt vmcnt(0)" ::: "memory")
__device__ __forceinline__ unsigned f2bf(float f) { unsigned u = __builtin_bit_cast(unsigned, f); return (u + 0x7fffu + ((u >> 16) & 1u)) >> 16; }
__device__ __forceinline__ unsigned pk2(float lo, float hi) { return pg8::cvt_pk_bf16(lo, hi); }
__device__ __forceinline__ float bflo(unsigned w) { return __builtin_bit_cast(float, w << 16); }
__device__ __forceinline__ float bfhi(unsigned w) { return __builtin_bit_cast(float, w & 0xffff0000u); }
__device__ __forceinline__ float bf1(bf16 h) { return __builtin_bit_cast(float, (unsigned)h << 16); }
__device__ __forceinline__ float sigmoidf_(float x) { return __builtin_amdgcn_rcpf(1.0f + __expf(-x)); }
template <int CTRL> __device__ __forceinline__ float dpp_add(float x) {
    return x + __builtin_bit_cast(float, __builtin_amdgcn_update_dpp(0, __builtin_bit_cast(int, x), CTRL, 0xf, 0xf, true));
}
__device__ __forceinline__ float red16(float x) {
    x = dpp_add<0xB1>(x);
    x = dpp_add<0x4E>(x);
    x = dpp_add<0x141>(x);
    x = dpp_add<0x140>(x);
    return x;
}
template <int CTRL, int RM> __device__ __forceinline__ float dpp_max(float x) {
    return fmaxf(x, __builtin_bit_cast(float, __builtin_amdgcn_update_dpp(__builtin_bit_cast(int, x), __builtin_bit_cast(int, x), CTRL, RM, 0xf, false)));
}
template <int CTRL, int RM> __device__ __forceinline__ float dpp_sum(float x) {
    return x + __builtin_bit_cast(float, __builtin_amdgcn_update_dpp(0, __builtin_bit_cast(int, x), CTRL, RM, 0xf, false));
}
__device__ __forceinline__ float wave_max_u(float x) {
    x = dpp_max<0xB1, 0xf>(x); x = dpp_max<0x4E, 0xf>(x); x = dpp_max<0x141, 0xf>(x); x = dpp_max<0x140, 0xf>(x);
    x = dpp_max<0x142, 0xa>(x); x = dpp_max<0x143, 0xc>(x);
    return __builtin_bit_cast(float, __builtin_amdgcn_readlane(__builtin_bit_cast(int, x), 63));
}
__device__ __forceinline__ float wave_sum_u(float x) {
    x = dpp_sum<0xB1, 0xf>(x); x = dpp_sum<0x4E, 0xf>(x); x = dpp_sum<0x141, 0xf>(x); x = dpp_sum<0x140, 0xf>(x);
    x = dpp_sum<0x142, 0xa>(x); x = dpp_sum<0x143, 0xc>(x);
    return __builtin_bit_cast(float, __builtin_amdgcn_readlane(__builtin_bit_cast(int, x), 63));
}
__device__ __forceinline__ float wave_sum(float v) { return wave_sum_u(v); }
__device__ __forceinline__ float bpermf(int srclane, float v) { return __builtin_bit_cast(float, __builtin_amdgcn_ds_bpermute(srclane << 2, __builtin_bit_cast(int, v))); }
__device__ __forceinline__ int bpermi(int srclane, int v) { return __builtin_amdgcn_ds_bpermute(srclane << 2, v); }

#define XB_TMO      128
#define XB_XCNT(j)  (256  + 64 * (j))
#define XB_XSUB(j)  (1280 + 64 * (j))
#define XB_XGEN(j)  (2304 + 64 * (j))
#define XB_TOP      3328
#define XB_TOPGEN   3392
#define XCD_BAR_WORDS 3456
#define XB_SPIN_CAP (1u << 20)

__device__ __forceinline__ unsigned xb_ld(unsigned* p)              { return __hip_atomic_load(p, __ATOMIC_RELAXED, __HIP_MEMORY_SCOPE_AGENT); }
__device__ __forceinline__ unsigned xb_add(unsigned* p, unsigned v) { return __hip_atomic_fetch_add(p, v, __ATOMIC_RELAXED, __HIP_MEMORY_SCOPE_AGENT); }
__device__ __forceinline__ unsigned xb_xcc_id() { return (unsigned)__builtin_amdgcn_s_getreg((3 << 11) | 20) & 0xFu; }
#define XB_SPIN(cond, bar) do { unsigned _sp = 0; while (cond) { __builtin_amdgcn_s_sleep(1); \
    if ((++_sp & 255u) == 0u) { if (xb_ld(&(bar)[XB_TMO])) break; if (_sp > XB_SPIN_CAP) { atomicAdd(&(bar)[XB_TMO], 1u); break; } } } } while (0)

struct XcdBarrier { unsigned* bar; unsigned x; volatile LAS unsigned* st; };

__device__ __forceinline__ XcdBarrier xcd_barrier_post(unsigned* bar, volatile LAS unsigned* st, bool t0) {
    XcdBarrier b; b.bar = bar; b.x = xb_xcc_id(); b.st = st;
    if (t0) (void)xb_add(&bar[XB_XCNT(b.x)], 1u);
    return b;
}
__device__ __forceinline__ void xcd_barrier_complete(unsigned* bar, unsigned x, unsigned& nloc, unsigned& nx) {
    const unsigned G = gridDim.x * gridDim.y * gridDim.z;
    unsigned sum, cnt, mine, sp = 0u;
    for (;;) {
        sum = 0u; cnt = 0u; mine = 0u;
#pragma unroll
        for (unsigned j = 0; j < 16; ++j) { const unsigned c = xb_ld(&bar[XB_XCNT(j)]); sum += c; cnt += (c > 0u) ? 1u : 0u; mine = (j == x) ? c : mine; }
        if (sum == G) break;
        __builtin_amdgcn_s_sleep(1);
        if ((++sp & 255u) == 0u) { if (xb_ld(&bar[XB_TMO])) break; if (sp > XB_SPIN_CAP) { atomicAdd(&bar[XB_TMO], 1u); break; } }
    }
    nloc = mine > 0u ? mine : 1u; nx = cnt > 0u ? cnt : 1u;
}
__device__ __forceinline__ void xcd_barrier(const XcdBarrier& b, bool t0) {
    asm volatile("s_waitcnt vmcnt(0)" ::: "memory");
    __syncthreads();
    if (t0) {
        unsigned* bar = b.bar;
        __builtin_amdgcn_s_waitcnt(0);
        unsigned nloc = b.st[0], nx = b.st[1];
        if (nloc == 0u) { xcd_barrier_complete(bar, b.x, nloc, nx); b.st[0] = nloc; b.st[1] = nx; }
        const unsigned old = xb_add(&bar[XB_XSUB(b.x)], 1u);
        const unsigned gen = old / nloc;
        if (old + 1u == (gen + 1u) * nloc) {
            __builtin_amdgcn_fence(__ATOMIC_RELEASE, "agent");
            asm volatile("s_waitcnt vmcnt(0)" ::: "memory");
            const unsigned og = xb_add(&bar[XB_TOP], 1u);
            const unsigned tg = og / nx;
            if (og + 1u == (tg + 1u) * nx) xb_add(&bar[XB_TOPGEN], 1u);
            else XB_SPIN(xb_ld(&bar[XB_TOPGEN]) == tg, bar);
            __builtin_amdgcn_fence(__ATOMIC_ACQUIRE, "agent");
            xb_add(&bar[XB_XGEN(b.x)], 1u);
            asm volatile("s_waitcnt vmcnt(0)" ::: "memory");
        } else {
            XB_SPIN(xb_ld(&bar[XB_XGEN(b.x)]) == gen, bar);
            __builtin_amdgcn_fence(__ATOMIC_ACQUIRE, "agent");
            asm volatile("s_waitcnt vmcnt(0)" ::: "memory");
        }
    }
    __syncthreads();
}

struct Frame {
    LAS unsigned char* lds;
    unsigned char* ws;
    const float* const* in;
    int tid, lane, wave;
    int vcu, G;
};
struct Args { const float* in[33]; float* out; unsigned char* ws; int ph_lo, ph_hi; };


namespace pg8 {
typedef unsigned u32x4 __attribute__((ext_vector_type(4)));
struct RowOrder : StaticOrder {
    int lat;
    __host__ __device__ void init_rows(int lat_, int N, int G_, int c_) { lat = lat_; init(lat_ ? NBATCH * SEQ : MALL, N, G_, c_); }
    __host__ __device__ bool next(int i, Unit& u) const { if (!StaticOrder::next(i, u)) return false; if (lat) u.pm = 33 * (u.pm >> 5) + 1 + (u.pm & 31); return true; }
};
#define EPI_LOOP_ROWS for (int ai = 0; ai < 2; ++ai) _Pragma("unroll") for (int m = 0; m < 4; ++m)
#define EPI_PIN asm volatile("" ::: "memory")

struct EpiStoreBf16 {
    static constexpr bool PERM = true, AFTER_DRAIN = false;
    bf16_t* O; int ldc;
    __device__ __forceinline__ void operator()(const f32x4 (&acc)[2][2][4][2], const Unit& u, int wr, int wc, int fr, int fq) const {
        const int row0 = u.pm * BM + wr * 64 + fr, col0 = u.pn * BM + wc * 32 + 8 * fq;
#pragma unroll
        EPI_LOOP_ROWS { bf16_t* rowp = O + (size_t)(row0 + ai * HALF + m * 16) * ldc + col0;
#pragma unroll
            for (int bj = 0; bj < 2; ++bj) { const f32x4 v0 = acc[ai][bj][m][0], v1 = acc[ai][bj][m][1];
                u32x4 w; w.x = cvt_pk_bf16(v0[0], v0[1]); w.y = cvt_pk_bf16(v0[2], v0[3]); w.z = cvt_pk_bf16(v1[0], v1[1]); w.w = cvt_pk_bf16(v1[2], v1[3]);
                *(u32x4*)(rowp + bj * HALF) = w; } }
    }
};
struct EpiGate {
    static constexpr bool PERM = true, AFTER_DRAIN = false;
    bf16_t* O; int ldc; const float* bias;
    __device__ __forceinline__ void operator()(const f32x4 (&acc)[2][2][4][2], const Unit& u, int wr, int wc, int fr, int fq) const {
        const int row0 = u.pm * BM + wr * 64 + fr, col0 = u.pn * BM + wc * 32 + 8 * fq;
        f32x4 bv[2][2];
#pragma unroll
        for (int bj = 0; bj < 2; ++bj)
#pragma unroll
            for (int n = 0; n < 2; ++n) bv[bj][n] = *(const f32x4*)(bias + col0 + bj * HALF + 4 * n);
#pragma unroll
        EPI_LOOP_ROWS { EPI_PIN; bf16_t* rowp = O + (size_t)(row0 + ai * HALF + m * 16) * ldc + col0;
#pragma unroll
            for (int bj = 0; bj < 2; ++bj) { f32x4 v0 = acc[ai][bj][m][0] + bv[bj][0], v1 = acc[ai][bj][m][1] + bv[bj][1];
#pragma unroll
                for (int e = 0; e < 4; ++e) { v0[e] = __builtin_amdgcn_rcpf(1.0f + __expf(-v0[e])); v1[e] = __builtin_amdgcn_rcpf(1.0f + __expf(-v1[e])); }
                u32x4 w; w.x = cvt_pk_bf16(v0[0], v0[1]); w.y = cvt_pk_bf16(v0[2], v0[3]); w.z = cvt_pk_bf16(v1[0], v1[1]); w.w = cvt_pk_bf16(v1[2], v1[3]);
                *(u32x4*)(rowp + bj * HALF) = w; } }
    }
};
__device__ __forceinline__ float bf_lo(unsigned w) { return __builtin_bit_cast(float, w << 16); }
__device__ __forceinline__ float bf_hi(unsigned w) { return __builtin_bit_cast(float, w & 0xffff0000u); }
struct EpiMulAdd {
    static constexpr bool PERM = true, AFTER_DRAIN = false;
    bf16_t* O; const bf16_t* Gt; const bf16_t* Ad; int ldc;
    __device__ __forceinline__ void operator()(const f32x4 (&acc)[2][2][4][2], const Unit& u, int wr, int wc, int fr, int fq) const {
        const int row0 = u.pm * BM + wr * 64 + fr, col0 = u.pn * BM + wc * 32 + 8 * fq;
#pragma unroll
        EPI_LOOP_ROWS { EPI_PIN; const size_t ro = (size_t)(row0 + ai * HALF + m * 16) * ldc + col0;
#pragma unroll
            for (int bj = 0; bj < 2; ++bj) { const f32x4 v0 = acc[ai][bj][m][0], v1 = acc[ai][bj][m][1];
                const u32x4 g = *(const u32x4*)(Gt + ro + bj * HALF);
                float o[8];
                o[0] = bf_lo(g.x) * v0[0]; o[1] = bf_hi(g.x) * v0[1]; o[2] = bf_lo(g.y) * v0[2]; o[3] = bf_hi(g.y) * v0[3];
                o[4] = bf_lo(g.z) * v1[0]; o[5] = bf_hi(g.z) * v1[1]; o[6] = bf_lo(g.w) * v1[2]; o[7] = bf_hi(g.w) * v1[3];
                if (Ad) { const u32x4 a = *(const u32x4*)(Ad + ro + bj * HALF);
                    o[0] += bf_lo(a.x); o[1] += bf_hi(a.x); o[2] += bf_lo(a.y); o[3] += bf_hi(a.y); o[4] += bf_lo(a.z); o[5] += bf_hi(a.z); o[6] += bf_lo(a.w); o[7] += bf_hi(a.w); }
                u32x4 w; w.x = cvt_pk_bf16(o[0], o[1]); w.y = cvt_pk_bf16(o[2], o[3]); w.z = cvt_pk_bf16(o[4], o[5]); w.w = cvt_pk_bf16(o[6], o[7]);
                *(u32x4*)(O + ro + bj * HALF) = w; } }
    }
};
struct EpiResid {
    static constexpr bool PERM = false, AFTER_DRAIN = false;
    float* X; const float* gate;
    const float* xin; const float* cin;
    __device__ __forceinline__ void operator()(const f32x4 (&acc)[2][2][4][2], const Unit& u, int wr, int wc, int fr, int fq) const {
        const int row0 = u.pm * BM + wr * 64 + fr, col0 = u.pn * BM + wc * 32 + 4 * fq;
        const int bb = u.pm / 33, pt = u.pm - bb * 33, mr = (pt == 0) ? 2 : bb;
        const float* gp = gate + (size_t)mr * 12288 + col0;
        const float* sbase = xin ? (pt == 0 ? cin + (size_t)bb * CTXL * DM : xin + ((size_t)bb * SEQ + (size_t)(pt - 1) * BM) * DM) : X + (size_t)u.pm * BM * DM;
        f32x4 gv[2][2];
#pragma unroll
        for (int bj = 0; bj < 2; ++bj)
#pragma unroll
            for (int n = 0; n < 2; ++n) gv[bj][n] = *(const f32x4*)(gp + bj * HALF + n * 16);
#pragma unroll
        EPI_LOOP_ROWS { EPI_PIN; const int rl = wr * 64 + fr + ai * HALF + m * 16; float* rowp = X + (size_t)(u.pm * BM + rl) * DM + col0; const float* srow = sbase + (size_t)rl * DM + col0;
#pragma unroll
            for (int bj = 0; bj < 2; ++bj)
#pragma unroll
                for (int n = 0; n < 2; ++n) *(f32x4*)(rowp + bj * HALF + n * 16) = *(const f32x4*)(srow + bj * HALF + n * 16) + gv[bj][n] * acc[ai][bj][m][n]; }
    }
};
struct EpiF32 {
    static constexpr bool PERM = false, AFTER_DRAIN = false;
    float* C; int ldc;
    __device__ __forceinline__ void operator()(const f32x4 (&acc)[2][2][4][2], const Unit& u, int wr, int wc, int fr, int fq) const {
        const int row0 = u.pm * BM + wr * 64 + fr, col0 = u.pn * BM + wc * 32 + 4 * fq;
#pragma unroll
        EPI_LOOP_ROWS { float* rowp = C + (size_t)(row0 + ai * HALF + m * 16) * ldc + col0;
#pragma unroll
            for (int bj = 0; bj < 2; ++bj)
#pragma unroll
                for (int n = 0; n < 2; ++n) *(f32x4*)(rowp + bj * HALF + n * 16) = acc[ai][bj][m][n]; }
    }
};
struct EpiQ {
    static constexpr bool PERM = true, AFTER_DRAIN = false;
    bf16_t* Q; const f32x2* rope; float qscale;
    __device__ __forceinline__ void operator()(const f32x4 (&acc)[2][2][4][2], const Unit& u, int wr, int wc, int fr, int fq) const {
        const int bb = u.pm / 33, tp0 = (u.pm - bb * 33) * BM + wr * 64 + fr, col0 = u.pn * BM + wc * 32 + 8 * fq;
#pragma unroll
        for (int bj = 0; bj < 2; ++bj) { const int c = col0 + bj * HALF, hd = c / QKD, d = c - hd * QKD;
#pragma unroll
            EPI_LOOP_ROWS { EPI_PIN; const int tp = tp0 + ai * HALF + m * 16;
                f32x4 v0 = acc[ai][bj][m][0], v1 = acc[ai][bj][m][1];
                if (d >= 64) { const int i0 = (d - 64) >> 1; const f32x2* rp = rope + (size_t)tp * 16 + i0;
                    const f32x2 c0 = rp[0], c1 = rp[1], c2 = rp[2], c3 = rp[3];
                    float a, b;
                    a = v0[0]; b = v0[1]; v0[0] = a * c0.x - b * c0.y; v0[1] = a * c0.y + b * c0.x;
                    a = v0[2]; b = v0[3]; v0[2] = a * c1.x - b * c1.y; v0[3] = a * c1.y + b * c1.x;
                    a = v1[0]; b = v1[1]; v1[0] = a * c2.x - b * c2.y; v1[1] = a * c2.y + b * c2.x;
                    a = v1[2]; b = v1[3]; v1[2] = a * c3.x - b * c3.y; v1[3] = a * c3.y + b * c3.x; }
                v0 = v0 * qscale; v1 = v1 * qscale;
                u32x4 w; w.x = cvt_pk_bf16(v0[0], v0[1]); w.y = cvt_pk_bf16(v0[2], v0[3]); w.z = cvt_pk_bf16(v1[0], v1[1]); w.w = cvt_pk_bf16(v1[2], v1[3]);
                *(u32x4*)(Q + ((size_t)(bb * NH + hd) * TPB + tp) * QKD + d) = w; } }
    }
};
struct EpiKV {
    static constexpr bool PERM = true, AFTER_DRAIN = false;
    bf16_t* K; bf16_t* V;
    __device__ __forceinline__ void operator()(const f32x4 (&acc)[2][2][4][2], const Unit& u, int wr, int wc, int fr, int fq) const {
        const int bb = u.pm / 33, tp0 = (u.pm - bb * 33) * BM + wr * 64 + fr;
        const bool isK = wc < 2;
        bf16_t* base = isK ? K : V; const int pitch = isK ? QKD : 64, doff = 32 * (wc & 1) + 8 * fq;
#pragma unroll
        for (int bj = 0; bj < 2; ++bj) { const int hd = 2 * u.pn + bj;
            bf16_t* hb = base + (size_t)(bb * NH + hd) * TPB * pitch;
#pragma unroll
            EPI_LOOP_ROWS { EPI_PIN; const int tp = tp0 + ai * HALF + m * 16;
                const f32x4 v0 = acc[ai][bj][m][0], v1 = acc[ai][bj][m][1];
                u32x4 w; w.x = cvt_pk_bf16(v0[0], v0[1]); w.y = cvt_pk_bf16(v0[2], v0[3]); w.z = cvt_pk_bf16(v1[0], v1[1]); w.w = cvt_pk_bf16(v1[2], v1[3]);
                *(u32x4*)((char*)hb + (unsigned)((tp * pitch + doff) * 2)) = w; } }
    }
};
}

struct TItem { const float* W; bf16* WT; int K, ldw, c0, N, mapq, item; };
__device__ __forceinline__ void p0_item_load(const TItem& T, int lane, f32x4 (&x)[8]) {
    const int nblk = T.N / 32, kb = T.item / nblk, nb = T.item - kb * nblk, k0 = 64 * kb, n0 = 32 * nb;
    const float* p = T.W + (size_t)(k0 + (lane >> 3)) * T.ldw + T.c0 + n0 + (lane & 7) * 4;
#pragma unroll
    for (int i = 0; i < 8; ++i) x[i] = *(const GAS f32x4*)(p + (size_t)(8 * i) * T.ldw);
}
__device__ __forceinline__ void p0_item_finish(const TItem& T, const f32x4 (&x)[8], LAS float* scr, int lane) {
    const int nblk = T.N / 32, kb = T.item / nblk, nb = T.item - kb * nblk, k0 = 64 * kb, n0 = 32 * nb;
#pragma unroll
    for (int i = 0; i < 8; ++i) { LAS float* d = scr + (8 * i + (lane >> 3)) * 33 + (lane & 7) * 4; d[0] = x[i].x; d[1] = x[i].y; d[2] = x[i].z; d[3] = x[i].w; }
    LDS_WAIT(); asm volatile("" ::: "memory");
    const int c = lane & 7;
#pragma unroll
    for (int j = 0; j < 4; ++j) { const int n = (lane >> 3) + 8 * j; const LAS float* s = scr + (8 * c) * 33 + n;
        v4u o; o.x = pk2(s[0 * 33], s[1 * 33]); o.y = pk2(s[2 * 33], s[3 * 33]); o.z = pk2(s[4 * 33], s[5 * 33]); o.w = pk2(s[6 * 33], s[7 * 33]);
        int nn = n0 + n;
        if (T.mapq) { const int hd = nn / QKD, d = nn - hd * QKD; if (d >= 64) { const int i = (d - 64) & 15, s2 = (d - 64) >> 4; nn = hd * QKD + 64 + 2 * i + s2; } }
        *(GAS v4u*)(T.WT + (size_t)nn * T.K + k0 + 8 * c) = o; }
    LDS_WAIT(); asm volatile("" ::: "memory");
}

__device__ __forceinline__ const float* karg(int i);
constexpr int TB_INA = (DM / 128) * ((INA + 127) / 128), TB_G = (DM / 128) * (DM / 128), TB_BR = (RW / 128) * (DM / 128), TB_UQ = (512 / 128) * (NQ / 128), TB_UKV = (256 / 128) * (NKV / 128);
constexpr int TB_N = TB_INA + 2 * TB_G + 2 * TB_BR + TB_G + TB_UQ + TB_UKV;
constexpr int TI_LR = 1 * (RW / 32), TI_N = 4 * TI_LR;
__device__ __forceinline__ TItem p0_resolve_big(unsigned char* ws, int git) {
    const int l = git / TB_N; int r = git - l * TB_N; TItem T; T.mapq = 0; T.c0 = 0;
    if (r < TB_INA) { T.W = karg(7) + (size_t)l * DM * INC; T.K = DM; T.ldw = INC; T.N = INA; T.WT = (bf16*)(ws + WS_WINA) + (size_t)l * INA_P * DM; T.item = r; return T; } r -= TB_INA;
    if (r < TB_G) { T.W = karg(7) + (size_t)l * DM * INC; T.K = DM; T.ldw = INC; T.c0 = INA; T.N = DM; T.WT = (bf16*)(ws + WS_WGA) + (size_t)l * DM * DM; T.item = r; return T; } r -= TB_G;
    if (r < TB_G) { T.W = karg(7) + (size_t)l * DM * INC; T.K = DM; T.ldw = INC; T.c0 = INA + DM; T.N = DM; T.WT = (bf16*)(ws + WS_WGB) + (size_t)l * DM * DM; T.item = r; return T; } r -= TB_G;
    if (r < TB_BR) { T.W = karg(24) + (size_t)l * RW * DM; T.K = RW; T.ldw = DM; T.N = DM; T.WT = (bf16*)(ws + WS_WA) + (size_t)l * DM * RW; T.item = r; return T; } r -= TB_BR;
    if (r < TB_BR) { T.W = karg(25) + (size_t)l * RW * DM; T.K = RW; T.ldw = DM; T.N = DM; T.WT = (bf16*)(ws + WS_WB) + (size_t)l * DM * RW; T.item = r; return T; } r -= TB_BR;
    if (r < TB_G) { T.W = karg(26) + (size_t)l * DM * DM; T.K = DM; T.ldw = DM; T.N = DM; T.WT = (bf16*)(ws + WS_WO) + (size_t)l * DM * DM; T.item = r; return T; } r -= TB_G;
    if (r < TB_UQ) { T.W = karg(21) + (size_t)l * 512 * NQ; T.K = 512; T.ldw = NQ; T.N = NQ; T.WT = (bf16*)(ws + WS_WUQ) + (size_t)l * NQ * 512; T.item = r; T.mapq = 1; return T; } r -= TB_UQ;
    { T.W = karg(23) + (size_t)l * 256 * NKV; T.K = 256; T.ldw = NKV; T.N = NKV; T.WT = (bf16*)(ws + WS_WUKV) + (size_t)l * NKV * 256; T.item = r; return T; }
}
__device__ __forceinline__ void p0_big_load(const TItem& T, int tid, f32x4 (&x)[8]) {
    const int nblk = (T.N + 127) / 128, kb = T.item / nblk, nb = T.item - kb * nblk, k0 = 128 * kb, col = 128 * nb + (tid & 31) * 4;
    const float* p = T.W + (size_t)(k0 + (tid >> 5)) * T.ldw + T.c0 + col; const bool ok = col < T.N;
#pragma unroll
    for (int i = 0; i < 8; ++i) x[i] = ok ? *(const GAS f32x4*)(p + (size_t)(16 * i) * T.ldw) : (f32x4){0.f, 0.f, 0.f, 0.f};
}
__device__ __forceinline__ void p0_big_finish(const TItem& T, const f32x4 (&x)[8], LAS float* tile, int tid) {
    const int nblk = (T.N + 127) / 128, kb = T.item / nblk, nb = T.item - kb * nblk, k0 = 128 * kb, n0 = 128 * nb;
    __syncthreads();
#pragma unroll
    for (int i = 0; i < 8; ++i) *(LAS f32x4*)(tile + ((tid >> 5) + 16 * i) * 132 + (tid & 31) * 4) = x[i];
    __syncthreads();
    const int n = tid & 127, cg = tid >> 7; int nn = n0 + n;
    if (nn < T.N) {
        if (T.mapq) { const int hd = nn / QKD, d = nn - hd * QKD; if (d >= 64) { const int i = (d - 64) & 15, s2 = (d - 64) >> 4; nn = hd * QKD + 64 + 2 * i + s2; } }
#pragma unroll
        for (int c = 0; c < 4; ++c) { const LAS float* s = tile + (32 * cg + 8 * c) * 132 + n;
            v4u o; o.x = pk2(s[0 * 132], s[1 * 132]); o.y = pk2(s[2 * 132], s[3 * 132]); o.z = pk2(s[4 * 132], s[5 * 132]); o.w = pk2(s[6 * 132], s[7 * 132]);
            *(GAS v4u*)(T.WT + (size_t)nn * T.K + k0 + 32 * cg + 8 * c) = o; } }
}
__device__ __forceinline__ TItem p0_resolve(unsigned char* ws, int git) {
    const int l = git / TI_N; int r = git - l * TI_N; TItem T; T.mapq = 0; T.c0 = 0;
    const int which = r / TI_LR, d = which & 1, isa = which >> 1; r -= which * TI_LR;
    T.W = (isa ? karg(13) : karg(11)) + (size_t)(l * 2 + d) * 64 * RW; T.K = 64; T.ldw = RW; T.N = RW; T.WT = (bf16*)(ws + (isa ? WS_AUP : WS_WUP)) + (size_t)(l * 2 + d) * RW * 64; T.item = r; return T;
}
__device__ __forceinline__ void p0_prologue(Frame& F) {
    LAS float* scr = (LAS float*)(F.lds + F.wave * 16384);
    const int gw = F.vcu * NWAVES + F.wave, NGW = F.G * NWAVES;
    unsigned char* ws = F.ws;
    for (int rp_ = 0; rp_ < (DBG_REPEAT == 102 ? 2 : 1); ++rp_)
    { float* modw = (float*)(ws + WS_CTL + CTL_MOD_OFF); const float* adaw = karg(4); const float* adab = karg(5); const float* cin = karg(1); const float* cctx = karg(3);
      LAS float* SIL = (LAS float*)F.lds;
      LAS f32x2* part = (LAS f32x2*)(F.lds + 32768);
      if (F.vcu < NLAYER * 96) {
          for (int i = F.tid; i < 3 * DM; i += 512) { const int r = i >> 11, k = i & 2047; const float c = r < 2 ? cin[r * DM + k] : cctx[k]; SIL[i] = c / (1.f + __expf(-c)); }
          __syncthreads(); }
      for (int uu = F.vcu; uu < NLAYER * 96; uu += F.G) { const int cb = uu % 96, l = uu / 96;
          const int n0 = cb * 128 + F.lane * 2; const float* aw = adaw + (size_t)l * DM * 12288 + n0;
          f32x2 a0 = {0, 0}, a1 = a0, a2 = a0;
#pragma unroll 1
          for (int k0 = F.wave * 256; k0 < F.wave * 256 + 256; k0 += 16) { f32x2 w[16];
#pragma unroll
              for (int j = 0; j < 16; ++j) w[j] = *(const GAS f32x2*)(aw + (size_t)(k0 + j) * 12288);
#pragma unroll
              for (int j = 0; j < 16; ++j) { a0 = a0 + w[j] * SIL[k0 + j]; a1 = a1 + w[j] * SIL[DM + k0 + j]; a2 = a2 + w[j] * SIL[2 * DM + k0 + j]; } }
          __syncthreads();
          part[(F.wave * 3 + 0) * 64 + F.lane] = a0; part[(F.wave * 3 + 1) * 64 + F.lane] = a1; part[(F.wave * 3 + 2) * 64 + F.lane] = a2;
          __syncthreads();
          if (F.wave < 3) { f32x2 s = *(const GAS f32x2*)(adab + (size_t)l * 12288 + n0);
#pragma unroll
              for (int w8 = 0; w8 < 8; ++w8) s = s + part[(w8 * 3 + F.wave) * 64 + F.lane];
              *(GAS f32x2*)(modw + ((size_t)l * 3 + F.wave) * 12288 + n0) = s; }
          __syncthreads(); } }
    for (int rp_ = 0; rp_ < (DBG_REPEAT == 101 ? 2 : 1); ++rp_)
    { unsigned* ctr = (unsigned*)(ws + WS_CTL) + 2048 + 64 * rp_; LAS float* tile = (LAS float*)F.lds; LAS int* slot = (LAS int*)(F.lds + 128 * 132 * 4);
#define P0_GRAB(dst) do { __syncthreads(); if (F.tid == 0) *slot = (int)__hip_atomic_fetch_add(ctr, 1u, __ATOMIC_RELAXED, __HIP_MEMORY_SCOPE_AGENT); __syncthreads(); dst = *slot; } while (0)
      int it; P0_GRAB(it); f32x4 xa[8], xb[8]; TItem T, Tn;
      if (it < NLAYER * TB_N) { T = p0_resolve_big(ws, it); p0_big_load(T, F.tid, xa); }
      while (it < NLAYER * TB_N) { int itn; P0_GRAB(itn); const bool more = itn < NLAYER * TB_N;
          if (more) { Tn = p0_resolve_big(ws, itn); p0_big_load(Tn, F.tid, xb); }
          p0_big_finish(T, xa, tile, F.tid);
          if (more) { T = Tn;
#pragma unroll
              for (int i = 0; i < 8; ++i) xa[i] = xb[i]; }
          it = itn; }
#undef P0_GRAB
      __syncthreads();
      for (int itw = gw; itw < NLAYER * TI_N; itw += NGW) { f32x4 xw[8]; const TItem Tw = p0_resolve(ws, itw); p0_item_load(Tw, F.lane, xw); p0_item_finish(Tw, xw, scr, F.lane); }
    }
    const int gt = gw * 64 + F.lane, NGT = NGW * 64;
    { const float* gup = karg(14);
    for (int i = gt; i < NLAYER * 2 * 32 * RW; i += NGT) { const int ch = i & 1023, r = (i >> 10) & 31, ld = i >> 15;
        ((bf16*)(ws + WS_GUP))[((size_t)ld * RW + ch) * 32 + r] = (bf16)f2bf(gup[i]); } }
    for (int i = gt; i < NLAYER * (INA_P - INA) * DM / 8; i += NGT) { const int l = i / ((INA_P - INA) * DM / 8), r = i - l * ((INA_P - INA) * DM / 8);
        ((GAS v4u*)((bf16*)(ws + WS_WINA) + ((size_t)l * INA_P + INA) * DM))[r] = (v4u){0u, 0u, 0u, 0u}; }
    { f32x2* rt = (f32x2*)(ws + WS_ROPE);
      for (int i = gt; i < TPB * 16; i += NGT) { const int tp = i >> 4, k = i & 15; f32x2 o = {1.f, 0.f};
          if (tp >= CTXL) { const int t = tp - CTXL, row = t >> 6, col = t & 63, j = k & 7; const float fr = powf(10000.0f, -(float)j / 8.0f);
              const float ang = (float)(k < 8 ? row : col) * fr; o.x = cosf(ang); o.y = sinf(ang); }
          rt[i] = o; } }
    for (int rp_ = 0; rp_ < (DBG_REPEAT == 103 ? 2 : 1); ++rp_)
    { LAS float* KEY = (LAS float*)F.lds;
      LAS float* WQT = (LAS float*)(F.lds + 65536);
      const float* pkeys = karg(29); const float* pwq = karg(28);
      __syncthreads();
      for (int uu = F.vcu; uu < NLAYER * 16 * 32; uu += F.G) { const int kb = uu & 31, hp = (uu >> 5) & 15, l = uu >> 9;
          const GAS f32x4* ksrc = (const GAS f32x4*)(pkeys + ((size_t)l * 16 + hp) * 16384);
          for (int i = F.tid; i < 4096; i += 512) ((LAS f32x4*)KEY)[i] = ksrc[i];
          for (int i = F.tid; i < 2048; i += 512) { const int kk = i >> 5, d4 = i & 31;
              *(LAS f32x4*)(WQT + kk * 132 + d4 * 4) = *(const GAS f32x4*)(pwq + ((size_t)l * DM + kb * 64 + kk) * DM + hp * 128 + d4 * 4); }
          __syncthreads();
          const int kq = F.tid & 15, keyq = F.tid >> 4;
          float acc[4][4];
#pragma unroll
          for (int j = 0; j < 4; ++j)
#pragma unroll
              for (int i = 0; i < 4; ++i) acc[j][i] = 0.f;
          for (int d = 0; d < 128; d += 4) { f32x4 w[4], q[4];
#pragma unroll
              for (int i = 0; i < 4; ++i) w[i] = *(LAS f32x4*)(WQT + (kq + 16 * i) * 132 + d);
#pragma unroll
              for (int j = 0; j < 4; ++j) q[j] = *(LAS f32x4*)(KEY + (4 * keyq + j) * 128 + d);
#pragma unroll
              for (int j = 0; j < 4; ++j)
#pragma unroll
                  for (int i = 0; i < 4; ++i) acc[j][i] += q[j].x * w[i].x + q[j].y * w[i].y + q[j].z * w[i].z + q[j].w * w[i].w; }
          bf16* dst = (bf16*)(ws + WS_WQK) + ((size_t)l * DM + hp * 128 + 4 * keyq) * DM + kb * 64 + kq;
#pragma unroll
          for (int j = 0; j < 4; ++j)
#pragma unroll
              for (int i = 0; i < 4; ++i) dst[(size_t)j * DM + 16 * i] = (bf16)f2bf(acc[j][i]);
          __syncthreads(); } }
}

__device__ __forceinline__ void modnorm_phase(Frame& F, const float* X, const float* g, const float* mod  , int chunk_sh, bf16* H, int skip_ctx, const float* xin = nullptr, const float* cin = nullptr) {
    const int gw = F.vcu * NWAVES + F.wave, NGW = F.G * NWAVES;
    for (int m = gw; m < MALL; m += NGW) {
        const int b = m / TPB, tp = m - b * TPB; if (skip_ctx && tp < CTXL) continue;
        const int mr = tp < CTXL ? 2 : b;
        const float* srow = xin ? (tp < CTXL ? cin + ((size_t)b * CTXL + tp) * DM : xin + ((size_t)b * SEQ + (tp - CTXL)) * DM) : X + (size_t)m * DM;
        const GAS f32x4* xr = (const GAS f32x4*)srow + F.lane;
        f32x4 v[8]; float s = 0.f;
#pragma unroll
        for (int j = 0; j < 8; ++j) { v[j] = xr[64 * j]; s += (v[j].x * v[j].x + v[j].y * v[j].y) + (v[j].z * v[j].z + v[j].w * v[j].w); }
        const float rs = rsqrtf(wave_sum(s) * (1.f / DM) + NORM_EPS);
        const float* sh = mod + (size_t)mr * 12288 + chunk_sh * DM; const float* sc = sh + DM;
        GAS v2u* o8 = (GAS v2u*)(H + (size_t)m * DM) + F.lane;
#pragma unroll
        for (int j = 0; j < 8; ++j) { const int c = (F.lane + 64 * j) * 4;
            const f32x4 gg = *(const GAS f32x4*)(g + c), s1 = *(const GAS f32x4*)(sc + c), s0 = *(const GAS f32x4*)(sh + c);
            f32x4 y = v[j] * rs * gg; y = y * (s1 + 1.0f) + s0;
            v2u o; o.x = pk2(y.x, y.y); o.y = pk2(y.z, y.w); o8[64 * j] = o; }
    }
}

typedef float f32x4v __attribute__((ext_vector_type(4)));
#define MFMA16(a, b, c) __builtin_amdgcn_mfma_f32_16x16x32_bf16((a), (b), (c), 0, 0, 0)
#define MFMA32(a, b, c) __builtin_amdgcn_mfma_f32_32x32x16_bf16((a), (b), (c), 0, 0, 0)

struct FeatP {
    const bf16* PA; const float* mu; const float* w0; const float* a0; const float* k_k; const float* k_a; const float* r_k;
    const bf16* WUP; const bf16* AUP; const bf16* GUP;
    const float* qnorm; const float* kvnorm; const f32x2* rope;
    bf16* RI; bf16* GG; float* BON; bf16* QN; bf16* KVN; bf16* K;
};
__device__ __forceinline__ f32x4 ld4bf(const bf16* p) { const v2u w = *(const GAS v2u*)p; return (f32x4){bflo(w.x), bfhi(w.x), bflo(w.y), bfhi(w.y)}; }
__device__ __forceinline__ f32x4 mix4(const bf16* PA, int m, int c, bool hp, bool hn, const float* mu) {
    const f32x4 pc = ld4bf(PA + (size_t)m * INA_P + c);
    f32x4 pp = {0, 0, 0, 0}, pn = {0, 0, 0, 0};
    if (hp) pp = ld4bf(PA + (size_t)(m - 1) * INA_P + c);
    if (hn) pn = ld4bf(PA + (size_t)(m + 1) * INA_P + c);
    const f32x4 mm = *(const GAS f32x4*)(mu + c);
    return pc + ((pp + pn) * 0.5f - pc) * mm;
}
__device__ __forceinline__ void unpack8(const v4u w, float (&x)[8]) { x[0] = bflo(w.x); x[1] = bfhi(w.x); x[2] = bflo(w.y); x[3] = bfhi(w.y); x[4] = bflo(w.z); x[5] = bfhi(w.z); x[6] = bflo(w.w); x[7] = bfhi(w.w); }
__device__ __forceinline__ v4u pack8f(const float (&x)[8]) { v4u o; o.x = pk2(x[0], x[1]); o.y = pk2(x[2], x[3]); o.z = pk2(x[4], x[5]); o.w = pk2(x[6], x[7]); return o; }
__device__ __forceinline__ void mix8(const bf16* rowc, bool hp, bool hn, const float (&mu)[8], float (&o)[8]) {
    const v4u zc = {0u, 0u, 0u, 0u};
    const v4u wc = *(const GAS v4u*)rowc, wp = hp ? *(const GAS v4u*)(rowc - INA_P) : zc, wn = hn ? *(const GAS v4u*)(rowc + INA_P) : zc;
    float c[8], p[8], n[8]; unpack8(wc, c); unpack8(wp, p); unpack8(wn, n);
#pragma unroll
    for (int e = 0; e < 8; ++e) o[e] = c[e] + (0.5f * (p[e] + n[e]) - c[e]) * mu[e];
}
struct Raw3 { v4u c, p, n; };
__device__ __forceinline__ Raw3 load3(const bf16* rowc, bool hp, bool hn) { const v4u zc = {0u, 0u, 0u, 0u}; Raw3 r; r.c = *(const GAS v4u*)rowc; r.p = hp ? *(const GAS v4u*)(rowc - INA_P) : zc; r.n = hn ? *(const GAS v4u*)(rowc + INA_P) : zc; return r; }
__device__ __forceinline__ void mix8r(const Raw3& w, const float (&mu)[8], float (&o)[8]) {
    float c[8], p[8], n[8]; unpack8(w.c, c); unpack8(w.p, p); unpack8(w.n, n);
#pragma unroll
    for (int e = 0; e < 8; ++e) o[e] = c[e] + (0.5f * (p[e] + n[e]) - c[e]) * mu[e];
}
__device__ __forceinline__ void features_phase(Frame& F, const FeatP& P) {
    constexpr int LAP = 328;
    LAS bf16* LA = (LAS bf16*)F.lds;
    LAS float* SSQ = (LAS float*)(F.lds + 10752);
    LAS float* PRM = (LAS float*)(F.lds + 12288);
    const int lane = F.lane, w = F.wave, tk = lane & 15, q4 = lane >> 4;
    constexpr int NTILE = MALL / 16, NTG = 64;
    for (int su = F.vcu; su < 4 * NTG; su += F.G) {
        const int cg = su & 3, tg = su >> 2, cw = 256 * cg + 32 * w, ch8 = cw + 8 * q4, hd = 4 * cg + (w >> 1);
        __syncthreads();
        for (int i = F.tid; i < 2560; i += 512) { const int prm = i >> 8, c = (i & 255) + 256 * cg; float v;
            switch (prm) { case 0: v = P.k_k[c]; break; case 1: v = P.k_a[c]; break; case 2: v = P.r_k[c]; break; case 3: v = P.w0[c]; break; case 4: v = P.w0[RW + c]; break;
                           case 5: v = P.a0[c]; break; case 6: v = P.a0[RW + c]; break; case 7: v = P.mu[c]; break; case 8: v = P.mu[RW + c]; break; default: v = P.mu[2 * RW + c]; break; }
            PRM[i] = v; }
        bf16x8 fw[2][2][2], fa[2][2][2], fg[2][2];
        { const int chA = cw + 8 * (tk >> 2) + (tk & 3);
#pragma unroll
          for (int d = 0; d < 2; ++d)
#pragma unroll
              for (int t = 0; t < 2; ++t) {
#pragma unroll
                  for (int ks = 0; ks < 2; ++ks) { fw[d][t][ks] = *(const GAS bf16x8*)(P.WUP + ((size_t)d * RW + chA + 4 * t) * 64 + ks * 32 + q4 * 8); fa[d][t][ks] = *(const GAS bf16x8*)(P.AUP + ((size_t)d * RW + chA + 4 * t) * 64 + ks * 32 + q4 * 8); }
                  fg[d][t] = *(const GAS bf16x8*)(P.GUP + ((size_t)d * RW + chA + 4 * t) * 32 + q4 * 8); } }
        for (int tt = tg; tt < NTILE; tt += NTG) {
            const int m0 = tt * 16;
            const int m = m0 + tk, b = m / TPB, tp = m - b * TPB;
            const bool hp = (tp != 0) && (tp != CTXL), hn = (tp != CTXL - 1) && (tp != TPB - 1);
            const bf16* rowp = P.PA + (size_t)m * INA_P + ch8;
            const Raw3 rawk = load3(rowp + RW, hp, hn), rawr = load3(rowp, hp, hn), rawv = load3(rowp + 2 * RW, hp, hn);
            __syncthreads();
            for (int it = F.tid; it < 640; it += 512) { const int tkk = it / 40, c8 = (it - tkk * 40) * 8, c = C_WD + c8, m = m0 + tkk, tp = m % TPB;
                const bool hp = (tp != 0) && (tp != CTXL), hn = (tp != CTXL - 1) && (tp != TPB - 1);
                float mu[8], v[8];
                { const f32x4 a = *(const GAS f32x4*)(P.mu + c), b2 = *(const GAS f32x4*)(P.mu + c + 4); mu[0] = a.x; mu[1] = a.y; mu[2] = a.z; mu[3] = a.w; mu[4] = b2.x; mu[5] = b2.y; mu[6] = b2.z; mu[7] = b2.w; }
                mix8(P.PA + (size_t)m * INA_P + c, hp, hn, mu, v);
#pragma unroll
                for (int e = 0; e < 8; ++e) { if (c < C_AD) v[e] = 1.0f - 2.0f * __builtin_amdgcn_rcpf(1.0f + __expf(2.0f * v[e])); else if (c >= C_GD) v[e] = sigmoidf_(v[e]); }
                *(LAS v4u*)(LA + tkk * LAP + c8) = pack8f(v); }
            if ((tt & 3) == cg) {
#pragma unroll
                for (int t2 = 0; t2 < 2; ++t2) { const int m = m0 + 2 * w + t2, b = m / TPB, tp = m - b * TPB; const bf16* row = P.PA + (size_t)m * INA_P;
                    { float x[8]; unpack8(*(const GAS v4u*)(row + C_QC + lane * 8), x); float s = 0.f;
#pragma unroll
                      for (int e = 0; e < 8; ++e) s += x[e] * x[e];
                      const float rs = rsqrtf(wave_sum(s) * (1.f / 512.f) + NORM_EPS);
#pragma unroll
                      for (int e = 0; e < 8; ++e) x[e] = x[e] * rs * P.qnorm[lane * 8 + e];
                      *(GAS v4u*)(P.QN + (size_t)m * 512 + lane * 8) = pack8f(x); }
                    { const v2u q = *(const GAS v2u*)(row + C_KVC + lane * 4);
                      float x[4] = {bflo(q.x), bfhi(q.x), bflo(q.y), bfhi(q.y)}; float s = 0.f;
#pragma unroll
                      for (int e = 0; e < 4; ++e) s += x[e] * x[e];
                      const float rs = rsqrtf(wave_sum(s) * (1.f / 256.f) + NORM_EPS);
#pragma unroll
                      for (int e = 0; e < 4; ++e) x[e] = x[e] * rs * P.kvnorm[lane * 4 + e];
                      v2u o; o.x = pk2(x[0], x[1]); o.y = pk2(x[2], x[3]);
                      *(GAS v2u*)(P.KVN + (size_t)m * 256 + lane * 4) = o; }
                    if (lane < 16) { const float x1 = bf1(row[C_KR + lane]), x2 = bf1(row[C_KR + 16 + lane]); const f32x2 cs = P.rope[(size_t)tp * 16 + lane];
                        const unsigned o = pk2(x1 * cs.x - x2 * cs.y, x1 * cs.y + x2 * cs.x);
#pragma unroll
                        for (int h2 = 0; h2 < NH; ++h2) *(GAS unsigned*)(P.K + ((size_t)(b * NH + h2) * TPB + tp) * QKD + 64 + 2 * lane) = o; } } }
            const int pc = 32 * w + 8 * q4;
            float prm[8], kmx[8], kx[8];
#pragma unroll
            for (int e = 0; e < 8; ++e) prm[e] = PRM[8 * 256 + pc + e];
            mix8r(rawk, prm, kmx);
            { float s = 0.f;
#pragma unroll
              for (int e = 0; e < 8; ++e) { kx[e] = kmx[e] * PRM[0 * 256 + pc + e]; s += kx[e] * kx[e]; }
              s += bpermf(lane ^ 16, s); s += bpermf(lane ^ 32, s);
              if (q4 == 0) SSQ[tk * 8 + w] = s; }
            __syncthreads();
            const float rsn = rsqrtf(SSQ[tk * 8 + w] + SSQ[tk * 8 + (w ^ 1)] + 1e-12f);
            f32x4 cw_[2][2], ca_[2][2], cg_[2][2];
#pragma unroll
            for (int d = 0; d < 2; ++d) {
                const bf16x8 bg = *(const LAS bf16x8*)(LA + tk * LAP + 256 + d * 32 + q4 * 8);
                bf16x8 bw[2], ba[2];
#pragma unroll
                for (int ks = 0; ks < 2; ++ks) { bw[ks] = *(const LAS bf16x8*)(LA + tk * LAP + d * 64 + ks * 32 + q4 * 8); ba[ks] = *(const LAS bf16x8*)(LA + tk * LAP + 128 + d * 64 + ks * 32 + q4 * 8); }
#pragma unroll
                for (int t = 0; t < 2; ++t) { f32x4 z = {0, 0, 0, 0};
                    cw_[d][t] = MFMA16(fw[d][t][1], bw[1], MFMA16(fw[d][t][0], bw[0], z));
                    ca_[d][t] = MFMA16(fa[d][t][1], ba[1], MFMA16(fa[d][t][0], ba[0], z));
                    cg_[d][t] = MFMA16(fg[d][t], bg, z); } }
            float r8[8], v8[8], kk8[8];
#pragma unroll
            for (int e = 0; e < 8; ++e) prm[e] = PRM[7 * 256 + pc + e];
            mix8r(rawr, prm, r8);
#pragma unroll
            for (int e = 0; e < 8; ++e) prm[e] = PRM[9 * 256 + pc + e];
            mix8r(rawv, prm, v8);
#pragma unroll
            for (int e = 0; e < 8; ++e) kk8[e] = kx[e] * rsn;
            bf16* rec = P.RI + ((size_t)(b * NH + hd) * TPB + tp) * RREC + (ch8 & 63);
            *(GAS v4u*)(rec) = pack8f(r8); *(GAS v4u*)(rec + 64) = pack8f(kk8); *(GAS v4u*)(rec + 128) = pack8f(v8);
#pragma unroll
            for (int d = 0; d < 2; ++d) {
                float ld[8], ke[8], bb[8], gg[8]; float bs = 0.f;
#pragma unroll
                for (int e = 0; e < 8; ++e) { const int t = e >> 2, r = e & 3;
                    ld[e] = -0.60653066f * sigmoidf_(PRM[(3 + d) * 256 + pc + e] + cw_[d][t][r]);
                    const float aa = sigmoidf_(PRM[(5 + d) * 256 + pc + e] + ca_[d][t][r]);
                    ke[e] = kmx[e] * (1.0f + (aa - 1.0f) * PRM[1 * 256 + pc + e]); bb[e] = kk8[e] * aa; gg[e] = cg_[d][t][r];
                    bs += r8[e] * ke[e] * PRM[2 * 256 + pc + e]; }
                *(GAS v4u*)(rec + (3 + 3 * d) * 64) = pack8f(ld); *(GAS v4u*)(rec + (4 + 3 * d) * 64) = pack8f(bb); *(GAS v4u*)(rec + (5 + 3 * d) * 64) = pack8f(ke);
                *(GAS v4u*)(P.GG + ((size_t)d * MALL + m) * RW + ch8) = pack8f(gg);
                bs += bpermf(lane ^ 16, bs); bs += bpermf(lane ^ 32, bs);
                if (q4 == 0) P.BON[((size_t)d * MALL + m) * 32 + 2 * hd + (w & 1)] = bs; }
        }
    }
}

__device__ __forceinline__ void cvt_row_load(f32x4 (&x)[8], const float* src) {
#pragma unroll
    for (int q = 0; q < 8; ++q) x[q] = *(const GAS f32x4*)(src + q * 4);
}
__device__ __forceinline__ void cvt_row_store(const f32x4 (&x)[8], unsigned char* dst, float* scale_slot, int lane) {
    float am = 0.f;
#pragma unroll
    for (int q = 0; q < 8; ++q) am = fmaxf(am, fmaxf(fmaxf(fabsf(x[q].x), fabsf(x[q].y)), fmaxf(fabsf(x[q].z), fabsf(x[q].w))));
    am = fmaxf(wave_max_u(am), 1e-30f);
    const float g = 6.0f / am, inv = am * (1.0f / 6.0f);
    v4u o;
#pragma unroll
    for (int q = 0; q < 4; ++q) { unsigned w = 0u;
        w = __builtin_amdgcn_cvt_scalef32_pk_fp4_f32(w, x[2 * q].x * g, x[2 * q].y * g, 1.0f, 0);
        w = __builtin_amdgcn_cvt_scalef32_pk_fp4_f32(w, x[2 * q].z * g, x[2 * q].w * g, 1.0f, 1);
        w = __builtin_amdgcn_cvt_scalef32_pk_fp4_f32(w, x[2 * q + 1].x * g, x[2 * q + 1].y * g, 1.0f, 2);
        w = __builtin_amdgcn_cvt_scalef32_pk_fp4_f32(w, x[2 * q + 1].z * g, x[2 * q + 1].w * g, 1.0f, 3);
        o[q] = w; }
    *(GAS v4u*)dst = o;
    if (lane == 0) *scale_slot = inv;
}
struct ScanCvt { const float* pu; const float* pv; unsigned char* PU8; unsigned char* PV8; float* SU; float* SV; };
constexpr int SCH = 32;
constexpr int SSTEP = 6 * 64;
__device__ __forceinline__ int scan_tp(int dir, int s) { return dir == 0 ? s : (s < CTXL ? (CTXL - 1 - s) : (TPB - 1 - (s - CTXL))); }
__device__ __forceinline__ void scan_load(v4u (&rg)[6], const bf16* RIh, int dir, int chunk, int htid) {
    const int tp = scan_tp(dir, chunk * SCH + (htid >> 3));
    const bf16* rec = RIh + (size_t)tp * RREC + (htid & 7) * 8;
#pragma unroll
    for (int i = 0; i < 3; ++i) rg[i] = *(const GAS v4u*)(rec + i * 64);
    rec += (3 + 3 * dir) * 64;
#pragma unroll
    for (int i = 0; i < 3; ++i) rg[3 + i] = *(const GAS v4u*)(rec + i * 64);
}
__device__ __forceinline__ void scan_store(const v4u (&rg)[6], LAS float* buf, int htid) {
    LAS float* d0 = buf + (htid >> 3) * SSTEP + (htid & 7) * 8;
#pragma unroll
    for (int i = 0; i < 6; ++i) { constexpr int SLOT[6] = {4, 0, 5, 2, 1, 3};
        const v4u wv = rg[i];
        f32x4 lo = {bflo(wv.x), bfhi(wv.x), bflo(wv.y), bfhi(wv.y)}, hi = {bflo(wv.z), bfhi(wv.z), bflo(wv.w), bfhi(wv.w)};
        if (i == 3) {
#pragma unroll
            for (int e = 0; e < 4; ++e) { lo[e] = __expf(lo[e]); hi[e] = __expf(hi[e]); } }
        LAS float* d = d0 + SLOT[i] * 64;
        *(LAS f32x4*)d = lo; *(LAS f32x4*)(d + 4) = hi; }
}
__device__ __forceinline__ void scan_phase(Frame& F, const bf16* RI, bf16* Y, const ScanCvt& C) {
    LAS float* bufs = (LAS float*)F.lds;
    constexpr int NCH = TPB / SCH;
    for (int uu = F.vcu; uu < NBATCH * NH * 2 * 4; uu += F.G) {
        const int rg = uu & 3, dir = (uu >> 2) & 1, hd = (uu >> 3) & 15, b = uu >> 7;
        const bf16* RIh = RI + (size_t)(b * NH + hd) * TPB * RREC;
        const int htid = F.tid - 256;
        v4u ra[6], rb[6];
        f32x4 xc[8];
        __syncthreads();
        if (F.wave >= 4) { scan_load(rb, RIh, dir, 0, htid); scan_load(ra, RIh, dir, 1, htid); scan_store(rb, bufs, htid); scan_load(rb, RIh, dir, 2, htid); }
        __syncthreads();
        const int j = F.lane & 15, rowl = F.lane >> 4, row = rg * 16 + (F.wave & 3) * 4 + rowl;
        f32x2 S01 = {0.f, 0.f}, S23 = {0.f, 0.f};
        bf16* yb = Y + ((size_t)dir * MALL + (size_t)b * TPB) * RW + hd * 64 + row;
        for (int c = 0; c < NCH; ++c) {
            LAS float* cur = bufs + (c & 1) * (SCH * SSTEP);
            if (F.wave >= 4) {
                if (c + 1 < NCH) {
                    if ((c & 1) == 0) { scan_store(ra, bufs + (SCH * SSTEP), htid); if (c + 3 < NCH) scan_load(ra, RIh, dir, c + 3, htid); }
                    else { scan_store(rb, bufs, htid); if (c + 3 < NCH) scan_load(rb, RIh, dir, c + 3, htid); }  }
                if ((c & 3) == 0 && (c >> 3) < 32) { const int r = uu * 4 + (F.wave - 4) + 1024 * (c >> 3);
                    if ((c & 7) == 0) cvt_row_load(xc, ((r >= NEXP) ? C.pv + (size_t)(r - NEXP) * DM : C.pu + (size_t)r * DM) + F.lane * 32);
                    else cvt_row_store(xc, ((r >= NEXP) ? C.PV8 + (size_t)(r - NEXP) * (DM / 2) : C.PU8 + (size_t)r * (DM / 2)) + F.lane * 16, (r >= NEXP) ? C.SV + (r - NEXP) : C.SU + r, F.lane); } }
            else {
#pragma unroll
                for (int h16 = 0; h16 < 2; ++h16) {
                    const LAS float* sp = cur + (h16 * 16) * SSTEP;
                    f32x4 kk = *(const LAS f32x4*)(sp + 4 * j), bb = *(const LAS f32x4*)(sp + 64 + 4 * j), ww = *(const LAS f32x4*)(sp + 128 + 4 * j),
                          ke = *(const LAS f32x4*)(sp + 192 + 4 * j), rr = *(const LAS f32x4*)(sp + 256 + 4 * j);
                    float ykeep = 0.f, ypart; f32x2 u2, t2, vv; vv.x = sp[320 + row];
#define SCAN_DPP(r, ctl) "v_add_f32_dpp " r ", " r ", " r " " ctl " row_mask:0xf bank_mask:0xf bound_ctrl:1\n\t"
#define SCAN_MAIN(SEL) asm volatile( \
                        "v_pk_mul_f32 v[242:243], %[kexy], %[vv] op_sel_hi:[1,0]\n\t" \
                        "v_add_f32 v246, v250, v251\n\t" \
                        "v_add_f32_dpp v248, %[yp], %[yp] quad_perm:[1,0,3,2] row_mask:0xf bank_mask:0xf bound_ctrl:1\n\t" \
                        "v_pk_mul_f32 v[244:245], %[kezw], %[vv] op_sel_hi:[1,0]\n\t" \
                        SCAN_DPP("v246", "quad_perm:[1,0,3,2]") SCAN_DPP("v248", "quad_perm:[2,3,0,1]") \
                        "v_pk_fma_f32 %[s01], %[s01], %[wwxy], v[242:243]\n\t" \
                        SCAN_DPP("v246", "quad_perm:[2,3,0,1]") SCAN_DPP("v248", "row_half_mirror") \
                        "v_pk_fma_f32 %[s23], %[s23], %[wwzw], v[244:245]\n\t" \
                        SCAN_DPP("v246", "row_half_mirror") SCAN_DPP("v248", "row_mirror") \
                        SEL "\n\t" \
                        SCAN_DPP("v246", "row_mirror") \
                        "v_pk_fma_f32 %[s01], %[bbxy], v[246:247], %[s01] op_sel_hi:[1,0,1] neg_lo:[0,1,0] neg_hi:[0,1,0]\n\t" \
                        "v_pk_fma_f32 %[s23], %[bbzw], v[246:247], %[s23] op_sel_hi:[1,0,1] neg_lo:[0,1,0] neg_hi:[0,1,0]\n\t" \
                        "v_pk_mul_f32 v[252:253], %[s01], %[rrxy]" \
                        : [s01] "+v"(S01), [s23] "+v"(S23), [yk] "+v"(ykeep), "={v[252:253]}"(u2) \
                        : [kexy] "v"(ke.xy), [kezw] "v"(ke.zw), [vv] "v"(vv), [wwxy] "v"(ww.xy), [wwzw] "v"(ww.zw), [bbxy] "v"(bb.xy), [bbzw] "v"(bb.zw), [rrxy] "v"(rr.xy), [yp] "v"(ypart), [msk] "s"(msk), "{v[250:251]}"(t2) \
                        : "v242", "v243", "v244", "v245", "v246", "v247", "v248")
                    asm volatile("v_pk_mul_f32 v[250:251], %[s01], %[kxy]\n\tv_mov_b32 %[yp], 0\n\tv_pk_fma_f32 v[250:251], %[s23], %[kzw], v[250:251]"
                                 : "=&{v[250:251]}"(t2), [yp] "=&v"(ypart) : [s01] "v"(S01), [s23] "v"(S23), [kxy] "v"(kk.xy), [kzw] "v"(kk.zw));
#pragma unroll
                    for (int st = 0; st < 16; ++st) {
                        f32x4 nkk = kk, nbb = bb, nww = ww, nke = ke, nrr = rr; f32x2 nvv = vv;
                        const LAS float* sn = sp + (st + 1) * SSTEP;
                        if (st + 1 < 16) { nkk = *(const LAS f32x4*)(sn + 4 * j); nke = *(const LAS f32x4*)(sn + 192 + 4 * j); nvv.x = sn[320 + row]; nww = *(const LAS f32x4*)(sn + 128 + 4 * j); nbb = *(const LAS f32x4*)(sn + 64 + 4 * j);
                            nrr = *(const LAS f32x4*)(sn + 256 + 4 * j); }
                        const unsigned long long msk = 0x0001000100010001ull << ((st + 15) & 15);
                        if (st > 0) SCAN_MAIN("v_cndmask_b32_e64 %[yk], %[yk], v248, %[msk]"); else SCAN_MAIN("s_nop 0");
                        if (st + 1 < 16)
                            asm volatile("v_pk_mul_f32 v[250:251], %[s01], %[kxy]\n\tv_pk_fma_f32 v[252:253], %[s23], %[rrzw], v[252:253]\n\tv_pk_fma_f32 v[250:251], %[s23], %[kzw], v[250:251]\n\tv_add_f32 %[yp], v252, v253"
                                         : "=&{v[250:251]}"(t2), "={v[252:253]}"(u2), [yp] "=&v"(ypart) : [s01] "v"(S01), [s23] "v"(S23), [kxy] "v"(nkk.xy), [kzw] "v"(nkk.zw), [rrzw] "v"(rr.zw), "1"(u2));
                        else
                            asm volatile("s_nop 0\n\tv_pk_fma_f32 v[252:253], %[s23], %[rrzw], v[252:253]" : "={v[252:253]}"(u2) : [s23] "v"(S23), [rrzw] "v"(rr.zw), "0"(u2));
                        kk = nkk; bb = nbb; ww = nww; ke = nke; rr = nrr; vv = nvv;
                        __builtin_amdgcn_sched_barrier(0);
                    }
#undef SCAN_MAIN
#undef SCAN_DPP
                    { const float y = red16(u2.x + u2.y); ykeep = (j == 15) ? y : ykeep; }
                    const int tp = scan_tp(dir, c * SCH + h16 * 16 + j);
                    *(GAS bf16*)(yb + (size_t)tp * RW) = (bf16)f2bf(ykeep);
                }
            }
            __syncthreads();
        }
    }
}

constexpr int AKP = 208, AVP = 192;
constexpr int ATILE = 64 * AKP + 64 * AVP;
__device__ __forceinline__ bf16x8 pack8(const f32x16& x, int s) {
    v4u p; p.x = pk2(x[8 * s + 0], x[8 * s + 1]); p.y = pk2(x[8 * s + 2], x[8 * s + 3]); p.z = pk2(x[8 * s + 4], x[8 * s + 5]); p.w = pk2(x[8 * s + 6], x[8 * s + 7]);
    return __builtin_bit_cast(bf16x8, p);
}
__device__ __forceinline__ void attn_phase(Frame& F, const bf16* Q, const bf16* K, const bf16* V, bf16* YB, int with_ctx) {
    const int lane = F.lane, half = lane >> 5, l31 = lane & 31, l16 = lane & 15, g1 = (lane >> 4) & 1;
    const int nunits = NBATCH * NH * 32 + (with_ctx ? NBATCH * NH : 0);
    for (int uu = F.vcu; uu < nunits; uu += F.G) {
        int bh, q0, nkt;
        if (uu < NBATCH * NH * 32) { bh = uu >> 5; q0 = CTXL + (uu & 31) * 256; nkt = TPB / 64; } else { bh = uu - NBATCH * NH * 32; q0 = 0; nkt = CTXL / 64; }
        const bf16* Kh = K + (size_t)bh * TPB * QKD; const bf16* Vh = V + (size_t)bh * TPB * 64; const bf16* Qh = Q + (size_t)bh * TPB * QKD;
        const int tq = q0 + F.wave * 32 + l31;
        bf16x8 qf[6];
#pragma unroll
        for (int ks = 0; ks < 6; ++ks) qf[ks] = *(const GAS bf16x8*)(Qh + (size_t)tq * QKD + 16 * ks + 8 * half);
        f32x16 o0, o1;
#pragma unroll
        for (int i = 0; i < 16; ++i) { o0[i] = 0.f; o1[i] = 0.f; }
        float l_run = 0.f;
        f32x16 cinit;
#pragma unroll
        for (int i = 0; i < 16; ++i) cinit[i] = 0.f;
        asm volatile("" : "+v"(cinit));
        const int kc1 = F.tid + 512; const bool k1ok = kc1 < 768;
        const unsigned kd0 = (unsigned)((F.tid / 12) * AKP + (F.tid % 12) * 16), kd1 = (unsigned)((kc1 / 12) * AKP + (kc1 % 12) * 16), vd = (unsigned)(64 * AKP + (F.tid >> 3) * AVP + (F.tid & 7) * 16);
        v4u kr0, kr1 = {0, 0, 0, 0}, vr;
        kr0 = *(const GAS v4u*)(Kh + (size_t)F.tid * 8); if (k1ok) kr1 = *(const GAS v4u*)(Kh + (size_t)kc1 * 8); vr = *(const GAS v4u*)(Vh + (size_t)F.tid * 8);
        __syncthreads();
        *(LAS v4u*)(F.lds + kd0) = kr0; if (k1ok) *(LAS v4u*)(F.lds + kd1) = kr1; *(LAS v4u*)(F.lds + vd) = vr;
        __syncthreads();
        for (int kt = 0; kt < nkt; ++kt) {
            const bool more = kt + 1 < nkt;
            if (more) { const bf16* kn = Kh + (size_t)(kt + 1) * 64 * QKD; const bf16* vn = Vh + (size_t)(kt + 1) * 64 * 64;
                kr0 = *(const GAS v4u*)(kn + (size_t)F.tid * 8); if (k1ok) kr1 = *(const GAS v4u*)(kn + (size_t)kc1 * 8); vr = *(const GAS v4u*)(vn + (size_t)F.tid * 8); }
            LAS unsigned char* Kb = F.lds + (kt & 1) * ATILE; LAS unsigned char* Vb = Kb + 64 * AKP;
            f32x16 s0, s1;
            { bf16x8 ka[6], kb2[6];
#pragma unroll
              for (int ks = 0; ks < 6; ++ks) { ka[ks] = *(const LAS bf16x8*)(Kb + l31 * AKP + (16 * ks + 8 * half) * 2); kb2[ks] = *(const LAS bf16x8*)(Kb + (32 + l31) * AKP + (16 * ks + 8 * half) * 2); }
              s0 = MFMA32(ka[0], qf[0], cinit); s1 = MFMA32(kb2[0], qf[0], cinit);
#pragma unroll
              for (int ks = 1; ks < 6; ++ks) { s0 = MFMA32(ka[ks], qf[ks], s0); s1 = MFMA32(kb2[ks], qf[ks], s1); }
              __builtin_amdgcn_sched_group_barrier(0x100, 12, 0); __builtin_amdgcn_sched_group_barrier(0x8, 12, 0); }
            bf16x8 va[2][2][2];
#pragma unroll
            for (int t = 0; t < 2; ++t)
#pragma unroll
                for (int s = 0; s < 2; ++s) { const int kb = 32 * t + 16 * s + 4 * half + (l16 >> 2);
#pragma unroll
                    for (int dvt = 0; dvt < 2; ++dvt) { const LAS unsigned char* vp = Vb + kb * AVP + (32 * dvt + 16 * g1 + 4 * (l16 & 3)) * 2;
                        const s16x4 lo = __builtin_amdgcn_ds_read_tr16_b64_v4i16((LAS s16x4*)vp), hi = __builtin_amdgcn_ds_read_tr16_b64_v4i16((LAS s16x4*)(vp + 8 * AVP));
                        va[t][s][dvt] = __builtin_shufflevector(lo, hi, 0, 1, 2, 3, 4, 5, 6, 7); } }
            __builtin_amdgcn_sched_group_barrier(0x100, 16, 0);
            float mx = s0[0];
#pragma unroll
            for (int i = 1; i < 16; ++i) mx = fmaxf(mx, s0[i]);
#pragma unroll
            for (int i = 0; i < 16; ++i) mx = fmaxf(mx, s1[i]);
            mx = fmaxf(mx, bpermf(lane ^ 32, mx));
            if (kt == 0 || __any(mx > 8.0f)) {
                const float d = (kt == 0) ? mx : fmaxf(mx, 0.f), alpha = (kt == 0) ? 1.0f : __builtin_amdgcn_exp2f(-d);
                l_run *= alpha;
#pragma unroll
                for (int i = 0; i < 16; ++i) { o0[i] *= alpha; o1[i] *= alpha; s0[i] -= d; s1[i] -= d; cinit[i] -= d; }
                asm volatile("" : "+v"(cinit));
            }
#pragma unroll
            for (int i = 0; i < 16; ++i) { s0[i] = __builtin_amdgcn_exp2f(s0[i]); s1[i] = __builtin_amdgcn_exp2f(s1[i]); }
            float ps = 0.f;
#pragma unroll
            for (int i = 0; i < 16; ++i) ps += s0[i] + s1[i];
            l_run += ps;
            { bf16x8 pf[2][2];
#pragma unroll
              for (int t = 0; t < 2; ++t)
#pragma unroll
                  for (int s = 0; s < 2; ++s) pf[t][s] = pack8(t == 0 ? s0 : s1, s);
#pragma unroll
              for (int t = 0; t < 2; ++t)
#pragma unroll
                  for (int s = 0; s < 2; ++s) { o0 = MFMA32(va[t][s][0], pf[t][s], o0); o1 = MFMA32(va[t][s][1], pf[t][s], o1); } }
            if (more) { LAS unsigned char* nb = F.lds + ((kt + 1) & 1) * ATILE;
                *(LAS v4u*)(nb + kd0) = kr0; if (k1ok) *(LAS v4u*)(nb + kd1) = kr1; *(LAS v4u*)(nb + vd) = vr; }
            __syncthreads();
        }
        const float linv = (DBG_SKIP & 4) ? 0.f : 1.0f / (l_run + bpermf(lane ^ 32, l_run));
        const int b = bh >> 4, hd = bh & 15;
        bf16* op = YB + ((size_t)b * TPB + tq) * RW + hd * 64 + 4 * half;
#pragma unroll
        for (int g = 0; g < 4; ++g) {
            v2u w; w.x = pk2(o0[4 * g] * linv, o0[4 * g + 1] * linv); w.y = pk2(o0[4 * g + 2] * linv, o0[4 * g + 3] * linv); *(GAS v2u*)(op + 8 * g) = w;
            w.x = pk2(o1[4 * g] * linv, o1[4 * g + 1] * linv); w.y = pk2(o1[4 * g + 2] * linv, o1[4 * g + 3] * linv); *(GAS v2u*)(op + 32 + 8 * g) = w; }
    }
}

__device__ __forceinline__ void readout_phase(Frame& F, const bf16* Y, const bf16* GG, const float* BON, const bf16* RI, const float* ln_w, const float* ln_b, bf16* YA) {
    const int gw = F.vcu * NWAVES + F.wave, NGW = F.G * NWAVES, lane = F.lane, hd = lane >> 2, ch0 = hd * 64 + (lane & 3) * 16;
    for (int m = gw; m < MALL; m += NGW) {
        const int b = m / TPB, tp = m - b * TPB;
        const bf16* rec = RI + ((size_t)(b * NH + hd) * TPB + tp) * RREC + 128 + (lane & 3) * 16;
        float vv[16], out[16];
        { const v4u a = *(const GAS v4u*)rec, c = *(const GAS v4u*)(rec + 8);
          vv[0] = bflo(a.x); vv[1] = bfhi(a.x); vv[2] = bflo(a.y); vv[3] = bfhi(a.y); vv[4] = bflo(a.z); vv[5] = bfhi(a.z); vv[6] = bflo(a.w); vv[7] = bfhi(a.w);
          vv[8] = bflo(c.x); vv[9] = bfhi(c.x); vv[10] = bflo(c.y); vv[11] = bfhi(c.y); vv[12] = bflo(c.z); vv[13] = bfhi(c.z); vv[14] = bflo(c.w); vv[15] = bfhi(c.w); }
#pragma unroll
        for (int e = 0; e < 16; ++e) out[e] = 0.f;
#pragma unroll
        for (int d = 0; d < 2; ++d) {
            const bf16* yp = Y + ((size_t)d * MALL + m) * RW + ch0; const bf16* gp = GG + ((size_t)d * MALL + m) * RW + ch0;
            float y[16], g[16];
            { const v4u a = *(const GAS v4u*)yp, c = *(const GAS v4u*)(yp + 8);
              y[0] = bflo(a.x); y[1] = bfhi(a.x); y[2] = bflo(a.y); y[3] = bfhi(a.y); y[4] = bflo(a.z); y[5] = bfhi(a.z); y[6] = bflo(a.w); y[7] = bfhi(a.w);
              y[8] = bflo(c.x); y[9] = bfhi(c.x); y[10] = bflo(c.y); y[11] = bfhi(c.y); y[12] = bflo(c.z); y[13] = bfhi(c.z); y[14] = bflo(c.w); y[15] = bfhi(c.w); }
            { const v4u a = *(const GAS v4u*)gp, c = *(const GAS v4u*)(gp + 8);
              g[0] = bflo(a.x); g[1] = bfhi(a.x); g[2] = bflo(a.y); g[3] = bfhi(a.y); g[4] = bflo(a.z); g[5] = bfhi(a.z); g[6] = bflo(a.w); g[7] = bfhi(a.w);
              g[8] = bflo(c.x); g[9] = bfhi(c.x); g[10] = bflo(c.y); g[11] = bfhi(c.y); g[12] = bflo(c.z); g[13] = bfhi(c.z); g[14] = bflo(c.w); g[15] = bfhi(c.w); }
            float s = 0.f;
#pragma unroll
            for (int e = 0; e < 16; ++e) s += y[e];
            s = dpp_add<0xB1>(s); s = dpp_add<0x4E>(s);
            const float mean = s * (1.f / 64.f); float q = 0.f;
#pragma unroll
            for (int e = 0; e < 16; ++e) { y[e] -= mean; q += y[e] * y[e]; }
            q = dpp_add<0xB1>(q); q = dpp_add<0x4E>(q);
            const float rstd = rsqrtf(q * (1.f / 64.f) + 64e-5f), bon = BON[((size_t)d * MALL + m) * 32 + 2 * hd] + BON[((size_t)d * MALL + m) * 32 + 2 * hd + 1];
#pragma unroll
            for (int e = 0; e < 16; ++e) out[e] += (y[e] * rstd * ln_w[ch0 + e] + ln_b[ch0 + e] + bon * vv[e]) * g[e];
        }
        if (DBG_SKIP & 2) {
#pragma unroll
            for (int e = 0; e < 16; ++e) out[e] = 0.f; }
        v4u o0, o1;
        o0.x = pk2(out[0], out[1]); o0.y = pk2(out[2], out[3]); o0.z = pk2(out[4], out[5]); o0.w = pk2(out[6], out[7]);
        o1.x = pk2(out[8], out[9]); o1.y = pk2(out[10], out[11]); o1.z = pk2(out[12], out[13]); o1.w = pk2(out[14], out[15]);
        *(GAS v4u*)(YA + (size_t)m * RW + ch0) = o0; *(GAS v4u*)(YA + (size_t)m * RW + ch0 + 8) = o1;
    }
}


__device__ __forceinline__ unsigned f2key(float f) { const unsigned u = __builtin_bit_cast(unsigned, f); return (u & 0x80000000u) ? ~u : (u | 0x80000000u); }
__device__ __forceinline__ float key2f(unsigned k) { const unsigned u = (k & 0x80000000u) ? (k & 0x7fffffffu) : ~k; return __builtin_bit_cast(float, u); }
template <int CTRL, int RM> __device__ __forceinline__ unsigned dpp_umax(unsigned x) {
    const unsigned y = (unsigned)__builtin_amdgcn_update_dpp(0, (int)x, CTRL, RM, 0xf, false); return x > y ? x : y; }
__device__ __forceinline__ unsigned row_umax(unsigned x) { x = dpp_umax<0xB1, 0xf>(x); x = dpp_umax<0x4E, 0xf>(x); x = dpp_umax<0x141, 0xf>(x); x = dpp_umax<0x140, 0xf>(x); return x; }
#define SEL_CE(a_, b_) do { const unsigned hi_ = (a_) > (b_) ? (a_) : (b_), lo_ = (a_) > (b_) ? (b_) : (a_); (a_) = hi_; (b_) = lo_; } while (0)
__device__ __forceinline__ void sel_keys8(unsigned (&k)[8], const float* p, int id0) {
    const f32x4 v0 = *(const GAS f32x4*)p, v1 = *(const GAS f32x4*)(p + 4);
    k[0] = (f2key(v0.x) & ~127u) | (unsigned)(id0 + 0); k[1] = (f2key(v0.y) & ~127u) | (unsigned)(id0 + 1); k[2] = (f2key(v0.z) & ~127u) | (unsigned)(id0 + 2); k[3] = (f2key(v0.w) & ~127u) | (unsigned)(id0 + 3);
    k[4] = (f2key(v1.x) & ~127u) | (unsigned)(id0 + 4); k[5] = (f2key(v1.y) & ~127u) | (unsigned)(id0 + 5); k[6] = (f2key(v1.z) & ~127u) | (unsigned)(id0 + 6); k[7] = (f2key(v1.w) & ~127u) | (unsigned)(id0 + 7);
    SEL_CE(k[0], k[1]); SEL_CE(k[2], k[3]); SEL_CE(k[4], k[5]); SEL_CE(k[6], k[7]); SEL_CE(k[0], k[2]); SEL_CE(k[1], k[3]); SEL_CE(k[4], k[6]); SEL_CE(k[5], k[7]); SEL_CE(k[1], k[2]); SEL_CE(k[5], k[6]);
    SEL_CE(k[0], k[4]); SEL_CE(k[1], k[5]); SEL_CE(k[2], k[6]); SEL_CE(k[3], k[7]); SEL_CE(k[2], k[4]); SEL_CE(k[3], k[5]); SEL_CE(k[1], k[2]); SEL_CE(k[3], k[4]); SEL_CE(k[5], k[6]);
}
__device__ __forceinline__ void top16_rows2(const float* pa, const float* pb, int l16, unsigned& ra, unsigned& rb) {
    unsigned ka[8], kb[8]; sel_keys8(ka, pa + 8 * l16, 8 * l16); sel_keys8(kb, pb + 8 * l16, 8 * l16);
    ra = 0u; rb = 0u;
#pragma unroll
    for (int it = 0; it < 16; ++it) {
        const unsigned ma = row_umax(ka[0]), mb = row_umax(kb[0]); const bool oa = ka[0] == ma, ob = kb[0] == mb;
#pragma unroll
        for (int e = 0; e < 7; ++e) { ka[e] = oa ? ka[e + 1] : ka[e]; kb[e] = ob ? kb[e + 1] : kb[e]; }
        ka[7] = oa ? 0u : ka[7]; kb[7] = ob ? 0u : kb[7];
        ra = (l16 == it) ? ma : ra; rb = (l16 == it) ? mb : rb;
    }
}
struct SelP { const float* SC; int* ESEL; float* EGATE; int last; };
__device__ __forceinline__ void select_phase(Frame& F, const SelP& P) {
    const int gw = F.vcu * NWAVES + F.wave, NGW = F.G * NWAVES, lane = F.lane, row = lane >> 4, l16 = lane & 15, rbase = lane & 48;
    const int i1 = (int)((0x3332222211111111ull >> (4 * l16)) & 15ull), j1 = (int)((0x2104321076543210ull >> (4 * l16)) & 15ull), i2 = (int)((0xdcba987766554443ull >> (4 * l16)) & 15ull), j2 = (int)((0x0000001010102103ull >> (4 * l16)) & 15ull);
    for (int m = gw; m < MALL; m += NGW) {
        bool tok = true; int tp = 0; if (tok) { tp = m % TPB; if (P.last && tp < CTXL) tok = false; }
        if (tok) {
            const float* srow = P.SC + (size_t)m * DM;
#pragma unroll 1
            for (int G = 0; G < 2; ++G) {
                const float* hrow = srow + (4 * G + row) * 256;
                unsigned recA, recB; top16_rows2(hrow, hrow + 128, l16, recA, recB);
                const float va = key2f(recA & ~127u), vb = key2f(recB & ~127u);
                const float a0 = bpermf(rbase, va), a1 = bpermf(rbase + i1, va), b1 = bpermf(rbase + j1, vb), a2 = bpermf(rbase + i2, va), b2 = bpermf(rbase + j2, vb), a3 = bpermf(rbase + 14 + (l16 & 1), va), b0 = bpermf(rbase, vb);
                unsigned ck[4];
                ck[0] = (f2key(a0 + vb) & ~255u) | (unsigned)l16; ck[1] = (f2key(a1 + b1) & ~255u) | (unsigned)(16 * i1 + j1); ck[2] = (f2key(a2 + b2) & ~255u) | (unsigned)(16 * i2 + j2);
                ck[3] = (l16 < 2) ? ((f2key(a3 + b0) & ~255u) | (unsigned)(16 * (14 + l16))) : 0u;
                SEL_CE(ck[0], ck[1]); SEL_CE(ck[2], ck[3]); SEL_CE(ck[0], ck[2]); SEL_CE(ck[1], ck[3]); SEL_CE(ck[1], ck[2]);
                unsigned rec = 0u;
#pragma unroll
                for (int it = 0; it < 16; ++it) {
                    const unsigned mh = row_umax(ck[0]); const bool own = ck[0] == mh;
                    ck[0] = own ? ck[1] : ck[0]; ck[1] = own ? ck[2] : ck[1]; ck[2] = own ? ck[3] : ck[2]; ck[3] = own ? 0u : ck[3];
                    rec = (l16 == it) ? mh : rec;
                }
                const float ts = key2f(rec & ~255u), tmax = bpermf(rbase, ts);
                const float ev = __expf(ts - tmax), esum = red16(ev);
                const int ci = (int)((rec >> 4) & 15u), cj = (int)(rec & 15u);
                const int expert = bpermi(rbase + ci, (int)(recA & 127u)) * 128 + bpermi(rbase + cj, (int)(recB & 127u));
                const int slot = (4 * G + row) * 16 + l16; P.ESEL[(size_t)m * 128 + slot] = expert; P.EGATE[(size_t)m * 128 + slot] = ev / esum;
            }
        }
    }
}
struct PeerP { const float* nmod; const float* ng; bf16* Hout;   const int* ESEL; const float* EGATE; const bf16* H; const unsigned char* PU; const unsigned char* PV; const float* SU; const float* SV; float* X; const float* mod;   const float* fin_g; float* out; int last; int dry; };
__device__ __forceinline__ void peer_phase(Frame& F, const PeerP& P) {
    const int gw = F.vcu * NWAVES + F.wave, NGW = F.G * NWAVES, lane = F.lane;
    float pr_s2 = 0.f, pr_d2 = 0.f, pr_tg = 0.f, pr_n = 0.f;
    for (int m = gw; m < MALL; m += NGW) {
        const int b = m / TPB, tp = m - b * TPB; if (P.last && tp < CTXL) continue;
        const int mr = tp < CTXL ? 2 : b;
        const int emask_ = (P.dry & 2) ? 1023 : 0x7fffffff;
        const int eidx[2] = {P.ESEL[(size_t)m * 128 + lane] & emask_, P.ESEL[(size_t)m * 128 + 64 + lane] & emask_}; const float egate[2] = {P.EGATE[(size_t)m * 128 + lane], P.EGATE[(size_t)m * 128 + 64 + lane]};
        typedef int v8i __attribute__((ext_vector_type(8)));
        LAS unsigned char* hq = F.lds + F.wave * 4096;
        { const v4u a0 = *(const GAS v4u*)(P.H + (size_t)m * DM + lane * 32), a1 = *(const GAS v4u*)(P.H + (size_t)m * DM + lane * 32 + 8), a2 = *(const GAS v4u*)(P.H + (size_t)m * DM + lane * 32 + 16), a3 = *(const GAS v4u*)(P.H + (size_t)m * DM + lane * 32 + 24);
          const v4u hv[4] = {a0, a1, a2, a3}; v4u o[2];
#pragma unroll
          for (int j = 0; j < 4; ++j) { int w0 = 0, w1 = 0;
              w0 = __builtin_amdgcn_cvt_pk_fp8_f32(bflo(hv[j].x), bfhi(hv[j].x), w0, false); w0 = __builtin_amdgcn_cvt_pk_fp8_f32(bflo(hv[j].y), bfhi(hv[j].y), w0, true);
              w1 = __builtin_amdgcn_cvt_pk_fp8_f32(bflo(hv[j].z), bfhi(hv[j].z), w1, false); w1 = __builtin_amdgcn_cvt_pk_fp8_f32(bflo(hv[j].w), bfhi(hv[j].w), w1, true);
              o[j >> 1][2 * (j & 1)] = (unsigned)w0; o[j >> 1][2 * (j & 1) + 1] = (unsigned)w1; }
          *(LAS v4u*)(hq + lane * 32) = o[0]; *(LAS v4u*)(hq + lane * 32 + 16) = o[1];
          unsigned z_ = 0u; asm volatile("" : "+v"(z_));
          if (lane < 2) *(LAS v4u*)(hq + 2048 + lane * 16) = (v4u){z_, z_, z_, z_}; }
        const int li = lane & 15, kb = lane >> 4;
        int rowoff[8];
#pragma unroll
        for (int g = 0; g < 8; ++g) rowoff[g] = bpermi(16 * (g & 3) + li, eidx[g >> 2]) * (DM / 2) + 16 * kb;
        f32x4 dacc[8];
#pragma unroll
        for (int g = 0; g < 8; ++g) dacc[g] = (f32x4){0.f, 0.f, 0.f, 0.f};
        const unsigned hb = (li == 0) ? (unsigned)(16 * kb) : 2048u;
        const unsigned hb2 = (li == 0) ? 64u : 16u;
        const unsigned hstep = (li == 0) ? 128u : 0u;
        v4u ua[8], ub[8];
#pragma unroll
        for (int g = 0; g < 8; ++g) ua[g] = *(const GAS v4u*)(P.PU + (unsigned)rowoff[g]);
#pragma unroll 1
        for (int s = 0; s < ((P.dry & 4) ? 2 : 16); s += 2) {
#pragma unroll
            for (int g = 0; g < 8; ++g) ub[g] = *(const GAS v4u*)(P.PU + (unsigned)(rowoff[g] + 64 * (s + 1)));
            { const v4u b0 = *(const LAS v4u*)(hq + hb + hstep * s), b1 = *(const LAS v4u*)(hq + hb + hstep * s + hb2);
              const v8i bf = {(int)b0.x, (int)b0.y, (int)b0.z, (int)b0.w, (int)b1.x, (int)b1.y, (int)b1.z, (int)b1.w};
#pragma unroll
              for (int g = 0; g < 8; ++g) { const v8i af = {(int)ua[g].x, (int)ua[g].y, (int)ua[g].z, (int)ua[g].w, 0, 0, 0, 0};
                  dacc[g] = __builtin_amdgcn_mfma_scale_f32_16x16x128_f8f6f4(af, bf, dacc[g], 4, 0, 0, 0x7f7f7f7f, 0, 0x7f7f7f7f); } }
            if (s + 2 < 16) {
#pragma unroll
                for (int g = 0; g < 8; ++g) ua[g] = *(const GAS v4u*)(P.PU + (unsigned)(rowoff[g] + 64 * (s + 2))); }
            { const v4u b0 = *(const LAS v4u*)(hq + hb + hstep * (s + 1)), b1 = *(const LAS v4u*)(hq + hb + hstep * (s + 1) + hb2);
              const v8i bf = {(int)b0.x, (int)b0.y, (int)b0.z, (int)b0.w, (int)b1.x, (int)b1.y, (int)b1.z, (int)b1.w};
#pragma unroll
              for (int g = 0; g < 8; ++g) { const v8i af = {(int)ub[g].x, (int)ub[g].y, (int)ub[g].z, (int)ub[g].w, 0, 0, 0, 0};
                  dacc[g] = __builtin_amdgcn_mfma_scale_f32_16x16x128_f8f6f4(af, bf, dacc[g], 4, 0, 0, 0x7f7f7f7f, 0, 0x7f7f7f7f); } }
        }
        float coef[2];
#pragma unroll
        for (int sl = 0; sl < 2; ++sl) { float mydot = 0.f;
#pragma unroll
            for (int g4 = 0; g4 < 4; ++g4)
#pragma unroll
                for (int r = 0; r < 4; ++r) { const float t = bpermf(16 * ((lane >> 2) & 3), dacc[4 * sl + g4][r]); if ((lane >> 4) == g4 && (lane & 3) == r) mydot = t; }
            mydot *= P.SU[eidx[sl]];
            if (DBG_PROBE == 4) {
                float ref = 0.f;
                for (int e = 0; e < 64; ++e) { const int ex = __builtin_amdgcn_readlane(eidx[sl], e); const v4u uu = *(const GAS v4u*)(P.PU + (size_t)ex * (DM / 2) + lane * 16); float s1 = 0.f;
                    const v4u hv2[4] = {*(const GAS v4u*)(P.H + (size_t)m * DM + lane * 32), *(const GAS v4u*)(P.H + (size_t)m * DM + lane * 32 + 8), *(const GAS v4u*)(P.H + (size_t)m * DM + lane * 32 + 16), *(const GAS v4u*)(P.H + (size_t)m * DM + lane * 32 + 24)};
#pragma unroll
                    for (int d = 0; d < 4; ++d) { const unsigned w = uu[d]; const unsigned hw[4] = {hv2[d].x, hv2[d].y, hv2[d].z, hv2[d].w};
                        f32x2 x = __builtin_amdgcn_cvt_scalef32_pk_f32_fp4(w, 1.0f, 0); s1 += x.x * bflo(hw[0]) + x.y * bfhi(hw[0]); x = __builtin_amdgcn_cvt_scalef32_pk_f32_fp4(w, 1.0f, 1); s1 += x.x * bflo(hw[1]) + x.y * bfhi(hw[1]);
                        x = __builtin_amdgcn_cvt_scalef32_pk_f32_fp4(w, 1.0f, 2); s1 += x.x * bflo(hw[2]) + x.y * bfhi(hw[2]); x = __builtin_amdgcn_cvt_scalef32_pk_f32_fp4(w, 1.0f, 3); s1 += x.x * bflo(hw[3]) + x.y * bfhi(hw[3]); }
                    const float tot = wave_sum_u(s1) * P.SU[ex]; if (lane == e) ref = tot; }
                pr_s2 = fmaxf(pr_s2, wave_max_u(fabsf(mydot - ref) / (fabsf(ref) + 0.25f))); pr_n = 1.f; }
            coef[sl] = egate[sl] * 0.5f * mydot * (1.0f + erff(mydot * 0.70710678f));
            if ((DBG_SKIP & 16) && sl == 0) coef[sl] = 0.f;
            if ((DBG_SKIP & 32) && sl == 1) coef[sl] = 0.f;
        }
        const float coefs[2] = {coef[0] * P.SV[eidx[0]], coef[1] * P.SV[eidx[1]]};
        f32x2 acc2[16];
#pragma unroll
        for (int i = 0; i < 16; ++i) acc2[i] = (f32x2){0.f, 0.f};
#define PEER_LOADV(U, C, e0_) do { const int e1_ = (e0_); const int ev_ = (e1_ & 64) ? eidx[1] : eidx[0]; const int cv_ = __builtin_bit_cast(int, (e1_ & 64) ? coefs[1] : coefs[0]); \
            _Pragma("unroll") for (int q = 0; q < 8; ++q) { const int ex = __builtin_amdgcn_readlane(ev_, (e1_ & 63) + q); U[q] = *(const GAS v4u*)(P.PV + (size_t)ex * (DM / 2) + lane * 16); \
            C[q] = __builtin_bit_cast(float, __builtin_amdgcn_readlane(cv_, (e1_ & 63) + q)); } } while (0)
#define PEER_AXPY(U, C) do { _Pragma("unroll") for (int q = 0; q < 8; ++q) _Pragma("unroll") for (int d = 0; d < 4; ++d) { const unsigned w = U[q][d]; \
            acc2[4 * d + 0] = __builtin_amdgcn_cvt_scalef32_pk_f32_fp4(w, 1.0f, 0) * C[q] + acc2[4 * d + 0]; acc2[4 * d + 1] = __builtin_amdgcn_cvt_scalef32_pk_f32_fp4(w, 1.0f, 1) * C[q] + acc2[4 * d + 1]; \
            acc2[4 * d + 2] = __builtin_amdgcn_cvt_scalef32_pk_f32_fp4(w, 1.0f, 2) * C[q] + acc2[4 * d + 2]; acc2[4 * d + 3] = __builtin_amdgcn_cvt_scalef32_pk_f32_fp4(w, 1.0f, 3) * C[q] + acc2[4 * d + 3]; } } while (0)
        f32x4 xpre[8];
        { const float* xr0 = P.X + (size_t)m * DM + lane * 32;
#pragma unroll
          for (int hq = 0; hq < 8; ++hq) xpre[hq] = *(const GAS f32x4*)(xr0 + hq * 4); }
        {
            v4u ua[8], ub[8]; float ca[8], cb[8];
            PEER_LOADV(ua, ca, 0);
#pragma unroll 1
            for (int it = 0; it < ((P.dry & 8) ? 2 : 8); ++it) {
                PEER_LOADV(ub, cb, 16 * it + 8); PEER_AXPY(ua, ca);
                if (it < 7) PEER_LOADV(ua, ca, 16 * it + 16);
                PEER_AXPY(ub, cb);
            }
        }
#undef PEER_LOADV
#undef PEER_AXPY
        float acc[32];
#pragma unroll
        for (int i = 0; i < 16; ++i) { acc[2 * i] = acc2[i].x; acc[2 * i + 1] = acc2[i].y; }
        if (P.dry) { float sm_ = 0.f;
#pragma unroll
            for (int i = 0; i < 32; ++i) sm_ += acc[i];
            if (sm_ == 1.2345e-30f) P.X[lane] = sm_;
            if (!(P.dry & 16)) continue; }
        if (DBG_SKIP & 1) {
#pragma unroll
            for (int i = 0; i < 32; ++i) acc[i] = 0.f; }
        if (((DBG_SKIP & 64) && !P.last) || ((DBG_SKIP & 128) && P.last)) {
#pragma unroll
            for (int i = 0; i < 32; ++i) acc[i] = 0.f; }
        if (DBG_SKIP & 8) {
#pragma unroll
            for (int i = 0; i < 32; ++i) acc[i] = -acc[i]; }
        int m_l = m, lane_l = lane; asm volatile("" : "+v"(m_l), "+v"(lane_l));
        const int b_l = m_l / TPB, tp_l = m_l - b_l * TPB, mr_l = tp_l < CTXL ? 2 : b_l;
        float* xr = P.X + (size_t)m_l * DM + lane_l * 32; const float* g2 = P.mod + (size_t)mr_l * 12288 + 5 * DM + lane_l * 32;
        float ss = 0.f;
#pragma unroll
        for (int hq = 0; hq < 8; ++hq) { const int c = hq * 4;
            f32x4 xv = xpre[hq]; const f32x4 gv = *(const GAS f32x4*)(g2 + c);
#pragma unroll
            for (int e = 0; e < 4; ++e) { xv[e] += gv[e] * acc[4 * hq + e]; ss += xv[e] * xv[e]; acc[4 * hq + e] = xv[e]; }
            if (!P.last) *(GAS f32x4*)((P.dry ? (float*)(F.ws + 760 * MiB) + (size_t)m_l * DM + lane_l * 32 : xr) + c) = xv; }
        if (!P.last) {
            const float rs = rsqrtf(wave_sum(ss) * (1.f / DM) + NORM_EPS); const float* sh = P.nmod + (size_t)mr_l * 12288 + lane_l * 32; const float* sc = sh + DM; const float* ngp = P.ng + lane_l * 32;
            bf16* ho = (P.dry ? (bf16*)(F.ws + 892 * MiB) : P.Hout) + (size_t)m_l * DM + lane_l * 32;
#pragma unroll
            for (int hq = 0; hq < 4; ++hq) { const int c = hq * 8; float y[8];
                const f32x4 n0 = *(const GAS f32x4*)(ngp + c), n1 = *(const GAS f32x4*)(ngp + c + 4), s0 = *(const GAS f32x4*)(sc + c), s1 = *(const GAS f32x4*)(sc + c + 4), h0 = *(const GAS f32x4*)(sh + c), h1 = *(const GAS f32x4*)(sh + c + 4);
#pragma unroll
                for (int e = 0; e < 4; ++e) { y[e] = acc[8 * hq + e] * rs * n0[e] * (1.0f + s0[e]) + h0[e]; y[4 + e] = acc[8 * hq + 4 + e] * rs * n1[e] * (1.0f + s1[e]) + h1[e]; }
                *(GAS v4u*)(ho + c) = pack8f(y); } }
        if (P.last) { const float rs = rsqrtf(wave_sum(ss) * (1.f / DM) + NORM_EPS); float* orow = P.out + ((size_t)b_l * SEQ + (tp_l - CTXL)) * DM + lane_l * 32; const float* fgp = P.fin_g + lane_l * 32;
#pragma unroll
            for (int hq = 0; hq < 8; ++hq) { const int c = hq * 4; const f32x4 fg = *(const GAS f32x4*)(fgp + c);
                f32x4 o;
#pragma unroll
                for (int e = 0; e < 4; ++e) o[e] = acc[4 * hq + e] * rs * fg[e];
                *(GAS f32x4*)(orow + c) = o; } }
    }
    if (DBG_PROBE && DBG_PROBE != 5 && !P.last && lane == 0) { float* pp = (float*)(F.ws + WS_CTL + CTL_PROBE_OFF) + gw * 4; pp[0] = pr_s2; pp[1] = pr_d2; pp[2] = pr_tg; pp[3] = pr_n; }
}


constexpr int PH_PER_LAYER = 12, NPHASE = 1 + NLAYER * PH_PER_LAYER;
#ifndef ONLY_PHASE
#define ONLY_PHASE -1
#endif
#define T0() (wave_s == 0 && pg8::opaque_lane() == 0)
#define PH_ON(k) (ONLY_PHASE < 0 || ONLY_PHASE == (k))
#define GEMM_CALL(EPI, SCHED, g, S, E) pg8::gemm_phase<EPI, SCHED, true, true>(F.lds, g, S, E, wave_s)
#define GEMM_CALL_NA(EPI, SCHED, g, S, E) pg8::gemm_phase<EPI, SCHED, false, true>(F.lds, g, S, E, wave_s)

__device__ __forceinline__ const float* karg(int i) {
    asm volatile("" : "+s"(i));
    const __attribute__((address_space(4))) unsigned long long* ka = (const __attribute__((address_space(4))) unsigned long long*)__builtin_amdgcn_kernarg_segment_ptr();
    return (const float*)ka[i];
}
__global__ void __launch_bounds__(NWAVES * 64, 2) mk_fwd(Args args) {
    extern __shared__ __attribute__((aligned(16))) unsigned char lds[];
    Frame F;
    F.lds = (LAS unsigned char*)lds; F.ws = args.ws;
    const int wave_s = __builtin_amdgcn_readfirstlane((int)threadIdx.x >> 6);
    F.tid = threadIdx.x; F.lane = F.tid & 63; F.wave = wave_s;
    F.G = gridDim.x; { const int bx = blockIdx.x; F.vcu = (F.G % 8 == 0) ? (bx % 8) * (F.G / 8) + bx / 8 : bx; }
    unsigned char* ws = args.ws;
    volatile LAS unsigned* MISC = (volatile LAS unsigned*)(F.lds + MISC_OFF);
    for (int u = F.tid; u < (LDS_BYTES - LDSCTL_OFF) / 4; u += NWAVES * 64) ((LAS unsigned*)(F.lds + LDSCTL_OFF))[u] = 0u;
    __syncthreads();
    const int lo = args.ph_lo, hi = args.ph_hi;
    XcdBarrier bar; bar.bar = (unsigned*)(ws + WS_CTL) + CW_BAR; bar.x = 0; bar.st = nullptr;
    if (hi - lo > 1) bar = xcd_barrier_post((unsigned*)(ws + WS_CTL) + CW_BAR, MISC + 8, T0());
#define IN(k) (lo <= (k) && (k) < hi)
#define REFRAME() do { const int lz_ = pg8::opaque_lane(); F.lane = lz_; F.tid = wave_s * 64 + lz_; F.wave = wave_s; ws = (unsigned char*)karg(34); F.ws = ws; { int g_ = (int)gridDim.x, b_ = (int)blockIdx.x; asm volatile("" : "+s"(g_), "+s"(b_)); bx = b_; F.G = g_; F.vcu = ((g_ & 7) == 0) ? (b_ & 7) * (g_ >> 3) + (b_ >> 3) : b_; } } while (0)
#define SEAM(k) do { if (IN((k) + 1)) xcd_barrier(bar, T0()); } while (0)
#define XBUF ((float*)(ws + WS_X))
#define HBUF ((bf16*)(ws + WS_H))
#define MODP ((const float*)(ws + WS_CTL + CTL_MOD_OFF) + (size_t)l * 3 * 12288)
    int bx = (int)blockIdx.x;

    for (int rep_ = 0; rep_ < ((DBG_REPEAT == 100) ? 2 : 1); ++rep_) if (PH_ON(100) && IN(0)) { REFRAME(); if (rep_) xcd_barrier(bar, T0()); p0_prologue(F); SEAM(0); if (DBG_REPEAT == 200) { for (int i_ = 0; i_ < 32; ++i_) xcd_barrier(bar, T0()); } }

    for (int l = 0; l < NLAYER; ++l) {
        const int base = 1 + l * PH_PER_LAYER;
        const int last = (l == NLAYER - 1);
        for (int rep_ = 0; rep_ < ((DBG_REPEAT == 0) ? 2 : 1); ++rep_) if (PH_ON(0) && IN(base + 0) && l == 0) { REFRAME(); if (rep_) xcd_barrier(bar, T0()); modnorm_phase(F, XBUF, karg(6) + (size_t)l * DM, MODP, 0, HBUF, 0, l == 0 ? karg(0) : nullptr, l == 0 ? karg(2) : nullptr); SEAM(base + 0); }
        for (int rep_ = 0; rep_ < ((DBG_REPEAT == 1) ? 2 : 1); ++rep_) if (PH_ON(1) && IN(base + 1)) { REFRAME(); if (rep_) xcd_barrier(bar, T0());
            pg8::Gemm g{HBUF, (const bf16*)(ws + WS_WINA) + (size_t)l * INA_P * DM, MALL, INA_P, DM}; pg8::RowOrder S; S.init_rows(0, INA_P, F.G, bx);
            pg8::EpiStoreBf16 E{(bf16*)(ws + WS_PA), INA_P};
            GEMM_CALL(pg8::EpiStoreBf16, pg8::RowOrder, g, S, E);
            SEAM(base + 1); }
        for (int rep_ = 0; rep_ < ((DBG_REPEAT == 2) ? 2 : 1); ++rep_) if (PH_ON(2) && IN(base + 2)) { REFRAME(); if (rep_) xcd_barrier(bar, T0());
            FeatP P;
            P.PA = (const bf16*)(ws + WS_PA); P.mu = karg(9) + (size_t)l * RWC; P.w0 = karg(10) + (size_t)l * 2 * RW; P.a0 = karg(12) + (size_t)l * 2 * RW;
            P.k_k = karg(15) + (size_t)l * RW; P.k_a = karg(16) + (size_t)l * RW; P.r_k = karg(17) + (size_t)l * RW;
            P.WUP = (const bf16*)(ws + WS_WUP) + (size_t)l * 2 * RW * 64; P.AUP = (const bf16*)(ws + WS_AUP) + (size_t)l * 2 * RW * 64; P.GUP = (const bf16*)(ws + WS_GUP) + (size_t)l * 2 * RW * 32;
            P.qnorm = karg(20) + (size_t)l * 512; P.kvnorm = karg(22) + (size_t)l * 256; P.rope = (const f32x2*)(ws + WS_ROPE);
            P.RI = (bf16*)(ws + WS_RI); P.GG = (bf16*)(ws + WS_GG); P.BON = (float*)(ws + WS_BON); P.QN = (bf16*)(ws + WS_QN); P.KVN = (bf16*)(ws + WS_KVN); P.K = (bf16*)(ws + WS_K);
            features_phase(F, P);
            SEAM(base + 2); }
        for (int rep_ = 0; rep_ < ((DBG_REPEAT == 3) ? 2 : 1); ++rep_) if (PH_ON(3) && IN(base + 3)) { REFRAME(); if (rep_) xcd_barrier(bar, T0());
            { pg8::Gemm g{(const bf16*)(ws + WS_QN), (const bf16*)(ws + WS_WUQ) + (size_t)l * NQ * 512, MALL, NQ, 512};
              pg8::EpiQ E{(bf16*)(ws + WS_Q), (const f32x2*)(ws + WS_ROPE), 0.14724444f};
              pg8::RowOrder S; S.init_rows(last, NQ, F.G, bx); GEMM_CALL_NA(pg8::EpiQ, pg8::RowOrder, g, S, E); }
            { pg8::Gemm g{(const bf16*)(ws + WS_KVN), (const bf16*)(ws + WS_WUKV) + (size_t)l * NKV * 256, MALL, NKV, 256}; pg8::RowOrder S; S.init_rows(0, NKV, F.G, bx);
              pg8::EpiKV E{(bf16*)(ws + WS_K), (bf16*)(ws + WS_V)};
              GEMM_CALL_NA(pg8::EpiKV, pg8::RowOrder, g, S, E); }
            SEAM(base + 3); }
        for (int rep_ = 0; rep_ < ((DBG_REPEAT == 4) ? 2 : 1); ++rep_) if (PH_ON(4) && IN(base + 4)) { REFRAME(); if (rep_) xcd_barrier(bar, T0());
            ScanCvt C; C.pu = karg(30) + (size_t)l * NEXP * DM; C.pv = karg(31) + (size_t)l * NEXP * DM; C.PU8 = ws + WS_P4; C.PV8 = ws + WS_P4 + (size_t)NEXP * (DM / 2); C.SU = (float*)(ws + WS_P4S); C.SV = (float*)(ws + WS_P4S) + NEXP;
            scan_phase(F, (const bf16*)(ws + WS_RI), (bf16*)(ws + WS_Y), C); SEAM(base + 4); }
        for (int rep_ = 0; rep_ < ((DBG_REPEAT == 5) ? 2 : 1); ++rep_) if (PH_ON(5) && IN(base + 5)) { REFRAME(); if (rep_) xcd_barrier(bar, T0());
            attn_phase(F, (const bf16*)(ws + WS_Q), (const bf16*)(ws + WS_K), (const bf16*)(ws + WS_V), (bf16*)(ws + WS_YB), !last);
            readout_phase(F, (const bf16*)(ws + WS_Y), (const bf16*)(ws + WS_GG), (const float*)(ws + WS_BON), (const bf16*)(ws + WS_RI), karg(18) + (size_t)l * RW, karg(19) + (size_t)l * RW, (bf16*)(ws + WS_YA));
            SEAM(base + 5); }
        for (int rep_ = 0; rep_ < ((DBG_REPEAT == 6) ? 2 : 1); ++rep_) if (PH_ON(6) && IN(base + 6)) { REFRAME(); if (rep_) xcd_barrier(bar, T0());
            bf16* T1 = (bf16*)(ws + WS_T1); bf16* T2 = (bf16*)(ws + WS_T2);
            const pg8::Gemm g1{HBUF, (const bf16*)(ws + WS_WGA) + (size_t)l * DM * DM, MALL, DM, DM}, g2{(const bf16*)(ws + WS_YA), (const bf16*)(ws + WS_WA) + (size_t)l * DM * RW, MALL, DM, RW};
            const pg8::Gemm g3{HBUF, (const bf16*)(ws + WS_WGB) + (size_t)l * DM * DM, MALL, DM, DM}, g4{(const bf16*)(ws + WS_YB), (const bf16*)(ws + WS_WB) + (size_t)l * DM * RW, MALL, DM, RW};
            const pg8::EpiGate E1{T1, DM, karg(8) + (size_t)l * 2 * DM}, E3{T2, DM, karg(8) + (size_t)l * 2 * DM + DM};
            const pg8::EpiMulAdd E2{T1, T1, nullptr, DM}, E4{T1, T2, T1, DM};
            pg8::RowOrder S; S.init_rows(last, DM, F.G, bx);
            GEMM_CALL(pg8::EpiGate, pg8::RowOrder, g1, S, E1); GEMM_CALL(pg8::EpiMulAdd, pg8::RowOrder, g2, S, E2); GEMM_CALL(pg8::EpiGate, pg8::RowOrder, g3, S, E3); GEMM_CALL(pg8::EpiMulAdd, pg8::RowOrder, g4, S, E4);
            SEAM(base + 6); }
        for (int rep_ = 0; rep_ < ((DBG_REPEAT == 7) ? 2 : 1); ++rep_) if (PH_ON(7) && IN(base + 7)) { REFRAME(); if (rep_) xcd_barrier(bar, T0());
            const pg8::Gemm g{(const bf16*)(ws + WS_T1), (const bf16*)(ws + WS_WO) + (size_t)l * DM * DM, MALL, DM, DM};
            const pg8::EpiResid E{XBUF, MODP + 2 * DM, l == 0 ? karg(0) : nullptr, l == 0 ? karg(2) : nullptr};
            pg8::RowOrder S; S.init_rows(last, DM, F.G, bx); GEMM_CALL(pg8::EpiResid, pg8::RowOrder, g, S, E);
            SEAM(base + 7); }
        for (int rep_ = 0; rep_ < ((DBG_REPEAT == 8) ? 2 : 1); ++rep_) if (PH_ON(8) && IN(base + 8)) { REFRAME(); if (rep_) xcd_barrier(bar, T0());
            modnorm_phase(F, XBUF, karg(27) + (size_t)l * DM, MODP, 3, HBUF, last);
            SEAM(base + 8); }
        for (int rep_ = 0; rep_ < ((DBG_REPEAT == 9) ? 2 : 1); ++rep_) if (PH_ON(9) && IN(base + 9)) { REFRAME(); if (rep_) xcd_barrier(bar, T0());
            const pg8::Gemm g{HBUF, (const bf16*)(ws + WS_WQK) + (size_t)l * DM * DM, MALL, DM, DM};
            const pg8::EpiF32 E{(float*)(ws + WS_SC), DM};
            pg8::RowOrder S; S.init_rows(last, DM, F.G, bx); GEMM_CALL(pg8::EpiF32, pg8::RowOrder, g, S, E);
            SEAM(base + 9); }
        for (int rep_ = 0; rep_ < ((DBG_REPEAT == 10) ? 2 : 1); ++rep_) if (PH_ON(10) && IN(base + 10)) { REFRAME(); if (rep_) xcd_barrier(bar, T0());
            SelP P; P.SC = (const float*)(ws + WS_SC); P.ESEL = (int*)(ws + WS_T1); P.EGATE = (float*)(ws + WS_T1 + 16 * MiB);
            P.last = last;
            select_phase(F, P);
            SEAM(base + 10); }
        for (int rep_ = 0; rep_ < ((DBG_REPEAT == 11) ? 2 : 1); ++rep_) if (PH_ON(11) && IN(base + 11)) { REFRAME(); if (rep_) xcd_barrier(bar, T0());
            PeerP P; P.nmod = MODP + 3 * 12288; P.ng = karg(6) + (size_t)(l + 1) * DM; P.Hout = HBUF; P.ESEL = (const int*)(ws + WS_T1); P.EGATE = (const float*)(ws + WS_T1 + 16 * MiB); P.H = HBUF; P.PU = ws + WS_P4; P.PV = ws + WS_P4 + (size_t)NEXP * (DM / 2); P.SU = (const float*)(ws + WS_P4S); P.SV = (const float*)(ws + WS_P4S) + NEXP; P.X = XBUF; P.mod = MODP; P.fin_g = karg(32); P.out = (float*)karg(33); P.last = last; P.dry = (DBG_REPEAT == 11 && rep_ == 0) ? DBG_DRY : 0;
            peer_phase(F, P);
            SEAM(base + 11); }
    }
#undef IN
#undef SEAM
#undef XBUF
#undef HBUF
#undef MODP
}

__device__ __forceinline__ float mx_a_val(int i, int k) { const int c = (i * 131 + k * 17 + (k >> 3) * 5) & 15; const float mag[8] = {0.f, .5f, 1.f, 1.5f, 2.f, 3.f, 4.f, 6.f}; return (c & 8) ? -mag[c & 7] : mag[c & 7]; }
__device__ __forceinline__ int mx_a_code(int i, int k) { return (i * 131 + k * 17 + (k >> 3) * 5) & 15; }
__device__ __forceinline__ float mx_b_val(int k, int j) { return (float)(((k * 7 + j * 13 + (k >> 4)) % 9) - 4); }
__device__ __forceinline__ int mx_kmap(int hyp, int kb, int e) { const int h = hyp % 3; return h == 0 ? 32 * kb + e : h == 1 ? 32 * (e >> 3) + 8 * kb + (e & 7) : 64 * (e >> 4) + 16 * kb + (e & 15); }
__global__ void __launch_bounds__(512) dbg_fill(const float* pp, float* o) {
    __shared__ float vsh;
    float v = 0.f;
    if (DBG_PROBE == 5) {
        if (threadIdx.x < 64) { typedef int v8i __attribute__((ext_vector_type(8))); typedef float f4 __attribute__((ext_vector_type(4)));
            const int lane = threadIdx.x, i = lane & 15, kb = lane >> 4; float code = 0.f;
            for (int hyp = 0; hyp < 18; ++hyp) { const int nibswap = hyp / 9, ha = hyp % 3, hb2 = (hyp / 3) % 3;
                unsigned aw[4] = {0u, 0u, 0u, 0u}; int bw[8] = {0, 0, 0, 0, 0, 0, 0, 0};
                for (int e = 0; e < 32; ++e) { const int k = mx_kmap(ha, kb, e); const unsigned c = (unsigned)mx_a_code(i, k); const int pos = nibswap ? (e ^ 1) : e; aw[pos >> 3] |= c << (4 * (pos & 7)); }
                for (int q = 0; q < 8; ++q) { int w = 0; const float f0 = mx_b_val(mx_kmap(hb2, kb, 4 * q + 0), i), f1 = mx_b_val(mx_kmap(hb2, kb, 4 * q + 1), i), f2 = mx_b_val(mx_kmap(hb2, kb, 4 * q + 2), i), f3 = mx_b_val(mx_kmap(hb2, kb, 4 * q + 3), i);
                    w = __builtin_amdgcn_cvt_pk_fp8_f32(f0, f1, w, false); w = __builtin_amdgcn_cvt_pk_fp8_f32(f2, f3, w, true); bw[q] = w; }
                const v8i af = {(int)aw[0], (int)aw[1], (int)aw[2], (int)aw[3], 0, 0, 0, 0}, bf = {bw[0], bw[1], bw[2], bw[3], bw[4], bw[5], bw[6], bw[7]};
                f4 d = {0.f, 0.f, 0.f, 0.f};
                d = __builtin_amdgcn_mfma_scale_f32_16x16x128_f8f6f4(af, bf, d, 4, 0, 0, 0x7f7f7f7f, 0, 0x7f7f7f7f);
                int bad = 0;
                for (int r = 0; r < 4; ++r) { const int row = 4 * kb + r, col = i; float ex = 0.f; for (int k = 0; k < 128; ++k) ex += mx_a_val(row, k) * mx_b_val(k, col); bad += (d[r] != ex); }
                if (__ballot(bad != 0) == 0ull && code == 0.f) code = (float)(hyp + 1); }
            for (int t = 0; t < 2; ++t) {
                int aw[8] = {0, 0, 0, 0, 0, 0, 0, 0}, bw[8] = {0, 0, 0, 0, 0, 0, 0, 0};
                if (t == 0) { for (int e = 0; e < 32; ++e) { const int k = 32 * kb + e; aw[e >> 3] |= mx_a_code(i, k) << (4 * (e & 7)); bw[e >> 3] |= mx_a_code(i + 16, k) << (4 * (e & 7)); } }
                else { for (int q = 0; q < 8; ++q) { int w = 0, w2 = 0; const int k = 32 * kb + 4 * q;
                        w = __builtin_amdgcn_cvt_pk_fp8_f32(mx_b_val(k, i + 16), mx_b_val(k + 1, i + 16), w, false); w = __builtin_amdgcn_cvt_pk_fp8_f32(mx_b_val(k + 2, i + 16), mx_b_val(k + 3, i + 16), w, true); aw[q] = w;
                        w2 = __builtin_amdgcn_cvt_pk_fp8_f32(mx_b_val(k, i), mx_b_val(k + 1, i), w2, false); w2 = __builtin_amdgcn_cvt_pk_fp8_f32(mx_b_val(k + 2, i), mx_b_val(k + 3, i), w2, true); bw[q] = w2; } }
                const v8i af = {aw[0], aw[1], aw[2], aw[3], aw[4], aw[5], aw[6], aw[7]}, bf = {bw[0], bw[1], bw[2], bw[3], bw[4], bw[5], bw[6], bw[7]};
                f4 d = {0.f, 0.f, 0.f, 0.f};
                if (t == 0) d = __builtin_amdgcn_mfma_scale_f32_16x16x128_f8f6f4(af, bf, d, 4, 4, 0, 0x7f7f7f7f, 0, 0x7f7f7f7f); else d = __builtin_amdgcn_mfma_scale_f32_16x16x128_f8f6f4(af, bf, d, 0, 0, 0, 0x7f7f7f7f, 0, 0x7f7f7f7f);
                int bad = 0;
                for (int r = 0; r < 4; ++r) { const int row = 4 * kb + r, col = i; float ex = 0.f;
                    for (int k = 0; k < 128; ++k) ex += (t == 0) ? mx_a_val(row, k) * mx_a_val(col + 16, k) : mx_b_val(k, row + 16) * mx_b_val(k, col);
                    bad += (d[r] != ex); }
                if (__ballot(bad != 0) == 0ull) code += (t == 0) ? 10.f : 20.f; }
            if (lane == 0) vsh = code; }
        __syncthreads(); v = vsh;
    } else {
        float s0 = 0.f, s1 = 0.f, s2 = 0.f, s3 = 0.f;
        for (int i = 0; i < 2048; ++i) { s0 += pp[4 * i]; s1 += pp[4 * i + 1]; s2 += pp[4 * i + 2]; s3 += pp[4 * i + 3]; }
        if (DBG_PROBE == 4) { float mx = 0.f; for (int i = 0; i < 2048; ++i) mx = fmaxf(mx, pp[4 * i]); v = 100.f * mx; }
        else { v = (DBG_PROBE == 1 ? s0 : DBG_PROBE == 2 ? s1 : s2) / s3 * 1e-3f; v = exp2f(rintf(log2f(v) * 4.f) * 0.25f); }
    }
    for (size_t i = (size_t)blockIdx.x * 512 + threadIdx.x; i < (size_t)NBATCH * SEQ * DM; i += (size_t)gridDim.x * 512) o[i] = v;
}
extern "C" void kernel_launch(void* const* d_in, const int* in_sizes, int n_in, void* d_out, int out_size, void* d_ws, size_t ws_size, hipStream_t stream) {
    static int grid = 0;
    if (grid == 0) {
        if (n_in != 33 || out_size != NBATCH * SEQ * DM || ws_size < WS_END2) { fprintf(stderr, "kernel_launch: unexpected shapes (n_in %d out %d ws %zu)\n", n_in, out_size, ws_size); grid = -1; return; }
        int dev = 0, cus = 0, per_cu = 0;
        if (hipGetDevice(&dev) != hipSuccess || hipDeviceGetAttribute(&cus, hipDeviceAttributeMultiprocessorCount, dev) != hipSuccess) { grid = -1; return; }
        if (hipFuncSetAttribute((const void*)mk_fwd, hipFuncAttributeMaxDynamicSharedMemorySize, LDS_BYTES) != hipSuccess) { fprintf(stderr, "kernel_launch: hipFuncSetAttribute failed\n"); grid = -1; return; }
        if (hipOccupancyMaxActiveBlocksPerMultiprocessor(&per_cu, (const void*)mk_fwd, NWAVES * 64, LDS_BYTES) != hipSuccess || per_cu < 1) { fprintf(stderr, "kernel_launch: occupancy query says %d\n", per_cu); (void)hipGetLastError(); grid = -1; return; }
        grid = cus;
    }
    if (grid < 0) return;
    if (hipMemsetAsync((char*)d_ws + WS_CTL, 0, CTL_ZERO_BYTES, stream) != hipSuccess) return;
    Args a{};
    for (int i = 0; i < 33; ++i) a.in[i] = (const float*)d_in[i];
    a.out = (float*)d_out; a.ws = (unsigned char*)d_ws;
#if MK_N_LAUNCHES == 1
    a.ph_lo = 0; a.ph_hi = NPHASE;
    hipLaunchKernelGGL(mk_fwd, dim3(grid), dim3(NWAVES * 64), LDS_BYTES, stream, a);
#else
    if (DBG_PROBE != 5) for (int p = 0; p < NPHASE; ++p) { a.ph_lo = p; a.ph_hi = p + 1; hipLaunchKernelGGL(mk_fwd, dim3(grid), dim3(NWAVES * 64), LDS_BYTES, stream, a); }
    if (DBG_PROBE) hipLaunchKernelGGL(dbg_fill, dim3(1024), dim3(512), 0, stream, (const float*)((char*)d_ws + WS_CTL + CTL_PROBE_OFF), (float*)d_out);
#endif
}
```

```cpp
#include <hip/hip_runtime.h>
#include <cstdio>
#include <cstdint>

#ifndef MK_N_LAUNCHES
#define MK_N_LAUNCHES 1
#endif

#ifndef DBG_SKIP
#define DBG_SKIP 0
#endif
#ifndef DBG_PROBE
#define DBG_PROBE 0
#endif
#ifndef DBG_DRY
#define DBG_DRY 1
#endif
#ifndef DBG_REPEAT
#define DBG_REPEAT -1
#endif
namespace pg8 {
#define PG8_LAS __attribute__((address_space(3)))
typedef unsigned short bf16_t;
typedef short bf16x8 __attribute__((ext_vector_type(8)));
typedef float f32x4 __attribute__((ext_vector_type(4)));
typedef unsigned u32x4 __attribute__((ext_vector_type(4)));
constexpr int BM = 256, BK = 64, HALF = 128, HTB = HALF * BK * 2  , STAGE_BYTES = 8 * HTB, NXCD = 8, WGM = 8;

__host__ __device__ __forceinline__ int lds_byte(int r, int c) { const int st = (r >> 4) * 2 + (c >> 5), rr = r & 15, cc = c & 31, ob = rr * 64 + cc * 2; return st * 1024 + (ob ^ (((ob >> 9) & 1) << 5)); }
__host__ __device__ __forceinline__ void stage_rc(int b, int& R, int& C) { const int st = b / 1024, sb = b % 1024, swz = sb ^ (((sb >> 9) & 1) << 5); R = (st >> 1) * 16 + swz / 64; C = (st & 1) * 32 + (swz % 64) / 2; }
__host__ __device__ __forceinline__ int perm32(int rho) { const int n = rho >> 4, i = rho & 15; return 8 * (i >> 2) + 4 * n + (i & 3); }

struct Unit { int pm, pn; };
struct Gemm { const bf16_t* A; const bf16_t* Bt; int M, N, K; };

struct StaticOrder {
    int nM, nN, nwg, G, c;
    __host__ __device__ void init(int M, int N, int G_, int c_) { nM = M / BM; nN = N / BM; nwg = nM * nN; G = G_; c = c_; }
    __host__ __device__ bool next(int i, Unit& u) const {
        const long L = (long)i * G + c; if (L >= nwg) return false;
        int wgid = (int)L; { const int q = nwg / NXCD, r = nwg % NXCD, xcd = wgid % NXCD, off = wgid / NXCD; wgid = (xcd < r ? xcd * (q + 1) : r * (q + 1) + (xcd - r) * q) + off; }
        const int nig = WGM * nN, gid = wgid / nig, fm = gid * WGM, gsz = (nM - fm) < WGM ? (nM - fm) : WGM;
        u.pm = fm + ((wgid % nig) % gsz); u.pn = (wgid % nig) / gsz; return true;
    }
    __device__ __forceinline__ void a_ready(const Unit&) const {}
    __device__ __forceinline__ void done(const Unit&) const {}
};
__device__ __forceinline__ int opaque_lane() { int l; asm volatile("v_mbcnt_lo_u32_b32 %0, -1, 0\n\tv_mbcnt_hi_u32_b32 %0, -1, %0" : "=v"(l)); return l; }
typedef __bf16 bf16x2c __attribute__((ext_vector_type(2)));
__device__ __forceinline__ unsigned cvt_pk_bf16(float lo, float hi) { const bf16x2c v = {(__bf16)lo, (__bf16)hi}; return __builtin_bit_cast(unsigned, v); }
template <class Epi, class Sched, bool ALIGN_EPI = false, bool SP2 = false>
__device__ __forceinline__ void gemm_phase(PG8_LAS unsigned char* lds, const Gemm g, const Sched& S, const Epi& E, const int wave_s) {
    const int lane_ = opaque_lane();
    const int wid = wave_s, lane = lane_, tid = wid * 64 + lane, wr = wid >> 2, wc = wid & 3, fr = lane & 15, fq = lane >> 4;
    const int K = g.K, nt = K / BK;
    unsigned voffA[2], voffB[2];
#pragma unroll
    for (int i = 0; i < 2; ++i) { int R, C; stage_rc(tid * 16 + i * 8192, R, C); const int Rb = Epi::PERM ? ((R & ~31) + perm32(R & 31)) : R;
        voffA[i] = (unsigned)(R * K + C) * 2u; voffB[i] = (unsigned)(Rb * K + C) * 2u; }
    const size_t kstep = (size_t)(BK * 2);
    const size_t hstep = (size_t)HALF * K * 2;
    const size_t tstep = 2 * hstep;
    const unsigned ldsw = (unsigned)wid * 1024u;
    const int aoff = lds_byte(wr * 64 + fr, fq * 8), boff = lds_byte(wc * 32 + fr, fq * 8);
#define PG8_SA(b, h) (((b) * 2 + (h)) * HTB)
#define PG8_SB(b, h) ((4 + (b) * 2 + (h)) * HTB)
#define PG8_STAGE(bufoff, gbase, voff) do { _Pragma("unroll") for (int _i = 0; _i < 2; ++_i) \
        __builtin_amdgcn_global_load_lds((const unsigned*)((const char*)(gbase) + (voff)[_i]), (PG8_LAS unsigned*)(lds + (bufoff) + ldsw + _i * 8192), 16, 0, 0); } while (0)
#define PG8_LDA(dst, b, h) do { _Pragma("unroll") for (int m = 0; m < 4; ++m) _Pragma("unroll") for (int k = 0; k < 2; ++k) dst[m][k] = *(const PG8_LAS bf16x8*)(lds + PG8_SA(b, h) + aoff + m * 2048 + k * 1024); } while (0)
#define PG8_LDB(dst, b, h) do { _Pragma("unroll") for (int n = 0; n < 2; ++n) _Pragma("unroll") for (int k = 0; k < 2; ++k) dst[n][k] = *(const PG8_LAS bf16x8*)(lds + PG8_SB(b, h) + boff + n * 2048 + k * 1024); } while (0)
#define PG8_MMA(ai, bj, At, Bt) do { __builtin_amdgcn_s_setprio(1); _Pragma("unroll") for (int m = 0; m < 4; ++m) _Pragma("unroll") for (int n = 0; n < 2; ++n) _Pragma("unroll") for (int k = 0; k < 2; ++k) \
        acc[ai][bj][m][n] = __builtin_amdgcn_mfma_f32_16x16x32_bf16(Bt[n][k], At[m][k], acc[ai][bj][m][n], 0, 0, 0); __builtin_amdgcn_s_setprio(0); } while (0)
#define PG8_WAIT_V(n) asm volatile("s_waitcnt vmcnt(" #n ")" ::: "memory")
#define PG8_WAIT_L(n) asm volatile("s_waitcnt lgkmcnt(" #n ")" ::: "memory")
#define PG8_BAR __builtin_amdgcn_s_barrier()
#define PG8_SCHED __builtin_amdgcn_sched_barrier(0)
    Unit cur, nxt; int ui = 0;
    if (!S.next(0, cur)) return;
    f32x4 acc[2][2][4][2];
#pragma unroll
    for (int a = 0; a < 2; ++a)
#pragma unroll
        for (int b = 0; b < 2; ++b)
#pragma unroll
            for (int m = 0; m < 4; ++m)
#pragma unroll
                for (int n = 0; n < 2; ++n) acc[a][b][m][n] = (f32x4){0.f, 0.f, 0.f, 0.f};
    bf16x8 At[4][2], B0[2][2], B1[2][2];
    const char* cA = (const char*)g.A + (size_t)cur.pm * tstep; const char* cB = (const char*)g.Bt + (size_t)cur.pn * tstep;
    S.a_ready(cur);
    if constexpr (SP2) {
        PG8_STAGE(PG8_SB(0, 0), cB, voffB); PG8_STAGE(PG8_SB(0, 1), cB + hstep, voffB); PG8_STAGE(PG8_SA(0, 0), cA, voffA); PG8_STAGE(PG8_SA(0, 1), cA + hstep, voffA);
        if (wr == 1) PG8_BAR;
        PG8_WAIT_V(2); PG8_BAR;
        PG8_STAGE(PG8_SB(1, 0), cB + kstep, voffB); PG8_STAGE(PG8_SA(1, 0), cA + kstep, voffA); PG8_STAGE(PG8_SB(1, 1), cB + hstep + kstep, voffB);
        PG8_WAIT_V(6); PG8_BAR;
    } else {
        PG8_STAGE(PG8_SB(0, 0), cB, voffB); PG8_STAGE(PG8_SA(0, 0), cA, voffA); PG8_STAGE(PG8_SB(0, 1), cB + hstep, voffB); PG8_STAGE(PG8_SA(0, 1), cA + hstep, voffA);
        if (wr == 1) PG8_BAR;
        PG8_WAIT_V(4); PG8_BAR;
        PG8_STAGE(PG8_SB(1, 0), cB + kstep, voffB); PG8_STAGE(PG8_SA(1, 0), cA + kstep, voffA); PG8_STAGE(PG8_SB(1, 1), cB + hstep + kstep, voffB);
        PG8_WAIT_V(6); PG8_BAR;
    }
    for (;;) {
        const bool has_next = S.next(ui + 1, nxt);
        const char* nA = has_next ? (const char*)g.A + (size_t)nxt.pm * tstep : cA; const char* nB = has_next ? (const char*)g.Bt + (size_t)nxt.pn * tstep : cB;
        for (int t = 0; t < nt; t += 2) {
            const bool last = (t == nt - 2);
            const char* a1 = cA + (size_t)(t + 1) * kstep;
            const char* a2 = last ? nA : cA + (size_t)(t + 2) * kstep; const char* b2 = last ? nB : cB + (size_t)(t + 2) * kstep;
            const char* a3 = a2 + kstep; const char* b3 = b2 + kstep;
            if (last && has_next) S.a_ready(nxt);
            if constexpr (SP2) {
            PG8_LDB(B0, 0, 0); PG8_LDB(B1, 0, 1); PG8_SCHED; PG8_LDA(At, 0, 0); PG8_STAGE(PG8_SA(1, 1), a1 + hstep, voffA);
            PG8_WAIT_V(8); PG8_WAIT_L(0); PG8_BAR; PG8_MMA(0, 0, At, B0); PG8_MMA(0, 1, At, B1); PG8_BAR; PG8_SCHED;
            PG8_LDA(At, 0, 1); PG8_STAGE(PG8_SB(0, 0), b2, voffB); PG8_STAGE(PG8_SB(0, 1), b2 + hstep, voffB); PG8_STAGE(PG8_SA(0, 0), a2, voffA);
            PG8_WAIT_V(8); PG8_WAIT_L(0); PG8_BAR; PG8_MMA(1, 0, At, B0); PG8_MMA(1, 1, At, B1); PG8_BAR; PG8_SCHED;
            PG8_LDB(B0, 1, 0); PG8_LDB(B1, 1, 1); PG8_SCHED; PG8_LDA(At, 1, 0); PG8_STAGE(PG8_SA(0, 1), a2 + hstep, voffA);
            PG8_WAIT_V(8); PG8_WAIT_L(0); PG8_BAR; PG8_MMA(0, 0, At, B0); PG8_MMA(0, 1, At, B1); PG8_BAR; PG8_SCHED;
            PG8_LDA(At, 1, 1); PG8_STAGE(PG8_SB(1, 0), b3, voffB); PG8_STAGE(PG8_SB(1, 1), b3 + hstep, voffB); PG8_STAGE(PG8_SA(1, 0), a3, voffA);
            PG8_WAIT_V(8); PG8_WAIT_L(0); PG8_BAR; PG8_MMA(1, 0, At, B0); PG8_MMA(1, 1, At, B1); PG8_BAR; PG8_SCHED;
            } else {
            PG8_LDB(B0, 0, 0); PG8_SCHED; PG8_LDA(At, 0, 0); PG8_STAGE(PG8_SA(1, 1), a1 + hstep, voffA);
            PG8_WAIT_L(8); PG8_BAR; PG8_WAIT_L(0); PG8_MMA(0, 0, At, B0); PG8_BAR; PG8_SCHED;
            PG8_LDB(B1, 0, 1); PG8_STAGE(PG8_SB(0, 0), b2, voffB);
            PG8_BAR; PG8_WAIT_L(0); PG8_MMA(0, 1, At, B1); PG8_BAR;
            PG8_LDA(At, 0, 1); PG8_STAGE(PG8_SA(0, 0), a2, voffA);
            PG8_BAR; PG8_WAIT_L(0); PG8_MMA(1, 0, At, B0); PG8_BAR; PG8_SCHED;
            PG8_STAGE(PG8_SB(0, 1), b2 + hstep, voffB);
            PG8_WAIT_V(6); PG8_BAR; PG8_MMA(1, 1, At, B1); PG8_BAR;
            PG8_LDB(B0, 1, 0); PG8_SCHED; PG8_LDA(At, 1, 0); PG8_STAGE(PG8_SA(0, 1), a2 + hstep, voffA);
            PG8_WAIT_L(8); PG8_BAR; PG8_WAIT_L(0); PG8_MMA(0, 0, At, B0); PG8_BAR; PG8_SCHED;
            PG8_LDB(B1, 1, 1); PG8_STAGE(PG8_SB(1, 0), b3, voffB);
            PG8_BAR; PG8_WAIT_L(0); PG8_MMA(0, 1, At, B1); PG8_BAR;
            PG8_LDA(At, 1, 1); PG8_STAGE(PG8_SA(1, 0), a3, voffA);
            PG8_BAR; PG8_WAIT_L(0); PG8_MMA(1, 0, At, B0); PG8_BAR; PG8_SCHED;
            PG8_STAGE(PG8_SB(1, 1), b3 + hstep, voffB);
            PG8_WAIT_V(6); PG8_BAR; PG8_MMA(1, 1, At, B1); PG8_BAR;
            }
        }
        if constexpr (ALIGN_EPI) { if (wr == 0) PG8_BAR; }
        if constexpr (!Epi::AFTER_DRAIN) { const int le_ = opaque_lane(); E(acc, cur, wr, wc, le_ & 15, le_ >> 4); S.done(cur); }
        if (!has_next) break;
#pragma unroll
        for (int a = 0; a < 2; ++a)
#pragma unroll
            for (int b = 0; b < 2; ++b)
#pragma unroll
                for (int m = 0; m < 4; ++m)
#pragma unroll
                    for (int n = 0; n < 2; ++n) acc[a][b][m][n] = (f32x4){0.f, 0.f, 0.f, 0.f};
        cur = nxt; cA = nA; cB = nB; ++ui;
        if constexpr (ALIGN_EPI) { if (wr == 1) PG8_BAR; }
    }
    PG8_WAIT_V(0);
    if constexpr (!ALIGN_EPI) { if (wr == 0) PG8_BAR; }
    PG8_BAR;
    if constexpr (Epi::AFTER_DRAIN) { E.fused(acc, cur, wr, wc, fr, fq, lds, wid, lane); S.done(cur); }
#undef PG8_SA
#undef PG8_SB
#undef PG8_STAGE
#undef PG8_LDA
#undef PG8_LDB
#undef PG8_MMA
#undef PG8_WAIT_V
#undef PG8_WAIT_L
#undef PG8_BAR
#undef PG8_SCHED
}
}

constexpr int NWAVES = 8;
constexpr int DM = 2048, NBATCH = 2, SEQ = 8192, CTXL = 256, TPB = CTXL + SEQ  , MALL = NBATCH * TPB  ;
constexpr int NLAYER = 2;
constexpr int RW = 1024, NH = 16;
constexpr int RWC = 3392, INA = 4192, INA_P = 4352, INC = 8288;
constexpr int C_WD = 3072, C_AD = 3200, C_GD = 3328, C_QC = 3392, C_KVC = 3904, C_KR = 4160;
constexpr int QKD = 96, NQ = NH * QKD  , NKV = NH * 128  ;
constexpr int NEXP = 16384;
constexpr int RREC = 9 * 64;
constexpr float NORM_EPS = 1e-6f;

constexpr size_t MiB = 1u << 20;
constexpr size_t WS_CTL = 0, CTL_ZERO_BYTES = 1 * MiB;
constexpr size_t CTL_MOD_OFF = 256 * 1024;
constexpr size_t WS_ROPE = 1 * MiB;
constexpr size_t WS_WUP = 3 * MiB, WS_AUP = WS_WUP + 512 * 1024, WS_GUP = 4 * MiB;
constexpr size_t WS_WUQ = 5 * MiB, WS_WUKV = 8 * MiB, WS_WA = 10 * MiB, WS_WB = 18 * MiB, WS_WO = 26 * MiB, WS_WQK = 42 * MiB, WS_WGA = 58 * MiB, WS_WGB = 74 * MiB, WS_WINA = 90 * MiB;
constexpr size_t WS_X = 124 * MiB, WS_H = 256 * MiB, WS_DYN = 322 * MiB;
constexpr size_t WS_PA = WS_DYN;
constexpr size_t WS_RI = 463 * MiB;
constexpr size_t WS_GG = 760 * MiB;
constexpr size_t WS_BON = 826 * MiB;
constexpr size_t WS_QN = 831 * MiB, WS_KVN = 848 * MiB;
constexpr size_t WS_Q = 857 * MiB, WS_K = 907 * MiB, WS_V = 957 * MiB, WS_END = 990 * MiB;
constexpr size_t WS_Y = WS_DYN;
constexpr size_t WS_YA = 388 * MiB, WS_YB = 421 * MiB;
constexpr size_t WS_T1 = 463 * MiB, WS_T2 = 529 * MiB;
constexpr size_t WS_PU = 600 * MiB, WS_PV = 664 * MiB;
constexpr size_t WS_P4 = 990 * MiB, WS_P4S = 1022 * MiB, WS_END2 = 1023 * MiB;
constexpr size_t WS_SC = WS_DYN;
static_assert(WS_PA + (size_t)MALL * INA_P * 2 <= WS_RI && WS_RI + (size_t)NBATCH * NH * TPB * RREC * 2 <= WS_GG && WS_GG + (size_t)2 * MALL * RW * 2 <= WS_BON, "ws map 1");
static_assert(WS_BON + (size_t)2 * MALL * 32 * 4 <= WS_QN && WS_QN + (size_t)MALL * 512 * 2 <= WS_KVN && WS_KVN + (size_t)MALL * 256 * 2 <= WS_Q, "ws map 2");
static_assert(WS_Q + (size_t)NBATCH * NH * TPB * QKD * 2 <= WS_K && WS_K + (size_t)NBATCH * NH * TPB * QKD * 2 <= WS_V && WS_V + (size_t)NBATCH * NH * TPB * 64 * 2 <= WS_END, "ws map 3");
static_assert(WS_Y + (size_t)2 * MALL * RW * 2 <= WS_YA && WS_YA + (size_t)MALL * RW * 2 <= WS_YB && WS_YB + (size_t)MALL * RW * 2 <= WS_RI, "ws map 4");
static_assert(WS_T1 + (size_t)MALL * DM * 2 <= WS_T2 && WS_T2 + (size_t)MALL * DM * 2 <= WS_PU && WS_PU + (size_t)NEXP * DM * 2 <= WS_PV && WS_PV + (size_t)NEXP * DM * 2 <= WS_GG, "ws map 5");
static_assert(WS_SC + (size_t)MALL * DM * 4 <= WS_T1 && WS_X + (size_t)MALL * DM * 4 <= WS_H && WS_H + (size_t)MALL * DM * 2 <= WS_DYN, "ws map 6");
static_assert(WS_WINA + (size_t)NLAYER * INA_P * DM * 2 <= WS_X, "ws map 7");
constexpr size_t CTL_PROBE_OFF = 640 * 1024;
constexpr int CW_BAR = 4096;

constexpr int RING_BYTES = 131072;
constexpr int LDSCTL_OFF = RING_BYTES, MISC_OFF = LDSCTL_OFF + 320;
constexpr int LDS_BYTES = 147456;

#define GAS __attribute__((address_space(1)))
#define LAS __attribute__((address_space(3)))
typedef unsigned short bf16;
typedef unsigned v4u __attribute__((ext_vector_type(4)));
typedef unsigned v2u __attribute__((ext_vector_type(2)));
typedef float f32x4 __attribute__((ext_vector_type(4)));
typedef float f32x2 __attribute__((ext_vector_type(2)));
typedef float f32x16 __attribute__((ext_vector_type(16)));
typedef short bf16x8 __attribute__((ext_vector_type(8)));
typedef short s16x4 __attribute__((ext_vector_type(4)));
typedef __bf16 bf16x2v __attribute__((ext_vector_type(2)));
typedef __bf16 bf16x8v __attribute__((ext_vector_type(8)));
typedef GAS unsigned gu32;
#define RLX_AGENT __ATOMIC_RELAXED, __HIP_MEMORY_SCOPE_AGENT
#define LDS_WAIT() asm volatile("s_waitcnt lgkmcnt(0)" ::: "memory")
#define VM_WAIT() asm volatile("s_waitcnt vmcnt(0)" ::: "memory")
__device__ __forceinline__ unsigned f2bf(float f) { unsigned u = __builtin_bit_cast(unsigned, f); return (u + 0x7fffu + ((u >> 16) & 1u)) >> 16; }
__device__ __forceinline__ unsigned pk2(float lo, float hi) { return pg8::cvt_pk_bf16(lo, hi); }
__device__ __forceinline__ float bflo(unsigned w) { return __builtin_bit_cast(float, w << 16); }
__device__ __forceinline__ float bfhi(unsigned w) { return __builtin_bit_cast(float, w & 0xffff0000u); }
__device__ __forceinline__ float bf1(bf16 h) { return __builtin_bit_cast(float, (unsigned)h << 16); }
__device__ __forceinline__ float sigmoidf_(float x) { return __builtin_amdgcn_rcpf(1.0f + __expf(-x)); }
template <int CTRL> __device__ __forceinline__ float dpp_add(float x) {
    return x + __builtin_bit_cast(float, __builtin_amdgcn_update_dpp(0, __builtin_bit_cast(int, x), CTRL, 0xf, 0xf, true));
}
__device__ __forceinline__ float red16(float x) {
    x = dpp_add<0xB1>(x);
    x = dpp_add<0x4E>(x);
    x = dpp_add<0x141>(x);
    x = dpp_add<0x140>(x);
    return x;
}
template <int CTRL, int RM> __device__ __forceinline__ float dpp_max(float x) {
    return fmaxf(x, __builtin_bit_cast(float, __builtin_amdgcn_update_dpp(__builtin_bit_cast(int, x), __builtin_bit_cast(int, x), CTRL, RM, 0xf, false)));
}
template <int CTRL, int RM> __device__ __forceinline__ float dpp_sum(float x) {
    return x + __builtin_bit_cast(float, __builtin_amdgcn_update_dpp(0, __builtin_bit_cast(int, x), CTRL, RM, 0xf, false));
}
__device__ __forceinline__ float wave_max_u(float x) {
    x = dpp_max<0xB1, 0xf>(x); x = dpp_max<0x4E, 0xf>(x); x = dpp_max<0x141, 0xf>(x); x = dpp_max<0x140, 0xf>(x);
    x = dpp_max<0x142, 0xa>(x); x = dpp_max<0x143, 0xc>(x);
    return __builtin_bit_cast(float, __builtin_amdgcn_readlane(__builtin_bit_cast(int, x), 63));
}
__device__ __forceinline__ float wave_sum_u(float x) {
    x = dpp_sum<0xB1, 0xf>(x); x = dpp_sum<0x4E, 0xf>(x); x = dpp_sum<0x141, 0xf>(x); x = dpp_sum<0x140, 0xf>(x);
    x = dpp_sum<0x142, 0xa>(x); x = dpp_sum<0x143, 0xc>(x);
    return __builtin_bit_cast(float, __builtin_amdgcn_readlane(__builtin_bit_cast(int, x), 63));
}
__device__ __forceinline__ float wave_sum(float v) { return wave_sum_u(v); }
__device__ __forceinline__ float bpermf(int srclane, float v) { return __builtin_bit_cast(float, __builtin_amdgcn_ds_bpermute(srclane << 2, __builtin_bit_cast(int, v))); }
__device__ __forceinline__ int bpermi(int srclane, int v) { return __builtin_amdgcn_ds_bpermute(srclane << 2, v); }

#define XB_TMO      128
#define XB_XCNT(j)  (256  + 64 * (j))
#define XB_XSUB(j)  (1280 + 64 * (j))
#define XB_XGEN(j)  (2304 + 64 * (j))
#define XB_TOP      3328
#define XB_TOPGEN   3392
#define XCD_BAR_WORDS 3456
#define XB_SPIN_CAP (1u << 20)

__device__ __forceinline__ unsigned xb_ld(unsigned* p)              { return __hip_atomic_load(p, __ATOMIC_RELAXED, __HIP_MEMORY_SCOPE_AGENT); }
__device__ __forceinline__ unsigned xb_add(unsigned* p, unsigned v) { return __hip_atomic_fetch_add(p, v, __ATOMIC_RELAXED, __HIP_MEMORY_SCOPE_AGENT); }
__device__ __forceinline__ unsigned xb_xcc_id() { return (unsigned)__builtin_amdgcn_s_getreg((3 << 11) | 20) & 0xFu; }
#define XB_SPIN(cond, bar) do { unsigned _sp = 0; while (cond) { __builtin_amdgcn_s_sleep(1); \
    if ((++_sp & 255u) == 0u) { if (xb_ld(&(bar)[XB_TMO])) break; if (_sp > XB_SPIN_CAP) { atomicAdd(&(bar)[XB_TMO], 1u); break; } } } } while (0)

struct XcdBarrier { unsigned* bar; unsigned x; volatile LAS unsigned* st; };

__device__ __forceinline__ XcdBarrier xcd_barrier_post(unsigned* bar, volatile LAS unsigned* st, bool t0) {
    XcdBarrier b; b.bar = bar; b.x = xb_xcc_id(); b.st = st;
    if (t0) (void)xb_add(&bar[XB_XCNT(b.x)], 1u);
    return b;
}
__device__ __forceinline__ void xcd_barrier_complete(unsigned* bar, unsigned x, unsigned& nloc, unsigned& nx) {
    const unsigned G = gridDim.x * gridDim.y * gridDim.z;
    unsigned sum, cnt, mine, sp = 0u;
    for (;;) {
        sum = 0u; cnt = 0u; mine = 0u;
#pragma unroll
        for (unsigned j = 0; j < 16; ++j) { const unsigned c = xb_ld(&bar[XB_XCNT(j)]); sum += c; cnt += (c > 0u) ? 1u : 0u; mine = (j == x) ? c : mine; }
        if (sum == G) break;
        __builtin_amdgcn_s_sleep(1);
        if ((++sp & 255u) == 0u) { if (xb_ld(&bar[XB_TMO])) break; if (sp > XB_SPIN_CAP) { atomicAdd(&bar[XB_TMO], 1u); break; } }
    }
    nloc = mine > 0u ? mine : 1u; nx = cnt > 0u ? cnt : 1u;
}
__device__ __forceinline__ void xcd_barrier(const XcdBarrier& b, bool t0) {
    asm volatile("s_waitcnt vmcnt(0)" ::: "memory");
    __syncthreads();
    if (t0) {
        unsigned* bar = b.bar;
        __builtin_amdgcn_s_waitcnt(0);
        unsigned nloc = b.st[0], nx = b.st[1];
        if (nloc == 0u) { xcd_barrier_complete(bar, b.x, nloc, nx); b.st[0] = nloc; b.st[1] = nx; }
        const unsigned old = xb_add(&bar[XB_XSUB(b.x)], 1u);
        const unsigned gen = old / nloc;
        if (old + 1u == (gen + 1u) * nloc) {
            __builtin_amdgcn_fence(__ATOMIC_RELEASE, "agent");
            asm volatile("s_waitcnt vmcnt(0)" ::: "memory");
            const unsigned og = xb_add(&bar[XB_TOP], 1u);
            const unsigned tg = og / nx;
            if (og + 1u == (tg + 1u) * nx) xb_add(&bar[XB_TOPGEN], 1u);
            else XB_SPIN(xb_ld(&bar[XB_TOPGEN]) == tg, bar);
            __builtin_amdgcn_fence(__ATOMIC_ACQUIRE, "agent");
            xb_add(&bar[XB_XGEN(b.x)], 1u);
            asm volatile("s_waitcnt vmcnt(0)" ::: "memory");
        } else {
            XB_SPIN(xb_ld(&bar[XB_XGEN(b.x)]) == gen, bar);
            __builtin_amdgcn_fence(__ATOMIC_ACQUIRE, "agent");
            asm volatile("s_waitcnt vmcnt(0)" ::: "memory");
        }
    }
    __syncthreads();
}

struct Frame {
    LAS unsigned char* lds;
    unsigned char* ws;
    const float* const* in;
    int tid, lane, wave;
    int vcu, G;
};
struct Args { const float* in[33]; float* out; unsigned char* ws; int ph_lo, ph_hi; };


namespace pg8 {
typedef unsigned u32x4 __attribute__((ext_vector_type(4)));
struct RowOrder : StaticOrder {
    int lat;
    __host__ __device__ void init_rows(int lat_, int N, int G_, int c_) { lat = lat_; init(lat_ ? NBATCH * SEQ : MALL, N, G_, c_); }
    __host__ __device__ bool next(int i, Unit& u) const { if (!StaticOrder::next(i, u)) return false; if (lat) u.pm = 33 * (u.pm >> 5) + 1 + (u.pm & 31); return true; }
};
#define EPI_LOOP_ROWS for (int ai = 0; ai < 2; ++ai) _Pragma("unroll") for (int m = 0; m < 4; ++m)
#define EPI_PIN asm volatile("" ::: "memory")

struct EpiStoreBf16 {
    static constexpr bool PERM = true, AFTER_DRAIN = false;
    bf16_t* O; int ldc;
    __device__ __forceinline__ void operator()(const f32x4 (&acc)[2][2][4][2], const Unit& u, int wr, int wc, int fr, int fq) const {
        const int row0 = u.pm * BM + wr * 64 + fr, col0 = u.pn * BM + wc * 32 + 8 * fq;
#pragma unroll
        EPI_LOOP_ROWS { bf16_t* rowp = O + (size_t)(row0 + ai * HALF + m * 16) * ldc + col0;
#pragma unroll
            for (int bj = 0; bj < 2; ++bj) { const f32x4 v0 = acc[ai][bj][m][0], v1 = acc[ai][bj][m][1];
                u32x4 w; w.x = cvt_pk_bf16(v0[0], v0[1]); w.y = cvt_pk_bf16(v0[2], v0[3]); w.z = cvt_pk_bf16(v1[0], v1[1]); w.w = cvt_pk_bf16(v1[2], v1[3]);
                *(u32x4*)(rowp + bj * HALF) = w; } }
    }
};
struct EpiGate {
    static constexpr bool PERM = true, AFTER_DRAIN = false;
    bf16_t* O; int ldc; const float* bias;
    __device__ __forceinline__ void operator()(const f32x4 (&acc)[2][2][4][2], const Unit& u, int wr, int wc, int fr, int fq) const {
        const int row0 = u.pm * BM + wr * 64 + fr, col0 = u.pn * BM + wc * 32 + 8 * fq;
        f32x4 bv[2][2];
#pragma unroll
        for (int bj = 0; bj < 2; ++bj)
#pragma unroll
            for (int n = 0; n < 2; ++n) bv[bj][n] = *(const f32x4*)(bias + col0 + bj * HALF + 4 * n);
#pragma unroll
        EPI_LOOP_ROWS { EPI_PIN; bf16_t* rowp = O + (size_t)(row0 + ai * HALF + m * 16) * ldc + col0;
#pragma unroll
            for (int bj = 0; bj < 2; ++bj) { f32x4 v0 = acc[ai][bj][m][0] + bv[bj][0], v1 = acc[ai][bj][m][1] + bv[bj][1];
#pragma unroll
                for (int e = 0; e < 4; ++e) { v0[e] = __builtin_amdgcn_rcpf(1.0f + __expf(-v0[e])); v1[e] = __builtin_amdgcn_rcpf(1.0f + __expf(-v1[e])); }
                u32x4 w; w.x = cvt_pk_bf16(v0[0], v0[1]); w.y = cvt_pk_bf16(v0[2], v0[3]); w.z = cvt_pk_bf16(v1[0], v1[1]); w.w = cvt_pk_bf16(v1[2], v1[3]);
                *(u32x4*)(rowp + bj * HALF) = w; } }
    }
};
__device__ __forceinline__ float bf_lo(unsigned w) { return __builtin_bit_cast(float, w << 16); }
__device__ __forceinline__ float bf_hi(unsigned w) { return __builtin_bit_cast(float, w & 0xffff0000u); }
struct EpiMulAdd {
    static constexpr bool PERM = true, AFTER_DRAIN = false;
    bf16_t* O; const bf16_t* Gt; const bf16_t* Ad; int ldc;
    __device__ __forceinline__ void operator()(const f32x4 (&acc)[2][2][4][2], const Unit& u, int wr, int wc, int fr, int fq) const {
        const int row0 = u.pm * BM + wr * 64 + fr, col0 = u.pn * BM + wc * 32 + 8 * fq;
#pragma unroll
        EPI_LOOP_ROWS { EPI_PIN; const size_t ro = (size_t)(row0 + ai * HALF + m * 16) * ldc + col0;
#pragma unroll
            for (int bj = 0; bj < 2; ++bj) { const f32x4 v0 = acc[ai][bj][m][0], v1 = acc[ai][bj][m][1];
                const u32x4 g = *(const u32x4*)(Gt + ro + bj * HALF);
                float o[8];
                o[0] = bf_lo(g.x) * v0[0]; o[1] = bf_hi(g.x) * v0[1]; o[2] = bf_lo(g.y) * v0[2]; o[3] = bf_hi(g.y) * v0[3];
                o[4] = bf_lo(g.z) * v1[0]; o[5] = bf_hi(g.z) * v1[1]; o[6] = bf_lo(g.w) * v1[2]; o[7] = bf_hi(g.w) * v1[3];
                if (Ad) { const u32x4 a = *(const u32x4*)(Ad + ro + bj * HALF);
                    o[0] += bf_lo(a.x); o[1] += bf_hi(a.x); o[2] += bf_lo(a.y); o[3] += bf_hi(a.y); o[4] += bf_lo(a.z); o[5] += bf_hi(a.z); o[6] += bf_lo(a.w); o[7] += bf_hi(a.w); }
                u32x4 w; w.x = cvt_pk_bf16(o[0], o[1]); w.y = cvt_pk_bf16(o[2], o[3]); w.z = cvt_pk_bf16(o[4], o[5]); w.w = cvt_pk_bf16(o[6], o[7]);
                *(u32x4*)(O + ro + bj * HALF) = w; } }
    }
};
struct EpiResid {
    static constexpr bool PERM = false, AFTER_DRAIN = false;
    float* X; const float* gate;
    const float* xin; const float* cin;
    __device__ __forceinline__ void operator()(const f32x4 (&acc)[2][2][4][2], const Unit& u, int wr, int wc, int fr, int fq) const {
        const int row0 = u.pm * BM + wr * 64 + fr, col0 = u.pn * BM + wc * 32 + 4 * fq;
        const int bb = u.pm / 33, pt = u.pm - bb * 33, mr = (pt == 0) ? 2 : bb;
        const float* gp = gate + (size_t)mr * 12288 + col0;
        const float* sbase = xin ? (pt == 0 ? cin + (size_t)bb * CTXL * DM : xin + ((size_t)bb * SEQ + (size_t)(pt - 1) * BM) * DM) : X + (size_t)u.pm * BM * DM;
        f32x4 gv[2][2];
#pragma unroll
        for (int bj = 0; bj < 2; ++bj)
#pragma unroll
            for (int n = 0; n < 2; ++n) gv[bj][n] = *(const f32x4*)(gp + bj * HALF + n * 16);
#pragma unroll
        EPI_LOOP_ROWS { EPI_PIN; const int rl = wr * 64 + fr + ai * HALF + m * 16; float* rowp = X + (size_t)(u.pm * BM + rl) * DM + col0; const float* srow = sbase + (size_t)rl * DM + col0;
#pragma unroll
            for (int bj = 0; bj < 2; ++bj)
#pragma unroll
                for (int n = 0; n < 2; ++n) *(f32x4*)(rowp + bj * HALF + n * 16) = *(const f32x4*)(srow + bj * HALF + n * 16) + gv[bj][n] * acc[ai][bj][m][n]; }
    }
};
struct EpiF32 {
    static constexpr bool PERM = false, AFTER_DRAIN = false;
    float* C; int ldc;
    __device__ __forceinline__ void operator()(const f32x4 (&acc)[2][2][4][2], const Unit& u, int wr, int wc, int fr, int fq) const {
        const int row0 = u.pm * BM + wr * 64 + fr, col0 = u.pn * BM + wc * 32 + 4 * fq;
#pragma unroll
        EPI_LOOP_ROWS { float* rowp = C + (size_t)(row0 + ai * HALF + m * 16) * ldc + col0;
#pragma unroll
            for (int bj = 0; bj < 2; ++bj)
#pragma unroll
                for (int n = 0; n < 2; ++n) *(f32x4*)(rowp + bj * HALF + n * 16) = acc[ai][bj][m][n]; }
    }
};
struct EpiQ {
    static constexpr bool PERM = true, AFTER_DRAIN = false;
    bf16_t* Q; const f32x2* rope; float qscale;
    __device__ __forceinline__ void operator()(const f32x4 (&acc)[2][2][4][2], const Unit& u, int wr, int wc, int fr, int fq) const {
        const int bb = u.pm / 33, tp0 = (u.pm - bb * 33) * BM + wr * 64 + fr, col0 = u.pn * BM + wc * 32 + 8 * fq;
#pragma unroll
        for (int bj = 0; bj < 2; ++bj) { const int c = col0 + bj * HALF, hd = c / QKD, d = c - hd * QKD;
#pragma unroll
            EPI_LOOP_ROWS { EPI_PIN; const int tp = tp0 + ai * HALF + m * 16;
                f32x4 v0 = acc[ai][bj][m][0], v1 = acc[ai][bj][m][1];
                if (d >= 64) { const int i0 = (d - 64) >> 1; const f32x2* rp = rope + (size_t)tp * 16 + i0;
                    const f32x2 c0 = rp[0], c1 = rp[1], c2 = rp[2], c3 = rp[3];
                    float a, b;
                    a = v0[0]; b = v0[1]; v0[0] = a * c0.x - b * c0.y; v0[1] = a * c0.y + b * c0.x;
                    a = v0[2]; b = v0[3]; v0[2] = a * c1.x - b * c1.y; v0[3] = a * c1.y + b * c1.x;
                    a = v1[0]; b = v1[1]; v1[0] = a * c2.x - b * c2.y; v1[1] = a * c2.y + b * c2.x;
                    a = v1[2]; b = v1[3]; v1[2] = a * c3.x - b * c3.y; v1[3] = a * c3.y + b * c3.x; }
                v0 = v0 * qscale; v1 = v1 * qscale;
                u32x4 w; w.x = cvt_pk_bf16(v0[0], v0[1]); w.y = cvt_pk_bf16(v0[2], v0[3]); w.z = cvt_pk_bf16(v1[0], v1[1]); w.w = cvt_pk_bf16(v1[2], v1[3]);
                *(u32x4*)(Q + ((size_t)(bb * NH + hd) * TPB + tp) * QKD + d) = w; } }
    }
};
struct EpiKV {
    static constexpr bool PERM = true, AFTER_DRAIN = false;
    bf16_t* K; bf16_t* V;
    __device__ __forceinline__ void operator()(const f32x4 (&acc)[2][2][4][2], const Unit& u, int wr, int wc, int fr, int fq) const {
        const int bb = u.pm / 33, tp0 = (u.pm - bb * 33) * BM + wr * 64 + fr;
        const bool isK = wc < 2;
        bf16_t* base = isK ? K : V; const int pitch = isK ? QKD : 64, doff = 32 * (wc & 1) + 8 * fq;
#pragma unroll
        for (int bj = 0; bj < 2; ++bj) { const int hd = 2 * u.pn + bj;
            bf16_t* hb = base + (size_t)(bb * NH + hd) * TPB * pitch;
#pragma unroll
            EPI_LOOP_ROWS { EPI_PIN; const int tp = tp0 + ai * HALF + m * 16;
                const f32x4 v0 = acc[ai][bj][m][0], v1 = acc[ai][bj][m][1];
                u32x4 w; w.x = cvt_pk_bf16(v0[0], v0[1]); w.y = cvt_pk_bf16(v0[2], v0[3]); w.z = cvt_pk_bf16(v1[0], v1[1]); w.w = cvt_pk_bf16(v1[2], v1[3]);
                *(u32x4*)((char*)hb + (unsigned)((tp * pitch + doff) * 2)) = w; } }
    }
};
}

struct TItem { const float* W; bf16* WT; int K, ldw, c0, N, mapq, item; };
__device__ __forceinline__ void p0_item_load(const TItem& T, int lane, f32x4 (&x)[8]) {
    const int nblk = T.N / 32, kb = T.item / nblk, nb = T.item - kb * nblk, k0 = 64 * kb, n0 = 32 * nb;
    const float* p = T.W + (size_t)(k0 + (lane >> 3)) * T.ldw + T.c0 + n0 + (lane & 7) * 4;
#pragma unroll
    for (int i = 0; i < 8; ++i) x[i] = *(const GAS f32x4*)(p + (size_t)(8 * i) * T.ldw);
}
__device__ __forceinline__ void p0_item_finish(const TItem& T, const f32x4 (&x)[8], LAS float* scr, int lane) {
    const int nblk = T.N / 32, kb = T.item / nblk, nb = T.item - kb * nblk, k0 = 64 * kb, n0 = 32 * nb;
#pragma unroll
    for (int i = 0; i < 8; ++i) { LAS float* d = scr + (8 * i + (lane >> 3)) * 33 + (lane & 7) * 4; d[0] = x[i].x; d[1] = x[i].y; d[2] = x[i].z; d[3] = x[i].w; }
    LDS_WAIT(); asm volatile("" ::: "memory");
    const int c = lane & 7;
#pragma unroll
    for (int j = 0; j < 4; ++j) { const int n = (lane >> 3) + 8 * j; const LAS float* s = scr + (8 * c) * 33 + n;
        v4u o; o.x = pk2(s[0 * 33], s[1 * 33]); o.y = pk2(s[2 * 33], s[3 * 33]); o.z = pk2(s[4 * 33], s[5 * 33]); o.w = pk2(s[6 * 33], s[7 * 33]);
        int nn = n0 + n;
        if (T.mapq) { const int hd = nn / QKD, d = nn - hd * QKD; if (d >= 64) { const int i = (d - 64) & 15, s2 = (d - 64) >> 4; nn = hd * QKD + 64 + 2 * i + s2; } }
        *(GAS v4u*)(T.WT + (size_t)nn * T.K + k0 + 8 * c) = o; }
    LDS_WAIT(); asm volatile("" ::: "memory");
}

__device__ __forceinline__ const float* karg(int i);
constexpr int TB_INA = (DM / 128) * ((INA + 127) / 128), TB_G = (DM / 128) * (DM / 128), TB_BR = (RW / 128) * (DM / 128), TB_UQ = (512 / 128) * (NQ / 128), TB_UKV = (256 / 128) * (NKV / 128);
constexpr int TB_N = TB_INA + 2 * TB_G + 2 * TB_BR + TB_G + TB_UQ + TB_UKV;
constexpr int TI_LR = 1 * (RW / 32), TI_N = 4 * TI_LR;
__device__ __forceinline__ TItem p0_resolve_big(unsigned char* ws, int git) {
    const int l = git / TB_N; int r = git - l * TB_N; TItem T; T.mapq = 0; T.c0 = 0;
    if (r < TB_INA) { T.W = karg(7) + (size_t)l * DM * INC; T.K = DM; T.ldw = INC; T.N = INA; T.WT = (bf16*)(ws + WS_WINA) + (size_t)l * INA_P * DM; T.item = r; return T; } r -= TB_INA;
    if (r < TB_G) { T.W = karg(7) + (size_t)l * DM * INC; T.K = DM; T.ldw = INC; T.c0 = INA; T.N = DM; T.WT = (bf16*)(ws + WS_WGA) + (size_t)l * DM * DM; T.item = r; return T; } r -= TB_G;
    if (r < TB_G) { T.W = karg(7) + (size_t)l * DM * INC; T.K = DM; T.ldw = INC; T.c0 = INA + DM; T.N = DM; T.WT = (bf16*)(ws + WS_WGB) + (size_t)l * DM * DM; T.item = r; return T; } r -= TB_G;
    if (r < TB_BR) { T.W = karg(24) + (size_t)l * RW * DM; T.K = RW; T.ldw = DM; T.N = DM; T.WT = (bf16*)(ws + WS_WA) + (size_t)l * DM * RW; T.item = r; return T; } r -= TB_BR;
    if (r < TB_BR) { T.W = karg(25) + (size_t)l * RW * DM; T.K = RW; T.ldw = DM; T.N = DM; T.WT = (bf16*)(ws + WS_WB) + (size_t)l * DM * RW; T.item = r; return T; } r -= TB_BR;
    if (r < TB_G) { T.W = karg(26) + (size_t)l * DM * DM; T.K = DM; T.ldw = DM; T.N = DM; T.WT = (bf16*)(ws + WS_WO) + (size_t)l * DM * DM; T.item = r; return T; } r -= TB_G;
    if (r < TB_UQ) { T.W = karg(21) + (size_t)l * 512 * NQ; T.K = 512; T.ldw = NQ; T.N = NQ; T.WT = (bf16*)(ws + WS_WUQ) + (size_t)l * NQ * 512; T.item = r; T.mapq = 1; return T; } r -= TB_UQ;
    { T.W = karg(23) + (size_t)l * 256 * NKV; T.K = 256; T.ldw = NKV; T.N = NKV; T.WT = (bf16*)(ws + WS_WUKV) + (size_t)l * NKV * 256; T.item = r; return T; }
}
__device__ __forceinline__ void p0_big_load(const TItem& T, int tid, f32x4 (&x)[8]) {
    const int nblk = (T.N + 127) / 128, kb = T.item / nblk, nb = T.item - kb * nblk, k0 = 128 * kb, col = 128 * nb + (tid & 31) * 4;
    const float* p = T.W + (size_t)(k0 + (tid >> 5)) * T.ldw + T.c0 + col; const bool ok = col < T.N;
#pragma unroll
    for (int i = 0; i < 8; ++i) x[i] = ok ? *(const GAS f32x4*)(p + (size_t)(16 * i) * T.ldw) : (f32x4){0.f, 0.f, 0.f, 0.f};
}
__device__ __forceinline__ void p0_big_finish(const TItem& T, const f32x4 (&x)[8], LAS float* tile, int tid) {
    const int nblk = (T.N + 127) / 128, kb = T.item / nblk, nb = T.item - kb * nblk, k0 = 128 * kb, n0 = 128 * nb;
    __syncthreads();
#pragma unroll
    for (int i = 0; i < 8; ++i) *(LAS f32x4*)(tile + ((tid >> 5) + 16 * i) * 132 + (tid & 31) * 4) = x[i];
    __syncthreads();
    const int n = tid & 127, cg = tid >> 7; int nn = n0 + n;
    if (nn < T.N) {
        if (T.mapq) { const int hd = nn / QKD, d = nn - hd * QKD; if (d >= 64) { const int i = (d - 64) & 15, s2 = (d - 64) >> 4; nn = hd * QKD + 64 + 2 * i + s2; } }
#pragma unroll
        for (int c = 0; c < 4; ++c) { const LAS float* s = tile + (32 * cg + 8 * c) * 132 + n;
            v4u o; o.x = pk2(s[0 * 132], s[1 * 132]); o.y = pk2(s[2 * 132], s[3 * 132]); o.z = pk2(s[4 * 132], s[5 * 132]); o.w = pk2(s[6 * 132], s[7 * 132]);
            *(GAS v4u*)(T.WT + (size_t)nn * T.K + k0 + 32 * cg + 8 * c) = o; } }
}
__device__ __forceinline__ TItem p0_resolve(unsigned char* ws, int git) {
    const int l = git / TI_N; int r = git - l * TI_N; TItem T; T.mapq = 0; T.c0 = 0;
    const int which = r / TI_LR, d = which & 1, isa = which >> 1; r -= which * TI_LR;
    T.W = (isa ? karg(13) : karg(11)) + (size_t)(l * 2 + d) * 64 * RW; T.K = 64; T.ldw = RW; T.N = RW; T.WT = (bf16*)(ws + (isa ? WS_AUP : WS_WUP)) + (size_t)(l * 2 + d) * RW * 64; T.item = r; return T;
}
__device__ __forceinline__ void p0_prologue(Frame& F, int l_lo, int l_hi, int svcu, int sG) {
    LAS float* scr = (LAS float*)(F.lds + F.wave * 16384);
    const int gw = svcu * NWAVES + F.wave, NGW = sG * NWAVES;
    unsigned char* ws = F.ws;
    for (int rp_ = 0; rp_ < (DBG_REPEAT == 102 ? 2 : 1); ++rp_)
    { float* modw = (float*)(ws + WS_CTL + CTL_MOD_OFF); const float* adaw = karg(4); const float* adab = karg(5); const float* cin = karg(1); const float* cctx = karg(3);
      LAS float* SIL = (LAS float*)F.lds;
      LAS f32x2* part = (LAS f32x2*)(F.lds + 32768);
      if (svcu >= 0 && l_lo * 96 + svcu < l_hi * 96) {
          for (int i = F.tid; i < 3 * DM; i += 512) { const int r = i >> 11, k = i & 2047; const float c = r < 2 ? cin[r * DM + k] : cctx[k]; SIL[i] = c / (1.f + __expf(-c)); }
          __syncthreads(); }
      if (svcu >= 0) for (int uu = l_lo * 96 + svcu; uu < l_hi * 96; uu += sG) { const int cb = uu % 96, l = uu / 96;
          const int n0 = cb * 128 + F.lane * 2; const float* aw = adaw + (size_t)l * DM * 12288 + n0;
          f32x2 a0 = {0, 0}, a1 = a0, a2 = a0;
#pragma unroll 1
          for (int k0 = F.wave * 256; k0 < F.wave * 256 + 256; k0 += 16) { f32x2 w[16];
#pragma unroll
              for (int j = 0; j < 16; ++j) w[j] = *(const GAS f32x2*)(aw + (size_t)(k0 + j) * 12288);
#pragma unroll
              for (int j = 0; j < 16; ++j) { a0 = a0 + w[j] * SIL[k0 + j]; a1 = a1 + w[j] * SIL[DM + k0 + j]; a2 = a2 + w[j] * SIL[2 * DM + k0 + j]; } }
          __syncthreads();
          part[(F.wave * 3 + 0) * 64 + F.lane] = a0; part[(F.wave * 3 + 1) * 64 + F.lane] = a1; part[(F.wave * 3 + 2) * 64 + F.lane] = a2;
          __syncthreads();
          if (F.wave < 3) { f32x2 s = *(const GAS f32x2*)(adab + (size_t)l * 12288 + n0);
#pragma unroll
              for (int w8 = 0; w8 < 8; ++w8) s = s + part[(w8 * 3 + F.wave) * 64 + F.lane];
              *(GAS f32x2*)(modw + ((size_t)l * 3 + F.wave) * 12288 + n0) = s; }
          __syncthreads(); } }
    for (int rp_ = 0; rp_ < (DBG_REPEAT == 101 ? 2 : 1); ++rp_)
    { unsigned* ctr = (unsigned*)(ws + WS_CTL) + 2048 + 64 * rp_ + 128 * l_lo; LAS float* tile = (LAS float*)F.lds; LAS int* slot = (LAS int*)(F.lds + 128 * 132 * 4);
#define P0_GRAB(dst) do { __syncthreads(); if (F.tid == 0) *slot = (int)__hip_atomic_fetch_add(ctr, 1u, __ATOMIC_RELAXED, __HIP_MEMORY_SCOPE_AGENT); __syncthreads(); dst = *slot; } while (0)
      const int it_end = l_hi * TB_N;
      int it; P0_GRAB(it); it += l_lo * TB_N; f32x4 xa[8], xb[8]; TItem T, Tn;
      if (it < it_end) { T = p0_resolve_big(ws, it); p0_big_load(T, F.tid, xa); }
      while (it < it_end) { int itn; P0_GRAB(itn); itn += l_lo * TB_N; const bool more = itn < it_end;
          if (more) { Tn = p0_resolve_big(ws, itn); p0_big_load(Tn, F.tid, xb); }
          p0_big_finish(T, xa, tile, F.tid);
          if (more) { T = Tn;
#pragma unroll
              for (int i = 0; i < 8; ++i) xa[i] = xb[i]; }
          it = itn; }
#undef P0_GRAB
      __syncthreads();
      if (svcu >= 0) for (int itw = l_lo * TI_N + gw; itw < l_hi * TI_N; itw += NGW) { f32x4 xw[8]; const TItem Tw = p0_resolve(ws, itw); p0_item_load(Tw, F.lane, xw); p0_item_finish(Tw, xw, scr, F.lane); }
    }
    const int gt = gw * 64 + F.lane, NGT = NGW * 64;
    { const float* gup = karg(14);
    if (svcu >= 0) for (int i = l_lo * 2 * 32 * RW + gt; i < l_hi * 2 * 32 * RW; i += NGT) { const int ch = i & 1023, r = (i >> 10) & 31, ld = i >> 15;
        ((bf16*)(ws + WS_GUP))[((size_t)ld * RW + ch) * 32 + r] = (bf16)f2bf(gup[i]); } }
    if (svcu >= 0) for (int i = l_lo * ((INA_P - INA) * DM / 8) + gt; i < l_hi * ((INA_P - INA) * DM / 8); i += NGT) { const int l = i / ((INA_P - INA) * DM / 8), r = i - l * ((INA_P - INA) * DM / 8);
        ((GAS v4u*)((bf16*)(ws + WS_WINA) + ((size_t)l * INA_P + INA) * DM))[r] = (v4u){0u, 0u, 0u, 0u}; }
    { f32x2* rt = (f32x2*)(ws + WS_ROPE);
      if (l_lo == 0 && svcu >= 0) for (int i = gt; i < TPB * 16; i += NGT) { const int tp = i >> 4, k = i & 15; f32x2 o = {1.f, 0.f};
          if (tp >= CTXL) { const int t = tp - CTXL, row = t >> 6, col = t & 63, j = k & 7; const float fr = powf(10000.0f, -(float)j / 8.0f);
              const float ang = (float)(k < 8 ? row : col) * fr; o.x = cosf(ang); o.y = sinf(ang); }
          rt[i] = o; } }
    for (int rp_ = 0; rp_ < (DBG_REPEAT == 103 ? 2 : 1); ++rp_)
    { LAS float* KEY = (LAS float*)F.lds;
      LAS float* WQT = (LAS float*)(F.lds + 65536);
      const float* pkeys = karg(29); const float* pwq = karg(28);
      __syncthreads();
      if (svcu >= 0) for (int uu = l_lo * 512 + svcu; uu < l_hi * 512; uu += sG) { const int kb = uu & 31, hp = (uu >> 5) & 15, l = uu >> 9;
          const GAS f32x4* ksrc = (const GAS f32x4*)(pkeys + ((size_t)l * 16 + hp) * 16384);
          for (int i = F.tid; i < 4096; i += 512) ((LAS f32x4*)KEY)[i] = ksrc[i];
          for (int i = F.tid; i < 2048; i += 512) { const int kk = i >> 5, d4 = i & 31;
              *(LAS f32x4*)(WQT + kk * 132 + d4 * 4) = *(const GAS f32x4*)(pwq + ((size_t)l * DM + kb * 64 + kk) * DM + hp * 128 + d4 * 4); }
          __syncthreads();
          const int kq = F.tid & 15, keyq = F.tid >> 4;
          float acc[4][4];
#pragma unroll
          for (int j = 0; j < 4; ++j)
#pragma unroll
              for (int i = 0; i < 4; ++i) acc[j][i] = 0.f;
          for (int d = 0; d < 128; d += 4) { f32x4 w[4], q[4];
#pragma unroll
              for (int i = 0; i < 4; ++i) w[i] = *(LAS f32x4*)(WQT + (kq + 16 * i) * 132 + d);
#pragma unroll
              for (int j = 0; j < 4; ++j) q[j] = *(LAS f32x4*)(KEY + (4 * keyq + j) * 128 + d);
#pragma unroll
              for (int j = 0; j < 4; ++j)
#pragma unroll
                  for (int i = 0; i < 4; ++i) acc[j][i] += q[j].x * w[i].x + q[j].y * w[i].y + q[j].z * w[i].z + q[j].w * w[i].w; }
          bf16* dst = (bf16*)(ws + WS_WQK) + ((size_t)l * DM + hp * 128 + 4 * keyq) * DM + kb * 64 + kq;
#pragma unroll
          for (int j = 0; j < 4; ++j)
#pragma unroll
              for (int i = 0; i < 4; ++i) dst[(size_t)j * DM + 16 * i] = (bf16)f2bf(acc[j][i]);
          __syncthreads(); } }
}

__device__ __forceinline__ const float* modnorm_src(int m, const float* X, const float* xin, const float* cin) {
    const int b = m / TPB, tp = m - b * TPB;
    return xin ? (tp < CTXL ? cin + ((size_t)b * CTXL + tp) * DM : xin + ((size_t)b * SEQ + (tp - CTXL)) * DM) : X + (size_t)m * DM;
}
__device__ __forceinline__ void modnorm_phase(Frame& F, const float* X, const float* g, const float* mod  , int chunk_sh, bf16* H, int skip_ctx, const float* xin = nullptr, const float* cin = nullptr) {
    const int gw = F.vcu * NWAVES + F.wave, NGW = F.G * NWAVES;
    int m = gw; while (m < MALL && skip_ctx && (m % TPB) < CTXL) m += NGW;
    f32x4 v[8], ga[8], sb[8]; int mr_cur = -1;
    if (m < MALL) { const GAS f32x4* xr = (const GAS f32x4*)modnorm_src(m, X, xin, cin) + F.lane;
#pragma unroll
        for (int j = 0; j < 8; ++j) v[j] = xr[64 * j]; }
    while (m < MALL) {
        int mn = m + NGW; while (mn < MALL && skip_ctx && (mn % TPB) < CTXL) mn += NGW;
        f32x4 nv[8];
        if (mn < MALL) { const GAS f32x4* xr = (const GAS f32x4*)modnorm_src(mn, X, xin, cin) + F.lane;
#pragma unroll
            for (int j = 0; j < 8; ++j) nv[j] = xr[64 * j]; }
        const int b = m / TPB, tp = m - b * TPB, mr = tp < CTXL ? 2 : b;
        if (mr != mr_cur) { mr_cur = mr; const float* sh = mod + (size_t)mr * 12288 + chunk_sh * DM; const float* sc = sh + DM;
#pragma unroll
            for (int j = 0; j < 8; ++j) { const int c = (F.lane + 64 * j) * 4; const f32x4 gg = *(const GAS f32x4*)(g + c), s1 = *(const GAS f32x4*)(sc + c); ga[j] = gg * (s1 + 1.0f); sb[j] = *(const GAS f32x4*)(sh + c); } }
        float s = 0.f;
#pragma unroll
        for (int j = 0; j < 8; ++j) s += (v[j].x * v[j].x + v[j].y * v[j].y) + (v[j].z * v[j].z + v[j].w * v[j].w);
        const float rs = rsqrtf(wave_sum(s) * (1.f / DM) + NORM_EPS);
        GAS v2u* o8 = (GAS v2u*)(H + (size_t)m * DM) + F.lane;
#pragma unroll
        for (int j = 0; j < 8; ++j) { const f32x4 y = (v[j] * rs) * ga[j] + sb[j];
            v2u o; o.x = pk2(y.x, y.y); o.y = pk2(y.z, y.w); o8[64 * j] = o; }
#pragma unroll
        for (int j = 0; j < 8; ++j) v[j] = nv[j];
        m = mn;
    }
}

typedef float f32x4v __attribute__((ext_vector_type(4)));
#define MFMA16(a, b, c) __builtin_amdgcn_mfma_f32_16x16x32_bf16((a), (b), (c), 0, 0, 0)
#define MFMA32(a, b, c) __builtin_amdgcn_mfma_f32_32x32x16_bf16((a), (b), (c), 0, 0, 0)

struct FeatP {
    const bf16* PA; const float* mu; const float* w0; const float* a0; const float* k_k; const float* k_a; const float* r_k;
    const bf16* WUP; const bf16* AUP; const bf16* GUP;
    const float* qnorm; const float* kvnorm; const f32x2* rope;
    bf16* RI; bf16* GG; float* BON; bf16* QN; bf16* KVN; bf16* K;
};
__device__ __forceinline__ f32x4 ld4bf(const bf16* p) { const v2u w = *(const GAS v2u*)p; return (f32x4){bflo(w.x), bfhi(w.x), bflo(w.y), bfhi(w.y)}; }
__device__ __forceinline__ f32x4 mix4(const bf16* PA, int m, int c, bool hp, bool hn, const float* mu) {
    const f32x4 pc = ld4bf(PA + (size_t)m * INA_P + c);
    f32x4 pp = {0, 0, 0, 0}, pn = {0, 0, 0, 0};
    if (hp) pp = ld4bf(PA + (size_t)(m - 1) * INA_P + c);
    if (hn) pn = ld4bf(PA + (size_t)(m + 1) * INA_P + c);
    const f32x4 mm = *(const GAS f32x4*)(mu + c);
    return pc + ((pp + pn) * 0.5f - pc) * mm;
}
__device__ __forceinline__ void unpack8(const v4u w, float (&x)[8]) { x[0] = bflo(w.x); x[1] = bfhi(w.x); x[2] = bflo(w.y); x[3] = bfhi(w.y); x[4] = bflo(w.z); x[5] = bfhi(w.z); x[6] = bflo(w.w); x[7] = bfhi(w.w); }
__device__ __forceinline__ v4u pack8f(const float (&x)[8]) { v4u o; o.x = pk2(x[0], x[1]); o.y = pk2(x[2], x[3]); o.z = pk2(x[4], x[5]); o.w = pk2(x[6], x[7]); return o; }
__device__ __forceinline__ void mix8(const bf16* rowc, bool hp, bool hn, const float (&mu)[8], float (&o)[8]) {
    const v4u zc = {0u, 0u, 0u, 0u};
    const v4u wc = *(const GAS v4u*)rowc, wp = hp ? *(const GAS v4u*)(rowc - INA_P) : zc, wn = hn ? *(const GAS v4u*)(rowc + INA_P) : zc;
    float c[8], p[8], n[8]; unpack8(wc, c); unpack8(wp, p); unpack8(wn, n);
#pragma unroll
    for (int e = 0; e < 8; ++e) o[e] = c[e] + (0.5f * (p[e] + n[e]) - c[e]) * mu[e];
}
struct Raw3 { v4u c, p, n; };
__device__ __forceinline__ Raw3 load3(const bf16* rowc, bool hp, bool hn) { const v4u zc = {0u, 0u, 0u, 0u}; Raw3 r; r.c = *(const GAS v4u*)rowc; r.p = hp ? *(const GAS v4u*)(rowc - INA_P) : zc; r.n = hn ? *(const GAS v4u*)(rowc + INA_P) : zc; return r; }
__device__ __forceinline__ void mix8r(const Raw3& w, const float (&mu)[8], float (&o)[8]) {
    float c[8], p[8], n[8]; unpack8(w.c, c); unpack8(w.p, p); unpack8(w.n, n);
#pragma unroll
    for (int e = 0; e < 8; ++e) o[e] = c[e] + (0.5f * (p[e] + n[e]) - c[e]) * mu[e];
}
__device__ __forceinline__ void features_phase(Frame& F, const FeatP& P) {
    constexpr int LAP = 328;
    LAS bf16* LA = (LAS bf16*)F.lds;
    LAS float* SSQ = (LAS float*)(F.lds + 10752);
    LAS float* PRM = (LAS float*)(F.lds + 12288);
    const int lane = F.lane, w = F.wave, tk = lane & 15, q4 = lane >> 4;
    constexpr int NTILE = MALL / 16, NTG = 64;
    for (int su = F.vcu; su < 4 * NTG; su += F.G) {
        const int cg = su & 3, tg = su >> 2, cw = 256 * cg + 32 * w, ch8 = cw + 8 * q4, hd = 4 * cg + (w >> 1);
        __syncthreads();
        for (int i = F.tid; i < 2560; i += 512) { const int prm = i >> 8, c = (i & 255) + 256 * cg; float v;
            switch (prm) { case 0: v = P.k_k[c]; break; case 1: v = P.k_a[c]; break; case 2: v = P.r_k[c]; break; case 3: v = P.w0[c]; break; case 4: v = P.w0[RW + c]; break;
                           case 5: v = P.a0[c]; break; case 6: v = P.a0[RW + c]; break; case 7: v = P.mu[c]; break; case 8: v = P.mu[RW + c]; break; default: v = P.mu[2 * RW + c]; break; }
            PRM[i] = v; }
        bf16x8 fw[2][2][2], fa[2][2][2], fg[2][2];
        { const int chA = cw + 8 * (tk >> 2) + (tk & 3);
#pragma unroll
          for (int d = 0; d < 2; ++d)
#pragma unroll
              for (int t = 0; t < 2; ++t) {
#pragma unroll
                  for (int ks = 0; ks < 2; ++ks) { fw[d][t][ks] = *(const GAS bf16x8*)(P.WUP + ((size_t)d * RW + chA + 4 * t) * 64 + ks * 32 + q4 * 8); fa[d][t][ks] = *(const GAS bf16x8*)(P.AUP + ((size_t)d * RW + chA + 4 * t) * 64 + ks * 32 + q4 * 8); }
                  fg[d][t] = *(const GAS bf16x8*)(P.GUP + ((size_t)d * RW + chA + 4 * t) * 32 + q4 * 8); } }
        for (int tt = tg; tt < NTILE; tt += NTG) {
            const int m0 = tt * 16;
            const int m = m0 + tk, b = m / TPB, tp = m - b * TPB;
            const bool hp = (tp != 0) && (tp != CTXL), hn = (tp != CTXL - 1) && (tp != TPB - 1);
            const bf16* rowp = P.PA + (size_t)m * INA_P + ch8;
            const Raw3 rawk = load3(rowp + RW, hp, hn), rawr = load3(rowp, hp, hn), rawv = load3(rowp + 2 * RW, hp, hn);
            __syncthreads();
            for (int it = F.tid; it < 640; it += 512) { const int tkk = it / 40, c8 = (it - tkk * 40) * 8, c = C_WD + c8, m = m0 + tkk, tp = m % TPB;
                const bool hp = (tp != 0) && (tp != CTXL), hn = (tp != CTXL - 1) && (tp != TPB - 1);
                float mu[8], v[8];
                { const f32x4 a = *(const GAS f32x4*)(P.mu + c), b2 = *(const GAS f32x4*)(P.mu + c + 4); mu[0] = a.x; mu[1] = a.y; mu[2] = a.z; mu[3] = a.w; mu[4] = b2.x; mu[5] = b2.y; mu[6] = b2.z; mu[7] = b2.w; }
                mix8(P.PA + (size_t)m * INA_P + c, hp, hn, mu, v);
#pragma unroll
                for (int e = 0; e < 8; ++e) { if (c < C_AD) v[e] = 1.0f - 2.0f * __builtin_amdgcn_rcpf(1.0f + __expf(2.0f * v[e])); else if (c >= C_GD) v[e] = sigmoidf_(v[e]); }
                *(LAS v4u*)(LA + tkk * LAP + c8) = pack8f(v); }
            if ((tt & 3) == cg) {
#pragma unroll
                for (int t2 = 0; t2 < 2; ++t2) { const int m = m0 + 2 * w + t2, b = m / TPB, tp = m - b * TPB; const bf16* row = P.PA + (size_t)m * INA_P;
                    { float x[8]; unpack8(*(const GAS v4u*)(row + C_QC + lane * 8), x); float s = 0.f;
#pragma unroll
                      for (int e = 0; e < 8; ++e) s += x[e] * x[e];
                      const float rs = rsqrtf(wave_sum(s) * (1.f / 512.f) + NORM_EPS);
#pragma unroll
                      for (int e = 0; e < 8; ++e) x[e] = x[e] * rs * P.qnorm[lane * 8 + e];
                      *(GAS v4u*)(P.QN + (size_t)m * 512 + lane * 8) = pack8f(x); }
                    { const v2u q = *(const GAS v2u*)(row + C_KVC + lane * 4);
                      float x[4] = {bflo(q.x), bfhi(q.x), bflo(q.y), bfhi(q.y)}; float s = 0.f;
#pragma unroll
                      for (int e = 0; e < 4; ++e) s += x[e] * x[e];
                      const float rs = rsqrtf(wave_sum(s) * (1.f / 256.f) + NORM_EPS);
#pragma unroll
                      for (int e = 0; e < 4; ++e) x[e] = x[e] * rs * P.kvnorm[lane * 4 + e];
                      v2u o; o.x = pk2(x[0], x[1]); o.y = pk2(x[2], x[3]);
                      *(GAS v2u*)(P.KVN + (size_t)m * 256 + lane * 4) = o; }
                    if (lane < 16) { const float x1 = bf1(row[C_KR + lane]), x2 = bf1(row[C_KR + 16 + lane]); const f32x2 cs = P.rope[(size_t)tp * 16 + lane];
                        const unsigned o = pk2(x1 * cs.x - x2 * cs.y, x1 * cs.y + x2 * cs.x);
#pragma unroll
                        for (int h2 = 0; h2 < NH; ++h2) *(GAS unsigned*)(P.K + ((size_t)(b * NH + h2) * TPB + tp) * QKD + 64 + 2 * lane) = o; } } }
            const int pc = 32 * w + 8 * q4;
            float prm[8], kmx[8], kx[8];
#pragma unroll
            for (int e = 0; e < 8; ++e) prm[e] = PRM[8 * 256 + pc + e];
            mix8r(rawk, prm, kmx);
            { float s = 0.f;
#pragma unroll
              for (int e = 0; e < 8; ++e) { kx[e] = kmx[e] * PRM[0 * 256 + pc + e]; s += kx[e] * kx[e]; }
              s += bpermf(lane ^ 16, s); s += bpermf(lane ^ 32, s);
              if (q4 == 0) SSQ[tk * 8 + w] = s; }
            __syncthreads();
            const float rsn = rsqrtf(SSQ[tk * 8 + w] + SSQ[tk * 8 + (w ^ 1)] + 1e-12f);
            f32x4 cw_[2][2], ca_[2][2], cg_[2][2];
#pragma unroll
            for (int d = 0; d < 2; ++d) {
                const bf16x8 bg = *(const LAS bf16x8*)(LA + tk * LAP + 256 + d * 32 + q4 * 8);
                bf16x8 bw[2], ba[2];
#pragma unroll
                for (int ks = 0; ks < 2; ++ks) { bw[ks] = *(const LAS bf16x8*)(LA + tk * LAP + d * 64 + ks * 32 + q4 * 8); ba[ks] = *(const LAS bf16x8*)(LA + tk * LAP + 128 + d * 64 + ks * 32 + q4 * 8); }
#pragma unroll
                for (int t = 0; t < 2; ++t) { f32x4 z = {0, 0, 0, 0};
                    cw_[d][t] = MFMA16(fw[d][t][1], bw[1], MFMA16(fw[d][t][0], bw[0], z));
                    ca_[d][t] = MFMA16(fa[d][t][1], ba[1], MFMA16(fa[d][t][0], ba[0], z));
                    cg_[d][t] = MFMA16(fg[d][t], bg, z); } }
            float r8[8], v8[8], kk8[8];
#pragma unroll
            for (int e = 0; e < 8; ++e) prm[e] = PRM[7 * 256 + pc + e];
            mix8r(rawr, prm, r8);
#pragma unroll
            for (int e = 0; e < 8; ++e) prm[e] = PRM[9 * 256 + pc + e];
            mix8r(rawv, prm, v8);
#pragma unroll
            for (int e = 0; e < 8; ++e) kk8[e] = kx[e] * rsn;
            bf16* rec = P.RI + ((size_t)(b * NH + hd) * TPB + tp) * RREC + (ch8 & 63);
            *(GAS v4u*)(rec) = pack8f(r8); *(GAS v4u*)(rec + 64) = pack8f(kk8); *(GAS v4u*)(rec + 128) = pack8f(v8);
#pragma unroll
            for (int d = 0; d < 2; ++d) {
                float ld[8], ke[8], bb[8], gg[8]; float bs = 0.f;
#pragma unroll
                for (int e = 0; e < 8; ++e) { const int t = e >> 2, r = e & 3;
                    ld[e] = -0.60653066f * sigmoidf_(PRM[(3 + d) * 256 + pc + e] + cw_[d][t][r]);
                    const float aa = sigmoidf_(PRM[(5 + d) * 256 + pc + e] + ca_[d][t][r]);
                    ke[e] = kmx[e] * (1.0f + (aa - 1.0f) * PRM[1 * 256 + pc + e]); bb[e] = kk8[e] * aa; gg[e] = cg_[d][t][r];
                    bs += r8[e] * ke[e] * PRM[2 * 256 + pc + e]; }
                *(GAS v4u*)(rec + (3 + 3 * d) * 64) = pack8f(ld); *(GAS v4u*)(rec + (4 + 3 * d) * 64) = pack8f(bb); *(GAS v4u*)(rec + (5 + 3 * d) * 64) = pack8f(ke);
                *(GAS v4u*)(P.GG + ((size_t)d * MALL + m) * RW + ch8) = pack8f(gg);
                bs += bpermf(lane ^ 16, bs); bs += bpermf(lane ^ 32, bs);
                if (q4 == 0) P.BON[((size_t)d * MALL + m) * 32 + 2 * hd + (w & 1)] = bs; }
        }
    }
}

__device__ __forceinline__ void cvt_row_load(f32x4 (&x)[8], const float* src) {
#pragma unroll
    for (int q = 0; q < 8; ++q) x[q] = *(const GAS f32x4*)(src + q * 4);
}
__device__ __forceinline__ void cvt_row_store(const f32x4 (&x)[8], unsigned char* dst, float* scale_slot, int lane) {
    float am = 0.f;
#pragma unroll
    for (int q = 0; q < 8; ++q) am = fmaxf(am, fmaxf(fmaxf(fabsf(x[q].x), fabsf(x[q].y)), fmaxf(fabsf(x[q].z), fabsf(x[q].w))));
    am = fmaxf(wave_max_u(am), 1e-30f);
    const float g = 6.0f / am, inv = am * (1.0f / 6.0f);
    v4u o;
#pragma unroll
    for (int q = 0; q < 4; ++q) { unsigned w = 0u;
        w = __builtin_amdgcn_cvt_scalef32_pk_fp4_f32(w, x[2 * q].x * g, x[2 * q].y * g, 1.0f, 0);
        w = __builtin_amdgcn_cvt_scalef32_pk_fp4_f32(w, x[2 * q].z * g, x[2 * q].w * g, 1.0f, 1);
        w = __builtin_amdgcn_cvt_scalef32_pk_fp4_f32(w, x[2 * q + 1].x * g, x[2 * q + 1].y * g, 1.0f, 2);
        w = __builtin_amdgcn_cvt_scalef32_pk_fp4_f32(w, x[2 * q + 1].z * g, x[2 * q + 1].w * g, 1.0f, 3);
        o[q] = w; }
    *(GAS v4u*)dst = o;
    if (lane == 0) *scale_slot = inv;
}
struct ScanCvt { const float* pu; const float* pv; unsigned char* PU8; unsigned char* PV8; float* SU; float* SV; };
constexpr int SCH = 32;
constexpr int SSTEP = 6 * 64;
__device__ __forceinline__ int scan_tp(int dir, int s) { return dir == 0 ? s : (s < CTXL ? (CTXL - 1 - s) : (TPB - 1 - (s - CTXL))); }
__device__ __forceinline__ void scan_load(v4u (&rg)[6], const bf16* RIh, int dir, int chunk, int htid) {
    const int tp = scan_tp(dir, chunk * SCH + (htid >> 3));
    const bf16* rec = RIh + (size_t)tp * RREC + (htid & 7) * 8;
#pragma unroll
    for (int i = 0; i < 3; ++i) rg[i] = *(const GAS v4u*)(rec + i * 64);
    rec += (3 + 3 * dir) * 64;
#pragma unroll
    for (int i = 0; i < 3; ++i) rg[3 + i] = *(const GAS v4u*)(rec + i * 64);
}
__device__ __forceinline__ void scan_store(const v4u (&rg)[6], LAS float* buf, int htid) {
    LAS float* d0 = buf + (htid >> 3) * SSTEP + (htid & 7) * 8;
#pragma unroll
    for (int i = 0; i < 6; ++i) { constexpr int SLOT[6] = {4, 0, 5, 2, 1, 3};
        const v4u wv = rg[i];
        f32x4 lo = {bflo(wv.x), bfhi(wv.x), bflo(wv.y), bfhi(wv.y)}, hi = {bflo(wv.z), bfhi(wv.z), bflo(wv.w), bfhi(wv.w)};
        if (i == 3) {
#pragma unroll
            for (int e = 0; e < 4; ++e) { lo[e] = __expf(lo[e]); hi[e] = __expf(hi[e]); } }
        LAS float* d = d0 + SLOT[i] * 64;
        *(LAS f32x4*)d = lo; *(LAS f32x4*)(d + 4) = hi; }
}
__device__ __forceinline__ void scan_phase(Frame& F, const bf16* RI, bf16* Y, const ScanCvt& C) {
    LAS float* bufs = (LAS float*)F.lds;
    constexpr int NCH = TPB / SCH;
    for (int uu = F.vcu; uu < NBATCH * NH * 2 * 4; uu += F.G) {
        const int rg = uu & 3, dir = (uu >> 2) & 1, hd = (uu >> 3) & 15, b = uu >> 7;
        const bf16* RIh = RI + (size_t)(b * NH + hd) * TPB * RREC;
        const int htid = F.tid - 256;
        v4u ra[6], rb[6];
        f32x4 xc[8];
        __syncthreads();
        if (F.wave >= 4) { scan_load(rb, RIh, dir, 0, htid); scan_load(ra, RIh, dir, 1, htid); scan_store(rb, bufs, htid); scan_load(rb, RIh, dir, 2, htid); }
        __syncthreads();
        const int j = F.lane & 15, rowl = F.lane >> 4, row = rg * 16 + (F.wave & 3) * 4 + rowl;
        f32x2 S01 = {0.f, 0.f}, S23 = {0.f, 0.f};
        bf16* yb = Y + ((size_t)dir * MALL + (size_t)b * TPB) * RW + hd * 64 + row;
        for (int c = 0; c < NCH; ++c) {
            LAS float* cur = bufs + (c & 1) * (SCH * SSTEP);
            if (F.wave >= 4) {
                if (c + 1 < NCH) {
                    if ((c & 1) == 0) { scan_store(ra, bufs + (SCH * SSTEP), htid); if (c + 3 < NCH) scan_load(ra, RIh, dir, c + 3, htid); }
                    else { scan_store(rb, bufs, htid); if (c + 3 < NCH) scan_load(rb, RIh, dir, c + 3, htid); }  }
                if ((c & 3) == 0 && (c >> 3) < 32) { const int r = uu * 4 + (F.wave - 4) + 1024 * (c >> 3);
                    if ((c & 7) == 0) cvt_row_load(xc, ((r >= NEXP) ? C.pv + (size_t)(r - NEXP) * DM : C.pu + (size_t)r * DM) + F.lane * 32);
                    else cvt_row_store(xc, ((r >= NEXP) ? C.PV8 + (size_t)(r - NEXP) * (DM / 2) : C.PU8 + (size_t)r * (DM / 2)) + F.lane * 16, (r >= NEXP) ? C.SV + (r - NEXP) : C.SU + r, F.lane); } }
            else {
#pragma unroll
                for (int h16 = 0; h16 < 2; ++h16) {
                    const LAS float* sp = cur + (h16 * 16) * SSTEP;
                    f32x4 kk = *(const LAS f32x4*)(sp + 4 * j), bb = *(const LAS f32x4*)(sp + 64 + 4 * j), ww = *(const LAS f32x4*)(sp + 128 + 4 * j),
                          ke = *(const LAS f32x4*)(sp + 192 + 4 * j), rr = *(const LAS f32x4*)(sp + 256 + 4 * j);
                    float ykeep = 0.f, ypart; f32x2 u2, t2, vv; vv.x = sp[320 + row];
#define SCAN_DPP(r, ctl) "v_add_f32_dpp " r ", " r ", " r " " ctl " row_mask:0xf bank_mask:0xf bound_ctrl:1\n\t"
#define SCAN_MAIN(SEL) asm volatile( \
                        "v_pk_mul_f32 v[242:243], %[kexy], %[vv] op_sel_hi:[1,0]\n\t" \
                        "v_add_f32 v246, v250, v251\n\t" \
                        "v_add_f32_dpp v248, %[yp], %[yp] quad_perm:[1,0,3,2] row_mask:0xf bank_mask:0xf bound_ctrl:1\n\t" \
                        "v_pk_mul_f32 v[244:245], %[kezw], %[vv] op_sel_hi:[1,0]\n\t" \
                        SCAN_DPP("v246", "quad_perm:[1,0,3,2]") SCAN_DPP("v248", "quad_perm:[2,3,0,1]") \
                        "v_pk_fma_f32 %[s01], %[s01], %[wwxy], v[242:243]\n\t" \
                        SCAN_DPP("v246", "quad_perm:[2,3,0,1]") SCAN_DPP("v248", "row_half_mirror") \
                        "v_pk_fma_f32 %[s23], %[s23], %[wwzw], v[244:245]\n\t" \
                        SCAN_DPP("v246", "row_half_mirror") SCAN_DPP("v248", "row_mirror") \
                        SEL "\n\t" \
                        SCAN_DPP("v246", "row_mirror") \
                        "v_pk_fma_f32 %[s01], %[bbxy], v[246:247], %[s01] op_sel_hi:[1,0,1] neg_lo:[0,1,0] neg_hi:[0,1,0]\n\t" \
                        "v_pk_fma_f32 %[s23], %[bbzw], v[246:247], %[s23] op_sel_hi:[1,0,1] neg_lo:[0,1,0] neg_hi:[0,1,0]\n\t" \
                        "v_pk_mul_f32 v[252:253], %[s01], %[rrxy]" \
                        : [s01] "+v"(S01), [s23] "+v"(S23), [yk] "+v"(ykeep), "={v[252:253]}"(u2) \
                        : [kexy] "v"(ke.xy), [kezw] "v"(ke.zw), [vv] "v"(vv), [wwxy] "v"(ww.xy), [wwzw] "v"(ww.zw), [bbxy] "v"(bb.xy), [bbzw] "v"(bb.zw), [rrxy] "v"(rr.xy), [yp] "v"(ypart), [msk] "s"(msk), "{v[250:251]}"(t2) \
                        : "v242", "v243", "v244", "v245", "v246", "v247", "v248")
                    asm volatile("v_pk_mul_f32 v[250:251], %[s01], %[kxy]\n\tv_mov_b32 %[yp], 0\n\tv_pk_fma_f32 v[250:251], %[s23], %[kzw], v[250:251]"
                                 : "=&{v[250:251]}"(t2), [yp] "=&v"(ypart) : [s01] "v"(S01), [s23] "v"(S23), [kxy] "v"(kk.xy), [kzw] "v"(kk.zw));
#pragma unroll
                    for (int st = 0; st < 16; ++st) {
                        f32x4 nkk = kk, nbb = bb, nww = ww, nke = ke, nrr = rr; f32x2 nvv = vv;
                        const LAS float* sn = sp + (st + 1) * SSTEP;
                        if (st + 1 < 16) { nkk = *(const LAS f32x4*)(sn + 4 * j); nke = *(const LAS f32x4*)(sn + 192 + 4 * j); nvv.x = sn[320 + row]; nww = *(const LAS f32x4*)(sn + 128 + 4 * j); nbb = *(const LAS f32x4*)(sn + 64 + 4 * j);
                            nrr = *(const LAS f32x4*)(sn + 256 + 4 * j); }
                        const unsigned long long msk = 0x0001000100010001ull << ((st + 15) & 15);
                        if (st > 0) SCAN_MAIN("v_cndmask_b32_e64 %[yk], %[yk], v248, %[msk]"); else SCAN_MAIN("s_nop 0");
                        if (st + 1 < 16)
                            asm volatile("v_pk_mul_f32 v[250:251], %[s01], %[kxy]\n\tv_pk_fma_f32 v[252:253], %[s23], %[rrzw], v[252:253]\n\tv_pk_fma_f32 v[250:251], %[s23], %[kzw], v[250:251]\n\tv_add_f32 %[yp], v252, v253"
                                         : "=&{v[250:251]}"(t2), "={v[252:253]}"(u2), [yp] "=&v"(ypart) : [s01] "v"(S01), [s23] "v"(S23), [kxy] "v"(nkk.xy), [kzw] "v"(nkk.zw), [rrzw] "v"(rr.zw), "1"(u2));
                        else
                            asm volatile("s_nop 0\n\tv_pk_fma_f32 v[252:253], %[s23], %[rrzw], v[252:253]" : "={v[252:253]}"(u2) : [s23] "v"(S23), [rrzw] "v"(rr.zw), "0"(u2));
                        kk = nkk; bb = nbb; ww = nww; ke = nke; rr = nrr; vv = nvv;
                        __builtin_amdgcn_sched_barrier(0);
                    }
#undef SCAN_MAIN
#undef SCAN_DPP
                    { const float y = red16(u2.x + u2.y); ykeep = (j == 15) ? y : ykeep; }
                    const int tp = scan_tp(dir, c * SCH + h16 * 16 + j);
                    *(GAS bf16*)(yb + (size_t)tp * RW) = (bf16)f2bf(ykeep);
                }
            }
            __syncthreads();
        }
    }
}

constexpr int AKP = 208, AVP = 192;
constexpr int ATILE = 64 * AKP + 64 * AVP;
__device__ __forceinline__ bf16x8 pack8(const f32x16& x, int s) {
    v4u p; p.x = pk2(x[8 * s + 0], x[8 * s + 1]); p.y = pk2(x[8 * s + 2], x[8 * s + 3]); p.z = pk2(x[8 * s + 4], x[8 * s + 5]); p.w = pk2(x[8 * s + 6], x[8 * s + 7]);
    return __builtin_bit_cast(bf16x8, p);
}
__device__ __forceinline__ void attn_phase(Frame& F, const bf16* Q, const bf16* K, const bf16* V, bf16* YB, int with_ctx) {
    const int lane = F.lane, half = lane >> 5, l31 = lane & 31, l16 = lane & 15, g1 = (lane >> 4) & 1;
    const int nunits = NBATCH * NH * 32 + (with_ctx ? NBATCH * NH : 0);
    for (int uu = F.vcu; uu < nunits; uu += F.G) {
        int bh, q0, nkt;
        if (uu < NBATCH * NH * 32) { bh = uu >> 5; q0 = CTXL + (uu & 31) * 256; nkt = TPB / 64; } else { bh = uu - NBATCH * NH * 32; q0 = 0; nkt = CTXL / 64; }
        const bf16* Kh = K + (size_t)bh * TPB * QKD; const bf16* Vh = V + (size_t)bh * TPB * 64; const bf16* Qh = Q + (size_t)bh * TPB * QKD;
        const int tq = q0 + F.wave * 32 + l31;
        bf16x8 qf[6];
#pragma unroll
        for (int ks = 0; ks < 6; ++ks) qf[ks] = *(const GAS bf16x8*)(Qh + (size_t)tq * QKD + 16 * ks + 8 * half);
        f32x16 o0, o1;
#pragma unroll
        for (int i = 0; i < 16; ++i) { o0[i] = 0.f; o1[i] = 0.f; }
        float l_run = 0.f;
        f32x16 cinit;
#pragma unroll
        for (int i = 0; i < 16; ++i) cinit[i] = 0.f;
        asm volatile("" : "+v"(cinit));
        const int kc1 = F.tid + 512; const bool k1ok = kc1 < 768;
        const unsigned kd0 = (unsigned)((F.tid / 12) * AKP + (F.tid % 12) * 16), kd1 = (unsigned)((kc1 / 12) * AKP + (kc1 % 12) * 16), vd = (unsigned)(64 * AKP + (F.tid >> 3) * AVP + (F.tid & 7) * 16);
        v4u kr0, kr1 = {0, 0, 0, 0}, vr;
        kr0 = *(const GAS v4u*)(Kh + (size_t)F.tid * 8); if (k1ok) kr1 = *(const GAS v4u*)(Kh + (size_t)kc1 * 8); vr = *(const GAS v4u*)(Vh + (size_t)F.tid * 8);
        __syncthreads();
        *(LAS v4u*)(F.lds + kd0) = kr0; if (k1ok) *(LAS v4u*)(F.lds + kd1) = kr1; *(LAS v4u*)(F.lds + vd) = vr;
        __syncthreads();
        for (int kt = 0; kt < nkt; ++kt) {
            const bool more = kt + 1 < nkt;
            if (more) { const bf16* kn = Kh + (size_t)(kt + 1) * 64 * QKD; const bf16* vn = Vh + (size_t)(kt + 1) * 64 * 64;
                kr0 = *(const GAS v4u*)(kn + (size_t)F.tid * 8); if (k1ok) kr1 = *(const GAS v4u*)(kn + (size_t)kc1 * 8); vr = *(const GAS v4u*)(vn + (size_t)F.tid * 8); }
            LAS unsigned char* Kb = F.lds + (kt & 1) * ATILE; LAS unsigned char* Vb = Kb + 64 * AKP;
            f32x16 s0, s1;
            { bf16x8 ka[6], kb2[6];
#pragma unroll
              for (int ks = 0; ks < 6; ++ks) { ka[ks] = *(const LAS bf16x8*)(Kb + l31 * AKP + (16 * ks + 8 * half) * 2); kb2[ks] = *(const LAS bf16x8*)(Kb + (32 + l31) * AKP + (16 * ks + 8 * half) * 2); }
              s0 = MFMA32(ka[0], qf[0], cinit); s1 = MFMA32(kb2[0], qf[0], cinit);
#pragma unroll
              for (int ks = 1; ks < 6; ++ks) { s0 = MFMA32(ka[ks], qf[ks], s0); s1 = MFMA32(kb2[ks], qf[ks], s1); }
              __builtin_amdgcn_sched_group_barrier(0x100, 12, 0); __builtin_amdgcn_sched_group_barrier(0x8, 12, 0); }
            bf16x8 va[2][2][2];
#pragma unroll
            for (int t = 0; t < 2; ++t)
#pragma unroll
                for (int s = 0; s < 2; ++s) { const int kb = 32 * t + 16 * s + 4 * half + (l16 >> 2);
#pragma unroll
                    for (int dvt = 0; dvt < 2; ++dvt) { const LAS unsigned char* vp = Vb + kb * AVP + (32 * dvt + 16 * g1 + 4 * (l16 & 3)) * 2;
                        const s16x4 lo = __builtin_amdgcn_ds_read_tr16_b64_v4i16((LAS s16x4*)vp), hi = __builtin_amdgcn_ds_read_tr16_b64_v4i16((LAS s16x4*)(vp + 8 * AVP));
                        va[t][s][dvt] = __builtin_shufflevector(lo, hi, 0, 1, 2, 3, 4, 5, 6, 7); } }
            __builtin_amdgcn_sched_group_barrier(0x100, 16, 0);
            float mx = s0[0];
#pragma unroll
            for (int i = 1; i < 16; ++i) mx = fmaxf(mx, s0[i]);
#pragma unroll
            for (int i = 0; i < 16; ++i) mx = fmaxf(mx, s1[i]);
            mx = fmaxf(mx, bpermf(lane ^ 32, mx));
            if (kt == 0 || __any(mx > 8.0f)) {
                const float d = (kt == 0) ? mx : fmaxf(mx, 0.f), alpha = (kt == 0) ? 1.0f : __builtin_amdgcn_exp2f(-d);
                l_run *= alpha;
#pragma unroll
                for (int i = 0; i < 16; ++i) { o0[i] *= alpha; o1[i] *= alpha; s0[i] -= d; s1[i] -= d; cinit[i] -= d; }
                asm volatile("" : "+v"(cinit));
            }
#pragma unroll
            for (int i = 0; i < 16; ++i) { s0[i] = __builtin_amdgcn_exp2f(s0[i]); s1[i] = __builtin_amdgcn_exp2f(s1[i]); }
            float ps = 0.f;
#pragma unroll
            for (int i = 0; i < 16; ++i) ps += s0[i] + s1[i];
            l_run += ps;
            { bf16x8 pf[2][2];
#pragma unroll
              for (int t = 0; t < 2; ++t)
#pragma unroll
                  for (int s = 0; s < 2; ++s) pf[t][s] = pack8(t == 0 ? s0 : s1, s);
#pragma unroll
              for (int t = 0; t < 2; ++t)
#pragma unroll
                  for (int s = 0; s < 2; ++s) { o0 = MFMA32(va[t][s][0], pf[t][s], o0); o1 = MFMA32(va[t][s][1], pf[t][s], o1); } }
            if (more) { LAS unsigned char* nb = F.lds + ((kt + 1) & 1) * ATILE;
                *(LAS v4u*)(nb + kd0) = kr0; if (k1ok) *(LAS v4u*)(nb + kd1) = kr1; *(LAS v4u*)(nb + vd) = vr; }
            __syncthreads();
        }
        const float linv = (DBG_SKIP & 4) ? 0.f : 1.0f / (l_run + bpermf(lane ^ 32, l_run));
        const int b = bh >> 4, hd = bh & 15;
        bf16* op = YB + ((size_t)b * TPB + tq) * RW + hd * 64 + 4 * half;
#pragma unroll
        for (int g = 0; g < 4; ++g) {
            v2u w; w.x = pk2(o0[4 * g] * linv, o0[4 * g + 1] * linv); w.y = pk2(o0[4 * g + 2] * linv, o0[4 * g + 3] * linv); *(GAS v2u*)(op + 8 * g) = w;
            w.x = pk2(o1[4 * g] * linv, o1[4 * g + 1] * linv); w.y = pk2(o1[4 * g + 2] * linv, o1[4 * g + 3] * linv); *(GAS v2u*)(op + 32 + 8 * g) = w; }
    }
}

__device__ __forceinline__ void readout_phase(Frame& F, const bf16* Y, const bf16* GG, const float* BON, const bf16* RI, const float* ln_w, const float* ln_b, bf16* YA) {
    const int gw = F.vcu * NWAVES + F.wave, NGW = F.G * NWAVES, lane = F.lane, hd = lane >> 2, ch0 = hd * 64 + (lane & 3) * 16;
    for (int m = gw; m < MALL; m += NGW) {
        const int b = m / TPB, tp = m - b * TPB;
        const bf16* rec = RI + ((size_t)(b * NH + hd) * TPB + tp) * RREC + 128 + (lane & 3) * 16;
        float vv[16], out[16];
        { const v4u a = *(const GAS v4u*)rec, c = *(const GAS v4u*)(rec + 8);
          vv[0] = bflo(a.x); vv[1] = bfhi(a.x); vv[2] = bflo(a.y); vv[3] = bfhi(a.y); vv[4] = bflo(a.z); vv[5] = bfhi(a.z); vv[6] = bflo(a.w); vv[7] = bfhi(a.w);
          vv[8] = bflo(c.x); vv[9] = bfhi(c.x); vv[10] = bflo(c.y); vv[11] = bfhi(c.y); vv[12] = bflo(c.z); vv[13] = bfhi(c.z); vv[14] = bflo(c.w); vv[15] = bfhi(c.w); }
#pragma unroll
        for (int e = 0; e < 16; ++e) out[e] = 0.f;
#pragma unroll
        for (int d = 0; d < 2; ++d) {
            const bf16* yp = Y + ((size_t)d * MALL + m) * RW + ch0; const bf16* gp = GG + ((size_t)d * MALL + m) * RW + ch0;
            float y[16], g[16];
            { const v4u a = *(const GAS v4u*)yp, c = *(const GAS v4u*)(yp + 8);
              y[0] = bflo(a.x); y[1] = bfhi(a.x); y[2] = bflo(a.y); y[3] = bfhi(a.y); y[4] = bflo(a.z); y[5] = bfhi(a.z); y[6] = bflo(a.w); y[7] = bfhi(a.w);
              y[8] = bflo(c.x); y[9] = bfhi(c.x); y[10] = bflo(c.y); y[11] = bfhi(c.y); y[12] = bflo(c.z); y[13] = bfhi(c.z); y[14] = bflo(c.w); y[15] = bfhi(c.w); }
            { const v4u a = *(const GAS v4u*)gp, c = *(const GAS v4u*)(gp + 8);
              g[0] = bflo(a.x); g[1] = bfhi(a.x); g[2] = bflo(a.y); g[3] = bfhi(a.y); g[4] = bflo(a.z); g[5] = bfhi(a.z); g[6] = bflo(a.w); g[7] = bfhi(a.w);
              g[8] = bflo(c.x); g[9] = bfhi(c.x); g[10] = bflo(c.y); g[11] = bfhi(c.y); g[12] = bflo(c.z); g[13] = bfhi(c.z); g[14] = bflo(c.w); g[15] = bfhi(c.w); }
            float s = 0.f;
#pragma unroll
            for (int e = 0; e < 16; ++e) s += y[e];
            s = dpp_add<0xB1>(s); s = dpp_add<0x4E>(s);
            const float mean = s * (1.f / 64.f); float q = 0.f;
#pragma unroll
            for (int e = 0; e < 16; ++e) { y[e] -= mean; q += y[e] * y[e]; }
            q = dpp_add<0xB1>(q); q = dpp_add<0x4E>(q);
            const float rstd = rsqrtf(q * (1.f / 64.f) + 64e-5f), bon = BON[((size_t)d * MALL + m) * 32 + 2 * hd] + BON[((size_t)d * MALL + m) * 32 + 2 * hd + 1];
#pragma unroll
            for (int e = 0; e < 16; ++e) out[e] += (y[e] * rstd * ln_w[ch0 + e] + ln_b[ch0 + e] + bon * vv[e]) * g[e];
        }
        if (DBG_SKIP & 2) {
#pragma unroll
            for (int e = 0; e < 16; ++e) out[e] = 0.f; }
        v4u o0, o1;
        o0.x = pk2(out[0], out[1]); o0.y = pk2(out[2], out[3]); o0.z = pk2(out[4], out[5]); o0.w = pk2(out[6], out[7]);
        o1.x = pk2(out[8], out[9]); o1.y = pk2(out[10], out[11]); o1.z = pk2(out[12], out[13]); o1.w = pk2(out[14], out[15]);
        *(GAS v4u*)(YA + (size_t)m * RW + ch0) = o0; *(GAS v4u*)(YA + (size_t)m * RW + ch0 + 8) = o1;
    }
}


__device__ __forceinline__ unsigned f2key(float f) { const unsigned u = __builtin_bit_cast(unsigned, f); return (u & 0x80000000u) ? ~u : (u | 0x80000000u); }
__device__ __forceinline__ float key2f(unsigned k) { const unsigned u = (k & 0x80000000u) ? (k & 0x7fffffffu) : ~k; return __builtin_bit_cast(float, u); }
template <int CTRL, int RM> __device__ __forceinline__ unsigned dpp_umax(unsigned x) {
    const unsigned y = (unsigned)__builtin_amdgcn_update_dpp(0, (int)x, CTRL, RM, 0xf, false); return x > y ? x : y; }
__device__ __forceinline__ unsigned row_umax(unsigned x) { x = dpp_umax<0xB1, 0xf>(x); x = dpp_umax<0x4E, 0xf>(x); x = dpp_umax<0x141, 0xf>(x); x = dpp_umax<0x140, 0xf>(x); return x; }
#define SEL_CE(a_, b_) do { const unsigned hi_ = (a_) > (b_) ? (a_) : (b_), lo_ = (a_) > (b_) ? (b_) : (a_); (a_) = hi_; (b_) = lo_; } while (0)
__device__ __forceinline__ void sel_keys8(unsigned (&k)[8], const float* p, int id0) {
    const f32x4 v0 = *(const GAS f32x4*)p, v1 = *(const GAS f32x4*)(p + 4);
    k[0] = (f2key(v0.x) & ~127u) | (unsigned)(id0 + 0); k[1] = (f2key(v0.y) & ~127u) | (unsigned)(id0 + 1); k[2] = (f2key(v0.z) & ~127u) | (unsigned)(id0 + 2); k[3] = (f2key(v0.w) & ~127u) | (unsigned)(id0 + 3);
    k[4] = (f2key(v1.x) & ~127u) | (unsigned)(id0 + 4); k[5] = (f2key(v1.y) & ~127u) | (unsigned)(id0 + 5); k[6] = (f2key(v1.z) & ~127u) | (unsigned)(id0 + 6); k[7] = (f2key(v1.w) & ~127u) | (unsigned)(id0 + 7);
    SEL_CE(k[0], k[1]); SEL_CE(k[2], k[3]); SEL_CE(k[4], k[5]); SEL_CE(k[6], k[7]); SEL_CE(k[0], k[2]); SEL_CE(k[1], k[3]); SEL_CE(k[4], k[6]); SEL_CE(k[5], k[7]); SEL_CE(k[1], k[2]); SEL_CE(k[5], k[6]);
    SEL_CE(k[0], k[4]); SEL_CE(k[1], k[5]); SEL_CE(k[2], k[6]); SEL_CE(k[3], k[7]); SEL_CE(k[2], k[4]); SEL_CE(k[3], k[5]); SEL_CE(k[1], k[2]); SEL_CE(k[3], k[4]); SEL_CE(k[5], k[6]);
}
__device__ __forceinline__ void top16_rows2(const float* pa, const float* pb, int l16, unsigned& ra, unsigned& rb) {
    unsigned ka[8], kb[8]; sel_keys8(ka, pa + 8 * l16, 8 * l16); sel_keys8(kb, pb + 8 * l16, 8 * l16);
    ra = 0u; rb = 0u;
#pragma unroll
    for (int it = 0; it < 16; ++it) {
        const unsigned ma = row_umax(ka[0]), mb = row_umax(kb[0]); const bool oa = ka[0] == ma, ob = kb[0] == mb;
#pragma unroll
        for (int e = 0; e < 7; ++e) { ka[e] = oa ? ka[e + 1] : ka[e]; kb[e] = ob ? kb[e + 1] : kb[e]; }
        ka[7] = oa ? 0u : ka[7]; kb[7] = ob ? 0u : kb[7];
        ra = (l16 == it) ? ma : ra; rb = (l16 == it) ? mb : rb;
    }
}
struct SelP { const float* SC; int* ESEL; float* EGATE; int last; };
__device__ __forceinline__ void select_phase(Frame& F, const SelP& P) {
    const int gw = F.vcu * NWAVES + F.wave, NGW = F.G * NWAVES, lane = F.lane, row = lane >> 4, l16 = lane & 15, rbase = lane & 48;
    const int i1 = (int)((0x3332222211111111ull >> (4 * l16)) & 15ull), j1 = (int)((0x2104321076543210ull >> (4 * l16)) & 15ull), i2 = (int)((0xdcba987766554443ull >> (4 * l16)) & 15ull), j2 = (int)((0x0000001010102103ull >> (4 * l16)) & 15ull);
    for (int m = gw; m < MALL; m += NGW) {
        bool tok = true; int tp = 0; if (tok) { tp = m % TPB; if (P.last && tp < CTXL) tok = false; }
        if (tok) {
            const float* srow = P.SC + (size_t)m * DM;
#pragma unroll 1
            for (int G = 0; G < 2; ++G) {
                const float* hrow = srow + (4 * G + row) * 256;
                unsigned recA, recB; top16_rows2(hrow, hrow + 128, l16, recA, recB);
                const float va = key2f(recA & ~127u), vb = key2f(recB & ~127u);
                const float a0 = bpermf(rbase, va), a1 = bpermf(rbase + i1, va), b1 = bpermf(rbase + j1, vb), a2 = bpermf(rbase + i2, va), b2 = bpermf(rbase + j2, vb), a3 = bpermf(rbase + 14 + (l16 & 1), va), b0 = bpermf(rbase, vb);
                unsigned ck[4];
                ck[0] = (f2key(a0 + vb) & ~255u) | (unsigned)l16; ck[1] = (f2key(a1 + b1) & ~255u) | (unsigned)(16 * i1 + j1); ck[2] = (f2key(a2 + b2) & ~255u) | (unsigned)(16 * i2 + j2);
                ck[3] = (l16 < 2) ? ((f2key(a3 + b0) & ~255u) | (unsigned)(16 * (14 + l16))) : 0u;
                SEL_CE(ck[0], ck[1]); SEL_CE(ck[2], ck[3]); SEL_CE(ck[0], ck[2]); SEL_CE(ck[1], ck[3]); SEL_CE(ck[1], ck[2]);
                unsigned rec = 0u;
#pragma unroll
                for (int it = 0; it < 16; ++it) {
                    const unsigned mh = row_umax(ck[0]); const bool own = ck[0] == mh;
                    ck[0] = own ? ck[1] : ck[0]; ck[1] = own ? ck[2] : ck[1]; ck[2] = own ? ck[3] : ck[2]; ck[3] = own ? 0u : ck[3];
                    rec = (l16 == it) ? mh : rec;
                }
                const float ts = key2f(rec & ~255u), tmax = bpermf(rbase, ts);
                const float ev = __expf(ts - tmax), esum = red16(ev);
                const int ci = (int)((rec >> 4) & 15u), cj = (int)(rec & 15u);
                const int expert = bpermi(rbase + ci, (int)(recA & 127u)) * 128 + bpermi(rbase + cj, (int)(recB & 127u));
                const int slot = (4 * G + row) * 16 + l16; P.ESEL[(size_t)m * 128 + slot] = expert; P.EGATE[(size_t)m * 128 + slot] = ev / esum;
            }
        }
    }
}
struct PeerP { const float* nmod; const float* ng; bf16* Hout;   const int* ESEL; const float* EGATE; const bf16* H; const unsigned char* PU; const unsigned char* PV; const float* SU; const float* SV; float* X; const float* mod;   const float* fin_g; float* out; int last; int dry; };
__device__ __forceinline__ void peer_phase(Frame& F, const PeerP& P) {
    const int gw = F.vcu * NWAVES + F.wave, NGW = F.G * NWAVES, lane = F.lane;
    float pr_s2 = 0.f, pr_d2 = 0.f, pr_tg = 0.f, pr_n = 0.f;
    int m0 = gw; while (m0 < MALL && P.last && (m0 % TPB) < CTXL) m0 += NGW;
    int pe0 = 0, pe1 = 0; float pg0 = 0.f, pg1 = 0.f; v4u ph0 = {0u, 0u, 0u, 0u}, ph1 = ph0, ph2 = ph0, ph3 = ph0;
    if (m0 < MALL) { pe0 = P.ESEL[(size_t)m0 * 128 + lane]; pe1 = P.ESEL[(size_t)m0 * 128 + 64 + lane]; pg0 = P.EGATE[(size_t)m0 * 128 + lane]; pg1 = P.EGATE[(size_t)m0 * 128 + 64 + lane];
        const bf16* hp = P.H + (size_t)m0 * DM + lane * 32; ph0 = *(const GAS v4u*)hp; ph1 = *(const GAS v4u*)(hp + 8); ph2 = *(const GAS v4u*)(hp + 16); ph3 = *(const GAS v4u*)(hp + 24); }
    for (int m = m0, mn = 0; m < MALL; m = mn) {
        mn = m + NGW; while (mn < MALL && P.last && (mn % TPB) < CTXL) mn += NGW;
        const int b = m / TPB, tp = m - b * TPB;
        const int mr = tp < CTXL ? 2 : b;
        const int emask_ = (P.dry & 2) ? 1023 : 0x7fffffff;
        const int eidx[2] = {pe0 & emask_, pe1 & emask_}; const float egate[2] = {pg0, pg1};
        typedef int v8i __attribute__((ext_vector_type(8)));
        LAS unsigned char* hq = F.lds + F.wave * 4096;
        { const v4u hv[4] = {ph0, ph1, ph2, ph3}; v4u o[2];
#pragma unroll
          for (int j = 0; j < 4; ++j) { int w0 = 0, w1 = 0;
              w0 = __builtin_amdgcn_cvt_pk_fp8_f32(bflo(hv[j].x), bfhi(hv[j].x), w0, false); w0 = __builtin_amdgcn_cvt_pk_fp8_f32(bflo(hv[j].y), bfhi(hv[j].y), w0, true);
              w1 = __builtin_amdgcn_cvt_pk_fp8_f32(bflo(hv[j].z), bfhi(hv[j].z), w1, false); w1 = __builtin_amdgcn_cvt_pk_fp8_f32(bflo(hv[j].w), bfhi(hv[j].w), w1, true);
              o[j >> 1][2 * (j & 1)] = (unsigned)w0; o[j >> 1][2 * (j & 1) + 1] = (unsigned)w1; }
          *(LAS v4u*)(hq + lane * 32) = o[0]; *(LAS v4u*)(hq + lane * 32 + 16) = o[1];
          unsigned z_ = 0u; asm volatile("" : "+v"(z_));
          if (lane < 2) *(LAS v4u*)(hq + 2048 + lane * 16) = (v4u){z_, z_, z_, z_}; }
        const int li = lane & 15, kb = lane >> 4;
        int rowoff[8];
#pragma unroll
        for (int g = 0; g < 8; ++g) rowoff[g] = bpermi(16 * (g & 3) + li, eidx[g >> 2]) * (DM / 2) + 16 * kb;
        f32x4 dacc[8];
#pragma unroll
        for (int g = 0; g < 8; ++g) dacc[g] = (f32x4){0.f, 0.f, 0.f, 0.f};
        const unsigned hb = (li == 0) ? (unsigned)(16 * kb) : 2048u;
        const unsigned hb2 = (li == 0) ? 64u : 16u;
        const unsigned hstep = (li == 0) ? 128u : 0u;
        v4u ua[8], ub[8];
#pragma unroll
        for (int g = 0; g < 8; ++g) ua[g] = *(const GAS v4u*)(P.PU + (unsigned)rowoff[g]);
#pragma unroll 1
        for (int s = 0; s < ((P.dry & 4) ? 2 : 16); s += 2) {
#pragma unroll
            for (int g = 0; g < 8; ++g) ub[g] = *(const GAS v4u*)(P.PU + (unsigned)(rowoff[g] + 64 * (s + 1)));
            { const v4u b0 = *(const LAS v4u*)(hq + hb + hstep * s), b1 = *(const LAS v4u*)(hq + hb + hstep * s + hb2);
              const v8i bf = {(int)b0.x, (int)b0.y, (int)b0.z, (int)b0.w, (int)b1.x, (int)b1.y, (int)b1.z, (int)b1.w};
#pragma unroll
              for (int g = 0; g < 8; ++g) { const v8i af = {(int)ua[g].x, (int)ua[g].y, (int)ua[g].z, (int)ua[g].w, 0, 0, 0, 0};
                  dacc[g] = __builtin_amdgcn_mfma_scale_f32_16x16x128_f8f6f4(af, bf, dacc[g], 4, 0, 0, 0x7f7f7f7f, 0, 0x7f7f7f7f); } }
            if (s + 2 < 16) {
#pragma unroll
                for (int g = 0; g < 8; ++g) ua[g] = *(const GAS v4u*)(P.PU + (unsigned)(rowoff[g] + 64 * (s + 2))); }
            { const v4u b0 = *(const LAS v4u*)(hq + hb + hstep * (s + 1)), b1 = *(const LAS v4u*)(hq + hb + hstep * (s + 1) + hb2);
              const v8i bf = {(int)b0.x, (int)b0.y, (int)b0.z, (int)b0.w, (int)b1.x, (int)b1.y, (int)b1.z, (int)b1.w};
#pragma unroll
              for (int g = 0; g < 8; ++g) { const v8i af = {(int)ub[g].x, (int)ub[g].y, (int)ub[g].z, (int)ub[g].w, 0, 0, 0, 0};
                  dacc[g] = __builtin_amdgcn_mfma_scale_f32_16x16x128_f8f6f4(af, bf, dacc[g], 4, 0, 0, 0x7f7f7f7f, 0, 0x7f7f7f7f); } }
        }
        float coef[2];
#pragma unroll
        for (int sl = 0; sl < 2; ++sl) { float mydot = 0.f;
#pragma unroll
            for (int g4 = 0; g4 < 4; ++g4)
#pragma unroll
                for (int r = 0; r < 4; ++r) { const float t = bpermf(16 * ((lane >> 2) & 3), dacc[4 * sl + g4][r]); if ((lane >> 4) == g4 && (lane & 3) == r) mydot = t; }
            mydot *= P.SU[eidx[sl]];
            if (DBG_PROBE == 4) {
                float ref = 0.f;
                for (int e = 0; e < 64; ++e) { const int ex = __builtin_amdgcn_readlane(eidx[sl], e); const v4u uu = *(const GAS v4u*)(P.PU + (size_t)ex * (DM / 2) + lane * 16); float s1 = 0.f;
                    const v4u hv2[4] = {*(const GAS v4u*)(P.H + (size_t)m * DM + lane * 32), *(const GAS v4u*)(P.H + (size_t)m * DM + lane * 32 + 8), *(const GAS v4u*)(P.H + (size_t)m * DM + lane * 32 + 16), *(const GAS v4u*)(P.H + (size_t)m * DM + lane * 32 + 24)};
#pragma unroll
                    for (int d = 0; d < 4; ++d) { const unsigned w = uu[d]; const unsigned hw[4] = {hv2[d].x, hv2[d].y, hv2[d].z, hv2[d].w};
                        f32x2 x = __builtin_amdgcn_cvt_scalef32_pk_f32_fp4(w, 1.0f, 0); s1 += x.x * bflo(hw[0]) + x.y * bfhi(hw[0]); x = __builtin_amdgcn_cvt_scalef32_pk_f32_fp4(w, 1.0f, 1); s1 += x.x * bflo(hw[1]) + x.y * bfhi(hw[1]);
                        x = __builtin_amdgcn_cvt_scalef32_pk_f32_fp4(w, 1.0f, 2); s1 += x.x * bflo(hw[2]) + x.y * bfhi(hw[2]); x = __builtin_amdgcn_cvt_scalef32_pk_f32_fp4(w, 1.0f, 3); s1 += x.x * bflo(hw[3]) + x.y * bfhi(hw[3]); }
                    const float tot = wave_sum_u(s1) * P.SU[ex]; if (lane == e) ref = tot; }
                pr_s2 = fmaxf(pr_s2, wave_max_u(fabsf(mydot - ref) / (fabsf(ref) + 0.25f))); pr_n = 1.f; }
            coef[sl] = egate[sl] * 0.5f * mydot * (1.0f + erff(mydot * 0.70710678f));
            if ((DBG_SKIP & 16) && sl == 0) coef[sl] = 0.f;
            if ((DBG_SKIP & 32) && sl == 1) coef[sl] = 0.f;
        }
        const float coefs[2] = {coef[0] * P.SV[eidx[0]], coef[1] * P.SV[eidx[1]]};
        f32x2 acc2[16];
#pragma unroll
        for (int i = 0; i < 16; ++i) acc2[i] = (f32x2){0.f, 0.f};
#define PEER_LOADV(U, C, e0_) do { const int e1_ = (e0_); const int ev_ = (e1_ & 64) ? eidx[1] : eidx[0]; const int cv_ = __builtin_bit_cast(int, (e1_ & 64) ? coefs[1] : coefs[0]); \
            _Pragma("unroll") for (int q = 0; q < 8; ++q) { const int ex = __builtin_amdgcn_readlane(ev_, (e1_ & 63) + q); U[q] = *(const GAS v4u*)(P.PV + (size_t)ex * (DM / 2) + lane * 16); \
            C[q] = __builtin_bit_cast(float, __builtin_amdgcn_readlane(cv_, (e1_ & 63) + q)); } } while (0)
#define PEER_AXPY(U, C) do { if (P.dry & 32) { _Pragma("unroll") for (int q = 0; q < 8; ++q) _Pragma("unroll") for (int d = 0; d < 4; ++d) acc2[d].x += __builtin_bit_cast(float, U[q][d] & 0x3fffffffu) * C[q]; } else \
            _Pragma("unroll") for (int q = 0; q < 8; ++q) _Pragma("unroll") for (int d = 0; d < 4; ++d) { const unsigned w = U[q][d]; \
            acc2[4 * d + 0] = __builtin_amdgcn_cvt_scalef32_pk_f32_fp4(w, 1.0f, 0) * C[q] + acc2[4 * d + 0]; acc2[4 * d + 1] = __builtin_amdgcn_cvt_scalef32_pk_f32_fp4(w, 1.0f, 1) * C[q] + acc2[4 * d + 1]; \
            acc2[4 * d + 2] = __builtin_amdgcn_cvt_scalef32_pk_f32_fp4(w, 1.0f, 2) * C[q] + acc2[4 * d + 2]; acc2[4 * d + 3] = __builtin_amdgcn_cvt_scalef32_pk_f32_fp4(w, 1.0f, 3) * C[q] + acc2[4 * d + 3]; } } while (0)
        if (mn < MALL) { pe0 = P.ESEL[(size_t)mn * 128 + lane]; pe1 = P.ESEL[(size_t)mn * 128 + 64 + lane]; pg0 = P.EGATE[(size_t)mn * 128 + lane]; pg1 = P.EGATE[(size_t)mn * 128 + 64 + lane];
            const bf16* hp = P.H + (size_t)mn * DM + lane * 32; ph0 = *(const GAS v4u*)hp; ph1 = *(const GAS v4u*)(hp + 8); ph2 = *(const GAS v4u*)(hp + 16); ph3 = *(const GAS v4u*)(hp + 24); }
        f32x4 xpre[8];
        { const float* xr0 = P.X + (size_t)m * DM + lane * 32;
#pragma unroll
          for (int hq = 0; hq < 8; ++hq) xpre[hq] = *(const GAS f32x4*)(xr0 + hq * 4); }
        {
            v4u ua[8], ub[8]; float ca[8], cb[8];
            PEER_LOADV(ua, ca, 0);
#pragma unroll 1
            for (int it = 0; it < ((P.dry & 8) ? 2 : 8); ++it) {
                PEER_LOADV(ub, cb, 16 * it + 8); PEER_AXPY(ua, ca);
                if (it < 7) PEER_LOADV(ua, ca, 16 * it + 16);
                PEER_AXPY(ub, cb);
            }
        }
#undef PEER_LOADV
#undef PEER_AXPY
        float acc[32];
#pragma unroll
        for (int i = 0; i < 16; ++i) { acc[2 * i] = acc2[i].x; acc[2 * i + 1] = acc2[i].y; }
        if (P.dry) { float sm_ = 0.f;
#pragma unroll
            for (int i = 0; i < 32; ++i) sm_ += acc[i];
            if (sm_ == 1.2345e-30f) P.X[lane] = sm_;
            if (!(P.dry & 16)) continue; }
        if (DBG_SKIP & 1) {
#pragma unroll
            for (int i = 0; i < 32; ++i) acc[i] = 0.f; }
        if (((DBG_SKIP & 64) && !P.last) || ((DBG_SKIP & 128) && P.last)) {
#pragma unroll
            for (int i = 0; i < 32; ++i) acc[i] = 0.f; }
        if (DBG_SKIP & 8) {
#pragma unroll
            for (int i = 0; i < 32; ++i) acc[i] = -acc[i]; }
        int m_l = m, lane_l = lane; asm volatile("" : "+v"(m_l), "+v"(lane_l));
        const int b_l = m_l / TPB, tp_l = m_l - b_l * TPB, mr_l = tp_l < CTXL ? 2 : b_l;
        float* xr = P.X + (size_t)m_l * DM + lane_l * 32; const float* g2 = P.mod + (size_t)mr_l * 12288 + 5 * DM + lane_l * 32;
        float ss = 0.f;
#pragma unroll
        for (int hq = 0; hq < 8; ++hq) { const int c = hq * 4;
            f32x4 xv = xpre[hq]; const f32x4 gv = *(const GAS f32x4*)(g2 + c);
#pragma unroll
            for (int e = 0; e < 4; ++e) { xv[e] += gv[e] * acc[4 * hq + e]; ss += xv[e] * xv[e]; acc[4 * hq + e] = xv[e]; }
            if (!P.last) *(GAS f32x4*)((P.dry ? (float*)(F.ws + 760 * MiB) + (size_t)m_l * DM + lane_l * 32 : xr) + c) = xv; }
        if (!P.last) {
            const float rs = rsqrtf(wave_sum(ss) * (1.f / DM) + NORM_EPS); const float* sh = P.nmod + (size_t)mr_l * 12288 + lane_l * 32; const float* sc = sh + DM; const float* ngp = P.ng + lane_l * 32;
            bf16* ho = (P.dry ? (bf16*)(F.ws + 892 * MiB) : P.Hout) + (size_t)m_l * DM + lane_l * 32;
#pragma unroll
            for (int hq = 0; hq < 4; ++hq) { const int c = hq * 8; float y[8];
                const f32x4 n0 = *(const GAS f32x4*)(ngp + c), n1 = *(const GAS f32x4*)(ngp + c + 4), s0 = *(const GAS f32x4*)(sc + c), s1 = *(const GAS f32x4*)(sc + c + 4), h0 = *(const GAS f32x4*)(sh + c), h1 = *(const GAS f32x4*)(sh + c + 4);
#pragma unroll
                for (int e = 0; e < 4; ++e) { y[e] = acc[8 * hq + e] * rs * n0[e] * (1.0f + s0[e]) + h0[e]; y[4 + e] = acc[8 * hq + 4 + e] * rs * n1[e] * (1.0f + s1[e]) + h1[e]; }
                *(GAS v4u*)(ho + c) = pack8f(y); } }
        if (P.last) { const float rs = rsqrtf(wave_sum(ss) * (1.f / DM) + NORM_EPS); float* orow = P.out + ((size_t)b_l * SEQ + (tp_l - CTXL)) * DM + lane_l * 32; const float* fgp = P.fin_g + lane_l * 32;
#pragma unroll
            for (int hq = 0; hq < 8; ++hq) { const int c = hq * 4; const f32x4 fg = *(const GAS f32x4*)(fgp + c);
                f32x4 o;
#pragma unroll
                for (int e = 0; e < 4; ++e) o[e] = acc[4 * hq + e] * rs * fg[e];
                *(GAS f32x4*)(orow + c) = o; } }
    }
    if (DBG_PROBE && DBG_PROBE != 5 && !P.last && lane == 0) { float* pp = (float*)(F.ws + WS_CTL + CTL_PROBE_OFF) + gw * 4; pp[0] = pr_s2; pp[1] = pr_d2; pp[2] = pr_tg; pp[3] = pr_n; }
}


constexpr int PH_PER_LAYER = 12, NPHASE = 1 + NLAYER * PH_PER_LAYER;
#ifndef ONLY_PHASE
#define ONLY_PHASE -1
#endif
#define T0() (wave_s == 0 && pg8::opaque_lane() == 0)
#define PH_ON(k) (ONLY_PHASE < 0 || ONLY_PHASE == (k))
#define GEMM_CALL(EPI, SCHED, g, S, E) pg8::gemm_phase<EPI, SCHED, true, true>(F.lds, g, S, E, wave_s)
#define GEMM_CALL_NA(EPI, SCHED, g, S, E) pg8::gemm_phase<EPI, SCHED, false, true>(F.lds, g, S, E, wave_s)

__device__ __forceinline__ const float* karg(int i) {
    asm volatile("" : "+s"(i));
    const __attribute__((address_space(4))) unsigned long long* ka = (const __attribute__((address_space(4))) unsigned long long*)__builtin_amdgcn_kernarg_segment_ptr();
    return (const float*)ka[i];
}
__global__ void __launch_bounds__(NWAVES * 64, 2) mk_fwd(Args args) {
    extern __shared__ __attribute__((aligned(16))) unsigned char lds[];
    Frame F;
    F.lds = (LAS unsigned char*)lds; F.ws = args.ws;
    const int wave_s = __builtin_amdgcn_readfirstlane((int)threadIdx.x >> 6);
    F.tid = threadIdx.x; F.lane = F.tid & 63; F.wave = wave_s;
    F.G = gridDim.x; { const int bx = blockIdx.x; F.vcu = (F.G % 8 == 0) ? (bx % 8) * (F.G / 8) + bx / 8 : bx; }
    unsigned char* ws = args.ws;
    volatile LAS unsigned* MISC = (volatile LAS unsigned*)(F.lds + MISC_OFF);
    for (int u = F.tid; u < (LDS_BYTES - LDSCTL_OFF) / 4; u += NWAVES * 64) ((LAS unsigned*)(F.lds + LDSCTL_OFF))[u] = 0u;
    __syncthreads();
    const int lo = args.ph_lo, hi = args.ph_hi;
    XcdBarrier bar; bar.bar = (unsigned*)(ws + WS_CTL) + CW_BAR; bar.x = 0; bar.st = nullptr;
    if (hi - lo > 1) bar = xcd_barrier_post((unsigned*)(ws + WS_CTL) + CW_BAR, MISC + 8, T0());
#define IN(k) (lo <= (k) && (k) < hi)
#define REFRAME() do { const int lz_ = pg8::opaque_lane(); F.lane = lz_; F.tid = wave_s * 64 + lz_; F.wave = wave_s; ws = (unsigned char*)karg(34); F.ws = ws; { int g_ = (int)gridDim.x, b_ = (int)blockIdx.x; asm volatile("" : "+s"(g_), "+s"(b_)); bx = b_; F.G = g_; F.vcu = ((g_ & 7) == 0) ? (b_ & 7) * (g_ >> 3) + (b_ >> 3) : b_; } } while (0)
#define SEAM(k) do { if (IN((k) + 1)) xcd_barrier(bar, T0()); } while (0)
#define XBUF ((float*)(ws + WS_X))
#define HBUF ((bf16*)(ws + WS_H))
#define MODP ((const float*)(ws + WS_CTL + CTL_MOD_OFF) + (size_t)l * 3 * 12288)
    int bx = (int)blockIdx.x;

    for (int rep_ = 0; rep_ < ((DBG_REPEAT == 100) ? 2 : 1); ++rep_) if (PH_ON(100) && IN(0)) { REFRAME(); if (rep_) xcd_barrier(bar, T0()); p0_prologue(F, 0, (MK_N_LAUNCHES == 1) ? 1 : NLAYER, F.vcu, F.G); SEAM(0); if (DBG_REPEAT == 200) { for (int i_ = 0; i_ < 32; ++i_) xcd_barrier(bar, T0()); } }

    for (int l = 0; l < NLAYER; ++l) {
        const int base = 1 + l * PH_PER_LAYER;
        const int last = (l == NLAYER - 1);
        for (int rep_ = 0; rep_ < ((DBG_REPEAT == 0) ? 2 : 1); ++rep_) if (PH_ON(0) && IN(base + 0) && l == 0) { REFRAME(); if (rep_) xcd_barrier(bar, T0()); modnorm_phase(F, XBUF, karg(6) + (size_t)l * DM, MODP, 0, HBUF, 0, l == 0 ? karg(0) : nullptr, l == 0 ? karg(2) : nullptr); SEAM(base + 0); }
        for (int rep_ = 0; rep_ < ((DBG_REPEAT == 1) ? 2 : 1); ++rep_) if (PH_ON(1) && IN(base + 1)) { REFRAME(); if (rep_) xcd_barrier(bar, T0());
            pg8::Gemm g{HBUF, (const bf16*)(ws + WS_WINA) + (size_t)l * INA_P * DM, MALL, INA_P, DM}; pg8::RowOrder S; S.init_rows(0, INA_P, F.G, bx);
            pg8::EpiStoreBf16 E{(bf16*)(ws + WS_PA), INA_P};
            GEMM_CALL(pg8::EpiStoreBf16, pg8::RowOrder, g, S, E);
            SEAM(base + 1); }
        for (int rep_ = 0; rep_ < ((DBG_REPEAT == 2) ? 2 : 1); ++rep_) if (PH_ON(2) && IN(base + 2)) { REFRAME(); if (rep_) xcd_barrier(bar, T0());
            FeatP P;
            P.PA = (const bf16*)(ws + WS_PA); P.mu = karg(9) + (size_t)l * RWC; P.w0 = karg(10) + (size_t)l * 2 * RW; P.a0 = karg(12) + (size_t)l * 2 * RW;
            P.k_k = karg(15) + (size_t)l * RW; P.k_a = karg(16) + (size_t)l * RW; P.r_k = karg(17) + (size_t)l * RW;
            P.WUP = (const bf16*)(ws + WS_WUP) + (size_t)l * 2 * RW * 64; P.AUP = (const bf16*)(ws + WS_AUP) + (size_t)l * 2 * RW * 64; P.GUP = (const bf16*)(ws + WS_GUP) + (size_t)l * 2 * RW * 32;
            P.qnorm = karg(20) + (size_t)l * 512; P.kvnorm = karg(22) + (size_t)l * 256; P.rope = (const f32x2*)(ws + WS_ROPE);
            P.RI = (bf16*)(ws + WS_RI); P.GG = (bf16*)(ws + WS_GG); P.BON = (float*)(ws + WS_BON); P.QN = (bf16*)(ws + WS_QN); P.KVN = (bf16*)(ws + WS_KVN); P.K = (bf16*)(ws + WS_K);
            features_phase(F, P);
            SEAM(base + 2); }
        for (int rep_ = 0; rep_ < ((DBG_REPEAT == 3) ? 2 : 1); ++rep_) if (PH_ON(3) && IN(base + 3)) { REFRAME(); if (rep_) xcd_barrier(bar, T0());
            { pg8::Gemm g{(const bf16*)(ws + WS_QN), (const bf16*)(ws + WS_WUQ) + (size_t)l * NQ * 512, MALL, NQ, 512};
              pg8::EpiQ E{(bf16*)(ws + WS_Q), (const f32x2*)(ws + WS_ROPE), 0.14724444f};
              pg8::RowOrder S; S.init_rows(last, NQ, F.G, bx); GEMM_CALL_NA(pg8::EpiQ, pg8::RowOrder, g, S, E); }
            { pg8::Gemm g{(const bf16*)(ws + WS_KVN), (const bf16*)(ws + WS_WUKV) + (size_t)l * NKV * 256, MALL, NKV, 256}; pg8::RowOrder S; S.init_rows(0, NKV, F.G, bx);
              pg8::EpiKV E{(bf16*)(ws + WS_K), (bf16*)(ws + WS_V)};
              GEMM_CALL_NA(pg8::EpiKV, pg8::RowOrder, g, S, E); }
            SEAM(base + 3); }
        for (int rep_ = 0; rep_ < ((DBG_REPEAT == 4) ? 2 : 1); ++rep_) if (PH_ON(4) && IN(base + 4)) { REFRAME(); if (rep_) xcd_barrier(bar, T0());
            ScanCvt C; C.pu = karg(30) + (size_t)l * NEXP * DM; C.pv = karg(31) + (size_t)l * NEXP * DM; C.PU8 = ws + WS_P4; C.PV8 = ws + WS_P4 + (size_t)NEXP * (DM / 2); C.SU = (float*)(ws + WS_P4S); C.SV = (float*)(ws + WS_P4S) + NEXP;
            scan_phase(F, (const bf16*)(ws + WS_RI), (bf16*)(ws + WS_Y), C); SEAM(base + 4); }
        for (int rep_ = 0; rep_ < ((DBG_REPEAT == 5) ? 2 : 1); ++rep_) if (PH_ON(5) && IN(base + 5)) { REFRAME(); if (rep_) xcd_barrier(bar, T0());
            attn_phase(F, (const bf16*)(ws + WS_Q), (const bf16*)(ws + WS_K), (const bf16*)(ws + WS_V), (bf16*)(ws + WS_YB), !last);
            readout_phase(F, (const bf16*)(ws + WS_Y), (const bf16*)(ws + WS_GG), (const float*)(ws + WS_BON), (const bf16*)(ws + WS_RI), karg(18) + (size_t)l * RW, karg(19) + (size_t)l * RW, (bf16*)(ws + WS_YA));
            SEAM(base + 5); }
        for (int rep_ = 0; rep_ < ((DBG_REPEAT == 6) ? 2 : 1); ++rep_) if (PH_ON(6) && IN(base + 6)) { REFRAME(); if (rep_) xcd_barrier(bar, T0());
            bf16* T1 = (bf16*)(ws + WS_T1); bf16* T2 = (bf16*)(ws + WS_T2);
            const pg8::Gemm g1{HBUF, (const bf16*)(ws + WS_WGA) + (size_t)l * DM * DM, MALL, DM, DM}, g2{(const bf16*)(ws + WS_YA), (const bf16*)(ws + WS_WA) + (size_t)l * DM * RW, MALL, DM, RW};
            const pg8::Gemm g3{HBUF, (const bf16*)(ws + WS_WGB) + (size_t)l * DM * DM, MALL, DM, DM}, g4{(const bf16*)(ws + WS_YB), (const bf16*)(ws + WS_WB) + (size_t)l * DM * RW, MALL, DM, RW};
            const pg8::EpiGate E1{T1, DM, karg(8) + (size_t)l * 2 * DM}, E3{T2, DM, karg(8) + (size_t)l * 2 * DM + DM};
            const pg8::EpiMulAdd E2{T1, T1, nullptr, DM}, E4{T1, T2, T1, DM};
            pg8::RowOrder S; S.init_rows(last, DM, F.G, bx);
            GEMM_CALL(pg8::EpiGate, pg8::RowOrder, g1, S, E1); GEMM_CALL(pg8::EpiMulAdd, pg8::RowOrder, g2, S, E2); GEMM_CALL(pg8::EpiGate, pg8::RowOrder, g3, S, E3); GEMM_CALL(pg8::EpiMulAdd, pg8::RowOrder, g4, S, E4);
            if (MK_N_LAUNCHES == 1 && l == 0 && rep_ == 0) { __syncthreads();
                const int late = (F.G > 32) ? 16 : 0; p0_prologue(F, 1, NLAYER, (bx >= late) ? bx - late : -1, F.G - late); }
            SEAM(base + 6); }
        for (int rep_ = 0; rep_ < ((DBG_REPEAT == 7) ? 2 : 1); ++rep_) if (PH_ON(7) && IN(base + 7)) { REFRAME(); if (rep_) xcd_barrier(bar, T0());
            const pg8::Gemm g{(const bf16*)(ws + WS_T1), (const bf16*)(ws + WS_WO) + (size_t)l * DM * DM, MALL, DM, DM};
            const pg8::EpiResid E{XBUF, MODP + 2 * DM, l == 0 ? karg(0) : nullptr, l == 0 ? karg(2) : nullptr};
            pg8::RowOrder S; S.init_rows(last, DM, F.G, bx); GEMM_CALL(pg8::EpiResid, pg8::RowOrder, g, S, E);
            SEAM(base + 7); }
        for (int rep_ = 0; rep_ < ((DBG_REPEAT == 8) ? 2 : 1); ++rep_) if (PH_ON(8) && IN(base + 8)) { REFRAME(); if (rep_) xcd_barrier(bar, T0());
            modnorm_phase(F, XBUF, karg(27) + (size_t)l * DM, MODP, 3, HBUF, last);
            SEAM(base + 8); }
        for (int rep_ = 0; rep_ < ((DBG_REPEAT == 9) ? 2 : 1); ++rep_) if (PH_ON(9) && IN(base + 9)) { REFRAME(); if (rep_) xcd_barrier(bar, T0());
            const pg8::Gemm g{HBUF, (const bf16*)(ws + WS_WQK) + (size_t)l * DM * DM, MALL, DM, DM};
            const pg8::EpiF32 E{(float*)(ws + WS_SC), DM};
            pg8::RowOrder S; S.init_rows(last, DM, F.G, bx); GEMM_CALL(pg8::EpiF32, pg8::RowOrder, g, S, E);
            SEAM(base + 9); }
        for (int rep_ = 0; rep_ < ((DBG_REPEAT == 10) ? 2 : 1); ++rep_) if (PH_ON(10) && IN(base + 10)) { REFRAME(); if (rep_) xcd_barrier(bar, T0());
            SelP P; P.SC = (const float*)(ws + WS_SC); P.ESEL = (int*)(ws + WS_T1); P.EGATE = (float*)(ws + WS_T1 + 16 * MiB);
            P.last = last;
            select_phase(F, P);
            SEAM(base + 10); }
        for (int rep_ = 0; rep_ < ((DBG_REPEAT == 11) ? 2 : 1); ++rep_) if (PH_ON(11) && IN(base + 11)) { REFRAME(); if (rep_) xcd_barrier(bar, T0());
            PeerP P; P.nmod = MODP + 3 * 12288; P.ng = karg(6) + (size_t)(l + 1) * DM; P.Hout = HBUF; P.ESEL = (const int*)(ws + WS_T1); P.EGATE = (const float*)(ws + WS_T1 + 16 * MiB); P.H = HBUF; P.PU = ws + WS_P4; P.PV = ws + WS_P4 + (size_t)NEXP * (DM / 2); P.SU = (const float*)(ws + WS_P4S); P.SV = (const float*)(ws + WS_P4S) + NEXP; P.X = XBUF; P.mod = MODP; P.fin_g = karg(32); P.out = (float*)karg(33); P.last = last; P.dry = (DBG_REPEAT == 11 && rep_ == 0) ? DBG_DRY : 0;
            peer_phase(F, P);
            SEAM(base + 11); }
    }
#undef IN
#undef SEAM
#undef XBUF
#undef HBUF
#undef MODP
}

__device__ __forceinline__ float mx_a_val(int i, int k) { const int c = (i * 131 + k * 17 + (k >> 3) * 5) & 15; const float mag[8] = {0.f, .5f, 1.f, 1.5f, 2.f, 3.f, 4.f, 6.f}; return (c & 8) ? -mag[c & 7] : mag[c & 7]; }
__device__ __forceinline__ int mx_a_code(int i, int k) { return (i * 131 + k * 17 + (k >> 3) * 5) & 15; }
__device__ __forceinline__ float mx_b_val(int k, int j) { return (float)(((k * 7 + j * 13 + (k >> 4)) % 9) - 4); }
__device__ __forceinline__ int mx_kmap(int hyp, int kb, int e) { const int h = hyp % 3; return h == 0 ? 32 * kb + e : h == 1 ? 32 * (e >> 3) + 8 * kb + (e & 7) : 64 * (e >> 4) + 16 * kb + (e & 15); }
__global__ void __launch_bounds__(512) dbg_fill(const float* pp, float* o) {
    __shared__ float vsh;
    float v = 0.f;
    if (DBG_PROBE == 5) {
        if (threadIdx.x < 64) { typedef int v8i __attribute__((ext_vector_type(8))); typedef float f4 __attribute__((ext_vector_type(4)));
            const int lane = threadIdx.x, i = lane & 15, kb = lane >> 4; float code = 0.f;
            for (int hyp = 0; hyp < 18; ++hyp) { const int nibswap = hyp / 9, ha = hyp % 3, hb2 = (hyp / 3) % 3;
                unsigned aw[4] = {0u, 0u, 0u, 0u}; int bw[8] = {0, 0, 0, 0, 0, 0, 0, 0};
                for (int e = 0; e < 32; ++e) { const int k = mx_kmap(ha, kb, e); const unsigned c = (unsigned)mx_a_code(i, k); const int pos = nibswap ? (e ^ 1) : e; aw[pos >> 3] |= c << (4 * (pos & 7)); }
                for (int q = 0; q < 8; ++q) { int w = 0; const float f0 = mx_b_val(mx_kmap(hb2, kb, 4 * q + 0), i), f1 = mx_b_val(mx_kmap(hb2, kb, 4 * q + 1), i), f2 = mx_b_val(mx_kmap(hb2, kb, 4 * q + 2), i), f3 = mx_b_val(mx_kmap(hb2, kb, 4 * q + 3), i);
                    w = __builtin_amdgcn_cvt_pk_fp8_f32(f0, f1, w, false); w = __builtin_amdgcn_cvt_pk_fp8_f32(f2, f3, w, true); bw[q] = w; }
                const v8i af = {(int)aw[0], (int)aw[1], (int)aw[2], (int)aw[3], 0, 0, 0, 0}, bf = {bw[0], bw[1], bw[2], bw[3], bw[4], bw[5], bw[6], bw[7]};
                f4 d = {0.f, 0.f, 0.f, 0.f};
                d = __builtin_amdgcn_mfma_scale_f32_16x16x128_f8f6f4(af, bf, d, 4, 0, 0, 0x7f7f7f7f, 0, 0x7f7f7f7f);
                int bad = 0;
                for (int r = 0; r < 4; ++r) { const int row = 4 * kb + r, col = i; float ex = 0.f; for (int k = 0; k < 128; ++k) ex += mx_a_val(row, k) * mx_b_val(k, col); bad += (d[r] != ex); }
                if (__ballot(bad != 0) == 0ull && code == 0.f) code = (float)(hyp + 1); }
            for (int t = 0; t < 2; ++t) {
                int aw[8] = {0, 0, 0, 0, 0, 0, 0, 0}, bw[8] = {0, 0, 0, 0, 0, 0, 0, 0};
                if (t == 0) { for (int e = 0; e < 32; ++e) { const int k = 32 * kb + e; aw[e >> 3] |= mx_a_code(i, k) << (4 * (e & 7)); bw[e >> 3] |= mx_a_code(i + 16, k) << (4 * (e & 7)); } }
                else { for (int q = 0; q < 8; ++q) { int w = 0, w2 = 0; const int k = 32 * kb + 4 * q;
                        w = __builtin_amdgcn_cvt_pk_fp8_f32(mx_b_val(k, i + 16), mx_b_val(k + 1, i + 16), w, false); w = __builtin_amdgcn_cvt_pk_fp8_f32(mx_b_val(k + 2, i + 16), mx_b_val(k + 3, i + 16), w, true); aw[q] = w;
                        w2 = __builtin_amdgcn_cvt_pk_fp8_f32(mx_b_val(k, i), mx_b_val(k + 1, i), w2, false); w2 = __builtin_amdgcn_cvt_pk_fp8_f32(mx_b_val(k + 2, i), mx_b_val(k + 3, i), w2, true); bw[q] = w2; } }
                const v8i af = {aw[0], aw[1], aw[2], aw[3], aw[4], aw[5], aw[6], aw[7]}, bf = {bw[0], bw[1], bw[2], bw[3], bw[4], bw[5], bw[6], bw[7]};
                f4 d = {0.f, 0.f, 0.f, 0.f};
                if (t == 0) d = __builtin_amdgcn_mfma_scale_f32_16x16x128_f8f6f4(af, bf, d, 4, 4, 0, 0x7f7f7f7f, 0, 0x7f7f7f7f); else d = __builtin_amdgcn_mfma_scale_f32_16x16x128_f8f6f4(af, bf, d, 0, 0, 0, 0x7f7f7f7f, 0, 0x7f7f7f7f);
                int bad = 0;
                for (int r = 0; r < 4; ++r) { const int row = 4 * kb + r, col = i; float ex = 0.f;
                    for (int k = 0; k < 128; ++k) ex += (t == 0) ? mx_a_val(row, k) * mx_a_val(col + 16, k) : mx_b_val(k, row + 16) * mx_b_val(k, col);
                    bad += (d[r] != ex); }
                if (__ballot(bad != 0) == 0ull) code += (t == 0) ? 10.f : 20.f; }
            if (lane == 0) vsh = code; }
        __syncthreads(); v = vsh;
    } else {
        float s0 = 0.f, s1 = 0.f, s2 = 0.f, s3 = 0.f;
        for (int i = 0; i < 2048; ++i) { s0 += pp[4 * i]; s1 += pp[4 * i + 1]; s2 += pp[4 * i + 2]; s3 += pp[4 * i + 3]; }
        if (DBG_PROBE == 4) { float mx = 0.f; for (int i = 0; i < 2048; ++i) mx = fmaxf(mx, pp[4 * i]); v = 100.f * mx; }
        else { v = (DBG_PROBE == 1 ? s0 : DBG_PROBE == 2 ? s1 : s2) / s3 * 1e-3f; v = exp2f(rintf(log2f(v) * 4.f) * 0.25f); }
    }
    for (size_t i = (size_t)blockIdx.x * 512 + threadIdx.x; i < (size_t)NBATCH * SEQ * DM; i += (size_t)gridDim.x * 512) o[i] = v;
}
extern "C" void kernel_launch(void* const* d_in, const int* in_sizes, int n_in, void* d_out, int out_size, void* d_ws, size_t ws_size, hipStream_t stream) {
    static int grid = 0;
    if (grid == 0) {
        if (n_in != 33 || out_size != NBATCH * SEQ * DM || ws_size < WS_END2) { fprintf(stderr, "kernel_launch: unexpected shapes (n_in %d out %d ws %zu)\n", n_in, out_size, ws_size); grid = -1; return; }
        int dev = 0, cus = 0, per_cu = 0;
        if (hipGetDevice(&dev) != hipSuccess || hipDeviceGetAttribute(&cus, hipDeviceAttributeMultiprocessorCount, dev) != hipSuccess) { grid = -1; return; }
        if (hipFuncSetAttribute((const void*)mk_fwd, hipFuncAttributeMaxDynamicSharedMemorySize, LDS_BYTES) != hipSuccess) { fprintf(stderr, "kernel_launch: hipFuncSetAttribute failed\n"); grid = -1; return; }
        if (hipOccupancyMaxActiveBlocksPerMultiprocessor(&per_cu, (const void*)mk_fwd, NWAVES * 64, LDS_BYTES) != hipSuccess || per_cu < 1) { fprintf(stderr, "kernel_launch: occupancy query says %d\n", per_cu); (void)hipGetLastError(); grid = -1; return; }
        grid = cus;
    }
    if (grid < 0) return;
    if (hipMemsetAsync((char*)d_ws + WS_CTL, 0, CTL_ZERO_BYTES, stream) != hipSuccess) return;
    Args a{};
    for (int i = 0; i < 33; ++i) a.in[i] = (const float*)d_in[i];
    a.out = (float*)d_out; a.ws = (unsigned char*)d_ws;
#if MK_N_LAUNCHES == 1
    a.ph_lo = 0; a.ph_hi = NPHASE;
    hipLaunchKernelGGL(mk_fwd, dim3(grid), dim3(NWAVES * 64), LDS_BYTES, stream, a);
#else
    if (DBG_PROBE != 5) for (int p = 0; p < NPHASE; ++p) { a.ph_lo = p; a.ph_hi = p + 1; hipLaunchKernelGGL(mk_fwd, dim3(grid), dim3(NWAVES * 64), LDS_BYTES, stream, a); }
    if (DBG_PROBE) hipLaunchKernelGGL(dbg_fill, dim3(1024), dim3(512), 0, stream, (const float*)((char*)d_ws + WS_CTL + CTL_PROBE_OFF), (float*)d_out);
#endif
}
```

```cpp
#include <hip/hip_runtime.h>
#include <cstdio>
#include <cstdint>

#ifndef MK_N_LAUNCHES
#define MK_N_LAUNCHES 1
#endif

#ifndef DBG_SKIP
#define DBG_SKIP 0
#endif
#ifndef DBG_PROBE
#define DBG_PROBE 0
#endif
#ifndef DBG_DRY
#define DBG_DRY 1
#endif
#ifndef DBG_REPEAT
#define DBG_REPEAT -1
#endif
namespace pg8 {
#define PG8_LAS __attribute__((address_space(3)))
typedef unsigned short bf16_t;
typedef short bf16x8 __attribute__((ext_vector_type(8)));
typedef float f32x4 __attribute__((ext_vector_type(4)));
typedef unsigned u32x4 __attribute__((ext_vector_type(4)));
constexpr int BM = 256, BK = 64, HALF = 128, HTB = HALF * BK * 2  , STAGE_BYTES = 8 * HTB, NXCD = 8, WGM = 8;

__host__ __device__ __forceinline__ int lds_byte(int r, int c) { const int st = (r >> 4) * 2 + (c >> 5), rr = r & 15, cc = c & 31, ob = rr * 64 + cc * 2; return st * 1024 + (ob ^ (((ob >> 9) & 1) << 5)); }
__host__ __device__ __forceinline__ void stage_rc(int b, int& R, int& C) { const int st = b / 1024, sb = b % 1024, swz = sb ^ (((sb >> 9) & 1) << 5); R = (st >> 1) * 16 + swz / 64; C = (st & 1) * 32 + (swz % 64) / 2; }
__host__ __device__ __forceinline__ int perm32(int rho) { const int n = rho >> 4, i = rho & 15; return 8 * (i >> 2) + 4 * n + (i & 3); }

struct Unit { int pm, pn; };
struct Gemm { const bf16_t* A; const bf16_t* Bt; int M, N, K; };

struct StaticOrder {
    int nM, nN, nwg, G, c;
    __host__ __device__ void init(int M, int N, int G_, int c_) { nM = M / BM; nN = N / BM; nwg = nM * nN; G = G_; c = c_; }
    __host__ __device__ bool next(int i, Unit& u) const {
        const long L = (long)i * G + c; if (L >= nwg) return false;
        int wgid = (int)L; { const int q = nwg / NXCD, r = nwg % NXCD, xcd = wgid % NXCD, off = wgid / NXCD; wgid = (xcd < r ? xcd * (q + 1) : r * (q + 1) + (xcd - r) * q) + off; }
        const int nig = WGM * nN, gid = wgid / nig, fm = gid * WGM, gsz = (nM - fm) < WGM ? (nM - fm) : WGM;
        u.pm = fm + ((wgid % nig) % gsz); u.pn = (wgid % nig) / gsz; return true;
    }
    __device__ __forceinline__ void a_ready(const Unit&) const {}
    __device__ __forceinline__ void done(const Unit&) const {}
};
__device__ __forceinline__ int opaque_lane() { int l; asm volatile("v_mbcnt_lo_u32_b32 %0, -1, 0\n\tv_mbcnt_hi_u32_b32 %0, -1, %0" : "=v"(l)); return l; }
typedef __bf16 bf16x2c __attribute__((ext_vector_type(2)));
__device__ __forceinline__ unsigned cvt_pk_bf16(float lo, float hi) { const bf16x2c v = {(__bf16)lo, (__bf16)hi}; return __builtin_bit_cast(unsigned, v); }
template <class Epi, class Sched, bool ALIGN_EPI = false, bool SP2 = false>
__device__ __forceinline__ void gemm_phase(PG8_LAS unsigned char* lds, const Gemm g, const Sched& S, const Epi& E, const int wave_s) {
    const int lane_ = opaque_lane();
    const int wid = wave_s, lane = lane_, tid = wid * 64 + lane, wr = wid >> 2, wc = wid & 3, fr = lane & 15, fq = lane >> 4;
    const int K = g.K, nt = K / BK;
    unsigned voffA[2], voffB[2];
#pragma unroll
    for (int i = 0; i < 2; ++i) { int R, C; stage_rc(tid * 16 + i * 8192, R, C); const int Rb = Epi::PERM ? ((R & ~31) + perm32(R & 31)) : R;
        voffA[i] = (unsigned)(R * K + C) * 2u; voffB[i] = (unsigned)(Rb * K + C) * 2u; }
    const size_t kstep = (size_t)(BK * 2);
    const size_t hstep = (size_t)HALF * K * 2;
    const size_t tstep = 2 * hstep;
    const unsigned ldsw = (unsigned)wid * 1024u;
    const int aoff = lds_byte(wr * 64 + fr, fq * 8), boff = lds_byte(wc * 32 + fr, fq * 8);
#define PG8_SA(b, h) (((b) * 2 + (h)) * HTB)
#define PG8_SB(b, h) ((4 + (b) * 2 + (h)) * HTB)
#define PG8_STAGE(bufoff, gbase, voff) do { _Pragma("unroll") for (int _i = 0; _i < 2; ++_i) \
        __builtin_amdgcn_global_load_lds((const unsigned*)((const char*)(gbase) + (voff)[_i]), (PG8_LAS unsigned*)(lds + (bufoff) + ldsw + _i * 8192), 16, 0, 0); } while (0)
#define PG8_LDA(dst, b, h) do { _Pragma("unroll") for (int m = 0; m < 4; ++m) _Pragma("unroll") for (int k = 0; k < 2; ++k) dst[m][k] = *(const PG8_LAS bf16x8*)(lds + PG8_SA(b, h) + aoff + m * 2048 + k * 1024); } while (0)
#define PG8_LDB(dst, b, h) do { _Pragma("unroll") for (int n = 0; n < 2; ++n) _Pragma("unroll") for (int k = 0; k < 2; ++k) dst[n][k] = *(const PG8_LAS bf16x8*)(lds + PG8_SB(b, h) + boff + n * 2048 + k * 1024); } while (0)
#define PG8_MMA(ai, bj, At, Bt) do { __builtin_amdgcn_s_setprio(1); _Pragma("unroll") for (int m = 0; m < 4; ++m) _Pragma("unroll") for (int n = 0; n < 2; ++n) _Pragma("unroll") for (int k = 0; k < 2; ++k) \
        acc[ai][bj][m][n] = __builtin_amdgcn_mfma_f32_16x16x32_bf16(Bt[n][k], At[m][k], acc[ai][bj][m][n], 0, 0, 0); __builtin_amdgcn_s_setprio(0); } while (0)
#define PG8_WAIT_V(n) asm volatile("s_waitcnt vmcnt(" #n ")" ::: "memory")
#define PG8_WAIT_L(n) asm volatile("s_waitcnt lgkmcnt(" #n ")" ::: "memory")
#define PG8_BAR __builtin_amdgcn_s_barrier()
#define PG8_SCHED __builtin_amdgcn_sched_barrier(0)
    Unit cur, nxt; int ui = 0;
    if (!S.next(0, cur)) return;
    f32x4 acc[2][2][4][2];
#pragma unroll
    for (int a = 0; a < 2; ++a)
#pragma unroll
        for (int b = 0; b < 2; ++b)
#pragma unroll
            for (int m = 0; m < 4; ++m)
#pragma unroll
                for (int n = 0; n < 2; ++n) acc[a][b][m][n] = (f32x4){0.f, 0.f, 0.f, 0.f};
    bf16x8 At[4][2], B0[2][2], B1[2][2];
    const char* cA = (const char*)g.A + (size_t)cur.pm * tstep; const char* cB = (const char*)g.Bt + (size_t)cur.pn * tstep;
    S.a_ready(cur);
    if constexpr (SP2) {
        PG8_STAGE(PG8_SB(0, 0), cB, voffB); PG8_STAGE(PG8_SB(0, 1), cB + hstep, voffB); PG8_STAGE(PG8_SA(0, 0), cA, voffA); PG8_STAGE(PG8_SA(0, 1), cA + hstep, voffA);
        if (wr == 1) PG8_BAR;
        PG8_WAIT_V(2); PG8_BAR;
        PG8_STAGE(PG8_SB(1, 0), cB + kstep, voffB); PG8_STAGE(PG8_SA(1, 0), cA + kstep, voffA); PG8_STAGE(PG8_SB(1, 1), cB + hstep + kstep, voffB);
        PG8_WAIT_V(6); PG8_BAR;
    } else {
        PG8_STAGE(PG8_SB(0, 0), cB, voffB); PG8_STAGE(PG8_SA(0, 0), cA, voffA); PG8_STAGE(PG8_SB(0, 1), cB + hstep, voffB); PG8_STAGE(PG8_SA(0, 1), cA + hstep, voffA);
        if (wr == 1) PG8_BAR;
        PG8_WAIT_V(4); PG8_BAR;
        PG8_STAGE(PG8_SB(1, 0), cB + kstep, voffB); PG8_STAGE(PG8_SA(1, 0), cA + kstep, voffA); PG8_STAGE(PG8_SB(1, 1), cB + hstep + kstep, voffB);
        PG8_WAIT_V(6); PG8_BAR;
    }
    for (;;) {
        const bool has_next = S.next(ui + 1, nxt);
        const char* nA = has_next ? (const char*)g.A + (size_t)nxt.pm * tstep : cA; const char* nB = has_next ? (const char*)g.Bt + (size_t)nxt.pn * tstep : cB;
        for (int t = 0; t < nt; t += 2) {
            const bool last = (t == nt - 2);
            const char* a1 = cA + (size_t)(t + 1) * kstep;
            const char* a2 = last ? nA : cA + (size_t)(t + 2) * kstep; const char* b2 = last ? nB : cB + (size_t)(t + 2) * kstep;
            const char* a3 = a2 + kstep; const char* b3 = b2 + kstep;
            if (last && has_next) S.a_ready(nxt);
            if constexpr (SP2) {
            PG8_LDB(B0, 0, 0); PG8_LDB(B1, 0, 1); PG8_SCHED; PG8_LDA(At, 0, 0); PG8_STAGE(PG8_SA(1, 1), a1 + hstep, voffA);
            PG8_WAIT_V(8); PG8_WAIT_L(0); PG8_BAR; PG8_MMA(0, 0, At, B0); PG8_MMA(0, 1, At, B1); PG8_BAR; PG8_SCHED;
            PG8_LDA(At, 0, 1); PG8_STAGE(PG8_SB(0, 0), b2, voffB); PG8_STAGE(PG8_SB(0, 1), b2 + hstep, voffB); PG8_STAGE(PG8_SA(0, 0), a2, voffA);
            PG8_WAIT_V(8); PG8_WAIT_L(0); PG8_BAR; PG8_MMA(1, 0, At, B0); PG8_MMA(1, 1, At, B1); PG8_BAR; PG8_SCHED;
            PG8_LDB(B0, 1, 0); PG8_LDB(B1, 1, 1); PG8_SCHED; PG8_LDA(At, 1, 0); PG8_STAGE(PG8_SA(0, 1), a2 + hstep, voffA);
            PG8_WAIT_V(8); PG8_WAIT_L(0); PG8_BAR; PG8_MMA(0, 0, At, B0); PG8_MMA(0, 1, At, B1); PG8_BAR; PG8_SCHED;
            PG8_LDA(At, 1, 1); PG8_STAGE(PG8_SB(1, 0), b3, voffB); PG8_STAGE(PG8_SB(1, 1), b3 + hstep, voffB); PG8_STAGE(PG8_SA(1, 0), a3, voffA);
            PG8_WAIT_V(8); PG8_WAIT_L(0); PG8_BAR; PG8_MMA(1, 0, At, B0); PG8_MMA(1, 1, At, B1); PG8_BAR; PG8_SCHED;
            } else {
            PG8_LDB(B0, 0, 0); PG8_SCHED; PG8_LDA(At, 0, 0); PG8_STAGE(PG8_SA(1, 1), a1 + hstep, voffA);
            PG8_WAIT_L(8); PG8_BAR; PG8_WAIT_L(0); PG8_MMA(0, 0, At, B0); PG8_BAR; PG8_SCHED;
            PG8_LDB(B1, 0, 1); PG8_STAGE(PG8_SB(0, 0), b2, voffB);
            PG8_BAR; PG8_WAIT_L(0); PG8_MMA(0, 1, At, B1); PG8_BAR;
            PG8_LDA(At, 0, 1); PG8_STAGE(PG8_SA(0, 0), a2, voffA);
            PG8_BAR; PG8_WAIT_L(0); PG8_MMA(1, 0, At, B0); PG8_BAR; PG8_SCHED;
            PG8_STAGE(PG8_SB(0, 1), b2 + hstep, voffB);
            PG8_WAIT_V(6); PG8_BAR; PG8_MMA(1, 1, At, B1); PG8_BAR;
            PG8_LDB(B0, 1, 0); PG8_SCHED; PG8_LDA(At, 1, 0); PG8_STAGE(PG8_SA(0, 1), a2 + hstep, voffA);
            PG8_WAIT_L(8); PG8_BAR; PG8_WAIT_L(0); PG8_MMA(0, 0, At, B0); PG8_BAR; PG8_SCHED;
            PG8_LDB(B1, 1, 1); PG8_STAGE(PG8_SB(1, 0), b3, voffB);
            PG8_BAR; PG8_WAIT_L(0); PG8_MMA(0, 1, At, B1); PG8_BAR;
            PG8_LDA(At, 1, 1); PG8_STAGE(PG8_SA(1, 0), a3, voffA);
            PG8_BAR; PG8_WAIT_L(0); PG8_MMA(1, 0, At, B0); PG8_BAR; PG8_SCHED;
            PG8_STAGE(PG8_SB(1, 1), b3 + hstep, voffB);
            PG8_WAIT_V(6); PG8_BAR; PG8_MMA(1, 1, At, B1); PG8_BAR;
            }
        }
        if constexpr (ALIGN_EPI) { if (wr == 0) PG8_BAR; }
        if constexpr (!Epi::AFTER_DRAIN) { const int le_ = opaque_lane(); E(acc, cur, wr, wc, le_ & 15, le_ >> 4); S.done(cur); }
        if (!has_next) break;
#pragma unroll
        for (int a = 0; a < 2; ++a)
#pragma unroll
            for (int b = 0; b < 2; ++b)
#pragma unroll
                for (int m = 0; m < 4; ++m)
#pragma unroll
                    for (int n = 0; n < 2; ++n) acc[a][b][m][n] = (f32x4){0.f, 0.f, 0.f, 0.f};
        cur = nxt; cA = nA; cB = nB; ++ui;
        if constexpr (ALIGN_EPI) { if (wr == 1) PG8_BAR; }
    }
    PG8_WAIT_V(0);
    if constexpr (!ALIGN_EPI) { if (wr == 0) PG8_BAR; }
    PG8_BAR;
    if constexpr (Epi::AFTER_DRAIN) { E.fused(acc, cur, wr, wc, fr, fq, lds, wid, lane); S.done(cur); }
#undef PG8_SA
#undef PG8_SB
#undef PG8_STAGE
#undef PG8_LDA
#undef PG8_LDB
#undef PG8_MMA
#undef PG8_WAIT_V
#undef PG8_WAIT_L
#undef PG8_BAR
#undef PG8_SCHED
}
}

constexpr int NWAVES = 8;
constexpr int DM = 2048, NBATCH = 2, SEQ = 8192, CTXL = 256, TPB = CTXL + SEQ  , MALL = NBATCH * TPB  ;
constexpr int NLAYER = 2;
constexpr int RW = 1024, NH = 16;
constexpr int RWC = 3392, INA = 4192, INA_P = 4352, INC = 8288;
constexpr int C_WD = 3072, C_AD = 3200, C_GD = 3328, C_QC = 3392, C_KVC = 3904, C_KR = 4160;
constexpr int QKD = 96, NQ = NH * QKD  , NKV = NH * 128  ;
constexpr int NEXP = 16384;
constexpr int RREC = 9 * 64;
constexpr float NORM_EPS = 1e-6f;

constexpr size_t MiB = 1u << 20;
constexpr size_t WS_CTL = 0, CTL_ZERO_BYTES = 1 * MiB;
constexpr size_t CTL_MOD_OFF = 256 * 1024;
constexpr size_t WS_ROPE = 1 * MiB;
constexpr size_t WS_WUP = 3 * MiB, WS_AUP = WS_WUP + 512 * 1024, WS_GUP = 4 * MiB;
constexpr size_t WS_WUQ = 5 * MiB, WS_WUKV = 8 * MiB, WS_WA = 10 * MiB, WS_WB = 18 * MiB, WS_WO = 26 * MiB, WS_WQK = 42 * MiB, WS_WGA = 58 * MiB, WS_WGB = 74 * MiB, WS_WINA = 90 * MiB;
constexpr size_t WS_X = 124 * MiB, WS_H = 256 * MiB, WS_DYN = 322 * MiB;
constexpr size_t WS_PA = WS_DYN;
constexpr size_t WS_RI = 463 * MiB;
constexpr size_t WS_GG = 760 * MiB;
constexpr size_t WS_BON = 826 * MiB;
constexpr size_t WS_QN = 831 * MiB, WS_KVN = 848 * MiB;
constexpr size_t WS_Q = 857 * MiB, WS_K = 907 * MiB, WS_V = 957 * MiB, WS_END = 990 * MiB;
constexpr size_t WS_Y = WS_DYN;
constexpr size_t WS_YA = 388 * MiB, WS_YB = 421 * MiB;
constexpr size_t WS_T1 = 463 * MiB, WS_T2 = 529 * MiB;
constexpr size_t WS_PU = 600 * MiB, WS_PV = 664 * MiB;
constexpr size_t WS_P4 = 990 * MiB, WS_P4S = 1022 * MiB, WS_END2 = 1023 * MiB;
constexpr size_t WS_SC = WS_DYN;
static_assert(WS_PA + (size_t)MALL * INA_P * 2 <= WS_RI && WS_RI + (size_t)NBATCH * NH * TPB * RREC * 2 <= WS_GG && WS_GG + (size_t)2 * MALL * RW * 2 <= WS_BON, "ws map 1");
static_assert(WS_BON + (size_t)2 * MALL * 32 * 4 <= WS_QN && WS_QN + (size_t)MALL * 512 * 2 <= WS_KVN && WS_KVN + (size_t)MALL * 256 * 2 <= WS_Q, "ws map 2");
static_assert(WS_Q + (size_t)NBATCH * NH * TPB * QKD * 2 <= WS_K && WS_K + (size_t)NBATCH * NH * TPB * QKD * 2 <= WS_V && WS_V + (size_t)NBATCH * NH * TPB * 64 * 2 <= WS_END, "ws map 3");
static_assert(WS_Y + (size_t)2 * MALL * RW * 2 <= WS_YA && WS_YA + (size_t)MALL * RW * 2 <= WS_YB && WS_YB + (size_t)MALL * RW * 2 <= WS_RI, "ws map 4");
static_assert(WS_T1 + (size_t)MALL * DM * 2 <= WS_T2 && WS_T2 + (size_t)MALL * DM * 2 <= WS_PU && WS_PU + (size_t)NEXP * DM * 2 <= WS_PV && WS_PV + (size_t)NEXP * DM * 2 <= WS_GG, "ws map 5");
static_assert(WS_SC + (size_t)MALL * DM * 4 <= WS_T1 && WS_X + (size_t)MALL * DM * 4 <= WS_H && WS_H + (size_t)MALL * DM * 2 <= WS_DYN, "ws map 6");
static_assert(WS_WINA + (size_t)NLAYER * INA_P * DM * 2 <= WS_X, "ws map 7");
constexpr size_t CTL_PROBE_OFF = 640 * 1024;
constexpr int CW_BAR = 4096;

constexpr int RING_BYTES = 131072;
constexpr int LDSCTL_OFF = RING_BYTES, MISC_OFF = LDSCTL_OFF + 320;
constexpr int LDS_BYTES = 147456;

#define GAS __attribute__((address_space(1)))
#define LAS __attribute__((address_space(3)))
typedef unsigned short bf16;
typedef unsigned v4u __attribute__((ext_vector_type(4)));
typedef unsigned v2u __attribute__((ext_vector_type(2)));
typedef float f32x4 __attribute__((ext_vector_type(4)));
typedef float f32x2 __attribute__((ext_vector_type(2)));
typedef float f32x16 __attribute__((ext_vector_type(16)));
typedef short bf16x8 __attribute__((ext_vector_type(8)));
typedef short s16x4 __attribute__((ext_vector_type(4)));
typedef __bf16 bf16x2v __attribute__((ext_vector_type(2)));
typedef __bf16 bf16x8v __attribute__((ext_vector_type(8)));
typedef GAS unsigned gu32;
#define RLX_AGENT __ATOMIC_RELAXED, __HIP_MEMORY_SCOPE_AGENT
#define LDS_WAIT() asm volatile("s_waitcnt lgkmcnt(0)" ::: "memory")
#define VM_WAIT() asm volatile("s_waitcnt vmcnt(0)" ::: "memory")
__device__ __forceinline__ unsigned f2bf(float f) { unsigned u = __builtin_bit_cast(unsigned, f); return (u + 0x7fffu + ((u >> 16) & 1u)) >> 16; }
__device__ __forceinline__ unsigned pk2(float lo, float hi) { return pg8::cvt_pk_bf16(lo, hi); }
__device__ __forceinline__ float bflo(unsigned w) { return __builtin_bit_cast(float, w << 16); }
__device__ __forceinline__ float bfhi(unsigned w) { return __builtin_bit_cast(float, w & 0xffff0000u); }
__device__ __forceinline__ float bf1(bf16 h) { return __builtin_bit_cast(float, (unsigned)h << 16); }
__device__ __forceinline__ float sigmoidf_(float x) { return __builtin_amdgcn_rcpf(1.0f + __expf(-x)); }
template <int CTRL> __device__ __forceinline__ float dpp_add(float x) {
    return x + __builtin_bit_cast(float, __builtin_amdgcn_update_dpp(0, __builtin_bit_cast(int, x), CTRL, 0xf, 0xf, true));
}
__device__ __forceinline__ float red16(float x) {
    x = dpp_add<0xB1>(x);
    x = dpp_add<0x4E>(x);
    x = dpp_add<0x141>(x);
    x = dpp_add<0x140>(x);
    return x;
}
template <int CTRL, int RM> __device__ __forceinline__ float dpp_max(float x) {
    return fmaxf(x, __builtin_bit_cast(float, __builtin_amdgcn_update_dpp(__builtin_bit_cast(int, x), __builtin_bit_cast(int, x), CTRL, RM, 0xf, false)));
}
template <int CTRL, int RM> __device__ __forceinline__ float dpp_sum(float x) {
    return x + __builtin_bit_cast(float, __builtin_amdgcn_update_dpp(0, __builtin_bit_cast(int, x), CTRL, RM, 0xf, false));
}
__device__ __forceinline__ float wave_max_u(float x) {
    x = dpp_max<0xB1, 0xf>(x); x = dpp_max<0x4E, 0xf>(x); x = dpp_max<0x141, 0xf>(x); x = dpp_max<0x140, 0xf>(x);
    x = dpp_max<0x142, 0xa>(x); x = dpp_max<0x143, 0xc>(x);
    return __builtin_bit_cast(float, __builtin_amdgcn_readlane(__builtin_bit_cast(int, x), 63));
}
__device__ __forceinline__ float wave_sum_u(float x) {
    x = dpp_sum<0xB1, 0xf>(x); x = dpp_sum<0x4E, 0xf>(x); x = dpp_sum<0x141, 0xf>(x); x = dpp_sum<0x140, 0xf>(x);
    x = dpp_sum<0x142, 0xa>(x); x = dpp_sum<0x143, 0xc>(x);
    return __builtin_bit_cast(float, __builtin_amdgcn_readlane(__builtin_bit_cast(int, x), 63));
}
__device__ __forceinline__ float wave_sum(float v) { return wave_sum_u(v); }
__device__ __forceinline__ float bpermf(int srclane, float v) { return __builtin_bit_cast(float, __builtin_amdgcn_ds_bpermute(srclane << 2, __builtin_bit_cast(int, v))); }
__device__ __forceinline__ int bpermi(int srclane, int v) { return __builtin_amdgcn_ds_bpermute(srclane << 2, v); }

#define XB_TMO      128
#define XB_XCNT(j)  (256  + 64 * (j))
#define XB_XSUB(j)  (1280 + 64 * (j))
#define XB_XGEN(j)  (2304 + 64 * (j))
#define XB_TOP      3328
#define XB_TOPGEN   3392
#define XCD_BAR_WORDS 3456
#define XB_SPIN_CAP (1u << 20)

__device__ __forceinline__ unsigned xb_ld(unsigned* p)              { return __hip_atomic_load(p, __ATOMIC_RELAXED, __HIP_MEMORY_SCOPE_AGENT); }
__device__ __forceinline__ unsigned xb_add(unsigned* p, unsigned v) { return __hip_atomic_fetch_add(p, v, __ATOMIC_RELAXED, __HIP_MEMORY_SCOPE_AGENT); }
__device__ __forceinline__ unsigned xb_xcc_id() { return (unsigned)__builtin_amdgcn_s_getreg((3 << 11) | 20) & 0xFu; }
#define XB_SPIN(cond, bar) do { unsigned _sp = 0; while (cond) { __builtin_amdgcn_s_sleep(1); \
    if ((++_sp & 255u) == 0u) { if (xb_ld(&(bar)[XB_TMO])) break; if (_sp > XB_SPIN_CAP) { atomicAdd(&(bar)[XB_TMO], 1u); break; } } } } while (0)

struct XcdBarrier { unsigned* bar; unsigned x; volatile LAS unsigned* st; };

__device__ __forceinline__ XcdBarrier xcd_barrier_post(unsigned* bar, volatile LAS unsigned* st, bool t0) {
    XcdBarrier b; b.bar = bar; b.x = xb_xcc_id(); b.st = st;
    if (t0) (void)xb_add(&bar[XB_XCNT(b.x)], 1u);
    return b;
}
__device__ __forceinline__ void xcd_barrier_complete(unsigned* bar, unsigned x, unsigned& nloc, unsigned& nx) {
    const unsigned G = gridDim.x * gridDim.y * gridDim.z;
    unsigned sum, cnt, mine, sp = 0u;
    for (;;) {
        sum = 0u; cnt = 0u; mine = 0u;
#pragma unroll
        for (unsigned j = 0; j < 16; ++j) { const unsigned c = xb_ld(&bar[XB_XCNT(j)]); sum += c; cnt += (c > 0u) ? 1u : 0u; mine = (j == x) ? c : mine; }
        if (sum == G) break;
        __builtin_amdgcn_s_sleep(1);
        if ((++sp & 255u) == 0u) { if (xb_ld(&bar[XB_TMO])) break; if (sp > XB_SPIN_CAP) { atomicAdd(&bar[XB_TMO], 1u); break; } }
    }
    nloc = mine > 0u ? mine : 1u; nx = cnt > 0u ? cnt : 1u;
}
__device__ __forceinline__ void xcd_barrier(const XcdBarrier& b, bool t0) {
    asm volatile("s_waitcnt vmcnt(0)" ::: "memory");
    __syncthreads();
    if (t0) {
        unsigned* bar = b.bar;
        __builtin_amdgcn_s_waitcnt(0);
        unsigned nloc = b.st[0], nx = b.st[1];
        if (nloc == 0u) { xcd_barrier_complete(bar, b.x, nloc, nx); b.st[0] = nloc; b.st[1] = nx; }
        const unsigned old = xb_add(&bar[XB_XSUB(b.x)], 1u);
        const unsigned gen = old / nloc;
        if (old + 1u == (gen + 1u) * nloc) {
            __builtin_amdgcn_fence(__ATOMIC_RELEASE, "agent");
            asm volatile("s_waitcnt vmcnt(0)" ::: "memory");
            const unsigned og = xb_add(&bar[XB_TOP], 1u);
            const unsigned tg = og / nx;
            if (og + 1u == (tg + 1u) * nx) xb_add(&bar[XB_TOPGEN], 1u);
            else XB_SPIN(xb_ld(&bar[XB_TOPGEN]) == tg, bar);
            __builtin_amdgcn_fence(__ATOMIC_ACQUIRE, "agent");
            xb_add(&bar[XB_XGEN(b.x)], 1u);
            asm volatile("s_waitcnt vmcnt(0)" ::: "memory");
        } else {
            XB_SPIN(xb_ld(&bar[XB_XGEN(b.x)]) == gen, bar);
            __builtin_amdgcn_fence(__ATOMIC_ACQUIRE, "agent");
            asm volatile("s_waitcnt vmcnt(0)" ::: "memory");
        }
    }
    __syncthreads();
}

struct Frame {
    LAS unsigned char* lds;
    unsigned char* ws;
    const float* const* in;
    int tid, lane, wave;
    int vcu, G;
};
struct Args { const float* in[33]; float* out; unsigned char* ws; int ph_lo, ph_hi; };


namespace pg8 {
typedef unsigned u32x4 __attribute__((ext_vector_type(4)));
struct RowOrder : StaticOrder {
    int lat;
    __host__ __device__ void init_rows(int lat_, int N, int G_, int c_) { lat = lat_; init(lat_ ? NBATCH * SEQ : MALL, N, G_, c_); }
    __host__ __device__ bool next(int i, Unit& u) const { if (!StaticOrder::next(i, u)) return false; if (lat) u.pm = 33 * (u.pm >> 5) + 1 + (u.pm & 31); return true; }
};
#define EPI_LOOP_ROWS for (int ai = 0; ai < 2; ++ai) _Pragma("unroll") for (int m = 0; m < 4; ++m)
#define EPI_PIN asm volatile("" ::: "memory")

struct EpiStoreBf16 {
    static constexpr bool PERM = true, AFTER_DRAIN = false;
    bf16_t* O; int ldc;
    __device__ __forceinline__ void operator()(const f32x4 (&acc)[2][2][4][2], const Unit& u, int wr, int wc, int fr, int fq) const {
        const int row0 = u.pm * BM + wr * 64 + fr, col0 = u.pn * BM + wc * 32 + 8 * fq;
#pragma unroll
        EPI_LOOP_ROWS { bf16_t* rowp = O + (size_t)(row0 + ai * HALF + m * 16) * ldc + col0;
#pragma unroll
            for (int bj = 0; bj < 2; ++bj) { const f32x4 v0 = acc[ai][bj][m][0], v1 = acc[ai][bj][m][1];
                u32x4 w; w.x = cvt_pk_bf16(v0[0], v0[1]); w.y = cvt_pk_bf16(v0[2], v0[3]); w.z = cvt_pk_bf16(v1[0], v1[1]); w.w = cvt_pk_bf16(v1[2], v1[3]);
                *(u32x4*)(rowp + bj * HALF) = w; } }
    }
};
struct EpiGate {
    static constexpr bool PERM = true, AFTER_DRAIN = false;
    bf16_t* O; int ldc; const float* bias;
    __device__ __forceinline__ void operator()(const f32x4 (&acc)[2][2][4][2], const Unit& u, int wr, int wc, int fr, int fq) const {
        const int row0 = u.pm * BM + wr * 64 + fr, col0 = u.pn * BM + wc * 32 + 8 * fq;
        f32x4 bv[2][2];
#pragma unroll
        for (int bj = 0; bj < 2; ++bj)
#pragma unroll
            for (int n = 0; n < 2; ++n) bv[bj][n] = *(const f32x4*)(bias + col0 + bj * HALF + 4 * n);
#pragma unroll
        EPI_LOOP_ROWS { EPI_PIN; bf16_t* rowp = O + (size_t)(row0 + ai * HALF + m * 16) * ldc + col0;
#pragma unroll
            for (int bj = 0; bj < 2; ++bj) { f32x4 v0 = acc[ai][bj][m][0] + bv[bj][0], v1 = acc[ai][bj][m][1] + bv[bj][1];
#pragma unroll
                for (int e = 0; e < 4; ++e) { v0[e] = __builtin_amdgcn_rcpf(1.0f + __expf(-v0[e])); v1[e] = __builtin_amdgcn_rcpf(1.0f + __expf(-v1[e])); }
                u32x4 w; w.x = cvt_pk_bf16(v0[0], v0[1]); w.y = cvt_pk_bf16(v0[2], v0[3]); w.z = cvt_pk_bf16(v1[0], v1[1]); w.w = cvt_pk_bf16(v1[2], v1[3]);
                *(u32x4*)(rowp + bj * HALF) = w; } }
    }
};
__device__ __forceinline__ float bf_lo(unsigned w) { return __builtin_bit_cast(float, w << 16); }
__device__ __forceinline__ float bf_hi(unsigned w) { return __builtin_bit_cast(float, w & 0xffff0000u); }
struct EpiMulAdd {
    static constexpr bool PERM = true, AFTER_DRAIN = false;
    bf16_t* O; const bf16_t* Gt; const bf16_t* Ad; int ldc;
    __device__ __forceinline__ void operator()(const f32x4 (&acc)[2][2][4][2], const Unit& u, int wr, int wc, int fr, int fq) const {
        const int row0 = u.pm * BM + wr * 64 + fr, col0 = u.pn * BM + wc * 32 + 8 * fq;
#pragma unroll
        EPI_LOOP_ROWS { EPI_PIN; const size_t ro = (size_t)(row0 + ai * HALF + m * 16) * ldc + col0;
#pragma unroll
            for (int bj = 0; bj < 2; ++bj) { const f32x4 v0 = acc[ai][bj][m][0], v1 = acc[ai][bj][m][1];
                const u32x4 g = *(const u32x4*)(Gt + ro + bj * HALF);
                float o[8];
                o[0] = bf_lo(g.x) * v0[0]; o[1] = bf_hi(g.x) * v0[1]; o[2] = bf_lo(g.y) * v0[2]; o[3] = bf_hi(g.y) * v0[3];
                o[4] = bf_lo(g.z) * v1[0]; o[5] = bf_hi(g.z) * v1[1]; o[6] = bf_lo(g.w) * v1[2]; o[7] = bf_hi(g.w) * v1[3];
                if (Ad) { const u32x4 a = *(const u32x4*)(Ad + ro + bj * HALF);
                    o[0] += bf_lo(a.x); o[1] += bf_hi(a.x); o[2] += bf_lo(a.y); o[3] += bf_hi(a.y); o[4] += bf_lo(a.z); o[5] += bf_hi(a.z); o[6] += bf_lo(a.w); o[7] += bf_hi(a.w); }
                u32x4 w; w.x = cvt_pk_bf16(o[0], o[1]); w.y = cvt_pk_bf16(o[2], o[3]); w.z = cvt_pk_bf16(o[4], o[5]); w.w = cvt_pk_bf16(o[6], o[7]);
                *(u32x4*)(O + ro + bj * HALF) = w; } }
    }
};
struct EpiResid {
    static constexpr bool PERM = false, AFTER_DRAIN = false;
    float* X; const float* gate;
    const float* xin; const float* cin;
    __device__ __forceinline__ void operator()(const f32x4 (&acc)[2][2][4][2], const Unit& u, int wr, int wc, int fr, int fq) const {
        const int row0 = u.pm * BM + wr * 64 + fr, col0 = u.pn * BM + wc * 32 + 4 * fq;
        const int bb = u.pm / 33, pt = u.pm - bb * 33, mr = (pt == 0) ? 2 : bb;
        const float* gp = gate + (size_t)mr * 12288 + col0;
        const float* sbase = xin ? (pt == 0 ? cin + (size_t)bb * CTXL * DM : xin + ((size_t)bb * SEQ + (size_t)(pt - 1) * BM) * DM) : X + (size_t)u.pm * BM * DM;
        f32x4 gv[2][2];
#pragma unroll
        for (int bj = 0; bj < 2; ++bj)
#pragma unroll
            for (int n = 0; n < 2; ++n) gv[bj][n] = *(const f32x4*)(gp + bj * HALF + n * 16);
#pragma unroll
        EPI_LOOP_ROWS { EPI_PIN; const int rl = wr * 64 + fr + ai * HALF + m * 16; float* rowp = X + (size_t)(u.pm * BM + rl) * DM + col0; const float* srow = sbase + (size_t)rl * DM + col0;
#pragma unroll
            for (int bj = 0; bj < 2; ++bj)
#pragma unroll
                for (int n = 0; n < 2; ++n) *(f32x4*)(rowp + bj * HALF + n * 16) = *(const f32x4*)(srow + bj * HALF + n * 16) + gv[bj][n] * acc[ai][bj][m][n]; }
    }
};
struct EpiF32 {
    static constexpr bool PERM = false, AFTER_DRAIN = false;
    float* C; int ldc;
    __device__ __forceinline__ void operator()(const f32x4 (&acc)[2][2][4][2], const Unit& u, int wr, int wc, int fr, int fq) const {
        const int row0 = u.pm * BM + wr * 64 + fr, col0 = u.pn * BM + wc * 32 + 4 * fq;
#pragma unroll
        EPI_LOOP_ROWS { float* rowp = C + (size_t)(row0 + ai * HALF + m * 16) * ldc + col0;
#pragma unroll
            for (int bj = 0; bj < 2; ++bj)
#pragma unroll
                for (int n = 0; n < 2; ++n) *(f32x4*)(rowp + bj * HALF + n * 16) = acc[ai][bj][m][n]; }
    }
};
struct EpiQ {
    static constexpr bool PERM = true, AFTER_DRAIN = false;
    bf16_t* Q; const f32x2* rope; float qscale;
    __device__ __forceinline__ void operator()(const f32x4 (&acc)[2][2][4][2], const Unit& u, int wr, int wc, int fr, int fq) const {
        const int bb = u.pm / 33, tp0 = (u.pm - bb * 33) * BM + wr * 64 + fr, col0 = u.pn * BM + wc * 32 + 8 * fq;
#pragma unroll
        for (int bj = 0; bj < 2; ++bj) { const int c = col0 + bj * HALF, hd = c / QKD, d = c - hd * QKD;
#pragma unroll
            EPI_LOOP_ROWS { EPI_PIN; const int tp = tp0 + ai * HALF + m * 16;
                f32x4 v0 = acc[ai][bj][m][0], v1 = acc[ai][bj][m][1];
                if (d >= 64) { const int i0 = (d - 64) >> 1; const f32x2* rp = rope + (size_t)tp * 16 + i0;
                    const f32x2 c0 = rp[0], c1 = rp[1], c2 = rp[2], c3 = rp[3];
                    float a, b;
                    a = v0[0]; b = v0[1]; v0[0] = a * c0.x - b * c0.y; v0[1] = a * c0.y + b * c0.x;
                    a = v0[2]; b = v0[3]; v0[2] = a * c1.x - b * c1.y; v0[3] = a * c1.y + b * c1.x;
                    a = v1[0]; b = v1[1]; v1[0] = a * c2.x - b * c2.y; v1[1] = a * c2.y + b * c2.x;
                    a = v1[2]; b = v1[3]; v1[2] = a * c3.x - b * c3.y; v1[3] = a * c3.y + b * c3.x; }
                v0 = v0 * qscale; v1 = v1 * qscale;
                u32x4 w; w.x = cvt_pk_bf16(v0[0], v0[1]); w.y = cvt_pk_bf16(v0[2], v0[3]); w.z = cvt_pk_bf16(v1[0], v1[1]); w.w = cvt_pk_bf16(v1[2], v1[3]);
                *(u32x4*)(Q + ((size_t)(bb * NH + hd) * TPB + tp) * QKD + d) = w; } }
    }
};
struct EpiKV {
    static constexpr bool PERM = true, AFTER_DRAIN = false;
    bf16_t* K; bf16_t* V;
    __device__ __forceinline__ void operator()(const f32x4 (&acc)[2][2][4][2], const Unit& u, int wr, int wc, int fr, int fq) const {
        const int bb = u.pm / 33, tp0 = (u.pm - bb * 33) * BM + wr * 64 + fr;
        const bool isK = wc < 2;
        bf16_t* base = isK ? K : V; const int pitch = isK ? QKD : 64, doff = 32 * (wc & 1) + 8 * fq;
#pragma unroll
        for (int bj = 0; bj < 2; ++bj) { const int hd = 2 * u.pn + bj;
            bf16_t* hb = base + (size_t)(bb * NH + hd) * TPB * pitch;
#pragma unroll
            EPI_LOOP_ROWS { EPI_PIN; const int tp = tp0 + ai * HALF + m * 16;
                const f32x4 v0 = acc[ai][bj][m][0], v1 = acc[ai][bj][m][1];
                u32x4 w; w.x = cvt_pk_bf16(v0[0], v0[1]); w.y = cvt_pk_bf16(v0[2], v0[3]); w.z = cvt_pk_bf16(v1[0], v1[1]); w.w = cvt_pk_bf16(v1[2], v1[3]);
                *(u32x4*)((char*)hb + (unsigned)((tp * pitch + doff) * 2)) = w; } }
    }
};
}

struct TItem { const float* W; bf16* WT; int K, ldw, c0, N, mapq, item; };
__device__ __forceinline__ void p0_item_load(const TItem& T, int lane, f32x4 (&x)[8]) {
    const int nblk = T.N / 32, kb = T.item / nblk, nb = T.item - kb * nblk, k0 = 64 * kb, n0 = 32 * nb;
    const float* p = T.W + (size_t)(k0 + (lane >> 3)) * T.ldw + T.c0 + n0 + (lane & 7) * 4;
#pragma unroll
    for (int i = 0; i < 8; ++i) x[i] = *(const GAS f32x4*)(p + (size_t)(8 * i) * T.ldw);
}
__device__ __forceinline__ void p0_item_finish(const TItem& T, const f32x4 (&x)[8], LAS float* scr, int lane) {
    const int nblk = T.N / 32, kb = T.item / nblk, nb = T.item - kb * nblk, k0 = 64 * kb, n0 = 32 * nb;
#pragma unroll
    for (int i = 0; i < 8; ++i) { LAS float* d = scr + (8 * i + (lane >> 3)) * 33 + (lane & 7) * 4; d[0] = x[i].x; d[1] = x[i].y; d[2] = x[i].z; d[3] = x[i].w; }
    LDS_WAIT(); asm volatile("" ::: "memory");
    const int c = lane & 7;
#pragma unroll
    for (int j = 0; j < 4; ++j) { const int n = (lane >> 3) + 8 * j; const LAS float* s = scr + (8 * c) * 33 + n;
        v4u o; o.x = pk2(s[0 * 33], s[1 * 33]); o.y = pk2(s[2 * 33], s[3 * 33]); o.z = pk2(s[4 * 33], s[5 * 33]); o.w = pk2(s[6 * 33], s[7 * 33]);
        int nn = n0 + n;
        if (T.mapq) { const int hd = nn / QKD, d = nn - hd * QKD; if (d >= 64) { const int i = (d - 64) & 15, s2 = (d - 64) >> 4; nn = hd * QKD + 64 + 2 * i + s2; } }
        *(GAS v4u*)(T.WT + (size_t)nn * T.K + k0 + 8 * c) = o; }
    LDS_WAIT(); asm volatile("" ::: "memory");
}

__device__ __forceinline__ const float* karg(int i);
constexpr int TB_INA = (DM / 128) * ((INA + 127) / 128), TB_G = (DM / 128) * (DM / 128), TB_BR = (RW / 128) * (DM / 128), TB_UQ = (512 / 128) * (NQ / 128), TB_UKV = (256 / 128) * (NKV / 128);
constexpr int TB_N = TB_INA + 2 * TB_G + 2 * TB_BR + TB_G + TB_UQ + TB_UKV;
constexpr int TI_LR = 1 * (RW / 32), TI_N = 4 * TI_LR;
__device__ __forceinline__ TItem p0_resolve_big(unsigned char* ws, int git) {
    const int l = git / TB_N; int r = git - l * TB_N; TItem T; T.mapq = 0; T.c0 = 0;
    if (r < TB_INA) { T.W = karg(7) + (size_t)l * DM * INC; T.K = DM; T.ldw = INC; T.N = INA; T.WT = (bf16*)(ws + WS_WINA) + (size_t)l * INA_P * DM; T.item = r; return T; } r -= TB_INA;
    if (r < TB_G) { T.W = karg(7) + (size_t)l * DM * INC; T.K = DM; T.ldw = INC; T.c0 = INA; T.N = DM; T.WT = (bf16*)(ws + WS_WGA) + (size_t)l * DM * DM; T.item = r; return T; } r -= TB_G;
    if (r < TB_G) { T.W = karg(7) + (size_t)l * DM * INC; T.K = DM; T.ldw = INC; T.c0 = INA + DM; T.N = DM; T.WT = (bf16*)(ws + WS_WGB) + (size_t)l * DM * DM; T.item = r; return T; } r -= TB_G;
    if (r < TB_BR) { T.W = karg(24) + (size_t)l * RW * DM; T.K = RW; T.ldw = DM; T.N = DM; T.WT = (bf16*)(ws + WS_WA) + (size_t)l * DM * RW; T.item = r; return T; } r -= TB_BR;
    if (r < TB_BR) { T.W = karg(25) + (size_t)l * RW * DM; T.K = RW; T.ldw = DM; T.N = DM; T.WT = (bf16*)(ws + WS_WB) + (size_t)l * DM * RW; T.item = r; return T; } r -= TB_BR;
    if (r < TB_G) { T.W = karg(26) + (size_t)l * DM * DM; T.K = DM; T.ldw = DM; T.N = DM; T.WT = (bf16*)(ws + WS_WO) + (size_t)l * DM * DM; T.item = r; return T; } r -= TB_G;
    if (r < TB_UQ) { T.W = karg(21) + (size_t)l * 512 * NQ; T.K = 512; T.ldw = NQ; T.N = NQ; T.WT = (bf16*)(ws + WS_WUQ) + (size_t)l * NQ * 512; T.item = r; T.mapq = 1; return T; } r -= TB_UQ;
    { T.W = karg(23) + (size_t)l * 256 * NKV; T.K = 256; T.ldw = NKV; T.N = NKV; T.WT = (bf16*)(ws + WS_WUKV) + (size_t)l * NKV * 256; T.item = r; return T; }
}
__device__ __forceinline__ void p0_big_load(const TItem& T, int tid, f32x4 (&x)[8]) {
    const int nblk = (T.N + 127) / 128, kb = T.item / nblk, nb = T.item - kb * nblk, k0 = 128 * kb, col = 128 * nb + (tid & 31) * 4;
    const float* p = T.W + (size_t)(k0 + (tid >> 5)) * T.ldw + T.c0 + col; const bool ok = col < T.N;
#pragma unroll
    for (int i = 0; i < 8; ++i) x[i] = ok ? *(const GAS f32x4*)(p + (size_t)(16 * i) * T.ldw) : (f32x4){0.f, 0.f, 0.f, 0.f};
}
__device__ __forceinline__ void p0_big_finish(const TItem& T, const f32x4 (&x)[8], LAS float* tile, int tid) {
    const int nblk = (T.N + 127) / 128, kb = T.item / nblk, nb = T.item - kb * nblk, k0 = 128 * kb, n0 = 128 * nb;
    __syncthreads();
#pragma unroll
    for (int i = 0; i < 8; ++i) *(LAS f32x4*)(tile + ((tid >> 5) + 16 * i) * 132 + (tid & 31) * 4) = x[i];
    __syncthreads();
    const int n = tid & 127, cg = tid >> 7; int nn = n0 + n;
    if (nn < T.N) {
        if (T.mapq) { const int hd = nn / QKD, d = nn - hd * QKD; if (d >= 64) { const int i = (d - 64) & 15, s2 = (d - 64) >> 4; nn = hd * QKD + 64 + 2 * i + s2; } }
#pragma unroll
        for (int c = 0; c < 4; ++c) { const LAS float* s = tile + (32 * cg + 8 * c) * 132 + n;
            v4u o; o.x = pk2(s[0 * 132], s[1 * 132]); o.y = pk2(s[2 * 132], s[3 * 132]); o.z = pk2(s[4 * 132], s[5 * 132]); o.w = pk2(s[6 * 132], s[7 * 132]);
            *(GAS v4u*)(T.WT + (size_t)nn * T.K + k0 + 32 * cg + 8 * c) = o; } }
}
__device__ __forceinline__ TItem p0_resolve(unsigned char* ws, int git) {
    const int l = git / TI_N; int r = git - l * TI_N; TItem T; T.mapq = 0; T.c0 = 0;
    const int which = r / TI_LR, d = which & 1, isa = which >> 1; r -= which * TI_LR;
    T.W = (isa ? karg(13) : karg(11)) + (size_t)(l * 2 + d) * 64 * RW; T.K = 64; T.ldw = RW; T.N = RW; T.WT = (bf16*)(ws + (isa ? WS_AUP : WS_WUP)) + (size_t)(l * 2 + d) * RW * 64; T.item = r; return T;
}
__device__ __forceinline__ void p0_prologue(Frame& F, int l_lo, int l_hi, int svcu, int sG) {
    LAS float* scr = (LAS float*)(F.lds + F.wave * 16384);
    const int gw = svcu * NWAVES + F.wave, NGW = sG * NWAVES;
    unsigned char* ws = F.ws;
    for (int rp_ = 0; rp_ < (DBG_REPEAT == 102 ? 2 : 1); ++rp_)
    { float* modw = (float*)(ws + WS_CTL + CTL_MOD_OFF); const float* adaw = karg(4); const float* adab = karg(5); const float* cin = karg(1); const float* cctx = karg(3);
      LAS float* SIL = (LAS float*)F.lds;
      LAS f32x2* part = (LAS f32x2*)(F.lds + 32768);
      if (svcu >= 0 && l_lo * 96 + svcu < l_hi * 96) {
          for (int i = F.tid; i < 3 * DM; i += 512) { const int r = i >> 11, k = i & 2047; const float c = r < 2 ? cin[r * DM + k] : cctx[k]; SIL[i] = c / (1.f + __expf(-c)); }
          __syncthreads(); }
      if (svcu >= 0) for (int uu = l_lo * 96 + svcu; uu < l_hi * 96; uu += sG) { const int cb = uu % 96, l = uu / 96;
          const int n0 = cb * 128 + F.lane * 2; const float* aw = adaw + (size_t)l * DM * 12288 + n0;
          f32x2 a0 = {0, 0}, a1 = a0, a2 = a0;
#pragma unroll 1
          for (int k0 = F.wave * 256; k0 < F.wave * 256 + 256; k0 += 16) { f32x2 w[16];
#pragma unroll
              for (int j = 0; j < 16; ++j) w[j] = *(const GAS f32x2*)(aw + (size_t)(k0 + j) * 12288);
#pragma unroll
              for (int j = 0; j < 16; ++j) { a0 = a0 + w[j] * SIL[k0 + j]; a1 = a1 + w[j] * SIL[DM + k0 + j]; a2 = a2 + w[j] * SIL[2 * DM + k0 + j]; } }
          __syncthreads();
          part[(F.wave * 3 + 0) * 64 + F.lane] = a0; part[(F.wave * 3 + 1) * 64 + F.lane] = a1; part[(F.wave * 3 + 2) * 64 + F.lane] = a2;
          __syncthreads();
          if (F.wave < 3) { f32x2 s = *(const GAS f32x2*)(adab + (size_t)l * 12288 + n0);
#pragma unroll
              for (int w8 = 0; w8 < 8; ++w8) s = s + part[(w8 * 3 + F.wave) * 64 + F.lane];
              *(GAS f32x2*)(modw + ((size_t)l * 3 + F.wave) * 12288 + n0) = s; }
          __syncthreads(); } }
    for (int rp_ = 0; rp_ < (DBG_REPEAT == 101 ? 2 : 1); ++rp_)
    { unsigned* ctr = (unsigned*)(ws + WS_CTL) + 2048 + 64 * rp_ + 128 * l_lo; LAS float* tile = (LAS float*)F.lds; LAS int* slot = (LAS int*)(F.lds + 128 * 132 * 4);
#define P0_GRAB(dst) do { __syncthreads(); if (F.tid == 0) *slot = (int)__hip_atomic_fetch_add(ctr, 1u, __ATOMIC_RELAXED, __HIP_MEMORY_SCOPE_AGENT); __syncthreads(); dst = *slot; } while (0)
      const int it_end = l_hi * TB_N;
      int it; P0_GRAB(it); it += l_lo * TB_N; f32x4 xa[8], xb[8]; TItem T, Tn;
      if (it < it_end) { T = p0_resolve_big(ws, it); p0_big_load(T, F.tid, xa); }
      while (it < it_end) { int itn; P0_GRAB(itn); itn += l_lo * TB_N; const bool more = itn < it_end;
          if (more) { Tn = p0_resolve_big(ws, itn); p0_big_load(Tn, F.tid, xb); }
          p0_big_finish(T, xa, tile, F.tid);
          if (more) { T = Tn;
#pragma unroll
              for (int i = 0; i < 8; ++i) xa[i] = xb[i]; }
          it = itn; }
#undef P0_GRAB
      __syncthreads();
      if (svcu >= 0) for (int itw = l_lo * TI_N + gw; itw < l_hi * TI_N; itw += NGW) { f32x4 xw[8]; const TItem Tw = p0_resolve(ws, itw); p0_item_load(Tw, F.lane, xw); p0_item_finish(Tw, xw, scr, F.lane); }
    }
    const int gt = gw * 64 + F.lane, NGT = NGW * 64;
    { const float* gup = karg(14);
    if (svcu >= 0) for (int i = l_lo * 2 * 32 * RW + gt; i < l_hi * 2 * 32 * RW; i += NGT) { const int ch = i & 1023, r = (i >> 10) & 31, ld = i >> 15;
        ((bf16*)(ws + WS_GUP))[((size_t)ld * RW + ch) * 32 + r] = (bf16)f2bf(gup[i]); } }
    if (svcu >= 0) for (int i = l_lo * ((INA_P - INA) * DM / 8) + gt; i < l_hi * ((INA_P - INA) * DM / 8); i += NGT) { const int l = i / ((INA_P - INA) * DM / 8), r = i - l * ((INA_P - INA) * DM / 8);
        ((GAS v4u*)((bf16*)(ws + WS_WINA) + ((size_t)l * INA_P + INA) * DM))[r] = (v4u){0u, 0u, 0u, 0u}; }
    { f32x2* rt = (f32x2*)(ws + WS_ROPE);
      if (l_lo == 0 && svcu >= 0) for (int i = gt; i < TPB * 16; i += NGT) { const int tp = i >> 4, k = i & 15; f32x2 o = {1.f, 0.f};
          if (tp >= CTXL) { const int t = tp - CTXL, row = t >> 6, col = t & 63, j = k & 7; const float fr = powf(10000.0f, -(float)j / 8.0f);
              const float ang = (float)(k < 8 ? row : col) * fr; o.x = cosf(ang); o.y = sinf(ang); }
          rt[i] = o; } }
    for (int rp_ = 0; rp_ < (DBG_REPEAT == 103 ? 2 : 1); ++rp_)
    { LAS float* KEY = (LAS float*)F.lds;
      LAS float* WQT = (LAS float*)(F.lds + 65536);
      const float* pkeys = karg(29); const float* pwq = karg(28);
      __syncthreads();
      if (svcu >= 0) for (int uu = l_lo * 512 + svcu; uu < l_hi * 512; uu += sG) { const int kb = uu & 31, hp = (uu >> 5) & 15, l = uu >> 9;
          const GAS f32x4* ksrc = (const GAS f32x4*)(pkeys + ((size_t)l * 16 + hp) * 16384);
          for (int i = F.tid; i < 4096; i += 512) ((LAS f32x4*)KEY)[i] = ksrc[i];
          for (int i = F.tid; i < 2048; i += 512) { const int kk = i >> 5, d4 = i & 31;
              *(LAS f32x4*)(WQT + kk * 132 + d4 * 4) = *(const GAS f32x4*)(pwq + ((size_t)l * DM + kb * 64 + kk) * DM + hp * 128 + d4 * 4); }
          __syncthreads();
          const int kq = F.tid & 15, keyq = F.tid >> 4;
          float acc[4][4];
#pragma unroll
          for (int j = 0; j < 4; ++j)
#pragma unroll
              for (int i = 0; i < 4; ++i) acc[j][i] = 0.f;
          for (int d = 0; d < 128; d += 4) { f32x4 w[4], q[4];
#pragma unroll
              for (int i = 0; i < 4; ++i) w[i] = *(LAS f32x4*)(WQT + (kq + 16 * i) * 132 + d);
#pragma unroll
              for (int j = 0; j < 4; ++j) q[j] = *(LAS f32x4*)(KEY + (4 * keyq + j) * 128 + d);
#pragma unroll
              for (int j = 0; j < 4; ++j)
#pragma unroll
                  for (int i = 0; i < 4; ++i) acc[j][i] += q[j].x * w[i].x + q[j].y * w[i].y + q[j].z * w[i].z + q[j].w * w[i].w; }
          bf16* dst = (bf16*)(ws + WS_WQK) + ((size_t)l * DM + hp * 128 + 4 * keyq) * DM + kb * 64 + kq;
#pragma unroll
          for (int j = 0; j < 4; ++j)
#pragma unroll
              for (int i = 0; i < 4; ++i) dst[(size_t)j * DM + 16 * i] = (bf16)f2bf(acc[j][i]);
          __syncthreads(); } }
}

__device__ __forceinline__ const float* modnorm_src(int m, const float* X, const float* xin, const float* cin) {
    const int b = m / TPB, tp = m - b * TPB;
    return xin ? (tp < CTXL ? cin + ((size_t)b * CTXL + tp) * DM : xin + ((size_t)b * SEQ + (tp - CTXL)) * DM) : X + (size_t)m * DM;
}
__device__ __forceinline__ void modnorm_phase(Frame& F, const float* X, const float* g, const float* mod  , int chunk_sh, bf16* H, int skip_ctx, const float* xin = nullptr, const float* cin = nullptr) {
    const int gw = F.vcu * NWAVES + F.wave, NGW = F.G * NWAVES;
    int m = gw; while (m < MALL && skip_ctx && (m % TPB) < CTXL) m += NGW;
    f32x4 v[8], ga[8], sb[8]; int mr_cur = -1;
    if (m < MALL) { const GAS f32x4* xr = (const GAS f32x4*)modnorm_src(m, X, xin, cin) + F.lane;
#pragma unroll
        for (int j = 0; j < 8; ++j) v[j] = xr[64 * j]; }
    while (m < MALL) {
        int mn = m + NGW; while (mn < MALL && skip_ctx && (mn % TPB) < CTXL) mn += NGW;
        f32x4 nv[8];
        if (mn < MALL) { const GAS f32x4* xr = (const GAS f32x4*)modnorm_src(mn, X, xin, cin) + F.lane;
#pragma unroll
            for (int j = 0; j < 8; ++j) nv[j] = xr[64 * j]; }
        const int b = m / TPB, tp = m - b * TPB, mr = tp < CTXL ? 2 : b;
        if (mr != mr_cur) { mr_cur = mr; const float* sh = mod + (size_t)mr * 12288 + chunk_sh * DM; const float* sc = sh + DM;
#pragma unroll
            for (int j = 0; j < 8; ++j) { const int c = (F.lane + 64 * j) * 4; const f32x4 gg = *(const GAS f32x4*)(g + c), s1 = *(const GAS f32x4*)(sc + c); ga[j] = gg * (s1 + 1.0f); sb[j] = *(const GAS f32x4*)(sh + c); } }
        float s = 0.f;
#pragma unroll
        for (int j = 0; j < 8; ++j) s += (v[j].x * v[j].x + v[j].y * v[j].y) + (v[j].z * v[j].z + v[j].w * v[j].w);
        const float rs = rsqrtf(wave_sum(s) * (1.f / DM) + NORM_EPS);
        GAS v2u* o8 = (GAS v2u*)(H + (size_t)m * DM) + F.lane;
#pragma unroll
        for (int j = 0; j < 8; ++j) { const f32x4 y = (v[j] * rs) * ga[j] + sb[j];
            v2u o; o.x = pk2(y.x, y.y); o.y = pk2(y.z, y.w); o8[64 * j] = o; }
#pragma unroll
        for (int j = 0; j < 8; ++j) v[j] = nv[j];
        m = mn;
    }
}

typedef float f32x4v __attribute__((ext_vector_type(4)));
#define MFMA16(a, b, c) __builtin_amdgcn_mfma_f32_16x16x32_bf16((a), (b), (c), 0, 0, 0)
#define MFMA32(a, b, c) __builtin_amdgcn_mfma_f32_32x32x16_bf16((a), (b), (c), 0, 0, 0)

struct FeatP {
    const bf16* PA; const float* mu; const float* w0; const float* a0; const float* k_k; const float* k_a; const float* r_k;
    const bf16* WUP; const bf16* AUP; const bf16* GUP;
    const float* qnorm; const float* kvnorm; const f32x2* rope;
    bf16* RI; bf16* GG; float* BON; bf16* QN; bf16* KVN; bf16* K;
};
__device__ __forceinline__ f32x4 ld4bf(const bf16* p) { const v2u w = *(const GAS v2u*)p; return (f32x4){bflo(w.x), bfhi(w.x), bflo(w.y), bfhi(w.y)}; }
__device__ __forceinline__ f32x4 mix4(const bf16* PA, int m, int c, bool hp, bool hn, const float* mu) {
    const f32x4 pc = ld4bf(PA + (size_t)m * INA_P + c);
    f32x4 pp = {0, 0, 0, 0}, pn = {0, 0, 0, 0};
    if (hp) pp = ld4bf(PA + (size_t)(m - 1) * INA_P + c);
    if (hn) pn = ld4bf(PA + (size_t)(m + 1) * INA_P + c);
    const f32x4 mm = *(const GAS f32x4*)(mu + c);
    return pc + ((pp + pn) * 0.5f - pc) * mm;
}
__device__ __forceinline__ void unpack8(const v4u w, float (&x)[8]) { x[0] = bflo(w.x); x[1] = bfhi(w.x); x[2] = bflo(w.y); x[3] = bfhi(w.y); x[4] = bflo(w.z); x[5] = bfhi(w.z); x[6] = bflo(w.w); x[7] = bfhi(w.w); }
__device__ __forceinline__ v4u pack8f(const float (&x)[8]) { v4u o; o.x = pk2(x[0], x[1]); o.y = pk2(x[2], x[3]); o.z = pk2(x[4], x[5]); o.w = pk2(x[6], x[7]); return o; }
__device__ __forceinline__ void mix8(const bf16* rowc, bool hp, bool hn, const float (&mu)[8], float (&o)[8]) {
    const v4u zc = {0u, 0u, 0u, 0u};
    const v4u wc = *(const GAS v4u*)rowc, wp = hp ? *(const GAS v4u*)(rowc - INA_P) : zc, wn = hn ? *(const GAS v4u*)(rowc + INA_P) : zc;
    float c[8], p[8], n[8]; unpack8(wc, c); unpack8(wp, p); unpack8(wn, n);
#pragma unroll
    for (int e = 0; e < 8; ++e) o[e] = c[e] + (0.5f * (p[e] + n[e]) - c[e]) * mu[e];
}
struct Raw3 { v4u c, p, n; };
__device__ __forceinline__ Raw3 load3(const bf16* rowc, bool hp, bool hn) { const v4u zc = {0u, 0u, 0u, 0u}; Raw3 r; r.c = *(const GAS v4u*)rowc; r.p = hp ? *(const GAS v4u*)(rowc - INA_P) : zc; r.n = hn ? *(const GAS v4u*)(rowc + INA_P) : zc; return r; }
__device__ __forceinline__ void mix8r(const Raw3& w, const float (&mu)[8], float (&o)[8]) {
    float c[8], p[8], n[8]; unpack8(w.c, c); unpack8(w.p, p); unpack8(w.n, n);
#pragma unroll
    for (int e = 0; e < 8; ++e) o[e] = c[e] + (0.5f * (p[e] + n[e]) - c[e]) * mu[e];
}
__device__ __forceinline__ void features_phase(Frame& F, const FeatP& P) {
    constexpr int LAP = 328;
    LAS bf16* LA = (LAS bf16*)F.lds;
    LAS float* SSQ = (LAS float*)(F.lds + 10752);
    LAS float* PRM = (LAS float*)(F.lds + 12288);
    const int lane = F.lane, w = F.wave, tk = lane & 15, q4 = lane >> 4;
    constexpr int NTILE = MALL / 16, NTG = 64;
    for (int su = F.vcu; su < 4 * NTG; su += F.G) {
        const int cg = su & 3, tg = su >> 2, cw = 256 * cg + 32 * w, ch8 = cw + 8 * q4, hd = 4 * cg + (w >> 1);
        __syncthreads();
        for (int i = F.tid; i < 2560; i += 512) { const int prm = i >> 8, c = (i & 255) + 256 * cg; float v;
            switch (prm) { case 0: v = P.k_k[c]; break; case 1: v = P.k_a[c]; break; case 2: v = P.r_k[c]; break; case 3: v = P.w0[c]; break; case 4: v = P.w0[RW + c]; break;
                           case 5: v = P.a0[c]; break; case 6: v = P.a0[RW + c]; break; case 7: v = P.mu[c]; break; case 8: v = P.mu[RW + c]; break; default: v = P.mu[2 * RW + c]; break; }
            PRM[i] = v; }
        bf16x8 fw[2][2][2], fa[2][2][2], fg[2][2];
        { const int chA = cw + 8 * (tk >> 2) + (tk & 3);
#pragma unroll
          for (int d = 0; d < 2; ++d)
#pragma unroll
              for (int t = 0; t < 2; ++t) {
#pragma unroll
                  for (int ks = 0; ks < 2; ++ks) { fw[d][t][ks] = *(const GAS bf16x8*)(P.WUP + ((size_t)d * RW + chA + 4 * t) * 64 + ks * 32 + q4 * 8); fa[d][t][ks] = *(const GAS bf16x8*)(P.AUP + ((size_t)d * RW + chA + 4 * t) * 64 + ks * 32 + q4 * 8); }
                  fg[d][t] = *(const GAS bf16x8*)(P.GUP + ((size_t)d * RW + chA + 4 * t) * 32 + q4 * 8); } }
        for (int tt = tg; tt < NTILE; tt += NTG) {
            const int m0 = tt * 16;
            const int m = m0 + tk, b = m / TPB, tp = m - b * TPB;
            const bool hp = (tp != 0) && (tp != CTXL), hn = (tp != CTXL - 1) && (tp != TPB - 1);
            const bf16* rowp = P.PA + (size_t)m * INA_P + ch8;
            const Raw3 rawk = load3(rowp + RW, hp, hn), rawr = load3(rowp, hp, hn), rawv = load3(rowp + 2 * RW, hp, hn);
            __syncthreads();
            for (int it = F.tid; it < 640; it += 512) { const int tkk = it / 40, c8 = (it - tkk * 40) * 8, c = C_WD + c8, m = m0 + tkk, tp = m % TPB;
                const bool hp = (tp != 0) && (tp != CTXL), hn = (tp != CTXL - 1) && (tp != TPB - 1);
                float mu[8], v[8];
                { const f32x4 a = *(const GAS f32x4*)(P.mu + c), b2 = *(const GAS f32x4*)(P.mu + c + 4); mu[0] = a.x; mu[1] = a.y; mu[2] = a.z; mu[3] = a.w; mu[4] = b2.x; mu[5] = b2.y; mu[6] = b2.z; mu[7] = b2.w; }
                mix8(P.PA + (size_t)m * INA_P + c, hp, hn, mu, v);
#pragma unroll
                for (int e = 0; e < 8; ++e) { if (c < C_AD) v[e] = 1.0f - 2.0f * __builtin_amdgcn_rcpf(1.0f + __expf(2.0f * v[e])); else if (c >= C_GD) v[e] = sigmoidf_(v[e]); }
                *(LAS v4u*)(LA + tkk * LAP + c8) = pack8f(v); }
            if ((tt & 3) == cg) {
#pragma unroll
                for (int t2 = 0; t2 < 2; ++t2) { const int m = m0 + 2 * w + t2, b = m / TPB, tp = m - b * TPB; const bf16* row = P.PA + (size_t)m * INA_P;
                    { float x[8]; unpack8(*(const GAS v4u*)(row + C_QC + lane * 8), x); float s = 0.f;
#pragma unroll
                      for (int e = 0; e < 8; ++e) s += x[e] * x[e];
                      const float rs = rsqrtf(wave_sum(s) * (1.f / 512.f) + NORM_EPS);
#pragma unroll
                      for (int e = 0; e < 8; ++e) x[e] = x[e] * rs * P.qnorm[lane * 8 + e];
                      *(GAS v4u*)(P.QN + (size_t)m * 512 + lane * 8) = pack8f(x); }
                    { const v2u q = *(const GAS v2u*)(row + C_KVC + lane * 4);
                      float x[4] = {bflo(q.x), bfhi(q.x), bflo(q.y), bfhi(q.y)}; float s = 0.f;
#pragma unroll
                      for (int e = 0; e < 4; ++e) s += x[e] * x[e];
                      const float rs = rsqrtf(wave_sum(s) * (1.f / 256.f) + NORM_EPS);
#pragma unroll
                      for (int e = 0; e < 4; ++e) x[e] = x[e] * rs * P.kvnorm[lane * 4 + e];
                      v2u o; o.x = pk2(x[0], x[1]); o.y = pk2(x[2], x[3]);
                      *(GAS v2u*)(P.KVN + (size_t)m * 256 + lane * 4) = o; }
                    if (lane < 16) { const float x1 = bf1(row[C_KR + lane]), x2 = bf1(row[C_KR + 16 + lane]); const f32x2 cs = P.rope[(size_t)tp * 16 + lane];
                        const unsigned o = pk2(x1 * cs.x - x2 * cs.y, x1 * cs.y + x2 * cs.x);
#pragma unroll
                        for (int h2 = 0; h2 < NH; ++h2) *(GAS unsigned*)(P.K + ((size_t)(b * NH + h2) * TPB + tp) * QKD + 64 + 2 * lane) = o; } } }
            const int pc = 32 * w + 8 * q4;
            float prm[8], kmx[8], kx[8];
#pragma unroll
            for (int e = 0; e < 8; ++e) prm[e] = PRM[8 * 256 + pc + e];
            mix8r(rawk, prm, kmx);
            { float s = 0.f;
#pragma unroll
              for (int e = 0; e < 8; ++e) { kx[e] = kmx[e] * PRM[0 * 256 + pc + e]; s += kx[e] * kx[e]; }
              s += bpermf(lane ^ 16, s); s += bpermf(lane ^ 32, s);
              if (q4 == 0) SSQ[tk * 8 + w] = s; }
            __syncthreads();
            const float rsn = rsqrtf(SSQ[tk * 8 + w] + SSQ[tk * 8 + (w ^ 1)] + 1e-12f);
            f32x4 cw_[2][2], ca_[2][2], cg_[2][2];
#pragma unroll
            for (int d = 0; d < 2; ++d) {
                const bf16x8 bg = *(const LAS bf16x8*)(LA + tk * LAP + 256 + d * 32 + q4 * 8);
                bf16x8 bw[2], ba[2];
#pragma unroll
                for (int ks = 0; ks < 2; ++ks) { bw[ks] = *(const LAS bf16x8*)(LA + tk * LAP + d * 64 + ks * 32 + q4 * 8); ba[ks] = *(const LAS bf16x8*)(LA + tk * LAP + 128 + d * 64 + ks * 32 + q4 * 8); }
#pragma unroll
                for (int t = 0; t < 2; ++t) { f32x4 z = {0, 0, 0, 0};
                    cw_[d][t] = MFMA16(fw[d][t][1], bw[1], MFMA16(fw[d][t][0], bw[0], z));
                    ca_[d][t] = MFMA16(fa[d][t][1], ba[1], MFMA16(fa[d][t][0], ba[0], z));
                    cg_[d][t] = MFMA16(fg[d][t], bg, z); } }
            float r8[8], v8[8], kk8[8];
#pragma unroll
            for (int e = 0; e < 8; ++e) prm[e] = PRM[7 * 256 + pc + e];
            mix8r(rawr, prm, r8);
#pragma unroll
            for (int e = 0; e < 8; ++e) prm[e] = PRM[9 * 256 + pc + e];
            mix8r(rawv, prm, v8);
#pragma unroll
            for (int e = 0; e < 8; ++e) kk8[e] = kx[e] * rsn;
            bf16* rec = P.RI + ((size_t)(b * NH + hd) * TPB + tp) * RREC + (ch8 & 63);
            *(GAS v4u*)(rec) = pack8f(r8); *(GAS v4u*)(rec + 64) = pack8f(kk8); *(GAS v4u*)(rec + 128) = pack8f(v8);
#pragma unroll
            for (int d = 0; d < 2; ++d) {
                float ld[8], ke[8], bb[8], gg[8]; float bs = 0.f;
#pragma unroll
                for (int e = 0; e < 8; ++e) { const int t = e >> 2, r = e & 3;
                    ld[e] = -0.60653066f * sigmoidf_(PRM[(3 + d) * 256 + pc + e] + cw_[d][t][r]);
                    const float aa = sigmoidf_(PRM[(5 + d) * 256 + pc + e] + ca_[d][t][r]);
                    ke[e] = kmx[e] * (1.0f + (aa - 1.0f) * PRM[1 * 256 + pc + e]); bb[e] = kk8[e] * aa; gg[e] = cg_[d][t][r];
                    bs += r8[e] * ke[e] * PRM[2 * 256 + pc + e]; }
                *(GAS v4u*)(rec + (3 + 3 * d) * 64) = pack8f(ld); *(GAS v4u*)(rec + (4 + 3 * d) * 64) = pack8f(bb); *(GAS v4u*)(rec + (5 + 3 * d) * 64) = pack8f(ke);
                *(GAS v4u*)(P.GG + ((size_t)d * MALL + m) * RW + ch8) = pack8f(gg);
                bs += bpermf(lane ^ 16, bs); bs += bpermf(lane ^ 32, bs);
                if (q4 == 0) P.BON[((size_t)d * MALL + m) * 32 + 2 * hd + (w & 1)] = bs; }
        }
    }
}

__device__ __forceinline__ void cvt_row_load(f32x4 (&x)[8], const float* src) {
#pragma unroll
    for (int q = 0; q < 8; ++q) x[q] = *(const GAS f32x4*)(src + q * 4);
}
__device__ __forceinline__ void cvt_row_store(const f32x4 (&x)[8], unsigned char* dst, float* scale_slot, int lane) {
    float am = 0.f;
#pragma unroll
    for (int q = 0; q < 8; ++q) am = fmaxf(am, fmaxf(fmaxf(fabsf(x[q].x), fabsf(x[q].y)), fmaxf(fabsf(x[q].z), fabsf(x[q].w))));
    am = fmaxf(wave_max_u(am), 1e-30f);
    const float g = 6.0f / am, inv = am * (1.0f / 6.0f);
    v4u o;
#pragma unroll
    for (int q = 0; q < 4; ++q) { unsigned w = 0u;
        w = __builtin_amdgcn_cvt_scalef32_pk_fp4_f32(w, x[2 * q].x * g, x[2 * q].y * g, 1.0f, 0);
        w = __builtin_amdgcn_cvt_scalef32_pk_fp4_f32(w, x[2 * q].z * g, x[2 * q].w * g, 1.0f, 1);
        w = __builtin_amdgcn_cvt_scalef32_pk_fp4_f32(w, x[2 * q + 1].x * g, x[2 * q + 1].y * g, 1.0f, 2);
        w = __builtin_amdgcn_cvt_scalef32_pk_fp4_f32(w, x[2 * q + 1].z * g, x[2 * q + 1].w * g, 1.0f, 3);
        o[q] = w; }
    *(GAS v4u*)dst = o;
    if (lane == 0) *scale_slot = inv;
}
struct ScanCvt { const float* pu; const float* pv; unsigned char* PU8; unsigned char* PV8; float* SU; float* SV; };
constexpr int SCH = 32;
constexpr int SSTEP = 6 * 64;
__device__ __forceinline__ int scan_tp(int dir, int s) { return dir == 0 ? s : (s < CTXL ? (CTXL - 1 - s) : (TPB - 1 - (s - CTXL))); }
__device__ __forceinline__ void scan_load(v4u (&rg)[6], const bf16* RIh, int dir, int chunk, int htid) {
    const int tp = scan_tp(dir, chunk * SCH + (htid >> 3));
    const bf16* rec = RIh + (size_t)tp * RREC + (htid & 7) * 8;
#pragma unroll
    for (int i = 0; i < 3; ++i) rg[i] = *(const GAS v4u*)(rec + i * 64);
    rec += (3 + 3 * dir) * 64;
#pragma unroll
    for (int i = 0; i < 3; ++i) rg[3 + i] = *(const GAS v4u*)(rec + i * 64);
}
__device__ __forceinline__ void scan_store(const v4u (&rg)[6], LAS float* buf, int htid) {
    LAS float* d0 = buf + (htid >> 3) * SSTEP + (htid & 7) * 8;
#pragma unroll
    for (int i = 0; i < 6; ++i) { constexpr int SLOT[6] = {4, 0, 5, 2, 1, 3};
        const v4u wv = rg[i];
        f32x4 lo = {bflo(wv.x), bfhi(wv.x), bflo(wv.y), bfhi(wv.y)}, hi = {bflo(wv.z), bfhi(wv.z), bflo(wv.w), bfhi(wv.w)};
        if (i == 3) {
#pragma unroll
            for (int e = 0; e < 4; ++e) { lo[e] = __expf(lo[e]); hi[e] = __expf(hi[e]); } }
        LAS float* d = d0 + SLOT[i] * 64;
        *(LAS f32x4*)d = lo; *(LAS f32x4*)(d + 4) = hi; }
}
__device__ __forceinline__ void scan_phase(Frame& F, const bf16* RI, bf16* Y, const ScanCvt& C) {
    LAS float* bufs = (LAS float*)F.lds;
    constexpr int NCH = TPB / SCH;
    for (int uu = F.vcu; uu < NBATCH * NH * 2 * 4; uu += F.G) {
        const int rg = uu & 3, dir = (uu >> 2) & 1, hd = (uu >> 3) & 15, b = uu >> 7;
        const bf16* RIh = RI + (size_t)(b * NH + hd) * TPB * RREC;
        const int htid = F.tid - 256;
        v4u ra[6], rb[6];
        f32x4 xc[8];
        __syncthreads();
        if (F.wave >= 4) { scan_load(rb, RIh, dir, 0, htid); scan_load(ra, RIh, dir, 1, htid); scan_store(rb, bufs, htid); scan_load(rb, RIh, dir, 2, htid); }
        __syncthreads();
        const int j = F.lane & 15, rowl = F.lane >> 4, row = rg * 16 + (F.wave & 3) * 4 + rowl;
        f32x2 S01 = {0.f, 0.f}, S23 = {0.f, 0.f};
        bf16* yb = Y + ((size_t)dir * MALL + (size_t)b * TPB) * RW + hd * 64 + row;
        for (int c = 0; c < NCH; ++c) {
            LAS float* cur = bufs + (c & 1) * (SCH * SSTEP);
            if (F.wave >= 4) {
                if (c + 1 < NCH) {
                    if ((c & 1) == 0) { scan_store(ra, bufs + (SCH * SSTEP), htid); if (c + 3 < NCH) scan_load(ra, RIh, dir, c + 3, htid); }
                    else { scan_store(rb, bufs, htid); if (c + 3 < NCH) scan_load(rb, RIh, dir, c + 3, htid); }  }
                if ((c & 3) == 0 && (c >> 3) < 32) { const int r = uu * 4 + (F.wave - 4) + 1024 * (c >> 3);
                    if ((c & 7) == 0) cvt_row_load(xc, ((r >= NEXP) ? C.pv + (size_t)(r - NEXP) * DM : C.pu + (size_t)r * DM) + F.lane * 32);
                    else cvt_row_store(xc, ((r >= NEXP) ? C.PV8 + (size_t)(r - NEXP) * (DM / 2) : C.PU8 + (size_t)r * (DM / 2)) + F.lane * 16, (r >= NEXP) ? C.SV + (r - NEXP) : C.SU + r, F.lane); } }
            else {
#pragma unroll
                for (int h16 = 0; h16 < 2; ++h16) {
                    const LAS float* sp = cur + (h16 * 16) * SSTEP;
                    f32x4 kk = *(const LAS f32x4*)(sp + 4 * j), bb = *(const LAS f32x4*)(sp + 64 + 4 * j), ww = *(const LAS f32x4*)(sp + 128 + 4 * j),
                          ke = *(const LAS f32x4*)(sp + 192 + 4 * j), rr = *(const LAS f32x4*)(sp + 256 + 4 * j);
                    float ykeep = 0.f, ypart; f32x2 u2, t2, vv; vv.x = sp[320 + row];
#define SCAN_DPP(r, ctl) "v_add_f32_dpp " r ", " r ", " r " " ctl " row_mask:0xf bank_mask:0xf bound_ctrl:1\n\t"
#define SCAN_MAIN(SEL) asm volatile( \
                        "v_pk_mul_f32 v[242:243], %[kexy], %[vv] op_sel_hi:[1,0]\n\t" \
                        "v_add_f32 v246, v250, v251\n\t" \
                        "v_add_f32_dpp v248, %[yp], %[yp] quad_perm:[1,0,3,2] row_mask:0xf bank_mask:0xf bound_ctrl:1\n\t" \
                        "v_pk_mul_f32 v[244:245], %[kezw], %[vv] op_sel_hi:[1,0]\n\t" \
                        SCAN_DPP("v246", "quad_perm:[1,0,3,2]") SCAN_DPP("v248", "quad_perm:[2,3,0,1]") \
                        "v_pk_fma_f32 %[s01], %[s01], %[wwxy], v[242:243]\n\t" \
                        SCAN_DPP("v246", "quad_perm:[2,3,0,1]") SCAN_DPP("v248", "row_half_mirror") \
                        "v_pk_fma_f32 %[s23], %[s23], %[wwzw], v[244:245]\n\t" \
                        SCAN_DPP("v246", "row_half_mirror") SCAN_DPP("v248", "row_mirror") \
                        SEL "\n\t" \
                        SCAN_DPP("v246", "row_mirror") \
                        "v_pk_fma_f32 %[s01], %[bbxy], v[246:247], %[s01] op_sel_hi:[1,0,1] neg_lo:[0,1,0] neg_hi:[0,1,0]\n\t" \
                        "v_pk_fma_f32 %[s23], %[bbzw], v[246:247], %[s23] op_sel_hi:[1,0,1] neg_lo:[0,1,0] neg_hi:[0,1,0]\n\t" \
                        "v_pk_mul_f32 v[252:253], %[s01], %[rrxy]" \
                        : [s01] "+v"(S01), [s23] "+v"(S23), [yk] "+v"(ykeep), "={v[252:253]}"(u2) \
                        : [kexy] "v"(ke.xy), [kezw] "v"(ke.zw), [vv] "v"(vv), [wwxy] "v"(ww.xy), [wwzw] "v"(ww.zw), [bbxy] "v"(bb.xy), [bbzw] "v"(bb.zw), [rrxy] "v"(rr.xy), [yp] "v"(ypart), [msk] "s"(msk), "{v[250:251]}"(t2) \
                        : "v242", "v243", "v244", "v245", "v246", "v247", "v248")
                    asm volatile("v_pk_mul_f32 v[250:251], %[s01], %[kxy]\n\tv_mov_b32 %[yp], 0\n\tv_pk_fma_f32 v[250:251], %[s23], %[kzw], v[250:251]"
                                 : "=&{v[250:251]}"(t2), [yp] "=&v"(ypart) : [s01] "v"(S01), [s23] "v"(S23), [kxy] "v"(kk.xy), [kzw] "v"(kk.zw));
#pragma unroll
                    for (int st = 0; st < 16; ++st) {
                        f32x4 nkk = kk, nbb = bb, nww = ww, nke = ke, nrr = rr; f32x2 nvv = vv;
                        const LAS float* sn = sp + (st + 1) * SSTEP;
                        if (st + 1 < 16) { nkk = *(const LAS f32x4*)(sn + 4 * j); nke = *(const LAS f32x4*)(sn + 192 + 4 * j); nvv.x = sn[320 + row]; nww = *(const LAS f32x4*)(sn + 128 + 4 * j); nbb = *(const LAS f32x4*)(sn + 64 + 4 * j);
                            nrr = *(const LAS f32x4*)(sn + 256 + 4 * j); }
                        const unsigned long long msk = 0x0001000100010001ull << ((st + 15) & 15);
                        if (st > 0) SCAN_MAIN("v_cndmask_b32_e64 %[yk], %[yk], v248, %[msk]"); else SCAN_MAIN("s_nop 0");
                        if (st + 1 < 16)
                            asm volatile("v_pk_mul_f32 v[250:251], %[s01], %[kxy]\n\tv_pk_fma_f32 v[252:253], %[s23], %[rrzw], v[252:253]\n\tv_pk_fma_f32 v[250:251], %[s23], %[kzw], v[250:251]\n\tv_add_f32 %[yp], v252, v253"
                                         : "=&{v[250:251]}"(t2), "={v[252:253]}"(u2), [yp] "=&v"(ypart) : [s01] "v"(S01), [s23] "v"(S23), [kxy] "v"(nkk.xy), [kzw] "v"(nkk.zw), [rrzw] "v"(rr.zw), "1"(u2));
                        else
                            asm volatile("s_nop 0\n\tv_pk_fma_f32 v[252:253], %[s23], %[rrzw], v[252:253]" : "={v[252:253]}"(u2) : [s23] "v"(S23), [rrzw] "v"(rr.zw), "0"(u2));
                        kk = nkk; bb = nbb; ww = nww; ke = nke; rr = nrr; vv = nvv;
                        __builtin_amdgcn_sched_barrier(0);
                    }
#undef SCAN_MAIN
#undef SCAN_DPP
                    { const float y = red16(u2.x + u2.y); ykeep = (j == 15) ? y : ykeep; }
                    const int tp = scan_tp(dir, c * SCH + h16 * 16 + j);
                    *(GAS bf16*)(yb + (size_t)tp * RW) = (bf16)f2bf(ykeep);
                }
            }
            __syncthreads();
        }
    }
}

constexpr int AKP = 208, AVP = 192;
constexpr int ATILE = 64 * AKP + 64 * AVP;
__device__ __forceinline__ bf16x8 pack8(const f32x16& x, int s) {
    v4u p; p.x = pk2(x[8 * s + 0], x[8 * s + 1]); p.y = pk2(x[8 * s + 2], x[8 * s + 3]); p.z = pk2(x[8 * s + 4], x[8 * s + 5]); p.w = pk2(x[8 * s + 6], x[8 * s + 7]);
    return __builtin_bit_cast(bf16x8, p);
}
__device__ __forceinline__ void attn_phase(Frame& F, const bf16* Q, const bf16* K, const bf16* V, bf16* YB, int with_ctx) {
    const int lane = F.lane, half = lane >> 5, l31 = lane & 31, l16 = lane & 15, g1 = (lane >> 4) & 1;
    const int nunits = NBATCH * NH * 32 + (with_ctx ? NBATCH * NH : 0);
    for (int uu = F.vcu; uu < nunits; uu += F.G) {
        int bh, q0, nkt;
        if (uu < NBATCH * NH * 32) { bh = uu >> 5; q0 = CTXL + (uu & 31) * 256; nkt = TPB / 64; } else { bh = uu - NBATCH * NH * 32; q0 = 0; nkt = CTXL / 64; }
        const bf16* Kh = K + (size_t)bh * TPB * QKD; const bf16* Vh = V + (size_t)bh * TPB * 64; const bf16* Qh = Q + (size_t)bh * TPB * QKD;
        const int tq = q0 + F.wave * 32 + l31;
        bf16x8 qf[6];
#pragma unroll
        for (int ks = 0; ks < 6; ++ks) qf[ks] = *(const GAS bf16x8*)(Qh + (size_t)tq * QKD + 16 * ks + 8 * half);
        f32x16 o0, o1;
#pragma unroll
        for (int i = 0; i < 16; ++i) { o0[i] = 0.f; o1[i] = 0.f; }
        float l_run = 0.f;
        f32x16 cinit;
#pragma unroll
        for (int i = 0; i < 16; ++i) cinit[i] = 0.f;
        asm volatile("" : "+v"(cinit));
        const int kc1 = F.tid + 512; const bool k1ok = kc1 < 768;
        const unsigned kd0 = (unsigned)((F.tid / 12) * AKP + (F.tid % 12) * 16), kd1 = (unsigned)((kc1 / 12) * AKP + (kc1 % 12) * 16), vd = (unsigned)(64 * AKP + (F.tid >> 3) * AVP + (F.tid & 7) * 16);
        v4u kr0, kr1 = {0, 0, 0, 0}, vr;
        kr0 = *(const GAS v4u*)(Kh + (size_t)F.tid * 8); if (k1ok) kr1 = *(const GAS v4u*)(Kh + (size_t)kc1 * 8); vr = *(const GAS v4u*)(Vh + (size_t)F.tid * 8);
        __syncthreads();
        *(LAS v4u*)(F.lds + kd0) = kr0; if (k1ok) *(LAS v4u*)(F.lds + kd1) = kr1; *(LAS v4u*)(F.lds + vd) = vr;
        __syncthreads();
        for (int kt = 0; kt < nkt; ++kt) {
            const bool more = kt + 1 < nkt;
            if (more) { const bf16* kn = Kh + (size_t)(kt + 1) * 64 * QKD; const bf16* vn = Vh + (size_t)(kt + 1) * 64 * 64;
                kr0 = *(const GAS v4u*)(kn + (size_t)F.tid * 8); if (k1ok) kr1 = *(const GAS v4u*)(kn + (size_t)kc1 * 8); vr = *(const GAS v4u*)(vn + (size_t)F.tid * 8); }
            LAS unsigned char* Kb = F.lds + (kt & 1) * ATILE; LAS unsigned char* Vb = Kb + 64 * AKP;
            f32x16 s0, s1;
            { bf16x8 ka[6], kb2[6];
#pragma unroll
              for (int ks = 0; ks < 6; ++ks) { ka[ks] = *(const LAS bf16x8*)(Kb + l31 * AKP + (16 * ks + 8 * half) * 2); kb2[ks] = *(const LAS bf16x8*)(Kb + (32 + l31) * AKP + (16 * ks + 8 * half) * 2); }
              s0 = MFMA32(ka[0], qf[0], cinit); s1 = MFMA32(kb2[0], qf[0], cinit);
#pragma unroll
              for (int ks = 1; ks < 6; ++ks) { s0 = MFMA32(ka[ks], qf[ks], s0); s1 = MFMA32(kb2[ks], qf[ks], s1); }
              __builtin_amdgcn_sched_group_barrier(0x100, 12, 0); __builtin_amdgcn_sched_group_barrier(0x8, 12, 0); }
            bf16x8 va[2][2][2];
#pragma unroll
            for (int t = 0; t < 2; ++t)
#pragma unroll
                for (int s = 0; s < 2; ++s) { const int kb = 32 * t + 16 * s + 4 * half + (l16 >> 2);
#pragma unroll
                    for (int dvt = 0; dvt < 2; ++dvt) { const LAS unsigned char* vp = Vb + kb * AVP + (32 * dvt + 16 * g1 + 4 * (l16 & 3)) * 2;
                        const s16x4 lo = __builtin_amdgcn_ds_read_tr16_b64_v4i16((LAS s16x4*)vp), hi = __builtin_amdgcn_ds_read_tr16_b64_v4i16((LAS s16x4*)(vp + 8 * AVP));
                        va[t][s][dvt] = __builtin_shufflevector(lo, hi, 0, 1, 2, 3, 4, 5, 6, 7); } }
            __builtin_amdgcn_sched_group_barrier(0x100, 16, 0);
            float mx = s0[0];
#pragma unroll
            for (int i = 1; i < 16; ++i) mx = fmaxf(mx, s0[i]);
#pragma unroll
            for (int i = 0; i < 16; ++i) mx = fmaxf(mx, s1[i]);
            mx = fmaxf(mx, bpermf(lane ^ 32, mx));
            if (kt == 0 || __any(mx > 8.0f)) {
                const float d = (kt == 0) ? mx : fmaxf(mx, 0.f), alpha = (kt == 0) ? 1.0f : __builtin_amdgcn_exp2f(-d);
                l_run *= alpha;
#pragma unroll
                for (int i = 0; i < 16; ++i) { o0[i] *= alpha; o1[i] *= alpha; s0[i] -= d; s1[i] -= d; cinit[i] -= d; }
                asm volatile("" : "+v"(cinit));
            }
#pragma unroll
            for (int i = 0; i < 16; ++i) { s0[i] = __builtin_amdgcn_exp2f(s0[i]); s1[i] = __builtin_amdgcn_exp2f(s1[i]); }
            float ps = 0.f;
#pragma unroll
            for (int i = 0; i < 16; ++i) ps += s0[i] + s1[i];
            l_run += ps;
            { bf16x8 pf[2][2];
#pragma unroll
              for (int t = 0; t < 2; ++t)
#pragma unroll
                  for (int s = 0; s < 2; ++s) pf[t][s] = pack8(t == 0 ? s0 : s1, s);
#pragma unroll
              for (int t = 0; t < 2; ++t)
#pragma unroll
                  for (int s = 0; s < 2; ++s) { o0 = MFMA32(va[t][s][0], pf[t][s], o0); o1 = MFMA32(va[t][s][1], pf[t][s], o1); } }
            if (more) { LAS unsigned char* nb = F.lds + ((kt + 1) & 1) * ATILE;
                *(LAS v4u*)(nb + kd0) = kr0; if (k1ok) *(LAS v4u*)(nb + kd1) = kr1; *(LAS v4u*)(nb + vd) = vr; }
            __syncthreads();
        }
        const float linv = (DBG_SKIP & 4) ? 0.f : 1.0f / (l_run + bpermf(lane ^ 32, l_run));
        const int b = bh >> 4, hd = bh & 15;
        bf16* op = YB + ((size_t)b * TPB + tq) * RW + hd * 64 + 4 * half;
#pragma unroll
        for (int g = 0; g < 4; ++g) {
            v2u w; w.x = pk2(o0[4 * g] * linv, o0[4 * g + 1] * linv); w.y = pk2(o0[4 * g + 2] * linv, o0[4 * g + 3] * linv); *(GAS v2u*)(op + 8 * g) = w;
            w.x = pk2(o1[4 * g] * linv, o1[4 * g + 1] * linv); w.y = pk2(o1[4 * g + 2] * linv, o1[4 * g + 3] * linv); *(GAS v2u*)(op + 32 + 8 * g) = w; }
    }
}

struct RoRaw { v4u va, vc, ya[2], yc[2], ga[2], gc[2]; float b0[2], b1[2]; };
__device__ __forceinline__ void readout_load(RoRaw& r, int m, int lane, const bf16* Y, const bf16* GG, const float* BON, const bf16* RI) {
    const int hd = lane >> 2, ch0 = hd * 64 + (lane & 3) * 16, b = m / TPB, tp = m - b * TPB;
    const bf16* rec = RI + ((size_t)(b * NH + hd) * TPB + tp) * RREC + 128 + (lane & 3) * 16;
    r.va = *(const GAS v4u*)rec; r.vc = *(const GAS v4u*)(rec + 8);
#pragma unroll
    for (int d = 0; d < 2; ++d) { const bf16* yp = Y + ((size_t)d * MALL + m) * RW + ch0; const bf16* gp = GG + ((size_t)d * MALL + m) * RW + ch0;
        r.ya[d] = *(const GAS v4u*)yp; r.yc[d] = *(const GAS v4u*)(yp + 8); r.ga[d] = *(const GAS v4u*)gp; r.gc[d] = *(const GAS v4u*)(gp + 8);
        r.b0[d] = BON[((size_t)d * MALL + m) * 32 + 2 * hd]; r.b1[d] = BON[((size_t)d * MALL + m) * 32 + 2 * hd + 1]; }
}
__device__ __forceinline__ void readout_phase(Frame& F, const bf16* Y, const bf16* GG, const float* BON, const bf16* RI, const float* ln_w, const float* ln_b, bf16* YA) {
    const int gw = F.vcu * NWAVES + F.wave, NGW = F.G * NWAVES, lane = F.lane, hd = lane >> 2, ch0 = hd * 64 + (lane & 3) * 16;
    RoRaw cur, nxt;
    if (gw < MALL) readout_load(cur, gw, lane, Y, GG, BON, RI);
    for (int m = gw; m < MALL; m += NGW) {
        if (m + NGW < MALL) readout_load(nxt, m + NGW, lane, Y, GG, BON, RI);
        float vv[16], out[16];
        unpack8(cur.va, *(float(*)[8])&vv[0]); unpack8(cur.vc, *(float(*)[8])&vv[8]);
#pragma unroll
        for (int e = 0; e < 16; ++e) out[e] = 0.f;
#pragma unroll
        for (int d = 0; d < 2; ++d) {
            float y[16], g[16];
            unpack8(cur.ya[d], *(float(*)[8])&y[0]); unpack8(cur.yc[d], *(float(*)[8])&y[8]); unpack8(cur.ga[d], *(float(*)[8])&g[0]); unpack8(cur.gc[d], *(float(*)[8])&g[8]);
            float s = 0.f;
#pragma unroll
            for (int e = 0; e < 16; ++e) s += y[e];
            s = dpp_add<0xB1>(s); s = dpp_add<0x4E>(s);
            const float mean = s * (1.f / 64.f); float q = 0.f;
#pragma unroll
            for (int e = 0; e < 16; ++e) { y[e] -= mean; q += y[e] * y[e]; }
            q = dpp_add<0xB1>(q); q = dpp_add<0x4E>(q);
            const float rstd = rsqrtf(q * (1.f / 64.f) + 64e-5f), bon = cur.b0[d] + cur.b1[d];
#pragma unroll
            for (int e = 0; e < 16; ++e) out[e] += (y[e] * rstd * ln_w[ch0 + e] + ln_b[ch0 + e] + bon * vv[e]) * g[e];
        }
        if (DBG_SKIP & 2) {
#pragma unroll
            for (int e = 0; e < 16; ++e) out[e] = 0.f; }
        v4u o0, o1;
        o0.x = pk2(out[0], out[1]); o0.y = pk2(out[2], out[3]); o0.z = pk2(out[4], out[5]); o0.w = pk2(out[6], out[7]);
        o1.x = pk2(out[8], out[9]); o1.y = pk2(out[10], out[11]); o1.z = pk2(out[12], out[13]); o1.w = pk2(out[14], out[15]);
        *(GAS v4u*)(YA + (size_t)m * RW + ch0) = o0; *(GAS v4u*)(YA + (size_t)m * RW + ch0 + 8) = o1;
        cur = nxt;
    }
}


__device__ __forceinline__ unsigned f2key(float f) { const unsigned u = __builtin_bit_cast(unsigned, f); return (u & 0x80000000u) ? ~u : (u | 0x80000000u); }
__device__ __forceinline__ float key2f(unsigned k) { const unsigned u = (k & 0x80000000u) ? (k & 0x7fffffffu) : ~k; return __builtin_bit_cast(float, u); }
template <int CTRL, int RM> __device__ __forceinline__ unsigned dpp_umax(unsigned x) {
    const unsigned y = (unsigned)__builtin_amdgcn_update_dpp(0, (int)x, CTRL, RM, 0xf, false); return x > y ? x : y; }
__device__ __forceinline__ unsigned row_umax(unsigned x) { x = dpp_umax<0xB1, 0xf>(x); x = dpp_umax<0x4E, 0xf>(x); x = dpp_umax<0x141, 0xf>(x); x = dpp_umax<0x140, 0xf>(x); return x; }
#define SEL_CE(a_, b_) do { const unsigned hi_ = (a_) > (b_) ? (a_) : (b_), lo_ = (a_) > (b_) ? (b_) : (a_); (a_) = hi_; (b_) = lo_; } while (0)
__device__ __forceinline__ void sel_keys8(unsigned (&k)[8], const float* p, int id0) {
    const f32x4 v0 = *(const GAS f32x4*)p, v1 = *(const GAS f32x4*)(p + 4);
    k[0] = (f2key(v0.x) & ~127u) | (unsigned)(id0 + 0); k[1] = (f2key(v0.y) & ~127u) | (unsigned)(id0 + 1); k[2] = (f2key(v0.z) & ~127u) | (unsigned)(id0 + 2); k[3] = (f2key(v0.w) & ~127u) | (unsigned)(id0 + 3);
    k[4] = (f2key(v1.x) & ~127u) | (unsigned)(id0 + 4); k[5] = (f2key(v1.y) & ~127u) | (unsigned)(id0 + 5); k[6] = (f2key(v1.z) & ~127u) | (unsigned)(id0 + 6); k[7] = (f2key(v1.w) & ~127u) | (unsigned)(id0 + 7);
    SEL_CE(k[0], k[1]); SEL_CE(k[2], k[3]); SEL_CE(k[4], k[5]); SEL_CE(k[6], k[7]); SEL_CE(k[0], k[2]); SEL_CE(k[1], k[3]); SEL_CE(k[4], k[6]); SEL_CE(k[5], k[7]); SEL_CE(k[1], k[2]); SEL_CE(k[5], k[6]);
    SEL_CE(k[0], k[4]); SEL_CE(k[1], k[5]); SEL_CE(k[2], k[6]); SEL_CE(k[3], k[7]); SEL_CE(k[2], k[4]); SEL_CE(k[3], k[5]); SEL_CE(k[1], k[2]); SEL_CE(k[3], k[4]); SEL_CE(k[5], k[6]);
}
__device__ __forceinline__ void top16_rows2(const float* pa, const float* pb, int l16, unsigned& ra, unsigned& rb) {
    unsigned ka[8], kb[8]; sel_keys8(ka, pa + 8 * l16, 8 * l16); sel_keys8(kb, pb + 8 * l16, 8 * l16);
    ra = 0u; rb = 0u;
#pragma unroll
    for (int it = 0; it < 16; ++it) {
        const unsigned ma = row_umax(ka[0]), mb = row_umax(kb[0]); const bool oa = ka[0] == ma, ob = kb[0] == mb;
#pragma unroll
        for (int e = 0; e < 7; ++e) { ka[e] = oa ? ka[e + 1] : ka[e]; kb[e] = ob ? kb[e + 1] : kb[e]; }
        ka[7] = oa ? 0u : ka[7]; kb[7] = ob ? 0u : kb[7];
        ra = (l16 == it) ? ma : ra; rb = (l16 == it) ? mb : rb;
    }
}
struct SelP { const float* SC; int* ESEL; float* EGATE; int last; };
__device__ __forceinline__ void select_token(const float* srow, int lane, int (&eidx)[2], float (&egate)[2]) {
    const int row = lane >> 4, l16 = lane & 15, rbase = lane & 48;
    const int i1 = (int)((0x3332222211111111ull >> (4 * l16)) & 15ull), j1 = (int)((0x2104321076543210ull >> (4 * l16)) & 15ull), i2 = (int)((0xdcba987766554443ull >> (4 * l16)) & 15ull), j2 = (int)((0x0000001010102103ull >> (4 * l16)) & 15ull);
#pragma unroll
    for (int G = 0; G < 2; ++G) {
                const float* hrow = srow + (4 * G + row) * 256;
                unsigned recA, recB; top16_rows2(hrow, hrow + 128, l16, recA, recB);
                const float va = key2f(recA & ~127u), vb = key2f(recB & ~127u);
                const float a0 = bpermf(rbase, va), a1 = bpermf(rbase + i1, va), b1 = bpermf(rbase + j1, vb), a2 = bpermf(rbase + i2, va), b2 = bpermf(rbase + j2, vb), a3 = bpermf(rbase + 14 + (l16 & 1), va), b0 = bpermf(rbase, vb);
                unsigned ck[4];
                ck[0] = (f2key(a0 + vb) & ~255u) | (unsigned)l16; ck[1] = (f2key(a1 + b1) & ~255u) | (unsigned)(16 * i1 + j1); ck[2] = (f2key(a2 + b2) & ~255u) | (unsigned)(16 * i2 + j2);
                ck[3] = (l16 < 2) ? ((f2key(a3 + b0) & ~255u) | (unsigned)(16 * (14 + l16))) : 0u;
                SEL_CE(ck[0], ck[1]); SEL_CE(ck[2], ck[3]); SEL_CE(ck[0], ck[2]); SEL_CE(ck[1], ck[3]); SEL_CE(ck[1], ck[2]);
                unsigned rec = 0u;
#pragma unroll
                for (int it = 0; it < 16; ++it) {
                    const unsigned mh = row_umax(ck[0]); const bool own = ck[0] == mh;
                    ck[0] = own ? ck[1] : ck[0]; ck[1] = own ? ck[2] : ck[1]; ck[2] = own ? ck[3] : ck[2]; ck[3] = own ? 0u : ck[3];
                    rec = (l16 == it) ? mh : rec;
                }
                const float ts = key2f(rec & ~255u), tmax = bpermf(rbase, ts);
                const float ev = __expf(ts - tmax), esum = red16(ev);
                const int ci = (int)((rec >> 4) & 15u), cj = (int)(rec & 15u);
                const int expert = bpermi(rbase + ci, (int)(recA & 127u)) * 128 + bpermi(rbase + cj, (int)(recB & 127u));
                eidx[G] = expert; egate[G] = ev / esum;
    }
}
__device__ __forceinline__ void select_phase(Frame& F, const SelP& P) {
    const int gw = F.vcu * NWAVES + F.wave, NGW = F.G * NWAVES, lane = F.lane, row = lane >> 4, l16 = lane & 15, rbase = lane & 48;
    const int i1 = (int)((0x3332222211111111ull >> (4 * l16)) & 15ull), j1 = (int)((0x2104321076543210ull >> (4 * l16)) & 15ull), i2 = (int)((0xdcba987766554443ull >> (4 * l16)) & 15ull), j2 = (int)((0x0000001010102103ull >> (4 * l16)) & 15ull);
    for (int m = gw; m < MALL; m += NGW) {
        bool tok = true; int tp = 0; if (tok) { tp = m % TPB; if (P.last && tp < CTXL) tok = false; }
        if (tok) {
            const float* srow = P.SC + (size_t)m * DM;
#pragma unroll 1
            for (int G = 0; G < 2; ++G) {
                const float* hrow = srow + (4 * G + row) * 256;
                unsigned recA, recB; top16_rows2(hrow, hrow + 128, l16, recA, recB);
                const float va = key2f(recA & ~127u), vb = key2f(recB & ~127u);
                const float a0 = bpermf(rbase, va), a1 = bpermf(rbase + i1, va), b1 = bpermf(rbase + j1, vb), a2 = bpermf(rbase + i2, va), b2 = bpermf(rbase + j2, vb), a3 = bpermf(rbase + 14 + (l16 & 1), va), b0 = bpermf(rbase, vb);
                unsigned ck[4];
                ck[0] = (f2key(a0 + vb) & ~255u) | (unsigned)l16; ck[1] = (f2key(a1 + b1) & ~255u) | (unsigned)(16 * i1 + j1); ck[2] = (f2key(a2 + b2) & ~255u) | (unsigned)(16 * i2 + j2);
                ck[3] = (l16 < 2) ? ((f2key(a3 + b0) & ~255u) | (unsigned)(16 * (14 + l16))) : 0u;
                SEL_CE(ck[0], ck[1]); SEL_CE(ck[2], ck[3]); SEL_CE(ck[0], ck[2]); SEL_CE(ck[1], ck[3]); SEL_CE(ck[1], ck[2]);
                unsigned rec = 0u;
#pragma unroll
                for (int it = 0; it < 16; ++it) {
                    const unsigned mh = row_umax(ck[0]); const bool own = ck[0] == mh;
                    ck[0] = own ? ck[1] : ck[0]; ck[1] = own ? ck[2] : ck[1]; ck[2] = own ? ck[3] : ck[2]; ck[3] = own ? 0u : ck[3];
                    rec = (l16 == it) ? mh : rec;
                }
                const float ts = key2f(rec & ~255u), tmax = bpermf(rbase, ts);
                const float ev = __expf(ts - tmax), esum = red16(ev);
                const int ci = (int)((rec >> 4) & 15u), cj = (int)(rec & 15u);
                const int expert = bpermi(rbase + ci, (int)(recA & 127u)) * 128 + bpermi(rbase + cj, (int)(recB & 127u));
                const int slot = (4 * G + row) * 16 + l16; P.ESEL[(size_t)m * 128 + slot] = expert; P.EGATE[(size_t)m * 128 + slot] = ev / esum;
            }
        }
    }
}
struct PeerP { const float* SC; const float* nmod; const float* ng; bf16* Hout;   const int* ESEL; const float* EGATE; const bf16* H; const unsigned char* PU; const unsigned char* PV; const float* SU; const float* SV; float* X; const float* mod;   const float* fin_g; float* out; int last; int dry; };
__device__ __forceinline__ void peer_phase(Frame& F, const PeerP& P) {
    const int gw = F.vcu * NWAVES + F.wave, NGW = F.G * NWAVES, lane = F.lane;
    float pr_s2 = 0.f, pr_d2 = 0.f, pr_tg = 0.f, pr_n = 0.f;
    int m0 = gw; while (m0 < MALL && P.last && (m0 % TPB) < CTXL) m0 += NGW;
    v4u ph0 = {0u, 0u, 0u, 0u}, ph1 = ph0, ph2 = ph0, ph3 = ph0;
    if (m0 < MALL) { const bf16* hp = P.H + (size_t)m0 * DM + lane * 32; ph0 = *(const GAS v4u*)hp; ph1 = *(const GAS v4u*)(hp + 8); ph2 = *(const GAS v4u*)(hp + 16); ph3 = *(const GAS v4u*)(hp + 24); }
    for (int m = m0, mn = 0; m < MALL; m = mn) {
        mn = m + NGW; while (mn < MALL && P.last && (mn % TPB) < CTXL) mn += NGW;
        const int b = m / TPB, tp = m - b * TPB;
        const int mr = tp < CTXL ? 2 : b;
        const int emask_ = (P.dry & 2) ? 1023 : 0x7fffffff;
        int eidx[2]; float egate[2]; select_token(P.SC + (size_t)m * DM, lane, eidx, egate);
        eidx[0] &= emask_; eidx[1] &= emask_;
        typedef int v8i __attribute__((ext_vector_type(8)));
        LAS unsigned char* hq = F.lds + F.wave * 4096;
        { const v4u hv[4] = {ph0, ph1, ph2, ph3}; v4u o[2];
#pragma unroll
          for (int j = 0; j < 4; ++j) { int w0 = 0, w1 = 0;
              w0 = __builtin_amdgcn_cvt_pk_fp8_f32(bflo(hv[j].x), bfhi(hv[j].x), w0, false); w0 = __builtin_amdgcn_cvt_pk_fp8_f32(bflo(hv[j].y), bfhi(hv[j].y), w0, true);
              w1 = __builtin_amdgcn_cvt_pk_fp8_f32(bflo(hv[j].z), bfhi(hv[j].z), w1, false); w1 = __builtin_amdgcn_cvt_pk_fp8_f32(bflo(hv[j].w), bfhi(hv[j].w), w1, true);
              o[j >> 1][2 * (j & 1)] = (unsigned)w0; o[j >> 1][2 * (j & 1) + 1] = (unsigned)w1; }
          *(LAS v4u*)(hq + lane * 32) = o[0]; *(LAS v4u*)(hq + lane * 32 + 16) = o[1];
          unsigned z_ = 0u; asm volatile("" : "+v"(z_));
          if (lane < 2) *(LAS v4u*)(hq + 2048 + lane * 16) = (v4u){z_, z_, z_, z_}; }
        const int li = lane & 15, kb = lane >> 4;
        int rowoff[8];
#pragma unroll
        for (int g = 0; g < 8; ++g) rowoff[g] = bpermi(16 * (g & 3) + li, eidx[g >> 2]) * (DM / 2) + 16 * kb;
        f32x4 dacc[8];
#pragma unroll
        for (int g = 0; g < 8; ++g) dacc[g] = (f32x4){0.f, 0.f, 0.f, 0.f};
        const unsigned hb = (li == 0) ? (unsigned)(16 * kb) : 2048u;
        const unsigned hb2 = (li == 0) ? 64u : 16u;
        const unsigned hstep = (li == 0) ? 128u : 0u;
        v4u ua[8], ub[8];
#pragma unroll
        for (int g = 0; g < 8; ++g) ua[g] = *(const GAS v4u*)(P.PU + (unsigned)rowoff[g]);
#pragma unroll 1
        for (int s = 0; s < ((P.dry & 4) ? 2 : 16); s += 2) {
#pragma unroll
            for (int g = 0; g < 8; ++g) ub[g] = *(const GAS v4u*)(P.PU + (unsigned)(rowoff[g] + 64 * (s + 1)));
            { const v4u b0 = *(const LAS v4u*)(hq + hb + hstep * s), b1 = *(const LAS v4u*)(hq + hb + hstep * s + hb2);
              const v8i bf = {(int)b0.x, (int)b0.y, (int)b0.z, (int)b0.w, (int)b1.x, (int)b1.y, (int)b1.z, (int)b1.w};
#pragma unroll
              for (int g = 0; g < 8; ++g) { const v8i af = {(int)ua[g].x, (int)ua[g].y, (int)ua[g].z, (int)ua[g].w, 0, 0, 0, 0};
                  dacc[g] = __builtin_amdgcn_mfma_scale_f32_16x16x128_f8f6f4(af, bf, dacc[g], 4, 0, 0, 0x7f7f7f7f, 0, 0x7f7f7f7f); } }
            if (s + 2 < 16) {
#pragma unroll
                for (int g = 0; g < 8; ++g) ua[g] = *(const GAS v4u*)(P.PU + (unsigned)(rowoff[g] + 64 * (s + 2))); }
            { const v4u b0 = *(const LAS v4u*)(hq + hb + hstep * (s + 1)), b1 = *(const LAS v4u*)(hq + hb + hstep * (s + 1) + hb2);
              const v8i bf = {(int)b0.x, (int)b0.y, (int)b0.z, (int)b0.w, (int)b1.x, (int)b1.y, (int)b1.z, (int)b1.w};
#pragma unroll
              for (int g = 0; g < 8; ++g) { const v8i af = {(int)ub[g].x, (int)ub[g].y, (int)ub[g].z, (int)ub[g].w, 0, 0, 0, 0};
                  dacc[g] = __builtin_amdgcn_mfma_scale_f32_16x16x128_f8f6f4(af, bf, dacc[g], 4, 0, 0, 0x7f7f7f7f, 0, 0x7f7f7f7f); } }
        }
        float coef[2];
#pragma unroll
        for (int sl = 0; sl < 2; ++sl) { float mydot = 0.f;
#pragma unroll
            for (int g4 = 0; g4 < 4; ++g4)
#pragma unroll
                for (int r = 0; r < 4; ++r) { const float t = bpermf(16 * ((lane >> 2) & 3), dacc[4 * sl + g4][r]); if ((lane >> 4) == g4 && (lane & 3) == r) mydot = t; }
            mydot *= P.SU[eidx[sl]];
            if (DBG_PROBE == 4) {
                float ref = 0.f;
                for (int e = 0; e < 64; ++e) { const int ex = __builtin_amdgcn_readlane(eidx[sl], e); const v4u uu = *(const GAS v4u*)(P.PU + (size_t)ex * (DM / 2) + lane * 16); float s1 = 0.f;
                    const v4u hv2[4] = {*(const GAS v4u*)(P.H + (size_t)m * DM + lane * 32), *(const GAS v4u*)(P.H + (size_t)m * DM + lane * 32 + 8), *(const GAS v4u*)(P.H + (size_t)m * DM + lane * 32 + 16), *(const GAS v4u*)(P.H + (size_t)m * DM + lane * 32 + 24)};
#pragma unroll
                    for (int d = 0; d < 4; ++d) { const unsigned w = uu[d]; const unsigned hw[4] = {hv2[d].x, hv2[d].y, hv2[d].z, hv2[d].w};
                        f32x2 x = __builtin_amdgcn_cvt_scalef32_pk_f32_fp4(w, 1.0f, 0); s1 += x.x * bflo(hw[0]) + x.y * bfhi(hw[0]); x = __builtin_amdgcn_cvt_scalef32_pk_f32_fp4(w, 1.0f, 1); s1 += x.x * bflo(hw[1]) + x.y * bfhi(hw[1]);
                        x = __builtin_amdgcn_cvt_scalef32_pk_f32_fp4(w, 1.0f, 2); s1 += x.x * bflo(hw[2]) + x.y * bfhi(hw[2]); x = __builtin_amdgcn_cvt_scalef32_pk_f32_fp4(w, 1.0f, 3); s1 += x.x * bflo(hw[3]) + x.y * bfhi(hw[3]); }
                    const float tot = wave_sum_u(s1) * P.SU[ex]; if (lane == e) ref = tot; }
                pr_s2 = fmaxf(pr_s2, wave_max_u(fabsf(mydot - ref) / (fabsf(ref) + 0.25f))); pr_n = 1.f; }
            coef[sl] = egate[sl] * 0.5f * mydot * (1.0f + erff(mydot * 0.70710678f));
            if ((DBG_SKIP & 16) && sl == 0) coef[sl] = 0.f;
            if ((DBG_SKIP & 32) && sl == 1) coef[sl] = 0.f;
        }
        const float coefs[2] = {coef[0] * P.SV[eidx[0]], coef[1] * P.SV[eidx[1]]};
        f32x2 acc2[16];
#pragma unroll
        for (int i = 0; i < 16; ++i) acc2[i] = (f32x2){0.f, 0.f};
#define PEER_LOADV(U, C, e0_) do { const int e1_ = (e0_); const int ev_ = (e1_ & 64) ? eidx[1] : eidx[0]; const int cv_ = __builtin_bit_cast(int, (e1_ & 64) ? coefs[1] : coefs[0]); \
            _Pragma("unroll") for (int q = 0; q < 8; ++q) { const int ex = __builtin_amdgcn_readlane(ev_, (e1_ & 63) + q); U[q] = *(const GAS v4u*)(P.PV + (size_t)ex * (DM / 2) + lane * 16); \
            C[q] = __builtin_bit_cast(float, __builtin_amdgcn_readlane(cv_, (e1_ & 63) + q)); } } while (0)
#define PEER_AXPY(U, C) do { if (P.dry & 32) { _Pragma("unroll") for (int q = 0; q < 8; ++q) _Pragma("unroll") for (int d = 0; d < 4; ++d) acc2[d].x += __builtin_bit_cast(float, U[q][d] & 0x3fffffffu) * C[q]; } else \
            _Pragma("unroll") for (int q = 0; q < 8; ++q) _Pragma("unroll") for (int d = 0; d < 4; ++d) { const unsigned w = U[q][d]; \
            acc2[4 * d + 0] = __builtin_amdgcn_cvt_scalef32_pk_f32_fp4(w, 1.0f, 0) * C[q] + acc2[4 * d + 0]; acc2[4 * d + 1] = __builtin_amdgcn_cvt_scalef32_pk_f32_fp4(w, 1.0f, 1) * C[q] + acc2[4 * d + 1]; \
            acc2[4 * d + 2] = __builtin_amdgcn_cvt_scalef32_pk_f32_fp4(w, 1.0f, 2) * C[q] + acc2[4 * d + 2]; acc2[4 * d + 3] = __builtin_amdgcn_cvt_scalef32_pk_f32_fp4(w, 1.0f, 3) * C[q] + acc2[4 * d + 3]; } } while (0)
        if (mn < MALL) {
            const bf16* hp = P.H + (size_t)mn * DM + lane * 32; ph0 = *(const GAS v4u*)hp; ph1 = *(const GAS v4u*)(hp + 8); ph2 = *(const GAS v4u*)(hp + 16); ph3 = *(const GAS v4u*)(hp + 24); }
        f32x4 xpre[8];
        { const float* xr0 = P.X + (size_t)m * DM + lane * 32;
#pragma unroll
          for (int hq = 0; hq < 8; ++hq) xpre[hq] = *(const GAS f32x4*)(xr0 + hq * 4); }
        {
            v4u ua[8], ub[8]; float ca[8], cb[8];
            PEER_LOADV(ua, ca, 0);
#pragma unroll 1
            for (int it = 0; it < ((P.dry & 8) ? 2 : 8); ++it) {
                PEER_LOADV(ub, cb, 16 * it + 8); PEER_AXPY(ua, ca);
                if (it < 7) PEER_LOADV(ua, ca, 16 * it + 16);
                PEER_AXPY(ub, cb);
            }
        }
#undef PEER_LOADV
#undef PEER_AXPY
        float acc[32];
#pragma unroll
        for (int i = 0; i < 16; ++i) { acc[2 * i] = acc2[i].x; acc[2 * i + 1] = acc2[i].y; }
        if (P.dry) { float sm_ = 0.f;
#pragma unroll
            for (int i = 0; i < 32; ++i) sm_ += acc[i];
            if (sm_ == 1.2345e-30f) P.X[lane] = sm_;
            if (!(P.dry & 16)) continue; }
        if (DBG_SKIP & 1) {
#pragma unroll
            for (int i = 0; i < 32; ++i) acc[i] = 0.f; }
        if (((DBG_SKIP & 64) && !P.last) || ((DBG_SKIP & 128) && P.last)) {
#pragma unroll
            for (int i = 0; i < 32; ++i) acc[i] = 0.f; }
        if (DBG_SKIP & 8) {
#pragma unroll
            for (int i = 0; i < 32; ++i) acc[i] = -acc[i]; }
        int m_l = m, lane_l = lane; asm volatile("" : "+v"(m_l), "+v"(lane_l));
        const int b_l = m_l / TPB, tp_l = m_l - b_l * TPB, mr_l = tp_l < CTXL ? 2 : b_l;
        float* xr = P.X + (size_t)m_l * DM + lane_l * 32; const float* g2 = P.mod + (size_t)mr_l * 12288 + 5 * DM + lane_l * 32;
        float ss = 0.f;
#pragma unroll
        for (int hq = 0; hq < 8; ++hq) { const int c = hq * 4;
            f32x4 xv = xpre[hq]; const f32x4 gv = *(const GAS f32x4*)(g2 + c);
#pragma unroll
            for (int e = 0; e < 4; ++e) { xv[e] += gv[e] * acc[4 * hq + e]; ss += xv[e] * xv[e]; acc[4 * hq + e] = xv[e]; }
            if (!P.last) *(GAS f32x4*)((P.dry ? (float*)(F.ws + 760 * MiB) + (size_t)m_l * DM + lane_l * 32 : xr) + c) = xv; }
        if (!P.last) {
            const float rs = rsqrtf(wave_sum(ss) * (1.f / DM) + NORM_EPS); const float* sh = P.nmod + (size_t)mr_l * 12288 + lane_l * 32; const float* sc = sh + DM; const float* ngp = P.ng + lane_l * 32;
            bf16* ho = (P.dry ? (bf16*)(F.ws + 892 * MiB) : P.Hout) + (size_t)m_l * DM + lane_l * 32;
#pragma unroll
            for (int hq = 0; hq < 4; ++hq) { const int c = hq * 8; float y[8];
                const f32x4 n0 = *(const GAS f32x4*)(ngp + c), n1 = *(const GAS f32x4*)(ngp + c + 4), s0 = *(const GAS f32x4*)(sc + c), s1 = *(const GAS f32x4*)(sc + c + 4), h0 = *(const GAS f32x4*)(sh + c), h1 = *(const GAS f32x4*)(sh + c + 4);
#pragma unroll
                for (int e = 0; e < 4; ++e) { y[e] = acc[8 * hq + e] * rs * n0[e] * (1.0f + s0[e]) + h0[e]; y[4 + e] = acc[8 * hq + 4 + e] * rs * n1[e] * (1.0f + s1[e]) + h1[e]; }
                *(GAS v4u*)(ho + c) = pack8f(y); } }
        if (P.last) { const float rs = rsqrtf(wave_sum(ss) * (1.f / DM) + NORM_EPS); float* orow = P.out + ((size_t)b_l * SEQ + (tp_l - CTXL)) * DM + lane_l * 32; const float* fgp = P.fin_g + lane_l * 32;
#pragma unroll
            for (int hq = 0; hq < 8; ++hq) { const int c = hq * 4; const f32x4 fg = *(const GAS f32x4*)(fgp + c);
                f32x4 o;
#pragma unroll
                for (int e = 0; e < 4; ++e) o[e] = acc[4 * hq + e] * rs * fg[e];
                *(GAS f32x4*)(orow + c) = o; } }
    }
    if (DBG_PROBE && DBG_PROBE != 5 && !P.last && lane == 0) { float* pp = (float*)(F.ws + WS_CTL + CTL_PROBE_OFF) + gw * 4; pp[0] = pr_s2; pp[1] = pr_d2; pp[2] = pr_tg; pp[3] = pr_n; }
}


constexpr int PH_PER_LAYER = 12, NPHASE = 1 + NLAYER * PH_PER_LAYER;
#ifndef ONLY_PHASE
#define ONLY_PHASE -1
#endif
#define T0() (wave_s == 0 && pg8::opaque_lane() == 0)
#define PH_ON(k) (ONLY_PHASE < 0 || ONLY_PHASE == (k))
#define GEMM_CALL(EPI, SCHED, g, S, E) pg8::gemm_phase<EPI, SCHED, true, true>(F.lds, g, S, E, wave_s)
#define GEMM_CALL_NA(EPI, SCHED, g, S, E) pg8::gemm_phase<EPI, SCHED, false, true>(F.lds, g, S, E, wave_s)

__device__ __forceinline__ const float* karg(int i) {
    asm volatile("" : "+s"(i));
    const __attribute__((address_space(4))) unsigned long long* ka = (const __attribute__((address_space(4))) unsigned long long*)__builtin_amdgcn_kernarg_segment_ptr();
    return (const float*)ka[i];
}
__global__ void __launch_bounds__(NWAVES * 64, 2) mk_fwd(Args args) {
    extern __shared__ __attribute__((aligned(16))) unsigned char lds[];
    Frame F;
    F.lds = (LAS unsigned char*)lds; F.ws = args.ws;
    const int wave_s = __builtin_amdgcn_readfirstlane((int)threadIdx.x >> 6);
    F.tid = threadIdx.x; F.lane = F.tid & 63; F.wave = wave_s;
    F.G = gridDim.x; { const int bx = blockIdx.x; F.vcu = (F.G % 8 == 0) ? (bx % 8) * (F.G / 8) + bx / 8 : bx; }
    unsigned char* ws = args.ws;
    volatile LAS unsigned* MISC = (volatile LAS unsigned*)(F.lds + MISC_OFF);
    for (int u = F.tid; u < (LDS_BYTES - LDSCTL_OFF) / 4; u += NWAVES * 64) ((LAS unsigned*)(F.lds + LDSCTL_OFF))[u] = 0u;
    __syncthreads();
    const int lo = args.ph_lo, hi = args.ph_hi;
    XcdBarrier bar; bar.bar = (unsigned*)(ws + WS_CTL) + CW_BAR; bar.x = 0; bar.st = nullptr;
    if (hi - lo > 1) bar = xcd_barrier_post((unsigned*)(ws + WS_CTL) + CW_BAR, MISC + 8, T0());
#define IN(k) (lo <= (k) && (k) < hi)
#define REFRAME() do { const int lz_ = pg8::opaque_lane(); F.lane = lz_; F.tid = wave_s * 64 + lz_; F.wave = wave_s; ws = (unsigned char*)karg(34); F.ws = ws; { int g_ = (int)gridDim.x, b_ = (int)blockIdx.x; asm volatile("" : "+s"(g_), "+s"(b_)); bx = b_; F.G = g_; F.vcu = ((g_ & 7) == 0) ? (b_ & 7) * (g_ >> 3) + (b_ >> 3) : b_; } } while (0)
#define SEAM(k) do { if (IN((k) + 1)) xcd_barrier(bar, T0()); } while (0)
#define XBUF ((float*)(ws + WS_X))
#define HBUF ((bf16*)(ws + WS_H))
#define MODP ((const float*)(ws + WS_CTL + CTL_MOD_OFF) + (size_t)l * 3 * 12288)
    int bx = (int)blockIdx.x;

    for (int rep_ = 0; rep_ < ((DBG_REPEAT == 100) ? 2 : 1); ++rep_) if (PH_ON(100) && IN(0)) { REFRAME(); if (rep_) xcd_barrier(bar, T0()); p0_prologue(F, 0, (MK_N_LAUNCHES == 1) ? 1 : NLAYER, F.vcu, F.G); SEAM(0); if (DBG_REPEAT == 200) { for (int i_ = 0; i_ < 32; ++i_) xcd_barrier(bar, T0()); } }

    for (int l = 0; l < NLAYER; ++l) {
        const int base = 1 + l * PH_PER_LAYER;
        const int last = (l == NLAYER - 1);
        for (int rep_ = 0; rep_ < ((DBG_REPEAT == 0) ? 2 : 1); ++rep_) if (PH_ON(0) && IN(base + 0) && l == 0) { REFRAME(); if (rep_) xcd_barrier(bar, T0()); modnorm_phase(F, XBUF, karg(6) + (size_t)l * DM, MODP, 0, HBUF, 0, l == 0 ? karg(0) : nullptr, l == 0 ? karg(2) : nullptr); SEAM(base + 0); }
        for (int rep_ = 0; rep_ < ((DBG_REPEAT == 1) ? 2 : 1); ++rep_) if (PH_ON(1) && IN(base + 1)) { REFRAME(); if (rep_) xcd_barrier(bar, T0());
            pg8::Gemm g{HBUF, (const bf16*)(ws + WS_WINA) + (size_t)l * INA_P * DM, MALL, INA_P, DM}; pg8::RowOrder S; S.init_rows(0, INA_P, F.G, bx);
            pg8::EpiStoreBf16 E{(bf16*)(ws + WS_PA), INA_P};
            GEMM_CALL(pg8::EpiStoreBf16, pg8::RowOrder, g, S, E);
            SEAM(base + 1); }
        for (int rep_ = 0; rep_ < ((DBG_REPEAT == 2) ? 2 : 1); ++rep_) if (PH_ON(2) && IN(base + 2)) { REFRAME(); if (rep_) xcd_barrier(bar, T0());
            FeatP P;
            P.PA = (const bf16*)(ws + WS_PA); P.mu = karg(9) + (size_t)l * RWC; P.w0 = karg(10) + (size_t)l * 2 * RW; P.a0 = karg(12) + (size_t)l * 2 * RW;
            P.k_k = karg(15) + (size_t)l * RW; P.k_a = karg(16) + (size_t)l * RW; P.r_k = karg(17) + (size_t)l * RW;
            P.WUP = (const bf16*)(ws + WS_WUP) + (size_t)l * 2 * RW * 64; P.AUP = (const bf16*)(ws + WS_AUP) + (size_t)l * 2 * RW * 64; P.GUP = (const bf16*)(ws + WS_GUP) + (size_t)l * 2 * RW * 32;
            P.qnorm = karg(20) + (size_t)l * 512; P.kvnorm = karg(22) + (size_t)l * 256; P.rope = (const f32x2*)(ws + WS_ROPE);
            P.RI = (bf16*)(ws + WS_RI); P.GG = (bf16*)(ws + WS_GG); P.BON = (float*)(ws + WS_BON); P.QN = (bf16*)(ws + WS_QN); P.KVN = (bf16*)(ws + WS_KVN); P.K = (bf16*)(ws + WS_K);
            features_phase(F, P);
            SEAM(base + 2); }
        for (int rep_ = 0; rep_ < ((DBG_REPEAT == 3) ? 2 : 1); ++rep_) if (PH_ON(3) && IN(base + 3)) { REFRAME(); if (rep_) xcd_barrier(bar, T0());
            { pg8::Gemm g{(const bf16*)(ws + WS_QN), (const bf16*)(ws + WS_WUQ) + (size_t)l * NQ * 512, MALL, NQ, 512};
              pg8::EpiQ E{(bf16*)(ws + WS_Q), (const f32x2*)(ws + WS_ROPE), 0.14724444f};
              pg8::RowOrder S; S.init_rows(last, NQ, F.G, bx); GEMM_CALL_NA(pg8::EpiQ, pg8::RowOrder, g, S, E); }
            { pg8::Gemm g{(const bf16*)(ws + WS_KVN), (const bf16*)(ws + WS_WUKV) + (size_t)l * NKV * 256, MALL, NKV, 256}; pg8::RowOrder S; S.init_rows(0, NKV, F.G, bx);
              pg8::EpiKV E{(bf16*)(ws + WS_K), (bf16*)(ws + WS_V)};
              GEMM_CALL_NA(pg8::EpiKV, pg8::RowOrder, g, S, E); }
            SEAM(base + 3); }
        for (int rep_ = 0; rep_ < ((DBG_REPEAT == 4) ? 2 : 1); ++rep_) if (PH_ON(4) && IN(base + 4)) { REFRAME(); if (rep_) xcd_barrier(bar, T0());
            ScanCvt C; C.pu = karg(30) + (size_t)l * NEXP * DM; C.pv = karg(31) + (size_t)l * NEXP * DM; C.PU8 = ws + WS_P4; C.PV8 = ws + WS_P4 + (size_t)NEXP * (DM / 2); C.SU = (float*)(ws + WS_P4S); C.SV = (float*)(ws + WS_P4S) + NEXP;
            scan_phase(F, (const bf16*)(ws + WS_RI), (bf16*)(ws + WS_Y), C); SEAM(base + 4); }
        for (int rep_ = 0; rep_ < ((DBG_REPEAT == 5) ? 2 : 1); ++rep_) if (PH_ON(5) && IN(base + 5)) { REFRAME(); if (rep_) xcd_barrier(bar, T0());
            attn_phase(F, (const bf16*)(ws + WS_Q), (const bf16*)(ws + WS_K), (const bf16*)(ws + WS_V), (bf16*)(ws + WS_YB), !last);
            readout_phase(F, (const bf16*)(ws + WS_Y), (const bf16*)(ws + WS_GG), (const float*)(ws + WS_BON), (const bf16*)(ws + WS_RI), karg(18) + (size_t)l * RW, karg(19) + (size_t)l * RW, (bf16*)(ws + WS_YA));
            SEAM(base + 5); }
        for (int rep_ = 0; rep_ < ((DBG_REPEAT == 6) ? 2 : 1); ++rep_) if (PH_ON(6) && IN(base + 6)) { REFRAME(); if (rep_) xcd_barrier(bar, T0());
            bf16* T1 = (bf16*)(ws + WS_T1); bf16* T2 = (bf16*)(ws + WS_T2);
            const pg8::Gemm g1{HBUF, (const bf16*)(ws + WS_WGA) + (size_t)l * DM * DM, MALL, DM, DM}, g2{(const bf16*)(ws + WS_YA), (const bf16*)(ws + WS_WA) + (size_t)l * DM * RW, MALL, DM, RW};
            const pg8::Gemm g3{HBUF, (const bf16*)(ws + WS_WGB) + (size_t)l * DM * DM, MALL, DM, DM}, g4{(const bf16*)(ws + WS_YB), (const bf16*)(ws + WS_WB) + (size_t)l * DM * RW, MALL, DM, RW};
            const pg8::EpiGate E1{T1, DM, karg(8) + (size_t)l * 2 * DM}, E3{T2, DM, karg(8) + (size_t)l * 2 * DM + DM};
            const pg8::EpiMulAdd E2{T1, T1, nullptr, DM}, E4{T1, T2, T1, DM};
            pg8::RowOrder S; S.init_rows(last, DM, F.G, bx);
            GEMM_CALL(pg8::EpiGate, pg8::RowOrder, g1, S, E1); GEMM_CALL(pg8::EpiMulAdd, pg8::RowOrder, g2, S, E2); GEMM_CALL(pg8::EpiGate, pg8::RowOrder, g3, S, E3); GEMM_CALL(pg8::EpiMulAdd, pg8::RowOrder, g4, S, E4);
            if (MK_N_LAUNCHES == 1 && l == 0 && rep_ == 0) { __syncthreads();
                const int late = (F.G > 32) ? 16 : 0; p0_prologue(F, 1, NLAYER, (bx >= late) ? bx - late : -1, F.G - late); }
            SEAM(base + 6); }
        for (int rep_ = 0; rep_ < ((DBG_REPEAT == 7) ? 2 : 1); ++rep_) if (PH_ON(7) && IN(base + 7)) { REFRAME(); if (rep_) xcd_barrier(bar, T0());
            const pg8::Gemm g{(const bf16*)(ws + WS_T1), (const bf16*)(ws + WS_WO) + (size_t)l * DM * DM, MALL, DM, DM};
            const pg8::EpiResid E{XBUF, MODP + 2 * DM, l == 0 ? karg(0) : nullptr, l == 0 ? karg(2) : nullptr};
            pg8::RowOrder S; S.init_rows(last, DM, F.G, bx); GEMM_CALL(pg8::EpiResid, pg8::RowOrder, g, S, E);
            SEAM(base + 7); }
        for (int rep_ = 0; rep_ < ((DBG_REPEAT == 8) ? 2 : 1); ++rep_) if (PH_ON(8) && IN(base + 8)) { REFRAME(); if (rep_) xcd_barrier(bar, T0());
            modnorm_phase(F, XBUF, karg(27) + (size_t)l * DM, MODP, 3, HBUF, last);
            SEAM(base + 8); }
        for (int rep_ = 0; rep_ < ((DBG_REPEAT == 9) ? 2 : 1); ++rep_) if (PH_ON(9) && IN(base + 9)) { REFRAME(); if (rep_) xcd_barrier(bar, T0());
            const pg8::Gemm g{HBUF, (const bf16*)(ws + WS_WQK) + (size_t)l * DM * DM, MALL, DM, DM};
            const pg8::EpiF32 E{(float*)(ws + WS_SC), DM};
            pg8::RowOrder S; S.init_rows(last, DM, F.G, bx); GEMM_CALL(pg8::EpiF32, pg8::RowOrder, g, S, E);
            SEAM(base + 9); }
        for (int rep_ = 0; rep_ < ((DBG_REPEAT == 11) ? 2 : 1); ++rep_) if (PH_ON(11) && IN(base + 11)) { REFRAME(); if (rep_) xcd_barrier(bar, T0());
            PeerP P; P.SC = (const float*)(ws + WS_SC); P.nmod = MODP + 3 * 12288; P.ng = karg(6) + (size_t)(l + 1) * DM; P.Hout = HBUF; P.ESEL = (const int*)(ws + WS_T1); P.EGATE = (const float*)(ws + WS_T1 + 16 * MiB); P.H = HBUF; P.PU = ws + WS_P4; P.PV = ws + WS_P4 + (size_t)NEXP * (DM / 2); P.SU = (const float*)(ws + WS_P4S); P.SV = (const float*)(ws + WS_P4S) + NEXP; P.X = XBUF; P.mod = MODP; P.fin_g = karg(32); P.out = (float*)karg(33); P.last = last; P.dry = (DBG_REPEAT == 11 && rep_ == 0) ? DBG_DRY : 0;
            peer_phase(F, P);
            SEAM(base + 11); }
    }
#undef IN
#undef SEAM
#undef XBUF
#undef HBUF
#undef MODP
}

__device__ __forceinline__ float mx_a_val(int i, int k) { const int c = (i * 131 + k * 17 + (k >> 3) * 5) & 15; const float mag[8] = {0.f, .5f, 1.f, 1.5f, 2.f, 3.f, 4.f, 6.f}; return (c & 8) ? -mag[c & 7] : mag[c & 7]; }
__device__ __forceinline__ int mx_a_code(int i, int k) { return (i * 131 + k * 17 + (k >> 3) * 5) & 15; }
__device__ __forceinline__ float mx_b_val(int k, int j) { return (float)(((k * 7 + j * 13 + (k >> 4)) % 9) - 4); }
__device__ __forceinline__ int mx_kmap(int hyp, int kb, int e) { const int h = hyp % 3; return h == 0 ? 32 * kb + e : h == 1 ? 32 * (e >> 3) + 8 * kb + (e & 7) : 64 * (e >> 4) + 16 * kb + (e & 15); }
__global__ void __launch_bounds__(512) dbg_fill(const float* pp, float* o) {
    __shared__ float vsh;
    float v = 0.f;
    if (DBG_PROBE == 5) {
        if (threadIdx.x < 64) { typedef int v8i __attribute__((ext_vector_type(8))); typedef float f4 __attribute__((ext_vector_type(4)));
            const int lane = threadIdx.x, i = lane & 15, kb = lane >> 4; float code = 0.f;
            for (int hyp = 0; hyp < 18; ++hyp) { const int nibswap = hyp / 9, ha = hyp % 3, hb2 = (hyp / 3) % 3;
                unsigned aw[4] = {0u, 0u, 0u, 0u}; int bw[8] = {0, 0, 0, 0, 0, 0, 0, 0};
                for (int e = 0; e < 32; ++e) { const int k = mx_kmap(ha, kb, e); const unsigned c = (unsigned)mx_a_code(i, k); const int pos = nibswap ? (e ^ 1) : e; aw[pos >> 3] |= c << (4 * (pos & 7)); }
                for (int q = 0; q < 8; ++q) { int w = 0; const float f0 = mx_b_val(mx_kmap(hb2, kb, 4 * q + 0), i), f1 = mx_b_val(mx_kmap(hb2, kb, 4 * q + 1), i), f2 = mx_b_val(mx_kmap(hb2, kb, 4 * q + 2), i), f3 = mx_b_val(mx_kmap(hb2, kb, 4 * q + 3), i);
                    w = __builtin_amdgcn_cvt_pk_fp8_f32(f0, f1, w, false); w = __builtin_amdgcn_cvt_pk_fp8_f32(f2, f3, w, true); bw[q] = w; }
                const v8i af = {(int)aw[0], (int)aw[1], (int)aw[2], (int)aw[3], 0, 0, 0, 0}, bf = {bw[0], bw[1], bw[2], bw[3], bw[4], bw[5], bw[6], bw[7]};
                f4 d = {0.f, 0.f, 0.f, 0.f};
                d = __builtin_amdgcn_mfma_scale_f32_16x16x128_f8f6f4(af, bf, d, 4, 0, 0, 0x7f7f7f7f, 0, 0x7f7f7f7f);
                int bad = 0;
                for (int r = 0; r < 4; ++r) { const int row = 4 * kb + r, col = i; float ex = 0.f; for (int k = 0; k < 128; ++k) ex += mx_a_val(row, k) * mx_b_val(k, col); bad += (d[r] != ex); }
                if (__ballot(bad != 0) == 0ull && code == 0.f) code = (float)(hyp + 1); }
            for (int t = 0; t < 2; ++t) {
                int aw[8] = {0, 0, 0, 0, 0, 0, 0, 0}, bw[8] = {0, 0, 0, 0, 0, 0, 0, 0};
                if (t == 0) { for (int e = 0; e < 32; ++e) { const int k = 32 * kb + e; aw[e >> 3] |= mx_a_code(i, k) << (4 * (e & 7)); bw[e >> 3] |= mx_a_code(i + 16, k) << (4 * (e & 7)); } }
                else { for (int q = 0; q < 8; ++q) { int w = 0, w2 = 0; const int k = 32 * kb + 4 * q;
                        w = __builtin_amdgcn_cvt_pk_fp8_f32(mx_b_val(k, i + 16), mx_b_val(k + 1, i + 16), w, false); w = __builtin_amdgcn_cvt_pk_fp8_f32(mx_b_val(k + 2, i + 16), mx_b_val(k + 3, i + 16), w, true); aw[q] = w;
                        w2 = __builtin_amdgcn_cvt_pk_fp8_f32(mx_b_val(k, i), mx_b_val(k + 1, i), w2, false); w2 = __builtin_amdgcn_cvt_pk_fp8_f32(mx_b_val(k + 2, i), mx_b_val(k + 3, i), w2, true); bw[q] = w2; } }
                const v8i af = {aw[0], aw[1], aw[2], aw[3], aw[4], aw[5], aw[6], aw[7]}, bf = {bw[0], bw[1], bw[2], bw[3], bw[4], bw[5], bw[6], bw[7]};
                f4 d = {0.f, 0.f, 0.f, 0.f};
                if (t == 0) d = __builtin_amdgcn_mfma_scale_f32_16x16x128_f8f6f4(af, bf, d, 4, 4, 0, 0x7f7f7f7f, 0, 0x7f7f7f7f); else d = __builtin_amdgcn_mfma_scale_f32_16x16x128_f8f6f4(af, bf, d, 0, 0, 0, 0x7f7f7f7f, 0, 0x7f7f7f7f);
                int bad = 0;
                for (int r = 0; r < 4; ++r) { const int row = 4 * kb + r, col = i; float ex = 0.f;
                    for (int k = 0; k < 128; ++k) ex += (t == 0) ? mx_a_val(row, k) * mx_a_val(col + 16, k) : mx_b_val(k, row + 16) * mx_b_val(k, col);
                    bad += (d[r] != ex); }
                if (__ballot(bad != 0) == 0ull) code += (t == 0) ? 10.f : 20.f; }
            if (lane == 0) vsh = code; }
        __syncthreads(); v = vsh;
    } else {
        float s0 = 0.f, s1 = 0.f, s2 = 0.f, s3 = 0.f;
        for (int i = 0; i < 2048; ++i) { s0 += pp[4 * i]; s1 += pp[4 * i + 1]; s2 += pp[4 * i + 2]; s3 += pp[4 * i + 3]; }
        if (DBG_PROBE == 4) { float mx = 0.f; for (int i = 0; i < 2048; ++i) mx = fmaxf(mx, pp[4 * i]); v = 100.f * mx; }
        else { v = (DBG_PROBE == 1 ? s0 : DBG_PROBE == 2 ? s1 : s2) / s3 * 1e-3f; v = exp2f(rintf(log2f(v) * 4.f) * 0.25f); }
    }
    for (size_t i = (size_t)blockIdx.x * 512 + threadIdx.x; i < (size_t)NBATCH * SEQ * DM; i += (size_t)gridDim.x * 512) o[i] = v;
}
extern "C" void kernel_launch(void* const* d_in, const int* in_sizes, int n_in, void* d_out, int out_size, void* d_ws, size_t ws_size, hipStream_t stream) {
    static int grid = 0;
    if (grid == 0) {
        if (n_in != 33 || out_size != NBATCH * SEQ * DM || ws_size < WS_END2) { fprintf(stderr, "kernel_launch: unexpected shapes (n_in %d out %d ws %zu)\n", n_in, out_size, ws_size); grid = -1; return; }
        int dev = 0, cus = 0, per_cu = 0;
        if (hipGetDevice(&dev) != hipSuccess || hipDeviceGetAttribute(&cus, hipDeviceAttributeMultiprocessorCount, dev) != hipSuccess) { grid = -1; return; }
        if (hipFuncSetAttribute((const void*)mk_fwd, hipFuncAttributeMaxDynamicSharedMemorySize, LDS_BYTES) != hipSuccess) { fprintf(stderr, "kernel_launch: hipFuncSetAttribute failed\n"); grid = -1; return; }
        if (hipOccupancyMaxActiveBlocksPerMultiprocessor(&per_cu, (const void*)mk_fwd, NWAVES * 64, LDS_BYTES) != hipSuccess || per_cu < 1) { fprintf(stderr, "kernel_launch: occupancy query says %d\n", per_cu); (void)hipGetLastError(); grid = -1; return; }
        grid = cus;
    }
    if (grid < 0) return;
    if (hipMemsetAsync((char*)d_ws + WS_CTL, 0, CTL_ZERO_BYTES, stream) != hipSuccess) return;
    Args a{};
    for (int i = 0; i < 33; ++i) a.in[i] = (const float*)d_in[i];
    a.out = (float*)d_out; a.ws = (unsigned char*)d_ws;
#if MK_N_LAUNCHES == 1
    a.ph_lo = 0; a.ph_hi = NPHASE;
    hipLaunchKernelGGL(mk_fwd, dim3(grid), dim3(NWAVES * 64), LDS_BYTES, stream, a);
#else
    if (DBG_PROBE != 5) for (int p = 0; p < NPHASE; ++p) { a.ph_lo = p; a.ph_hi = p + 1; hipLaunchKernelGGL(mk_fwd, dim3(grid), dim3(NWAVES * 64), LDS_BYTES, stream, a); }
    if (DBG_PROBE) hipLaunchKernelGGL(dbg_fill, dim3(1024), dim3(512), 0, stream, (const float*)((char*)d_ws + WS_CTL + CTL_PROBE_OFF), (float*)d_out);
#endif
}
```

```cpp
#include <hip/hip_runtime.h>
#include <cstdio>
#include <cstdint>

#ifndef MK_N_LAUNCHES
#define MK_N_LAUNCHES 1
#endif

#ifndef DBG_SKIP
#define DBG_SKIP 0
#endif
#ifndef DBG_PROBE
#define DBG_PROBE 0
#endif
#ifndef DBG_DRY
#define DBG_DRY 1
#endif
#ifndef DBG_REPEAT
#define DBG_REPEAT -1
#endif
namespace pg8 {
#define PG8_LAS __attribute__((address_space(3)))
typedef unsigned short bf16_t;
typedef short bf16x8 __attribute__((ext_vector_type(8)));
typedef float f32x4 __attribute__((ext_vector_type(4)));
typedef unsigned u32x4 __attribute__((ext_vector_type(4)));
constexpr int BM = 256, BK = 64, HALF = 128, HTB = HALF * BK * 2  , STAGE_BYTES = 8 * HTB, NXCD = 8, WGM = 8;

__host__ __device__ __forceinline__ int lds_byte(int r, int c) { const int st = (r >> 4) * 2 + (c >> 5), rr = r & 15, cc = c & 31, ob = rr * 64 + cc * 2; return st * 1024 + (ob ^ (((ob >> 9) & 1) << 5)); }
__host__ __device__ __forceinline__ void stage_rc(int b, int& R, int& C) { const int st = b / 1024, sb = b % 1024, swz = sb ^ (((sb >> 9) & 1) << 5); R = (st >> 1) * 16 + swz / 64; C = (st & 1) * 32 + (swz % 64) / 2; }
__host__ __device__ __forceinline__ int perm32(int rho) { const int n = rho >> 4, i = rho & 15; return 8 * (i >> 2) + 4 * n + (i & 3); }

struct Unit { int pm, pn; };
struct Gemm { const bf16_t* A; const bf16_t* Bt; int M, N, K; };

struct StaticOrder {
    int nM, nN, nwg, G, c;
    __host__ __device__ void init(int M, int N, int G_, int c_) { nM = M / BM; nN = N / BM; nwg = nM * nN; G = G_; c = c_; }
    __host__ __device__ bool next(int i, Unit& u) const {
        const long L = (long)i * G + c; if (L >= nwg) return false;
        int wgid = (int)L; { const int q = nwg / NXCD, r = nwg % NXCD, xcd = wgid % NXCD, off = wgid / NXCD; wgid = (xcd < r ? xcd * (q + 1) : r * (q + 1) + (xcd - r) * q) + off; }
        const int nig = WGM * nN, gid = wgid / nig, fm = gid * WGM, gsz = (nM - fm) < WGM ? (nM - fm) : WGM;
        u.pm = fm + ((wgid % nig) % gsz); u.pn = (wgid % nig) / gsz; return true;
    }
    __device__ __forceinline__ void a_ready(const Unit&) const {}
    __device__ __forceinline__ void done(const Unit&) const {}
};
__device__ __forceinline__ int opaque_lane() { int l; asm volatile("v_mbcnt_lo_u32_b32 %0, -1, 0\n\tv_mbcnt_hi_u32_b32 %0, -1, %0" : "=v"(l)); return l; }
typedef __bf16 bf16x2c __attribute__((ext_vector_type(2)));
__device__ __forceinline__ unsigned cvt_pk_bf16(float lo, float hi) { const bf16x2c v = {(__bf16)lo, (__bf16)hi}; return __builtin_bit_cast(unsigned, v); }
template <class Epi, class Sched, bool ALIGN_EPI = false, bool SP2 = false>
__device__ __forceinline__ void gemm_phase(PG8_LAS unsigned char* lds, const Gemm g, const Sched& S, const Epi& E, const int wave_s) {
    const int lane_ = opaque_lane();
    const int wid = wave_s, lane = lane_, tid = wid * 64 + lane, wr = wid >> 2, wc = wid & 3, fr = lane & 15, fq = lane >> 4;
    const int K = g.K, nt = K / BK;
    unsigned voffA[2], voffB[2];
#pragma unroll
    for (int i = 0; i < 2; ++i) { int R, C; stage_rc(tid * 16 + i * 8192, R, C); const int Rb = Epi::PERM ? ((R & ~31) + perm32(R & 31)) : R;
        voffA[i] = (unsigned)(R * K + C) * 2u; voffB[i] = (unsigned)(Rb * K + C) * 2u; }
    const size_t kstep = (size_t)(BK * 2);
    const size_t hstep = (size_t)HALF * K * 2;
    const size_t tstep = 2 * hstep;
    const unsigned ldsw = (unsigned)wid * 1024u;
    const int aoff = lds_byte(wr * 64 + fr, fq * 8), boff = lds_byte(wc * 32 + fr, fq * 8);
#define PG8_SA(b, h) (((b) * 2 + (h)) * HTB)
#define PG8_SB(b, h) ((4 + (b) * 2 + (h)) * HTB)
#define PG8_STAGE(bufoff, gbase, voff) do { _Pragma("unroll") for (int _i = 0; _i < 2; ++_i) \
        __builtin_amdgcn_global_load_lds((const unsigned*)((const char*)(gbase) + (voff)[_i]), (PG8_LAS unsigned*)(lds + (bufoff) + ldsw + _i * 8192), 16, 0, 0); } while (0)
#define PG8_LDA(dst, b, h) do { _Pragma("unroll") for (int m = 0; m < 4; ++m) _Pragma("unroll") for (int k = 0; k < 2; ++k) dst[m][k] = *(const PG8_LAS bf16x8*)(lds + PG8_SA(b, h) + aoff + m * 2048 + k * 1024); } while (0)
#define PG8_LDB(dst, b, h) do { _Pragma("unroll") for (int n = 0; n < 2; ++n) _Pragma("unroll") for (int k = 0; k < 2; ++k) dst[n][k] = *(const PG8_LAS bf16x8*)(lds + PG8_SB(b, h) + boff + n * 2048 + k * 1024); } while (0)
#define PG8_MMA(ai, bj, At, Bt) do { __builtin_amdgcn_s_setprio(1); _Pragma("unroll") for (int m = 0; m < 4; ++m) _Pragma("unroll") for (int n = 0; n < 2; ++n) _Pragma("unroll") for (int k = 0; k < 2; ++k) \
        acc[ai][bj][m][n] = __builtin_amdgcn_mfma_f32_16x16x32_bf16(Bt[n][k], At[m][k], acc[ai][bj][m][n], 0, 0, 0); __builtin_amdgcn_s_setprio(0); } while (0)
#define PG8_WAIT_V(n) asm volatile("s_waitcnt vmcnt(" #n ")" ::: "memory")
#define PG8_WAIT_L(n) asm volatile("s_waitcnt lgkmcnt(" #n ")" ::: "memory")
#define PG8_BAR __builtin_amdgcn_s_barrier()
#define PG8_SCHED __builtin_amdgcn_sched_barrier(0)
    Unit cur, nxt; int ui = 0;
    if (!S.next(0, cur)) return;
    f32x4 acc[2][2][4][2];
#pragma unroll
    for (int a = 0; a < 2; ++a)
#pragma unroll
        for (int b = 0; b < 2; ++b)
#pragma unroll
            for (int m = 0; m < 4; ++m)
#pragma unroll
                for (int n = 0; n < 2; ++n) acc[a][b][m][n] = (f32x4){0.f, 0.f, 0.f, 0.f};
    bf16x8 At[4][2], B0[2][2], B1[2][2];
    const char* cA = (const char*)g.A + (size_t)cur.pm * tstep; const char* cB = (const char*)g.Bt + (size_t)cur.pn * tstep;
    S.a_ready(cur);
    if constexpr (SP2) {
        PG8_STAGE(PG8_SB(0, 0), cB, voffB); PG8_STAGE(PG8_SB(0, 1), cB + hstep, voffB); PG8_STAGE(PG8_SA(0, 0), cA, voffA); PG8_STAGE(PG8_SA(0, 1), cA + hstep, voffA);
        if (wr == 1) PG8_BAR;
        PG8_WAIT_V(2); PG8_BAR;
        PG8_STAGE(PG8_SB(1, 0), cB + kstep, voffB); PG8_STAGE(PG8_SA(1, 0), cA + kstep, voffA); PG8_STAGE(PG8_SB(1, 1), cB + hstep + kstep, voffB);
        PG8_WAIT_V(6); PG8_BAR;
    } else {
        PG8_STAGE(PG8_SB(0, 0), cB, voffB); PG8_STAGE(PG8_SA(0, 0), cA, voffA); PG8_STAGE(PG8_SB(0, 1), cB + hstep, voffB); PG8_STAGE(PG8_SA(0, 1), cA + hstep, voffA);
        if (wr == 1) PG8_BAR;
        PG8_WAIT_V(4); PG8_BAR;
        PG8_STAGE(PG8_SB(1, 0), cB + kstep, voffB); PG8_STAGE(PG8_SA(1, 0), cA + kstep, voffA); PG8_STAGE(PG8_SB(1, 1), cB + hstep + kstep, voffB);
        PG8_WAIT_V(6); PG8_BAR;
    }
    for (;;) {
        const bool has_next = S.next(ui + 1, nxt);
        const char* nA = has_next ? (const char*)g.A + (size_t)nxt.pm * tstep : cA; const char* nB = has_next ? (const char*)g.Bt + (size_t)nxt.pn * tstep : cB;
        for (int t = 0; t < nt; t += 2) {
            const bool last = (t == nt - 2);
            const char* a1 = cA + (size_t)(t + 1) * kstep;
            const char* a2 = last ? nA : cA + (size_t)(t + 2) * kstep; const char* b2 = last ? nB : cB + (size_t)(t + 2) * kstep;
            const char* a3 = a2 + kstep; const char* b3 = b2 + kstep;
            if (last && has_next) S.a_ready(nxt);
            if constexpr (SP2) {
            PG8_LDB(B0, 0, 0); PG8_LDB(B1, 0, 1); PG8_SCHED; PG8_LDA(At, 0, 0); PG8_STAGE(PG8_SA(1, 1), a1 + hstep, voffA);
            PG8_WAIT_V(8); PG8_WAIT_L(0); PG8_BAR; PG8_MMA(0, 0, At, B0); PG8_MMA(0, 1, At, B1); PG8_BAR; PG8_SCHED;
            PG8_LDA(At, 0, 1); PG8_STAGE(PG8_SB(0, 0), b2, voffB); PG8_STAGE(PG8_SB(0, 1), b2 + hstep, voffB); PG8_STAGE(PG8_SA(0, 0), a2, voffA);
            PG8_WAIT_V(8); PG8_WAIT_L(0); PG8_BAR; PG8_MMA(1, 0, At, B0); PG8_MMA(1, 1, At, B1); PG8_BAR; PG8_SCHED;
            PG8_LDB(B0, 1, 0); PG8_LDB(B1, 1, 1); PG8_SCHED; PG8_LDA(At, 1, 0); PG8_STAGE(PG8_SA(0, 1), a2 + hstep, voffA);
            PG8_WAIT_V(8); PG8_WAIT_L(0); PG8_BAR; PG8_MMA(0, 0, At, B0); PG8_MMA(0, 1, At, B1); PG8_BAR; PG8_SCHED;
            PG8_LDA(At, 1, 1); PG8_STAGE(PG8_SB(1, 0), b3, voffB); PG8_STAGE(PG8_SB(1, 1), b3 + hstep, voffB); PG8_STAGE(PG8_SA(1, 0), a3, voffA);
            PG8_WAIT_V(8); PG8_WAIT_L(0); PG8_BAR; PG8_MMA(1, 0, At, B0); PG8_MMA(1, 1, At, B1); PG8_BAR; PG8_SCHED;
            } else {
            PG8_LDB(B0, 0, 0); PG8_SCHED; PG8_LDA(At, 0, 0); PG8_STAGE(PG8_SA(1, 1), a1 + hstep, voffA);
            PG8_WAIT_L(8); PG8_BAR; PG8_WAIT_L(0); PG8_MMA(0, 0, At, B0); PG8_BAR; PG8_SCHED;
            PG8_LDB(B1, 0, 1); PG8_STAGE(PG8_SB(0, 0), b2, voffB);
            PG8_BAR; PG8_WAIT_L(0); PG8_MMA(0, 1, At, B1); PG8_BAR;
            PG8_LDA(At, 0, 1); PG8_STAGE(PG8_SA(0, 0), a2, voffA);
            PG8_BAR; PG8_WAIT_L(0); PG8_MMA(1, 0, At, B0); PG8_BAR; PG8_SCHED;
            PG8_STAGE(PG8_SB(0, 1), b2 + hstep, voffB);
            PG8_WAIT_V(6); PG8_BAR; PG8_MMA(1, 1, At, B1); PG8_BAR;
            PG8_LDB(B0, 1, 0); PG8_SCHED; PG8_LDA(At, 1, 0); PG8_STAGE(PG8_SA(0, 1), a2 + hstep, voffA);
            PG8_WAIT_L(8); PG8_BAR; PG8_WAIT_L(0); PG8_MMA(0, 0, At, B0); PG8_BAR; PG8_SCHED;
            PG8_LDB(B1, 1, 1); PG8_STAGE(PG8_SB(1, 0), b3, voffB);
            PG8_BAR; PG8_WAIT_L(0); PG8_MMA(0, 1, At, B1); PG8_BAR;
            PG8_LDA(At, 1, 1); PG8_STAGE(PG8_SA(1, 0), a3, voffA);
            PG8_BAR; PG8_WAIT_L(0); PG8_MMA(1, 0, At, B0); PG8_BAR; PG8_SCHED;
            PG8_STAGE(PG8_SB(1, 1), b3 + hstep, voffB);
            PG8_WAIT_V(6); PG8_BAR; PG8_MMA(1, 1, At, B1); PG8_BAR;
            }
        }
        if constexpr (ALIGN_EPI) { if (wr == 0) PG8_BAR; }
        if constexpr (!Epi::AFTER_DRAIN) { const int le_ = opaque_lane(); E(acc, cur, wr, wc, le_ & 15, le_ >> 4); S.done(cur); }
        if (!has_next) break;
#pragma unroll
        for (int a = 0; a < 2; ++a)
#pragma unroll
            for (int b = 0; b < 2; ++b)
#pragma unroll
                for (int m = 0; m < 4; ++m)
#pragma unroll
                    for (int n = 0; n < 2; ++n) acc[a][b][m][n] = (f32x4){0.f, 0.f, 0.f, 0.f};
        cur = nxt; cA = nA; cB = nB; ++ui;
        if constexpr (ALIGN_EPI) { if (wr == 1) PG8_BAR; }
    }
    PG8_WAIT_V(0);
    if constexpr (!ALIGN_EPI) { if (wr == 0) PG8_BAR; }
    PG8_BAR;
    if constexpr (Epi::AFTER_DRAIN) { E.fused(acc, cur, wr, wc, fr, fq, lds, wid, lane); S.done(cur); }
#undef PG8_SA
#undef PG8_SB
#undef PG8_STAGE
#undef PG8_LDA
#undef PG8_LDB
#undef PG8_MMA
#undef PG8_WAIT_V
#undef PG8_WAIT_L
#undef PG8_BAR
#undef PG8_SCHED
}
}

constexpr int NWAVES = 8;
constexpr int DM = 2048, NBATCH = 2, SEQ = 8192, CTXL = 256, TPB = CTXL + SEQ  , MALL = NBATCH * TPB  ;
constexpr int NLAYER = 2;
constexpr int RW = 1024, NH = 16;
constexpr int RWC = 3392, INA = 4192, INA_P = 4352, INC = 8288;
constexpr int C_WD = 3072, C_AD = 3200, C_GD = 3328, C_QC = 3392, C_KVC = 3904, C_KR = 4160;
constexpr int QKD = 96, NQ = NH * QKD  , NKV = NH * 128  ;
constexpr int NEXP = 16384;
constexpr int RREC = 9 * 64;
constexpr float NORM_EPS = 1e-6f;

constexpr size_t MiB = 1u << 20;
constexpr size_t WS_CTL = 0, CTL_ZERO_BYTES = 1 * MiB;
constexpr size_t CTL_MOD_OFF = 256 * 1024;
constexpr size_t WS_ROPE = 1 * MiB;
constexpr size_t WS_WUP = 3 * MiB, WS_AUP = WS_WUP + 512 * 1024, WS_GUP = 4 * MiB;
constexpr size_t WS_WUQ = 5 * MiB, WS_WUKV = 8 * MiB, WS_WA = 10 * MiB, WS_WB = 18 * MiB, WS_WO = 26 * MiB, WS_WQK = 42 * MiB, WS_WGA = 58 * MiB, WS_WGB = 74 * MiB, WS_WINA = 90 * MiB;
constexpr size_t WS_X = 124 * MiB, WS_H = 256 * MiB, WS_DYN = 322 * MiB;
constexpr size_t WS_PA = WS_DYN;
constexpr size_t WS_RI = 463 * MiB;
constexpr size_t WS_GG = 760 * MiB;
constexpr size_t WS_BON = 826 * MiB;
constexpr size_t WS_QN = 831 * MiB, WS_KVN = 848 * MiB;
constexpr size_t WS_Q = 857 * MiB, WS_K = 907 * MiB, WS_V = 957 * MiB, WS_END = 990 * MiB;
constexpr size_t WS_Y = WS_DYN;
constexpr size_t WS_YA = 388 * MiB, WS_YB = 421 * MiB;
constexpr size_t WS_T1 = 463 * MiB, WS_T2 = 529 * MiB;
constexpr size_t WS_PU = 600 * MiB, WS_PV = 664 * MiB;
constexpr size_t WS_P4 = 990 * MiB, WS_P4S = 1022 * MiB, WS_END2 = 1023 * MiB;
constexpr size_t WS_SC = WS_DYN;
static_assert(WS_PA + (size_t)MALL * INA_P * 2 <= WS_RI && WS_RI + (size_t)NBATCH * NH * TPB * RREC * 2 <= WS_GG && WS_GG + (size_t)2 * MALL * RW * 2 <= WS_BON, "ws map 1");
static_assert(WS_BON + (size_t)2 * MALL * 32 * 4 <= WS_QN && WS_QN + (size_t)MALL * 512 * 2 <= WS_KVN && WS_KVN + (size_t)MALL * 256 * 2 <= WS_Q, "ws map 2");
static_assert(WS_Q + (size_t)NBATCH * NH * TPB * QKD * 2 <= WS_K && WS_K + (size_t)NBATCH * NH * TPB * QKD * 2 <= WS_V && WS_V + (size_t)NBATCH * NH * TPB * 64 * 2 <= WS_END, "ws map 3");
static_assert(WS_Y + (size_t)2 * MALL * RW * 2 <= WS_YA && WS_YA + (size_t)MALL * RW * 2 <= WS_YB && WS_YB + (size_t)MALL * RW * 2 <= WS_RI, "ws map 4");
static_assert(WS_T1 + (size_t)MALL * DM * 2 <= WS_T2 && WS_T2 + (size_t)MALL * DM * 2 <= WS_PU && WS_PU + (size_t)NEXP * DM * 2 <= WS_PV && WS_PV + (size_t)NEXP * DM * 2 <= WS_GG, "ws map 5");
static_assert(WS_SC + (size_t)MALL * DM * 4 <= WS_T1 && WS_X + (size_t)MALL * DM * 4 <= WS_H && WS_H + (size_t)MALL * DM * 2 <= WS_DYN, "ws map 6");
static_assert(WS_WINA + (size_t)NLAYER * INA_P * DM * 2 <= WS_X, "ws map 7");
constexpr size_t CTL_PROBE_OFF = 640 * 1024;
constexpr int CW_BAR = 4096;

constexpr int RING_BYTES = 131072;
constexpr int LDSCTL_OFF = RING_BYTES, MISC_OFF = LDSCTL_OFF + 320;
constexpr int LDS_BYTES = 147456;

#define GAS __attribute__((address_space(1)))
#define LAS __attribute__((address_space(3)))
typedef unsigned short bf16;
typedef unsigned v4u __attribute__((ext_vector_type(4)));
typedef unsigned v2u __attribute__((ext_vector_type(2)));
typedef float f32x4 __attribute__((ext_vector_type(4)));
typedef float f32x2 __attribute__((ext_vector_type(2)));
typedef float f32x16 __attribute__((ext_vector_type(16)));
typedef short bf16x8 __attribute__((ext_vector_type(8)));
typedef short s16x4 __attribute__((ext_vector_type(4)));
typedef __bf16 bf16x2v __attribute__((ext_vector_type(2)));
typedef __bf16 bf16x8v __attribute__((ext_vector_type(8)));
typedef GAS unsigned gu32;
#define RLX_AGENT __ATOMIC_RELAXED, __HIP_MEMORY_SCOPE_AGENT
#define LDS_WAIT() asm volatile("s_waitcnt lgkmcnt(0)" ::: "memory")
#define VM_WAIT() asm volatile("s_waitcnt vmcnt(0)" ::: "memory")
__device__ __forceinline__ unsigned f2bf(float f) { unsigned u = __builtin_bit_cast(unsigned, f); return (u + 0x7fffu + ((u >> 16) & 1u)) >> 16; }
__device__ __forceinline__ unsigned pk2(float lo, float hi) { return pg8::cvt_pk_bf16(lo, hi); }
__device__ __forceinline__ float bflo(unsigned w) { return __builtin_bit_cast(float, w << 16); }
__device__ __forceinline__ float bfhi(unsigned w) { return __builtin_bit_cast(float, w & 0xffff0000u); }
__device__ __forceinline__ float bf1(bf16 h) { return __builtin_bit_cast(float, (unsigned)h << 16); }
__device__ __forceinline__ float sigmoidf_(float x) { return __builtin_amdgcn_rcpf(1.0f + __expf(-x)); }
template <int CTRL> __device__ __forceinline__ float dpp_add(float x) {
    return x + __builtin_bit_cast(float, __builtin_amdgcn_update_dpp(0, __builtin_bit_cast(int, x), CTRL, 0xf, 0xf, true));
}
__device__ __forceinline__ float red16(float x) {
    x = dpp_add<0xB1>(x);
    x = dpp_add<0x4E>(x);
    x = dpp_add<0x141>(x);
    x = dpp_add<0x140>(x);
    return x;
}
template <int CTRL, int RM> __device__ __forceinline__ float dpp_max(float x) {
    return fmaxf(x, __builtin_bit_cast(float, __builtin_amdgcn_update_dpp(__builtin_bit_cast(int, x), __builtin_bit_cast(int, x), CTRL, RM, 0xf, false)));
}
template <int CTRL, int RM> __device__ __forceinline__ float dpp_sum(float x) {
    return x + __builtin_bit_cast(float, __builtin_amdgcn_update_dpp(0, __builtin_bit_cast(int, x), CTRL, RM, 0xf, false));
}
__device__ __forceinline__ float wave_max_u(float x) {
    x = dpp_max<0xB1, 0xf>(x); x = dpp_max<0x4E, 0xf>(x); x = dpp_max<0x141, 0xf>(x); x = dpp_max<0x140, 0xf>(x);
    x = dpp_max<0x142, 0xa>(x); x = dpp_max<0x143, 0xc>(x);
    return __builtin_bit_cast(float, __builtin_amdgcn_readlane(__builtin_bit_cast(int, x), 63));
}
__device__ __forceinline__ float wave_sum_u(float x) {
    x = dpp_sum<0xB1, 0xf>(x); x = dpp_sum<0x4E, 0xf>(x); x = dpp_sum<0x141, 0xf>(x); x = dpp_sum<0x140, 0xf>(x);
    x = dpp_sum<0x142, 0xa>(x); x = dpp_sum<0x143, 0xc>(x);
    return __builtin_bit_cast(float, __builtin_amdgcn_readlane(__builtin_bit_cast(int, x), 63));
}
__device__ __forceinline__ float wave_sum(float v) { return wave_sum_u(v); }
__device__ __forceinline__ float bpermf(int srclane, float v) { return __builtin_bit_cast(float, __builtin_amdgcn_ds_bpermute(srclane << 2, __builtin_bit_cast(int, v))); }
__device__ __forceinline__ int bpermi(int srclane, int v) { return __builtin_amdgcn_ds_bpermute(srclane << 2, v); }

#define XB_TMO      128
#define XB_XCNT(j)  (256  + 64 * (j))
#define XB_XSUB(j)  (1280 + 64 * (j))
#define XB_XGEN(j)  (2304 + 64 * (j))
#define XB_TOP      3328
#define XB_TOPGEN   3392
#define XCD_BAR_WORDS 3456
#define XB_SPIN_CAP (1u << 20)

__device__ __forceinline__ unsigned xb_ld(unsigned* p)              { return __hip_atomic_load(p, __ATOMIC_RELAXED, __HIP_MEMORY_SCOPE_AGENT); }
__device__ __forceinline__ unsigned xb_add(unsigned* p, unsigned v) { return __hip_atomic_fetch_add(p, v, __ATOMIC_RELAXED, __HIP_MEMORY_SCOPE_AGENT); }
__device__ __forceinline__ unsigned xb_xcc_id() { return (unsigned)__builtin_amdgcn_s_getreg((3 << 11) | 20) & 0xFu; }
#define XB_SPIN(cond, bar) do { unsigned _sp = 0; while (cond) { __builtin_amdgcn_s_sleep(1); \
    if ((++_sp & 255u) == 0u) { if (xb_ld(&(bar)[XB_TMO])) break; if (_sp > XB_SPIN_CAP) { atomicAdd(&(bar)[XB_TMO], 1u); break; } } } } while (0)

struct XcdBarrier { unsigned* bar; unsigned x; volatile LAS unsigned* st; };

__device__ __forceinline__ XcdBarrier xcd_barrier_post(unsigned* bar, volatile LAS unsigned* st, bool t0) {
    XcdBarrier b; b.bar = bar; b.x = xb_xcc_id(); b.st = st;
    if (t0) (void)xb_add(&bar[XB_XCNT(b.x)], 1u);
    return b;
}
__device__ __forceinline__ void xcd_barrier_complete(unsigned* bar, unsigned x, unsigned& nloc, unsigned& nx) {
    const unsigned G = gridDim.x * gridDim.y * gridDim.z;
    unsigned sum, cnt, mine, sp = 0u;
    for (;;) {
        sum = 0u; cnt = 0u; mine = 0u;
#pragma unroll
        for (unsigned j = 0; j < 16; ++j) { const unsigned c = xb_ld(&bar[XB_XCNT(j)]); sum += c; cnt += (c > 0u) ? 1u : 0u; mine = (j == x) ? c : mine; }
        if (sum == G) break;
        __builtin_amdgcn_s_sleep(1);
        if ((++sp & 255u) == 0u) { if (xb_ld(&bar[XB_TMO])) break; if (sp > XB_SPIN_CAP) { atomicAdd(&bar[XB_TMO], 1u); break; } }
    }
    nloc = mine > 0u ? mine : 1u; nx = cnt > 0u ? cnt : 1u;
}
__device__ __forceinline__ void xcd_barrier(const XcdBarrier& b, bool t0) {
    asm volatile("s_waitcnt vmcnt(0)" ::: "memory");
    __syncthreads();
    if (t0) {
        unsigned* bar = b.bar;
        __builtin_amdgcn_s_waitcnt(0);
        unsigned nloc = b.st[0], nx = b.st[1];
        if (nloc == 0u) { xcd_barrier_complete(bar, b.x, nloc, nx); b.st[0] = nloc; b.st[1] = nx; }
        const unsigned old = xb_add(&bar[XB_XSUB(b.x)], 1u);
        const unsigned gen = old / nloc;
        if (old + 1u == (gen + 1u) * nloc) {
            __builtin_amdgcn_fence(__ATOMIC_RELEASE, "agent");
            asm volatile("s_waitcnt vmcnt(0)" ::: "memory");
            const unsigned og = xb_add(&bar[XB_TOP], 1u);
            const unsigned tg = og / nx;
            if (og + 1u == (tg + 1u) * nx) xb_add(&bar[XB_TOPGEN], 1u);
            else XB_SPIN(xb_ld(&bar[XB_TOPGEN]) == tg, bar);
            __builtin_amdgcn_fence(__ATOMIC_ACQUIRE, "agent");
            xb_add(&bar[XB_XGEN(b.x)], 1u);
            asm volatile("s_waitcnt vmcnt(0)" ::: "memory");
        } else {
            XB_SPIN(xb_ld(&bar[XB_XGEN(b.x)]) == gen, bar);
            __builtin_amdgcn_fence(__ATOMIC_ACQUIRE, "agent");
            asm volatile("s_waitcnt vmcnt(0)" ::: "memory");
        }
    }
    __syncthreads();
}

struct Frame {
    LAS unsigned char* lds;
    unsigned char* ws;
    const float* const* in;
    int tid, lane, wave;
    int vcu, G;
};
struct Args { const float* in[33]; float* out; unsigned char* ws; int ph_lo, ph_hi; };


namespace pg8 {
typedef unsigned u32x4 __attribute__((ext_vector_type(4)));
struct RowOrder : StaticOrder {
    int lat;
    __host__ __device__ void init_rows(int lat_, int N, int G_, int c_) { lat = lat_; init(lat_ ? NBATCH * SEQ : MALL, N, G_, c_); }
    __host__ __device__ bool next(int i, Unit& u) const { if (!StaticOrder::next(i, u)) return false; if (lat) u.pm = 33 * (u.pm >> 5) + 1 + (u.pm & 31); return true; }
};
#define EPI_LOOP_ROWS for (int ai = 0; ai < 2; ++ai) _Pragma("unroll") for (int m = 0; m < 4; ++m)
#define EPI_PIN asm volatile("" ::: "memory")

struct EpiStoreBf16 {
    static constexpr bool PERM = true, AFTER_DRAIN = false;
    bf16_t* O; int ldc;
    __device__ __forceinline__ void operator()(const f32x4 (&acc)[2][2][4][2], const Unit& u, int wr, int wc, int fr, int fq) const {
        const int row0 = u.pm * BM + wr * 64 + fr, col0 = u.pn * BM + wc * 32 + 8 * fq;
#pragma unroll
        EPI_LOOP_ROWS { bf16_t* rowp = O + (size_t)(row0 + ai * HALF + m * 16) * ldc + col0;
#pragma unroll
            for (int bj = 0; bj < 2; ++bj) { const f32x4 v0 = acc[ai][bj][m][0], v1 = acc[ai][bj][m][1];
                u32x4 w; w.x = cvt_pk_bf16(v0[0], v0[1]); w.y = cvt_pk_bf16(v0[2], v0[3]); w.z = cvt_pk_bf16(v1[0], v1[1]); w.w = cvt_pk_bf16(v1[2], v1[3]);
                *(u32x4*)(rowp + bj * HALF) = w; } }
    }
};
struct EpiGate {
    static constexpr bool PERM = true, AFTER_DRAIN = false;
    bf16_t* O; int ldc; const float* bias;
    __device__ __forceinline__ void operator()(const f32x4 (&acc)[2][2][4][2], const Unit& u, int wr, int wc, int fr, int fq) const {
        const int row0 = u.pm * BM + wr * 64 + fr, col0 = u.pn * BM + wc * 32 + 8 * fq;
        f32x4 bv[2][2];
#pragma unroll
        for (int bj = 0; bj < 2; ++bj)
#pragma unroll
            for (int n = 0; n < 2; ++n) bv[bj][n] = *(const f32x4*)(bias + col0 + bj * HALF + 4 * n);
#pragma unroll
        EPI_LOOP_ROWS { EPI_PIN; bf16_t* rowp = O + (size_t)(row0 + ai * HALF + m * 16) * ldc + col0;
#pragma unroll
            for (int bj = 0; bj < 2; ++bj) { f32x4 v0 = acc[ai][bj][m][0] + bv[bj][0], v1 = acc[ai][bj][m][1] + bv[bj][1];
#pragma unroll
                for (int e = 0; e < 4; ++e) { v0[e] = __builtin_amdgcn_rcpf(1.0f + __expf(-v0[e])); v1[e] = __builtin_amdgcn_rcpf(1.0f + __expf(-v1[e])); }
                u32x4 w; w.x = cvt_pk_bf16(v0[0], v0[1]); w.y = cvt_pk_bf16(v0[2], v0[3]); w.z = cvt_pk_bf16(v1[0], v1[1]); w.w = cvt_pk_bf16(v1[2], v1[3]);
                *(u32x4*)(rowp + bj * HALF) = w; } }
    }
};
__device__ __forceinline__ float bf_lo(unsigned w) { return __builtin_bit_cast(float, w << 16); }
__device__ __forceinline__ float bf_hi(unsigned w) { return __builtin_bit_cast(float, w & 0xffff0000u); }
struct EpiMulAdd {
    static constexpr bool PERM = true, AFTER_DRAIN = false;
    bf16_t* O; const bf16_t* Gt; const bf16_t* Ad; int ldc;
    __device__ __forceinline__ void operator()(const f32x4 (&acc)[2][2][4][2], const Unit& u, int wr, int wc, int fr, int fq) const {
        const int row0 = u.pm * BM + wr * 64 + fr, col0 = u.pn * BM + wc * 32 + 8 * fq;
#pragma unroll
        EPI_LOOP_ROWS { EPI_PIN; const size_t ro = (size_t)(row0 + ai * HALF + m * 16) * ldc + col0;
#pragma unroll
            for (int bj = 0; bj < 2; ++bj) { const f32x4 v0 = acc[ai][bj][m][0], v1 = acc[ai][bj][m][1];
                const u32x4 g = *(const u32x4*)(Gt + ro + bj * HALF);
                float o[8];
                o[0] = bf_lo(g.x) * v0[0]; o[1] = bf_hi(g.x) * v0[1]; o[2] = bf_lo(g.y) * v0[2]; o[3] = bf_hi(g.y) * v0[3];
                o[4] = bf_lo(g.z) * v1[0]; o[5] = bf_hi(g.z) * v1[1]; o[6] = bf_lo(g.w) * v1[2]; o[7] = bf_hi(g.w) * v1[3];
                if (Ad) { const u32x4 a = *(const u32x4*)(Ad + ro + bj * HALF);
                    o[0] += bf_lo(a.x); o[1] += bf_hi(a.x); o[2] += bf_lo(a.y); o[3] += bf_hi(a.y); o[4] += bf_lo(a.z); o[5] += bf_hi(a.z); o[6] += bf_lo(a.w); o[7] += bf_hi(a.w); }
                u32x4 w; w.x = cvt_pk_bf16(o[0], o[1]); w.y = cvt_pk_bf16(o[2], o[3]); w.z = cvt_pk_bf16(o[4], o[5]); w.w = cvt_pk_bf16(o[6], o[7]);
                *(u32x4*)(O + ro + bj * HALF) = w; } }
    }
};
struct EpiResid {
    static constexpr bool PERM = true, AFTER_DRAIN = false;
    bf16_t* X; const float* gate;
    const float* xin; const float* cin;
    __device__ __forceinline__ void operator()(const f32x4 (&acc)[2][2][4][2], const Unit& u, int wr, int wc, int fr, int fq) const {
        const int col0 = u.pn * BM + wc * 32 + 8 * fq;
        const int bb = u.pm / 33, pt = u.pm - bb * 33, mr = (pt == 0) ? 2 : bb;
        const float* gp = gate + (size_t)mr * 12288 + col0;
        const float* sbase = xin ? (pt == 0 ? cin + (size_t)bb * CTXL * DM : xin + ((size_t)bb * SEQ + (size_t)(pt - 1) * BM) * DM) : nullptr;
        f32x4 gv[2][2];
#pragma unroll
        for (int bj = 0; bj < 2; ++bj)
#pragma unroll
            for (int n = 0; n < 2; ++n) gv[bj][n] = *(const f32x4*)(gp + bj * HALF + n * 4);
#pragma unroll
        EPI_LOOP_ROWS { EPI_PIN; const int rl = wr * 64 + fr + ai * HALF + m * 16; bf16_t* rowp = X + (size_t)(u.pm * BM + rl) * DM + col0;
#pragma unroll
            for (int bj = 0; bj < 2; ++bj) { f32x4 s0, s1;
                if (sbase) { const float* srow = sbase + (size_t)rl * DM + col0 + bj * HALF; s0 = *(const f32x4*)srow; s1 = *(const f32x4*)(srow + 4); }
                else { const u32x4 w = *(const u32x4*)(rowp + bj * HALF);
                    s0 = (f32x4){__builtin_bit_cast(float, w.x << 16), __builtin_bit_cast(float, w.x & 0xffff0000u), __builtin_bit_cast(float, w.y << 16), __builtin_bit_cast(float, w.y & 0xffff0000u)};
                    s1 = (f32x4){__builtin_bit_cast(float, w.z << 16), __builtin_bit_cast(float, w.z & 0xffff0000u), __builtin_bit_cast(float, w.w << 16), __builtin_bit_cast(float, w.w & 0xffff0000u)}; }
                const f32x4 r0 = s0 + gv[bj][0] * acc[ai][bj][m][0], r1 = s1 + gv[bj][1] * acc[ai][bj][m][1];
                u32x4 o; o.x = cvt_pk_bf16(r0[0], r0[1]); o.y = cvt_pk_bf16(r0[2], r0[3]); o.z = cvt_pk_bf16(r1[0], r1[1]); o.w = cvt_pk_bf16(r1[2], r1[3]);
                *(u32x4*)(rowp + bj * HALF) = o; } }
    }
};
struct EpiF32 {
    static constexpr bool PERM = false, AFTER_DRAIN = false;
    float* C; int ldc;
    __device__ __forceinline__ void operator()(const f32x4 (&acc)[2][2][4][2], const Unit& u, int wr, int wc, int fr, int fq) const {
        const int row0 = u.pm * BM + wr * 64 + fr, col0 = u.pn * BM + wc * 32 + 4 * fq;
#pragma unroll
        EPI_LOOP_ROWS { float* rowp = C + (size_t)(row0 + ai * HALF + m * 16) * ldc + col0;
#pragma unroll
            for (int bj = 0; bj < 2; ++bj)
#pragma unroll
                for (int n = 0; n < 2; ++n) *(f32x4*)(rowp + bj * HALF + n * 16) = acc[ai][bj][m][n]; }
    }
};
struct EpiF16 {
    static constexpr bool PERM = true, AFTER_DRAIN = false;
    _Float16* C; int ldc;
    __device__ __forceinline__ void operator()(const f32x4 (&acc)[2][2][4][2], const Unit& u, int wr, int wc, int fr, int fq) const {
        typedef _Float16 h2 __attribute__((ext_vector_type(2)));
        const int row0 = u.pm * BM + wr * 64 + fr, col0 = u.pn * BM + wc * 32 + 8 * fq;
#pragma unroll
        EPI_LOOP_ROWS { _Float16* rowp = C + (size_t)(row0 + ai * HALF + m * 16) * ldc + col0;
#pragma unroll
            for (int bj = 0; bj < 2; ++bj) { const f32x4 v0 = acc[ai][bj][m][0], v1 = acc[ai][bj][m][1];
                u32x4 w; w.x = __builtin_bit_cast(unsigned, (h2){(_Float16)v0[0], (_Float16)v0[1]}); w.y = __builtin_bit_cast(unsigned, (h2){(_Float16)v0[2], (_Float16)v0[3]});
                w.z = __builtin_bit_cast(unsigned, (h2){(_Float16)v1[0], (_Float16)v1[1]}); w.w = __builtin_bit_cast(unsigned, (h2){(_Float16)v1[2], (_Float16)v1[3]});
                *(u32x4*)(rowp + bj * HALF) = w; } }
    }
};
struct EpiQ {
    static constexpr bool PERM = true, AFTER_DRAIN = false;
    bf16_t* Q; const f32x2* rope; float qscale;
    __device__ __forceinline__ void operator()(const f32x4 (&acc)[2][2][4][2], const Unit& u, int wr, int wc, int fr, int fq) const {
        const int bb = u.pm / 33, tp0 = (u.pm - bb * 33) * BM + wr * 64 + fr, col0 = u.pn * BM + wc * 32 + 8 * fq;
#pragma unroll
        for (int bj = 0; bj < 2; ++bj) { const int c = col0 + bj * HALF, hd = c / QKD, d = c - hd * QKD;
#pragma unroll
            EPI_LOOP_ROWS { EPI_PIN; const int tp = tp0 + ai * HALF + m * 16;
                f32x4 v0 = acc[ai][bj][m][0], v1 = acc[ai][bj][m][1];
                if (d >= 64) { const int i0 = (d - 64) >> 1; const f32x2* rp = rope + (size_t)tp * 16 + i0;
                    const f32x2 c0 = rp[0], c1 = rp[1], c2 = rp[2], c3 = rp[3];
                    float a, b;
                    a = v0[0]; b = v0[1]; v0[0] = a * c0.x - b * c0.y; v0[1] = a * c0.y + b * c0.x;
                    a = v0[2]; b = v0[3]; v0[2] = a * c1.x - b * c1.y; v0[3] = a * c1.y + b * c1.x;
                    a = v1[0]; b = v1[1]; v1[0] = a * c2.x - b * c2.y; v1[1] = a * c2.y + b * c2.x;
                    a = v1[2]; b = v1[3]; v1[2] = a * c3.x - b * c3.y; v1[3] = a * c3.y + b * c3.x; }
                v0 = v0 * qscale; v1 = v1 * qscale;
                u32x4 w; w.x = cvt_pk_bf16(v0[0], v0[1]); w.y = cvt_pk_bf16(v0[2], v0[3]); w.z = cvt_pk_bf16(v1[0], v1[1]); w.w = cvt_pk_bf16(v1[2], v1[3]);
                *(u32x4*)(Q + ((size_t)(bb * NH + hd) * TPB + tp) * QKD + d) = w; } }
    }
};
struct EpiKV {
    static constexpr bool PERM = true, AFTER_DRAIN = false;
    bf16_t* K; bf16_t* V;
    __device__ __forceinline__ void operator()(const f32x4 (&acc)[2][2][4][2], const Unit& u, int wr, int wc, int fr, int fq) const {
        const int bb = u.pm / 33, tp0 = (u.pm - bb * 33) * BM + wr * 64 + fr;
        const bool isK = wc < 2;
        bf16_t* base = isK ? K : V; const int pitch = isK ? QKD : 64, doff = 32 * (wc & 1) + 8 * fq;
#pragma unroll
        for (int bj = 0; bj < 2; ++bj) { const int hd = 2 * u.pn + bj;
            bf16_t* hb = base + (size_t)(bb * NH + hd) * TPB * pitch;
#pragma unroll
            EPI_LOOP_ROWS { EPI_PIN; const int tp = tp0 + ai * HALF + m * 16;
                const f32x4 v0 = acc[ai][bj][m][0], v1 = acc[ai][bj][m][1];
                u32x4 w; w.x = cvt_pk_bf16(v0[0], v0[1]); w.y = cvt_pk_bf16(v0[2], v0[3]); w.z = cvt_pk_bf16(v1[0], v1[1]); w.w = cvt_pk_bf16(v1[2], v1[3]);
                *(u32x4*)((char*)hb + (unsigned)((tp * pitch + doff) * 2)) = w; } }
    }
};
}

struct TItem { const float* W; bf16* WT; int K, ldw, c0, N, mapq, item; };
__device__ __forceinline__ void p0_item_load(const TItem& T, int lane, f32x4 (&x)[8]) {
    const int nblk = T.N / 32, kb = T.item / nblk, nb = T.item - kb * nblk, k0 = 64 * kb, n0 = 32 * nb;
    const float* p = T.W + (size_t)(k0 + (lane >> 3)) * T.ldw + T.c0 + n0 + (lane & 7) * 4;
#pragma unroll
    for (int i = 0; i < 8; ++i) x[i] = *(const GAS f32x4*)(p + (size_t)(8 * i) * T.ldw);
}
__device__ __forceinline__ void p0_item_finish(const TItem& T, const f32x4 (&x)[8], LAS float* scr, int lane) {
    const int nblk = T.N / 32, kb = T.item / nblk, nb = T.item - kb * nblk, k0 = 64 * kb, n0 = 32 * nb;
#pragma unroll
    for (int i = 0; i < 8; ++i) { LAS float* d = scr + (8 * i + (lane >> 3)) * 33 + (lane & 7) * 4; d[0] = x[i].x; d[1] = x[i].y; d[2] = x[i].z; d[3] = x[i].w; }
    LDS_WAIT(); asm volatile("" ::: "memory");
    const int c = lane & 7;
#pragma unroll
    for (int j = 0; j < 4; ++j) { const int n = (lane >> 3) + 8 * j; const LAS float* s = scr + (8 * c) * 33 + n;
        v4u o; o.x = pk2(s[0 * 33], s[1 * 33]); o.y = pk2(s[2 * 33], s[3 * 33]); o.z = pk2(s[4 * 33], s[5 * 33]); o.w = pk2(s[6 * 33], s[7 * 33]);
        int nn = n0 + n;
        if (T.mapq) { const int hd = nn / QKD, d = nn - hd * QKD; if (d >= 64) { const int i = (d - 64) & 15, s2 = (d - 64) >> 4; nn = hd * QKD + 64 + 2 * i + s2; } }
        *(GAS v4u*)(T.WT + (size_t)nn * T.K + k0 + 8 * c) = o; }
    LDS_WAIT(); asm volatile("" ::: "memory");
}

__device__ __forceinline__ const float* karg(int i);
constexpr int TB_INA = (DM / 128) * ((INA + 127) / 128), TB_G = (DM / 128) * (DM / 128), TB_BR = (RW / 128) * (DM / 128), TB_UQ = (512 / 128) * (NQ / 128), TB_UKV = (256 / 128) * (NKV / 128);
constexpr int TB_N = TB_INA + 2 * TB_G + 2 * TB_BR + TB_G + TB_UQ + TB_UKV;
constexpr int TI_LR = 1 * (RW / 32), TI_N = 4 * TI_LR;
__device__ __forceinline__ TItem p0_resolve_big(unsigned char* ws, int git) {
    const int l = git / TB_N; int r = git - l * TB_N; TItem T; T.mapq = 0; T.c0 = 0;
    if (r < TB_INA) { T.W = karg(7) + (size_t)l * DM * INC; T.K = DM; T.ldw = INC; T.N = INA; T.WT = (bf16*)(ws + WS_WINA) + (size_t)l * INA_P * DM; T.item = r; return T; } r -= TB_INA;
    if (r < TB_G) { T.W = karg(7) + (size_t)l * DM * INC; T.K = DM; T.ldw = INC; T.c0 = INA; T.N = DM; T.WT = (bf16*)(ws + WS_WGA) + (size_t)l * DM * DM; T.item = r; return T; } r -= TB_G;
    if (r < TB_G) { T.W = karg(7) + (size_t)l * DM * INC; T.K = DM; T.ldw = INC; T.c0 = INA + DM; T.N = DM; T.WT = (bf16*)(ws + WS_WGB) + (size_t)l * DM * DM; T.item = r; return T; } r -= TB_G;
    if (r < TB_BR) { T.W = karg(24) + (size_t)l * RW * DM; T.K = RW; T.ldw = DM; T.N = DM; T.WT = (bf16*)(ws + WS_WA) + (size_t)l * DM * RW; T.item = r; return T; } r -= TB_BR;
    if (r < TB_BR) { T.W = karg(25) + (size_t)l * RW * DM; T.K = RW; T.ldw = DM; T.N = DM; T.WT = (bf16*)(ws + WS_WB) + (size_t)l * DM * RW; T.item = r; return T; } r -= TB_BR;
    if (r < TB_G) { T.W = karg(26) + (size_t)l * DM * DM; T.K = DM; T.ldw = DM; T.N = DM; T.WT = (bf16*)(ws + WS_WO) + (size_t)l * DM * DM; T.item = r; return T; } r -= TB_G;
    if (r < TB_UQ) { T.W = karg(21) + (size_t)l * 512 * NQ; T.K = 512; T.ldw = NQ; T.N = NQ; T.WT = (bf16*)(ws + WS_WUQ) + (size_t)l * NQ * 512; T.item = r; T.mapq = 1; return T; } r -= TB_UQ;
    { T.W = karg(23) + (size_t)l * 256 * NKV; T.K = 256; T.ldw = NKV; T.N = NKV; T.WT = (bf16*)(ws + WS_WUKV) + (size_t)l * NKV * 256; T.item = r; return T; }
}
__device__ __forceinline__ void p0_big_load(const TItem& T, int tid, f32x4 (&x)[8]) {
    const int nblk = (T.N + 127) / 128, kb = T.item / nblk, nb = T.item - kb * nblk, k0 = 128 * kb, col = 128 * nb + (tid & 31) * 4;
    const float* p = T.W + (size_t)(k0 + (tid >> 5)) * T.ldw + T.c0 + col; const bool ok = col < T.N;
#pragma unroll
    for (int i = 0; i < 8; ++i) x[i] = ok ? *(const GAS f32x4*)(p + (size_t)(16 * i) * T.ldw) : (f32x4){0.f, 0.f, 0.f, 0.f};
}
__device__ __forceinline__ void p0_big_finish(const TItem& T, const f32x4 (&x)[8], LAS float* tile, int tid) {
    const int nblk = (T.N + 127) / 128, kb = T.item / nblk, nb = T.item - kb * nblk, k0 = 128 * kb, n0 = 128 * nb;
    __syncthreads();
#pragma unroll
    for (int i = 0; i < 8; ++i) *(LAS f32x4*)(tile + ((tid >> 5) + 16 * i) * 132 + (tid & 31) * 4) = x[i];
    __syncthreads();
    const int n = tid & 127, cg = tid >> 7; int nn = n0 + n;
    if (nn < T.N) {
        if (T.mapq) { const int hd = nn / QKD, d = nn - hd * QKD; if (d >= 64) { const int i = (d - 64) & 15, s2 = (d - 64) >> 4; nn = hd * QKD + 64 + 2 * i + s2; } }
#pragma unroll
        for (int c = 0; c < 4; ++c) { const LAS float* s = tile + (32 * cg + 8 * c) * 132 + n;
            v4u o; o.x = pk2(s[0 * 132], s[1 * 132]); o.y = pk2(s[2 * 132], s[3 * 132]); o.z = pk2(s[4 * 132], s[5 * 132]); o.w = pk2(s[6 * 132], s[7 * 132]);
            *(GAS v4u*)(T.WT + (size_t)nn * T.K + k0 + 32 * cg + 8 * c) = o; } }
}
__device__ __forceinline__ TItem p0_resolve(unsigned char* ws, int git) {
    const int l = git / TI_N; int r = git - l * TI_N; TItem T; T.mapq = 0; T.c0 = 0;
    const int which = r / TI_LR, d = which & 1, isa = which >> 1; r -= which * TI_LR;
    T.W = (isa ? karg(13) : karg(11)) + (size_t)(l * 2 + d) * 64 * RW; T.K = 64; T.ldw = RW; T.N = RW; T.WT = (bf16*)(ws + (isa ? WS_AUP : WS_WUP)) + (size_t)(l * 2 + d) * RW * 64; T.item = r; return T;
}
__device__ __forceinline__ void p0_prologue(Frame& F, int l_lo, int l_hi, int svcu, int sG) {
    LAS float* scr = (LAS float*)(F.lds + F.wave * 16384);
    const int gw = svcu * NWAVES + F.wave, NGW = sG * NWAVES;
    unsigned char* ws = F.ws;
    for (int rp_ = 0; rp_ < (DBG_REPEAT == 102 ? 2 : 1); ++rp_)
    { float* modw = (float*)(ws + WS_CTL + CTL_MOD_OFF); const float* adaw = karg(4); const float* adab = karg(5); const float* cin = karg(1); const float* cctx = karg(3);
      LAS float* SIL = (LAS float*)F.lds;
      LAS f32x2* part = (LAS f32x2*)(F.lds + 32768);
      if (svcu >= 0 && l_lo * 96 + svcu < l_hi * 96) {
          for (int i = F.tid; i < 3 * DM; i += 512) { const int r = i >> 11, k = i & 2047; const float c = r < 2 ? cin[r * DM + k] : cctx[k]; SIL[i] = c / (1.f + __expf(-c)); }
          __syncthreads(); }
      if (svcu >= 0) for (int uu = l_lo * 96 + svcu; uu < l_hi * 96; uu += sG) { const int cb = uu % 96, l = uu / 96;
          const int n0 = cb * 128 + F.lane * 2; const float* aw = adaw + (size_t)l * DM * 12288 + n0;
          f32x2 a0 = {0, 0}, a1 = a0, a2 = a0;
#pragma unroll 1
          for (int k0 = F.wave * 256; k0 < F.wave * 256 + 256; k0 += 16) { f32x2 w[16];
#pragma unroll
              for (int j = 0; j < 16; ++j) w[j] = *(const GAS f32x2*)(aw + (size_t)(k0 + j) * 12288);
#pragma unroll
              for (int j = 0; j < 16; ++j) { a0 = a0 + w[j] * SIL[k0 + j]; a1 = a1 + w[j] * SIL[DM + k0 + j]; a2 = a2 + w[j] * SIL[2 * DM + k0 + j]; } }
          __syncthreads();
          part[(F.wave * 3 + 0) * 64 + F.lane] = a0; part[(F.wave * 3 + 1) * 64 + F.lane] = a1; part[(F.wave * 3 + 2) * 64 + F.lane] = a2;
          __syncthreads();
          if (F.wave < 3) { f32x2 s = *(const GAS f32x2*)(adab + (size_t)l * 12288 + n0);
#pragma unroll
              for (int w8 = 0; w8 < 8; ++w8) s = s + part[(w8 * 3 + F.wave) * 64 + F.lane];
              *(GAS f32x2*)(modw + ((size_t)l * 3 + F.wave) * 12288 + n0) = s; }
          __syncthreads(); } }
    for (int rp_ = 0; rp_ < (DBG_REPEAT == 101 ? 2 : 1); ++rp_)
    { unsigned* ctr = (unsigned*)(ws + WS_CTL) + 2048 + 64 * rp_ + 128 * l_lo; LAS float* tile = (LAS float*)F.lds; LAS int* slot = (LAS int*)(F.lds + 128 * 132 * 4);
#define P0_GRAB(dst) do { __syncthreads(); if (F.tid == 0) *slot = (int)__hip_atomic_fetch_add(ctr, 1u, __ATOMIC_RELAXED, __HIP_MEMORY_SCOPE_AGENT); __syncthreads(); dst = *slot; } while (0)
      const int it_end = l_hi * TB_N;
      int it; P0_GRAB(it); it += l_lo * TB_N; f32x4 xa[8], xb[8]; TItem T, Tn;
      if (it < it_end) { T = p0_resolve_big(ws, it); p0_big_load(T, F.tid, xa); }
      while (it < it_end) { int itn; P0_GRAB(itn); itn += l_lo * TB_N; const bool more = itn < it_end;
          if (more) { Tn = p0_resolve_big(ws, itn); p0_big_load(Tn, F.tid, xb); }
          p0_big_finish(T, xa, tile, F.tid);
          if (more) { T = Tn;
#pragma unroll
              for (int i = 0; i < 8; ++i) xa[i] = xb[i]; }
          it = itn; }
#undef P0_GRAB
      __syncthreads();
      if (svcu >= 0) for (int itw = l_lo * TI_N + gw; itw < l_hi * TI_N; itw += NGW) { f32x4 xw[8]; const TItem Tw = p0_resolve(ws, itw); p0_item_load(Tw, F.lane, xw); p0_item_finish(Tw, xw, scr, F.lane); }
    }
    const int gt = gw * 64 + F.lane, NGT = NGW * 64;
    { const float* gup = karg(14);
    if (svcu >= 0) for (int i = l_lo * 2 * 32 * RW + gt; i < l_hi * 2 * 32 * RW; i += NGT) { const int ch = i & 1023, r = (i >> 10) & 31, ld = i >> 15;
        ((bf16*)(ws + WS_GUP))[((size_t)ld * RW + ch) * 32 + r] = (bf16)f2bf(gup[i]); } }
    if (svcu >= 0) for (int i = l_lo * ((INA_P - INA) * DM / 8) + gt; i < l_hi * ((INA_P - INA) * DM / 8); i += NGT) { const int l = i / ((INA_P - INA) * DM / 8), r = i - l * ((INA_P - INA) * DM / 8);
        ((GAS v4u*)((bf16*)(ws + WS_WINA) + ((size_t)l * INA_P + INA) * DM))[r] = (v4u){0u, 0u, 0u, 0u}; }
    { f32x2* rt = (f32x2*)(ws + WS_ROPE);
      if (l_lo == 0 && svcu >= 0) for (int i = gt; i < TPB * 16; i += NGT) { const int tp = i >> 4, k = i & 15; f32x2 o = {1.f, 0.f};
          if (tp >= CTXL) { const int t = tp - CTXL, row = t >> 6, col = t & 63, j = k & 7; const float fr = powf(10000.0f, -(float)j / 8.0f);
              const float ang = (float)(k < 8 ? row : col) * fr; o.x = cosf(ang); o.y = sinf(ang); }
          rt[i] = o; } }
    for (int rp_ = 0; rp_ < (DBG_REPEAT == 103 ? 2 : 1); ++rp_)
    { LAS float* KEY = (LAS float*)F.lds;
      LAS float* WQT = (LAS float*)(F.lds + 65536);
      const float* pkeys = karg(29); const float* pwq = karg(28);
      __syncthreads();
      if (svcu >= 0) for (int uu = l_lo * 512 + svcu; uu < l_hi * 512; uu += sG) { const int kb = uu & 31, hp = (uu >> 5) & 15, l = uu >> 9;
          const GAS f32x4* ksrc = (const GAS f32x4*)(pkeys + ((size_t)l * 16 + hp) * 16384);
          for (int i = F.tid; i < 4096; i += 512) ((LAS f32x4*)KEY)[i] = ksrc[i];
          for (int i = F.tid; i < 2048; i += 512) { const int kk = i >> 5, d4 = i & 31;
              *(LAS f32x4*)(WQT + kk * 132 + d4 * 4) = *(const GAS f32x4*)(pwq + ((size_t)l * DM + kb * 64 + kk) * DM + hp * 128 + d4 * 4); }
          __syncthreads();
          const int kq = F.tid & 15, keyq = F.tid >> 4;
          float acc[4][4];
#pragma unroll
          for (int j = 0; j < 4; ++j)
#pragma unroll
              for (int i = 0; i < 4; ++i) acc[j][i] = 0.f;
          for (int d = 0; d < 128; d += 4) { f32x4 w[4], q[4];
#pragma unroll
              for (int i = 0; i < 4; ++i) w[i] = *(LAS f32x4*)(WQT + (kq + 16 * i) * 132 + d);
#pragma unroll
              for (int j = 0; j < 4; ++j) q[j] = *(LAS f32x4*)(KEY + (4 * keyq + j) * 128 + d);
#pragma unroll
              for (int j = 0; j < 4; ++j)
#pragma unroll
                  for (int i = 0; i < 4; ++i) acc[j][i] += q[j].x * w[i].x + q[j].y * w[i].y + q[j].z * w[i].z + q[j].w * w[i].w; }
          bf16* dst = (bf16*)(ws + WS_WQK) + ((size_t)l * DM + hp * 128 + 4 * keyq) * DM + kb * 64 + kq;
#pragma unroll
          for (int j = 0; j < 4; ++j)
#pragma unroll
              for (int i = 0; i < 4; ++i) dst[(size_t)j * DM + 16 * i] = (bf16)f2bf(acc[j][i]);
          __syncthreads(); } }
}

__device__ __forceinline__ const float* modnorm_src(int m, const float* X, const float* xin, const float* cin) {
    const int b = m / TPB, tp = m - b * TPB;
    return xin ? (tp < CTXL ? cin + ((size_t)b * CTXL + tp) * DM : xin + ((size_t)b * SEQ + (tp - CTXL)) * DM) : X + (size_t)m * DM;
}
__device__ __forceinline__ void modnorm_phase_bf(Frame& F, const bf16* X, const float* g, const float* mod  , int chunk_sh, bf16* H, int skip_ctx) {
    const int gw = F.vcu * NWAVES + F.wave, NGW = F.G * NWAVES;
    int m = gw; while (m < MALL && skip_ctx && (m % TPB) < CTXL) m += NGW;
    v4u v[4]; f32x4 ga[8], sb[8]; int mr_cur = -1;
    if (m < MALL) { const GAS v4u* xr = (const GAS v4u*)(X + (size_t)m * DM) + F.lane;
#pragma unroll
        for (int j = 0; j < 4; ++j) v[j] = xr[64 * j]; }
    while (m < MALL) {
        int mn = m + NGW; while (mn < MALL && skip_ctx && (mn % TPB) < CTXL) mn += NGW;
        v4u nv[4];
        if (mn < MALL) { const GAS v4u* xr = (const GAS v4u*)(X + (size_t)mn * DM) + F.lane;
#pragma unroll
            for (int j = 0; j < 4; ++j) nv[j] = xr[64 * j]; }
        const int b = m / TPB, tp = m - b * TPB, mr = tp < CTXL ? 2 : b;
        if (mr != mr_cur) { mr_cur = mr; const float* sh = mod + (size_t)mr * 12288 + chunk_sh * DM; const float* sc = sh + DM;
#pragma unroll
            for (int q = 0; q < 8; ++q) { const int c = (F.lane + 64 * (q >> 1)) * 8 + 4 * (q & 1); const f32x4 gg = *(const GAS f32x4*)(g + c), s1 = *(const GAS f32x4*)(sc + c); ga[q] = gg * (s1 + 1.0f); sb[q] = *(const GAS f32x4*)(sh + c); } }
        float x[4][8]; float s = 0.f;
#pragma unroll
        for (int j = 0; j < 4; ++j) { x[j][0] = bflo(v[j].x); x[j][1] = bfhi(v[j].x); x[j][2] = bflo(v[j].y); x[j][3] = bfhi(v[j].y); x[j][4] = bflo(v[j].z); x[j][5] = bfhi(v[j].z); x[j][6] = bflo(v[j].w); x[j][7] = bfhi(v[j].w);
#pragma unroll
            for (int e = 0; e < 8; ++e) s += x[j][e] * x[j][e]; }
        const float rs = rsqrtf(wave_sum(s) * (1.f / DM) + NORM_EPS);
        GAS v4u* o8 = (GAS v4u*)(H + (size_t)m * DM) + F.lane;
#pragma unroll
        for (int j = 0; j < 4; ++j) { float y[8];
#pragma unroll
            for (int e = 0; e < 8; ++e) y[e] = (x[j][e] * rs) * ga[2 * j + (e >> 2)][e & 3] + sb[2 * j + (e >> 2)][e & 3];
            v4u o; o.x = pk2(y[0], y[1]); o.y = pk2(y[2], y[3]); o.z = pk2(y[4], y[5]); o.w = pk2(y[6], y[7]); o8[64 * j] = o; }
#pragma unroll
        for (int j = 0; j < 4; ++j) v[j] = nv[j];
        m = mn;
    }
}
__device__ __forceinline__ void modnorm_phase(Frame& F, const float* X, const float* g, const float* mod  , int chunk_sh, bf16* H, int skip_ctx, const float* xin = nullptr, const float* cin = nullptr) {
    const int gw = F.vcu * NWAVES + F.wave, NGW = F.G * NWAVES;
    int m = gw; while (m < MALL && skip_ctx && (m % TPB) < CTXL) m += NGW;
    f32x4 v[8], ga[8], sb[8]; int mr_cur = -1;
    if (m < MALL) { const GAS f32x4* xr = (const GAS f32x4*)modnorm_src(m, X, xin, cin) + F.lane;
#pragma unroll
        for (int j = 0; j < 8; ++j) v[j] = xr[64 * j]; }
    while (m < MALL) {
        int mn = m + NGW; while (mn < MALL && skip_ctx && (mn % TPB) < CTXL) mn += NGW;
        f32x4 nv[8];
        if (mn < MALL) { const GAS f32x4* xr = (const GAS f32x4*)modnorm_src(mn, X, xin, cin) + F.lane;
#pragma unroll
            for (int j = 0; j < 8; ++j) nv[j] = xr[64 * j]; }
        const int b = m / TPB, tp = m - b * TPB, mr = tp < CTXL ? 2 : b;
        if (mr != mr_cur) { mr_cur = mr; const float* sh = mod + (size_t)mr * 12288 + chunk_sh * DM; const float* sc = sh + DM;
#pragma unroll
            for (int j = 0; j < 8; ++j) { const int c = (F.lane + 64 * j) * 4; const f32x4 gg = *(const GAS f32x4*)(g + c), s1 = *(const GAS f32x4*)(sc + c); ga[j] = gg * (s1 + 1.0f); sb[j] = *(const GAS f32x4*)(sh + c); } }
        float s = 0.f;
#pragma unroll
        for (int j = 0; j < 8; ++j) s += (v[j].x * v[j].x + v[j].y * v[j].y) + (v[j].z * v[j].z + v[j].w * v[j].w);
        const float rs = rsqrtf(wave_sum(s) * (1.f / DM) + NORM_EPS);
        GAS v2u* o8 = (GAS v2u*)(H + (size_t)m * DM) + F.lane;
#pragma unroll
        for (int j = 0; j < 8; ++j) { const f32x4 y = (v[j] * rs) * ga[j] + sb[j];
            v2u o; o.x = pk2(y.x, y.y); o.y = pk2(y.z, y.w); o8[64 * j] = o; }
#pragma unroll
        for (int j = 0; j < 8; ++j) v[j] = nv[j];
        m = mn;
    }
}

typedef float f32x4v __attribute__((ext_vector_type(4)));
#define MFMA16(a, b, c) __builtin_amdgcn_mfma_f32_16x16x32_bf16((a), (b), (c), 0, 0, 0)
#define MFMA32(a, b, c) __builtin_amdgcn_mfma_f32_32x32x16_bf16((a), (b), (c), 0, 0, 0)

struct FeatP {
    const bf16* PA; const float* mu; const float* w0; const float* a0; const float* k_k; const float* k_a; const float* r_k;
    const bf16* WUP; const bf16* AUP; const bf16* GUP;
    const float* qnorm; const float* kvnorm; const f32x2* rope;
    bf16* RI; bf16* GG; float* BON; bf16* QN; bf16* KVN; bf16* K;
};
__device__ __forceinline__ f32x4 ld4bf(const bf16* p) { const v2u w = *(const GAS v2u*)p; return (f32x4){bflo(w.x), bfhi(w.x), bflo(w.y), bfhi(w.y)}; }
__device__ __forceinline__ f32x4 mix4(const bf16* PA, int m, int c, bool hp, bool hn, const float* mu) {
    const f32x4 pc = ld4bf(PA + (size_t)m * INA_P + c);
    f32x4 pp = {0, 0, 0, 0}, pn = {0, 0, 0, 0};
    if (hp) pp = ld4bf(PA + (size_t)(m - 1) * INA_P + c);
    if (hn) pn = ld4bf(PA + (size_t)(m + 1) * INA_P + c);
    const f32x4 mm = *(const GAS f32x4*)(mu + c);
    return pc + ((pp + pn) * 0.5f - pc) * mm;
}
__device__ __forceinline__ void unpack8(const v4u w, float (&x)[8]) { x[0] = bflo(w.x); x[1] = bfhi(w.x); x[2] = bflo(w.y); x[3] = bfhi(w.y); x[4] = bflo(w.z); x[5] = bfhi(w.z); x[6] = bflo(w.w); x[7] = bfhi(w.w); }
__device__ __forceinline__ v4u pack8f(const float (&x)[8]) { v4u o; o.x = pk2(x[0], x[1]); o.y = pk2(x[2], x[3]); o.z = pk2(x[4], x[5]); o.w = pk2(x[6], x[7]); return o; }
__device__ __forceinline__ void mix8(const bf16* rowc, bool hp, bool hn, const float (&mu)[8], float (&o)[8]) {
    const v4u zc = {0u, 0u, 0u, 0u};
    const v4u wc = *(const GAS v4u*)rowc, wp = hp ? *(const GAS v4u*)(rowc - INA_P) : zc, wn = hn ? *(const GAS v4u*)(rowc + INA_P) : zc;
    float c[8], p[8], n[8]; unpack8(wc, c); unpack8(wp, p); unpack8(wn, n);
#pragma unroll
    for (int e = 0; e < 8; ++e) o[e] = c[e] + (0.5f * (p[e] + n[e]) - c[e]) * mu[e];
}
struct Raw3 { v4u c, p, n; };
__device__ __forceinline__ Raw3 load3(const bf16* rowc, bool hp, bool hn) { const v4u zc = {0u, 0u, 0u, 0u}; Raw3 r; r.c = *(const GAS v4u*)rowc; r.p = hp ? *(const GAS v4u*)(rowc - INA_P) : zc; r.n = hn ? *(const GAS v4u*)(rowc + INA_P) : zc; return r; }
__device__ __forceinline__ void mix8r(const Raw3& w, const float (&mu)[8], float (&o)[8]) {
    float c[8], p[8], n[8]; unpack8(w.c, c); unpack8(w.p, p); unpack8(w.n, n);
#pragma unroll
    for (int e = 0; e < 8; ++e) o[e] = c[e] + (0.5f * (p[e] + n[e]) - c[e]) * mu[e];
}
__device__ __forceinline__ void features_phase(Frame& F, const FeatP& P) {
    constexpr int LAP = 328;
    LAS bf16* LA = (LAS bf16*)F.lds;
    LAS float* SSQ = (LAS float*)(F.lds + 10752);
    LAS float* PRM = (LAS float*)(F.lds + 12288);
    const int lane = F.lane, w = F.wave, tk = lane & 15, q4 = lane >> 4;
    constexpr int NTILE = MALL / 16, NTG = 64;
    for (int su = F.vcu; su < 4 * NTG; su += F.G) {
        const int cg = su & 3, tg = su >> 2, cw = 256 * cg + 32 * w, ch8 = cw + 8 * q4, hd = 4 * cg + (w >> 1);
        __syncthreads();
        for (int i = F.tid; i < 2560; i += 512) { const int prm = i >> 8, c = (i & 255) + 256 * cg; float v;
            switch (prm) { case 0: v = P.k_k[c]; break; case 1: v = P.k_a[c]; break; case 2: v = P.r_k[c]; break; case 3: v = P.w0[c]; break; case 4: v = P.w0[RW + c]; break;
                           case 5: v = P.a0[c]; break; case 6: v = P.a0[RW + c]; break; case 7: v = P.mu[c]; break; case 8: v = P.mu[RW + c]; break; default: v = P.mu[2 * RW + c]; break; }
            PRM[i] = v; }
        bf16x8 fw[2][2][2], fa[2][2][2], fg[2][2];
        { const int chA = cw + 8 * (tk >> 2) + (tk & 3);
#pragma unroll
          for (int d = 0; d < 2; ++d)
#pragma unroll
              for (int t = 0; t < 2; ++t) {
#pragma unroll
                  for (int ks = 0; ks < 2; ++ks) { fw[d][t][ks] = *(const GAS bf16x8*)(P.WUP + ((size_t)d * RW + chA + 4 * t) * 64 + ks * 32 + q4 * 8); fa[d][t][ks] = *(const GAS bf16x8*)(P.AUP + ((size_t)d * RW + chA + 4 * t) * 64 + ks * 32 + q4 * 8); }
                  fg[d][t] = *(const GAS bf16x8*)(P.GUP + ((size_t)d * RW + chA + 4 * t) * 32 + q4 * 8); } }
        for (int tt = tg; tt < NTILE; tt += NTG) {
            const int m0 = tt * 16;
            const int m = m0 + tk, b = m / TPB, tp = m - b * TPB;
            const bool hp = (tp != 0) && (tp != CTXL), hn = (tp != CTXL - 1) && (tp != TPB - 1);
            const bf16* rowp = P.PA + (size_t)m * INA_P + ch8;
            const Raw3 rawk = load3(rowp + RW, hp, hn), rawr = load3(rowp, hp, hn), rawv = load3(rowp + 2 * RW, hp, hn);
            __syncthreads();
            for (int it = F.tid; it < 640; it += 512) { const int tkk = it / 40, c8 = (it - tkk * 40) * 8, c = C_WD + c8, m = m0 + tkk, tp = m % TPB;
                const bool hp = (tp != 0) && (tp != CTXL), hn = (tp != CTXL - 1) && (tp != TPB - 1);
                float mu[8], v[8];
                { const f32x4 a = *(const GAS f32x4*)(P.mu + c), b2 = *(const GAS f32x4*)(P.mu + c + 4); mu[0] = a.x; mu[1] = a.y; mu[2] = a.z; mu[3] = a.w; mu[4] = b2.x; mu[5] = b2.y; mu[6] = b2.z; mu[7] = b2.w; }
                mix8(P.PA + (size_t)m * INA_P + c, hp, hn, mu, v);
#pragma unroll
                for (int e = 0; e < 8; ++e) { if (c < C_AD) v[e] = 1.0f - 2.0f * __builtin_amdgcn_rcpf(1.0f + __expf(2.0f * v[e])); else if (c >= C_GD) v[e] = sigmoidf_(v[e]); }
                *(LAS v4u*)(LA + tkk * LAP + c8) = pack8f(v); }
            if ((tt & 3) == cg) {
#pragma unroll
                for (int t2 = 0; t2 < 2; ++t2) { const int m = m0 + 2 * w + t2, b = m / TPB, tp = m - b * TPB; const bf16* row = P.PA + (size_t)m * INA_P;
                    { float x[8]; unpack8(*(const GAS v4u*)(row + C_QC + lane * 8), x); float s = 0.f;
#pragma unroll
                      for (int e = 0; e < 8; ++e) s += x[e] * x[e];
                      const float rs = rsqrtf(wave_sum(s) * (1.f / 512.f) + NORM_EPS);
#pragma unroll
                      for (int e = 0; e < 8; ++e) x[e] = x[e] * rs * P.qnorm[lane * 8 + e];
                      *(GAS v4u*)(P.QN + (size_t)m * 512 + lane * 8) = pack8f(x); }
                    { const v2u q = *(const GAS v2u*)(row + C_KVC + lane * 4);
                      float x[4] = {bflo(q.x), bfhi(q.x), bflo(q.y), bfhi(q.y)}; float s = 0.f;
#pragma unroll
                      for (int e = 0; e < 4; ++e) s += x[e] * x[e];
                      const float rs = rsqrtf(wave_sum(s) * (1.f / 256.f) + NORM_EPS);
#pragma unroll
                      for (int e = 0; e < 4; ++e) x[e] = x[e] * rs * P.kvnorm[lane * 4 + e];
                      v2u o; o.x = pk2(x[0], x[1]); o.y = pk2(x[2], x[3]);
                      *(GAS v2u*)(P.KVN + (size_t)m * 256 + lane * 4) = o; }
                    if (lane < 16) { const float x1 = bf1(row[C_KR + lane]), x2 = bf1(row[C_KR + 16 + lane]); const f32x2 cs = P.rope[(size_t)tp * 16 + lane];
                        const unsigned o = pk2(x1 * cs.x - x2 * cs.y, x1 * cs.y + x2 * cs.x);
#pragma unroll
                        for (int h2 = 0; h2 < NH; ++h2) *(GAS unsigned*)(P.K + ((size_t)(b * NH + h2) * TPB + tp) * QKD + 64 + 2 * lane) = o; } } }
            const int pc = 32 * w + 8 * q4;
            float prm[8], kmx[8], kx[8];
#pragma unroll
            for (int e = 0; e < 8; ++e) prm[e] = PRM[8 * 256 + pc + e];
            mix8r(rawk, prm, kmx);
            { float s = 0.f;
#pragma unroll
              for (int e = 0; e < 8; ++e) { kx[e] = kmx[e] * PRM[0 * 256 + pc + e]; s += kx[e] * kx[e]; }
              s += bpermf(lane ^ 16, s); s += bpermf(lane ^ 32, s);
              if (q4 == 0) SSQ[tk * 8 + w] = s; }
            __syncthreads();
            const float rsn = rsqrtf(SSQ[tk * 8 + w] + SSQ[tk * 8 + (w ^ 1)] + 1e-12f);
            f32x4 cw_[2][2], ca_[2][2], cg_[2][2];
#pragma unroll
            for (int d = 0; d < 2; ++d) {
                const bf16x8 bg = *(const LAS bf16x8*)(LA + tk * LAP + 256 + d * 32 + q4 * 8);
                bf16x8 bw[2], ba[2];
#pragma unroll
                for (int ks = 0; ks < 2; ++ks) { bw[ks] = *(const LAS bf16x8*)(LA + tk * LAP + d * 64 + ks * 32 + q4 * 8); ba[ks] = *(const LAS bf16x8*)(LA + tk * LAP + 128 + d * 64 + ks * 32 + q4 * 8); }
#pragma unroll
                for (int t = 0; t < 2; ++t) { f32x4 z = {0, 0, 0, 0};
                    cw_[d][t] = MFMA16(fw[d][t][1], bw[1], MFMA16(fw[d][t][0], bw[0], z));
                    ca_[d][t] = MFMA16(fa[d][t][1], ba[1], MFMA16(fa[d][t][0], ba[0], z));
                    cg_[d][t] = MFMA16(fg[d][t], bg, z); } }
            float r8[8], v8[8], kk8[8];
#pragma unroll
            for (int e = 0; e < 8; ++e) prm[e] = PRM[7 * 256 + pc + e];
            mix8r(rawr, prm, r8);
#pragma unroll
            for (int e = 0; e < 8; ++e) prm[e] = PRM[9 * 256 + pc + e];
            mix8r(rawv, prm, v8);
#pragma unroll
            for (int e = 0; e < 8; ++e) kk8[e] = kx[e] * rsn;
            bf16* rec = P.RI + ((size_t)(b * NH + hd) * TPB + tp) * RREC + (ch8 & 63);
            *(GAS v4u*)(rec) = pack8f(r8); *(GAS v4u*)(rec + 64) = pack8f(kk8); *(GAS v4u*)(rec + 128) = pack8f(v8);
#pragma unroll
            for (int d = 0; d < 2; ++d) {
                float ld[8], ke[8], bb[8], gg[8]; float bs = 0.f;
#pragma unroll
                for (int e = 0; e < 8; ++e) { const int t = e >> 2, r = e & 3;
                    ld[e] = -0.60653066f * sigmoidf_(PRM[(3 + d) * 256 + pc + e] + cw_[d][t][r]);
                    const float aa = sigmoidf_(PRM[(5 + d) * 256 + pc + e] + ca_[d][t][r]);
                    ke[e] = kmx[e] * (1.0f + (aa - 1.0f) * PRM[1 * 256 + pc + e]); bb[e] = kk8[e] * aa; gg[e] = cg_[d][t][r];
                    bs += r8[e] * ke[e] * PRM[2 * 256 + pc + e]; }
                *(GAS v4u*)(rec + (3 + 3 * d) * 64) = pack8f(ld); *(GAS v4u*)(rec + (4 + 3 * d) * 64) = pack8f(bb); *(GAS v4u*)(rec + (5 + 3 * d) * 64) = pack8f(ke);
                *(GAS v4u*)(P.GG + ((size_t)d * MALL + m) * RW + ch8) = pack8f(gg);
                bs += bpermf(lane ^ 16, bs); bs += bpermf(lane ^ 32, bs);
                if (q4 == 0) P.BON[((size_t)d * MALL + m) * 32 + 2 * hd + (w & 1)] = bs; }
        }
    }
}

__device__ __forceinline__ void cvt_row_load(f32x4 (&x)[8], const float* src) {
#pragma unroll
    for (int q = 0; q < 8; ++q) x[q] = *(const GAS f32x4*)(src + q * 4);
}
__device__ __forceinline__ void cvt_row_store(const f32x4 (&x)[8], unsigned char* dst, float* scale_slot, int lane) {
    float am = 0.f;
#pragma unroll
    for (int q = 0; q < 8; ++q) am = fmaxf(am, fmaxf(fmaxf(fabsf(x[q].x), fabsf(x[q].y)), fmaxf(fabsf(x[q].z), fabsf(x[q].w))));
    am = fmaxf(wave_max_u(am), 1e-30f);
    const float g = 6.0f / am, inv = am * (1.0f / 6.0f);
    v4u o;
#pragma unroll
    for (int q = 0; q < 4; ++q) { unsigned w = 0u;
        w = __builtin_amdgcn_cvt_scalef32_pk_fp4_f32(w, x[2 * q].x * g, x[2 * q].y * g, 1.0f, 0);
        w = __builtin_amdgcn_cvt_scalef32_pk_fp4_f32(w, x[2 * q].z * g, x[2 * q].w * g, 1.0f, 1);
        w = __builtin_amdgcn_cvt_scalef32_pk_fp4_f32(w, x[2 * q + 1].x * g, x[2 * q + 1].y * g, 1.0f, 2);
        w = __builtin_amdgcn_cvt_scalef32_pk_fp4_f32(w, x[2 * q + 1].z * g, x[2 * q + 1].w * g, 1.0f, 3);
        o[q] = w; }
    *(GAS v4u*)dst = o;
    if (lane == 0) *scale_slot = inv;
}
struct ScanCvt { const float* pu; const float* pv; unsigned char* PU8; unsigned char* PV8; float* SU; float* SV; };
constexpr int SCH = 32;
constexpr int SSTEP = 6 * 64;
__device__ __forceinline__ int scan_tp(int dir, int s) { return dir == 0 ? s : (s < CTXL ? (CTXL - 1 - s) : (TPB - 1 - (s - CTXL))); }
__device__ __forceinline__ void scan_load(v4u (&rg)[6], const bf16* RIh, int dir, int chunk, int htid) {
    const int tp = scan_tp(dir, chunk * SCH + (htid >> 3));
    const bf16* rec = RIh + (size_t)tp * RREC + (htid & 7) * 8;
#pragma unroll
    for (int i = 0; i < 3; ++i) rg[i] = *(const GAS v4u*)(rec + i * 64);
    rec += (3 + 3 * dir) * 64;
#pragma unroll
    for (int i = 0; i < 3; ++i) rg[3 + i] = *(const GAS v4u*)(rec + i * 64);
}
__device__ __forceinline__ void scan_store(const v4u (&rg)[6], LAS float* buf, int htid) {
    LAS float* d0 = buf + (htid >> 3) * SSTEP + (htid & 7) * 8;
#pragma unroll
    for (int i = 0; i < 6; ++i) { constexpr int SLOT[6] = {4, 0, 5, 2, 1, 3};
        const v4u wv = rg[i];
        f32x4 lo = {bflo(wv.x), bfhi(wv.x), bflo(wv.y), bfhi(wv.y)}, hi = {bflo(wv.z), bfhi(wv.z), bflo(wv.w), bfhi(wv.w)};
        if (i == 3) {
#pragma unroll
            for (int e = 0; e < 4; ++e) { lo[e] = __expf(lo[e]); hi[e] = __expf(hi[e]); } }
        LAS float* d = d0 + SLOT[i] * 64;
        *(LAS f32x4*)d = lo; *(LAS f32x4*)(d + 4) = hi; }
}
__device__ __forceinline__ void scan_phase(Frame& F, const bf16* RI, bf16* Y, const ScanCvt& C) {
    LAS float* bufs = (LAS float*)F.lds;
    constexpr int NCH = TPB / SCH;
    for (int uu = F.vcu; uu < NBATCH * NH * 2 * 4; uu += F.G) {
        const int rg = uu & 3, dir = (uu >> 2) & 1, hd = (uu >> 3) & 15, b = uu >> 7;
        const bf16* RIh = RI + (size_t)(b * NH + hd) * TPB * RREC;
        const int htid = F.tid - 256;
        v4u ra[6], rb[6];
        f32x4 xc[8];
        __syncthreads();
        if (F.wave >= 4) { scan_load(rb, RIh, dir, 0, htid); scan_load(ra, RIh, dir, 1, htid); scan_store(rb, bufs, htid); scan_load(rb, RIh, dir, 2, htid); }
        __syncthreads();
        const int j = F.lane & 15, rowl = F.lane >> 4, row = rg * 16 + (F.wave & 3) * 4 + rowl;
        f32x2 S01 = {0.f, 0.f}, S23 = {0.f, 0.f};
        bf16* yb = Y + ((size_t)dir * MALL + (size_t)b * TPB) * RW + hd * 64 + row;
        for (int c = 0; c < NCH; ++c) {
            LAS float* cur = bufs + (c & 1) * (SCH * SSTEP);
            if (F.wave >= 4) {
                if (c + 1 < NCH) {
                    if ((c & 1) == 0) { scan_store(ra, bufs + (SCH * SSTEP), htid); if (c + 3 < NCH) scan_load(ra, RIh, dir, c + 3, htid); }
                    else { scan_store(rb, bufs, htid); if (c + 3 < NCH) scan_load(rb, RIh, dir, c + 3, htid); }  }
                if ((c & 3) == 0 && (c >> 3) < 32) { const int r = uu * 4 + (F.wave - 4) + 1024 * (c >> 3);
                    if ((c & 7) == 0) cvt_row_load(xc, ((r >= NEXP) ? C.pv + (size_t)(r - NEXP) * DM : C.pu + (size_t)r * DM) + F.lane * 32);
                    else cvt_row_store(xc, ((r >= NEXP) ? C.PV8 + (size_t)(r - NEXP) * (DM / 2) : C.PU8 + (size_t)r * (DM / 2)) + F.lane * 16, (r >= NEXP) ? C.SV + (r - NEXP) : C.SU + r, F.lane); } }
            else {
#pragma unroll
                for (int h16 = 0; h16 < 2; ++h16) {
                    const LAS float* sp = cur + (h16 * 16) * SSTEP;
                    f32x4 kk = *(const LAS f32x4*)(sp + 4 * j), bb = *(const LAS f32x4*)(sp + 64 + 4 * j), ww = *(const LAS f32x4*)(sp + 128 + 4 * j),
                          ke = *(const LAS f32x4*)(sp + 192 + 4 * j), rr = *(const LAS f32x4*)(sp + 256 + 4 * j);
                    float ykeep = 0.f, ypart; f32x2 u2, t2, vv; vv.x = sp[320 + row];
#define SCAN_DPP(r, ctl) "v_add_f32_dpp " r ", " r ", " r " " ctl " row_mask:0xf bank_mask:0xf bound_ctrl:1\n\t"
#define SCAN_MAIN(SEL) asm volatile( \
                        "v_pk_mul_f32 v[242:243], %[kexy], %[vv] op_sel_hi:[1,0]\n\t" \
                        "v_add_f32 v246, v250, v251\n\t" \
                        "v_add_f32_dpp v248, %[yp], %[yp] quad_perm:[1,0,3,2] row_mask:0xf bank_mask:0xf bound_ctrl:1\n\t" \
                        "v_pk_mul_f32 v[244:245], %[kezw], %[vv] op_sel_hi:[1,0]\n\t" \
                        SCAN_DPP("v246", "quad_perm:[1,0,3,2]") SCAN_DPP("v248", "quad_perm:[2,3,0,1]") \
                        "v_pk_fma_f32 %[s01], %[s01], %[wwxy], v[242:243]\n\t" \
                        SCAN_DPP("v246", "quad_perm:[2,3,0,1]") SCAN_DPP("v248", "row_half_mirror") \
                        "v_pk_fma_f32 %[s23], %[s23], %[wwzw], v[244:245]\n\t" \
                        SCAN_DPP("v246", "row_half_mirror") SCAN_DPP("v248", "row_mirror") \
                        SEL "\n\t" \
                        SCAN_DPP("v246", "row_mirror") \
                        "v_pk_fma_f32 %[s01], %[bbxy], v[246:247], %[s01] op_sel_hi:[1,0,1] neg_lo:[0,1,0] neg_hi:[0,1,0]\n\t" \
                        "v_pk_fma_f32 %[s23], %[bbzw], v[246:247], %[s23] op_sel_hi:[1,0,1] neg_lo:[0,1,0] neg_hi:[0,1,0]\n\t" \
                        "v_pk_mul_f32 v[252:253], %[s01], %[rrxy]" \
                        : [s01] "+v"(S01), [s23] "+v"(S23), [yk] "+v"(ykeep), "={v[252:253]}"(u2) \
                        : [kexy] "v"(ke.xy), [kezw] "v"(ke.zw), [vv] "v"(vv), [wwxy] "v"(ww.xy), [wwzw] "v"(ww.zw), [bbxy] "v"(bb.xy), [bbzw] "v"(bb.zw), [rrxy] "v"(rr.xy), [yp] "v"(ypart), [msk] "s"(msk), "{v[250:251]}"(t2) \
                        : "v242", "v243", "v244", "v245", "v246", "v247", "v248")
                    asm volatile("v_pk_mul_f32 v[250:251], %[s01], %[kxy]\n\tv_mov_b32 %[yp], 0\n\tv_pk_fma_f32 v[250:251], %[s23], %[kzw], v[250:251]"
                                 : "=&{v[250:251]}"(t2), [yp] "=&v"(ypart) : [s01] "v"(S01), [s23] "v"(S23), [kxy] "v"(kk.xy), [kzw] "v"(kk.zw));
#pragma unroll
                    for (int st = 0; st < 16; ++st) {
                        f32x4 nkk = kk, nbb = bb, nww = ww, nke = ke, nrr = rr; f32x2 nvv = vv;
                        const LAS float* sn = sp + (st + 1) * SSTEP;
                        if (st + 1 < 16) { nkk = *(const LAS f32x4*)(sn + 4 * j); nke = *(const LAS f32x4*)(sn + 192 + 4 * j); nvv.x = sn[320 + row]; nww = *(const LAS f32x4*)(sn + 128 + 4 * j); nbb = *(const LAS f32x4*)(sn + 64 + 4 * j);
                            nrr = *(const LAS f32x4*)(sn + 256 + 4 * j); }
                        const unsigned long long msk = 0x0001000100010001ull << ((st + 15) & 15);
                        if (st > 0) SCAN_MAIN("v_cndmask_b32_e64 %[yk], %[yk], v248, %[msk]"); else SCAN_MAIN("s_nop 0");
                        if (st + 1 < 16)
                            asm volatile("v_pk_mul_f32 v[250:251], %[s01], %[kxy]\n\tv_pk_fma_f32 v[252:253], %[s23], %[rrzw], v[252:253]\n\tv_pk_fma_f32 v[250:251], %[s23], %[kzw], v[250:251]\n\tv_add_f32 %[yp], v252, v253"
                                         : "=&{v[250:251]}"(t2), "={v[252:253]}"(u2), [yp] "=&v"(ypart) : [s01] "v"(S01), [s23] "v"(S23), [kxy] "v"(nkk.xy), [kzw] "v"(nkk.zw), [rrzw] "v"(rr.zw), "1"(u2));
                        else
                            asm volatile("s_nop 0\n\tv_pk_fma_f32 v[252:253], %[s23], %[rrzw], v[252:253]" : "={v[252:253]}"(u2) : [s23] "v"(S23), [rrzw] "v"(rr.zw), "0"(u2));
                        kk = nkk; bb = nbb; ww = nww; ke = nke; rr = nrr; vv = nvv;
                        __builtin_amdgcn_sched_barrier(0);
                    }
#undef SCAN_MAIN
#undef SCAN_DPP
                    { const float y = red16(u2.x + u2.y); ykeep = (j == 15) ? y : ykeep; }
                    const int tp = scan_tp(dir, c * SCH + h16 * 16 + j);
                    *(GAS bf16*)(yb + (size_t)tp * RW) = (bf16)f2bf(ykeep);
                }
            }
            __syncthreads();
        }
    }
}

constexpr int AKP = 208, AVP = 192;
constexpr int ATILE = 64 * AKP + 64 * AVP;
__device__ __forceinline__ bf16x8 pack8(const f32x16& x, int s) {
    v4u p; p.x = pk2(x[8 * s + 0], x[8 * s + 1]); p.y = pk2(x[8 * s + 2], x[8 * s + 3]); p.z = pk2(x[8 * s + 4], x[8 * s + 5]); p.w = pk2(x[8 * s + 6], x[8 * s + 7]);
    return __builtin_bit_cast(bf16x8, p);
}
__device__ __forceinline__ void attn_phase(Frame& F, const bf16* Q, const bf16* K, const bf16* V, bf16* YB, int with_ctx) {
    const int lane = F.lane, half = lane >> 5, l31 = lane & 31, l16 = lane & 15, g1 = (lane >> 4) & 1;
    const int nunits = NBATCH * NH * 32 + (with_ctx ? NBATCH * NH : 0);
    for (int uu = F.vcu; uu < nunits; uu += F.G) {
        int bh, q0, nkt;
        if (uu < NBATCH * NH * 32) { bh = uu >> 5; q0 = CTXL + (uu & 31) * 256; nkt = TPB / 64; } else { bh = uu - NBATCH * NH * 32; q0 = 0; nkt = CTXL / 64; }
        const bf16* Kh = K + (size_t)bh * TPB * QKD; const bf16* Vh = V + (size_t)bh * TPB * 64; const bf16* Qh = Q + (size_t)bh * TPB * QKD;
        const int tq = q0 + F.wave * 32 + l31;
        bf16x8 qf[6];
#pragma unroll
        for (int ks = 0; ks < 6; ++ks) qf[ks] = *(const GAS bf16x8*)(Qh + (size_t)tq * QKD + 16 * ks + 8 * half);
        f32x16 o0, o1;
#pragma unroll
        for (int i = 0; i < 16; ++i) { o0[i] = 0.f; o1[i] = 0.f; }
        float l_run = 0.f;
        f32x16 cinit;
#pragma unroll
        for (int i = 0; i < 16; ++i) cinit[i] = 0.f;
        asm volatile("" : "+v"(cinit));
        const int kc1 = F.tid + 512; const bool k1ok = kc1 < 768;
        const unsigned kd0 = (unsigned)((F.tid / 12) * AKP + (F.tid % 12) * 16), kd1 = (unsigned)((kc1 / 12) * AKP + (kc1 % 12) * 16), vd = (unsigned)(64 * AKP + (F.tid >> 3) * AVP + (F.tid & 7) * 16);
        v4u kr0, kr1 = {0, 0, 0, 0}, vr;
        kr0 = *(const GAS v4u*)(Kh + (size_t)F.tid * 8); if (k1ok) kr1 = *(const GAS v4u*)(Kh + (size_t)kc1 * 8); vr = *(const GAS v4u*)(Vh + (size_t)F.tid * 8);
        __syncthreads();
        *(LAS v4u*)(F.lds + kd0) = kr0; if (k1ok) *(LAS v4u*)(F.lds + kd1) = kr1; *(LAS v4u*)(F.lds + vd) = vr;
        __syncthreads();
        for (int kt = 0; kt < nkt; ++kt) {
            const bool more = kt + 1 < nkt;
            if (more) { const bf16* kn = Kh + (size_t)(kt + 1) * 64 * QKD; const bf16* vn = Vh + (size_t)(kt + 1) * 64 * 64;
                kr0 = *(const GAS v4u*)(kn + (size_t)F.tid * 8); if (k1ok) kr1 = *(const GAS v4u*)(kn + (size_t)kc1 * 8); vr = *(const GAS v4u*)(vn + (size_t)F.tid * 8); }
            LAS unsigned char* Kb = F.lds + (kt & 1) * ATILE; LAS unsigned char* Vb = Kb + 64 * AKP;
            f32x16 s0, s1;
            { bf16x8 ka[6], kb2[6];
#pragma unroll
              for (int ks = 0; ks < 6; ++ks) { ka[ks] = *(const LAS bf16x8*)(Kb + l31 * AKP + (16 * ks + 8 * half) * 2); kb2[ks] = *(const LAS bf16x8*)(Kb + (32 + l31) * AKP + (16 * ks + 8 * half) * 2); }
              s0 = MFMA32(ka[0], qf[0], cinit); s1 = MFMA32(kb2[0], qf[0], cinit);
#pragma unroll
              for (int ks = 1; ks < 6; ++ks) { s0 = MFMA32(ka[ks], qf[ks], s0); s1 = MFMA32(kb2[ks], qf[ks], s1); }
              __builtin_amdgcn_sched_group_barrier(0x100, 12, 0); __builtin_amdgcn_sched_group_barrier(0x8, 12, 0); }
            bf16x8 va[2][2][2];
#pragma unroll
            for (int t = 0; t < 2; ++t)
#pragma unroll
                for (int s = 0; s < 2; ++s) { const int kb = 32 * t + 16 * s + 4 * half + (l16 >> 2);
#pragma unroll
                    for (int dvt = 0; dvt < 2; ++dvt) { const LAS unsigned char* vp = Vb + kb * AVP + (32 * dvt + 16 * g1 + 4 * (l16 & 3)) * 2;
                        const s16x4 lo = __builtin_amdgcn_ds_read_tr16_b64_v4i16((LAS s16x4*)vp), hi = __builtin_amdgcn_ds_read_tr16_b64_v4i16((LAS s16x4*)(vp + 8 * AVP));
                        va[t][s][dvt] = __builtin_shufflevector(lo, hi, 0, 1, 2, 3, 4, 5, 6, 7); } }
            __builtin_amdgcn_sched_group_barrier(0x100, 16, 0);
            float mx = s0[0];
#pragma unroll
            for (int i = 1; i < 16; ++i) mx = fmaxf(mx, s0[i]);
#pragma unroll
            for (int i = 0; i < 16; ++i) mx = fmaxf(mx, s1[i]);
            mx = fmaxf(mx, bpermf(lane ^ 32, mx));
            if (kt == 0 || __any(mx > 8.0f)) {
                const float d = (kt == 0) ? mx : fmaxf(mx, 0.f), alpha = (kt == 0) ? 1.0f : __builtin_amdgcn_exp2f(-d);
                l_run *= alpha;
#pragma unroll
                for (int i = 0; i < 16; ++i) { o0[i] *= alpha; o1[i] *= alpha; s0[i] -= d; s1[i] -= d; cinit[i] -= d; }
                asm volatile("" : "+v"(cinit));
            }
#pragma unroll
            for (int i = 0; i < 16; ++i) { s0[i] = __builtin_amdgcn_exp2f(s0[i]); s1[i] = __builtin_amdgcn_exp2f(s1[i]); }
            float ps = 0.f;
#pragma unroll
            for (int i = 0; i < 16; ++i) ps += s0[i] + s1[i];
            l_run += ps;
            { bf16x8 pf[2][2];
#pragma unroll
              for (int t = 0; t < 2; ++t)
#pragma unroll
                  for (int s = 0; s < 2; ++s) pf[t][s] = pack8(t == 0 ? s0 : s1, s);
#pragma unroll
              for (int t = 0; t < 2; ++t)
#pragma unroll
                  for (int s = 0; s < 2; ++s) { o0 = MFMA32(va[t][s][0], pf[t][s], o0); o1 = MFMA32(va[t][s][1], pf[t][s], o1); } }
            if (more) { LAS unsigned char* nb = F.lds + ((kt + 1) & 1) * ATILE;
                *(LAS v4u*)(nb + kd0) = kr0; if (k1ok) *(LAS v4u*)(nb + kd1) = kr1; *(LAS v4u*)(nb + vd) = vr; }
            __syncthreads();
        }
        const float linv = (DBG_SKIP & 4) ? 0.f : 1.0f / (l_run + bpermf(lane ^ 32, l_run));
        const int b = bh >> 4, hd = bh & 15;
        bf16* op = YB + ((size_t)b * TPB + tq) * RW + hd * 64 + 4 * half;
#pragma unroll
        for (int g = 0; g < 4; ++g) {
            v2u w; w.x = pk2(o0[4 * g] * linv, o0[4 * g + 1] * linv); w.y = pk2(o0[4 * g + 2] * linv, o0[4 * g + 3] * linv); *(GAS v2u*)(op + 8 * g) = w;
            w.x = pk2(o1[4 * g] * linv, o1[4 * g + 1] * linv); w.y = pk2(o1[4 * g + 2] * linv, o1[4 * g + 3] * linv); *(GAS v2u*)(op + 32 + 8 * g) = w; }
    }
}

struct RoRaw { v4u va, vc, ya[2], yc[2], ga[2], gc[2]; float b0[2], b1[2]; };
__device__ __forceinline__ void readout_load(RoRaw& r, int m, int lane, const bf16* Y, const bf16* GG, const float* BON, const bf16* RI) {
    const int hd = lane >> 2, ch0 = hd * 64 + (lane & 3) * 16, b = m / TPB, tp = m - b * TPB;
    const bf16* rec = RI + ((size_t)(b * NH + hd) * TPB + tp) * RREC + 128 + (lane & 3) * 16;
    r.va = *(const GAS v4u*)rec; r.vc = *(const GAS v4u*)(rec + 8);
#pragma unroll
    for (int d = 0; d < 2; ++d) { const bf16* yp = Y + ((size_t)d * MALL + m) * RW + ch0; const bf16* gp = GG + ((size_t)d * MALL + m) * RW + ch0;
        r.ya[d] = *(const GAS v4u*)yp; r.yc[d] = *(const GAS v4u*)(yp + 8); r.ga[d] = *(const GAS v4u*)gp; r.gc[d] = *(const GAS v4u*)(gp + 8);
        r.b0[d] = BON[((size_t)d * MALL + m) * 32 + 2 * hd]; r.b1[d] = BON[((size_t)d * MALL + m) * 32 + 2 * hd + 1]; }
}
__device__ __forceinline__ void readout_phase(Frame& F, const bf16* Y, const bf16* GG, const float* BON, const bf16* RI, const float* ln_w, const float* ln_b, bf16* YA) {
    const int gw = F.vcu * NWAVES + F.wave, NGW = F.G * NWAVES, lane = F.lane, hd = lane >> 2, ch0 = hd * 64 + (lane & 3) * 16;
    RoRaw cur, nxt;
    if (gw < MALL) readout_load(cur, gw, lane, Y, GG, BON, RI);
    for (int m = gw; m < MALL; m += NGW) {
        if (m + NGW < MALL) readout_load(nxt, m + NGW, lane, Y, GG, BON, RI);
        float vv[16], out[16];
        unpack8(cur.va, *(float(*)[8])&vv[0]); unpack8(cur.vc, *(float(*)[8])&vv[8]);
#pragma unroll
        for (int e = 0; e < 16; ++e) out[e] = 0.f;
#pragma unroll
        for (int d = 0; d < 2; ++d) {
            float y[16], g[16];
            unpack8(cur.ya[d], *(float(*)[8])&y[0]); unpack8(cur.yc[d], *(float(*)[8])&y[8]); unpack8(cur.ga[d], *(float(*)[8])&g[0]); unpack8(cur.gc[d], *(float(*)[8])&g[8]);
            float s = 0.f;
#pragma unroll
            for (int e = 0; e < 16; ++e) s += y[e];
            s = dpp_add<0xB1>(s); s = dpp_add<0x4E>(s);
            const float mean = s * (1.f / 64.f); float q = 0.f;
#pragma unroll
            for (int e = 0; e < 16; ++e) { y[e] -= mean; q += y[e] * y[e]; }
            q = dpp_add<0xB1>(q); q = dpp_add<0x4E>(q);
            const float rstd = rsqrtf(q * (1.f / 64.f) + 64e-5f), bon = cur.b0[d] + cur.b1[d];
#pragma unroll
            for (int e = 0; e < 16; ++e) out[e] += (y[e] * rstd * ln_w[ch0 + e] + ln_b[ch0 + e] + bon * vv[e]) * g[e];
        }
        if (DBG_SKIP & 2) {
#pragma unroll
            for (int e = 0; e < 16; ++e) out[e] = 0.f; }
        v4u o0, o1;
        o0.x = pk2(out[0], out[1]); o0.y = pk2(out[2], out[3]); o0.z = pk2(out[4], out[5]); o0.w = pk2(out[6], out[7]);
        o1.x = pk2(out[8], out[9]); o1.y = pk2(out[10], out[11]); o1.z = pk2(out[12], out[13]); o1.w = pk2(out[14], out[15]);
        *(GAS v4u*)(YA + (size_t)m * RW + ch0) = o0; *(GAS v4u*)(YA + (size_t)m * RW + ch0 + 8) = o1;
        cur = nxt;
    }
}


__device__ __forceinline__ unsigned f2key(float f) { const unsigned u = __builtin_bit_cast(unsigned, f); return (u & 0x80000000u) ? ~u : (u | 0x80000000u); }
__device__ __forceinline__ float key2f(unsigned k) { const unsigned u = (k & 0x80000000u) ? (k & 0x7fffffffu) : ~k; return __builtin_bit_cast(float, u); }
template <int CTRL, int RM> __device__ __forceinline__ unsigned dpp_umax(unsigned x) {
    const unsigned y = (unsigned)__builtin_amdgcn_update_dpp(0, (int)x, CTRL, RM, 0xf, false); return x > y ? x : y; }
__device__ __forceinline__ unsigned row_umax(unsigned x) { x = dpp_umax<0xB1, 0xf>(x); x = dpp_umax<0x4E, 0xf>(x); x = dpp_umax<0x141, 0xf>(x); x = dpp_umax<0x140, 0xf>(x); return x; }
#define SEL_CE(a_, b_) do { const unsigned hi_ = (a_) > (b_) ? (a_) : (b_), lo_ = (a_) > (b_) ? (b_) : (a_); (a_) = hi_; (b_) = lo_; } while (0)
__device__ __forceinline__ void sel_keys8(unsigned (&k)[8], const _Float16* p, int id0) {
    typedef _Float16 h8 __attribute__((ext_vector_type(8)));
    const h8 hv = *(const GAS h8*)p;
    const f32x4 v0 = {(float)hv[0], (float)hv[1], (float)hv[2], (float)hv[3]}, v1 = {(float)hv[4], (float)hv[5], (float)hv[6], (float)hv[7]};
    k[0] = (f2key(v0.x) & ~127u) | (unsigned)(id0 + 0); k[1] = (f2key(v0.y) & ~127u) | (unsigned)(id0 + 1); k[2] = (f2key(v0.z) & ~127u) | (unsigned)(id0 + 2); k[3] = (f2key(v0.w) & ~127u) | (unsigned)(id0 + 3);
    k[4] = (f2key(v1.x) & ~127u) | (unsigned)(id0 + 4); k[5] = (f2key(v1.y) & ~127u) | (unsigned)(id0 + 5); k[6] = (f2key(v1.z) & ~127u) | (unsigned)(id0 + 6); k[7] = (f2key(v1.w) & ~127u) | (unsigned)(id0 + 7);
    SEL_CE(k[0], k[1]); SEL_CE(k[2], k[3]); SEL_CE(k[4], k[5]); SEL_CE(k[6], k[7]); SEL_CE(k[0], k[2]); SEL_CE(k[1], k[3]); SEL_CE(k[4], k[6]); SEL_CE(k[5], k[7]); SEL_CE(k[1], k[2]); SEL_CE(k[5], k[6]);
    SEL_CE(k[0], k[4]); SEL_CE(k[1], k[5]); SEL_CE(k[2], k[6]); SEL_CE(k[3], k[7]); SEL_CE(k[2], k[4]); SEL_CE(k[3], k[5]); SEL_CE(k[1], k[2]); SEL_CE(k[3], k[4]); SEL_CE(k[5], k[6]);
}
__device__ __forceinline__ void top16_rows2(const _Float16* pa, const _Float16* pb, int l16, unsigned& ra, unsigned& rb) {
    unsigned ka[8], kb[8]; sel_keys8(ka, pa + 8 * l16, 8 * l16); sel_keys8(kb, pb + 8 * l16, 8 * l16);
    ra = 0u; rb = 0u;
#pragma unroll
    for (int it = 0; it < 16; ++it) {
        const unsigned ma = row_umax(ka[0]), mb = row_umax(kb[0]); const bool oa = ka[0] == ma, ob = kb[0] == mb;
#pragma unroll
        for (int e = 0; e < 7; ++e) { ka[e] = oa ? ka[e + 1] : ka[e]; kb[e] = ob ? kb[e + 1] : kb[e]; }
        ka[7] = oa ? 0u : ka[7]; kb[7] = ob ? 0u : kb[7];
        ra = (l16 == it) ? ma : ra; rb = (l16 == it) ? mb : rb;
    }
}
struct SelP { const float* SC; int* ESEL; float* EGATE; int last; };
__device__ __forceinline__ void select_token(const _Float16* srow, int lane, int (&eidx)[2], float (&egate)[2]) {
    const int row = lane >> 4, l16 = lane & 15, rbase = lane & 48;
    const int i1 = (int)((0x3332222211111111ull >> (4 * l16)) & 15ull), j1 = (int)((0x2104321076543210ull >> (4 * l16)) & 15ull), i2 = (int)((0xdcba987766554443ull >> (4 * l16)) & 15ull), j2 = (int)((0x0000001010102103ull >> (4 * l16)) & 15ull);
#pragma unroll
    for (int G = 0; G < 2; ++G) {
                const _Float16* hrow = srow + (4 * G + row) * 256;
                unsigned recA, recB; top16_rows2(hrow, hrow + 128, l16, recA, recB);
                const float va = key2f(recA & ~127u), vb = key2f(recB & ~127u);
                const float a0 = bpermf(rbase, va), a1 = bpermf(rbase + i1, va), b1 = bpermf(rbase + j1, vb), a2 = bpermf(rbase + i2, va), b2 = bpermf(rbase + j2, vb), a3 = bpermf(rbase + 14 + (l16 & 1), va), b0 = bpermf(rbase, vb);
                unsigned ck[4];
                ck[0] = (f2key(a0 + vb) & ~255u) | (unsigned)l16; ck[1] = (f2key(a1 + b1) & ~255u) | (unsigned)(16 * i1 + j1); ck[2] = (f2key(a2 + b2) & ~255u) | (unsigned)(16 * i2 + j2);
                ck[3] = (l16 < 2) ? ((f2key(a3 + b0) & ~255u) | (unsigned)(16 * (14 + l16))) : 0u;
                SEL_CE(ck[0], ck[1]); SEL_CE(ck[2], ck[3]); SEL_CE(ck[0], ck[2]); SEL_CE(ck[1], ck[3]); SEL_CE(ck[1], ck[2]);
                unsigned rec = 0u;
#pragma unroll
                for (int it = 0; it < 16; ++it) {
                    const unsigned mh = row_umax(ck[0]); const bool own = ck[0] == mh;
                    ck[0] = own ? ck[1] : ck[0]; ck[1] = own ? ck[2] : ck[1]; ck[2] = own ? ck[3] : ck[2]; ck[3] = own ? 0u : ck[3];
                    rec = (l16 == it) ? mh : rec;
                }
                const float ts = key2f(rec & ~255u), tmax = bpermf(rbase, ts);
                const float ev = __expf(ts - tmax), esum = red16(ev);
                const int ci = (int)((rec >> 4) & 15u), cj = (int)(rec & 15u);
                const int expert = bpermi(rbase + ci, (int)(recA & 127u)) * 128 + bpermi(rbase + cj, (int)(recB & 127u));
                eidx[G] = expert; egate[G] = ev / esum;
    }
}
struct PeerP { const _Float16* SC; const float* nmod; const float* ng; bf16* Hout;   const int* ESEL; const float* EGATE; const bf16* H; const unsigned char* PU; const unsigned char* PV; const float* SU; const float* SV; bf16* X; const float* mod;   const float* fin_g; float* out; int last; int dry; };
__device__ __forceinline__ void peer_phase(Frame& F, const PeerP& P) {
    const int gw = F.vcu * NWAVES + F.wave, NGW = F.G * NWAVES, lane = F.lane;
    float pr_s2 = 0.f, pr_d2 = 0.f, pr_tg = 0.f, pr_n = 0.f;
    int m0 = gw; while (m0 < MALL && P.last && (m0 % TPB) < CTXL) m0 += NGW;
    v4u ph0 = {0u, 0u, 0u, 0u}, ph1 = ph0, ph2 = ph0, ph3 = ph0;
    if (m0 < MALL) { const bf16* hp = P.H + (size_t)m0 * DM + lane * 32; ph0 = *(const GAS v4u*)hp; ph1 = *(const GAS v4u*)(hp + 8); ph2 = *(const GAS v4u*)(hp + 16); ph3 = *(const GAS v4u*)(hp + 24); }
    for (int m = m0, mn = 0; m < MALL; m = mn) {
        mn = m + NGW; while (mn < MALL && P.last && (mn % TPB) < CTXL) mn += NGW;
        const int b = m / TPB, tp = m - b * TPB;
        const int mr = tp < CTXL ? 2 : b;
        const int emask_ = (P.dry & 2) ? 1023 : 0x7fffffff;
        int eidx[2]; float egate[2]; select_token(P.SC + (size_t)m * DM, lane, eidx, egate);
        eidx[0] &= emask_; eidx[1] &= emask_;
        typedef int v8i __attribute__((ext_vector_type(8)));
        LAS unsigned char* hq = F.lds + F.wave * 4096;
        { const v4u hv[4] = {ph0, ph1, ph2, ph3}; v4u o[2];
#pragma unroll
          for (int j = 0; j < 4; ++j) { int w0 = 0, w1 = 0;
              w0 = __builtin_amdgcn_cvt_pk_fp8_f32(bflo(hv[j].x), bfhi(hv[j].x), w0, false); w0 = __builtin_amdgcn_cvt_pk_fp8_f32(bflo(hv[j].y), bfhi(hv[j].y), w0, true);
              w1 = __builtin_amdgcn_cvt_pk_fp8_f32(bflo(hv[j].z), bfhi(hv[j].z), w1, false); w1 = __builtin_amdgcn_cvt_pk_fp8_f32(bflo(hv[j].w), bfhi(hv[j].w), w1, true);
              o[j >> 1][2 * (j & 1)] = (unsigned)w0; o[j >> 1][2 * (j & 1) + 1] = (unsigned)w1; }
          *(LAS v4u*)(hq + lane * 32) = o[0]; *(LAS v4u*)(hq + lane * 32 + 16) = o[1];
          unsigned z_ = 0u; asm volatile("" : "+v"(z_));
          if (lane < 2) *(LAS v4u*)(hq + 2048 + lane * 16) = (v4u){z_, z_, z_, z_}; }
        const int li = lane & 15, kb = lane >> 4;
        int rowoff[8];
#pragma unroll
        for (int g = 0; g < 8; ++g) rowoff[g] = bpermi(16 * (g & 3) + li, eidx[g >> 2]) * (DM / 2) + 16 * kb;
        f32x4 dacc[8];
#pragma unroll
        for (int g = 0; g < 8; ++g) dacc[g] = (f32x4){0.f, 0.f, 0.f, 0.f};
        const unsigned hb = (li == 0) ? (unsigned)(16 * kb) : 2048u;
        const unsigned hb2 = (li == 0) ? 64u : 16u;
        const unsigned hstep = (li == 0) ? 128u : 0u;
        v4u ua[8], ub[8];
#pragma unroll
        for (int g = 0; g < 8; ++g) ua[g] = *(const GAS v4u*)(P.PU + (unsigned)rowoff[g]);
#pragma unroll 1
        for (int s = 0; s < ((P.dry & 4) ? 2 : 16); s += 2) {
#pragma unroll
            for (int g = 0; g < 8; ++g) ub[g] = *(const GAS v4u*)(P.PU + (unsigned)(rowoff[g] + 64 * (s + 1)));
            { const v4u b0 = *(const LAS v4u*)(hq + hb + hstep * s), b1 = *(const LAS v4u*)(hq + hb + hstep * s + hb2);
              const v8i bf = {(int)b0.x, (int)b0.y, (int)b0.z, (int)b0.w, (int)b1.x, (int)b1.y, (int)b1.z, (int)b1.w};
#pragma unroll
              for (int g = 0; g < 8; ++g) { const v8i af = {(int)ua[g].x, (int)ua[g].y, (int)ua[g].z, (int)ua[g].w, 0, 0, 0, 0};
                  dacc[g] = __builtin_amdgcn_mfma_scale_f32_16x16x128_f8f6f4(af, bf, dacc[g], 4, 0, 0, 0x7f7f7f7f, 0, 0x7f7f7f7f); } }
            if (s + 2 < 16) {
#pragma unroll
                for (int g = 0; g < 8; ++g) ua[g] = *(const GAS v4u*)(P.PU + (unsigned)(rowoff[g] + 64 * (s + 2))); }
            { const v4u b0 = *(const LAS v4u*)(hq + hb + hstep * (s + 1)), b1 = *(const LAS v4u*)(hq + hb + hstep * (s + 1) + hb2);
              const v8i bf = {(int)b0.x, (int)b0.y, (int)b0.z, (int)b0.w, (int)b1.x, (int)b1.y, (int)b1.z, (int)b1.w};
#pragma unroll
              for (int g = 0; g < 8; ++g) { const v8i af = {(int)ub[g].x, (int)ub[g].y, (int)ub[g].z, (int)ub[g].w, 0, 0, 0, 0};
                  dacc[g] = __builtin_amdgcn_mfma_scale_f32_16x16x128_f8f6f4(af, bf, dacc[g], 4, 0, 0, 0x7f7f7f7f, 0, 0x7f7f7f7f); } }
        }
        float coef[2];
#pragma unroll
        for (int sl = 0; sl < 2; ++sl) { float mydot = 0.f;
#pragma unroll
            for (int g4 = 0; g4 < 4; ++g4)
#pragma unroll
                for (int r = 0; r < 4; ++r) { const float t = bpermf(16 * ((lane >> 2) & 3), dacc[4 * sl + g4][r]); if ((lane >> 4) == g4 && (lane & 3) == r) mydot = t; }
            mydot *= P.SU[eidx[sl]];
            if (DBG_PROBE == 4) {
                float ref = 0.f;
                for (int e = 0; e < 64; ++e) { const int ex = __builtin_amdgcn_readlane(eidx[sl], e); const v4u uu = *(const GAS v4u*)(P.PU + (size_t)ex * (DM / 2) + lane * 16); float s1 = 0.f;
                    const v4u hv2[4] = {*(const GAS v4u*)(P.H + (size_t)m * DM + lane * 32), *(const GAS v4u*)(P.H + (size_t)m * DM + lane * 32 + 8), *(const GAS v4u*)(P.H + (size_t)m * DM + lane * 32 + 16), *(const GAS v4u*)(P.H + (size_t)m * DM + lane * 32 + 24)};
#pragma unroll
                    for (int d = 0; d < 4; ++d) { const unsigned w = uu[d]; const unsigned hw[4] = {hv2[d].x, hv2[d].y, hv2[d].z, hv2[d].w};
                        f32x2 x = __builtin_amdgcn_cvt_scalef32_pk_f32_fp4(w, 1.0f, 0); s1 += x.x * bflo(hw[0]) + x.y * bfhi(hw[0]); x = __builtin_amdgcn_cvt_scalef32_pk_f32_fp4(w, 1.0f, 1); s1 += x.x * bflo(hw[1]) + x.y * bfhi(hw[1]);
                        x = __builtin_amdgcn_cvt_scalef32_pk_f32_fp4(w, 1.0f, 2); s1 += x.x * bflo(hw[2]) + x.y * bfhi(hw[2]); x = __builtin_amdgcn_cvt_scalef32_pk_f32_fp4(w, 1.0f, 3); s1 += x.x * bflo(hw[3]) + x.y * bfhi(hw[3]); }
                    const float tot = wave_sum_u(s1) * P.SU[ex]; if (lane == e) ref = tot; }
                pr_s2 = fmaxf(pr_s2, wave_max_u(fabsf(mydot - ref) / (fabsf(ref) + 0.25f))); pr_n = 1.f; }
            coef[sl] = egate[sl] * 0.5f * mydot * (1.0f + erff(mydot * 0.70710678f));
            if ((DBG_SKIP & 16) && sl == 0) coef[sl] = 0.f;
            if ((DBG_SKIP & 32) && sl == 1) coef[sl] = 0.f;
        }
        const float coefs[2] = {coef[0] * P.SV[eidx[0]], coef[1] * P.SV[eidx[1]]};
        f32x2 acc2[16];
#pragma unroll
        for (int i = 0; i < 16; ++i) acc2[i] = (f32x2){0.f, 0.f};
#define PEER_LOADV(U, C, e0_) do { const int e1_ = (e0_); const int ev_ = (e1_ & 64) ? eidx[1] : eidx[0]; const int cv_ = __builtin_bit_cast(int, (e1_ & 64) ? coefs[1] : coefs[0]); \
            _Pragma("unroll") for (int q = 0; q < 8; ++q) { const int ex = __builtin_amdgcn_readlane(ev_, (e1_ & 63) + q); U[q] = *(const GAS v4u*)(P.PV + (size_t)ex * (DM / 2) + lane * 16); \
            C[q] = __builtin_bit_cast(float, __builtin_amdgcn_readlane(cv_, (e1_ & 63) + q)); } } while (0)
#define PEER_AXPY(U, C) do { if (P.dry & 32) { _Pragma("unroll") for (int q = 0; q < 8; ++q) _Pragma("unroll") for (int d = 0; d < 4; ++d) acc2[d].x += __builtin_bit_cast(float, U[q][d] & 0x3fffffffu) * C[q]; } else \
            _Pragma("unroll") for (int q = 0; q < 8; ++q) _Pragma("unroll") for (int d = 0; d < 4; ++d) { const unsigned w = U[q][d]; \
            acc2[4 * d + 0] = __builtin_amdgcn_cvt_scalef32_pk_f32_fp4(w, 1.0f, 0) * C[q] + acc2[4 * d + 0]; acc2[4 * d + 1] = __builtin_amdgcn_cvt_scalef32_pk_f32_fp4(w, 1.0f, 1) * C[q] + acc2[4 * d + 1]; \
            acc2[4 * d + 2] = __builtin_amdgcn_cvt_scalef32_pk_f32_fp4(w, 1.0f, 2) * C[q] + acc2[4 * d + 2]; acc2[4 * d + 3] = __builtin_amdgcn_cvt_scalef32_pk_f32_fp4(w, 1.0f, 3) * C[q] + acc2[4 * d + 3]; } } while (0)
        if (mn < MALL) {
            const bf16* hp = P.H + (size_t)mn * DM + lane * 32; ph0 = *(const GAS v4u*)hp; ph1 = *(const GAS v4u*)(hp + 8); ph2 = *(const GAS v4u*)(hp + 16); ph3 = *(const GAS v4u*)(hp + 24); }
        v4u xpre[4];
        { const bf16* xr0 = P.X + (size_t)m * DM + lane * 32;
#pragma unroll
          for (int hq = 0; hq < 4; ++hq) xpre[hq] = *(const GAS v4u*)(xr0 + hq * 8); }
        {
            v4u ua[8], ub[8]; float ca[8], cb[8];
            PEER_LOADV(ua, ca, 0);
#pragma unroll 1
            for (int it = 0; it < ((P.dry & 8) ? 2 : 8); ++it) {
                PEER_LOADV(ub, cb, 16 * it + 8); PEER_AXPY(ua, ca);
                if (it < 7) PEER_LOADV(ua, ca, 16 * it + 16);
                PEER_AXPY(ub, cb);
            }
        }
#undef PEER_LOADV
#undef PEER_AXPY
        float acc[32];
#pragma unroll
        for (int i = 0; i < 16; ++i) { acc[2 * i] = acc2[i].x; acc[2 * i + 1] = acc2[i].y; }
        if (P.dry) { float sm_ = 0.f;
#pragma unroll
            for (int i = 0; i < 32; ++i) sm_ += acc[i];
            if (sm_ == 1.2345e-30f) P.X[lane] = sm_;
            if (!(P.dry & 16)) continue; }
        if (DBG_SKIP & 1) {
#pragma unroll
            for (int i = 0; i < 32; ++i) acc[i] = 0.f; }
        if (((DBG_SKIP & 64) && !P.last) || ((DBG_SKIP & 128) && P.last)) {
#pragma unroll
            for (int i = 0; i < 32; ++i) acc[i] = 0.f; }
        if (DBG_SKIP & 8) {
#pragma unroll
            for (int i = 0; i < 32; ++i) acc[i] = -acc[i]; }
        int m_l = m, lane_l = lane; asm volatile("" : "+v"(m_l), "+v"(lane_l));
        const int b_l = m_l / TPB, tp_l = m_l - b_l * TPB, mr_l = tp_l < CTXL ? 2 : b_l;
        bf16* xr = (P.dry ? (bf16*)(F.ws + 760 * MiB) : P.X) + (size_t)m_l * DM + lane_l * 32; const float* g2 = P.mod + (size_t)mr_l * 12288 + 5 * DM + lane_l * 32;
        float ss = 0.f;
#pragma unroll
        for (int hq = 0; hq < 4; ++hq) { const int c = hq * 8; float xf[8]; unpack8(xpre[hq], xf);
            const f32x4 g0 = *(const GAS f32x4*)(g2 + c), g1 = *(const GAS f32x4*)(g2 + c + 4);
#pragma unroll
            for (int e = 0; e < 8; ++e) { const float xv = xf[e] + (e < 4 ? g0[e & 3] : g1[e & 3]) * acc[8 * hq + e]; ss += xv * xv; acc[8 * hq + e] = xv; xf[e] = xv; }
            if (!P.last) *(GAS v4u*)(xr + c) = pack8f(xf); }
        if (!P.last) {
            const float rs = rsqrtf(wave_sum(ss) * (1.f / DM) + NORM_EPS); const float* sh = P.nmod + (size_t)mr_l * 12288 + lane_l * 32; const float* sc = sh + DM; const float* ngp = P.ng + lane_l * 32;
            bf16* ho = (P.dry ? (bf16*)(F.ws + 892 * MiB) : P.Hout) + (size_t)m_l * DM + lane_l * 32;
#pragma unroll
            for (int hq = 0; hq < 4; ++hq) { const int c = hq * 8; float y[8];
                const f32x4 n0 = *(const GAS f32x4*)(ngp + c), n1 = *(const GAS f32x4*)(ngp + c + 4), s0 = *(const GAS f32x4*)(sc + c), s1 = *(const GAS f32x4*)(sc + c + 4), h0 = *(const GAS f32x4*)(sh + c), h1 = *(const GAS f32x4*)(sh + c + 4);
#pragma unroll
                for (int e = 0; e < 4; ++e) { y[e] = acc[8 * hq + e] * rs * n0[e] * (1.0f + s0[e]) + h0[e]; y[4 + e] = acc[8 * hq + 4 + e] * rs * n1[e] * (1.0f + s1[e]) + h1[e]; }
                *(GAS v4u*)(ho + c) = pack8f(y); } }
        if (P.last) { const float rs = rsqrtf(wave_sum(ss) * (1.f / DM) + NORM_EPS); float* orow = P.out + ((size_t)b_l * SEQ + (tp_l - CTXL)) * DM + lane_l * 32; const float* fgp = P.fin_g + lane_l * 32;
#pragma unroll
            for (int hq = 0; hq < 8; ++hq) { const int c = hq * 4; const f32x4 fg = *(const GAS f32x4*)(fgp + c);
                f32x4 o;
#pragma unroll
                for (int e = 0; e < 4; ++e) o[e] = acc[4 * hq + e] * rs * fg[e];
                *(GAS f32x4*)(orow + c) = o; } }
    }
    if (DBG_PROBE && DBG_PROBE != 5 && !P.last && lane == 0) { float* pp = (float*)(F.ws + WS_CTL + CTL_PROBE_OFF) + gw * 4; pp[0] = pr_s2; pp[1] = pr_d2; pp[2] = pr_tg; pp[3] = pr_n; }
}


constexpr int PH_PER_LAYER = 12, NPHASE = 1 + NLAYER * PH_PER_LAYER;
#ifndef ONLY_PHASE
#define ONLY_PHASE -1
#endif
#define T0() (wave_s == 0 && pg8::opaque_lane() == 0)
#define PH_ON(k) (ONLY_PHASE < 0 || ONLY_PHASE == (k))
#define GEMM_CALL(EPI, SCHED, g, S, E) pg8::gemm_phase<EPI, SCHED, true, true>(F.lds, g, S, E, wave_s)
#define GEMM_CALL_NA(EPI, SCHED, g, S, E) pg8::gemm_phase<EPI, SCHED, false, true>(F.lds, g, S, E, wave_s)

__device__ __forceinline__ const float* karg(int i) {
    asm volatile("" : "+s"(i));
    const __attribute__((address_space(4))) unsigned long long* ka = (const __attribute__((address_space(4))) unsigned long long*)__builtin_amdgcn_kernarg_segment_ptr();
    return (const float*)ka[i];
}
__global__ void __launch_bounds__(NWAVES * 64, 2) mk_fwd(Args args) {
    extern __shared__ __attribute__((aligned(16))) unsigned char lds[];
    Frame F;
    F.lds = (LAS unsigned char*)lds; F.ws = args.ws;
    const int wave_s = __builtin_amdgcn_readfirstlane((int)threadIdx.x >> 6);
    F.tid = threadIdx.x; F.lane = F.tid & 63; F.wave = wave_s;
    F.G = gridDim.x; { const int bx = blockIdx.x; F.vcu = (F.G % 8 == 0) ? (bx % 8) * (F.G / 8) + bx / 8 : bx; }
    unsigned char* ws = args.ws;
    volatile LAS unsigned* MISC = (volatile LAS unsigned*)(F.lds + MISC_OFF);
    for (int u = F.tid; u < (LDS_BYTES - LDSCTL_OFF) / 4; u += NWAVES * 64) ((LAS unsigned*)(F.lds + LDSCTL_OFF))[u] = 0u;
    __syncthreads();
    const int lo = args.ph_lo, hi = args.ph_hi;
    XcdBarrier bar; bar.bar = (unsigned*)(ws + WS_CTL) + CW_BAR; bar.x = 0; bar.st = nullptr;
    if (hi - lo > 1) bar = xcd_barrier_post((unsigned*)(ws + WS_CTL) + CW_BAR, MISC + 8, T0());
#define IN(k) (lo <= (k) && (k) < hi)
#define REFRAME() do { const int lz_ = pg8::opaque_lane(); F.lane = lz_; F.tid = wave_s * 64 + lz_; F.wave = wave_s; ws = (unsigned char*)karg(34); F.ws = ws; { int g_ = (int)gridDim.x, b_ = (int)blockIdx.x; asm volatile("" : "+s"(g_), "+s"(b_)); bx = b_; F.G = g_; F.vcu = ((g_ & 7) == 0) ? (b_ & 7) * (g_ >> 3) + (b_ >> 3) : b_; } } while (0)
#define SEAM(k) do { if (IN((k) + 1)) xcd_barrier(bar, T0()); } while (0)
#define XBUF ((bf16*)(ws + WS_X))
#define HBUF ((bf16*)(ws + WS_H))
#define MODP ((const float*)(ws + WS_CTL + CTL_MOD_OFF) + (size_t)l * 3 * 12288)
    int bx = (int)blockIdx.x;

    for (int rep_ = 0; rep_ < ((DBG_REPEAT == 100) ? 2 : 1); ++rep_) if (PH_ON(100) && IN(0)) { REFRAME(); if (rep_) xcd_barrier(bar, T0()); p0_prologue(F, 0, (MK_N_LAUNCHES == 1) ? 1 : NLAYER, F.vcu, F.G); SEAM(0); if (DBG_REPEAT == 200) { for (int i_ = 0; i_ < 32; ++i_) xcd_barrier(bar, T0()); } }

    for (int l = 0; l < NLAYER; ++l) {
        const int base = 1 + l * PH_PER_LAYER;
        const int last = (l == NLAYER - 1);
        for (int rep_ = 0; rep_ < ((DBG_REPEAT == 0) ? 2 : 1); ++rep_) if (PH_ON(0) && IN(base + 0) && l == 0) { REFRAME(); if (rep_) xcd_barrier(bar, T0()); modnorm_phase(F, nullptr, karg(6) + (size_t)l * DM, MODP, 0, HBUF, 0, karg(0), karg(2)); SEAM(base + 0); }
        for (int rep_ = 0; rep_ < ((DBG_REPEAT == 1) ? 2 : 1); ++rep_) if (PH_ON(1) && IN(base + 1)) { REFRAME(); if (rep_) xcd_barrier(bar, T0());
            pg8::Gemm g{HBUF, (const bf16*)(ws + WS_WINA) + (size_t)l * INA_P * DM, MALL, INA_P, DM}; pg8::RowOrder S; S.init_rows(0, INA_P, F.G, bx);
            pg8::EpiStoreBf16 E{(bf16*)(ws + WS_PA), INA_P};
            GEMM_CALL(pg8::EpiStoreBf16, pg8::RowOrder, g, S, E);
            SEAM(base + 1); }
        for (int rep_ = 0; rep_ < ((DBG_REPEAT == 2) ? 2 : 1); ++rep_) if (PH_ON(2) && IN(base + 2)) { REFRAME(); if (rep_) xcd_barrier(bar, T0());
            FeatP P;
            P.PA = (const bf16*)(ws + WS_PA); P.mu = karg(9) + (size_t)l * RWC; P.w0 = karg(10) + (size_t)l * 2 * RW; P.a0 = karg(12) + (size_t)l * 2 * RW;
            P.k_k = karg(15) + (size_t)l * RW; P.k_a = karg(16) + (size_t)l * RW; P.r_k = karg(17) + (size_t)l * RW;
            P.WUP = (const bf16*)(ws + WS_WUP) + (size_t)l * 2 * RW * 64; P.AUP = (const bf16*)(ws + WS_AUP) + (size_t)l * 2 * RW * 64; P.GUP = (const bf16*)(ws + WS_GUP) + (size_t)l * 2 * RW * 32;
            P.qnorm = karg(20) + (size_t)l * 512; P.kvnorm = karg(22) + (size_t)l * 256; P.rope = (const f32x2*)(ws + WS_ROPE);
            P.RI = (bf16*)(ws + WS_RI); P.GG = (bf16*)(ws + WS_GG); P.BON = (float*)(ws + WS_BON); P.QN = (bf16*)(ws + WS_QN); P.KVN = (bf16*)(ws + WS_KVN); P.K = (bf16*)(ws + WS_K);
            features_phase(F, P);
            SEAM(base + 2); }
        for (int rep_ = 0; rep_ < ((DBG_REPEAT == 3) ? 2 : 1); ++rep_) if (PH_ON(3) && IN(base + 3)) { REFRAME(); if (rep_) xcd_barrier(bar, T0());
            { pg8::Gemm g{(const bf16*)(ws + WS_QN), (const bf16*)(ws + WS_WUQ) + (size_t)l * NQ * 512, MALL, NQ, 512};
              pg8::EpiQ E{(bf16*)(ws + WS_Q), (const f32x2*)(ws + WS_ROPE), 0.14724444f};
              pg8::RowOrder S; S.init_rows(last, NQ, F.G, bx); GEMM_CALL_NA(pg8::EpiQ, pg8::RowOrder, g, S, E); }
            { pg8::Gemm g{(const bf16*)(ws + WS_KVN), (const bf16*)(ws + WS_WUKV) + (size_t)l * NKV * 256, MALL, NKV, 256}; pg8::RowOrder S; S.init_rows(0, NKV, F.G, bx);
              pg8::EpiKV E{(bf16*)(ws + WS_K), (bf16*)(ws + WS_V)};
              GEMM_CALL_NA(pg8::EpiKV, pg8::RowOrder, g, S, E); }
            SEAM(base + 3); }
        for (int rep_ = 0; rep_ < ((DBG_REPEAT == 4) ? 2 : 1); ++rep_) if (PH_ON(4) && IN(base + 4)) { REFRAME(); if (rep_) xcd_barrier(bar, T0());
            ScanCvt C; C.pu = karg(30) + (size_t)l * NEXP * DM; C.pv = karg(31) + (size_t)l * NEXP * DM; C.PU8 = ws + WS_P4; C.PV8 = ws + WS_P4 + (size_t)NEXP * (DM / 2); C.SU = (float*)(ws + WS_P4S); C.SV = (float*)(ws + WS_P4S) + NEXP;
            scan_phase(F, (const bf16*)(ws + WS_RI), (bf16*)(ws + WS_Y), C); SEAM(base + 4); }
        for (int rep_ = 0; rep_ < ((DBG_REPEAT == 5) ? 2 : 1); ++rep_) if (PH_ON(5) && IN(base + 5)) { REFRAME(); if (rep_) xcd_barrier(bar, T0());
            attn_phase(F, (const bf16*)(ws + WS_Q), (const bf16*)(ws + WS_K), (const bf16*)(ws + WS_V), (bf16*)(ws + WS_YB), !last);
            readout_phase(F, (const bf16*)(ws + WS_Y), (const bf16*)(ws + WS_GG), (const float*)(ws + WS_BON), (const bf16*)(ws + WS_RI), karg(18) + (size_t)l * RW, karg(19) + (size_t)l * RW, (bf16*)(ws + WS_YA));
            SEAM(base + 5); }
        for (int rep_ = 0; rep_ < ((DBG_REPEAT == 6) ? 2 : 1); ++rep_) if (PH_ON(6) && IN(base + 6)) { REFRAME(); if (rep_) xcd_barrier(bar, T0());
            bf16* T1 = (bf16*)(ws + WS_T1); bf16* T2 = (bf16*)(ws + WS_T2);
            const pg8::Gemm g1{HBUF, (const bf16*)(ws + WS_WGA) + (size_t)l * DM * DM, MALL, DM, DM}, g2{(const bf16*)(ws + WS_YA), (const bf16*)(ws + WS_WA) + (size_t)l * DM * RW, MALL, DM, RW};
            const pg8::Gemm g3{HBUF, (const bf16*)(ws + WS_WGB) + (size_t)l * DM * DM, MALL, DM, DM}, g4{(const bf16*)(ws + WS_YB), (const bf16*)(ws + WS_WB) + (size_t)l * DM * RW, MALL, DM, RW};
            const pg8::EpiGate E1{T1, DM, karg(8) + (size_t)l * 2 * DM}, E3{T2, DM, karg(8) + (size_t)l * 2 * DM + DM};
            const pg8::EpiMulAdd E2{T1, T1, nullptr, DM}, E4{T1, T2, T1, DM};
            pg8::RowOrder S; S.init_rows(last, DM, F.G, bx);
            GEMM_CALL(pg8::EpiGate, pg8::RowOrder, g1, S, E1); GEMM_CALL(pg8::EpiMulAdd, pg8::RowOrder, g2, S, E2); GEMM_CALL(pg8::EpiGate, pg8::RowOrder, g3, S, E3); GEMM_CALL(pg8::EpiMulAdd, pg8::RowOrder, g4, S, E4);
            if (MK_N_LAUNCHES == 1 && l == 0 && rep_ == 0) { __syncthreads();
                const int late = (F.G > 32) ? 16 : 0; p0_prologue(F, 1, NLAYER, (bx >= late) ? bx - late : -1, F.G - late); }
            SEAM(base + 6); }
        for (int rep_ = 0; rep_ < ((DBG_REPEAT == 7) ? 2 : 1); ++rep_) if (PH_ON(7) && IN(base + 7)) { REFRAME(); if (rep_) xcd_barrier(bar, T0());
            const pg8::Gemm g{(const bf16*)(ws + WS_T1), (const bf16*)(ws + WS_WO) + (size_t)l * DM * DM, MALL, DM, DM};
            const pg8::EpiResid E{XBUF, MODP + 2 * DM, l == 0 ? karg(0) : nullptr, l == 0 ? karg(2) : nullptr};
            pg8::RowOrder S; S.init_rows(last, DM, F.G, bx); GEMM_CALL(pg8::EpiResid, pg8::RowOrder, g, S, E);
            SEAM(base + 7); }
        for (int rep_ = 0; rep_ < ((DBG_REPEAT == 8) ? 2 : 1); ++rep_) if (PH_ON(8) && IN(base + 8)) { REFRAME(); if (rep_) xcd_barrier(bar, T0());
            modnorm_phase_bf(F, XBUF, karg(27) + (size_t)l * DM, MODP, 3, HBUF, last);
            SEAM(base + 8); }
        for (int rep_ = 0; rep_ < ((DBG_REPEAT == 9) ? 2 : 1); ++rep_) if (PH_ON(9) && IN(base + 9)) { REFRAME(); if (rep_) xcd_barrier(bar, T0());
            const pg8::Gemm g{HBUF, (const bf16*)(ws + WS_WQK) + (size_t)l * DM * DM, MALL, DM, DM};
            const pg8::EpiF16 E{(_Float16*)(ws + WS_SC), DM};
            pg8::RowOrder S; S.init_rows(last, DM, F.G, bx); GEMM_CALL(pg8::EpiF16, pg8::RowOrder, g, S, E);
            SEAM(base + 9); }
        for (int rep_ = 0; rep_ < ((DBG_REPEAT == 11) ? 2 : 1); ++rep_) if (PH_ON(11) && IN(base + 11)) { REFRAME(); if (rep_) xcd_barrier(bar, T0());
            PeerP P; P.SC = (const _Float16*)(ws + WS_SC); P.nmod = MODP + 3 * 12288; P.ng = karg(6) + (size_t)(l + 1) * DM; P.Hout = HBUF; P.ESEL = (const int*)(ws + WS_T1); P.EGATE = (const float*)(ws + WS_T1 + 16 * MiB); P.H = HBUF; P.PU = ws + WS_P4; P.PV = ws + WS_P4 + (size_t)NEXP * (DM / 2); P.SU = (const float*)(ws + WS_P4S); P.SV = (const float*)(ws + WS_P4S) + NEXP; P.X = XBUF; P.mod = MODP; P.fin_g = karg(32); P.out = (float*)karg(33); P.last = last; P.dry = (DBG_REPEAT == 11 && rep_ == 0) ? DBG_DRY : 0;
            peer_phase(F, P);
            SEAM(base + 11); }
    }
#undef IN
#undef SEAM
#undef XBUF
#undef HBUF
#undef MODP
}

__device__ __forceinline__ float mx_a_val(int i, int k) { const int c = (i * 131 + k * 17 + (k >> 3) * 5) & 15; const float mag[8] = {0.f, .5f, 1.f, 1.5f, 2.f, 3.f, 4.f, 6.f}; return (c & 8) ? -mag[c & 7] : mag[c & 7]; }
__device__ __forceinline__ int mx_a_code(int i, int k) { return (i * 131 + k * 17 + (k >> 3) * 5) & 15; }
__device__ __forceinline__ float mx_b_val(int k, int j) { return (float)(((k * 7 + j * 13 + (k >> 4)) % 9) - 4); }
__device__ __forceinline__ int mx_kmap(int hyp, int kb, int e) { const int h = hyp % 3; return h == 0 ? 32 * kb + e : h == 1 ? 32 * (e >> 3) + 8 * kb + (e & 7) : 64 * (e >> 4) + 16 * kb + (e & 15); }
__global__ void __launch_bounds__(512) dbg_fill(const float* pp, float* o) {
    __shared__ float vsh;
    float v = 0.f;
    if (DBG_PROBE == 5) {
        if (threadIdx.x < 64) { typedef int v8i __attribute__((ext_vector_type(8))); typedef float f4 __attribute__((ext_vector_type(4)));
            const int lane = threadIdx.x, i = lane & 15, kb = lane >> 4; float code = 0.f;
            for (int hyp = 0; hyp < 18; ++hyp) { const int nibswap = hyp / 9, ha = hyp % 3, hb2 = (hyp / 3) % 3;
                unsigned aw[4] = {0u, 0u, 0u, 0u}; int bw[8] = {0, 0, 0, 0, 0, 0, 0, 0};
                for (int e = 0; e < 32; ++e) { const int k = mx_kmap(ha, kb, e); const unsigned c = (unsigned)mx_a_code(i, k); const int pos = nibswap ? (e ^ 1) : e; aw[pos >> 3] |= c << (4 * (pos & 7)); }
                for (int q = 0; q < 8; ++q) { int w = 0; const float f0 = mx_b_val(mx_kmap(hb2, kb, 4 * q + 0), i), f1 = mx_b_val(mx_kmap(hb2, kb, 4 * q + 1), i), f2 = mx_b_val(mx_kmap(hb2, kb, 4 * q + 2), i), f3 = mx_b_val(mx_kmap(hb2, kb, 4 * q + 3), i);
                    w = __builtin_amdgcn_cvt_pk_fp8_f32(f0, f1, w, false); w = __builtin_amdgcn_cvt_pk_fp8_f32(f2, f3, w, true); bw[q] = w; }
                const v8i af = {(int)aw[0], (int)aw[1], (int)aw[2], (int)aw[3], 0, 0, 0, 0}, bf = {bw[0], bw[1], bw[2], bw[3], bw[4], bw[5], bw[6], bw[7]};
                f4 d = {0.f, 0.f, 0.f, 0.f};
                d = __builtin_amdgcn_mfma_scale_f32_16x16x128_f8f6f4(af, bf, d, 4, 0, 0, 0x7f7f7f7f, 0, 0x7f7f7f7f);
                int bad = 0;
                for (int r = 0; r < 4; ++r) { const int row = 4 * kb + r, col = i; float ex = 0.f; for (int k = 0; k < 128; ++k) ex += mx_a_val(row, k) * mx_b_val(k, col); bad += (d[r] != ex); }
                if (__ballot(bad != 0) == 0ull && code == 0.f) code = (float)(hyp + 1); }
            for (int t = 0; t < 2; ++t) {
                int aw[8] = {0, 0, 0, 0, 0, 0, 0, 0}, bw[8] = {0, 0, 0, 0, 0, 0, 0, 0};
                if (t == 0) { for (int e = 0; e < 32; ++e) { const int k = 32 * kb + e; aw[e >> 3] |= mx_a_code(i, k) << (4 * (e & 7)); bw[e >> 3] |= mx_a_code(i + 16, k) << (4 * (e & 7)); } }
                else { for (int q = 0; q < 8; ++q) { int w = 0, w2 = 0; const int k = 32 * kb + 4 * q;
                        w = __builtin_amdgcn_cvt_pk_fp8_f32(mx_b_val(k, i + 16), mx_b_val(k + 1, i + 16), w, false); w = __builtin_amdgcn_cvt_pk_fp8_f32(mx_b_val(k + 2, i + 16), mx_b_val(k + 3, i + 16), w, true); aw[q] = w;
                        w2 = __builtin_amdgcn_cvt_pk_fp8_f32(mx_b_val(k, i), mx_b_val(k + 1, i), w2, false); w2 = __builtin_amdgcn_cvt_pk_fp8_f32(mx_b_val(k + 2, i), mx_b_val(k + 3, i), w2, true); bw[q] = w2; } }
                const v8i af = {aw[0], aw[1], aw[2], aw[3], aw[4], aw[5], aw[6], aw[7]}, bf = {bw[0], bw[1], bw[2], bw[3], bw[4], bw[5], bw[6], bw[7]};
                f4 d = {0.f, 0.f, 0.f, 0.f};
                if (t == 0) d = __builtin_amdgcn_mfma_scale_f32_16x16x128_f8f6f4(af, bf, d, 4, 4, 0, 0x7f7f7f7f, 0, 0x7f7f7f7f); else d = __builtin_amdgcn_mfma_scale_f32_16x16x128_f8f6f4(af, bf, d, 0, 0, 0, 0x7f7f7f7f, 0, 0x7f7f7f7f);
                int bad = 0;
                for (int r = 0; r < 4; ++r) { const int row = 4 * kb + r, col = i; float ex = 0.f;
                    for (int k = 0; k < 128; ++k) ex += (t == 0) ? mx_a_val(row, k) * mx_a_val(col + 16, k) : mx_b_val(k, row + 16) * mx_b_val(k, col);
                    bad += (d[r] != ex); }
                if (__ballot(bad != 0) == 0ull) code += (t == 0) ? 10.f : 20.f; }
            if (lane == 0) vsh = code; }
        __syncthreads(); v = vsh;
    } else {
        float s0 = 0.f, s1 = 0.f, s2 = 0.f, s3 = 0.f;
        for (int i = 0; i < 2048; ++i) { s0 += pp[4 * i]; s1 += pp[4 * i + 1]; s2 += pp[4 * i + 2]; s3 += pp[4 * i + 3]; }
        if (DBG_PROBE == 4) { float mx = 0.f; for (int i = 0; i < 2048; ++i) mx = fmaxf(mx, pp[4 * i]); v = 100.f * mx; }
        else { v = (DBG_PROBE == 1 ? s0 : DBG_PROBE == 2 ? s1 : s2) / s3 * 1e-3f; v = exp2f(rintf(log2f(v) * 4.f) * 0.25f); }
    }
    for (size_t i = (size_t)blockIdx.x * 512 + threadIdx.x; i < (size_t)NBATCH * SEQ * DM; i += (size_t)gridDim.x * 512) o[i] = v;
}
extern "C" void kernel_launch(void* const* d_in, const int* in_sizes, int n_in, void* d_out, int out_size, void* d_ws, size_t ws_size, hipStream_t stream) {
    static int grid = 0;
    if (grid == 0) {
        if (n_in != 33 || out_size != NBATCH * SEQ * DM || ws_size < WS_END2) { fprintf(stderr, "kernel_launch: unexpected shapes (n_in %d out %d ws %zu)\n", n_in, out_size, ws_size); grid = -1; return; }
        int dev = 0, cus = 0, per_cu = 0;
        if (hipGetDevice(&dev) != hipSuccess || hipDeviceGetAttribute(&cus, hipDeviceAttributeMultiprocessorCount, dev) != hipSuccess) { grid = -1; return; }
        if (hipFuncSetAttribute((const void*)mk_fwd, hipFuncAttributeMaxDynamicSharedMemorySize, LDS_BYTES) != hipSuccess) { fprintf(stderr, "kernel_launch: hipFuncSetAttribute failed\n"); grid = -1; return; }
        if (hipOccupancyMaxActiveBlocksPerMultiprocessor(&per_cu, (const void*)mk_fwd, NWAVES * 64, LDS_BYTES) != hipSuccess || per_cu < 1) { fprintf(stderr, "kernel_launch: occupancy query says %d\n", per_cu); (void)hipGetLastError(); grid = -1; return; }
        grid = cus;
    }
    if (grid < 0) return;
    if (hipMemsetAsync((char*)d_ws + WS_CTL, 0, CTL_ZERO_BYTES, stream) != hipSuccess) return;
    Args a{};
    for (int i = 0; i < 33; ++i) a.in[i] = (const float*)d_in[i];
    a.out = (float*)d_out; a.ws = (unsigned char*)d_ws;
#if MK_N_LAUNCHES == 1
    a.ph_lo = 0; a.ph_hi = NPHASE;
    hipLaunchKernelGGL(mk_fwd, dim3(grid), dim3(NWAVES * 64), LDS_BYTES, stream, a);
#else
    if (DBG_PROBE != 5) for (int p = 0; p < NPHASE; ++p) { a.ph_lo = p; a.ph_hi = p + 1; hipLaunchKernelGGL(mk_fwd, dim3(grid), dim3(NWAVES * 64), LDS_BYTES, stream, a); }
    if (DBG_PROBE) hipLaunchKernelGGL(dbg_fill, dim3(1024), dim3(512), 0, stream, (const float*)((char*)d_ws + WS_CTL + CTL_PROBE_OFF), (float*)d_out);
#endif
}
```

```cpp
#include <hip/hip_runtime.h>
#include <cstdio>
#include <cstdint>

#ifndef MK_N_LAUNCHES
#define MK_N_LAUNCHES 1
#endif

#ifndef DBG_SKIP
#define DBG_SKIP 0
#endif
#ifndef DBG_PROBE
#define DBG_PROBE 0
#endif
#ifndef DBG_DRY
#define DBG_DRY 1
#endif
#ifndef DBG_REPEAT
#define DBG_REPEAT -1
#endif
namespace pg8 {
#define PG8_LAS __attribute__((address_space(3)))
typedef unsigned short bf16_t;
typedef short bf16x8 __attribute__((ext_vector_type(8)));
typedef float f32x4 __attribute__((ext_vector_type(4)));
typedef unsigned u32x4 __attribute__((ext_vector_type(4)));
constexpr int BM = 256, BK = 64, HALF = 128, HTB = HALF * BK * 2  , STAGE_BYTES = 8 * HTB, NXCD = 8, WGM = 8;

__host__ __device__ __forceinline__ int lds_byte(int r, int c) { const int st = (r >> 4) * 2 + (c >> 5), rr = r & 15, cc = c & 31, ob = rr * 64 + cc * 2; return st * 1024 + (ob ^ (((ob >> 9) & 1) << 5)); }
__host__ __device__ __forceinline__ void stage_rc(int b, int& R, int& C) { const int st = b / 1024, sb = b % 1024, swz = sb ^ (((sb >> 9) & 1) << 5); R = (st >> 1) * 16 + swz / 64; C = (st & 1) * 32 + (swz % 64) / 2; }
__host__ __device__ __forceinline__ int perm32(int rho) { const int n = rho >> 4, i = rho & 15; return 8 * (i >> 2) + 4 * n + (i & 3); }

struct Unit { int pm, pn; };
struct Gemm { const bf16_t* A; const bf16_t* Bt; int M, N, K; };

struct StaticOrder {
    int nM, nN, nwg, G, c;
    __host__ __device__ void init(int M, int N, int G_, int c_) { nM = M / BM; nN = N / BM; nwg = nM * nN; G = G_; c = c_; }
    __host__ __device__ bool next(int i, Unit& u) const {
        const long L = (long)i * G + c; if (L >= nwg) return false;
        int wgid = (int)L; { const int q = nwg / NXCD, r = nwg % NXCD, xcd = wgid % NXCD, off = wgid / NXCD; wgid = (xcd < r ? xcd * (q + 1) : r * (q + 1) + (xcd - r) * q) + off; }
        const int nig = WGM * nN, gid = wgid / nig, fm = gid * WGM, gsz = (nM - fm) < WGM ? (nM - fm) : WGM;
        u.pm = fm + ((wgid % nig) % gsz); u.pn = (wgid % nig) / gsz; return true;
    }
    __device__ __forceinline__ void a_ready(const Unit&) const {}
    __device__ __forceinline__ void done(const Unit&) const {}
};
__device__ __forceinline__ int opaque_lane() { int l; asm volatile("v_mbcnt_lo_u32_b32 %0, -1, 0\n\tv_mbcnt_hi_u32_b32 %0, -1, %0" : "=v"(l)); return l; }
typedef __bf16 bf16x2c __attribute__((ext_vector_type(2)));
__device__ __forceinline__ unsigned cvt_pk_bf16(float lo, float hi) { const bf16x2c v = {(__bf16)lo, (__bf16)hi}; return __builtin_bit_cast(unsigned, v); }
template <class Epi, class Sched, bool ALIGN_EPI = false, bool SP2 = false>
__device__ __forceinline__ void gemm_phase(PG8_LAS unsigned char* lds, const Gemm g, const Sched& S, const Epi& E, const int wave_s) {
    const int lane_ = opaque_lane();
    const int wid = wave_s, lane = lane_, tid = wid * 64 + lane, wr = wid >> 2, wc = wid & 3, fr = lane & 15, fq = lane >> 4;
    const int K = g.K, nt = K / BK;
    unsigned voffA[2], voffB[2];
#pragma unroll
    for (int i = 0; i < 2; ++i) { int R, C; stage_rc(tid * 16 + i * 8192, R, C); const int Rb = Epi::PERM ? ((R & ~31) + perm32(R & 31)) : R;
        voffA[i] = (unsigned)(R * K + C) * 2u; voffB[i] = (unsigned)(Rb * K + C) * 2u; }
    const size_t kstep = (size_t)(BK * 2);
    const size_t hstep = (size_t)HALF * K * 2;
    const size_t tstep = 2 * hstep;
    const unsigned ldsw = (unsigned)wid * 1024u;
    const int aoff = lds_byte(wr * 64 + fr, fq * 8), boff = lds_byte(wc * 32 + fr, fq * 8);
#define PG8_SA(b, h) (((b) * 2 + (h)) * HTB)
#define PG8_SB(b, h) ((4 + (b) * 2 + (h)) * HTB)
#define PG8_STAGE(bufoff, gbase, voff) do { _Pragma("unroll") for (int _i = 0; _i < 2; ++_i) \
        __builtin_amdgcn_global_load_lds((const unsigned*)((const char*)(gbase) + (voff)[_i]), (PG8_LAS unsigned*)(lds + (bufoff) + ldsw + _i * 8192), 16, 0, 0); } while (0)
#define PG8_LDA(dst, b, h) do { _Pragma("unroll") for (int m = 0; m < 4; ++m) _Pragma("unroll") for (int k = 0; k < 2; ++k) dst[m][k] = *(const PG8_LAS bf16x8*)(lds + PG8_SA(b, h) + aoff + m * 2048 + k * 1024); } while (0)
#define PG8_LDB(dst, b, h) do { _Pragma("unroll") for (int n = 0; n < 2; ++n) _Pragma("unroll") for (int k = 0; k < 2; ++k) dst[n][k] = *(const PG8_LAS bf16x8*)(lds + PG8_SB(b, h) + boff + n * 2048 + k * 1024); } while (0)
#define PG8_MMA(ai, bj, At, Bt) do { __builtin_amdgcn_s_setprio(1); _Pragma("unroll") for (int m = 0; m < 4; ++m) _Pragma("unroll") for (int n = 0; n < 2; ++n) _Pragma("unroll") for (int k = 0; k < 2; ++k) \
        acc[ai][bj][m][n] = __builtin_amdgcn_mfma_f32_16x16x32_bf16(Bt[n][k], At[m][k], acc[ai][bj][m][n], 0, 0, 0); __builtin_amdgcn_s_setprio(0); } while (0)
#define PG8_WAIT_V(n) asm volatile("s_waitcnt vmcnt(" #n ")" ::: "memory")
#define PG8_WAIT_L(n) asm volatile("s_waitcnt lgkmcnt(" #n ")" ::: "memory")
#define PG8_BAR __builtin_amdgcn_s_barrier()
#define PG8_SCHED __builtin_amdgcn_sched_barrier(0)
    Unit cur, nxt; int ui = 0;
    if (!S.next(0, cur)) return;
    f32x4 acc[2][2][4][2];
#pragma unroll
    for (int a = 0; a < 2; ++a)
#pragma unroll
        for (int b = 0; b < 2; ++b)
#pragma unroll
            for (int m = 0; m < 4; ++m)
#pragma unroll
                for (int n = 0; n < 2; ++n) acc[a][b][m][n] = (f32x4){0.f, 0.f, 0.f, 0.f};
    bf16x8 At[4][2], B0[2][2], B1[2][2];
    const char* cA = (const char*)g.A + (size_t)cur.pm * tstep; const char* cB = (const char*)g.Bt + (size_t)cur.pn * tstep;
    S.a_ready(cur);
    if constexpr (SP2) {
        PG8_STAGE(PG8_SB(0, 0), cB, voffB); PG8_STAGE(PG8_SB(0, 1), cB + hstep, voffB); PG8_STAGE(PG8_SA(0, 0), cA, voffA); PG8_STAGE(PG8_SA(0, 1), cA + hstep, voffA);
        if (wr == 1) PG8_BAR;
        PG8_WAIT_V(2); PG8_BAR;
        PG8_STAGE(PG8_SB(1, 0), cB + kstep, voffB); PG8_STAGE(PG8_SA(1, 0), cA + kstep, voffA); PG8_STAGE(PG8_SB(1, 1), cB + hstep + kstep, voffB);
        PG8_WAIT_V(6); PG8_BAR;
    } else {
        PG8_STAGE(PG8_SB(0, 0), cB, voffB); PG8_STAGE(PG8_SA(0, 0), cA, voffA); PG8_STAGE(PG8_SB(0, 1), cB + hstep, voffB); PG8_STAGE(PG8_SA(0, 1), cA + hstep, voffA);
        if (wr == 1) PG8_BAR;
        PG8_WAIT_V(4); PG8_BAR;
        PG8_STAGE(PG8_SB(1, 0), cB + kstep, voffB); PG8_STAGE(PG8_SA(1, 0), cA + kstep, voffA); PG8_STAGE(PG8_SB(1, 1), cB + hstep + kstep, voffB);
        PG8_WAIT_V(6); PG8_BAR;
    }
    for (;;) {
        const bool has_next = S.next(ui + 1, nxt);
        const char* nA = has_next ? (const char*)g.A + (size_t)nxt.pm * tstep : cA; const char* nB = has_next ? (const char*)g.Bt + (size_t)nxt.pn * tstep : cB;
        for (int t = 0; t < nt; t += 2) {
            const bool last = (t == nt - 2);
            const char* a1 = cA + (size_t)(t + 1) * kstep;
            const char* a2 = last ? nA : cA + (size_t)(t + 2) * kstep; const char* b2 = last ? nB : cB + (size_t)(t + 2) * kstep;
            const char* a3 = a2 + kstep; const char* b3 = b2 + kstep;
            if (last && has_next) S.a_ready(nxt);
            if constexpr (SP2) {
            PG8_LDB(B0, 0, 0); PG8_LDB(B1, 0, 1); PG8_SCHED; PG8_LDA(At, 0, 0); PG8_STAGE(PG8_SA(1, 1), a1 + hstep, voffA);
            PG8_WAIT_V(8); PG8_WAIT_L(0); PG8_BAR; PG8_MMA(0, 0, At, B0); PG8_MMA(0, 1, At, B1); PG8_BAR; PG8_SCHED;
            PG8_LDA(At, 0, 1); PG8_STAGE(PG8_SB(0, 0), b2, voffB); PG8_STAGE(PG8_SB(0, 1), b2 + hstep, voffB); PG8_STAGE(PG8_SA(0, 0), a2, voffA);
            PG8_WAIT_V(8); PG8_WAIT_L(0); PG8_BAR; PG8_MMA(1, 0, At, B0); PG8_MMA(1, 1, At, B1); PG8_BAR; PG8_SCHED;
            PG8_LDB(B0, 1, 0); PG8_LDB(B1, 1, 1); PG8_SCHED; PG8_LDA(At, 1, 0); PG8_STAGE(PG8_SA(0, 1), a2 + hstep, voffA);
            PG8_WAIT_V(8); PG8_WAIT_L(0); PG8_BAR; PG8_MMA(0, 0, At, B0); PG8_MMA(0, 1, At, B1); PG8_BAR; PG8_SCHED;
            PG8_LDA(At, 1, 1); PG8_STAGE(PG8_SB(1, 0), b3, voffB); PG8_STAGE(PG8_SB(1, 1), b3 + hstep, voffB); PG8_STAGE(PG8_SA(1, 0), a3, voffA);
            PG8_WAIT_V(8); PG8_WAIT_L(0); PG8_BAR; PG8_MMA(1, 0, At, B0); PG8_MMA(1, 1, At, B1); PG8_BAR; PG8_SCHED;
            } else {
            PG8_LDB(B0, 0, 0); PG8_SCHED; PG8_LDA(At, 0, 0); PG8_STAGE(PG8_SA(1, 1), a1 + hstep, voffA);
            PG8_WAIT_L(8); PG8_BAR; PG8_WAIT_L(0); PG8_MMA(0, 0, At, B0); PG8_BAR; PG8_SCHED;
            PG8_LDB(B1, 0, 1); PG8_STAGE(PG8_SB(0, 0), b2, voffB);
            PG8_BAR; PG8_WAIT_L(0); PG8_MMA(0, 1, At, B1); PG8_BAR;
            PG8_LDA(At, 0, 1); PG8_STAGE(PG8_SA(0, 0), a2, voffA);
            PG8_BAR; PG8_WAIT_L(0); PG8_MMA(1, 0, At, B0); PG8_BAR; PG8_SCHED;
            PG8_STAGE(PG8_SB(0, 1), b2 + hstep, voffB);
            PG8_WAIT_V(6); PG8_BAR; PG8_MMA(1, 1, At, B1); PG8_BAR;
            PG8_LDB(B0, 1, 0); PG8_SCHED; PG8_LDA(At, 1, 0); PG8_STAGE(PG8_SA(0, 1), a2 + hstep, voffA);
            PG8_WAIT_L(8); PG8_BAR; PG8_WAIT_L(0); PG8_MMA(0, 0, At, B0); PG8_BAR; PG8_SCHED;
            PG8_LDB(B1, 1, 1); PG8_STAGE(PG8_SB(1, 0), b3, voffB);
            PG8_BAR; PG8_WAIT_L(0); PG8_MMA(0, 1, At, B1); PG8_BAR;
            PG8_LDA(At, 1, 1); PG8_STAGE(PG8_SA(1, 0), a3, voffA);
            PG8_BAR; PG8_WAIT_L(0); PG8_MMA(1, 0, At, B0); PG8_BAR; PG8_SCHED;
            PG8_STAGE(PG8_SB(1, 1), b3 + hstep, voffB);
            PG8_WAIT_V(6); PG8_BAR; PG8_MMA(1, 1, At, B1); PG8_BAR;
            }
        }
        if constexpr (ALIGN_EPI) { if (wr == 0) PG8_BAR; }
        if constexpr (!Epi::AFTER_DRAIN) { const int le_ = opaque_lane(); E(acc, cur, wr, wc, le_ & 15, le_ >> 4); S.done(cur); }
        if (!has_next) break;
#pragma unroll
        for (int a = 0; a < 2; ++a)
#pragma unroll
            for (int b = 0; b < 2; ++b)
#pragma unroll
                for (int m = 0; m < 4; ++m)
#pragma unroll
                    for (int n = 0; n < 2; ++n) acc[a][b][m][n] = (f32x4){0.f, 0.f, 0.f, 0.f};
        cur = nxt; cA = nA; cB = nB; ++ui;
        if constexpr (ALIGN_EPI) { if (wr == 1) PG8_BAR; }
    }
    PG8_WAIT_V(0);
    if constexpr (!ALIGN_EPI) { if (wr == 0) PG8_BAR; }
    PG8_BAR;
    if constexpr (Epi::AFTER_DRAIN) { E.fused(acc, cur, wr, wc, fr, fq, lds, wid, lane); S.done(cur); }
#undef PG8_SA
#undef PG8_SB
#undef PG8_STAGE
#undef PG8_LDA
#undef PG8_LDB
#undef PG8_MMA
#undef PG8_WAIT_V
#undef PG8_WAIT_L
#undef PG8_BAR
#undef PG8_SCHED
}
}

constexpr int NWAVES = 8;
constexpr int DM = 2048, NBATCH = 2, SEQ = 8192, CTXL = 256, TPB = CTXL + SEQ  , MALL = NBATCH * TPB  ;
constexpr int NLAYER = 2;
constexpr int RW = 1024, NH = 16;
constexpr int RWC = 3392, INA = 4192, INA_P = 4352, INC = 8288;
constexpr int C_WD = 3072, C_AD = 3200, C_GD = 3328, C_QC = 3392, C_KVC = 3904, C_KR = 4160;
constexpr int QKD = 96, NQ = NH * QKD  , NKV = NH * 128  ;
constexpr int NEXP = 16384;
constexpr int RREC = 9 * 64;
constexpr float NORM_EPS = 1e-6f;

constexpr size_t MiB = 1u << 20;
constexpr size_t WS_CTL = 0, CTL_ZERO_BYTES = 1 * MiB;
constexpr size_t CTL_MOD_OFF = 256 * 1024;
constexpr size_t WS_ROPE = 1 * MiB;
constexpr size_t WS_WUP = 3 * MiB, WS_AUP = WS_WUP + 512 * 1024, WS_GUP = 4 * MiB;
constexpr size_t WS_WUQ = 5 * MiB, WS_WUKV = 8 * MiB, WS_WA = 10 * MiB, WS_WB = 18 * MiB, WS_WO = 26 * MiB, WS_WQK = 42 * MiB, WS_WGA = 58 * MiB, WS_WGB = 74 * MiB, WS_WINA = 90 * MiB;
constexpr size_t WS_X = 124 * MiB, WS_H = 256 * MiB, WS_DYN = 322 * MiB;
constexpr size_t WS_PA = WS_DYN;
constexpr size_t WS_RI = 463 * MiB;
constexpr size_t WS_GG = 760 * MiB;
constexpr size_t WS_BON = 826 * MiB;
constexpr size_t WS_QN = 831 * MiB, WS_KVN = 848 * MiB;
constexpr size_t WS_Q = 857 * MiB, WS_K = 907 * MiB, WS_V = 957 * MiB, WS_END = 990 * MiB;
constexpr size_t WS_Y = WS_DYN;
constexpr size_t WS_YA = 388 * MiB, WS_YB = 421 * MiB;
constexpr size_t WS_T1 = 463 * MiB, WS_T2 = 529 * MiB;
constexpr size_t WS_PU = 600 * MiB, WS_PV = 664 * MiB;
constexpr size_t WS_P4 = 990 * MiB, WS_P4S = 1022 * MiB, WS_END2 = 1023 * MiB;
constexpr size_t WS_SC = WS_DYN;
static_assert(WS_PA + (size_t)MALL * INA_P * 2 <= WS_RI && WS_RI + (size_t)NBATCH * NH * TPB * RREC * 2 <= WS_GG && WS_GG + (size_t)2 * MALL * RW * 2 <= WS_BON, "ws map 1");
static_assert(WS_BON + (size_t)2 * MALL * 32 * 4 <= WS_QN && WS_QN + (size_t)MALL * 512 * 2 <= WS_KVN && WS_KVN + (size_t)MALL * 256 * 2 <= WS_Q, "ws map 2");
static_assert(WS_Q + (size_t)NBATCH * NH * TPB * QKD * 2 <= WS_K && WS_K + (size_t)NBATCH * NH * TPB * QKD * 2 <= WS_V && WS_V + (size_t)NBATCH * NH * TPB * 64 * 2 <= WS_END, "ws map 3");
static_assert(WS_Y + (size_t)2 * MALL * RW * 2 <= WS_YA && WS_YA + (size_t)MALL * RW * 2 <= WS_YB && WS_YB + (size_t)MALL * RW * 2 <= WS_RI, "ws map 4");
static_assert(WS_T1 + (size_t)MALL * DM * 2 <= WS_T2 && WS_T2 + (size_t)MALL * DM * 2 <= WS_PU && WS_PU + (size_t)NEXP * DM * 2 <= WS_PV && WS_PV + (size_t)NEXP * DM * 2 <= WS_GG, "ws map 5");
static_assert(WS_SC + (size_t)MALL * DM * 4 <= WS_T1 && WS_X + (size_t)MALL * DM * 4 <= WS_H && WS_H + (size_t)MALL * DM * 2 <= WS_DYN, "ws map 6");
static_assert(WS_WINA + (size_t)NLAYER * INA_P * DM * 2 <= WS_X, "ws map 7");
constexpr size_t CTL_PROBE_OFF = 640 * 1024;
constexpr int CW_BAR = 4096;

constexpr int RING_BYTES = 131072;
constexpr int LDSCTL_OFF = RING_BYTES, MISC_OFF = LDSCTL_OFF + 320;
constexpr int LDS_BYTES = 147456;

#define GAS __attribute__((address_space(1)))
#define LAS __attribute__((address_space(3)))
typedef unsigned short bf16;
typedef unsigned v4u __attribute__((ext_vector_type(4)));
typedef unsigned v2u __attribute__((ext_vector_type(2)));
typedef float f32x4 __attribute__((ext_vector_type(4)));
typedef float f32x2 __attribute__((ext_vector_type(2)));
typedef float f32x16 __attribute__((ext_vector_type(16)));
typedef short bf16x8 __attribute__((ext_vector_type(8)));
typedef short s16x4 __attribute__((ext_vector_type(4)));
typedef __bf16 bf16x2v __attribute__((ext_vector_type(2)));
typedef __bf16 bf16x8v __attribute__((ext_vector_type(8)));
typedef GAS unsigned gu32;
#define RLX_AGENT __ATOMIC_RELAXED, __HIP_MEMORY_SCOPE_AGENT
#define LDS_WAIT() asm volatile("s_waitcnt lgkmcnt(0)" ::: "memory")
#define VM_WAIT() asm volatile("s_waitcnt vmcnt(0)" ::: "memory")
__device__ __forceinline__ unsigned f2bf(float f) { unsigned u = __builtin_bit_cast(unsigned, f); return (u + 0x7fffu + ((u >> 16) & 1u)) >> 16; }
__device__ __forceinline__ unsigned pk2(float lo, float hi) { return pg8::cvt_pk_bf16(lo, hi); }
__device__ __forceinline__ float bflo(unsigned w) { return __builtin_bit_cast(float, w << 16); }
__device__ __forceinline__ float bfhi(unsigned w) { return __builtin_bit_cast(float, w & 0xffff0000u); }
__device__ __forceinline__ float bf1(bf16 h) { return __builtin_bit_cast(float, (unsigned)h << 16); }
__device__ __forceinline__ float sigmoidf_(float x) { return __builtin_amdgcn_rcpf(1.0f + __expf(-x)); }
template <int CTRL> __device__ __forceinline__ float dpp_add(float x) {
    return x + __builtin_bit_cast(float, __builtin_amdgcn_update_dpp(0, __builtin_bit_cast(int, x), CTRL, 0xf, 0xf, true));
}
__device__ __forceinline__ float red16(float x) {
    x = dpp_add<0xB1>(x);
    x = dpp_add<0x4E>(x);
    x = dpp_add<0x141>(x);
    x = dpp_add<0x140>(x);
    return x;
}
template <int CTRL, int RM> __device__ __forceinline__ float dpp_max(float x) {
    return fmaxf(x, __builtin_bit_cast(float, __builtin_amdgcn_update_dpp(__builtin_bit_cast(int, x), __builtin_bit_cast(int, x), CTRL, RM, 0xf, false)));
}
template <int CTRL, int RM> __device__ __forceinline__ float dpp_sum(float x) {
    return x + __builtin_bit_cast(float, __builtin_amdgcn_update_dpp(0, __builtin_bit_cast(int, x), CTRL, RM, 0xf, false));
}
__device__ __forceinline__ float wave_max_u(float x) {
    x = dpp_max<0xB1, 0xf>(x); x = dpp_max<0x4E, 0xf>(x); x = dpp_max<0x141, 0xf>(x); x = dpp_max<0x140, 0xf>(x);
    x = dpp_max<0x142, 0xa>(x); x = dpp_max<0x143, 0xc>(x);
    return __builtin_bit_cast(float, __builtin_amdgcn_readlane(__builtin_bit_cast(int, x), 63));
}
__device__ __forceinline__ float wave_sum_u(float x) {
    x = dpp_sum<0xB1, 0xf>(x); x = dpp_sum<0x4E, 0xf>(x); x = dpp_sum<0x141, 0xf>(x); x = dpp_sum<0x140, 0xf>(x);
    x = dpp_sum<0x142, 0xa>(x); x = dpp_sum<0x143, 0xc>(x);
    return __builtin_bit_cast(float, __builtin_amdgcn_readlane(__builtin_bit_cast(int, x), 63));
}
__device__ __forceinline__ float wave_sum(float v) { return wave_sum_u(v); }
__device__ __forceinline__ float bpermf(int srclane, float v) { return __builtin_bit_cast(float, __builtin_amdgcn_ds_bpermute(srclane << 2, __builtin_bit_cast(int, v))); }
__device__ __forceinline__ int bpermi(int srclane, int v) { return __builtin_amdgcn_ds_bpermute(srclane << 2, v); }

#define XB_TMO      128
#define XB_XCNT(j)  (256  + 64 * (j))
#define XB_XSUB(j)  (1280 + 64 * (j))
#define XB_XGEN(j)  (2304 + 64 * (j))
#define XB_TOP      3328
#define XB_TOPGEN   3392
#define XCD_BAR_WORDS 3456
#define XB_SPIN_CAP (1u << 20)

__device__ __forceinline__ unsigned xb_ld(unsigned* p)              { return __hip_atomic_load(p, __ATOMIC_RELAXED, __HIP_MEMORY_SCOPE_AGENT); }
__device__ __forceinline__ unsigned xb_add(unsigned* p, unsigned v) { return __hip_atomic_fetch_add(p, v, __ATOMIC_RELAXED, __HIP_MEMORY_SCOPE_AGENT); }
__device__ __forceinline__ unsigned xb_xcc_id() { return (unsigned)__builtin_amdgcn_s_getreg((3 << 11) | 20) & 0xFu; }
#define XB_SPIN(cond, bar) do { unsigned _sp = 0; while (cond) { __builtin_amdgcn_s_sleep(1); \
    if ((++_sp & 255u) == 0u) { if (xb_ld(&(bar)[XB_TMO])) break; if (_sp > XB_SPIN_CAP) { atomicAdd(&(bar)[XB_TMO], 1u); break; } } } } while (0)

struct XcdBarrier { unsigned* bar; unsigned x; volatile LAS unsigned* st; };

__device__ __forceinline__ XcdBarrier xcd_barrier_post(unsigned* bar, volatile LAS unsigned* st, bool t0) {
    XcdBarrier b; b.bar = bar; b.x = xb_xcc_id(); b.st = st;
    if (t0) (void)xb_add(&bar[XB_XCNT(b.x)], 1u);
    return b;
}
__device__ __forceinline__ void xcd_barrier_complete(unsigned* bar, unsigned x, unsigned& nloc, unsigned& nx) {
    const unsigned G = gridDim.x * gridDim.y * gridDim.z;
    unsigned sum, cnt, mine, sp = 0u;
    for (;;) {
        sum = 0u; cnt = 0u; mine = 0u;
#pragma unroll
        for (unsigned j = 0; j < 16; ++j) { const unsigned c = xb_ld(&bar[XB_XCNT(j)]); sum += c; cnt += (c > 0u) ? 1u : 0u; mine = (j == x) ? c : mine; }
        if (sum == G) break;
        __builtin_amdgcn_s_sleep(1);
        if ((++sp & 255u) == 0u) { if (xb_ld(&bar[XB_TMO])) break; if (sp > XB_SPIN_CAP) { atomicAdd(&bar[XB_TMO], 1u); break; } }
    }
    nloc = mine > 0u ? mine : 1u; nx = cnt > 0u ? cnt : 1u;
}
__device__ __forceinline__ void xcd_barrier(const XcdBarrier& b, bool t0) {
    asm volatile("s_waitcnt vmcnt(0)" ::: "memory");
    __syncthreads();
    if (t0) {
        unsigned* bar = b.bar;
        __builtin_amdgcn_s_waitcnt(0);
        unsigned nloc = b.st[0], nx = b.st[1];
        if (nloc == 0u) { xcd_barrier_complete(bar, b.x, nloc, nx); b.st[0] = nloc; b.st[1] = nx; }
        const unsigned old = xb_add(&bar[XB_XSUB(b.x)], 1u);
        const unsigned gen = old / nloc;
        if (old + 1u == (gen + 1u) * nloc) {
            __builtin_amdgcn_fence(__ATOMIC_RELEASE, "agent");
            asm volatile("s_waitcnt vmcnt(0)" ::: "memory");
            const unsigned og = xb_add(&bar[XB_TOP], 1u);
            const unsigned tg = og / nx;
            if (og + 1u == (tg + 1u) * nx) xb_add(&bar[XB_TOPGEN], 1u);
            else XB_SPIN(xb_ld(&bar[XB_TOPGEN]) == tg, bar);
            __builtin_amdgcn_fence(__ATOMIC_ACQUIRE, "agent");
            xb_add(&bar[XB_XGEN(b.x)], 1u);
            asm volatile("s_waitcnt vmcnt(0)" ::: "memory");
        } else {
            XB_SPIN(xb_ld(&bar[XB_XGEN(b.x)]) == gen, bar);
            __builtin_amdgcn_fence(__ATOMIC_ACQUIRE, "agent");
            asm volatile("s_waitcnt vmcnt(0)" ::: "memory");
        }
    }
    __syncthreads();
}

struct Frame {
    LAS unsigned char* lds;
    unsigned char* ws;
    const float* const* in;
    int tid, lane, wave;
    int vcu, G;
};
struct Args { const float* in[33]; float* out; unsigned char* ws; int ph_lo, ph_hi; };


namespace pg8 {
typedef unsigned u32x4 __attribute__((ext_vector_type(4)));
struct RowOrder : StaticOrder {
    int lat;
    __host__ __device__ void init_rows(int lat_, int N, int G_, int c_) { lat = lat_; init(lat_ ? NBATCH * SEQ : MALL, N, G_, c_); }
    __host__ __device__ bool next(int i, Unit& u) const { if (!StaticOrder::next(i, u)) return false; if (lat) u.pm = 33 * (u.pm >> 5) + 1 + (u.pm & 31); return true; }
};
#define EPI_LOOP_ROWS for (int ai = 0; ai < 2; ++ai) _Pragma("unroll") for (int m = 0; m < 4; ++m)
#define EPI_PIN asm volatile("" ::: "memory")

struct EpiStoreBf16 {
    static constexpr bool PERM = true, AFTER_DRAIN = false;
    bf16_t* O; int ldc;
    __device__ __forceinline__ void operator()(const f32x4 (&acc)[2][2][4][2], const Unit& u, int wr, int wc, int fr, int fq) const {
        const int row0 = u.pm * BM + wr * 64 + fr, col0 = u.pn * BM + wc * 32 + 8 * fq;
#pragma unroll
        EPI_LOOP_ROWS { bf16_t* rowp = O + (size_t)(row0 + ai * HALF + m * 16) * ldc + col0;
#pragma unroll
            for (int bj = 0; bj < 2; ++bj) { const f32x4 v0 = acc[ai][bj][m][0], v1 = acc[ai][bj][m][1];
                u32x4 w; w.x = cvt_pk_bf16(v0[0], v0[1]); w.y = cvt_pk_bf16(v0[2], v0[3]); w.z = cvt_pk_bf16(v1[0], v1[1]); w.w = cvt_pk_bf16(v1[2], v1[3]);
                *(u32x4*)(rowp + bj * HALF) = w; } }
    }
};
struct EpiGate {
    static constexpr bool PERM = true, AFTER_DRAIN = false;
    bf16_t* O; int ldc; const float* bias;
    __device__ __forceinline__ void operator()(const f32x4 (&acc)[2][2][4][2], const Unit& u, int wr, int wc, int fr, int fq) const {
        const int row0 = u.pm * BM + wr * 64 + fr, col0 = u.pn * BM + wc * 32 + 8 * fq;
        f32x4 bv[2][2];
#pragma unroll
        for (int bj = 0; bj < 2; ++bj)
#pragma unroll
            for (int n = 0; n < 2; ++n) bv[bj][n] = *(const f32x4*)(bias + col0 + bj * HALF + 4 * n);
#pragma unroll
        EPI_LOOP_ROWS { EPI_PIN; bf16_t* rowp = O + (size_t)(row0 + ai * HALF + m * 16) * ldc + col0;
#pragma unroll
            for (int bj = 0; bj < 2; ++bj) { f32x4 v0 = acc[ai][bj][m][0] + bv[bj][0], v1 = acc[ai][bj][m][1] + bv[bj][1];
#pragma unroll
                for (int e = 0; e < 4; ++e) { v0[e] = __builtin_amdgcn_rcpf(1.0f + __expf(-v0[e])); v1[e] = __builtin_amdgcn_rcpf(1.0f + __expf(-v1[e])); }
                u32x4 w; w.x = cvt_pk_bf16(v0[0], v0[1]); w.y = cvt_pk_bf16(v0[2], v0[3]); w.z = cvt_pk_bf16(v1[0], v1[1]); w.w = cvt_pk_bf16(v1[2], v1[3]);
                *(u32x4*)(rowp + bj * HALF) = w; } }
    }
};
__device__ __forceinline__ float bf_lo(unsigned w) { return __builtin_bit_cast(float, w << 16); }
__device__ __forceinline__ float bf_hi(unsigned w) { return __builtin_bit_cast(float, w & 0xffff0000u); }
struct EpiMulAdd {
    static constexpr bool PERM = true, AFTER_DRAIN = false;
    bf16_t* O; const bf16_t* Gt; const bf16_t* Ad; int ldc;
    __device__ __forceinline__ void operator()(const f32x4 (&acc)[2][2][4][2], const Unit& u, int wr, int wc, int fr, int fq) const {
        const int row0 = u.pm * BM + wr * 64 + fr, col0 = u.pn * BM + wc * 32 + 8 * fq;
#pragma unroll
        EPI_LOOP_ROWS { EPI_PIN; const size_t ro = (size_t)(row0 + ai * HALF + m * 16) * ldc + col0;
#pragma unroll
            for (int bj = 0; bj < 2; ++bj) { const f32x4 v0 = acc[ai][bj][m][0], v1 = acc[ai][bj][m][1];
                const u32x4 g = *(const u32x4*)(Gt + ro + bj * HALF);
                float o[8];
                o[0] = bf_lo(g.x) * v0[0]; o[1] = bf_hi(g.x) * v0[1]; o[2] = bf_lo(g.y) * v0[2]; o[3] = bf_hi(g.y) * v0[3];
                o[4] = bf_lo(g.z) * v1[0]; o[5] = bf_hi(g.z) * v1[1]; o[6] = bf_lo(g.w) * v1[2]; o[7] = bf_hi(g.w) * v1[3];
                if (Ad) { const u32x4 a = *(const u32x4*)(Ad + ro + bj * HALF);
                    o[0] += bf_lo(a.x); o[1] += bf_hi(a.x); o[2] += bf_lo(a.y); o[3] += bf_hi(a.y); o[4] += bf_lo(a.z); o[5] += bf_hi(a.z); o[6] += bf_lo(a.w); o[7] += bf_hi(a.w); }
                u32x4 w; w.x = cvt_pk_bf16(o[0], o[1]); w.y = cvt_pk_bf16(o[2], o[3]); w.z = cvt_pk_bf16(o[4], o[5]); w.w = cvt_pk_bf16(o[6], o[7]);
                *(u32x4*)(O + ro + bj * HALF) = w; } }
    }
};
struct EpiResid {
    static constexpr bool PERM = true, AFTER_DRAIN = false;
    bf16_t* X; const float* gate;
    const float* xin; const float* cin;
    __device__ __forceinline__ void operator()(const f32x4 (&acc)[2][2][4][2], const Unit& u, int wr, int wc, int fr, int fq) const {
        const int col0 = u.pn * BM + wc * 32 + 8 * fq;
        const int bb = u.pm / 33, pt = u.pm - bb * 33, mr = (pt == 0) ? 2 : bb;
        const float* gp = gate + (size_t)mr * 12288 + col0;
        const float* sbase = xin ? (pt == 0 ? cin + (size_t)bb * CTXL * DM : xin + ((size_t)bb * SEQ + (size_t)(pt - 1) * BM) * DM) : nullptr;
        f32x4 gv[2][2];
#pragma unroll
        for (int bj = 0; bj < 2; ++bj)
#pragma unroll
            for (int n = 0; n < 2; ++n) gv[bj][n] = *(const f32x4*)(gp + bj * HALF + n * 4);
#pragma unroll
        EPI_LOOP_ROWS { EPI_PIN; const int rl = wr * 64 + fr + ai * HALF + m * 16; bf16_t* rowp = X + (size_t)(u.pm * BM + rl) * DM + col0;
#pragma unroll
            for (int bj = 0; bj < 2; ++bj) { f32x4 s0, s1;
                if (sbase) { const float* srow = sbase + (size_t)rl * DM + col0 + bj * HALF; s0 = *(const f32x4*)srow; s1 = *(const f32x4*)(srow + 4); }
                else { const u32x4 w = *(const u32x4*)(rowp + bj * HALF);
                    s0 = (f32x4){__builtin_bit_cast(float, w.x << 16), __builtin_bit_cast(float, w.x & 0xffff0000u), __builtin_bit_cast(float, w.y << 16), __builtin_bit_cast(float, w.y & 0xffff0000u)};
                    s1 = (f32x4){__builtin_bit_cast(float, w.z << 16), __builtin_bit_cast(float, w.z & 0xffff0000u), __builtin_bit_cast(float, w.w << 16), __builtin_bit_cast(float, w.w & 0xffff0000u)}; }
                const f32x4 r0 = s0 + gv[bj][0] * acc[ai][bj][m][0], r1 = s1 + gv[bj][1] * acc[ai][bj][m][1];
                u32x4 o; o.x = cvt_pk_bf16(r0[0], r0[1]); o.y = cvt_pk_bf16(r0[2], r0[3]); o.z = cvt_pk_bf16(r1[0], r1[1]); o.w = cvt_pk_bf16(r1[2], r1[3]);
                *(u32x4*)(rowp + bj * HALF) = o; } }
    }
};
struct EpiF32 {
    static constexpr bool PERM = false, AFTER_DRAIN = false;
    float* C; int ldc;
    __device__ __forceinline__ void operator()(const f32x4 (&acc)[2][2][4][2], const Unit& u, int wr, int wc, int fr, int fq) const {
        const int row0 = u.pm * BM + wr * 64 + fr, col0 = u.pn * BM + wc * 32 + 4 * fq;
#pragma unroll
        EPI_LOOP_ROWS { float* rowp = C + (size_t)(row0 + ai * HALF + m * 16) * ldc + col0;
#pragma unroll
            for (int bj = 0; bj < 2; ++bj)
#pragma unroll
                for (int n = 0; n < 2; ++n) *(f32x4*)(rowp + bj * HALF + n * 16) = acc[ai][bj][m][n]; }
    }
};
struct EpiF16 {
    static constexpr bool PERM = true, AFTER_DRAIN = false;
    _Float16* C; int ldc;
    __device__ __forceinline__ void operator()(const f32x4 (&acc)[2][2][4][2], const Unit& u, int wr, int wc, int fr, int fq) const {
        typedef _Float16 h2 __attribute__((ext_vector_type(2)));
        const int row0 = u.pm * BM + wr * 64 + fr, col0 = u.pn * BM + wc * 32 + 8 * fq;
#pragma unroll
        EPI_LOOP_ROWS { _Float16* rowp = C + (size_t)(row0 + ai * HALF + m * 16) * ldc + col0;
#pragma unroll
            for (int bj = 0; bj < 2; ++bj) { const f32x4 v0 = acc[ai][bj][m][0], v1 = acc[ai][bj][m][1];
                u32x4 w; w.x = __builtin_bit_cast(unsigned, (h2){(_Float16)v0[0], (_Float16)v0[1]}); w.y = __builtin_bit_cast(unsigned, (h2){(_Float16)v0[2], (_Float16)v0[3]});
                w.z = __builtin_bit_cast(unsigned, (h2){(_Float16)v1[0], (_Float16)v1[1]}); w.w = __builtin_bit_cast(unsigned, (h2){(_Float16)v1[2], (_Float16)v1[3]});
                *(u32x4*)(rowp + bj * HALF) = w; } }
    }
};
struct EpiQ {
    static constexpr bool PERM = true, AFTER_DRAIN = false;
    bf16_t* Q; const f32x2* rope; float qscale;
    __device__ __forceinline__ void operator()(const f32x4 (&acc)[2][2][4][2], const Unit& u, int wr, int wc, int fr, int fq) const {
        const int bb = u.pm / 33, tp0 = (u.pm - bb * 33) * BM + wr * 64 + fr, col0 = u.pn * BM + wc * 32 + 8 * fq;
#pragma unroll
        for (int bj = 0; bj < 2; ++bj) { const int c = col0 + bj * HALF, hd = c / QKD, d = c - hd * QKD;
#pragma unroll
            EPI_LOOP_ROWS { EPI_PIN; const int tp = tp0 + ai * HALF + m * 16;
                f32x4 v0 = acc[ai][bj][m][0], v1 = acc[ai][bj][m][1];
                if (d >= 64) { const int i0 = (d - 64) >> 1; const f32x2* rp = rope + (size_t)tp * 16 + i0;
                    const f32x2 c0 = rp[0], c1 = rp[1], c2 = rp[2], c3 = rp[3];
                    float a, b;
                    a = v0[0]; b = v0[1]; v0[0] = a * c0.x - b * c0.y; v0[1] = a * c0.y + b * c0.x;
                    a = v0[2]; b = v0[3]; v0[2] = a * c1.x - b * c1.y; v0[3] = a * c1.y + b * c1.x;
                    a = v1[0]; b = v1[1]; v1[0] = a * c2.x - b * c2.y; v1[1] = a * c2.y + b * c2.x;
                    a = v1[2]; b = v1[3]; v1[2] = a * c3.x - b * c3.y; v1[3] = a * c3.y + b * c3.x; }
                v0 = v0 * qscale; v1 = v1 * qscale;
                u32x4 w; w.x = cvt_pk_bf16(v0[0], v0[1]); w.y = cvt_pk_bf16(v0[2], v0[3]); w.z = cvt_pk_bf16(v1[0], v1[1]); w.w = cvt_pk_bf16(v1[2], v1[3]);
                *(u32x4*)(Q + ((size_t)(bb * NH + hd) * TPB + tp) * QKD + d) = w; } }
    }
};
struct EpiKV {
    static constexpr bool PERM = true, AFTER_DRAIN = false;
    bf16_t* K; bf16_t* V;
    __device__ __forceinline__ void operator()(const f32x4 (&acc)[2][2][4][2], const Unit& u, int wr, int wc, int fr, int fq) const {
        const int bb = u.pm / 33, tp0 = (u.pm - bb * 33) * BM + wr * 64 + fr;
        const bool isK = wc < 2;
        bf16_t* base = isK ? K : V; const int pitch = isK ? QKD : 64, doff = 32 * (wc & 1) + 8 * fq;
#pragma unroll
        for (int bj = 0; bj < 2; ++bj) { const int hd = 2 * u.pn + bj;
            bf16_t* hb = base + (size_t)(bb * NH + hd) * TPB * pitch;
#pragma unroll
            EPI_LOOP_ROWS { EPI_PIN; const int tp = tp0 + ai * HALF + m * 16;
                const f32x4 v0 = acc[ai][bj][m][0], v1 = acc[ai][bj][m][1];
                u32x4 w; w.x = cvt_pk_bf16(v0[0], v0[1]); w.y = cvt_pk_bf16(v0[2], v0[3]); w.z = cvt_pk_bf16(v1[0], v1[1]); w.w = cvt_pk_bf16(v1[2], v1[3]);
                *(u32x4*)((char*)hb + (unsigned)((tp * pitch + doff) * 2)) = w; } }
    }
};
}

struct TItem { const float* W; bf16* WT; int K, ldw, c0, N, mapq, item; };
__device__ __forceinline__ void p0_item_load(const TItem& T, int lane, f32x4 (&x)[8]) {
    const int nblk = T.N / 32, kb = T.item / nblk, nb = T.item - kb * nblk, k0 = 64 * kb, n0 = 32 * nb;
    const float* p = T.W + (size_t)(k0 + (lane >> 3)) * T.ldw + T.c0 + n0 + (lane & 7) * 4;
#pragma unroll
    for (int i = 0; i < 8; ++i) x[i] = *(const GAS f32x4*)(p + (size_t)(8 * i) * T.ldw);
}
__device__ __forceinline__ void p0_item_finish(const TItem& T, const f32x4 (&x)[8], LAS float* scr, int lane) {
    const int nblk = T.N / 32, kb = T.item / nblk, nb = T.item - kb * nblk, k0 = 64 * kb, n0 = 32 * nb;
#pragma unroll
    for (int i = 0; i < 8; ++i) { LAS float* d = scr + (8 * i + (lane >> 3)) * 33 + (lane & 7) * 4; d[0] = x[i].x; d[1] = x[i].y; d[2] = x[i].z; d[3] = x[i].w; }
    LDS_WAIT(); asm volatile("" ::: "memory");
    const int c = lane & 7;
#pragma unroll
    for (int j = 0; j < 4; ++j) { const int n = (lane >> 3) + 8 * j; const LAS float* s = scr + (8 * c) * 33 + n;
        v4u o; o.x = pk2(s[0 * 33], s[1 * 33]); o.y = pk2(s[2 * 33], s[3 * 33]); o.z = pk2(s[4 * 33], s[5 * 33]); o.w = pk2(s[6 * 33], s[7 * 33]);
        int nn = n0 + n;
        if (T.mapq) { const int hd = nn / QKD, d = nn - hd * QKD; if (d >= 64) { const int i = (d - 64) & 15, s2 = (d - 64) >> 4; nn = hd * QKD + 64 + 2 * i + s2; } }
        *(GAS v4u*)(T.WT + (size_t)nn * T.K + k0 + 8 * c) = o; }
    LDS_WAIT(); asm volatile("" ::: "memory");
}

__device__ __forceinline__ const float* karg(int i);
constexpr int TB_INA = (DM / 128) * ((INA + 127) / 128), TB_G = (DM / 128) * (DM / 128), TB_BR = (RW / 128) * (DM / 128), TB_UQ = (512 / 128) * (NQ / 128), TB_UKV = (256 / 128) * (NKV / 128);
constexpr int TB_N = TB_INA + 2 * TB_G + 2 * TB_BR + TB_G + TB_UQ + TB_UKV;
constexpr int TI_LR = 1 * (RW / 32), TI_N = 4 * TI_LR;
__device__ __forceinline__ TItem p0_resolve_big(unsigned char* ws, int git) {
    const int l = git / TB_N; int r = git - l * TB_N; TItem T; T.mapq = 0; T.c0 = 0;
    if (r < TB_INA) { T.W = karg(7) + (size_t)l * DM * INC; T.K = DM; T.ldw = INC; T.N = INA; T.WT = (bf16*)(ws + WS_WINA) + (size_t)l * INA_P * DM; T.item = r; return T; } r -= TB_INA;
    if (r < TB_G) { T.W = karg(7) + (size_t)l * DM * INC; T.K = DM; T.ldw = INC; T.c0 = INA; T.N = DM; T.WT = (bf16*)(ws + WS_WGA) + (size_t)l * DM * DM; T.item = r; return T; } r -= TB_G;
    if (r < TB_G) { T.W = karg(7) + (size_t)l * DM * INC; T.K = DM; T.ldw = INC; T.c0 = INA + DM; T.N = DM; T.WT = (bf16*)(ws + WS_WGB) + (size_t)l * DM * DM; T.item = r; return T; } r -= TB_G;
    if (r < TB_BR) { T.W = karg(24) + (size_t)l * RW * DM; T.K = RW; T.ldw = DM; T.N = DM; T.WT = (bf16*)(ws + WS_WA) + (size_t)l * DM * RW; T.item = r; return T; } r -= TB_BR;
    if (r < TB_BR) { T.W = karg(25) + (size_t)l * RW * DM; T.K = RW; T.ldw = DM; T.N = DM; T.WT = (bf16*)(ws + WS_WB) + (size_t)l * DM * RW; T.item = r; return T; } r -= TB_BR;
    if (r < TB_G) { T.W = karg(26) + (size_t)l * DM * DM; T.K = DM; T.ldw = DM; T.N = DM; T.WT = (bf16*)(ws + WS_WO) + (size_t)l * DM * DM; T.item = r; return T; } r -= TB_G;
    if (r < TB_UQ) { T.W = karg(21) + (size_t)l * 512 * NQ; T.K = 512; T.ldw = NQ; T.N = NQ; T.WT = (bf16*)(ws + WS_WUQ) + (size_t)l * NQ * 512; T.item = r; T.mapq = 1; return T; } r -= TB_UQ;
    { T.W = karg(23) + (size_t)l * 256 * NKV; T.K = 256; T.ldw = NKV; T.N = NKV; T.WT = (bf16*)(ws + WS_WUKV) + (size_t)l * NKV * 256; T.item = r; return T; }
}
__device__ __forceinline__ void p0_big_load(const TItem& T, int tid, f32x4 (&x)[8]) {
    const int nblk = (T.N + 127) / 128, kb = T.item / nblk, nb = T.item - kb * nblk, k0 = 128 * kb, col = 128 * nb + (tid & 31) * 4;
    const float* p = T.W + (size_t)(k0 + (tid >> 5)) * T.ldw + T.c0 + col; const bool ok = col < T.N;
#pragma unroll
    for (int i = 0; i < 8; ++i) x[i] = ok ? *(const GAS f32x4*)(p + (size_t)(16 * i) * T.ldw) : (f32x4){0.f, 0.f, 0.f, 0.f};
}
__device__ __forceinline__ void p0_big_finish(const TItem& T, const f32x4 (&x)[8], LAS float* tile, int tid) {
    const int nblk = (T.N + 127) / 128, kb = T.item / nblk, nb = T.item - kb * nblk, k0 = 128 * kb, n0 = 128 * nb;
    __syncthreads();
#pragma unroll
    for (int i = 0; i < 8; ++i) *(LAS f32x4*)(tile + ((tid >> 5) + 16 * i) * 132 + (tid & 31) * 4) = x[i];
    __syncthreads();
    const int n = tid & 127, cg = tid >> 7; int nn = n0 + n;
    if (nn < T.N) {
        if (T.mapq) { const int hd = nn / QKD, d = nn - hd * QKD; if (d >= 64) { const int i = (d - 64) & 15, s2 = (d - 64) >> 4; nn = hd * QKD + 64 + 2 * i + s2; } }
#pragma unroll
        for (int c = 0; c < 4; ++c) { const LAS float* s = tile + (32 * cg + 8 * c) * 132 + n;
            v4u o; o.x = pk2(s[0 * 132], s[1 * 132]); o.y = pk2(s[2 * 132], s[3 * 132]); o.z = pk2(s[4 * 132], s[5 * 132]); o.w = pk2(s[6 * 132], s[7 * 132]);
            *(GAS v4u*)(T.WT + (size_t)nn * T.K + k0 + 32 * cg + 8 * c) = o; } }
}
__device__ __forceinline__ TItem p0_resolve(unsigned char* ws, int git) {
    const int l = git / TI_N; int r = git - l * TI_N; TItem T; T.mapq = 0; T.c0 = 0;
    const int which = r / TI_LR, d = which & 1, isa = which >> 1; r -= which * TI_LR;
    T.W = (isa ? karg(13) : karg(11)) + (size_t)(l * 2 + d) * 64 * RW; T.K = 64; T.ldw = RW; T.N = RW; T.WT = (bf16*)(ws + (isa ? WS_AUP : WS_WUP)) + (size_t)(l * 2 + d) * RW * 64; T.item = r; return T;
}
constexpr int NWI_INA = (DM / 64) * (INA / 32), NWI_G = (DM / 64) * (DM / 32), NWI_BR = (RW / 64) * (DM / 32), NWI_UQ = (512 / 64) * (NQ / 32), NWI_UKV = (256 / 64) * (NKV / 32);
constexpr int NW_ITEMS = NWI_INA + 2 * NWI_G + 2 * NWI_BR + NWI_G + NWI_UQ + NWI_UKV + TI_N;
__device__ __forceinline__ TItem p0_resolve_wave(unsigned char* ws, int l, int r) {
    TItem T; T.mapq = 0; T.c0 = 0;
    if (r < NWI_INA) { T.W = karg(7) + (size_t)l * DM * INC; T.K = DM; T.ldw = INC; T.N = INA; T.WT = (bf16*)(ws + WS_WINA) + (size_t)l * INA_P * DM; T.item = r; return T; } r -= NWI_INA;
    if (r < NWI_G) { T.W = karg(7) + (size_t)l * DM * INC; T.K = DM; T.ldw = INC; T.c0 = INA; T.N = DM; T.WT = (bf16*)(ws + WS_WGA) + (size_t)l * DM * DM; T.item = r; return T; } r -= NWI_G;
    if (r < NWI_G) { T.W = karg(7) + (size_t)l * DM * INC; T.K = DM; T.ldw = INC; T.c0 = INA + DM; T.N = DM; T.WT = (bf16*)(ws + WS_WGB) + (size_t)l * DM * DM; T.item = r; return T; } r -= NWI_G;
    if (r < NWI_BR) { T.W = karg(24) + (size_t)l * RW * DM; T.K = RW; T.ldw = DM; T.N = DM; T.WT = (bf16*)(ws + WS_WA) + (size_t)l * DM * RW; T.item = r; return T; } r -= NWI_BR;
    if (r < NWI_BR) { T.W = karg(25) + (size_t)l * RW * DM; T.K = RW; T.ldw = DM; T.N = DM; T.WT = (bf16*)(ws + WS_WB) + (size_t)l * DM * RW; T.item = r; return T; } r -= NWI_BR;
    if (r < NWI_G) { T.W = karg(26) + (size_t)l * DM * DM; T.K = DM; T.ldw = DM; T.N = DM; T.WT = (bf16*)(ws + WS_WO) + (size_t)l * DM * DM; T.item = r; return T; } r -= NWI_G;
    if (r < NWI_UQ) { T.W = karg(21) + (size_t)l * 512 * NQ; T.K = 512; T.ldw = NQ; T.N = NQ; T.WT = (bf16*)(ws + WS_WUQ) + (size_t)l * NQ * 512; T.item = r; T.mapq = 1; return T; } r -= NWI_UQ;
    if (r < NWI_UKV) { T.W = karg(23) + (size_t)l * 256 * NKV; T.K = 256; T.ldw = NKV; T.N = NKV; T.WT = (bf16*)(ws + WS_WUKV) + (size_t)l * NKV * 256; T.item = r; return T; } r -= NWI_UKV;
    return p0_resolve(ws, l * TI_N + r);
}
__device__ __forceinline__ void p0_prologue(Frame& F, int l_lo, int l_hi, int svcu, int sG, int with_tr = 1) {
    LAS float* scr = (LAS float*)(F.lds + F.wave * 16384);
    const int gw = svcu * NWAVES + F.wave, NGW = sG * NWAVES;
    unsigned char* ws = F.ws;
    for (int rp_ = 0; rp_ < (DBG_REPEAT == 102 ? 2 : 1); ++rp_)
    { float* modw = (float*)(ws + WS_CTL + CTL_MOD_OFF); const float* adaw = karg(4); const float* adab = karg(5); const float* cin = karg(1); const float* cctx = karg(3);
      LAS float* SIL = (LAS float*)F.lds;
      LAS f32x2* part = (LAS f32x2*)(F.lds + 32768);
      if (svcu >= 0 && l_lo * 96 + svcu < l_hi * 96) {
          for (int i = F.tid; i < 3 * DM; i += 512) { const int r = i >> 11, k = i & 2047; const float c = r < 2 ? cin[r * DM + k] : cctx[k]; SIL[i] = c / (1.f + __expf(-c)); }
          __syncthreads(); }
      if (svcu >= 0) for (int uu = l_lo * 96 + svcu; uu < l_hi * 96; uu += sG) { const int cb = uu % 96, l = uu / 96;
          const int n0 = cb * 128 + F.lane * 2; const float* aw = adaw + (size_t)l * DM * 12288 + n0;
          f32x2 a0 = {0, 0}, a1 = a0, a2 = a0;
#pragma unroll 1
          for (int k0 = F.wave * 256; k0 < F.wave * 256 + 256; k0 += 16) { f32x2 w[16];
#pragma unroll
              for (int j = 0; j < 16; ++j) w[j] = *(const GAS f32x2*)(aw + (size_t)(k0 + j) * 12288);
#pragma unroll
              for (int j = 0; j < 16; ++j) { a0 = a0 + w[j] * SIL[k0 + j]; a1 = a1 + w[j] * SIL[DM + k0 + j]; a2 = a2 + w[j] * SIL[2 * DM + k0 + j]; } }
          __syncthreads();
          part[(F.wave * 3 + 0) * 64 + F.lane] = a0; part[(F.wave * 3 + 1) * 64 + F.lane] = a1; part[(F.wave * 3 + 2) * 64 + F.lane] = a2;
          __syncthreads();
          if (F.wave < 3) { f32x2 s = *(const GAS f32x2*)(adab + (size_t)l * 12288 + n0);
#pragma unroll
              for (int w8 = 0; w8 < 8; ++w8) s = s + part[(w8 * 3 + F.wave) * 64 + F.lane];
              *(GAS f32x2*)(modw + ((size_t)l * 3 + F.wave) * 12288 + n0) = s; }
          __syncthreads(); } }
    if (with_tr) for (int rp_ = 0; rp_ < (DBG_REPEAT == 101 ? 2 : 1); ++rp_)
    { unsigned* ctr = (unsigned*)(ws + WS_CTL) + 2048 + 64 * rp_ + 128 * l_lo; LAS float* tile = (LAS float*)F.lds; LAS int* slot = (LAS int*)(F.lds + 128 * 132 * 4);
#define P0_GRAB(dst) do { __syncthreads(); if (F.tid == 0) *slot = (int)__hip_atomic_fetch_add(ctr, 1u, __ATOMIC_RELAXED, __HIP_MEMORY_SCOPE_AGENT); __syncthreads(); dst = *slot; } while (0)
      const int it_end = l_hi * TB_N;
      int it; P0_GRAB(it); it += l_lo * TB_N; f32x4 xa[8], xb[8]; TItem T, Tn;
      if (it < it_end) { T = p0_resolve_big(ws, it); p0_big_load(T, F.tid, xa); }
      while (it < it_end) { int itn; P0_GRAB(itn); itn += l_lo * TB_N; const bool more = itn < it_end;
          if (more) { Tn = p0_resolve_big(ws, itn); p0_big_load(Tn, F.tid, xb); }
          p0_big_finish(T, xa, tile, F.tid);
          if (more) { T = Tn;
#pragma unroll
              for (int i = 0; i < 8; ++i) xa[i] = xb[i]; }
          it = itn; }
#undef P0_GRAB
      __syncthreads();
      if (svcu >= 0) for (int itw = l_lo * TI_N + gw; itw < l_hi * TI_N; itw += NGW) { f32x4 xw[8]; const TItem Tw = p0_resolve(ws, itw); p0_item_load(Tw, F.lane, xw); p0_item_finish(Tw, xw, scr, F.lane); }
    }
    const int gt = gw * 64 + F.lane, NGT = NGW * 64;
    { const float* gup = karg(14);
    if (svcu >= 0) for (int i = l_lo * 2 * 32 * RW + gt; i < l_hi * 2 * 32 * RW; i += NGT) { const int ch = i & 1023, r = (i >> 10) & 31, ld = i >> 15;
        ((bf16*)(ws + WS_GUP))[((size_t)ld * RW + ch) * 32 + r] = (bf16)f2bf(gup[i]); } }
    if (svcu >= 0) for (int i = l_lo * ((INA_P - INA) * DM / 8) + gt; i < l_hi * ((INA_P - INA) * DM / 8); i += NGT) { const int l = i / ((INA_P - INA) * DM / 8), r = i - l * ((INA_P - INA) * DM / 8);
        ((GAS v4u*)((bf16*)(ws + WS_WINA) + ((size_t)l * INA_P + INA) * DM))[r] = (v4u){0u, 0u, 0u, 0u}; }
    { f32x2* rt = (f32x2*)(ws + WS_ROPE);
      if (l_lo == 0 && svcu >= 0) for (int i = gt; i < TPB * 16; i += NGT) { const int tp = i >> 4, k = i & 15; f32x2 o = {1.f, 0.f};
          if (tp >= CTXL) { const int t = tp - CTXL, row = t >> 6, col = t & 63, j = k & 7; const float fr = powf(10000.0f, -(float)j / 8.0f);
              const float ang = (float)(k < 8 ? row : col) * fr; o.x = cosf(ang); o.y = sinf(ang); }
          rt[i] = o; } }
    for (int rp_ = 0; rp_ < (DBG_REPEAT == 103 ? 2 : 1); ++rp_)
    { LAS float* KEY = (LAS float*)F.lds;
      LAS float* WQT = (LAS float*)(F.lds + 65536);
      const float* pkeys = karg(29); const float* pwq = karg(28);
      __syncthreads();
      if (svcu >= 0) for (int uu = l_lo * 512 + svcu; uu < l_hi * 512; uu += sG) { const int kb = uu & 31, hp = (uu >> 5) & 15, l = uu >> 9;
          const GAS f32x4* ksrc = (const GAS f32x4*)(pkeys + ((size_t)l * 16 + hp) * 16384);
          for (int i = F.tid; i < 4096; i += 512) ((LAS f32x4*)KEY)[i] = ksrc[i];
          for (int i = F.tid; i < 2048; i += 512) { const int kk = i >> 5, d4 = i & 31;
              *(LAS f32x4*)(WQT + kk * 132 + d4 * 4) = *(const GAS f32x4*)(pwq + ((size_t)l * DM + kb * 64 + kk) * DM + hp * 128 + d4 * 4); }
          __syncthreads();
          const int kq = F.tid & 15, keyq = F.tid >> 4;
          float acc[4][4];
#pragma unroll
          for (int j = 0; j < 4; ++j)
#pragma unroll
              for (int i = 0; i < 4; ++i) acc[j][i] = 0.f;
          for (int d = 0; d < 128; d += 4) { f32x4 w[4], q[4];
#pragma unroll
              for (int i = 0; i < 4; ++i) w[i] = *(LAS f32x4*)(WQT + (kq + 16 * i) * 132 + d);
#pragma unroll
              for (int j = 0; j < 4; ++j) q[j] = *(LAS f32x4*)(KEY + (4 * keyq + j) * 128 + d);
#pragma unroll
              for (int j = 0; j < 4; ++j)
#pragma unroll
                  for (int i = 0; i < 4; ++i) acc[j][i] += q[j].x * w[i].x + q[j].y * w[i].y + q[j].z * w[i].z + q[j].w * w[i].w; }
          bf16* dst = (bf16*)(ws + WS_WQK) + ((size_t)l * DM + hp * 128 + 4 * keyq) * DM + kb * 64 + kq;
#pragma unroll
          for (int j = 0; j < 4; ++j)
#pragma unroll
              for (int i = 0; i < 4; ++i) dst[(size_t)j * DM + 16 * i] = (bf16)f2bf(acc[j][i]);
          __syncthreads(); } }
}

__device__ __forceinline__ const float* modnorm_src(int m, const float* X, const float* xin, const float* cin) {
    const int b = m / TPB, tp = m - b * TPB;
    return xin ? (tp < CTXL ? cin + ((size_t)b * CTXL + tp) * DM : xin + ((size_t)b * SEQ + (tp - CTXL)) * DM) : X + (size_t)m * DM;
}
__device__ __forceinline__ void modnorm_phase_bf(Frame& F, const bf16* X, const float* g, const float* mod  , int chunk_sh, bf16* H, int skip_ctx) {
    const int gw = F.vcu * NWAVES + F.wave, NGW = F.G * NWAVES;
    int m = gw; while (m < MALL && skip_ctx && (m % TPB) < CTXL) m += NGW;
    v4u v[4]; f32x4 ga[8], sb[8]; int mr_cur = -1;
    if (m < MALL) { const GAS v4u* xr = (const GAS v4u*)(X + (size_t)m * DM) + F.lane;
#pragma unroll
        for (int j = 0; j < 4; ++j) v[j] = xr[64 * j]; }
    while (m < MALL) {
        int mn = m + NGW; while (mn < MALL && skip_ctx && (mn % TPB) < CTXL) mn += NGW;
        v4u nv[4];
        if (mn < MALL) { const GAS v4u* xr = (const GAS v4u*)(X + (size_t)mn * DM) + F.lane;
#pragma unroll
            for (int j = 0; j < 4; ++j) nv[j] = xr[64 * j]; }
        const int b = m / TPB, tp = m - b * TPB, mr = tp < CTXL ? 2 : b;
        if (mr != mr_cur) { mr_cur = mr; const float* sh = mod + (size_t)mr * 12288 + chunk_sh * DM; const float* sc = sh + DM;
#pragma unroll
            for (int q = 0; q < 8; ++q) { const int c = (F.lane + 64 * (q >> 1)) * 8 + 4 * (q & 1); const f32x4 gg = *(const GAS f32x4*)(g + c), s1 = *(const GAS f32x4*)(sc + c); ga[q] = gg * (s1 + 1.0f); sb[q] = *(const GAS f32x4*)(sh + c); } }
        float x[4][8]; float s = 0.f;
#pragma unroll
        for (int j = 0; j < 4; ++j) { x[j][0] = bflo(v[j].x); x[j][1] = bfhi(v[j].x); x[j][2] = bflo(v[j].y); x[j][3] = bfhi(v[j].y); x[j][4] = bflo(v[j].z); x[j][5] = bfhi(v[j].z); x[j][6] = bflo(v[j].w); x[j][7] = bfhi(v[j].w);
#pragma unroll
            for (int e = 0; e < 8; ++e) s += x[j][e] * x[j][e]; }
        const float rs = rsqrtf(wave_sum(s) * (1.f / DM) + NORM_EPS);
        GAS v4u* o8 = (GAS v4u*)(H + (size_t)m * DM) + F.lane;
#pragma unroll
        for (int j = 0; j < 4; ++j) { float y[8];
#pragma unroll
            for (int e = 0; e < 8; ++e) y[e] = (x[j][e] * rs) * ga[2 * j + (e >> 2)][e & 3] + sb[2 * j + (e >> 2)][e & 3];
            v4u o; o.x = pk2(y[0], y[1]); o.y = pk2(y[2], y[3]); o.z = pk2(y[4], y[5]); o.w = pk2(y[6], y[7]); o8[64 * j] = o; }
#pragma unroll
        for (int j = 0; j < 4; ++j) v[j] = nv[j];
        m = mn;
    }
}
__device__ __forceinline__ void modnorm_phase(Frame& F, const float* X, const float* g, const float* mod  , int chunk_sh, bf16* H, int skip_ctx, const float* xin = nullptr, const float* cin = nullptr) {
    const int gw = F.vcu * NWAVES + F.wave, NGW = F.G * NWAVES;
    int m = gw; while (m < MALL && skip_ctx && (m % TPB) < CTXL) m += NGW;
    f32x4 v[8], ga[8], sb[8]; int mr_cur = -1;
    if (m < MALL) { const GAS f32x4* xr = (const GAS f32x4*)modnorm_src(m, X, xin, cin) + F.lane;
#pragma unroll
        for (int j = 0; j < 8; ++j) v[j] = xr[64 * j]; }
    while (m < MALL) {
        int mn = m + NGW; while (mn < MALL && skip_ctx && (mn % TPB) < CTXL) mn += NGW;
        f32x4 nv[8];
        if (mn < MALL) { const GAS f32x4* xr = (const GAS f32x4*)modnorm_src(mn, X, xin, cin) + F.lane;
#pragma unroll
            for (int j = 0; j < 8; ++j) nv[j] = xr[64 * j]; }
        const int b = m / TPB, tp = m - b * TPB, mr = tp < CTXL ? 2 : b;
        if (mr != mr_cur) { mr_cur = mr; const float* sh = mod + (size_t)mr * 12288 + chunk_sh * DM; const float* sc = sh + DM;
#pragma unroll
            for (int j = 0; j < 8; ++j) { const int c = (F.lane + 64 * j) * 4; const f32x4 gg = *(const GAS f32x4*)(g + c), s1 = *(const GAS f32x4*)(sc + c); ga[j] = gg * (s1 + 1.0f); sb[j] = *(const GAS f32x4*)(sh + c); } }
        float s = 0.f;
#pragma unroll
        for (int j = 0; j < 8; ++j) s += (v[j].x * v[j].x + v[j].y * v[j].y) + (v[j].z * v[j].z + v[j].w * v[j].w);
        const float rs = rsqrtf(wave_sum(s) * (1.f / DM) + NORM_EPS);
        GAS v2u* o8 = (GAS v2u*)(H + (size_t)m * DM) + F.lane;
#pragma unroll
        for (int j = 0; j < 8; ++j) { const f32x4 y = (v[j] * rs) * ga[j] + sb[j];
            v2u o; o.x = pk2(y.x, y.y); o.y = pk2(y.z, y.w); o8[64 * j] = o; }
#pragma unroll
        for (int j = 0; j < 8; ++j) v[j] = nv[j];
        m = mn;
    }
}

typedef float f32x4v __attribute__((ext_vector_type(4)));
#define MFMA16(a, b, c) __builtin_amdgcn_mfma_f32_16x16x32_bf16((a), (b), (c), 0, 0, 0)
#define MFMA32(a, b, c) __builtin_amdgcn_mfma_f32_32x32x16_bf16((a), (b), (c), 0, 0, 0)

struct FeatP {
    const bf16* PA; const float* mu; const float* w0; const float* a0; const float* k_k; const float* k_a; const float* r_k;
    const bf16* WUP; const bf16* AUP; const bf16* GUP;
    const float* qnorm; const float* kvnorm; const f32x2* rope;
    bf16* RI; bf16* GG; float* BON; bf16* QN; bf16* KVN; bf16* K;
};
__device__ __forceinline__ f32x4 ld4bf(const bf16* p) { const v2u w = *(const GAS v2u*)p; return (f32x4){bflo(w.x), bfhi(w.x), bflo(w.y), bfhi(w.y)}; }
__device__ __forceinline__ f32x4 mix4(const bf16* PA, int m, int c, bool hp, bool hn, const float* mu) {
    const f32x4 pc = ld4bf(PA + (size_t)m * INA_P + c);
    f32x4 pp = {0, 0, 0, 0}, pn = {0, 0, 0, 0};
    if (hp) pp = ld4bf(PA + (size_t)(m - 1) * INA_P + c);
    if (hn) pn = ld4bf(PA + (size_t)(m + 1) * INA_P + c);
    const f32x4 mm = *(const GAS f32x4*)(mu + c);
    return pc + ((pp + pn) * 0.5f - pc) * mm;
}
__device__ __forceinline__ void unpack8(const v4u w, float (&x)[8]) { x[0] = bflo(w.x); x[1] = bfhi(w.x); x[2] = bflo(w.y); x[3] = bfhi(w.y); x[4] = bflo(w.z); x[5] = bfhi(w.z); x[6] = bflo(w.w); x[7] = bfhi(w.w); }
__device__ __forceinline__ v4u pack8f(const float (&x)[8]) { v4u o; o.x = pk2(x[0], x[1]); o.y = pk2(x[2], x[3]); o.z = pk2(x[4], x[5]); o.w = pk2(x[6], x[7]); return o; }
__device__ __forceinline__ void mix8(const bf16* rowc, bool hp, bool hn, const float (&mu)[8], float (&o)[8]) {
    const v4u zc = {0u, 0u, 0u, 0u};
    const v4u wc = *(const GAS v4u*)rowc, wp = hp ? *(const GAS v4u*)(rowc - INA_P) : zc, wn = hn ? *(const GAS v4u*)(rowc + INA_P) : zc;
    float c[8], p[8], n[8]; unpack8(wc, c); unpack8(wp, p); unpack8(wn, n);
#pragma unroll
    for (int e = 0; e < 8; ++e) o[e] = c[e] + (0.5f * (p[e] + n[e]) - c[e]) * mu[e];
}
struct Raw3 { v4u c, p, n; };
__device__ __forceinline__ Raw3 load3(const bf16* rowc, bool hp, bool hn) { const v4u zc = {0u, 0u, 0u, 0u}; Raw3 r; r.c = *(const GAS v4u*)rowc; r.p = hp ? *(const GAS v4u*)(rowc - INA_P) : zc; r.n = hn ? *(const GAS v4u*)(rowc + INA_P) : zc; return r; }
__device__ __forceinline__ void mix8r(const Raw3& w, const float (&mu)[8], float (&o)[8]) {
    float c[8], p[8], n[8]; unpack8(w.c, c); unpack8(w.p, p); unpack8(w.n, n);
#pragma unroll
    for (int e = 0; e < 8; ++e) o[e] = c[e] + (0.5f * (p[e] + n[e]) - c[e]) * mu[e];
}
__device__ __forceinline__ void features_phase(Frame& F, const FeatP& P) {
    constexpr int LAP = 328;
    LAS bf16* LA = (LAS bf16*)F.lds;
    LAS float* SSQ = (LAS float*)(F.lds + 10752);
    LAS float* PRM = (LAS float*)(F.lds + 12288);
    const int lane = F.lane, w = F.wave, tk = lane & 15, q4 = lane >> 4;
    constexpr int NTILE = MALL / 16, NTG = 64;
    for (int su = F.vcu; su < 4 * NTG; su += F.G) {
        const int cg = su & 3, tg = su >> 2, cw = 256 * cg + 32 * w, ch8 = cw + 8 * q4, hd = 4 * cg + (w >> 1);
        __syncthreads();
        for (int i = F.tid; i < 2560; i += 512) { const int prm = i >> 8, c = (i & 255) + 256 * cg; float v;
            switch (prm) { case 0: v = P.k_k[c]; break; case 1: v = P.k_a[c]; break; case 2: v = P.r_k[c]; break; case 3: v = P.w0[c]; break; case 4: v = P.w0[RW + c]; break;
                           case 5: v = P.a0[c]; break; case 6: v = P.a0[RW + c]; break; case 7: v = P.mu[c]; break; case 8: v = P.mu[RW + c]; break; default: v = P.mu[2 * RW + c]; break; }
            PRM[i] = v; }
        bf16x8 fw[2][2][2], fa[2][2][2], fg[2][2];
        { const int chA = cw + 8 * (tk >> 2) + (tk & 3);
#pragma unroll
          for (int d = 0; d < 2; ++d)
#pragma unroll
              for (int t = 0; t < 2; ++t) {
#pragma unroll
                  for (int ks = 0; ks < 2; ++ks) { fw[d][t][ks] = *(const GAS bf16x8*)(P.WUP + ((size_t)d * RW + chA + 4 * t) * 64 + ks * 32 + q4 * 8); fa[d][t][ks] = *(const GAS bf16x8*)(P.AUP + ((size_t)d * RW + chA + 4 * t) * 64 + ks * 32 + q4 * 8); }
                  fg[d][t] = *(const GAS bf16x8*)(P.GUP + ((size_t)d * RW + chA + 4 * t) * 32 + q4 * 8); } }
        for (int tt = tg; tt < NTILE; tt += NTG) {
            const int m0 = tt * 16;
            const int m = m0 + tk, b = m / TPB, tp = m - b * TPB;
            const bool hp = (tp != 0) && (tp != CTXL), hn = (tp != CTXL - 1) && (tp != TPB - 1);
            const bf16* rowp = P.PA + (size_t)m * INA_P + ch8;
            const Raw3 rawk = load3(rowp + RW, hp, hn), rawr = load3(rowp, hp, hn), rawv = load3(rowp + 2 * RW, hp, hn);
            __syncthreads();
            for (int it = F.tid; it < 640; it += 512) { const int tkk = it / 40, c8 = (it - tkk * 40) * 8, c = C_WD + c8, m = m0 + tkk, tp = m % TPB;
                const bool hp = (tp != 0) && (tp != CTXL), hn = (tp != CTXL - 1) && (tp != TPB - 1);
                float mu[8], v[8];
                { const f32x4 a = *(const GAS f32x4*)(P.mu + c), b2 = *(const GAS f32x4*)(P.mu + c + 4); mu[0] = a.x; mu[1] = a.y; mu[2] = a.z; mu[3] = a.w; mu[4] = b2.x; mu[5] = b2.y; mu[6] = b2.z; mu[7] = b2.w; }
                mix8(P.PA + (size_t)m * INA_P + c, hp, hn, mu, v);
#pragma unroll
                for (int e = 0; e < 8; ++e) { if (c < C_AD) v[e] = 1.0f - 2.0f * __builtin_amdgcn_rcpf(1.0f + __expf(2.0f * v[e])); else if (c >= C_GD) v[e] = sigmoidf_(v[e]); }
                *(LAS v4u*)(LA + tkk * LAP + c8) = pack8f(v); }
            if ((tt & 3) == cg) {
#pragma unroll
                for (int t2 = 0; t2 < 2; ++t2) { const int m = m0 + 2 * w + t2, b = m / TPB, tp = m - b * TPB; const bf16* row = P.PA + (size_t)m * INA_P;
                    { float x[8]; unpack8(*(const GAS v4u*)(row + C_QC + lane * 8), x); float s = 0.f;
#pragma unroll
                      for (int e = 0; e < 8; ++e) s += x[e] * x[e];
                      const float rs = rsqrtf(wave_sum(s) * (1.f / 512.f) + NORM_EPS);
#pragma unroll
                      for (int e = 0; e < 8; ++e) x[e] = x[e] * rs * P.qnorm[lane * 8 + e];
                      *(GAS v4u*)(P.QN + (size_t)m * 512 + lane * 8) = pack8f(x); }
                    { const v2u q = *(const GAS v2u*)(row + C_KVC + lane * 4);
                      float x[4] = {bflo(q.x), bfhi(q.x), bflo(q.y), bfhi(q.y)}; float s = 0.f;
#pragma unroll
                      for (int e = 0; e < 4; ++e) s += x[e] * x[e];
                      const float rs = rsqrtf(wave_sum(s) * (1.f / 256.f) + NORM_EPS);
#pragma unroll
                      for (int e = 0; e < 4; ++e) x[e] = x[e] * rs * P.kvnorm[lane * 4 + e];
                      v2u o; o.x = pk2(x[0], x[1]); o.y = pk2(x[2], x[3]);
                      *(GAS v2u*)(P.KVN + (size_t)m * 256 + lane * 4) = o; }
                    if (lane < 16) { const float x1 = bf1(row[C_KR + lane]), x2 = bf1(row[C_KR + 16 + lane]); const f32x2 cs = P.rope[(size_t)tp * 16 + lane];
                        const unsigned o = pk2(x1 * cs.x - x2 * cs.y, x1 * cs.y + x2 * cs.x);
#pragma unroll
                        for (int h2 = 0; h2 < NH; ++h2) *(GAS unsigned*)(P.K + ((size_t)(b * NH + h2) * TPB + tp) * QKD + 64 + 2 * lane) = o; } } }
            const int pc = 32 * w + 8 * q4;
            float prm[8], kmx[8], kx[8];
#pragma unroll
            for (int e = 0; e < 8; ++e) prm[e] = PRM[8 * 256 + pc + e];
            mix8r(rawk, prm, kmx);
            { float s = 0.f;
#pragma unroll
              for (int e = 0; e < 8; ++e) { kx[e] = kmx[e] * PRM[0 * 256 + pc + e]; s += kx[e] * kx[e]; }
              s += bpermf(lane ^ 16, s); s += bpermf(lane ^ 32, s);
              if (q4 == 0) SSQ[tk * 8 + w] = s; }
            __syncthreads();
            const float rsn = rsqrtf(SSQ[tk * 8 + w] + SSQ[tk * 8 + (w ^ 1)] + 1e-12f);
            f32x4 cw_[2][2], ca_[2][2], cg_[2][2];
#pragma unroll
            for (int d = 0; d < 2; ++d) {
                const bf16x8 bg = *(const LAS bf16x8*)(LA + tk * LAP + 256 + d * 32 + q4 * 8);
                bf16x8 bw[2], ba[2];
#pragma unroll
                for (int ks = 0; ks < 2; ++ks) { bw[ks] = *(const LAS bf16x8*)(LA + tk * LAP + d * 64 + ks * 32 + q4 * 8); ba[ks] = *(const LAS bf16x8*)(LA + tk * LAP + 128 + d * 64 + ks * 32 + q4 * 8); }
#pragma unroll
                for (int t = 0; t < 2; ++t) { f32x4 z = {0, 0, 0, 0};
                    cw_[d][t] = MFMA16(fw[d][t][1], bw[1], MFMA16(fw[d][t][0], bw[0], z));
                    ca_[d][t] = MFMA16(fa[d][t][1], ba[1], MFMA16(fa[d][t][0], ba[0], z));
                    cg_[d][t] = MFMA16(fg[d][t], bg, z); } }
            float r8[8], v8[8], kk8[8];
#pragma unroll
            for (int e = 0; e < 8; ++e) prm[e] = PRM[7 * 256 + pc + e];
            mix8r(rawr, prm, r8);
#pragma unroll
            for (int e = 0; e < 8; ++e) prm[e] = PRM[9 * 256 + pc + e];
            mix8r(rawv, prm, v8);
#pragma unroll
            for (int e = 0; e < 8; ++e) kk8[e] = kx[e] * rsn;
            bf16* rec = P.RI + ((size_t)(b * NH + hd) * TPB + tp) * RREC + (ch8 & 63);
            *(GAS v4u*)(rec) = pack8f(r8); *(GAS v4u*)(rec + 64) = pack8f(kk8); *(GAS v4u*)(rec + 128) = pack8f(v8);
#pragma unroll
            for (int d = 0; d < 2; ++d) {
                float ld[8], ke[8], bb[8], gg[8]; float bs = 0.f;
#pragma unroll
                for (int e = 0; e < 8; ++e) { const int t = e >> 2, r = e & 3;
                    ld[e] = -0.60653066f * sigmoidf_(PRM[(3 + d) * 256 + pc + e] + cw_[d][t][r]);
                    const float aa = sigmoidf_(PRM[(5 + d) * 256 + pc + e] + ca_[d][t][r]);
                    ke[e] = kmx[e] * (1.0f + (aa - 1.0f) * PRM[1 * 256 + pc + e]); bb[e] = kk8[e] * aa; gg[e] = cg_[d][t][r];
                    bs += r8[e] * ke[e] * PRM[2 * 256 + pc + e]; }
                *(GAS v4u*)(rec + (3 + 3 * d) * 64) = pack8f(ld); *(GAS v4u*)(rec + (4 + 3 * d) * 64) = pack8f(bb); *(GAS v4u*)(rec + (5 + 3 * d) * 64) = pack8f(ke);
                *(GAS v4u*)(P.GG + ((size_t)d * MALL + m) * RW + ch8) = pack8f(gg);
                bs += bpermf(lane ^ 16, bs); bs += bpermf(lane ^ 32, bs);
                if (q4 == 0) P.BON[((size_t)d * MALL + m) * 32 + 2 * hd + (w & 1)] = bs; }
        }
    }
}

__device__ __forceinline__ void cvt_row_load(f32x4 (&x)[8], const float* src) {
#pragma unroll
    for (int q = 0; q < 8; ++q) x[q] = *(const GAS f32x4*)(src + q * 4);
}
__device__ __forceinline__ void cvt_row_store(const f32x4 (&x)[8], unsigned char* dst, float* scale_slot, int lane) {
    float am = 0.f;
#pragma unroll
    for (int q = 0; q < 8; ++q) am = fmaxf(am, fmaxf(fmaxf(fabsf(x[q].x), fabsf(x[q].y)), fmaxf(fabsf(x[q].z), fabsf(x[q].w))));
    am = fmaxf(wave_max_u(am), 1e-30f);
    const float g = 6.0f / am, inv = am * (1.0f / 6.0f);
    v4u o;
#pragma unroll
    for (int q = 0; q < 4; ++q) { unsigned w = 0u;
        w = __builtin_amdgcn_cvt_scalef32_pk_fp4_f32(w, x[2 * q].x * g, x[2 * q].y * g, 1.0f, 0);
        w = __builtin_amdgcn_cvt_scalef32_pk_fp4_f32(w, x[2 * q].z * g, x[2 * q].w * g, 1.0f, 1);
        w = __builtin_amdgcn_cvt_scalef32_pk_fp4_f32(w, x[2 * q + 1].x * g, x[2 * q + 1].y * g, 1.0f, 2);
        w = __builtin_amdgcn_cvt_scalef32_pk_fp4_f32(w, x[2 * q + 1].z * g, x[2 * q + 1].w * g, 1.0f, 3);
        o[q] = w; }
    *(GAS v4u*)dst = o;
    if (lane == 0) *scale_slot = inv;
}
struct ScanCvt { const float* pu; const float* pv; unsigned char* PU8; unsigned char* PV8; float* SU; float* SV; int wl; };
constexpr int SCH = 32;
constexpr int SSTEP = 6 * 64;
__device__ __forceinline__ int scan_tp(int dir, int s) { return dir == 0 ? s : (s < CTXL ? (CTXL - 1 - s) : (TPB - 1 - (s - CTXL))); }
__device__ __forceinline__ void scan_load(v4u (&rg)[6], const bf16* RIh, int dir, int chunk, int htid) {
    const int tp = scan_tp(dir, chunk * SCH + (htid >> 3));
    const bf16* rec = RIh + (size_t)tp * RREC + (htid & 7) * 8;
#pragma unroll
    for (int i = 0; i < 3; ++i) rg[i] = *(const GAS v4u*)(rec + i * 64);
    rec += (3 + 3 * dir) * 64;
#pragma unroll
    for (int i = 0; i < 3; ++i) rg[3 + i] = *(const GAS v4u*)(rec + i * 64);
}
__device__ __forceinline__ void scan_store(const v4u (&rg)[6], LAS float* buf, int htid) {
    LAS float* d0 = buf + (htid >> 3) * SSTEP + (htid & 7) * 8;
#pragma unroll
    for (int i = 0; i < 6; ++i) { constexpr int SLOT[6] = {4, 0, 5, 2, 1, 3};
        const v4u wv = rg[i];
        f32x4 lo = {bflo(wv.x), bfhi(wv.x), bflo(wv.y), bfhi(wv.y)}, hi = {bflo(wv.z), bfhi(wv.z), bflo(wv.w), bfhi(wv.w)};
        if (i == 3) {
#pragma unroll
            for (int e = 0; e < 4; ++e) { lo[e] = __expf(lo[e]); hi[e] = __expf(hi[e]); } }
        LAS float* d = d0 + SLOT[i] * 64;
        *(LAS f32x4*)d = lo; *(LAS f32x4*)(d + 4) = hi; }
}
__device__ __forceinline__ void scan_phase(Frame& F, const bf16* RI, bf16* Y, const ScanCvt& C) {
    LAS float* bufs = (LAS float*)F.lds;
    constexpr int NCH = TPB / SCH;
    for (int uu = F.vcu; uu < NBATCH * NH * 2 * 4; uu += F.G) {
        const int rg = uu & 3, dir = (uu >> 2) & 1, hd = (uu >> 3) & 15, b = uu >> 7;
        const bf16* RIh = RI + (size_t)(b * NH + hd) * TPB * RREC;
        const int htid = F.tid - 256;
        v4u ra[6], rb[6];
        f32x4 xw[8];
        LAS float* wscr = (LAS float*)(F.lds + (((F.wave & 3) == 3) ? LDSCTL_OFF + 4096 : 98304 + (F.wave & 3) * 8448));
        f32x4 xc[8];
        __syncthreads();
        if (F.wave >= 4) { scan_load(rb, RIh, dir, 0, htid); scan_load(ra, RIh, dir, 1, htid); scan_store(rb, bufs, htid); scan_load(rb, RIh, dir, 2, htid); }
        __syncthreads();
        const int j = F.lane & 15, rowl = F.lane >> 4, row = rg * 16 + (F.wave & 3) * 4 + rowl;
        f32x2 S01 = {0.f, 0.f}, S23 = {0.f, 0.f};
        bf16* yb = Y + ((size_t)dir * MALL + (size_t)b * TPB) * RW + hd * 64 + row;
        for (int c = 0; c < NCH; ++c) {
            LAS float* cur = bufs + (c & 1) * (SCH * SSTEP);
            if (F.wave >= 4) {
                if (c + 1 < NCH) {
                    if ((c & 1) == 0) { scan_store(ra, bufs + (SCH * SSTEP), htid); if (c + 3 < NCH) scan_load(ra, RIh, dir, c + 3, htid); }
                    else { scan_store(rb, bufs, htid); if (c + 3 < NCH) scan_load(rb, RIh, dir, c + 3, htid); }  }
                if (C.wl >= 0 && (c & 3) == 2) { const int wi = uu * 4 + (F.wave - 4) + 1024 * (c >> 3);
                    if (wi < NW_ITEMS) { const TItem Tw = p0_resolve_wave(F.ws, C.wl, wi); if ((c & 7) == 2) p0_item_load(Tw, F.lane, xw); else p0_item_finish(Tw, xw, wscr, F.lane); } }
                if ((c & 3) == 0 && (c >> 3) < 32) { const int r = uu * 4 + (F.wave - 4) + 1024 * (c >> 3);
                    if ((c & 7) == 0) cvt_row_load(xc, ((r >= NEXP) ? C.pv + (size_t)(r - NEXP) * DM : C.pu + (size_t)r * DM) + F.lane * 32);
                    else cvt_row_store(xc, ((r >= NEXP) ? C.PV8 + (size_t)(r - NEXP) * (DM / 2) : C.PU8 + (size_t)r * (DM / 2)) + F.lane * 16, (r >= NEXP) ? C.SV + (r - NEXP) : C.SU + r, F.lane); } }
            else {
#pragma unroll
                for (int h16 = 0; h16 < 2; ++h16) {
                    const LAS float* sp = cur + (h16 * 16) * SSTEP;
                    f32x4 kk = *(const LAS f32x4*)(sp + 4 * j), bb = *(const LAS f32x4*)(sp + 64 + 4 * j), ww = *(const LAS f32x4*)(sp + 128 + 4 * j),
                          ke = *(const LAS f32x4*)(sp + 192 + 4 * j), rr = *(const LAS f32x4*)(sp + 256 + 4 * j);
                    float ykeep = 0.f, ypart; f32x2 u2, t2, vv; vv.x = sp[320 + row];
#define SCAN_DPP(r, ctl) "v_add_f32_dpp " r ", " r ", " r " " ctl " row_mask:0xf bank_mask:0xf bound_ctrl:1\n\t"
#define SCAN_MAIN(SEL) asm volatile( \
                        "v_pk_mul_f32 v[242:243], %[kexy], %[vv] op_sel_hi:[1,0]\n\t" \
                        "v_add_f32 v246, v250, v251\n\t" \
                        "v_add_f32_dpp v248, %[yp], %[yp] quad_perm:[1,0,3,2] row_mask:0xf bank_mask:0xf bound_ctrl:1\n\t" \
                        "v_pk_mul_f32 v[244:245], %[kezw], %[vv] op_sel_hi:[1,0]\n\t" \
                        SCAN_DPP("v246", "quad_perm:[1,0,3,2]") SCAN_DPP("v248", "quad_perm:[2,3,0,1]") \
                        "v_pk_fma_f32 %[s01], %[s01], %[wwxy], v[242:243]\n\t" \
                        SCAN_DPP("v246", "quad_perm:[2,3,0,1]") SCAN_DPP("v248", "row_half_mirror") \
                        "v_pk_fma_f32 %[s23], %[s23], %[wwzw], v[244:245]\n\t" \
                        SCAN_DPP("v246", "row_half_mirror") SCAN_DPP("v248", "row_mirror") \
                        SEL "\n\t" \
                        SCAN_DPP("v246", "row_mirror") \
                        "v_pk_fma_f32 %[s01], %[bbxy], v[246:247], %[s01] op_sel_hi:[1,0,1] neg_lo:[0,1,0] neg_hi:[0,1,0]\n\t" \
                        "v_pk_fma_f32 %[s23], %[bbzw], v[246:247], %[s23] op_sel_hi:[1,0,1] neg_lo:[0,1,0] neg_hi:[0,1,0]\n\t" \
                        "v_pk_mul_f32 v[252:253], %[s01], %[rrxy]" \
                        : [s01] "+v"(S01), [s23] "+v"(S23), [yk] "+v"(ykeep), "={v[252:253]}"(u2) \
                        : [kexy] "v"(ke.xy), [kezw] "v"(ke.zw), [vv] "v"(vv), [wwxy] "v"(ww.xy), [wwzw] "v"(ww.zw), [bbxy] "v"(bb.xy), [bbzw] "v"(bb.zw), [rrxy] "v"(rr.xy), [yp] "v"(ypart), [msk] "s"(msk), "{v[250:251]}"(t2) \
                        : "v242", "v243", "v244", "v245", "v246", "v247", "v248")
                    asm volatile("v_pk_mul_f32 v[250:251], %[s01], %[kxy]\n\tv_mov_b32 %[yp], 0\n\tv_pk_fma_f32 v[250:251], %[s23], %[kzw], v[250:251]"
                                 : "=&{v[250:251]}"(t2), [yp] "=&v"(ypart) : [s01] "v"(S01), [s23] "v"(S23), [kxy] "v"(kk.xy), [kzw] "v"(kk.zw));
#pragma unroll
                    for (int st = 0; st < 16; ++st) {
                        f32x4 nkk = kk, nbb = bb, nww = ww, nke = ke, nrr = rr; f32x2 nvv = vv;
                        const LAS float* sn = sp + (st + 1) * SSTEP;
                        if (st + 1 < 16) { nkk = *(const LAS f32x4*)(sn + 4 * j); nke = *(const LAS f32x4*)(sn + 192 + 4 * j); nvv.x = sn[320 + row]; nww = *(const LAS f32x4*)(sn + 128 + 4 * j); nbb = *(const LAS f32x4*)(sn + 64 + 4 * j);
                            nrr = *(const LAS f32x4*)(sn + 256 + 4 * j); }
                        const unsigned long long msk = 0x0001000100010001ull << ((st + 15) & 15);
                        if (st > 0) SCAN_MAIN("v_cndmask_b32_e64 %[yk], %[yk], v248, %[msk]"); else SCAN_MAIN("s_nop 0");
                        if (st + 1 < 16)
                            asm volatile("v_pk_mul_f32 v[250:251], %[s01], %[kxy]\n\tv_pk_fma_f32 v[252:253], %[s23], %[rrzw], v[252:253]\n\tv_pk_fma_f32 v[250:251], %[s23], %[kzw], v[250:251]\n\tv_add_f32 %[yp], v252, v253"
                                         : "=&{v[250:251]}"(t2), "={v[252:253]}"(u2), [yp] "=&v"(ypart) : [s01] "v"(S01), [s23] "v"(S23), [kxy] "v"(nkk.xy), [kzw] "v"(nkk.zw), [rrzw] "v"(rr.zw), "1"(u2));
                        else
                            asm volatile("s_nop 0\n\tv_pk_fma_f32 v[252:253], %[s23], %[rrzw], v[252:253]" : "={v[252:253]}"(u2) : [s23] "v"(S23), [rrzw] "v"(rr.zw), "0"(u2));
                        kk = nkk; bb = nbb; ww = nww; ke = nke; rr = nrr; vv = nvv;
                        __builtin_amdgcn_sched_barrier(0);
                    }
#undef SCAN_MAIN
#undef SCAN_DPP
                    { const float y = red16(u2.x + u2.y); ykeep = (j == 15) ? y : ykeep; }
                    const int tp = scan_tp(dir, c * SCH + h16 * 16 + j);
                    *(GAS bf16*)(yb + (size_t)tp * RW) = (bf16)f2bf(ykeep);
                }
            }
            __syncthreads();
        }
    }
}

constexpr int AKP = 208, AVP = 192;
constexpr int ATILE = 64 * AKP + 64 * AVP;
__device__ __forceinline__ bf16x8 pack8(const f32x16& x, int s) {
    v4u p; p.x = pk2(x[8 * s + 0], x[8 * s + 1]); p.y = pk2(x[8 * s + 2], x[8 * s + 3]); p.z = pk2(x[8 * s + 4], x[8 * s + 5]); p.w = pk2(x[8 * s + 6], x[8 * s + 7]);
    return __builtin_bit_cast(bf16x8, p);
}
__device__ __forceinline__ void attn_phase(Frame& F, const bf16* Q, const bf16* K, const bf16* V, bf16* YB, int with_ctx) {
    const int lane = F.lane, half = lane >> 5, l31 = lane & 31, l16 = lane & 15, g1 = (lane >> 4) & 1;
    const int nunits = NBATCH * NH * 32 + (with_ctx ? NBATCH * NH : 0);
    for (int uu = F.vcu; uu < nunits; uu += F.G) {
        int bh, q0, nkt;
        if (uu < NBATCH * NH * 32) { bh = uu >> 5; q0 = CTXL + (uu & 31) * 256; nkt = TPB / 64; } else { bh = uu - NBATCH * NH * 32; q0 = 0; nkt = CTXL / 64; }
        const bf16* Kh = K + (size_t)bh * TPB * QKD; const bf16* Vh = V + (size_t)bh * TPB * 64; const bf16* Qh = Q + (size_t)bh * TPB * QKD;
        const int tq = q0 + F.wave * 32 + l31;
        bf16x8 qf[6];
#pragma unroll
        for (int ks = 0; ks < 6; ++ks) qf[ks] = *(const GAS bf16x8*)(Qh + (size_t)tq * QKD + 16 * ks + 8 * half);
        f32x16 o0, o1;
#pragma unroll
        for (int i = 0; i < 16; ++i) { o0[i] = 0.f; o1[i] = 0.f; }
        float l_run = 0.f;
        f32x16 cinit;
#pragma unroll
        for (int i = 0; i < 16; ++i) cinit[i] = 0.f;
        asm volatile("" : "+v"(cinit));
        const int kc1 = F.tid + 512; const bool k1ok = kc1 < 768;
        const unsigned kd0 = (unsigned)((F.tid / 12) * AKP + (F.tid % 12) * 16), kd1 = (unsigned)((kc1 / 12) * AKP + (kc1 % 12) * 16), vd = (unsigned)(64 * AKP + (F.tid >> 3) * AVP + (F.tid & 7) * 16);
        v4u kr0, kr1 = {0, 0, 0, 0}, vr;
        kr0 = *(const GAS v4u*)(Kh + (size_t)F.tid * 8); if (k1ok) kr1 = *(const GAS v4u*)(Kh + (size_t)kc1 * 8); vr = *(const GAS v4u*)(Vh + (size_t)F.tid * 8);
        __syncthreads();
        *(LAS v4u*)(F.lds + kd0) = kr0; if (k1ok) *(LAS v4u*)(F.lds + kd1) = kr1; *(LAS v4u*)(F.lds + vd) = vr;
        __syncthreads();
        for (int kt = 0; kt < nkt; ++kt) {
            const bool more = kt + 1 < nkt;
            if (more) { const bf16* kn = Kh + (size_t)(kt + 1) * 64 * QKD; const bf16* vn = Vh + (size_t)(kt + 1) * 64 * 64;
                kr0 = *(const GAS v4u*)(kn + (size_t)F.tid * 8); if (k1ok) kr1 = *(const GAS v4u*)(kn + (size_t)kc1 * 8); vr = *(const GAS v4u*)(vn + (size_t)F.tid * 8); }
            LAS unsigned char* Kb = F.lds + (kt & 1) * ATILE; LAS unsigned char* Vb = Kb + 64 * AKP;
            f32x16 s0, s1;
            { bf16x8 ka[6], kb2[6];
#pragma unroll
              for (int ks = 0; ks < 6; ++ks) { ka[ks] = *(const LAS bf16x8*)(Kb + l31 * AKP + (16 * ks + 8 * half) * 2); kb2[ks] = *(const LAS bf16x8*)(Kb + (32 + l31) * AKP + (16 * ks + 8 * half) * 2); }
              s0 = MFMA32(ka[0], qf[0], cinit); s1 = MFMA32(kb2[0], qf[0], cinit);
#pragma unroll
              for (int ks = 1; ks < 6; ++ks) { s0 = MFMA32(ka[ks], qf[ks], s0); s1 = MFMA32(kb2[ks], qf[ks], s1); }
              __builtin_amdgcn_sched_group_barrier(0x100, 12, 0); __builtin_amdgcn_sched_group_barrier(0x8, 12, 0); }
            bf16x8 va[2][2][2];
#pragma unroll
            for (int t = 0; t < 2; ++t)
#pragma unroll
                for (int s = 0; s < 2; ++s) { const int kb = 32 * t + 16 * s + 4 * half + (l16 >> 2);
#pragma unroll
                    for (int dvt = 0; dvt < 2; ++dvt) { const LAS unsigned char* vp = Vb + kb * AVP + (32 * dvt + 16 * g1 + 4 * (l16 & 3)) * 2;
                        const s16x4 lo = __builtin_amdgcn_ds_read_tr16_b64_v4i16((LAS s16x4*)vp), hi = __builtin_amdgcn_ds_read_tr16_b64_v4i16((LAS s16x4*)(vp + 8 * AVP));
                        va[t][s][dvt] = __builtin_shufflevector(lo, hi, 0, 1, 2, 3, 4, 5, 6, 7); } }
            __builtin_amdgcn_sched_group_barrier(0x100, 16, 0);
            float mx = s0[0];
#pragma unroll
            for (int i = 1; i < 16; ++i) mx = fmaxf(mx, s0[i]);
#pragma unroll
            for (int i = 0; i < 16; ++i) mx = fmaxf(mx, s1[i]);
            if (kt == 0 || __any(mx > 8.0f)) {
                mx = fmaxf(mx, bpermf(lane ^ 32, mx));
                const float d = (kt == 0) ? mx : fmaxf(mx, 0.f), alpha = (kt == 0) ? 1.0f : __builtin_amdgcn_exp2f(-d);
                l_run *= alpha;
#pragma unroll
                for (int i = 0; i < 16; ++i) { o0[i] *= alpha; o1[i] *= alpha; s0[i] -= d; s1[i] -= d; cinit[i] -= d; }
                asm volatile("" : "+v"(cinit));
            }
#pragma unroll
            for (int i = 0; i < 16; ++i) { s0[i] = __builtin_amdgcn_exp2f(s0[i]); s1[i] = __builtin_amdgcn_exp2f(s1[i]); }
            float ps = 0.f;
#pragma unroll
            for (int i = 0; i < 16; ++i) ps += s0[i] + s1[i];
            l_run += ps;
            { bf16x8 pf[2][2];
#pragma unroll
              for (int t = 0; t < 2; ++t)
#pragma unroll
                  for (int s = 0; s < 2; ++s) pf[t][s] = pack8(t == 0 ? s0 : s1, s);
#pragma unroll
              for (int t = 0; t < 2; ++t)
#pragma unroll
                  for (int s = 0; s < 2; ++s) { o0 = MFMA32(va[t][s][0], pf[t][s], o0); o1 = MFMA32(va[t][s][1], pf[t][s], o1); } }
            if (more) { LAS unsigned char* nb = F.lds + ((kt + 1) & 1) * ATILE;
                *(LAS v4u*)(nb + kd0) = kr0; if (k1ok) *(LAS v4u*)(nb + kd1) = kr1; *(LAS v4u*)(nb + vd) = vr; }
            __syncthreads();
        }
        const float linv = (DBG_SKIP & 4) ? 0.f : 1.0f / (l_run + bpermf(lane ^ 32, l_run));
        const int b = bh >> 4, hd = bh & 15;
        bf16* op = YB + ((size_t)b * TPB + tq) * RW + hd * 64 + 4 * half;
#pragma unroll
        for (int g = 0; g < 4; ++g) {
            v2u w; w.x = pk2(o0[4 * g] * linv, o0[4 * g + 1] * linv); w.y = pk2(o0[4 * g + 2] * linv, o0[4 * g + 3] * linv); *(GAS v2u*)(op + 8 * g) = w;
            w.x = pk2(o1[4 * g] * linv, o1[4 * g + 1] * linv); w.y = pk2(o1[4 * g + 2] * linv, o1[4 * g + 3] * linv); *(GAS v2u*)(op + 32 + 8 * g) = w; }
    }
}

struct RoRaw { v4u va, vc, ya[2], yc[2], ga[2], gc[2]; float b0[2], b1[2]; };
__device__ __forceinline__ void readout_load(RoRaw& r, int m, int lane, const bf16* Y, const bf16* GG, const float* BON, const bf16* RI) {
    const int hd = lane >> 2, ch0 = hd * 64 + (lane & 3) * 16, b = m / TPB, tp = m - b * TPB;
    const bf16* rec = RI + ((size_t)(b * NH + hd) * TPB + tp) * RREC + 128 + (lane & 3) * 16;
    r.va = *(const GAS v4u*)rec; r.vc = *(const GAS v4u*)(rec + 8);
#pragma unroll
    for (int d = 0; d < 2; ++d) { const bf16* yp = Y + ((size_t)d * MALL + m) * RW + ch0; const bf16* gp = GG + ((size_t)d * MALL + m) * RW + ch0;
        r.ya[d] = *(const GAS v4u*)yp; r.yc[d] = *(const GAS v4u*)(yp + 8); r.ga[d] = *(const GAS v4u*)gp; r.gc[d] = *(const GAS v4u*)(gp + 8);
        r.b0[d] = BON[((size_t)d * MALL + m) * 32 + 2 * hd]; r.b1[d] = BON[((size_t)d * MALL + m) * 32 + 2 * hd + 1]; }
}
__device__ __forceinline__ void readout_phase(Frame& F, const bf16* Y, const bf16* GG, const float* BON, const bf16* RI, const float* ln_w, const float* ln_b, bf16* YA) {
    const int gw = F.vcu * NWAVES + F.wave, NGW = F.G * NWAVES, lane = F.lane, hd = lane >> 2, ch0 = hd * 64 + (lane & 3) * 16;
    RoRaw cur, nxt;
    if (gw < MALL) readout_load(cur, gw, lane, Y, GG, BON, RI);
    for (int m = gw; m < MALL; m += NGW) {
        if (m + NGW < MALL) readout_load(nxt, m + NGW, lane, Y, GG, BON, RI);
        float vv[16], out[16];
        unpack8(cur.va, *(float(*)[8])&vv[0]); unpack8(cur.vc, *(float(*)[8])&vv[8]);
#pragma unroll
        for (int e = 0; e < 16; ++e) out[e] = 0.f;
#pragma unroll
        for (int d = 0; d < 2; ++d) {
            float y[16], g[16];
            unpack8(cur.ya[d], *(float(*)[8])&y[0]); unpack8(cur.yc[d], *(float(*)[8])&y[8]); unpack8(cur.ga[d], *(float(*)[8])&g[0]); unpack8(cur.gc[d], *(float(*)[8])&g[8]);
            float s = 0.f;
#pragma unroll
            for (int e = 0; e < 16; ++e) s += y[e];
            s = dpp_add<0xB1>(s); s = dpp_add<0x4E>(s);
            const float mean = s * (1.f / 64.f); float q = 0.f;
#pragma unroll
            for (int e = 0; e < 16; ++e) { y[e] -= mean; q += y[e] * y[e]; }
            q = dpp_add<0xB1>(q); q = dpp_add<0x4E>(q);
            const float rstd = rsqrtf(q * (1.f / 64.f) + 64e-5f), bon = cur.b0[d] + cur.b1[d];
#pragma unroll
            for (int e = 0; e < 16; ++e) out[e] += (y[e] * rstd * ln_w[ch0 + e] + ln_b[ch0 + e] + bon * vv[e]) * g[e];
        }
        if (DBG_SKIP & 2) {
#pragma unroll
            for (int e = 0; e < 16; ++e) out[e] = 0.f; }
        v4u o0, o1;
        o0.x = pk2(out[0], out[1]); o0.y = pk2(out[2], out[3]); o0.z = pk2(out[4], out[5]); o0.w = pk2(out[6], out[7]);
        o1.x = pk2(out[8], out[9]); o1.y = pk2(out[10], out[11]); o1.z = pk2(out[12], out[13]); o1.w = pk2(out[14], out[15]);
        *(GAS v4u*)(YA + (size_t)m * RW + ch0) = o0; *(GAS v4u*)(YA + (size_t)m * RW + ch0 + 8) = o1;
        cur = nxt;
    }
}


__device__ __forceinline__ unsigned f2key(float f) { const unsigned u = __builtin_bit_cast(unsigned, f); return (u & 0x80000000u) ? ~u : (u | 0x80000000u); }
__device__ __forceinline__ float key2f(unsigned k) { const unsigned u = (k & 0x80000000u) ? (k & 0x7fffffffu) : ~k; return __builtin_bit_cast(float, u); }
template <int CTRL, int RM> __device__ __forceinline__ unsigned dpp_umax(unsigned x) {
    const unsigned y = (unsigned)__builtin_amdgcn_update_dpp(0, (int)x, CTRL, RM, 0xf, false); return x > y ? x : y; }
__device__ __forceinline__ unsigned row_umax(unsigned x) { x = dpp_umax<0xB1, 0xf>(x); x = dpp_umax<0x4E, 0xf>(x); x = dpp_umax<0x141, 0xf>(x); x = dpp_umax<0x140, 0xf>(x); return x; }
#define SEL_CE(a_, b_) do { const unsigned hi_ = (a_) > (b_) ? (a_) : (b_), lo_ = (a_) > (b_) ? (b_) : (a_); (a_) = hi_; (b_) = lo_; } while (0)
__device__ __forceinline__ void sel_keys8(unsigned (&k)[8], const _Float16* p, int id0) {
    typedef _Float16 h8 __attribute__((ext_vector_type(8)));
    const h8 hv = *(const GAS h8*)p;
    const f32x4 v0 = {(float)hv[0], (float)hv[1], (float)hv[2], (float)hv[3]}, v1 = {(float)hv[4], (float)hv[5], (float)hv[6], (float)hv[7]};
    k[0] = (f2key(v0.x) & ~127u) | (unsigned)(id0 + 0); k[1] = (f2key(v0.y) & ~127u) | (unsigned)(id0 + 1); k[2] = (f2key(v0.z) & ~127u) | (unsigned)(id0 + 2); k[3] = (f2key(v0.w) & ~127u) | (unsigned)(id0 + 3);
    k[4] = (f2key(v1.x) & ~127u) | (unsigned)(id0 + 4); k[5] = (f2key(v1.y) & ~127u) | (unsigned)(id0 + 5); k[6] = (f2key(v1.z) & ~127u) | (unsigned)(id0 + 6); k[7] = (f2key(v1.w) & ~127u) | (unsigned)(id0 + 7);
    SEL_CE(k[0], k[1]); SEL_CE(k[2], k[3]); SEL_CE(k[4], k[5]); SEL_CE(k[6], k[7]); SEL_CE(k[0], k[2]); SEL_CE(k[1], k[3]); SEL_CE(k[4], k[6]); SEL_CE(k[5], k[7]); SEL_CE(k[1], k[2]); SEL_CE(k[5], k[6]);
    SEL_CE(k[0], k[4]); SEL_CE(k[1], k[5]); SEL_CE(k[2], k[6]); SEL_CE(k[3], k[7]); SEL_CE(k[2], k[4]); SEL_CE(k[3], k[5]); SEL_CE(k[1], k[2]); SEL_CE(k[3], k[4]); SEL_CE(k[5], k[6]);
}
__device__ __forceinline__ void top16_rows2(const _Float16* pa, const _Float16* pb, int l16, unsigned& ra, unsigned& rb) {
    unsigned ka[8], kb[8]; sel_keys8(ka, pa + 8 * l16, 8 * l16); sel_keys8(kb, pb + 8 * l16, 8 * l16);
    ra = 0u; rb = 0u;
#pragma unroll
    for (int it = 0; it < 16; ++it) {
        const unsigned ma = row_umax(ka[0]), mb = row_umax(kb[0]); const bool oa = ka[0] == ma, ob = kb[0] == mb;
#pragma unroll
        for (int e = 0; e < 7; ++e) { ka[e] = oa ? ka[e + 1] : ka[e]; kb[e] = ob ? kb[e + 1] : kb[e]; }
        ka[7] = oa ? 0u : ka[7]; kb[7] = ob ? 0u : kb[7];
        ra = (l16 == it) ? ma : ra; rb = (l16 == it) ? mb : rb;
    }
}
struct SelP { const float* SC; int* ESEL; float* EGATE; int last; };
__device__ __forceinline__ void select_token(const _Float16* srow, int lane, int (&eidx)[2], float (&egate)[2]) {
    const int row = lane >> 4, l16 = lane & 15, rbase = lane & 48;
    const int i1 = (int)((0x3332222211111111ull >> (4 * l16)) & 15ull), j1 = (int)((0x2104321076543210ull >> (4 * l16)) & 15ull), i2 = (int)((0xdcba987766554443ull >> (4 * l16)) & 15ull), j2 = (int)((0x0000001010102103ull >> (4 * l16)) & 15ull);
#pragma unroll
    for (int G = 0; G < 2; ++G) {
                const _Float16* hrow = srow + (4 * G + row) * 256;
                unsigned recA, recB; top16_rows2(hrow, hrow + 128, l16, recA, recB);
                const float va = key2f(recA & ~127u), vb = key2f(recB & ~127u);
                const float a0 = bpermf(rbase, va), a1 = bpermf(rbase + i1, va), b1 = bpermf(rbase + j1, vb), a2 = bpermf(rbase + i2, va), b2 = bpermf(rbase + j2, vb), a3 = bpermf(rbase + 14 + (l16 & 1), va), b0 = bpermf(rbase, vb);
                unsigned ck[4];
                ck[0] = (f2key(a0 + vb) & ~255u) | (unsigned)l16; ck[1] = (f2key(a1 + b1) & ~255u) | (unsigned)(16 * i1 + j1); ck[2] = (f2key(a2 + b2) & ~255u) | (unsigned)(16 * i2 + j2);
                ck[3] = (l16 < 2) ? ((f2key(a3 + b0) & ~255u) | (unsigned)(16 * (14 + l16))) : 0u;
                SEL_CE(ck[0], ck[1]); SEL_CE(ck[2], ck[3]); SEL_CE(ck[0], ck[2]); SEL_CE(ck[1], ck[3]); SEL_CE(ck[1], ck[2]);
                unsigned rec = 0u;
#pragma unroll
                for (int it = 0; it < 16; ++it) {
                    const unsigned mh = row_umax(ck[0]); const bool own = ck[0] == mh;
                    ck[0] = own ? ck[1] : ck[0]; ck[1] = own ? ck[2] : ck[1]; ck[2] = own ? ck[3] : ck[2]; ck[3] = own ? 0u : ck[3];
                    rec = (l16 == it) ? mh : rec;
                }
                const float ts = key2f(rec & ~255u), tmax = bpermf(rbase, ts);
                const float ev = __expf(ts - tmax), esum = red16(ev);
                const int ci = (int)((rec >> 4) & 15u), cj = (int)(rec & 15u);
                const int expert = bpermi(rbase + ci, (int)(recA & 127u)) * 128 + bpermi(rbase + cj, (int)(recB & 127u));
                eidx[G] = expert; egate[G] = ev / esum;
    }
}
struct PeerP { const _Float16* SC; const float* nmod; const float* ng; bf16* Hout;   const int* ESEL; const float* EGATE; const bf16* H; const unsigned char* PU; const unsigned char* PV; const float* SU; const float* SV; bf16* X; const float* mod;   const float* fin_g; float* out; int last; int dry; };
__device__ __forceinline__ void peer_phase(Frame& F, const PeerP& P) {
    const int gw = F.vcu * NWAVES + F.wave, NGW = F.G * NWAVES, lane = F.lane;
    float pr_s2 = 0.f, pr_d2 = 0.f, pr_tg = 0.f, pr_n = 0.f;
    int m0 = gw; while (m0 < MALL && P.last && (m0 % TPB) < CTXL) m0 += NGW;
    v4u ph0 = {0u, 0u, 0u, 0u}, ph1 = ph0, ph2 = ph0, ph3 = ph0;
    if (m0 < MALL) { const bf16* hp = P.H + (size_t)m0 * DM + lane * 32; ph0 = *(const GAS v4u*)hp; ph1 = *(const GAS v4u*)(hp + 8); ph2 = *(const GAS v4u*)(hp + 16); ph3 = *(const GAS v4u*)(hp + 24); }
    for (int m = m0, mn = 0; m < MALL; m = mn) {
        mn = m + NGW; while (mn < MALL && P.last && (mn % TPB) < CTXL) mn += NGW;
        const int b = m / TPB, tp = m - b * TPB;
        const int mr = tp < CTXL ? 2 : b;
        const int emask_ = (P.dry & 2) ? 1023 : 0x7fffffff;
        int eidx[2]; float egate[2]; select_token(P.SC + (size_t)m * DM, lane, eidx, egate);
        eidx[0] &= emask_; eidx[1] &= emask_;
        typedef int v8i __attribute__((ext_vector_type(8)));
        LAS unsigned char* hq = F.lds + F.wave * 4096;
        { const v4u hv[4] = {ph0, ph1, ph2, ph3}; v4u o[2];
#pragma unroll
          for (int j = 0; j < 4; ++j) { int w0 = 0, w1 = 0;
              w0 = __builtin_amdgcn_cvt_pk_fp8_f32(bflo(hv[j].x), bfhi(hv[j].x), w0, false); w0 = __builtin_amdgcn_cvt_pk_fp8_f32(bflo(hv[j].y), bfhi(hv[j].y), w0, true);
              w1 = __builtin_amdgcn_cvt_pk_fp8_f32(bflo(hv[j].z), bfhi(hv[j].z), w1, false); w1 = __builtin_amdgcn_cvt_pk_fp8_f32(bflo(hv[j].w), bfhi(hv[j].w), w1, true);
              o[j >> 1][2 * (j & 1)] = (unsigned)w0; o[j >> 1][2 * (j & 1) + 1] = (unsigned)w1; }
          *(LAS v4u*)(hq + lane * 32) = o[0]; *(LAS v4u*)(hq + lane * 32 + 16) = o[1];
          unsigned z_ = 0u; asm volatile("" : "+v"(z_));
          if (lane < 2) *(LAS v4u*)(hq + 2048 + lane * 16) = (v4u){z_, z_, z_, z_}; }
        const int li = lane & 15, kb = lane >> 4;
        int rowoff[8];
#pragma unroll
        for (int g = 0; g < 8; ++g) rowoff[g] = bpermi(16 * (g & 3) + li, eidx[g >> 2]) * (DM / 2) + 16 * kb;
        f32x4 dacc[8];
#pragma unroll
        for (int g = 0; g < 8; ++g) dacc[g] = (f32x4){0.f, 0.f, 0.f, 0.f};
        const unsigned hb = (li == 0) ? (unsigned)(16 * kb) : 2048u;
        const unsigned hb2 = (li == 0) ? 64u : 16u;
        const unsigned hstep = (li == 0) ? 128u : 0u;
        v4u ua[8], ub[8];
#pragma unroll
        for (int g = 0; g < 8; ++g) ua[g] = *(const GAS v4u*)(P.PU + (unsigned)rowoff[g]);
#pragma unroll 1
        for (int s = 0; s < ((P.dry & 4) ? 2 : 16); s += 2) {
#pragma unroll
            for (int g = 0; g < 8; ++g) ub[g] = *(const GAS v4u*)(P.PU + (unsigned)(rowoff[g] + 64 * (s + 1)));
            { const v4u b0 = *(const LAS v4u*)(hq + hb + hstep * s), b1 = *(const LAS v4u*)(hq + hb + hstep * s + hb2);
              const v8i bf = {(int)b0.x, (int)b0.y, (int)b0.z, (int)b0.w, (int)b1.x, (int)b1.y, (int)b1.z, (int)b1.w};
#pragma unroll
              for (int g = 0; g < 8; ++g) { const v8i af = {(int)ua[g].x, (int)ua[g].y, (int)ua[g].z, (int)ua[g].w, 0, 0, 0, 0};
                  dacc[g] = __builtin_amdgcn_mfma_scale_f32_16x16x128_f8f6f4(af, bf, dacc[g], 4, 0, 0, 0x7f7f7f7f, 0, 0x7f7f7f7f); } }
            if (s + 2 < 16) {
#pragma unroll
                for (int g = 0; g < 8; ++g) ua[g] = *(const GAS v4u*)(P.PU + (unsigned)(rowoff[g] + 64 * (s + 2))); }
            { const v4u b0 = *(const LAS v4u*)(hq + hb + hstep * (s + 1)), b1 = *(const LAS v4u*)(hq + hb + hstep * (s + 1) + hb2);
              const v8i bf = {(int)b0.x, (int)b0.y, (int)b0.z, (int)b0.w, (int)b1.x, (int)b1.y, (int)b1.z, (int)b1.w};
#pragma unroll
              for (int g = 0; g < 8; ++g) { const v8i af = {(int)ub[g].x, (int)ub[g].y, (int)ub[g].z, (int)ub[g].w, 0, 0, 0, 0};
                  dacc[g] = __builtin_amdgcn_mfma_scale_f32_16x16x128_f8f6f4(af, bf, dacc[g], 4, 0, 0, 0x7f7f7f7f, 0, 0x7f7f7f7f); } }
        }
        float coef[2];
#pragma unroll
        for (int sl = 0; sl < 2; ++sl) { float mydot = 0.f;
#pragma unroll
            for (int g4 = 0; g4 < 4; ++g4)
#pragma unroll
                for (int r = 0; r < 4; ++r) { const float t = bpermf(16 * ((lane >> 2) & 3), dacc[4 * sl + g4][r]); if ((lane >> 4) == g4 && (lane & 3) == r) mydot = t; }
            mydot *= P.SU[eidx[sl]];
            if (DBG_PROBE == 4) {
                float ref = 0.f;
                for (int e = 0; e < 64; ++e) { const int ex = __builtin_amdgcn_readlane(eidx[sl], e); const v4u uu = *(const GAS v4u*)(P.PU + (size_t)ex * (DM / 2) + lane * 16); float s1 = 0.f;
                    const v4u hv2[4] = {*(const GAS v4u*)(P.H + (size_t)m * DM + lane * 32), *(const GAS v4u*)(P.H + (size_t)m * DM + lane * 32 + 8), *(const GAS v4u*)(P.H + (size_t)m * DM + lane * 32 + 16), *(const GAS v4u*)(P.H + (size_t)m * DM + lane * 32 + 24)};
#pragma unroll
                    for (int d = 0; d < 4; ++d) { const unsigned w = uu[d]; const unsigned hw[4] = {hv2[d].x, hv2[d].y, hv2[d].z, hv2[d].w};
                        f32x2 x = __builtin_amdgcn_cvt_scalef32_pk_f32_fp4(w, 1.0f, 0); s1 += x.x * bflo(hw[0]) + x.y * bfhi(hw[0]); x = __builtin_amdgcn_cvt_scalef32_pk_f32_fp4(w, 1.0f, 1); s1 += x.x * bflo(hw[1]) + x.y * bfhi(hw[1]);
                        x = __builtin_amdgcn_cvt_scalef32_pk_f32_fp4(w, 1.0f, 2); s1 += x.x * bflo(hw[2]) + x.y * bfhi(hw[2]); x = __builtin_amdgcn_cvt_scalef32_pk_f32_fp4(w, 1.0f, 3); s1 += x.x * bflo(hw[3]) + x.y * bfhi(hw[3]); }
                    const float tot = wave_sum_u(s1) * P.SU[ex]; if (lane == e) ref = tot; }
                pr_s2 = fmaxf(pr_s2, wave_max_u(fabsf(mydot - ref) / (fabsf(ref) + 0.25f))); pr_n = 1.f; }
            coef[sl] = egate[sl] * 0.5f * mydot * (1.0f + erff(mydot * 0.70710678f));
            if ((DBG_SKIP & 16) && sl == 0) coef[sl] = 0.f;
            if ((DBG_SKIP & 32) && sl == 1) coef[sl] = 0.f;
        }
        const float coefs[2] = {coef[0] * P.SV[eidx[0]], coef[1] * P.SV[eidx[1]]};
        f32x2 acc2[16];
#pragma unroll
        for (int i = 0; i < 16; ++i) acc2[i] = (f32x2){0.f, 0.f};
#define PEER_LOADV(U, C, e0_) do { const int e1_ = (e0_); const int ev_ = (e1_ & 64) ? eidx[1] : eidx[0]; const int cv_ = __builtin_bit_cast(int, (e1_ & 64) ? coefs[1] : coefs[0]); \
            _Pragma("unroll") for (int q = 0; q < 8; ++q) { const int ex = __builtin_amdgcn_readlane(ev_, (e1_ & 63) + q); U[q] = *(const GAS v4u*)(P.PV + (size_t)ex * (DM / 2) + lane * 16); \
            C[q] = __builtin_bit_cast(float, __builtin_amdgcn_readlane(cv_, (e1_ & 63) + q)); } } while (0)
#define PEER_AXPY(U, C) do { if (P.dry & 32) { _Pragma("unroll") for (int q = 0; q < 8; ++q) _Pragma("unroll") for (int d = 0; d < 4; ++d) acc2[d].x += __builtin_bit_cast(float, U[q][d] & 0x3fffffffu) * C[q]; } else \
            _Pragma("unroll") for (int q = 0; q < 8; ++q) _Pragma("unroll") for (int d = 0; d < 4; ++d) { const unsigned w = U[q][d]; \
            acc2[4 * d + 0] = __builtin_amdgcn_cvt_scalef32_pk_f32_fp4(w, 1.0f, 0) * C[q] + acc2[4 * d + 0]; acc2[4 * d + 1] = __builtin_amdgcn_cvt_scalef32_pk_f32_fp4(w, 1.0f, 1) * C[q] + acc2[4 * d + 1]; \
            acc2[4 * d + 2] = __builtin_amdgcn_cvt_scalef32_pk_f32_fp4(w, 1.0f, 2) * C[q] + acc2[4 * d + 2]; acc2[4 * d + 3] = __builtin_amdgcn_cvt_scalef32_pk_f32_fp4(w, 1.0f, 3) * C[q] + acc2[4 * d + 3]; } } while (0)
        if (mn < MALL) {
            const bf16* hp = P.H + (size_t)mn * DM + lane * 32; ph0 = *(const GAS v4u*)hp; ph1 = *(const GAS v4u*)(hp + 8); ph2 = *(const GAS v4u*)(hp + 16); ph3 = *(const GAS v4u*)(hp + 24); }
        v4u xpre[4];
        { const bf16* xr0 = P.X + (size_t)m * DM + lane * 32;
#pragma unroll
          for (int hq = 0; hq < 4; ++hq) xpre[hq] = *(const GAS v4u*)(xr0 + hq * 8); }
        {
            v4u ua[8], ub[8]; float ca[8], cb[8];
            PEER_LOADV(ua, ca, 0);
#pragma unroll 1
            for (int it = 0; it < ((P.dry & 8) ? 2 : 8); ++it) {
                PEER_LOADV(ub, cb, 16 * it + 8); PEER_AXPY(ua, ca);
                if (it < 7) PEER_LOADV(ua, ca, 16 * it + 16);
                PEER_AXPY(ub, cb);
            }
        }
#undef PEER_LOADV
#undef PEER_AXPY
        float acc[32];
#pragma unroll
        for (int i = 0; i < 16; ++i) { acc[2 * i] = acc2[i].x; acc[2 * i + 1] = acc2[i].y; }
        if (P.dry) { float sm_ = 0.f;
#pragma unroll
            for (int i = 0; i < 32; ++i) sm_ += acc[i];
            if (sm_ == 1.2345e-30f) P.X[lane] = sm_;
            if (!(P.dry & 16)) continue; }
        if (DBG_SKIP & 1) {
#pragma unroll
            for (int i = 0; i < 32; ++i) acc[i] = 0.f; }
        if (((DBG_SKIP & 64) && !P.last) || ((DBG_SKIP & 128) && P.last)) {
#pragma unroll
            for (int i = 0; i < 32; ++i) acc[i] = 0.f; }
        if (DBG_SKIP & 8) {
#pragma unroll
            for (int i = 0; i < 32; ++i) acc[i] = -acc[i]; }
        int m_l = m, lane_l = lane; asm volatile("" : "+v"(m_l), "+v"(lane_l));
        const int b_l = m_l / TPB, tp_l = m_l - b_l * TPB, mr_l = tp_l < CTXL ? 2 : b_l;
        bf16* xr = (P.dry ? (bf16*)(F.ws + 760 * MiB) : P.X) + (size_t)m_l * DM + lane_l * 32; const float* g2 = P.mod + (size_t)mr_l * 12288 + 5 * DM + lane_l * 32;
        float ss = 0.f;
#pragma unroll
        for (int hq = 0; hq < 4; ++hq) { const int c = hq * 8; float xf[8]; unpack8(xpre[hq], xf);
            const f32x4 g0 = *(const GAS f32x4*)(g2 + c), g1 = *(const GAS f32x4*)(g2 + c + 4);
#pragma unroll
            for (int e = 0; e < 8; ++e) { const float xv = xf[e] + (e < 4 ? g0[e & 3] : g1[e & 3]) * acc[8 * hq + e]; ss += xv * xv; acc[8 * hq + e] = xv; xf[e] = xv; }
            if (!P.last) *(GAS v4u*)(xr + c) = pack8f(xf); }
        if (!P.last) {
            const float rs = rsqrtf(wave_sum(ss) * (1.f / DM) + NORM_EPS); const float* sh = P.nmod + (size_t)mr_l * 12288 + lane_l * 32; const float* sc = sh + DM; const float* ngp = P.ng + lane_l * 32;
            bf16* ho = (P.dry ? (bf16*)(F.ws + 892 * MiB) : P.Hout) + (size_t)m_l * DM + lane_l * 32;
#pragma unroll
            for (int hq = 0; hq < 4; ++hq) { const int c = hq * 8; float y[8];
                const f32x4 n0 = *(const GAS f32x4*)(ngp + c), n1 = *(const GAS f32x4*)(ngp + c + 4), s0 = *(const GAS f32x4*)(sc + c), s1 = *(const GAS f32x4*)(sc + c + 4), h0 = *(const GAS f32x4*)(sh + c), h1 = *(const GAS f32x4*)(sh + c + 4);
#pragma unroll
                for (int e = 0; e < 4; ++e) { y[e] = acc[8 * hq + e] * rs * n0[e] * (1.0f + s0[e]) + h0[e]; y[4 + e] = acc[8 * hq + 4 + e] * rs * n1[e] * (1.0f + s1[e]) + h1[e]; }
                *(GAS v4u*)(ho + c) = pack8f(y); } }
        if (P.last) { const float rs = rsqrtf(wave_sum(ss) * (1.f / DM) + NORM_EPS); float* orow = P.out + ((size_t)b_l * SEQ + (tp_l - CTXL)) * DM + lane_l * 32; const float* fgp = P.fin_g + lane_l * 32;
#pragma unroll
            for (int hq = 0; hq < 8; ++hq) { const int c = hq * 4; const f32x4 fg = *(const GAS f32x4*)(fgp + c);
                f32x4 o;
#pragma unroll
                for (int e = 0; e < 4; ++e) o[e] = acc[4 * hq + e] * rs * fg[e];
                *(GAS f32x4*)(orow + c) = o; } }
    }
    if (DBG_PROBE && DBG_PROBE != 5 && !P.last && lane == 0) { float* pp = (float*)(F.ws + WS_CTL + CTL_PROBE_OFF) + gw * 4; pp[0] = pr_s2; pp[1] = pr_d2; pp[2] = pr_tg; pp[3] = pr_n; }
}


constexpr int PH_PER_LAYER = 12, NPHASE = 1 + NLAYER * PH_PER_LAYER;
#ifndef ONLY_PHASE
#define ONLY_PHASE -1
#endif
#define T0() (wave_s == 0 && pg8::opaque_lane() == 0)
#define PH_ON(k) (ONLY_PHASE < 0 || ONLY_PHASE == (k))
#define GEMM_CALL(EPI, SCHED, g, S, E) pg8::gemm_phase<EPI, SCHED, true, true>(F.lds, g, S, E, wave_s)
#define GEMM_CALL_NA(EPI, SCHED, g, S, E) pg8::gemm_phase<EPI, SCHED, false, true>(F.lds, g, S, E, wave_s)

__device__ __forceinline__ const float* karg(int i) {
    asm volatile("" : "+s"(i));
    const __attribute__((address_space(4))) unsigned long long* ka = (const __attribute__((address_space(4))) unsigned long long*)__builtin_amdgcn_kernarg_segment_ptr();
    return (const float*)ka[i];
}
__global__ void __launch_bounds__(NWAVES * 64, 2) mk_fwd(Args args) {
    extern __shared__ __attribute__((aligned(16))) unsigned char lds[];
    Frame F;
    F.lds = (LAS unsigned char*)lds; F.ws = args.ws;
    const int wave_s = __builtin_amdgcn_readfirstlane((int)threadIdx.x >> 6);
    F.tid = threadIdx.x; F.lane = F.tid & 63; F.wave = wave_s;
    F.G = gridDim.x; { const int bx = blockIdx.x; F.vcu = (F.G % 8 == 0) ? (bx % 8) * (F.G / 8) + bx / 8 : bx; }
    unsigned char* ws = args.ws;
    volatile LAS unsigned* MISC = (volatile LAS unsigned*)(F.lds + MISC_OFF);
    for (int u = F.tid; u < (LDS_BYTES - LDSCTL_OFF) / 4; u += NWAVES * 64) ((LAS unsigned*)(F.lds + LDSCTL_OFF))[u] = 0u;
    __syncthreads();
    const int lo = args.ph_lo, hi = args.ph_hi;
    XcdBarrier bar; bar.bar = (unsigned*)(ws + WS_CTL) + CW_BAR; bar.x = 0; bar.st = nullptr;
    if (hi - lo > 1) bar = xcd_barrier_post((unsigned*)(ws + WS_CTL) + CW_BAR, MISC + 8, T0());
#define IN(k) (lo <= (k) && (k) < hi)
#define REFRAME() do { const int lz_ = pg8::opaque_lane(); F.lane = lz_; F.tid = wave_s * 64 + lz_; F.wave = wave_s; ws = (unsigned char*)karg(34); F.ws = ws; { int g_ = (int)gridDim.x, b_ = (int)blockIdx.x; asm volatile("" : "+s"(g_), "+s"(b_)); bx = b_; F.G = g_; F.vcu = ((g_ & 7) == 0) ? (b_ & 7) * (g_ >> 3) + (b_ >> 3) : b_; } } while (0)
#define SEAM(k) do { if (IN((k) + 1)) xcd_barrier(bar, T0()); } while (0)
#define XBUF ((bf16*)(ws + WS_X))
#define HBUF ((bf16*)(ws + WS_H))
#define MODP ((const float*)(ws + WS_CTL + CTL_MOD_OFF) + (size_t)l * 3 * 12288)
    int bx = (int)blockIdx.x;

    for (int rep_ = 0; rep_ < ((DBG_REPEAT == 100) ? 2 : 1); ++rep_) if (PH_ON(100) && IN(0)) { REFRAME(); if (rep_) xcd_barrier(bar, T0()); p0_prologue(F, 0, (MK_N_LAUNCHES == 1) ? 1 : NLAYER, F.vcu, F.G); SEAM(0); if (DBG_REPEAT == 200) { for (int i_ = 0; i_ < 32; ++i_) xcd_barrier(bar, T0()); } }

    for (int l = 0; l < NLAYER; ++l) {
        const int base = 1 + l * PH_PER_LAYER;
        const int last = (l == NLAYER - 1);
        for (int rep_ = 0; rep_ < ((DBG_REPEAT == 0) ? 2 : 1); ++rep_) if (PH_ON(0) && IN(base + 0) && l == 0) { REFRAME(); if (rep_) xcd_barrier(bar, T0()); modnorm_phase(F, nullptr, karg(6) + (size_t)l * DM, MODP, 0, HBUF, 0, karg(0), karg(2)); SEAM(base + 0); }
        for (int rep_ = 0; rep_ < ((DBG_REPEAT == 1) ? 2 : 1); ++rep_) if (PH_ON(1) && IN(base + 1)) { REFRAME(); if (rep_) xcd_barrier(bar, T0());
            pg8::Gemm g{HBUF, (const bf16*)(ws + WS_WINA) + (size_t)l * INA_P * DM, MALL, INA_P, DM}; pg8::RowOrder S; S.init_rows(0, INA_P, F.G, bx);
            pg8::EpiStoreBf16 E{(bf16*)(ws + WS_PA), INA_P};
            GEMM_CALL(pg8::EpiStoreBf16, pg8::RowOrder, g, S, E);
            SEAM(base + 1); }
        for (int rep_ = 0; rep_ < ((DBG_REPEAT == 2) ? 2 : 1); ++rep_) if (PH_ON(2) && IN(base + 2)) { REFRAME(); if (rep_) xcd_barrier(bar, T0());
            FeatP P;
            P.PA = (const bf16*)(ws + WS_PA); P.mu = karg(9) + (size_t)l * RWC; P.w0 = karg(10) + (size_t)l * 2 * RW; P.a0 = karg(12) + (size_t)l * 2 * RW;
            P.k_k = karg(15) + (size_t)l * RW; P.k_a = karg(16) + (size_t)l * RW; P.r_k = karg(17) + (size_t)l * RW;
            P.WUP = (const bf16*)(ws + WS_WUP) + (size_t)l * 2 * RW * 64; P.AUP = (const bf16*)(ws + WS_AUP) + (size_t)l * 2 * RW * 64; P.GUP = (const bf16*)(ws + WS_GUP) + (size_t)l * 2 * RW * 32;
            P.qnorm = karg(20) + (size_t)l * 512; P.kvnorm = karg(22) + (size_t)l * 256; P.rope = (const f32x2*)(ws + WS_ROPE);
            P.RI = (bf16*)(ws + WS_RI); P.GG = (bf16*)(ws + WS_GG); P.BON = (float*)(ws + WS_BON); P.QN = (bf16*)(ws + WS_QN); P.KVN = (bf16*)(ws + WS_KVN); P.K = (bf16*)(ws + WS_K);
            features_phase(F, P);
            SEAM(base + 2); }
        for (int rep_ = 0; rep_ < ((DBG_REPEAT == 3) ? 2 : 1); ++rep_) if (PH_ON(3) && IN(base + 3)) { REFRAME(); if (rep_) xcd_barrier(bar, T0());
            { pg8::Gemm g{(const bf16*)(ws + WS_QN), (const bf16*)(ws + WS_WUQ) + (size_t)l * NQ * 512, MALL, NQ, 512};
              pg8::EpiQ E{(bf16*)(ws + WS_Q), (const f32x2*)(ws + WS_ROPE), 0.14724444f};
              pg8::RowOrder S; S.init_rows(last, NQ, F.G, bx); GEMM_CALL_NA(pg8::EpiQ, pg8::RowOrder, g, S, E); }
            { pg8::Gemm g{(const bf16*)(ws + WS_KVN), (const bf16*)(ws + WS_WUKV) + (size_t)l * NKV * 256, MALL, NKV, 256}; pg8::RowOrder S; S.init_rows(0, NKV, F.G, bx);
              pg8::EpiKV E{(bf16*)(ws + WS_K), (bf16*)(ws + WS_V)};
              GEMM_CALL_NA(pg8::EpiKV, pg8::RowOrder, g, S, E); }
            SEAM(base + 3); }
        for (int rep_ = 0; rep_ < ((DBG_REPEAT == 4) ? 2 : 1); ++rep_) if (PH_ON(4) && IN(base + 4)) { REFRAME(); if (rep_) xcd_barrier(bar, T0());
            ScanCvt C; C.pu = karg(30) + (size_t)l * NEXP * DM; C.pv = karg(31) + (size_t)l * NEXP * DM; C.PU8 = ws + WS_P4; C.PV8 = ws + WS_P4 + (size_t)NEXP * (DM / 2); C.SU = (float*)(ws + WS_P4S); C.SV = (float*)(ws + WS_P4S) + NEXP; C.wl = (MK_N_LAUNCHES == 1 && l + 1 < NLAYER && F.G == 256) ? l + 1 : -1;
            scan_phase(F, (const bf16*)(ws + WS_RI), (bf16*)(ws + WS_Y), C); SEAM(base + 4); }
        for (int rep_ = 0; rep_ < ((DBG_REPEAT == 5) ? 2 : 1); ++rep_) if (PH_ON(5) && IN(base + 5)) { REFRAME(); if (rep_) xcd_barrier(bar, T0());
            attn_phase(F, (const bf16*)(ws + WS_Q), (const bf16*)(ws + WS_K), (const bf16*)(ws + WS_V), (bf16*)(ws + WS_YB), !last);
            readout_phase(F, (const bf16*)(ws + WS_Y), (const bf16*)(ws + WS_GG), (const float*)(ws + WS_BON), (const bf16*)(ws + WS_RI), karg(18) + (size_t)l * RW, karg(19) + (size_t)l * RW, (bf16*)(ws + WS_YA));
            SEAM(base + 5); }
        for (int rep_ = 0; rep_ < ((DBG_REPEAT == 6) ? 2 : 1); ++rep_) if (PH_ON(6) && IN(base + 6)) { REFRAME(); if (rep_) xcd_barrier(bar, T0());
            bf16* T1 = (bf16*)(ws + WS_T1); bf16* T2 = (bf16*)(ws + WS_T2);
            const pg8::Gemm g1{HBUF, (const bf16*)(ws + WS_WGA) + (size_t)l * DM * DM, MALL, DM, DM}, g2{(const bf16*)(ws + WS_YA), (const bf16*)(ws + WS_WA) + (size_t)l * DM * RW, MALL, DM, RW};
            const pg8::Gemm g3{HBUF, (const bf16*)(ws + WS_WGB) + (size_t)l * DM * DM, MALL, DM, DM}, g4{(const bf16*)(ws + WS_YB), (const bf16*)(ws + WS_WB) + (size_t)l * DM * RW, MALL, DM, RW};
            const pg8::EpiGate E1{T1, DM, karg(8) + (size_t)l * 2 * DM}, E3{T2, DM, karg(8) + (size_t)l * 2 * DM + DM};
            const pg8::EpiMulAdd E2{T1, T1, nullptr, DM}, E4{T1, T2, T1, DM};
            pg8::RowOrder S; S.init_rows(last, DM, F.G, bx);
            GEMM_CALL(pg8::EpiGate, pg8::RowOrder, g1, S, E1); GEMM_CALL(pg8::EpiMulAdd, pg8::RowOrder, g2, S, E2); GEMM_CALL(pg8::EpiGate, pg8::RowOrder, g3, S, E3); GEMM_CALL(pg8::EpiMulAdd, pg8::RowOrder, g4, S, E4);
            if (MK_N_LAUNCHES == 1 && l == 0 && rep_ == 0) { __syncthreads();
                const int late = (F.G > 32) ? 16 : 0; p0_prologue(F, 1, NLAYER, (bx >= late) ? bx - late : -1, F.G - late, (F.G == 256) ? 0 : 1); }
            SEAM(base + 6); }
        for (int rep_ = 0; rep_ < ((DBG_REPEAT == 7) ? 2 : 1); ++rep_) if (PH_ON(7) && IN(base + 7)) { REFRAME(); if (rep_) xcd_barrier(bar, T0());
            const pg8::Gemm g{(const bf16*)(ws + WS_T1), (const bf16*)(ws + WS_WO) + (size_t)l * DM * DM, MALL, DM, DM};
            const pg8::EpiResid E{XBUF, MODP + 2 * DM, l == 0 ? karg(0) : nullptr, l == 0 ? karg(2) : nullptr};
            pg8::RowOrder S; S.init_rows(last, DM, F.G, bx); GEMM_CALL(pg8::EpiResid, pg8::RowOrder, g, S, E);
            SEAM(base + 7); }
        for (int rep_ = 0; rep_ < ((DBG_REPEAT == 8) ? 2 : 1); ++rep_) if (PH_ON(8) && IN(base + 8)) { REFRAME(); if (rep_) xcd_barrier(bar, T0());
            modnorm_phase_bf(F, XBUF, karg(27) + (size_t)l * DM, MODP, 3, HBUF, last);
            SEAM(base + 8); }
        for (int rep_ = 0; rep_ < ((DBG_REPEAT == 9) ? 2 : 1); ++rep_) if (PH_ON(9) && IN(base + 9)) { REFRAME(); if (rep_) xcd_barrier(bar, T0());
            const pg8::Gemm g{HBUF, (const bf16*)(ws + WS_WQK) + (size_t)l * DM * DM, MALL, DM, DM};
            const pg8::EpiF16 E{(_Float16*)(ws + WS_SC), DM};
            pg8::RowOrder S; S.init_rows(last, DM, F.G, bx); GEMM_CALL(pg8::EpiF16, pg8::RowOrder, g, S, E);
            SEAM(base + 9); }
        for (int rep_ = 0; rep_ < ((DBG_REPEAT == 11) ? 2 : 1); ++rep_) if (PH_ON(11) && IN(base + 11)) { REFRAME(); if (rep_) xcd_barrier(bar, T0());
            PeerP P; P.SC = (const _Float16*)(ws + WS_SC); P.nmod = MODP + 3 * 12288; P.ng = karg(6) + (size_t)(l + 1) * DM; P.Hout = HBUF; P.ESEL = (const int*)(ws + WS_T1); P.EGATE = (const float*)(ws + WS_T1 + 16 * MiB); P.H = HBUF; P.PU = ws + WS_P4; P.PV = ws + WS_P4 + (size_t)NEXP * (DM / 2); P.SU = (const float*)(ws + WS_P4S); P.SV = (const float*)(ws + WS_P4S) + NEXP; P.X = XBUF; P.mod = MODP; P.fin_g = karg(32); P.out = (float*)karg(33); P.last = last; P.dry = (DBG_REPEAT == 11 && rep_ == 0) ? DBG_DRY : 0;
            peer_phase(F, P);
            SEAM(base + 11); }
    }
#undef IN
#undef SEAM
#undef XBUF
#undef HBUF
#undef MODP
}

__device__ __forceinline__ float mx_a_val(int i, int k) { const int c = (i * 131 + k * 17 + (k >> 3) * 5) & 15; const float mag[8] = {0.f, .5f, 1.f, 1.5f, 2.f, 3.f, 4.f, 6.f}; return (c & 8) ? -mag[c & 7] : mag[c & 7]; }
__device__ __forceinline__ int mx_a_code(int i, int k) { return (i * 131 + k * 17 + (k >> 3) * 5) & 15; }
__device__ __forceinline__ float mx_b_val(int k, int j) { return (float)(((k * 7 + j * 13 + (k >> 4)) % 9) - 4); }
__device__ __forceinline__ int mx_kmap(int hyp, int kb, int e) { const int h = hyp % 3; return h == 0 ? 32 * kb + e : h == 1 ? 32 * (e >> 3) + 8 * kb + (e & 7) : 64 * (e >> 4) + 16 * kb + (e & 15); }
__global__ void __launch_bounds__(512) dbg_fill(const float* pp, float* o) {
    __shared__ float vsh;
    float v = 0.f;
    if (DBG_PROBE == 5) {
        if (threadIdx.x < 64) { typedef int v8i __attribute__((ext_vector_type(8))); typedef float f4 __attribute__((ext_vector_type(4)));
            const int lane = threadIdx.x, i = lane & 15, kb = lane >> 4; float code = 0.f;
            for (int hyp = 0; hyp < 18; ++hyp) { const int nibswap = hyp / 9, ha = hyp % 3, hb2 = (hyp / 3) % 3;
                unsigned aw[4] = {0u, 0u, 0u, 0u}; int bw[8] = {0, 0, 0, 0, 0, 0, 0, 0};
                for (int e = 0; e < 32; ++e) { const int k = mx_kmap(ha, kb, e); const unsigned c = (unsigned)mx_a_code(i, k); const int pos = nibswap ? (e ^ 1) : e; aw[pos >> 3] |= c << (4 * (pos & 7)); }
                for (int q = 0; q < 8; ++q) { int w = 0; const float f0 = mx_b_val(mx_kmap(hb2, kb, 4 * q + 0), i), f1 = mx_b_val(mx_kmap(hb2, kb, 4 * q + 1), i), f2 = mx_b_val(mx_kmap(hb2, kb, 4 * q + 2), i), f3 = mx_b_val(mx_kmap(hb2, kb, 4 * q + 3), i);
                    w = __builtin_amdgcn_cvt_pk_fp8_f32(f0, f1, w, false); w = __builtin_amdgcn_cvt_pk_fp8_f32(f2, f3, w, true); bw[q] = w; }
                const v8i af = {(int)aw[0], (int)aw[1], (int)aw[2], (int)aw[3], 0, 0, 0, 0}, bf = {bw[0], bw[1], bw[2], bw[3], bw[4], bw[5], bw[6], bw[7]};
                f4 d = {0.f, 0.f, 0.f, 0.f};
                d = __builtin_amdgcn_mfma_scale_f32_16x16x128_f8f6f4(af, bf, d, 4, 0, 0, 0x7f7f7f7f, 0, 0x7f7f7f7f);
                int bad = 0;
                for (int r = 0; r < 4; ++r) { const int row = 4 * kb + r, col = i; float ex = 0.f; for (int k = 0; k < 128; ++k) ex += mx_a_val(row, k) * mx_b_val(k, col); bad += (d[r] != ex); }
                if (__ballot(bad != 0) == 0ull && code == 0.f) code = (float)(hyp + 1); }
            for (int t = 0; t < 2; ++t) {
                int aw[8] = {0, 0, 0, 0, 0, 0, 0, 0}, bw[8] = {0, 0, 0, 0, 0, 0, 0, 0};
                if (t == 0) { for (int e = 0; e < 32; ++e) { const int k = 32 * kb + e; aw[e >> 3] |= mx_a_code(i, k) << (4 * (e & 7)); bw[e >> 3] |= mx_a_code(i + 16, k) << (4 * (e & 7)); } }
                else { for (int q = 0; q < 8; ++q) { int w = 0, w2 = 0; const int k = 32 * kb + 4 * q;
                        w = __builtin_amdgcn_cvt_pk_fp8_f32(mx_b_val(k, i + 16), mx_b_val(k + 1, i + 16), w, false); w = __builtin_amdgcn_cvt_pk_fp8_f32(mx_b_val(k + 2, i + 16), mx_b_val(k + 3, i + 16), w, true); aw[q] = w;
                        w2 = __builtin_amdgcn_cvt_pk_fp8_f32(mx_b_val(k, i), mx_b_val(k + 1, i), w2, false); w2 = __builtin_amdgcn_cvt_pk_fp8_f32(mx_b_val(k + 2, i), mx_b_val(k + 3, i), w2, true); bw[q] = w2; } }
                const v8i af = {aw[0], aw[1], aw[2], aw[3], aw[4], aw[5], aw[6], aw[7]}, bf = {bw[0], bw[1], bw[2], bw[3], bw[4], bw[5], bw[6], bw[7]};
                f4 d = {0.f, 0.f, 0.f, 0.f};
                if (t == 0) d = __builtin_amdgcn_mfma_scale_f32_16x16x128_f8f6f4(af, bf, d, 4, 4, 0, 0x7f7f7f7f, 0, 0x7f7f7f7f); else d = __builtin_amdgcn_mfma_scale_f32_16x16x128_f8f6f4(af, bf, d, 0, 0, 0, 0x7f7f7f7f, 0, 0x7f7f7f7f);
                int bad = 0;
                for (int r = 0; r < 4; ++r) { const int row = 4 * kb + r, col = i; float ex = 0.f;
                    for (int k = 0; k < 128; ++k) ex += (t == 0) ? mx_a_val(row, k) * mx_a_val(col + 16, k) : mx_b_val(k, row + 16) * mx_b_val(k, col);
                    bad += (d[r] != ex); }
                if (__ballot(bad != 0) == 0ull) code += (t == 0) ? 10.f : 20.f; }
            if (lane == 0) vsh = code; }
        __syncthreads(); v = vsh;
    } else {
        float s0 = 0.f, s1 = 0.f, s2 = 0.f, s3 = 0.f;
        for (int i = 0; i < 2048; ++i) { s0 += pp[4 * i]; s1 += pp[4 * i + 1]; s2 += pp[4 * i + 2]; s3 += pp[4 * i + 3]; }
        if (DBG_PROBE == 4) { float mx = 0.f; for (int i = 0; i < 2048; ++i) mx = fmaxf(mx, pp[4 * i]); v = 100.f * mx; }
        else { v = (DBG_PROBE == 1 ? s0 : DBG_PROBE == 2 ? s1 : s2) / s3 * 1e-3f; v = exp2f(rintf(log2f(v) * 4.f) * 0.25f); }
    }
    for (size_t i = (size_t)blockIdx.x * 512 + threadIdx.x; i < (size_t)NBATCH * SEQ * DM; i += (size_t)gridDim.x * 512) o[i] = v;
}
extern "C" void kernel_launch(void* const* d_in, const int* in_sizes, int n_in, void* d_out, int out_size, void* d_ws, size_t ws_size, hipStream_t stream) {
    static int grid = 0;
    if (grid == 0) {
        if (n_in != 33 || out_size != NBATCH * SEQ * DM || ws_size < WS_END2) { fprintf(stderr, "kernel_launch: unexpected shapes (n_in %d out %d ws %zu)\n", n_in, out_size, ws_size); grid = -1; return; }
        int dev = 0, cus = 0, per_cu = 0;
        if (hipGetDevice(&dev) != hipSuccess || hipDeviceGetAttribute(&cus, hipDeviceAttributeMultiprocessorCount, dev) != hipSuccess) { grid = -1; return; }
        if (hipFuncSetAttribute((const void*)mk_fwd, hipFuncAttributeMaxDynamicSharedMemorySize, LDS_BYTES) != hipSuccess) { fprintf(stderr, "kernel_launch: hipFuncSetAttribute failed\n"); grid = -1; return; }
        if (hipOccupancyMaxActiveBlocksPerMultiprocessor(&per_cu, (const void*)mk_fwd, NWAVES * 64, LDS_BYTES) != hipSuccess || per_cu < 1) { fprintf(stderr, "kernel_launch: occupancy query says %d\n", per_cu); (void)hipGetLastError(); grid = -1; return; }
        grid = cus;
    }
    if (grid < 0) return;
    if (hipMemsetAsync((char*)d_ws + WS_CTL, 0, CTL_ZERO_BYTES, stream) != hipSuccess) return;
    Args a{};
    for (int i = 0; i < 33; ++i) a.in[i] = (const float*)d_in[i];
    a.out = (float*)d_out; a.ws = (unsigned char*)d_ws;
#if MK_N_LAUNCHES == 1
    a.ph_lo = 0; a.ph_hi = NPHASE;
    hipLaunchKernelGGL(mk_fwd, dim3(grid), dim3(NWAVES * 64), LDS_BYTES, stream, a);
#else
    if (DBG_PROBE != 5) for (int p = 0; p < NPHASE; ++p) { a.ph_lo = p; a.ph_hi = p + 1; hipLaunchKernelGGL(mk_fwd, dim3(grid), dim3(NWAVES * 64), LDS_BYTES, stream, a); }
    if (DBG_PROBE) hipLaunchKernelGGL(dbg_fill, dim3(1024), dim3(512), 0, stream, (const float*)((char*)d_ws + WS_CTL + CTL_PROBE_OFF), (float*)d_out);
#endif
}
```

```cpp
#include <hip/hip_runtime.h>
#include <cstdio>
#include <cstdint>

#ifndef MK_N_LAUNCHES
#define MK_N_LAUNCHES 1
#endif

#ifndef DBG_SKIP
#define DBG_SKIP 0
#endif
#ifndef DBG_PROBE
#define DBG_PROBE 0
#endif
#ifndef DBG_DRY
#define DBG_DRY 1
#endif
#ifndef DBG_REPEAT
#define DBG_REPEAT -1
#endif
namespace pg8 {
#define PG8_LAS __attribute__((address_space(3)))
typedef unsigned short bf16_t;
typedef short bf16x8 __attribute__((ext_vector_type(8)));
typedef float f32x4 __attribute__((ext_vector_type(4)));
typedef unsigned u32x4 __attribute__((ext_vector_type(4)));
constexpr int BM = 256, BK = 64, HALF = 128, HTB = HALF * BK * 2  , STAGE_BYTES = 8 * HTB, NXCD = 8, WGM = 8;

__host__ __device__ __forceinline__ int lds_byte(int r, int c) { const int st = (r >> 4) * 2 + (c >> 5), rr = r & 15, cc = c & 31, ob = rr * 64 + cc * 2; return st * 1024 + (ob ^ (((ob >> 9) & 1) << 5)); }
__host__ __device__ __forceinline__ void stage_rc(int b, int& R, int& C) { const int st = b / 1024, sb = b % 1024, swz = sb ^ (((sb >> 9) & 1) << 5); R = (st >> 1) * 16 + swz / 64; C = (st & 1) * 32 + (swz % 64) / 2; }
__host__ __device__ __forceinline__ int perm32(int rho) { const int n = rho >> 4, i = rho & 15; return 8 * (i >> 2) + 4 * n + (i & 3); }

struct Unit { int pm, pn; };
struct Gemm { const bf16_t* A; const bf16_t* Bt; int M, N, K; };

struct StaticOrder {
    int nM, nN, nwg, G, c;
    __host__ __device__ void init(int M, int N, int G_, int c_) { nM = M / BM; nN = N / BM; nwg = nM * nN; G = G_; c = c_; }
    __host__ __device__ bool next(int i, Unit& u) const {
        const long L = (long)i * G + c; if (L >= nwg) return false;
        int wgid = (int)L; { const int q = nwg / NXCD, r = nwg % NXCD, xcd = wgid % NXCD, off = wgid / NXCD; wgid = (xcd < r ? xcd * (q + 1) : r * (q + 1) + (xcd - r) * q) + off; }
        const int nig = WGM * nN, gid = wgid / nig, fm = gid * WGM, gsz = (nM - fm) < WGM ? (nM - fm) : WGM;
        u.pm = fm + ((wgid % nig) % gsz); u.pn = (wgid % nig) / gsz; return true;
    }
    __device__ __forceinline__ void a_ready(const Unit&) const {}
    __device__ __forceinline__ void done(const Unit&) const {}
};
__device__ __forceinline__ int opaque_lane() { int l; asm volatile("v_mbcnt_lo_u32_b32 %0, -1, 0\n\tv_mbcnt_hi_u32_b32 %0, -1, %0" : "=v"(l)); return l; }
typedef __bf16 bf16x2c __attribute__((ext_vector_type(2)));
__device__ __forceinline__ unsigned cvt_pk_bf16(float lo, float hi) { const bf16x2c v = {(__bf16)lo, (__bf16)hi}; return __builtin_bit_cast(unsigned, v); }
template <class Epi, class Sched, bool ALIGN_EPI = false, bool SP2 = false>
__device__ __forceinline__ void gemm_phase(PG8_LAS unsigned char* lds, const Gemm g, const Sched& S, const Epi& E, const int wave_s) {
    const int lane_ = opaque_lane();
    const int wid = wave_s, lane = lane_, tid = wid * 64 + lane, wr = wid >> 2, wc = wid & 3, fr = lane & 15, fq = lane >> 4;
    const int K = g.K, nt = K / BK;
    unsigned voffA[2], voffB[2];
#pragma unroll
    for (int i = 0; i < 2; ++i) { int R, C; stage_rc(tid * 16 + i * 8192, R, C); const int Rb = Epi::PERM ? ((R & ~31) + perm32(R & 31)) : R;
        voffA[i] = (unsigned)(R * K + C) * 2u; voffB[i] = (unsigned)(Rb * K + C) * 2u; }
    const size_t kstep = (size_t)(BK * 2);
    const size_t hstep = (size_t)HALF * K * 2;
    const size_t tstep = 2 * hstep;
    const unsigned ldsw = (unsigned)wid * 1024u;
    const int aoff = lds_byte(wr * 64 + fr, fq * 8), boff = lds_byte(wc * 32 + fr, fq * 8);
#define PG8_SA(b, h) (((b) * 2 + (h)) * HTB)
#define PG8_SB(b, h) ((4 + (b) * 2 + (h)) * HTB)
#define PG8_STAGE(bufoff, gbase, voff) do { _Pragma("unroll") for (int _i = 0; _i < 2; ++_i) \
        __builtin_amdgcn_global_load_lds((const unsigned*)((const char*)(gbase) + (voff)[_i]), (PG8_LAS unsigned*)(lds + (bufoff) + ldsw + _i * 8192), 16, 0, 0); } while (0)
#define PG8_LDA(dst, b, h) do { _Pragma("unroll") for (int m = 0; m < 4; ++m) _Pragma("unroll") for (int k = 0; k < 2; ++k) dst[m][k] = *(const PG8_LAS bf16x8*)(lds + PG8_SA(b, h) + aoff + m * 2048 + k * 1024); } while (0)
#define PG8_LDB(dst, b, h) do { _Pragma("unroll") for (int n = 0; n < 2; ++n) _Pragma("unroll") for (int k = 0; k < 2; ++k) dst[n][k] = *(const PG8_LAS bf16x8*)(lds + PG8_SB(b, h) + boff + n * 2048 + k * 1024); } while (0)
#define PG8_MMA(ai, bj, At, Bt) do { __builtin_amdgcn_s_setprio(1); _Pragma("unroll") for (int m = 0; m < 4; ++m) _Pragma("unroll") for (int n = 0; n < 2; ++n) _Pragma("unroll") for (int k = 0; k < 2; ++k) \
        acc[ai][bj][m][n] = __builtin_amdgcn_mfma_f32_16x16x32_bf16(Bt[n][k], At[m][k], acc[ai][bj][m][n], 0, 0, 0); __builtin_amdgcn_s_setprio(0); } while (0)
#define PG8_WAIT_V(n) asm volatile("s_waitcnt vmcnt(" #n ")" ::: "memory")
#define PG8_WAIT_L(n) asm volatile("s_waitcnt lgkmcnt(" #n ")" ::: "memory")
#define PG8_BAR __builtin_amdgcn_s_barrier()
#define PG8_SCHED __builtin_amdgcn_sched_barrier(0)
    Unit cur, nxt; int ui = 0;
    if (!S.next(0, cur)) return;
    f32x4 acc[2][2][4][2];
#pragma unroll
    for (int a = 0; a < 2; ++a)
#pragma unroll
        for (int b = 0; b < 2; ++b)
#pragma unroll
            for (int m = 0; m < 4; ++m)
#pragma unroll
                for (int n = 0; n < 2; ++n) acc[a][b][m][n] = (f32x4){0.f, 0.f, 0.f, 0.f};
    bf16x8 At[4][2], B0[2][2], B1[2][2];
    const char* cA = (const char*)g.A + (size_t)cur.pm * tstep; const char* cB = (const char*)g.Bt + (size_t)cur.pn * tstep;
    S.a_ready(cur);
    if constexpr (SP2) {
        PG8_STAGE(PG8_SB(0, 0), cB, voffB); PG8_STAGE(PG8_SB(0, 1), cB + hstep, voffB); PG8_STAGE(PG8_SA(0, 0), cA, voffA); PG8_STAGE(PG8_SA(0, 1), cA + hstep, voffA);
        if (wr == 1) PG8_BAR;
        PG8_WAIT_V(2); PG8_BAR;
        PG8_STAGE(PG8_SB(1, 0), cB + kstep, voffB); PG8_STAGE(PG8_SA(1, 0), cA + kstep, voffA); PG8_STAGE(PG8_SB(1, 1), cB + hstep + kstep, voffB);
        PG8_WAIT_V(6); PG8_BAR;
    } else {
        PG8_STAGE(PG8_SB(0, 0), cB, voffB); PG8_STAGE(PG8_SA(0, 0), cA, voffA); PG8_STAGE(PG8_SB(0, 1), cB + hstep, voffB); PG8_STAGE(PG8_SA(0, 1), cA + hstep, voffA);
        if (wr == 1) PG8_BAR;
        PG8_WAIT_V(4); PG8_BAR;
        PG8_STAGE(PG8_SB(1, 0), cB + kstep, voffB); PG8_STAGE(PG8_SA(1, 0), cA + kstep, voffA); PG8_STAGE(PG8_SB(1, 1), cB + hstep + kstep, voffB);
        PG8_WAIT_V(6); PG8_BAR;
    }
    for (;;) {
        const bool has_next = S.next(ui + 1, nxt);
        const char* nA = has_next ? (const char*)g.A + (size_t)nxt.pm * tstep : cA; const char* nB = has_next ? (const char*)g.Bt + (size_t)nxt.pn * tstep : cB;
        for (int t = 0; t < nt; t += 2) {
            const bool last = (t == nt - 2);
            const char* a1 = cA + (size_t)(t + 1) * kstep;
            const char* a2 = last ? nA : cA + (size_t)(t + 2) * kstep; const char* b2 = last ? nB : cB + (size_t)(t + 2) * kstep;
            const char* a3 = a2 + kstep; const char* b3 = b2 + kstep;
            if (last && has_next) S.a_ready(nxt);
            if constexpr (SP2) {
            PG8_LDB(B0, 0, 0); PG8_LDB(B1, 0, 1); PG8_SCHED; PG8_LDA(At, 0, 0); PG8_STAGE(PG8_SA(1, 1), a1 + hstep, voffA);
            PG8_WAIT_V(8); PG8_WAIT_L(0); PG8_BAR; PG8_MMA(0, 0, At, B0); PG8_MMA(0, 1, At, B1); PG8_BAR; PG8_SCHED;
            PG8_LDA(At, 0, 1); PG8_STAGE(PG8_SB(0, 0), b2, voffB); PG8_STAGE(PG8_SB(0, 1), b2 + hstep, voffB); PG8_STAGE(PG8_SA(0, 0), a2, voffA);
            PG8_WAIT_V(8); PG8_WAIT_L(0); PG8_BAR; PG8_MMA(1, 0, At, B0); PG8_MMA(1, 1, At, B1); PG8_BAR; PG8_SCHED;
            PG8_LDB(B0, 1, 0); PG8_LDB(B1, 1, 1); PG8_SCHED; PG8_LDA(At, 1, 0); PG8_STAGE(PG8_SA(0, 1), a2 + hstep, voffA);
            PG8_WAIT_V(8); PG8_WAIT_L(0); PG8_BAR; PG8_MMA(0, 0, At, B0); PG8_MMA(0, 1, At, B1); PG8_BAR; PG8_SCHED;
            PG8_LDA(At, 1, 1); PG8_STAGE(PG8_SB(1, 0), b3, voffB); PG8_STAGE(PG8_SB(1, 1), b3 + hstep, voffB); PG8_STAGE(PG8_SA(1, 0), a3, voffA);
            PG8_WAIT_V(8); PG8_WAIT_L(0); PG8_BAR; PG8_MMA(1, 0, At, B0); PG8_MMA(1, 1, At, B1); PG8_BAR; PG8_SCHED;
            } else {
            PG8_LDB(B0, 0, 0); PG8_SCHED; PG8_LDA(At, 0, 0); PG8_STAGE(PG8_SA(1, 1), a1 + hstep, voffA);
            PG8_WAIT_L(8); PG8_BAR; PG8_WAIT_L(0); PG8_MMA(0, 0, At, B0); PG8_BAR; PG8_SCHED;
            PG8_LDB(B1, 0, 1); PG8_STAGE(PG8_SB(0, 0), b2, voffB);
            PG8_BAR; PG8_WAIT_L(0); PG8_MMA(0, 1, At, B1); PG8_BAR;
            PG8_LDA(At, 0, 1); PG8_STAGE(PG8_SA(0, 0), a2, voffA);
            PG8_BAR; PG8_WAIT_L(0); PG8_MMA(1, 0, At, B0); PG8_BAR; PG8_SCHED;
            PG8_STAGE(PG8_SB(0, 1), b2 + hstep, voffB);
            PG8_WAIT_V(6); PG8_BAR; PG8_MMA(1, 1, At, B1); PG8_BAR;
            PG8_LDB(B0, 1, 0); PG8_SCHED; PG8_LDA(At, 1, 0); PG8_STAGE(PG8_SA(0, 1), a2 + hstep, voffA);
            PG8_WAIT_L(8); PG8_BAR; PG8_WAIT_L(0); PG8_MMA(0, 0, At, B0); PG8_BAR; PG8_SCHED;
            PG8_LDB(B1, 1, 1); PG8_STAGE(PG8_SB(1, 0), b3, voffB);
            PG8_BAR; PG8_WAIT_L(0); PG8_MMA(0, 1, At, B1); PG8_BAR;
            PG8_LDA(At, 1, 1); PG8_STAGE(PG8_SA(1, 0), a3, voffA);
            PG8_BAR; PG8_WAIT_L(0); PG8_MMA(1, 0, At, B0); PG8_BAR; PG8_SCHED;
            PG8_STAGE(PG8_SB(1, 1), b3 + hstep, voffB);
            PG8_WAIT_V(6); PG8_BAR; PG8_MMA(1, 1, At, B1); PG8_BAR;
            }
        }
        if constexpr (ALIGN_EPI) { if (wr == 0) PG8_BAR; }
        if constexpr (!Epi::AFTER_DRAIN) { const int le_ = opaque_lane(); E(acc, cur, wr, wc, le_ & 15, le_ >> 4); S.done(cur); }
        if (!has_next) break;
#pragma unroll
        for (int a = 0; a < 2; ++a)
#pragma unroll
            for (int b = 0; b < 2; ++b)
#pragma unroll
                for (int m = 0; m < 4; ++m)
#pragma unroll
                    for (int n = 0; n < 2; ++n) acc[a][b][m][n] = (f32x4){0.f, 0.f, 0.f, 0.f};
        cur = nxt; cA = nA; cB = nB; ++ui;
        if constexpr (ALIGN_EPI) { if (wr == 1) PG8_BAR; }
    }
    PG8_WAIT_V(0);
    if constexpr (!ALIGN_EPI) { if (wr == 0) PG8_BAR; }
    PG8_BAR;
    if constexpr (Epi::AFTER_DRAIN) { E.fused(acc, cur, wr, wc, fr, fq, lds, wid, lane); S.done(cur); }
#undef PG8_SA
#undef PG8_SB
#undef PG8_STAGE
#undef PG8_LDA
#undef PG8_LDB
#undef PG8_MMA
#undef PG8_WAIT_V
#undef PG8_WAIT_L
#undef PG8_BAR
#undef PG8_SCHED
}
}

constexpr int NWAVES = 8;
constexpr int DM = 2048, NBATCH = 2, SEQ = 8192, CTXL = 256, TPB = CTXL + SEQ  , MALL = NBATCH * TPB  ;
constexpr int NLAYER = 2;
constexpr int RW = 1024, NH = 16;
constexpr int RWC = 3392, INA = 4192, INA_P = 4352, INC = 8288;
constexpr int C_WD = 3072, C_AD = 3200, C_GD = 3328, C_QC = 3392, C_KVC = 3904, C_KR = 4160;
constexpr int QKD = 96, NQ = NH * QKD  , NKV = NH * 128  ;
constexpr int NEXP = 16384;
constexpr int RREC = 9 * 64;
constexpr float NORM_EPS = 1e-6f;

constexpr size_t MiB = 1u << 20;
constexpr size_t WS_CTL = 0, CTL_ZERO_BYTES = 1 * MiB;
constexpr size_t CTL_MOD_OFF = 256 * 1024;
constexpr size_t WS_ROPE = 1 * MiB;
constexpr size_t WS_WUP = 3 * MiB, WS_AUP = WS_WUP + 512 * 1024, WS_GUP = 4 * MiB;
constexpr size_t WS_WUQ = 5 * MiB, WS_WUKV = 8 * MiB, WS_WA = 10 * MiB, WS_WB = 18 * MiB, WS_WO = 26 * MiB, WS_WQK = 42 * MiB, WS_WGA = 58 * MiB, WS_WGB = 74 * MiB, WS_WINA = 90 * MiB;
constexpr size_t WS_X = 124 * MiB, WS_H = 256 * MiB, WS_DYN = 322 * MiB;
constexpr size_t WS_PA = WS_DYN;
constexpr size_t WS_RI = 463 * MiB;
constexpr size_t WS_GG = 760 * MiB;
constexpr size_t WS_BON = 826 * MiB;
constexpr size_t WS_QN = 831 * MiB, WS_KVN = 848 * MiB;
constexpr size_t WS_Q = 857 * MiB, WS_K = 907 * MiB, WS_V = 957 * MiB, WS_END = 990 * MiB;
constexpr size_t WS_Y = WS_DYN;
constexpr size_t WS_YA = 388 * MiB, WS_YB = 421 * MiB;
constexpr size_t WS_T1 = 463 * MiB, WS_T2 = 529 * MiB;
constexpr size_t WS_PU = 600 * MiB, WS_PV = 664 * MiB;
constexpr size_t WS_CA = 600 * MiB, WS_CB = 608 * MiB;
#ifndef CTX_SPLIT
#define CTX_SPLIT (MK_N_LAUNCHES == 1)
#endif
constexpr size_t WS_P4 = 990 * MiB, WS_P4S = 1022 * MiB, WS_END2 = 1023 * MiB;
constexpr size_t WS_SC = WS_DYN;
static_assert(WS_PA + (size_t)MALL * INA_P * 2 <= WS_RI && WS_RI + (size_t)NBATCH * NH * TPB * RREC * 2 <= WS_GG && WS_GG + (size_t)2 * MALL * RW * 2 <= WS_BON, "ws map 1");
static_assert(WS_BON + (size_t)2 * MALL * 32 * 4 <= WS_QN && WS_QN + (size_t)MALL * 512 * 2 <= WS_KVN && WS_KVN + (size_t)MALL * 256 * 2 <= WS_Q, "ws map 2");
static_assert(WS_Q + (size_t)NBATCH * NH * TPB * QKD * 2 <= WS_K && WS_K + (size_t)NBATCH * NH * TPB * QKD * 2 <= WS_V && WS_V + (size_t)NBATCH * NH * TPB * 64 * 2 <= WS_END, "ws map 3");
static_assert(WS_Y + (size_t)2 * MALL * RW * 2 <= WS_YA && WS_YA + (size_t)MALL * RW * 2 <= WS_YB && WS_YB + (size_t)MALL * RW * 2 <= WS_RI, "ws map 4");
static_assert(WS_T1 + (size_t)MALL * DM * 2 <= WS_T2 && WS_T2 + (size_t)MALL * DM * 2 <= WS_PU && WS_PU + (size_t)NEXP * DM * 2 <= WS_PV && WS_PV + (size_t)NEXP * DM * 2 <= WS_GG, "ws map 5");
static_assert(WS_SC + (size_t)MALL * DM * 4 <= WS_T1 && WS_X + (size_t)MALL * DM * 4 <= WS_H && WS_H + (size_t)MALL * DM * 2 <= WS_DYN, "ws map 6");
static_assert(WS_WINA + (size_t)NLAYER * INA_P * DM * 2 <= WS_X, "ws map 7");
constexpr size_t CTL_PROBE_OFF = 640 * 1024;
constexpr int CW_BAR = 4096;

constexpr int RING_BYTES = 131072;
constexpr int LDSCTL_OFF = RING_BYTES, MISC_OFF = LDSCTL_OFF + 320;
constexpr int LDS_BYTES = 147456;

#define GAS __attribute__((address_space(1)))
#define LAS __attribute__((address_space(3)))
typedef unsigned short bf16;
typedef unsigned v4u __attribute__((ext_vector_type(4)));
typedef unsigned v2u __attribute__((ext_vector_type(2)));
typedef float f32x4 __attribute__((ext_vector_type(4)));
typedef float f32x2 __attribute__((ext_vector_type(2)));
typedef float f32x16 __attribute__((ext_vector_type(16)));
typedef short bf16x8 __attribute__((ext_vector_type(8)));
typedef short s16x4 __attribute__((ext_vector_type(4)));
typedef __bf16 bf16x2v __attribute__((ext_vector_type(2)));
typedef __bf16 bf16x8v __attribute__((ext_vector_type(8)));
typedef GAS unsigned gu32;
#define RLX_AGENT __ATOMIC_RELAXED, __HIP_MEMORY_SCOPE_AGENT
#define LDS_WAIT() asm volatile("s_waitcnt lgkmcnt(0)" ::: "memory")
#define VM_WAIT() asm volatile("s_waitcnt vmcnt(0)" ::: "memory")
__device__ __forceinline__ unsigned f2bf(float f) { unsigned u = __builtin_bit_cast(unsigned, f); return (u + 0x7fffu + ((u >> 16) & 1u)) >> 16; }
__device__ __forceinline__ unsigned pk2(float lo, float hi) { return pg8::cvt_pk_bf16(lo, hi); }
__device__ __forceinline__ float bflo(unsigned w) { return __builtin_bit_cast(float, w << 16); }
__device__ __forceinline__ float bfhi(unsigned w) { return __builtin_bit_cast(float, w & 0xffff0000u); }
__device__ __forceinline__ float bf1(bf16 h) { return __builtin_bit_cast(float, (unsigned)h << 16); }
__device__ __forceinline__ float sigmoidf_(float x) { return __builtin_amdgcn_rcpf(1.0f + __expf(-x)); }
template <int CTRL> __device__ __forceinline__ float dpp_add(float x) {
    return x + __builtin_bit_cast(float, __builtin_amdgcn_update_dpp(0, __builtin_bit_cast(int, x), CTRL, 0xf, 0xf, true));
}
__device__ __forceinline__ float red16(float x) {
    x = dpp_add<0xB1>(x);
    x = dpp_add<0x4E>(x);
    x = dpp_add<0x141>(x);
    x = dpp_add<0x140>(x);
    return x;
}
template <int CTRL, int RM> __device__ __forceinline__ float dpp_max(float x) {
    return fmaxf(x, __builtin_bit_cast(float, __builtin_amdgcn_update_dpp(__builtin_bit_cast(int, x), __builtin_bit_cast(int, x), CTRL, RM, 0xf, false)));
}
template <int CTRL, int RM> __device__ __forceinline__ float dpp_sum(float x) {
    return x + __builtin_bit_cast(float, __builtin_amdgcn_update_dpp(0, __builtin_bit_cast(int, x), CTRL, RM, 0xf, false));
}
__device__ __forceinline__ float wave_max_u(float x) {
    x = dpp_max<0xB1, 0xf>(x); x = dpp_max<0x4E, 0xf>(x); x = dpp_max<0x141, 0xf>(x); x = dpp_max<0x140, 0xf>(x);
    x = dpp_max<0x142, 0xa>(x); x = dpp_max<0x143, 0xc>(x);
    return __builtin_bit_cast(float, __builtin_amdgcn_readlane(__builtin_bit_cast(int, x), 63));
}
__device__ __forceinline__ float wave_sum_u(float x) {
    x = dpp_sum<0xB1, 0xf>(x); x = dpp_sum<0x4E, 0xf>(x); x = dpp_sum<0x141, 0xf>(x); x = dpp_sum<0x140, 0xf>(x);
    x = dpp_sum<0x142, 0xa>(x); x = dpp_sum<0x143, 0xc>(x);
    return __builtin_bit_cast(float, __builtin_amdgcn_readlane(__builtin_bit_cast(int, x), 63));
}
__device__ __forceinline__ float wave_sum(float v) { return wave_sum_u(v); }
__device__ __forceinline__ float bpermf(int srclane, float v) { return __builtin_bit_cast(float, __builtin_amdgcn_ds_bpermute(srclane << 2, __builtin_bit_cast(int, v))); }
__device__ __forceinline__ int bpermi(int srclane, int v) { return __builtin_amdgcn_ds_bpermute(srclane << 2, v); }

#define XB_TMO      128
#define XB_XCNT(j)  (256  + 64 * (j))
#define XB_XSUB(j)  (1280 + 64 * (j))
#define XB_XGEN(j)  (2304 + 64 * (j))
#define XB_TOP      3328
#define XB_TOPGEN   3392
#define XCD_BAR_WORDS 3456
#define XB_SPIN_CAP (1u << 20)

__device__ __forceinline__ unsigned xb_ld(unsigned* p)              { return __hip_atomic_load(p, __ATOMIC_RELAXED, __HIP_MEMORY_SCOPE_AGENT); }
__device__ __forceinline__ unsigned xb_add(unsigned* p, unsigned v) { return __hip_atomic_fetch_add(p, v, __ATOMIC_RELAXED, __HIP_MEMORY_SCOPE_AGENT); }
__device__ __forceinline__ unsigned xb_xcc_id() { return (unsigned)__builtin_amdgcn_s_getreg((3 << 11) | 20) & 0xFu; }
#define XB_SPIN(cond, bar) do { unsigned _sp = 0; while (cond) { __builtin_amdgcn_s_sleep(1); \
    if ((++_sp & 255u) == 0u) { if (xb_ld(&(bar)[XB_TMO])) break; if (_sp > XB_SPIN_CAP) { atomicAdd(&(bar)[XB_TMO], 1u); break; } } } } while (0)

struct XcdBarrier { unsigned* bar; unsigned x; volatile LAS unsigned* st; };

__device__ __forceinline__ XcdBarrier xcd_barrier_post(unsigned* bar, volatile LAS unsigned* st, bool t0) {
    XcdBarrier b; b.bar = bar; b.x = xb_xcc_id(); b.st = st;
    if (t0) (void)xb_add(&bar[XB_XCNT(b.x)], 1u);
    return b;
}
__device__ __forceinline__ void xcd_barrier_complete(unsigned* bar, unsigned x, unsigned& nloc, unsigned& nx) {
    const unsigned G = gridDim.x * gridDim.y * gridDim.z;
    unsigned sum, cnt, mine, sp = 0u;
    for (;;) {
        sum = 0u; cnt = 0u; mine = 0u;
#pragma unroll
        for (unsigned j = 0; j < 16; ++j) { const unsigned c = xb_ld(&bar[XB_XCNT(j)]); sum += c; cnt += (c > 0u) ? 1u : 0u; mine = (j == x) ? c : mine; }
        if (sum == G) break;
        __builtin_amdgcn_s_sleep(1);
        if ((++sp & 255u) == 0u) { if (xb_ld(&bar[XB_TMO])) break; if (sp > XB_SPIN_CAP) { atomicAdd(&bar[XB_TMO], 1u); break; } }
    }
    nloc = mine > 0u ? mine : 1u; nx = cnt > 0u ? cnt : 1u;
}
__device__ __forceinline__ void xcd_barrier(const XcdBarrier& b, bool t0) {
    asm volatile("s_waitcnt vmcnt(0)" ::: "memory");
    __syncthreads();
    if (t0) {
        unsigned* bar = b.bar;
        __builtin_amdgcn_s_waitcnt(0);
        unsigned nloc = b.st[0], nx = b.st[1];
        if (nloc == 0u) { xcd_barrier_complete(bar, b.x, nloc, nx); b.st[0] = nloc; b.st[1] = nx; }
        const unsigned old = xb_add(&bar[XB_XSUB(b.x)], 1u);
        const unsigned gen = old / nloc;
        if (old + 1u == (gen + 1u) * nloc) {
            __builtin_amdgcn_fence(__ATOMIC_RELEASE, "agent");
            asm volatile("s_waitcnt vmcnt(0)" ::: "memory");
            const unsigned og = xb_add(&bar[XB_TOP], 1u);
            const unsigned tg = og / nx;
            if (og + 1u == (tg + 1u) * nx) xb_add(&bar[XB_TOPGEN], 1u);
            else XB_SPIN(xb_ld(&bar[XB_TOPGEN]) == tg, bar);
            __builtin_amdgcn_fence(__ATOMIC_ACQUIRE, "agent");
            xb_add(&bar[XB_XGEN(b.x)], 1u);
            asm volatile("s_waitcnt vmcnt(0)" ::: "memory");
        } else {
            XB_SPIN(xb_ld(&bar[XB_XGEN(b.x)]) == gen, bar);
            __builtin_amdgcn_fence(__ATOMIC_ACQUIRE, "agent");
            asm volatile("s_waitcnt vmcnt(0)" ::: "memory");
        }
    }
    __syncthreads();
}

struct Frame {
    LAS unsigned char* lds;
    unsigned char* ws;
    const float* const* in;
    int tid, lane, wave;
    int vcu, G;
};
struct Args { const float* in[33]; float* out; unsigned char* ws; int ph_lo, ph_hi; };


namespace pg8 {
typedef unsigned u32x4 __attribute__((ext_vector_type(4)));
struct RowOrder : StaticOrder {
    int lat;
    __host__ __device__ void init_rows(int lat_, int N, int G_, int c_) { lat = lat_; init(lat_ ? NBATCH * SEQ : MALL, N, G_, c_); }
    __host__ __device__ bool next(int i, Unit& u) const { if (!StaticOrder::next(i, u)) return false; if (lat) u.pm = 33 * (u.pm >> 5) + 1 + (u.pm & 31); return true; }
};
#define EPI_LOOP_ROWS for (int ai = 0; ai < 2; ++ai) _Pragma("unroll") for (int m = 0; m < 4; ++m)
#define EPI_PIN asm volatile("" ::: "memory")

struct EpiStoreBf16 {
    static constexpr bool PERM = true, AFTER_DRAIN = false;
    bf16_t* O; int ldc;
    __device__ __forceinline__ void operator()(const f32x4 (&acc)[2][2][4][2], const Unit& u, int wr, int wc, int fr, int fq) const {
        const int row0 = u.pm * BM + wr * 64 + fr, col0 = u.pn * BM + wc * 32 + 8 * fq;
#pragma unroll
        EPI_LOOP_ROWS { bf16_t* rowp = O + (size_t)(row0 + ai * HALF + m * 16) * ldc + col0;
#pragma unroll
            for (int bj = 0; bj < 2; ++bj) { const f32x4 v0 = acc[ai][bj][m][0], v1 = acc[ai][bj][m][1];
                u32x4 w; w.x = cvt_pk_bf16(v0[0], v0[1]); w.y = cvt_pk_bf16(v0[2], v0[3]); w.z = cvt_pk_bf16(v1[0], v1[1]); w.w = cvt_pk_bf16(v1[2], v1[3]);
                *(u32x4*)(rowp + bj * HALF) = w; } }
    }
};
struct EpiGate {
    static constexpr bool PERM = true, AFTER_DRAIN = false;
    bf16_t* O; int ldc; const float* bias;
    __device__ __forceinline__ void operator()(const f32x4 (&acc)[2][2][4][2], const Unit& u, int wr, int wc, int fr, int fq) const {
        const int row0 = u.pm * BM + wr * 64 + fr, col0 = u.pn * BM + wc * 32 + 8 * fq;
        f32x4 bv[2][2];
#pragma unroll
        for (int bj = 0; bj < 2; ++bj)
#pragma unroll
            for (int n = 0; n < 2; ++n) bv[bj][n] = *(const f32x4*)(bias + col0 + bj * HALF + 4 * n);
#pragma unroll
        EPI_LOOP_ROWS { EPI_PIN; bf16_t* rowp = O + (size_t)(row0 + ai * HALF + m * 16) * ldc + col0;
#pragma unroll
            for (int bj = 0; bj < 2; ++bj) { f32x4 v0 = acc[ai][bj][m][0] + bv[bj][0], v1 = acc[ai][bj][m][1] + bv[bj][1];
#pragma unroll
                for (int e = 0; e < 4; ++e) { v0[e] = __builtin_amdgcn_rcpf(1.0f + __expf(-v0[e])); v1[e] = __builtin_amdgcn_rcpf(1.0f + __expf(-v1[e])); }
                u32x4 w; w.x = cvt_pk_bf16(v0[0], v0[1]); w.y = cvt_pk_bf16(v0[2], v0[3]); w.z = cvt_pk_bf16(v1[0], v1[1]); w.w = cvt_pk_bf16(v1[2], v1[3]);
                *(u32x4*)(rowp + bj * HALF) = w; } }
    }
};
__device__ __forceinline__ float bf_lo(unsigned w) { return __builtin_bit_cast(float, w << 16); }
__device__ __forceinline__ float bf_hi(unsigned w) { return __builtin_bit_cast(float, w & 0xffff0000u); }
struct EpiMulAdd {
    static constexpr bool PERM = true, AFTER_DRAIN = false;
    bf16_t* O; const bf16_t* Gt; const bf16_t* Ad; int ldc;
    __device__ __forceinline__ void operator()(const f32x4 (&acc)[2][2][4][2], const Unit& u, int wr, int wc, int fr, int fq) const {
        const int row0 = u.pm * BM + wr * 64 + fr, col0 = u.pn * BM + wc * 32 + 8 * fq;
#pragma unroll
        EPI_LOOP_ROWS { EPI_PIN; const size_t ro = (size_t)(row0 + ai * HALF + m * 16) * ldc + col0;
#pragma unroll
            for (int bj = 0; bj < 2; ++bj) { const f32x4 v0 = acc[ai][bj][m][0], v1 = acc[ai][bj][m][1];
                const u32x4 g = *(const u32x4*)(Gt + ro + bj * HALF);
                float o[8];
                o[0] = bf_lo(g.x) * v0[0]; o[1] = bf_hi(g.x) * v0[1]; o[2] = bf_lo(g.y) * v0[2]; o[3] = bf_hi(g.y) * v0[3];
                o[4] = bf_lo(g.z) * v1[0]; o[5] = bf_hi(g.z) * v1[1]; o[6] = bf_lo(g.w) * v1[2]; o[7] = bf_hi(g.w) * v1[3];
                if (Ad) { const u32x4 a = *(const u32x4*)(Ad + ro + bj * HALF);
                    o[0] += bf_lo(a.x); o[1] += bf_hi(a.x); o[2] += bf_lo(a.y); o[3] += bf_hi(a.y); o[4] += bf_lo(a.z); o[5] += bf_hi(a.z); o[6] += bf_lo(a.w); o[7] += bf_hi(a.w); }
                u32x4 w; w.x = cvt_pk_bf16(o[0], o[1]); w.y = cvt_pk_bf16(o[2], o[3]); w.z = cvt_pk_bf16(o[4], o[5]); w.w = cvt_pk_bf16(o[6], o[7]);
                *(u32x4*)(O + ro + bj * HALF) = w; } }
    }
};
struct EpiResid {
    static constexpr bool PERM = true, AFTER_DRAIN = false;
    bf16_t* X; const float* gate;
    const float* xin; const float* cin;
    __device__ __forceinline__ void operator()(const f32x4 (&acc)[2][2][4][2], const Unit& u, int wr, int wc, int fr, int fq) const {
        const int col0 = u.pn * BM + wc * 32 + 8 * fq;
        const int bb = u.pm / 33, pt = u.pm - bb * 33, mr = (pt == 0) ? 2 : bb;
        const float* gp = gate + (size_t)mr * 12288 + col0;
        const float* sbase = xin ? (pt == 0 ? cin + (size_t)bb * CTXL * DM : xin + ((size_t)bb * SEQ + (size_t)(pt - 1) * BM) * DM) : nullptr;
        f32x4 gv[2][2];
#pragma unroll
        for (int bj = 0; bj < 2; ++bj)
#pragma unroll
            for (int n = 0; n < 2; ++n) gv[bj][n] = *(const f32x4*)(gp + bj * HALF + n * 4);
#pragma unroll
        EPI_LOOP_ROWS { EPI_PIN; const int rl = wr * 64 + fr + ai * HALF + m * 16; bf16_t* rowp = X + (size_t)(u.pm * BM + rl) * DM + col0;
#pragma unroll
            for (int bj = 0; bj < 2; ++bj) { f32x4 s0, s1;
                if (sbase) { const float* srow = sbase + (size_t)rl * DM + col0 + bj * HALF; s0 = *(const f32x4*)srow; s1 = *(const f32x4*)(srow + 4); }
                else { const u32x4 w = *(const u32x4*)(rowp + bj * HALF);
                    s0 = (f32x4){__builtin_bit_cast(float, w.x << 16), __builtin_bit_cast(float, w.x & 0xffff0000u), __builtin_bit_cast(float, w.y << 16), __builtin_bit_cast(float, w.y & 0xffff0000u)};
                    s1 = (f32x4){__builtin_bit_cast(float, w.z << 16), __builtin_bit_cast(float, w.z & 0xffff0000u), __builtin_bit_cast(float, w.w << 16), __builtin_bit_cast(float, w.w & 0xffff0000u)}; }
                const f32x4 r0 = s0 + gv[bj][0] * acc[ai][bj][m][0], r1 = s1 + gv[bj][1] * acc[ai][bj][m][1];
                u32x4 o; o.x = cvt_pk_bf16(r0[0], r0[1]); o.y = cvt_pk_bf16(r0[2], r0[3]); o.z = cvt_pk_bf16(r1[0], r1[1]); o.w = cvt_pk_bf16(r1[2], r1[3]);
                *(u32x4*)(rowp + bj * HALF) = o; } }
    }
};
struct EpiF32 {
    static constexpr bool PERM = false, AFTER_DRAIN = false;
    float* C; int ldc;
    __device__ __forceinline__ void operator()(const f32x4 (&acc)[2][2][4][2], const Unit& u, int wr, int wc, int fr, int fq) const {
        const int row0 = u.pm * BM + wr * 64 + fr, col0 = u.pn * BM + wc * 32 + 4 * fq;
#pragma unroll
        EPI_LOOP_ROWS { float* rowp = C + (size_t)(row0 + ai * HALF + m * 16) * ldc + col0;
#pragma unroll
            for (int bj = 0; bj < 2; ++bj)
#pragma unroll
                for (int n = 0; n < 2; ++n) *(f32x4*)(rowp + bj * HALF + n * 16) = acc[ai][bj][m][n]; }
    }
};
struct EpiCtxF32 {
    static constexpr bool PERM = false, AFTER_DRAIN = false;
    float* C; int ldc;
    __device__ __forceinline__ void operator()(const f32x4 (&acc)[2][2][4][2], const Unit& u, int wr, int wc, int fr, int fq) const {
        const int row0 = (u.pm ? BM : 0) + wr * 64 + fr, col0 = u.pn * BM + wc * 32 + 4 * fq;
#pragma unroll
        EPI_LOOP_ROWS { float* rowp = C + (size_t)(row0 + ai * HALF + m * 16) * ldc + col0;
#pragma unroll
            for (int bj = 0; bj < 2; ++bj)
#pragma unroll
                for (int n = 0; n < 2; ++n) *(f32x4*)(rowp + bj * HALF + n * 16) = acc[ai][bj][m][n]; }
    }
};
struct CtxOrder {
    int u0;
    __host__ __device__ bool next(int i, Unit& u) const { if (i != 0 || u0 < 0) return false; u.pm = (u0 >> 3) ? 33 : 0; u.pn = u0 & 7; return true; }
    __device__ __forceinline__ void a_ready(const Unit&) const {}
    __device__ __forceinline__ void done(const Unit&) const {}
};
struct EpiF16 {
    static constexpr bool PERM = true, AFTER_DRAIN = false;
    _Float16* C; int ldc;
    __device__ __forceinline__ void operator()(const f32x4 (&acc)[2][2][4][2], const Unit& u, int wr, int wc, int fr, int fq) const {
        typedef _Float16 h2 __attribute__((ext_vector_type(2)));
        const int row0 = u.pm * BM + wr * 64 + fr, col0 = u.pn * BM + wc * 32 + 8 * fq;
#pragma unroll
        EPI_LOOP_ROWS { _Float16* rowp = C + (size_t)(row0 + ai * HALF + m * 16) * ldc + col0;
#pragma unroll
            for (int bj = 0; bj < 2; ++bj) { const f32x4 v0 = acc[ai][bj][m][0], v1 = acc[ai][bj][m][1];
                u32x4 w; w.x = __builtin_bit_cast(unsigned, (h2){(_Float16)v0[0], (_Float16)v0[1]}); w.y = __builtin_bit_cast(unsigned, (h2){(_Float16)v0[2], (_Float16)v0[3]});
                w.z = __builtin_bit_cast(unsigned, (h2){(_Float16)v1[0], (_Float16)v1[1]}); w.w = __builtin_bit_cast(unsigned, (h2){(_Float16)v1[2], (_Float16)v1[3]});
                *(u32x4*)(rowp + bj * HALF) = w; } }
    }
};
struct EpiQ {
    static constexpr bool PERM = true, AFTER_DRAIN = false;
    bf16_t* Q; const f32x2* rope; float qscale;
    __device__ __forceinline__ void operator()(const f32x4 (&acc)[2][2][4][2], const Unit& u, int wr, int wc, int fr, int fq) const {
        const int bb = u.pm / 33, tp0 = (u.pm - bb * 33) * BM + wr * 64 + fr, col0 = u.pn * BM + wc * 32 + 8 * fq;
#pragma unroll
        for (int bj = 0; bj < 2; ++bj) { const int c = col0 + bj * HALF, hd = c / QKD, d = c - hd * QKD;
#pragma unroll
            EPI_LOOP_ROWS { EPI_PIN; const int tp = tp0 + ai * HALF + m * 16;
                f32x4 v0 = acc[ai][bj][m][0], v1 = acc[ai][bj][m][1];
                if (d >= 64) { const int i0 = (d - 64) >> 1; const f32x2* rp = rope + (size_t)tp * 16 + i0;
                    const f32x2 c0 = rp[0], c1 = rp[1], c2 = rp[2], c3 = rp[3];
                    float a, b;
                    a = v0[0]; b = v0[1]; v0[0] = a * c0.x - b * c0.y; v0[1] = a * c0.y + b * c0.x;
                    a = v0[2]; b = v0[3]; v0[2] = a * c1.x - b * c1.y; v0[3] = a * c1.y + b * c1.x;
                    a = v1[0]; b = v1[1]; v1[0] = a * c2.x - b * c2.y; v1[1] = a * c2.y + b * c2.x;
                    a = v1[2]; b = v1[3]; v1[2] = a * c3.x - b * c3.y; v1[3] = a * c3.y + b * c3.x; }
                v0 = v0 * qscale; v1 = v1 * qscale;
                u32x4 w; w.x = cvt_pk_bf16(v0[0], v0[1]); w.y = cvt_pk_bf16(v0[2], v0[3]); w.z = cvt_pk_bf16(v1[0], v1[1]); w.w = cvt_pk_bf16(v1[2], v1[3]);
                *(u32x4*)(Q + ((size_t)(bb * NH + hd) * TPB + tp) * QKD + d) = w; } }
    }
};
struct EpiKV {
    static constexpr bool PERM = true, AFTER_DRAIN = false;
    bf16_t* K; bf16_t* V;
    __device__ __forceinline__ void operator()(const f32x4 (&acc)[2][2][4][2], const Unit& u, int wr, int wc, int fr, int fq) const {
        const int bb = u.pm / 33, tp0 = (u.pm - bb * 33) * BM + wr * 64 + fr;
        const bool isK = wc < 2;
        bf16_t* base = isK ? K : V; const int pitch = isK ? QKD : 64, doff = 32 * (wc & 1) + 8 * fq;
#pragma unroll
        for (int bj = 0; bj < 2; ++bj) { const int hd = 2 * u.pn + bj;
            bf16_t* hb = base + (size_t)(bb * NH + hd) * TPB * pitch;
#pragma unroll
            EPI_LOOP_ROWS { EPI_PIN; const int tp = tp0 + ai * HALF + m * 16;
                const f32x4 v0 = acc[ai][bj][m][0], v1 = acc[ai][bj][m][1];
                u32x4 w; w.x = cvt_pk_bf16(v0[0], v0[1]); w.y = cvt_pk_bf16(v0[2], v0[3]); w.z = cvt_pk_bf16(v1[0], v1[1]); w.w = cvt_pk_bf16(v1[2], v1[3]);
                *(u32x4*)((char*)hb + (unsigned)((tp * pitch + doff) * 2)) = w; } }
    }
};
}

struct TItem { const float* W; bf16* WT; int K, ldw, c0, N, mapq, item; };
__device__ __forceinline__ void p0_item_load(const TItem& T, int lane, f32x4 (&x)[8]) {
    const int nblk = T.N / 32, kb = T.item / nblk, nb = T.item - kb * nblk, k0 = 64 * kb, n0 = 32 * nb;
    const float* p = T.W + (size_t)(k0 + (lane >> 3)) * T.ldw + T.c0 + n0 + (lane & 7) * 4;
#pragma unroll
    for (int i = 0; i < 8; ++i) x[i] = *(const GAS f32x4*)(p + (size_t)(8 * i) * T.ldw);
}
__device__ __forceinline__ void p0_item_finish(const TItem& T, const f32x4 (&x)[8], LAS float* scr, int lane) {
    const int nblk = T.N / 32, kb = T.item / nblk, nb = T.item - kb * nblk, k0 = 64 * kb, n0 = 32 * nb;
#pragma unroll
    for (int i = 0; i < 8; ++i) { LAS float* d = scr + (8 * i + (lane >> 3)) * 33 + (lane & 7) * 4; d[0] = x[i].x; d[1] = x[i].y; d[2] = x[i].z; d[3] = x[i].w; }
    LDS_WAIT(); asm volatile("" ::: "memory");
    const int c = lane & 7;
#pragma unroll
    for (int j = 0; j < 4; ++j) { const int n = (lane >> 3) + 8 * j; const LAS float* s = scr + (8 * c) * 33 + n;
        v4u o; o.x = pk2(s[0 * 33], s[1 * 33]); o.y = pk2(s[2 * 33], s[3 * 33]); o.z = pk2(s[4 * 33], s[5 * 33]); o.w = pk2(s[6 * 33], s[7 * 33]);
        int nn = n0 + n;
        if (T.mapq) { const int hd = nn / QKD, d = nn - hd * QKD; if (d >= 64) { const int i = (d - 64) & 15, s2 = (d - 64) >> 4; nn = hd * QKD + 64 + 2 * i + s2; } }
        *(GAS v4u*)(T.WT + (size_t)nn * T.K + k0 + 8 * c) = o; }
    LDS_WAIT(); asm volatile("" ::: "memory");
}

__device__ __forceinline__ const float* karg(int i);
constexpr int TB_INA = (DM / 128) * ((INA + 127) / 128), TB_G = (DM / 128) * (DM / 128), TB_BR = (RW / 128) * (DM / 128), TB_UQ = (512 / 128) * (NQ / 128), TB_UKV = (256 / 128) * (NKV / 128);
constexpr int TB_N = TB_INA + 2 * TB_G + 2 * TB_BR + TB_G + TB_UQ + TB_UKV;
constexpr int TI_LR = 1 * (RW / 32), TI_N = 4 * TI_LR;
__device__ __forceinline__ TItem p0_resolve_big(unsigned char* ws, int git) {
    const int l = git / TB_N; int r = git - l * TB_N; TItem T; T.mapq = 0; T.c0 = 0;
    if (r < TB_INA) { T.W = karg(7) + (size_t)l * DM * INC; T.K = DM; T.ldw = INC; T.N = INA; T.WT = (bf16*)(ws + WS_WINA) + (size_t)l * INA_P * DM; T.item = r; return T; } r -= TB_INA;
    if (r < TB_G) { T.W = karg(7) + (size_t)l * DM * INC; T.K = DM; T.ldw = INC; T.c0 = INA; T.N = DM; T.WT = (bf16*)(ws + WS_WGA) + (size_t)l * DM * DM; T.item = r; return T; } r -= TB_G;
    if (r < TB_G) { T.W = karg(7) + (size_t)l * DM * INC; T.K = DM; T.ldw = INC; T.c0 = INA + DM; T.N = DM; T.WT = (bf16*)(ws + WS_WGB) + (size_t)l * DM * DM; T.item = r; return T; } r -= TB_G;
    if (r < TB_BR) { T.W = karg(24) + (size_t)l * RW * DM; T.K = RW; T.ldw = DM; T.N = DM; T.WT = (bf16*)(ws + WS_WA) + (size_t)l * DM * RW; T.item = r; return T; } r -= TB_BR;
    if (r < TB_BR) { T.W = karg(25) + (size_t)l * RW * DM; T.K = RW; T.ldw = DM; T.N = DM; T.WT = (bf16*)(ws + WS_WB) + (size_t)l * DM * RW; T.item = r; return T; } r -= TB_BR;
    if (r < TB_G) { T.W = karg(26) + (size_t)l * DM * DM; T.K = DM; T.ldw = DM; T.N = DM; T.WT = (bf16*)(ws + WS_WO) + (size_t)l * DM * DM; T.item = r; return T; } r -= TB_G;
    if (r < TB_UQ) { T.W = karg(21) + (size_t)l * 512 * NQ; T.K = 512; T.ldw = NQ; T.N = NQ; T.WT = (bf16*)(ws + WS_WUQ) + (size_t)l * NQ * 512; T.item = r; T.mapq = 1; return T; } r -= TB_UQ;
    { T.W = karg(23) + (size_t)l * 256 * NKV; T.K = 256; T.ldw = NKV; T.N = NKV; T.WT = (bf16*)(ws + WS_WUKV) + (size_t)l * NKV * 256; T.item = r; return T; }
}
__device__ __forceinline__ void p0_big_load(const TItem& T, int tid, f32x4 (&x)[8]) {
    const int nblk = (T.N + 127) / 128, kb = T.item / nblk, nb = T.item - kb * nblk, k0 = 128 * kb, col = 128 * nb + (tid & 31) * 4;
    const float* p = T.W + (size_t)(k0 + (tid >> 5)) * T.ldw + T.c0 + col; const bool ok = col < T.N;
#pragma unroll
    for (int i = 0; i < 8; ++i) x[i] = ok ? *(const GAS f32x4*)(p + (size_t)(16 * i) * T.ldw) : (f32x4){0.f, 0.f, 0.f, 0.f};
}
__device__ __forceinline__ void p0_big_finish(const TItem& T, const f32x4 (&x)[8], LAS float* tile, int tid) {
    const int nblk = (T.N + 127) / 128, kb = T.item / nblk, nb = T.item - kb * nblk, k0 = 128 * kb, n0 = 128 * nb;
    __syncthreads();
#pragma unroll
    for (int i = 0; i < 8; ++i) *(LAS f32x4*)(tile + ((tid >> 5) + 16 * i) * 132 + (tid & 31) * 4) = x[i];
    __syncthreads();
    const int n = tid & 127, cg = tid >> 7; int nn = n0 + n;
    if (nn < T.N) {
        if (T.mapq) { const int hd = nn / QKD, d = nn - hd * QKD; if (d >= 64) { const int i = (d - 64) & 15, s2 = (d - 64) >> 4; nn = hd * QKD + 64 + 2 * i + s2; } }
#pragma unroll
        for (int c = 0; c < 4; ++c) { const LAS float* s = tile + (32 * cg + 8 * c) * 132 + n;
            v4u o; o.x = pk2(s[0 * 132], s[1 * 132]); o.y = pk2(s[2 * 132], s[3 * 132]); o.z = pk2(s[4 * 132], s[5 * 132]); o.w = pk2(s[6 * 132], s[7 * 132]);
            *(GAS v4u*)(T.WT + (size_t)nn * T.K + k0 + 32 * cg + 8 * c) = o; } }
}
__device__ __forceinline__ TItem p0_resolve(unsigned char* ws, int git) {
    const int l = git / TI_N; int r = git - l * TI_N; TItem T; T.mapq = 0; T.c0 = 0;
    const int which = r / TI_LR, d = which & 1, isa = which >> 1; r -= which * TI_LR;
    T.W = (isa ? karg(13) : karg(11)) + (size_t)(l * 2 + d) * 64 * RW; T.K = 64; T.ldw = RW; T.N = RW; T.WT = (bf16*)(ws + (isa ? WS_AUP : WS_WUP)) + (size_t)(l * 2 + d) * RW * 64; T.item = r; return T;
}
constexpr int NWI_INA = (DM / 64) * (INA / 32), NWI_G = (DM / 64) * (DM / 32), NWI_BR = (RW / 64) * (DM / 32), NWI_UQ = (512 / 64) * (NQ / 32), NWI_UKV = (256 / 64) * (NKV / 32);
constexpr int NW_ITEMS = NWI_INA + 2 * NWI_G + 2 * NWI_BR + NWI_G + NWI_UQ + NWI_UKV + TI_N;
__device__ __forceinline__ TItem p0_resolve_wave(unsigned char* ws, int l, int r) {
    TItem T; T.mapq = 0; T.c0 = 0;
    if (r < NWI_INA) { T.W = karg(7) + (size_t)l * DM * INC; T.K = DM; T.ldw = INC; T.N = INA; T.WT = (bf16*)(ws + WS_WINA) + (size_t)l * INA_P * DM; T.item = r; return T; } r -= NWI_INA;
    if (r < NWI_G) { T.W = karg(7) + (size_t)l * DM * INC; T.K = DM; T.ldw = INC; T.c0 = INA; T.N = DM; T.WT = (bf16*)(ws + WS_WGA) + (size_t)l * DM * DM; T.item = r; return T; } r -= NWI_G;
    if (r < NWI_G) { T.W = karg(7) + (size_t)l * DM * INC; T.K = DM; T.ldw = INC; T.c0 = INA + DM; T.N = DM; T.WT = (bf16*)(ws + WS_WGB) + (size_t)l * DM * DM; T.item = r; return T; } r -= NWI_G;
    if (r < NWI_BR) { T.W = karg(24) + (size_t)l * RW * DM; T.K = RW; T.ldw = DM; T.N = DM; T.WT = (bf16*)(ws + WS_WA) + (size_t)l * DM * RW; T.item = r; return T; } r -= NWI_BR;
    if (r < NWI_BR) { T.W = karg(25) + (size_t)l * RW * DM; T.K = RW; T.ldw = DM; T.N = DM; T.WT = (bf16*)(ws + WS_WB) + (size_t)l * DM * RW; T.item = r; return T; } r -= NWI_BR;
    if (r < NWI_G) { T.W = karg(26) + (size_t)l * DM * DM; T.K = DM; T.ldw = DM; T.N = DM; T.WT = (bf16*)(ws + WS_WO) + (size_t)l * DM * DM; T.item = r; return T; } r -= NWI_G;
    if (r < NWI_UQ) { T.W = karg(21) + (size_t)l * 512 * NQ; T.K = 512; T.ldw = NQ; T.N = NQ; T.WT = (bf16*)(ws + WS_WUQ) + (size_t)l * NQ * 512; T.item = r; T.mapq = 1; return T; } r -= NWI_UQ;
    if (r < NWI_UKV) { T.W = karg(23) + (size_t)l * 256 * NKV; T.K = 256; T.ldw = NKV; T.N = NKV; T.WT = (bf16*)(ws + WS_WUKV) + (size_t)l * NKV * 256; T.item = r; return T; } r -= NWI_UKV;
    return p0_resolve(ws, l * TI_N + r);
}
__device__ __forceinline__ void p0_prologue(Frame& F, int l_lo, int l_hi, int svcu, int sG, int with_tr = 1) {
    LAS float* scr = (LAS float*)(F.lds + F.wave * 16384);
    const int gw = svcu * NWAVES + F.wave, NGW = sG * NWAVES;
    unsigned char* ws = F.ws;
    for (int rp_ = 0; rp_ < (DBG_REPEAT == 102 ? 2 : 1); ++rp_)
    { float* modw = (float*)(ws + WS_CTL + CTL_MOD_OFF); const float* adaw = karg(4); const float* adab = karg(5); const float* cin = karg(1); const float* cctx = karg(3);
      LAS float* SIL = (LAS float*)F.lds;
      LAS f32x2* part = (LAS f32x2*)(F.lds + 32768);
      if (svcu >= 0 && l_lo * 96 + svcu < l_hi * 96) {
          for (int i = F.tid; i < 3 * DM; i += 512) { const int r = i >> 11, k = i & 2047; const float c = r < 2 ? cin[r * DM + k] : cctx[k]; SIL[i] = c / (1.f + __expf(-c)); }
          __syncthreads(); }
      if (svcu >= 0) for (int uu = l_lo * 96 + svcu; uu < l_hi * 96; uu += sG) { const int cb = uu % 96, l = uu / 96;
          const int n0 = cb * 128 + F.lane * 2; const float* aw = adaw + (size_t)l * DM * 12288 + n0;
          f32x2 a0 = {0, 0}, a1 = a0, a2 = a0;
#pragma unroll 1
          for (int k0 = F.wave * 256; k0 < F.wave * 256 + 256; k0 += 16) { f32x2 w[16];
#pragma unroll
              for (int j = 0; j < 16; ++j) w[j] = *(const GAS f32x2*)(aw + (size_t)(k0 + j) * 12288);
#pragma unroll
              for (int j = 0; j < 16; ++j) { a0 = a0 + w[j] * SIL[k0 + j]; a1 = a1 + w[j] * SIL[DM + k0 + j]; a2 = a2 + w[j] * SIL[2 * DM + k0 + j]; } }
          __syncthreads();
          part[(F.wave * 3 + 0) * 64 + F.lane] = a0; part[(F.wave * 3 + 1) * 64 + F.lane] = a1; part[(F.wave * 3 + 2) * 64 + F.lane] = a2;
          __syncthreads();
          if (F.wave < 3) { f32x2 s = *(const GAS f32x2*)(adab + (size_t)l * 12288 + n0);
#pragma unroll
              for (int w8 = 0; w8 < 8; ++w8) s = s + part[(w8 * 3 + F.wave) * 64 + F.lane];
              *(GAS f32x2*)(modw + ((size_t)l * 3 + F.wave) * 12288 + n0) = s; }
          __syncthreads(); } }
    if (with_tr) for (int rp_ = 0; rp_ < (DBG_REPEAT == 101 ? 2 : 1); ++rp_)
    { unsigned* ctr = (unsigned*)(ws + WS_CTL) + 2048 + 64 * rp_ + 128 * l_lo; LAS float* tile = (LAS float*)F.lds; LAS int* slot = (LAS int*)(F.lds + 128 * 132 * 4);
#define P0_GRAB(dst) do { __syncthreads(); if (F.tid == 0) *slot = (int)__hip_atomic_fetch_add(ctr, 1u, __ATOMIC_RELAXED, __HIP_MEMORY_SCOPE_AGENT); __syncthreads(); dst = *slot; } while (0)
      const int it_end = l_hi * TB_N;
      int it; P0_GRAB(it); it += l_lo * TB_N; f32x4 xa[8], xb[8]; TItem T, Tn;
      if (it < it_end) { T = p0_resolve_big(ws, it); p0_big_load(T, F.tid, xa); }
      while (it < it_end) { int itn; P0_GRAB(itn); itn += l_lo * TB_N; const bool more = itn < it_end;
          if (more) { Tn = p0_resolve_big(ws, itn); p0_big_load(Tn, F.tid, xb); }
          p0_big_finish(T, xa, tile, F.tid);
          if (more) { T = Tn;
#pragma unroll
              for (int i = 0; i < 8; ++i) xa[i] = xb[i]; }
          it = itn; }
#undef P0_GRAB
      __syncthreads();
      if (svcu >= 0) for (int itw = l_lo * TI_N + gw; itw < l_hi * TI_N; itw += NGW) { f32x4 xw[8]; const TItem Tw = p0_resolve(ws, itw); p0_item_load(Tw, F.lane, xw); p0_item_finish(Tw, xw, scr, F.lane); }
    }
    const int gt = gw * 64 + F.lane, NGT = NGW * 64;
    { const float* gup = karg(14);
    if (svcu >= 0) for (int i = l_lo * 2 * 32 * RW + gt; i < l_hi * 2 * 32 * RW; i += NGT) { const int ch = i & 1023, r = (i >> 10) & 31, ld = i >> 15;
        ((bf16*)(ws + WS_GUP))[((size_t)ld * RW + ch) * 32 + r] = (bf16)f2bf(gup[i]); } }
    if (svcu >= 0) for (int i = l_lo * ((INA_P - INA) * DM / 8) + gt; i < l_hi * ((INA_P - INA) * DM / 8); i += NGT) { const int l = i / ((INA_P - INA) * DM / 8), r = i - l * ((INA_P - INA) * DM / 8);
        ((GAS v4u*)((bf16*)(ws + WS_WINA) + ((size_t)l * INA_P + INA) * DM))[r] = (v4u){0u, 0u, 0u, 0u}; }
    { f32x2* rt = (f32x2*)(ws + WS_ROPE);
      if (l_lo == 0 && svcu >= 0) for (int i = gt; i < TPB * 16; i += NGT) { const int tp = i >> 4, k = i & 15; f32x2 o = {1.f, 0.f};
          if (tp >= CTXL) { const int t = tp - CTXL, row = t >> 6, col = t & 63, j = k & 7; const float fr = powf(10000.0f, -(float)j / 8.0f);
              const float ang = (float)(k < 8 ? row : col) * fr; o.x = cosf(ang); o.y = sinf(ang); }
          rt[i] = o; } }
    for (int rp_ = 0; rp_ < (DBG_REPEAT == 103 ? 2 : 1); ++rp_)
    { LAS float* KEY = (LAS float*)F.lds;
      LAS float* WQT = (LAS float*)(F.lds + 65536);
      const float* pkeys = karg(29); const float* pwq = karg(28);
      __syncthreads();
      if (svcu >= 0) for (int uu = l_lo * 512 + svcu; uu < l_hi * 512; uu += sG) { const int kb = uu & 31, hp = (uu >> 5) & 15, l = uu >> 9;
          const GAS f32x4* ksrc = (const GAS f32x4*)(pkeys + ((size_t)l * 16 + hp) * 16384);
          for (int i = F.tid; i < 4096; i += 512) ((LAS f32x4*)KEY)[i] = ksrc[i];
          for (int i = F.tid; i < 2048; i += 512) { const int kk = i >> 5, d4 = i & 31;
              *(LAS f32x4*)(WQT + kk * 132 + d4 * 4) = *(const GAS f32x4*)(pwq + ((size_t)l * DM + kb * 64 + kk) * DM + hp * 128 + d4 * 4); }
          __syncthreads();
          const int kq = F.tid & 15, keyq = F.tid >> 4;
          float acc[4][4];
#pragma unroll
          for (int j = 0; j < 4; ++j)
#pragma unroll
              for (int i = 0; i < 4; ++i) acc[j][i] = 0.f;
          for (int d = 0; d < 128; d += 4) { f32x4 w[4], q[4];
#pragma unroll
              for (int i = 0; i < 4; ++i) w[i] = *(LAS f32x4*)(WQT + (kq + 16 * i) * 132 + d);
#pragma unroll
              for (int j = 0; j < 4; ++j) q[j] = *(LAS f32x4*)(KEY + (4 * keyq + j) * 128 + d);
#pragma unroll
              for (int j = 0; j < 4; ++j)
#pragma unroll
                  for (int i = 0; i < 4; ++i) acc[j][i] += q[j].x * w[i].x + q[j].y * w[i].y + q[j].z * w[i].z + q[j].w * w[i].w; }
          bf16* dst = (bf16*)(ws + WS_WQK) + ((size_t)l * DM + hp * 128 + 4 * keyq) * DM + kb * 64 + kq;
#pragma unroll
          for (int j = 0; j < 4; ++j)
#pragma unroll
              for (int i = 0; i < 4; ++i) dst[(size_t)j * DM + 16 * i] = (bf16)f2bf(acc[j][i]);
          __syncthreads(); } }
}

__device__ __forceinline__ const float* modnorm_src(int m, const float* X, const float* xin, const float* cin) {
    const int b = m / TPB, tp = m - b * TPB;
    return xin ? (tp < CTXL ? cin + ((size_t)b * CTXL + tp) * DM : xin + ((size_t)b * SEQ + (tp - CTXL)) * DM) : X + (size_t)m * DM;
}
__device__ __forceinline__ void modnorm_phase_bf(Frame& F, const bf16* X, const float* g, const float* mod  , int chunk_sh, bf16* H, int skip_ctx) {
    const int gw = F.vcu * NWAVES + F.wave, NGW = F.G * NWAVES;
    int m = gw; while (m < MALL && skip_ctx && (m % TPB) < CTXL) m += NGW;
    v4u v[4]; f32x4 ga[8], sb[8]; int mr_cur = -1;
    if (m < MALL) { const GAS v4u* xr = (const GAS v4u*)(X + (size_t)m * DM) + F.lane;
#pragma unroll
        for (int j = 0; j < 4; ++j) v[j] = xr[64 * j]; }
    while (m < MALL) {
        int mn = m + NGW; while (mn < MALL && skip_ctx && (mn % TPB) < CTXL) mn += NGW;
        v4u nv[4];
        if (mn < MALL) { const GAS v4u* xr = (const GAS v4u*)(X + (size_t)mn * DM) + F.lane;
#pragma unroll
            for (int j = 0; j < 4; ++j) nv[j] = xr[64 * j]; }
        const int b = m / TPB, tp = m - b * TPB, mr = tp < CTXL ? 2 : b;
        if (mr != mr_cur) { mr_cur = mr; const float* sh = mod + (size_t)mr * 12288 + chunk_sh * DM; const float* sc = sh + DM;
#pragma unroll
            for (int q = 0; q < 8; ++q) { const int c = (F.lane + 64 * (q >> 1)) * 8 + 4 * (q & 1); const f32x4 gg = *(const GAS f32x4*)(g + c), s1 = *(const GAS f32x4*)(sc + c); ga[q] = gg * (s1 + 1.0f); sb[q] = *(const GAS f32x4*)(sh + c); } }
        float x[4][8]; float s = 0.f;
#pragma unroll
        for (int j = 0; j < 4; ++j) { x[j][0] = bflo(v[j].x); x[j][1] = bfhi(v[j].x); x[j][2] = bflo(v[j].y); x[j][3] = bfhi(v[j].y); x[j][4] = bflo(v[j].z); x[j][5] = bfhi(v[j].z); x[j][6] = bflo(v[j].w); x[j][7] = bfhi(v[j].w);
#pragma unroll
            for (int e = 0; e < 8; ++e) s += x[j][e] * x[j][e]; }
        const float rs = rsqrtf(wave_sum(s) * (1.f / DM) + NORM_EPS);
        GAS v4u* o8 = (GAS v4u*)(H + (size_t)m * DM) + F.lane;
#pragma unroll
        for (int j = 0; j < 4; ++j) { float y[8];
#pragma unroll
            for (int e = 0; e < 8; ++e) y[e] = (x[j][e] * rs) * ga[2 * j + (e >> 2)][e & 3] + sb[2 * j + (e >> 2)][e & 3];
            v4u o; o.x = pk2(y[0], y[1]); o.y = pk2(y[2], y[3]); o.z = pk2(y[4], y[5]); o.w = pk2(y[6], y[7]); o8[64 * j] = o; }
#pragma unroll
        for (int j = 0; j < 4; ++j) v[j] = nv[j];
        m = mn;
    }
}
__device__ __forceinline__ void modnorm_phase(Frame& F, const float* X, const float* g, const float* mod  , int chunk_sh, bf16* H, int skip_ctx, const float* xin = nullptr, const float* cin = nullptr) {
    const int gw = F.vcu * NWAVES + F.wave, NGW = F.G * NWAVES;
    int m = gw; while (m < MALL && skip_ctx && (m % TPB) < CTXL) m += NGW;
    f32x4 v[8], ga[8], sb[8]; int mr_cur = -1;
    if (m < MALL) { const GAS f32x4* xr = (const GAS f32x4*)modnorm_src(m, X, xin, cin) + F.lane;
#pragma unroll
        for (int j = 0; j < 8; ++j) v[j] = xr[64 * j]; }
    while (m < MALL) {
        int mn = m + NGW; while (mn < MALL && skip_ctx && (mn % TPB) < CTXL) mn += NGW;
        f32x4 nv[8];
        if (mn < MALL) { const GAS f32x4* xr = (const GAS f32x4*)modnorm_src(mn, X, xin, cin) + F.lane;
#pragma unroll
            for (int j = 0; j < 8; ++j) nv[j] = xr[64 * j]; }
        const int b = m / TPB, tp = m - b * TPB, mr = tp < CTXL ? 2 : b;
        if (mr != mr_cur) { mr_cur = mr; const float* sh = mod + (size_t)mr * 12288 + chunk_sh * DM; const float* sc = sh + DM;
#pragma unroll
            for (int j = 0; j < 8; ++j) { const int c = (F.lane + 64 * j) * 4; const f32x4 gg = *(const GAS f32x4*)(g + c), s1 = *(const GAS f32x4*)(sc + c); ga[j] = gg * (s1 + 1.0f); sb[j] = *(const GAS f32x4*)(sh + c); } }
        float s = 0.f;
#pragma unroll
        for (int j = 0; j < 8; ++j) s += (v[j].x * v[j].x + v[j].y * v[j].y) + (v[j].z * v[j].z + v[j].w * v[j].w);
        const float rs = rsqrtf(wave_sum(s) * (1.f / DM) + NORM_EPS);
        GAS v2u* o8 = (GAS v2u*)(H + (size_t)m * DM) + F.lane;
#pragma unroll
        for (int j = 0; j < 8; ++j) { const f32x4 y = (v[j] * rs) * ga[j] + sb[j];
            v2u o; o.x = pk2(y.x, y.y); o.y = pk2(y.z, y.w); o8[64 * j] = o; }
#pragma unroll
        for (int j = 0; j < 8; ++j) v[j] = nv[j];
        m = mn;
    }
}

typedef float f32x4v __attribute__((ext_vector_type(4)));
#define MFMA16(a, b, c) __builtin_amdgcn_mfma_f32_16x16x32_bf16((a), (b), (c), 0, 0, 0)
#define MFMA32(a, b, c) __builtin_amdgcn_mfma_f32_32x32x16_bf16((a), (b), (c), 0, 0, 0)

struct FeatP {
    const bf16* PA; const float* mu; const float* w0; const float* a0; const float* k_k; const float* k_a; const float* r_k;
    const bf16* WUP; const bf16* AUP; const bf16* GUP;
    const float* qnorm; const float* kvnorm; const f32x2* rope;
    bf16* RI; bf16* GG; float* BON; bf16* QN; bf16* KVN; bf16* K;
};
__device__ __forceinline__ f32x4 ld4bf(const bf16* p) { const v2u w = *(const GAS v2u*)p; return (f32x4){bflo(w.x), bfhi(w.x), bflo(w.y), bfhi(w.y)}; }
__device__ __forceinline__ f32x4 mix4(const bf16* PA, int m, int c, bool hp, bool hn, const float* mu) {
    const f32x4 pc = ld4bf(PA + (size_t)m * INA_P + c);
    f32x4 pp = {0, 0, 0, 0}, pn = {0, 0, 0, 0};
    if (hp) pp = ld4bf(PA + (size_t)(m - 1) * INA_P + c);
    if (hn) pn = ld4bf(PA + (size_t)(m + 1) * INA_P + c);
    const f32x4 mm = *(const GAS f32x4*)(mu + c);
    return pc + ((pp + pn) * 0.5f - pc) * mm;
}
__device__ __forceinline__ void unpack8(const v4u w, float (&x)[8]) { x[0] = bflo(w.x); x[1] = bfhi(w.x); x[2] = bflo(w.y); x[3] = bfhi(w.y); x[4] = bflo(w.z); x[5] = bfhi(w.z); x[6] = bflo(w.w); x[7] = bfhi(w.w); }
__device__ __forceinline__ v4u pack8f(const float (&x)[8]) { v4u o; o.x = pk2(x[0], x[1]); o.y = pk2(x[2], x[3]); o.z = pk2(x[4], x[5]); o.w = pk2(x[6], x[7]); return o; }
__device__ __forceinline__ void mix8(const bf16* rowc, bool hp, bool hn, const float (&mu)[8], float (&o)[8]) {
    const v4u zc = {0u, 0u, 0u, 0u};
    const v4u wc = *(const GAS v4u*)rowc, wp = hp ? *(const GAS v4u*)(rowc - INA_P) : zc, wn = hn ? *(const GAS v4u*)(rowc + INA_P) : zc;
    float c[8], p[8], n[8]; unpack8(wc, c); unpack8(wp, p); unpack8(wn, n);
#pragma unroll
    for (int e = 0; e < 8; ++e) o[e] = c[e] + (0.5f * (p[e] + n[e]) - c[e]) * mu[e];
}
struct Raw3 { v4u c, p, n; };
__device__ __forceinline__ Raw3 load3(const bf16* rowc, bool hp, bool hn) { const v4u zc = {0u, 0u, 0u, 0u}; Raw3 r; r.c = *(const GAS v4u*)rowc; r.p = hp ? *(const GAS v4u*)(rowc - INA_P) : zc; r.n = hn ? *(const GAS v4u*)(rowc + INA_P) : zc; return r; }
__device__ __forceinline__ void mix8r(const Raw3& w, const float (&mu)[8], float (&o)[8]) {
    float c[8], p[8], n[8]; unpack8(w.c, c); unpack8(w.p, p); unpack8(w.n, n);
#pragma unroll
    for (int e = 0; e < 8; ++e) o[e] = c[e] + (0.5f * (p[e] + n[e]) - c[e]) * mu[e];
}
__device__ __forceinline__ void features_phase(Frame& F, const FeatP& P) {
    constexpr int LAP = 328;
    LAS bf16* LA = (LAS bf16*)F.lds;
    LAS float* SSQ = (LAS float*)(F.lds + 10752);
    LAS float* PRM = (LAS float*)(F.lds + 12288);
    const int lane = F.lane, w = F.wave, tk = lane & 15, q4 = lane >> 4;
    constexpr int NTILE = MALL / 16, NTG = 64;
    for (int su = F.vcu; su < 4 * NTG; su += F.G) {
        const int cg = su & 3, tg = su >> 2, cw = 256 * cg + 32 * w, ch8 = cw + 8 * q4, hd = 4 * cg + (w >> 1);
        __syncthreads();
        for (int i = F.tid; i < 2560; i += 512) { const int prm = i >> 8, c = (i & 255) + 256 * cg; float v;
            switch (prm) { case 0: v = P.k_k[c]; break; case 1: v = P.k_a[c]; break; case 2: v = P.r_k[c]; break; case 3: v = P.w0[c]; break; case 4: v = P.w0[RW + c]; break;
                           case 5: v = P.a0[c]; break; case 6: v = P.a0[RW + c]; break; case 7: v = P.mu[c]; break; case 8: v = P.mu[RW + c]; break; default: v = P.mu[2 * RW + c]; break; }
            PRM[i] = v; }
        bf16x8 fw[2][2][2], fa[2][2][2], fg[2][2];
        { const int chA = cw + 8 * (tk >> 2) + (tk & 3);
#pragma unroll
          for (int d = 0; d < 2; ++d)
#pragma unroll
              for (int t = 0; t < 2; ++t) {
#pragma unroll
                  for (int ks = 0; ks < 2; ++ks) { fw[d][t][ks] = *(const GAS bf16x8*)(P.WUP + ((size_t)d * RW + chA + 4 * t) * 64 + ks * 32 + q4 * 8); fa[d][t][ks] = *(const GAS bf16x8*)(P.AUP + ((size_t)d * RW + chA + 4 * t) * 64 + ks * 32 + q4 * 8); }
                  fg[d][t] = *(const GAS bf16x8*)(P.GUP + ((size_t)d * RW + chA + 4 * t) * 32 + q4 * 8); } }
        for (int tt = tg; tt < NTILE; tt += NTG) {
            const int m0 = tt * 16;
            const int m = m0 + tk, b = m / TPB, tp = m - b * TPB;
            const bool hp = (tp != 0) && (tp != CTXL), hn = (tp != CTXL - 1) && (tp != TPB - 1);
            const bf16* rowp = P.PA + (size_t)m * INA_P + ch8;
            const Raw3 rawk = load3(rowp + RW, hp, hn), rawr = load3(rowp, hp, hn), rawv = load3(rowp + 2 * RW, hp, hn);
            __syncthreads();
            for (int it = F.tid; it < 640; it += 512) { const int tkk = it / 40, c8 = (it - tkk * 40) * 8, c = C_WD + c8, m = m0 + tkk, tp = m % TPB;
                const bool hp = (tp != 0) && (tp != CTXL), hn = (tp != CTXL - 1) && (tp != TPB - 1);
                float mu[8], v[8];
                { const f32x4 a = *(const GAS f32x4*)(P.mu + c), b2 = *(const GAS f32x4*)(P.mu + c + 4); mu[0] = a.x; mu[1] = a.y; mu[2] = a.z; mu[3] = a.w; mu[4] = b2.x; mu[5] = b2.y; mu[6] = b2.z; mu[7] = b2.w; }
                mix8(P.PA + (size_t)m * INA_P + c, hp, hn, mu, v);
#pragma unroll
                for (int e = 0; e < 8; ++e) { if (c < C_AD) v[e] = 1.0f - 2.0f * __builtin_amdgcn_rcpf(1.0f + __expf(2.0f * v[e])); else if (c >= C_GD) v[e] = sigmoidf_(v[e]); }
                *(LAS v4u*)(LA + tkk * LAP + c8) = pack8f(v); }
            if ((tt & 3) == cg) {
#pragma unroll
                for (int t2 = 0; t2 < 2; ++t2) { const int m = m0 + 2 * w + t2, b = m / TPB, tp = m - b * TPB; const bf16* row = P.PA + (size_t)m * INA_P;
                    { float x[8]; unpack8(*(const GAS v4u*)(row + C_QC + lane * 8), x); float s = 0.f;
#pragma unroll
                      for (int e = 0; e < 8; ++e) s += x[e] * x[e];
                      const float rs = rsqrtf(wave_sum(s) * (1.f / 512.f) + NORM_EPS);
#pragma unroll
                      for (int e = 0; e < 8; ++e) x[e] = x[e] * rs * P.qnorm[lane * 8 + e];
                      *(GAS v4u*)(P.QN + (size_t)m * 512 + lane * 8) = pack8f(x); }
                    { const v2u q = *(const GAS v2u*)(row + C_KVC + lane * 4);
                      float x[4] = {bflo(q.x), bfhi(q.x), bflo(q.y), bfhi(q.y)}; float s = 0.f;
#pragma unroll
                      for (int e = 0; e < 4; ++e) s += x[e] * x[e];
                      const float rs = rsqrtf(wave_sum(s) * (1.f / 256.f) + NORM_EPS);
#pragma unroll
                      for (int e = 0; e < 4; ++e) x[e] = x[e] * rs * P.kvnorm[lane * 4 + e];
                      v2u o; o.x = pk2(x[0], x[1]); o.y = pk2(x[2], x[3]);
                      *(GAS v2u*)(P.KVN + (size_t)m * 256 + lane * 4) = o; }
                    if (lane < 16) { const float x1 = bf1(row[C_KR + lane]), x2 = bf1(row[C_KR + 16 + lane]); const f32x2 cs = P.rope[(size_t)tp * 16 + lane];
                        const unsigned o = pk2(x1 * cs.x - x2 * cs.y, x1 * cs.y + x2 * cs.x);
#pragma unroll
                        for (int h2 = 0; h2 < NH; ++h2) *(GAS unsigned*)(P.K + ((size_t)(b * NH + h2) * TPB + tp) * QKD + 64 + 2 * lane) = o; } } }
            const int pc = 32 * w + 8 * q4;
            float prm[8], kmx[8], kx[8];
#pragma unroll
            for (int e = 0; e < 8; ++e) prm[e] = PRM[8 * 256 + pc + e];
            mix8r(rawk, prm, kmx);
            { float s = 0.f;
#pragma unroll
              for (int e = 0; e < 8; ++e) { kx[e] = kmx[e] * PRM[0 * 256 + pc + e]; s += kx[e] * kx[e]; }
              s += bpermf(lane ^ 16, s); s += bpermf(lane ^ 32, s);
              if (q4 == 0) SSQ[tk * 8 + w] = s; }
            __syncthreads();
            const float rsn = rsqrtf(SSQ[tk * 8 + w] + SSQ[tk * 8 + (w ^ 1)] + 1e-12f);
            f32x4 cw_[2][2], ca_[2][2], cg_[2][2];
#pragma unroll
            for (int d = 0; d < 2; ++d) {
                const bf16x8 bg = *(const LAS bf16x8*)(LA + tk * LAP + 256 + d * 32 + q4 * 8);
                bf16x8 bw[2], ba[2];
#pragma unroll
                for (int ks = 0; ks < 2; ++ks) { bw[ks] = *(const LAS bf16x8*)(LA + tk * LAP + d * 64 + ks * 32 + q4 * 8); ba[ks] = *(const LAS bf16x8*)(LA + tk * LAP + 128 + d * 64 + ks * 32 + q4 * 8); }
#pragma unroll
                for (int t = 0; t < 2; ++t) { f32x4 z = {0, 0, 0, 0};
                    cw_[d][t] = MFMA16(fw[d][t][1], bw[1], MFMA16(fw[d][t][0], bw[0], z));
                    ca_[d][t] = MFMA16(fa[d][t][1], ba[1], MFMA16(fa[d][t][0], ba[0], z));
                    cg_[d][t] = MFMA16(fg[d][t], bg, z); } }
            float r8[8], v8[8], kk8[8];
#pragma unroll
            for (int e = 0; e < 8; ++e) prm[e] = PRM[7 * 256 + pc + e];
            mix8r(rawr, prm, r8);
#pragma unroll
            for (int e = 0; e < 8; ++e) prm[e] = PRM[9 * 256 + pc + e];
            mix8r(rawv, prm, v8);
#pragma unroll
            for (int e = 0; e < 8; ++e) kk8[e] = kx[e] * rsn;
            bf16* rec = P.RI + ((size_t)(b * NH + hd) * TPB + tp) * RREC + (ch8 & 63);
            *(GAS v4u*)(rec) = pack8f(r8); *(GAS v4u*)(rec + 64) = pack8f(kk8); *(GAS v4u*)(rec + 128) = pack8f(v8);
#pragma unroll
            for (int d = 0; d < 2; ++d) {
                float ld[8], ke[8], bb[8], gg[8]; float bs = 0.f;
#pragma unroll
                for (int e = 0; e < 8; ++e) { const int t = e >> 2, r = e & 3;
                    ld[e] = -0.60653066f * sigmoidf_(PRM[(3 + d) * 256 + pc + e] + cw_[d][t][r]);
                    const float aa = sigmoidf_(PRM[(5 + d) * 256 + pc + e] + ca_[d][t][r]);
                    ke[e] = kmx[e] * (1.0f + (aa - 1.0f) * PRM[1 * 256 + pc + e]); bb[e] = kk8[e] * aa; gg[e] = cg_[d][t][r];
                    bs += r8[e] * ke[e] * PRM[2 * 256 + pc + e]; }
                *(GAS v4u*)(rec + (3 + 3 * d) * 64) = pack8f(ld); *(GAS v4u*)(rec + (4 + 3 * d) * 64) = pack8f(bb); *(GAS v4u*)(rec + (5 + 3 * d) * 64) = pack8f(ke);
                *(GAS v4u*)(P.GG + ((size_t)d * MALL + m) * RW + ch8) = pack8f(gg);
                bs += bpermf(lane ^ 16, bs); bs += bpermf(lane ^ 32, bs);
                if (q4 == 0) P.BON[((size_t)d * MALL + m) * 32 + 2 * hd + (w & 1)] = bs; }
        }
    }
}

__device__ __forceinline__ void cvt_row_load(f32x4 (&x)[8], const float* src) {
#pragma unroll
    for (int q = 0; q < 8; ++q) x[q] = *(const GAS f32x4*)(src + q * 4);
}
__device__ __forceinline__ void cvt_row_store(const f32x4 (&x)[8], unsigned char* dst, float* scale_slot, int lane) {
    float am = 0.f;
#pragma unroll
    for (int q = 0; q < 8; ++q) am = fmaxf(am, fmaxf(fmaxf(fabsf(x[q].x), fabsf(x[q].y)), fmaxf(fabsf(x[q].z), fabsf(x[q].w))));
    am = fmaxf(wave_max_u(am), 1e-30f);
    const float g = 6.0f / am, inv = am * (1.0f / 6.0f);
    v4u o;
#pragma unroll
    for (int q = 0; q < 4; ++q) { unsigned w = 0u;
        w = __builtin_amdgcn_cvt_scalef32_pk_fp4_f32(w, x[2 * q].x * g, x[2 * q].y * g, 1.0f, 0);
        w = __builtin_amdgcn_cvt_scalef32_pk_fp4_f32(w, x[2 * q].z * g, x[2 * q].w * g, 1.0f, 1);
        w = __builtin_amdgcn_cvt_scalef32_pk_fp4_f32(w, x[2 * q + 1].x * g, x[2 * q + 1].y * g, 1.0f, 2);
        w = __builtin_amdgcn_cvt_scalef32_pk_fp4_f32(w, x[2 * q + 1].z * g, x[2 * q + 1].w * g, 1.0f, 3);
        o[q] = w; }
    *(GAS v4u*)dst = o;
    if (lane == 0) *scale_slot = inv;
}
struct ScanCvt { const float* pu; const float* pv; unsigned char* PU8; unsigned char* PV8; float* SU; float* SV; int wl; };
constexpr int SCH = 32;
constexpr int SSTEP = 6 * 64;
__device__ __forceinline__ int scan_tp(int dir, int s) { return dir == 0 ? s : (s < CTXL ? (CTXL - 1 - s) : (TPB - 1 - (s - CTXL))); }
__device__ __forceinline__ void scan_load(v4u (&rg)[6], const bf16* RIh, int dir, int chunk, int htid) {
    const int tp = scan_tp(dir, chunk * SCH + (htid >> 3));
    const bf16* rec = RIh + (size_t)tp * RREC + (htid & 7) * 8;
#pragma unroll
    for (int i = 0; i < 3; ++i) rg[i] = *(const GAS v4u*)(rec + i * 64);
    rec += (3 + 3 * dir) * 64;
#pragma unroll
    for (int i = 0; i < 3; ++i) rg[3 + i] = *(const GAS v4u*)(rec + i * 64);
}
__device__ __forceinline__ void scan_store(const v4u (&rg)[6], LAS float* buf, int htid) {
    LAS float* d0 = buf + (htid >> 3) * SSTEP + (htid & 7) * 8;
#pragma unroll
    for (int i = 0; i < 6; ++i) { constexpr int SLOT[6] = {4, 0, 5, 2, 1, 3};
        const v4u wv = rg[i];
        f32x4 lo = {bflo(wv.x), bfhi(wv.x), bflo(wv.y), bfhi(wv.y)}, hi = {bflo(wv.z), bfhi(wv.z), bflo(wv.w), bfhi(wv.w)};
        if (i == 3) {
#pragma unroll
            for (int e = 0; e < 4; ++e) { lo[e] = __expf(lo[e]); hi[e] = __expf(hi[e]); } }
        LAS float* d = d0 + SLOT[i] * 64;
        *(LAS f32x4*)d = lo; *(LAS f32x4*)(d + 4) = hi; }
}
__device__ __forceinline__ void scan_phase(Frame& F, const bf16* RI, bf16* Y, const ScanCvt& C) {
    LAS float* bufs = (LAS float*)F.lds;
    constexpr int NCH = TPB / SCH;
    for (int uu = F.vcu; uu < NBATCH * NH * 2 * 4; uu += F.G) {
        const int rg = uu & 3, dir = (uu >> 2) & 1, hd = (uu >> 3) & 15, b = uu >> 7;
        const bf16* RIh = RI + (size_t)(b * NH + hd) * TPB * RREC;
        const int htid = F.tid - 256;
        v4u ra[6], rb[6];
        f32x4 xw[8];
        LAS float* wscr = (LAS float*)(F.lds + (((F.wave & 3) == 3) ? LDSCTL_OFF + 4096 : 98304 + (F.wave & 3) * 8448));
        f32x4 xc[8];
        __syncthreads();
        if (F.wave >= 4) { scan_load(rb, RIh, dir, 0, htid); scan_load(ra, RIh, dir, 1, htid); scan_store(rb, bufs, htid); scan_load(rb, RIh, dir, 2, htid); }
        __syncthreads();
        const int j = F.lane & 15, rowl = F.lane >> 4, row = rg * 16 + (F.wave & 3) * 4 + rowl;
        f32x2 S01 = {0.f, 0.f}, S23 = {0.f, 0.f};
        bf16* yb = Y + ((size_t)dir * MALL + (size_t)b * TPB) * RW + hd * 64 + row;
        for (int c = 0; c < NCH; ++c) {
            LAS float* cur = bufs + (c & 1) * (SCH * SSTEP);
            if (F.wave >= 4) {
                if (c + 1 < NCH) {
                    if ((c & 1) == 0) { scan_store(ra, bufs + (SCH * SSTEP), htid); if (c + 3 < NCH) scan_load(ra, RIh, dir, c + 3, htid); }
                    else { scan_store(rb, bufs, htid); if (c + 3 < NCH) scan_load(rb, RIh, dir, c + 3, htid); }  }
                if (C.wl >= 0 && (c & 3) == 2) { const int wi = uu * 4 + (F.wave - 4) + 1024 * (c >> 3);
                    if (wi < NW_ITEMS) { const TItem Tw = p0_resolve_wave(F.ws, C.wl, wi); if ((c & 7) == 2) p0_item_load(Tw, F.lane, xw); else p0_item_finish(Tw, xw, wscr, F.lane); } }
                if ((c & 3) == 0 && (c >> 3) < 32) { const int r = uu * 4 + (F.wave - 4) + 1024 * (c >> 3);
                    if ((c & 7) == 0) cvt_row_load(xc, ((r >= NEXP) ? C.pv + (size_t)(r - NEXP) * DM : C.pu + (size_t)r * DM) + F.lane * 32);
                    else cvt_row_store(xc, ((r >= NEXP) ? C.PV8 + (size_t)(r - NEXP) * (DM / 2) : C.PU8 + (size_t)r * (DM / 2)) + F.lane * 16, (r >= NEXP) ? C.SV + (r - NEXP) : C.SU + r, F.lane); } }
            else {
#pragma unroll
                for (int h16 = 0; h16 < 2; ++h16) {
                    const LAS float* sp = cur + (h16 * 16) * SSTEP;
                    f32x4 kk = *(const LAS f32x4*)(sp + 4 * j), bb = *(const LAS f32x4*)(sp + 64 + 4 * j), ww = *(const LAS f32x4*)(sp + 128 + 4 * j),
                          ke = *(const LAS f32x4*)(sp + 192 + 4 * j), rr = *(const LAS f32x4*)(sp + 256 + 4 * j);
                    float ykeep = 0.f, ypart; f32x2 u2, t2, vv; vv.x = sp[320 + row];
#define SCAN_DPP(r, ctl) "v_add_f32_dpp " r ", " r ", " r " " ctl " row_mask:0xf bank_mask:0xf bound_ctrl:1\n\t"
#define SCAN_MAIN(SEL) asm volatile( \
                        "v_pk_mul_f32 v[242:243], %[kexy], %[vv] op_sel_hi:[1,0]\n\t" \
                        "v_add_f32 v246, v250, v251\n\t" \
                        "v_add_f32_dpp v248, %[yp], %[yp] quad_perm:[1,0,3,2] row_mask:0xf bank_mask:0xf bound_ctrl:1\n\t" \
                        "v_pk_mul_f32 v[244:245], %[kezw], %[vv] op_sel_hi:[1,0]\n\t" \
                        SCAN_DPP("v246", "quad_perm:[1,0,3,2]") SCAN_DPP("v248", "quad_perm:[2,3,0,1]") \
                        "v_pk_fma_f32 %[s01], %[s01], %[wwxy], v[242:243]\n\t" \
                        SCAN_DPP("v246", "quad_perm:[2,3,0,1]") SCAN_DPP("v248", "row_half_mirror") \
                        "v_pk_fma_f32 %[s23], %[s23], %[wwzw], v[244:245]\n\t" \
                        SCAN_DPP("v246", "row_half_mirror") SCAN_DPP("v248", "row_mirror") \
                        SEL "\n\t" \
                        SCAN_DPP("v246", "row_mirror") \
                        "v_pk_fma_f32 %[s01], %[bbxy], v[246:247], %[s01] op_sel_hi:[1,0,1] neg_lo:[0,1,0] neg_hi:[0,1,0]\n\t" \
                        "v_pk_fma_f32 %[s23], %[bbzw], v[246:247], %[s23] op_sel_hi:[1,0,1] neg_lo:[0,1,0] neg_hi:[0,1,0]\n\t" \
                        "v_pk_mul_f32 v[252:253], %[s01], %[rrxy]" \
                        : [s01] "+v"(S01), [s23] "+v"(S23), [yk] "+v"(ykeep), "={v[252:253]}"(u2) \
                        : [kexy] "v"(ke.xy), [kezw] "v"(ke.zw), [vv] "v"(vv), [wwxy] "v"(ww.xy), [wwzw] "v"(ww.zw), [bbxy] "v"(bb.xy), [bbzw] "v"(bb.zw), [rrxy] "v"(rr.xy), [yp] "v"(ypart), [msk] "s"(msk), "{v[250:251]}"(t2) \
                        : "v242", "v243", "v244", "v245", "v246", "v247", "v248")
                    asm volatile("v_pk_mul_f32 v[250:251], %[s01], %[kxy]\n\tv_mov_b32 %[yp], 0\n\tv_pk_fma_f32 v[250:251], %[s23], %[kzw], v[250:251]"
                                 : "=&{v[250:251]}"(t2), [yp] "=&v"(ypart) : [s01] "v"(S01), [s23] "v"(S23), [kxy] "v"(kk.xy), [kzw] "v"(kk.zw));
#pragma unroll
                    for (int st = 0; st < 16; ++st) {
                        f32x4 nkk = kk, nbb = bb, nww = ww, nke = ke, nrr = rr; f32x2 nvv = vv;
                        const LAS float* sn = sp + (st + 1) * SSTEP;
                        if (st + 1 < 16) { nkk = *(const LAS f32x4*)(sn + 4 * j); nke = *(const LAS f32x4*)(sn + 192 + 4 * j); nvv.x = sn[320 + row]; nww = *(const LAS f32x4*)(sn + 128 + 4 * j); nbb = *(const LAS f32x4*)(sn + 64 + 4 * j);
                            nrr = *(const LAS f32x4*)(sn + 256 + 4 * j); }
                        const unsigned long long msk = 0x0001000100010001ull << ((st + 15) & 15);
                        if (st > 0) SCAN_MAIN("v_cndmask_b32_e64 %[yk], %[yk], v248, %[msk]"); else SCAN_MAIN("s_nop 0");
                        if (st + 1 < 16)
                            asm volatile("v_pk_mul_f32 v[250:251], %[s01], %[kxy]\n\tv_pk_fma_f32 v[252:253], %[s23], %[rrzw], v[252:253]\n\tv_pk_fma_f32 v[250:251], %[s23], %[kzw], v[250:251]\n\tv_add_f32 %[yp], v252, v253"
                                         : "=&{v[250:251]}"(t2), "={v[252:253]}"(u2), [yp] "=&v"(ypart) : [s01] "v"(S01), [s23] "v"(S23), [kxy] "v"(nkk.xy), [kzw] "v"(nkk.zw), [rrzw] "v"(rr.zw), "1"(u2));
                        else
                            asm volatile("s_nop 0\n\tv_pk_fma_f32 v[252:253], %[s23], %[rrzw], v[252:253]" : "={v[252:253]}"(u2) : [s23] "v"(S23), [rrzw] "v"(rr.zw), "0"(u2));
                        kk = nkk; bb = nbb; ww = nww; ke = nke; rr = nrr; vv = nvv;
                        __builtin_amdgcn_sched_barrier(0);
                    }
#undef SCAN_MAIN
#undef SCAN_DPP
                    { const float y = red16(u2.x + u2.y); ykeep = (j == 15) ? y : ykeep; }
                    const int tp = scan_tp(dir, c * SCH + h16 * 16 + j);
                    *(GAS bf16*)(yb + (size_t)tp * RW) = (bf16)f2bf(ykeep);
                }
            }
            __syncthreads();
        }
    }
}

constexpr int AKP = 208, AVP = 192;
constexpr int ATILE = 64 * AKP + 64 * AVP;
__device__ __forceinline__ bf16x8 pack8(const f32x16& x, int s) {
    v4u p; p.x = pk2(x[8 * s + 0], x[8 * s + 1]); p.y = pk2(x[8 * s + 2], x[8 * s + 3]); p.z = pk2(x[8 * s + 4], x[8 * s + 5]); p.w = pk2(x[8 * s + 6], x[8 * s + 7]);
    return __builtin_bit_cast(bf16x8, p);
}
__device__ __forceinline__ void attn_phase(Frame& F, const bf16* Q, const bf16* K, const bf16* V, bf16* YB, int with_ctx) {
    const int lane = F.lane, half = lane >> 5, l31 = lane & 31, l16 = lane & 15, g1 = (lane >> 4) & 1;
    const int nunits = NBATCH * NH * 32 + (with_ctx ? NBATCH * NH : 0);
    for (int uu = F.vcu; uu < nunits; uu += F.G) {
        int bh, q0, nkt;
        if (uu < NBATCH * NH * 32) { bh = uu >> 5; q0 = CTXL + (uu & 31) * 256; nkt = TPB / 64; } else { bh = uu - NBATCH * NH * 32; q0 = 0; nkt = CTXL / 64; }
        const bf16* Kh = K + (size_t)bh * TPB * QKD; const bf16* Vh = V + (size_t)bh * TPB * 64; const bf16* Qh = Q + (size_t)bh * TPB * QKD;
        const int tq = q0 + F.wave * 32 + l31;
        bf16x8 qf[6];
#pragma unroll
        for (int ks = 0; ks < 6; ++ks) qf[ks] = *(const GAS bf16x8*)(Qh + (size_t)tq * QKD + 16 * ks + 8 * half);
        f32x16 o0, o1;
#pragma unroll
        for (int i = 0; i < 16; ++i) { o0[i] = 0.f; o1[i] = 0.f; }
        float l_run = 0.f;
        f32x16 cinit;
#pragma unroll
        for (int i = 0; i < 16; ++i) cinit[i] = 0.f;
        asm volatile("" : "+v"(cinit));
        const int kc1 = F.tid + 512; const bool k1ok = kc1 < 768;
        const unsigned kd0 = (unsigned)((F.tid / 12) * AKP + (F.tid % 12) * 16), kd1 = (unsigned)((kc1 / 12) * AKP + (kc1 % 12) * 16), vd = (unsigned)(64 * AKP + (F.tid >> 3) * AVP + (F.tid & 7) * 16);
        v4u kr0, kr1 = {0, 0, 0, 0}, vr;
        kr0 = *(const GAS v4u*)(Kh + (size_t)F.tid * 8); if (k1ok) kr1 = *(const GAS v4u*)(Kh + (size_t)kc1 * 8); vr = *(const GAS v4u*)(Vh + (size_t)F.tid * 8);
        __syncthreads();
        *(LAS v4u*)(F.lds + kd0) = kr0; if (k1ok) *(LAS v4u*)(F.lds + kd1) = kr1; *(LAS v4u*)(F.lds + vd) = vr;
        __syncthreads();
        for (int kt = 0; kt < nkt; ++kt) {
            const bool more = kt + 1 < nkt;
            if (more) { const bf16* kn = Kh + (size_t)(kt + 1) * 64 * QKD; const bf16* vn = Vh + (size_t)(kt + 1) * 64 * 64;
                kr0 = *(const GAS v4u*)(kn + (size_t)F.tid * 8); if (k1ok) kr1 = *(const GAS v4u*)(kn + (size_t)kc1 * 8); vr = *(const GAS v4u*)(vn + (size_t)F.tid * 8); }
            LAS unsigned char* Kb = F.lds + (kt & 1) * ATILE; LAS unsigned char* Vb = Kb + 64 * AKP;
            f32x16 s0, s1;
            { bf16x8 ka[6], kb2[6];
#pragma unroll
              for (int ks = 0; ks < 6; ++ks) { ka[ks] = *(const LAS bf16x8*)(Kb + l31 * AKP + (16 * ks + 8 * half) * 2); kb2[ks] = *(const LAS bf16x8*)(Kb + (32 + l31) * AKP + (16 * ks + 8 * half) * 2); }
              s0 = MFMA32(ka[0], qf[0], cinit); s1 = MFMA32(kb2[0], qf[0], cinit);
#pragma unroll
              for (int ks = 1; ks < 6; ++ks) { s0 = MFMA32(ka[ks], qf[ks], s0); s1 = MFMA32(kb2[ks], qf[ks], s1); }
              __builtin_amdgcn_sched_group_barrier(0x100, 12, 0); __builtin_amdgcn_sched_group_barrier(0x8, 12, 0); }
            bf16x8 va[2][2][2];
#pragma unroll
            for (int t = 0; t < 2; ++t)
#pragma unroll
                for (int s = 0; s < 2; ++s) { const int kb = 32 * t + 16 * s + 4 * half + (l16 >> 2);
#pragma unroll
                    for (int dvt = 0; dvt < 2; ++dvt) { const LAS unsigned char* vp = Vb + kb * AVP + (32 * dvt + 16 * g1 + 4 * (l16 & 3)) * 2;
                        const s16x4 lo = __builtin_amdgcn_ds_read_tr16_b64_v4i16((LAS s16x4*)vp), hi = __builtin_amdgcn_ds_read_tr16_b64_v4i16((LAS s16x4*)(vp + 8 * AVP));
                        va[t][s][dvt] = __builtin_shufflevector(lo, hi, 0, 1, 2, 3, 4, 5, 6, 7); } }
            __builtin_amdgcn_sched_group_barrier(0x100, 16, 0);
            float mx = s0[0];
#pragma unroll
            for (int i = 1; i < 16; ++i) mx = fmaxf(mx, s0[i]);
#pragma unroll
            for (int i = 0; i < 16; ++i) mx = fmaxf(mx, s1[i]);
            if (kt == 0 || __any(mx > 8.0f)) {
                mx = fmaxf(mx, bpermf(lane ^ 32, mx));
                const float d = (kt == 0) ? mx : fmaxf(mx, 0.f), alpha = (kt == 0) ? 1.0f : __builtin_amdgcn_exp2f(-d);
                l_run *= alpha;
#pragma unroll
                for (int i = 0; i < 16; ++i) { o0[i] *= alpha; o1[i] *= alpha; s0[i] -= d; s1[i] -= d; cinit[i] -= d; }
                asm volatile("" : "+v"(cinit));
            }
#pragma unroll
            for (int i = 0; i < 16; ++i) { s0[i] = __builtin_amdgcn_exp2f(s0[i]); s1[i] = __builtin_amdgcn_exp2f(s1[i]); }
            float ps = 0.f;
#pragma unroll
            for (int i = 0; i < 16; ++i) ps += s0[i] + s1[i];
            l_run += ps;
            { bf16x8 pf[2][2];
#pragma unroll
              for (int t = 0; t < 2; ++t)
#pragma unroll
                  for (int s = 0; s < 2; ++s) pf[t][s] = pack8(t == 0 ? s0 : s1, s);
#pragma unroll
              for (int t = 0; t < 2; ++t)
#pragma unroll
                  for (int s = 0; s < 2; ++s) { o0 = MFMA32(va[t][s][0], pf[t][s], o0); o1 = MFMA32(va[t][s][1], pf[t][s], o1); } }
            if (more) { LAS unsigned char* nb = F.lds + ((kt + 1) & 1) * ATILE;
                *(LAS v4u*)(nb + kd0) = kr0; if (k1ok) *(LAS v4u*)(nb + kd1) = kr1; *(LAS v4u*)(nb + vd) = vr; }
            __syncthreads();
        }
        const float linv = (DBG_SKIP & 4) ? 0.f : 1.0f / (l_run + bpermf(lane ^ 32, l_run));
        const int b = bh >> 4, hd = bh & 15;
        bf16* op = YB + ((size_t)b * TPB + tq) * RW + hd * 64 + 4 * half;
#pragma unroll
        for (int g = 0; g < 4; ++g) {
            v2u w; w.x = pk2(o0[4 * g] * linv, o0[4 * g + 1] * linv); w.y = pk2(o0[4 * g + 2] * linv, o0[4 * g + 3] * linv); *(GAS v2u*)(op + 8 * g) = w;
            w.x = pk2(o1[4 * g] * linv, o1[4 * g + 1] * linv); w.y = pk2(o1[4 * g + 2] * linv, o1[4 * g + 3] * linv); *(GAS v2u*)(op + 32 + 8 * g) = w; }
    }
}

struct RoRaw { v4u va, vc, ya[2], yc[2], ga[2], gc[2]; float b0[2], b1[2]; };
__device__ __forceinline__ void readout_load(RoRaw& r, int m, int lane, const bf16* Y, const bf16* GG, const float* BON, const bf16* RI) {
    const int hd = lane >> 2, ch0 = hd * 64 + (lane & 3) * 16, b = m / TPB, tp = m - b * TPB;
    const bf16* rec = RI + ((size_t)(b * NH + hd) * TPB + tp) * RREC + 128 + (lane & 3) * 16;
    r.va = *(const GAS v4u*)rec; r.vc = *(const GAS v4u*)(rec + 8);
#pragma unroll
    for (int d = 0; d < 2; ++d) { const bf16* yp = Y + ((size_t)d * MALL + m) * RW + ch0; const bf16* gp = GG + ((size_t)d * MALL + m) * RW + ch0;
        r.ya[d] = *(const GAS v4u*)yp; r.yc[d] = *(const GAS v4u*)(yp + 8); r.ga[d] = *(const GAS v4u*)gp; r.gc[d] = *(const GAS v4u*)(gp + 8);
        r.b0[d] = BON[((size_t)d * MALL + m) * 32 + 2 * hd]; r.b1[d] = BON[((size_t)d * MALL + m) * 32 + 2 * hd + 1]; }
}
__device__ __forceinline__ void readout_phase(Frame& F, const bf16* Y, const bf16* GG, const float* BON, const bf16* RI, const float* ln_w, const float* ln_b, bf16* YA) {
    const int gw = F.vcu * NWAVES + F.wave, NGW = F.G * NWAVES, lane = F.lane, hd = lane >> 2, ch0 = hd * 64 + (lane & 3) * 16;
    RoRaw cur, nxt;
    if (gw < MALL) readout_load(cur, gw, lane, Y, GG, BON, RI);
    for (int m = gw; m < MALL; m += NGW) {
        if (m + NGW < MALL) readout_load(nxt, m + NGW, lane, Y, GG, BON, RI);
        float vv[16], out[16];
        unpack8(cur.va, *(float(*)[8])&vv[0]); unpack8(cur.vc, *(float(*)[8])&vv[8]);
#pragma unroll
        for (int e = 0; e < 16; ++e) out[e] = 0.f;
#pragma unroll
        for (int d = 0; d < 2; ++d) {
            float y[16], g[16];
            unpack8(cur.ya[d], *(float(*)[8])&y[0]); unpack8(cur.yc[d], *(float(*)[8])&y[8]); unpack8(cur.ga[d], *(float(*)[8])&g[0]); unpack8(cur.gc[d], *(float(*)[8])&g[8]);
            float s = 0.f;
#pragma unroll
            for (int e = 0; e < 16; ++e) s += y[e];
            s = dpp_add<0xB1>(s); s = dpp_add<0x4E>(s);
            const float mean = s * (1.f / 64.f); float q = 0.f;
#pragma unroll
            for (int e = 0; e < 16; ++e) { y[e] -= mean; q += y[e] * y[e]; }
            q = dpp_add<0xB1>(q); q = dpp_add<0x4E>(q);
            const float rstd = rsqrtf(q * (1.f / 64.f) + 64e-5f), bon = cur.b0[d] + cur.b1[d];
#pragma unroll
            for (int e = 0; e < 16; ++e) out[e] += (y[e] * rstd * ln_w[ch0 + e] + ln_b[ch0 + e] + bon * vv[e]) * g[e];
        }
        if (DBG_SKIP & 2) {
#pragma unroll
            for (int e = 0; e < 16; ++e) out[e] = 0.f; }
        v4u o0, o1;
        o0.x = pk2(out[0], out[1]); o0.y = pk2(out[2], out[3]); o0.z = pk2(out[4], out[5]); o0.w = pk2(out[6], out[7]);
        o1.x = pk2(out[8], out[9]); o1.y = pk2(out[10], out[11]); o1.z = pk2(out[12], out[13]); o1.w = pk2(out[14], out[15]);
        *(GAS v4u*)(YA + (size_t)m * RW + ch0) = o0; *(GAS v4u*)(YA + (size_t)m * RW + ch0 + 8) = o1;
        cur = nxt;
    }
}


__device__ __forceinline__ unsigned f2key(float f) { const unsigned u = __builtin_bit_cast(unsigned, f); return (u & 0x80000000u) ? ~u : (u | 0x80000000u); }
__device__ __forceinline__ float key2f(unsigned k) { const unsigned u = (k & 0x80000000u) ? (k & 0x7fffffffu) : ~k; return __builtin_bit_cast(float, u); }
template <int CTRL, int RM> __device__ __forceinline__ unsigned dpp_umax(unsigned x) {
    const unsigned y = (unsigned)__builtin_amdgcn_update_dpp(0, (int)x, CTRL, RM, 0xf, false); return x > y ? x : y; }
__device__ __forceinline__ unsigned row_umax(unsigned x) { x = dpp_umax<0xB1, 0xf>(x); x = dpp_umax<0x4E, 0xf>(x); x = dpp_umax<0x141, 0xf>(x); x = dpp_umax<0x140, 0xf>(x); return x; }
#define SEL_CE(a_, b_) do { const unsigned hi_ = (a_) > (b_) ? (a_) : (b_), lo_ = (a_) > (b_) ? (b_) : (a_); (a_) = hi_; (b_) = lo_; } while (0)
__device__ __forceinline__ void sel_keys8(unsigned (&k)[8], const _Float16* p, int id0) {
    typedef _Float16 h8 __attribute__((ext_vector_type(8)));
    const h8 hv = *(const GAS h8*)p;
    const f32x4 v0 = {(float)hv[0], (float)hv[1], (float)hv[2], (float)hv[3]}, v1 = {(float)hv[4], (float)hv[5], (float)hv[6], (float)hv[7]};
    k[0] = (f2key(v0.x) & ~127u) | (unsigned)(id0 + 0); k[1] = (f2key(v0.y) & ~127u) | (unsigned)(id0 + 1); k[2] = (f2key(v0.z) & ~127u) | (unsigned)(id0 + 2); k[3] = (f2key(v0.w) & ~127u) | (unsigned)(id0 + 3);
    k[4] = (f2key(v1.x) & ~127u) | (unsigned)(id0 + 4); k[5] = (f2key(v1.y) & ~127u) | (unsigned)(id0 + 5); k[6] = (f2key(v1.z) & ~127u) | (unsigned)(id0 + 6); k[7] = (f2key(v1.w) & ~127u) | (unsigned)(id0 + 7);
    SEL_CE(k[0], k[1]); SEL_CE(k[2], k[3]); SEL_CE(k[4], k[5]); SEL_CE(k[6], k[7]); SEL_CE(k[0], k[2]); SEL_CE(k[1], k[3]); SEL_CE(k[4], k[6]); SEL_CE(k[5], k[7]); SEL_CE(k[1], k[2]); SEL_CE(k[5], k[6]);
    SEL_CE(k[0], k[4]); SEL_CE(k[1], k[5]); SEL_CE(k[2], k[6]); SEL_CE(k[3], k[7]); SEL_CE(k[2], k[4]); SEL_CE(k[3], k[5]); SEL_CE(k[1], k[2]); SEL_CE(k[3], k[4]); SEL_CE(k[5], k[6]);
}
__device__ __forceinline__ void top16_rows2(const _Float16* pa, const _Float16* pb, int l16, unsigned& ra, unsigned& rb) {
    unsigned ka[8], kb[8]; sel_keys8(ka, pa + 8 * l16, 8 * l16); sel_keys8(kb, pb + 8 * l16, 8 * l16);
    ra = 0u; rb = 0u;
#pragma unroll
    for (int it = 0; it < 16; ++it) {
        const unsigned ma = row_umax(ka[0]), mb = row_umax(kb[0]); const bool oa = ka[0] == ma, ob = kb[0] == mb;
#pragma unroll
        for (int e = 0; e < 7; ++e) { ka[e] = oa ? ka[e + 1] : ka[e]; kb[e] = ob ? kb[e + 1] : kb[e]; }
        ka[7] = oa ? 0u : ka[7]; kb[7] = ob ? 0u : kb[7];
        ra = (l16 == it) ? ma : ra; rb = (l16 == it) ? mb : rb;
    }
}
struct SelP { const float* SC; int* ESEL; float* EGATE; int last; };
__device__ __forceinline__ void select_token(const _Float16* srow, int lane, int (&eidx)[2], float (&egate)[2]) {
    const int row = lane >> 4, l16 = lane & 15, rbase = lane & 48;
    const int i1 = (int)((0x3332222211111111ull >> (4 * l16)) & 15ull), j1 = (int)((0x2104321076543210ull >> (4 * l16)) & 15ull), i2 = (int)((0xdcba987766554443ull >> (4 * l16)) & 15ull), j2 = (int)((0x0000001010102103ull >> (4 * l16)) & 15ull);
#pragma unroll
    for (int G = 0; G < 2; ++G) {
                const _Float16* hrow = srow + (4 * G + row) * 256;
                unsigned recA, recB; top16_rows2(hrow, hrow + 128, l16, recA, recB);
                const float va = key2f(recA & ~127u), vb = key2f(recB & ~127u);
                const float a0 = bpermf(rbase, va), a1 = bpermf(rbase + i1, va), b1 = bpermf(rbase + j1, vb), a2 = bpermf(rbase + i2, va), b2 = bpermf(rbase + j2, vb), a3 = bpermf(rbase + 14 + (l16 & 1), va), b0 = bpermf(rbase, vb);
                unsigned ck[4];
                ck[0] = (f2key(a0 + vb) & ~255u) | (unsigned)l16; ck[1] = (f2key(a1 + b1) & ~255u) | (unsigned)(16 * i1 + j1); ck[2] = (f2key(a2 + b2) & ~255u) | (unsigned)(16 * i2 + j2);
                ck[3] = (l16 < 2) ? ((f2key(a3 + b0) & ~255u) | (unsigned)(16 * (14 + l16))) : 0u;
                SEL_CE(ck[0], ck[1]); SEL_CE(ck[2], ck[3]); SEL_CE(ck[0], ck[2]); SEL_CE(ck[1], ck[3]); SEL_CE(ck[1], ck[2]);
                unsigned rec = 0u;
#pragma unroll
                for (int it = 0; it < 16; ++it) {
                    const unsigned mh = row_umax(ck[0]); const bool own = ck[0] == mh;
                    ck[0] = own ? ck[1] : ck[0]; ck[1] = own ? ck[2] : ck[1]; ck[2] = own ? ck[3] : ck[2]; ck[3] = own ? 0u : ck[3];
                    rec = (l16 == it) ? mh : rec;
                }
                const float ts = key2f(rec & ~255u), tmax = bpermf(rbase, ts);
                const float ev = __expf(ts - tmax), esum = red16(ev);
                const int ci = (int)((rec >> 4) & 15u), cj = (int)(rec & 15u);
                const int expert = bpermi(rbase + ci, (int)(recA & 127u)) * 128 + bpermi(rbase + cj, (int)(recB & 127u));
                eidx[G] = expert; egate[G] = ev / esum;
    }
}
struct PeerP { const _Float16* SC; const float* nmod; const float* ng; bf16* Hout;   const int* ESEL; const float* EGATE; const bf16* H; const unsigned char* PU; const unsigned char* PV; const float* SU; const float* SV; bf16* X; const float* mod;   const float* fin_g; float* out; int last; int dry; };
__device__ __forceinline__ void peer_phase(Frame& F, const PeerP& P) {
    const int gw = F.vcu * NWAVES + F.wave, NGW = F.G * NWAVES, lane = F.lane;
    float pr_s2 = 0.f, pr_d2 = 0.f, pr_tg = 0.f, pr_n = 0.f;
    int m0 = gw; while (m0 < MALL && P.last && (m0 % TPB) < CTXL) m0 += NGW;
    v4u ph0 = {0u, 0u, 0u, 0u}, ph1 = ph0, ph2 = ph0, ph3 = ph0;
    if (m0 < MALL) { const bf16* hp = P.H + (size_t)m0 * DM + lane * 32; ph0 = *(const GAS v4u*)hp; ph1 = *(const GAS v4u*)(hp + 8); ph2 = *(const GAS v4u*)(hp + 16); ph3 = *(const GAS v4u*)(hp + 24); }
    for (int m = m0, mn = 0; m < MALL; m = mn) {
        mn = m + NGW; while (mn < MALL && P.last && (mn % TPB) < CTXL) mn += NGW;
        const int b = m / TPB, tp = m - b * TPB;
        const int mr = tp < CTXL ? 2 : b;
        const int emask_ = (P.dry & 2) ? 1023 : 0x7fffffff;
        int eidx[2]; float egate[2]; select_token(P.SC + (size_t)m * DM, lane, eidx, egate);
        eidx[0] &= emask_; eidx[1] &= emask_;
        typedef int v8i __attribute__((ext_vector_type(8)));
        LAS unsigned char* hq = F.lds + F.wave * 4096;
        { const v4u hv[4] = {ph0, ph1, ph2, ph3}; v4u o[2];
#pragma unroll
          for (int j = 0; j < 4; ++j) { int w0 = 0, w1 = 0;
              w0 = __builtin_amdgcn_cvt_pk_fp8_f32(bflo(hv[j].x), bfhi(hv[j].x), w0, false); w0 = __builtin_amdgcn_cvt_pk_fp8_f32(bflo(hv[j].y), bfhi(hv[j].y), w0, true);
              w1 = __builtin_amdgcn_cvt_pk_fp8_f32(bflo(hv[j].z), bfhi(hv[j].z), w1, false); w1 = __builtin_amdgcn_cvt_pk_fp8_f32(bflo(hv[j].w), bfhi(hv[j].w), w1, true);
              o[j >> 1][2 * (j & 1)] = (unsigned)w0; o[j >> 1][2 * (j & 1) + 1] = (unsigned)w1; }
          *(LAS v4u*)(hq + lane * 32) = o[0]; *(LAS v4u*)(hq + lane * 32 + 16) = o[1];
          unsigned z_ = 0u; asm volatile("" : "+v"(z_));
          if (lane < 2) *(LAS v4u*)(hq + 2048 + lane * 16) = (v4u){z_, z_, z_, z_}; }
        const int li = lane & 15, kb = lane >> 4;
        int rowoff[8];
#pragma unroll
        for (int g = 0; g < 8; ++g) rowoff[g] = bpermi(16 * (g & 3) + li, eidx[g >> 2]) * (DM / 2) + 16 * kb;
        f32x4 dacc[8];
#pragma unroll
        for (int g = 0; g < 8; ++g) dacc[g] = (f32x4){0.f, 0.f, 0.f, 0.f};
        const unsigned hb = (li == 0) ? (unsigned)(16 * kb) : 2048u;
        const unsigned hb2 = (li == 0) ? 64u : 16u;
        const unsigned hstep = (li == 0) ? 128u : 0u;
        v4u ua[8], ub[8];
#pragma unroll
        for (int g = 0; g < 8; ++g) ua[g] = *(const GAS v4u*)(P.PU + (unsigned)rowoff[g]);
#pragma unroll 1
        for (int s = 0; s < ((P.dry & 4) ? 2 : 16); s += 2) {
#pragma unroll
            for (int g = 0; g < 8; ++g) ub[g] = *(const GAS v4u*)(P.PU + (unsigned)(rowoff[g] + 64 * (s + 1)));
            { const v4u b0 = *(const LAS v4u*)(hq + hb + hstep * s), b1 = *(const LAS v4u*)(hq + hb + hstep * s + hb2);
              const v8i bf = {(int)b0.x, (int)b0.y, (int)b0.z, (int)b0.w, (int)b1.x, (int)b1.y, (int)b1.z, (int)b1.w};
#pragma unroll
              for (int g = 0; g < 8; ++g) { const v8i af = {(int)ua[g].x, (int)ua[g].y, (int)ua[g].z, (int)ua[g].w, 0, 0, 0, 0};
                  dacc[g] = __builtin_amdgcn_mfma_scale_f32_16x16x128_f8f6f4(af, bf, dacc[g], 4, 0, 0, 0x7f7f7f7f, 0, 0x7f7f7f7f); } }
            if (s + 2 < 16) {
#pragma unroll
                for (int g = 0; g < 8; ++g) ua[g] = *(const GAS v4u*)(P.PU + (unsigned)(rowoff[g] + 64 * (s + 2))); }
            { const v4u b0 = *(const LAS v4u*)(hq + hb + hstep * (s + 1)), b1 = *(const LAS v4u*)(hq + hb + hstep * (s + 1) + hb2);
              const v8i bf = {(int)b0.x, (int)b0.y, (int)b0.z, (int)b0.w, (int)b1.x, (int)b1.y, (int)b1.z, (int)b1.w};
#pragma unroll
              for (int g = 0; g < 8; ++g) { const v8i af = {(int)ub[g].x, (int)ub[g].y, (int)ub[g].z, (int)ub[g].w, 0, 0, 0, 0};
                  dacc[g] = __builtin_amdgcn_mfma_scale_f32_16x16x128_f8f6f4(af, bf, dacc[g], 4, 0, 0, 0x7f7f7f7f, 0, 0x7f7f7f7f); } }
        }
        float coef[2];
#pragma unroll
        for (int sl = 0; sl < 2; ++sl) { float mydot = 0.f;
#pragma unroll
            for (int g4 = 0; g4 < 4; ++g4)
#pragma unroll
                for (int r = 0; r < 4; ++r) { const float t = bpermf(16 * ((lane >> 2) & 3), dacc[4 * sl + g4][r]); if ((lane >> 4) == g4 && (lane & 3) == r) mydot = t; }
            mydot *= P.SU[eidx[sl]];
            if (DBG_PROBE == 4) {
                float ref = 0.f;
                for (int e = 0; e < 64; ++e) { const int ex = __builtin_amdgcn_readlane(eidx[sl], e); const v4u uu = *(const GAS v4u*)(P.PU + (size_t)ex * (DM / 2) + lane * 16); float s1 = 0.f;
                    const v4u hv2[4] = {*(const GAS v4u*)(P.H + (size_t)m * DM + lane * 32), *(const GAS v4u*)(P.H + (size_t)m * DM + lane * 32 + 8), *(const GAS v4u*)(P.H + (size_t)m * DM + lane * 32 + 16), *(const GAS v4u*)(P.H + (size_t)m * DM + lane * 32 + 24)};
#pragma unroll
                    for (int d = 0; d < 4; ++d) { const unsigned w = uu[d]; const unsigned hw[4] = {hv2[d].x, hv2[d].y, hv2[d].z, hv2[d].w};
                        f32x2 x = __builtin_amdgcn_cvt_scalef32_pk_f32_fp4(w, 1.0f, 0); s1 += x.x * bflo(hw[0]) + x.y * bfhi(hw[0]); x = __builtin_amdgcn_cvt_scalef32_pk_f32_fp4(w, 1.0f, 1); s1 += x.x * bflo(hw[1]) + x.y * bfhi(hw[1]);
                        x = __builtin_amdgcn_cvt_scalef32_pk_f32_fp4(w, 1.0f, 2); s1 += x.x * bflo(hw[2]) + x.y * bfhi(hw[2]); x = __builtin_amdgcn_cvt_scalef32_pk_f32_fp4(w, 1.0f, 3); s1 += x.x * bflo(hw[3]) + x.y * bfhi(hw[3]); }
                    const float tot = wave_sum_u(s1) * P.SU[ex]; if (lane == e) ref = tot; }
                pr_s2 = fmaxf(pr_s2, wave_max_u(fabsf(mydot - ref) / (fabsf(ref) + 0.25f))); pr_n = 1.f; }
            coef[sl] = egate[sl] * 0.5f * mydot * (1.0f + erff(mydot * 0.70710678f));
            if ((DBG_SKIP & 16) && sl == 0) coef[sl] = 0.f;
            if ((DBG_SKIP & 32) && sl == 1) coef[sl] = 0.f;
        }
        const float coefs[2] = {coef[0] * P.SV[eidx[0]], coef[1] * P.SV[eidx[1]]};
        f32x2 acc2[16];
#pragma unroll
        for (int i = 0; i < 16; ++i) acc2[i] = (f32x2){0.f, 0.f};
#define PEER_LOADV(U, C, e0_) do { const int e1_ = (e0_); const int ev_ = (e1_ & 64) ? eidx[1] : eidx[0]; const int cv_ = __builtin_bit_cast(int, (e1_ & 64) ? coefs[1] : coefs[0]); \
            _Pragma("unroll") for (int q = 0; q < 8; ++q) { const int ex = __builtin_amdgcn_readlane(ev_, (e1_ & 63) + q); U[q] = *(const GAS v4u*)(P.PV + (size_t)ex * (DM / 2) + lane * 16); \
            C[q] = __builtin_bit_cast(float, __builtin_amdgcn_readlane(cv_, (e1_ & 63) + q)); } } while (0)
#define PEER_AXPY(U, C) do { if (P.dry & 32) { _Pragma("unroll") for (int q = 0; q < 8; ++q) _Pragma("unroll") for (int d = 0; d < 4; ++d) acc2[d].x += __builtin_bit_cast(float, U[q][d] & 0x3fffffffu) * C[q]; } else \
            _Pragma("unroll") for (int q = 0; q < 8; ++q) _Pragma("unroll") for (int d = 0; d < 4; ++d) { const unsigned w = U[q][d]; \
            acc2[4 * d + 0] = __builtin_amdgcn_cvt_scalef32_pk_f32_fp4(w, 1.0f, 0) * C[q] + acc2[4 * d + 0]; acc2[4 * d + 1] = __builtin_amdgcn_cvt_scalef32_pk_f32_fp4(w, 1.0f, 1) * C[q] + acc2[4 * d + 1]; \
            acc2[4 * d + 2] = __builtin_amdgcn_cvt_scalef32_pk_f32_fp4(w, 1.0f, 2) * C[q] + acc2[4 * d + 2]; acc2[4 * d + 3] = __builtin_amdgcn_cvt_scalef32_pk_f32_fp4(w, 1.0f, 3) * C[q] + acc2[4 * d + 3]; } } while (0)
        if (mn < MALL) {
            const bf16* hp = P.H + (size_t)mn * DM + lane * 32; ph0 = *(const GAS v4u*)hp; ph1 = *(const GAS v4u*)(hp + 8); ph2 = *(const GAS v4u*)(hp + 16); ph3 = *(const GAS v4u*)(hp + 24); }
        v4u xpre[4];
        { const bf16* xr0 = P.X + (size_t)m * DM + lane * 32;
#pragma unroll
          for (int hq = 0; hq < 4; ++hq) xpre[hq] = *(const GAS v4u*)(xr0 + hq * 8); }
        {
            v4u ua[8], ub[8]; float ca[8], cb[8];
            PEER_LOADV(ua, ca, 0);
#pragma unroll 1
            for (int it = 0; it < ((P.dry & 8) ? 2 : 8); ++it) {
                PEER_LOADV(ub, cb, 16 * it + 8); PEER_AXPY(ua, ca);
                if (it < 7) PEER_LOADV(ua, ca, 16 * it + 16);
                PEER_AXPY(ub, cb);
            }
        }
#undef PEER_LOADV
#undef PEER_AXPY
        float acc[32];
#pragma unroll
        for (int i = 0; i < 16; ++i) { acc[2 * i] = acc2[i].x; acc[2 * i + 1] = acc2[i].y; }
        if (P.dry) { float sm_ = 0.f;
#pragma unroll
            for (int i = 0; i < 32; ++i) sm_ += acc[i];
            if (sm_ == 1.2345e-30f) P.X[lane] = sm_;
            if (!(P.dry & 16)) continue; }
        if (DBG_SKIP & 1) {
#pragma unroll
            for (int i = 0; i < 32; ++i) acc[i] = 0.f; }
        if (((DBG_SKIP & 64) && !P.last) || ((DBG_SKIP & 128) && P.last)) {
#pragma unroll
            for (int i = 0; i < 32; ++i) acc[i] = 0.f; }
        if (DBG_SKIP & 8) {
#pragma unroll
            for (int i = 0; i < 32; ++i) acc[i] = -acc[i]; }
        int m_l = m, lane_l = lane; asm volatile("" : "+v"(m_l), "+v"(lane_l));
        const int b_l = m_l / TPB, tp_l = m_l - b_l * TPB, mr_l = tp_l < CTXL ? 2 : b_l;
        bf16* xr = (P.dry ? (bf16*)(F.ws + 760 * MiB) : P.X) + (size_t)m_l * DM + lane_l * 32; const float* g2 = P.mod + (size_t)mr_l * 12288 + 5 * DM + lane_l * 32;
        float ss = 0.f;
#pragma unroll
        for (int hq = 0; hq < 4; ++hq) { const int c = hq * 8; float xf[8]; unpack8(xpre[hq], xf);
            const f32x4 g0 = *(const GAS f32x4*)(g2 + c), g1 = *(const GAS f32x4*)(g2 + c + 4);
#pragma unroll
            for (int e = 0; e < 8; ++e) { const float xv = xf[e] + (e < 4 ? g0[e & 3] : g1[e & 3]) * acc[8 * hq + e]; ss += xv * xv; acc[8 * hq + e] = xv; xf[e] = xv; }
            if (!P.last) *(GAS v4u*)(xr + c) = pack8f(xf); }
        if (!P.last) {
            const float rs = rsqrtf(wave_sum(ss) * (1.f / DM) + NORM_EPS); const float* sh = P.nmod + (size_t)mr_l * 12288 + lane_l * 32; const float* sc = sh + DM; const float* ngp = P.ng + lane_l * 32;
            bf16* ho = (P.dry ? (bf16*)(F.ws + 892 * MiB) : P.Hout) + (size_t)m_l * DM + lane_l * 32;
#pragma unroll
            for (int hq = 0; hq < 4; ++hq) { const int c = hq * 8; float y[8];
                const f32x4 n0 = *(const GAS f32x4*)(ngp + c), n1 = *(const GAS f32x4*)(ngp + c + 4), s0 = *(const GAS f32x4*)(sc + c), s1 = *(const GAS f32x4*)(sc + c + 4), h0 = *(const GAS f32x4*)(sh + c), h1 = *(const GAS f32x4*)(sh + c + 4);
#pragma unroll
                for (int e = 0; e < 4; ++e) { y[e] = acc[8 * hq + e] * rs * n0[e] * (1.0f + s0[e]) + h0[e]; y[4 + e] = acc[8 * hq + 4 + e] * rs * n1[e] * (1.0f + s1[e]) + h1[e]; }
                *(GAS v4u*)(ho + c) = pack8f(y); } }
        if (P.last) { const float rs = rsqrtf(wave_sum(ss) * (1.f / DM) + NORM_EPS); float* orow = P.out + ((size_t)b_l * SEQ + (tp_l - CTXL)) * DM + lane_l * 32; const float* fgp = P.fin_g + lane_l * 32;
#pragma unroll
            for (int hq = 0; hq < 8; ++hq) { const int c = hq * 4; const f32x4 fg = *(const GAS f32x4*)(fgp + c);
                f32x4 o;
#pragma unroll
                for (int e = 0; e < 4; ++e) o[e] = acc[4 * hq + e] * rs * fg[e];
                *(GAS f32x4*)(orow + c) = o; } }
    }
    if (DBG_PROBE && DBG_PROBE != 5 && !P.last && lane == 0) { float* pp = (float*)(F.ws + WS_CTL + CTL_PROBE_OFF) + gw * 4; pp[0] = pr_s2; pp[1] = pr_d2; pp[2] = pr_tg; pp[3] = pr_n; }
}


constexpr int PH_PER_LAYER = 12, NPHASE = 1 + NLAYER * PH_PER_LAYER;
#ifndef ONLY_PHASE
#define ONLY_PHASE -1
#endif
#define T0() (wave_s == 0 && pg8::opaque_lane() == 0)
#define PH_ON(k) (ONLY_PHASE < 0 || ONLY_PHASE == (k))
#define GEMM_CALL(EPI, SCHED, g, S, E) pg8::gemm_phase<EPI, SCHED, true, true>(F.lds, g, S, E, wave_s)
#define GEMM_CALL_NA(EPI, SCHED, g, S, E) pg8::gemm_phase<EPI, SCHED, false, true>(F.lds, g, S, E, wave_s)

__device__ __forceinline__ const float* karg(int i) {
    asm volatile("" : "+s"(i));
    const __attribute__((address_space(4))) unsigned long long* ka = (const __attribute__((address_space(4))) unsigned long long*)__builtin_amdgcn_kernarg_segment_ptr();
    return (const float*)ka[i];
}
__global__ void __launch_bounds__(NWAVES * 64, 2) mk_fwd(Args args) {
    extern __shared__ __attribute__((aligned(16))) unsigned char lds[];
    Frame F;
    F.lds = (LAS unsigned char*)lds; F.ws = args.ws;
    const int wave_s = __builtin_amdgcn_readfirstlane((int)threadIdx.x >> 6);
    F.tid = threadIdx.x; F.lane = F.tid & 63; F.wave = wave_s;
    F.G = gridDim.x; { const int bx = blockIdx.x; F.vcu = (F.G % 8 == 0) ? (bx % 8) * (F.G / 8) + bx / 8 : bx; }
    unsigned char* ws = args.ws;
    volatile LAS unsigned* MISC = (volatile LAS unsigned*)(F.lds + MISC_OFF);
    for (int u = F.tid; u < (LDS_BYTES - LDSCTL_OFF) / 4; u += NWAVES * 64) ((LAS unsigned*)(F.lds + LDSCTL_OFF))[u] = 0u;
    __syncthreads();
    const int lo = args.ph_lo, hi = args.ph_hi;
    XcdBarrier bar; bar.bar = (unsigned*)(ws + WS_CTL) + CW_BAR; bar.x = 0; bar.st = nullptr;
    if (hi - lo > 1) bar = xcd_barrier_post((unsigned*)(ws + WS_CTL) + CW_BAR, MISC + 8, T0());
#define IN(k) (lo <= (k) && (k) < hi)
#define REFRAME() do { const int lz_ = pg8::opaque_lane(); F.lane = lz_; F.tid = wave_s * 64 + lz_; F.wave = wave_s; ws = (unsigned char*)karg(34); F.ws = ws; { int g_ = (int)gridDim.x, b_ = (int)blockIdx.x; asm volatile("" : "+s"(g_), "+s"(b_)); bx = b_; F.G = g_; F.vcu = ((g_ & 7) == 0) ? (b_ & 7) * (g_ >> 3) + (b_ >> 3) : b_; } } while (0)
#define SEAM(k) do { if (IN((k) + 1)) xcd_barrier(bar, T0()); } while (0)
#define XBUF ((bf16*)(ws + WS_X))
#define HBUF ((bf16*)(ws + WS_H))
#define MODP ((const float*)(ws + WS_CTL + CTL_MOD_OFF) + (size_t)l * 3 * 12288)
    int bx = (int)blockIdx.x;

    for (int rep_ = 0; rep_ < ((DBG_REPEAT == 100) ? 2 : 1); ++rep_) if (PH_ON(100) && IN(0)) { REFRAME(); if (rep_) xcd_barrier(bar, T0()); p0_prologue(F, 0, (MK_N_LAUNCHES == 1) ? 1 : NLAYER, F.vcu, F.G); SEAM(0); if (DBG_REPEAT == 200) { for (int i_ = 0; i_ < 32; ++i_) xcd_barrier(bar, T0()); } }

    for (int l = 0; l < NLAYER; ++l) {
        const int base = 1 + l * PH_PER_LAYER;
        const int last = (l == NLAYER - 1);
        for (int rep_ = 0; rep_ < ((DBG_REPEAT == 0) ? 2 : 1); ++rep_) if (PH_ON(0) && IN(base + 0) && l == 0) { REFRAME(); if (rep_) xcd_barrier(bar, T0()); modnorm_phase(F, nullptr, karg(6) + (size_t)l * DM, MODP, 0, HBUF, 0, karg(0), karg(2)); SEAM(base + 0); }
        for (int rep_ = 0; rep_ < ((DBG_REPEAT == 1) ? 2 : 1); ++rep_) if (PH_ON(1) && IN(base + 1)) { REFRAME(); if (rep_) xcd_barrier(bar, T0());
            pg8::Gemm g{HBUF, (const bf16*)(ws + WS_WINA) + (size_t)l * INA_P * DM, MALL, INA_P, DM}; pg8::RowOrder S; S.init_rows(0, INA_P, F.G, bx);
            pg8::EpiStoreBf16 E{(bf16*)(ws + WS_PA), INA_P};
            GEMM_CALL(pg8::EpiStoreBf16, pg8::RowOrder, g, S, E);
            SEAM(base + 1); }
        for (int rep_ = 0; rep_ < ((DBG_REPEAT == 2) ? 2 : 1); ++rep_) if (PH_ON(2) && IN(base + 2)) { REFRAME(); if (rep_) xcd_barrier(bar, T0());
            FeatP P;
            P.PA = (const bf16*)(ws + WS_PA); P.mu = karg(9) + (size_t)l * RWC; P.w0 = karg(10) + (size_t)l * 2 * RW; P.a0 = karg(12) + (size_t)l * 2 * RW;
            P.k_k = karg(15) + (size_t)l * RW; P.k_a = karg(16) + (size_t)l * RW; P.r_k = karg(17) + (size_t)l * RW;
            P.WUP = (const bf16*)(ws + WS_WUP) + (size_t)l * 2 * RW * 64; P.AUP = (const bf16*)(ws + WS_AUP) + (size_t)l * 2 * RW * 64; P.GUP = (const bf16*)(ws + WS_GUP) + (size_t)l * 2 * RW * 32;
            P.qnorm = karg(20) + (size_t)l * 512; P.kvnorm = karg(22) + (size_t)l * 256; P.rope = (const f32x2*)(ws + WS_ROPE);
            P.RI = (bf16*)(ws + WS_RI); P.GG = (bf16*)(ws + WS_GG); P.BON = (float*)(ws + WS_BON); P.QN = (bf16*)(ws + WS_QN); P.KVN = (bf16*)(ws + WS_KVN); P.K = (bf16*)(ws + WS_K);
            features_phase(F, P);
            SEAM(base + 2); }
        for (int rep_ = 0; rep_ < ((DBG_REPEAT == 3) ? 2 : 1); ++rep_) if (PH_ON(3) && IN(base + 3)) { REFRAME(); if (rep_) xcd_barrier(bar, T0());
            { pg8::Gemm g{(const bf16*)(ws + WS_QN), (const bf16*)(ws + WS_WUQ) + (size_t)l * NQ * 512, MALL, NQ, 512};
              pg8::EpiQ E{(bf16*)(ws + WS_Q), (const f32x2*)(ws + WS_ROPE), 0.14724444f};
              pg8::RowOrder S; S.init_rows(last, NQ, F.G, bx); GEMM_CALL_NA(pg8::EpiQ, pg8::RowOrder, g, S, E); }
            { pg8::Gemm g{(const bf16*)(ws + WS_KVN), (const bf16*)(ws + WS_WUKV) + (size_t)l * NKV * 256, MALL, NKV, 256}; pg8::RowOrder S; S.init_rows(0, NKV, F.G, bx);
              pg8::EpiKV E{(bf16*)(ws + WS_K), (bf16*)(ws + WS_V)};
              GEMM_CALL_NA(pg8::EpiKV, pg8::RowOrder, g, S, E); }
            SEAM(base + 3); }
        for (int rep_ = 0; rep_ < ((DBG_REPEAT == 4) ? 2 : 1); ++rep_) if (PH_ON(4) && IN(base + 4)) { REFRAME(); if (rep_) xcd_barrier(bar, T0());
            ScanCvt C; C.pu = karg(30) + (size_t)l * NEXP * DM; C.pv = karg(31) + (size_t)l * NEXP * DM; C.PU8 = ws + WS_P4; C.PV8 = ws + WS_P4 + (size_t)NEXP * (DM / 2); C.SU = (float*)(ws + WS_P4S); C.SV = (float*)(ws + WS_P4S) + NEXP; C.wl = (MK_N_LAUNCHES == 1 && l + 1 < NLAYER && F.G == 256) ? l + 1 : -1;
            scan_phase(F, (const bf16*)(ws + WS_RI), (bf16*)(ws + WS_Y), C); SEAM(base + 4); }
        for (int rep_ = 0; rep_ < ((DBG_REPEAT == 5) ? 2 : 1); ++rep_) if (PH_ON(5) && IN(base + 5)) { REFRAME(); if (rep_) xcd_barrier(bar, T0());
            attn_phase(F, (const bf16*)(ws + WS_Q), (const bf16*)(ws + WS_K), (const bf16*)(ws + WS_V), (bf16*)(ws + WS_YB), !last);
            readout_phase(F, (const bf16*)(ws + WS_Y), (const bf16*)(ws + WS_GG), (const float*)(ws + WS_BON), (const bf16*)(ws + WS_RI), karg(18) + (size_t)l * RW, karg(19) + (size_t)l * RW, (bf16*)(ws + WS_YA));
            SEAM(base + 5); }
        for (int rep_ = 0; rep_ < ((DBG_REPEAT == 6) ? 2 : 1); ++rep_) if (PH_ON(6) && IN(base + 6)) { REFRAME(); if (rep_) xcd_barrier(bar, T0());
            bf16* T1 = (bf16*)(ws + WS_T1); bf16* T2 = (bf16*)(ws + WS_T2);
            const pg8::Gemm g1{HBUF, (const bf16*)(ws + WS_WGA) + (size_t)l * DM * DM, MALL, DM, DM}, g2{(const bf16*)(ws + WS_YA), (const bf16*)(ws + WS_WA) + (size_t)l * DM * RW, MALL, DM, RW};
            const pg8::Gemm g3{HBUF, (const bf16*)(ws + WS_WGB) + (size_t)l * DM * DM, MALL, DM, DM}, g4{(const bf16*)(ws + WS_YB), (const bf16*)(ws + WS_WB) + (size_t)l * DM * RW, MALL, DM, RW};
            const pg8::EpiGate E1{T1, DM, karg(8) + (size_t)l * 2 * DM}, E3{T2, DM, karg(8) + (size_t)l * 2 * DM + DM};
            const pg8::EpiMulAdd E2{T1, T1, nullptr, DM}, E4{T1, T2, T1, DM};
            const bool split = CTX_SPLIT && !last && F.G >= 128;
            pg8::RowOrder S; S.init_rows(last || split, DM, F.G, bx);
            GEMM_CALL(pg8::EpiGate, pg8::RowOrder, g1, S, E1); GEMM_CALL(pg8::EpiMulAdd, pg8::RowOrder, g2, S, E2); GEMM_CALL(pg8::EpiGate, pg8::RowOrder, g3, S, E3); GEMM_CALL(pg8::EpiMulAdd, pg8::RowOrder, g4, S, E4);
            if (split) {
                pg8::CtxOrder Sg, Sp; Sg.u0 = (bx < 32) ? (bx & 15) : -1; Sp.u0 = (bx >= 32 && bx < 64) ? (bx & 15) : -1;
                const bool second = (bx & 16) != 0;
                const pg8::Gemm gg = second ? g3 : g1, gp = second ? g4 : g2;
                const pg8::EpiGate EG = second ? E3 : E1;
                const pg8::EpiCtxF32 EP{(float*)(ws + (second ? WS_CB : WS_CA)), DM};
                GEMM_CALL(pg8::EpiGate, pg8::CtxOrder, gg, Sg, EG); GEMM_CALL(pg8::EpiCtxF32, pg8::CtxOrder, gp, Sp, EP); }
            if (MK_N_LAUNCHES == 1 && l == 0 && rep_ == 0) { __syncthreads();
                const int late = split ? 64 : (F.G > 32) ? 16 : 0; p0_prologue(F, 1, NLAYER, (bx >= late) ? bx - late : -1, F.G - late, (F.G == 256) ? 0 : 1); }
            SEAM(base + 6); }
        for (int rep_ = 0; rep_ < ((DBG_REPEAT == 7) ? 2 : 1); ++rep_) if (PH_ON(7) && IN(base + 7)) { REFRAME(); if (rep_) xcd_barrier(bar, T0());
            if (CTX_SPLIT && !last && F.G >= 128 && rep_ == 0) {
                bf16* T1 = (bf16*)(ws + WS_T1); const bf16* T2 = (const bf16*)(ws + WS_T2); const float* CA = (const float*)(ws + WS_CA); const float* CB = (const float*)(ws + WS_CB);
                for (int e = bx * (NWAVES * 64) + F.tid; e < 512 * (DM / 8); e += F.G * (NWAVES * 64)) { const int r = e >> 8, c0 = (e & 255) * 8; const size_t go = (size_t)((r < 256) ? r : 33 * 256 + (r - 256)) * DM + c0;
                    const v4u ga = *(const GAS v4u*)(T1 + go), gb = *(const GAS v4u*)(T2 + go);
                    const f32x4 a0 = *(const GAS f32x4*)(CA + (size_t)r * DM + c0), a1 = *(const GAS f32x4*)(CA + (size_t)r * DM + c0 + 4), b0 = *(const GAS f32x4*)(CB + (size_t)r * DM + c0), b1 = *(const GAS f32x4*)(CB + (size_t)r * DM + c0 + 4);
                    v4u o;
                    o.x = pk2(bflo(ga.x) * a0[0] + bflo(gb.x) * b0[0], bfhi(ga.x) * a0[1] + bfhi(gb.x) * b0[1]); o.y = pk2(bflo(ga.y) * a0[2] + bflo(gb.y) * b0[2], bfhi(ga.y) * a0[3] + bfhi(gb.y) * b0[3]);
                    o.z = pk2(bflo(ga.z) * a1[0] + bflo(gb.z) * b1[0], bfhi(ga.z) * a1[1] + bfhi(gb.z) * b1[1]); o.w = pk2(bflo(ga.w) * a1[2] + bflo(gb.w) * b1[2], bfhi(ga.w) * a1[3] + bfhi(gb.w) * b1[3]);
                    *(GAS v4u*)(T1 + go) = o; }
                xcd_barrier(bar, T0()); }
            const pg8::Gemm g{(const bf16*)(ws + WS_T1), (const bf16*)(ws + WS_WO) + (size_t)l * DM * DM, MALL, DM, DM};
            const pg8::EpiResid E{XBUF, MODP + 2 * DM, l == 0 ? karg(0) : nullptr, l == 0 ? karg(2) : nullptr};
            pg8::RowOrder S; S.init_rows(last, DM, F.G, bx); GEMM_CALL(pg8::EpiResid, pg8::RowOrder, g, S, E);
            SEAM(base + 7); }
        for (int rep_ = 0; rep_ < ((DBG_REPEAT == 8) ? 2 : 1); ++rep_) if (PH_ON(8) && IN(base + 8)) { REFRAME(); if (rep_) xcd_barrier(bar, T0());
            modnorm_phase_bf(F, XBUF, karg(27) + (size_t)l * DM, MODP, 3, HBUF, last);
            SEAM(base + 8); }
        for (int rep_ = 0; rep_ < ((DBG_REPEAT == 9) ? 2 : 1); ++rep_) if (PH_ON(9) && IN(base + 9)) { REFRAME(); if (rep_) xcd_barrier(bar, T0());
            const pg8::Gemm g{HBUF, (const bf16*)(ws + WS_WQK) + (size_t)l * DM * DM, MALL, DM, DM};
            const pg8::EpiF16 E{(_Float16*)(ws + WS_SC), DM};
            pg8::RowOrder S; S.init_rows(last, DM, F.G, bx); GEMM_CALL(pg8::EpiF16, pg8::RowOrder, g, S, E);
            SEAM(base + 9); }
        for (int rep_ = 0; rep_ < ((DBG_REPEAT == 11) ? 2 : 1); ++rep_) if (PH_ON(11) && IN(base + 11)) { REFRAME(); if (rep_) xcd_barrier(bar, T0());
            PeerP P; P.SC = (const _Float16*)(ws + WS_SC); P.nmod = MODP + 3 * 12288; P.ng = karg(6) + (size_t)(l + 1) * DM; P.Hout = HBUF; P.ESEL = (const int*)(ws + WS_T1); P.EGATE = (const float*)(ws + WS_T1 + 16 * MiB); P.H = HBUF; P.PU = ws + WS_P4; P.PV = ws + WS_P4 + (size_t)NEXP * (DM / 2); P.SU = (const float*)(ws + WS_P4S); P.SV = (const float*)(ws + WS_P4S) + NEXP; P.X = XBUF; P.mod = MODP; P.fin_g = karg(32); P.out = (float*)karg(33); P.last = last; P.dry = (DBG_REPEAT == 11 && rep_ == 0) ? DBG_DRY : 0;
            peer_phase(F, P);
            SEAM(base + 11); }
    }
#undef IN
#undef SEAM
#undef XBUF
#undef HBUF
#undef MODP
}

__device__ __forceinline__ float mx_a_val(int i, int k) { const int c = (i * 131 + k * 17 + (k >> 3) * 5) & 15; const float mag[8] = {0.f, .5f, 1.f, 1.5f, 2.f, 3.f, 4.f, 6.f}; return (c & 8) ? -mag[c & 7] : mag[c & 7]; }
__device__ __forceinline__ int mx_a_code(int i, int k) { return (i * 131 + k * 17 + (k >> 3) * 5) & 15; }
__device__ __forceinline__ float mx_b_val(int k, int j) { return (float)(((k * 7 + j * 13 + (k >> 4)) % 9) - 4); }
__device__ __forceinline__ int mx_kmap(int hyp, int kb, int e) { const int h = hyp % 3; return h == 0 ? 32 * kb + e : h == 1 ? 32 * (e >> 3) + 8 * kb + (e & 7) : 64 * (e >> 4) + 16 * kb + (e & 15); }
__global__ void __launch_bounds__(512) dbg_fill(const float* pp, float* o) {
    __shared__ float vsh;
    float v = 0.f;
    if (DBG_PROBE == 5) {
        if (threadIdx.x < 64) { typedef int v8i __attribute__((ext_vector_type(8))); typedef float f4 __attribute__((ext_vector_type(4)));
            const int lane = threadIdx.x, i = lane & 15, kb = lane >> 4; float code = 0.f;
            for (int hyp = 0; hyp < 18; ++hyp) { const int nibswap = hyp / 9, ha = hyp % 3, hb2 = (hyp / 3) % 3;
                unsigned aw[4] = {0u, 0u, 0u, 0u}; int bw[8] = {0, 0, 0, 0, 0, 0, 0, 0};
                for (int e = 0; e < 32; ++e) { const int k = mx_kmap(ha, kb, e); const unsigned c = (unsigned)mx_a_code(i, k); const int pos = nibswap ? (e ^ 1) : e; aw[pos >> 3] |= c << (4 * (pos & 7)); }
                for (int q = 0; q < 8; ++q) { int w = 0; const float f0 = mx_b_val(mx_kmap(hb2, kb, 4 * q + 0), i), f1 = mx_b_val(mx_kmap(hb2, kb, 4 * q + 1), i), f2 = mx_b_val(mx_kmap(hb2, kb, 4 * q + 2), i), f3 = mx_b_val(mx_kmap(hb2, kb, 4 * q + 3), i);
                    w = __builtin_amdgcn_cvt_pk_fp8_f32(f0, f1, w, false); w = __builtin_amdgcn_cvt_pk_fp8_f32(f2, f3, w, true); bw[q] = w; }
                const v8i af = {(int)aw[0], (int)aw[1], (int)aw[2], (int)aw[3], 0, 0, 0, 0}, bf = {bw[0], bw[1], bw[2], bw[3], bw[4], bw[5], bw[6], bw[7]};
                f4 d = {0.f, 0.f, 0.f, 0.f};
                d = __builtin_amdgcn_mfma_scale_f32_16x16x128_f8f6f4(af, bf, d, 4, 0, 0, 0x7f7f7f7f, 0, 0x7f7f7f7f);
                int bad = 0;
                for (int r = 0; r < 4; ++r) { const int row = 4 * kb + r, col = i; float ex = 0.f; for (int k = 0; k < 128; ++k) ex += mx_a_val(row, k) * mx_b_val(k, col); bad += (d[r] != ex); }
                if (__ballot(bad != 0) == 0ull && code == 0.f) code = (float)(hyp + 1); }
            for (int t = 0; t < 2; ++t) {
                int aw[8] = {0, 0, 0, 0, 0, 0, 0, 0}, bw[8] = {0, 0, 0, 0, 0, 0, 0, 0};
                if (t == 0) { for (int e = 0; e < 32; ++e) { const int k = 32 * kb + e; aw[e >> 3] |= mx_a_code(i, k) << (4 * (e & 7)); bw[e >> 3] |= mx_a_code(i + 16, k) << (4 * (e & 7)); } }
                else { for (int q = 0; q < 8; ++q) { int w = 0, w2 = 0; const int k = 32 * kb + 4 * q;
                        w = __builtin_amdgcn_cvt_pk_fp8_f32(mx_b_val(k, i + 16), mx_b_val(k + 1, i + 16), w, false); w = __builtin_amdgcn_cvt_pk_fp8_f32(mx_b_val(k + 2, i + 16), mx_b_val(k + 3, i + 16), w, true); aw[q] = w;
                        w2 = __builtin_amdgcn_cvt_pk_fp8_f32(mx_b_val(k, i), mx_b_val(k + 1, i), w2, false); w2 = __builtin_amdgcn_cvt_pk_fp8_f32(mx_b_val(k + 2, i), mx_b_val(k + 3, i), w2, true); bw[q] = w2; } }
                const v8i af = {aw[0], aw[1], aw[2], aw[3], aw[4], aw[5], aw[6], aw[7]}, bf = {bw[0], bw[1], bw[2], bw[3], bw[4], bw[5], bw[6], bw[7]};
                f4 d = {0.f, 0.f, 0.f, 0.f};
                if (t == 0) d = __builtin_amdgcn_mfma_scale_f32_16x16x128_f8f6f4(af, bf, d, 4, 4, 0, 0x7f7f7f7f, 0, 0x7f7f7f7f); else d = __builtin_amdgcn_mfma_scale_f32_16x16x128_f8f6f4(af, bf, d, 0, 0, 0, 0x7f7f7f7f, 0, 0x7f7f7f7f);
                int bad = 0;
                for (int r = 0; r < 4; ++r) { const int row = 4 * kb + r, col = i; float ex = 0.f;
                    for (int k = 0; k < 128; ++k) ex += (t == 0) ? mx_a_val(row, k) * mx_a_val(col + 16, k) : mx_b_val(k, row + 16) * mx_b_val(k, col);
                    bad += (d[r] != ex); }
                if (__ballot(bad != 0) == 0ull) code += (t == 0) ? 10.f : 20.f; }
            if (lane == 0) vsh = code; }
        __syncthreads(); v = vsh;
    } else {
        float s0 = 0.f, s1 = 0.f, s2 = 0.f, s3 = 0.f;
        for (int i = 0; i < 2048; ++i) { s0 += pp[4 * i]; s1 += pp[4 * i + 1]; s2 += pp[4 * i + 2]; s3 += pp[4 * i + 3]; }
        if (DBG_PROBE == 4) { float mx = 0.f; for (int i = 0; i < 2048; ++i) mx = fmaxf(mx, pp[4 * i]); v = 100.f * mx; }
        else { v = (DBG_PROBE == 1 ? s0 : DBG_PROBE == 2 ? s1 : s2) / s3 * 1e-3f; v = exp2f(rintf(log2f(v) * 4.f) * 0.25f); }
    }
    for (size_t i = (size_t)blockIdx.x * 512 + threadIdx.x; i < (size_t)NBATCH * SEQ * DM; i += (size_t)gridDim.x * 512) o[i] = v;
}
extern "C" void kernel_launch(void* const* d_in, const int* in_sizes, int n_in, void* d_out, int out_size, void* d_ws, size_t ws_size, hipStream_t stream) {
    static int grid = 0;
    if (grid == 0) {
        if (n_in != 33 || out_size != NBATCH * SEQ * DM || ws_size < WS_END2) { fprintf(stderr, "kernel_launch: unexpected shapes (n_in %d out %d ws %zu)\n", n_in, out_size, ws_size); grid = -1; return; }
        int dev = 0, cus = 0, per_cu = 0;
        if (hipGetDevice(&dev) != hipSuccess || hipDeviceGetAttribute(&cus, hipDeviceAttributeMultiprocessorCount, dev) != hipSuccess) { grid = -1; return; }
        if (hipFuncSetAttribute((const void*)mk_fwd, hipFuncAttributeMaxDynamicSharedMemorySize, LDS_BYTES) != hipSuccess) { fprintf(stderr, "kernel_launch: hipFuncSetAttribute failed\n"); grid = -1; return; }
        if (hipOccupancyMaxActiveBlocksPerMultiprocessor(&per_cu, (const void*)mk_fwd, NWAVES * 64, LDS_BYTES) != hipSuccess || per_cu < 1) { fprintf(stderr, "kernel_launch: occupancy query says %d\n", per_cu); (void)hipGetLastError(); grid = -1; return; }
        grid = cus;
    }
    if (grid < 0) return;
    if (hipMemsetAsync((char*)d_ws + WS_CTL, 0, CTL_ZERO_BYTES, stream) != hipSuccess) return;
    Args a{};
    for (int i = 0; i < 33; ++i) a.in[i] = (const float*)d_in[i];
    a.out = (float*)d_out; a.ws = (unsigned char*)d_ws;
#if MK_N_LAUNCHES == 1
    a.ph_lo = 0; a.ph_hi = NPHASE;
    hipLaunchKernelGGL(mk_fwd, dim3(grid), dim3(NWAVES * 64), LDS_BYTES, stream, a);
#else
    if (DBG_PROBE != 5) for (int p = 0; p < NPHASE; ++p) { a.ph_lo = p; a.ph_hi = p + 1; hipLaunchKernelGGL(mk_fwd, dim3(grid), dim3(NWAVES * 64), LDS_BYTES, stream, a); }
    if (DBG_PROBE) hipLaunchKernelGGL(dbg_fill, dim3(1024), dim3(512), 0, stream, (const float*)((char*)d_ws + WS_CTL + CTL_PROBE_OFF), (float*)d_out);
#endif
}
```

```cpp
#include <hip/hip_runtime.h>
#include <cstdio>
#include <cstdint>

#ifndef MK_N_LAUNCHES
#define MK_N_LAUNCHES 1
#endif

#ifndef DBG_SKIP
#define DBG_SKIP 0
#endif
#ifndef DBG_PROBE
#define DBG_PROBE 0
#endif
#ifndef DBG_DRY
#define DBG_DRY 1
#endif
#ifndef DBG_REPEAT
#define DBG_REPEAT -1
#endif
namespace pg8 {
#define PG8_LAS __attribute__((address_space(3)))
typedef unsigned short bf16_t;
typedef short bf16x8 __attribute__((ext_vector_type(8)));
typedef float f32x4 __attribute__((ext_vector_type(4)));
typedef unsigned u32x4 __attribute__((ext_vector_type(4)));
constexpr int BM = 256, BK = 64, HALF = 128, HTB = HALF * BK * 2  , STAGE_BYTES = 8 * HTB, NXCD = 8, WGM = 8;

__host__ __device__ __forceinline__ int lds_byte(int r, int c) { const int st = (r >> 4) * 2 + (c >> 5), rr = r & 15, cc = c & 31, ob = rr * 64 + cc * 2; return st * 1024 + (ob ^ (((ob >> 9) & 1) << 5)); }
__host__ __device__ __forceinline__ void stage_rc(int b, int& R, int& C) { const int st = b / 1024, sb = b % 1024, swz = sb ^ (((sb >> 9) & 1) << 5); R = (st >> 1) * 16 + swz / 64; C = (st & 1) * 32 + (swz % 64) / 2; }
__host__ __device__ __forceinline__ int perm32(int rho) { const int n = rho >> 4, i = rho & 15; return 8 * (i >> 2) + 4 * n + (i & 3); }

struct Unit { int pm, pn; };
struct Gemm { const bf16_t* A; const bf16_t* Bt; int M, N, K; };

struct StaticOrder {
    int nM, nN, nwg, G, c;
    __host__ __device__ void init(int M, int N, int G_, int c_) { nM = M / BM; nN = N / BM; nwg = nM * nN; G = G_; c = c_; }
    __host__ __device__ bool next(int i, Unit& u) const {
        const long L = (long)i * G + c; if (L >= nwg) return false;
        int wgid = (int)L; { const int q = nwg / NXCD, r = nwg % NXCD, xcd = wgid % NXCD, off = wgid / NXCD; wgid = (xcd < r ? xcd * (q + 1) : r * (q + 1) + (xcd - r) * q) + off; }
        const int nig = WGM * nN, gid = wgid / nig, fm = gid * WGM, gsz = (nM - fm) < WGM ? (nM - fm) : WGM;
        u.pm = fm + ((wgid % nig) % gsz); u.pn = (wgid % nig) / gsz; return true;
    }
    __device__ __forceinline__ void a_ready(const Unit&) const {}
    __device__ __forceinline__ void done(const Unit&) const {}
};
__device__ __forceinline__ int opaque_lane() { int l; asm volatile("v_mbcnt_lo_u32_b32 %0, -1, 0\n\tv_mbcnt_hi_u32_b32 %0, -1, %0" : "=v"(l)); return l; }
typedef __bf16 bf16x2c __attribute__((ext_vector_type(2)));
__device__ __forceinline__ unsigned cvt_pk_bf16(float lo, float hi) { const bf16x2c v = {(__bf16)lo, (__bf16)hi}; return __builtin_bit_cast(unsigned, v); }
template <class Epi, class Sched, bool ALIGN_EPI = false, bool SP2 = false>
__device__ __forceinline__ void gemm_phase(PG8_LAS unsigned char* lds, const Gemm g, const Sched& S, const Epi& E, const int wave_s) {
    const int lane_ = opaque_lane();
    const int wid = wave_s, lane = lane_, tid = wid * 64 + lane, wr = wid >> 2, wc = wid & 3, fr = lane & 15, fq = lane >> 4;
    const int K = g.K, nt = K / BK;
    unsigned voffA[2], voffB[2];
#pragma unroll
    for (int i = 0; i < 2; ++i) { int R, C; stage_rc(tid * 16 + i * 8192, R, C); const int Rb = Epi::PERM ? ((R & ~31) + perm32(R & 31)) : R;
        voffA[i] = (unsigned)(R * K + C) * 2u; voffB[i] = (unsigned)(Rb * K + C) * 2u; }
    const size_t kstep = (size_t)(BK * 2);
    const size_t hstep = (size_t)HALF * K * 2;
    const size_t tstep = 2 * hstep;
    const unsigned ldsw = (unsigned)wid * 1024u;
    const int aoff = lds_byte(wr * 64 + fr, fq * 8), boff = lds_byte(wc * 32 + fr, fq * 8);
#define PG8_SA(b, h) (((b) * 2 + (h)) * HTB)
#define PG8_SB(b, h) ((4 + (b) * 2 + (h)) * HTB)
#define PG8_STAGE(bufoff, gbase, voff) do { _Pragma("unroll") for (int _i = 0; _i < 2; ++_i) \
        __builtin_amdgcn_global_load_lds((const unsigned*)((const char*)(gbase) + (voff)[_i]), (PG8_LAS unsigned*)(lds + (bufoff) + ldsw + _i * 8192), 16, 0, 0); } while (0)
#define PG8_LDA(dst, b, h) do { _Pragma("unroll") for (int m = 0; m < 4; ++m) _Pragma("unroll") for (int k = 0; k < 2; ++k) dst[m][k] = *(const PG8_LAS bf16x8*)(lds + PG8_SA(b, h) + aoff + m * 2048 + k * 1024); } while (0)
#define PG8_LDB(dst, b, h) do { _Pragma("unroll") for (int n = 0; n < 2; ++n) _Pragma("unroll") for (int k = 0; k < 2; ++k) dst[n][k] = *(const PG8_LAS bf16x8*)(lds + PG8_SB(b, h) + boff + n * 2048 + k * 1024); } while (0)
#define PG8_MMA(ai, bj, At, Bt) do { __builtin_amdgcn_s_setprio(1); _Pragma("unroll") for (int m = 0; m < 4; ++m) _Pragma("unroll") for (int n = 0; n < 2; ++n) _Pragma("unroll") for (int k = 0; k < 2; ++k) \
        acc[ai][bj][m][n] = __builtin_amdgcn_mfma_f32_16x16x32_bf16(Bt[n][k], At[m][k], acc[ai][bj][m][n], 0, 0, 0); __builtin_amdgcn_s_setprio(0); } while (0)
#define PG8_WAIT_V(n) asm volatile("s_waitcnt vmcnt(" #n ")" ::: "memory")
#define PG8_WAIT_L(n) asm volatile("s_waitcnt lgkmcnt(" #n ")" ::: "memory")
#define PG8_BAR __builtin_amdgcn_s_barrier()
#define PG8_SCHED __builtin_amdgcn_sched_barrier(0)
    Unit cur, nxt; int ui = 0;
    if (!S.next(0, cur)) return;
    f32x4 acc[2][2][4][2];
#pragma unroll
    for (int a = 0; a < 2; ++a)
#pragma unroll
        for (int b = 0; b < 2; ++b)
#pragma unroll
            for (int m = 0; m < 4; ++m)
#pragma unroll
                for (int n = 0; n < 2; ++n) acc[a][b][m][n] = (f32x4){0.f, 0.f, 0.f, 0.f};
    bf16x8 At[4][2], B0[2][2], B1[2][2];
    const char* cA = (const char*)g.A + (size_t)cur.pm * tstep; const char* cB = (const char*)g.Bt + (size_t)cur.pn * tstep;
    S.a_ready(cur);
    if constexpr (SP2) {
        PG8_STAGE(PG8_SB(0, 0), cB, voffB); PG8_STAGE(PG8_SB(0, 1), cB + hstep, voffB); PG8_STAGE(PG8_SA(0, 0), cA, voffA); PG8_STAGE(PG8_SA(0, 1), cA + hstep, voffA);
        if (wr == 1) PG8_BAR;
        PG8_WAIT_V(2); PG8_BAR;
        PG8_STAGE(PG8_SB(1, 0), cB + kstep, voffB); PG8_STAGE(PG8_SA(1, 0), cA + kstep, voffA); PG8_STAGE(PG8_SB(1, 1), cB + hstep + kstep, voffB);
        PG8_WAIT_V(6); PG8_BAR;
    } else {
        PG8_STAGE(PG8_SB(0, 0), cB, voffB); PG8_STAGE(PG8_SA(0, 0), cA, voffA); PG8_STAGE(PG8_SB(0, 1), cB + hstep, voffB); PG8_STAGE(PG8_SA(0, 1), cA + hstep, voffA);
        if (wr == 1) PG8_BAR;
        PG8_WAIT_V(4); PG8_BAR;
        PG8_STAGE(PG8_SB(1, 0), cB + kstep, voffB); PG8_STAGE(PG8_SA(1, 0), cA + kstep, voffA); PG8_STAGE(PG8_SB(1, 1), cB + hstep + kstep, voffB);
        PG8_WAIT_V(6); PG8_BAR;
    }
    for (;;) {
        const bool has_next = S.next(ui + 1, nxt);
        const char* nA = has_next ? (const char*)g.A + (size_t)nxt.pm * tstep : cA; const char* nB = has_next ? (const char*)g.Bt + (size_t)nxt.pn * tstep : cB;
        for (int t = 0; t < nt; t += 2) {
            const bool last = (t == nt - 2);
            const char* a1 = cA + (size_t)(t + 1) * kstep;
            const char* a2 = last ? nA : cA + (size_t)(t + 2) * kstep; const char* b2 = last ? nB : cB + (size_t)(t + 2) * kstep;
            const char* a3 = a2 + kstep; const char* b3 = b2 + kstep;
            if (last && has_next) S.a_ready(nxt);
            if constexpr (SP2) {
            PG8_LDB(B0, 0, 0); PG8_LDB(B1, 0, 1); PG8_SCHED; PG8_LDA(At, 0, 0); PG8_STAGE(PG8_SA(1, 1), a1 + hstep, voffA);
            PG8_WAIT_V(8); PG8_WAIT_L(0); PG8_BAR; PG8_MMA(0, 0, At, B0); PG8_MMA(0, 1, At, B1); PG8_BAR; PG8_SCHED;
            PG8_LDA(At, 0, 1); PG8_STAGE(PG8_SB(0, 0), b2, voffB); PG8_STAGE(PG8_SB(0, 1), b2 + hstep, voffB); PG8_STAGE(PG8_SA(0, 0), a2, voffA);
            PG8_WAIT_V(8); PG8_WAIT_L(0); PG8_BAR; PG8_MMA(1, 0, At, B0); PG8_MMA(1, 1, At, B1); PG8_BAR; PG8_SCHED;
            PG8_LDB(B0, 1, 0); PG8_LDB(B1, 1, 1); PG8_SCHED; PG8_LDA(At, 1, 0); PG8_STAGE(PG8_SA(0, 1), a2 + hstep, voffA);
            PG8_WAIT_V(8); PG8_WAIT_L(0); PG8_BAR; PG8_MMA(0, 0, At, B0); PG8_MMA(0, 1, At, B1); PG8_BAR; PG8_SCHED;
            PG8_LDA(At, 1, 1); PG8_STAGE(PG8_SB(1, 0), b3, voffB); PG8_STAGE(PG8_SB(1, 1), b3 + hstep, voffB); PG8_STAGE(PG8_SA(1, 0), a3, voffA);
            PG8_WAIT_V(8); PG8_WAIT_L(0); PG8_BAR; PG8_MMA(1, 0, At, B0); PG8_MMA(1, 1, At, B1); PG8_BAR; PG8_SCHED;
            } else {
            PG8_LDB(B0, 0, 0); PG8_SCHED; PG8_LDA(At, 0, 0); PG8_STAGE(PG8_SA(1, 1), a1 + hstep, voffA);
            PG8_WAIT_L(8); PG8_BAR; PG8_WAIT_L(0); PG8_MMA(0, 0, At, B0); PG8_BAR; PG8_SCHED;
            PG8_LDB(B1, 0, 1); PG8_STAGE(PG8_SB(0, 0), b2, voffB);
            PG8_BAR; PG8_WAIT_L(0); PG8_MMA(0, 1, At, B1); PG8_BAR;
            PG8_LDA(At, 0, 1); PG8_STAGE(PG8_SA(0, 0), a2, voffA);
            PG8_BAR; PG8_WAIT_L(0); PG8_MMA(1, 0, At, B0); PG8_BAR; PG8_SCHED;
            PG8_STAGE(PG8_SB(0, 1), b2 + hstep, voffB);
            PG8_WAIT_V(6); PG8_BAR; PG8_MMA(1, 1, At, B1); PG8_BAR;
            PG8_LDB(B0, 1, 0); PG8_SCHED; PG8_LDA(At, 1, 0); PG8_STAGE(PG8_SA(0, 1), a2 + hstep, voffA);
            PG8_WAIT_L(8); PG8_BAR; PG8_WAIT_L(0); PG8_MMA(0, 0, At, B0); PG8_BAR; PG8_SCHED;
            PG8_LDB(B1, 1, 1); PG8_STAGE(PG8_SB(1, 0), b3, voffB);
            PG8_BAR; PG8_WAIT_L(0); PG8_MMA(0, 1, At, B1); PG8_BAR;
            PG8_LDA(At, 1, 1); PG8_STAGE(PG8_SA(1, 0), a3, voffA);
            PG8_BAR; PG8_WAIT_L(0); PG8_MMA(1, 0, At, B0); PG8_BAR; PG8_SCHED;
            PG8_STAGE(PG8_SB(1, 1), b3 + hstep, voffB);
            PG8_WAIT_V(6); PG8_BAR; PG8_MMA(1, 1, At, B1); PG8_BAR;
            }
        }
        if constexpr (ALIGN_EPI) { if (wr == 0) PG8_BAR; }
        if constexpr (!Epi::AFTER_DRAIN) { const int le_ = opaque_lane(); E(acc, cur, wr, wc, le_ & 15, le_ >> 4); S.done(cur); }
        if (!has_next) break;
#pragma unroll
        for (int a = 0; a < 2; ++a)
#pragma unroll
            for (int b = 0; b < 2; ++b)
#pragma unroll
                for (int m = 0; m < 4; ++m)
#pragma unroll
                    for (int n = 0; n < 2; ++n) acc[a][b][m][n] = (f32x4){0.f, 0.f, 0.f, 0.f};
        cur = nxt; cA = nA; cB = nB; ++ui;
        if constexpr (ALIGN_EPI) { if (wr == 1) PG8_BAR; }
    }
    PG8_WAIT_V(0);
    if constexpr (!ALIGN_EPI) { if (wr == 0) PG8_BAR; }
    PG8_BAR;
    if constexpr (Epi::AFTER_DRAIN) { E.fused(acc, cur, wr, wc, fr, fq, lds, wid, lane); S.done(cur); }
#undef PG8_SA
#undef PG8_SB
#undef PG8_STAGE
#undef PG8_LDA
#undef PG8_LDB
#undef PG8_MMA
#undef PG8_WAIT_V
#undef PG8_WAIT_L
#undef PG8_BAR
#undef PG8_SCHED
}
}

constexpr int NWAVES = 8;
constexpr int DM = 2048, NBATCH = 2, SEQ = 8192, CTXL = 256, TPB = CTXL + SEQ  , MALL = NBATCH * TPB  ;
constexpr int NLAYER = 2;
constexpr int RW = 1024, NH = 16;
constexpr int RWC = 3392, INA = 4192, INA_P = 4352, INC = 8288;
constexpr int C_WD = 3072, C_AD = 3200, C_GD = 3328, C_QC = 3392, C_KVC = 3904, C_KR = 4160;
constexpr int QKD = 96, NQ = NH * QKD  , NKV = NH * 128  ;
constexpr int NEXP = 16384;
constexpr int RREC = 9 * 64;
constexpr float NORM_EPS = 1e-6f;

constexpr size_t MiB = 1u << 20;
constexpr size_t WS_CTL = 0, CTL_ZERO_BYTES = 1 * MiB;
constexpr size_t CTL_MOD_OFF = 256 * 1024;
constexpr size_t WS_ROPE = 1 * MiB;
constexpr size_t WS_WUP = 3 * MiB, WS_AUP = WS_WUP + 512 * 1024, WS_GUP = 4 * MiB;
constexpr size_t WS_WUQ = 5 * MiB, WS_WUKV = 8 * MiB, WS_WA = 10 * MiB, WS_WB = 18 * MiB, WS_WO = 26 * MiB, WS_WQK = 42 * MiB, WS_WGA = 58 * MiB, WS_WGB = 74 * MiB, WS_WINA = 90 * MiB;
constexpr size_t WS_X = 124 * MiB, WS_H = 256 * MiB, WS_DYN = 322 * MiB;
constexpr size_t WS_PA = WS_DYN;
constexpr size_t WS_RI = 463 * MiB;
constexpr size_t WS_GG = 760 * MiB;
constexpr size_t WS_BON = 826 * MiB;
constexpr size_t WS_QN = 831 * MiB, WS_KVN = 848 * MiB;
constexpr size_t WS_Q = 857 * MiB, WS_K = 907 * MiB, WS_V = 957 * MiB, WS_END = 990 * MiB;
constexpr size_t WS_Y = WS_DYN;
constexpr size_t WS_YA = 388 * MiB, WS_YB = 421 * MiB;
constexpr size_t WS_T1 = 463 * MiB, WS_T2 = 529 * MiB;
constexpr size_t WS_PU = 600 * MiB, WS_PV = 664 * MiB;
constexpr size_t WS_CA = 600 * MiB, WS_CB = 608 * MiB;
#ifndef CTX_SPLIT
#define CTX_SPLIT (MK_N_LAUNCHES == 1)
#endif
constexpr size_t WS_P4 = 990 * MiB, WS_P4S = 1022 * MiB, WS_END2 = 1023 * MiB;
constexpr size_t WS_SC = WS_DYN;
static_assert(WS_PA + (size_t)MALL * INA_P * 2 <= WS_RI && WS_RI + (size_t)NBATCH * NH * TPB * RREC * 2 <= WS_GG && WS_GG + (size_t)2 * MALL * RW * 2 <= WS_BON, "ws map 1");
static_assert(WS_BON + (size_t)2 * MALL * 32 * 4 <= WS_QN && WS_QN + (size_t)MALL * 512 * 2 <= WS_KVN && WS_KVN + (size_t)MALL * 256 * 2 <= WS_Q, "ws map 2");
static_assert(WS_Q + (size_t)NBATCH * NH * TPB * QKD * 2 <= WS_K && WS_K + (size_t)NBATCH * NH * TPB * QKD * 2 <= WS_V && WS_V + (size_t)NBATCH * NH * TPB * 64 * 2 <= WS_END, "ws map 3");
static_assert(WS_Y + (size_t)2 * MALL * RW * 2 <= WS_YA && WS_YA + (size_t)MALL * RW * 2 <= WS_YB && WS_YB + (size_t)MALL * RW * 2 <= WS_RI, "ws map 4");
static_assert(WS_T1 + (size_t)MALL * DM * 2 <= WS_T2 && WS_T2 + (size_t)MALL * DM * 2 <= WS_PU && WS_PU + (size_t)NEXP * DM * 2 <= WS_PV && WS_PV + (size_t)NEXP * DM * 2 <= WS_GG, "ws map 5");
static_assert(WS_SC + (size_t)MALL * DM * 4 <= WS_T1 && WS_X + (size_t)MALL * DM * 4 <= WS_H && WS_H + (size_t)MALL * DM * 2 <= WS_DYN, "ws map 6");
static_assert(WS_WINA + (size_t)NLAYER * INA_P * DM * 2 <= WS_X, "ws map 7");
constexpr size_t CTL_PROBE_OFF = 640 * 1024;
constexpr int CW_BAR = 4096;

constexpr int RING_BYTES = 131072;
constexpr int LDSCTL_OFF = RING_BYTES, MISC_OFF = LDSCTL_OFF + 320;
constexpr int LDS_BYTES = 147456;

#define GAS __attribute__((address_space(1)))
#define LAS __attribute__((address_space(3)))
typedef unsigned short bf16;
typedef unsigned v4u __attribute__((ext_vector_type(4)));
typedef unsigned v2u __attribute__((ext_vector_type(2)));
typedef float f32x4 __attribute__((ext_vector_type(4)));
typedef float f32x2 __attribute__((ext_vector_type(2)));
typedef float f32x16 __attribute__((ext_vector_type(16)));
typedef short bf16x8 __attribute__((ext_vector_type(8)));
typedef short s16x4 __attribute__((ext_vector_type(4)));
typedef __bf16 bf16x2v __attribute__((ext_vector_type(2)));
typedef __bf16 bf16x8v __attribute__((ext_vector_type(8)));
typedef GAS unsigned gu32;
#define RLX_AGENT __ATOMIC_RELAXED, __HIP_MEMORY_SCOPE_AGENT
#define LDS_WAIT() asm volatile("s_waitcnt lgkmcnt(0)" ::: "memory")
#define VM_WAIT() asm volatile("s_waitcnt vmcnt(0)" ::: "memory")
__device__ __forceinline__ unsigned f2bf(float f) { unsigned u = __builtin_bit_cast(unsigned, f); return (u + 0x7fffu + ((u >> 16) & 1u)) >> 16; }
__device__ __forceinline__ unsigned pk2(float lo, float hi) { return pg8::cvt_pk_bf16(lo, hi); }
__device__ __forceinline__ float bflo(unsigned w) { return __builtin_bit_cast(float, w << 16); }
__device__ __forceinline__ float bfhi(unsigned w) { return __builtin_bit_cast(float, w & 0xffff0000u); }
__device__ __forceinline__ float bf1(bf16 h) { return __builtin_bit_cast(float, (unsigned)h << 16); }
__device__ __forceinline__ float sigmoidf_(float x) { return __builtin_amdgcn_rcpf(1.0f + __expf(-x)); }
template <int CTRL> __device__ __forceinline__ float dpp_add(float x) {
    return x + __builtin_bit_cast(float, __builtin_amdgcn_update_dpp(0, __builtin_bit_cast(int, x), CTRL, 0xf, 0xf, true));
}
__device__ __forceinline__ float red16(float x) {
    x = dpp_add<0xB1>(x);
    x = dpp_add<0x4E>(x);
    x = dpp_add<0x141>(x);
    x = dpp_add<0x140>(x);
    return x;
}
template <int CTRL, int RM> __device__ __forceinline__ float dpp_max(float x) {
    return fmaxf(x, __builtin_bit_cast(float, __builtin_amdgcn_update_dpp(__builtin_bit_cast(int, x), __builtin_bit_cast(int, x), CTRL, RM, 0xf, false)));
}
template <int CTRL, int RM> __device__ __forceinline__ float dpp_sum(float x) {
    return x + __builtin_bit_cast(float, __builtin_amdgcn_update_dpp(0, __builtin_bit_cast(int, x), CTRL, RM, 0xf, false));
}
__device__ __forceinline__ float wave_max_u(float x) {
    x = dpp_max<0xB1, 0xf>(x); x = dpp_max<0x4E, 0xf>(x); x = dpp_max<0x141, 0xf>(x); x = dpp_max<0x140, 0xf>(x);
    x = dpp_max<0x142, 0xa>(x); x = dpp_max<0x143, 0xc>(x);
    return __builtin_bit_cast(float, __builtin_amdgcn_readlane(__builtin_bit_cast(int, x), 63));
}
__device__ __forceinline__ float wave_sum_u(float x) {
    x = dpp_sum<0xB1, 0xf>(x); x = dpp_sum<0x4E, 0xf>(x); x = dpp_sum<0x141, 0xf>(x); x = dpp_sum<0x140, 0xf>(x);
    x = dpp_sum<0x142, 0xa>(x); x = dpp_sum<0x143, 0xc>(x);
    return __builtin_bit_cast(float, __builtin_amdgcn_readlane(__builtin_bit_cast(int, x), 63));
}
__device__ __forceinline__ float wave_sum(float v) { return wave_sum_u(v); }
__device__ __forceinline__ float bpermf(int srclane, float v) { return __builtin_bit_cast(float, __builtin_amdgcn_ds_bpermute(srclane << 2, __builtin_bit_cast(int, v))); }
__device__ __forceinline__ int bpermi(int srclane, int v) { return __builtin_amdgcn_ds_bpermute(srclane << 2, v); }

#define XB_TMO      128
#define XB_XCNT(j)  (256  + 64 * (j))
#define XB_XSUB(j)  (1280 + 64 * (j))
#define XB_XGEN(j)  (2304 + 64 * (j))
#define XB_TOP      3328
#define XB_TOPGEN   3392
#define XCD_BAR_WORDS 3456
#define XB_SPIN_CAP (1u << 20)

__device__ __forceinline__ unsigned xb_ld(unsigned* p)              { return __hip_atomic_load(p, __ATOMIC_RELAXED, __HIP_MEMORY_SCOPE_AGENT); }
__device__ __forceinline__ unsigned xb_add(unsigned* p, unsigned v) { return __hip_atomic_fetch_add(p, v, __ATOMIC_RELAXED, __HIP_MEMORY_SCOPE_AGENT); }
__device__ __forceinline__ unsigned xb_xcc_id() { return (unsigned)__builtin_amdgcn_s_getreg((3 << 11) | 20) & 0xFu; }
#define XB_SPIN(cond, bar) do { unsigned _sp = 0; while (cond) { __builtin_amdgcn_s_sleep(1); \
    if ((++_sp & 255u) == 0u) { if (xb_ld(&(bar)[XB_TMO])) break; if (_sp > XB_SPIN_CAP) { atomicAdd(&(bar)[XB_TMO], 1u); break; } } } } while (0)

struct XcdBarrier { unsigned* bar; unsigned x; volatile LAS unsigned* st; };

__device__ __forceinline__ XcdBarrier xcd_barrier_post(unsigned* bar, volatile LAS unsigned* st, bool t0) {
    XcdBarrier b; b.bar = bar; b.x = xb_xcc_id(); b.st = st;
    if (t0) (void)xb_add(&bar[XB_XCNT(b.x)], 1u);
    return b;
}
__device__ __forceinline__ void xcd_barrier_complete(unsigned* bar, unsigned x, unsigned& nloc, unsigned& nx) {
    const unsigned G = gridDim.x * gridDim.y * gridDim.z;
    unsigned sum, cnt, mine, sp = 0u;
    for (;;) {
        sum = 0u; cnt = 0u; mine = 0u;
#pragma unroll
        for (unsigned j = 0; j < 16; ++j) { const unsigned c = xb_ld(&bar[XB_XCNT(j)]); sum += c; cnt += (c > 0u) ? 1u : 0u; mine = (j == x) ? c : mine; }
        if (sum == G) break;
        __builtin_amdgcn_s_sleep(1);
        if ((++sp & 255u) == 0u) { if (xb_ld(&bar[XB_TMO])) break; if (sp > XB_SPIN_CAP) { atomicAdd(&bar[XB_TMO], 1u); break; } }
    }
    nloc = mine > 0u ? mine : 1u; nx = cnt > 0u ? cnt : 1u;
}
__device__ __forceinline__ void xcd_barrier(const XcdBarrier& b, bool t0) {
    asm volatile("s_waitcnt vmcnt(0)" ::: "memory");
    __syncthreads();
    if (t0) {
        unsigned* bar = b.bar;
        __builtin_amdgcn_s_waitcnt(0);
        unsigned nloc = b.st[0], nx = b.st[1];
        if (nloc == 0u) { xcd_barrier_complete(bar, b.x, nloc, nx); b.st[0] = nloc; b.st[1] = nx; }
        const unsigned old = xb_add(&bar[XB_XSUB(b.x)], 1u);
        const unsigned gen = old / nloc;
        if (old + 1u == (gen + 1u) * nloc) {
            __builtin_amdgcn_fence(__ATOMIC_RELEASE, "agent");
            asm volatile("s_waitcnt vmcnt(0)" ::: "memory");
            const unsigned og = xb_add(&bar[XB_TOP], 1u);
            const unsigned tg = og / nx;
            if (og + 1u == (tg + 1u) * nx) xb_add(&bar[XB_TOPGEN], 1u);
            else XB_SPIN(xb_ld(&bar[XB_TOPGEN]) == tg, bar);
            __builtin_amdgcn_fence(__ATOMIC_ACQUIRE, "agent");
            xb_add(&bar[XB_XGEN(b.x)], 1u);
            asm volatile("s_waitcnt vmcnt(0)" ::: "memory");
        } else {
            XB_SPIN(xb_ld(&bar[XB_XGEN(b.x)]) == gen, bar);
            __builtin_amdgcn_fence(__ATOMIC_ACQUIRE, "agent");
            asm volatile("s_waitcnt vmcnt(0)" ::: "memory");
        }
    }
    __syncthreads();
}

struct Frame {
    LAS unsigned char* lds;
    unsigned char* ws;
    const float* const* in;
    int tid, lane, wave;
    int vcu, G;
};
struct Args { const float* in[33]; float* out; unsigned char* ws; int ph_lo, ph_hi; };


namespace pg8 {
typedef unsigned u32x4 __attribute__((ext_vector_type(4)));
struct RowOrder : StaticOrder {
    int lat;
    __host__ __device__ void init_rows(int lat_, int N, int G_, int c_) { lat = lat_; init(lat_ ? NBATCH * SEQ : MALL, N, G_, c_); }
    __host__ __device__ bool next(int i, Unit& u) const { if (!StaticOrder::next(i, u)) return false; if (lat) u.pm = 33 * (u.pm >> 5) + 1 + (u.pm & 31); return true; }
};
#define EPI_LOOP_ROWS for (int ai = 0; ai < 2; ++ai) _Pragma("unroll") for (int m = 0; m < 4; ++m)
#define EPI_PIN asm volatile("" ::: "memory")

struct EpiStoreBf16 {
    static constexpr bool PERM = true, AFTER_DRAIN = false;
    bf16_t* O; int ldc;
    __device__ __forceinline__ void operator()(const f32x4 (&acc)[2][2][4][2], const Unit& u, int wr, int wc, int fr, int fq) const {
        const int row0 = u.pm * BM + wr * 64 + fr, col0 = u.pn * BM + wc * 32 + 8 * fq;
#pragma unroll
        EPI_LOOP_ROWS { bf16_t* rowp = O + (size_t)(row0 + ai * HALF + m * 16) * ldc + col0;
#pragma unroll
            for (int bj = 0; bj < 2; ++bj) { const f32x4 v0 = acc[ai][bj][m][0], v1 = acc[ai][bj][m][1];
                u32x4 w; w.x = cvt_pk_bf16(v0[0], v0[1]); w.y = cvt_pk_bf16(v0[2], v0[3]); w.z = cvt_pk_bf16(v1[0], v1[1]); w.w = cvt_pk_bf16(v1[2], v1[3]);
                *(u32x4*)(rowp + bj * HALF) = w; } }
    }
};
struct EpiGate {
    static constexpr bool PERM = true, AFTER_DRAIN = false;
    bf16_t* O; int ldc; const float* bias;
    __device__ __forceinline__ void operator()(const f32x4 (&acc)[2][2][4][2], const Unit& u, int wr, int wc, int fr, int fq) const {
        const int row0 = u.pm * BM + wr * 64 + fr, col0 = u.pn * BM + wc * 32 + 8 * fq;
        f32x4 bv[2][2];
#pragma unroll
        for (int bj = 0; bj < 2; ++bj)
#pragma unroll
            for (int n = 0; n < 2; ++n) bv[bj][n] = *(const f32x4*)(bias + col0 + bj * HALF + 4 * n);
#pragma unroll
        EPI_LOOP_ROWS { EPI_PIN; bf16_t* rowp = O + (size_t)(row0 + ai * HALF + m * 16) * ldc + col0;
#pragma unroll
            for (int bj = 0; bj < 2; ++bj) { f32x4 v0 = acc[ai][bj][m][0] + bv[bj][0], v1 = acc[ai][bj][m][1] + bv[bj][1];
#pragma unroll
                for (int e = 0; e < 4; ++e) { v0[e] = __builtin_amdgcn_rcpf(1.0f + __expf(-v0[e])); v1[e] = __builtin_amdgcn_rcpf(1.0f + __expf(-v1[e])); }
                u32x4 w; w.x = cvt_pk_bf16(v0[0], v0[1]); w.y = cvt_pk_bf16(v0[2], v0[3]); w.z = cvt_pk_bf16(v1[0], v1[1]); w.w = cvt_pk_bf16(v1[2], v1[3]);
                *(u32x4*)(rowp + bj * HALF) = w; } }
    }
};
__device__ __forceinline__ float bf_lo(unsigned w) { return __builtin_bit_cast(float, w << 16); }
__device__ __forceinline__ float bf_hi(unsigned w) { return __builtin_bit_cast(float, w & 0xffff0000u); }
struct EpiMulAdd {
    static constexpr bool PERM = true, AFTER_DRAIN = false;
    bf16_t* O; const bf16_t* Gt; const bf16_t* Ad; int ldc;
    __device__ __forceinline__ void operator()(const f32x4 (&acc)[2][2][4][2], const Unit& u, int wr, int wc, int fr, int fq) const {
        const int row0 = u.pm * BM + wr * 64 + fr, col0 = u.pn * BM + wc * 32 + 8 * fq;
#pragma unroll
        EPI_LOOP_ROWS { EPI_PIN; const size_t ro = (size_t)(row0 + ai * HALF + m * 16) * ldc + col0;
#pragma unroll
            for (int bj = 0; bj < 2; ++bj) { const f32x4 v0 = acc[ai][bj][m][0], v1 = acc[ai][bj][m][1];
                const u32x4 g = *(const u32x4*)(Gt + ro + bj * HALF);
                float o[8];
                o[0] = bf_lo(g.x) * v0[0]; o[1] = bf_hi(g.x) * v0[1]; o[2] = bf_lo(g.y) * v0[2]; o[3] = bf_hi(g.y) * v0[3];
                o[4] = bf_lo(g.z) * v1[0]; o[5] = bf_hi(g.z) * v1[1]; o[6] = bf_lo(g.w) * v1[2]; o[7] = bf_hi(g.w) * v1[3];
                if (Ad) { const u32x4 a = *(const u32x4*)(Ad + ro + bj * HALF);
                    o[0] += bf_lo(a.x); o[1] += bf_hi(a.x); o[2] += bf_lo(a.y); o[3] += bf_hi(a.y); o[4] += bf_lo(a.z); o[5] += bf_hi(a.z); o[6] += bf_lo(a.w); o[7] += bf_hi(a.w); }
                u32x4 w; w.x = cvt_pk_bf16(o[0], o[1]); w.y = cvt_pk_bf16(o[2], o[3]); w.z = cvt_pk_bf16(o[4], o[5]); w.w = cvt_pk_bf16(o[6], o[7]);
                *(u32x4*)(O + ro + bj * HALF) = w; } }
    }
};
struct EpiResid {
    static constexpr bool PERM = true, AFTER_DRAIN = false;
    bf16_t* X; const float* gate;
    const float* xin; const float* cin;
    __device__ __forceinline__ void operator()(const f32x4 (&acc)[2][2][4][2], const Unit& u, int wr, int wc, int fr, int fq) const {
        const int col0 = u.pn * BM + wc * 32 + 8 * fq;
        const int bb = u.pm / 33, pt = u.pm - bb * 33, mr = (pt == 0) ? 2 : bb;
        const float* gp = gate + (size_t)mr * 12288 + col0;
        const float* sbase = xin ? (pt == 0 ? cin + (size_t)bb * CTXL * DM : xin + ((size_t)bb * SEQ + (size_t)(pt - 1) * BM) * DM) : nullptr;
        f32x4 gv[2][2];
#pragma unroll
        for (int bj = 0; bj < 2; ++bj)
#pragma unroll
            for (int n = 0; n < 2; ++n) gv[bj][n] = *(const f32x4*)(gp + bj * HALF + n * 4);
#pragma unroll
        EPI_LOOP_ROWS { EPI_PIN; const int rl = wr * 64 + fr + ai * HALF + m * 16; bf16_t* rowp = X + (size_t)(u.pm * BM + rl) * DM + col0;
#pragma unroll
            for (int bj = 0; bj < 2; ++bj) { f32x4 s0, s1;
                if (sbase) { const float* srow = sbase + (size_t)rl * DM + col0 + bj * HALF; s0 = *(const f32x4*)srow; s1 = *(const f32x4*)(srow + 4); }
                else { const u32x4 w = *(const u32x4*)(rowp + bj * HALF);
                    s0 = (f32x4){__builtin_bit_cast(float, w.x << 16), __builtin_bit_cast(float, w.x & 0xffff0000u), __builtin_bit_cast(float, w.y << 16), __builtin_bit_cast(float, w.y & 0xffff0000u)};
                    s1 = (f32x4){__builtin_bit_cast(float, w.z << 16), __builtin_bit_cast(float, w.z & 0xffff0000u), __builtin_bit_cast(float, w.w << 16), __builtin_bit_cast(float, w.w & 0xffff0000u)}; }
                const f32x4 r0 = s0 + gv[bj][0] * acc[ai][bj][m][0], r1 = s1 + gv[bj][1] * acc[ai][bj][m][1];
                u32x4 o; o.x = cvt_pk_bf16(r0[0], r0[1]); o.y = cvt_pk_bf16(r0[2], r0[3]); o.z = cvt_pk_bf16(r1[0], r1[1]); o.w = cvt_pk_bf16(r1[2], r1[3]);
                *(u32x4*)(rowp + bj * HALF) = o; } }
    }
};
struct EpiF32 {
    static constexpr bool PERM = false, AFTER_DRAIN = false;
    float* C; int ldc;
    __device__ __forceinline__ void operator()(const f32x4 (&acc)[2][2][4][2], const Unit& u, int wr, int wc, int fr, int fq) const {
        const int row0 = u.pm * BM + wr * 64 + fr, col0 = u.pn * BM + wc * 32 + 4 * fq;
#pragma unroll
        EPI_LOOP_ROWS { float* rowp = C + (size_t)(row0 + ai * HALF + m * 16) * ldc + col0;
#pragma unroll
            for (int bj = 0; bj < 2; ++bj)
#pragma unroll
                for (int n = 0; n < 2; ++n) *(f32x4*)(rowp + bj * HALF + n * 16) = acc[ai][bj][m][n]; }
    }
};
struct EpiCtxF32 {
    static constexpr bool PERM = false, AFTER_DRAIN = false;
    float* C; int ldc;
    __device__ __forceinline__ void operator()(const f32x4 (&acc)[2][2][4][2], const Unit& u, int wr, int wc, int fr, int fq) const {
        const int row0 = (u.pm ? BM : 0) + wr * 64 + fr, col0 = u.pn * BM + wc * 32 + 4 * fq;
#pragma unroll
        EPI_LOOP_ROWS { float* rowp = C + (size_t)(row0 + ai * HALF + m * 16) * ldc + col0;
#pragma unroll
            for (int bj = 0; bj < 2; ++bj)
#pragma unroll
                for (int n = 0; n < 2; ++n) *(f32x4*)(rowp + bj * HALF + n * 16) = acc[ai][bj][m][n]; }
    }
};
struct CtxOrder {
    int u0;
    __host__ __device__ bool next(int i, Unit& u) const { if (i != 0 || u0 < 0) return false; u.pm = (u0 >> 3) ? 33 : 0; u.pn = u0 & 7; return true; }
    __device__ __forceinline__ void a_ready(const Unit&) const {}
    __device__ __forceinline__ void done(const Unit&) const {}
};
struct EpiF16 {
    static constexpr bool PERM = true, AFTER_DRAIN = false;
    _Float16* C; int ldc;
    __device__ __forceinline__ void operator()(const f32x4 (&acc)[2][2][4][2], const Unit& u, int wr, int wc, int fr, int fq) const {
        typedef _Float16 h2 __attribute__((ext_vector_type(2)));
        const int row0 = u.pm * BM + wr * 64 + fr, col0 = u.pn * BM + wc * 32 + 8 * fq;
#pragma unroll
        EPI_LOOP_ROWS { _Float16* rowp = C + (size_t)(row0 + ai * HALF + m * 16) * ldc + col0;
#pragma unroll
            for (int bj = 0; bj < 2; ++bj) { const f32x4 v0 = acc[ai][bj][m][0], v1 = acc[ai][bj][m][1];
                u32x4 w; w.x = __builtin_bit_cast(unsigned, (h2){(_Float16)v0[0], (_Float16)v0[1]}); w.y = __builtin_bit_cast(unsigned, (h2){(_Float16)v0[2], (_Float16)v0[3]});
                w.z = __builtin_bit_cast(unsigned, (h2){(_Float16)v1[0], (_Float16)v1[1]}); w.w = __builtin_bit_cast(unsigned, (h2){(_Float16)v1[2], (_Float16)v1[3]});
                *(u32x4*)(rowp + bj * HALF) = w; } }
    }
};
struct EpiQ {
    static constexpr bool PERM = true, AFTER_DRAIN = false;
    bf16_t* Q; const f32x2* rope; float qscale;
    __device__ __forceinline__ void operator()(const f32x4 (&acc)[2][2][4][2], const Unit& u, int wr, int wc, int fr, int fq) const {
        const int bb = u.pm / 33, tp0 = (u.pm - bb * 33) * BM + wr * 64 + fr, col0 = u.pn * BM + wc * 32 + 8 * fq;
#pragma unroll
        for (int bj = 0; bj < 2; ++bj) { const int c = col0 + bj * HALF, hd = c / QKD, d = c - hd * QKD;
#pragma unroll
            EPI_LOOP_ROWS { EPI_PIN; const int tp = tp0 + ai * HALF + m * 16;
                f32x4 v0 = acc[ai][bj][m][0], v1 = acc[ai][bj][m][1];
                if (d >= 64) { const int i0 = (d - 64) >> 1; const f32x2* rp = rope + (size_t)tp * 16 + i0;
                    const f32x2 c0 = rp[0], c1 = rp[1], c2 = rp[2], c3 = rp[3];
                    float a, b;
                    a = v0[0]; b = v0[1]; v0[0] = a * c0.x - b * c0.y; v0[1] = a * c0.y + b * c0.x;
                    a = v0[2]; b = v0[3]; v0[2] = a * c1.x - b * c1.y; v0[3] = a * c1.y + b * c1.x;
                    a = v1[0]; b = v1[1]; v1[0] = a * c2.x - b * c2.y; v1[1] = a * c2.y + b * c2.x;
                    a = v1[2]; b = v1[3]; v1[2] = a * c3.x - b * c3.y; v1[3] = a * c3.y + b * c3.x; }
                v0 = v0 * qscale; v1 = v1 * qscale;
                u32x4 w; w.x = cvt_pk_bf16(v0[0], v0[1]); w.y = cvt_pk_bf16(v0[2], v0[3]); w.z = cvt_pk_bf16(v1[0], v1[1]); w.w = cvt_pk_bf16(v1[2], v1[3]);
                *(u32x4*)(Q + ((size_t)(bb * NH + hd) * TPB + tp) * QKD + d) = w; } }
    }
};
struct EpiKV {
    static constexpr bool PERM = true, AFTER_DRAIN = false;
    bf16_t* K; bf16_t* V;
    __device__ __forceinline__ void operator()(const f32x4 (&acc)[2][2][4][2], const Unit& u, int wr, int wc, int fr, int fq) const {
        const int bb = u.pm / 33, tp0 = (u.pm - bb * 33) * BM + wr * 64 + fr;
        const bool isK = wc < 2;
        bf16_t* base = isK ? K : V; const int pitch = isK ? QKD : 64, doff = 32 * (wc & 1) + 8 * fq;
#pragma unroll
        for (int bj = 0; bj < 2; ++bj) { const int hd = 2 * u.pn + bj;
            bf16_t* hb = base + (size_t)(bb * NH + hd) * TPB * pitch;
#pragma unroll
            EPI_LOOP_ROWS { EPI_PIN; const int tp = tp0 + ai * HALF + m * 16;
                const f32x4 v0 = acc[ai][bj][m][0], v1 = acc[ai][bj][m][1];
                u32x4 w; w.x = cvt_pk_bf16(v0[0], v0[1]); w.y = cvt_pk_bf16(v0[2], v0[3]); w.z = cvt_pk_bf16(v1[0], v1[1]); w.w = cvt_pk_bf16(v1[2], v1[3]);
                *(u32x4*)((char*)hb + (unsigned)((tp * pitch + doff) * 2)) = w; } }
    }
};
}

struct TItem { const float* W; bf16* WT; int K, ldw, c0, N, mapq, item; };
__device__ __forceinline__ void p0_item_load(const TItem& T, int lane, f32x4 (&x)[8]) {
    const int nblk = T.N / 32, kb = T.item / nblk, nb = T.item - kb * nblk, k0 = 64 * kb, n0 = 32 * nb;
    const float* p = T.W + (size_t)(k0 + (lane >> 3)) * T.ldw + T.c0 + n0 + (lane & 7) * 4;
#pragma unroll
    for (int i = 0; i < 8; ++i) x[i] = *(const GAS f32x4*)(p + (size_t)(8 * i) * T.ldw);
}
__device__ __forceinline__ void p0_item_finish(const TItem& T, const f32x4 (&x)[8], LAS float* scr, int lane) {
    const int nblk = T.N / 32, kb = T.item / nblk, nb = T.item - kb * nblk, k0 = 64 * kb, n0 = 32 * nb;
#pragma unroll
    for (int i = 0; i < 8; ++i) { LAS float* d = scr + (8 * i + (lane >> 3)) * 33 + (lane & 7) * 4; d[0] = x[i].x; d[1] = x[i].y; d[2] = x[i].z; d[3] = x[i].w; }
    LDS_WAIT(); asm volatile("" ::: "memory");
    const int c = lane & 7;
#pragma unroll
    for (int j = 0; j < 4; ++j) { const int n = (lane >> 3) + 8 * j; const LAS float* s = scr + (8 * c) * 33 + n;
        v4u o; o.x = pk2(s[0 * 33], s[1 * 33]); o.y = pk2(s[2 * 33], s[3 * 33]); o.z = pk2(s[4 * 33], s[5 * 33]); o.w = pk2(s[6 * 33], s[7 * 33]);
        int nn = n0 + n;
        if (T.mapq) { const int hd = nn / QKD, d = nn - hd * QKD; if (d >= 64) { const int i = (d - 64) & 15, s2 = (d - 64) >> 4; nn = hd * QKD + 64 + 2 * i + s2; } }
        *(GAS v4u*)(T.WT + (size_t)nn * T.K + k0 + 8 * c) = o; }
    LDS_WAIT(); asm volatile("" ::: "memory");
}

__device__ __forceinline__ const float* karg(int i);
constexpr int TB_INA = (DM / 128) * ((INA + 127) / 128), TB_G = (DM / 128) * (DM / 128), TB_BR = (RW / 128) * (DM / 128), TB_UQ = (512 / 128) * (NQ / 128), TB_UKV = (256 / 128) * (NKV / 128);
constexpr int TB_N = TB_INA + 2 * TB_G + 2 * TB_BR + TB_G + TB_UQ + TB_UKV;
constexpr int TI_LR = 1 * (RW / 32), TI_N = 4 * TI_LR;
__device__ __forceinline__ TItem p0_resolve_big(unsigned char* ws, int git) {
    const int l = git / TB_N; int r = git - l * TB_N; TItem T; T.mapq = 0; T.c0 = 0;
    if (r < TB_INA) { T.W = karg(7) + (size_t)l * DM * INC; T.K = DM; T.ldw = INC; T.N = INA; T.WT = (bf16*)(ws + WS_WINA) + (size_t)l * INA_P * DM; T.item = r; return T; } r -= TB_INA;
    if (r < TB_G) { T.W = karg(7) + (size_t)l * DM * INC; T.K = DM; T.ldw = INC; T.c0 = INA; T.N = DM; T.WT = (bf16*)(ws + WS_WGA) + (size_t)l * DM * DM; T.item = r; return T; } r -= TB_G;
    if (r < TB_G) { T.W = karg(7) + (size_t)l * DM * INC; T.K = DM; T.ldw = INC; T.c0 = INA + DM; T.N = DM; T.WT = (bf16*)(ws + WS_WGB) + (size_t)l * DM * DM; T.item = r; return T; } r -= TB_G;
    if (r < TB_BR) { T.W = karg(24) + (size_t)l * RW * DM; T.K = RW; T.ldw = DM; T.N = DM; T.WT = (bf16*)(ws + WS_WA) + (size_t)l * DM * RW; T.item = r; return T; } r -= TB_BR;
    if (r < TB_BR) { T.W = karg(25) + (size_t)l * RW * DM; T.K = RW; T.ldw = DM; T.N = DM; T.WT = (bf16*)(ws + WS_WB) + (size_t)l * DM * RW; T.item = r; return T; } r -= TB_BR;
    if (r < TB_G) { T.W = karg(26) + (size_t)l * DM * DM; T.K = DM; T.ldw = DM; T.N = DM; T.WT = (bf16*)(ws + WS_WO) + (size_t)l * DM * DM; T.item = r; return T; } r -= TB_G;
    if (r < TB_UQ) { T.W = karg(21) + (size_t)l * 512 * NQ; T.K = 512; T.ldw = NQ; T.N = NQ; T.WT = (bf16*)(ws + WS_WUQ) + (size_t)l * NQ * 512; T.item = r; T.mapq = 1; return T; } r -= TB_UQ;
    { T.W = karg(23) + (size_t)l * 256 * NKV; T.K = 256; T.ldw = NKV; T.N = NKV; T.WT = (bf16*)(ws + WS_WUKV) + (size_t)l * NKV * 256; T.item = r; return T; }
}
__device__ __forceinline__ void p0_big_load(const TItem& T, int tid, f32x4 (&x)[8]) {
    const int nblk = (T.N + 127) / 128, kb = T.item / nblk, nb = T.item - kb * nblk, k0 = 128 * kb, col = 128 * nb + (tid & 31) * 4;
    const float* p = T.W + (size_t)(k0 + (tid >> 5)) * T.ldw + T.c0 + col; const bool ok = col < T.N;
#pragma unroll
    for (int i = 0; i < 8; ++i) x[i] = ok ? *(const GAS f32x4*)(p + (size_t)(16 * i) * T.ldw) : (f32x4){0.f, 0.f, 0.f, 0.f};
}
__device__ __forceinline__ void p0_big_finish(const TItem& T, const f32x4 (&x)[8], LAS float* tile, int tid) {
    const int nblk = (T.N + 127) / 128, kb = T.item / nblk, nb = T.item - kb * nblk, k0 = 128 * kb, n0 = 128 * nb;
    __syncthreads();
#pragma unroll
    for (int i = 0; i < 8; ++i) *(LAS f32x4*)(tile + ((tid >> 5) + 16 * i) * 132 + (tid & 31) * 4) = x[i];
    __syncthreads();
    const int n = tid & 127, cg = tid >> 7; int nn = n0 + n;
    if (nn < T.N) {
        if (T.mapq) { const int hd = nn / QKD, d = nn - hd * QKD; if (d >= 64) { const int i = (d - 64) & 15, s2 = (d - 64) >> 4; nn = hd * QKD + 64 + 2 * i + s2; } }
#pragma unroll
        for (int c = 0; c < 4; ++c) { const LAS float* s = tile + (32 * cg + 8 * c) * 132 + n;
            v4u o; o.x = pk2(s[0 * 132], s[1 * 132]); o.y = pk2(s[2 * 132], s[3 * 132]); o.z = pk2(s[4 * 132], s[5 * 132]); o.w = pk2(s[6 * 132], s[7 * 132]);
            *(GAS v4u*)(T.WT + (size_t)nn * T.K + k0 + 32 * cg + 8 * c) = o; } }
}
__device__ __forceinline__ TItem p0_resolve(unsigned char* ws, int git) {
    const int l = git / TI_N; int r = git - l * TI_N; TItem T; T.mapq = 0; T.c0 = 0;
    const int which = r / TI_LR, d = which & 1, isa = which >> 1; r -= which * TI_LR;
    T.W = (isa ? karg(13) : karg(11)) + (size_t)(l * 2 + d) * 64 * RW; T.K = 64; T.ldw = RW; T.N = RW; T.WT = (bf16*)(ws + (isa ? WS_AUP : WS_WUP)) + (size_t)(l * 2 + d) * RW * 64; T.item = r; return T;
}
constexpr int NWI_INA = (DM / 64) * (INA / 32), NWI_G = (DM / 64) * (DM / 32), NWI_BR = (RW / 64) * (DM / 32), NWI_UQ = (512 / 64) * (NQ / 32), NWI_UKV = (256 / 64) * (NKV / 32);
constexpr int NW_ITEMS = NWI_INA + 2 * NWI_G + 2 * NWI_BR + NWI_G + NWI_UQ + NWI_UKV + TI_N;
__device__ __forceinline__ TItem p0_resolve_wave(unsigned char* ws, int l, int r) {
    TItem T; T.mapq = 0; T.c0 = 0;
    if (r < NWI_INA) { T.W = karg(7) + (size_t)l * DM * INC; T.K = DM; T.ldw = INC; T.N = INA; T.WT = (bf16*)(ws + WS_WINA) + (size_t)l * INA_P * DM; T.item = r; return T; } r -= NWI_INA;
    if (r < NWI_G) { T.W = karg(7) + (size_t)l * DM * INC; T.K = DM; T.ldw = INC; T.c0 = INA; T.N = DM; T.WT = (bf16*)(ws + WS_WGA) + (size_t)l * DM * DM; T.item = r; return T; } r -= NWI_G;
    if (r < NWI_G) { T.W = karg(7) + (size_t)l * DM * INC; T.K = DM; T.ldw = INC; T.c0 = INA + DM; T.N = DM; T.WT = (bf16*)(ws + WS_WGB) + (size_t)l * DM * DM; T.item = r; return T; } r -= NWI_G;
    if (r < NWI_BR) { T.W = karg(24) + (size_t)l * RW * DM; T.K = RW; T.ldw = DM; T.N = DM; T.WT = (bf16*)(ws + WS_WA) + (size_t)l * DM * RW; T.item = r; return T; } r -= NWI_BR;
    if (r < NWI_BR) { T.W = karg(25) + (size_t)l * RW * DM; T.K = RW; T.ldw = DM; T.N = DM; T.WT = (bf16*)(ws + WS_WB) + (size_t)l * DM * RW; T.item = r; return T; } r -= NWI_BR;
    if (r < NWI_G) { T.W = karg(26) + (size_t)l * DM * DM; T.K = DM; T.ldw = DM; T.N = DM; T.WT = (bf16*)(ws + WS_WO) + (size_t)l * DM * DM; T.item = r; return T; } r -= NWI_G;
    if (r < NWI_UQ) { T.W = karg(21) + (size_t)l * 512 * NQ; T.K = 512; T.ldw = NQ; T.N = NQ; T.WT = (bf16*)(ws + WS_WUQ) + (size_t)l * NQ * 512; T.item = r; T.mapq = 1; return T; } r -= NWI_UQ;
    if (r < NWI_UKV) { T.W = karg(23) + (size_t)l * 256 * NKV; T.K = 256; T.ldw = NKV; T.N = NKV; T.WT = (bf16*)(ws + WS_WUKV) + (size_t)l * NKV * 256; T.item = r; return T; } r -= NWI_UKV;
    return p0_resolve(ws, l * TI_N + r);
}
__device__ __forceinline__ void p0_prologue(Frame& F, int l_lo, int l_hi, int svcu, int sG, int with_tr = 1) {
    LAS float* scr = (LAS float*)(F.lds + F.wave * 16384);
    const int gw = svcu * NWAVES + F.wave, NGW = sG * NWAVES;
    unsigned char* ws = F.ws;
    for (int rp_ = 0; rp_ < (DBG_REPEAT == 102 ? 2 : 1); ++rp_)
    { float* modw = (float*)(ws + WS_CTL + CTL_MOD_OFF); const float* adaw = karg(4); const float* adab = karg(5); const float* cin = karg(1); const float* cctx = karg(3);
      LAS float* SIL = (LAS float*)F.lds;
      LAS f32x2* part = (LAS f32x2*)(F.lds + 32768);
      if (svcu >= 0 && l_lo * 96 + svcu < l_hi * 96) {
          for (int i = F.tid; i < 3 * DM; i += 512) { const int r = i >> 11, k = i & 2047; const float c = r < 2 ? cin[r * DM + k] : cctx[k]; SIL[i] = c / (1.f + __expf(-c)); }
          __syncthreads(); }
      if (svcu >= 0) for (int uu = l_lo * 96 + svcu; uu < l_hi * 96; uu += sG) { const int cb = uu % 96, l = uu / 96;
          const int n0 = cb * 128 + F.lane * 2; const float* aw = adaw + (size_t)l * DM * 12288 + n0;
          f32x2 a0 = {0, 0}, a1 = a0, a2 = a0;
#pragma unroll 1
          for (int k0 = F.wave * 256; k0 < F.wave * 256 + 256; k0 += 16) { f32x2 w[16];
#pragma unroll
              for (int j = 0; j < 16; ++j) w[j] = *(const GAS f32x2*)(aw + (size_t)(k0 + j) * 12288);
#pragma unroll
              for (int j = 0; j < 16; ++j) { a0 = a0 + w[j] * SIL[k0 + j]; a1 = a1 + w[j] * SIL[DM + k0 + j]; a2 = a2 + w[j] * SIL[2 * DM + k0 + j]; } }
          __syncthreads();
          part[(F.wave * 3 + 0) * 64 + F.lane] = a0; part[(F.wave * 3 + 1) * 64 + F.lane] = a1; part[(F.wave * 3 + 2) * 64 + F.lane] = a2;
          __syncthreads();
          if (F.wave < 3) { f32x2 s = *(const GAS f32x2*)(adab + (size_t)l * 12288 + n0);
#pragma unroll
              for (int w8 = 0; w8 < 8; ++w8) s = s + part[(w8 * 3 + F.wave) * 64 + F.lane];
              *(GAS f32x2*)(modw + ((size_t)l * 3 + F.wave) * 12288 + n0) = s; }
          __syncthreads(); } }
    if (with_tr) for (int rp_ = 0; rp_ < (DBG_REPEAT == 101 ? 2 : 1); ++rp_)
    { unsigned* ctr = (unsigned*)(ws + WS_CTL) + 2048 + 64 * rp_ + 128 * l_lo; LAS float* tile = (LAS float*)F.lds; LAS int* slot = (LAS int*)(F.lds + 128 * 132 * 4);
#define P0_GRAB(dst) do { __syncthreads(); if (F.tid == 0) *slot = (int)__hip_atomic_fetch_add(ctr, 1u, __ATOMIC_RELAXED, __HIP_MEMORY_SCOPE_AGENT); __syncthreads(); dst = *slot; } while (0)
      const int it_end = l_hi * TB_N;
      int it; P0_GRAB(it); it += l_lo * TB_N; f32x4 xa[8], xb[8]; TItem T, Tn;
      if (it < it_end) { T = p0_resolve_big(ws, it); p0_big_load(T, F.tid, xa); }
      while (it < it_end) { int itn; P0_GRAB(itn); itn += l_lo * TB_N; const bool more = itn < it_end;
          if (more) { Tn = p0_resolve_big(ws, itn); p0_big_load(Tn, F.tid, xb); }
          p0_big_finish(T, xa, tile, F.tid);
          if (more) { T = Tn;
#pragma unroll
              for (int i = 0; i < 8; ++i) xa[i] = xb[i]; }
          it = itn; }
#undef P0_GRAB
      __syncthreads();
      if (svcu >= 0) for (int itw = l_lo * TI_N + gw; itw < l_hi * TI_N; itw += NGW) { f32x4 xw[8]; const TItem Tw = p0_resolve(ws, itw); p0_item_load(Tw, F.lane, xw); p0_item_finish(Tw, xw, scr, F.lane); }
    }
    const int gt = gw * 64 + F.lane, NGT = NGW * 64;
    { const float* gup = karg(14);
    if (svcu >= 0) for (int i = l_lo * 2 * 32 * RW + gt; i < l_hi * 2 * 32 * RW; i += NGT) { const int ch = i & 1023, r = (i >> 10) & 31, ld = i >> 15;
        ((bf16*)(ws + WS_GUP))[((size_t)ld * RW + ch) * 32 + r] = (bf16)f2bf(gup[i]); } }
    if (svcu >= 0) for (int i = l_lo * ((INA_P - INA) * DM / 8) + gt; i < l_hi * ((INA_P - INA) * DM / 8); i += NGT) { const int l = i / ((INA_P - INA) * DM / 8), r = i - l * ((INA_P - INA) * DM / 8);
        ((GAS v4u*)((bf16*)(ws + WS_WINA) + ((size_t)l * INA_P + INA) * DM))[r] = (v4u){0u, 0u, 0u, 0u}; }
    { f32x2* rt = (f32x2*)(ws + WS_ROPE);
      if (l_lo == 0 && svcu >= 0) for (int i = gt; i < TPB * 16; i += NGT) { const int tp = i >> 4, k = i & 15; f32x2 o = {1.f, 0.f};
          if (tp >= CTXL) { const int t = tp - CTXL, row = t >> 6, col = t & 63, j = k & 7; const float fr = powf(10000.0f, -(float)j / 8.0f);
              const float ang = (float)(k < 8 ? row : col) * fr; o.x = cosf(ang); o.y = sinf(ang); }
          rt[i] = o; } }
    for (int rp_ = 0; rp_ < (DBG_REPEAT == 103 ? 2 : 1); ++rp_)
    { LAS float* KEY = (LAS float*)F.lds;
      LAS float* WQT = (LAS float*)(F.lds + 65536);
      const float* pkeys = karg(29); const float* pwq = karg(28);
      __syncthreads();
      if (svcu >= 0) for (int uu = l_lo * 512 + svcu; uu < l_hi * 512; uu += sG) { const int kb = uu & 31, hp = (uu >> 5) & 15, l = uu >> 9;
          const GAS f32x4* ksrc = (const GAS f32x4*)(pkeys + ((size_t)l * 16 + hp) * 16384);
          for (int i = F.tid; i < 4096; i += 512) ((LAS f32x4*)KEY)[i] = ksrc[i];
          for (int i = F.tid; i < 2048; i += 512) { const int kk = i >> 5, d4 = i & 31;
              *(LAS f32x4*)(WQT + kk * 132 + d4 * 4) = *(const GAS f32x4*)(pwq + ((size_t)l * DM + kb * 64 + kk) * DM + hp * 128 + d4 * 4); }
          __syncthreads();
          const int kq = F.tid & 15, keyq = F.tid >> 4;
          float acc[4][4];
#pragma unroll
          for (int j = 0; j < 4; ++j)
#pragma unroll
              for (int i = 0; i < 4; ++i) acc[j][i] = 0.f;
          for (int d = 0; d < 128; d += 4) { f32x4 w[4], q[4];
#pragma unroll
              for (int i = 0; i < 4; ++i) w[i] = *(LAS f32x4*)(WQT + (kq + 16 * i) * 132 + d);
#pragma unroll
              for (int j = 0; j < 4; ++j) q[j] = *(LAS f32x4*)(KEY + (4 * keyq + j) * 128 + d);
#pragma unroll
              for (int j = 0; j < 4; ++j)
#pragma unroll
                  for (int i = 0; i < 4; ++i) acc[j][i] += q[j].x * w[i].x + q[j].y * w[i].y + q[j].z * w[i].z + q[j].w * w[i].w; }
          bf16* dst = (bf16*)(ws + WS_WQK) + ((size_t)l * DM + hp * 128 + 4 * keyq) * DM + kb * 64 + kq;
#pragma unroll
          for (int j = 0; j < 4; ++j)
#pragma unroll
              for (int i = 0; i < 4; ++i) dst[(size_t)j * DM + 16 * i] = (bf16)f2bf(acc[j][i]);
          __syncthreads(); } }
}

__device__ __forceinline__ const float* modnorm_src(int m, const float* X, const float* xin, const float* cin) {
    const int b = m / TPB, tp = m - b * TPB;
    return xin ? (tp < CTXL ? cin + ((size_t)b * CTXL + tp) * DM : xin + ((size_t)b * SEQ + (tp - CTXL)) * DM) : X + (size_t)m * DM;
}
__device__ __forceinline__ void modnorm_phase_bf(Frame& F, const bf16* X, const float* g, const float* mod  , int chunk_sh, bf16* H, int skip_ctx) {
    const int gw = F.vcu * NWAVES + F.wave, NGW = F.G * NWAVES;
    int m = gw; while (m < MALL && skip_ctx && (m % TPB) < CTXL) m += NGW;
    v4u v[4]; f32x4 ga[8], sb[8]; int mr_cur = -1;
    if (m < MALL) { const GAS v4u* xr = (const GAS v4u*)(X + (size_t)m * DM) + F.lane;
#pragma unroll
        for (int j = 0; j < 4; ++j) v[j] = xr[64 * j]; }
    while (m < MALL) {
        int mn = m + NGW; while (mn < MALL && skip_ctx && (mn % TPB) < CTXL) mn += NGW;
        v4u nv[4];
        if (mn < MALL) { const GAS v4u* xr = (const GAS v4u*)(X + (size_t)mn * DM) + F.lane;
#pragma unroll
            for (int j = 0; j < 4; ++j) nv[j] = xr[64 * j]; }
        const int b = m / TPB, tp = m - b * TPB, mr = tp < CTXL ? 2 : b;
        if (mr != mr_cur) { mr_cur = mr; const float* sh = mod + (size_t)mr * 12288 + chunk_sh * DM; const float* sc = sh + DM;
#pragma unroll
            for (int q = 0; q < 8; ++q) { const int c = (F.lane + 64 * (q >> 1)) * 8 + 4 * (q & 1); const f32x4 gg = *(const GAS f32x4*)(g + c), s1 = *(const GAS f32x4*)(sc + c); ga[q] = gg * (s1 + 1.0f); sb[q] = *(const GAS f32x4*)(sh + c); } }
        float x[4][8]; float s = 0.f;
#pragma unroll
        for (int j = 0; j < 4; ++j) { x[j][0] = bflo(v[j].x); x[j][1] = bfhi(v[j].x); x[j][2] = bflo(v[j].y); x[j][3] = bfhi(v[j].y); x[j][4] = bflo(v[j].z); x[j][5] = bfhi(v[j].z); x[j][6] = bflo(v[j].w); x[j][7] = bfhi(v[j].w);
#pragma unroll
            for (int e = 0; e < 8; ++e) s += x[j][e] * x[j][e]; }
        const float rs = rsqrtf(wave_sum(s) * (1.f / DM) + NORM_EPS);
        GAS v4u* o8 = (GAS v4u*)(H + (size_t)m * DM) + F.lane;
#pragma unroll
        for (int j = 0; j < 4; ++j) { float y[8];
#pragma unroll
            for (int e = 0; e < 8; ++e) y[e] = (x[j][e] * rs) * ga[2 * j + (e >> 2)][e & 3] + sb[2 * j + (e >> 2)][e & 3];
            v4u o; o.x = pk2(y[0], y[1]); o.y = pk2(y[2], y[3]); o.z = pk2(y[4], y[5]); o.w = pk2(y[6], y[7]); o8[64 * j] = o; }
#pragma unroll
        for (int j = 0; j < 4; ++j) v[j] = nv[j];
        m = mn;
    }
}
__device__ __forceinline__ void modnorm_phase(Frame& F, const float* X, const float* g, const float* mod  , int chunk_sh, bf16* H, int skip_ctx, const float* xin = nullptr, const float* cin = nullptr) {
    const int gw = F.vcu * NWAVES + F.wave, NGW = F.G * NWAVES;
    int m = gw; while (m < MALL && skip_ctx && (m % TPB) < CTXL) m += NGW;
    f32x4 v[8], ga[8], sb[8]; int mr_cur = -1;
    if (m < MALL) { const GAS f32x4* xr = (const GAS f32x4*)modnorm_src(m, X, xin, cin) + F.lane;
#pragma unroll
        for (int j = 0; j < 8; ++j) v[j] = xr[64 * j]; }
    while (m < MALL) {
        int mn = m + NGW; while (mn < MALL && skip_ctx && (mn % TPB) < CTXL) mn += NGW;
        f32x4 nv[8];
        if (mn < MALL) { const GAS f32x4* xr = (const GAS f32x4*)modnorm_src(mn, X, xin, cin) + F.lane;
#pragma unroll
            for (int j = 0; j < 8; ++j) nv[j] = xr[64 * j]; }
        const int b = m / TPB, tp = m - b * TPB, mr = tp < CTXL ? 2 : b;
        if (mr != mr_cur) { mr_cur = mr; const float* sh = mod + (size_t)mr * 12288 + chunk_sh * DM; const float* sc = sh + DM;
#pragma unroll
            for (int j = 0; j < 8; ++j) { const int c = (F.lane + 64 * j) * 4; const f32x4 gg = *(const GAS f32x4*)(g + c), s1 = *(const GAS f32x4*)(sc + c); ga[j] = gg * (s1 + 1.0f); sb[j] = *(const GAS f32x4*)(sh + c); } }
        float s = 0.f;
#pragma unroll
        for (int j = 0; j < 8; ++j) s += (v[j].x * v[j].x + v[j].y * v[j].y) + (v[j].z * v[j].z + v[j].w * v[j].w);
        const float rs = rsqrtf(wave_sum(s) * (1.f / DM) + NORM_EPS);
        GAS v2u* o8 = (GAS v2u*)(H + (size_t)m * DM) + F.lane;
#pragma unroll
        for (int j = 0; j < 8; ++j) { const f32x4 y = (v[j] * rs) * ga[j] + sb[j];
            v2u o; o.x = pk2(y.x, y.y); o.y = pk2(y.z, y.w); o8[64 * j] = o; }
#pragma unroll
        for (int j = 0; j < 8; ++j) v[j] = nv[j];
        m = mn;
    }
}

typedef float f32x4v __attribute__((ext_vector_type(4)));
#define MFMA16(a, b, c) __builtin_amdgcn_mfma_f32_16x16x32_bf16((a), (b), (c), 0, 0, 0)
#define MFMA32(a, b, c) __builtin_amdgcn_mfma_f32_32x32x16_bf16((a), (b), (c), 0, 0, 0)

struct FeatP {
    const bf16* PA; const float* mu; const float* w0; const float* a0; const float* k_k; const float* k_a; const float* r_k;
    const bf16* WUP; const bf16* AUP; const bf16* GUP;
    const float* qnorm; const float* kvnorm; const f32x2* rope;
    bf16* RI; bf16* GG; float* BON; bf16* QN; bf16* KVN; bf16* K;
};
__device__ __forceinline__ f32x4 ld4bf(const bf16* p) { const v2u w = *(const GAS v2u*)p; return (f32x4){bflo(w.x), bfhi(w.x), bflo(w.y), bfhi(w.y)}; }
__device__ __forceinline__ f32x4 mix4(const bf16* PA, int m, int c, bool hp, bool hn, const float* mu) {
    const f32x4 pc = ld4bf(PA + (size_t)m * INA_P + c);
    f32x4 pp = {0, 0, 0, 0}, pn = {0, 0, 0, 0};
    if (hp) pp = ld4bf(PA + (size_t)(m - 1) * INA_P + c);
    if (hn) pn = ld4bf(PA + (size_t)(m + 1) * INA_P + c);
    const f32x4 mm = *(const GAS f32x4*)(mu + c);
    return pc + ((pp + pn) * 0.5f - pc) * mm;
}
__device__ __forceinline__ void unpack8(const v4u w, float (&x)[8]) { x[0] = bflo(w.x); x[1] = bfhi(w.x); x[2] = bflo(w.y); x[3] = bfhi(w.y); x[4] = bflo(w.z); x[5] = bfhi(w.z); x[6] = bflo(w.w); x[7] = bfhi(w.w); }
__device__ __forceinline__ v4u pack8f(const float (&x)[8]) { v4u o; o.x = pk2(x[0], x[1]); o.y = pk2(x[2], x[3]); o.z = pk2(x[4], x[5]); o.w = pk2(x[6], x[7]); return o; }
__device__ __forceinline__ void mix8(const bf16* rowc, bool hp, bool hn, const float (&mu)[8], float (&o)[8]) {
    const v4u zc = {0u, 0u, 0u, 0u};
    const v4u wc = *(const GAS v4u*)rowc, wp = hp ? *(const GAS v4u*)(rowc - INA_P) : zc, wn = hn ? *(const GAS v4u*)(rowc + INA_P) : zc;
    float c[8], p[8], n[8]; unpack8(wc, c); unpack8(wp, p); unpack8(wn, n);
#pragma unroll
    for (int e = 0; e < 8; ++e) o[e] = c[e] + (0.5f * (p[e] + n[e]) - c[e]) * mu[e];
}
struct Raw3 { v4u c, p, n; };
__device__ __forceinline__ Raw3 load3(const bf16* rowc, bool hp, bool hn) { const v4u zc = {0u, 0u, 0u, 0u}; Raw3 r; r.c = *(const GAS v4u*)rowc; r.p = hp ? *(const GAS v4u*)(rowc - INA_P) : zc; r.n = hn ? *(const GAS v4u*)(rowc + INA_P) : zc; return r; }
__device__ __forceinline__ void mix8r(const Raw3& w, const float (&mu)[8], float (&o)[8]) {
    float c[8], p[8], n[8]; unpack8(w.c, c); unpack8(w.p, p); unpack8(w.n, n);
#pragma unroll
    for (int e = 0; e < 8; ++e) o[e] = c[e] + (0.5f * (p[e] + n[e]) - c[e]) * mu[e];
}
__device__ __forceinline__ void features_phase(Frame& F, const FeatP& P) {
    constexpr int LAP = 328;
    LAS bf16* LA = (LAS bf16*)F.lds;
    LAS float* SSQ = (LAS float*)(F.lds + 10752);
    LAS float* PRM = (LAS float*)(F.lds + 12288);
    const int lane = F.lane, w = F.wave, tk = lane & 15, q4 = lane >> 4;
    constexpr int NTILE = MALL / 16, NTG = 64;
    for (int su = F.vcu; su < 4 * NTG; su += F.G) {
        const int cg = su & 3, tg = su >> 2, cw = 256 * cg + 32 * w, ch8 = cw + 8 * q4, hd = 4 * cg + (w >> 1);
        __syncthreads();
        for (int i = F.tid; i < 2560; i += 512) { const int prm = i >> 8, c = (i & 255) + 256 * cg; float v;
            switch (prm) { case 0: v = P.k_k[c]; break; case 1: v = P.k_a[c]; break; case 2: v = P.r_k[c]; break; case 3: v = P.w0[c]; break; case 4: v = P.w0[RW + c]; break;
                           case 5: v = P.a0[c]; break; case 6: v = P.a0[RW + c]; break; case 7: v = P.mu[c]; break; case 8: v = P.mu[RW + c]; break; default: v = P.mu[2 * RW + c]; break; }
            PRM[i] = v; }
        bf16x8 fw[2][2][2], fa[2][2][2], fg[2][2];
        { const int chA = cw + 8 * (tk >> 2) + (tk & 3);
#pragma unroll
          for (int d = 0; d < 2; ++d)
#pragma unroll
              for (int t = 0; t < 2; ++t) {
#pragma unroll
                  for (int ks = 0; ks < 2; ++ks) { fw[d][t][ks] = *(const GAS bf16x8*)(P.WUP + ((size_t)d * RW + chA + 4 * t) * 64 + ks * 32 + q4 * 8); fa[d][t][ks] = *(const GAS bf16x8*)(P.AUP + ((size_t)d * RW + chA + 4 * t) * 64 + ks * 32 + q4 * 8); }
                  fg[d][t] = *(const GAS bf16x8*)(P.GUP + ((size_t)d * RW + chA + 4 * t) * 32 + q4 * 8); } }
        for (int tt = tg; tt < NTILE; tt += NTG) {
            const int m0 = tt * 16;
            const int m = m0 + tk, b = m / TPB, tp = m - b * TPB;
            const bool hp = (tp != 0) && (tp != CTXL), hn = (tp != CTXL - 1) && (tp != TPB - 1);
            const bf16* rowp = P.PA + (size_t)m * INA_P + ch8;
            const Raw3 rawk = load3(rowp + RW, hp, hn), rawr = load3(rowp, hp, hn), rawv = load3(rowp + 2 * RW, hp, hn);
            __syncthreads();
            for (int it = F.tid; it < 640; it += 512) { const int tkk = it / 40, c8 = (it - tkk * 40) * 8, c = C_WD + c8, m = m0 + tkk, tp = m % TPB;
                const bool hp = (tp != 0) && (tp != CTXL), hn = (tp != CTXL - 1) && (tp != TPB - 1);
                float mu[8], v[8];
                { const f32x4 a = *(const GAS f32x4*)(P.mu + c), b2 = *(const GAS f32x4*)(P.mu + c + 4); mu[0] = a.x; mu[1] = a.y; mu[2] = a.z; mu[3] = a.w; mu[4] = b2.x; mu[5] = b2.y; mu[6] = b2.z; mu[7] = b2.w; }
                mix8(P.PA + (size_t)m * INA_P + c, hp, hn, mu, v);
#pragma unroll
                for (int e = 0; e < 8; ++e) { if (c < C_AD) v[e] = 1.0f - 2.0f * __builtin_amdgcn_rcpf(1.0f + __expf(2.0f * v[e])); else if (c >= C_GD) v[e] = sigmoidf_(v[e]); }
                *(LAS v4u*)(LA + tkk * LAP + c8) = pack8f(v); }
            if ((tt & 3) == cg) {
#pragma unroll
                for (int t2 = 0; t2 < 2; ++t2) { const int m = m0 + 2 * w + t2, b = m / TPB, tp = m - b * TPB; const bf16* row = P.PA + (size_t)m * INA_P;
                    { float x[8]; unpack8(*(const GAS v4u*)(row + C_QC + lane * 8), x); float s = 0.f;
#pragma unroll
                      for (int e = 0; e < 8; ++e) s += x[e] * x[e];
                      const float rs = rsqrtf(wave_sum(s) * (1.f / 512.f) + NORM_EPS);
#pragma unroll
                      for (int e = 0; e < 8; ++e) x[e] = x[e] * rs * P.qnorm[lane * 8 + e];
                      *(GAS v4u*)(P.QN + (size_t)m * 512 + lane * 8) = pack8f(x); }
                    { const v2u q = *(const GAS v2u*)(row + C_KVC + lane * 4);
                      float x[4] = {bflo(q.x), bfhi(q.x), bflo(q.y), bfhi(q.y)}; float s = 0.f;
#pragma unroll
                      for (int e = 0; e < 4; ++e) s += x[e] * x[e];
                      const float rs = rsqrtf(wave_sum(s) * (1.f / 256.f) + NORM_EPS);
#pragma unroll
                      for (int e = 0; e < 4; ++e) x[e] = x[e] * rs * P.kvnorm[lane * 4 + e];
                      v2u o; o.x = pk2(x[0], x[1]); o.y = pk2(x[2], x[3]);
                      *(GAS v2u*)(P.KVN + (size_t)m * 256 + lane * 4) = o; }
                    if (lane < 16) { const float x1 = bf1(row[C_KR + lane]), x2 = bf1(row[C_KR + 16 + lane]); const f32x2 cs = P.rope[(size_t)tp * 16 + lane];
                        const unsigned o = pk2(x1 * cs.x - x2 * cs.y, x1 * cs.y + x2 * cs.x);
#pragma unroll
                        for (int h2 = 0; h2 < NH; ++h2) *(GAS unsigned*)(P.K + ((size_t)(b * NH + h2) * TPB + tp) * QKD + 64 + 2 * lane) = o; } } }
            const int pc = 32 * w + 8 * q4;
            float prm[8], kmx[8], kx[8];
#pragma unroll
            for (int e = 0; e < 8; ++e) prm[e] = PRM[8 * 256 + pc + e];
            mix8r(rawk, prm, kmx);
            { float s = 0.f;
#pragma unroll
              for (int e = 0; e < 8; ++e) { kx[e] = kmx[e] * PRM[0 * 256 + pc + e]; s += kx[e] * kx[e]; }
              s += bpermf(lane ^ 16, s); s += bpermf(lane ^ 32, s);
              if (q4 == 0) SSQ[tk * 8 + w] = s; }
            __syncthreads();
            const float rsn = rsqrtf(SSQ[tk * 8 + w] + SSQ[tk * 8 + (w ^ 1)] + 1e-12f);
            f32x4 cw_[2][2], ca_[2][2], cg_[2][2];
#pragma unroll
            for (int d = 0; d < 2; ++d) {
                const bf16x8 bg = *(const LAS bf16x8*)(LA + tk * LAP + 256 + d * 32 + q4 * 8);
                bf16x8 bw[2], ba[2];
#pragma unroll
                for (int ks = 0; ks < 2; ++ks) { bw[ks] = *(const LAS bf16x8*)(LA + tk * LAP + d * 64 + ks * 32 + q4 * 8); ba[ks] = *(const LAS bf16x8*)(LA + tk * LAP + 128 + d * 64 + ks * 32 + q4 * 8); }
#pragma unroll
                for (int t = 0; t < 2; ++t) { f32x4 z = {0, 0, 0, 0};
                    cw_[d][t] = MFMA16(fw[d][t][1], bw[1], MFMA16(fw[d][t][0], bw[0], z));
                    ca_[d][t] = MFMA16(fa[d][t][1], ba[1], MFMA16(fa[d][t][0], ba[0], z));
                    cg_[d][t] = MFMA16(fg[d][t], bg, z); } }
            float r8[8], v8[8], kk8[8];
#pragma unroll
            for (int e = 0; e < 8; ++e) prm[e] = PRM[7 * 256 + pc + e];
            mix8r(rawr, prm, r8);
#pragma unroll
            for (int e = 0; e < 8; ++e) prm[e] = PRM[9 * 256 + pc + e];
            mix8r(rawv, prm, v8);
#pragma unroll
            for (int e = 0; e < 8; ++e) kk8[e] = kx[e] * rsn;
            bf16* rec = P.RI + ((size_t)(b * NH + hd) * TPB + tp) * RREC + (ch8 & 63);
            *(GAS v4u*)(rec) = pack8f(r8); *(GAS v4u*)(rec + 64) = pack8f(kk8); *(GAS v4u*)(rec + 128) = pack8f(v8);
#pragma unroll
            for (int d = 0; d < 2; ++d) {
                float ld[8], ke[8], bb[8], gg[8]; float bs = 0.f;
#pragma unroll
                for (int e = 0; e < 8; ++e) { const int t = e >> 2, r = e & 3;
                    ld[e] = -0.60653066f * sigmoidf_(PRM[(3 + d) * 256 + pc + e] + cw_[d][t][r]);
                    const float aa = sigmoidf_(PRM[(5 + d) * 256 + pc + e] + ca_[d][t][r]);
                    ke[e] = kmx[e] * (1.0f + (aa - 1.0f) * PRM[1 * 256 + pc + e]); bb[e] = kk8[e] * aa; gg[e] = cg_[d][t][r];
                    bs += r8[e] * ke[e] * PRM[2 * 256 + pc + e]; }
                *(GAS v4u*)(rec + (3 + 3 * d) * 64) = pack8f(ld); *(GAS v4u*)(rec + (4 + 3 * d) * 64) = pack8f(bb); *(GAS v4u*)(rec + (5 + 3 * d) * 64) = pack8f(ke);
                *(GAS v4u*)(P.GG + ((size_t)d * MALL + m) * RW + ch8) = pack8f(gg);
                bs += bpermf(lane ^ 16, bs); bs += bpermf(lane ^ 32, bs);
                if (q4 == 0) P.BON[((size_t)d * MALL + m) * 32 + 2 * hd + (w & 1)] = bs; }
        }
    }
}

__device__ __forceinline__ void cvt_row_load(f32x4 (&x)[8], const float* src) {
#pragma unroll
    for (int q = 0; q < 8; ++q) x[q] = *(const GAS f32x4*)(src + q * 4);
}
__device__ __forceinline__ void cvt_row_store(const f32x4 (&x)[8], unsigned char* dst, float* scale_slot, int lane) {
    float am = 0.f;
#pragma unroll
    for (int q = 0; q < 8; ++q) am = fmaxf(am, fmaxf(fmaxf(fabsf(x[q].x), fabsf(x[q].y)), fmaxf(fabsf(x[q].z), fabsf(x[q].w))));
    am = fmaxf(wave_max_u(am), 1e-30f);
    const float g = 6.0f / am, inv = am * (1.0f / 6.0f);
    v4u o;
#pragma unroll
    for (int q = 0; q < 4; ++q) { unsigned w = 0u;
        w = __builtin_amdgcn_cvt_scalef32_pk_fp4_f32(w, x[2 * q].x * g, x[2 * q].y * g, 1.0f, 0);
        w = __builtin_amdgcn_cvt_scalef32_pk_fp4_f32(w, x[2 * q].z * g, x[2 * q].w * g, 1.0f, 1);
        w = __builtin_amdgcn_cvt_scalef32_pk_fp4_f32(w, x[2 * q + 1].x * g, x[2 * q + 1].y * g, 1.0f, 2);
        w = __builtin_amdgcn_cvt_scalef32_pk_fp4_f32(w, x[2 * q + 1].z * g, x[2 * q + 1].w * g, 1.0f, 3);
        o[q] = w; }
    *(GAS v4u*)dst = o;
    if (lane == 0) *scale_slot = inv;
}
struct ScanCvt { const float* pu; const float* pv; unsigned char* PU8; unsigned char* PV8; float* SU; float* SV; int wl; };
constexpr int SCH = 32;
constexpr int SSTEP = 6 * 64;
__device__ __forceinline__ int scan_tp(int dir, int s) { return dir == 0 ? s : (s < CTXL ? (CTXL - 1 - s) : (TPB - 1 - (s - CTXL))); }
__device__ __forceinline__ void scan_load(v4u (&rg)[6], const bf16* RIh, int dir, int chunk, int htid) {
    const int tp = scan_tp(dir, chunk * SCH + (htid >> 3));
    const bf16* rec = RIh + (size_t)tp * RREC + (htid & 7) * 8;
#pragma unroll
    for (int i = 0; i < 3; ++i) rg[i] = *(const GAS v4u*)(rec + i * 64);
    rec += (3 + 3 * dir) * 64;
#pragma unroll
    for (int i = 0; i < 3; ++i) rg[3 + i] = *(const GAS v4u*)(rec + i * 64);
}
__device__ __forceinline__ void scan_store(const v4u (&rg)[6], LAS float* buf, int htid) {
    LAS float* d0 = buf + (htid >> 3) * SSTEP + (htid & 7) * 8;
#pragma unroll
    for (int i = 0; i < 6; ++i) { constexpr int SLOT[6] = {4, 0, 5, 2, 1, 3};
        const v4u wv = rg[i];
        f32x4 lo = {bflo(wv.x), bfhi(wv.x), bflo(wv.y), bfhi(wv.y)}, hi = {bflo(wv.z), bfhi(wv.z), bflo(wv.w), bfhi(wv.w)};
        if (i == 3) {
#pragma unroll
            for (int e = 0; e < 4; ++e) { lo[e] = __expf(lo[e]); hi[e] = __expf(hi[e]); } }
        LAS float* d = d0 + SLOT[i] * 64;
        *(LAS f32x4*)d = lo; *(LAS f32x4*)(d + 4) = hi; }
}
__device__ __forceinline__ void scan_phase(Frame& F, const bf16* RI, bf16* Y, const ScanCvt& C) {
    LAS float* bufs = (LAS float*)F.lds;
    constexpr int NCH = TPB / SCH;
    for (int uu = F.vcu; uu < NBATCH * NH * 2 * 4; uu += F.G) {
        const int rg = uu & 3, dir = (uu >> 2) & 1, hd = (uu >> 3) & 15, b = uu >> 7;
        const bf16* RIh = RI + (size_t)(b * NH + hd) * TPB * RREC;
        const int htid = F.tid - 256;
        v4u ra[6], rb[6];
        f32x4 xw[8];
        LAS float* wscr = (LAS float*)(F.lds + (((F.wave & 3) == 3) ? LDSCTL_OFF + 4096 : 98304 + (F.wave & 3) * 8448));
        f32x4 xc[8];
        __syncthreads();
        if (F.wave >= 4) { scan_load(rb, RIh, dir, 0, htid); scan_load(ra, RIh, dir, 1, htid); scan_store(rb, bufs, htid); scan_load(rb, RIh, dir, 2, htid); }
        __syncthreads();
        const int j = F.lane & 15, rowl = F.lane >> 4, row = rg * 16 + (F.wave & 3) * 4 + rowl;
        f32x2 S01 = {0.f, 0.f}, S23 = {0.f, 0.f};
        bf16* yb = Y + ((size_t)dir * MALL + (size_t)b * TPB) * RW + hd * 64 + row;
        for (int c = 0; c < NCH; ++c) {
            LAS float* cur = bufs + (c & 1) * (SCH * SSTEP);
            if (F.wave >= 4) {
                if (c + 1 < NCH) {
                    if ((c & 1) == 0) { scan_store(ra, bufs + (SCH * SSTEP), htid); if (c + 3 < NCH) scan_load(ra, RIh, dir, c + 3, htid); }
                    else { scan_store(rb, bufs, htid); if (c + 3 < NCH) scan_load(rb, RIh, dir, c + 3, htid); }  }
                if (C.wl >= 0 && (c & 3) == 2) { const int wi = uu * 4 + (F.wave - 4) + 1024 * (c >> 3);
                    if (wi < NW_ITEMS) { const TItem Tw = p0_resolve_wave(F.ws, C.wl, wi); if ((c & 7) == 2) p0_item_load(Tw, F.lane, xw); else p0_item_finish(Tw, xw, wscr, F.lane); } }
                if ((c & 3) == 0 && (c >> 3) < 32) { const int r = uu * 4 + (F.wave - 4) + 1024 * (c >> 3);
                    if ((c & 7) == 0) cvt_row_load(xc, ((r >= NEXP) ? C.pv + (size_t)(r - NEXP) * DM : C.pu + (size_t)r * DM) + F.lane * 32);
                    else cvt_row_store(xc, ((r >= NEXP) ? C.PV8 + (size_t)(r - NEXP) * (DM / 2) : C.PU8 + (size_t)r * (DM / 2)) + F.lane * 16, (r >= NEXP) ? C.SV + (r - NEXP) : C.SU + r, F.lane); } }
            else {
#pragma unroll
                for (int h16 = 0; h16 < 2; ++h16) {
                    const LAS float* sp = cur + (h16 * 16) * SSTEP;
                    f32x4 kk = *(const LAS f32x4*)(sp + 4 * j), bb = *(const LAS f32x4*)(sp + 64 + 4 * j), ww = *(const LAS f32x4*)(sp + 128 + 4 * j),
                          ke = *(const LAS f32x4*)(sp + 192 + 4 * j), rr = *(const LAS f32x4*)(sp + 256 + 4 * j);
                    float ykeep = 0.f, ypart; f32x2 u2, t2, vv; vv.x = sp[320 + row];
#define SCAN_DPP(r, ctl) "v_add_f32_dpp " r ", " r ", " r " " ctl " row_mask:0xf bank_mask:0xf bound_ctrl:1\n\t"
#define SCAN_MAIN(SEL) asm volatile( \
                        "v_pk_mul_f32 v[242:243], %[kexy], %[vv] op_sel_hi:[1,0]\n\t" \
                        "v_add_f32 v246, v250, v251\n\t" \
                        "v_add_f32_dpp v248, %[yp], %[yp] quad_perm:[1,0,3,2] row_mask:0xf bank_mask:0xf bound_ctrl:1\n\t" \
                        "v_pk_mul_f32 v[244:245], %[kezw], %[vv] op_sel_hi:[1,0]\n\t" \
                        SCAN_DPP("v246", "quad_perm:[1,0,3,2]") SCAN_DPP("v248", "quad_perm:[2,3,0,1]") \
                        "v_pk_fma_f32 %[s01], %[s01], %[wwxy], v[242:243]\n\t" \
                        SCAN_DPP("v246", "quad_perm:[2,3,0,1]") SCAN_DPP("v248", "row_half_mirror") \
                        "v_pk_fma_f32 %[s23], %[s23], %[wwzw], v[244:245]\n\t" \
                        SCAN_DPP("v246", "row_half_mirror") SCAN_DPP("v248", "row_mirror") \
                        SEL "\n\t" \
                        SCAN_DPP("v246", "row_mirror") \
                        "v_pk_fma_f32 %[s01], %[bbxy], v[246:247], %[s01] op_sel_hi:[1,0,1] neg_lo:[0,1,0] neg_hi:[0,1,0]\n\t" \
                        "v_pk_fma_f32 %[s23], %[bbzw], v[246:247], %[s23] op_sel_hi:[1,0,1] neg_lo:[0,1,0] neg_hi:[0,1,0]\n\t" \
                        "v_pk_mul_f32 v[252:253], %[s01], %[rrxy]" \
                        : [s01] "+v"(S01), [s23] "+v"(S23), [yk] "+v"(ykeep), "={v[252:253]}"(u2) \
                        : [kexy] "v"(ke.xy), [kezw] "v"(ke.zw), [vv] "v"(vv), [wwxy] "v"(ww.xy), [wwzw] "v"(ww.zw), [bbxy] "v"(bb.xy), [bbzw] "v"(bb.zw), [rrxy] "v"(rr.xy), [yp] "v"(ypart), [msk] "s"(msk), "{v[250:251]}"(t2) \
                        : "v242", "v243", "v244", "v245", "v246", "v247", "v248")
                    asm volatile("v_pk_mul_f32 v[250:251], %[s01], %[kxy]\n\tv_mov_b32 %[yp], 0\n\tv_pk_fma_f32 v[250:251], %[s23], %[kzw], v[250:251]"
                                 : "=&{v[250:251]}"(t2), [yp] "=&v"(ypart) : [s01] "v"(S01), [s23] "v"(S23), [kxy] "v"(kk.xy), [kzw] "v"(kk.zw));
#pragma unroll
                    for (int st = 0; st < 16; ++st) {
                        f32x4 nkk = kk, nbb = bb, nww = ww, nke = ke, nrr = rr; f32x2 nvv = vv;
                        const LAS float* sn = sp + (st + 1) * SSTEP;
                        if (st + 1 < 16) { nkk = *(const LAS f32x4*)(sn + 4 * j); nke = *(const LAS f32x4*)(sn + 192 + 4 * j); nvv.x = sn[320 + row]; nww = *(const LAS f32x4*)(sn + 128 + 4 * j); nbb = *(const LAS f32x4*)(sn + 64 + 4 * j);
                            nrr = *(const LAS f32x4*)(sn + 256 + 4 * j); }
                        const unsigned long long msk = 0x0001000100010001ull << ((st + 15) & 15);
                        if (st > 0) SCAN_MAIN("v_cndmask_b32_e64 %[yk], %[yk], v248, %[msk]"); else SCAN_MAIN("s_nop 0");
                        if (st + 1 < 16)
                            asm volatile("v_pk_mul_f32 v[250:251], %[s01], %[kxy]\n\tv_pk_fma_f32 v[252:253], %[s23], %[rrzw], v[252:253]\n\tv_pk_fma_f32 v[250:251], %[s23], %[kzw], v[250:251]\n\tv_add_f32 %[yp], v252, v253"
                                         : "=&{v[250:251]}"(t2), "={v[252:253]}"(u2), [yp] "=&v"(ypart) : [s01] "v"(S01), [s23] "v"(S23), [kxy] "v"(nkk.xy), [kzw] "v"(nkk.zw), [rrzw] "v"(rr.zw), "1"(u2));
                        else
                            asm volatile("s_nop 0\n\tv_pk_fma_f32 v[252:253], %[s23], %[rrzw], v[252:253]" : "={v[252:253]}"(u2) : [s23] "v"(S23), [rrzw] "v"(rr.zw), "0"(u2));
                        kk = nkk; bb = nbb; ww = nww; ke = nke; rr = nrr; vv = nvv;
                        __builtin_amdgcn_sched_barrier(0);
                    }
#undef SCAN_MAIN
#undef SCAN_DPP
                    { const float y = red16(u2.x + u2.y); ykeep = (j == 15) ? y : ykeep; }
                    const int tp = scan_tp(dir, c * SCH + h16 * 16 + j);
                    *(GAS bf16*)(yb + (size_t)tp * RW) = (bf16)f2bf(ykeep);
                }
            }
            __syncthreads();
        }
    }
}

constexpr int AKP = 208, AVP = 192;
constexpr int ATILE = 64 * AKP + 64 * AVP;
__device__ __forceinline__ bf16x8 pack8(const f32x16& x, int s) {
    v4u p; p.x = pk2(x[8 * s + 0], x[8 * s + 1]); p.y = pk2(x[8 * s + 2], x[8 * s + 3]); p.z = pk2(x[8 * s + 4], x[8 * s + 5]); p.w = pk2(x[8 * s + 6], x[8 * s + 7]);
    return __builtin_bit_cast(bf16x8, p);
}
__device__ __forceinline__ void attn_phase(Frame& F, const bf16* Q, const bf16* K, const bf16* V, bf16* YB, int with_ctx) {
    const int lane = F.lane, half = lane >> 5, l31 = lane & 31, l16 = lane & 15, g1 = (lane >> 4) & 1;
    const int nunits = NBATCH * NH * 32 + (with_ctx ? NBATCH * NH : 0);
    for (int uu = F.vcu; uu < nunits; uu += F.G) {
        int bh, q0, nkt;
        if (uu < NBATCH * NH * 32) { bh = uu >> 5; q0 = CTXL + (uu & 31) * 256; nkt = TPB / 64; } else { bh = uu - NBATCH * NH * 32; q0 = 0; nkt = CTXL / 64; }
        const bf16* Kh = K + (size_t)bh * TPB * QKD; const bf16* Vh = V + (size_t)bh * TPB * 64; const bf16* Qh = Q + (size_t)bh * TPB * QKD;
        const int tq = q0 + F.wave * 32 + l31;
        bf16x8 qf[6];
#pragma unroll
        for (int ks = 0; ks < 6; ++ks) qf[ks] = *(const GAS bf16x8*)(Qh + (size_t)tq * QKD + 16 * ks + 8 * half);
        f32x16 o0, o1;
#pragma unroll
        for (int i = 0; i < 16; ++i) { o0[i] = 0.f; o1[i] = 0.f; }
        float l_run = 0.f;
        f32x16 cinit;
#pragma unroll
        for (int i = 0; i < 16; ++i) cinit[i] = 0.f;
        asm volatile("" : "+v"(cinit));
        const int kc1 = F.tid + 512; const bool k1ok = kc1 < 768;
        const unsigned kd0 = (unsigned)((F.tid / 12) * AKP + (F.tid % 12) * 16), kd1 = (unsigned)((kc1 / 12) * AKP + (kc1 % 12) * 16), vd = (unsigned)(64 * AKP + (F.tid >> 3) * AVP + (F.tid & 7) * 16);
        v4u kr0, kr1 = {0, 0, 0, 0}, vr;
        kr0 = *(const GAS v4u*)(Kh + (size_t)F.tid * 8); if (k1ok) kr1 = *(const GAS v4u*)(Kh + (size_t)kc1 * 8); vr = *(const GAS v4u*)(Vh + (size_t)F.tid * 8);
        __syncthreads();
        *(LAS v4u*)(F.lds + kd0) = kr0; if (k1ok) *(LAS v4u*)(F.lds + kd1) = kr1; *(LAS v4u*)(F.lds + vd) = vr;
        if (nkt > 1) { const bf16* kn = Kh + (size_t)64 * QKD; const bf16* vn = Vh + (size_t)64 * 64;
            kr0 = *(const GAS v4u*)(kn + (size_t)F.tid * 8); if (k1ok) kr1 = *(const GAS v4u*)(kn + (size_t)kc1 * 8); vr = *(const GAS v4u*)(vn + (size_t)F.tid * 8);
            *(LAS v4u*)(F.lds + ATILE + kd0) = kr0; if (k1ok) *(LAS v4u*)(F.lds + ATILE + kd1) = kr1; *(LAS v4u*)(F.lds + ATILE + vd) = vr; }
        __syncthreads();
        bf16x8 ka[6];
#pragma unroll
        for (int ks = 0; ks < 6; ++ks) ka[ks] = *(const LAS bf16x8*)(F.lds + l31 * AKP + (16 * ks + 8 * half) * 2);
        int bc = 0, bn = ATILE, bw = 2 * ATILE;
        for (int kt = 0; kt < nkt; ++kt) {
            const bool more = kt + 1 < nkt, more2 = kt + 2 < nkt;
            if (more2) { const bf16* kn = Kh + (size_t)(kt + 2) * 64 * QKD; const bf16* vn = Vh + (size_t)(kt + 2) * 64 * 64;
                kr0 = *(const GAS v4u*)(kn + (size_t)F.tid * 8); if (k1ok) kr1 = *(const GAS v4u*)(kn + (size_t)kc1 * 8); vr = *(const GAS v4u*)(vn + (size_t)F.tid * 8); }
            LAS unsigned char* Kb = F.lds + bc; LAS unsigned char* Vb = Kb + 64 * AKP;
            f32x16 s0, s1;
            { bf16x8 kb2[6];
#pragma unroll
              for (int ks = 0; ks < 6; ++ks) kb2[ks] = *(const LAS bf16x8*)(Kb + (32 + l31) * AKP + (16 * ks + 8 * half) * 2);
              s0 = MFMA32(ka[0], qf[0], cinit);
#pragma unroll
              for (int ks = 1; ks < 6; ++ks) s0 = MFMA32(ka[ks], qf[ks], s0);
              s1 = MFMA32(kb2[0], qf[0], cinit);
#pragma unroll
              for (int ks = 1; ks < 6; ++ks) s1 = MFMA32(kb2[ks], qf[ks], s1);
              __builtin_amdgcn_sched_group_barrier(0x100, 6, 0); __builtin_amdgcn_sched_group_barrier(0x8, 12, 0); }
            bf16x8 va[2][2][2];
#pragma unroll
            for (int t = 0; t < 2; ++t)
#pragma unroll
                for (int s = 0; s < 2; ++s) { const int kb = 32 * t + 16 * s + 4 * half + (l16 >> 2);
#pragma unroll
                    for (int dvt = 0; dvt < 2; ++dvt) { const LAS unsigned char* vp = Vb + kb * AVP + (32 * dvt + 16 * g1 + 4 * (l16 & 3)) * 2;
                        const s16x4 lo = __builtin_amdgcn_ds_read_tr16_b64_v4i16((LAS s16x4*)vp), hi = __builtin_amdgcn_ds_read_tr16_b64_v4i16((LAS s16x4*)(vp + 8 * AVP));
                        va[t][s][dvt] = __builtin_shufflevector(lo, hi, 0, 1, 2, 3, 4, 5, 6, 7); } }
            __builtin_amdgcn_sched_group_barrier(0x100, 16, 0);
            if (more) { const LAS unsigned char* Kn = F.lds + bn;
#pragma unroll
                for (int ks = 0; ks < 6; ++ks) ka[ks] = *(const LAS bf16x8*)(Kn + l31 * AKP + (16 * ks + 8 * half) * 2); }
            float mx = s0[0];
#pragma unroll
            for (int i = 1; i < 16; ++i) mx = fmaxf(mx, s0[i]);
#pragma unroll
            for (int i = 0; i < 16; ++i) mx = fmaxf(mx, s1[i]);
            if (kt == 0 || __any(mx > 8.0f)) {
                mx = fmaxf(mx, bpermf(lane ^ 32, mx));
                const float d = (kt == 0) ? mx : fmaxf(mx, 0.f), alpha = (kt == 0) ? 1.0f : __builtin_amdgcn_exp2f(-d);
                l_run *= alpha;
#pragma unroll
                for (int i = 0; i < 16; ++i) { o0[i] *= alpha; o1[i] *= alpha; s0[i] -= d; s1[i] -= d; cinit[i] -= d; }
                asm volatile("" : "+v"(cinit));
            }
#pragma unroll
            for (int i = 0; i < 16; ++i) { s0[i] = __builtin_amdgcn_exp2f(s0[i]); s1[i] = __builtin_amdgcn_exp2f(s1[i]); }
            float ps = 0.f;
#pragma unroll
            for (int i = 0; i < 16; ++i) ps += s0[i] + s1[i];
            l_run += ps;
            { bf16x8 pf[2][2];
#pragma unroll
              for (int t = 0; t < 2; ++t)
#pragma unroll
                  for (int s = 0; s < 2; ++s) pf[t][s] = pack8(t == 0 ? s0 : s1, s);
#pragma unroll
              for (int t = 0; t < 2; ++t)
#pragma unroll
                  for (int s = 0; s < 2; ++s) { o0 = MFMA32(va[t][s][0], pf[t][s], o0); o1 = MFMA32(va[t][s][1], pf[t][s], o1); } }
            if (more2) { LAS unsigned char* nb = F.lds + bw;
                *(LAS v4u*)(nb + kd0) = kr0; if (k1ok) *(LAS v4u*)(nb + kd1) = kr1; *(LAS v4u*)(nb + vd) = vr; }
            __syncthreads();
            { const int t_ = bc; bc = bn; bn = bw; bw = t_; }
        }
        const float linv = (DBG_SKIP & 4) ? 0.f : 1.0f / (l_run + bpermf(lane ^ 32, l_run));
        const int b = bh >> 4, hd = bh & 15;
        bf16* op = YB + ((size_t)b * TPB + tq) * RW + hd * 64 + 4 * half;
#pragma unroll
        for (int g = 0; g < 4; ++g) {
            v2u w; w.x = pk2(o0[4 * g] * linv, o0[4 * g + 1] * linv); w.y = pk2(o0[4 * g + 2] * linv, o0[4 * g + 3] * linv); *(GAS v2u*)(op + 8 * g) = w;
            w.x = pk2(o1[4 * g] * linv, o1[4 * g + 1] * linv); w.y = pk2(o1[4 * g + 2] * linv, o1[4 * g + 3] * linv); *(GAS v2u*)(op + 32 + 8 * g) = w; }
    }
}

struct RoRaw { v4u va, vc, ya[2], yc[2], ga[2], gc[2]; float b0[2], b1[2]; };
__device__ __forceinline__ void readout_load(RoRaw& r, int m, int lane, const bf16* Y, const bf16* GG, const float* BON, const bf16* RI) {
    const int hd = lane >> 2, ch0 = hd * 64 + (lane & 3) * 16, b = m / TPB, tp = m - b * TPB;
    const bf16* rec = RI + ((size_t)(b * NH + hd) * TPB + tp) * RREC + 128 + (lane & 3) * 16;
    r.va = *(const GAS v4u*)rec; r.vc = *(const GAS v4u*)(rec + 8);
#pragma unroll
    for (int d = 0; d < 2; ++d) { const bf16* yp = Y + ((size_t)d * MALL + m) * RW + ch0; const bf16* gp = GG + ((size_t)d * MALL + m) * RW + ch0;
        r.ya[d] = *(const GAS v4u*)yp; r.yc[d] = *(const GAS v4u*)(yp + 8); r.ga[d] = *(const GAS v4u*)gp; r.gc[d] = *(const GAS v4u*)(gp + 8);
        r.b0[d] = BON[((size_t)d * MALL + m) * 32 + 2 * hd]; r.b1[d] = BON[((size_t)d * MALL + m) * 32 + 2 * hd + 1]; }
}
__device__ __forceinline__ void readout_phase(Frame& F, const bf16* Y, const bf16* GG, const float* BON, const bf16* RI, const float* ln_w, const float* ln_b, bf16* YA) {
    const int gw = F.vcu * NWAVES + F.wave, NGW = F.G * NWAVES, lane = F.lane, hd = lane >> 2, ch0 = hd * 64 + (lane & 3) * 16;
    RoRaw cur, nxt;
    if (gw < MALL) readout_load(cur, gw, lane, Y, GG, BON, RI);
    for (int m = gw; m < MALL; m += NGW) {
        if (m + NGW < MALL) readout_load(nxt, m + NGW, lane, Y, GG, BON, RI);
        float vv[16], out[16];
        unpack8(cur.va, *(float(*)[8])&vv[0]); unpack8(cur.vc, *(float(*)[8])&vv[8]);
#pragma unroll
        for (int e = 0; e < 16; ++e) out[e] = 0.f;
#pragma unroll
        for (int d = 0; d < 2; ++d) {
            float y[16], g[16];
            unpack8(cur.ya[d], *(float(*)[8])&y[0]); unpack8(cur.yc[d], *(float(*)[8])&y[8]); unpack8(cur.ga[d], *(float(*)[8])&g[0]); unpack8(cur.gc[d], *(float(*)[8])&g[8]);
            float s = 0.f;
#pragma unroll
            for (int e = 0; e < 16; ++e) s += y[e];
            s = dpp_add<0xB1>(s); s = dpp_add<0x4E>(s);
            const float mean = s * (1.f / 64.f); float q = 0.f;
#pragma unroll
            for (int e = 0; e < 16; ++e) { y[e] -= mean; q += y[e] * y[e]; }
            q = dpp_add<0xB1>(q); q = dpp_add<0x4E>(q);
            const float rstd = rsqrtf(q * (1.f / 64.f) + 64e-5f), bon = cur.b0[d] + cur.b1[d];
#pragma unroll
            for (int e = 0; e < 16; ++e) out[e] += (y[e] * rstd * ln_w[ch0 + e] + ln_b[ch0 + e] + bon * vv[e]) * g[e];
        }
        if (DBG_SKIP & 2) {
#pragma unroll
            for (int e = 0; e < 16; ++e) out[e] = 0.f; }
        v4u o0, o1;
        o0.x = pk2(out[0], out[1]); o0.y = pk2(out[2], out[3]); o0.z = pk2(out[4], out[5]); o0.w = pk2(out[6], out[7]);
        o1.x = pk2(out[8], out[9]); o1.y = pk2(out[10], out[11]); o1.z = pk2(out[12], out[13]); o1.w = pk2(out[14], out[15]);
        *(GAS v4u*)(YA + (size_t)m * RW + ch0) = o0; *(GAS v4u*)(YA + (size_t)m * RW + ch0 + 8) = o1;
        cur = nxt;
    }
}


__device__ __forceinline__ unsigned f2key(float f) { const unsigned u = __builtin_bit_cast(unsigned, f); return (u & 0x80000000u) ? ~u : (u | 0x80000000u); }
__device__ __forceinline__ float key2f(unsigned k) { const unsigned u = (k & 0x80000000u) ? (k & 0x7fffffffu) : ~k; return __builtin_bit_cast(float, u); }
template <int CTRL, int RM> __device__ __forceinline__ unsigned dpp_umax(unsigned x) {
    const unsigned y = (unsigned)__builtin_amdgcn_update_dpp(0, (int)x, CTRL, RM, 0xf, false); return x > y ? x : y; }
__device__ __forceinline__ unsigned row_umax(unsigned x) { x = dpp_umax<0xB1, 0xf>(x); x = dpp_umax<0x4E, 0xf>(x); x = dpp_umax<0x141, 0xf>(x); x = dpp_umax<0x140, 0xf>(x); return x; }
#define SEL_CE(a_, b_) do { const unsigned hi_ = (a_) > (b_) ? (a_) : (b_), lo_ = (a_) > (b_) ? (b_) : (a_); (a_) = hi_; (b_) = lo_; } while (0)
__device__ __forceinline__ void sel_keys8(unsigned (&k)[8], const _Float16* p, int id0) {
    typedef _Float16 h8 __attribute__((ext_vector_type(8)));
    const h8 hv = *(const GAS h8*)p;
    const f32x4 v0 = {(float)hv[0], (float)hv[1], (float)hv[2], (float)hv[3]}, v1 = {(float)hv[4], (float)hv[5], (float)hv[6], (float)hv[7]};
    k[0] = (f2key(v0.x) & ~127u) | (unsigned)(id0 + 0); k[1] = (f2key(v0.y) & ~127u) | (unsigned)(id0 + 1); k[2] = (f2key(v0.z) & ~127u) | (unsigned)(id0 + 2); k[3] = (f2key(v0.w) & ~127u) | (unsigned)(id0 + 3);
    k[4] = (f2key(v1.x) & ~127u) | (unsigned)(id0 + 4); k[5] = (f2key(v1.y) & ~127u) | (unsigned)(id0 + 5); k[6] = (f2key(v1.z) & ~127u) | (unsigned)(id0 + 6); k[7] = (f2key(v1.w) & ~127u) | (unsigned)(id0 + 7);
    SEL_CE(k[0], k[1]); SEL_CE(k[2], k[3]); SEL_CE(k[4], k[5]); SEL_CE(k[6], k[7]); SEL_CE(k[0], k[2]); SEL_CE(k[1], k[3]); SEL_CE(k[4], k[6]); SEL_CE(k[5], k[7]); SEL_CE(k[1], k[2]); SEL_CE(k[5], k[6]);
    SEL_CE(k[0], k[4]); SEL_CE(k[1], k[5]); SEL_CE(k[2], k[6]); SEL_CE(k[3], k[7]); SEL_CE(k[2], k[4]); SEL_CE(k[3], k[5]); SEL_CE(k[1], k[2]); SEL_CE(k[3], k[4]); SEL_CE(k[5], k[6]);
}
__device__ __forceinline__ void top16_rows2(const _Float16* pa, const _Float16* pb, int l16, unsigned& ra, unsigned& rb) {
    unsigned ka[8], kb[8]; sel_keys8(ka, pa + 8 * l16, 8 * l16); sel_keys8(kb, pb + 8 * l16, 8 * l16);
    ra = 0u; rb = 0u;
#pragma unroll
    for (int it = 0; it < 16; ++it) {
        const unsigned ma = row_umax(ka[0]), mb = row_umax(kb[0]); const bool oa = ka[0] == ma, ob = kb[0] == mb;
#pragma unroll
        for (int e = 0; e < 7; ++e) { ka[e] = oa ? ka[e + 1] : ka[e]; kb[e] = ob ? kb[e + 1] : kb[e]; }
        ka[7] = oa ? 0u : ka[7]; kb[7] = ob ? 0u : kb[7];
        ra = (l16 == it) ? ma : ra; rb = (l16 == it) ? mb : rb;
    }
}
struct SelP { const float* SC; int* ESEL; float* EGATE; int last; };
__device__ __forceinline__ void select_token(const _Float16* srow, int lane, int (&eidx)[2], float (&egate)[2]) {
    const int row = lane >> 4, l16 = lane & 15, rbase = lane & 48;
    const int i1 = (int)((0x3332222211111111ull >> (4 * l16)) & 15ull), j1 = (int)((0x2104321076543210ull >> (4 * l16)) & 15ull), i2 = (int)((0xdcba987766554443ull >> (4 * l16)) & 15ull), j2 = (int)((0x0000001010102103ull >> (4 * l16)) & 15ull);
#pragma unroll
    for (int G = 0; G < 2; ++G) {
                const _Float16* hrow = srow + (4 * G + row) * 256;
                unsigned recA, recB; top16_rows2(hrow, hrow + 128, l16, recA, recB);
                const float va = key2f(recA & ~127u), vb = key2f(recB & ~127u);
                const float a0 = bpermf(rbase, va), a1 = bpermf(rbase + i1, va), b1 = bpermf(rbase + j1, vb), a2 = bpermf(rbase + i2, va), b2 = bpermf(rbase + j2, vb), a3 = bpermf(rbase + 14 + (l16 & 1), va), b0 = bpermf(rbase, vb);
                unsigned ck[4];
                ck[0] = (f2key(a0 + vb) & ~255u) | (unsigned)l16; ck[1] = (f2key(a1 + b1) & ~255u) | (unsigned)(16 * i1 + j1); ck[2] = (f2key(a2 + b2) & ~255u) | (unsigned)(16 * i2 + j2);
                ck[3] = (l16 < 2) ? ((f2key(a3 + b0) & ~255u) | (unsigned)(16 * (14 + l16))) : 0u;
                SEL_CE(ck[0], ck[1]); SEL_CE(ck[2], ck[3]); SEL_CE(ck[0], ck[2]); SEL_CE(ck[1], ck[3]); SEL_CE(ck[1], ck[2]);
                unsigned rec = 0u;
#pragma unroll
                for (int it = 0; it < 16; ++it) {
                    const unsigned mh = row_umax(ck[0]); const bool own = ck[0] == mh;
                    ck[0] = own ? ck[1] : ck[0]; ck[1] = own ? ck[2] : ck[1]; ck[2] = own ? ck[3] : ck[2]; ck[3] = own ? 0u : ck[3];
                    rec = (l16 == it) ? mh : rec;
                }
                const float ts = key2f(rec & ~255u), tmax = bpermf(rbase, ts);
                const float ev = __expf(ts - tmax), esum = red16(ev);
                const int ci = (int)((rec >> 4) & 15u), cj = (int)(rec & 15u);
                const int expert = bpermi(rbase + ci, (int)(recA & 127u)) * 128 + bpermi(rbase + cj, (int)(recB & 127u));
                eidx[G] = expert; egate[G] = ev / esum;
    }
}
struct PeerP { const _Float16* SC; const float* nmod; const float* ng; bf16* Hout;   const int* ESEL; const float* EGATE; const bf16* H; const unsigned char* PU; const unsigned char* PV; const float* SU; const float* SV; bf16* X; const float* mod;   const float* fin_g; float* out; int last; int dry; };
__device__ __forceinline__ void peer_phase(Frame& F, const PeerP& P) {
    const int gw = F.vcu * NWAVES + F.wave, NGW = F.G * NWAVES, lane = F.lane;
    float pr_s2 = 0.f, pr_d2 = 0.f, pr_tg = 0.f, pr_n = 0.f;
    int m0 = gw; while (m0 < MALL && P.last && (m0 % TPB) < CTXL) m0 += NGW;
    v4u ph0 = {0u, 0u, 0u, 0u}, ph1 = ph0, ph2 = ph0, ph3 = ph0;
    if (m0 < MALL) { const bf16* hp = P.H + (size_t)m0 * DM + lane * 32; ph0 = *(const GAS v4u*)hp; ph1 = *(const GAS v4u*)(hp + 8); ph2 = *(const GAS v4u*)(hp + 16); ph3 = *(const GAS v4u*)(hp + 24); }
    for (int m = m0, mn = 0; m < MALL; m = mn) {
        mn = m + NGW; while (mn < MALL && P.last && (mn % TPB) < CTXL) mn += NGW;
        const int b = m / TPB, tp = m - b * TPB;
        const int mr = tp < CTXL ? 2 : b;
        const int emask_ = (P.dry & 2) ? 1023 : 0x7fffffff;
        int eidx[2]; float egate[2]; select_token(P.SC + (size_t)m * DM, lane, eidx, egate);
        eidx[0] &= emask_; eidx[1] &= emask_;
        typedef int v8i __attribute__((ext_vector_type(8)));
        LAS unsigned char* hq = F.lds + F.wave * 4096;
        { const v4u hv[4] = {ph0, ph1, ph2, ph3}; v4u o[2];
#pragma unroll
          for (int j = 0; j < 4; ++j) { int w0 = 0, w1 = 0;
              w0 = __builtin_amdgcn_cvt_pk_fp8_f32(bflo(hv[j].x), bfhi(hv[j].x), w0, false); w0 = __builtin_amdgcn_cvt_pk_fp8_f32(bflo(hv[j].y), bfhi(hv[j].y), w0, true);
              w1 = __builtin_amdgcn_cvt_pk_fp8_f32(bflo(hv[j].z), bfhi(hv[j].z), w1, false); w1 = __builtin_amdgcn_cvt_pk_fp8_f32(bflo(hv[j].w), bfhi(hv[j].w), w1, true);
              o[j >> 1][2 * (j & 1)] = (unsigned)w0; o[j >> 1][2 * (j & 1) + 1] = (unsigned)w1; }
          *(LAS v4u*)(hq + lane * 32) = o[0]; *(LAS v4u*)(hq + lane * 32 + 16) = o[1];
          unsigned z_ = 0u; asm volatile("" : "+v"(z_));
          if (lane < 2) *(LAS v4u*)(hq + 2048 + lane * 16) = (v4u){z_, z_, z_, z_}; }
        const int li = lane & 15, kb = lane >> 4;
        int rowoff[8];
#pragma unroll
        for (int g = 0; g < 8; ++g) rowoff[g] = bpermi(16 * (g & 3) + li, eidx[g >> 2]) * (DM / 2) + 16 * kb;
        f32x4 dacc[8];
#pragma unroll
        for (int g = 0; g < 8; ++g) dacc[g] = (f32x4){0.f, 0.f, 0.f, 0.f};
        const unsigned hb = (li == 0) ? (unsigned)(16 * kb) : 2048u;
        const unsigned hb2 = (li == 0) ? 64u : 16u;
        const unsigned hstep = (li == 0) ? 128u : 0u;
        v4u ua[8], ub[8];
#pragma unroll
        for (int g = 0; g < 8; ++g) ua[g] = *(const GAS v4u*)(P.PU + (unsigned)rowoff[g]);
#pragma unroll 1
        for (int s = 0; s < ((P.dry & 4) ? 2 : 16); s += 2) {
#pragma unroll
            for (int g = 0; g < 8; ++g) ub[g] = *(const GAS v4u*)(P.PU + (unsigned)(rowoff[g] + 64 * (s + 1)));
            { const v4u b0 = *(const LAS v4u*)(hq + hb + hstep * s), b1 = *(const LAS v4u*)(hq + hb + hstep * s + hb2);
              const v8i bf = {(int)b0.x, (int)b0.y, (int)b0.z, (int)b0.w, (int)b1.x, (int)b1.y, (int)b1.z, (int)b1.w};
#pragma unroll
              for (int g = 0; g < 8; ++g) { const v8i af = {(int)ua[g].x, (int)ua[g].y, (int)ua[g].z, (int)ua[g].w, 0, 0, 0, 0};
                  dacc[g] = __builtin_amdgcn_mfma_scale_f32_16x16x128_f8f6f4(af, bf, dacc[g], 4, 0, 0, 0x7f7f7f7f, 0, 0x7f7f7f7f); } }
            if (s + 2 < 16) {
#pragma unroll
                for (int g = 0; g < 8; ++g) ua[g] = *(const GAS v4u*)(P.PU + (unsigned)(rowoff[g] + 64 * (s + 2))); }
            { const v4u b0 = *(const LAS v4u*)(hq + hb + hstep * (s + 1)), b1 = *(const LAS v4u*)(hq + hb + hstep * (s + 1) + hb2);
              const v8i bf = {(int)b0.x, (int)b0.y, (int)b0.z, (int)b0.w, (int)b1.x, (int)b1.y, (int)b1.z, (int)b1.w};
#pragma unroll
              for (int g = 0; g < 8; ++g) { const v8i af = {(int)ub[g].x, (int)ub[g].y, (int)ub[g].z, (int)ub[g].w, 0, 0, 0, 0};
                  dacc[g] = __builtin_amdgcn_mfma_scale_f32_16x16x128_f8f6f4(af, bf, dacc[g], 4, 0, 0, 0x7f7f7f7f, 0, 0x7f7f7f7f); } }
        }
        float coef[2];
#pragma unroll
        for (int sl = 0; sl < 2; ++sl) { float mydot = 0.f;
#pragma unroll
            for (int g4 = 0; g4 < 4; ++g4)
#pragma unroll
                for (int r = 0; r < 4; ++r) { const float t = bpermf(16 * ((lane >> 2) & 3), dacc[4 * sl + g4][r]); if ((lane >> 4) == g4 && (lane & 3) == r) mydot = t; }
            mydot *= P.SU[eidx[sl]];
            if (DBG_PROBE == 4) {
                float ref = 0.f;
                for (int e = 0; e < 64; ++e) { const int ex = __builtin_amdgcn_readlane(eidx[sl], e); const v4u uu = *(const GAS v4u*)(P.PU + (size_t)ex * (DM / 2) + lane * 16); float s1 = 0.f;
                    const v4u hv2[4] = {*(const GAS v4u*)(P.H + (size_t)m * DM + lane * 32), *(const GAS v4u*)(P.H + (size_t)m * DM + lane * 32 + 8), *(const GAS v4u*)(P.H + (size_t)m * DM + lane * 32 + 16), *(const GAS v4u*)(P.H + (size_t)m * DM + lane * 32 + 24)};
#pragma unroll
                    for (int d = 0; d < 4; ++d) { const unsigned w = uu[d]; const unsigned hw[4] = {hv2[d].x, hv2[d].y, hv2[d].z, hv2[d].w};
                        f32x2 x = __builtin_amdgcn_cvt_scalef32_pk_f32_fp4(w, 1.0f, 0); s1 += x.x * bflo(hw[0]) + x.y * bfhi(hw[0]); x = __builtin_amdgcn_cvt_scalef32_pk_f32_fp4(w, 1.0f, 1); s1 += x.x * bflo(hw[1]) + x.y * bfhi(hw[1]);
                        x = __builtin_amdgcn_cvt_scalef32_pk_f32_fp4(w, 1.0f, 2); s1 += x.x * bflo(hw[2]) + x.y * bfhi(hw[2]); x = __builtin_amdgcn_cvt_scalef32_pk_f32_fp4(w, 1.0f, 3); s1 += x.x * bflo(hw[3]) + x.y * bfhi(hw[3]); }
                    const float tot = wave_sum_u(s1) * P.SU[ex]; if (lane == e) ref = tot; }
                pr_s2 = fmaxf(pr_s2, wave_max_u(fabsf(mydot - ref) / (fabsf(ref) + 0.25f))); pr_n = 1.f; }
            coef[sl] = egate[sl] * 0.5f * mydot * (1.0f + erff(mydot * 0.70710678f));
            if ((DBG_SKIP & 16) && sl == 0) coef[sl] = 0.f;
            if ((DBG_SKIP & 32) && sl == 1) coef[sl] = 0.f;
        }
        const float coefs[2] = {coef[0] * P.SV[eidx[0]], coef[1] * P.SV[eidx[1]]};
        f32x2 acc2[16];
#pragma unroll
        for (int i = 0; i < 16; ++i) acc2[i] = (f32x2){0.f, 0.f};
#define PEER_LOADV(U, C, e0_) do { const int e1_ = (e0_); const int ev_ = (e1_ & 64) ? eidx[1] : eidx[0]; const int cv_ = __builtin_bit_cast(int, (e1_ & 64) ? coefs[1] : coefs[0]); \
            _Pragma("unroll") for (int q = 0; q < 8; ++q) { const int ex = __builtin_amdgcn_readlane(ev_, (e1_ & 63) + q); U[q] = *(const GAS v4u*)(P.PV + (size_t)ex * (DM / 2) + lane * 16); \
            C[q] = __builtin_bit_cast(float, __builtin_amdgcn_readlane(cv_, (e1_ & 63) + q)); } } while (0)
#define PEER_AXPY(U, C) do { if (P.dry & 32) { _Pragma("unroll") for (int q = 0; q < 8; ++q) _Pragma("unroll") for (int d = 0; d < 4; ++d) acc2[d].x += __builtin_bit_cast(float, U[q][d] & 0x3fffffffu) * C[q]; } else \
            _Pragma("unroll") for (int q = 0; q < 8; ++q) _Pragma("unroll") for (int d = 0; d < 4; ++d) { const unsigned w = U[q][d]; \
            acc2[4 * d + 0] = __builtin_amdgcn_cvt_scalef32_pk_f32_fp4(w, 1.0f, 0) * C[q] + acc2[4 * d + 0]; acc2[4 * d + 1] = __builtin_amdgcn_cvt_scalef32_pk_f32_fp4(w, 1.0f, 1) * C[q] + acc2[4 * d + 1]; \
            acc2[4 * d + 2] = __builtin_amdgcn_cvt_scalef32_pk_f32_fp4(w, 1.0f, 2) * C[q] + acc2[4 * d + 2]; acc2[4 * d + 3] = __builtin_amdgcn_cvt_scalef32_pk_f32_fp4(w, 1.0f, 3) * C[q] + acc2[4 * d + 3]; } } while (0)
        if (mn < MALL) {
            const bf16* hp = P.H + (size_t)mn * DM + lane * 32; ph0 = *(const GAS v4u*)hp; ph1 = *(const GAS v4u*)(hp + 8); ph2 = *(const GAS v4u*)(hp + 16); ph3 = *(const GAS v4u*)(hp + 24); }
        v4u xpre[4];
        { const bf16* xr0 = P.X + (size_t)m * DM + lane * 32;
#pragma unroll
          for (int hq = 0; hq < 4; ++hq) xpre[hq] = *(const GAS v4u*)(xr0 + hq * 8); }
        {
            v4u ua[8], ub[8]; float ca[8], cb[8];
            PEER_LOADV(ua, ca, 0);
#pragma unroll 1
            for (int it = 0; it < ((P.dry & 8) ? 2 : 8); ++it) {
                PEER_LOADV(ub, cb, 16 * it + 8); PEER_AXPY(ua, ca);
                if (it < 7) PEER_LOADV(ua, ca, 16 * it + 16);
                PEER_AXPY(ub, cb);
            }
        }
#undef PEER_LOADV
#undef PEER_AXPY
        float acc[32];
#pragma unroll
        for (int i = 0; i < 16; ++i) { acc[2 * i] = acc2[i].x; acc[2 * i + 1] = acc2[i].y; }
        if (P.dry) { float sm_ = 0.f;
#pragma unroll
            for (int i = 0; i < 32; ++i) sm_ += acc[i];
            if (sm_ == 1.2345e-30f) P.X[lane] = sm_;
            if (!(P.dry & 16)) continue; }
        if (DBG_SKIP & 1) {
#pragma unroll
            for (int i = 0; i < 32; ++i) acc[i] = 0.f; }
        if (((DBG_SKIP & 64) && !P.last) || ((DBG_SKIP & 128) && P.last)) {
#pragma unroll
            for (int i = 0; i < 32; ++i) acc[i] = 0.f; }
        if (DBG_SKIP & 8) {
#pragma unroll
            for (int i = 0; i < 32; ++i) acc[i] = -acc[i]; }
        int m_l = m, lane_l = lane; asm volatile("" : "+v"(m_l), "+v"(lane_l));
        const int b_l = m_l / TPB, tp_l = m_l - b_l * TPB, mr_l = tp_l < CTXL ? 2 : b_l;
        bf16* xr = (P.dry ? (bf16*)(F.ws + 760 * MiB) : P.X) + (size_t)m_l * DM + lane_l * 32; const float* g2 = P.mod + (size_t)mr_l * 12288 + 5 * DM + lane_l * 32;
        float ss = 0.f;
#pragma unroll
        for (int hq = 0; hq < 4; ++hq) { const int c = hq * 8; float xf[8]; unpack8(xpre[hq], xf);
            const f32x4 g0 = *(const GAS f32x4*)(g2 + c), g1 = *(const GAS f32x4*)(g2 + c + 4);
#pragma unroll
            for (int e = 0; e < 8; ++e) { const float xv = xf[e] + (e < 4 ? g0[e & 3] : g1[e & 3]) * acc[8 * hq + e]; ss += xv * xv; acc[8 * hq + e] = xv; xf[e] = xv; }
            if (!P.last) *(GAS v4u*)(xr + c) = pack8f(xf); }
        if (!P.last) {
            const float rs = rsqrtf(wave_sum(ss) * (1.f / DM) + NORM_EPS); const float* sh = P.nmod + (size_t)mr_l * 12288 + lane_l * 32; const float* sc = sh + DM; const float* ngp = P.ng + lane_l * 32;
            bf16* ho = (P.dry ? (bf16*)(F.ws + 892 * MiB) : P.Hout) + (size_t)m_l * DM + lane_l * 32;
#pragma unroll
            for (int hq = 0; hq < 4; ++hq) { const int c = hq * 8; float y[8];
                const f32x4 n0 = *(const GAS f32x4*)(ngp + c), n1 = *(const GAS f32x4*)(ngp + c + 4), s0 = *(const GAS f32x4*)(sc + c), s1 = *(const GAS f32x4*)(sc + c + 4), h0 = *(const GAS f32x4*)(sh + c), h1 = *(const GAS f32x4*)(sh + c + 4);
#pragma unroll
                for (int e = 0; e < 4; ++e) { y[e] = acc[8 * hq + e] * rs * n0[e] * (1.0f + s0[e]) + h0[e]; y[4 + e] = acc[8 * hq + 4 + e] * rs * n1[e] * (1.0f + s1[e]) + h1[e]; }
                *(GAS v4u*)(ho + c) = pack8f(y); } }
        if (P.last) { const float rs = rsqrtf(wave_sum(ss) * (1.f / DM) + NORM_EPS); float* orow = P.out + ((size_t)b_l * SEQ + (tp_l - CTXL)) * DM + lane_l * 32; const float* fgp = P.fin_g + lane_l * 32;
#pragma unroll
            for (int hq = 0; hq < 8; ++hq) { const int c = hq * 4; const f32x4 fg = *(const GAS f32x4*)(fgp + c);
                f32x4 o;
#pragma unroll
                for (int e = 0; e < 4; ++e) o[e] = acc[4 * hq + e] * rs * fg[e];
                *(GAS f32x4*)(orow + c) = o; } }
    }
    if (DBG_PROBE && DBG_PROBE != 5 && !P.last && lane == 0) { float* pp = (float*)(F.ws + WS_CTL + CTL_PROBE_OFF) + gw * 4; pp[0] = pr_s2; pp[1] = pr_d2; pp[2] = pr_tg; pp[3] = pr_n; }
}


constexpr int PH_PER_LAYER = 12, NPHASE = 1 + NLAYER * PH_PER_LAYER;
#ifndef ONLY_PHASE
#define ONLY_PHASE -1
#endif
#define T0() (wave_s == 0 && pg8::opaque_lane() == 0)
#define PH_ON(k) (ONLY_PHASE < 0 || ONLY_PHASE == (k))
#define GEMM_CALL(EPI, SCHED, g, S, E) pg8::gemm_phase<EPI, SCHED, true, true>(F.lds, g, S, E, wave_s)
#define GEMM_CALL_NA(EPI, SCHED, g, S, E) pg8::gemm_phase<EPI, SCHED, false, true>(F.lds, g, S, E, wave_s)

__device__ __forceinline__ const float* karg(int i) {
    asm volatile("" : "+s"(i));
    const __attribute__((address_space(4))) unsigned long long* ka = (const __attribute__((address_space(4))) unsigned long long*)__builtin_amdgcn_kernarg_segment_ptr();
    return (const float*)ka[i];
}
__global__ void __launch_bounds__(NWAVES * 64, 2) mk_fwd(Args args) {
    extern __shared__ __attribute__((aligned(16))) unsigned char lds[];
    Frame F;
    F.lds = (LAS unsigned char*)lds; F.ws = args.ws;
    const int wave_s = __builtin_amdgcn_readfirstlane((int)threadIdx.x >> 6);
    F.tid = threadIdx.x; F.lane = F.tid & 63; F.wave = wave_s;
    F.G = gridDim.x; { const int bx = blockIdx.x; F.vcu = (F.G % 8 == 0) ? (bx % 8) * (F.G / 8) + bx / 8 : bx; }
    unsigned char* ws = args.ws;
    volatile LAS unsigned* MISC = (volatile LAS unsigned*)(F.lds + MISC_OFF);
    for (int u = F.tid; u < (LDS_BYTES - LDSCTL_OFF) / 4; u += NWAVES * 64) ((LAS unsigned*)(F.lds + LDSCTL_OFF))[u] = 0u;
    __syncthreads();
    const int lo = args.ph_lo, hi = args.ph_hi;
    XcdBarrier bar; bar.bar = (unsigned*)(ws + WS_CTL) + CW_BAR; bar.x = 0; bar.st = nullptr;
    if (hi - lo > 1) bar = xcd_barrier_post((unsigned*)(ws + WS_CTL) + CW_BAR, MISC + 8, T0());
#define IN(k) (lo <= (k) && (k) < hi)
#define REFRAME() do { const int lz_ = pg8::opaque_lane(); F.lane = lz_; F.tid = wave_s * 64 + lz_; F.wave = wave_s; ws = (unsigned char*)karg(34); F.ws = ws; { int g_ = (int)gridDim.x, b_ = (int)blockIdx.x; asm volatile("" : "+s"(g_), "+s"(b_)); bx = b_; F.G = g_; F.vcu = ((g_ & 7) == 0) ? (b_ & 7) * (g_ >> 3) + (b_ >> 3) : b_; } } while (0)
#define SEAM(k) do { if (IN((k) + 1)) xcd_barrier(bar, T0()); } while (0)
#define XBUF ((bf16*)(ws + WS_X))
#define HBUF ((bf16*)(ws + WS_H))
#define MODP ((const float*)(ws + WS_CTL + CTL_MOD_OFF) + (size_t)l * 3 * 12288)
    int bx = (int)blockIdx.x;

    for (int rep_ = 0; rep_ < ((DBG_REPEAT == 100) ? 2 : 1); ++rep_) if (PH_ON(100) && IN(0)) { REFRAME(); if (rep_) xcd_barrier(bar, T0()); p0_prologue(F, 0, (MK_N_LAUNCHES == 1) ? 1 : NLAYER, F.vcu, F.G); SEAM(0); if (DBG_REPEAT == 200) { for (int i_ = 0; i_ < 32; ++i_) xcd_barrier(bar, T0()); } }

    for (int l = 0; l < NLAYER; ++l) {
        const int base = 1 + l * PH_PER_LAYER;
        const int last = (l == NLAYER - 1);
        for (int rep_ = 0; rep_ < ((DBG_REPEAT == 0) ? 2 : 1); ++rep_) if (PH_ON(0) && IN(base + 0) && l == 0) { REFRAME(); if (rep_) xcd_barrier(bar, T0()); modnorm_phase(F, nullptr, karg(6) + (size_t)l * DM, MODP, 0, HBUF, 0, karg(0), karg(2)); SEAM(base + 0); }
        for (int rep_ = 0; rep_ < ((DBG_REPEAT == 1) ? 2 : 1); ++rep_) if (PH_ON(1) && IN(base + 1)) { REFRAME(); if (rep_) xcd_barrier(bar, T0());
            pg8::Gemm g{HBUF, (const bf16*)(ws + WS_WINA) + (size_t)l * INA_P * DM, MALL, INA_P, DM}; pg8::RowOrder S; S.init_rows(0, INA_P, F.G, bx);
            pg8::EpiStoreBf16 E{(bf16*)(ws + WS_PA), INA_P};
            GEMM_CALL(pg8::EpiStoreBf16, pg8::RowOrder, g, S, E);
            SEAM(base + 1); }
        for (int rep_ = 0; rep_ < ((DBG_REPEAT == 2) ? 2 : 1); ++rep_) if (PH_ON(2) && IN(base + 2)) { REFRAME(); if (rep_) xcd_barrier(bar, T0());
            FeatP P;
            P.PA = (const bf16*)(ws + WS_PA); P.mu = karg(9) + (size_t)l * RWC; P.w0 = karg(10) + (size_t)l * 2 * RW; P.a0 = karg(12) + (size_t)l * 2 * RW;
            P.k_k = karg(15) + (size_t)l * RW; P.k_a = karg(16) + (size_t)l * RW; P.r_k = karg(17) + (size_t)l * RW;
            P.WUP = (const bf16*)(ws + WS_WUP) + (size_t)l * 2 * RW * 64; P.AUP = (const bf16*)(ws + WS_AUP) + (size_t)l * 2 * RW * 64; P.GUP = (const bf16*)(ws + WS_GUP) + (size_t)l * 2 * RW * 32;
            P.qnorm = karg(20) + (size_t)l * 512; P.kvnorm = karg(22) + (size_t)l * 256; P.rope = (const f32x2*)(ws + WS_ROPE);
            P.RI = (bf16*)(ws + WS_RI); P.GG = (bf16*)(ws + WS_GG); P.BON = (float*)(ws + WS_BON); P.QN = (bf16*)(ws + WS_QN); P.KVN = (bf16*)(ws + WS_KVN); P.K = (bf16*)(ws + WS_K);
            features_phase(F, P);
            SEAM(base + 2); }
        for (int rep_ = 0; rep_ < ((DBG_REPEAT == 3) ? 2 : 1); ++rep_) if (PH_ON(3) && IN(base + 3)) { REFRAME(); if (rep_) xcd_barrier(bar, T0());
            { pg8::Gemm g{(const bf16*)(ws + WS_QN), (const bf16*)(ws + WS_WUQ) + (size_t)l * NQ * 512, MALL, NQ, 512};
              pg8::EpiQ E{(bf16*)(ws + WS_Q), (const f32x2*)(ws + WS_ROPE), 0.14724444f};
              pg8::RowOrder S; S.init_rows(last, NQ, F.G, bx); GEMM_CALL_NA(pg8::EpiQ, pg8::RowOrder, g, S, E); }
            { pg8::Gemm g{(const bf16*)(ws + WS_KVN), (const bf16*)(ws + WS_WUKV) + (size_t)l * NKV * 256, MALL, NKV, 256}; pg8::RowOrder S; S.init_rows(0, NKV, F.G, bx);
              pg8::EpiKV E{(bf16*)(ws + WS_K), (bf16*)(ws + WS_V)};
              GEMM_CALL_NA(pg8::EpiKV, pg8::RowOrder, g, S, E); }
            SEAM(base + 3); }
        for (int rep_ = 0; rep_ < ((DBG_REPEAT == 4) ? 2 : 1); ++rep_) if (PH_ON(4) && IN(base + 4)) { REFRAME(); if (rep_) xcd_barrier(bar, T0());
            ScanCvt C; C.pu = karg(30) + (size_t)l * NEXP * DM; C.pv = karg(31) + (size_t)l * NEXP * DM; C.PU8 = ws + WS_P4; C.PV8 = ws + WS_P4 + (size_t)NEXP * (DM / 2); C.SU = (float*)(ws + WS_P4S); C.SV = (float*)(ws + WS_P4S) + NEXP; C.wl = (MK_N_LAUNCHES == 1 && l + 1 < NLAYER && F.G == 256) ? l + 1 : -1;
            scan_phase(F, (const bf16*)(ws + WS_RI), (bf16*)(ws + WS_Y), C); SEAM(base + 4); }
        for (int rep_ = 0; rep_ < ((DBG_REPEAT == 5) ? 2 : 1); ++rep_) if (PH_ON(5) && IN(base + 5)) { REFRAME(); if (rep_) xcd_barrier(bar, T0());
            attn_phase(F, (const bf16*)(ws + WS_Q), (const bf16*)(ws + WS_K), (const bf16*)(ws + WS_V), (bf16*)(ws + WS_YB), !last);
            readout_phase(F, (const bf16*)(ws + WS_Y), (const bf16*)(ws + WS_GG), (const float*)(ws + WS_BON), (const bf16*)(ws + WS_RI), karg(18) + (size_t)l * RW, karg(19) + (size_t)l * RW, (bf16*)(ws + WS_YA));
            SEAM(base + 5); }
        for (int rep_ = 0; rep_ < ((DBG_REPEAT == 6) ? 2 : 1); ++rep_) if (PH_ON(6) && IN(base + 6)) { REFRAME(); if (rep_) xcd_barrier(bar, T0());
            bf16* T1 = (bf16*)(ws + WS_T1); bf16* T2 = (bf16*)(ws + WS_T2);
            const pg8::Gemm g1{HBUF, (const bf16*)(ws + WS_WGA) + (size_t)l * DM * DM, MALL, DM, DM}, g2{(const bf16*)(ws + WS_YA), (const bf16*)(ws + WS_WA) + (size_t)l * DM * RW, MALL, DM, RW};
            const pg8::Gemm g3{HBUF, (const bf16*)(ws + WS_WGB) + (size_t)l * DM * DM, MALL, DM, DM}, g4{(const bf16*)(ws + WS_YB), (const bf16*)(ws + WS_WB) + (size_t)l * DM * RW, MALL, DM, RW};
            const pg8::EpiGate E1{T1, DM, karg(8) + (size_t)l * 2 * DM}, E3{T2, DM, karg(8) + (size_t)l * 2 * DM + DM};
            const pg8::EpiMulAdd E2{T1, T1, nullptr, DM}, E4{T1, T2, T1, DM};
            const bool split = CTX_SPLIT && !last && F.G >= 128;
            pg8::RowOrder S; S.init_rows(last || split, DM, F.G, bx);
            GEMM_CALL(pg8::EpiGate, pg8::RowOrder, g1, S, E1); GEMM_CALL(pg8::EpiMulAdd, pg8::RowOrder, g2, S, E2); GEMM_CALL(pg8::EpiGate, pg8::RowOrder, g3, S, E3); GEMM_CALL(pg8::EpiMulAdd, pg8::RowOrder, g4, S, E4);
            if (split) {
                pg8::CtxOrder Sg, Sp; Sg.u0 = (bx < 32) ? (bx & 15) : -1; Sp.u0 = (bx >= 32 && bx < 64) ? (bx & 15) : -1;
                const bool second = (bx & 16) != 0;
                const pg8::Gemm gg = second ? g3 : g1, gp = second ? g4 : g2;
                const pg8::EpiGate EG = second ? E3 : E1;
                const pg8::EpiCtxF32 EP{(float*)(ws + (second ? WS_CB : WS_CA)), DM};
                GEMM_CALL(pg8::EpiGate, pg8::CtxOrder, gg, Sg, EG); GEMM_CALL(pg8::EpiCtxF32, pg8::CtxOrder, gp, Sp, EP); }
            if (MK_N_LAUNCHES == 1 && l == 0 && rep_ == 0) { __syncthreads();
                const int late = split ? 64 : (F.G > 32) ? 16 : 0; p0_prologue(F, 1, NLAYER, (bx >= late) ? bx - late : -1, F.G - late, (F.G == 256) ? 0 : 1); }
            SEAM(base + 6); }
        for (int rep_ = 0; rep_ < ((DBG_REPEAT == 7) ? 2 : 1); ++rep_) if (PH_ON(7) && IN(base + 7)) { REFRAME(); if (rep_) xcd_barrier(bar, T0());
            if (CTX_SPLIT && !last && F.G >= 128 && rep_ == 0) {
                bf16* T1 = (bf16*)(ws + WS_T1); const bf16* T2 = (const bf16*)(ws + WS_T2); const float* CA = (const float*)(ws + WS_CA); const float* CB = (const float*)(ws + WS_CB);
                for (int e = bx * (NWAVES * 64) + F.tid; e < 512 * (DM / 8); e += F.G * (NWAVES * 64)) { const int r = e >> 8, c0 = (e & 255) * 8; const size_t go = (size_t)((r < 256) ? r : 33 * 256 + (r - 256)) * DM + c0;
                    const v4u ga = *(const GAS v4u*)(T1 + go), gb = *(const GAS v4u*)(T2 + go);
                    const f32x4 a0 = *(const GAS f32x4*)(CA + (size_t)r * DM + c0), a1 = *(const GAS f32x4*)(CA + (size_t)r * DM + c0 + 4), b0 = *(const GAS f32x4*)(CB + (size_t)r * DM + c0), b1 = *(const GAS f32x4*)(CB + (size_t)r * DM + c0 + 4);
                    v4u o;
                    o.x = pk2(bflo(ga.x) * a0[0] + bflo(gb.x) * b0[0], bfhi(ga.x) * a0[1] + bfhi(gb.x) * b0[1]); o.y = pk2(bflo(ga.y) * a0[2] + bflo(gb.y) * b0[2], bfhi(ga.y) * a0[3] + bfhi(gb.y) * b0[3]);
                    o.z = pk2(bflo(ga.z) * a1[0] + bflo(gb.z) * b1[0], bfhi(ga.z) * a1[1] + bfhi(gb.z) * b1[1]); o.w = pk2(bflo(ga.w) * a1[2] + bflo(gb.w) * b1[2], bfhi(ga.w) * a1[3] + bfhi(gb.w) * b1[3]);
                    *(GAS v4u*)(T1 + go) = o; }
                xcd_barrier(bar, T0()); }
            const pg8::Gemm g{(const bf16*)(ws + WS_T1), (const bf16*)(ws + WS_WO) + (size_t)l * DM * DM, MALL, DM, DM};
            const pg8::EpiResid E{XBUF, MODP + 2 * DM, l == 0 ? karg(0) : nullptr, l == 0 ? karg(2) : nullptr};
            pg8::RowOrder S; S.init_rows(last, DM, F.G, bx); GEMM_CALL(pg8::EpiResid, pg8::RowOrder, g, S, E);
            SEAM(base + 7); }
        for (int rep_ = 0; rep_ < ((DBG_REPEAT == 8) ? 2 : 1); ++rep_) if (PH_ON(8) && IN(base + 8)) { REFRAME(); if (rep_) xcd_barrier(bar, T0());
            modnorm_phase_bf(F, XBUF, karg(27) + (size_t)l * DM, MODP, 3, HBUF, last);
            SEAM(base + 8); }
        for (int rep_ = 0; rep_ < ((DBG_REPEAT == 9) ? 2 : 1); ++rep_) if (PH_ON(9) && IN(base + 9)) { REFRAME(); if (rep_) xcd_barrier(bar, T0());
            const pg8::Gemm g{HBUF, (const bf16*)(ws + WS_WQK) + (size_t)l * DM * DM, MALL, DM, DM};
            const pg8::EpiF16 E{(_Float16*)(ws + WS_SC), DM};
            pg8::RowOrder S; S.init_rows(last, DM, F.G, bx); GEMM_CALL(pg8::EpiF16, pg8::RowOrder, g, S, E);
            SEAM(base + 9); }
        for (int rep_ = 0; rep_ < ((DBG_REPEAT == 11) ? 2 : 1); ++rep_) if (PH_ON(11) && IN(base + 11)) { REFRAME(); if (rep_) xcd_barrier(bar, T0());
            PeerP P; P.SC = (const _Float16*)(ws + WS_SC); P.nmod = MODP + 3 * 12288; P.ng = karg(6) + (size_t)(l + 1) * DM; P.Hout = HBUF; P.ESEL = (const int*)(ws + WS_T1); P.EGATE = (const float*)(ws + WS_T1 + 16 * MiB); P.H = HBUF; P.PU = ws + WS_P4; P.PV = ws + WS_P4 + (size_t)NEXP * (DM / 2); P.SU = (const float*)(ws + WS_P4S); P.SV = (const float*)(ws + WS_P4S) + NEXP; P.X = XBUF; P.mod = MODP; P.fin_g = karg(32); P.out = (float*)karg(33); P.last = last; P.dry = (DBG_REPEAT == 11 && rep_ == 0) ? DBG_DRY : 0;
            peer_phase(F, P);
            SEAM(base + 11); }
    }
#undef IN
#undef SEAM
#undef XBUF
#undef HBUF
#undef MODP
}

__device__ __forceinline__ float mx_a_val(int i, int k) { const int c = (i * 131 + k * 17 + (k >> 3) * 5) & 15; const float mag[8] = {0.f, .5f, 1.f, 1.5f, 2.f, 3.f, 4.f, 6.f}; return (c & 8) ? -mag[c & 7] : mag[c & 7]; }
__device__ __forceinline__ int mx_a_code(int i, int k) { return (i * 131 + k * 17 + (k >> 3) * 5) & 15; }
__device__ __forceinline__ float mx_b_val(int k, int j) { return (float)(((k * 7 + j * 13 + (k >> 4)) % 9) - 4); }
__device__ __forceinline__ int mx_kmap(int hyp, int kb, int e) { const int h = hyp % 3; return h == 0 ? 32 * kb + e : h == 1 ? 32 * (e >> 3) + 8 * kb + (e & 7) : 64 * (e >> 4) + 16 * kb + (e & 15); }
__global__ void __launch_bounds__(512) dbg_fill(const float* pp, float* o) {
    __shared__ float vsh;
    float v = 0.f;
    if (DBG_PROBE == 5) {
        if (threadIdx.x < 64) { typedef int v8i __attribute__((ext_vector_type(8))); typedef float f4 __attribute__((ext_vector_type(4)));
            const int lane = threadIdx.x, i = lane & 15, kb = lane >> 4; float code = 0.f;
            for (int hyp = 0; hyp < 18; ++hyp) { const int nibswap = hyp / 9, ha = hyp % 3, hb2 = (hyp / 3) % 3;
                unsigned aw[4] = {0u, 0u, 0u, 0u}; int bw[8] = {0, 0, 0, 0, 0, 0, 0, 0};
                for (int e = 0; e < 32; ++e) { const int k = mx_kmap(ha, kb, e); const unsigned c = (unsigned)mx_a_code(i, k); const int pos = nibswap ? (e ^ 1) : e; aw[pos >> 3] |= c << (4 * (pos & 7)); }
                for (int q = 0; q < 8; ++q) { int w = 0; const float f0 = mx_b_val(mx_kmap(hb2, kb, 4 * q + 0), i), f1 = mx_b_val(mx_kmap(hb2, kb, 4 * q + 1), i), f2 = mx_b_val(mx_kmap(hb2, kb, 4 * q + 2), i), f3 = mx_b_val(mx_kmap(hb2, kb, 4 * q + 3), i);
                    w = __builtin_amdgcn_cvt_pk_fp8_f32(f0, f1, w, false); w = __builtin_amdgcn_cvt_pk_fp8_f32(f2, f3, w, true); bw[q] = w; }
                const v8i af = {(int)aw[0], (int)aw[1], (int)aw[2], (int)aw[3], 0, 0, 0, 0}, bf = {bw[0], bw[1], bw[2], bw[3], bw[4], bw[5], bw[6], bw[7]};
                f4 d = {0.f, 0.f, 0.f, 0.f};
                d = __builtin_amdgcn_mfma_scale_f32_16x16x128_f8f6f4(af, bf, d, 4, 0, 0, 0x7f7f7f7f, 0, 0x7f7f7f7f);
                int bad = 0;
                for (int r = 0; r < 4; ++r) { const int row = 4 * kb + r, col = i; float ex = 0.f; for (int k = 0; k < 128; ++k) ex += mx_a_val(row, k) * mx_b_val(k, col); bad += (d[r] != ex); }
                if (__ballot(bad != 0) == 0ull && code == 0.f) code = (float)(hyp + 1); }
            for (int t = 0; t < 2; ++t) {
                int aw[8] = {0, 0, 0, 0, 0, 0, 0, 0}, bw[8] = {0, 0, 0, 0, 0, 0, 0, 0};
                if (t == 0) { for (int e = 0; e < 32; ++e) { const int k = 32 * kb + e; aw[e >> 3] |= mx_a_code(i, k) << (4 * (e & 7)); bw[e >> 3] |= mx_a_code(i + 16, k) << (4 * (e & 7)); } }
                else { for (int q = 0; q < 8; ++q) { int w = 0, w2 = 0; const int k = 32 * kb + 4 * q;
                        w = __builtin_amdgcn_cvt_pk_fp8_f32(mx_b_val(k, i + 16), mx_b_val(k + 1, i + 16), w, false); w = __builtin_amdgcn_cvt_pk_fp8_f32(mx_b_val(k + 2, i + 16), mx_b_val(k + 3, i + 16), w, true); aw[q] = w;
                        w2 = __builtin_amdgcn_cvt_pk_fp8_f32(mx_b_val(k, i), mx_b_val(k + 1, i), w2, false); w2 = __builtin_amdgcn_cvt_pk_fp8_f32(mx_b_val(k + 2, i), mx_b_val(k + 3, i), w2, true); bw[q] = w2; } }
                const v8i af = {aw[0], aw[1], aw[2], aw[3], aw[4], aw[5], aw[6], aw[7]}, bf = {bw[0], bw[1], bw[2], bw[3], bw[4], bw[5], bw[6], bw[7]};
                f4 d = {0.f, 0.f, 0.f, 0.f};
                if (t == 0) d = __builtin_amdgcn_mfma_scale_f32_16x16x128_f8f6f4(af, bf, d, 4, 4, 0, 0x7f7f7f7f, 0, 0x7f7f7f7f); else d = __builtin_amdgcn_mfma_scale_f32_16x16x128_f8f6f4(af, bf, d, 0, 0, 0, 0x7f7f7f7f, 0, 0x7f7f7f7f);
                int bad = 0;
                for (int r = 0; r < 4; ++r) { const int row = 4 * kb + r, col = i; float ex = 0.f;
                    for (int k = 0; k < 128; ++k) ex += (t == 0) ? mx_a_val(row, k) * mx_a_val(col + 16, k) : mx_b_val(k, row + 16) * mx_b_val(k, col);
                    bad += (d[r] != ex); }
                if (__ballot(bad != 0) == 0ull) code += (t == 0) ? 10.f : 20.f; }
            if (lane == 0) vsh = code; }
        __syncthreads(); v = vsh;
    } else {
        float s0 = 0.f, s1 = 0.f, s2 = 0.f, s3 = 0.f;
        for (int i = 0; i < 2048; ++i) { s0 += pp[4 * i]; s1 += pp[4 * i + 1]; s2 += pp[4 * i + 2]; s3 += pp[4 * i + 3]; }
        if (DBG_PROBE == 4) { float mx = 0.f; for (int i = 0; i < 2048; ++i) mx = fmaxf(mx, pp[4 * i]); v = 100.f * mx; }
        else { v = (DBG_PROBE == 1 ? s0 : DBG_PROBE == 2 ? s1 : s2) / s3 * 1e-3f; v = exp2f(rintf(log2f(v) * 4.f) * 0.25f); }
    }
    for (size_t i = (size_t)blockIdx.x * 512 + threadIdx.x; i < (size_t)NBATCH * SEQ * DM; i += (size_t)gridDim.x * 512) o[i] = v;
}
extern "C" void kernel_launch(void* const* d_in, const int* in_sizes, int n_in, void* d_out, int out_size, void* d_ws, size_t ws_size, hipStream_t stream) {
    static int grid = 0;
    if (grid == 0) {
        if (n_in != 33 || out_size != NBATCH * SEQ * DM || ws_size < WS_END2) { fprintf(stderr, "kernel_launch: unexpected shapes (n_in %d out %d ws %zu)\n", n_in, out_size, ws_size); grid = -1; return; }
        int dev = 0, cus = 0, per_cu = 0;
        if (hipGetDevice(&dev) != hipSuccess || hipDeviceGetAttribute(&cus, hipDeviceAttributeMultiprocessorCount, dev) != hipSuccess) { grid = -1; return; }
        if (hipFuncSetAttribute((const void*)mk_fwd, hipFuncAttributeMaxDynamicSharedMemorySize, LDS_BYTES) != hipSuccess) { fprintf(stderr, "kernel_launch: hipFuncSetAttribute failed\n"); grid = -1; return; }
        if (hipOccupancyMaxActiveBlocksPerMultiprocessor(&per_cu, (const void*)mk_fwd, NWAVES * 64, LDS_BYTES) != hipSuccess || per_cu < 1) { fprintf(stderr, "kernel_launch: occupancy query says %d\n", per_cu); (void)hipGetLastError(); grid = -1; return; }
        grid = cus;
    }
    if (grid < 0) return;
    if (hipMemsetAsync((char*)d_ws + WS_CTL, 0, CTL_ZERO_BYTES, stream) != hipSuccess) return;
    Args a{};
    for (int i = 0; i < 33; ++i) a.in[i] = (const float*)d_in[i];
    a.out = (float*)d_out; a.ws = (unsigned char*)d_ws;
#if MK_N_LAUNCHES == 1
    a.ph_lo = 0; a.ph_hi = NPHASE;
    hipLaunchKernelGGL(mk_fwd, dim3(grid), dim3(NWAVES * 64), LDS_BYTES, stream, a);
#else
    if (DBG_PROBE != 5) for (int p = 0; p < NPHASE; ++p) { a.ph_lo = p; a.ph_hi = p + 1; hipLaunchKernelGGL(mk_fwd, dim3(grid), dim3(NWAVES * 64), LDS_BYTES, stream, a); }
    if (DBG_PROBE) hipLaunchKernelGGL(dbg_fill, dim3(1024), dim3(512), 0, stream, (const float*)((char*)d_ws + WS_CTL + CTL_PROBE_OFF), (float*)d_out);
#endif
}
```

```cpp
#include <hip/hip_runtime.h>
#include <cstdio>
#include <cstdint>

#ifndef MK_N_LAUNCHES
#define MK_N_LAUNCHES 1
#endif

#ifndef DBG_SKIP
#define DBG_SKIP 0
#endif
#ifndef DBG_PROBE
#define DBG_PROBE 0
#endif
#ifndef DBG_DRY
#define DBG_DRY 1
#endif
#ifndef DBG_REPEAT
#define DBG_REPEAT -1
#endif
namespace pg8 {
#define PG8_LAS __attribute__((address_space(3)))
typedef unsigned short bf16_t;
typedef short bf16x8 __attribute__((ext_vector_type(8)));
typedef float f32x4 __attribute__((ext_vector_type(4)));
typedef unsigned u32x4 __attribute__((ext_vector_type(4)));
constexpr int BM = 256, BK = 64, HALF = 128, HTB = HALF * BK * 2  , STAGE_BYTES = 8 * HTB, NXCD = 8, WGM = 8;

__host__ __device__ __forceinline__ int lds_byte(int r, int c) { const int st = (r >> 4) * 2 + (c >> 5), rr = r & 15, cc = c & 31, ob = rr * 64 + cc * 2; return st * 1024 + (ob ^ (((ob >> 9) & 1) << 5)); }
__host__ __device__ __forceinline__ void stage_rc(int b, int& R, int& C) { const int st = b / 1024, sb = b % 1024, swz = sb ^ (((sb >> 9) & 1) << 5); R = (st >> 1) * 16 + swz / 64; C = (st & 1) * 32 + (swz % 64) / 2; }
__host__ __device__ __forceinline__ int perm32(int rho) { const int n = rho >> 4, i = rho & 15; return 8 * (i >> 2) + 4 * n + (i & 3); }

struct Unit { int pm, pn; };
struct Gemm { const bf16_t* A; const bf16_t* Bt; int M, N, K; };

struct StaticOrder {
    int nM, nN, nwg, G, c;
    __host__ __device__ void init(int M, int N, int G_, int c_) { nM = M / BM; nN = N / BM; nwg = nM * nN; G = G_; c = c_; }
    __host__ __device__ bool next(int i, Unit& u) const {
        const long L = (long)i * G + c; if (L >= nwg) return false;
        int wgid = (int)L; { const int q = nwg / NXCD, r = nwg % NXCD, xcd = wgid % NXCD, off = wgid / NXCD; wgid = (xcd < r ? xcd * (q + 1) : r * (q + 1) + (xcd - r) * q) + off; }
        const int nig = WGM * nN, gid = wgid / nig, fm = gid * WGM, gsz = (nM - fm) < WGM ? (nM - fm) : WGM;
        u.pm = fm + ((wgid % nig) % gsz); u.pn = (wgid % nig) / gsz; return true;
    }
    __device__ __forceinline__ void a_ready(const Unit&) const {}
    __device__ __forceinline__ void done(const Unit&) const {}
};
__device__ __forceinline__ int opaque_lane() { int l; asm volatile("v_mbcnt_lo_u32_b32 %0, -1, 0\n\tv_mbcnt_hi_u32_b32 %0, -1, %0" : "=v"(l)); return l; }
typedef __bf16 bf16x2c __attribute__((ext_vector_type(2)));
__device__ __forceinline__ unsigned cvt_pk_bf16(float lo, float hi) { const bf16x2c v = {(__bf16)lo, (__bf16)hi}; return __builtin_bit_cast(unsigned, v); }
template <class Epi, class Sched, bool ALIGN_EPI = false, bool SP2 = false>
__device__ __forceinline__ void gemm_phase(PG8_LAS unsigned char* lds, const Gemm g, const Sched& S, const Epi& E, const int wave_s) {
    const int lane_ = opaque_lane();
    const int wid = wave_s, lane = lane_, tid = wid * 64 + lane, wr = wid >> 2, wc = wid & 3, fr = lane & 15, fq = lane >> 4;
    const int K = g.K, nt = K / BK;
    unsigned voffA[2], voffB[2];
#pragma unroll
    for (int i = 0; i < 2; ++i) { int R, C; stage_rc(tid * 16 + i * 8192, R, C); const int Rb = Epi::PERM ? ((R & ~31) + perm32(R & 31)) : R;
        voffA[i] = (unsigned)(R * K + C) * 2u; voffB[i] = (unsigned)(Rb * K + C) * 2u; }
    const size_t kstep = (size_t)(BK * 2);
    const size_t hstep = (size_t)HALF * K * 2;
    const size_t tstep = 2 * hstep;
    const unsigned ldsw = (unsigned)wid * 1024u;
    const int aoff = lds_byte(wr * 64 + fr, fq * 8), boff = lds_byte(wc * 32 + fr, fq * 8);
#define PG8_SA(b, h) (((b) * 2 + (h)) * HTB)
#define PG8_SB(b, h) ((4 + (b) * 2 + (h)) * HTB)
#define PG8_STAGE(bufoff, gbase, voff) do { _Pragma("unroll") for (int _i = 0; _i < 2; ++_i) \
        __builtin_amdgcn_global_load_lds((const unsigned*)((const char*)(gbase) + (voff)[_i]), (PG8_LAS unsigned*)(lds + (bufoff) + ldsw + _i * 8192), 16, 0, 0); } while (0)
#define PG8_LDA(dst, b, h) do { _Pragma("unroll") for (int m = 0; m < 4; ++m) _Pragma("unroll") for (int k = 0; k < 2; ++k) dst[m][k] = *(const PG8_LAS bf16x8*)(lds + PG8_SA(b, h) + aoff + m * 2048 + k * 1024); } while (0)
#define PG8_LDB(dst, b, h) do { _Pragma("unroll") for (int n = 0; n < 2; ++n) _Pragma("unroll") for (int k = 0; k < 2; ++k) dst[n][k] = *(const PG8_LAS bf16x8*)(lds + PG8_SB(b, h) + boff + n * 2048 + k * 1024); } while (0)
#define PG8_MMA(ai, bj, At, Bt) do { __builtin_amdgcn_s_setprio(1); _Pragma("unroll") for (int m = 0; m < 4; ++m) _Pragma("unroll") for (int n = 0; n < 2; ++n) _Pragma("unroll") for (int k = 0; k < 2; ++k) \
        acc[ai][bj][m][n] = __builtin_amdgcn_mfma_f32_16x16x32_bf16(Bt[n][k], At[m][k], acc[ai][bj][m][n], 0, 0, 0); __builtin_amdgcn_s_setprio(0); } while (0)
#define PG8_WAIT_V(n) asm volatile("s_waitcnt vmcnt(" #n ")" ::: "memory")
#define PG8_WAIT_L(n) asm volatile("s_waitcnt lgkmcnt(" #n ")" ::: "memory")
#define PG8_BAR __builtin_amdgcn_s_barrier()
#define PG8_SCHED __builtin_amdgcn_sched_barrier(0)
    Unit cur, nxt; int ui = 0;
    if (!S.next(0, cur)) return;
    f32x4 acc[2][2][4][2];
#pragma unroll
    for (int a = 0; a < 2; ++a)
#pragma unroll
        for (int b = 0; b < 2; ++b)
#pragma unroll
            for (int m = 0; m < 4; ++m)
#pragma unroll
                for (int n = 0; n < 2; ++n) acc[a][b][m][n] = (f32x4){0.f, 0.f, 0.f, 0.f};
    bf16x8 At[4][2], B0[2][2], B1[2][2];
    const char* cA = (const char*)g.A + (size_t)cur.pm * tstep; const char* cB = (const char*)g.Bt + (size_t)cur.pn * tstep;
    S.a_ready(cur);
    if constexpr (SP2) {
        PG8_STAGE(PG8_SB(0, 0), cB, voffB); PG8_STAGE(PG8_SB(0, 1), cB + hstep, voffB); PG8_STAGE(PG8_SA(0, 0), cA, voffA); PG8_STAGE(PG8_SA(0, 1), cA + hstep, voffA);
        if (wr == 1) PG8_BAR;
        PG8_WAIT_V(2); PG8_BAR;
        PG8_STAGE(PG8_SB(1, 0), cB + kstep, voffB); PG8_STAGE(PG8_SA(1, 0), cA + kstep, voffA); PG8_STAGE(PG8_SB(1, 1), cB + hstep + kstep, voffB);
        PG8_WAIT_V(6); PG8_BAR;
    } else {
        PG8_STAGE(PG8_SB(0, 0), cB, voffB); PG8_STAGE(PG8_SA(0, 0), cA, voffA); PG8_STAGE(PG8_SB(0, 1), cB + hstep, voffB); PG8_STAGE(PG8_SA(0, 1), cA + hstep, voffA);
        if (wr == 1) PG8_BAR;
        PG8_WAIT_V(4); PG8_BAR;
        PG8_STAGE(PG8_SB(1, 0), cB + kstep, voffB); PG8_STAGE(PG8_SA(1, 0), cA + kstep, voffA); PG8_STAGE(PG8_SB(1, 1), cB + hstep + kstep, voffB);
        PG8_WAIT_V(6); PG8_BAR;
    }
    for (;;) {
        const bool has_next = S.next(ui + 1, nxt);
        const char* nA = has_next ? (const char*)g.A + (size_t)nxt.pm * tstep : cA; const char* nB = has_next ? (const char*)g.Bt + (size_t)nxt.pn * tstep : cB;
        for (int t = 0; t < nt; t += 2) {
            const bool last = (t == nt - 2);
            const char* a1 = cA + (size_t)(t + 1) * kstep;
            const char* a2 = last ? nA : cA + (size_t)(t + 2) * kstep; const char* b2 = last ? nB : cB + (size_t)(t + 2) * kstep;
            const char* a3 = a2 + kstep; const char* b3 = b2 + kstep;
            if (last && has_next) S.a_ready(nxt);
            if constexpr (SP2) {
            PG8_LDB(B0, 0, 0); PG8_LDB(B1, 0, 1); PG8_SCHED; PG8_LDA(At, 0, 0); PG8_STAGE(PG8_SA(1, 1), a1 + hstep, voffA);
            PG8_WAIT_V(8); PG8_WAIT_L(0); PG8_BAR; PG8_MMA(0, 0, At, B0); PG8_MMA(0, 1, At, B1); PG8_BAR; PG8_SCHED;
            PG8_LDA(At, 0, 1); PG8_STAGE(PG8_SB(0, 0), b2, voffB); PG8_STAGE(PG8_SB(0, 1), b2 + hstep, voffB); PG8_STAGE(PG8_SA(0, 0), a2, voffA);
            PG8_WAIT_V(8); PG8_WAIT_L(0); PG8_BAR; PG8_MMA(1, 0, At, B0); PG8_MMA(1, 1, At, B1); PG8_BAR; PG8_SCHED;
            PG8_LDB(B0, 1, 0); PG8_LDB(B1, 1, 1); PG8_SCHED; PG8_LDA(At, 1, 0); PG8_STAGE(PG8_SA(0, 1), a2 + hstep, voffA);
            PG8_WAIT_V(8); PG8_WAIT_L(0); PG8_BAR; PG8_MMA(0, 0, At, B0); PG8_MMA(0, 1, At, B1); PG8_BAR; PG8_SCHED;
            PG8_LDA(At, 1, 1); PG8_STAGE(PG8_SB(1, 0), b3, voffB); PG8_STAGE(PG8_SB(1, 1), b3 + hstep, voffB); PG8_STAGE(PG8_SA(1, 0), a3, voffA);
            PG8_WAIT_V(8); PG8_WAIT_L(0); PG8_BAR; PG8_MMA(1, 0, At, B0); PG8_MMA(1, 1, At, B1); PG8_BAR; PG8_SCHED;
            } else {
            PG8_LDB(B0, 0, 0); PG8_SCHED; PG8_LDA(At, 0, 0); PG8_STAGE(PG8_SA(1, 1), a1 + hstep, voffA);
            PG8_WAIT_L(8); PG8_BAR; PG8_WAIT_L(0); PG8_MMA(0, 0, At, B0); PG8_BAR; PG8_SCHED;
            PG8_LDB(B1, 0, 1); PG8_STAGE(PG8_SB(0, 0), b2, voffB);
            PG8_BAR; PG8_WAIT_L(0); PG8_MMA(0, 1, At, B1); PG8_BAR;
            PG8_LDA(At, 0, 1); PG8_STAGE(PG8_SA(0, 0), a2, voffA);
            PG8_BAR; PG8_WAIT_L(0); PG8_MMA(1, 0, At, B0); PG8_BAR; PG8_SCHED;
            PG8_STAGE(PG8_SB(0, 1), b2 + hstep, voffB);
            PG8_WAIT_V(6); PG8_BAR; PG8_MMA(1, 1, At, B1); PG8_BAR;
            PG8_LDB(B0, 1, 0); PG8_SCHED; PG8_LDA(At, 1, 0); PG8_STAGE(PG8_SA(0, 1), a2 + hstep, voffA);
            PG8_WAIT_L(8); PG8_BAR; PG8_WAIT_L(0); PG8_MMA(0, 0, At, B0); PG8_BAR; PG8_SCHED;
            PG8_LDB(B1, 1, 1); PG8_STAGE(PG8_SB(1, 0), b3, voffB);
            PG8_BAR; PG8_WAIT_L(0); PG8_MMA(0, 1, At, B1); PG8_BAR;
            PG8_LDA(At, 1, 1); PG8_STAGE(PG8_SA(1, 0), a3, voffA);
            PG8_BAR; PG8_WAIT_L(0); PG8_MMA(1, 0, At, B0); PG8_BAR; PG8_SCHED;
            PG8_STAGE(PG8_SB(1, 1), b3 + hstep, voffB);
            PG8_WAIT_V(6); PG8_BAR; PG8_MMA(1, 1, At, B1); PG8_BAR;
            }
        }
        if constexpr (ALIGN_EPI) { if (wr == 0) PG8_BAR; }
        if constexpr (!Epi::AFTER_DRAIN) { const int le_ = opaque_lane(); E(acc, cur, wr, wc, le_ & 15, le_ >> 4); S.done(cur); }
        if (!has_next) break;
#pragma unroll
        for (int a = 0; a < 2; ++a)
#pragma unroll
            for (int b = 0; b < 2; ++b)
#pragma unroll
                for (int m = 0; m < 4; ++m)
#pragma unroll
                    for (int n = 0; n < 2; ++n) acc[a][b][m][n] = (f32x4){0.f, 0.f, 0.f, 0.f};
        cur = nxt; cA = nA; cB = nB; ++ui;
        if constexpr (ALIGN_EPI) { if (wr == 1) PG8_BAR; }
    }
    PG8_WAIT_V(0);
    if constexpr (!ALIGN_EPI) { if (wr == 0) PG8_BAR; }
    PG8_BAR;
    if constexpr (Epi::AFTER_DRAIN) { E.fused(acc, cur, wr, wc, fr, fq, lds, wid, lane); S.done(cur); }
#undef PG8_SA
#undef PG8_SB
#undef PG8_STAGE
#undef PG8_LDA
#undef PG8_LDB
#undef PG8_MMA
#undef PG8_WAIT_V
#undef PG8_WAIT_L
#undef PG8_BAR
#undef PG8_SCHED
}
}

constexpr int NWAVES = 8;
constexpr int DM = 2048, NBATCH = 2, SEQ = 8192, CTXL = 256, TPB = CTXL + SEQ  , MALL = NBATCH * TPB  ;
constexpr int NLAYER = 2;
constexpr int RW = 1024, NH = 16;
constexpr int RWC = 3392, INA = 4192, INA_P = 4352, INC = 8288;
constexpr int C_WD = 3072, C_AD = 3200, C_GD = 3328, C_QC = 3392, C_KVC = 3904, C_KR = 4160;
constexpr int QKD = 96, NQ = NH * QKD  , NKV = NH * 128  ;
constexpr int NEXP = 16384;
constexpr int RREC = 9 * 64;
constexpr float NORM_EPS = 1e-6f;

constexpr size_t MiB = 1u << 20;
constexpr size_t WS_CTL = 0, CTL_ZERO_BYTES = 1 * MiB;
constexpr size_t CTL_MOD_OFF = 256 * 1024;
constexpr size_t WS_ROPE = 1 * MiB;
constexpr size_t WS_WUP = 3 * MiB, WS_AUP = WS_WUP + 512 * 1024, WS_GUP = 4 * MiB;
constexpr size_t WS_WUQ = 5 * MiB, WS_WUKV = 8 * MiB, WS_WA = 10 * MiB, WS_WB = 18 * MiB, WS_WO = 26 * MiB, WS_WQK = 42 * MiB, WS_WGA = 58 * MiB, WS_WGB = 74 * MiB, WS_WINA = 90 * MiB;
constexpr size_t WS_X = 124 * MiB, WS_H = 256 * MiB, WS_DYN = 322 * MiB;
constexpr size_t WS_PA = WS_DYN;
constexpr size_t WS_RI = 463 * MiB;
constexpr size_t WS_GG = 760 * MiB;
constexpr size_t WS_BON = 826 * MiB;
constexpr size_t WS_QN = 831 * MiB, WS_KVN = 848 * MiB;
constexpr size_t WS_Q = 857 * MiB, WS_K = 907 * MiB, WS_V = 957 * MiB, WS_END = 990 * MiB;
constexpr size_t WS_Y = WS_DYN;
constexpr size_t WS_YA = 388 * MiB, WS_YB = 421 * MiB;
constexpr size_t WS_T1 = 463 * MiB, WS_T2 = 529 * MiB;
constexpr size_t WS_PU = 600 * MiB, WS_PV = 664 * MiB;
constexpr size_t WS_CA = 600 * MiB, WS_CB = 608 * MiB;
#ifndef CTX_SPLIT
#define CTX_SPLIT (MK_N_LAUNCHES == 1)
#endif
constexpr size_t WS_P4 = 990 * MiB, WS_P4S = 1022 * MiB, WS_END2 = 1023 * MiB;
constexpr size_t WS_SC = WS_DYN;
static_assert(WS_PA + (size_t)MALL * INA_P * 2 <= WS_RI && WS_RI + (size_t)NBATCH * NH * TPB * RREC * 2 <= WS_GG && WS_GG + (size_t)2 * MALL * RW * 2 <= WS_BON, "ws map 1");
static_assert(WS_BON + (size_t)2 * MALL * 32 * 4 <= WS_QN && WS_QN + (size_t)MALL * 512 * 2 <= WS_KVN && WS_KVN + (size_t)MALL * 256 * 2 <= WS_Q, "ws map 2");
static_assert(WS_Q + (size_t)NBATCH * NH * TPB * QKD * 2 <= WS_K && WS_K + (size_t)NBATCH * NH * TPB * QKD * 2 <= WS_V && WS_V + (size_t)NBATCH * NH * TPB * 64 * 2 <= WS_END, "ws map 3");
static_assert(WS_Y + (size_t)2 * MALL * RW * 2 <= WS_YA && WS_YA + (size_t)MALL * RW * 2 <= WS_YB && WS_YB + (size_t)MALL * RW * 2 <= WS_RI, "ws map 4");
static_assert(WS_T1 + (size_t)MALL * DM * 2 <= WS_T2 && WS_T2 + (size_t)MALL * DM * 2 <= WS_PU && WS_PU + (size_t)NEXP * DM * 2 <= WS_PV && WS_PV + (size_t)NEXP * DM * 2 <= WS_GG, "ws map 5");
static_assert(WS_SC + (size_t)MALL * DM * 4 <= WS_T1 && WS_X + (size_t)MALL * DM * 4 <= WS_H && WS_H + (size_t)MALL * DM * 2 <= WS_DYN, "ws map 6");
static_assert(WS_WINA + (size_t)NLAYER * INA_P * DM * 2 <= WS_X, "ws map 7");
constexpr size_t CTL_PROBE_OFF = 640 * 1024;
constexpr int CW_BAR = 4096;

constexpr int RING_BYTES = 131072;
constexpr int LDSCTL_OFF = RING_BYTES, MISC_OFF = LDSCTL_OFF + 320;
constexpr int LDS_BYTES = 147456;

#define GAS __attribute__((address_space(1)))
#define LAS __attribute__((address_space(3)))
typedef unsigned short bf16;
typedef unsigned v4u __attribute__((ext_vector_type(4)));
typedef unsigned v2u __attribute__((ext_vector_type(2)));
typedef float f32x4 __attribute__((ext_vector_type(4)));
typedef float f32x2 __attribute__((ext_vector_type(2)));
typedef float f32x16 __attribute__((ext_vector_type(16)));
typedef short bf16x8 __attribute__((ext_vector_type(8)));
typedef short s16x4 __attribute__((ext_vector_type(4)));
typedef __bf16 bf16x2v __attribute__((ext_vector_type(2)));
typedef __bf16 bf16x8v __attribute__((ext_vector_type(8)));
typedef GAS unsigned gu32;
#define RLX_AGENT __ATOMIC_RELAXED, __HIP_MEMORY_SCOPE_AGENT
#define LDS_WAIT() asm volatile("s_waitcnt lgkmcnt(0)" ::: "memory")
#define VM_WAIT() asm volatile("s_waitcnt vmcnt(0)" ::: "memory")
__device__ __forceinline__ unsigned f2bf(float f) { unsigned u = __builtin_bit_cast(unsigned, f); return (u + 0x7fffu + ((u >> 16) & 1u)) >> 16; }
__device__ __forceinline__ unsigned pk2(float lo, float hi) { return pg8::cvt_pk_bf16(lo, hi); }
__device__ __forceinline__ float bflo(unsigned w) { return __builtin_bit_cast(float, w << 16); }
__device__ __forceinline__ float bfhi(unsigned w) { return __builtin_bit_cast(float, w & 0xffff0000u); }
__device__ __forceinline__ float bf1(bf16 h) { return __builtin_bit_cast(float, (unsigned)h << 16); }
__device__ __forceinline__ float sigmoidf_(float x) { return __builtin_amdgcn_rcpf(1.0f + __expf(-x)); }
template <int CTRL> __device__ __forceinline__ float dpp_add(float x) {
    return x + __builtin_bit_cast(float, __builtin_amdgcn_update_dpp(0, __builtin_bit_cast(int, x), CTRL, 0xf, 0xf, true));
}
__device__ __forceinline__ float red16(float x) {
    x = dpp_add<0xB1>(x);
    x = dpp_add<0x4E>(x);
    x = dpp_add<0x141>(x);
    x = dpp_add<0x140>(x);
    return x;
}
template <int CTRL, int RM> __device__ __forceinline__ float dpp_max(float x) {
    return fmaxf(x, __builtin_bit_cast(float, __builtin_amdgcn_update_dpp(__builtin_bit_cast(int, x), __builtin_bit_cast(int, x), CTRL, RM, 0xf, false)));
}
template <int CTRL, int RM> __device__ __forceinline__ float dpp_sum(float x) {
    return x + __builtin_bit_cast(float, __builtin_amdgcn_update_dpp(0, __builtin_bit_cast(int, x), CTRL, RM, 0xf, false));
}
__device__ __forceinline__ float wave_max_u(float x) {
    x = dpp_max<0xB1, 0xf>(x); x = dpp_max<0x4E, 0xf>(x); x = dpp_max<0x141, 0xf>(x); x = dpp_max<0x140, 0xf>(x);
    x = dpp_max<0x142, 0xa>(x); x = dpp_max<0x143, 0xc>(x);
    return __builtin_bit_cast(float, __builtin_amdgcn_readlane(__builtin_bit_cast(int, x), 63));
}
__device__ __forceinline__ float wave_sum_u(float x) {
    x = dpp_sum<0xB1, 0xf>(x); x = dpp_sum<0x4E, 0xf>(x); x = dpp_sum<0x141, 0xf>(x); x = dpp_sum<0x140, 0xf>(x);
    x = dpp_sum<0x142, 0xa>(x); x = dpp_sum<0x143, 0xc>(x);
    return __builtin_bit_cast(float, __builtin_amdgcn_readlane(__builtin_bit_cast(int, x), 63));
}
__device__ __forceinline__ float wave_sum(float v) { return wave_sum_u(v); }
__device__ __forceinline__ float bpermf(int srclane, float v) { return __builtin_bit_cast(float, __builtin_amdgcn_ds_bpermute(srclane << 2, __builtin_bit_cast(int, v))); }
__device__ __forceinline__ int bpermi(int srclane, int v) { return __builtin_amdgcn_ds_bpermute(srclane << 2, v); }

#define XB_TMO      128
#define XB_XCNT(j)  (256  + 64 * (j))
#define XB_XSUB(j)  (1280 + 64 * (j))
#define XB_XGEN(j)  (2304 + 64 * (j))
#define XB_TOP      3328
#define XB_TOPGEN   3392
#define XCD_BAR_WORDS 3456
#define XB_SPIN_CAP (1u << 20)

__device__ __forceinline__ unsigned xb_ld(unsigned* p)              { return __hip_atomic_load(p, __ATOMIC_RELAXED, __HIP_MEMORY_SCOPE_AGENT); }
__device__ __forceinline__ unsigned xb_add(unsigned* p, unsigned v) { return __hip_atomic_fetch_add(p, v, __ATOMIC_RELAXED, __HIP_MEMORY_SCOPE_AGENT); }
__device__ __forceinline__ unsigned xb_xcc_id() { return (unsigned)__builtin_amdgcn_s_getreg((3 << 11) | 20) & 0xFu; }
#define XB_SPIN(cond, bar) do { unsigned _sp = 0; while (cond) { __builtin_amdgcn_s_sleep(1); \
    if ((++_sp & 255u) == 0u) { if (xb_ld(&(bar)[XB_TMO])) break; if (_sp > XB_SPIN_CAP) { atomicAdd(&(bar)[XB_TMO], 1u); break; } } } } while (0)

struct XcdBarrier { unsigned* bar; unsigned x; volatile LAS unsigned* st; };

__device__ __forceinline__ XcdBarrier xcd_barrier_post(unsigned* bar, volatile LAS unsigned* st, bool t0) {
    XcdBarrier b; b.bar = bar; b.x = xb_xcc_id(); b.st = st;
    if (t0) (void)xb_add(&bar[XB_XCNT(b.x)], 1u);
    return b;
}
__device__ __forceinline__ void xcd_barrier_complete(unsigned* bar, unsigned x, unsigned& nloc, unsigned& nx) {
    const unsigned G = gridDim.x * gridDim.y * gridDim.z;
    unsigned sum, cnt, mine, sp = 0u;
    for (;;) {
        sum = 0u; cnt = 0u; mine = 0u;
#pragma unroll
        for (unsigned j = 0; j < 16; ++j) { const unsigned c = xb_ld(&bar[XB_XCNT(j)]); sum += c; cnt += (c > 0u) ? 1u : 0u; mine = (j == x) ? c : mine; }
        if (sum == G) break;
        __builtin_amdgcn_s_sleep(1);
        if ((++sp & 255u) == 0u) { if (xb_ld(&bar[XB_TMO])) break; if (sp > XB_SPIN_CAP) { atomicAdd(&bar[XB_TMO], 1u); break; } }
    }
    nloc = mine > 0u ? mine : 1u; nx = cnt > 0u ? cnt : 1u;
}
__device__ __forceinline__ void xcd_barrier(const XcdBarrier& b, bool t0) {
    asm volatile("s_waitcnt vmcnt(0)" ::: "memory");
    __syncthreads();
    if (t0) {
        unsigned* bar = b.bar;
        __builtin_amdgcn_s_waitcnt(0);
        unsigned nloc = b.st[0], nx = b.st[1];
        if (nloc == 0u) { xcd_barrier_complete(bar, b.x, nloc, nx); b.st[0] = nloc; b.st[1] = nx; }
        const unsigned old = xb_add(&bar[XB_XSUB(b.x)], 1u);
        const unsigned gen = old / nloc;
        if (old + 1u == (gen + 1u) * nloc) {
            __builtin_amdgcn_fence(__ATOMIC_RELEASE, "agent");
            asm volatile("s_waitcnt vmcnt(0)" ::: "memory");
            const unsigned og = xb_add(&bar[XB_TOP], 1u);
            const unsigned tg = og / nx;
            if (og + 1u == (tg + 1u) * nx) xb_add(&bar[XB_TOPGEN], 1u);
            else XB_SPIN(xb_ld(&bar[XB_TOPGEN]) == tg, bar);
            __builtin_amdgcn_fence(__ATOMIC_ACQUIRE, "agent");
            xb_add(&bar[XB_XGEN(b.x)], 1u);
            asm volatile("s_waitcnt vmcnt(0)" ::: "memory");
        } else {
            XB_SPIN(xb_ld(&bar[XB_XGEN(b.x)]) == gen, bar);
            __builtin_amdgcn_fence(__ATOMIC_ACQUIRE, "agent");
            asm volatile("s_waitcnt vmcnt(0)" ::: "memory");
        }
    }
    __syncthreads();
}

struct Frame {
    LAS unsigned char* lds;
    unsigned char* ws;
    const float* const* in;
    int tid, lane, wave;
    int vcu, G;
};
struct Args { const float* in[33]; float* out; unsigned char* ws; int ph_lo, ph_hi; };


namespace pg8 {
typedef unsigned u32x4 __attribute__((ext_vector_type(4)));
struct RowOrder : StaticOrder {
    int lat;
    __host__ __device__ void init_rows(int lat_, int N, int G_, int c_) { lat = lat_; init(lat_ ? NBATCH * SEQ : MALL, N, G_, c_); }
    __host__ __device__ bool next(int i, Unit& u) const { if (!StaticOrder::next(i, u)) return false; if (lat) u.pm = 33 * (u.pm >> 5) + 1 + (u.pm & 31); return true; }
};
#define EPI_LOOP_ROWS for (int ai = 0; ai < 2; ++ai) _Pragma("unroll") for (int m = 0; m < 4; ++m)
#define EPI_PIN asm volatile("" ::: "memory")

struct EpiStoreBf16 {
    static constexpr bool PERM = true, AFTER_DRAIN = false;
    bf16_t* O; int ldc;
    __device__ __forceinline__ void operator()(const f32x4 (&acc)[2][2][4][2], const Unit& u, int wr, int wc, int fr, int fq) const {
        const int row0 = u.pm * BM + wr * 64 + fr, col0 = u.pn * BM + wc * 32 + 8 * fq;
#pragma unroll
        EPI_LOOP_ROWS { bf16_t* rowp = O + (size_t)(row0 + ai * HALF + m * 16) * ldc + col0;
#pragma unroll
            for (int bj = 0; bj < 2; ++bj) { const f32x4 v0 = acc[ai][bj][m][0], v1 = acc[ai][bj][m][1];
                u32x4 w; w.x = cvt_pk_bf16(v0[0], v0[1]); w.y = cvt_pk_bf16(v0[2], v0[3]); w.z = cvt_pk_bf16(v1[0], v1[1]); w.w = cvt_pk_bf16(v1[2], v1[3]);
                *(u32x4*)(rowp + bj * HALF) = w; } }
    }
};
struct EpiGate {
    static constexpr bool PERM = true, AFTER_DRAIN = false;
    bf16_t* O; int ldc; const float* bias;
    __device__ __forceinline__ void operator()(const f32x4 (&acc)[2][2][4][2], const Unit& u, int wr, int wc, int fr, int fq) const {
        const int row0 = u.pm * BM + wr * 64 + fr, col0 = u.pn * BM + wc * 32 + 8 * fq;
        f32x4 bv[2][2];
#pragma unroll
        for (int bj = 0; bj < 2; ++bj)
#pragma unroll
            for (int n = 0; n < 2; ++n) bv[bj][n] = *(const f32x4*)(bias + col0 + bj * HALF + 4 * n);
#pragma unroll
        EPI_LOOP_ROWS { EPI_PIN; bf16_t* rowp = O + (size_t)(row0 + ai * HALF + m * 16) * ldc + col0;
#pragma unroll
            for (int bj = 0; bj < 2; ++bj) { f32x4 v0 = acc[ai][bj][m][0] + bv[bj][0], v1 = acc[ai][bj][m][1] + bv[bj][1];
#pragma unroll
                for (int e = 0; e < 4; ++e) { v0[e] = __builtin_amdgcn_rcpf(1.0f + __expf(-v0[e])); v1[e] = __builtin_amdgcn_rcpf(1.0f + __expf(-v1[e])); }
                u32x4 w; w.x = cvt_pk_bf16(v0[0], v0[1]); w.y = cvt_pk_bf16(v0[2], v0[3]); w.z = cvt_pk_bf16(v1[0], v1[1]); w.w = cvt_pk_bf16(v1[2], v1[3]);
                *(u32x4*)(rowp + bj * HALF) = w; } }
    }
};
__device__ __forceinline__ float bf_lo(unsigned w) { return __builtin_bit_cast(float, w << 16); }
__device__ __forceinline__ float bf_hi(unsigned w) { return __builtin_bit_cast(float, w & 0xffff0000u); }
struct EpiMulAdd {
    static constexpr bool PERM = true, AFTER_DRAIN = false;
    bf16_t* O; const bf16_t* Gt; const bf16_t* Ad; int ldc;
    __device__ __forceinline__ void operator()(const f32x4 (&acc)[2][2][4][2], const Unit& u, int wr, int wc, int fr, int fq) const {
        const int row0 = u.pm * BM + wr * 64 + fr, col0 = u.pn * BM + wc * 32 + 8 * fq;
#pragma unroll
        EPI_LOOP_ROWS { EPI_PIN; const size_t ro = (size_t)(row0 + ai * HALF + m * 16) * ldc + col0;
#pragma unroll
            for (int bj = 0; bj < 2; ++bj) { const f32x4 v0 = acc[ai][bj][m][0], v1 = acc[ai][bj][m][1];
                const u32x4 g = *(const u32x4*)(Gt + ro + bj * HALF);
                float o[8];
                o[0] = bf_lo(g.x) * v0[0]; o[1] = bf_hi(g.x) * v0[1]; o[2] = bf_lo(g.y) * v0[2]; o[3] = bf_hi(g.y) * v0[3];
                o[4] = bf_lo(g.z) * v1[0]; o[5] = bf_hi(g.z) * v1[1]; o[6] = bf_lo(g.w) * v1[2]; o[7] = bf_hi(g.w) * v1[3];
                if (Ad) { const u32x4 a = *(const u32x4*)(Ad + ro + bj * HALF);
                    o[0] += bf_lo(a.x); o[1] += bf_hi(a.x); o[2] += bf_lo(a.y); o[3] += bf_hi(a.y); o[4] += bf_lo(a.z); o[5] += bf_hi(a.z); o[6] += bf_lo(a.w); o[7] += bf_hi(a.w); }
                u32x4 w; w.x = cvt_pk_bf16(o[0], o[1]); w.y = cvt_pk_bf16(o[2], o[3]); w.z = cvt_pk_bf16(o[4], o[5]); w.w = cvt_pk_bf16(o[6], o[7]);
                *(u32x4*)(O + ro + bj * HALF) = w; } }
    }
};
struct EpiResid {
    static constexpr bool PERM = true, AFTER_DRAIN = false;
    bf16_t* X; const float* gate;
    const float* xin; const float* cin;
    __device__ __forceinline__ void operator()(const f32x4 (&acc)[2][2][4][2], const Unit& u, int wr, int wc, int fr, int fq) const {
        const int col0 = u.pn * BM + wc * 32 + 8 * fq;
        const int bb = u.pm / 33, pt = u.pm - bb * 33, mr = (pt == 0) ? 2 : bb;
        const float* gp = gate + (size_t)mr * 12288 + col0;
        const float* sbase = xin ? (pt == 0 ? cin + (size_t)bb * CTXL * DM : xin + ((size_t)bb * SEQ + (size_t)(pt - 1) * BM) * DM) : nullptr;
        f32x4 gv[2][2];
#pragma unroll
        for (int bj = 0; bj < 2; ++bj)
#pragma unroll
            for (int n = 0; n < 2; ++n) gv[bj][n] = *(const f32x4*)(gp + bj * HALF + n * 4);
#pragma unroll
        EPI_LOOP_ROWS { EPI_PIN; const int rl = wr * 64 + fr + ai * HALF + m * 16; bf16_t* rowp = X + (size_t)(u.pm * BM + rl) * DM + col0;
#pragma unroll
            for (int bj = 0; bj < 2; ++bj) { f32x4 s0, s1;
                if (sbase) { const float* srow = sbase + (size_t)rl * DM + col0 + bj * HALF; s0 = *(const f32x4*)srow; s1 = *(const f32x4*)(srow + 4); }
                else { const u32x4 w = *(const u32x4*)(rowp + bj * HALF);
                    s0 = (f32x4){__builtin_bit_cast(float, w.x << 16), __builtin_bit_cast(float, w.x & 0xffff0000u), __builtin_bit_cast(float, w.y << 16), __builtin_bit_cast(float, w.y & 0xffff0000u)};
                    s1 = (f32x4){__builtin_bit_cast(float, w.z << 16), __builtin_bit_cast(float, w.z & 0xffff0000u), __builtin_bit_cast(float, w.w << 16), __builtin_bit_cast(float, w.w & 0xffff0000u)}; }
                const f32x4 r0 = s0 + gv[bj][0] * acc[ai][bj][m][0], r1 = s1 + gv[bj][1] * acc[ai][bj][m][1];
                u32x4 o; o.x = cvt_pk_bf16(r0[0], r0[1]); o.y = cvt_pk_bf16(r0[2], r0[3]); o.z = cvt_pk_bf16(r1[0], r1[1]); o.w = cvt_pk_bf16(r1[2], r1[3]);
                *(u32x4*)(rowp + bj * HALF) = o; } }
    }
};
struct EpiF32 {
    static constexpr bool PERM = false, AFTER_DRAIN = false;
    float* C; int ldc;
    __device__ __forceinline__ void operator()(const f32x4 (&acc)[2][2][4][2], const Unit& u, int wr, int wc, int fr, int fq) const {
        const int row0 = u.pm * BM + wr * 64 + fr, col0 = u.pn * BM + wc * 32 + 4 * fq;
#pragma unroll
        EPI_LOOP_ROWS { float* rowp = C + (size_t)(row0 + ai * HALF + m * 16) * ldc + col0;
#pragma unroll
            for (int bj = 0; bj < 2; ++bj)
#pragma unroll
                for (int n = 0; n < 2; ++n) *(f32x4*)(rowp + bj * HALF + n * 16) = acc[ai][bj][m][n]; }
    }
};
struct EpiCtxF32 {
    static constexpr bool PERM = false, AFTER_DRAIN = false;
    float* C; int ldc;
    __device__ __forceinline__ void operator()(const f32x4 (&acc)[2][2][4][2], const Unit& u, int wr, int wc, int fr, int fq) const {
        const int row0 = (u.pm ? BM : 0) + wr * 64 + fr, col0 = u.pn * BM + wc * 32 + 4 * fq;
#pragma unroll
        EPI_LOOP_ROWS { float* rowp = C + (size_t)(row0 + ai * HALF + m * 16) * ldc + col0;
#pragma unroll
            for (int bj = 0; bj < 2; ++bj)
#pragma unroll
                for (int n = 0; n < 2; ++n) *(f32x4*)(rowp + bj * HALF + n * 16) = acc[ai][bj][m][n]; }
    }
};
struct CtxOrder {
    int u0;
    __host__ __device__ bool next(int i, Unit& u) const { if (i != 0 || u0 < 0) return false; u.pm = (u0 >> 3) ? 33 : 0; u.pn = u0 & 7; return true; }
    __device__ __forceinline__ void a_ready(const Unit&) const {}
    __device__ __forceinline__ void done(const Unit&) const {}
};
struct EpiF16 {
    static constexpr bool PERM = true, AFTER_DRAIN = false;
    _Float16* C; int ldc;
    __device__ __forceinline__ void operator()(const f32x4 (&acc)[2][2][4][2], const Unit& u, int wr, int wc, int fr, int fq) const {
        typedef _Float16 h2 __attribute__((ext_vector_type(2)));
        const int row0 = u.pm * BM + wr * 64 + fr, col0 = u.pn * BM + wc * 32 + 8 * fq;
#pragma unroll
        EPI_LOOP_ROWS { _Float16* rowp = C + (size_t)(row0 + ai * HALF + m * 16) * ldc + col0;
#pragma unroll
            for (int bj = 0; bj < 2; ++bj) { const f32x4 v0 = acc[ai][bj][m][0], v1 = acc[ai][bj][m][1];
                u32x4 w; w.x = __builtin_bit_cast(unsigned, (h2){(_Float16)v0[0], (_Float16)v0[1]}); w.y = __builtin_bit_cast(unsigned, (h2){(_Float16)v0[2], (_Float16)v0[3]});
                w.z = __builtin_bit_cast(unsigned, (h2){(_Float16)v1[0], (_Float16)v1[1]}); w.w = __builtin_bit_cast(unsigned, (h2){(_Float16)v1[2], (_Float16)v1[3]});
                *(u32x4*)(rowp + bj * HALF) = w; } }
    }
};
struct EpiQ {
    static constexpr bool PERM = true, AFTER_DRAIN = false;
    bf16_t* Q; const f32x2* rope; float qscale;
    __device__ __forceinline__ void operator()(const f32x4 (&acc)[2][2][4][2], const Unit& u, int wr, int wc, int fr, int fq) const {
        const int bb = u.pm / 33, tp0 = (u.pm - bb * 33) * BM + wr * 64 + fr, col0 = u.pn * BM + wc * 32 + 8 * fq;
#pragma unroll
        for (int bj = 0; bj < 2; ++bj) { const int c = col0 + bj * HALF, hd = c / QKD, d = c - hd * QKD;
#pragma unroll
            EPI_LOOP_ROWS { EPI_PIN; const int tp = tp0 + ai * HALF + m * 16;
                f32x4 v0 = acc[ai][bj][m][0], v1 = acc[ai][bj][m][1];
                if (d >= 64) { const int i0 = (d - 64) >> 1; const f32x2* rp = rope + (size_t)tp * 16 + i0;
                    const f32x2 c0 = rp[0], c1 = rp[1], c2 = rp[2], c3 = rp[3];
                    float a, b;
                    a = v0[0]; b = v0[1]; v0[0] = a * c0.x - b * c0.y; v0[1] = a * c0.y + b * c0.x;
                    a = v0[2]; b = v0[3]; v0[2] = a * c1.x - b * c1.y; v0[3] = a * c1.y + b * c1.x;
                    a = v1[0]; b = v1[1]; v1[0] = a * c2.x - b * c2.y; v1[1] = a * c2.y + b * c2.x;
                    a = v1[2]; b = v1[3]; v1[2] = a * c3.x - b * c3.y; v1[3] = a * c3.y + b * c3.x; }
                v0 = v0 * qscale; v1 = v1 * qscale;
                u32x4 w; w.x = cvt_pk_bf16(v0[0], v0[1]); w.y = cvt_pk_bf16(v0[2], v0[3]); w.z = cvt_pk_bf16(v1[0], v1[1]); w.w = cvt_pk_bf16(v1[2], v1[3]);
                *(u32x4*)(Q + ((size_t)(bb * NH + hd) * TPB + tp) * QKD + d) = w; } }
    }
};
struct EpiKV {
    static constexpr bool PERM = true, AFTER_DRAIN = false;
    bf16_t* K; bf16_t* V;
    __device__ __forceinline__ void operator()(const f32x4 (&acc)[2][2][4][2], const Unit& u, int wr, int wc, int fr, int fq) const {
        const int bb = u.pm / 33, tp0 = (u.pm - bb * 33) * BM + wr * 64 + fr;
        const bool isK = wc < 2;
        bf16_t* base = isK ? K : V; const int pitch = isK ? QKD : 64, doff = 32 * (wc & 1) + 8 * fq;
#pragma unroll
        for (int bj = 0; bj < 2; ++bj) { const int hd = 2 * u.pn + bj;
            bf16_t* hb = base + (size_t)(bb * NH + hd) * TPB * pitch;
#pragma unroll
            EPI_LOOP_ROWS { EPI_PIN; const int tp = tp0 + ai * HALF + m * 16;
                const f32x4 v0 = acc[ai][bj][m][0], v1 = acc[ai][bj][m][1];
                u32x4 w; w.x = cvt_pk_bf16(v0[0], v0[1]); w.y = cvt_pk_bf16(v0[2], v0[3]); w.z = cvt_pk_bf16(v1[0], v1[1]); w.w = cvt_pk_bf16(v1[2], v1[3]);
                *(u32x4*)((char*)hb + (unsigned)((tp * pitch + doff) * 2)) = w; } }
    }
};
}

struct TItem { const float* W; bf16* WT; int K, ldw, c0, N, mapq, item; };
__device__ __forceinline__ void p0_item_load(const TItem& T, int lane, f32x4 (&x)[8]) {
    const int nblk = T.N / 32, kb = T.item / nblk, nb = T.item - kb * nblk, k0 = 64 * kb, n0 = 32 * nb;
    const float* p = T.W + (size_t)(k0 + (lane >> 3)) * T.ldw + T.c0 + n0 + (lane & 7) * 4;
#pragma unroll
    for (int i = 0; i < 8; ++i) x[i] = *(const GAS f32x4*)(p + (size_t)(8 * i) * T.ldw);
}
__device__ __forceinline__ void p0_item_finish(const TItem& T, const f32x4 (&x)[8], LAS float* scr, int lane) {
    const int nblk = T.N / 32, kb = T.item / nblk, nb = T.item - kb * nblk, k0 = 64 * kb, n0 = 32 * nb;
#pragma unroll
    for (int i = 0; i < 8; ++i) { LAS float* d = scr + (8 * i + (lane >> 3)) * 33 + (lane & 7) * 4; d[0] = x[i].x; d[1] = x[i].y; d[2] = x[i].z; d[3] = x[i].w; }
    LDS_WAIT(); asm volatile("" ::: "memory");
    const int c = lane & 7;
#pragma unroll
    for (int j = 0; j < 4; ++j) { const int n = (lane >> 3) + 8 * j; const LAS float* s = scr + (8 * c) * 33 + n;
        v4u o; o.x = pk2(s[0 * 33], s[1 * 33]); o.y = pk2(s[2 * 33], s[3 * 33]); o.z = pk2(s[4 * 33], s[5 * 33]); o.w = pk2(s[6 * 33], s[7 * 33]);
        int nn = n0 + n;
        if (T.mapq) { const int hd = nn / QKD, d = nn - hd * QKD; if (d >= 64) { const int i = (d - 64) & 15, s2 = (d - 64) >> 4; nn = hd * QKD + 64 + 2 * i + s2; } }
        *(GAS v4u*)(T.WT + (size_t)nn * T.K + k0 + 8 * c) = o; }
    LDS_WAIT(); asm volatile("" ::: "memory");
}

__device__ __forceinline__ const float* karg(int i);
constexpr int TB_INA = (DM / 128) * ((INA + 127) / 128), TB_G = (DM / 128) * (DM / 128), TB_BR = (RW / 128) * (DM / 128), TB_UQ = (512 / 128) * (NQ / 128), TB_UKV = (256 / 128) * (NKV / 128);
constexpr int TB_N = TB_INA + 2 * TB_G + 2 * TB_BR + TB_G + TB_UQ + TB_UKV;
constexpr int TI_LR = 1 * (RW / 32), TI_N = 4 * TI_LR;
__device__ __forceinline__ TItem p0_resolve_big(unsigned char* ws, int git) {
    const int l = git / TB_N; int r = git - l * TB_N; TItem T; T.mapq = 0; T.c0 = 0;
    if (r < TB_INA) { T.W = karg(7) + (size_t)l * DM * INC; T.K = DM; T.ldw = INC; T.N = INA; T.WT = (bf16*)(ws + WS_WINA) + (size_t)l * INA_P * DM; T.item = r; return T; } r -= TB_INA;
    if (r < TB_G) { T.W = karg(7) + (size_t)l * DM * INC; T.K = DM; T.ldw = INC; T.c0 = INA; T.N = DM; T.WT = (bf16*)(ws + WS_WGA) + (size_t)l * DM * DM; T.item = r; return T; } r -= TB_G;
    if (r < TB_G) { T.W = karg(7) + (size_t)l * DM * INC; T.K = DM; T.ldw = INC; T.c0 = INA + DM; T.N = DM; T.WT = (bf16*)(ws + WS_WGB) + (size_t)l * DM * DM; T.item = r; return T; } r -= TB_G;
    if (r < TB_BR) { T.W = karg(24) + (size_t)l * RW * DM; T.K = RW; T.ldw = DM; T.N = DM; T.WT = (bf16*)(ws + WS_WA) + (size_t)l * DM * RW; T.item = r; return T; } r -= TB_BR;
    if (r < TB_BR) { T.W = karg(25) + (size_t)l * RW * DM; T.K = RW; T.ldw = DM; T.N = DM; T.WT = (bf16*)(ws + WS_WB) + (size_t)l * DM * RW; T.item = r; return T; } r -= TB_BR;
    if (r < TB_G) { T.W = karg(26) + (size_t)l * DM * DM; T.K = DM; T.ldw = DM; T.N = DM; T.WT = (bf16*)(ws + WS_WO) + (size_t)l * DM * DM; T.item = r; return T; } r -= TB_G;
    if (r < TB_UQ) { T.W = karg(21) + (size_t)l * 512 * NQ; T.K = 512; T.ldw = NQ; T.N = NQ; T.WT = (bf16*)(ws + WS_WUQ) + (size_t)l * NQ * 512; T.item = r; T.mapq = 1; return T; } r -= TB_UQ;
    { T.W = karg(23) + (size_t)l * 256 * NKV; T.K = 256; T.ldw = NKV; T.N = NKV; T.WT = (bf16*)(ws + WS_WUKV) + (size_t)l * NKV * 256; T.item = r; return T; }
}
__device__ __forceinline__ void p0_big_load(const TItem& T, int tid, f32x4 (&x)[8]) {
    const int nblk = (T.N + 127) / 128, kb = T.item / nblk, nb = T.item - kb * nblk, k0 = 128 * kb, col = 128 * nb + (tid & 31) * 4;
    const float* p = T.W + (size_t)(k0 + (tid >> 5)) * T.ldw + T.c0 + col; const bool ok = col < T.N;
#pragma unroll
    for (int i = 0; i < 8; ++i) x[i] = ok ? *(const GAS f32x4*)(p + (size_t)(16 * i) * T.ldw) : (f32x4){0.f, 0.f, 0.f, 0.f};
}
__device__ __forceinline__ void p0_big_finish(const TItem& T, const f32x4 (&x)[8], LAS float* tile, int tid) {
    const int nblk = (T.N + 127) / 128, kb = T.item / nblk, nb = T.item - kb * nblk, k0 = 128 * kb, n0 = 128 * nb;
    __syncthreads();
#pragma unroll
    for (int i = 0; i < 8; ++i) *(LAS f32x4*)(tile + ((tid >> 5) + 16 * i) * 132 + (tid & 31) * 4) = x[i];
    __syncthreads();
    const int n = tid & 127, cg = tid >> 7; int nn = n0 + n;
    if (nn < T.N) {
        if (T.mapq) { const int hd = nn / QKD, d = nn - hd * QKD; if (d >= 64) { const int i = (d - 64) & 15, s2 = (d - 64) >> 4; nn = hd * QKD + 64 + 2 * i + s2; } }
#pragma unroll
        for (int c = 0; c < 4; ++c) { const LAS float* s = tile + (32 * cg + 8 * c) * 132 + n;
            v4u o; o.x = pk2(s[0 * 132], s[1 * 132]); o.y = pk2(s[2 * 132], s[3 * 132]); o.z = pk2(s[4 * 132], s[5 * 132]); o.w = pk2(s[6 * 132], s[7 * 132]);
            *(GAS v4u*)(T.WT + (size_t)nn * T.K + k0 + 32 * cg + 8 * c) = o; } }
}
__device__ __forceinline__ TItem p0_resolve(unsigned char* ws, int git) {
    const int l = git / TI_N; int r = git - l * TI_N; TItem T; T.mapq = 0; T.c0 = 0;
    const int which = r / TI_LR, d = which & 1, isa = which >> 1; r -= which * TI_LR;
    T.W = (isa ? karg(13) : karg(11)) + (size_t)(l * 2 + d) * 64 * RW; T.K = 64; T.ldw = RW; T.N = RW; T.WT = (bf16*)(ws + (isa ? WS_AUP : WS_WUP)) + (size_t)(l * 2 + d) * RW * 64; T.item = r; return T;
}
constexpr int NWI_INA = (DM / 64) * (INA / 32), NWI_G = (DM / 64) * (DM / 32), NWI_BR = (RW / 64) * (DM / 32), NWI_UQ = (512 / 64) * (NQ / 32), NWI_UKV = (256 / 64) * (NKV / 32);
constexpr int NW_ITEMS = NWI_INA + 2 * NWI_G + 2 * NWI_BR + NWI_G + NWI_UQ + NWI_UKV + TI_N;
__device__ __forceinline__ TItem p0_resolve_wave(unsigned char* ws, int l, int r) {
    TItem T; T.mapq = 0; T.c0 = 0;
    if (r < NWI_INA) { T.W = karg(7) + (size_t)l * DM * INC; T.K = DM; T.ldw = INC; T.N = INA; T.WT = (bf16*)(ws + WS_WINA) + (size_t)l * INA_P * DM; T.item = r; return T; } r -= NWI_INA;
    if (r < NWI_G) { T.W = karg(7) + (size_t)l * DM * INC; T.K = DM; T.ldw = INC; T.c0 = INA; T.N = DM; T.WT = (bf16*)(ws + WS_WGA) + (size_t)l * DM * DM; T.item = r; return T; } r -= NWI_G;
    if (r < NWI_G) { T.W = karg(7) + (size_t)l * DM * INC; T.K = DM; T.ldw = INC; T.c0 = INA + DM; T.N = DM; T.WT = (bf16*)(ws + WS_WGB) + (size_t)l * DM * DM; T.item = r; return T; } r -= NWI_G;
    if (r < NWI_BR) { T.W = karg(24) + (size_t)l * RW * DM; T.K = RW; T.ldw = DM; T.N = DM; T.WT = (bf16*)(ws + WS_WA) + (size_t)l * DM * RW; T.item = r; return T; } r -= NWI_BR;
    if (r < NWI_BR) { T.W = karg(25) + (size_t)l * RW * DM; T.K = RW; T.ldw = DM; T.N = DM; T.WT = (bf16*)(ws + WS_WB) + (size_t)l * DM * RW; T.item = r; return T; } r -= NWI_BR;
    if (r < NWI_G) { T.W = karg(26) + (size_t)l * DM * DM; T.K = DM; T.ldw = DM; T.N = DM; T.WT = (bf16*)(ws + WS_WO) + (size_t)l * DM * DM; T.item = r; return T; } r -= NWI_G;
    if (r < NWI_UQ) { T.W = karg(21) + (size_t)l * 512 * NQ; T.K = 512; T.ldw = NQ; T.N = NQ; T.WT = (bf16*)(ws + WS_WUQ) + (size_t)l * NQ * 512; T.item = r; T.mapq = 1; return T; } r -= NWI_UQ;
    if (r < NWI_UKV) { T.W = karg(23) + (size_t)l * 256 * NKV; T.K = 256; T.ldw = NKV; T.N = NKV; T.WT = (bf16*)(ws + WS_WUKV) + (size_t)l * NKV * 256; T.item = r; return T; } r -= NWI_UKV;
    return p0_resolve(ws, l * TI_N + r);
}
__device__ __forceinline__ void p0_prologue(Frame& F, int l_lo, int l_hi, int svcu, int sG, int with_tr = 1) {
    LAS float* scr = (LAS float*)(F.lds + F.wave * 16384);
    const int gw = svcu * NWAVES + F.wave, NGW = sG * NWAVES;
    unsigned char* ws = F.ws;
    for (int rp_ = 0; rp_ < (DBG_REPEAT == 102 ? 2 : 1); ++rp_)
    { float* modw = (float*)(ws + WS_CTL + CTL_MOD_OFF); const float* adaw = karg(4); const float* adab = karg(5); const float* cin = karg(1); const float* cctx = karg(3);
      LAS float* SIL = (LAS float*)F.lds;
      LAS f32x2* part = (LAS f32x2*)(F.lds + 32768);
      if (svcu >= 0 && l_lo * 96 + svcu < l_hi * 96) {
          for (int i = F.tid; i < 3 * DM; i += 512) { const int r = i >> 11, k = i & 2047; const float c = r < 2 ? cin[r * DM + k] : cctx[k]; SIL[i] = c / (1.f + __expf(-c)); }
          __syncthreads(); }
      if (svcu >= 0) for (int uu = l_lo * 96 + svcu; uu < l_hi * 96; uu += sG) { const int cb = uu % 96, l = uu / 96;
          const int n0 = cb * 128 + F.lane * 2; const float* aw = adaw + (size_t)l * DM * 12288 + n0;
          f32x2 a0 = {0, 0}, a1 = a0, a2 = a0;
#pragma unroll 1
          for (int k0 = F.wave * 256; k0 < F.wave * 256 + 256; k0 += 16) { f32x2 w[16];
#pragma unroll
              for (int j = 0; j < 16; ++j) w[j] = *(const GAS f32x2*)(aw + (size_t)(k0 + j) * 12288);
#pragma unroll
              for (int j = 0; j < 16; ++j) { a0 = a0 + w[j] * SIL[k0 + j]; a1 = a1 + w[j] * SIL[DM + k0 + j]; a2 = a2 + w[j] * SIL[2 * DM + k0 + j]; } }
          __syncthreads();
          part[(F.wave * 3 + 0) * 64 + F.lane] = a0; part[(F.wave * 3 + 1) * 64 + F.lane] = a1; part[(F.wave * 3 + 2) * 64 + F.lane] = a2;
          __syncthreads();
          if (F.wave < 3) { f32x2 s = *(const GAS f32x2*)(adab + (size_t)l * 12288 + n0);
#pragma unroll
              for (int w8 = 0; w8 < 8; ++w8) s = s + part[(w8 * 3 + F.wave) * 64 + F.lane];
              *(GAS f32x2*)(modw + ((size_t)l * 3 + F.wave) * 12288 + n0) = s; }
          __syncthreads(); } }
    if (with_tr) for (int rp_ = 0; rp_ < (DBG_REPEAT == 101 ? 2 : 1); ++rp_)
    { unsigned* ctr = (unsigned*)(ws + WS_CTL) + 2048 + 64 * rp_ + 128 * l_lo; LAS float* tile = (LAS float*)F.lds; LAS int* slot = (LAS int*)(F.lds + 128 * 132 * 4);
#define P0_GRAB(dst) do { __syncthreads(); if (F.tid == 0) *slot = (int)__hip_atomic_fetch_add(ctr, 1u, __ATOMIC_RELAXED, __HIP_MEMORY_SCOPE_AGENT); __syncthreads(); dst = *slot; } while (0)
      const int it_end = l_hi * TB_N;
      int it; P0_GRAB(it); it += l_lo * TB_N; f32x4 xa[8], xb[8]; TItem T, Tn;
      if (it < it_end) { T = p0_resolve_big(ws, it); p0_big_load(T, F.tid, xa); }
      while (it < it_end) { int itn; P0_GRAB(itn); itn += l_lo * TB_N; const bool more = itn < it_end;
          if (more) { Tn = p0_resolve_big(ws, itn); p0_big_load(Tn, F.tid, xb); }
          p0_big_finish(T, xa, tile, F.tid);
          if (more) { T = Tn;
#pragma unroll
              for (int i = 0; i < 8; ++i) xa[i] = xb[i]; }
          it = itn; }
#undef P0_GRAB
      __syncthreads();
      if (svcu >= 0) for (int itw = l_lo * TI_N + gw; itw < l_hi * TI_N; itw += NGW) { f32x4 xw[8]; const TItem Tw = p0_resolve(ws, itw); p0_item_load(Tw, F.lane, xw); p0_item_finish(Tw, xw, scr, F.lane); }
    }
    const int gt = gw * 64 + F.lane, NGT = NGW * 64;
    { const float* gup = karg(14);
    if (svcu >= 0) for (int i = l_lo * 2 * 32 * RW + gt; i < l_hi * 2 * 32 * RW; i += NGT) { const int ch = i & 1023, r = (i >> 10) & 31, ld = i >> 15;
        ((bf16*)(ws + WS_GUP))[((size_t)ld * RW + ch) * 32 + r] = (bf16)f2bf(gup[i]); } }
    if (svcu >= 0) for (int i = l_lo * ((INA_P - INA) * DM / 8) + gt; i < l_hi * ((INA_P - INA) * DM / 8); i += NGT) { const int l = i / ((INA_P - INA) * DM / 8), r = i - l * ((INA_P - INA) * DM / 8);
        ((GAS v4u*)((bf16*)(ws + WS_WINA) + ((size_t)l * INA_P + INA) * DM))[r] = (v4u){0u, 0u, 0u, 0u}; }
    { f32x2* rt = (f32x2*)(ws + WS_ROPE);
      if (l_lo == 0 && svcu >= 0) for (int i = gt; i < TPB * 16; i += NGT) { const int tp = i >> 4, k = i & 15; f32x2 o = {1.f, 0.f};
          if (tp >= CTXL) { const int t = tp - CTXL, row = t >> 6, col = t & 63, j = k & 7; const float fr = powf(10000.0f, -(float)j / 8.0f);
              const float ang = (float)(k < 8 ? row : col) * fr; o.x = cosf(ang); o.y = sinf(ang); }
          rt[i] = o; } }
    for (int rp_ = 0; rp_ < (DBG_REPEAT == 103 ? 2 : 1); ++rp_)
    { LAS float* KEY = (LAS float*)F.lds;
      LAS float* WQT = (LAS float*)(F.lds + 65536);
      const float* pkeys = karg(29); const float* pwq = karg(28);
      __syncthreads();
      if (svcu >= 0) for (int uu = l_lo * 512 + svcu; uu < l_hi * 512; uu += sG) { const int kb = uu & 31, hp = (uu >> 5) & 15, l = uu >> 9;
          const GAS f32x4* ksrc = (const GAS f32x4*)(pkeys + ((size_t)l * 16 + hp) * 16384);
          for (int i = F.tid; i < 4096; i += 512) ((LAS f32x4*)KEY)[i] = ksrc[i];
          for (int i = F.tid; i < 2048; i += 512) { const int kk = i >> 5, d4 = i & 31;
              *(LAS f32x4*)(WQT + kk * 132 + d4 * 4) = *(const GAS f32x4*)(pwq + ((size_t)l * DM + kb * 64 + kk) * DM + hp * 128 + d4 * 4); }
          __syncthreads();
          const int kq = F.tid & 15, keyq = F.tid >> 4;
          float acc[4][4];
#pragma unroll
          for (int j = 0; j < 4; ++j)
#pragma unroll
              for (int i = 0; i < 4; ++i) acc[j][i] = 0.f;
          for (int d = 0; d < 128; d += 4) { f32x4 w[4], q[4];
#pragma unroll
              for (int i = 0; i < 4; ++i) w[i] = *(LAS f32x4*)(WQT + (kq + 16 * i) * 132 + d);
#pragma unroll
              for (int j = 0; j < 4; ++j) q[j] = *(LAS f32x4*)(KEY + (4 * keyq + j) * 128 + d);
#pragma unroll
              for (int j = 0; j < 4; ++j)
#pragma unroll
                  for (int i = 0; i < 4; ++i) acc[j][i] += q[j].x * w[i].x + q[j].y * w[i].y + q[j].z * w[i].z + q[j].w * w[i].w; }
          bf16* dst = (bf16*)(ws + WS_WQK) + ((size_t)l * DM + hp * 128 + 4 * keyq) * DM + kb * 64 + kq;
#pragma unroll
          for (int j = 0; j < 4; ++j)
#pragma unroll
              for (int i = 0; i < 4; ++i) dst[(size_t)j * DM + 16 * i] = (bf16)f2bf(acc[j][i]);
          __syncthreads(); } }
}

__device__ __forceinline__ const float* modnorm_src(int m, const float* X, const float* xin, const float* cin) {
    const int b = m / TPB, tp = m - b * TPB;
    return xin ? (tp < CTXL ? cin + ((size_t)b * CTXL + tp) * DM : xin + ((size_t)b * SEQ + (tp - CTXL)) * DM) : X + (size_t)m * DM;
}
__device__ __forceinline__ void modnorm_phase_bf(Frame& F, const bf16* X, const float* g, const float* mod  , int chunk_sh, bf16* H, int skip_ctx) {
    const int gw = F.vcu * NWAVES + F.wave, NGW = F.G * NWAVES;
    int m = gw; while (m < MALL && skip_ctx && (m % TPB) < CTXL) m += NGW;
    v4u v[4]; f32x4 ga[8], sb[8]; int mr_cur = -1;
    if (m < MALL) { const GAS v4u* xr = (const GAS v4u*)(X + (size_t)m * DM) + F.lane;
#pragma unroll
        for (int j = 0; j < 4; ++j) v[j] = xr[64 * j]; }
    while (m < MALL) {
        int mn = m + NGW; while (mn < MALL && skip_ctx && (mn % TPB) < CTXL) mn += NGW;
        v4u nv[4];
        if (mn < MALL) { const GAS v4u* xr = (const GAS v4u*)(X + (size_t)mn * DM) + F.lane;
#pragma unroll
            for (int j = 0; j < 4; ++j) nv[j] = xr[64 * j]; }
        const int b = m / TPB, tp = m - b * TPB, mr = tp < CTXL ? 2 : b;
        if (mr != mr_cur) { mr_cur = mr; const float* sh = mod + (size_t)mr * 12288 + chunk_sh * DM; const float* sc = sh + DM;
#pragma unroll
            for (int q = 0; q < 8; ++q) { const int c = (F.lane + 64 * (q >> 1)) * 8 + 4 * (q & 1); const f32x4 gg = *(const GAS f32x4*)(g + c), s1 = *(const GAS f32x4*)(sc + c); ga[q] = gg * (s1 + 1.0f); sb[q] = *(const GAS f32x4*)(sh + c); } }
        float x[4][8]; float s = 0.f;
#pragma unroll
        for (int j = 0; j < 4; ++j) { x[j][0] = bflo(v[j].x); x[j][1] = bfhi(v[j].x); x[j][2] = bflo(v[j].y); x[j][3] = bfhi(v[j].y); x[j][4] = bflo(v[j].z); x[j][5] = bfhi(v[j].z); x[j][6] = bflo(v[j].w); x[j][7] = bfhi(v[j].w);
#pragma unroll
            for (int e = 0; e < 8; ++e) s += x[j][e] * x[j][e]; }
        const float rs = rsqrtf(wave_sum(s) * (1.f / DM) + NORM_EPS);
        GAS v4u* o8 = (GAS v4u*)(H + (size_t)m * DM) + F.lane;
#pragma unroll
        for (int j = 0; j < 4; ++j) { float y[8];
#pragma unroll
            for (int e = 0; e < 8; ++e) y[e] = (x[j][e] * rs) * ga[2 * j + (e >> 2)][e & 3] + sb[2 * j + (e >> 2)][e & 3];
            v4u o; o.x = pk2(y[0], y[1]); o.y = pk2(y[2], y[3]); o.z = pk2(y[4], y[5]); o.w = pk2(y[6], y[7]); o8[64 * j] = o; }
#pragma unroll
        for (int j = 0; j < 4; ++j) v[j] = nv[j];
        m = mn;
    }
}
__device__ __forceinline__ void modnorm_phase(Frame& F, const float* X, const float* g, const float* mod  , int chunk_sh, bf16* H, int skip_ctx, const float* xin = nullptr, const float* cin = nullptr) {
    const int gw = F.vcu * NWAVES + F.wave, NGW = F.G * NWAVES;
    int m = gw; while (m < MALL && skip_ctx && (m % TPB) < CTXL) m += NGW;
    f32x4 v[8], ga[8], sb[8]; int mr_cur = -1;
    if (m < MALL) { const GAS f32x4* xr = (const GAS f32x4*)modnorm_src(m, X, xin, cin) + F.lane;
#pragma unroll
        for (int j = 0; j < 8; ++j) v[j] = xr[64 * j]; }
    while (m < MALL) {
        int mn = m + NGW; while (mn < MALL && skip_ctx && (mn % TPB) < CTXL) mn += NGW;
        f32x4 nv[8];
        if (mn < MALL) { const GAS f32x4* xr = (const GAS f32x4*)modnorm_src(mn, X, xin, cin) + F.lane;
#pragma unroll
            for (int j = 0; j < 8; ++j) nv[j] = xr[64 * j]; }
        const int b = m / TPB, tp = m - b * TPB, mr = tp < CTXL ? 2 : b;
        if (mr != mr_cur) { mr_cur = mr; const float* sh = mod + (size_t)mr * 12288 + chunk_sh * DM; const float* sc = sh + DM;
#pragma unroll
            for (int j = 0; j < 8; ++j) { const int c = (F.lane + 64 * j) * 4; const f32x4 gg = *(const GAS f32x4*)(g + c), s1 = *(const GAS f32x4*)(sc + c); ga[j] = gg * (s1 + 1.0f); sb[j] = *(const GAS f32x4*)(sh + c); } }
        float s = 0.f;
#pragma unroll
        for (int j = 0; j < 8; ++j) s += (v[j].x * v[j].x + v[j].y * v[j].y) + (v[j].z * v[j].z + v[j].w * v[j].w);
        const float rs = rsqrtf(wave_sum(s) * (1.f / DM) + NORM_EPS);
        GAS v2u* o8 = (GAS v2u*)(H + (size_t)m * DM) + F.lane;
#pragma unroll
        for (int j = 0; j < 8; ++j) { const f32x4 y = (v[j] * rs) * ga[j] + sb[j];
            v2u o; o.x = pk2(y.x, y.y); o.y = pk2(y.z, y.w); o8[64 * j] = o; }
#pragma unroll
        for (int j = 0; j < 8; ++j) v[j] = nv[j];
        m = mn;
    }
}

typedef float f32x4v __attribute__((ext_vector_type(4)));
#define MFMA16(a, b, c) __builtin_amdgcn_mfma_f32_16x16x32_bf16((a), (b), (c), 0, 0, 0)
#define MFMA32(a, b, c) __builtin_amdgcn_mfma_f32_32x32x16_bf16((a), (b), (c), 0, 0, 0)

struct FeatP {
    const bf16* PA; const float* mu; const float* w0; const float* a0; const float* k_k; const float* k_a; const float* r_k;
    const bf16* WUP; const bf16* AUP; const bf16* GUP;
    const float* qnorm; const float* kvnorm; const f32x2* rope;
    bf16* RI; bf16* GG; float* BON; bf16* QN; bf16* KVN; bf16* K;
};
__device__ __forceinline__ f32x4 ld4bf(const bf16* p) { const v2u w = *(const GAS v2u*)p; return (f32x4){bflo(w.x), bfhi(w.x), bflo(w.y), bfhi(w.y)}; }
__device__ __forceinline__ f32x4 mix4(const bf16* PA, int m, int c, bool hp, bool hn, const float* mu) {
    const f32x4 pc = ld4bf(PA + (size_t)m * INA_P + c);
    f32x4 pp = {0, 0, 0, 0}, pn = {0, 0, 0, 0};
    if (hp) pp = ld4bf(PA + (size_t)(m - 1) * INA_P + c);
    if (hn) pn = ld4bf(PA + (size_t)(m + 1) * INA_P + c);
    const f32x4 mm = *(const GAS f32x4*)(mu + c);
    return pc + ((pp + pn) * 0.5f - pc) * mm;
}
__device__ __forceinline__ void unpack8(const v4u w, float (&x)[8]) { x[0] = bflo(w.x); x[1] = bfhi(w.x); x[2] = bflo(w.y); x[3] = bfhi(w.y); x[4] = bflo(w.z); x[5] = bfhi(w.z); x[6] = bflo(w.w); x[7] = bfhi(w.w); }
__device__ __forceinline__ v4u pack8f(const float (&x)[8]) { v4u o; o.x = pk2(x[0], x[1]); o.y = pk2(x[2], x[3]); o.z = pk2(x[4], x[5]); o.w = pk2(x[6], x[7]); return o; }
__device__ __forceinline__ void mix8(const bf16* rowc, bool hp, bool hn, const float (&mu)[8], float (&o)[8]) {
    const v4u zc = {0u, 0u, 0u, 0u};
    const v4u wc = *(const GAS v4u*)rowc, wp = hp ? *(const GAS v4u*)(rowc - INA_P) : zc, wn = hn ? *(const GAS v4u*)(rowc + INA_P) : zc;
    float c[8], p[8], n[8]; unpack8(wc, c); unpack8(wp, p); unpack8(wn, n);
#pragma unroll
    for (int e = 0; e < 8; ++e) o[e] = c[e] + (0.5f * (p[e] + n[e]) - c[e]) * mu[e];
}
struct Raw3 { v4u c, p, n; };
__device__ __forceinline__ Raw3 load3(const bf16* rowc, bool hp, bool hn) { const v4u zc = {0u, 0u, 0u, 0u}; Raw3 r; r.c = *(const GAS v4u*)rowc; r.p = hp ? *(const GAS v4u*)(rowc - INA_P) : zc; r.n = hn ? *(const GAS v4u*)(rowc + INA_P) : zc; return r; }
__device__ __forceinline__ void mix8r(const Raw3& w, const float (&mu)[8], float (&o)[8]) {
    float c[8], p[8], n[8]; unpack8(w.c, c); unpack8(w.p, p); unpack8(w.n, n);
#pragma unroll
    for (int e = 0; e < 8; ++e) o[e] = c[e] + (0.5f * (p[e] + n[e]) - c[e]) * mu[e];
}
__device__ __forceinline__ void features_phase(Frame& F, const FeatP& P) {
    constexpr int LAP = 328;
    LAS bf16* LA = (LAS bf16*)F.lds;
    LAS float* SSQ = (LAS float*)(F.lds + 10752);
    LAS float* PRM = (LAS float*)(F.lds + 12288);
    const int lane = F.lane, w = F.wave, tk = lane & 15, q4 = lane >> 4;
    constexpr int NTILE = MALL / 16, NTG = 64;
    for (int su = F.vcu; su < 4 * NTG; su += F.G) {
        const int cg = su & 3, tg = su >> 2, cw = 256 * cg + 32 * w, ch8 = cw + 8 * q4, hd = 4 * cg + (w >> 1);
        __syncthreads();
        for (int i = F.tid; i < 2560; i += 512) { const int prm = i >> 8, c = (i & 255) + 256 * cg; float v;
            switch (prm) { case 0: v = P.k_k[c]; break; case 1: v = P.k_a[c]; break; case 2: v = P.r_k[c]; break; case 3: v = P.w0[c]; break; case 4: v = P.w0[RW + c]; break;
                           case 5: v = P.a0[c]; break; case 6: v = P.a0[RW + c]; break; case 7: v = P.mu[c]; break; case 8: v = P.mu[RW + c]; break; default: v = P.mu[2 * RW + c]; break; }
            PRM[i] = v; }
        bf16x8 fw[2][2][2], fa[2][2][2], fg[2][2];
        { const int chA = cw + 8 * (tk >> 2) + (tk & 3);
#pragma unroll
          for (int d = 0; d < 2; ++d)
#pragma unroll
              for (int t = 0; t < 2; ++t) {
#pragma unroll
                  for (int ks = 0; ks < 2; ++ks) { fw[d][t][ks] = *(const GAS bf16x8*)(P.WUP + ((size_t)d * RW + chA + 4 * t) * 64 + ks * 32 + q4 * 8); fa[d][t][ks] = *(const GAS bf16x8*)(P.AUP + ((size_t)d * RW + chA + 4 * t) * 64 + ks * 32 + q4 * 8); }
                  fg[d][t] = *(const GAS bf16x8*)(P.GUP + ((size_t)d * RW + chA + 4 * t) * 32 + q4 * 8); } }
        for (int tt = tg; tt < NTILE; tt += NTG) {
            const int m0 = tt * 16;
            const int m = m0 + tk, b = m / TPB, tp = m - b * TPB;
            const bool hp = (tp != 0) && (tp != CTXL), hn = (tp != CTXL - 1) && (tp != TPB - 1);
            const bf16* rowp = P.PA + (size_t)m * INA_P + ch8;
            const Raw3 rawk = load3(rowp + RW, hp, hn), rawr = load3(rowp, hp, hn), rawv = load3(rowp + 2 * RW, hp, hn);
            __syncthreads();
            for (int it = F.tid; it < 640; it += 512) { const int tkk = it / 40, c8 = (it - tkk * 40) * 8, c = C_WD + c8, m = m0 + tkk, tp = m % TPB;
                const bool hp = (tp != 0) && (tp != CTXL), hn = (tp != CTXL - 1) && (tp != TPB - 1);
                float mu[8], v[8];
                { const f32x4 a = *(const GAS f32x4*)(P.mu + c), b2 = *(const GAS f32x4*)(P.mu + c + 4); mu[0] = a.x; mu[1] = a.y; mu[2] = a.z; mu[3] = a.w; mu[4] = b2.x; mu[5] = b2.y; mu[6] = b2.z; mu[7] = b2.w; }
                mix8(P.PA + (size_t)m * INA_P + c, hp, hn, mu, v);
#pragma unroll
                for (int e = 0; e < 8; ++e) { if (c < C_AD) v[e] = 1.0f - 2.0f * __builtin_amdgcn_rcpf(1.0f + __expf(2.0f * v[e])); else if (c >= C_GD) v[e] = sigmoidf_(v[e]); }
                *(LAS v4u*)(LA + tkk * LAP + c8) = pack8f(v); }
            if ((tt & 3) == cg) {
#pragma unroll
                for (int t2 = 0; t2 < 2; ++t2) { const int m = m0 + 2 * w + t2, b = m / TPB, tp = m - b * TPB; const bf16* row = P.PA + (size_t)m * INA_P;
                    { float x[8]; unpack8(*(const GAS v4u*)(row + C_QC + lane * 8), x); float s = 0.f;
#pragma unroll
                      for (int e = 0; e < 8; ++e) s += x[e] * x[e];
                      const float rs = rsqrtf(wave_sum(s) * (1.f / 512.f) + NORM_EPS);
#pragma unroll
                      for (int e = 0; e < 8; ++e) x[e] = x[e] * rs * P.qnorm[lane * 8 + e];
                      *(GAS v4u*)(P.QN + (size_t)m * 512 + lane * 8) = pack8f(x); }
                    { const v2u q = *(const GAS v2u*)(row + C_KVC + lane * 4);
                      float x[4] = {bflo(q.x), bfhi(q.x), bflo(q.y), bfhi(q.y)}; float s = 0.f;
#pragma unroll
                      for (int e = 0; e < 4; ++e) s += x[e] * x[e];
                      const float rs = rsqrtf(wave_sum(s) * (1.f / 256.f) + NORM_EPS);
#pragma unroll
                      for (int e = 0; e < 4; ++e) x[e] = x[e] * rs * P.kvnorm[lane * 4 + e];
                      v2u o; o.x = pk2(x[0], x[1]); o.y = pk2(x[2], x[3]);
                      *(GAS v2u*)(P.KVN + (size_t)m * 256 + lane * 4) = o; }
                    if (lane < 16) { const float x1 = bf1(row[C_KR + lane]), x2 = bf1(row[C_KR + 16 + lane]); const f32x2 cs = P.rope[(size_t)tp * 16 + lane];
                        const unsigned o = pk2(x1 * cs.x - x2 * cs.y, x1 * cs.y + x2 * cs.x);
#pragma unroll
                        for (int h2 = 0; h2 < NH; ++h2) *(GAS unsigned*)(P.K + ((size_t)(b * NH + h2) * TPB + tp) * QKD + 64 + 2 * lane) = o; } } }
            const int pc = 32 * w + 8 * q4;
            float prm[8], kmx[8], kx[8];
#pragma unroll
            for (int e = 0; e < 8; ++e) prm[e] = PRM[8 * 256 + pc + e];
            mix8r(rawk, prm, kmx);
            { float s = 0.f;
#pragma unroll
              for (int e = 0; e < 8; ++e) { kx[e] = kmx[e] * PRM[0 * 256 + pc + e]; s += kx[e] * kx[e]; }
              s += bpermf(lane ^ 16, s); s += bpermf(lane ^ 32, s);
              if (q4 == 0) SSQ[tk * 8 + w] = s; }
            __syncthreads();
            const float rsn = rsqrtf(SSQ[tk * 8 + w] + SSQ[tk * 8 + (w ^ 1)] + 1e-12f);
            f32x4 cw_[2][2], ca_[2][2], cg_[2][2];
#pragma unroll
            for (int d = 0; d < 2; ++d) {
                const bf16x8 bg = *(const LAS bf16x8*)(LA + tk * LAP + 256 + d * 32 + q4 * 8);
                bf16x8 bw[2], ba[2];
#pragma unroll
                for (int ks = 0; ks < 2; ++ks) { bw[ks] = *(const LAS bf16x8*)(LA + tk * LAP + d * 64 + ks * 32 + q4 * 8); ba[ks] = *(const LAS bf16x8*)(LA + tk * LAP + 128 + d * 64 + ks * 32 + q4 * 8); }
#pragma unroll
                for (int t = 0; t < 2; ++t) { f32x4 z = {0, 0, 0, 0};
                    cw_[d][t] = MFMA16(fw[d][t][1], bw[1], MFMA16(fw[d][t][0], bw[0], z));
                    ca_[d][t] = MFMA16(fa[d][t][1], ba[1], MFMA16(fa[d][t][0], ba[0], z));
                    cg_[d][t] = MFMA16(fg[d][t], bg, z); } }
            float r8[8], v8[8], kk8[8];
#pragma unroll
            for (int e = 0; e < 8; ++e) prm[e] = PRM[7 * 256 + pc + e];
            mix8r(rawr, prm, r8);
#pragma unroll
            for (int e = 0; e < 8; ++e) prm[e] = PRM[9 * 256 + pc + e];
            mix8r(rawv, prm, v8);
#pragma unroll
            for (int e = 0; e < 8; ++e) kk8[e] = kx[e] * rsn;
            bf16* rec = P.RI + ((size_t)(b * NH + hd) * TPB + tp) * RREC + (ch8 & 63);
            *(GAS v4u*)(rec) = pack8f(r8); *(GAS v4u*)(rec + 64) = pack8f(kk8); *(GAS v4u*)(rec + 128) = pack8f(v8);
#pragma unroll
            for (int d = 0; d < 2; ++d) {
                float ld[8], ke[8], bb[8], gg[8]; float bs = 0.f;
#pragma unroll
                for (int e = 0; e < 8; ++e) { const int t = e >> 2, r = e & 3;
                    ld[e] = -0.60653066f * sigmoidf_(PRM[(3 + d) * 256 + pc + e] + cw_[d][t][r]);
                    const float aa = sigmoidf_(PRM[(5 + d) * 256 + pc + e] + ca_[d][t][r]);
                    ke[e] = kmx[e] * (1.0f + (aa - 1.0f) * PRM[1 * 256 + pc + e]); bb[e] = kk8[e] * aa; gg[e] = cg_[d][t][r];
                    bs += r8[e] * ke[e] * PRM[2 * 256 + pc + e]; }
                *(GAS v4u*)(rec + (3 + 3 * d) * 64) = pack8f(ld); *(GAS v4u*)(rec + (4 + 3 * d) * 64) = pack8f(bb); *(GAS v4u*)(rec + (5 + 3 * d) * 64) = pack8f(ke);
                *(GAS v4u*)(P.GG + ((size_t)d * MALL + m) * RW + ch8) = pack8f(gg);
                bs += bpermf(lane ^ 16, bs); bs += bpermf(lane ^ 32, bs);
                if (q4 == 0) P.BON[((size_t)d * MALL + m) * 32 + 2 * hd + (w & 1)] = bs; }
        }
    }
}

__device__ __forceinline__ void cvt_row_load(f32x4 (&x)[8], const float* src) {
#pragma unroll
    for (int q = 0; q < 8; ++q) x[q] = *(const GAS f32x4*)(src + q * 4);
}
__device__ __forceinline__ void cvt_row_store(const f32x4 (&x)[8], unsigned char* dst, float* scale_slot, int lane) {
    float am = 0.f;
#pragma unroll
    for (int q = 0; q < 8; ++q) am = fmaxf(am, fmaxf(fmaxf(fabsf(x[q].x), fabsf(x[q].y)), fmaxf(fabsf(x[q].z), fabsf(x[q].w))));
    am = fmaxf(wave_max_u(am), 1e-30f);
    const float g = 6.0f / am, inv = am * (1.0f / 6.0f);
    v4u o;
#pragma unroll
    for (int q = 0; q < 4; ++q) { unsigned w = 0u;
        w = __builtin_amdgcn_cvt_scalef32_pk_fp4_f32(w, x[2 * q].x * g, x[2 * q].y * g, 1.0f, 0);
        w = __builtin_amdgcn_cvt_scalef32_pk_fp4_f32(w, x[2 * q].z * g, x[2 * q].w * g, 1.0f, 1);
        w = __builtin_amdgcn_cvt_scalef32_pk_fp4_f32(w, x[2 * q + 1].x * g, x[2 * q + 1].y * g, 1.0f, 2);
        w = __builtin_amdgcn_cvt_scalef32_pk_fp4_f32(w, x[2 * q + 1].z * g, x[2 * q + 1].w * g, 1.0f, 3);
        o[q] = w; }
    *(GAS v4u*)dst = o;
    if (lane == 0) *scale_slot = inv;
}
struct ScanCvt { const float* pu; const float* pv; unsigned char* PU8; unsigned char* PV8; float* SU; float* SV; int wl; };
constexpr int SCH = 32;
constexpr int SSTEP = 6 * 64;
__device__ __forceinline__ int scan_tp(int dir, int s) { return dir == 0 ? s : (s < CTXL ? (CTXL - 1 - s) : (TPB - 1 - (s - CTXL))); }
__device__ __forceinline__ void scan_load(v4u (&rg)[6], const bf16* RIh, int dir, int chunk, int htid) {
    const int tp = scan_tp(dir, chunk * SCH + (htid >> 3));
    const bf16* rec = RIh + (size_t)tp * RREC + (htid & 7) * 8;
#pragma unroll
    for (int i = 0; i < 3; ++i) rg[i] = *(const GAS v4u*)(rec + i * 64);
    rec += (3 + 3 * dir) * 64;
#pragma unroll
    for (int i = 0; i < 3; ++i) rg[3 + i] = *(const GAS v4u*)(rec + i * 64);
}
__device__ __forceinline__ void scan_store(const v4u (&rg)[6], LAS float* buf, int htid) {
    LAS float* d0 = buf + (htid >> 3) * SSTEP + (htid & 7) * 8;
#pragma unroll
    for (int i = 0; i < 6; ++i) { constexpr int SLOT[6] = {4, 0, 5, 2, 1, 3};
        const v4u wv = rg[i];
        f32x4 lo = {bflo(wv.x), bfhi(wv.x), bflo(wv.y), bfhi(wv.y)}, hi = {bflo(wv.z), bfhi(wv.z), bflo(wv.w), bfhi(wv.w)};
        if (i == 3) {
#pragma unroll
            for (int e = 0; e < 4; ++e) { lo[e] = __expf(lo[e]); hi[e] = __expf(hi[e]); } }
        LAS float* d = d0 + SLOT[i] * 64;
        *(LAS f32x4*)d = lo; *(LAS f32x4*)(d + 4) = hi; }
}
__device__ __forceinline__ void scan_phase(Frame& F, const bf16* RI, bf16* Y, const ScanCvt& C) {
    LAS float* bufs = (LAS float*)F.lds;
    constexpr int NCH = TPB / SCH;
    for (int uu = F.vcu; uu < NBATCH * NH * 2 * 4; uu += F.G) {
        const int rg = uu & 3, dir = (uu >> 2) & 1, hd = (uu >> 3) & 15, b = uu >> 7;
        const bf16* RIh = RI + (size_t)(b * NH + hd) * TPB * RREC;
        const int htid = F.tid - 256;
        v4u ra[6], rb[6];
        f32x4 xw[8];
        LAS float* wscr = (LAS float*)(F.lds + (((F.wave & 3) == 3) ? LDSCTL_OFF + 4096 : 98304 + (F.wave & 3) * 8448));
        f32x4 xc[8];
        __syncthreads();
        if (F.wave >= 4) { scan_load(rb, RIh, dir, 0, htid); scan_load(ra, RIh, dir, 1, htid); scan_store(rb, bufs, htid); scan_load(rb, RIh, dir, 2, htid); }
        __syncthreads();
        const int j = F.lane & 15, rowl = F.lane >> 4, row = rg * 16 + (F.wave & 3) * 4 + rowl;
        f32x2 S01 = {0.f, 0.f}, S23 = {0.f, 0.f};
        bf16* yb = Y + ((size_t)dir * MALL + (size_t)b * TPB) * RW + hd * 64 + row;
        for (int c = 0; c < NCH; ++c) {
            LAS float* cur = bufs + (c & 1) * (SCH * SSTEP);
            if (F.wave >= 4) {
                if (c + 1 < NCH) {
                    if ((c & 1) == 0) { scan_store(ra, bufs + (SCH * SSTEP), htid); if (c + 3 < NCH) scan_load(ra, RIh, dir, c + 3, htid); }
                    else { scan_store(rb, bufs, htid); if (c + 3 < NCH) scan_load(rb, RIh, dir, c + 3, htid); }  }
                if (C.wl >= 0 && (c & 3) == 2) { const int wi = uu * 4 + (F.wave - 4) + 1024 * (c >> 3);
                    if (wi < NW_ITEMS) { const TItem Tw = p0_resolve_wave(F.ws, C.wl, wi); if ((c & 7) == 2) p0_item_load(Tw, F.lane, xw); else p0_item_finish(Tw, xw, wscr, F.lane); } }
                if ((c & 3) == 0 && (c >> 3) < 32) { const int r = uu * 4 + (F.wave - 4) + 1024 * (c >> 3);
                    if ((c & 7) == 0) cvt_row_load(xc, ((r >= NEXP) ? C.pv + (size_t)(r - NEXP) * DM : C.pu + (size_t)r * DM) + F.lane * 32);
                    else cvt_row_store(xc, ((r >= NEXP) ? C.PV8 + (size_t)(r - NEXP) * (DM / 2) : C.PU8 + (size_t)r * (DM / 2)) + F.lane * 16, (r >= NEXP) ? C.SV + (r - NEXP) : C.SU + r, F.lane); } }
            else {
#pragma unroll
                for (int h16 = 0; h16 < 2; ++h16) {
                    const LAS float* sp = cur + (h16 * 16) * SSTEP;
                    f32x4 kk = *(const LAS f32x4*)(sp + 4 * j), bb = *(const LAS f32x4*)(sp + 64 + 4 * j), ww = *(const LAS f32x4*)(sp + 128 + 4 * j),
                          ke = *(const LAS f32x4*)(sp + 192 + 4 * j), rr = *(const LAS f32x4*)(sp + 256 + 4 * j);
                    float ykeep = 0.f, ypart; f32x2 u2, t2, vv; vv.x = sp[320 + row];
#define SCAN_DPP(r, ctl) "v_add_f32_dpp " r ", " r ", " r " " ctl " row_mask:0xf bank_mask:0xf bound_ctrl:1\n\t"
#define SCAN_MAIN(SEL) asm volatile( \
                        "v_pk_mul_f32 v[242:243], %[kexy], %[vv] op_sel_hi:[1,0]\n\t" \
                        "v_add_f32 v246, v250, v251\n\t" \
                        "v_add_f32_dpp v248, %[yp], %[yp] quad_perm:[1,0,3,2] row_mask:0xf bank_mask:0xf bound_ctrl:1\n\t" \
                        "v_pk_mul_f32 v[244:245], %[kezw], %[vv] op_sel_hi:[1,0]\n\t" \
                        SCAN_DPP("v246", "quad_perm:[1,0,3,2]") SCAN_DPP("v248", "quad_perm:[2,3,0,1]") \
                        "v_pk_fma_f32 %[s01], %[s01], %[wwxy], v[242:243]\n\t" \
                        SCAN_DPP("v246", "quad_perm:[2,3,0,1]") SCAN_DPP("v248", "row_half_mirror") \
                        "v_pk_fma_f32 %[s23], %[s23], %[wwzw], v[244:245]\n\t" \
                        SCAN_DPP("v246", "row_half_mirror") SCAN_DPP("v248", "row_mirror") \
                        SEL "\n\t" \
                        SCAN_DPP("v246", "row_mirror") \
                        "v_pk_fma_f32 %[s01], %[bbxy], v[246:247], %[s01] op_sel_hi:[1,0,1] neg_lo:[0,1,0] neg_hi:[0,1,0]\n\t" \
                        "v_pk_fma_f32 %[s23], %[bbzw], v[246:247], %[s23] op_sel_hi:[1,0,1] neg_lo:[0,1,0] neg_hi:[0,1,0]\n\t" \
                        "v_pk_mul_f32 v[252:253], %[s01], %[rrxy]" \
                        : [s01] "+v"(S01), [s23] "+v"(S23), [yk] "+v"(ykeep), "={v[252:253]}"(u2) \
                        : [kexy] "v"(ke.xy), [kezw] "v"(ke.zw), [vv] "v"(vv), [wwxy] "v"(ww.xy), [wwzw] "v"(ww.zw), [bbxy] "v"(bb.xy), [bbzw] "v"(bb.zw), [rrxy] "v"(rr.xy), [yp] "v"(ypart), [msk] "s"(msk), "{v[250:251]}"(t2) \
                        : "v242", "v243", "v244", "v245", "v246", "v247", "v248")
                    asm volatile("v_pk_mul_f32 v[250:251], %[s01], %[kxy]\n\tv_mov_b32 %[yp], 0\n\tv_pk_fma_f32 v[250:251], %[s23], %[kzw], v[250:251]"
                                 : "=&{v[250:251]}"(t2), [yp] "=&v"(ypart) : [s01] "v"(S01), [s23] "v"(S23), [kxy] "v"(kk.xy), [kzw] "v"(kk.zw));
#pragma unroll
                    for (int st = 0; st < 16; ++st) {
                        f32x4 nkk = kk, nbb = bb, nww = ww, nke = ke, nrr = rr; f32x2 nvv = vv;
                        const LAS float* sn = sp + (st + 1) * SSTEP;
                        if (st + 1 < 16) { nkk = *(const LAS f32x4*)(sn + 4 * j); nke = *(const LAS f32x4*)(sn + 192 + 4 * j); nvv.x = sn[320 + row]; nww = *(const LAS f32x4*)(sn + 128 + 4 * j); nbb = *(const LAS f32x4*)(sn + 64 + 4 * j);
                            nrr = *(const LAS f32x4*)(sn + 256 + 4 * j); }
                        const unsigned long long msk = 0x0001000100010001ull << ((st + 15) & 15);
                        if (st > 0) SCAN_MAIN("v_cndmask_b32_e64 %[yk], %[yk], v248, %[msk]"); else SCAN_MAIN("s_nop 0");
                        if (st + 1 < 16)
                            asm volatile("v_pk_mul_f32 v[250:251], %[s01], %[kxy]\n\tv_pk_fma_f32 v[252:253], %[s23], %[rrzw], v[252:253]\n\tv_pk_fma_f32 v[250:251], %[s23], %[kzw], v[250:251]\n\tv_add_f32 %[yp], v252, v253"
                                         : "=&{v[250:251]}"(t2), "={v[252:253]}"(u2), [yp] "=&v"(ypart) : [s01] "v"(S01), [s23] "v"(S23), [kxy] "v"(nkk.xy), [kzw] "v"(nkk.zw), [rrzw] "v"(rr.zw), "1"(u2));
                        else
                            asm volatile("s_nop 0\n\tv_pk_fma_f32 v[252:253], %[s23], %[rrzw], v[252:253]" : "={v[252:253]}"(u2) : [s23] "v"(S23), [rrzw] "v"(rr.zw), "0"(u2));
                        kk = nkk; bb = nbb; ww = nww; ke = nke; rr = nrr; vv = nvv;
                        __builtin_amdgcn_sched_barrier(0);
                    }
#undef SCAN_MAIN
#undef SCAN_DPP
                    { const float y = red16(u2.x + u2.y); ykeep = (j == 15) ? y : ykeep; }
                    const int tp = scan_tp(dir, c * SCH + h16 * 16 + j);
                    *(GAS bf16*)(yb + (size_t)tp * RW) = (bf16)f2bf(ykeep);
                }
            }
            __syncthreads();
        }
    }
}

constexpr int AKP = 208, AVP = 192;
constexpr int ATILE = 64 * AKP + 64 * AVP;
__device__ __forceinline__ bf16x8 pack8(const f32x16& x, int s) {
    v4u p; p.x = pk2(x[8 * s + 0], x[8 * s + 1]); p.y = pk2(x[8 * s + 2], x[8 * s + 3]); p.z = pk2(x[8 * s + 4], x[8 * s + 5]); p.w = pk2(x[8 * s + 6], x[8 * s + 7]);
    return __builtin_bit_cast(bf16x8, p);
}
__device__ __forceinline__ void attn_phase(Frame& F, const bf16* Q, const bf16* K, const bf16* V, bf16* YB, int with_ctx) {
    const int lane = F.lane, half = lane >> 5, l31 = lane & 31, l16 = lane & 15, g1 = (lane >> 4) & 1;
    const int nunits = NBATCH * NH * 32 + (with_ctx ? NBATCH * NH : 0);
    for (int uu = F.vcu; uu < nunits; uu += F.G) {
        int bh, q0, nkt;
        if (uu < NBATCH * NH * 32) { bh = uu >> 5; q0 = CTXL + (uu & 31) * 256; nkt = TPB / 64; } else { bh = uu - NBATCH * NH * 32; q0 = 0; nkt = CTXL / 64; }
        const bf16* Kh = K + (size_t)bh * TPB * QKD; const bf16* Vh = V + (size_t)bh * TPB * 64; const bf16* Qh = Q + (size_t)bh * TPB * QKD;
        const int tq = q0 + F.wave * 32 + l31;
        bf16x8 qf[6];
#pragma unroll
        for (int ks = 0; ks < 6; ++ks) qf[ks] = *(const GAS bf16x8*)(Qh + (size_t)tq * QKD + 16 * ks + 8 * half);
        f32x16 o0, o1;
#pragma unroll
        for (int i = 0; i < 16; ++i) { o0[i] = 0.f; o1[i] = 0.f; }
        float l_run = 0.f;
        f32x16 cinit;
#pragma unroll
        for (int i = 0; i < 16; ++i) cinit[i] = 0.f;
        asm volatile("" : "+v"(cinit));
        const int kc1 = F.tid + 512; const bool k1ok = kc1 < 768;
        const unsigned kd0 = (unsigned)((F.tid / 12) * AKP + (F.tid % 12) * 16), kd1 = (unsigned)((kc1 / 12) * AKP + (kc1 % 12) * 16), vd = (unsigned)(64 * AKP + (F.tid >> 3) * AVP + (F.tid & 7) * 16);
        v4u kr0, kr1 = {0, 0, 0, 0}, vr;
        kr0 = *(const GAS v4u*)(Kh + (size_t)F.tid * 8); if (k1ok) kr1 = *(const GAS v4u*)(Kh + (size_t)kc1 * 8); vr = *(const GAS v4u*)(Vh + (size_t)F.tid * 8);
        __syncthreads();
        *(LAS v4u*)(F.lds + kd0) = kr0; if (k1ok) *(LAS v4u*)(F.lds + kd1) = kr1; *(LAS v4u*)(F.lds + vd) = vr;
        if (nkt > 1) { const bf16* kn = Kh + (size_t)64 * QKD; const bf16* vn = Vh + (size_t)64 * 64;
            kr0 = *(const GAS v4u*)(kn + (size_t)F.tid * 8); if (k1ok) kr1 = *(const GAS v4u*)(kn + (size_t)kc1 * 8); vr = *(const GAS v4u*)(vn + (size_t)F.tid * 8);
            *(LAS v4u*)(F.lds + ATILE + kd0) = kr0; if (k1ok) *(LAS v4u*)(F.lds + ATILE + kd1) = kr1; *(LAS v4u*)(F.lds + ATILE + vd) = vr; }
        __syncthreads();
        bf16x8 ka[6], kb2[6];
#pragma unroll
        for (int ks = 0; ks < 6; ++ks) { ka[ks] = *(const LAS bf16x8*)(F.lds + l31 * AKP + (16 * ks + 8 * half) * 2); kb2[ks] = *(const LAS bf16x8*)(F.lds + (32 + l31) * AKP + (16 * ks + 8 * half) * 2); }
        int bc = 0, bn = ATILE, bw = 2 * ATILE;
        for (int kt = 0; kt < nkt; ++kt) {
            const bool more = kt + 1 < nkt, more2 = kt + 2 < nkt;
            if (more2) { const bf16* kn = Kh + (size_t)(kt + 2) * 64 * QKD; const bf16* vn = Vh + (size_t)(kt + 2) * 64 * 64;
                kr0 = *(const GAS v4u*)(kn + (size_t)F.tid * 8); if (k1ok) kr1 = *(const GAS v4u*)(kn + (size_t)kc1 * 8); vr = *(const GAS v4u*)(vn + (size_t)F.tid * 8); }
            LAS unsigned char* Kb = F.lds + bc; LAS unsigned char* Vb = Kb + 64 * AKP;
            f32x16 s0, s1;
            { s0 = MFMA32(ka[0], qf[0], cinit);
#pragma unroll
              for (int ks = 1; ks < 6; ++ks) s0 = MFMA32(ka[ks], qf[ks], s0);
              s1 = MFMA32(kb2[0], qf[0], cinit);
#pragma unroll
              for (int ks = 1; ks < 6; ++ks) s1 = MFMA32(kb2[ks], qf[ks], s1);
              __builtin_amdgcn_sched_group_barrier(0x8, 12, 0); }
            bf16x8 va[2][2][2];
#pragma unroll
            for (int t = 0; t < 2; ++t)
#pragma unroll
                for (int s = 0; s < 2; ++s) { const int kb = 32 * t + 16 * s + 4 * half + (l16 >> 2);
#pragma unroll
                    for (int dvt = 0; dvt < 2; ++dvt) { const LAS unsigned char* vp = Vb + kb * AVP + (32 * dvt + 16 * g1 + 4 * (l16 & 3)) * 2;
                        const s16x4 lo = __builtin_amdgcn_ds_read_tr16_b64_v4i16((LAS s16x4*)vp), hi = __builtin_amdgcn_ds_read_tr16_b64_v4i16((LAS s16x4*)(vp + 8 * AVP));
                        va[t][s][dvt] = __builtin_shufflevector(lo, hi, 0, 1, 2, 3, 4, 5, 6, 7); } }
            __builtin_amdgcn_sched_group_barrier(0x100, 16, 0);
            if (more) { const LAS unsigned char* Kn = F.lds + bn;
#pragma unroll
                for (int ks = 0; ks < 6; ++ks) { ka[ks] = *(const LAS bf16x8*)(Kn + l31 * AKP + (16 * ks + 8 * half) * 2); kb2[ks] = *(const LAS bf16x8*)(Kn + (32 + l31) * AKP + (16 * ks + 8 * half) * 2); } }
            float mx = s0[0];
#pragma unroll
            for (int i = 1; i < 16; ++i) mx = fmaxf(mx, s0[i]);
#pragma unroll
            for (int i = 0; i < 16; ++i) mx = fmaxf(mx, s1[i]);
            if (kt == 0 || __any(mx > 8.0f)) {
                mx = fmaxf(mx, bpermf(lane ^ 32, mx));
                const float d = (kt == 0) ? mx : fmaxf(mx, 0.f), alpha = (kt == 0) ? 1.0f : __builtin_amdgcn_exp2f(-d);
                l_run *= alpha;
#pragma unroll
                for (int i = 0; i < 16; ++i) { o0[i] *= alpha; o1[i] *= alpha; s0[i] -= d; s1[i] -= d; cinit[i] -= d; }
                asm volatile("" : "+v"(cinit));
            }
#pragma unroll
            for (int i = 0; i < 16; ++i) { s0[i] = __builtin_amdgcn_exp2f(s0[i]); s1[i] = __builtin_amdgcn_exp2f(s1[i]); }
            float ps = 0.f;
#pragma unroll
            for (int i = 0; i < 16; ++i) ps += s0[i] + s1[i];
            l_run += ps;
            { bf16x8 pf[2][2];
#pragma unroll
              for (int t = 0; t < 2; ++t)
#pragma unroll
                  for (int s = 0; s < 2; ++s) pf[t][s] = pack8(t == 0 ? s0 : s1, s);
#pragma unroll
              for (int t = 0; t < 2; ++t)
#pragma unroll
                  for (int s = 0; s < 2; ++s) { o0 = MFMA32(va[t][s][0], pf[t][s], o0); o1 = MFMA32(va[t][s][1], pf[t][s], o1); } }
            if (more2) { LAS unsigned char* nb = F.lds + bw;
                *(LAS v4u*)(nb + kd0) = kr0; if (k1ok) *(LAS v4u*)(nb + kd1) = kr1; *(LAS v4u*)(nb + vd) = vr; }
            __syncthreads();
            { const int t_ = bc; bc = bn; bn = bw; bw = t_; }
        }
        const float linv = (DBG_SKIP & 4) ? 0.f : 1.0f / (l_run + bpermf(lane ^ 32, l_run));
        const int b = bh >> 4, hd = bh & 15;
        bf16* op = YB + ((size_t)b * TPB + tq) * RW + hd * 64 + 4 * half;
#pragma unroll
        for (int g = 0; g < 4; ++g) {
            v2u w; w.x = pk2(o0[4 * g] * linv, o0[4 * g + 1] * linv); w.y = pk2(o0[4 * g + 2] * linv, o0[4 * g + 3] * linv); *(GAS v2u*)(op + 8 * g) = w;
            w.x = pk2(o1[4 * g] * linv, o1[4 * g + 1] * linv); w.y = pk2(o1[4 * g + 2] * linv, o1[4 * g + 3] * linv); *(GAS v2u*)(op + 32 + 8 * g) = w; }
    }
}

struct RoRaw { v4u va, vc, ya[2], yc[2], ga[2], gc[2]; float b0[2], b1[2]; };
__device__ __forceinline__ void readout_load(RoRaw& r, int m, int lane, const bf16* Y, const bf16* GG, const float* BON, const bf16* RI) {
    const int hd = lane >> 2, ch0 = hd * 64 + (lane & 3) * 16, b = m / TPB, tp = m - b * TPB;
    const bf16* rec = RI + ((size_t)(b * NH + hd) * TPB + tp) * RREC + 128 + (lane & 3) * 16;
    r.va = *(const GAS v4u*)rec; r.vc = *(const GAS v4u*)(rec + 8);
#pragma unroll
    for (int d = 0; d < 2; ++d) { const bf16* yp = Y + ((size_t)d * MALL + m) * RW + ch0; const bf16* gp = GG + ((size_t)d * MALL + m) * RW + ch0;
        r.ya[d] = *(const GAS v4u*)yp; r.yc[d] = *(const GAS v4u*)(yp + 8); r.ga[d] = *(const GAS v4u*)gp; r.gc[d] = *(const GAS v4u*)(gp + 8);
        r.b0[d] = BON[((size_t)d * MALL + m) * 32 + 2 * hd]; r.b1[d] = BON[((size_t)d * MALL + m) * 32 + 2 * hd + 1]; }
}
__device__ __forceinline__ void readout_phase(Frame& F, const bf16* Y, const bf16* GG, const float* BON, const bf16* RI, const float* ln_w, const float* ln_b, bf16* YA) {
    const int gw = F.vcu * NWAVES + F.wave, NGW = F.G * NWAVES, lane = F.lane, hd = lane >> 2, ch0 = hd * 64 + (lane & 3) * 16;
    RoRaw cur, nxt;
    if (gw < MALL) readout_load(cur, gw, lane, Y, GG, BON, RI);
    for (int m = gw; m < MALL; m += NGW) {
        if (m + NGW < MALL) readout_load(nxt, m + NGW, lane, Y, GG, BON, RI);
        float vv[16], out[16];
        unpack8(cur.va, *(float(*)[8])&vv[0]); unpack8(cur.vc, *(float(*)[8])&vv[8]);
#pragma unroll
        for (int e = 0; e < 16; ++e) out[e] = 0.f;
#pragma unroll
        for (int d = 0; d < 2; ++d) {
            float y[16], g[16];
            unpack8(cur.ya[d], *(float(*)[8])&y[0]); unpack8(cur.yc[d], *(float(*)[8])&y[8]); unpack8(cur.ga[d], *(float(*)[8])&g[0]); unpack8(cur.gc[d], *(float(*)[8])&g[8]);
            float s = 0.f;
#pragma unroll
            for (int e = 0; e < 16; ++e) s += y[e];
            s = dpp_add<0xB1>(s); s = dpp_add<0x4E>(s);
            const float mean = s * (1.f / 64.f); float q = 0.f;
#pragma unroll
            for (int e = 0; e < 16; ++e) { y[e] -= mean; q += y[e] * y[e]; }
            q = dpp_add<0xB1>(q); q = dpp_add<0x4E>(q);
            const float rstd = rsqrtf(q * (1.f / 64.f) + 64e-5f), bon = cur.b0[d] + cur.b1[d];
#pragma unroll
            for (int e = 0; e < 16; ++e) out[e] += (y[e] * rstd * ln_w[ch0 + e] + ln_b[ch0 + e] + bon * vv[e]) * g[e];
        }
        if (DBG_SKIP & 2) {
#pragma unroll
            for (int e = 0; e < 16; ++e) out[e] = 0.f; }
        v4u o0, o1;
        o0.x = pk2(out[0], out[1]); o0.y = pk2(out[2], out[3]); o0.z = pk2(out[4], out[5]); o0.w = pk2(out[6], out[7]);
        o1.x = pk2(out[8], out[9]); o1.y = pk2(out[10], out[11]); o1.z = pk2(out[12], out[13]); o1.w = pk2(out[14], out[15]);
        *(GAS v4u*)(YA + (size_t)m * RW + ch0) = o0; *(GAS v4u*)(YA + (size_t)m * RW + ch0 + 8) = o1;
        cur = nxt;
    }
}


__device__ __forceinline__ unsigned f2key(float f) { const unsigned u = __builtin_bit_cast(unsigned, f); return (u & 0x80000000u) ? ~u : (u | 0x80000000u); }
__device__ __forceinline__ float key2f(unsigned k) { const unsigned u = (k & 0x80000000u) ? (k & 0x7fffffffu) : ~k; return __builtin_bit_cast(float, u); }
template <int CTRL, int RM> __device__ __forceinline__ unsigned dpp_umax(unsigned x) {
    const unsigned y = (unsigned)__builtin_amdgcn_update_dpp(0, (int)x, CTRL, RM, 0xf, false); return x > y ? x : y; }
__device__ __forceinline__ unsigned row_umax(unsigned x) { x = dpp_umax<0xB1, 0xf>(x); x = dpp_umax<0x4E, 0xf>(x); x = dpp_umax<0x141, 0xf>(x); x = dpp_umax<0x140, 0xf>(x); return x; }
#define SEL_CE(a_, b_) do { const unsigned hi_ = (a_) > (b_) ? (a_) : (b_), lo_ = (a_) > (b_) ? (b_) : (a_); (a_) = hi_; (b_) = lo_; } while (0)
__device__ __forceinline__ void sel_keys8(unsigned (&k)[8], const _Float16* p, int id0) {
    typedef _Float16 h8 __attribute__((ext_vector_type(8)));
    const h8 hv = *(const GAS h8*)p;
    const f32x4 v0 = {(float)hv[0], (float)hv[1], (float)hv[2], (float)hv[3]}, v1 = {(float)hv[4], (float)hv[5], (float)hv[6], (float)hv[7]};
    k[0] = (f2key(v0.x) & ~127u) | (unsigned)(id0 + 0); k[1] = (f2key(v0.y) & ~127u) | (unsigned)(id0 + 1); k[2] = (f2key(v0.z) & ~127u) | (unsigned)(id0 + 2); k[3] = (f2key(v0.w) & ~127u) | (unsigned)(id0 + 3);
    k[4] = (f2key(v1.x) & ~127u) | (unsigned)(id0 + 4); k[5] = (f2key(v1.y) & ~127u) | (unsigned)(id0 + 5); k[6] = (f2key(v1.z) & ~127u) | (unsigned)(id0 + 6); k[7] = (f2key(v1.w) & ~127u) | (unsigned)(id0 + 7);
    SEL_CE(k[0], k[1]); SEL_CE(k[2], k[3]); SEL_CE(k[4], k[5]); SEL_CE(k[6], k[7]); SEL_CE(k[0], k[2]); SEL_CE(k[1], k[3]); SEL_CE(k[4], k[6]); SEL_CE(k[5], k[7]); SEL_CE(k[1], k[2]); SEL_CE(k[5], k[6]);
    SEL_CE(k[0], k[4]); SEL_CE(k[1], k[5]); SEL_CE(k[2], k[6]); SEL_CE(k[3], k[7]); SEL_CE(k[2], k[4]); SEL_CE(k[3], k[5]); SEL_CE(k[1], k[2]); SEL_CE(k[3], k[4]); SEL_CE(k[5], k[6]);
}
__device__ __forceinline__ void top16_rows2(const _Float16* pa, const _Float16* pb, int l16, unsigned& ra, unsigned& rb) {
    unsigned ka[8], kb[8]; sel_keys8(ka, pa + 8 * l16, 8 * l16); sel_keys8(kb, pb + 8 * l16, 8 * l16);
    ra = 0u; rb = 0u;
#pragma unroll
    for (int it = 0; it < 16; ++it) {
        const unsigned ma = row_umax(ka[0]), mb = row_umax(kb[0]); const bool oa = ka[0] == ma, ob = kb[0] == mb;
#pragma unroll
        for (int e = 0; e < 7; ++e) { ka[e] = oa ? ka[e + 1] : ka[e]; kb[e] = ob ? kb[e + 1] : kb[e]; }
        ka[7] = oa ? 0u : ka[7]; kb[7] = ob ? 0u : kb[7];
        ra = (l16 == it) ? ma : ra; rb = (l16 == it) ? mb : rb;
    }
}
struct SelP { const float* SC; int* ESEL; float* EGATE; int last; };
__device__ __forceinline__ void select_token(const _Float16* srow, int lane, int (&eidx)[2], float (&egate)[2]) {
    const int row = lane >> 4, l16 = lane & 15, rbase = lane & 48;
    const int i1 = (int)((0x3332222211111111ull >> (4 * l16)) & 15ull), j1 = (int)((0x2104321076543210ull >> (4 * l16)) & 15ull), i2 = (int)((0xdcba987766554443ull >> (4 * l16)) & 15ull), j2 = (int)((0x0000001010102103ull >> (4 * l16)) & 15ull);
#pragma unroll
    for (int G = 0; G < 2; ++G) {
                const _Float16* hrow = srow + (4 * G + row) * 256;
                unsigned recA, recB; top16_rows2(hrow, hrow + 128, l16, recA, recB);
                const float va = key2f(recA & ~127u), vb = key2f(recB & ~127u);
                const float a0 = bpermf(rbase, va), a1 = bpermf(rbase + i1, va), b1 = bpermf(rbase + j1, vb), a2 = bpermf(rbase + i2, va), b2 = bpermf(rbase + j2, vb), a3 = bpermf(rbase + 14 + (l16 & 1), va), b0 = bpermf(rbase, vb);
                unsigned ck[4];
                ck[0] = (f2key(a0 + vb) & ~255u) | (unsigned)l16; ck[1] = (f2key(a1 + b1) & ~255u) | (unsigned)(16 * i1 + j1); ck[2] = (f2key(a2 + b2) & ~255u) | (unsigned)(16 * i2 + j2);
                ck[3] = (l16 < 2) ? ((f2key(a3 + b0) & ~255u) | (unsigned)(16 * (14 + l16))) : 0u;
                SEL_CE(ck[0], ck[1]); SEL_CE(ck[2], ck[3]); SEL_CE(ck[0], ck[2]); SEL_CE(ck[1], ck[3]); SEL_CE(ck[1], ck[2]);
                unsigned rec = 0u;
#pragma unroll
                for (int it = 0; it < 16; ++it) {
                    const unsigned mh = row_umax(ck[0]); const bool own = ck[0] == mh;
                    ck[0] = own ? ck[1] : ck[0]; ck[1] = own ? ck[2] : ck[1]; ck[2] = own ? ck[3] : ck[2]; ck[3] = own ? 0u : ck[3];
                    rec = (l16 == it) ? mh : rec;
                }
                const float ts = key2f(rec & ~255u), tmax = bpermf(rbase, ts);
                const float ev = __expf(ts - tmax), esum = red16(ev);
                const int ci = (int)((rec >> 4) & 15u), cj = (int)(rec & 15u);
                const int expert = bpermi(rbase + ci, (int)(recA & 127u)) * 128 + bpermi(rbase + cj, (int)(recB & 127u));
                eidx[G] = expert; egate[G] = ev / esum;
    }
}
struct PeerP { const _Float16* SC; const float* nmod; const float* ng; bf16* Hout;   const int* ESEL; const float* EGATE; const bf16* H; const unsigned char* PU; const unsigned char* PV; const float* SU; const float* SV; bf16* X; const float* mod;   const float* fin_g; float* out; int last; int dry; };
__device__ __forceinline__ void peer_phase(Frame& F, const PeerP& P) {
    const int gw = F.vcu * NWAVES + F.wave, NGW = F.G * NWAVES, lane = F.lane;
    float pr_s2 = 0.f, pr_d2 = 0.f, pr_tg = 0.f, pr_n = 0.f;
    int m0 = gw; while (m0 < MALL && P.last && (m0 % TPB) < CTXL) m0 += NGW;
    v4u ph0 = {0u, 0u, 0u, 0u}, ph1 = ph0, ph2 = ph0, ph3 = ph0;
    if (m0 < MALL) { const bf16* hp = P.H + (size_t)m0 * DM + lane * 32; ph0 = *(const GAS v4u*)hp; ph1 = *(const GAS v4u*)(hp + 8); ph2 = *(const GAS v4u*)(hp + 16); ph3 = *(const GAS v4u*)(hp + 24); }
    for (int m = m0, mn = 0; m < MALL; m = mn) {
        mn = m + NGW; while (mn < MALL && P.last && (mn % TPB) < CTXL) mn += NGW;
        const int b = m / TPB, tp = m - b * TPB;
        const int mr = tp < CTXL ? 2 : b;
        const int emask_ = (P.dry & 2) ? 1023 : 0x7fffffff;
        int eidx[2]; float egate[2]; select_token(P.SC + (size_t)m * DM, lane, eidx, egate);
        eidx[0] &= emask_; eidx[1] &= emask_;
        typedef int v8i __attribute__((ext_vector_type(8)));
        LAS unsigned char* hq = F.lds + F.wave * 4096;
        { const v4u hv[4] = {ph0, ph1, ph2, ph3}; v4u o[2];
#pragma unroll
          for (int j = 0; j < 4; ++j) { int w0 = 0, w1 = 0;
              w0 = __builtin_amdgcn_cvt_pk_fp8_f32(bflo(hv[j].x), bfhi(hv[j].x), w0, false); w0 = __builtin_amdgcn_cvt_pk_fp8_f32(bflo(hv[j].y), bfhi(hv[j].y), w0, true);
              w1 = __builtin_amdgcn_cvt_pk_fp8_f32(bflo(hv[j].z), bfhi(hv[j].z), w1, false); w1 = __builtin_amdgcn_cvt_pk_fp8_f32(bflo(hv[j].w), bfhi(hv[j].w), w1, true);
              o[j >> 1][2 * (j & 1)] = (unsigned)w0; o[j >> 1][2 * (j & 1) + 1] = (unsigned)w1; }
          *(LAS v4u*)(hq + lane * 32) = o[0]; *(LAS v4u*)(hq + lane * 32 + 16) = o[1];
          unsigned z_ = 0u; asm volatile("" : "+v"(z_));
          if (lane < 2) *(LAS v4u*)(hq + 2048 + lane * 16) = (v4u){z_, z_, z_, z_}; }
        const int li = lane & 15, kb = lane >> 4;
        int rowoff[8];
#pragma unroll
        for (int g = 0; g < 8; ++g) rowoff[g] = bpermi(16 * (g & 3) + li, eidx[g >> 2]) * (DM / 2) + 16 * kb;
        f32x4 dacc[8];
#pragma unroll
        for (int g = 0; g < 8; ++g) dacc[g] = (f32x4){0.f, 0.f, 0.f, 0.f};
        const unsigned hb = (li == 0) ? (unsigned)(16 * kb) : 2048u;
        const unsigned hb2 = (li == 0) ? 64u : 16u;
        const unsigned hstep = (li == 0) ? 128u : 0u;
        v4u ua[8], ub[8];
#pragma unroll
        for (int g = 0; g < 8; ++g) ua[g] = *(const GAS v4u*)(P.PU + (unsigned)rowoff[g]);
#pragma unroll 1
        for (int s = 0; s < ((P.dry & 4) ? 2 : 16); s += 2) {
#pragma unroll
            for (int g = 0; g < 8; ++g) ub[g] = *(const GAS v4u*)(P.PU + (unsigned)(rowoff[g] + 64 * (s + 1)));
            { const v4u b0 = *(const LAS v4u*)(hq + hb + hstep * s), b1 = *(const LAS v4u*)(hq + hb + hstep * s + hb2);
              const v8i bf = {(int)b0.x, (int)b0.y, (int)b0.z, (int)b0.w, (int)b1.x, (int)b1.y, (int)b1.z, (int)b1.w};
#pragma unroll
              for (int g = 0; g < 8; ++g) { const v8i af = {(int)ua[g].x, (int)ua[g].y, (int)ua[g].z, (int)ua[g].w, 0, 0, 0, 0};
                  dacc[g] = __builtin_amdgcn_mfma_scale_f32_16x16x128_f8f6f4(af, bf, dacc[g], 4, 0, 0, 0x7f7f7f7f, 0, 0x7f7f7f7f); } }
            if (s + 2 < 16) {
#pragma unroll
                for (int g = 0; g < 8; ++g) ua[g] = *(const GAS v4u*)(P.PU + (unsigned)(rowoff[g] + 64 * (s + 2))); }
            { const v4u b0 = *(const LAS v4u*)(hq + hb + hstep * (s + 1)), b1 = *(const LAS v4u*)(hq + hb + hstep * (s + 1) + hb2);
              const v8i bf = {(int)b0.x, (int)b0.y, (int)b0.z, (int)b0.w, (int)b1.x, (int)b1.y, (int)b1.z, (int)b1.w};
#pragma unroll
              for (int g = 0; g < 8; ++g) { const v8i af = {(int)ub[g].x, (int)ub[g].y, (int)ub[g].z, (int)ub[g].w, 0, 0, 0, 0};
                  dacc[g] = __builtin_amdgcn_mfma_scale_f32_16x16x128_f8f6f4(af, bf, dacc[g], 4, 0, 0, 0x7f7f7f7f, 0, 0x7f7f7f7f); } }
        }
        float coef[2];
#pragma unroll
        for (int sl = 0; sl < 2; ++sl) { float mydot = 0.f;
#pragma unroll
            for (int g4 = 0; g4 < 4; ++g4)
#pragma unroll
                for (int r = 0; r < 4; ++r) { const float t = bpermf(16 * ((lane >> 2) & 3), dacc[4 * sl + g4][r]); if ((lane >> 4) == g4 && (lane & 3) == r) mydot = t; }
            mydot *= P.SU[eidx[sl]];
            if (DBG_PROBE == 4) {
                float ref = 0.f;
                for (int e = 0; e < 64; ++e) { const int ex = __builtin_amdgcn_readlane(eidx[sl], e); const v4u uu = *(const GAS v4u*)(P.PU + (size_t)ex * (DM / 2) + lane * 16); float s1 = 0.f;
                    const v4u hv2[4] = {*(const GAS v4u*)(P.H + (size_t)m * DM + lane * 32), *(const GAS v4u*)(P.H + (size_t)m * DM + lane * 32 + 8), *(const GAS v4u*)(P.H + (size_t)m * DM + lane * 32 + 16), *(const GAS v4u*)(P.H + (size_t)m * DM + lane * 32 + 24)};
#pragma unroll
                    for (int d = 0; d < 4; ++d) { const unsigned w = uu[d]; const unsigned hw[4] = {hv2[d].x, hv2[d].y, hv2[d].z, hv2[d].w};
                        f32x2 x = __builtin_amdgcn_cvt_scalef32_pk_f32_fp4(w, 1.0f, 0); s1 += x.x * bflo(hw[0]) + x.y * bfhi(hw[0]); x = __builtin_amdgcn_cvt_scalef32_pk_f32_fp4(w, 1.0f, 1); s1 += x.x * bflo(hw[1]) + x.y * bfhi(hw[1]);
                        x = __builtin_amdgcn_cvt_scalef32_pk_f32_fp4(w, 1.0f, 2); s1 += x.x * bflo(hw[2]) + x.y * bfhi(hw[2]); x = __builtin_amdgcn_cvt_scalef32_pk_f32_fp4(w, 1.0f, 3); s1 += x.x * bflo(hw[3]) + x.y * bfhi(hw[3]); }
                    const float tot = wave_sum_u(s1) * P.SU[ex]; if (lane == e) ref = tot; }
                pr_s2 = fmaxf(pr_s2, wave_max_u(fabsf(mydot - ref) / (fabsf(ref) + 0.25f))); pr_n = 1.f; }
            coef[sl] = egate[sl] * 0.5f * mydot * (1.0f + erff(mydot * 0.70710678f));
            if ((DBG_SKIP & 16) && sl == 0) coef[sl] = 0.f;
            if ((DBG_SKIP & 32) && sl == 1) coef[sl] = 0.f;
        }
        const float coefs[2] = {coef[0] * P.SV[eidx[0]], coef[1] * P.SV[eidx[1]]};
        f32x2 acc2[16];
#pragma unroll
        for (int i = 0; i < 16; ++i) acc2[i] = (f32x2){0.f, 0.f};
#define PEER_LOADV(U, C, e0_) do { const int e1_ = (e0_); const int ev_ = (e1_ & 64) ? eidx[1] : eidx[0]; const int cv_ = __builtin_bit_cast(int, (e1_ & 64) ? coefs[1] : coefs[0]); \
            _Pragma("unroll") for (int q = 0; q < 8; ++q) { const int ex = __builtin_amdgcn_readlane(ev_, (e1_ & 63) + q); U[q] = *(const GAS v4u*)(P.PV + (size_t)ex * (DM / 2) + lane * 16); \
            C[q] = __builtin_bit_cast(float, __builtin_amdgcn_readlane(cv_, (e1_ & 63) + q)); } } while (0)
#define PEER_AXPY(U, C) do { if (P.dry & 32) { _Pragma("unroll") for (int q = 0; q < 8; ++q) _Pragma("unroll") for (int d = 0; d < 4; ++d) acc2[d].x += __builtin_bit_cast(float, U[q][d] & 0x3fffffffu) * C[q]; } else \
            _Pragma("unroll") for (int q = 0; q < 8; ++q) _Pragma("unroll") for (int d = 0; d < 4; ++d) { const unsigned w = U[q][d]; \
            acc2[4 * d + 0] = __builtin_amdgcn_cvt_scalef32_pk_f32_fp4(w, 1.0f, 0) * C[q] + acc2[4 * d + 0]; acc2[4 * d + 1] = __builtin_amdgcn_cvt_scalef32_pk_f32_fp4(w, 1.0f, 1) * C[q] + acc2[4 * d + 1]; \
            acc2[4 * d + 2] = __builtin_amdgcn_cvt_scalef32_pk_f32_fp4(w, 1.0f, 2) * C[q] + acc2[4 * d + 2]; acc2[4 * d + 3] = __builtin_amdgcn_cvt_scalef32_pk_f32_fp4(w, 1.0f, 3) * C[q] + acc2[4 * d + 3]; } } while (0)
        if (mn < MALL) {
            const bf16* hp = P.H + (size_t)mn * DM + lane * 32; ph0 = *(const GAS v4u*)hp; ph1 = *(const GAS v4u*)(hp + 8); ph2 = *(const GAS v4u*)(hp + 16); ph3 = *(const GAS v4u*)(hp + 24); }
        v4u xpre[4];
        { const bf16* xr0 = P.X + (size_t)m * DM + lane * 32;
#pragma unroll
          for (int hq = 0; hq < 4; ++hq) xpre[hq] = *(const GAS v4u*)(xr0 + hq * 8); }
        {
            v4u ua[8], ub[8]; float ca[8], cb[8];
            PEER_LOADV(ua, ca, 0);
#pragma unroll 1
            for (int it = 0; it < ((P.dry & 8) ? 2 : 8); ++it) {
                PEER_LOADV(ub, cb, 16 * it + 8); PEER_AXPY(ua, ca);
                if (it < 7) PEER_LOADV(ua, ca, 16 * it + 16);
                PEER_AXPY(ub, cb);
            }
        }
#undef PEER_LOADV
#undef PEER_AXPY
        float acc[32];
#pragma unroll
        for (int i = 0; i < 16; ++i) { acc[2 * i] = acc2[i].x; acc[2 * i + 1] = acc2[i].y; }
        if (P.dry) { float sm_ = 0.f;
#pragma unroll
            for (int i = 0; i < 32; ++i) sm_ += acc[i];
            if (sm_ == 1.2345e-30f) P.X[lane] = sm_;
            if (!(P.dry & 16)) continue; }
        if (DBG_SKIP & 1) {
#pragma unroll
            for (int i = 0; i < 32; ++i) acc[i] = 0.f; }
        if (((DBG_SKIP & 64) && !P.last) || ((DBG_SKIP & 128) && P.last)) {
#pragma unroll
            for (int i = 0; i < 32; ++i) acc[i] = 0.f; }
        if (DBG_SKIP & 8) {
#pragma unroll
            for (int i = 0; i < 32; ++i) acc[i] = -acc[i]; }
        int m_l = m, lane_l = lane; asm volatile("" : "+v"(m_l), "+v"(lane_l));
        const int b_l = m_l / TPB, tp_l = m_l - b_l * TPB, mr_l = tp_l < CTXL ? 2 : b_l;
        bf16* xr = (P.dry ? (bf16*)(F.ws + 760 * MiB) : P.X) + (size_t)m_l * DM + lane_l * 32; const float* g2 = P.mod + (size_t)mr_l * 12288 + 5 * DM + lane_l * 32;
        float ss = 0.f;
#pragma unroll
        for (int hq = 0; hq < 4; ++hq) { const int c = hq * 8; float xf[8]; unpack8(xpre[hq], xf);
            const f32x4 g0 = *(const GAS f32x4*)(g2 + c), g1 = *(const GAS f32x4*)(g2 + c + 4);
#pragma unroll
            for (int e = 0; e < 8; ++e) { const float xv = xf[e] + (e < 4 ? g0[e & 3] : g1[e & 3]) * acc[8 * hq + e]; ss += xv * xv; acc[8 * hq + e] = xv; xf[e] = xv; }
            if (!P.last) *(GAS v4u*)(xr + c) = pack8f(xf); }
        if (!P.last) {
            const float rs = rsqrtf(wave_sum(ss) * (1.f / DM) + NORM_EPS); const float* sh = P.nmod + (size_t)mr_l * 12288 + lane_l * 32; const float* sc = sh + DM; const float* ngp = P.ng + lane_l * 32;
            bf16* ho = (P.dry ? (bf16*)(F.ws + 892 * MiB) : P.Hout) + (size_t)m_l * DM + lane_l * 32;
#pragma unroll
            for (int hq = 0; hq < 4; ++hq) { const int c = hq * 8; float y[8];
                const f32x4 n0 = *(const GAS f32x4*)(ngp + c), n1 = *(const GAS f32x4*)(ngp + c + 4), s0 = *(const GAS f32x4*)(sc + c), s1 = *(const GAS f32x4*)(sc + c + 4), h0 = *(const GAS f32x4*)(sh + c), h1 = *(const GAS f32x4*)(sh + c + 4);
#pragma unroll
                for (int e = 0; e < 4; ++e) { y[e] = acc[8 * hq + e] * rs * n0[e] * (1.0f + s0[e]) + h0[e]; y[4 + e] = acc[8 * hq + 4 + e] * rs * n1[e] * (1.0f + s1[e]) + h1[e]; }
                *(GAS v4u*)(ho + c) = pack8f(y); } }
        if (P.last) { const float rs = rsqrtf(wave_sum(ss) * (1.f / DM) + NORM_EPS); float* orow = P.out + ((size_t)b_l * SEQ + (tp_l - CTXL)) * DM + lane_l * 32; const float* fgp = P.fin_g + lane_l * 32;
#pragma unroll
            for (int hq = 0; hq < 8; ++hq) { const int c = hq * 4; const f32x4 fg = *(const GAS f32x4*)(fgp + c);
                f32x4 o;
#pragma unroll
                for (int e = 0; e < 4; ++e) o[e] = acc[4 * hq + e] * rs * fg[e];
                *(GAS f32x4*)(orow + c) = o; } }
    }
    if (DBG_PROBE && DBG_PROBE != 5 && !P.last && lane == 0) { float* pp = (float*)(F.ws + WS_CTL + CTL_PROBE_OFF) + gw * 4; pp[0] = pr_s2; pp[1] = pr_d2; pp[2] = pr_tg; pp[3] = pr_n; }
}


constexpr int PH_PER_LAYER = 12, NPHASE = 1 + NLAYER * PH_PER_LAYER;
#ifndef ONLY_PHASE
#define ONLY_PHASE -1
#endif
#define T0() (wave_s == 0 && pg8::opaque_lane() == 0)
#define PH_ON(k) (ONLY_PHASE < 0 || ONLY_PHASE == (k))
#define GEMM_CALL(EPI, SCHED, g, S, E) pg8::gemm_phase<EPI, SCHED, true, true>(F.lds, g, S, E, wave_s)
#define GEMM_CALL_NA(EPI, SCHED, g, S, E) pg8::gemm_phase<EPI, SCHED, false, true>(F.lds, g, S, E, wave_s)

__device__ __forceinline__ const float* karg(int i) {
    asm volatile("" : "+s"(i));
    const __attribute__((address_space(4))) unsigned long long* ka = (const __attribute__((address_space(4))) unsigned long long*)__builtin_amdgcn_kernarg_segment_ptr();
    return (const float*)ka[i];
}
__global__ void __launch_bounds__(NWAVES * 64, 2) mk_fwd(Args args) {
    extern __shared__ __attribute__((aligned(16))) unsigned char lds[];
    Frame F;
    F.lds = (LAS unsigned char*)lds; F.ws = args.ws;
    const int wave_s = __builtin_amdgcn_readfirstlane((int)threadIdx.x >> 6);
    F.tid = threadIdx.x; F.lane = F.tid & 63; F.wave = wave_s;
    F.G = gridDim.x; { const int bx = blockIdx.x; F.vcu = (F.G % 8 == 0) ? (bx % 8) * (F.G / 8) + bx / 8 : bx; }
    unsigned char* ws = args.ws;
    volatile LAS unsigned* MISC = (volatile LAS unsigned*)(F.lds + MISC_OFF);
    for (int u = F.tid; u < (LDS_BYTES - LDSCTL_OFF) / 4; u += NWAVES * 64) ((LAS unsigned*)(F.lds + LDSCTL_OFF))[u] = 0u;
    __syncthreads();
    const int lo = args.ph_lo, hi = args.ph_hi;
    XcdBarrier bar; bar.bar = (unsigned*)(ws + WS_CTL) + CW_BAR; bar.x = 0; bar.st = nullptr;
    if (hi - lo > 1) bar = xcd_barrier_post((unsigned*)(ws + WS_CTL) + CW_BAR, MISC + 8, T0());
#define IN(k) (lo <= (k) && (k) < hi)
#define REFRAME() do { const int lz_ = pg8::opaque_lane(); F.lane = lz_; F.tid = wave_s * 64 + lz_; F.wave = wave_s; ws = (unsigned char*)karg(34); F.ws = ws; { int g_ = (int)gridDim.x, b_ = (int)blockIdx.x; asm volatile("" : "+s"(g_), "+s"(b_)); bx = b_; F.G = g_; F.vcu = ((g_ & 7) == 0) ? (b_ & 7) * (g_ >> 3) + (b_ >> 3) : b_; } } while (0)
#define SEAM(k) do { if (IN((k) + 1)) xcd_barrier(bar, T0()); } while (0)
#define XBUF ((bf16*)(ws + WS_X))
#define HBUF ((bf16*)(ws + WS_H))
#define MODP ((const float*)(ws + WS_CTL + CTL_MOD_OFF) + (size_t)l * 3 * 12288)
    int bx = (int)blockIdx.x;

    for (int rep_ = 0; rep_ < ((DBG_REPEAT == 100) ? 2 : 1); ++rep_) if (PH_ON(100) && IN(0)) { REFRAME(); if (rep_) xcd_barrier(bar, T0()); p0_prologue(F, 0, (MK_N_LAUNCHES == 1) ? 1 : NLAYER, F.vcu, F.G); SEAM(0); if (DBG_REPEAT == 200) { for (int i_ = 0; i_ < 32; ++i_) xcd_barrier(bar, T0()); } }

    for (int l = 0; l < NLAYER; ++l) {
        const int base = 1 + l * PH_PER_LAYER;
        const int last = (l == NLAYER - 1);
        for (int rep_ = 0; rep_ < ((DBG_REPEAT == 0) ? 2 : 1); ++rep_) if (PH_ON(0) && IN(base + 0) && l == 0) { REFRAME(); if (rep_) xcd_barrier(bar, T0()); modnorm_phase(F, nullptr, karg(6) + (size_t)l * DM, MODP, 0, HBUF, 0, karg(0), karg(2)); SEAM(base + 0); }
        for (int rep_ = 0; rep_ < ((DBG_REPEAT == 1) ? 2 : 1); ++rep_) if (PH_ON(1) && IN(base + 1)) { REFRAME(); if (rep_) xcd_barrier(bar, T0());
            pg8::Gemm g{HBUF, (const bf16*)(ws + WS_WINA) + (size_t)l * INA_P * DM, MALL, INA_P, DM}; pg8::RowOrder S; S.init_rows(0, INA_P, F.G, bx);
            pg8::EpiStoreBf16 E{(bf16*)(ws + WS_PA), INA_P};
            GEMM_CALL(pg8::EpiStoreBf16, pg8::RowOrder, g, S, E);
            SEAM(base + 1); }
        for (int rep_ = 0; rep_ < ((DBG_REPEAT == 2) ? 2 : 1); ++rep_) if (PH_ON(2) && IN(base + 2)) { REFRAME(); if (rep_) xcd_barrier(bar, T0());
            FeatP P;
            P.PA = (const bf16*)(ws + WS_PA); P.mu = karg(9) + (size_t)l * RWC; P.w0 = karg(10) + (size_t)l * 2 * RW; P.a0 = karg(12) + (size_t)l * 2 * RW;
            P.k_k = karg(15) + (size_t)l * RW; P.k_a = karg(16) + (size_t)l * RW; P.r_k = karg(17) + (size_t)l * RW;
            P.WUP = (const bf16*)(ws + WS_WUP) + (size_t)l * 2 * RW * 64; P.AUP = (const bf16*)(ws + WS_AUP) + (size_t)l * 2 * RW * 64; P.GUP = (const bf16*)(ws + WS_GUP) + (size_t)l * 2 * RW * 32;
            P.qnorm = karg(20) + (size_t)l * 512; P.kvnorm = karg(22) + (size_t)l * 256; P.rope = (const f32x2*)(ws + WS_ROPE);
            P.RI = (bf16*)(ws + WS_RI); P.GG = (bf16*)(ws + WS_GG); P.BON = (float*)(ws + WS_BON); P.QN = (bf16*)(ws + WS_QN); P.KVN = (bf16*)(ws + WS_KVN); P.K = (bf16*)(ws + WS_K);
            features_phase(F, P);
            SEAM(base + 2); }
        for (int rep_ = 0; rep_ < ((DBG_REPEAT == 3) ? 2 : 1); ++rep_) if (PH_ON(3) && IN(base + 3)) { REFRAME(); if (rep_) xcd_barrier(bar, T0());
            { pg8::Gemm g{(const bf16*)(ws + WS_QN), (const bf16*)(ws + WS_WUQ) + (size_t)l * NQ * 512, MALL, NQ, 512};
              pg8::EpiQ E{(bf16*)(ws + WS_Q), (const f32x2*)(ws + WS_ROPE), 0.14724444f};
              pg8::RowOrder S; S.init_rows(last, NQ, F.G, bx); GEMM_CALL_NA(pg8::EpiQ, pg8::RowOrder, g, S, E); }
            { pg8::Gemm g{(const bf16*)(ws + WS_KVN), (const bf16*)(ws + WS_WUKV) + (size_t)l * NKV * 256, MALL, NKV, 256}; pg8::RowOrder S; S.init_rows(0, NKV, F.G, bx);
              pg8::EpiKV E{(bf16*)(ws + WS_K), (bf16*)(ws + WS_V)};
              GEMM_CALL_NA(pg8::EpiKV, pg8::RowOrder, g, S, E); }
            SEAM(base + 3); }
        for (int rep_ = 0; rep_ < ((DBG_REPEAT == 4) ? 2 : 1); ++rep_) if (PH_ON(4) && IN(base + 4)) { REFRAME(); if (rep_) xcd_barrier(bar, T0());
            ScanCvt C; C.pu = karg(30) + (size_t)l * NEXP * DM; C.pv = karg(31) + (size_t)l * NEXP * DM; C.PU8 = ws + WS_P4; C.PV8 = ws + WS_P4 + (size_t)NEXP * (DM / 2); C.SU = (float*)(ws + WS_P4S); C.SV = (float*)(ws + WS_P4S) + NEXP; C.wl = (MK_N_LAUNCHES == 1 && l + 1 < NLAYER && F.G == 256) ? l + 1 : -1;
            scan_phase(F, (const bf16*)(ws + WS_RI), (bf16*)(ws + WS_Y), C); SEAM(base + 4); }
        for (int rep_ = 0; rep_ < ((DBG_REPEAT == 5) ? 2 : 1); ++rep_) if (PH_ON(5) && IN(base + 5)) { REFRAME(); if (rep_) xcd_barrier(bar, T0());
            attn_phase(F, (const bf16*)(ws + WS_Q), (const bf16*)(ws + WS_K), (const bf16*)(ws + WS_V), (bf16*)(ws + WS_YB), !last);
            readout_phase(F, (const bf16*)(ws + WS_Y), (const bf16*)(ws + WS_GG), (const float*)(ws + WS_BON), (const bf16*)(ws + WS_RI), karg(18) + (size_t)l * RW, karg(19) + (size_t)l * RW, (bf16*)(ws + WS_YA));
            SEAM(base + 5); }
        for (int rep_ = 0; rep_ < ((DBG_REPEAT == 6) ? 2 : 1); ++rep_) if (PH_ON(6) && IN(base + 6)) { REFRAME(); if (rep_) xcd_barrier(bar, T0());
            bf16* T1 = (bf16*)(ws + WS_T1); bf16* T2 = (bf16*)(ws + WS_T2);
            const pg8::Gemm g1{HBUF, (const bf16*)(ws + WS_WGA) + (size_t)l * DM * DM, MALL, DM, DM}, g2{(const bf16*)(ws + WS_YA), (const bf16*)(ws + WS_WA) + (size_t)l * DM * RW, MALL, DM, RW};
            const pg8::Gemm g3{HBUF, (const bf16*)(ws + WS_WGB) + (size_t)l * DM * DM, MALL, DM, DM}, g4{(const bf16*)(ws + WS_YB), (const bf16*)(ws + WS_WB) + (size_t)l * DM * RW, MALL, DM, RW};
            const pg8::EpiGate E1{T1, DM, karg(8) + (size_t)l * 2 * DM}, E3{T2, DM, karg(8) + (size_t)l * 2 * DM + DM};
            const pg8::EpiMulAdd E2{T1, T1, nullptr, DM}, E4{T1, T2, T1, DM};
            const bool split = CTX_SPLIT && !last && F.G >= 128;
            pg8::RowOrder S; S.init_rows(last || split, DM, F.G, bx);
            GEMM_CALL(pg8::EpiGate, pg8::RowOrder, g1, S, E1); GEMM_CALL(pg8::EpiMulAdd, pg8::RowOrder, g2, S, E2); GEMM_CALL(pg8::EpiGate, pg8::RowOrder, g3, S, E3); GEMM_CALL(pg8::EpiMulAdd, pg8::RowOrder, g4, S, E4);
            if (split) {
                pg8::CtxOrder Sg, Sp; Sg.u0 = (bx < 32) ? (bx & 15) : -1; Sp.u0 = (bx >= 32 && bx < 64) ? (bx & 15) : -1;
                const bool second = (bx & 16) != 0;
                const pg8::Gemm gg = second ? g3 : g1, gp = second ? g4 : g2;
                const pg8::EpiGate EG = second ? E3 : E1;
                const pg8::EpiCtxF32 EP{(float*)(ws + (second ? WS_CB : WS_CA)), DM};
                GEMM_CALL(pg8::EpiGate, pg8::CtxOrder, gg, Sg, EG); GEMM_CALL(pg8::EpiCtxF32, pg8::CtxOrder, gp, Sp, EP); }
            if (MK_N_LAUNCHES == 1 && l == 0 && rep_ == 0) { __syncthreads();
                const int late = split ? 64 : (F.G > 32) ? 16 : 0; p0_prologue(F, 1, NLAYER, (bx >= late) ? bx - late : -1, F.G - late, (F.G == 256) ? 0 : 1); }
            SEAM(base + 6); }
        for (int rep_ = 0; rep_ < ((DBG_REPEAT == 7) ? 2 : 1); ++rep_) if (PH_ON(7) && IN(base + 7)) { REFRAME(); if (rep_) xcd_barrier(bar, T0());
            if (CTX_SPLIT && !last && F.G >= 128 && rep_ == 0) {
                bf16* T1 = (bf16*)(ws + WS_T1); const bf16* T2 = (const bf16*)(ws + WS_T2); const float* CA = (const float*)(ws + WS_CA); const float* CB = (const float*)(ws + WS_CB);
                for (int e = bx * (NWAVES * 64) + F.tid; e < 512 * (DM / 8); e += F.G * (NWAVES * 64)) { const int r = e >> 8, c0 = (e & 255) * 8; const size_t go = (size_t)((r < 256) ? r : 33 * 256 + (r - 256)) * DM + c0;
                    const v4u ga = *(const GAS v4u*)(T1 + go), gb = *(const GAS v4u*)(T2 + go);
                    const f32x4 a0 = *(const GAS f32x4*)(CA + (size_t)r * DM + c0), a1 = *(const GAS f32x4*)(CA + (size_t)r * DM + c0 + 4), b0 = *(const GAS f32x4*)(CB + (size_t)r * DM + c0), b1 = *(const GAS f32x4*)(CB + (size_t)r * DM + c0 + 4);
                    v4u o;
                    o.x = pk2(bflo(ga.x) * a0[0] + bflo(gb.x) * b0[0], bfhi(ga.x) * a0[1] + bfhi(gb.x) * b0[1]); o.y = pk2(bflo(ga.y) * a0[2] + bflo(gb.y) * b0[2], bfhi(ga.y) * a0[3] + bfhi(gb.y) * b0[3]);
                    o.z = pk2(bflo(ga.z) * a1[0] + bflo(gb.z) * b1[0], bfhi(ga.z) * a1[1] + bfhi(gb.z) * b1[1]); o.w = pk2(bflo(ga.w) * a1[2] + bflo(gb.w) * b1[2], bfhi(ga.w) * a1[3] + bfhi(gb.w) * b1[3]);
                    *(GAS v4u*)(T1 + go) = o; }
                xcd_barrier(bar, T0()); }
            const pg8::Gemm g{(const bf16*)(ws + WS_T1), (const bf16*)(ws + WS_WO) + (size_t)l * DM * DM, MALL, DM, DM};
            const pg8::EpiResid E{XBUF, MODP + 2 * DM, l == 0 ? karg(0) : nullptr, l == 0 ? karg(2) : nullptr};
            pg8::RowOrder S; S.init_rows(last, DM, F.G, bx); GEMM_CALL(pg8::EpiResid, pg8::RowOrder, g, S, E);
            SEAM(base + 7); }
        for (int rep_ = 0; rep_ < ((DBG_REPEAT == 8) ? 2 : 1); ++rep_) if (PH_ON(8) && IN(base + 8)) { REFRAME(); if (rep_) xcd_barrier(bar, T0());
            modnorm_phase_bf(F, XBUF, karg(27) + (size_t)l * DM, MODP, 3, HBUF, last);
            SEAM(base + 8); }
        for (int rep_ = 0; rep_ < ((DBG_REPEAT == 9) ? 2 : 1); ++rep_) if (PH_ON(9) && IN(base + 9)) { REFRAME(); if (rep_) xcd_barrier(bar, T0());
            const pg8::Gemm g{HBUF, (const bf16*)(ws + WS_WQK) + (size_t)l * DM * DM, MALL, DM, DM};
            const pg8::EpiF16 E{(_Float16*)(ws + WS_SC), DM};
            pg8::RowOrder S; S.init_rows(last, DM, F.G, bx); GEMM_CALL(pg8::EpiF16, pg8::RowOrder, g, S, E);
            SEAM(base + 9); }
        for (int rep_ = 0; rep_ < ((DBG_REPEAT == 11) ? 2 : 1); ++rep_) if (PH_ON(11) && IN(base + 11)) { REFRAME(); if (rep_) xcd_barrier(bar, T0());
            PeerP P; P.SC = (const _Float16*)(ws + WS_SC); P.nmod = MODP + 3 * 12288; P.ng = karg(6) + (size_t)(l + 1) * DM; P.Hout = HBUF; P.ESEL = (const int*)(ws + WS_T1); P.EGATE = (const float*)(ws + WS_T1 + 16 * MiB); P.H = HBUF; P.PU = ws + WS_P4; P.PV = ws + WS_P4 + (size_t)NEXP * (DM / 2); P.SU = (const float*)(ws + WS_P4S); P.SV = (const float*)(ws + WS_P4S) + NEXP; P.X = XBUF; P.mod = MODP; P.fin_g = karg(32); P.out = (float*)karg(33); P.last = last; P.dry = (DBG_REPEAT == 11 && rep_ == 0) ? DBG_DRY : 0;
            peer_phase(F, P);
            SEAM(base + 11); }
    }
#undef IN
#undef SEAM
#undef XBUF
#undef HBUF
#undef MODP
}

__device__ __forceinline__ float mx_a_val(int i, int k) { const int c = (i * 131 + k * 17 + (k >> 3) * 5) & 15; const float mag[8] = {0.f, .5f, 1.f, 1.5f, 2.f, 3.f, 4.f, 6.f}; return (c & 8) ? -mag[c & 7] : mag[c & 7]; }
__device__ __forceinline__ int mx_a_code(int i, int k) { return (i * 131 + k * 17 + (k >> 3) * 5) & 15; }
__device__ __forceinline__ float mx_b_val(int k, int j) { return (float)(((k * 7 + j * 13 + (k >> 4)) % 9) - 4); }
__device__ __forceinline__ int mx_kmap(int hyp, int kb, int e) { const int h = hyp % 3; return h == 0 ? 32 * kb + e : h == 1 ? 32 * (e >> 3) + 8 * kb + (e & 7) : 64 * (e >> 4) + 16 * kb + (e & 15); }
__global__ void __launch_bounds__(512) dbg_fill(const float* pp, float* o) {
    __shared__ float vsh;
    float v = 0.f;
    if (DBG_PROBE == 5) {
        if (threadIdx.x < 64) { typedef int v8i __attribute__((ext_vector_type(8))); typedef float f4 __attribute__((ext_vector_type(4)));
            const int lane = threadIdx.x, i = lane & 15, kb = lane >> 4; float code = 0.f;
            for (int hyp = 0; hyp < 18; ++hyp) { const int nibswap = hyp / 9, ha = hyp % 3, hb2 = (hyp / 3) % 3;
                unsigned aw[4] = {0u, 0u, 0u, 0u}; int bw[8] = {0, 0, 0, 0, 0, 0, 0, 0};
                for (int e = 0; e < 32; ++e) { const int k = mx_kmap(ha, kb, e); const unsigned c = (unsigned)mx_a_code(i, k); const int pos = nibswap ? (e ^ 1) : e; aw[pos >> 3] |= c << (4 * (pos & 7)); }
                for (int q = 0; q < 8; ++q) { int w = 0; const float f0 = mx_b_val(mx_kmap(hb2, kb, 4 * q + 0), i), f1 = mx_b_val(mx_kmap(hb2, kb, 4 * q + 1), i), f2 = mx_b_val(mx_kmap(hb2, kb, 4 * q + 2), i), f3 = mx_b_val(mx_kmap(hb2, kb, 4 * q + 3), i);
                    w = __builtin_amdgcn_cvt_pk_fp8_f32(f0, f1, w, false); w = __builtin_amdgcn_cvt_pk_fp8_f32(f2, f3, w, true); bw[q] = w; }
                const v8i af = {(int)aw[0], (int)aw[1], (int)aw[2], (int)aw[3], 0, 0, 0, 0}, bf = {bw[0], bw[1], bw[2], bw[3], bw[4], bw[5], bw[6], bw[7]};
                f4 d = {0.f, 0.f, 0.f, 0.f};
                d = __builtin_amdgcn_mfma_scale_f32_16x16x128_f8f6f4(af, bf, d, 4, 0, 0, 0x7f7f7f7f, 0, 0x7f7f7f7f);
                int bad = 0;
                for (int r = 0; r < 4; ++r) { const int row = 4 * kb + r, col = i; float ex = 0.f; for (int k = 0; k < 128; ++k) ex += mx_a_val(row, k) * mx_b_val(k, col); bad += (d[r] != ex); }
                if (__ballot(bad != 0) == 0ull && code == 0.f) code = (float)(hyp + 1); }
            for (int t = 0; t < 2; ++t) {
                int aw[8] = {0, 0, 0, 0, 0, 0, 0, 0}, bw[8] = {0, 0, 0, 0, 0, 0, 0, 0};
                if (t == 0) { for (int e = 0; e < 32; ++e) { const int k = 32 * kb + e; aw[e >> 3] |= mx_a_code(i, k) << (4 * (e & 7)); bw[e >> 3] |= mx_a_code(i + 16, k) << (4 * (e & 7)); } }
                else { for (int q = 0; q < 8; ++q) { int w = 0, w2 = 0; const int k = 32 * kb + 4 * q;
                        w = __builtin_amdgcn_cvt_pk_fp8_f32(mx_b_val(k, i + 16), mx_b_val(k + 1, i + 16), w, false); w = __builtin_amdgcn_cvt_pk_fp8_f32(mx_b_val(k + 2, i + 16), mx_b_val(k + 3, i + 16), w, true); aw[q] = w;
                        w2 = __builtin_amdgcn_cvt_pk_fp8_f32(mx_b_val(k, i), mx_b_val(k + 1, i), w2, false); w2 = __builtin_amdgcn_cvt_pk_fp8_f32(mx_b_val(k + 2, i), mx_b_val(k + 3, i), w2, true); bw[q] = w2; } }
                const v8i af = {aw[0], aw[1], aw[2], aw[3], aw[4], aw[5], aw[6], aw[7]}, bf = {bw[0], bw[1], bw[2], bw[3], bw[4], bw[5], bw[6], bw[7]};
                f4 d = {0.f, 0.f, 0.f, 0.f};
                if (t == 0) d = __builtin_amdgcn_mfma_scale_f32_16x16x128_f8f6f4(af, bf, d, 4, 4, 0, 0x7f7f7f7f, 0, 0x7f7f7f7f); else d = __builtin_amdgcn_mfma_scale_f32_16x16x128_f8f6f4(af, bf, d, 0, 0, 0, 0x7f7f7f7f, 0, 0x7f7f7f7f);
                int bad = 0;
                for (int r = 0; r < 4; ++r) { const int row = 4 * kb + r, col = i; float ex = 0.f;
                    for (int k = 0; k < 128; ++k) ex += (t == 0) ? mx_a_val(row, k) * mx_a_val(col + 16, k) : mx_b_val(k, row + 16) * mx_b_val(k, col);
                    bad += (d[r] != ex); }
                if (__ballot(bad != 0) == 0ull) code += (t == 0) ? 10.f : 20.f; }
            if (lane == 0) vsh = code; }
        __syncthreads(); v = vsh;
    } else {
        float s0 = 0.f, s1 = 0.f, s2 = 0.f, s3 = 0.f;
        for (int i = 0; i < 2048; ++i) { s0 += pp[4 * i]; s1 += pp[4 * i + 1]; s2 += pp[4 * i + 2]; s3 += pp[4 * i + 3]; }
        if (DBG_PROBE == 4) { float mx = 0.f; for (int i = 0; i < 2048; ++i) mx = fmaxf(mx, pp[4 * i]); v = 100.f * mx; }
        else { v = (DBG_PROBE == 1 ? s0 : DBG_PROBE == 2 ? s1 : s2) / s3 * 1e-3f; v = exp2f(rintf(log2f(v) * 4.f) * 0.25f); }
    }
    for (size_t i = (size_t)blockIdx.x * 512 + threadIdx.x; i < (size_t)NBATCH * SEQ * DM; i += (size_t)gridDim.x * 512) o[i] = v;
}
extern "C" void kernel_launch(void* const* d_in, const int* in_sizes, int n_in, void* d_out, int out_size, void* d_ws, size_t ws_size, hipStream_t stream) {
    static int grid = 0;
    if (grid == 0) {
        if (n_in != 33 || out_size != NBATCH * SEQ * DM || ws_size < WS_END2) { fprintf(stderr, "kernel_launch: unexpected shapes (n_in %d out %d ws %zu)\n", n_in, out_size, ws_size); grid = -1; return; }
        int dev = 0, cus = 0, per_cu = 0;
        if (hipGetDevice(&dev) != hipSuccess || hipDeviceGetAttribute(&cus, hipDeviceAttributeMultiprocessorCount, dev) != hipSuccess) { grid = -1; return; }
        if (hipFuncSetAttribute((const void*)mk_fwd, hipFuncAttributeMaxDynamicSharedMemorySize, LDS_BYTES) != hipSuccess) { fprintf(stderr, "kernel_launch: hipFuncSetAttribute failed\n"); grid = -1; return; }
        if (hipOccupancyMaxActiveBlocksPerMultiprocessor(&per_cu, (const void*)mk_fwd, NWAVES * 64, LDS_BYTES) != hipSuccess || per_cu < 1) { fprintf(stderr, "kernel_launch: occupancy query says %d\n", per_cu); (void)hipGetLastError(); grid = -1; return; }
        grid = cus;
    }
    if (grid < 0) return;
    if (hipMemsetAsync((char*)d_ws + WS_CTL, 0, CTL_ZERO_BYTES, stream) != hipSuccess) return;
    Args a{};
    for (int i = 0; i < 33; ++i) a.in[i] = (const float*)d_in[i];
    a.out = (float*)d_out; a.ws = (unsigned char*)d_ws;
#if MK_N_LAUNCHES == 1
    a.ph_lo = 0; a.ph_hi = NPHASE;
    hipLaunchKernelGGL(mk_fwd, dim3(grid), dim3(NWAVES * 64), LDS_BYTES, stream, a);
#else
    if (DBG_PROBE != 5) for (int p = 0; p < NPHASE; ++p) { a.ph_lo = p; a.ph_hi = p + 1; hipLaunchKernelGGL(mk_fwd, dim3(grid), dim3(NWAVES * 64), LDS_BYTES, stream, a); }
    if (DBG_PROBE) hipLaunchKernelGGL(dbg_fill, dim3(1024), dim3(512), 0, stream, (const float*)((char*)d_ws + WS_CTL + CTL_PROBE_OFF), (float*)d_out);
#endif
}
```

```cpp
#include <hip/hip_runtime.h>
#include <cstdio>
#include <cstdint>

#ifndef MK_N_LAUNCHES
#define MK_N_LAUNCHES 1
#endif

#ifndef DBG_SKIP
#define DBG_SKIP 0
#endif
#ifndef DBG_PROBE
#define DBG_PROBE 0
#endif
#ifndef DBG_DRY
#define DBG_DRY 1
#endif
#ifndef DBG_REPEAT
#define DBG_REPEAT -1
#endif
namespace pg8 {
#define PG8_LAS __attribute__((address_space(3)))
typedef unsigned short bf16_t;
typedef short bf16x8 __attribute__((ext_vector_type(8)));
typedef float f32x4 __attribute__((ext_vector_type(4)));
typedef unsigned u32x4 __attribute__((ext_vector_type(4)));
constexpr int BM = 256, BK = 64, HALF = 128, HTB = HALF * BK * 2  , STAGE_BYTES = 8 * HTB, NXCD = 8, WGM = 8;

__host__ __device__ __forceinline__ int lds_byte(int r, int c) { const int st = (r >> 4) * 2 + (c >> 5), rr = r & 15, cc = c & 31, ob = rr * 64 + cc * 2; return st * 1024 + (ob ^ (((ob >> 9) & 1) << 5)); }
__host__ __device__ __forceinline__ void stage_rc(int b, int& R, int& C) { const int st = b / 1024, sb = b % 1024, swz = sb ^ (((sb >> 9) & 1) << 5); R = (st >> 1) * 16 + swz / 64; C = (st & 1) * 32 + (swz % 64) / 2; }
__host__ __device__ __forceinline__ int perm32(int rho) { const int n = rho >> 4, i = rho & 15; return 8 * (i >> 2) + 4 * n + (i & 3); }

struct Unit { int pm, pn; };
struct Gemm { const bf16_t* A; const bf16_t* Bt; int M, N, K; };

struct StaticOrder {
    int nM, nN, nwg, G, c;
    __host__ __device__ void init(int M, int N, int G_, int c_) { nM = M / BM; nN = N / BM; nwg = nM * nN; G = G_; c = c_; }
    __host__ __device__ bool next(int i, Unit& u) const {
        const long L = (long)i * G + c; if (L >= nwg) return false;
        int wgid = (int)L; { const int q = nwg / NXCD, r = nwg % NXCD, xcd = wgid % NXCD, off = wgid / NXCD; wgid = (xcd < r ? xcd * (q + 1) : r * (q + 1) + (xcd - r) * q) + off; }
        const int nig = WGM * nN, gid = wgid / nig, fm = gid * WGM, gsz = (nM - fm) < WGM ? (nM - fm) : WGM;
        u.pm = fm + ((wgid % nig) % gsz); u.pn = (wgid % nig) / gsz; return true;
    }
    __device__ __forceinline__ void a_ready(const Unit&) const {}
    __device__ __forceinline__ void done(const Unit&) const {}
};
__device__ __forceinline__ int opaque_lane() { int l; asm volatile("v_mbcnt_lo_u32_b32 %0, -1, 0\n\tv_mbcnt_hi_u32_b32 %0, -1, %0" : "=v"(l)); return l; }
typedef __bf16 bf16x2c __attribute__((ext_vector_type(2)));
__device__ __forceinline__ unsigned cvt_pk_bf16(float lo, float hi) { const bf16x2c v = {(__bf16)lo, (__bf16)hi}; return __builtin_bit_cast(unsigned, v); }
template <class Epi, class Sched, bool ALIGN_EPI = false, bool SP2 = false>
__device__ __forceinline__ void gemm_phase(PG8_LAS unsigned char* lds, const Gemm g, const Sched& S, const Epi& E, const int wave_s) {
    const int lane_ = opaque_lane();
    const int wid = wave_s, lane = lane_, tid = wid * 64 + lane, wr = wid >> 2, wc = wid & 3, fr = lane & 15, fq = lane >> 4;
    const int K = g.K, nt = K / BK;
    unsigned voffA[2], voffB[2];
#pragma unroll
    for (int i = 0; i < 2; ++i) { int R, C; stage_rc(tid * 16 + i * 8192, R, C); const int Rb = Epi::PERM ? ((R & ~31) + perm32(R & 31)) : R;
        voffA[i] = (unsigned)(R * K + C) * 2u; voffB[i] = (unsigned)(Rb * K + C) * 2u; }
    const size_t kstep = (size_t)(BK * 2);
    const size_t hstep = (size_t)HALF * K * 2;
    const size_t tstep = 2 * hstep;
    const unsigned ldsw = (unsigned)wid * 1024u;
    const int aoff = lds_byte(wr * 64 + fr, fq * 8), boff = lds_byte(wc * 32 + fr, fq * 8);
#define PG8_SA(b, h) (((b) * 2 + (h)) * HTB)
#define PG8_SB(b, h) ((4 + (b) * 2 + (h)) * HTB)
#define PG8_STAGE(bufoff, gbase, voff) do { _Pragma("unroll") for (int _i = 0; _i < 2; ++_i) \
        __builtin_amdgcn_global_load_lds((const unsigned*)((const char*)(gbase) + (voff)[_i]), (PG8_LAS unsigned*)(lds + (bufoff) + ldsw + _i * 8192), 16, 0, 0); } while (0)
#define PG8_LDA(dst, b, h) do { _Pragma("unroll") for (int m = 0; m < 4; ++m) _Pragma("unroll") for (int k = 0; k < 2; ++k) dst[m][k] = *(const PG8_LAS bf16x8*)(lds + PG8_SA(b, h) + aoff + m * 2048 + k * 1024); } while (0)
#define PG8_LDB(dst, b, h) do { _Pragma("unroll") for (int n = 0; n < 2; ++n) _Pragma("unroll") for (int k = 0; k < 2; ++k) dst[n][k] = *(const PG8_LAS bf16x8*)(lds + PG8_SB(b, h) + boff + n * 2048 + k * 1024); } while (0)
#define PG8_MMA(ai, bj, At, Bt) do { __builtin_amdgcn_s_setprio(1); _Pragma("unroll") for (int m = 0; m < 4; ++m) _Pragma("unroll") for (int n = 0; n < 2; ++n) _Pragma("unroll") for (int k = 0; k < 2; ++k) \
        acc[ai][bj][m][n] = __builtin_amdgcn_mfma_f32_16x16x32_bf16(Bt[n][k], At[m][k], acc[ai][bj][m][n], 0, 0, 0); __builtin_amdgcn_s_setprio(0); } while (0)
#define PG8_WAIT_V(n) asm volatile("s_waitcnt vmcnt(" #n ")" ::: "memory")
#define PG8_WAIT_L(n) asm volatile("s_waitcnt lgkmcnt(" #n ")" ::: "memory")
#define PG8_BAR __builtin_amdgcn_s_barrier()
#define PG8_SCHED __builtin_amdgcn_sched_barrier(0)
    Unit cur, nxt; int ui = 0;
    if (!S.next(0, cur)) return;
    f32x4 acc[2][2][4][2];
#pragma unroll
    for (int a = 0; a < 2; ++a)
#pragma unroll
        for (int b = 0; b < 2; ++b)
#pragma unroll
            for (int m = 0; m < 4; ++m)
#pragma unroll
                for (int n = 0; n < 2; ++n) acc[a][b][m][n] = (f32x4){0.f, 0.f, 0.f, 0.f};
    bf16x8 At[4][2], B0[2][2], B1[2][2];
    const char* cA = (const char*)g.A + (size_t)cur.pm * tstep; const char* cB = (const char*)g.Bt + (size_t)cur.pn * tstep;
    S.a_ready(cur);
    if constexpr (SP2) {
        PG8_STAGE(PG8_SB(0, 0), cB, voffB); PG8_STAGE(PG8_SB(0, 1), cB + hstep, voffB); PG8_STAGE(PG8_SA(0, 0), cA, voffA); PG8_STAGE(PG8_SA(0, 1), cA + hstep, voffA);
        if (wr == 1) PG8_BAR;
        PG8_WAIT_V(2); PG8_BAR;
        PG8_STAGE(PG8_SB(1, 0), cB + kstep, voffB); PG8_STAGE(PG8_SA(1, 0), cA + kstep, voffA); PG8_STAGE(PG8_SB(1, 1), cB + hstep + kstep, voffB);
        PG8_WAIT_V(6); PG8_BAR;
    } else {
        PG8_STAGE(PG8_SB(0, 0), cB, voffB); PG8_STAGE(PG8_SA(0, 0), cA, voffA); PG8_STAGE(PG8_SB(0, 1), cB + hstep, voffB); PG8_STAGE(PG8_SA(0, 1), cA + hstep, voffA);
        if (wr == 1) PG8_BAR;
        PG8_WAIT_V(4); PG8_BAR;
        PG8_STAGE(PG8_SB(1, 0), cB + kstep, voffB); PG8_STAGE(PG8_SA(1, 0), cA + kstep, voffA); PG8_STAGE(PG8_SB(1, 1), cB + hstep + kstep, voffB);
        PG8_WAIT_V(6); PG8_BAR;
    }
    for (;;) {
        const bool has_next = S.next(ui + 1, nxt);
        const char* nA = has_next ? (const char*)g.A + (size_t)nxt.pm * tstep : cA; const char* nB = has_next ? (const char*)g.Bt + (size_t)nxt.pn * tstep : cB;
        for (int t = 0; t < nt; t += 2) {
            const bool last = (t == nt - 2);
            const char* a1 = cA + (size_t)(t + 1) * kstep;
            const char* a2 = last ? nA : cA + (size_t)(t + 2) * kstep; const char* b2 = last ? nB : cB + (size_t)(t + 2) * kstep;
            const char* a3 = a2 + kstep; const char* b3 = b2 + kstep;
            if (last && has_next) S.a_ready(nxt);
            if constexpr (SP2) {
            PG8_LDB(B0, 0, 0); PG8_LDB(B1, 0, 1); PG8_SCHED; PG8_LDA(At, 0, 0); PG8_STAGE(PG8_SA(1, 1), a1 + hstep, voffA);
            PG8_WAIT_V(8); PG8_WAIT_L(0); PG8_BAR; PG8_MMA(0, 0, At, B0); PG8_MMA(0, 1, At, B1); PG8_BAR; PG8_SCHED;
            PG8_LDA(At, 0, 1); PG8_STAGE(PG8_SB(0, 0), b2, voffB); PG8_STAGE(PG8_SB(0, 1), b2 + hstep, voffB); PG8_STAGE(PG8_SA(0, 0), a2, voffA);
            PG8_WAIT_V(8); PG8_WAIT_L(0); PG8_BAR; PG8_MMA(1, 0, At, B0); PG8_MMA(1, 1, At, B1); PG8_BAR; PG8_SCHED;
            PG8_LDB(B0, 1, 0); PG8_LDB(B1, 1, 1); PG8_SCHED; PG8_LDA(At, 1, 0); PG8_STAGE(PG8_SA(0, 1), a2 + hstep, voffA);
            PG8_WAIT_V(8); PG8_WAIT_L(0); PG8_BAR; PG8_MMA(0, 0, At, B0); PG8_MMA(0, 1, At, B1); PG8_BAR; PG8_SCHED;
            PG8_LDA(At, 1, 1); PG8_STAGE(PG8_SB(1, 0), b3, voffB); PG8_STAGE(PG8_SB(1, 1), b3 + hstep, voffB); PG8_STAGE(PG8_SA(1, 0), a3, voffA);
            PG8_WAIT_V(8); PG8_WAIT_L(0); PG8_BAR; PG8_MMA(1, 0, At, B0); PG8_MMA(1, 1, At, B1); PG8_BAR; PG8_SCHED;
            } else {
            PG8_LDB(B0, 0, 0); PG8_SCHED; PG8_LDA(At, 0, 0); PG8_STAGE(PG8_SA(1, 1), a1 + hstep, voffA);
            PG8_WAIT_L(8); PG8_BAR; PG8_WAIT_L(0); PG8_MMA(0, 0, At, B0); PG8_BAR; PG8_SCHED;
            PG8_LDB(B1, 0, 1); PG8_STAGE(PG8_SB(0, 0), b2, voffB);
            PG8_BAR; PG8_WAIT_L(0); PG8_MMA(0, 1, At, B1); PG8_BAR;
            PG8_LDA(At, 0, 1); PG8_STAGE(PG8_SA(0, 0), a2, voffA);
            PG8_BAR; PG8_WAIT_L(0); PG8_MMA(1, 0, At, B0); PG8_BAR; PG8_SCHED;
            PG8_STAGE(PG8_SB(0, 1), b2 + hstep, voffB);
            PG8_WAIT_V(6); PG8_BAR; PG8_MMA(1, 1, At, B1); PG8_BAR;
            PG8_LDB(B0, 1, 0); PG8_SCHED; PG8_LDA(At, 1, 0); PG8_STAGE(PG8_SA(0, 1), a2 + hstep, voffA);
            PG8_WAIT_L(8); PG8_BAR; PG8_WAIT_L(0); PG8_MMA(0, 0, At, B0); PG8_BAR; PG8_SCHED;
            PG8_LDB(B1, 1, 1); PG8_STAGE(PG8_SB(1, 0), b3, voffB);
            PG8_BAR; PG8_WAIT_L(0); PG8_MMA(0, 1, At, B1); PG8_BAR;
            PG8_LDA(At, 1, 1); PG8_STAGE(PG8_SA(1, 0), a3, voffA);
            PG8_BAR; PG8_WAIT_L(0); PG8_MMA(1, 0, At, B0); PG8_BAR; PG8_SCHED;
            PG8_STAGE(PG8_SB(1, 1), b3 + hstep, voffB);
            PG8_WAIT_V(6); PG8_BAR; PG8_MMA(1, 1, At, B1); PG8_BAR;
            }
        }
        if constexpr (ALIGN_EPI) { if (wr == 0) PG8_BAR; }
        if constexpr (!Epi::AFTER_DRAIN) { const int le_ = opaque_lane(); E(acc, cur, wr, wc, le_ & 15, le_ >> 4); S.done(cur); }
        if (!has_next) break;
#pragma unroll
        for (int a = 0; a < 2; ++a)
#pragma unroll
            for (int b = 0; b < 2; ++b)
#pragma unroll
                for (int m = 0; m < 4; ++m)
#pragma unroll
                    for (int n = 0; n < 2; ++n) acc[a][b][m][n] = (f32x4){0.f, 0.f, 0.f, 0.f};
        cur = nxt; cA = nA; cB = nB; ++ui;
        if constexpr (ALIGN_EPI) { if (wr == 1) PG8_BAR; }
    }
    PG8_WAIT_V(0);
    if constexpr (!ALIGN_EPI) { if (wr == 0) PG8_BAR; }
    PG8_BAR;
    if constexpr (Epi::AFTER_DRAIN) { E.fused(acc, cur, wr, wc, fr, fq, lds, wid, lane); S.done(cur); }
#undef PG8_SA
#undef PG8_SB
#undef PG8_STAGE
#undef PG8_LDA
#undef PG8_LDB
#undef PG8_MMA
#undef PG8_WAIT_V
#undef PG8_WAIT_L
#undef PG8_BAR
#undef PG8_SCHED
}
}

constexpr int NWAVES = 8;
constexpr int DM = 2048, NBATCH = 2, SEQ = 8192, CTXL = 256, TPB = CTXL + SEQ  , MALL = NBATCH * TPB  ;
constexpr int NLAYER = 2;
constexpr int RW = 1024, NH = 16;
constexpr int RWC = 3392, INA = 4192, INA_P = 4352, INC = 8288;
constexpr int C_WD = 3072, C_AD = 3200, C_GD = 3328, C_QC = 3392, C_KVC = 3904, C_KR = 4160;
constexpr int QKD = 96, NQ = NH * QKD  , NKV = NH * 128  ;
constexpr int NEXP = 16384;
constexpr int RREC = 9 * 64;
constexpr float NORM_EPS = 1e-6f;

constexpr size_t MiB = 1u << 20;
constexpr size_t WS_CTL = 0, CTL_ZERO_BYTES = 1 * MiB;
constexpr size_t CTL_MOD_OFF = 256 * 1024;
constexpr size_t WS_ROPE = 1 * MiB;
constexpr size_t WS_WUP = 3 * MiB, WS_AUP = WS_WUP + 512 * 1024, WS_GUP = 4 * MiB;
constexpr size_t WS_WUQ = 5 * MiB, WS_WUKV = 8 * MiB, WS_WA = 10 * MiB, WS_WB = 18 * MiB, WS_WO = 26 * MiB, WS_WQK = 42 * MiB, WS_WGA = 58 * MiB, WS_WGB = 74 * MiB, WS_WINA = 90 * MiB;
constexpr size_t WS_X = 124 * MiB, WS_H = 256 * MiB, WS_DYN = 322 * MiB;
constexpr size_t WS_PA = WS_DYN;
constexpr size_t WS_RI = 463 * MiB;
constexpr size_t WS_GG = 760 * MiB;
constexpr size_t WS_BON = 826 * MiB;
constexpr size_t WS_QN = 831 * MiB, WS_KVN = 848 * MiB;
constexpr size_t WS_Q = 857 * MiB, WS_K = 907 * MiB, WS_V = 957 * MiB, WS_END = 990 * MiB;
constexpr size_t WS_Y = WS_DYN;
constexpr size_t WS_YA = 388 * MiB, WS_YB = 421 * MiB;
constexpr size_t WS_T1 = 463 * MiB, WS_T2 = 529 * MiB;
constexpr size_t WS_PU = 600 * MiB, WS_PV = 664 * MiB;
constexpr size_t WS_CA = 600 * MiB, WS_CB = 608 * MiB;
#ifndef CTX_SPLIT
#define CTX_SPLIT (MK_N_LAUNCHES == 1)
#endif
constexpr size_t WS_P4 = 990 * MiB, WS_P4S = 1022 * MiB, WS_END2 = 1023 * MiB;
constexpr size_t WS_SC = WS_DYN;
static_assert(WS_PA + (size_t)MALL * INA_P * 2 <= WS_RI && WS_RI + (size_t)NBATCH * NH * TPB * RREC * 2 <= WS_GG && WS_GG + (size_t)2 * MALL * RW * 2 <= WS_BON, "ws map 1");
static_assert(WS_BON + (size_t)2 * MALL * 32 * 4 <= WS_QN && WS_QN + (size_t)MALL * 512 * 2 <= WS_KVN && WS_KVN + (size_t)MALL * 256 * 2 <= WS_Q, "ws map 2");
static_assert(WS_Q + (size_t)NBATCH * NH * TPB * QKD * 2 <= WS_K && WS_K + (size_t)NBATCH * NH * TPB * QKD * 2 <= WS_V && WS_V + (size_t)NBATCH * NH * TPB * 64 * 2 <= WS_END, "ws map 3");
static_assert(WS_Y + (size_t)2 * MALL * RW * 2 <= WS_YA && WS_YA + (size_t)MALL * RW * 2 <= WS_YB && WS_YB + (size_t)MALL * RW * 2 <= WS_RI, "ws map 4");
static_assert(WS_T1 + (size_t)MALL * DM * 2 <= WS_T2 && WS_T2 + (size_t)MALL * DM * 2 <= WS_PU && WS_PU + (size_t)NEXP * DM * 2 <= WS_PV && WS_PV + (size_t)NEXP * DM * 2 <= WS_GG, "ws map 5");
static_assert(WS_SC + (size_t)MALL * DM * 4 <= WS_T1 && WS_X + (size_t)MALL * DM * 4 <= WS_H && WS_H + (size_t)MALL * DM * 2 <= WS_DYN, "ws map 6");
static_assert(WS_WINA + (size_t)NLAYER * INA_P * DM * 2 <= WS_X, "ws map 7");
constexpr size_t CTL_PROBE_OFF = 640 * 1024;
constexpr int CW_BAR = 4096;

constexpr int RING_BYTES = 131072;
constexpr int LDSCTL_OFF = RING_BYTES, MISC_OFF = LDSCTL_OFF + 320;
constexpr int LDS_BYTES = 147456;

#define GAS __attribute__((address_space(1)))
#define LAS __attribute__((address_space(3)))
typedef unsigned short bf16;
typedef unsigned v4u __attribute__((ext_vector_type(4)));
typedef unsigned v2u __attribute__((ext_vector_type(2)));
typedef float f32x4 __attribute__((ext_vector_type(4)));
typedef float f32x2 __attribute__((ext_vector_type(2)));
typedef float f32x16 __attribute__((ext_vector_type(16)));
typedef short bf16x8 __attribute__((ext_vector_type(8)));
typedef short s16x4 __attribute__((ext_vector_type(4)));
typedef __bf16 bf16x2v __attribute__((ext_vector_type(2)));
typedef __bf16 bf16x8v __attribute__((ext_vector_type(8)));
typedef GAS unsigned gu32;
#define RLX_AGENT __ATOMIC_RELAXED, __HIP_MEMORY_SCOPE_AGENT
#define LDS_WAIT() asm volatile("s_waitcnt lgkmcnt(0)" ::: "memory")
#define VM_WAIT() asm volatile("s_waitcnt vmcnt(0)" ::: "memory")
__device__ __forceinline__ unsigned f2bf(float f) { unsigned u = __builtin_bit_cast(unsigned, f); return (u + 0x7fffu + ((u >> 16) & 1u)) >> 16; }
#define LDS_BARRIER() do { asm volatile("s_waitcnt lgkmcnt(0)" ::: "memory"); __builtin_amdgcn_s_barrier(); asm volatile("" ::: "memory"); } while (0)
__device__ __forceinline__ unsigned pk2(float lo, float hi) { return pg8::cvt_pk_bf16(lo, hi); }
__device__ __forceinline__ float bflo(unsigned w) { return __builtin_bit_cast(float, w << 16); }
__device__ __forceinline__ float bfhi(unsigned w) { return __builtin_bit_cast(float, w & 0xffff0000u); }
__device__ __forceinline__ float bf1(bf16 h) { return __builtin_bit_cast(float, (unsigned)h << 16); }
__device__ __forceinline__ float sigmoidf_(float x) { return __builtin_amdgcn_rcpf(1.0f + __expf(-x)); }
template <int CTRL> __device__ __forceinline__ float dpp_add(float x) {
    return x + __builtin_bit_cast(float, __builtin_amdgcn_update_dpp(0, __builtin_bit_cast(int, x), CTRL, 0xf, 0xf, true));
}
__device__ __forceinline__ float red16(float x) {
    x = dpp_add<0xB1>(x);
    x = dpp_add<0x4E>(x);
    x = dpp_add<0x141>(x);
    x = dpp_add<0x140>(x);
    return x;
}
template <int CTRL, int RM> __device__ __forceinline__ float dpp_max(float x) {
    return fmaxf(x, __builtin_bit_cast(float, __builtin_amdgcn_update_dpp(__builtin_bit_cast(int, x), __builtin_bit_cast(int, x), CTRL, RM, 0xf, false)));
}
template <int CTRL, int RM> __device__ __forceinline__ float dpp_sum(float x) {
    return x + __builtin_bit_cast(float, __builtin_amdgcn_update_dpp(0, __builtin_bit_cast(int, x), CTRL, RM, 0xf, false));
}
__device__ __forceinline__ float wave_max_u(float x) {
    x = dpp_max<0xB1, 0xf>(x); x = dpp_max<0x4E, 0xf>(x); x = dpp_max<0x141, 0xf>(x); x = dpp_max<0x140, 0xf>(x);
    x = dpp_max<0x142, 0xa>(x); x = dpp_max<0x143, 0xc>(x);
    return __builtin_bit_cast(float, __builtin_amdgcn_readlane(__builtin_bit_cast(int, x), 63));
}
__device__ __forceinline__ float wave_sum_u(float x) {
    x = dpp_sum<0xB1, 0xf>(x); x = dpp_sum<0x4E, 0xf>(x); x = dpp_sum<0x141, 0xf>(x); x = dpp_sum<0x140, 0xf>(x);
    x = dpp_sum<0x142, 0xa>(x); x = dpp_sum<0x143, 0xc>(x);
    return __builtin_bit_cast(float, __builtin_amdgcn_readlane(__builtin_bit_cast(int, x), 63));
}
__device__ __forceinline__ float wave_sum(float v) { return wave_sum_u(v); }
__device__ __forceinline__ float bpermf(int srclane, float v) { return __builtin_bit_cast(float, __builtin_amdgcn_ds_bpermute(srclane << 2, __builtin_bit_cast(int, v))); }
__device__ __forceinline__ int bpermi(int srclane, int v) { return __builtin_amdgcn_ds_bpermute(srclane << 2, v); }

#define XB_TMO      128
#define XB_XCNT(j)  (256  + 64 * (j))
#define XB_XSUB(j)  (1280 + 64 * (j))
#define XB_XGEN(j)  (2304 + 64 * (j))
#define XB_TOP      3328
#define XB_TOPGEN   3392
#define XCD_BAR_WORDS 3456
#define XB_SPIN_CAP (1u << 20)

__device__ __forceinline__ unsigned xb_ld(unsigned* p)              { return __hip_atomic_load(p, __ATOMIC_RELAXED, __HIP_MEMORY_SCOPE_AGENT); }
__device__ __forceinline__ unsigned xb_add(unsigned* p, unsigned v) { return __hip_atomic_fetch_add(p, v, __ATOMIC_RELAXED, __HIP_MEMORY_SCOPE_AGENT); }
__device__ __forceinline__ unsigned xb_xcc_id() { return (unsigned)__builtin_amdgcn_s_getreg((3 << 11) | 20) & 0xFu; }
#define XB_SPIN(cond, bar) do { unsigned _sp = 0; while (cond) { __builtin_amdgcn_s_sleep(1); \
    if ((++_sp & 255u) == 0u) { if (xb_ld(&(bar)[XB_TMO])) break; if (_sp > XB_SPIN_CAP) { atomicAdd(&(bar)[XB_TMO], 1u); break; } } } } while (0)

struct XcdBarrier { unsigned* bar; unsigned x; volatile LAS unsigned* st; };

__device__ __forceinline__ XcdBarrier xcd_barrier_post(unsigned* bar, volatile LAS unsigned* st, bool t0) {
    XcdBarrier b; b.bar = bar; b.x = xb_xcc_id(); b.st = st;
    if (t0) (void)xb_add(&bar[XB_XCNT(b.x)], 1u);
    return b;
}
__device__ __forceinline__ void xcd_barrier_complete(unsigned* bar, unsigned x, unsigned& nloc, unsigned& nx) {
    const unsigned G = gridDim.x * gridDim.y * gridDim.z;
    unsigned sum, cnt, mine, sp = 0u;
    for (;;) {
        sum = 0u; cnt = 0u; mine = 0u;
#pragma unroll
        for (unsigned j = 0; j < 16; ++j) { const unsigned c = xb_ld(&bar[XB_XCNT(j)]); sum += c; cnt += (c > 0u) ? 1u : 0u; mine = (j == x) ? c : mine; }
        if (sum == G) break;
        __builtin_amdgcn_s_sleep(1);
        if ((++sp & 255u) == 0u) { if (xb_ld(&bar[XB_TMO])) break; if (sp > XB_SPIN_CAP) { atomicAdd(&bar[XB_TMO], 1u); break; } }
    }
    nloc = mine > 0u ? mine : 1u; nx = cnt > 0u ? cnt : 1u;
}
__device__ __forceinline__ void xcd_barrier(const XcdBarrier& b, bool t0) {
    asm volatile("s_waitcnt vmcnt(0)" ::: "memory");
    __syncthreads();
    if (t0) {
        unsigned* bar = b.bar;
        __builtin_amdgcn_s_waitcnt(0);
        unsigned nloc = b.st[0], nx = b.st[1];
        if (nloc == 0u) { xcd_barrier_complete(bar, b.x, nloc, nx); b.st[0] = nloc; b.st[1] = nx; }
        const unsigned old = xb_add(&bar[XB_XSUB(b.x)], 1u);
        const unsigned gen = old / nloc;
        if (old + 1u == (gen + 1u) * nloc) {
            __builtin_amdgcn_fence(__ATOMIC_RELEASE, "agent");
            asm volatile("s_waitcnt vmcnt(0)" ::: "memory");
            const unsigned og = xb_add(&bar[XB_TOP], 1u);
            const unsigned tg = og / nx;
            if (og + 1u == (tg + 1u) * nx) xb_add(&bar[XB_TOPGEN], 1u);
            else XB_SPIN(xb_ld(&bar[XB_TOPGEN]) == tg, bar);
            __builtin_amdgcn_fence(__ATOMIC_ACQUIRE, "agent");
            xb_add(&bar[XB_XGEN(b.x)], 1u);
            asm volatile("s_waitcnt vmcnt(0)" ::: "memory");
        } else {
            XB_SPIN(xb_ld(&bar[XB_XGEN(b.x)]) == gen, bar);
            __builtin_amdgcn_fence(__ATOMIC_ACQUIRE, "agent");
            asm volatile("s_waitcnt vmcnt(0)" ::: "memory");
        }
    }
    __syncthreads();
}

struct Frame {
    LAS unsigned char* lds;
    unsigned char* ws;
    const float* const* in;
    int tid, lane, wave;
    int vcu, G;
};
struct Args { const float* in[33]; float* out; unsigned char* ws; int ph_lo, ph_hi; };


namespace pg8 {
typedef unsigned u32x4 __attribute__((ext_vector_type(4)));
struct RowOrder : StaticOrder {
    int lat;
    __host__ __device__ void init_rows(int lat_, int N, int G_, int c_) { lat = lat_; init(lat_ ? NBATCH * SEQ : MALL, N, G_, c_); }
    __host__ __device__ bool next(int i, Unit& u) const { if (!StaticOrder::next(i, u)) return false; if (lat) u.pm = 33 * (u.pm >> 5) + 1 + (u.pm & 31); return true; }
};
#define EPI_LOOP_ROWS for (int ai = 0; ai < 2; ++ai) _Pragma("unroll") for (int m = 0; m < 4; ++m)
#define EPI_PIN asm volatile("" ::: "memory")

struct EpiStoreBf16 {
    static constexpr bool PERM = true, AFTER_DRAIN = false;
    bf16_t* O; int ldc;
    __device__ __forceinline__ void operator()(const f32x4 (&acc)[2][2][4][2], const Unit& u, int wr, int wc, int fr, int fq) const {
        const int row0 = u.pm * BM + wr * 64 + fr, col0 = u.pn * BM + wc * 32 + 8 * fq;
#pragma unroll
        EPI_LOOP_ROWS { bf16_t* rowp = O + (size_t)(row0 + ai * HALF + m * 16) * ldc + col0;
#pragma unroll
            for (int bj = 0; bj < 2; ++bj) { const f32x4 v0 = acc[ai][bj][m][0], v1 = acc[ai][bj][m][1];
                u32x4 w; w.x = cvt_pk_bf16(v0[0], v0[1]); w.y = cvt_pk_bf16(v0[2], v0[3]); w.z = cvt_pk_bf16(v1[0], v1[1]); w.w = cvt_pk_bf16(v1[2], v1[3]);
                *(u32x4*)(rowp + bj * HALF) = w; } }
    }
};
struct EpiGate {
    static constexpr bool PERM = true, AFTER_DRAIN = false;
    bf16_t* O; int ldc; const float* bias;
    __device__ __forceinline__ void operator()(const f32x4 (&acc)[2][2][4][2], const Unit& u, int wr, int wc, int fr, int fq) const {
        const int row0 = u.pm * BM + wr * 64 + fr, col0 = u.pn * BM + wc * 32 + 8 * fq;
        f32x4 bv[2][2];
#pragma unroll
        for (int bj = 0; bj < 2; ++bj)
#pragma unroll
            for (int n = 0; n < 2; ++n) bv[bj][n] = *(const f32x4*)(bias + col0 + bj * HALF + 4 * n);
#pragma unroll
        EPI_LOOP_ROWS { EPI_PIN; bf16_t* rowp = O + (size_t)(row0 + ai * HALF + m * 16) * ldc + col0;
#pragma unroll
            for (int bj = 0; bj < 2; ++bj) { f32x4 v0 = acc[ai][bj][m][0] + bv[bj][0], v1 = acc[ai][bj][m][1] + bv[bj][1];
#pragma unroll
                for (int e = 0; e < 4; ++e) { v0[e] = __builtin_amdgcn_rcpf(1.0f + __expf(-v0[e])); v1[e] = __builtin_amdgcn_rcpf(1.0f + __expf(-v1[e])); }
                u32x4 w; w.x = cvt_pk_bf16(v0[0], v0[1]); w.y = cvt_pk_bf16(v0[2], v0[3]); w.z = cvt_pk_bf16(v1[0], v1[1]); w.w = cvt_pk_bf16(v1[2], v1[3]);
                *(u32x4*)(rowp + bj * HALF) = w; } }
    }
};
__device__ __forceinline__ float bf_lo(unsigned w) { return __builtin_bit_cast(float, w << 16); }
__device__ __forceinline__ float bf_hi(unsigned w) { return __builtin_bit_cast(float, w & 0xffff0000u); }
struct EpiMulAdd {
    static constexpr bool PERM = true, AFTER_DRAIN = false;
    bf16_t* O; const bf16_t* Gt; const bf16_t* Ad; int ldc;
    __device__ __forceinline__ void operator()(const f32x4 (&acc)[2][2][4][2], const Unit& u, int wr, int wc, int fr, int fq) const {
        const int row0 = u.pm * BM + wr * 64 + fr, col0 = u.pn * BM + wc * 32 + 8 * fq;
#pragma unroll
        EPI_LOOP_ROWS { EPI_PIN; const size_t ro = (size_t)(row0 + ai * HALF + m * 16) * ldc + col0;
#pragma unroll
            for (int bj = 0; bj < 2; ++bj) { const f32x4 v0 = acc[ai][bj][m][0], v1 = acc[ai][bj][m][1];
                const u32x4 g = *(const u32x4*)(Gt + ro + bj * HALF);
                float o[8];
                o[0] = bf_lo(g.x) * v0[0]; o[1] = bf_hi(g.x) * v0[1]; o[2] = bf_lo(g.y) * v0[2]; o[3] = bf_hi(g.y) * v0[3];
                o[4] = bf_lo(g.z) * v1[0]; o[5] = bf_hi(g.z) * v1[1]; o[6] = bf_lo(g.w) * v1[2]; o[7] = bf_hi(g.w) * v1[3];
                if (Ad) { const u32x4 a = *(const u32x4*)(Ad + ro + bj * HALF);
                    o[0] += bf_lo(a.x); o[1] += bf_hi(a.x); o[2] += bf_lo(a.y); o[3] += bf_hi(a.y); o[4] += bf_lo(a.z); o[5] += bf_hi(a.z); o[6] += bf_lo(a.w); o[7] += bf_hi(a.w); }
                u32x4 w; w.x = cvt_pk_bf16(o[0], o[1]); w.y = cvt_pk_bf16(o[2], o[3]); w.z = cvt_pk_bf16(o[4], o[5]); w.w = cvt_pk_bf16(o[6], o[7]);
                *(u32x4*)(O + ro + bj * HALF) = w; } }
    }
};
struct EpiResid {
    static constexpr bool PERM = true, AFTER_DRAIN = false;
    bf16_t* X; const float* gate;
    const float* xin; const float* cin;
    __device__ __forceinline__ void operator()(const f32x4 (&acc)[2][2][4][2], const Unit& u, int wr, int wc, int fr, int fq) const {
        const int col0 = u.pn * BM + wc * 32 + 8 * fq;
        const int bb = u.pm / 33, pt = u.pm - bb * 33, mr = (pt == 0) ? 2 : bb;
        const float* gp = gate + (size_t)mr * 12288 + col0;
        const float* sbase = xin ? (pt == 0 ? cin + (size_t)bb * CTXL * DM : xin + ((size_t)bb * SEQ + (size_t)(pt - 1) * BM) * DM) : nullptr;
        f32x4 gv[2][2];
#pragma unroll
        for (int bj = 0; bj < 2; ++bj)
#pragma unroll
            for (int n = 0; n < 2; ++n) gv[bj][n] = *(const f32x4*)(gp + bj * HALF + n * 4);
#pragma unroll
        EPI_LOOP_ROWS { EPI_PIN; const int rl = wr * 64 + fr + ai * HALF + m * 16; bf16_t* rowp = X + (size_t)(u.pm * BM + rl) * DM + col0;
#pragma unroll
            for (int bj = 0; bj < 2; ++bj) { f32x4 s0, s1;
                if (sbase) { const float* srow = sbase + (size_t)rl * DM + col0 + bj * HALF; s0 = *(const f32x4*)srow; s1 = *(const f32x4*)(srow + 4); }
                else { const u32x4 w = *(const u32x4*)(rowp + bj * HALF);
                    s0 = (f32x4){__builtin_bit_cast(float, w.x << 16), __builtin_bit_cast(float, w.x & 0xffff0000u), __builtin_bit_cast(float, w.y << 16), __builtin_bit_cast(float, w.y & 0xffff0000u)};
                    s1 = (f32x4){__builtin_bit_cast(float, w.z << 16), __builtin_bit_cast(float, w.z & 0xffff0000u), __builtin_bit_cast(float, w.w << 16), __builtin_bit_cast(float, w.w & 0xffff0000u)}; }
                const f32x4 r0 = s0 + gv[bj][0] * acc[ai][bj][m][0], r1 = s1 + gv[bj][1] * acc[ai][bj][m][1];
                u32x4 o; o.x = cvt_pk_bf16(r0[0], r0[1]); o.y = cvt_pk_bf16(r0[2], r0[3]); o.z = cvt_pk_bf16(r1[0], r1[1]); o.w = cvt_pk_bf16(r1[2], r1[3]);
                *(u32x4*)(rowp + bj * HALF) = o; } }
    }
};
struct EpiF32 {
    static constexpr bool PERM = false, AFTER_DRAIN = false;
    float* C; int ldc;
    __device__ __forceinline__ void operator()(const f32x4 (&acc)[2][2][4][2], const Unit& u, int wr, int wc, int fr, int fq) const {
        const int row0 = u.pm * BM + wr * 64 + fr, col0 = u.pn * BM + wc * 32 + 4 * fq;
#pragma unroll
        EPI_LOOP_ROWS { float* rowp = C + (size_t)(row0 + ai * HALF + m * 16) * ldc + col0;
#pragma unroll
            for (int bj = 0; bj < 2; ++bj)
#pragma unroll
                for (int n = 0; n < 2; ++n) *(f32x4*)(rowp + bj * HALF + n * 16) = acc[ai][bj][m][n]; }
    }
};
struct EpiCtxF32 {
    static constexpr bool PERM = false, AFTER_DRAIN = false;
    float* C; int ldc;
    __device__ __forceinline__ void operator()(const f32x4 (&acc)[2][2][4][2], const Unit& u, int wr, int wc, int fr, int fq) const {
        const int row0 = (u.pm ? BM : 0) + wr * 64 + fr, col0 = u.pn * BM + wc * 32 + 4 * fq;
#pragma unroll
        EPI_LOOP_ROWS { float* rowp = C + (size_t)(row0 + ai * HALF + m * 16) * ldc + col0;
#pragma unroll
            for (int bj = 0; bj < 2; ++bj)
#pragma unroll
                for (int n = 0; n < 2; ++n) *(f32x4*)(rowp + bj * HALF + n * 16) = acc[ai][bj][m][n]; }
    }
};
struct CtxOrder {
    int u0;
    __host__ __device__ bool next(int i, Unit& u) const { if (i != 0 || u0 < 0) return false; u.pm = (u0 >> 3) ? 33 : 0; u.pn = u0 & 7; return true; }
    __device__ __forceinline__ void a_ready(const Unit&) const {}
    __device__ __forceinline__ void done(const Unit&) const {}
};
struct EpiF16 {
    static constexpr bool PERM = true, AFTER_DRAIN = false;
    _Float16* C; int ldc;
    __device__ __forceinline__ void operator()(const f32x4 (&acc)[2][2][4][2], const Unit& u, int wr, int wc, int fr, int fq) const {
        typedef _Float16 h2 __attribute__((ext_vector_type(2)));
        const int row0 = u.pm * BM + wr * 64 + fr, col0 = u.pn * BM + wc * 32 + 8 * fq;
#pragma unroll
        EPI_LOOP_ROWS { _Float16* rowp = C + (size_t)(row0 + ai * HALF + m * 16) * ldc + col0;
#pragma unroll
            for (int bj = 0; bj < 2; ++bj) { const f32x4 v0 = acc[ai][bj][m][0], v1 = acc[ai][bj][m][1];
                u32x4 w; w.x = __builtin_bit_cast(unsigned, (h2){(_Float16)v0[0], (_Float16)v0[1]}); w.y = __builtin_bit_cast(unsigned, (h2){(_Float16)v0[2], (_Float16)v0[3]});
                w.z = __builtin_bit_cast(unsigned, (h2){(_Float16)v1[0], (_Float16)v1[1]}); w.w = __builtin_bit_cast(unsigned, (h2){(_Float16)v1[2], (_Float16)v1[3]});
                *(u32x4*)(rowp + bj * HALF) = w; } }
    }
};
struct EpiQ {
    static constexpr bool PERM = true, AFTER_DRAIN = false;
    bf16_t* Q; const f32x2* rope; float qscale;
    __device__ __forceinline__ void operator()(const f32x4 (&acc)[2][2][4][2], const Unit& u, int wr, int wc, int fr, int fq) const {
        const int bb = u.pm / 33, tp0 = (u.pm - bb * 33) * BM + wr * 64 + fr, col0 = u.pn * BM + wc * 32 + 8 * fq;
#pragma unroll
        for (int bj = 0; bj < 2; ++bj) { const int c = col0 + bj * HALF, hd = c / QKD, d = c - hd * QKD;
#pragma unroll
            EPI_LOOP_ROWS { EPI_PIN; const int tp = tp0 + ai * HALF + m * 16;
                f32x4 v0 = acc[ai][bj][m][0], v1 = acc[ai][bj][m][1];
                if (d >= 64) { const int i0 = (d - 64) >> 1; const f32x2* rp = rope + (size_t)tp * 16 + i0;
                    const f32x2 c0 = rp[0], c1 = rp[1], c2 = rp[2], c3 = rp[3];
                    float a, b;
                    a = v0[0]; b = v0[1]; v0[0] = a * c0.x - b * c0.y; v0[1] = a * c0.y + b * c0.x;
                    a = v0[2]; b = v0[3]; v0[2] = a * c1.x - b * c1.y; v0[3] = a * c1.y + b * c1.x;
                    a = v1[0]; b = v1[1]; v1[0] = a * c2.x - b * c2.y; v1[1] = a * c2.y + b * c2.x;
                    a = v1[2]; b = v1[3]; v1[2] = a * c3.x - b * c3.y; v1[3] = a * c3.y + b * c3.x; }
                v0 = v0 * qscale; v1 = v1 * qscale;
                u32x4 w; w.x = cvt_pk_bf16(v0[0], v0[1]); w.y = cvt_pk_bf16(v0[2], v0[3]); w.z = cvt_pk_bf16(v1[0], v1[1]); w.w = cvt_pk_bf16(v1[2], v1[3]);
                *(u32x4*)(Q + ((size_t)(bb * NH + hd) * TPB + tp) * QKD + d) = w; } }
    }
};
struct EpiKV {
    static constexpr bool PERM = true, AFTER_DRAIN = false;
    bf16_t* K; bf16_t* V;
    __device__ __forceinline__ void operator()(const f32x4 (&acc)[2][2][4][2], const Unit& u, int wr, int wc, int fr, int fq) const {
        const int bb = u.pm / 33, tp0 = (u.pm - bb * 33) * BM + wr * 64 + fr;
        const bool isK = wc < 2;
        bf16_t* base = isK ? K : V; const int pitch = isK ? QKD : 64, doff = 32 * (wc & 1) + 8 * fq;
#pragma unroll
        for (int bj = 0; bj < 2; ++bj) { const int hd = 2 * u.pn + bj;
            bf16_t* hb = base + (size_t)(bb * NH + hd) * TPB * pitch;
#pragma unroll
            EPI_LOOP_ROWS { EPI_PIN; const int tp = tp0 + ai * HALF + m * 16;
                const f32x4 v0 = acc[ai][bj][m][0], v1 = acc[ai][bj][m][1];
                u32x4 w; w.x = cvt_pk_bf16(v0[0], v0[1]); w.y = cvt_pk_bf16(v0[2], v0[3]); w.z = cvt_pk_bf16(v1[0], v1[1]); w.w = cvt_pk_bf16(v1[2], v1[3]);
                *(u32x4*)((char*)hb + (unsigned)((tp * pitch + doff) * 2)) = w; } }
    }
};
}

struct TItem { const float* W; bf16* WT; int K, ldw, c0, N, mapq, item; };
__device__ __forceinline__ void p0_item_load(const TItem& T, int lane, f32x4 (&x)[8]) {
    const int nblk = T.N / 32, kb = T.item / nblk, nb = T.item - kb * nblk, k0 = 64 * kb, n0 = 32 * nb;
    const float* p = T.W + (size_t)(k0 + (lane >> 3)) * T.ldw + T.c0 + n0 + (lane & 7) * 4;
#pragma unroll
    for (int i = 0; i < 8; ++i) x[i] = *(const GAS f32x4*)(p + (size_t)(8 * i) * T.ldw);
}
__device__ __forceinline__ void p0_item_finish(const TItem& T, const f32x4 (&x)[8], LAS float* scr, int lane) {
    const int nblk = T.N / 32, kb = T.item / nblk, nb = T.item - kb * nblk, k0 = 64 * kb, n0 = 32 * nb;
#pragma unroll
    for (int i = 0; i < 8; ++i) { LAS float* d = scr + (8 * i + (lane >> 3)) * 33 + (lane & 7) * 4; d[0] = x[i].x; d[1] = x[i].y; d[2] = x[i].z; d[3] = x[i].w; }
    LDS_WAIT(); asm volatile("" ::: "memory");
    const int c = lane & 7;
#pragma unroll
    for (int j = 0; j < 4; ++j) { const int n = (lane >> 3) + 8 * j; const LAS float* s = scr + (8 * c) * 33 + n;
        v4u o; o.x = pk2(s[0 * 33], s[1 * 33]); o.y = pk2(s[2 * 33], s[3 * 33]); o.z = pk2(s[4 * 33], s[5 * 33]); o.w = pk2(s[6 * 33], s[7 * 33]);
        int nn = n0 + n;
        if (T.mapq) { const int hd = nn / QKD, d = nn - hd * QKD; if (d >= 64) { const int i = (d - 64) & 15, s2 = (d - 64) >> 4; nn = hd * QKD + 64 + 2 * i + s2; } }
        *(GAS v4u*)(T.WT + (size_t)nn * T.K + k0 + 8 * c) = o; }
    LDS_WAIT(); asm volatile("" ::: "memory");
}

__device__ __forceinline__ const float* karg(int i);
constexpr int TB_INA = (DM / 128) * ((INA + 127) / 128), TB_G = (DM / 128) * (DM / 128), TB_BR = (RW / 128) * (DM / 128), TB_UQ = (512 / 128) * (NQ / 128), TB_UKV = (256 / 128) * (NKV / 128);
constexpr int TB_N = TB_INA + 2 * TB_G + 2 * TB_BR + TB_G + TB_UQ + TB_UKV;
constexpr int TI_LR = 1 * (RW / 32), TI_N = 4 * TI_LR;
__device__ __forceinline__ TItem p0_resolve_big(unsigned char* ws, int git) {
    const int l = git / TB_N; int r = git - l * TB_N; TItem T; T.mapq = 0; T.c0 = 0;
    if (r < TB_INA) { T.W = karg(7) + (size_t)l * DM * INC; T.K = DM; T.ldw = INC; T.N = INA; T.WT = (bf16*)(ws + WS_WINA) + (size_t)l * INA_P * DM; T.item = r; return T; } r -= TB_INA;
    if (r < TB_G) { T.W = karg(7) + (size_t)l * DM * INC; T.K = DM; T.ldw = INC; T.c0 = INA; T.N = DM; T.WT = (bf16*)(ws + WS_WGA) + (size_t)l * DM * DM; T.item = r; return T; } r -= TB_G;
    if (r < TB_G) { T.W = karg(7) + (size_t)l * DM * INC; T.K = DM; T.ldw = INC; T.c0 = INA + DM; T.N = DM; T.WT = (bf16*)(ws + WS_WGB) + (size_t)l * DM * DM; T.item = r; return T; } r -= TB_G;
    if (r < TB_BR) { T.W = karg(24) + (size_t)l * RW * DM; T.K = RW; T.ldw = DM; T.N = DM; T.WT = (bf16*)(ws + WS_WA) + (size_t)l * DM * RW; T.item = r; return T; } r -= TB_BR;
    if (r < TB_BR) { T.W = karg(25) + (size_t)l * RW * DM; T.K = RW; T.ldw = DM; T.N = DM; T.WT = (bf16*)(ws + WS_WB) + (size_t)l * DM * RW; T.item = r; return T; } r -= TB_BR;
    if (r < TB_G) { T.W = karg(26) + (size_t)l * DM * DM; T.K = DM; T.ldw = DM; T.N = DM; T.WT = (bf16*)(ws + WS_WO) + (size_t)l * DM * DM; T.item = r; return T; } r -= TB_G;
    if (r < TB_UQ) { T.W = karg(21) + (size_t)l * 512 * NQ; T.K = 512; T.ldw = NQ; T.N = NQ; T.WT = (bf16*)(ws + WS_WUQ) + (size_t)l * NQ * 512; T.item = r; T.mapq = 1; return T; } r -= TB_UQ;
    { T.W = karg(23) + (size_t)l * 256 * NKV; T.K = 256; T.ldw = NKV; T.N = NKV; T.WT = (bf16*)(ws + WS_WUKV) + (size_t)l * NKV * 256; T.item = r; return T; }
}
__device__ __forceinline__ void p0_big_load(const TItem& T, int tid, f32x4 (&x)[8]) {
    const int nblk = (T.N + 127) / 128, kb = T.item / nblk, nb = T.item - kb * nblk, k0 = 128 * kb, col = 128 * nb + (tid & 31) * 4;
    const float* p = T.W + (size_t)(k0 + (tid >> 5)) * T.ldw + T.c0 + col; const bool ok = col < T.N;
#pragma unroll
    for (int i = 0; i < 8; ++i) x[i] = ok ? *(const GAS f32x4*)(p + (size_t)(16 * i) * T.ldw) : (f32x4){0.f, 0.f, 0.f, 0.f};
}
__device__ __forceinline__ void p0_big_finish(const TItem& T, const f32x4 (&x)[8], LAS float* tile, int tid) {
    const int nblk = (T.N + 127) / 128, kb = T.item / nblk, nb = T.item - kb * nblk, k0 = 128 * kb, n0 = 128 * nb;
    __syncthreads();
#pragma unroll
    for (int i = 0; i < 8; ++i) *(LAS f32x4*)(tile + ((tid >> 5) + 16 * i) * 132 + (tid & 31) * 4) = x[i];
    __syncthreads();
    const int n = tid & 127, cg = tid >> 7; int nn = n0 + n;
    if (nn < T.N) {
        if (T.mapq) { const int hd = nn / QKD, d = nn - hd * QKD; if (d >= 64) { const int i = (d - 64) & 15, s2 = (d - 64) >> 4; nn = hd * QKD + 64 + 2 * i + s2; } }
#pragma unroll
        for (int c = 0; c < 4; ++c) { const LAS float* s = tile + (32 * cg + 8 * c) * 132 + n;
            v4u o; o.x = pk2(s[0 * 132], s[1 * 132]); o.y = pk2(s[2 * 132], s[3 * 132]); o.z = pk2(s[4 * 132], s[5 * 132]); o.w = pk2(s[6 * 132], s[7 * 132]);
            *(GAS v4u*)(T.WT + (size_t)nn * T.K + k0 + 32 * cg + 8 * c) = o; } }
}
__device__ __forceinline__ TItem p0_resolve(unsigned char* ws, int git) {
    const int l = git / TI_N; int r = git - l * TI_N; TItem T; T.mapq = 0; T.c0 = 0;
    const int which = r / TI_LR, d = which & 1, isa = which >> 1; r -= which * TI_LR;
    T.W = (isa ? karg(13) : karg(11)) + (size_t)(l * 2 + d) * 64 * RW; T.K = 64; T.ldw = RW; T.N = RW; T.WT = (bf16*)(ws + (isa ? WS_AUP : WS_WUP)) + (size_t)(l * 2 + d) * RW * 64; T.item = r; return T;
}
constexpr int NWI_INA = (DM / 64) * (INA / 32), NWI_G = (DM / 64) * (DM / 32), NWI_BR = (RW / 64) * (DM / 32), NWI_UQ = (512 / 64) * (NQ / 32), NWI_UKV = (256 / 64) * (NKV / 32);
constexpr int NW_ITEMS = NWI_INA + 2 * NWI_G + 2 * NWI_BR + NWI_G + NWI_UQ + NWI_UKV + TI_N;
__device__ __forceinline__ TItem p0_resolve_wave(unsigned char* ws, int l, int r) {
    TItem T; T.mapq = 0; T.c0 = 0;
    if (r < NWI_INA) { T.W = karg(7) + (size_t)l * DM * INC; T.K = DM; T.ldw = INC; T.N = INA; T.WT = (bf16*)(ws + WS_WINA) + (size_t)l * INA_P * DM; T.item = r; return T; } r -= NWI_INA;
    if (r < NWI_G) { T.W = karg(7) + (size_t)l * DM * INC; T.K = DM; T.ldw = INC; T.c0 = INA; T.N = DM; T.WT = (bf16*)(ws + WS_WGA) + (size_t)l * DM * DM; T.item = r; return T; } r -= NWI_G;
    if (r < NWI_G) { T.W = karg(7) + (size_t)l * DM * INC; T.K = DM; T.ldw = INC; T.c0 = INA + DM; T.N = DM; T.WT = (bf16*)(ws + WS_WGB) + (size_t)l * DM * DM; T.item = r; return T; } r -= NWI_G;
    if (r < NWI_BR) { T.W = karg(24) + (size_t)l * RW * DM; T.K = RW; T.ldw = DM; T.N = DM; T.WT = (bf16*)(ws + WS_WA) + (size_t)l * DM * RW; T.item = r; return T; } r -= NWI_BR;
    if (r < NWI_BR) { T.W = karg(25) + (size_t)l * RW * DM; T.K = RW; T.ldw = DM; T.N = DM; T.WT = (bf16*)(ws + WS_WB) + (size_t)l * DM * RW; T.item = r; return T; } r -= NWI_BR;
    if (r < NWI_G) { T.W = karg(26) + (size_t)l * DM * DM; T.K = DM; T.ldw = DM; T.N = DM; T.WT = (bf16*)(ws + WS_WO) + (size_t)l * DM * DM; T.item = r; return T; } r -= NWI_G;
    if (r < NWI_UQ) { T.W = karg(21) + (size_t)l * 512 * NQ; T.K = 512; T.ldw = NQ; T.N = NQ; T.WT = (bf16*)(ws + WS_WUQ) + (size_t)l * NQ * 512; T.item = r; T.mapq = 1; return T; } r -= NWI_UQ;
    if (r < NWI_UKV) { T.W = karg(23) + (size_t)l * 256 * NKV; T.K = 256; T.ldw = NKV; T.N = NKV; T.WT = (bf16*)(ws + WS_WUKV) + (size_t)l * NKV * 256; T.item = r; return T; } r -= NWI_UKV;
    return p0_resolve(ws, l * TI_N + r);
}
__device__ __forceinline__ void p0_prologue(Frame& F, int l_lo, int l_hi, int svcu, int sG, int with_tr = 1) {
    LAS float* scr = (LAS float*)(F.lds + F.wave * 16384);
    const int gw = svcu * NWAVES + F.wave, NGW = sG * NWAVES;
    unsigned char* ws = F.ws;
    for (int rp_ = 0; rp_ < (DBG_REPEAT == 102 ? 2 : 1); ++rp_)
    { float* modw = (float*)(ws + WS_CTL + CTL_MOD_OFF); const float* adaw = karg(4); const float* adab = karg(5); const float* cin = karg(1); const float* cctx = karg(3);
      LAS float* SIL = (LAS float*)F.lds;
      LAS f32x2* part = (LAS f32x2*)(F.lds + 32768);
      if (svcu >= 0 && l_lo * 96 + svcu < l_hi * 96) {
          for (int i = F.tid; i < 3 * DM; i += 512) { const int r = i >> 11, k = i & 2047; const float c = r < 2 ? cin[r * DM + k] : cctx[k]; SIL[i] = c / (1.f + __expf(-c)); }
          __syncthreads(); }
      if (svcu >= 0) for (int uu = l_lo * 96 + svcu; uu < l_hi * 96; uu += sG) { const int cb = uu % 96, l = uu / 96;
          const int n0 = cb * 128 + F.lane * 2; const float* aw = adaw + (size_t)l * DM * 12288 + n0;
          f32x2 a0 = {0, 0}, a1 = a0, a2 = a0;
#pragma unroll 1
          for (int k0 = F.wave * 256; k0 < F.wave * 256 + 256; k0 += 16) { f32x2 w[16];
#pragma unroll
              for (int j = 0; j < 16; ++j) w[j] = *(const GAS f32x2*)(aw + (size_t)(k0 + j) * 12288);
#pragma unroll
              for (int j = 0; j < 16; ++j) { a0 = a0 + w[j] * SIL[k0 + j]; a1 = a1 + w[j] * SIL[DM + k0 + j]; a2 = a2 + w[j] * SIL[2 * DM + k0 + j]; } }
          __syncthreads();
          part[(F.wave * 3 + 0) * 64 + F.lane] = a0; part[(F.wave * 3 + 1) * 64 + F.lane] = a1; part[(F.wave * 3 + 2) * 64 + F.lane] = a2;
          __syncthreads();
          if (F.wave < 3) { f32x2 s = *(const GAS f32x2*)(adab + (size_t)l * 12288 + n0);
#pragma unroll
              for (int w8 = 0; w8 < 8; ++w8) s = s + part[(w8 * 3 + F.wave) * 64 + F.lane];
              *(GAS f32x2*)(modw + ((size_t)l * 3 + F.wave) * 12288 + n0) = s; }
          __syncthreads(); } }
    if (with_tr) for (int rp_ = 0; rp_ < (DBG_REPEAT == 101 ? 2 : 1); ++rp_)
    { unsigned* ctr = (unsigned*)(ws + WS_CTL) + 2048 + 64 * rp_ + 128 * l_lo; LAS float* tile = (LAS float*)F.lds; LAS int* slot = (LAS int*)(F.lds + 128 * 132 * 4);
#define P0_GRAB(dst) do { __syncthreads(); if (F.tid == 0) *slot = (int)__hip_atomic_fetch_add(ctr, 1u, __ATOMIC_RELAXED, __HIP_MEMORY_SCOPE_AGENT); __syncthreads(); dst = *slot; } while (0)
      const int it_end = l_hi * TB_N;
      int it; P0_GRAB(it); it += l_lo * TB_N; f32x4 xa[8], xb[8]; TItem T, Tn;
      if (it < it_end) { T = p0_resolve_big(ws, it); p0_big_load(T, F.tid, xa); }
      while (it < it_end) { int itn; P0_GRAB(itn); itn += l_lo * TB_N; const bool more = itn < it_end;
          if (more) { Tn = p0_resolve_big(ws, itn); p0_big_load(Tn, F.tid, xb); }
          p0_big_finish(T, xa, tile, F.tid);
          if (more) { T = Tn;
#pragma unroll
              for (int i = 0; i < 8; ++i) xa[i] = xb[i]; }
          it = itn; }
#undef P0_GRAB
      __syncthreads();
      if (svcu >= 0) for (int itw = l_lo * TI_N + gw; itw < l_hi * TI_N; itw += NGW) { f32x4 xw[8]; const TItem Tw = p0_resolve(ws, itw); p0_item_load(Tw, F.lane, xw); p0_item_finish(Tw, xw, scr, F.lane); }
    }
    const int gt = gw * 64 + F.lane, NGT = NGW * 64;
    { const float* gup = karg(14);
    if (svcu >= 0) for (int i = l_lo * 2 * 32 * RW + gt; i < l_hi * 2 * 32 * RW; i += NGT) { const int ch = i & 1023, r = (i >> 10) & 31, ld = i >> 15;
        ((bf16*)(ws + WS_GUP))[((size_t)ld * RW + ch) * 32 + r] = (bf16)f2bf(gup[i]); } }
    if (svcu >= 0) for (int i = l_lo * ((INA_P - INA) * DM / 8) + gt; i < l_hi * ((INA_P - INA) * DM / 8); i += NGT) { const int l = i / ((INA_P - INA) * DM / 8), r = i - l * ((INA_P - INA) * DM / 8);
        v4u z_ = {0u, 0u, 0u, 0u}; asm volatile("" : "+v"(z_));
        ((GAS v4u*)((bf16*)(ws + WS_WINA) + ((size_t)l * INA_P + INA) * DM))[r] = z_; }
    { f32x2* rt = (f32x2*)(ws + WS_ROPE);
      if (l_lo == 0 && svcu >= 0) for (int i = gt; i < TPB * 16; i += NGT) { const int tp = i >> 4, k = i & 15; f32x2 o = {1.f, 0.f};
          if (tp >= CTXL) { const int t = tp - CTXL, row = t >> 6, col = t & 63, j = k & 7; const float fr = powf(10000.0f, -(float)j / 8.0f);
              const float ang = (float)(k < 8 ? row : col) * fr; o.x = cosf(ang); o.y = sinf(ang); }
          rt[i] = o; } }
    for (int rp_ = 0; rp_ < (DBG_REPEAT == 103 ? 2 : 1); ++rp_)
    { LAS float* KEY = (LAS float*)F.lds;
      LAS float* WQT = (LAS float*)(F.lds + 65536);
      const float* pkeys = karg(29); const float* pwq = karg(28);
      __syncthreads();
      if (svcu >= 0) for (int uu = l_lo * 512 + svcu; uu < l_hi * 512; uu += sG) { const int kb = uu & 31, hp = (uu >> 5) & 15, l = uu >> 9;
          const GAS f32x4* ksrc = (const GAS f32x4*)(pkeys + ((size_t)l * 16 + hp) * 16384);
          for (int i = F.tid; i < 4096; i += 512) ((LAS f32x4*)KEY)[i] = ksrc[i];
          for (int i = F.tid; i < 2048; i += 512) { const int kk = i >> 5, d4 = i & 31;
              *(LAS f32x4*)(WQT + kk * 132 + d4 * 4) = *(const GAS f32x4*)(pwq + ((size_t)l * DM + kb * 64 + kk) * DM + hp * 128 + d4 * 4); }
          __syncthreads();
          const int kq = F.tid & 15, keyq = F.tid >> 4;
          float acc[4][4];
#pragma unroll
          for (int j = 0; j < 4; ++j)
#pragma unroll
              for (int i = 0; i < 4; ++i) acc[j][i] = 0.f;
          for (int d = 0; d < 128; d += 4) { f32x4 w[4], q[4];
#pragma unroll
              for (int i = 0; i < 4; ++i) w[i] = *(LAS f32x4*)(WQT + (kq + 16 * i) * 132 + d);
#pragma unroll
              for (int j = 0; j < 4; ++j) q[j] = *(LAS f32x4*)(KEY + (4 * keyq + j) * 128 + d);
#pragma unroll
              for (int j = 0; j < 4; ++j)
#pragma unroll
                  for (int i = 0; i < 4; ++i) acc[j][i] += q[j].x * w[i].x + q[j].y * w[i].y + q[j].z * w[i].z + q[j].w * w[i].w; }
          bf16* dst = (bf16*)(ws + WS_WQK) + ((size_t)l * DM + hp * 128 + 4 * keyq) * DM + kb * 64 + kq;
#pragma unroll
          for (int j = 0; j < 4; ++j)
#pragma unroll
              for (int i = 0; i < 4; ++i) dst[(size_t)j * DM + 16 * i] = (bf16)f2bf(acc[j][i]);
          __syncthreads(); } }
}

__device__ __forceinline__ const float* modnorm_src(int m, const float* X, const float* xin, const float* cin) {
    const int b = m / TPB, tp = m - b * TPB;
    return xin ? (tp < CTXL ? cin + ((size_t)b * CTXL + tp) * DM : xin + ((size_t)b * SEQ + (tp - CTXL)) * DM) : X + (size_t)m * DM;
}
__device__ __forceinline__ void modnorm_phase_bf(Frame& F, const bf16* X, const float* g, const float* mod  , int chunk_sh, bf16* H, int skip_ctx) {
    const int gw = F.vcu * NWAVES + F.wave, NGW = F.G * NWAVES;
    int m = gw; while (m < MALL && skip_ctx && (m % TPB) < CTXL) m += NGW;
    v4u v[4]; f32x4 ga[8], sb[8]; int mr_cur = -1;
    if (m < MALL) { const GAS v4u* xr = (const GAS v4u*)(X + (size_t)m * DM) + F.lane;
#pragma unroll
        for (int j = 0; j < 4; ++j) v[j] = xr[64 * j]; }
    while (m < MALL) {
        int mn = m + NGW; while (mn < MALL && skip_ctx && (mn % TPB) < CTXL) mn += NGW;
        v4u nv[4];
        if (mn < MALL) { const GAS v4u* xr = (const GAS v4u*)(X + (size_t)mn * DM) + F.lane;
#pragma unroll
            for (int j = 0; j < 4; ++j) nv[j] = xr[64 * j]; }
        const int b = m / TPB, tp = m - b * TPB, mr = tp < CTXL ? 2 : b;
        if (mr != mr_cur) { mr_cur = mr; const float* sh = mod + (size_t)mr * 12288 + chunk_sh * DM; const float* sc = sh + DM;
#pragma unroll
            for (int q = 0; q < 8; ++q) { const int c = (F.lane + 64 * (q >> 1)) * 8 + 4 * (q & 1); const f32x4 gg = *(const GAS f32x4*)(g + c), s1 = *(const GAS f32x4*)(sc + c); ga[q] = gg * (s1 + 1.0f); sb[q] = *(const GAS f32x4*)(sh + c); } }
        float x[4][8]; float s = 0.f;
#pragma unroll
        for (int j = 0; j < 4; ++j) { x[j][0] = bflo(v[j].x); x[j][1] = bfhi(v[j].x); x[j][2] = bflo(v[j].y); x[j][3] = bfhi(v[j].y); x[j][4] = bflo(v[j].z); x[j][5] = bfhi(v[j].z); x[j][6] = bflo(v[j].w); x[j][7] = bfhi(v[j].w);
#pragma unroll
            for (int e = 0; e < 8; ++e) s += x[j][e] * x[j][e]; }
        const float rs = rsqrtf(wave_sum(s) * (1.f / DM) + NORM_EPS);
        GAS v4u* o8 = (GAS v4u*)(H + (size_t)m * DM) + F.lane;
#pragma unroll
        for (int j = 0; j < 4; ++j) { float y[8];
#pragma unroll
            for (int e = 0; e < 8; ++e) y[e] = (x[j][e] * rs) * ga[2 * j + (e >> 2)][e & 3] + sb[2 * j + (e >> 2)][e & 3];
            v4u o; o.x = pk2(y[0], y[1]); o.y = pk2(y[2], y[3]); o.z = pk2(y[4], y[5]); o.w = pk2(y[6], y[7]); o8[64 * j] = o; }
#pragma unroll
        for (int j = 0; j < 4; ++j) v[j] = nv[j];
        m = mn;
    }
}
__device__ __forceinline__ void modnorm_phase(Frame& F, const float* X, const float* g, const float* mod  , int chunk_sh, bf16* H, int skip_ctx, const float* xin = nullptr, const float* cin = nullptr) {
    const int gw = F.vcu * NWAVES + F.wave, NGW = F.G * NWAVES;
    int m = gw; while (m < MALL && skip_ctx && (m % TPB) < CTXL) m += NGW;
    f32x4 v[8], ga[8], sb[8]; int mr_cur = -1;
    if (m < MALL) { const GAS f32x4* xr = (const GAS f32x4*)modnorm_src(m, X, xin, cin) + F.lane;
#pragma unroll
        for (int j = 0; j < 8; ++j) v[j] = xr[64 * j]; }
    while (m < MALL) {
        int mn = m + NGW; while (mn < MALL && skip_ctx && (mn % TPB) < CTXL) mn += NGW;
        f32x4 nv[8];
        if (mn < MALL) { const GAS f32x4* xr = (const GAS f32x4*)modnorm_src(mn, X, xin, cin) + F.lane;
#pragma unroll
            for (int j = 0; j < 8; ++j) nv[j] = xr[64 * j]; }
        const int b = m / TPB, tp = m - b * TPB, mr = tp < CTXL ? 2 : b;
        if (mr != mr_cur) { mr_cur = mr; const float* sh = mod + (size_t)mr * 12288 + chunk_sh * DM; const float* sc = sh + DM;
#pragma unroll
            for (int j = 0; j < 8; ++j) { const int c = (F.lane + 64 * j) * 4; const f32x4 gg = *(const GAS f32x4*)(g + c), s1 = *(const GAS f32x4*)(sc + c); ga[j] = gg * (s1 + 1.0f); sb[j] = *(const GAS f32x4*)(sh + c); } }
        float s = 0.f;
#pragma unroll
        for (int j = 0; j < 8; ++j) s += (v[j].x * v[j].x + v[j].y * v[j].y) + (v[j].z * v[j].z + v[j].w * v[j].w);
        const float rs = rsqrtf(wave_sum(s) * (1.f / DM) + NORM_EPS);
        GAS v2u* o8 = (GAS v2u*)(H + (size_t)m * DM) + F.lane;
#pragma unroll
        for (int j = 0; j < 8; ++j) { const f32x4 y = (v[j] * rs) * ga[j] + sb[j];
            v2u o; o.x = pk2(y.x, y.y); o.y = pk2(y.z, y.w); o8[64 * j] = o; }
#pragma unroll
        for (int j = 0; j < 8; ++j) v[j] = nv[j];
        m = mn;
    }
}

typedef float f32x4v __attribute__((ext_vector_type(4)));
#define MFMA16(a, b, c) __builtin_amdgcn_mfma_f32_16x16x32_bf16((a), (b), (c), 0, 0, 0)
#define MFMA32(a, b, c) __builtin_amdgcn_mfma_f32_32x32x16_bf16((a), (b), (c), 0, 0, 0)

struct FeatP {
    const bf16* PA; const float* mu; const float* w0; const float* a0; const float* k_k; const float* k_a; const float* r_k;
    const bf16* WUP; const bf16* AUP; const bf16* GUP;
    const float* qnorm; const float* kvnorm; const f32x2* rope;
    bf16* RI; bf16* GG; float* BON; bf16* QN; bf16* KVN; bf16* K;
};
__device__ __forceinline__ f32x4 ld4bf(const bf16* p) { const v2u w = *(const GAS v2u*)p; return (f32x4){bflo(w.x), bfhi(w.x), bflo(w.y), bfhi(w.y)}; }
__device__ __forceinline__ f32x4 mix4(const bf16* PA, int m, int c, bool hp, bool hn, const float* mu) {
    const f32x4 pc = ld4bf(PA + (size_t)m * INA_P + c);
    f32x4 pp = {0, 0, 0, 0}, pn = {0, 0, 0, 0};
    if (hp) pp = ld4bf(PA + (size_t)(m - 1) * INA_P + c);
    if (hn) pn = ld4bf(PA + (size_t)(m + 1) * INA_P + c);
    const f32x4 mm = *(const GAS f32x4*)(mu + c);
    return pc + ((pp + pn) * 0.5f - pc) * mm;
}
__device__ __forceinline__ void unpack8(const v4u w, float (&x)[8]) { x[0] = bflo(w.x); x[1] = bfhi(w.x); x[2] = bflo(w.y); x[3] = bfhi(w.y); x[4] = bflo(w.z); x[5] = bfhi(w.z); x[6] = bflo(w.w); x[7] = bfhi(w.w); }
__device__ __forceinline__ v4u pack8f(const float (&x)[8]) { v4u o; o.x = pk2(x[0], x[1]); o.y = pk2(x[2], x[3]); o.z = pk2(x[4], x[5]); o.w = pk2(x[6], x[7]); return o; }
__device__ __forceinline__ void mix8(const bf16* rowc, bool hp, bool hn, const float (&mu)[8], float (&o)[8]) {
    const v4u zc = {0u, 0u, 0u, 0u};
    const v4u wc = *(const GAS v4u*)rowc, wp = hp ? *(const GAS v4u*)(rowc - INA_P) : zc, wn = hn ? *(const GAS v4u*)(rowc + INA_P) : zc;
    float c[8], p[8], n[8]; unpack8(wc, c); unpack8(wp, p); unpack8(wn, n);
#pragma unroll
    for (int e = 0; e < 8; ++e) o[e] = c[e] + (0.5f * (p[e] + n[e]) - c[e]) * mu[e];
}
struct Raw3 { v4u c, p, n; };
__device__ __forceinline__ Raw3 load3(const bf16* rowc, bool hp, bool hn) { const v4u zc = {0u, 0u, 0u, 0u}; Raw3 r; r.c = *(const GAS v4u*)rowc; r.p = hp ? *(const GAS v4u*)(rowc - INA_P) : zc; r.n = hn ? *(const GAS v4u*)(rowc + INA_P) : zc; return r; }
__device__ __forceinline__ void mix8r(const Raw3& w, const float (&mu)[8], float (&o)[8]) {
    float c[8], p[8], n[8]; unpack8(w.c, c); unpack8(w.p, p); unpack8(w.n, n);
#pragma unroll
    for (int e = 0; e < 8; ++e) o[e] = c[e] + (0.5f * (p[e] + n[e]) - c[e]) * mu[e];
}
__device__ __forceinline__ void features_phase(Frame& F, const FeatP& P) {
    constexpr int LAP = 328;
    LAS bf16* LA = (LAS bf16*)F.lds;
    LAS float* SSQ = (LAS float*)(F.lds + 10752);
    LAS float* PRM = (LAS float*)(F.lds + 12288);
    const int lane = F.lane, w = F.wave, tk = lane & 15, q4 = lane >> 4;
    constexpr int NTILE = MALL / 16, NTG = 64;
    for (int su = F.vcu; su < 4 * NTG; su += F.G) {
        const int cg = su & 3, tg = su >> 2, cw = 256 * cg + 32 * w, ch8 = cw + 8 * q4, hd = 4 * cg + (w >> 1);
        __syncthreads();
        for (int i = F.tid; i < 2560; i += 512) { const int prm = i >> 8, c = (i & 255) + 256 * cg; float v;
            switch (prm) { case 0: v = P.k_k[c]; break; case 1: v = P.k_a[c]; break; case 2: v = P.r_k[c]; break; case 3: v = P.w0[c]; break; case 4: v = P.w0[RW + c]; break;
                           case 5: v = P.a0[c]; break; case 6: v = P.a0[RW + c]; break; case 7: v = P.mu[c]; break; case 8: v = P.mu[RW + c]; break; default: v = P.mu[2 * RW + c]; break; }
            PRM[i] = v; }
        bf16x8 fw[2][2][2], fa[2][2][2], fg[2][2];
        { const int chA = cw + 8 * (tk >> 2) + (tk & 3);
#pragma unroll
          for (int d = 0; d < 2; ++d)
#pragma unroll
              for (int t = 0; t < 2; ++t) {
#pragma unroll
                  for (int ks = 0; ks < 2; ++ks) { fw[d][t][ks] = *(const GAS bf16x8*)(P.WUP + ((size_t)d * RW + chA + 4 * t) * 64 + ks * 32 + q4 * 8); fa[d][t][ks] = *(const GAS bf16x8*)(P.AUP + ((size_t)d * RW + chA + 4 * t) * 64 + ks * 32 + q4 * 8); }
                  fg[d][t] = *(const GAS bf16x8*)(P.GUP + ((size_t)d * RW + chA + 4 * t) * 32 + q4 * 8); } }
        for (int tt = tg; tt < NTILE; tt += NTG) {
            const int m0 = tt * 16;
            const int m = m0 + tk, b = m / TPB, tp = m - b * TPB;
            const bool hp = (tp != 0) && (tp != CTXL), hn = (tp != CTXL - 1) && (tp != TPB - 1);
            const bf16* rowp = P.PA + (size_t)m * INA_P + ch8;
            const Raw3 rawk = load3(rowp + RW, hp, hn), rawr = load3(rowp, hp, hn), rawv = load3(rowp + 2 * RW, hp, hn);
            __syncthreads();
            for (int it = F.tid; it < 640; it += 512) { const int tkk = it / 40, c8 = (it - tkk * 40) * 8, c = C_WD + c8, m = m0 + tkk, tp = m % TPB;
                const bool hp = (tp != 0) && (tp != CTXL), hn = (tp != CTXL - 1) && (tp != TPB - 1);
                float mu[8], v[8];
                { const f32x4 a = *(const GAS f32x4*)(P.mu + c), b2 = *(const GAS f32x4*)(P.mu + c + 4); mu[0] = a.x; mu[1] = a.y; mu[2] = a.z; mu[3] = a.w; mu[4] = b2.x; mu[5] = b2.y; mu[6] = b2.z; mu[7] = b2.w; }
                mix8(P.PA + (size_t)m * INA_P + c, hp, hn, mu, v);
#pragma unroll
                for (int e = 0; e < 8; ++e) { if (c < C_AD) v[e] = 1.0f - 2.0f * __builtin_amdgcn_rcpf(1.0f + __expf(2.0f * v[e])); else if (c >= C_GD) v[e] = sigmoidf_(v[e]); }
                *(LAS v4u*)(LA + tkk * LAP + c8) = pack8f(v); }
            if ((tt & 3) == cg) {
#pragma unroll
                for (int t2 = 0; t2 < 2; ++t2) { const int m = m0 + 2 * w + t2, b = m / TPB, tp = m - b * TPB; const bf16* row = P.PA + (size_t)m * INA_P;
                    { float x[8]; unpack8(*(const GAS v4u*)(row + C_QC + lane * 8), x); float s = 0.f;
#pragma unroll
                      for (int e = 0; e < 8; ++e) s += x[e] * x[e];
                      const float rs = rsqrtf(wave_sum(s) * (1.f / 512.f) + NORM_EPS);
#pragma unroll
                      for (int e = 0; e < 8; ++e) x[e] = x[e] * rs * P.qnorm[lane * 8 + e];
                      *(GAS v4u*)(P.QN + (size_t)m * 512 + lane * 8) = pack8f(x); }
                    { const v2u q = *(const GAS v2u*)(row + C_KVC + lane * 4);
                      float x[4] = {bflo(q.x), bfhi(q.x), bflo(q.y), bfhi(q.y)}; float s = 0.f;
#pragma unroll
                      for (int e = 0; e < 4; ++e) s += x[e] * x[e];
                      const float rs = rsqrtf(wave_sum(s) * (1.f / 256.f) + NORM_EPS);
#pragma unroll
                      for (int e = 0; e < 4; ++e) x[e] = x[e] * rs * P.kvnorm[lane * 4 + e];
                      v2u o; o.x = pk2(x[0], x[1]); o.y = pk2(x[2], x[3]);
                      *(GAS v2u*)(P.KVN + (size_t)m * 256 + lane * 4) = o; }
                    if (lane < 16) { const float x1 = bf1(row[C_KR + lane]), x2 = bf1(row[C_KR + 16 + lane]); const f32x2 cs = P.rope[(size_t)tp * 16 + lane];
                        const unsigned o = pk2(x1 * cs.x - x2 * cs.y, x1 * cs.y + x2 * cs.x);
#pragma unroll
                        for (int h2 = 0; h2 < NH; ++h2) *(GAS unsigned*)(P.K + ((size_t)(b * NH + h2) * TPB + tp) * QKD + 64 + 2 * lane) = o; } } }
            const int pc = 32 * w + 8 * q4;
            float prm[8], kmx[8], kx[8];
#pragma unroll
            for (int e = 0; e < 8; ++e) prm[e] = PRM[8 * 256 + pc + e];
            mix8r(rawk, prm, kmx);
            { float s = 0.f;
#pragma unroll
              for (int e = 0; e < 8; ++e) { kx[e] = kmx[e] * PRM[0 * 256 + pc + e]; s += kx[e] * kx[e]; }
              s += bpermf(lane ^ 16, s); s += bpermf(lane ^ 32, s);
              if (q4 == 0) SSQ[tk * 8 + w] = s; }
            __syncthreads();
            const float rsn = rsqrtf(SSQ[tk * 8 + w] + SSQ[tk * 8 + (w ^ 1)] + 1e-12f);
            f32x4 cw_[2][2], ca_[2][2], cg_[2][2];
#pragma unroll
            for (int d = 0; d < 2; ++d) {
                const bf16x8 bg = *(const LAS bf16x8*)(LA + tk * LAP + 256 + d * 32 + q4 * 8);
                bf16x8 bw[2], ba[2];
#pragma unroll
                for (int ks = 0; ks < 2; ++ks) { bw[ks] = *(const LAS bf16x8*)(LA + tk * LAP + d * 64 + ks * 32 + q4 * 8); ba[ks] = *(const LAS bf16x8*)(LA + tk * LAP + 128 + d * 64 + ks * 32 + q4 * 8); }
#pragma unroll
                for (int t = 0; t < 2; ++t) { f32x4 z = {0, 0, 0, 0};
                    cw_[d][t] = MFMA16(fw[d][t][1], bw[1], MFMA16(fw[d][t][0], bw[0], z));
                    ca_[d][t] = MFMA16(fa[d][t][1], ba[1], MFMA16(fa[d][t][0], ba[0], z));
                    cg_[d][t] = MFMA16(fg[d][t], bg, z); } }
            float r8[8], v8[8], kk8[8];
#pragma unroll
            for (int e = 0; e < 8; ++e) prm[e] = PRM[7 * 256 + pc + e];
            mix8r(rawr, prm, r8);
#pragma unroll
            for (int e = 0; e < 8; ++e) prm[e] = PRM[9 * 256 + pc + e];
            mix8r(rawv, prm, v8);
#pragma unroll
            for (int e = 0; e < 8; ++e) kk8[e] = kx[e] * rsn;
            bf16* rec = P.RI + ((size_t)(b * NH + hd) * TPB + tp) * RREC + (ch8 & 63);
            *(GAS v4u*)(rec) = pack8f(r8); *(GAS v4u*)(rec + 64) = pack8f(kk8); *(GAS v4u*)(rec + 128) = pack8f(v8);
#pragma unroll
            for (int d = 0; d < 2; ++d) {
                float ld[8], ke[8], bb[8], gg[8]; float bs = 0.f;
#pragma unroll
                for (int e = 0; e < 8; ++e) { const int t = e >> 2, r = e & 3;
                    ld[e] = -0.60653066f * sigmoidf_(PRM[(3 + d) * 256 + pc + e] + cw_[d][t][r]);
                    const float aa = sigmoidf_(PRM[(5 + d) * 256 + pc + e] + ca_[d][t][r]);
                    ke[e] = kmx[e] * (1.0f + (aa - 1.0f) * PRM[1 * 256 + pc + e]); bb[e] = kk8[e] * aa; gg[e] = cg_[d][t][r];
                    bs += r8[e] * ke[e] * PRM[2 * 256 + pc + e]; }
                *(GAS v4u*)(rec + (3 + 3 * d) * 64) = pack8f(ld); *(GAS v4u*)(rec + (4 + 3 * d) * 64) = pack8f(bb); *(GAS v4u*)(rec + (5 + 3 * d) * 64) = pack8f(ke);
                *(GAS v4u*)(P.GG + ((size_t)d * MALL + m) * RW + ch8) = pack8f(gg);
                bs += bpermf(lane ^ 16, bs); bs += bpermf(lane ^ 32, bs);
                if (q4 == 0) P.BON[((size_t)d * MALL + m) * 32 + 2 * hd + (w & 1)] = bs; }
        }
    }
}

__device__ __forceinline__ void cvt_row_load(f32x4 (&x)[8], const float* src) {
#pragma unroll
    for (int q = 0; q < 8; ++q) x[q] = *(const GAS f32x4*)(src + q * 4);
}
__device__ __forceinline__ void cvt_row_store(const f32x4 (&x)[8], unsigned char* dst, float* scale_slot, int lane) {
    float am = 0.f;
#pragma unroll
    for (int q = 0; q < 8; ++q) am = fmaxf(am, fmaxf(fmaxf(fabsf(x[q].x), fabsf(x[q].y)), fmaxf(fabsf(x[q].z), fabsf(x[q].w))));
    am = fmaxf(wave_max_u(am), 1e-30f);
    const float g = 6.0f / am, inv = am * (1.0f / 6.0f);
    v4u o;
#pragma unroll
    for (int q = 0; q < 4; ++q) { unsigned w = 0u;
        w = __builtin_amdgcn_cvt_scalef32_pk_fp4_f32(w, x[2 * q].x * g, x[2 * q].y * g, 1.0f, 0);
        w = __builtin_amdgcn_cvt_scalef32_pk_fp4_f32(w, x[2 * q].z * g, x[2 * q].w * g, 1.0f, 1);
        w = __builtin_amdgcn_cvt_scalef32_pk_fp4_f32(w, x[2 * q + 1].x * g, x[2 * q + 1].y * g, 1.0f, 2);
        w = __builtin_amdgcn_cvt_scalef32_pk_fp4_f32(w, x[2 * q + 1].z * g, x[2 * q + 1].w * g, 1.0f, 3);
        o[q] = w; }
    *(GAS v4u*)dst = o;
    if (lane == 0) *scale_slot = inv;
}
struct ScanCvt { const float* pu; const float* pv; unsigned char* PU8; unsigned char* PV8; float* SU; float* SV; int wl; };
constexpr int SCH = 32;
constexpr int SSTEP = 6 * 64;
__device__ __forceinline__ int scan_tp(int dir, int s) { return dir == 0 ? s : (s < CTXL ? (CTXL - 1 - s) : (TPB - 1 - (s - CTXL))); }
__device__ __forceinline__ void scan_load(v4u (&rg)[6], const bf16* RIh, int dir, int chunk, int htid) {
    const int tp = scan_tp(dir, chunk * SCH + (htid >> 3));
    const bf16* rec = RIh + (size_t)tp * RREC + (htid & 7) * 8;
#pragma unroll
    for (int i = 0; i < 3; ++i) rg[i] = *(const GAS v4u*)(rec + i * 64);
    rec += (3 + 3 * dir) * 64;
#pragma unroll
    for (int i = 0; i < 3; ++i) rg[3 + i] = *(const GAS v4u*)(rec + i * 64);
}
__device__ __forceinline__ void scan_store(const v4u (&rg)[6], LAS float* buf, int htid) {
    LAS float* d0 = buf + (htid >> 3) * SSTEP + (htid & 7) * 8;
#pragma unroll
    for (int i = 0; i < 6; ++i) { constexpr int SLOT[6] = {4, 0, 5, 2, 1, 3};
        const v4u wv = rg[i];
        f32x4 lo = {bflo(wv.x), bfhi(wv.x), bflo(wv.y), bfhi(wv.y)}, hi = {bflo(wv.z), bfhi(wv.z), bflo(wv.w), bfhi(wv.w)};
        if (i == 3) {
#pragma unroll
            for (int e = 0; e < 4; ++e) { lo[e] = __expf(lo[e]); hi[e] = __expf(hi[e]); } }
        LAS float* d = d0 + SLOT[i] * 64;
        *(LAS f32x4*)d = lo; *(LAS f32x4*)(d + 4) = hi; }
}
__device__ __forceinline__ void scan_phase(Frame& F, const bf16* RI, bf16* Y, const ScanCvt& C) {
    LAS float* bufs = (LAS float*)F.lds;
    constexpr int NCH = TPB / SCH;
    for (int uu = F.vcu; uu < NBATCH * NH * 2 * 4; uu += F.G) {
        const int rg = uu & 3, dir = (uu >> 2) & 1, hd = (uu >> 3) & 15, b = uu >> 7;
        const bf16* RIh = RI + (size_t)(b * NH + hd) * TPB * RREC;
        const int htid = F.tid - 256;
        v4u ra[6], rb[6];
        f32x4 xw[8];
        LAS float* wscr = (LAS float*)(F.lds + (((F.wave & 3) == 3) ? LDSCTL_OFF + 4096 : 98304 + (F.wave & 3) * 8448));
        f32x4 xc[8];
        __syncthreads();
        if (F.wave >= 4) { scan_load(rb, RIh, dir, 0, htid); scan_load(ra, RIh, dir, 1, htid); scan_store(rb, bufs, htid); scan_load(rb, RIh, dir, 2, htid); }
        __syncthreads();
        const int j = F.lane & 15, rowl = F.lane >> 4, row = rg * 16 + (F.wave & 3) * 4 + rowl;
        f32x2 S01 = {0.f, 0.f}, S23 = {0.f, 0.f};
        bf16* yb = Y + ((size_t)dir * MALL + (size_t)b * TPB) * RW + hd * 64 + row;
        for (int c = 0; c < NCH; ++c) {
            LAS float* cur = bufs + (c & 1) * (SCH * SSTEP);
            if (F.wave >= 4) {
                if (c + 1 < NCH) {
                    if ((c & 1) == 0) { scan_store(ra, bufs + (SCH * SSTEP), htid); if (c + 3 < NCH) scan_load(ra, RIh, dir, c + 3, htid); }
                    else { scan_store(rb, bufs, htid); if (c + 3 < NCH) scan_load(rb, RIh, dir, c + 3, htid); }  }
                if (C.wl >= 0 && (c & 3) == 2) { const int wi = uu * 4 + (F.wave - 4) + 1024 * (c >> 3);
                    if (wi < NW_ITEMS) { const TItem Tw = p0_resolve_wave(F.ws, C.wl, wi); if ((c & 7) == 2) p0_item_load(Tw, F.lane, xw); else p0_item_finish(Tw, xw, wscr, F.lane); } }
                if ((c & 3) == 0 && (c >> 3) < 32) { const int r = uu * 4 + (F.wave - 4) + 1024 * (c >> 3);
                    if ((c & 7) == 0) cvt_row_load(xc, ((r >= NEXP) ? C.pv + (size_t)(r - NEXP) * DM : C.pu + (size_t)r * DM) + F.lane * 32);
                    else cvt_row_store(xc, ((r >= NEXP) ? C.PV8 + (size_t)(r - NEXP) * (DM / 2) : C.PU8 + (size_t)r * (DM / 2)) + F.lane * 16, (r >= NEXP) ? C.SV + (r - NEXP) : C.SU + r, F.lane); } }
            else {
#pragma unroll
                for (int h16 = 0; h16 < 2; ++h16) {
                    const LAS float* sp = cur + (h16 * 16) * SSTEP;
                    f32x4 kk = *(const LAS f32x4*)(sp + 4 * j), bb = *(const LAS f32x4*)(sp + 64 + 4 * j), ww = *(const LAS f32x4*)(sp + 128 + 4 * j),
                          ke = *(const LAS f32x4*)(sp + 192 + 4 * j), rr = *(const LAS f32x4*)(sp + 256 + 4 * j);
                    float ykeep = 0.f, ypart; f32x2 u2, t2, vv; vv.x = sp[320 + row];
#define SCAN_DPP(r, ctl) "v_add_f32_dpp " r ", " r ", " r " " ctl " row_mask:0xf bank_mask:0xf bound_ctrl:1\n\t"
#define SCAN_MAIN(SEL) asm volatile( \
                        "v_pk_mul_f32 v[242:243], %[kexy], %[vv] op_sel_hi:[1,0]\n\t" \
                        "v_add_f32 v246, v250, v251\n\t" \
                        "v_add_f32_dpp v248, %[yp], %[yp] quad_perm:[1,0,3,2] row_mask:0xf bank_mask:0xf bound_ctrl:1\n\t" \
                        "v_pk_mul_f32 v[244:245], %[kezw], %[vv] op_sel_hi:[1,0]\n\t" \
                        SCAN_DPP("v246", "quad_perm:[1,0,3,2]") SCAN_DPP("v248", "quad_perm:[2,3,0,1]") \
                        "v_pk_fma_f32 %[s01], %[s01], %[wwxy], v[242:243]\n\t" \
                        SCAN_DPP("v246", "quad_perm:[2,3,0,1]") SCAN_DPP("v248", "row_half_mirror") \
                        "v_pk_fma_f32 %[s23], %[s23], %[wwzw], v[244:245]\n\t" \
                        SCAN_DPP("v246", "row_half_mirror") SCAN_DPP("v248", "row_mirror") \
                        SEL "\n\t" \
                        SCAN_DPP("v246", "row_mirror") \
                        "v_pk_fma_f32 %[s01], %[bbxy], v[246:247], %[s01] op_sel_hi:[1,0,1] neg_lo:[0,1,0] neg_hi:[0,1,0]\n\t" \
                        "v_pk_fma_f32 %[s23], %[bbzw], v[246:247], %[s23] op_sel_hi:[1,0,1] neg_lo:[0,1,0] neg_hi:[0,1,0]\n\t" \
                        "v_pk_mul_f32 v[252:253], %[s01], %[rrxy]" \
                        : [s01] "+v"(S01), [s23] "+v"(S23), [yk] "+v"(ykeep), "={v[252:253]}"(u2) \
                        : [kexy] "v"(ke.xy), [kezw] "v"(ke.zw), [vv] "v"(vv), [wwxy] "v"(ww.xy), [wwzw] "v"(ww.zw), [bbxy] "v"(bb.xy), [bbzw] "v"(bb.zw), [rrxy] "v"(rr.xy), [yp] "v"(ypart), [msk] "s"(msk), "{v[250:251]}"(t2) \
                        : "v242", "v243", "v244", "v245", "v246", "v247", "v248")
                    asm volatile("v_pk_mul_f32 v[250:251], %[s01], %[kxy]\n\tv_mov_b32 %[yp], 0\n\tv_pk_fma_f32 v[250:251], %[s23], %[kzw], v[250:251]"
                                 : "=&{v[250:251]}"(t2), [yp] "=&v"(ypart) : [s01] "v"(S01), [s23] "v"(S23), [kxy] "v"(kk.xy), [kzw] "v"(kk.zw));
#pragma unroll
                    for (int st = 0; st < 16; ++st) {
                        f32x4 nkk = kk, nbb = bb, nww = ww, nke = ke, nrr = rr; f32x2 nvv = vv;
                        const LAS float* sn = sp + (st + 1) * SSTEP;
                        if (st + 1 < 16) { nkk = *(const LAS f32x4*)(sn + 4 * j); nke = *(const LAS f32x4*)(sn + 192 + 4 * j); nvv.x = sn[320 + row]; nww = *(const LAS f32x4*)(sn + 128 + 4 * j); nbb = *(const LAS f32x4*)(sn + 64 + 4 * j);
                            nrr = *(const LAS f32x4*)(sn + 256 + 4 * j); }
                        const unsigned long long msk = 0x0001000100010001ull << ((st + 15) & 15);
                        if (st > 0) SCAN_MAIN("v_cndmask_b32_e64 %[yk], %[yk], v248, %[msk]"); else SCAN_MAIN("s_nop 0");
                        if (st + 1 < 16)
                            asm volatile("v_pk_mul_f32 v[250:251], %[s01], %[kxy]\n\tv_pk_fma_f32 v[252:253], %[s23], %[rrzw], v[252:253]\n\tv_pk_fma_f32 v[250:251], %[s23], %[kzw], v[250:251]\n\tv_add_f32 %[yp], v252, v253"
                                         : "=&{v[250:251]}"(t2), "={v[252:253]}"(u2), [yp] "=&v"(ypart) : [s01] "v"(S01), [s23] "v"(S23), [kxy] "v"(nkk.xy), [kzw] "v"(nkk.zw), [rrzw] "v"(rr.zw), "1"(u2));
                        else
                            asm volatile("s_nop 0\n\tv_pk_fma_f32 v[252:253], %[s23], %[rrzw], v[252:253]" : "={v[252:253]}"(u2) : [s23] "v"(S23), [rrzw] "v"(rr.zw), "0"(u2));
                        kk = nkk; bb = nbb; ww = nww; ke = nke; rr = nrr; vv = nvv;
                        __builtin_amdgcn_sched_barrier(0);
                    }
#undef SCAN_MAIN
#undef SCAN_DPP
                    { const float y = red16(u2.x + u2.y); ykeep = (j == 15) ? y : ykeep; }
                    const int tp = scan_tp(dir, c * SCH + h16 * 16 + j);
                    *(GAS bf16*)(yb + (size_t)tp * RW) = (bf16)f2bf(ykeep);
                }
            }
            LDS_BARRIER();
        }
    }
}

constexpr int AKP = 208, AVP = 192;
constexpr int ATILE = 64 * AKP + 64 * AVP;
__device__ __forceinline__ bf16x8 pack8(const f32x16& x, int s) {
    v4u p; p.x = pk2(x[8 * s + 0], x[8 * s + 1]); p.y = pk2(x[8 * s + 2], x[8 * s + 3]); p.z = pk2(x[8 * s + 4], x[8 * s + 5]); p.w = pk2(x[8 * s + 6], x[8 * s + 7]);
    return __builtin_bit_cast(bf16x8, p);
}
__device__ __forceinline__ void attn_phase(Frame& F, const bf16* Q, const bf16* K, const bf16* V, bf16* YB, int with_ctx) {
    const int lane = F.lane, half = lane >> 5, l31 = lane & 31, l16 = lane & 15, g1 = (lane >> 4) & 1;
    const int nunits = NBATCH * NH * 32 + (with_ctx ? NBATCH * NH : 0);
    for (int uu = F.vcu; uu < nunits; uu += F.G) {
        int bh, q0, nkt;
        if (uu < NBATCH * NH * 32) { bh = uu >> 5; q0 = CTXL + (uu & 31) * 256; nkt = TPB / 64; } else { bh = uu - NBATCH * NH * 32; q0 = 0; nkt = CTXL / 64; }
        const bf16* Kh = K + (size_t)bh * TPB * QKD; const bf16* Vh = V + (size_t)bh * TPB * 64; const bf16* Qh = Q + (size_t)bh * TPB * QKD;
        const int tq = q0 + F.wave * 32 + l31;
        bf16x8 qf[6];
#pragma unroll
        for (int ks = 0; ks < 6; ++ks) qf[ks] = *(const GAS bf16x8*)(Qh + (size_t)tq * QKD + 16 * ks + 8 * half);
        f32x16 o0, o1;
#pragma unroll
        for (int i = 0; i < 16; ++i) { o0[i] = 0.f; o1[i] = 0.f; }
        float l_run = 0.f;
        f32x16 cinit;
#pragma unroll
        for (int i = 0; i < 16; ++i) cinit[i] = 0.f;
        asm volatile("" : "+v"(cinit));
        const int kc1 = F.tid + 512; const bool k1ok = kc1 < 768;
        const unsigned kd0 = (unsigned)((F.tid / 12) * AKP + (F.tid % 12) * 16), kd1 = (unsigned)((kc1 / 12) * AKP + (kc1 % 12) * 16), vd = (unsigned)(64 * AKP + (F.tid >> 3) * AVP + (F.tid & 7) * 16);
        v4u kr0, kr1 = {0, 0, 0, 0}, vr;
        kr0 = *(const GAS v4u*)(Kh + (size_t)F.tid * 8); if (k1ok) kr1 = *(const GAS v4u*)(Kh + (size_t)kc1 * 8); vr = *(const GAS v4u*)(Vh + (size_t)F.tid * 8);
        __syncthreads();
        *(LAS v4u*)(F.lds + kd0) = kr0; if (k1ok) *(LAS v4u*)(F.lds + kd1) = kr1; *(LAS v4u*)(F.lds + vd) = vr;
        if (nkt > 1) { const bf16* kn = Kh + (size_t)64 * QKD; const bf16* vn = Vh + (size_t)64 * 64;
            kr0 = *(const GAS v4u*)(kn + (size_t)F.tid * 8); if (k1ok) kr1 = *(const GAS v4u*)(kn + (size_t)kc1 * 8); vr = *(const GAS v4u*)(vn + (size_t)F.tid * 8);
            *(LAS v4u*)(F.lds + ATILE + kd0) = kr0; if (k1ok) *(LAS v4u*)(F.lds + ATILE + kd1) = kr1; *(LAS v4u*)(F.lds + ATILE + vd) = vr; }
        __syncthreads();
        bf16x8 ka[6], kb2[6];
#pragma unroll
        for (int ks = 0; ks < 6; ++ks) { ka[ks] = *(const LAS bf16x8*)(F.lds + l31 * AKP + (16 * ks + 8 * half) * 2); kb2[ks] = *(const LAS bf16x8*)(F.lds + (32 + l31) * AKP + (16 * ks + 8 * half) * 2); }
        int bc = 0, bn = ATILE, bw = 2 * ATILE;
        for (int kt = 0; kt < nkt; ++kt) {
            const bool more = kt + 1 < nkt, more2 = kt + 2 < nkt;
            if (more2) { const bf16* kn = Kh + (size_t)(kt + 2) * 64 * QKD; const bf16* vn = Vh + (size_t)(kt + 2) * 64 * 64;
                kr0 = *(const GAS v4u*)(kn + (size_t)F.tid * 8); if (k1ok) kr1 = *(const GAS v4u*)(kn + (size_t)kc1 * 8); vr = *(const GAS v4u*)(vn + (size_t)F.tid * 8); }
            LAS unsigned char* Kb = F.lds + bc; LAS unsigned char* Vb = Kb + 64 * AKP;
            f32x16 s0, s1;
            { s0 = MFMA32(ka[0], qf[0], cinit);
#pragma unroll
              for (int ks = 1; ks < 6; ++ks) s0 = MFMA32(ka[ks], qf[ks], s0);
              s1 = MFMA32(kb2[0], qf[0], cinit);
#pragma unroll
              for (int ks = 1; ks < 6; ++ks) s1 = MFMA32(kb2[ks], qf[ks], s1);
              __builtin_amdgcn_sched_group_barrier(0x8, 12, 0); }
            bf16x8 va[2][2][2];
#pragma unroll
            for (int t = 0; t < 2; ++t)
#pragma unroll
                for (int s = 0; s < 2; ++s) { const int kb = 32 * t + 16 * s + 4 * half + (l16 >> 2);
#pragma unroll
                    for (int dvt = 0; dvt < 2; ++dvt) { const LAS unsigned char* vp = Vb + kb * AVP + (32 * dvt + 16 * g1 + 4 * (l16 & 3)) * 2;
                        const s16x4 lo = __builtin_amdgcn_ds_read_tr16_b64_v4i16((LAS s16x4*)vp), hi = __builtin_amdgcn_ds_read_tr16_b64_v4i16((LAS s16x4*)(vp + 8 * AVP));
                        va[t][s][dvt] = __builtin_shufflevector(lo, hi, 0, 1, 2, 3, 4, 5, 6, 7); } }
            __builtin_amdgcn_sched_group_barrier(0x100, 16, 0);
            if (more) { const LAS unsigned char* Kn = F.lds + bn;
#pragma unroll
                for (int ks = 0; ks < 6; ++ks) { ka[ks] = *(const LAS bf16x8*)(Kn + l31 * AKP + (16 * ks + 8 * half) * 2); kb2[ks] = *(const LAS bf16x8*)(Kn + (32 + l31) * AKP + (16 * ks + 8 * half) * 2); } }
            float mx = s0[0];
#pragma unroll
            for (int i = 1; i < 16; ++i) mx = fmaxf(mx, s0[i]);
#pragma unroll
            for (int i = 0; i < 16; ++i) mx = fmaxf(mx, s1[i]);
            if (kt == 0 || __any(mx > 8.0f)) {
                mx = fmaxf(mx, bpermf(lane ^ 32, mx));
                const float d = (kt == 0) ? mx : fmaxf(mx, 0.f), alpha = (kt == 0) ? 1.0f : __builtin_amdgcn_exp2f(-d);
                l_run *= alpha;
#pragma unroll
                for (int i = 0; i < 16; ++i) { o0[i] *= alpha; o1[i] *= alpha; s0[i] -= d; s1[i] -= d; cinit[i] -= d; }
                asm volatile("" : "+v"(cinit));
            }
#pragma unroll
            for (int i = 0; i < 16; ++i) { s0[i] = __builtin_amdgcn_exp2f(s0[i]); s1[i] = __builtin_amdgcn_exp2f(s1[i]); }
            float ps = 0.f;
#pragma unroll
            for (int i = 0; i < 16; ++i) ps += s0[i] + s1[i];
            l_run += ps;
            { bf16x8 pf[2][2];
#pragma unroll
              for (int t = 0; t < 2; ++t)
#pragma unroll
                  for (int s = 0; s < 2; ++s) pf[t][s] = pack8(t == 0 ? s0 : s1, s);
#pragma unroll
              for (int t = 0; t < 2; ++t)
#pragma unroll
                  for (int s = 0; s < 2; ++s) { o0 = MFMA32(va[t][s][0], pf[t][s], o0); o1 = MFMA32(va[t][s][1], pf[t][s], o1); } }
            if (more2) { LAS unsigned char* nb = F.lds + bw;
                *(LAS v4u*)(nb + kd0) = kr0; if (k1ok) *(LAS v4u*)(nb + kd1) = kr1; *(LAS v4u*)(nb + vd) = vr; }
            __syncthreads();
            { const int t_ = bc; bc = bn; bn = bw; bw = t_; }
        }
        const float linv = (DBG_SKIP & 4) ? 0.f : 1.0f / (l_run + bpermf(lane ^ 32, l_run));
        const int b = bh >> 4, hd = bh & 15;
        bf16* op = YB + ((size_t)b * TPB + tq) * RW + hd * 64 + 4 * half;
#pragma unroll
        for (int g = 0; g < 4; ++g) {
            v2u w; w.x = pk2(o0[4 * g] * linv, o0[4 * g + 1] * linv); w.y = pk2(o0[4 * g + 2] * linv, o0[4 * g + 3] * linv); *(GAS v2u*)(op + 8 * g) = w;
            w.x = pk2(o1[4 * g] * linv, o1[4 * g + 1] * linv); w.y = pk2(o1[4 * g + 2] * linv, o1[4 * g + 3] * linv); *(GAS v2u*)(op + 32 + 8 * g) = w; }
    }
}

struct RoRaw { v4u va, vc, ya[2], yc[2], ga[2], gc[2]; float b0[2], b1[2]; };
__device__ __forceinline__ void readout_load(RoRaw& r, int m, int lane, const bf16* Y, const bf16* GG, const float* BON, const bf16* RI) {
    const int hd = lane >> 2, ch0 = hd * 64 + (lane & 3) * 16, b = m / TPB, tp = m - b * TPB;
    const bf16* rec = RI + ((size_t)(b * NH + hd) * TPB + tp) * RREC + 128 + (lane & 3) * 16;
    r.va = *(const GAS v4u*)rec; r.vc = *(const GAS v4u*)(rec + 8);
#pragma unroll
    for (int d = 0; d < 2; ++d) { const bf16* yp = Y + ((size_t)d * MALL + m) * RW + ch0; const bf16* gp = GG + ((size_t)d * MALL + m) * RW + ch0;
        r.ya[d] = *(const GAS v4u*)yp; r.yc[d] = *(const GAS v4u*)(yp + 8); r.ga[d] = *(const GAS v4u*)gp; r.gc[d] = *(const GAS v4u*)(gp + 8);
        r.b0[d] = BON[((size_t)d * MALL + m) * 32 + 2 * hd]; r.b1[d] = BON[((size_t)d * MALL + m) * 32 + 2 * hd + 1]; }
}
__device__ __forceinline__ void readout_phase(Frame& F, const bf16* Y, const bf16* GG, const float* BON, const bf16* RI, const float* ln_w, const float* ln_b, bf16* YA) {
    const int gw = F.vcu * NWAVES + F.wave, NGW = F.G * NWAVES, lane = F.lane, hd = lane >> 2, ch0 = hd * 64 + (lane & 3) * 16;
    RoRaw cur, nxt;
    if (gw < MALL) readout_load(cur, gw, lane, Y, GG, BON, RI);
    for (int m = gw; m < MALL; m += NGW) {
        if (m + NGW < MALL) readout_load(nxt, m + NGW, lane, Y, GG, BON, RI);
        float vv[16], out[16];
        unpack8(cur.va, *(float(*)[8])&vv[0]); unpack8(cur.vc, *(float(*)[8])&vv[8]);
#pragma unroll
        for (int e = 0; e < 16; ++e) out[e] = 0.f;
#pragma unroll
        for (int d = 0; d < 2; ++d) {
            float y[16], g[16];
            unpack8(cur.ya[d], *(float(*)[8])&y[0]); unpack8(cur.yc[d], *(float(*)[8])&y[8]); unpack8(cur.ga[d], *(float(*)[8])&g[0]); unpack8(cur.gc[d], *(float(*)[8])&g[8]);
            float s = 0.f;
#pragma unroll
            for (int e = 0; e < 16; ++e) s += y[e];
            s = dpp_add<0xB1>(s); s = dpp_add<0x4E>(s);
            const float mean = s * (1.f / 64.f); float q = 0.f;
#pragma unroll
            for (int e = 0; e < 16; ++e) { y[e] -= mean; q += y[e] * y[e]; }
            q = dpp_add<0xB1>(q); q = dpp_add<0x4E>(q);
            const float rstd = rsqrtf(q * (1.f / 64.f) + 64e-5f), bon = cur.b0[d] + cur.b1[d];
#pragma unroll
            for (int e = 0; e < 16; ++e) out[e] += (y[e] * rstd * ln_w[ch0 + e] + ln_b[ch0 + e] + bon * vv[e]) * g[e];
        }
        if (DBG_SKIP & 2) {
#pragma unroll
            for (int e = 0; e < 16; ++e) out[e] = 0.f; }
        v4u o0, o1;
        o0.x = pk2(out[0], out[1]); o0.y = pk2(out[2], out[3]); o0.z = pk2(out[4], out[5]); o0.w = pk2(out[6], out[7]);
        o1.x = pk2(out[8], out[9]); o1.y = pk2(out[10], out[11]); o1.z = pk2(out[12], out[13]); o1.w = pk2(out[14], out[15]);
        *(GAS v4u*)(YA + (size_t)m * RW + ch0) = o0; *(GAS v4u*)(YA + (size_t)m * RW + ch0 + 8) = o1;
        cur = nxt;
    }
}


__device__ __forceinline__ unsigned f2key(float f) { const unsigned u = __builtin_bit_cast(unsigned, f); return (u & 0x80000000u) ? ~u : (u | 0x80000000u); }
__device__ __forceinline__ float key2f(unsigned k) { const unsigned u = (k & 0x80000000u) ? (k & 0x7fffffffu) : ~k; return __builtin_bit_cast(float, u); }
template <int CTRL, int RM> __device__ __forceinline__ unsigned dpp_umax(unsigned x) {
    const unsigned y = (unsigned)__builtin_amdgcn_update_dpp(0, (int)x, CTRL, RM, 0xf, false); return x > y ? x : y; }
__device__ __forceinline__ unsigned row_umax(unsigned x) { x = dpp_umax<0xB1, 0xf>(x); x = dpp_umax<0x4E, 0xf>(x); x = dpp_umax<0x141, 0xf>(x); x = dpp_umax<0x140, 0xf>(x); return x; }
#define SEL_CE(a_, b_) do { const unsigned hi_ = (a_) > (b_) ? (a_) : (b_), lo_ = (a_) > (b_) ? (b_) : (a_); (a_) = hi_; (b_) = lo_; } while (0)
__device__ __forceinline__ void sel_keys8(unsigned (&k)[8], const _Float16* p, int id0) {
    typedef _Float16 h8 __attribute__((ext_vector_type(8)));
    const h8 hv = *(const GAS h8*)p;
    const f32x4 v0 = {(float)hv[0], (float)hv[1], (float)hv[2], (float)hv[3]}, v1 = {(float)hv[4], (float)hv[5], (float)hv[6], (float)hv[7]};
    k[0] = (f2key(v0.x) & ~127u) | (unsigned)(id0 + 0); k[1] = (f2key(v0.y) & ~127u) | (unsigned)(id0 + 1); k[2] = (f2key(v0.z) & ~127u) | (unsigned)(id0 + 2); k[3] = (f2key(v0.w) & ~127u) | (unsigned)(id0 + 3);
    k[4] = (f2key(v1.x) & ~127u) | (unsigned)(id0 + 4); k[5] = (f2key(v1.y) & ~127u) | (unsigned)(id0 + 5); k[6] = (f2key(v1.z) & ~127u) | (unsigned)(id0 + 6); k[7] = (f2key(v1.w) & ~127u) | (unsigned)(id0 + 7);
    SEL_CE(k[0], k[1]); SEL_CE(k[2], k[3]); SEL_CE(k[4], k[5]); SEL_CE(k[6], k[7]); SEL_CE(k[0], k[2]); SEL_CE(k[1], k[3]); SEL_CE(k[4], k[6]); SEL_CE(k[5], k[7]); SEL_CE(k[1], k[2]); SEL_CE(k[5], k[6]);
    SEL_CE(k[0], k[4]); SEL_CE(k[1], k[5]); SEL_CE(k[2], k[6]); SEL_CE(k[3], k[7]); SEL_CE(k[2], k[4]); SEL_CE(k[3], k[5]); SEL_CE(k[1], k[2]); SEL_CE(k[3], k[4]); SEL_CE(k[5], k[6]);
}
__device__ __forceinline__ void top16_rows2(const _Float16* pa, const _Float16* pb, int l16, unsigned& ra, unsigned& rb) {
    unsigned ka[8], kb[8]; sel_keys8(ka, pa + 8 * l16, 8 * l16); sel_keys8(kb, pb + 8 * l16, 8 * l16);
    ra = 0u; rb = 0u;
#pragma unroll
    for (int it = 0; it < 16; ++it) {
        const unsigned ma = row_umax(ka[0]), mb = row_umax(kb[0]); const bool oa = ka[0] == ma, ob = kb[0] == mb;
#pragma unroll
        for (int e = 0; e < 7; ++e) { ka[e] = oa ? ka[e + 1] : ka[e]; kb[e] = ob ? kb[e + 1] : kb[e]; }
        ka[7] = oa ? 0u : ka[7]; kb[7] = ob ? 0u : kb[7];
        ra = (l16 == it) ? ma : ra; rb = (l16 == it) ? mb : rb;
    }
}
struct SelP { const float* SC; int* ESEL; float* EGATE; int last; };
__device__ __forceinline__ void select_token(const _Float16* srow, int lane, int (&eidx)[2], float (&egate)[2]) {
    const int row = lane >> 4, l16 = lane & 15, rbase = lane & 48;
    const int i1 = (int)((0x3332222211111111ull >> (4 * l16)) & 15ull), j1 = (int)((0x2104321076543210ull >> (4 * l16)) & 15ull), i2 = (int)((0xdcba987766554443ull >> (4 * l16)) & 15ull), j2 = (int)((0x0000001010102103ull >> (4 * l16)) & 15ull);
#pragma unroll
    for (int G = 0; G < 2; ++G) {
                const _Float16* hrow = srow + (4 * G + row) * 256;
                unsigned recA, recB; top16_rows2(hrow, hrow + 128, l16, recA, recB);
                const float va = key2f(recA & ~127u), vb = key2f(recB & ~127u);
                const float a0 = bpermf(rbase, va), a1 = bpermf(rbase + i1, va), b1 = bpermf(rbase + j1, vb), a2 = bpermf(rbase + i2, va), b2 = bpermf(rbase + j2, vb), a3 = bpermf(rbase + 14 + (l16 & 1), va), b0 = bpermf(rbase, vb);
                unsigned ck[4];
                ck[0] = (f2key(a0 + vb) & ~255u) | (unsigned)l16; ck[1] = (f2key(a1 + b1) & ~255u) | (unsigned)(16 * i1 + j1); ck[2] = (f2key(a2 + b2) & ~255u) | (unsigned)(16 * i2 + j2);
                ck[3] = (l16 < 2) ? ((f2key(a3 + b0) & ~255u) | (unsigned)(16 * (14 + l16))) : 0u;
                SEL_CE(ck[0], ck[1]); SEL_CE(ck[2], ck[3]); SEL_CE(ck[0], ck[2]); SEL_CE(ck[1], ck[3]); SEL_CE(ck[1], ck[2]);
                unsigned rec = 0u;
#pragma unroll
                for (int it = 0; it < 16; ++it) {
                    const unsigned mh = row_umax(ck[0]); const bool own = ck[0] == mh;
                    ck[0] = own ? ck[1] : ck[0]; ck[1] = own ? ck[2] : ck[1]; ck[2] = own ? ck[3] : ck[2]; ck[3] = own ? 0u : ck[3];
                    rec = (l16 == it) ? mh : rec;
                }
                const float ts = key2f(rec & ~255u), tmax = bpermf(rbase, ts);
                const float ev = __expf(ts - tmax), esum = red16(ev);
                const int ci = (int)((rec >> 4) & 15u), cj = (int)(rec & 15u);
                const int expert = bpermi(rbase + ci, (int)(recA & 127u)) * 128 + bpermi(rbase + cj, (int)(recB & 127u));
                eidx[G] = expert; egate[G] = ev / esum;
    }
}
struct PeerP { const _Float16* SC; const float* nmod; const float* ng; bf16* Hout;   const int* ESEL; const float* EGATE; const bf16* H; const unsigned char* PU; const unsigned char* PV; const float* SU; const float* SV; bf16* X; const float* mod;   const float* fin_g; float* out; int last; int dry; };
__device__ __forceinline__ void peer_phase(Frame& F, const PeerP& P) {
    const int gw = F.vcu * NWAVES + F.wave, NGW = F.G * NWAVES, lane = F.lane;
    float pr_s2 = 0.f, pr_d2 = 0.f, pr_tg = 0.f, pr_n = 0.f;
    int m0 = gw; while (m0 < MALL && P.last && (m0 % TPB) < CTXL) m0 += NGW;
    v4u ph0 = {0u, 0u, 0u, 0u}, ph1 = ph0, ph2 = ph0, ph3 = ph0;
    if (m0 < MALL) { const bf16* hp = P.H + (size_t)m0 * DM + lane * 32; ph0 = *(const GAS v4u*)hp; ph1 = *(const GAS v4u*)(hp + 8); ph2 = *(const GAS v4u*)(hp + 16); ph3 = *(const GAS v4u*)(hp + 24); }
    for (int m = m0, mn = 0; m < MALL; m = mn) {
        mn = m + NGW; while (mn < MALL && P.last && (mn % TPB) < CTXL) mn += NGW;
        const int b = m / TPB, tp = m - b * TPB;
        const int mr = tp < CTXL ? 2 : b;
        const int emask_ = (P.dry & 2) ? 1023 : 0x7fffffff;
        int eidx[2]; float egate[2]; select_token(P.SC + (size_t)m * DM, lane, eidx, egate);
        eidx[0] &= emask_; eidx[1] &= emask_;
        typedef int v8i __attribute__((ext_vector_type(8)));
        LAS unsigned char* hq = F.lds + F.wave * 4096;
        { const v4u hv[4] = {ph0, ph1, ph2, ph3}; v4u o[2];
#pragma unroll
          for (int j = 0; j < 4; ++j) { int w0 = 0, w1 = 0;
              w0 = __builtin_amdgcn_cvt_pk_fp8_f32(bflo(hv[j].x), bfhi(hv[j].x), w0, false); w0 = __builtin_amdgcn_cvt_pk_fp8_f32(bflo(hv[j].y), bfhi(hv[j].y), w0, true);
              w1 = __builtin_amdgcn_cvt_pk_fp8_f32(bflo(hv[j].z), bfhi(hv[j].z), w1, false); w1 = __builtin_amdgcn_cvt_pk_fp8_f32(bflo(hv[j].w), bfhi(hv[j].w), w1, true);
              o[j >> 1][2 * (j & 1)] = (unsigned)w0; o[j >> 1][2 * (j & 1) + 1] = (unsigned)w1; }
          *(LAS v4u*)(hq + lane * 32) = o[0]; *(LAS v4u*)(hq + lane * 32 + 16) = o[1];
          unsigned z_ = 0u; asm volatile("" : "+v"(z_));
          if (lane < 2) *(LAS v4u*)(hq + 2048 + lane * 16) = (v4u){z_, z_, z_, z_}; }
        const int li = lane & 15, kb = lane >> 4;
        int rowoff[8];
#pragma unroll
        for (int g = 0; g < 8; ++g) rowoff[g] = bpermi(16 * (g & 3) + li, eidx[g >> 2]) * (DM / 2) + 16 * kb;
        f32x4 dacc[8];
#pragma unroll
        for (int g = 0; g < 8; ++g) dacc[g] = (f32x4){0.f, 0.f, 0.f, 0.f};
        const unsigned hb = (li == 0) ? (unsigned)(16 * kb) : 2048u;
        const unsigned hb2 = (li == 0) ? 64u : 16u;
        const unsigned hstep = (li == 0) ? 128u : 0u;
        v4u ua[8], ub[8];
#pragma unroll
        for (int g = 0; g < 8; ++g) ua[g] = *(const GAS v4u*)(P.PU + (unsigned)rowoff[g]);
#pragma unroll 1
        for (int s = 0; s < ((P.dry & 4) ? 2 : 16); s += 2) {
#pragma unroll
            for (int g = 0; g < 8; ++g) ub[g] = *(const GAS v4u*)(P.PU + (unsigned)(rowoff[g] + 64 * (s + 1)));
            { const v4u b0 = *(const LAS v4u*)(hq + hb + hstep * s), b1 = *(const LAS v4u*)(hq + hb + hstep * s + hb2);
              const v8i bf = {(int)b0.x, (int)b0.y, (int)b0.z, (int)b0.w, (int)b1.x, (int)b1.y, (int)b1.z, (int)b1.w};
#pragma unroll
              for (int g = 0; g < 8; ++g) { const v8i af = {(int)ua[g].x, (int)ua[g].y, (int)ua[g].z, (int)ua[g].w, 0, 0, 0, 0};
                  dacc[g] = __builtin_amdgcn_mfma_scale_f32_16x16x128_f8f6f4(af, bf, dacc[g], 4, 0, 0, 0x7f7f7f7f, 0, 0x7f7f7f7f); } }
            if (s + 2 < 16) {
#pragma unroll
                for (int g = 0; g < 8; ++g) ua[g] = *(const GAS v4u*)(P.PU + (unsigned)(rowoff[g] + 64 * (s + 2))); }
            { const v4u b0 = *(const LAS v4u*)(hq + hb + hstep * (s + 1)), b1 = *(const LAS v4u*)(hq + hb + hstep * (s + 1) + hb2);
              const v8i bf = {(int)b0.x, (int)b0.y, (int)b0.z, (int)b0.w, (int)b1.x, (int)b1.y, (int)b1.z, (int)b1.w};
#pragma unroll
              for (int g = 0; g < 8; ++g) { const v8i af = {(int)ub[g].x, (int)ub[g].y, (int)ub[g].z, (int)ub[g].w, 0, 0, 0, 0};
                  dacc[g] = __builtin_amdgcn_mfma_scale_f32_16x16x128_f8f6f4(af, bf, dacc[g], 4, 0, 0, 0x7f7f7f7f, 0, 0x7f7f7f7f); } }
        }
        float coef[2];
#pragma unroll
        for (int sl = 0; sl < 2; ++sl) { float mydot = 0.f;
#pragma unroll
            for (int g4 = 0; g4 < 4; ++g4)
#pragma unroll
                for (int r = 0; r < 4; ++r) { const float t = bpermf(16 * ((lane >> 2) & 3), dacc[4 * sl + g4][r]); if ((lane >> 4) == g4 && (lane & 3) == r) mydot = t; }
            mydot *= P.SU[eidx[sl]];
            if (DBG_PROBE == 4) {
                float ref = 0.f;
                for (int e = 0; e < 64; ++e) { const int ex = __builtin_amdgcn_readlane(eidx[sl], e); const v4u uu = *(const GAS v4u*)(P.PU + (size_t)ex * (DM / 2) + lane * 16); float s1 = 0.f;
                    const v4u hv2[4] = {*(const GAS v4u*)(P.H + (size_t)m * DM + lane * 32), *(const GAS v4u*)(P.H + (size_t)m * DM + lane * 32 + 8), *(const GAS v4u*)(P.H + (size_t)m * DM + lane * 32 + 16), *(const GAS v4u*)(P.H + (size_t)m * DM + lane * 32 + 24)};
#pragma unroll
                    for (int d = 0; d < 4; ++d) { const unsigned w = uu[d]; const unsigned hw[4] = {hv2[d].x, hv2[d].y, hv2[d].z, hv2[d].w};
                        f32x2 x = __builtin_amdgcn_cvt_scalef32_pk_f32_fp4(w, 1.0f, 0); s1 += x.x * bflo(hw[0]) + x.y * bfhi(hw[0]); x = __builtin_amdgcn_cvt_scalef32_pk_f32_fp4(w, 1.0f, 1); s1 += x.x * bflo(hw[1]) + x.y * bfhi(hw[1]);
                        x = __builtin_amdgcn_cvt_scalef32_pk_f32_fp4(w, 1.0f, 2); s1 += x.x * bflo(hw[2]) + x.y * bfhi(hw[2]); x = __builtin_amdgcn_cvt_scalef32_pk_f32_fp4(w, 1.0f, 3); s1 += x.x * bflo(hw[3]) + x.y * bfhi(hw[3]); }
                    const float tot = wave_sum_u(s1) * P.SU[ex]; if (lane == e) ref = tot; }
                pr_s2 = fmaxf(pr_s2, wave_max_u(fabsf(mydot - ref) / (fabsf(ref) + 0.25f))); pr_n = 1.f; }
            coef[sl] = egate[sl] * 0.5f * mydot * (1.0f + erff(mydot * 0.70710678f));
            if ((DBG_SKIP & 16) && sl == 0) coef[sl] = 0.f;
            if ((DBG_SKIP & 32) && sl == 1) coef[sl] = 0.f;
        }
        const float coefs[2] = {coef[0] * P.SV[eidx[0]], coef[1] * P.SV[eidx[1]]};
        f32x2 acc2[16];
#pragma unroll
        for (int i = 0; i < 16; ++i) acc2[i] = (f32x2){0.f, 0.f};
#define PEER_LOADV(U, C, e0_) do { const int e1_ = (e0_); const int ev_ = (e1_ & 64) ? eidx[1] : eidx[0]; const int cv_ = __builtin_bit_cast(int, (e1_ & 64) ? coefs[1] : coefs[0]); \
            _Pragma("unroll") for (int q = 0; q < 8; ++q) { const int ex = __builtin_amdgcn_readlane(ev_, (e1_ & 63) + q); U[q] = *(const GAS v4u*)(P.PV + (size_t)ex * (DM / 2) + lane * 16); \
            C[q] = __builtin_bit_cast(float, __builtin_amdgcn_readlane(cv_, (e1_ & 63) + q)); } } while (0)
#define PEER_AXPY(U, C) do { if (P.dry & 32) { _Pragma("unroll") for (int q = 0; q < 8; ++q) _Pragma("unroll") for (int d = 0; d < 4; ++d) acc2[d].x += __builtin_bit_cast(float, U[q][d] & 0x3fffffffu) * C[q]; } else \
            _Pragma("unroll") for (int q = 0; q < 8; ++q) _Pragma("unroll") for (int d = 0; d < 4; ++d) { const unsigned w = U[q][d]; \
            acc2[4 * d + 0] = __builtin_amdgcn_cvt_scalef32_pk_f32_fp4(w, 1.0f, 0) * C[q] + acc2[4 * d + 0]; acc2[4 * d + 1] = __builtin_amdgcn_cvt_scalef32_pk_f32_fp4(w, 1.0f, 1) * C[q] + acc2[4 * d + 1]; \
            acc2[4 * d + 2] = __builtin_amdgcn_cvt_scalef32_pk_f32_fp4(w, 1.0f, 2) * C[q] + acc2[4 * d + 2]; acc2[4 * d + 3] = __builtin_amdgcn_cvt_scalef32_pk_f32_fp4(w, 1.0f, 3) * C[q] + acc2[4 * d + 3]; } } while (0)
        if (mn < MALL) {
            const bf16* hp = P.H + (size_t)mn * DM + lane * 32; ph0 = *(const GAS v4u*)hp; ph1 = *(const GAS v4u*)(hp + 8); ph2 = *(const GAS v4u*)(hp + 16); ph3 = *(const GAS v4u*)(hp + 24); }
        v4u xpre[4];
        { const bf16* xr0 = P.X + (size_t)m * DM + lane * 32;
#pragma unroll
          for (int hq = 0; hq < 4; ++hq) xpre[hq] = *(const GAS v4u*)(xr0 + hq * 8); }
        {
            v4u ua[8], ub[8]; float ca[8], cb[8];
            PEER_LOADV(ua, ca, 0);
#pragma unroll 1
            for (int it = 0; it < ((P.dry & 8) ? 2 : 8); ++it) {
                PEER_LOADV(ub, cb, 16 * it + 8); PEER_AXPY(ua, ca);
                if (it < 7) PEER_LOADV(ua, ca, 16 * it + 16);
                PEER_AXPY(ub, cb);
            }
        }
#undef PEER_LOADV
#undef PEER_AXPY
        float acc[32];
#pragma unroll
        for (int i = 0; i < 16; ++i) { acc[2 * i] = acc2[i].x; acc[2 * i + 1] = acc2[i].y; }
        if (P.dry) { float sm_ = 0.f;
#pragma unroll
            for (int i = 0; i < 32; ++i) sm_ += acc[i];
            if (sm_ == 1.2345e-30f) P.X[lane] = sm_;
            if (!(P.dry & 16)) continue; }
        if (DBG_SKIP & 1) {
#pragma unroll
            for (int i = 0; i < 32; ++i) acc[i] = 0.f; }
        if (((DBG_SKIP & 64) && !P.last) || ((DBG_SKIP & 128) && P.last)) {
#pragma unroll
            for (int i = 0; i < 32; ++i) acc[i] = 0.f; }
        if (DBG_SKIP & 8) {
#pragma unroll
            for (int i = 0; i < 32; ++i) acc[i] = -acc[i]; }
        int m_l = m, lane_l = lane; asm volatile("" : "+v"(m_l), "+v"(lane_l));
        const int b_l = m_l / TPB, tp_l = m_l - b_l * TPB, mr_l = tp_l < CTXL ? 2 : b_l;
        bf16* xr = (P.dry ? (bf16*)(F.ws + 760 * MiB) : P.X) + (size_t)m_l * DM + lane_l * 32; const float* g2 = P.mod + (size_t)mr_l * 12288 + 5 * DM + lane_l * 32;
        float ss = 0.f;
#pragma unroll
        for (int hq = 0; hq < 4; ++hq) { const int c = hq * 8; float xf[8]; unpack8(xpre[hq], xf);
            const f32x4 g0 = *(const GAS f32x4*)(g2 + c), g1 = *(const GAS f32x4*)(g2 + c + 4);
#pragma unroll
            for (int e = 0; e < 8; ++e) { const float xv = xf[e] + (e < 4 ? g0[e & 3] : g1[e & 3]) * acc[8 * hq + e]; ss += xv * xv; acc[8 * hq + e] = xv; xf[e] = xv; }
            if (!P.last) *(GAS v4u*)(xr + c) = pack8f(xf); }
        if (!P.last) {
            const float rs = rsqrtf(wave_sum(ss) * (1.f / DM) + NORM_EPS); const float* sh = P.nmod + (size_t)mr_l * 12288 + lane_l * 32; const float* sc = sh + DM; const float* ngp = P.ng + lane_l * 32;
            bf16* ho = (P.dry ? (bf16*)(F.ws + 892 * MiB) : P.Hout) + (size_t)m_l * DM + lane_l * 32;
#pragma unroll
            for (int hq = 0; hq < 4; ++hq) { const int c = hq * 8; float y[8];
                const f32x4 n0 = *(const GAS f32x4*)(ngp + c), n1 = *(const GAS f32x4*)(ngp + c + 4), s0 = *(const GAS f32x4*)(sc + c), s1 = *(const GAS f32x4*)(sc + c + 4), h0 = *(const GAS f32x4*)(sh + c), h1 = *(const GAS f32x4*)(sh + c + 4);
#pragma unroll
                for (int e = 0; e < 4; ++e) { y[e] = acc[8 * hq + e] * rs * n0[e] * (1.0f + s0[e]) + h0[e]; y[4 + e] = acc[8 * hq + 4 + e] * rs * n1[e] * (1.0f + s1[e]) + h1[e]; }
                *(GAS v4u*)(ho + c) = pack8f(y); } }
        if (P.last) { const float rs = rsqrtf(wave_sum(ss) * (1.f / DM) + NORM_EPS); float* orow = P.out + ((size_t)b_l * SEQ + (tp_l - CTXL)) * DM + lane_l * 32; const float* fgp = P.fin_g + lane_l * 32;
#pragma unroll
            for (int hq = 0; hq < 8; ++hq) { const int c = hq * 4; const f32x4 fg = *(const GAS f32x4*)(fgp + c);
                f32x4 o;
#pragma unroll
                for (int e = 0; e < 4; ++e) o[e] = acc[4 * hq + e] * rs * fg[e];
                *(GAS f32x4*)(orow + c) = o; } }
    }
    if (DBG_PROBE && DBG_PROBE != 5 && !P.last && lane == 0) { float* pp = (float*)(F.ws + WS_CTL + CTL_PROBE_OFF) + gw * 4; pp[0] = pr_s2; pp[1] = pr_d2; pp[2] = pr_tg; pp[3] = pr_n; }
}


constexpr int PH_PER_LAYER = 12, NPHASE = 1 + NLAYER * PH_PER_LAYER;
#ifndef ONLY_PHASE
#define ONLY_PHASE -1
#endif
#define T0() (wave_s == 0 && pg8::opaque_lane() == 0)
#define PH_ON(k) (ONLY_PHASE < 0 || ONLY_PHASE == (k))
#define GEMM_CALL(EPI, SCHED, g, S, E) pg8::gemm_phase<EPI, SCHED, true, true>(F.lds, g, S, E, wave_s)
#define GEMM_CALL_NA(EPI, SCHED, g, S, E) pg8::gemm_phase<EPI, SCHED, false, true>(F.lds, g, S, E, wave_s)

__device__ __forceinline__ const float* karg(int i) {
    asm volatile("" : "+s"(i));
    const __attribute__((address_space(4))) unsigned long long* ka = (const __attribute__((address_space(4))) unsigned long long*)__builtin_amdgcn_kernarg_segment_ptr();
    return (const float*)ka[i];
}
__global__ void __launch_bounds__(NWAVES * 64, 2) mk_fwd(Args args) {
    extern __shared__ __attribute__((aligned(16))) unsigned char lds[];
    Frame F;
    F.lds = (LAS unsigned char*)lds; F.ws = args.ws;
    const int wave_s = __builtin_amdgcn_readfirstlane((int)threadIdx.x >> 6);
    F.tid = threadIdx.x; F.lane = F.tid & 63; F.wave = wave_s;
    F.G = gridDim.x; { const int bx = blockIdx.x; F.vcu = (F.G % 8 == 0) ? (bx % 8) * (F.G / 8) + bx / 8 : bx; }
    unsigned char* ws = args.ws;
    volatile LAS unsigned* MISC = (volatile LAS unsigned*)(F.lds + MISC_OFF);
    for (int u = F.tid; u < (LDS_BYTES - LDSCTL_OFF) / 4; u += NWAVES * 64) ((LAS unsigned*)(F.lds + LDSCTL_OFF))[u] = 0u;
    __syncthreads();
    const int lo = args.ph_lo, hi = args.ph_hi;
    XcdBarrier bar; bar.bar = (unsigned*)(ws + WS_CTL) + CW_BAR; bar.x = 0; bar.st = nullptr;
    if (hi - lo > 1) bar = xcd_barrier_post((unsigned*)(ws + WS_CTL) + CW_BAR, MISC + 8, T0());
#define IN(k) (lo <= (k) && (k) < hi)
#define REFRAME() do { const int lz_ = pg8::opaque_lane(); F.lane = lz_; F.tid = wave_s * 64 + lz_; F.wave = wave_s; ws = (unsigned char*)karg(34); F.ws = ws; { int g_ = (int)gridDim.x, b_ = (int)blockIdx.x; asm volatile("" : "+s"(g_), "+s"(b_)); bx = b_; F.G = g_; F.vcu = ((g_ & 7) == 0) ? (b_ & 7) * (g_ >> 3) + (b_ >> 3) : b_; } } while (0)
#define SEAM(k) do { if (IN((k) + 1)) xcd_barrier(bar, T0()); } while (0)
#define XBUF ((bf16*)(ws + WS_X))
#define HBUF ((bf16*)(ws + WS_H))
#define MODP ((const float*)(ws + WS_CTL + CTL_MOD_OFF) + (size_t)l * 3 * 12288)
    int bx = (int)blockIdx.x;

    for (int rep_ = 0; rep_ < ((DBG_REPEAT == 100) ? 2 : 1); ++rep_) if (PH_ON(100) && IN(0)) { REFRAME(); if (rep_) xcd_barrier(bar, T0()); p0_prologue(F, 0, (MK_N_LAUNCHES == 1) ? 1 : NLAYER, F.vcu, F.G); SEAM(0); if (DBG_REPEAT == 200) { for (int i_ = 0; i_ < 32; ++i_) xcd_barrier(bar, T0()); } }

    for (int l = 0; l < NLAYER; ++l) {
        const int base = 1 + l * PH_PER_LAYER;
        const int last = (l == NLAYER - 1);
        for (int rep_ = 0; rep_ < ((DBG_REPEAT == 0) ? 2 : 1); ++rep_) if (PH_ON(0) && IN(base + 0) && l == 0) { REFRAME(); if (rep_) xcd_barrier(bar, T0()); modnorm_phase(F, nullptr, karg(6) + (size_t)l * DM, MODP, 0, HBUF, 0, karg(0), karg(2)); SEAM(base + 0); }
        for (int rep_ = 0; rep_ < ((DBG_REPEAT == 1) ? 2 : 1); ++rep_) if (PH_ON(1) && IN(base + 1)) { REFRAME(); if (rep_) xcd_barrier(bar, T0());
            pg8::Gemm g{HBUF, (const bf16*)(ws + WS_WINA) + (size_t)l * INA_P * DM, MALL, INA_P, DM}; pg8::RowOrder S; S.init_rows(0, INA_P, F.G, bx);
            pg8::EpiStoreBf16 E{(bf16*)(ws + WS_PA), INA_P};
            GEMM_CALL(pg8::EpiStoreBf16, pg8::RowOrder, g, S, E);
            SEAM(base + 1); }
        for (int rep_ = 0; rep_ < ((DBG_REPEAT == 2) ? 2 : 1); ++rep_) if (PH_ON(2) && IN(base + 2)) { REFRAME(); if (rep_) xcd_barrier(bar, T0());
            FeatP P;
            P.PA = (const bf16*)(ws + WS_PA); P.mu = karg(9) + (size_t)l * RWC; P.w0 = karg(10) + (size_t)l * 2 * RW; P.a0 = karg(12) + (size_t)l * 2 * RW;
            P.k_k = karg(15) + (size_t)l * RW; P.k_a = karg(16) + (size_t)l * RW; P.r_k = karg(17) + (size_t)l * RW;
            P.WUP = (const bf16*)(ws + WS_WUP) + (size_t)l * 2 * RW * 64; P.AUP = (const bf16*)(ws + WS_AUP) + (size_t)l * 2 * RW * 64; P.GUP = (const bf16*)(ws + WS_GUP) + (size_t)l * 2 * RW * 32;
            P.qnorm = karg(20) + (size_t)l * 512; P.kvnorm = karg(22) + (size_t)l * 256; P.rope = (const f32x2*)(ws + WS_ROPE);
            P.RI = (bf16*)(ws + WS_RI); P.GG = (bf16*)(ws + WS_GG); P.BON = (float*)(ws + WS_BON); P.QN = (bf16*)(ws + WS_QN); P.KVN = (bf16*)(ws + WS_KVN); P.K = (bf16*)(ws + WS_K);
            features_phase(F, P);
            SEAM(base + 2); }
        for (int rep_ = 0; rep_ < ((DBG_REPEAT == 3) ? 2 : 1); ++rep_) if (PH_ON(3) && IN(base + 3)) { REFRAME(); if (rep_) xcd_barrier(bar, T0());
            { pg8::Gemm g{(const bf16*)(ws + WS_QN), (const bf16*)(ws + WS_WUQ) + (size_t)l * NQ * 512, MALL, NQ, 512};
              pg8::EpiQ E{(bf16*)(ws + WS_Q), (const f32x2*)(ws + WS_ROPE), 0.14724444f};
              pg8::RowOrder S; S.init_rows(last, NQ, F.G, bx); GEMM_CALL_NA(pg8::EpiQ, pg8::RowOrder, g, S, E); }
            { pg8::Gemm g{(const bf16*)(ws + WS_KVN), (const bf16*)(ws + WS_WUKV) + (size_t)l * NKV * 256, MALL, NKV, 256}; pg8::RowOrder S; S.init_rows(0, NKV, F.G, bx);
              pg8::EpiKV E{(bf16*)(ws + WS_K), (bf16*)(ws + WS_V)};
              GEMM_CALL_NA(pg8::EpiKV, pg8::RowOrder, g, S, E); }
            SEAM(base + 3); }
        for (int rep_ = 0; rep_ < ((DBG_REPEAT == 4) ? 2 : 1); ++rep_) if (PH_ON(4) && IN(base + 4)) { REFRAME(); if (rep_) xcd_barrier(bar, T0());
            ScanCvt C; C.pu = karg(30) + (size_t)l * NEXP * DM; C.pv = karg(31) + (size_t)l * NEXP * DM; C.PU8 = ws + WS_P4; C.PV8 = ws + WS_P4 + (size_t)NEXP * (DM / 2); C.SU = (float*)(ws + WS_P4S); C.SV = (float*)(ws + WS_P4S) + NEXP; C.wl = (MK_N_LAUNCHES == 1 && l + 1 < NLAYER && F.G == 256) ? l + 1 : -1;
            scan_phase(F, (const bf16*)(ws + WS_RI), (bf16*)(ws + WS_Y), C); SEAM(base + 4); }
        for (int rep_ = 0; rep_ < ((DBG_REPEAT == 5) ? 2 : 1); ++rep_) if (PH_ON(5) && IN(base + 5)) { REFRAME(); if (rep_) xcd_barrier(bar, T0());
            attn_phase(F, (const bf16*)(ws + WS_Q), (const bf16*)(ws + WS_K), (const bf16*)(ws + WS_V), (bf16*)(ws + WS_YB), !last);
            readout_phase(F, (const bf16*)(ws + WS_Y), (const bf16*)(ws + WS_GG), (const float*)(ws + WS_BON), (const bf16*)(ws + WS_RI), karg(18) + (size_t)l * RW, karg(19) + (size_t)l * RW, (bf16*)(ws + WS_YA));
            SEAM(base + 5); }
        for (int rep_ = 0; rep_ < ((DBG_REPEAT == 6) ? 2 : 1); ++rep_) if (PH_ON(6) && IN(base + 6)) { REFRAME(); if (rep_) xcd_barrier(bar, T0());
            bf16* T1 = (bf16*)(ws + WS_T1); bf16* T2 = (bf16*)(ws + WS_T2);
            const pg8::Gemm g1{HBUF, (const bf16*)(ws + WS_WGA) + (size_t)l * DM * DM, MALL, DM, DM}, g2{(const bf16*)(ws + WS_YA), (const bf16*)(ws + WS_WA) + (size_t)l * DM * RW, MALL, DM, RW};
            const pg8::Gemm g3{HBUF, (const bf16*)(ws + WS_WGB) + (size_t)l * DM * DM, MALL, DM, DM}, g4{(const bf16*)(ws + WS_YB), (const bf16*)(ws + WS_WB) + (size_t)l * DM * RW, MALL, DM, RW};
            const pg8::EpiGate E1{T1, DM, karg(8) + (size_t)l * 2 * DM}, E3{T2, DM, karg(8) + (size_t)l * 2 * DM + DM};
            const pg8::EpiMulAdd E2{T1, T1, nullptr, DM}, E4{T1, T2, T1, DM};
            const bool split = CTX_SPLIT && !last && F.G >= 128;
            pg8::RowOrder S; S.init_rows(last || split, DM, F.G, bx);
            GEMM_CALL(pg8::EpiGate, pg8::RowOrder, g1, S, E1); GEMM_CALL(pg8::EpiMulAdd, pg8::RowOrder, g2, S, E2); GEMM_CALL(pg8::EpiGate, pg8::RowOrder, g3, S, E3); GEMM_CALL(pg8::EpiMulAdd, pg8::RowOrder, g4, S, E4);
            if (split) {
                pg8::CtxOrder Sg, Sp; Sg.u0 = (bx < 32) ? (bx & 15) : -1; Sp.u0 = (bx >= 32 && bx < 64) ? (bx & 15) : -1;
                const bool second = (bx & 16) != 0;
                const pg8::Gemm gg = second ? g3 : g1, gp = second ? g4 : g2;
                const pg8::EpiGate EG = second ? E3 : E1;
                const pg8::EpiCtxF32 EP{(float*)(ws + (second ? WS_CB : WS_CA)), DM};
                GEMM_CALL(pg8::EpiGate, pg8::CtxOrder, gg, Sg, EG); GEMM_CALL(pg8::EpiCtxF32, pg8::CtxOrder, gp, Sp, EP); }
            if (MK_N_LAUNCHES == 1 && l == 0 && rep_ == 0) { __syncthreads();
                const int late = split ? 64 : (F.G > 32) ? 16 : 0; p0_prologue(F, 1, NLAYER, (bx >= late) ? bx - late : -1, F.G - late, (F.G == 256) ? 0 : 1); }
            SEAM(base + 6); }
        for (int rep_ = 0; rep_ < ((DBG_REPEAT == 7) ? 2 : 1); ++rep_) if (PH_ON(7) && IN(base + 7)) { REFRAME(); if (rep_) xcd_barrier(bar, T0());
            if (CTX_SPLIT && !last && F.G >= 128 && rep_ == 0) {
                bf16* T1 = (bf16*)(ws + WS_T1); const bf16* T2 = (const bf16*)(ws + WS_T2); const float* CA = (const float*)(ws + WS_CA); const float* CB = (const float*)(ws + WS_CB);
                for (int e = bx * (NWAVES * 64) + F.tid; e < 512 * (DM / 8); e += F.G * (NWAVES * 64)) { const int r = e >> 8, c0 = (e & 255) * 8; const size_t go = (size_t)((r < 256) ? r : 33 * 256 + (r - 256)) * DM + c0;
                    const v4u ga = *(const GAS v4u*)(T1 + go), gb = *(const GAS v4u*)(T2 + go);
                    const f32x4 a0 = *(const GAS f32x4*)(CA + (size_t)r * DM + c0), a1 = *(const GAS f32x4*)(CA + (size_t)r * DM + c0 + 4), b0 = *(const GAS f32x4*)(CB + (size_t)r * DM + c0), b1 = *(const GAS f32x4*)(CB + (size_t)r * DM + c0 + 4);
                    v4u o;
                    o.x = pk2(bflo(ga.x) * a0[0] + bflo(gb.x) * b0[0], bfhi(ga.x) * a0[1] + bfhi(gb.x) * b0[1]); o.y = pk2(bflo(ga.y) * a0[2] + bflo(gb.y) * b0[2], bfhi(ga.y) * a0[3] + bfhi(gb.y) * b0[3]);
                    o.z = pk2(bflo(ga.z) * a1[0] + bflo(gb.z) * b1[0], bfhi(ga.z) * a1[1] + bfhi(gb.z) * b1[1]); o.w = pk2(bflo(ga.w) * a1[2] + bflo(gb.w) * b1[2], bfhi(ga.w) * a1[3] + bfhi(gb.w) * b1[3]);
                    *(GAS v4u*)(T1 + go) = o; }
                xcd_barrier(bar, T0()); }
            const pg8::Gemm g{(const bf16*)(ws + WS_T1), (const bf16*)(ws + WS_WO) + (size_t)l * DM * DM, MALL, DM, DM};
            const pg8::EpiResid E{XBUF, MODP + 2 * DM, l == 0 ? karg(0) : nullptr, l == 0 ? karg(2) : nullptr};
            pg8::RowOrder S; S.init_rows(last, DM, F.G, bx); GEMM_CALL(pg8::EpiResid, pg8::RowOrder, g, S, E);
            SEAM(base + 7); }
        for (int rep_ = 0; rep_ < ((DBG_REPEAT == 8) ? 2 : 1); ++rep_) if (PH_ON(8) && IN(base + 8)) { REFRAME(); if (rep_) xcd_barrier(bar, T0());
            modnorm_phase_bf(F, XBUF, karg(27) + (size_t)l * DM, MODP, 3, HBUF, last);
            SEAM(base + 8); }
        for (int rep_ = 0; rep_ < ((DBG_REPEAT == 9) ? 2 : 1); ++rep_) if (PH_ON(9) && IN(base + 9)) { REFRAME(); if (rep_) xcd_barrier(bar, T0());
            const pg8::Gemm g{HBUF, (const bf16*)(ws + WS_WQK) + (size_t)l * DM * DM, MALL, DM, DM};
            const pg8::EpiF16 E{(_Float16*)(ws + WS_SC), DM};
            pg8::RowOrder S; S.init_rows(last, DM, F.G, bx); GEMM_CALL(pg8::EpiF16, pg8::RowOrder, g, S, E);
            SEAM(base + 9); }
        for (int rep_ = 0; rep_ < ((DBG_REPEAT == 11) ? 2 : 1); ++rep_) if (PH_ON(11) && IN(base + 11)) { REFRAME(); if (rep_) xcd_barrier(bar, T0());
            PeerP P; P.SC = (const _Float16*)(ws + WS_SC); P.nmod = MODP + 3 * 12288; P.ng = karg(6) + (size_t)(l + 1) * DM; P.Hout = HBUF; P.ESEL = (const int*)(ws + WS_T1); P.EGATE = (const float*)(ws + WS_T1 + 16 * MiB); P.H = HBUF; P.PU = ws + WS_P4; P.PV = ws + WS_P4 + (size_t)NEXP * (DM / 2); P.SU = (const float*)(ws + WS_P4S); P.SV = (const float*)(ws + WS_P4S) + NEXP; P.X = XBUF; P.mod = MODP; P.fin_g = karg(32); P.out = (float*)karg(33); P.last = last; P.dry = (DBG_REPEAT == 11 && rep_ == 0) ? DBG_DRY : 0;
            peer_phase(F, P);
            SEAM(base + 11); }
    }
#undef IN
#undef SEAM
#undef XBUF
#undef HBUF
#undef MODP
}

__device__ __forceinline__ float mx_a_val(int i, int k) { const int c = (i * 131 + k * 17 + (k >> 3) * 5) & 15; const float mag[8] = {0.f, .5f, 1.f, 1.5f, 2.f, 3.f, 4.f, 6.f}; return (c & 8) ? -mag[c & 7] : mag[c & 7]; }
__device__ __forceinline__ int mx_a_code(int i, int k) { return (i * 131 + k * 17 + (k >> 3) * 5) & 15; }
__device__ __forceinline__ float mx_b_val(int k, int j) { return (float)(((k * 7 + j * 13 + (k >> 4)) % 9) - 4); }
__device__ __forceinline__ int mx_kmap(int hyp, int kb, int e) { const int h = hyp % 3; return h == 0 ? 32 * kb + e : h == 1 ? 32 * (e >> 3) + 8 * kb + (e & 7) : 64 * (e >> 4) + 16 * kb + (e & 15); }
__global__ void __launch_bounds__(512) dbg_fill(const float* pp, float* o) {
    __shared__ float vsh;
    float v = 0.f;
    if (DBG_PROBE == 5) {
        if (threadIdx.x < 64) { typedef int v8i __attribute__((ext_vector_type(8))); typedef float f4 __attribute__((ext_vector_type(4)));
            const int lane = threadIdx.x, i = lane & 15, kb = lane >> 4; float code = 0.f;
            for (int hyp = 0; hyp < 18; ++hyp) { const int nibswap = hyp / 9, ha = hyp % 3, hb2 = (hyp / 3) % 3;
                unsigned aw[4] = {0u, 0u, 0u, 0u}; int bw[8] = {0, 0, 0, 0, 0, 0, 0, 0};
                for (int e = 0; e < 32; ++e) { const int k = mx_kmap(ha, kb, e); const unsigned c = (unsigned)mx_a_code(i, k); const int pos = nibswap ? (e ^ 1) : e; aw[pos >> 3] |= c << (4 * (pos & 7)); }
                for (int q = 0; q < 8; ++q) { int w = 0; const float f0 = mx_b_val(mx_kmap(hb2, kb, 4 * q + 0), i), f1 = mx_b_val(mx_kmap(hb2, kb, 4 * q + 1), i), f2 = mx_b_val(mx_kmap(hb2, kb, 4 * q + 2), i), f3 = mx_b_val(mx_kmap(hb2, kb, 4 * q + 3), i);
                    w = __builtin_amdgcn_cvt_pk_fp8_f32(f0, f1, w, false); w = __builtin_amdgcn_cvt_pk_fp8_f32(f2, f3, w, true); bw[q] = w; }
                const v8i af = {(int)aw[0], (int)aw[1], (int)aw[2], (int)aw[3], 0, 0, 0, 0}, bf = {bw[0], bw[1], bw[2], bw[3], bw[4], bw[5], bw[6], bw[7]};
                f4 d = {0.f, 0.f, 0.f, 0.f};
                d = __builtin_amdgcn_mfma_scale_f32_16x16x128_f8f6f4(af, bf, d, 4, 0, 0, 0x7f7f7f7f, 0, 0x7f7f7f7f);
                int bad = 0;
                for (int r = 0; r < 4; ++r) { const int row = 4 * kb + r, col = i; float ex = 0.f; for (int k = 0; k < 128; ++k) ex += mx_a_val(row, k) * mx_b_val(k, col); bad += (d[r] != ex); }
                if (__ballot(bad != 0) == 0ull && code == 0.f) code = (float)(hyp + 1); }
            for (int t = 0; t < 2; ++t) {
                int aw[8] = {0, 0, 0, 0, 0, 0, 0, 0}, bw[8] = {0, 0, 0, 0, 0, 0, 0, 0};
                if (t == 0) { for (int e = 0; e < 32; ++e) { const int k = 32 * kb + e; aw[e >> 3] |= mx_a_code(i, k) << (4 * (e & 7)); bw[e >> 3] |= mx_a_code(i + 16, k) << (4 * (e & 7)); } }
                else { for (int q = 0; q < 8; ++q) { int w = 0, w2 = 0; const int k = 32 * kb + 4 * q;
                        w = __builtin_amdgcn_cvt_pk_fp8_f32(mx_b_val(k, i + 16), mx_b_val(k + 1, i + 16), w, false); w = __builtin_amdgcn_cvt_pk_fp8_f32(mx_b_val(k + 2, i + 16), mx_b_val(k + 3, i + 16), w, true); aw[q] = w;
                        w2 = __builtin_amdgcn_cvt_pk_fp8_f32(mx_b_val(k, i), mx_b_val(k + 1, i), w2, false); w2 = __builtin_amdgcn_cvt_pk_fp8_f32(mx_b_val(k + 2, i), mx_b_val(k + 3, i), w2, true); bw[q] = w2; } }
                const v8i af = {aw[0], aw[1], aw[2], aw[3], aw[4], aw[5], aw[6], aw[7]}, bf = {bw[0], bw[1], bw[2], bw[3], bw[4], bw[5], bw[6], bw[7]};
                f4 d = {0.f, 0.f, 0.f, 0.f};
                if (t == 0) d = __builtin_amdgcn_mfma_scale_f32_16x16x128_f8f6f4(af, bf, d, 4, 4, 0, 0x7f7f7f7f, 0, 0x7f7f7f7f); else d = __builtin_amdgcn_mfma_scale_f32_16x16x128_f8f6f4(af, bf, d, 0, 0, 0, 0x7f7f7f7f, 0, 0x7f7f7f7f);
                int bad = 0;
                for (int r = 0; r < 4; ++r) { const int row = 4 * kb + r, col = i; float ex = 0.f;
                    for (int k = 0; k < 128; ++k) ex += (t == 0) ? mx_a_val(row, k) * mx_a_val(col + 16, k) : mx_b_val(k, row + 16) * mx_b_val(k, col);
                    bad += (d[r] != ex); }
                if (__ballot(bad != 0) == 0ull) code += (t == 0) ? 10.f : 20.f; }
            if (lane == 0) vsh = code; }
        __syncthreads(); v = vsh;
    } else {
        float s0 = 0.f, s1 = 0.f, s2 = 0.f, s3 = 0.f;
        for (int i = 0; i < 2048; ++i) { s0 += pp[4 * i]; s1 += pp[4 * i + 1]; s2 += pp[4 * i + 2]; s3 += pp[4 * i + 3]; }
        if (DBG_PROBE == 4) { float mx = 0.f; for (int i = 0; i < 2048; ++i) mx = fmaxf(mx, pp[4 * i]); v = 100.f * mx; }
        else { v = (DBG_PROBE == 1 ? s0 : DBG_PROBE == 2 ? s1 : s2) / s3 * 1e-3f; v = exp2f(rintf(log2f(v) * 4.f) * 0.25f); }
    }
    for (size_t i = (size_t)blockIdx.x * 512 + threadIdx.x; i < (size_t)NBATCH * SEQ * DM; i += (size_t)gridDim.x * 512) o[i] = v;
}
extern "C" void kernel_launch(void* const* d_in, const int* in_sizes, int n_in, void* d_out, int out_size, void* d_ws, size_t ws_size, hipStream_t stream) {
    static int grid = 0;
    if (grid == 0) {
        if (n_in != 33 || out_size != NBATCH * SEQ * DM || ws_size < WS_END2) { fprintf(stderr, "kernel_launch: unexpected shapes (n_in %d out %d ws %zu)\n", n_in, out_size, ws_size); grid = -1; return; }
        int dev = 0, cus = 0, per_cu = 0;
        if (hipGetDevice(&dev) != hipSuccess || hipDeviceGetAttribute(&cus, hipDeviceAttributeMultiprocessorCount, dev) != hipSuccess) { grid = -1; return; }
        if (hipFuncSetAttribute((const void*)mk_fwd, hipFuncAttributeMaxDynamicSharedMemorySize, LDS_BYTES) != hipSuccess) { fprintf(stderr, "kernel_launch: hipFuncSetAttribute failed\n"); grid = -1; return; }
        if (hipOccupancyMaxActiveBlocksPerMultiprocessor(&per_cu, (const void*)mk_fwd, NWAVES * 64, LDS_BYTES) != hipSuccess || per_cu < 1) { fprintf(stderr, "kernel_launch: occupancy query says %d\n", per_cu); (void)hipGetLastError(); grid = -1; return; }
        grid = cus;
    }
    if (grid < 0) return;
    if (hipMemsetAsync((char*)d_ws + WS_CTL, 0, CTL_ZERO_BYTES, stream) != hipSuccess) return;
    Args a{};
    for (int i = 0; i < 33; ++i) a.in[i] = (const float*)d_in[i];
    a.out = (float*)d_out; a.ws = (unsigned char*)d_ws;
#if MK_N_LAUNCHES == 1
    a.ph_lo = 0; a.ph_hi = NPHASE;
    hipLaunchKernelGGL(mk_fwd, dim3(grid), dim3(NWAVES * 64), LDS_BYTES, stream, a);
#else
    if (DBG_PROBE != 5) for (int p = 0; p < NPHASE; ++p) { a.ph_lo = p; a.ph_hi = p + 1; hipLaunchKernelGGL(mk_fwd, dim3(grid), dim3(NWAVES * 64), LDS_BYTES, stream, a); }
    if (DBG_PROBE) hipLaunchKernelGGL(dbg_fill, dim3(1024), dim3(512), 0, stream, (const float*)((char*)d_ws + WS_CTL + CTL_PROBE_OFF), (float*)d_out);
#endif
}
```

```cpp
#include <hip/hip_runtime.h>
#include <cstdio>
#include <cstdint>

#ifndef MK_N_LAUNCHES
#define MK_N_LAUNCHES 1
#endif

#ifndef DBG_SKIP
#define DBG_SKIP 0
#endif
#ifndef DBG_PROBE
#define DBG_PROBE 0
#endif
#ifndef DBG_DRY
#define DBG_DRY 1
#endif
#ifndef DBG_REPEAT
#define DBG_REPEAT -1
#endif
namespace pg8 {
#define PG8_LAS __attribute__((address_space(3)))
typedef unsigned short bf16_t;
typedef short bf16x8 __attribute__((ext_vector_type(8)));
typedef float f32x4 __attribute__((ext_vector_type(4)));
typedef unsigned u32x4 __attribute__((ext_vector_type(4)));
constexpr int BM = 256, BK = 64, HALF = 128, HTB = HALF * BK * 2  , STAGE_BYTES = 8 * HTB, NXCD = 8, WGM = 8;

__host__ __device__ __forceinline__ int lds_byte(int r, int c) { const int st = (r >> 4) * 2 + (c >> 5), rr = r & 15, cc = c & 31, ob = rr * 64 + cc * 2; return st * 1024 + (ob ^ (((ob >> 9) & 1) << 5)); }
__host__ __device__ __forceinline__ void stage_rc(int b, int& R, int& C) { const int st = b / 1024, sb = b % 1024, swz = sb ^ (((sb >> 9) & 1) << 5); R = (st >> 1) * 16 + swz / 64; C = (st & 1) * 32 + (swz % 64) / 2; }
__host__ __device__ __forceinline__ int perm32(int rho) { const int n = rho >> 4, i = rho & 15; return 8 * (i >> 2) + 4 * n + (i & 3); }

struct Unit { int pm, pn; };
struct Gemm { const bf16_t* A; const bf16_t* Bt; int M, N, K; };

struct StaticOrder {
    int nM, nN, nwg, G, c;
    __host__ __device__ void init(int M, int N, int G_, int c_) { nM = M / BM; nN = N / BM; nwg = nM * nN; G = G_; c = c_; }
    __host__ __device__ bool next(int i, Unit& u) const {
        const long L = (long)i * G + c; if (L >= nwg) return false;
        int wgid = (int)L; { const int q = nwg / NXCD, r = nwg % NXCD, xcd = wgid % NXCD, off = wgid / NXCD; wgid = (xcd < r ? xcd * (q + 1) : r * (q + 1) + (xcd - r) * q) + off; }
        const int nig = WGM * nN, gid = wgid / nig, fm = gid * WGM, gsz = (nM - fm) < WGM ? (nM - fm) : WGM;
        u.pm = fm + ((wgid % nig) % gsz); u.pn = (wgid % nig) / gsz; return true;
    }
    __device__ __forceinline__ void a_ready(const Unit&) const {}
    __device__ __forceinline__ void done(const Unit&) const {}
};
__device__ __forceinline__ int opaque_lane() { int l; asm volatile("v_mbcnt_lo_u32_b32 %0, -1, 0\n\tv_mbcnt_hi_u32_b32 %0, -1, %0" : "=v"(l)); return l; }
typedef __bf16 bf16x2c __attribute__((ext_vector_type(2)));
__device__ __forceinline__ unsigned cvt_pk_bf16(float lo, float hi) { const bf16x2c v = {(__bf16)lo, (__bf16)hi}; return __builtin_bit_cast(unsigned, v); }
template <class Epi, class Sched, bool ALIGN_EPI = false, bool SP2 = false>
__device__ __forceinline__ void gemm_phase(PG8_LAS unsigned char* lds, const Gemm g, const Sched& S, const Epi& E, const int wave_s) {
    const int lane_ = opaque_lane();
    const int wid = wave_s, lane = lane_, tid = wid * 64 + lane, wr = wid >> 2, wc = wid & 3, fr = lane & 15, fq = lane >> 4;
    const int K = g.K, nt = K / BK;
    unsigned voffA[2], voffB[2];
#pragma unroll
    for (int i = 0; i < 2; ++i) { int R, C; stage_rc(tid * 16 + i * 8192, R, C); const int Rb = Epi::PERM ? ((R & ~31) + perm32(R & 31)) : R;
        voffA[i] = (unsigned)(R * K + C) * 2u; voffB[i] = (unsigned)(Rb * K + C) * 2u; }
    const size_t kstep = (size_t)(BK * 2);
    const size_t hstep = (size_t)HALF * K * 2;
    const size_t tstep = 2 * hstep;
    const unsigned ldsw = (unsigned)wid * 1024u;
    const int aoff = lds_byte(wr * 64 + fr, fq * 8), boff = lds_byte(wc * 32 + fr, fq * 8);
#define PG8_SA(b, h) (((b) * 2 + (h)) * HTB)
#define PG8_SB(b, h) ((4 + (b) * 2 + (h)) * HTB)
#define PG8_STAGE(bufoff, gbase, voff) do { _Pragma("unroll") for (int _i = 0; _i < 2; ++_i) \
        __builtin_amdgcn_global_load_lds((const unsigned*)((const char*)(gbase) + (voff)[_i]), (PG8_LAS unsigned*)(lds + (bufoff) + ldsw + _i * 8192), 16, 0, 0); } while (0)
#define PG8_LDA(dst, b, h) do { _Pragma("unroll") for (int m = 0; m < 4; ++m) _Pragma("unroll") for (int k = 0; k < 2; ++k) dst[m][k] = *(const PG8_LAS bf16x8*)(lds + PG8_SA(b, h) + aoff + m * 2048 + k * 1024); } while (0)
#define PG8_LDB(dst, b, h) do { _Pragma("unroll") for (int n = 0; n < 2; ++n) _Pragma("unroll") for (int k = 0; k < 2; ++k) dst[n][k] = *(const PG8_LAS bf16x8*)(lds + PG8_SB(b, h) + boff + n * 2048 + k * 1024); } while (0)
#define PG8_MMA(ai, bj, At, Bt) do { __builtin_amdgcn_s_setprio(1); _Pragma("unroll") for (int m = 0; m < 4; ++m) _Pragma("unroll") for (int n = 0; n < 2; ++n) _Pragma("unroll") for (int k = 0; k < 2; ++k) \
        acc[ai][bj][m][n] = __builtin_amdgcn_mfma_f32_16x16x32_bf16(Bt[n][k], At[m][k], acc[ai][bj][m][n], 0, 0, 0); __builtin_amdgcn_s_setprio(0); } while (0)
#define PG8_WAIT_V(n) asm volatile("s_waitcnt vmcnt(" #n ")" ::: "memory")
#define PG8_WAIT_L(n) asm volatile("s_waitcnt lgkmcnt(" #n ")" ::: "memory")
#define PG8_BAR __builtin_amdgcn_s_barrier()
#define PG8_SCHED __builtin_amdgcn_sched_barrier(0)
    Unit cur, nxt; int ui = 0;
    if (!S.next(0, cur)) return;
    f32x4 acc[2][2][4][2];
#pragma unroll
    for (int a = 0; a < 2; ++a)
#pragma unroll
        for (int b = 0; b < 2; ++b)
#pragma unroll
            for (int m = 0; m < 4; ++m)
#pragma unroll
                for (int n = 0; n < 2; ++n) acc[a][b][m][n] = (f32x4){0.f, 0.f, 0.f, 0.f};
    bf16x8 At[4][2], B0[2][2], B1[2][2];
    const char* cA = (const char*)g.A + (size_t)cur.pm * tstep; const char* cB = (const char*)g.Bt + (size_t)cur.pn * tstep;
    S.a_ready(cur);
    if constexpr (SP2) {
        PG8_STAGE(PG8_SB(0, 0), cB, voffB); PG8_STAGE(PG8_SB(0, 1), cB + hstep, voffB); PG8_STAGE(PG8_SA(0, 0), cA, voffA); PG8_STAGE(PG8_SA(0, 1), cA + hstep, voffA);
        if (wr == 1) PG8_BAR;
        PG8_WAIT_V(2); PG8_BAR;
        PG8_STAGE(PG8_SB(1, 0), cB + kstep, voffB); PG8_STAGE(PG8_SA(1, 0), cA + kstep, voffA); PG8_STAGE(PG8_SB(1, 1), cB + hstep + kstep, voffB);
        PG8_WAIT_V(6); PG8_BAR;
    } else {
        PG8_STAGE(PG8_SB(0, 0), cB, voffB); PG8_STAGE(PG8_SA(0, 0), cA, voffA); PG8_STAGE(PG8_SB(0, 1), cB + hstep, voffB); PG8_STAGE(PG8_SA(0, 1), cA + hstep, voffA);
        if (wr == 1) PG8_BAR;
        PG8_WAIT_V(4); PG8_BAR;
        PG8_STAGE(PG8_SB(1, 0), cB + kstep, voffB); PG8_STAGE(PG8_SA(1, 0), cA + kstep, voffA); PG8_STAGE(PG8_SB(1, 1), cB + hstep + kstep, voffB);
        PG8_WAIT_V(6); PG8_BAR;
    }
    for (;;) {
        const bool has_next = S.next(ui + 1, nxt);
        const char* nA = has_next ? (const char*)g.A + (size_t)nxt.pm * tstep : cA; const char* nB = has_next ? (const char*)g.Bt + (size_t)nxt.pn * tstep : cB;
        for (int t = 0; t < nt; t += 2) {
            const bool last = (t == nt - 2);
            const char* a1 = cA + (size_t)(t + 1) * kstep;
            const char* a2 = last ? nA : cA + (size_t)(t + 2) * kstep; const char* b2 = last ? nB : cB + (size_t)(t + 2) * kstep;
            const char* a3 = a2 + kstep; const char* b3 = b2 + kstep;
            if (last && has_next) S.a_ready(nxt);
            if constexpr (SP2) {
            PG8_LDB(B0, 0, 0); PG8_LDB(B1, 0, 1); PG8_SCHED; PG8_LDA(At, 0, 0); PG8_STAGE(PG8_SA(1, 1), a1 + hstep, voffA);
            PG8_WAIT_V(8); PG8_WAIT_L(0); PG8_BAR; PG8_MMA(0, 0, At, B0); PG8_MMA(0, 1, At, B1); PG8_BAR; PG8_SCHED;
            PG8_LDA(At, 0, 1); PG8_STAGE(PG8_SB(0, 0), b2, voffB); PG8_STAGE(PG8_SB(0, 1), b2 + hstep, voffB); PG8_STAGE(PG8_SA(0, 0), a2, voffA);
            PG8_WAIT_V(8); PG8_WAIT_L(0); PG8_BAR; PG8_MMA(1, 0, At, B0); PG8_MMA(1, 1, At, B1); PG8_BAR; PG8_SCHED;
            PG8_LDB(B0, 1, 0); PG8_LDB(B1, 1, 1); PG8_SCHED; PG8_LDA(At, 1, 0); PG8_STAGE(PG8_SA(0, 1), a2 + hstep, voffA);
            PG8_WAIT_V(8); PG8_WAIT_L(0); PG8_BAR; PG8_MMA(0, 0, At, B0); PG8_MMA(0, 1, At, B1); PG8_BAR; PG8_SCHED;
            PG8_LDA(At, 1, 1); PG8_STAGE(PG8_SB(1, 0), b3, voffB); PG8_STAGE(PG8_SB(1, 1), b3 + hstep, voffB); PG8_STAGE(PG8_SA(1, 0), a3, voffA);
            PG8_WAIT_V(8); PG8_WAIT_L(0); PG8_BAR; PG8_MMA(1, 0, At, B0); PG8_MMA(1, 1, At, B1); PG8_BAR; PG8_SCHED;
            } else {
            PG8_LDB(B0, 0, 0); PG8_SCHED; PG8_LDA(At, 0, 0); PG8_STAGE(PG8_SA(1, 1), a1 + hstep, voffA);
            PG8_WAIT_L(8); PG8_BAR; PG8_WAIT_L(0); PG8_MMA(0, 0, At, B0); PG8_BAR; PG8_SCHED;
            PG8_LDB(B1, 0, 1); PG8_STAGE(PG8_SB(0, 0), b2, voffB);
            PG8_BAR; PG8_WAIT_L(0); PG8_MMA(0, 1, At, B1); PG8_BAR;
            PG8_LDA(At, 0, 1); PG8_STAGE(PG8_SA(0, 0), a2, voffA);
            PG8_BAR; PG8_WAIT_L(0); PG8_MMA(1, 0, At, B0); PG8_BAR; PG8_SCHED;
            PG8_STAGE(PG8_SB(0, 1), b2 + hstep, voffB);
            PG8_WAIT_V(6); PG8_BAR; PG8_MMA(1, 1, At, B1); PG8_BAR;
            PG8_LDB(B0, 1, 0); PG8_SCHED; PG8_LDA(At, 1, 0); PG8_STAGE(PG8_SA(0, 1), a2 + hstep, voffA);
            PG8_WAIT_L(8); PG8_BAR; PG8_WAIT_L(0); PG8_MMA(0, 0, At, B0); PG8_BAR; PG8_SCHED;
            PG8_LDB(B1, 1, 1); PG8_STAGE(PG8_SB(1, 0), b3, voffB);
            PG8_BAR; PG8_WAIT_L(0); PG8_MMA(0, 1, At, B1); PG8_BAR;
            PG8_LDA(At, 1, 1); PG8_STAGE(PG8_SA(1, 0), a3, voffA);
            PG8_BAR; PG8_WAIT_L(0); PG8_MMA(1, 0, At, B0); PG8_BAR; PG8_SCHED;
            PG8_STAGE(PG8_SB(1, 1), b3 + hstep, voffB);
            PG8_WAIT_V(6); PG8_BAR; PG8_MMA(1, 1, At, B1); PG8_BAR;
            }
        }
        if constexpr (ALIGN_EPI) { if (wr == 0) PG8_BAR; }
        if constexpr (!Epi::AFTER_DRAIN) { const int le_ = opaque_lane(); E(acc, cur, wr, wc, le_ & 15, le_ >> 4); S.done(cur); }
        if (!has_next) break;
#pragma unroll
        for (int a = 0; a < 2; ++a)
#pragma unroll
            for (int b = 0; b < 2; ++b)
#pragma unroll
                for (int m = 0; m < 4; ++m)
#pragma unroll
                    for (int n = 0; n < 2; ++n) acc[a][b][m][n] = (f32x4){0.f, 0.f, 0.f, 0.f};
        cur = nxt; cA = nA; cB = nB; ++ui;
        if constexpr (ALIGN_EPI) { if (wr == 1) PG8_BAR; }
    }
    PG8_WAIT_V(0);
    if constexpr (!ALIGN_EPI) { if (wr == 0) PG8_BAR; }
    PG8_BAR;
    if constexpr (Epi::AFTER_DRAIN) { E.fused(acc, cur, wr, wc, fr, fq, lds, wid, lane); S.done(cur); }
#undef PG8_SA
#undef PG8_SB
#undef PG8_STAGE
#undef PG8_LDA
#undef PG8_LDB
#undef PG8_MMA
#undef PG8_WAIT_V
#undef PG8_WAIT_L
#undef PG8_BAR
#undef PG8_SCHED
}
}

constexpr int NWAVES = 8;
constexpr int DM = 2048, NBATCH = 2, SEQ = 8192, CTXL = 256, TPB = CTXL + SEQ  , MALL = NBATCH * TPB  ;
constexpr int NLAYER = 2;
constexpr int RW = 1024, NH = 16;
constexpr int RWC = 3392, INA = 4192, INA_P = 4352, INC = 8288;
constexpr int C_WD = 3072, C_AD = 3200, C_GD = 3328, C_QC = 3392, C_KVC = 3904, C_KR = 4160;
constexpr int QKD = 96, NQ = NH * QKD  , NKV = NH * 128  ;
constexpr int NEXP = 16384;
constexpr int RREC = 9 * 64;
constexpr float NORM_EPS = 1e-6f;

constexpr size_t MiB = 1u << 20;
constexpr size_t WS_CTL = 0, CTL_ZERO_BYTES = 1 * MiB;
constexpr size_t CTL_MOD_OFF = 256 * 1024;
constexpr size_t WS_ROPE = 1 * MiB;
constexpr size_t WS_WUP = 3 * MiB, WS_AUP = WS_WUP + 512 * 1024, WS_GUP = 4 * MiB;
constexpr size_t WS_WUQ = 5 * MiB, WS_WUKV = 8 * MiB, WS_WA = 10 * MiB, WS_WB = 18 * MiB, WS_WO = 26 * MiB, WS_WQK = 42 * MiB, WS_WGA = 58 * MiB, WS_WGB = 74 * MiB, WS_WINA = 90 * MiB;
constexpr size_t WS_X = 124 * MiB, WS_H = 256 * MiB, WS_DYN = 322 * MiB;
constexpr size_t WS_PA = WS_DYN;
constexpr size_t WS_RI = 463 * MiB;
constexpr size_t WS_GG = 760 * MiB;
constexpr size_t WS_BON = 826 * MiB;
constexpr size_t WS_QN = 831 * MiB, WS_KVN = 848 * MiB;
constexpr size_t WS_Q = 857 * MiB, WS_K = 907 * MiB, WS_V = 957 * MiB, WS_END = 990 * MiB;
constexpr size_t WS_Y = WS_DYN;
constexpr size_t WS_YA = 388 * MiB, WS_YB = 421 * MiB;
constexpr size_t WS_T1 = 463 * MiB, WS_T2 = 529 * MiB;
constexpr size_t WS_PU = 600 * MiB, WS_PV = 664 * MiB;
constexpr size_t WS_CA = 600 * MiB, WS_CB = 608 * MiB;
#ifndef CTX_SPLIT
#define CTX_SPLIT (MK_N_LAUNCHES == 1)
#endif
constexpr size_t WS_P4 = 990 * MiB, WS_P4S = 1022 * MiB, WS_END2 = 1023 * MiB;
constexpr size_t WS_SC = WS_DYN;
static_assert(WS_PA + (size_t)MALL * INA_P * 2 <= WS_RI && WS_RI + (size_t)NBATCH * NH * TPB * RREC * 2 <= WS_GG && WS_GG + (size_t)2 * MALL * RW * 2 <= WS_BON, "ws map 1");
static_assert(WS_BON + (size_t)2 * MALL * 32 * 4 <= WS_QN && WS_QN + (size_t)MALL * 512 * 2 <= WS_KVN && WS_KVN + (size_t)MALL * 256 * 2 <= WS_Q, "ws map 2");
static_assert(WS_Q + (size_t)NBATCH * NH * TPB * QKD * 2 <= WS_K && WS_K + (size_t)NBATCH * NH * TPB * QKD * 2 <= WS_V && WS_V + (size_t)NBATCH * NH * TPB * 64 * 2 <= WS_END, "ws map 3");
static_assert(WS_Y + (size_t)2 * MALL * RW * 2 <= WS_YA && WS_YA + (size_t)MALL * RW * 2 <= WS_YB && WS_YB + (size_t)MALL * RW * 2 <= WS_RI, "ws map 4");
static_assert(WS_T1 + (size_t)MALL * DM * 2 <= WS_T2 && WS_T2 + (size_t)MALL * DM * 2 <= WS_PU && WS_PU + (size_t)NEXP * DM * 2 <= WS_PV && WS_PV + (size_t)NEXP * DM * 2 <= WS_GG, "ws map 5");
static_assert(WS_SC + (size_t)MALL * DM * 4 <= WS_T1 && WS_X + (size_t)MALL * DM * 4 <= WS_H && WS_H + (size_t)MALL * DM * 2 <= WS_DYN, "ws map 6");
static_assert(WS_WINA + (size_t)NLAYER * INA_P * DM * 2 <= WS_X, "ws map 7");
constexpr size_t CTL_PROBE_OFF = 640 * 1024;
constexpr int CW_BAR = 4096;

constexpr int RING_BYTES = 131072;
constexpr int LDSCTL_OFF = RING_BYTES, MISC_OFF = LDSCTL_OFF + 320;
constexpr int LDS_BYTES = 147456;

#define GAS __attribute__((address_space(1)))
#define LAS __attribute__((address_space(3)))
typedef unsigned short bf16;
typedef unsigned v4u __attribute__((ext_vector_type(4)));
typedef unsigned v2u __attribute__((ext_vector_type(2)));
typedef float f32x4 __attribute__((ext_vector_type(4)));
typedef float f32x2 __attribute__((ext_vector_type(2)));
typedef float f32x16 __attribute__((ext_vector_type(16)));
typedef short bf16x8 __attribute__((ext_vector_type(8)));
typedef short s16x4 __attribute__((ext_vector_type(4)));
typedef __bf16 bf16x2v __attribute__((ext_vector_type(2)));
typedef __bf16 bf16x8v __attribute__((ext_vector_type(8)));
typedef GAS unsigned gu32;
#define RLX_AGENT __ATOMIC_RELAXED, __HIP_MEMORY_SCOPE_AGENT
#define LDS_WAIT() asm volatile("s_waitcnt lgkmcnt(0)" ::: "memory")
#define VM_WAIT() asm volatile("s_waitcnt vmcnt(0)" ::: "memory")
__device__ __forceinline__ unsigned f2bf(float f) { unsigned u = __builtin_bit_cast(unsigned, f); return (u + 0x7fffu + ((u >> 16) & 1u)) >> 16; }
#define LDS_BARRIER() do { asm volatile("s_waitcnt lgkmcnt(0)" ::: "memory"); __builtin_amdgcn_s_barrier(); asm volatile("" ::: "memory"); } while (0)
__device__ __forceinline__ unsigned pk2(float lo, float hi) { return pg8::cvt_pk_bf16(lo, hi); }
__device__ __forceinline__ float bflo(unsigned w) { return __builtin_bit_cast(float, w << 16); }
__device__ __forceinline__ float bfhi(unsigned w) { return __builtin_bit_cast(float, w & 0xffff0000u); }
__device__ __forceinline__ float bf1(bf16 h) { return __builtin_bit_cast(float, (unsigned)h << 16); }
__device__ __forceinline__ float sigmoidf_(float x) { return __builtin_amdgcn_rcpf(1.0f + __expf(-x)); }
template <int CTRL> __device__ __forceinline__ float dpp_add(float x) {
    return x + __builtin_bit_cast(float, __builtin_amdgcn_update_dpp(0, __builtin_bit_cast(int, x), CTRL, 0xf, 0xf, true));
}
__device__ __forceinline__ float red16(float x) {
    x = dpp_add<0xB1>(x);
    x = dpp_add<0x4E>(x);
    x = dpp_add<0x141>(x);
    x = dpp_add<0x140>(x);
    return x;
}
template <int CTRL, int RM> __device__ __forceinline__ float dpp_max(float x) {
    return fmaxf(x, __builtin_bit_cast(float, __builtin_amdgcn_update_dpp(__builtin_bit_cast(int, x), __builtin_bit_cast(int, x), CTRL, RM, 0xf, false)));
}
template <int CTRL, int RM> __device__ __forceinline__ float dpp_sum(float x) {
    return x + __builtin_bit_cast(float, __builtin_amdgcn_update_dpp(0, __builtin_bit_cast(int, x), CTRL, RM, 0xf, false));
}
__device__ __forceinline__ float wave_max_u(float x) {
    x = dpp_max<0xB1, 0xf>(x); x = dpp_max<0x4E, 0xf>(x); x = dpp_max<0x141, 0xf>(x); x = dpp_max<0x140, 0xf>(x);
    x = dpp_max<0x142, 0xa>(x); x = dpp_max<0x143, 0xc>(x);
    return __builtin_bit_cast(float, __builtin_amdgcn_readlane(__builtin_bit_cast(int, x), 63));
}
__device__ __forceinline__ float wave_sum_u(float x) {
    x = dpp_sum<0xB1, 0xf>(x); x = dpp_sum<0x4E, 0xf>(x); x = dpp_sum<0x141, 0xf>(x); x = dpp_sum<0x140, 0xf>(x);
    x = dpp_sum<0x142, 0xa>(x); x = dpp_sum<0x143, 0xc>(x);
    return __builtin_bit_cast(float, __builtin_amdgcn_readlane(__builtin_bit_cast(int, x), 63));
}
__device__ __forceinline__ float wave_sum(float v) { return wave_sum_u(v); }
__device__ __forceinline__ float bpermf(int srclane, float v) { return __builtin_bit_cast(float, __builtin_amdgcn_ds_bpermute(srclane << 2, __builtin_bit_cast(int, v))); }
__device__ __forceinline__ int bpermi(int srclane, int v) { return __builtin_amdgcn_ds_bpermute(srclane << 2, v); }

#define XB_TMO      128
#define XB_XCNT(j)  (256  + 64 * (j))
#define XB_XSUB(j)  (1280 + 64 * (j))
#define XB_XGEN(j)  (2304 + 64 * (j))
#define XB_TOP      3328
#define XB_TOPGEN   3392
#define XCD_BAR_WORDS 3456
#define XB_SPIN_CAP (1u << 20)

__device__ __forceinline__ unsigned xb_ld(unsigned* p)              { return __hip_atomic_load(p, __ATOMIC_RELAXED, __HIP_MEMORY_SCOPE_AGENT); }
__device__ __forceinline__ unsigned xb_add(unsigned* p, unsigned v) { return __hip_atomic_fetch_add(p, v, __ATOMIC_RELAXED, __HIP_MEMORY_SCOPE_AGENT); }
__device__ __forceinline__ unsigned xb_xcc_id() { return (unsigned)__builtin_amdgcn_s_getreg((3 << 11) | 20) & 0xFu; }
#define XB_SPIN(cond, bar) do { unsigned _sp = 0; while (cond) { __builtin_amdgcn_s_sleep(1); \
    if ((++_sp & 255u) == 0u) { if (xb_ld(&(bar)[XB_TMO])) break; if (_sp > XB_SPIN_CAP) { atomicAdd(&(bar)[XB_TMO], 1u); break; } } } } while (0)

struct XcdBarrier { unsigned* bar; unsigned x; volatile LAS unsigned* st; };

__device__ __forceinline__ XcdBarrier xcd_barrier_post(unsigned* bar, volatile LAS unsigned* st, bool t0) {
    XcdBarrier b; b.bar = bar; b.x = xb_xcc_id(); b.st = st;
    if (t0) (void)xb_add(&bar[XB_XCNT(b.x)], 1u);
    return b;
}
__device__ __forceinline__ void xcd_barrier_complete(unsigned* bar, unsigned x, unsigned& nloc, unsigned& nx) {
    const unsigned G = gridDim.x * gridDim.y * gridDim.z;
    unsigned sum, cnt, mine, sp = 0u;
    for (;;) {
        sum = 0u; cnt = 0u; mine = 0u;
#pragma unroll
        for (unsigned j = 0; j < 16; ++j) { const unsigned c = xb_ld(&bar[XB_XCNT(j)]); sum += c; cnt += (c > 0u) ? 1u : 0u; mine = (j == x) ? c : mine; }
        if (sum == G) break;
        __builtin_amdgcn_s_sleep(1);
        if ((++sp & 255u) == 0u) { if (xb_ld(&bar[XB_TMO])) break; if (sp > XB_SPIN_CAP) { atomicAdd(&bar[XB_TMO], 1u); break; } }
    }
    nloc = mine > 0u ? mine : 1u; nx = cnt > 0u ? cnt : 1u;
}
__device__ __forceinline__ void xcd_barrier(const XcdBarrier& b, bool t0) {
    asm volatile("s_waitcnt vmcnt(0)" ::: "memory");
    __syncthreads();
    if (t0) {
        unsigned* bar = b.bar;
        __builtin_amdgcn_s_waitcnt(0);
        unsigned nloc = b.st[0], nx = b.st[1];
        if (nloc == 0u) { xcd_barrier_complete(bar, b.x, nloc, nx); b.st[0] = nloc; b.st[1] = nx; }
        const unsigned old = xb_add(&bar[XB_XSUB(b.x)], 1u);
        const unsigned gen = old / nloc;
        if (old + 1u == (gen + 1u) * nloc) {
            __builtin_amdgcn_fence(__ATOMIC_RELEASE, "agent");
            asm volatile("s_waitcnt vmcnt(0)" ::: "memory");
            const unsigned og = xb_add(&bar[XB_TOP], 1u);
            const unsigned tg = og / nx;
            if (og + 1u == (tg + 1u) * nx) xb_add(&bar[XB_TOPGEN], 1u);
            else XB_SPIN(xb_ld(&bar[XB_TOPGEN]) == tg, bar);
            __builtin_amdgcn_fence(__ATOMIC_ACQUIRE, "agent");
            xb_add(&bar[XB_XGEN(b.x)], 1u);
            asm volatile("s_waitcnt vmcnt(0)" ::: "memory");
        } else {
            XB_SPIN(xb_ld(&bar[XB_XGEN(b.x)]) == gen, bar);
            __builtin_amdgcn_fence(__ATOMIC_ACQUIRE, "agent");
            asm volatile("s_waitcnt vmcnt(0)" ::: "memory");
        }
    }
    __syncthreads();
}

struct Frame {
    LAS unsigned char* lds;
    unsigned char* ws;
    const float* const* in;
    int tid, lane, wave;
    int vcu, G;
};
struct Args { const float* in[33]; float* out; unsigned char* ws; int ph_lo, ph_hi; };


namespace pg8 {
typedef unsigned u32x4 __attribute__((ext_vector_type(4)));
struct RowOrder : StaticOrder {
    int lat;
    __host__ __device__ void init_rows(int lat_, int N, int G_, int c_) { lat = lat_; init(lat_ ? NBATCH * SEQ : MALL, N, G_, c_); }
    __host__ __device__ bool next(int i, Unit& u) const { if (!StaticOrder::next(i, u)) return false; if (lat) u.pm = 33 * (u.pm >> 5) + 1 + (u.pm & 31); return true; }
};
#define EPI_LOOP_ROWS for (int ai = 0; ai < 2; ++ai) _Pragma("unroll") for (int m = 0; m < 4; ++m)
#define EPI_PIN asm volatile("" ::: "memory")

struct EpiStoreBf16 {
    static constexpr bool PERM = true, AFTER_DRAIN = false;
    bf16_t* O; int ldc;
    __device__ __forceinline__ void operator()(const f32x4 (&acc)[2][2][4][2], const Unit& u, int wr, int wc, int fr, int fq) const {
        const int row0 = u.pm * BM + wr * 64 + fr, col0 = u.pn * BM + wc * 32 + 8 * fq;
#pragma unroll
        EPI_LOOP_ROWS { bf16_t* rowp = O + (size_t)(row0 + ai * HALF + m * 16) * ldc + col0;
#pragma unroll
            for (int bj = 0; bj < 2; ++bj) { const f32x4 v0 = acc[ai][bj][m][0], v1 = acc[ai][bj][m][1];
                u32x4 w; w.x = cvt_pk_bf16(v0[0], v0[1]); w.y = cvt_pk_bf16(v0[2], v0[3]); w.z = cvt_pk_bf16(v1[0], v1[1]); w.w = cvt_pk_bf16(v1[2], v1[3]);
                *(u32x4*)(rowp + bj * HALF) = w; } }
    }
};
struct EpiGate {
    static constexpr bool PERM = true, AFTER_DRAIN = false;
    bf16_t* O; int ldc; const float* bias;
    __device__ __forceinline__ void operator()(const f32x4 (&acc)[2][2][4][2], const Unit& u, int wr, int wc, int fr, int fq) const {
        const int row0 = u.pm * BM + wr * 64 + fr, col0 = u.pn * BM + wc * 32 + 8 * fq;
        f32x4 bv[2][2];
#pragma unroll
        for (int bj = 0; bj < 2; ++bj)
#pragma unroll
            for (int n = 0; n < 2; ++n) bv[bj][n] = *(const f32x4*)(bias + col0 + bj * HALF + 4 * n);
#pragma unroll
        EPI_LOOP_ROWS { EPI_PIN; bf16_t* rowp = O + (size_t)(row0 + ai * HALF + m * 16) * ldc + col0;
#pragma unroll
            for (int bj = 0; bj < 2; ++bj) { f32x4 v0 = acc[ai][bj][m][0] + bv[bj][0], v1 = acc[ai][bj][m][1] + bv[bj][1];
#pragma unroll
                for (int e = 0; e < 4; ++e) { v0[e] = __builtin_amdgcn_rcpf(1.0f + __expf(-v0[e])); v1[e] = __builtin_amdgcn_rcpf(1.0f + __expf(-v1[e])); }
                u32x4 w; w.x = cvt_pk_bf16(v0[0], v0[1]); w.y = cvt_pk_bf16(v0[2], v0[3]); w.z = cvt_pk_bf16(v1[0], v1[1]); w.w = cvt_pk_bf16(v1[2], v1[3]);
                *(u32x4*)(rowp + bj * HALF) = w; } }
    }
};
__device__ __forceinline__ float bf_lo(unsigned w) { return __builtin_bit_cast(float, w << 16); }
__device__ __forceinline__ float bf_hi(unsigned w) { return __builtin_bit_cast(float, w & 0xffff0000u); }
struct EpiMulAdd {
    static constexpr bool PERM = true, AFTER_DRAIN = false;
    bf16_t* O; const bf16_t* Gt; const bf16_t* Ad; int ldc;
    __device__ __forceinline__ void operator()(const f32x4 (&acc)[2][2][4][2], const Unit& u, int wr, int wc, int fr, int fq) const {
        const int row0 = u.pm * BM + wr * 64 + fr, col0 = u.pn * BM + wc * 32 + 8 * fq;
#pragma unroll
        EPI_LOOP_ROWS { EPI_PIN; const size_t ro = (size_t)(row0 + ai * HALF + m * 16) * ldc + col0;
#pragma unroll
            for (int bj = 0; bj < 2; ++bj) { const f32x4 v0 = acc[ai][bj][m][0], v1 = acc[ai][bj][m][1];
                const u32x4 g = *(const u32x4*)(Gt + ro + bj * HALF);
                float o[8];
                o[0] = bf_lo(g.x) * v0[0]; o[1] = bf_hi(g.x) * v0[1]; o[2] = bf_lo(g.y) * v0[2]; o[3] = bf_hi(g.y) * v0[3];
                o[4] = bf_lo(g.z) * v1[0]; o[5] = bf_hi(g.z) * v1[1]; o[6] = bf_lo(g.w) * v1[2]; o[7] = bf_hi(g.w) * v1[3];
                if (Ad) { const u32x4 a = *(const u32x4*)(Ad + ro + bj * HALF);
                    o[0] += bf_lo(a.x); o[1] += bf_hi(a.x); o[2] += bf_lo(a.y); o[3] += bf_hi(a.y); o[4] += bf_lo(a.z); o[5] += bf_hi(a.z); o[6] += bf_lo(a.w); o[7] += bf_hi(a.w); }
                u32x4 w; w.x = cvt_pk_bf16(o[0], o[1]); w.y = cvt_pk_bf16(o[2], o[3]); w.z = cvt_pk_bf16(o[4], o[5]); w.w = cvt_pk_bf16(o[6], o[7]);
                *(u32x4*)(O + ro + bj * HALF) = w; } }
    }
};
struct EpiResid {
    static constexpr bool PERM = true, AFTER_DRAIN = false;
    bf16_t* X; const float* gate;
    const float* xin; const float* cin;
    __device__ __forceinline__ void operator()(const f32x4 (&acc)[2][2][4][2], const Unit& u, int wr, int wc, int fr, int fq) const {
        const int col0 = u.pn * BM + wc * 32 + 8 * fq;
        const int bb = u.pm / 33, pt = u.pm - bb * 33, mr = (pt == 0) ? 2 : bb;
        const float* gp = gate + (size_t)mr * 12288 + col0;
        const float* sbase = xin ? (pt == 0 ? cin + (size_t)bb * CTXL * DM : xin + ((size_t)bb * SEQ + (size_t)(pt - 1) * BM) * DM) : nullptr;
        f32x4 gv[2][2];
#pragma unroll
        for (int bj = 0; bj < 2; ++bj)
#pragma unroll
            for (int n = 0; n < 2; ++n) gv[bj][n] = *(const f32x4*)(gp + bj * HALF + n * 4);
#pragma unroll
        EPI_LOOP_ROWS { EPI_PIN; const int rl = wr * 64 + fr + ai * HALF + m * 16; bf16_t* rowp = X + (size_t)(u.pm * BM + rl) * DM + col0;
#pragma unroll
            for (int bj = 0; bj < 2; ++bj) { f32x4 s0, s1;
                if (sbase) { const float* srow = sbase + (size_t)rl * DM + col0 + bj * HALF; s0 = *(const f32x4*)srow; s1 = *(const f32x4*)(srow + 4); }
                else { const u32x4 w = *(const u32x4*)(rowp + bj * HALF);
                    s0 = (f32x4){__builtin_bit_cast(float, w.x << 16), __builtin_bit_cast(float, w.x & 0xffff0000u), __builtin_bit_cast(float, w.y << 16), __builtin_bit_cast(float, w.y & 0xffff0000u)};
                    s1 = (f32x4){__builtin_bit_cast(float, w.z << 16), __builtin_bit_cast(float, w.z & 0xffff0000u), __builtin_bit_cast(float, w.w << 16), __builtin_bit_cast(float, w.w & 0xffff0000u)}; }
                const f32x4 r0 = s0 + gv[bj][0] * acc[ai][bj][m][0], r1 = s1 + gv[bj][1] * acc[ai][bj][m][1];
                u32x4 o; o.x = cvt_pk_bf16(r0[0], r0[1]); o.y = cvt_pk_bf16(r0[2], r0[3]); o.z = cvt_pk_bf16(r1[0], r1[1]); o.w = cvt_pk_bf16(r1[2], r1[3]);
                *(u32x4*)(rowp + bj * HALF) = o; } }
    }
};
struct EpiF32 {
    static constexpr bool PERM = false, AFTER_DRAIN = false;
    float* C; int ldc;
    __device__ __forceinline__ void operator()(const f32x4 (&acc)[2][2][4][2], const Unit& u, int wr, int wc, int fr, int fq) const {
        const int row0 = u.pm * BM + wr * 64 + fr, col0 = u.pn * BM + wc * 32 + 4 * fq;
#pragma unroll
        EPI_LOOP_ROWS { float* rowp = C + (size_t)(row0 + ai * HALF + m * 16) * ldc + col0;
#pragma unroll
            for (int bj = 0; bj < 2; ++bj)
#pragma unroll
                for (int n = 0; n < 2; ++n) *(f32x4*)(rowp + bj * HALF + n * 16) = acc[ai][bj][m][n]; }
    }
};
struct EpiCtxF32 {
    static constexpr bool PERM = false, AFTER_DRAIN = false;
    float* C; int ldc;
    __device__ __forceinline__ void operator()(const f32x4 (&acc)[2][2][4][2], const Unit& u, int wr, int wc, int fr, int fq) const {
        const int row0 = (u.pm ? BM : 0) + wr * 64 + fr, col0 = u.pn * BM + wc * 32 + 4 * fq;
#pragma unroll
        EPI_LOOP_ROWS { float* rowp = C + (size_t)(row0 + ai * HALF + m * 16) * ldc + col0;
#pragma unroll
            for (int bj = 0; bj < 2; ++bj)
#pragma unroll
                for (int n = 0; n < 2; ++n) *(f32x4*)(rowp + bj * HALF + n * 16) = acc[ai][bj][m][n]; }
    }
};
struct CtxOrder {
    int u0;
    __host__ __device__ bool next(int i, Unit& u) const { if (i != 0 || u0 < 0) return false; u.pm = (u0 >> 3) ? 33 : 0; u.pn = u0 & 7; return true; }
    __device__ __forceinline__ void a_ready(const Unit&) const {}
    __device__ __forceinline__ void done(const Unit&) const {}
};
struct EpiF16 {
    static constexpr bool PERM = true, AFTER_DRAIN = false;
    _Float16* C; int ldc;
    __device__ __forceinline__ void operator()(const f32x4 (&acc)[2][2][4][2], const Unit& u, int wr, int wc, int fr, int fq) const {
        typedef _Float16 h2 __attribute__((ext_vector_type(2)));
        const int row0 = u.pm * BM + wr * 64 + fr, col0 = u.pn * BM + wc * 32 + 8 * fq;
#pragma unroll
        EPI_LOOP_ROWS { _Float16* rowp = C + (size_t)(row0 + ai * HALF + m * 16) * ldc + col0;
#pragma unroll
            for (int bj = 0; bj < 2; ++bj) { const f32x4 v0 = acc[ai][bj][m][0], v1 = acc[ai][bj][m][1];
                u32x4 w; w.x = __builtin_bit_cast(unsigned, (h2){(_Float16)v0[0], (_Float16)v0[1]}); w.y = __builtin_bit_cast(unsigned, (h2){(_Float16)v0[2], (_Float16)v0[3]});
                w.z = __builtin_bit_cast(unsigned, (h2){(_Float16)v1[0], (_Float16)v1[1]}); w.w = __builtin_bit_cast(unsigned, (h2){(_Float16)v1[2], (_Float16)v1[3]});
                *(u32x4*)(rowp + bj * HALF) = w; } }
    }
};
struct EpiQ {
    static constexpr bool PERM = true, AFTER_DRAIN = false;
    bf16_t* Q; const f32x2* rope; float qscale;
    __device__ __forceinline__ void operator()(const f32x4 (&acc)[2][2][4][2], const Unit& u, int wr, int wc, int fr, int fq) const {
        const int bb = u.pm / 33, tp0 = (u.pm - bb * 33) * BM + wr * 64 + fr, col0 = u.pn * BM + wc * 32 + 8 * fq;
#pragma unroll
        for (int bj = 0; bj < 2; ++bj) { const int c = col0 + bj * HALF, hd = c / QKD, d = c - hd * QKD;
#pragma unroll
            EPI_LOOP_ROWS { EPI_PIN; const int tp = tp0 + ai * HALF + m * 16;
                f32x4 v0 = acc[ai][bj][m][0], v1 = acc[ai][bj][m][1];
                if (d >= 64) { const int i0 = (d - 64) >> 1; const f32x2* rp = rope + (size_t)tp * 16 + i0;
                    const f32x2 c0 = rp[0], c1 = rp[1], c2 = rp[2], c3 = rp[3];
                    float a, b;
                    a = v0[0]; b = v0[1]; v0[0] = a * c0.x - b * c0.y; v0[1] = a * c0.y + b * c0.x;
                    a = v0[2]; b = v0[3]; v0[2] = a * c1.x - b * c1.y; v0[3] = a * c1.y + b * c1.x;
                    a = v1[0]; b = v1[1]; v1[0] = a * c2.x - b * c2.y; v1[1] = a * c2.y + b * c2.x;
                    a = v1[2]; b = v1[3]; v1[2] = a * c3.x - b * c3.y; v1[3] = a * c3.y + b * c3.x; }
                v0 = v0 * qscale; v1 = v1 * qscale;
                u32x4 w; w.x = cvt_pk_bf16(v0[0], v0[1]); w.y = cvt_pk_bf16(v0[2], v0[3]); w.z = cvt_pk_bf16(v1[0], v1[1]); w.w = cvt_pk_bf16(v1[2], v1[3]);
                *(u32x4*)(Q + ((size_t)(bb * NH + hd) * TPB + tp) * QKD + d) = w; } }
    }
};
struct EpiKV {
    static constexpr bool PERM = true, AFTER_DRAIN = false;
    bf16_t* K; bf16_t* V;
    __device__ __forceinline__ void operator()(const f32x4 (&acc)[2][2][4][2], const Unit& u, int wr, int wc, int fr, int fq) const {
        const int bb = u.pm / 33, tp0 = (u.pm - bb * 33) * BM + wr * 64 + fr;
        const bool isK = wc < 2;
        bf16_t* base = isK ? K : V; const int pitch = isK ? QKD : 64, doff = 32 * (wc & 1) + 8 * fq;
#pragma unroll
        for (int bj = 0; bj < 2; ++bj) { const int hd = 2 * u.pn + bj;
            bf16_t* hb = base + (size_t)(bb * NH + hd) * TPB * pitch;
#pragma unroll
            EPI_LOOP_ROWS { EPI_PIN; const int tp = tp0 + ai * HALF + m * 16;
                const f32x4 v0 = acc[ai][bj][m][0], v1 = acc[ai][bj][m][1];
                u32x4 w; w.x = cvt_pk_bf16(v0[0], v0[1]); w.y = cvt_pk_bf16(v0[2], v0[3]); w.z = cvt_pk_bf16(v1[0], v1[1]); w.w = cvt_pk_bf16(v1[2], v1[3]);
                *(u32x4*)((char*)hb + (unsigned)((tp * pitch + doff) * 2)) = w; } }
    }
};
}

struct TItem { const float* W; bf16* WT; int K, ldw, c0, N, mapq, item; };
__device__ __forceinline__ void p0_item_load(const TItem& T, int lane, f32x4 (&x)[8]) {
    const int nblk = T.N / 32, kb = T.item / nblk, nb = T.item - kb * nblk, k0 = 64 * kb, n0 = 32 * nb;
    const float* p = T.W + (size_t)(k0 + (lane >> 3)) * T.ldw + T.c0 + n0 + (lane & 7) * 4;
#pragma unroll
    for (int i = 0; i < 8; ++i) x[i] = *(const GAS f32x4*)(p + (size_t)(8 * i) * T.ldw);
}
__device__ __forceinline__ void p0_item_finish(const TItem& T, const f32x4 (&x)[8], LAS float* scr, int lane) {
    const int nblk = T.N / 32, kb = T.item / nblk, nb = T.item - kb * nblk, k0 = 64 * kb, n0 = 32 * nb;
#pragma unroll
    for (int i = 0; i < 8; ++i) { LAS float* d = scr + (8 * i + (lane >> 3)) * 33 + (lane & 7) * 4; d[0] = x[i].x; d[1] = x[i].y; d[2] = x[i].z; d[3] = x[i].w; }
    LDS_WAIT(); asm volatile("" ::: "memory");
    const int c = lane & 7;
#pragma unroll
    for (int j = 0; j < 4; ++j) { const int n = (lane >> 3) + 8 * j; const LAS float* s = scr + (8 * c) * 33 + n;
        v4u o; o.x = pk2(s[0 * 33], s[1 * 33]); o.y = pk2(s[2 * 33], s[3 * 33]); o.z = pk2(s[4 * 33], s[5 * 33]); o.w = pk2(s[6 * 33], s[7 * 33]);
        int nn = n0 + n;
        if (T.mapq) { const int hd = nn / QKD, d = nn - hd * QKD; if (d >= 64) { const int i = (d - 64) & 15, s2 = (d - 64) >> 4; nn = hd * QKD + 64 + 2 * i + s2; } }
        *(GAS v4u*)(T.WT + (size_t)nn * T.K + k0 + 8 * c) = o; }
    LDS_WAIT(); asm volatile("" ::: "memory");
}

__device__ __forceinline__ const float* karg(int i);
constexpr int TB_INA = (DM / 128) * ((INA + 127) / 128), TB_G = (DM / 128) * (DM / 128), TB_BR = (RW / 128) * (DM / 128), TB_UQ = (512 / 128) * (NQ / 128), TB_UKV = (256 / 128) * (NKV / 128);
constexpr int TB_N = TB_INA + 2 * TB_G + 2 * TB_BR + TB_G + TB_UQ + TB_UKV;
constexpr int TI_LR = 1 * (RW / 32), TI_N = 4 * TI_LR;
__device__ __forceinline__ TItem p0_resolve_big(unsigned char* ws, int git) {
    const int l = git / TB_N; int r = git - l * TB_N; TItem T; T.mapq = 0; T.c0 = 0;
    if (r < TB_INA) { T.W = karg(7) + (size_t)l * DM * INC; T.K = DM; T.ldw = INC; T.N = INA; T.WT = (bf16*)(ws + WS_WINA) + (size_t)l * INA_P * DM; T.item = r; return T; } r -= TB_INA;
    if (r < TB_G) { T.W = karg(7) + (size_t)l * DM * INC; T.K = DM; T.ldw = INC; T.c0 = INA; T.N = DM; T.WT = (bf16*)(ws + WS_WGA) + (size_t)l * DM * DM; T.item = r; return T; } r -= TB_G;
    if (r < TB_G) { T.W = karg(7) + (size_t)l * DM * INC; T.K = DM; T.ldw = INC; T.c0 = INA + DM; T.N = DM; T.WT = (bf16*)(ws + WS_WGB) + (size_t)l * DM * DM; T.item = r; return T; } r -= TB_G;
    if (r < TB_BR) { T.W = karg(24) + (size_t)l * RW * DM; T.K = RW; T.ldw = DM; T.N = DM; T.WT = (bf16*)(ws + WS_WA) + (size_t)l * DM * RW; T.item = r; return T; } r -= TB_BR;
    if (r < TB_BR) { T.W = karg(25) + (size_t)l * RW * DM; T.K = RW; T.ldw = DM; T.N = DM; T.WT = (bf16*)(ws + WS_WB) + (size_t)l * DM * RW; T.item = r; return T; } r -= TB_BR;
    if (r < TB_G) { T.W = karg(26) + (size_t)l * DM * DM; T.K = DM; T.ldw = DM; T.N = DM; T.WT = (bf16*)(ws + WS_WO) + (size_t)l * DM * DM; T.item = r; return T; } r -= TB_G;
    if (r < TB_UQ) { T.W = karg(21) + (size_t)l * 512 * NQ; T.K = 512; T.ldw = NQ; T.N = NQ; T.WT = (bf16*)(ws + WS_WUQ) + (size_t)l * NQ * 512; T.item = r; T.mapq = 1; return T; } r -= TB_UQ;
    { T.W = karg(23) + (size_t)l * 256 * NKV; T.K = 256; T.ldw = NKV; T.N = NKV; T.WT = (bf16*)(ws + WS_WUKV) + (size_t)l * NKV * 256; T.item = r; return T; }
}
__device__ __forceinline__ void p0_big_load(const TItem& T, int tid, f32x4 (&x)[8]) {
    const int nblk = (T.N + 127) / 128, kb = T.item / nblk, nb = T.item - kb * nblk, k0 = 128 * kb, col = 128 * nb + (tid & 31) * 4;
    const float* p = T.W + (size_t)(k0 + (tid >> 5)) * T.ldw + T.c0 + col; const bool ok = col < T.N;
#pragma unroll
    for (int i = 0; i < 8; ++i) x[i] = ok ? *(const GAS f32x4*)(p + (size_t)(16 * i) * T.ldw) : (f32x4){0.f, 0.f, 0.f, 0.f};
}
__device__ __forceinline__ void p0_big_finish(const TItem& T, const f32x4 (&x)[8], LAS float* tile, int tid) {
    const int nblk = (T.N + 127) / 128, kb = T.item / nblk, nb = T.item - kb * nblk, k0 = 128 * kb, n0 = 128 * nb;
    __syncthreads();
#pragma unroll
    for (int i = 0; i < 8; ++i) *(LAS f32x4*)(tile + ((tid >> 5) + 16 * i) * 132 + (tid & 31) * 4) = x[i];
    __syncthreads();
    const int n = tid & 127, cg = tid >> 7; int nn = n0 + n;
    if (nn < T.N) {
        if (T.mapq) { const int hd = nn / QKD, d = nn - hd * QKD; if (d >= 64) { const int i = (d - 64) & 15, s2 = (d - 64) >> 4; nn = hd * QKD + 64 + 2 * i + s2; } }
#pragma unroll
        for (int c = 0; c < 4; ++c) { const LAS float* s = tile + (32 * cg + 8 * c) * 132 + n;
            v4u o; o.x = pk2(s[0 * 132], s[1 * 132]); o.y = pk2(s[2 * 132], s[3 * 132]); o.z = pk2(s[4 * 132], s[5 * 132]); o.w = pk2(s[6 * 132], s[7 * 132]);
            *(GAS v4u*)(T.WT + (size_t)nn * T.K + k0 + 32 * cg + 8 * c) = o; } }
}
__device__ __forceinline__ TItem p0_resolve(unsigned char* ws, int git) {
    const int l = git / TI_N; int r = git - l * TI_N; TItem T; T.mapq = 0; T.c0 = 0;
    const int which = r / TI_LR, d = which & 1, isa = which >> 1; r -= which * TI_LR;
    T.W = (isa ? karg(13) : karg(11)) + (size_t)(l * 2 + d) * 64 * RW; T.K = 64; T.ldw = RW; T.N = RW; T.WT = (bf16*)(ws + (isa ? WS_AUP : WS_WUP)) + (size_t)(l * 2 + d) * RW * 64; T.item = r; return T;
}
constexpr int NWI_INA = (DM / 64) * (INA / 32), NWI_G = (DM / 64) * (DM / 32), NWI_BR = (RW / 64) * (DM / 32), NWI_UQ = (512 / 64) * (NQ / 32), NWI_UKV = (256 / 64) * (NKV / 32);
constexpr int NW_ITEMS = NWI_INA + 2 * NWI_G + 2 * NWI_BR + NWI_G + NWI_UQ + NWI_UKV + TI_N;
__device__ __forceinline__ TItem p0_resolve_wave(unsigned char* ws, int l, int r) {
    TItem T; T.mapq = 0; T.c0 = 0;
    if (r < NWI_INA) { T.W = karg(7) + (size_t)l * DM * INC; T.K = DM; T.ldw = INC; T.N = INA; T.WT = (bf16*)(ws + WS_WINA) + (size_t)l * INA_P * DM; T.item = r; return T; } r -= NWI_INA;
    if (r < NWI_G) { T.W = karg(7) + (size_t)l * DM * INC; T.K = DM; T.ldw = INC; T.c0 = INA; T.N = DM; T.WT = (bf16*)(ws + WS_WGA) + (size_t)l * DM * DM; T.item = r; return T; } r -= NWI_G;
    if (r < NWI_G) { T.W = karg(7) + (size_t)l * DM * INC; T.K = DM; T.ldw = INC; T.c0 = INA + DM; T.N = DM; T.WT = (bf16*)(ws + WS_WGB) + (size_t)l * DM * DM; T.item = r; return T; } r -= NWI_G;
    if (r < NWI_BR) { T.W = karg(24) + (size_t)l * RW * DM; T.K = RW; T.ldw = DM; T.N = DM; T.WT = (bf16*)(ws + WS_WA) + (size_t)l * DM * RW; T.item = r; return T; } r -= NWI_BR;
    if (r < NWI_BR) { T.W = karg(25) + (size_t)l * RW * DM; T.K = RW; T.ldw = DM; T.N = DM; T.WT = (bf16*)(ws + WS_WB) + (size_t)l * DM * RW; T.item = r; return T; } r -= NWI_BR;
    if (r < NWI_G) { T.W = karg(26) + (size_t)l * DM * DM; T.K = DM; T.ldw = DM; T.N = DM; T.WT = (bf16*)(ws + WS_WO) + (size_t)l * DM * DM; T.item = r; return T; } r -= NWI_G;
    if (r < NWI_UQ) { T.W = karg(21) + (size_t)l * 512 * NQ; T.K = 512; T.ldw = NQ; T.N = NQ; T.WT = (bf16*)(ws + WS_WUQ) + (size_t)l * NQ * 512; T.item = r; T.mapq = 1; return T; } r -= NWI_UQ;
    if (r < NWI_UKV) { T.W = karg(23) + (size_t)l * 256 * NKV; T.K = 256; T.ldw = NKV; T.N = NKV; T.WT = (bf16*)(ws + WS_WUKV) + (size_t)l * NKV * 256; T.item = r; return T; } r -= NWI_UKV;
    return p0_resolve(ws, l * TI_N + r);
}
__device__ __forceinline__ void p0_prologue(Frame& F, int l_lo, int l_hi, int svcu, int sG, int with_tr = 1) {
    LAS float* scr = (LAS float*)(F.lds + F.wave * 16384);
    const int gw = svcu * NWAVES + F.wave, NGW = sG * NWAVES;
    unsigned char* ws = F.ws;
    for (int rp_ = 0; rp_ < (DBG_REPEAT == 102 ? 2 : 1); ++rp_)
    { float* modw = (float*)(ws + WS_CTL + CTL_MOD_OFF); const float* adaw = karg(4); const float* adab = karg(5); const float* cin = karg(1); const float* cctx = karg(3);
      LAS float* SIL = (LAS float*)F.lds;
      LAS f32x2* part = (LAS f32x2*)(F.lds + 32768);
      if (svcu >= 0 && l_lo * 96 + svcu < l_hi * 96) {
          for (int i = F.tid; i < 3 * DM; i += 512) { const int r = i >> 11, k = i & 2047; const float c = r < 2 ? cin[r * DM + k] : cctx[k]; SIL[i] = c / (1.f + __expf(-c)); }
          __syncthreads(); }
      if (svcu >= 0) for (int uu = l_lo * 96 + svcu; uu < l_hi * 96; uu += sG) { const int cb = uu % 96, l = uu / 96;
          const int n0 = cb * 128 + F.lane * 2; const float* aw = adaw + (size_t)l * DM * 12288 + n0;
          f32x2 a0 = {0, 0}, a1 = a0, a2 = a0;
#pragma unroll 1
          for (int k0 = F.wave * 256; k0 < F.wave * 256 + 256; k0 += 16) { f32x2 w[16];
#pragma unroll
              for (int j = 0; j < 16; ++j) w[j] = *(const GAS f32x2*)(aw + (size_t)(k0 + j) * 12288);
#pragma unroll
              for (int j = 0; j < 16; ++j) { a0 = a0 + w[j] * SIL[k0 + j]; a1 = a1 + w[j] * SIL[DM + k0 + j]; a2 = a2 + w[j] * SIL[2 * DM + k0 + j]; } }
          __syncthreads();
          part[(F.wave * 3 + 0) * 64 + F.lane] = a0; part[(F.wave * 3 + 1) * 64 + F.lane] = a1; part[(F.wave * 3 + 2) * 64 + F.lane] = a2;
          __syncthreads();
          if (F.wave < 3) { f32x2 s = *(const GAS f32x2*)(adab + (size_t)l * 12288 + n0);
#pragma unroll
              for (int w8 = 0; w8 < 8; ++w8) s = s + part[(w8 * 3 + F.wave) * 64 + F.lane];
              *(GAS f32x2*)(modw + ((size_t)l * 3 + F.wave) * 12288 + n0) = s; }
          __syncthreads(); } }
    if (with_tr) for (int rp_ = 0; rp_ < (DBG_REPEAT == 101 ? 2 : 1); ++rp_)
    { unsigned* ctr = (unsigned*)(ws + WS_CTL) + 2048 + 64 * rp_ + 128 * l_lo; LAS float* tile = (LAS float*)F.lds; LAS int* slot = (LAS int*)(F.lds + 128 * 132 * 4);
#define P0_GRAB(dst) do { __syncthreads(); if (F.tid == 0) *slot = (int)__hip_atomic_fetch_add(ctr, 1u, __ATOMIC_RELAXED, __HIP_MEMORY_SCOPE_AGENT); __syncthreads(); dst = *slot; } while (0)
      const int it_end = l_hi * TB_N;
      int it; P0_GRAB(it); it += l_lo * TB_N; f32x4 xa[8], xb[8]; TItem T, Tn;
      if (it < it_end) { T = p0_resolve_big(ws, it); p0_big_load(T, F.tid, xa); }
      while (it < it_end) { int itn; P0_GRAB(itn); itn += l_lo * TB_N; const bool more = itn < it_end;
          if (more) { Tn = p0_resolve_big(ws, itn); p0_big_load(Tn, F.tid, xb); }
          p0_big_finish(T, xa, tile, F.tid);
          if (more) { T = Tn;
#pragma unroll
              for (int i = 0; i < 8; ++i) xa[i] = xb[i]; }
          it = itn; }
#undef P0_GRAB
      __syncthreads();
      if (svcu >= 0) for (int itw = l_lo * TI_N + gw; itw < l_hi * TI_N; itw += NGW) { f32x4 xw[8]; const TItem Tw = p0_resolve(ws, itw); p0_item_load(Tw, F.lane, xw); p0_item_finish(Tw, xw, scr, F.lane); }
    }
    const int gt = gw * 64 + F.lane, NGT = NGW * 64;
    { const float* gup = karg(14);
    if (svcu >= 0) for (int i = l_lo * 2 * 32 * RW + gt; i < l_hi * 2 * 32 * RW; i += NGT) { const int ch = i & 1023, r = (i >> 10) & 31, ld = i >> 15;
        ((bf16*)(ws + WS_GUP))[((size_t)ld * RW + ch) * 32 + r] = (bf16)f2bf(gup[i]); } }
    if (svcu >= 0) for (int i = l_lo * ((INA_P - INA) * DM / 8) + gt; i < l_hi * ((INA_P - INA) * DM / 8); i += NGT) { const int l = i / ((INA_P - INA) * DM / 8), r = i - l * ((INA_P - INA) * DM / 8);
        v4u z_ = {0u, 0u, 0u, 0u}; asm volatile("" : "+v"(z_));
        ((GAS v4u*)((bf16*)(ws + WS_WINA) + ((size_t)l * INA_P + INA) * DM))[r] = z_; }
    { f32x2* rt = (f32x2*)(ws + WS_ROPE);
      if (l_lo == 0 && svcu >= 0) for (int i = gt; i < TPB * 16; i += NGT) { const int tp = i >> 4, k = i & 15; f32x2 o = {1.f, 0.f};
          if (tp >= CTXL) { const int t = tp - CTXL, row = t >> 6, col = t & 63, j = k & 7; const float fr = powf(10000.0f, -(float)j / 8.0f);
              const float ang = (float)(k < 8 ? row : col) * fr; o.x = cosf(ang); o.y = sinf(ang); }
          rt[i] = o; } }
    for (int rp_ = 0; rp_ < (DBG_REPEAT == 103 ? 2 : 1); ++rp_)
    { LAS float* KEY = (LAS float*)F.lds;
      LAS float* WQT = (LAS float*)(F.lds + 65536);
      const float* pkeys = karg(29); const float* pwq = karg(28);
      __syncthreads();
      if (svcu >= 0) for (int uu = l_lo * 512 + svcu; uu < l_hi * 512; uu += sG) { const int kb = uu & 31, hp = (uu >> 5) & 15, l = uu >> 9;
          const GAS f32x4* ksrc = (const GAS f32x4*)(pkeys + ((size_t)l * 16 + hp) * 16384);
          for (int i = F.tid; i < 4096; i += 512) ((LAS f32x4*)KEY)[i] = ksrc[i];
          for (int i = F.tid; i < 2048; i += 512) { const int kk = i >> 5, d4 = i & 31;
              *(LAS f32x4*)(WQT + kk * 132 + d4 * 4) = *(const GAS f32x4*)(pwq + ((size_t)l * DM + kb * 64 + kk) * DM + hp * 128 + d4 * 4); }
          __syncthreads();
          const int kq = F.tid & 15, keyq = F.tid >> 4;
          float acc[4][4];
#pragma unroll
          for (int j = 0; j < 4; ++j)
#pragma unroll
              for (int i = 0; i < 4; ++i) acc[j][i] = 0.f;
          for (int d = 0; d < 128; d += 4) { f32x4 w[4], q[4];
#pragma unroll
              for (int i = 0; i < 4; ++i) w[i] = *(LAS f32x4*)(WQT + (kq + 16 * i) * 132 + d);
#pragma unroll
              for (int j = 0; j < 4; ++j) q[j] = *(LAS f32x4*)(KEY + (4 * keyq + j) * 128 + d);
#pragma unroll
              for (int j = 0; j < 4; ++j)
#pragma unroll
                  for (int i = 0; i < 4; ++i) acc[j][i] += q[j].x * w[i].x + q[j].y * w[i].y + q[j].z * w[i].z + q[j].w * w[i].w; }
          bf16* dst = (bf16*)(ws + WS_WQK) + ((size_t)l * DM + hp * 128 + 4 * keyq) * DM + kb * 64 + kq;
#pragma unroll
          for (int j = 0; j < 4; ++j)
#pragma unroll
              for (int i = 0; i < 4; ++i) dst[(size_t)j * DM + 16 * i] = (bf16)f2bf(acc[j][i]);
          __syncthreads(); } }
}

__device__ __forceinline__ const float* modnorm_src(int m, const float* X, const float* xin, const float* cin) {
    const int b = m / TPB, tp = m - b * TPB;
    return xin ? (tp < CTXL ? cin + ((size_t)b * CTXL + tp) * DM : xin + ((size_t)b * SEQ + (tp - CTXL)) * DM) : X + (size_t)m * DM;
}
__device__ __forceinline__ void modnorm_phase_bf(Frame& F, const bf16* X, const float* g, const float* mod  , int chunk_sh, bf16* H, int skip_ctx) {
    const int gw = F.vcu * NWAVES + F.wave, NGW = F.G * NWAVES;
    int m = gw; while (m < MALL && skip_ctx && (m % TPB) < CTXL) m += NGW;
    v4u v[4]; f32x4 ga[8], sb[8]; int mr_cur = -1;
    if (m < MALL) { const GAS v4u* xr = (const GAS v4u*)(X + (size_t)m * DM) + F.lane;
#pragma unroll
        for (int j = 0; j < 4; ++j) v[j] = xr[64 * j]; }
    while (m < MALL) {
        int mn = m + NGW; while (mn < MALL && skip_ctx && (mn % TPB) < CTXL) mn += NGW;
        v4u nv[4];
        if (mn < MALL) { const GAS v4u* xr = (const GAS v4u*)(X + (size_t)mn * DM) + F.lane;
#pragma unroll
            for (int j = 0; j < 4; ++j) nv[j] = xr[64 * j]; }
        const int b = m / TPB, tp = m - b * TPB, mr = tp < CTXL ? 2 : b;
        if (mr != mr_cur) { mr_cur = mr; const float* sh = mod + (size_t)mr * 12288 + chunk_sh * DM; const float* sc = sh + DM;
#pragma unroll
            for (int q = 0; q < 8; ++q) { const int c = (F.lane + 64 * (q >> 1)) * 8 + 4 * (q & 1); const f32x4 gg = *(const GAS f32x4*)(g + c), s1 = *(const GAS f32x4*)(sc + c); ga[q] = gg * (s1 + 1.0f); sb[q] = *(const GAS f32x4*)(sh + c); } }
        float x[4][8]; float s = 0.f;
#pragma unroll
        for (int j = 0; j < 4; ++j) { x[j][0] = bflo(v[j].x); x[j][1] = bfhi(v[j].x); x[j][2] = bflo(v[j].y); x[j][3] = bfhi(v[j].y); x[j][4] = bflo(v[j].z); x[j][5] = bfhi(v[j].z); x[j][6] = bflo(v[j].w); x[j][7] = bfhi(v[j].w);
#pragma unroll
            for (int e = 0; e < 8; ++e) s += x[j][e] * x[j][e]; }
        const float rs = rsqrtf(wave_sum(s) * (1.f / DM) + NORM_EPS);
        GAS v4u* o8 = (GAS v4u*)(H + (size_t)m * DM) + F.lane;
#pragma unroll
        for (int j = 0; j < 4; ++j) { float y[8];
#pragma unroll
            for (int e = 0; e < 8; ++e) y[e] = (x[j][e] * rs) * ga[2 * j + (e >> 2)][e & 3] + sb[2 * j + (e >> 2)][e & 3];
            v4u o; o.x = pk2(y[0], y[1]); o.y = pk2(y[2], y[3]); o.z = pk2(y[4], y[5]); o.w = pk2(y[6], y[7]); o8[64 * j] = o; }
#pragma unroll
        for (int j = 0; j < 4; ++j) v[j] = nv[j];
        m = mn;
    }
}
__device__ __forceinline__ void modnorm_phase(Frame& F, const float* X, const float* g, const float* mod  , int chunk_sh, bf16* H, int skip_ctx, const float* xin = nullptr, const float* cin = nullptr) {
    const int gw = F.vcu * NWAVES + F.wave, NGW = F.G * NWAVES;
    int m = gw; while (m < MALL && skip_ctx && (m % TPB) < CTXL) m += NGW;
    f32x4 v[8], ga[8], sb[8]; int mr_cur = -1;
    if (m < MALL) { const GAS f32x4* xr = (const GAS f32x4*)modnorm_src(m, X, xin, cin) + F.lane;
#pragma unroll
        for (int j = 0; j < 8; ++j) v[j] = xr[64 * j]; }
    while (m < MALL) {
        int mn = m + NGW; while (mn < MALL && skip_ctx && (mn % TPB) < CTXL) mn += NGW;
        f32x4 nv[8];
        if (mn < MALL) { const GAS f32x4* xr = (const GAS f32x4*)modnorm_src(mn, X, xin, cin) + F.lane;
#pragma unroll
            for (int j = 0; j < 8; ++j) nv[j] = xr[64 * j]; }
        const int b = m / TPB, tp = m - b * TPB, mr = tp < CTXL ? 2 : b;
        if (mr != mr_cur) { mr_cur = mr; const float* sh = mod + (size_t)mr * 12288 + chunk_sh * DM; const float* sc = sh + DM;
#pragma unroll
            for (int j = 0; j < 8; ++j) { const int c = (F.lane + 64 * j) * 4; const f32x4 gg = *(const GAS f32x4*)(g + c), s1 = *(const GAS f32x4*)(sc + c); ga[j] = gg * (s1 + 1.0f); sb[j] = *(const GAS f32x4*)(sh + c); } }
        float s = 0.f;
#pragma unroll
        for (int j = 0; j < 8; ++j) s += (v[j].x * v[j].x + v[j].y * v[j].y) + (v[j].z * v[j].z + v[j].w * v[j].w);
        const float rs = rsqrtf(wave_sum(s) * (1.f / DM) + NORM_EPS);
        GAS v2u* o8 = (GAS v2u*)(H + (size_t)m * DM) + F.lane;
#pragma unroll
        for (int j = 0; j < 8; ++j) { const f32x4 y = (v[j] * rs) * ga[j] + sb[j];
            v2u o; o.x = pk2(y.x, y.y); o.y = pk2(y.z, y.w); o8[64 * j] = o; }
#pragma unroll
        for (int j = 0; j < 8; ++j) v[j] = nv[j];
        m = mn;
    }
}

typedef float f32x4v __attribute__((ext_vector_type(4)));
#define MFMA16(a, b, c) __builtin_amdgcn_mfma_f32_16x16x32_bf16((a), (b), (c), 0, 0, 0)
#define MFMA32(a, b, c) __builtin_amdgcn_mfma_f32_32x32x16_bf16((a), (b), (c), 0, 0, 0)

struct FeatP {
    const bf16* PA; const float* mu; const float* w0; const float* a0; const float* k_k; const float* k_a; const float* r_k;
    const bf16* WUP; const bf16* AUP; const bf16* GUP;
    const float* qnorm; const float* kvnorm; const f32x2* rope;
    bf16* RI; bf16* GG; float* BON; bf16* QN; bf16* KVN; bf16* K;
};
__device__ __forceinline__ f32x4 ld4bf(const bf16* p) { const v2u w = *(const GAS v2u*)p; return (f32x4){bflo(w.x), bfhi(w.x), bflo(w.y), bfhi(w.y)}; }
__device__ __forceinline__ f32x4 mix4(const bf16* PA, int m, int c, bool hp, bool hn, const float* mu) {
    const f32x4 pc = ld4bf(PA + (size_t)m * INA_P + c);
    f32x4 pp = {0, 0, 0, 0}, pn = {0, 0, 0, 0};
    if (hp) pp = ld4bf(PA + (size_t)(m - 1) * INA_P + c);
    if (hn) pn = ld4bf(PA + (size_t)(m + 1) * INA_P + c);
    const f32x4 mm = *(const GAS f32x4*)(mu + c);
    return pc + ((pp + pn) * 0.5f - pc) * mm;
}
__device__ __forceinline__ void unpack8(const v4u w, float (&x)[8]) { x[0] = bflo(w.x); x[1] = bfhi(w.x); x[2] = bflo(w.y); x[3] = bfhi(w.y); x[4] = bflo(w.z); x[5] = bfhi(w.z); x[6] = bflo(w.w); x[7] = bfhi(w.w); }
__device__ __forceinline__ v4u pack8f(const float (&x)[8]) { v4u o; o.x = pk2(x[0], x[1]); o.y = pk2(x[2], x[3]); o.z = pk2(x[4], x[5]); o.w = pk2(x[6], x[7]); return o; }
__device__ __forceinline__ void mix8(const bf16* rowc, bool hp, bool hn, const float (&mu)[8], float (&o)[8]) {
    const v4u zc = {0u, 0u, 0u, 0u};
    const v4u wc = *(const GAS v4u*)rowc, wp = hp ? *(const GAS v4u*)(rowc - INA_P) : zc, wn = hn ? *(const GAS v4u*)(rowc + INA_P) : zc;
    float c[8], p[8], n[8]; unpack8(wc, c); unpack8(wp, p); unpack8(wn, n);
#pragma unroll
    for (int e = 0; e < 8; ++e) o[e] = c[e] + (0.5f * (p[e] + n[e]) - c[e]) * mu[e];
}
struct Raw3 { v4u c, p, n; };
__device__ __forceinline__ Raw3 load3(const bf16* rowc, bool hp, bool hn) { const v4u zc = {0u, 0u, 0u, 0u}; Raw3 r; r.c = *(const GAS v4u*)rowc; r.p = hp ? *(const GAS v4u*)(rowc - INA_P) : zc; r.n = hn ? *(const GAS v4u*)(rowc + INA_P) : zc; return r; }
__device__ __forceinline__ void mix8r(const Raw3& w, const float (&mu)[8], float (&o)[8]) {
    float c[8], p[8], n[8]; unpack8(w.c, c); unpack8(w.p, p); unpack8(w.n, n);
#pragma unroll
    for (int e = 0; e < 8; ++e) o[e] = c[e] + (0.5f * (p[e] + n[e]) - c[e]) * mu[e];
}
__device__ __forceinline__ void features_phase(Frame& F, const FeatP& P) {
    constexpr int LAP = 328;
    LAS bf16* LA = (LAS bf16*)F.lds;
    LAS float* SSQ = (LAS float*)(F.lds + 10752);
    LAS float* PRM = (LAS float*)(F.lds + 12288);
    const int lane = F.lane, w = F.wave, tk = lane & 15, q4 = lane >> 4;
    constexpr int NTILE = MALL / 16, NTG = 64;
    for (int su = F.vcu; su < 4 * NTG; su += F.G) {
        const int cg = su & 3, tg = su >> 2, cw = 256 * cg + 32 * w, ch8 = cw + 8 * q4, hd = 4 * cg + (w >> 1);
        __syncthreads();
        for (int i = F.tid; i < 2560; i += 512) { const int prm = i >> 8, c = (i & 255) + 256 * cg; float v;
            switch (prm) { case 0: v = P.k_k[c]; break; case 1: v = P.k_a[c]; break; case 2: v = P.r_k[c]; break; case 3: v = P.w0[c]; break; case 4: v = P.w0[RW + c]; break;
                           case 5: v = P.a0[c]; break; case 6: v = P.a0[RW + c]; break; case 7: v = P.mu[c]; break; case 8: v = P.mu[RW + c]; break; default: v = P.mu[2 * RW + c]; break; }
            PRM[i] = v; }
        bf16x8 fw[2][2][2], fa[2][2][2], fg[2][2];
        { const int chA = cw + 8 * (tk >> 2) + (tk & 3);
#pragma unroll
          for (int d = 0; d < 2; ++d)
#pragma unroll
              for (int t = 0; t < 2; ++t) {
#pragma unroll
                  for (int ks = 0; ks < 2; ++ks) { fw[d][t][ks] = *(const GAS bf16x8*)(P.WUP + ((size_t)d * RW + chA + 4 * t) * 64 + ks * 32 + q4 * 8); fa[d][t][ks] = *(const GAS bf16x8*)(P.AUP + ((size_t)d * RW + chA + 4 * t) * 64 + ks * 32 + q4 * 8); }
                  fg[d][t] = *(const GAS bf16x8*)(P.GUP + ((size_t)d * RW + chA + 4 * t) * 32 + q4 * 8); } }
        for (int tt = tg; tt < NTILE; tt += NTG) {
            const int m0 = tt * 16;
            const int m = m0 + tk, b = m / TPB, tp = m - b * TPB;
            const bool hp = (tp != 0) && (tp != CTXL), hn = (tp != CTXL - 1) && (tp != TPB - 1);
            const bf16* rowp = P.PA + (size_t)m * INA_P + ch8;
            const Raw3 rawk = load3(rowp + RW, hp, hn), rawr = load3(rowp, hp, hn), rawv = load3(rowp + 2 * RW, hp, hn);
            LDS_BARRIER();
            for (int it = F.tid; it < 640; it += 512) { const int tkk = it / 40, c8 = (it - tkk * 40) * 8, c = C_WD + c8, m = m0 + tkk, tp = m % TPB;
                const bool hp = (tp != 0) && (tp != CTXL), hn = (tp != CTXL - 1) && (tp != TPB - 1);
                float mu[8], v[8];
                { const f32x4 a = *(const GAS f32x4*)(P.mu + c), b2 = *(const GAS f32x4*)(P.mu + c + 4); mu[0] = a.x; mu[1] = a.y; mu[2] = a.z; mu[3] = a.w; mu[4] = b2.x; mu[5] = b2.y; mu[6] = b2.z; mu[7] = b2.w; }
                mix8(P.PA + (size_t)m * INA_P + c, hp, hn, mu, v);
#pragma unroll
                for (int e = 0; e < 8; ++e) { if (c < C_AD) v[e] = 1.0f - 2.0f * __builtin_amdgcn_rcpf(1.0f + __expf(2.0f * v[e])); else if (c >= C_GD) v[e] = sigmoidf_(v[e]); }
                *(LAS v4u*)(LA + tkk * LAP + c8) = pack8f(v); }
            if ((tt & 3) == cg) {
#pragma unroll
                for (int t2 = 0; t2 < 2; ++t2) { const int m = m0 + 2 * w + t2, b = m / TPB, tp = m - b * TPB; const bf16* row = P.PA + (size_t)m * INA_P;
                    { float x[8]; unpack8(*(const GAS v4u*)(row + C_QC + lane * 8), x); float s = 0.f;
#pragma unroll
                      for (int e = 0; e < 8; ++e) s += x[e] * x[e];
                      const float rs = rsqrtf(wave_sum(s) * (1.f / 512.f) + NORM_EPS);
#pragma unroll
                      for (int e = 0; e < 8; ++e) x[e] = x[e] * rs * P.qnorm[lane * 8 + e];
                      *(GAS v4u*)(P.QN + (size_t)m * 512 + lane * 8) = pack8f(x); }
                    { const v2u q = *(const GAS v2u*)(row + C_KVC + lane * 4);
                      float x[4] = {bflo(q.x), bfhi(q.x), bflo(q.y), bfhi(q.y)}; float s = 0.f;
#pragma unroll
                      for (int e = 0; e < 4; ++e) s += x[e] * x[e];
                      const float rs = rsqrtf(wave_sum(s) * (1.f / 256.f) + NORM_EPS);
#pragma unroll
                      for (int e = 0; e < 4; ++e) x[e] = x[e] * rs * P.kvnorm[lane * 4 + e];
                      v2u o; o.x = pk2(x[0], x[1]); o.y = pk2(x[2], x[3]);
                      *(GAS v2u*)(P.KVN + (size_t)m * 256 + lane * 4) = o; }
                    if (lane < 16) { const float x1 = bf1(row[C_KR + lane]), x2 = bf1(row[C_KR + 16 + lane]); const f32x2 cs = P.rope[(size_t)tp * 16 + lane];
                        const unsigned o = pk2(x1 * cs.x - x2 * cs.y, x1 * cs.y + x2 * cs.x);
#pragma unroll
                        for (int h2 = 0; h2 < NH; ++h2) *(GAS unsigned*)(P.K + ((size_t)(b * NH + h2) * TPB + tp) * QKD + 64 + 2 * lane) = o; } } }
            const int pc = 32 * w + 8 * q4;
            float prm[8], kmx[8], kx[8];
#pragma unroll
            for (int e = 0; e < 8; ++e) prm[e] = PRM[8 * 256 + pc + e];
            mix8r(rawk, prm, kmx);
            { float s = 0.f;
#pragma unroll
              for (int e = 0; e < 8; ++e) { kx[e] = kmx[e] * PRM[0 * 256 + pc + e]; s += kx[e] * kx[e]; }
              s += bpermf(lane ^ 16, s); s += bpermf(lane ^ 32, s);
              if (q4 == 0) SSQ[tk * 8 + w] = s; }
            __syncthreads();
            const float rsn = rsqrtf(SSQ[tk * 8 + w] + SSQ[tk * 8 + (w ^ 1)] + 1e-12f);
            f32x4 cw_[2][2], ca_[2][2], cg_[2][2];
#pragma unroll
            for (int d = 0; d < 2; ++d) {
                const bf16x8 bg = *(const LAS bf16x8*)(LA + tk * LAP + 256 + d * 32 + q4 * 8);
                bf16x8 bw[2], ba[2];
#pragma unroll
                for (int ks = 0; ks < 2; ++ks) { bw[ks] = *(const LAS bf16x8*)(LA + tk * LAP + d * 64 + ks * 32 + q4 * 8); ba[ks] = *(const LAS bf16x8*)(LA + tk * LAP + 128 + d * 64 + ks * 32 + q4 * 8); }
#pragma unroll
                for (int t = 0; t < 2; ++t) { f32x4 z = {0, 0, 0, 0};
                    cw_[d][t] = MFMA16(fw[d][t][1], bw[1], MFMA16(fw[d][t][0], bw[0], z));
                    ca_[d][t] = MFMA16(fa[d][t][1], ba[1], MFMA16(fa[d][t][0], ba[0], z));
                    cg_[d][t] = MFMA16(fg[d][t], bg, z); } }
            float r8[8], v8[8], kk8[8];
#pragma unroll
            for (int e = 0; e < 8; ++e) prm[e] = PRM[7 * 256 + pc + e];
            mix8r(rawr, prm, r8);
#pragma unroll
            for (int e = 0; e < 8; ++e) prm[e] = PRM[9 * 256 + pc + e];
            mix8r(rawv, prm, v8);
#pragma unroll
            for (int e = 0; e < 8; ++e) kk8[e] = kx[e] * rsn;
            bf16* rec = P.RI + ((size_t)(b * NH + hd) * TPB + tp) * RREC + (ch8 & 63);
            *(GAS v4u*)(rec) = pack8f(r8); *(GAS v4u*)(rec + 64) = pack8f(kk8); *(GAS v4u*)(rec + 128) = pack8f(v8);
#pragma unroll
            for (int d = 0; d < 2; ++d) {
                float ld[8], ke[8], bb[8], gg[8]; float bs = 0.f;
#pragma unroll
                for (int e = 0; e < 8; ++e) { const int t = e >> 2, r = e & 3;
                    ld[e] = -0.60653066f * sigmoidf_(PRM[(3 + d) * 256 + pc + e] + cw_[d][t][r]);
                    const float aa = sigmoidf_(PRM[(5 + d) * 256 + pc + e] + ca_[d][t][r]);
                    ke[e] = kmx[e] * (1.0f + (aa - 1.0f) * PRM[1 * 256 + pc + e]); bb[e] = kk8[e] * aa; gg[e] = cg_[d][t][r];
                    bs += r8[e] * ke[e] * PRM[2 * 256 + pc + e]; }
                *(GAS v4u*)(rec + (3 + 3 * d) * 64) = pack8f(ld); *(GAS v4u*)(rec + (4 + 3 * d) * 64) = pack8f(bb); *(GAS v4u*)(rec + (5 + 3 * d) * 64) = pack8f(ke);
                *(GAS v4u*)(P.GG + ((size_t)d * MALL + m) * RW + ch8) = pack8f(gg);
                bs += bpermf(lane ^ 16, bs); bs += bpermf(lane ^ 32, bs);
                if (q4 == 0) P.BON[((size_t)d * MALL + m) * 32 + 2 * hd + (w & 1)] = bs; }
        }
    }
}

__device__ __forceinline__ void cvt_row_load(f32x4 (&x)[8], const float* src) {
#pragma unroll
    for (int q = 0; q < 8; ++q) x[q] = *(const GAS f32x4*)(src + q * 4);
}
__device__ __forceinline__ void cvt_row_store(const f32x4 (&x)[8], unsigned char* dst, float* scale_slot, int lane) {
    float am = 0.f;
#pragma unroll
    for (int q = 0; q < 8; ++q) am = fmaxf(am, fmaxf(fmaxf(fabsf(x[q].x), fabsf(x[q].y)), fmaxf(fabsf(x[q].z), fabsf(x[q].w))));
    am = fmaxf(wave_max_u(am), 1e-30f);
    const float g = 6.0f / am, inv = am * (1.0f / 6.0f);
    v4u o;
#pragma unroll
    for (int q = 0; q < 4; ++q) { unsigned w = 0u;
        w = __builtin_amdgcn_cvt_scalef32_pk_fp4_f32(w, x[2 * q].x * g, x[2 * q].y * g, 1.0f, 0);
        w = __builtin_amdgcn_cvt_scalef32_pk_fp4_f32(w, x[2 * q].z * g, x[2 * q].w * g, 1.0f, 1);
        w = __builtin_amdgcn_cvt_scalef32_pk_fp4_f32(w, x[2 * q + 1].x * g, x[2 * q + 1].y * g, 1.0f, 2);
        w = __builtin_amdgcn_cvt_scalef32_pk_fp4_f32(w, x[2 * q + 1].z * g, x[2 * q + 1].w * g, 1.0f, 3);
        o[q] = w; }
    *(GAS v4u*)dst = o;
    if (lane == 0) *scale_slot = inv;
}
struct ScanCvt { const float* pu; const float* pv; unsigned char* PU8; unsigned char* PV8; float* SU; float* SV; int wl; };
constexpr int SCH = 32;
constexpr int SSTEP = 6 * 64;
__device__ __forceinline__ int scan_tp(int dir, int s) { return dir == 0 ? s : (s < CTXL ? (CTXL - 1 - s) : (TPB - 1 - (s - CTXL))); }
__device__ __forceinline__ void scan_load(v4u (&rg)[6], const bf16* RIh, int dir, int chunk, int htid) {
    const int tp = scan_tp(dir, chunk * SCH + (htid >> 3));
    const bf16* rec = RIh + (size_t)tp * RREC + (htid & 7) * 8;
#pragma unroll
    for (int i = 0; i < 3; ++i) rg[i] = *(const GAS v4u*)(rec + i * 64);
    rec += (3 + 3 * dir) * 64;
#pragma unroll
    for (int i = 0; i < 3; ++i) rg[3 + i] = *(const GAS v4u*)(rec + i * 64);
}
__device__ __forceinline__ void scan_store(const v4u (&rg)[6], LAS float* buf, int htid) {
    LAS float* d0 = buf + (htid >> 3) * SSTEP + (htid & 7) * 8;
#pragma unroll
    for (int i = 0; i < 6; ++i) { constexpr int SLOT[6] = {4, 0, 5, 2, 1, 3};
        const v4u wv = rg[i];
        f32x4 lo = {bflo(wv.x), bfhi(wv.x), bflo(wv.y), bfhi(wv.y)}, hi = {bflo(wv.z), bfhi(wv.z), bflo(wv.w), bfhi(wv.w)};
        if (i == 3) {
#pragma unroll
            for (int e = 0; e < 4; ++e) { lo[e] = __expf(lo[e]); hi[e] = __expf(hi[e]); } }
        LAS float* d = d0 + SLOT[i] * 64;
        *(LAS f32x4*)d = lo; *(LAS f32x4*)(d + 4) = hi; }
}
__device__ __forceinline__ void scan_phase(Frame& F, const bf16* RI, bf16* Y, const ScanCvt& C) {
    LAS float* bufs = (LAS float*)F.lds;
    constexpr int NCH = TPB / SCH;
    for (int uu = F.vcu; uu < NBATCH * NH * 2 * 4; uu += F.G) {
        const int rg = uu & 3, dir = (uu >> 2) & 1, hd = (uu >> 3) & 15, b = uu >> 7;
        const bf16* RIh = RI + (size_t)(b * NH + hd) * TPB * RREC;
        const int htid = F.tid - 256;
        v4u ra[6], rb[6];
        f32x4 xw[8];
        LAS float* wscr = (LAS float*)(F.lds + (((F.wave & 3) == 3) ? LDSCTL_OFF + 4096 : 98304 + (F.wave & 3) * 8448));
        f32x4 xc[8];
        __syncthreads();
        if (F.wave >= 4) { scan_load(rb, RIh, dir, 0, htid); scan_load(ra, RIh, dir, 1, htid); scan_store(rb, bufs, htid); scan_load(rb, RIh, dir, 2, htid); }
        __syncthreads();
        const int j = F.lane & 15, rowl = F.lane >> 4, row = rg * 16 + (F.wave & 3) * 4 + rowl;
        f32x2 S01 = {0.f, 0.f}, S23 = {0.f, 0.f};
        bf16* yb = Y + ((size_t)dir * MALL + (size_t)b * TPB) * RW + hd * 64 + row;
        for (int c = 0; c < NCH; ++c) {
            LAS float* cur = bufs + (c & 1) * (SCH * SSTEP);
            if (F.wave >= 4) {
                if (c + 1 < NCH) {
                    if ((c & 1) == 0) { scan_store(ra, bufs + (SCH * SSTEP), htid); if (c + 3 < NCH) scan_load(ra, RIh, dir, c + 3, htid); }
                    else { scan_store(rb, bufs, htid); if (c + 3 < NCH) scan_load(rb, RIh, dir, c + 3, htid); }  }
                if (C.wl >= 0 && (c & 3) == 2) { const int wi = uu * 4 + (F.wave - 4) + 1024 * (c >> 3);
                    if (wi < NW_ITEMS) { const TItem Tw = p0_resolve_wave(F.ws, C.wl, wi); if ((c & 7) == 2) p0_item_load(Tw, F.lane, xw); else p0_item_finish(Tw, xw, wscr, F.lane); } }
                if ((c & 3) == 0 && (c >> 3) < 32) { const int r = uu * 4 + (F.wave - 4) + 1024 * (c >> 3);
                    if ((c & 7) == 0) cvt_row_load(xc, ((r >= NEXP) ? C.pv + (size_t)(r - NEXP) * DM : C.pu + (size_t)r * DM) + F.lane * 32);
                    else cvt_row_store(xc, ((r >= NEXP) ? C.PV8 + (size_t)(r - NEXP) * (DM / 2) : C.PU8 + (size_t)r * (DM / 2)) + F.lane * 16, (r >= NEXP) ? C.SV + (r - NEXP) : C.SU + r, F.lane); } }
            else {
#pragma unroll
                for (int h16 = 0; h16 < 2; ++h16) {
                    const LAS float* sp = cur + (h16 * 16) * SSTEP;
                    f32x4 kk = *(const LAS f32x4*)(sp + 4 * j), bb = *(const LAS f32x4*)(sp + 64 + 4 * j), ww = *(const LAS f32x4*)(sp + 128 + 4 * j),
                          ke = *(const LAS f32x4*)(sp + 192 + 4 * j), rr = *(const LAS f32x4*)(sp + 256 + 4 * j);
                    float ykeep = 0.f, ypart; f32x2 u2, t2, vv; vv.x = sp[320 + row];
#define SCAN_DPP(r, ctl) "v_add_f32_dpp " r ", " r ", " r " " ctl " row_mask:0xf bank_mask:0xf bound_ctrl:1\n\t"
#define SCAN_MAIN(SEL) asm volatile( \
                        "v_pk_mul_f32 v[242:243], %[kexy], %[vv] op_sel_hi:[1,0]\n\t" \
                        "v_add_f32 v246, v250, v251\n\t" \
                        "v_add_f32_dpp v248, %[yp], %[yp] quad_perm:[1,0,3,2] row_mask:0xf bank_mask:0xf bound_ctrl:1\n\t" \
                        "v_pk_mul_f32 v[244:245], %[kezw], %[vv] op_sel_hi:[1,0]\n\t" \
                        SCAN_DPP("v246", "quad_perm:[1,0,3,2]") SCAN_DPP("v248", "quad_perm:[2,3,0,1]") \
                        "v_pk_fma_f32 %[s01], %[s01], %[wwxy], v[242:243]\n\t" \
                        SCAN_DPP("v246", "quad_perm:[2,3,0,1]") SCAN_DPP("v248", "row_half_mirror") \
                        "v_pk_fma_f32 %[s23], %[s23], %[wwzw], v[244:245]\n\t" \
                        SCAN_DPP("v246", "row_half_mirror") SCAN_DPP("v248", "row_mirror") \
                        SEL "\n\t" \
                        SCAN_DPP("v246", "row_mirror") \
                        "v_pk_fma_f32 %[s01], %[bbxy], v[246:247], %[s01] op_sel_hi:[1,0,1] neg_lo:[0,1,0] neg_hi:[0,1,0]\n\t" \
                        "v_pk_fma_f32 %[s23], %[bbzw], v[246:247], %[s23] op_sel_hi:[1,0,1] neg_lo:[0,1,0] neg_hi:[0,1,0]\n\t" \
                        "v_pk_mul_f32 v[252:253], %[s01], %[rrxy]" \
                        : [s01] "+v"(S01), [s23] "+v"(S23), [yk] "+v"(ykeep), "={v[252:253]}"(u2) \
                        : [kexy] "v"(ke.xy), [kezw] "v"(ke.zw), [vv] "v"(vv), [wwxy] "v"(ww.xy), [wwzw] "v"(ww.zw), [bbxy] "v"(bb.xy), [bbzw] "v"(bb.zw), [rrxy] "v"(rr.xy), [yp] "v"(ypart), [msk] "s"(msk), "{v[250:251]}"(t2) \
                        : "v242", "v243", "v244", "v245", "v246", "v247", "v248")
                    asm volatile("v_pk_mul_f32 v[250:251], %[s01], %[kxy]\n\tv_mov_b32 %[yp], 0\n\tv_pk_fma_f32 v[250:251], %[s23], %[kzw], v[250:251]"
                                 : "=&{v[250:251]}"(t2), [yp] "=&v"(ypart) : [s01] "v"(S01), [s23] "v"(S23), [kxy] "v"(kk.xy), [kzw] "v"(kk.zw));
#pragma unroll
                    for (int st = 0; st < 16; ++st) {
                        f32x4 nkk = kk, nbb = bb, nww = ww, nke = ke, nrr = rr; f32x2 nvv = vv;
                        const LAS float* sn = sp + (st + 1) * SSTEP;
                        if (st + 1 < 16) { nkk = *(const LAS f32x4*)(sn + 4 * j); nke = *(const LAS f32x4*)(sn + 192 + 4 * j); nvv.x = sn[320 + row]; nww = *(const LAS f32x4*)(sn + 128 + 4 * j); nbb = *(const LAS f32x4*)(sn + 64 + 4 * j);
                            nrr = *(const LAS f32x4*)(sn + 256 + 4 * j); }
                        const unsigned long long msk = 0x0001000100010001ull << ((st + 15) & 15);
                        if (st > 0) SCAN_MAIN("v_cndmask_b32_e64 %[yk], %[yk], v248, %[msk]"); else SCAN_MAIN("s_nop 0");
                        if (st + 1 < 16)
                            asm volatile("v_pk_mul_f32 v[250:251], %[s01], %[kxy]\n\tv_pk_fma_f32 v[252:253], %[s23], %[rrzw], v[252:253]\n\tv_pk_fma_f32 v[250:251], %[s23], %[kzw], v[250:251]\n\tv_add_f32 %[yp], v252, v253"
                                         : "=&{v[250:251]}"(t2), "={v[252:253]}"(u2), [yp] "=&v"(ypart) : [s01] "v"(S01), [s23] "v"(S23), [kxy] "v"(nkk.xy), [kzw] "v"(nkk.zw), [rrzw] "v"(rr.zw), "1"(u2));
                        else
                            asm volatile("s_nop 0\n\tv_pk_fma_f32 v[252:253], %[s23], %[rrzw], v[252:253]" : "={v[252:253]}"(u2) : [s23] "v"(S23), [rrzw] "v"(rr.zw), "0"(u2));
                        kk = nkk; bb = nbb; ww = nww; ke = nke; rr = nrr; vv = nvv;
                        __builtin_amdgcn_sched_barrier(0);
                    }
#undef SCAN_MAIN
#undef SCAN_DPP
                    { const float y = red16(u2.x + u2.y); ykeep = (j == 15) ? y : ykeep; }
                    const int tp = scan_tp(dir, c * SCH + h16 * 16 + j);
                    *(GAS bf16*)(yb + (size_t)tp * RW) = (bf16)f2bf(ykeep);
                }
            }
            __syncthreads();
        }
    }
}

constexpr int AKP = 208, AVP = 192;
constexpr int ATILE = 64 * AKP + 64 * AVP;
__device__ __forceinline__ bf16x8 pack8(const f32x16& x, int s) {
    v4u p; p.x = pk2(x[8 * s + 0], x[8 * s + 1]); p.y = pk2(x[8 * s + 2], x[8 * s + 3]); p.z = pk2(x[8 * s + 4], x[8 * s + 5]); p.w = pk2(x[8 * s + 6], x[8 * s + 7]);
    return __builtin_bit_cast(bf16x8, p);
}
__device__ __forceinline__ void attn_phase(Frame& F, const bf16* Q, const bf16* K, const bf16* V, bf16* YB, int with_ctx) {
    const int lane = F.lane, half = lane >> 5, l31 = lane & 31, l16 = lane & 15, g1 = (lane >> 4) & 1;
    const int nunits = NBATCH * NH * 32 + (with_ctx ? NBATCH * NH : 0);
    for (int uu = F.vcu; uu < nunits; uu += F.G) {
        int bh, q0, nkt;
        if (uu < NBATCH * NH * 32) { bh = uu >> 5; q0 = CTXL + (uu & 31) * 256; nkt = TPB / 64; } else { bh = uu - NBATCH * NH * 32; q0 = 0; nkt = CTXL / 64; }
        const bf16* Kh = K + (size_t)bh * TPB * QKD; const bf16* Vh = V + (size_t)bh * TPB * 64; const bf16* Qh = Q + (size_t)bh * TPB * QKD;
        const int tq = q0 + F.wave * 32 + l31;
        bf16x8 qf[6];
#pragma unroll
        for (int ks = 0; ks < 6; ++ks) qf[ks] = *(const GAS bf16x8*)(Qh + (size_t)tq * QKD + 16 * ks + 8 * half);
        f32x16 o0, o1;
#pragma unroll
        for (int i = 0; i < 16; ++i) { o0[i] = 0.f; o1[i] = 0.f; }
        float l_run = 0.f;
        f32x16 cinit;
#pragma unroll
        for (int i = 0; i < 16; ++i) cinit[i] = 0.f;
        asm volatile("" : "+v"(cinit));
        const int kc1 = F.tid + 512; const bool k1ok = kc1 < 768;
        const unsigned kd0 = (unsigned)((F.tid / 12) * AKP + (F.tid % 12) * 16), kd1 = (unsigned)((kc1 / 12) * AKP + (kc1 % 12) * 16), vd = (unsigned)(64 * AKP + (F.tid >> 3) * AVP + (F.tid & 7) * 16);
        v4u kr0, kr1 = {0, 0, 0, 0}, vr;
        kr0 = *(const GAS v4u*)(Kh + (size_t)F.tid * 8); if (k1ok) kr1 = *(const GAS v4u*)(Kh + (size_t)kc1 * 8); vr = *(const GAS v4u*)(Vh + (size_t)F.tid * 8);
        __syncthreads();
        *(LAS v4u*)(F.lds + kd0) = kr0; if (k1ok) *(LAS v4u*)(F.lds + kd1) = kr1; *(LAS v4u*)(F.lds + vd) = vr;
        if (nkt > 1) { const bf16* kn = Kh + (size_t)64 * QKD; const bf16* vn = Vh + (size_t)64 * 64;
            kr0 = *(const GAS v4u*)(kn + (size_t)F.tid * 8); if (k1ok) kr1 = *(const GAS v4u*)(kn + (size_t)kc1 * 8); vr = *(const GAS v4u*)(vn + (size_t)F.tid * 8);
            *(LAS v4u*)(F.lds + ATILE + kd0) = kr0; if (k1ok) *(LAS v4u*)(F.lds + ATILE + kd1) = kr1; *(LAS v4u*)(F.lds + ATILE + vd) = vr; }
        __syncthreads();
        bf16x8 ka[6], kb2[6];
#pragma unroll
        for (int ks = 0; ks < 6; ++ks) { ka[ks] = *(const LAS bf16x8*)(F.lds + l31 * AKP + (16 * ks + 8 * half) * 2); kb2[ks] = *(const LAS bf16x8*)(F.lds + (32 + l31) * AKP + (16 * ks + 8 * half) * 2); }
        int bc = 0, bn = ATILE, bw = 2 * ATILE;
        for (int kt = 0; kt < nkt; ++kt) {
            const bool more = kt + 1 < nkt, more2 = kt + 2 < nkt;
            if (more2) { const bf16* kn = Kh + (size_t)(kt + 2) * 64 * QKD; const bf16* vn = Vh + (size_t)(kt + 2) * 64 * 64;
                kr0 = *(const GAS v4u*)(kn + (size_t)F.tid * 8); if (k1ok) kr1 = *(const GAS v4u*)(kn + (size_t)kc1 * 8); vr = *(const GAS v4u*)(vn + (size_t)F.tid * 8); }
            LAS unsigned char* Kb = F.lds + bc; LAS unsigned char* Vb = Kb + 64 * AKP;
            f32x16 s0, s1;
            { s0 = MFMA32(ka[0], qf[0], cinit);
#pragma unroll
              for (int ks = 1; ks < 6; ++ks) s0 = MFMA32(ka[ks], qf[ks], s0);
              s1 = MFMA32(kb2[0], qf[0], cinit);
#pragma unroll
              for (int ks = 1; ks < 6; ++ks) s1 = MFMA32(kb2[ks], qf[ks], s1);
              __builtin_amdgcn_sched_group_barrier(0x8, 12, 0); }
            bf16x8 va[2][2][2];
#pragma unroll
            for (int t = 0; t < 2; ++t)
#pragma unroll
                for (int s = 0; s < 2; ++s) { const int kb = 32 * t + 16 * s + 4 * half + (l16 >> 2);
#pragma unroll
                    for (int dvt = 0; dvt < 2; ++dvt) { const LAS unsigned char* vp = Vb + kb * AVP + (32 * dvt + 16 * g1 + 4 * (l16 & 3)) * 2;
                        const s16x4 lo = __builtin_amdgcn_ds_read_tr16_b64_v4i16((LAS s16x4*)vp), hi = __builtin_amdgcn_ds_read_tr16_b64_v4i16((LAS s16x4*)(vp + 8 * AVP));
                        va[t][s][dvt] = __builtin_shufflevector(lo, hi, 0, 1, 2, 3, 4, 5, 6, 7); } }
            __builtin_amdgcn_sched_group_barrier(0x100, 16, 0);
            if (more) { const LAS unsigned char* Kn = F.lds + bn;
#pragma unroll
                for (int ks = 0; ks < 6; ++ks) { ka[ks] = *(const LAS bf16x8*)(Kn + l31 * AKP + (16 * ks + 8 * half) * 2); kb2[ks] = *(const LAS bf16x8*)(Kn + (32 + l31) * AKP + (16 * ks + 8 * half) * 2); } }
            float mx = s0[0];
#pragma unroll
            for (int i = 1; i < 16; ++i) mx = fmaxf(mx, s0[i]);
#pragma unroll
            for (int i = 0; i < 16; ++i) mx = fmaxf(mx, s1[i]);
            if (kt == 0 || __any(mx > 8.0f)) {
                mx = fmaxf(mx, bpermf(lane ^ 32, mx));
                const float d = (kt == 0) ? mx : fmaxf(mx, 0.f), alpha = (kt == 0) ? 1.0f : __builtin_amdgcn_exp2f(-d);
                l_run *= alpha;
#pragma unroll
                for (int i = 0; i < 16; ++i) { o0[i] *= alpha; o1[i] *= alpha; s0[i] -= d; s1[i] -= d; cinit[i] -= d; }
                asm volatile("" : "+v"(cinit));
            }
#pragma unroll
            for (int i = 0; i < 16; ++i) { s0[i] = __builtin_amdgcn_exp2f(s0[i]); s1[i] = __builtin_amdgcn_exp2f(s1[i]); }
            float ps = 0.f;
#pragma unroll
            for (int i = 0; i < 16; ++i) ps += s0[i] + s1[i];
            l_run += ps;
            { bf16x8 pf[2][2];
#pragma unroll
              for (int t = 0; t < 2; ++t)
#pragma unroll
                  for (int s = 0; s < 2; ++s) pf[t][s] = pack8(t == 0 ? s0 : s1, s);
#pragma unroll
              for (int t = 0; t < 2; ++t)
#pragma unroll
                  for (int s = 0; s < 2; ++s) { o0 = MFMA32(va[t][s][0], pf[t][s], o0); o1 = MFMA32(va[t][s][1], pf[t][s], o1); } }
            if (more2) { LAS unsigned char* nb = F.lds + bw;
                *(LAS v4u*)(nb + kd0) = kr0; if (k1ok) *(LAS v4u*)(nb + kd1) = kr1; *(LAS v4u*)(nb + vd) = vr; }
            __syncthreads();
            { const int t_ = bc; bc = bn; bn = bw; bw = t_; }
        }
        const float linv = (DBG_SKIP & 4) ? 0.f : 1.0f / (l_run + bpermf(lane ^ 32, l_run));
        const int b = bh >> 4, hd = bh & 15;
        bf16* op = YB + ((size_t)b * TPB + tq) * RW + hd * 64 + 4 * half;
#pragma unroll
        for (int g = 0; g < 4; ++g) {
            v2u w; w.x = pk2(o0[4 * g] * linv, o0[4 * g + 1] * linv); w.y = pk2(o0[4 * g + 2] * linv, o0[4 * g + 3] * linv); *(GAS v2u*)(op + 8 * g) = w;
            w.x = pk2(o1[4 * g] * linv, o1[4 * g + 1] * linv); w.y = pk2(o1[4 * g + 2] * linv, o1[4 * g + 3] * linv); *(GAS v2u*)(op + 32 + 8 * g) = w; }
    }
}

struct RoRaw { v4u va, vc, ya[2], yc[2], ga[2], gc[2]; float b0[2], b1[2]; };
__device__ __forceinline__ void readout_load(RoRaw& r, int m, int lane, const bf16* Y, const bf16* GG, const float* BON, const bf16* RI) {
    const int hd = lane >> 2, ch0 = hd * 64 + (lane & 3) * 16, b = m / TPB, tp = m - b * TPB;
    const bf16* rec = RI + ((size_t)(b * NH + hd) * TPB + tp) * RREC + 128 + (lane & 3) * 16;
    r.va = *(const GAS v4u*)rec; r.vc = *(const GAS v4u*)(rec + 8);
#pragma unroll
    for (int d = 0; d < 2; ++d) { const bf16* yp = Y + ((size_t)d * MALL + m) * RW + ch0; const bf16* gp = GG + ((size_t)d * MALL + m) * RW + ch0;
        r.ya[d] = *(const GAS v4u*)yp; r.yc[d] = *(const GAS v4u*)(yp + 8); r.ga[d] = *(const GAS v4u*)gp; r.gc[d] = *(const GAS v4u*)(gp + 8);
        r.b0[d] = BON[((size_t)d * MALL + m) * 32 + 2 * hd]; r.b1[d] = BON[((size_t)d * MALL + m) * 32 + 2 * hd + 1]; }
}
__device__ __forceinline__ void readout_phase(Frame& F, const bf16* Y, const bf16* GG, const float* BON, const bf16* RI, const float* ln_w, const float* ln_b, bf16* YA) {
    const int gw = F.vcu * NWAVES + F.wave, NGW = F.G * NWAVES, lane = F.lane, hd = lane >> 2, ch0 = hd * 64 + (lane & 3) * 16;
    RoRaw cur, nxt;
    if (gw < MALL) readout_load(cur, gw, lane, Y, GG, BON, RI);
    for (int m = gw; m < MALL; m += NGW) {
        if (m + NGW < MALL) readout_load(nxt, m + NGW, lane, Y, GG, BON, RI);
        float vv[16], out[16];
        unpack8(cur.va, *(float(*)[8])&vv[0]); unpack8(cur.vc, *(float(*)[8])&vv[8]);
#pragma unroll
        for (int e = 0; e < 16; ++e) out[e] = 0.f;
#pragma unroll
        for (int d = 0; d < 2; ++d) {
            float y[16], g[16];
            unpack8(cur.ya[d], *(float(*)[8])&y[0]); unpack8(cur.yc[d], *(float(*)[8])&y[8]); unpack8(cur.ga[d], *(float(*)[8])&g[0]); unpack8(cur.gc[d], *(float(*)[8])&g[8]);
            float s = 0.f;
#pragma unroll
            for (int e = 0; e < 16; ++e) s += y[e];
            s = dpp_add<0xB1>(s); s = dpp_add<0x4E>(s);
            const float mean = s * (1.f / 64.f); float q = 0.f;
#pragma unroll
            for (int e = 0; e < 16; ++e) { y[e] -= mean; q += y[e] * y[e]; }
            q = dpp_add<0xB1>(q); q = dpp_add<0x4E>(q);
            const float rstd = rsqrtf(q * (1.f / 64.f) + 64e-5f), bon = cur.b0[d] + cur.b1[d];
#pragma unroll
            for (int e = 0; e < 16; ++e) out[e] += (y[e] * rstd * ln_w[ch0 + e] + ln_b[ch0 + e] + bon * vv[e]) * g[e];
        }
        if (DBG_SKIP & 2) {
#pragma unroll
            for (int e = 0; e < 16; ++e) out[e] = 0.f; }
        v4u o0, o1;
        o0.x = pk2(out[0], out[1]); o0.y = pk2(out[2], out[3]); o0.z = pk2(out[4], out[5]); o0.w = pk2(out[6], out[7]);
        o1.x = pk2(out[8], out[9]); o1.y = pk2(out[10], out[11]); o1.z = pk2(out[12], out[13]); o1.w = pk2(out[14], out[15]);
        *(GAS v4u*)(YA + (size_t)m * RW + ch0) = o0; *(GAS v4u*)(YA + (size_t)m * RW + ch0 + 8) = o1;
        cur = nxt;
    }
}


__device__ __forceinline__ unsigned f2key(float f) { const unsigned u = __builtin_bit_cast(unsigned, f); return (u & 0x80000000u) ? ~u : (u | 0x80000000u); }
__device__ __forceinline__ float key2f(unsigned k) { const unsigned u = (k & 0x80000000u) ? (k & 0x7fffffffu) : ~k; return __builtin_bit_cast(float, u); }
template <int CTRL, int RM> __device__ __forceinline__ unsigned dpp_umax(unsigned x) {
    const unsigned y = (unsigned)__builtin_amdgcn_update_dpp(0, (int)x, CTRL, RM, 0xf, false); return x > y ? x : y; }
__device__ __forceinline__ unsigned row_umax(unsigned x) { x = dpp_umax<0xB1, 0xf>(x); x = dpp_umax<0x4E, 0xf>(x); x = dpp_umax<0x141, 0xf>(x); x = dpp_umax<0x140, 0xf>(x); return x; }
#define SEL_CE(a_, b_) do { const unsigned hi_ = (a_) > (b_) ? (a_) : (b_), lo_ = (a_) > (b_) ? (b_) : (a_); (a_) = hi_; (b_) = lo_; } while (0)
__device__ __forceinline__ void sel_keys8(unsigned (&k)[8], const _Float16* p, int id0) {
    typedef _Float16 h8 __attribute__((ext_vector_type(8)));
    const h8 hv = *(const GAS h8*)p;
    const f32x4 v0 = {(float)hv[0], (float)hv[1], (float)hv[2], (float)hv[3]}, v1 = {(float)hv[4], (float)hv[5], (float)hv[6], (float)hv[7]};
    k[0] = (f2key(v0.x) & ~127u) | (unsigned)(id0 + 0); k[1] = (f2key(v0.y) & ~127u) | (unsigned)(id0 + 1); k[2] = (f2key(v0.z) & ~127u) | (unsigned)(id0 + 2); k[3] = (f2key(v0.w) & ~127u) | (unsigned)(id0 + 3);
    k[4] = (f2key(v1.x) & ~127u) | (unsigned)(id0 + 4); k[5] = (f2key(v1.y) & ~127u) | (unsigned)(id0 + 5); k[6] = (f2key(v1.z) & ~127u) | (unsigned)(id0 + 6); k[7] = (f2key(v1.w) & ~127u) | (unsigned)(id0 + 7);
    SEL_CE(k[0], k[1]); SEL_CE(k[2], k[3]); SEL_CE(k[4], k[5]); SEL_CE(k[6], k[7]); SEL_CE(k[0], k[2]); SEL_CE(k[1], k[3]); SEL_CE(k[4], k[6]); SEL_CE(k[5], k[7]); SEL_CE(k[1], k[2]); SEL_CE(k[5], k[6]);
    SEL_CE(k[0], k[4]); SEL_CE(k[1], k[5]); SEL_CE(k[2], k[6]); SEL_CE(k[3], k[7]); SEL_CE(k[2], k[4]); SEL_CE(k[3], k[5]); SEL_CE(k[1], k[2]); SEL_CE(k[3], k[4]); SEL_CE(k[5], k[6]);
}
__device__ __forceinline__ void top16_rows2(const _Float16* pa, const _Float16* pb, int l16, unsigned& ra, unsigned& rb) {
    unsigned ka[8], kb[8]; sel_keys8(ka, pa + 8 * l16, 8 * l16); sel_keys8(kb, pb + 8 * l16, 8 * l16);
    ra = 0u; rb = 0u;
#pragma unroll
    for (int it = 0; it < 16; ++it) {
        const unsigned ma = row_umax(ka[0]), mb = row_umax(kb[0]); const bool oa = ka[0] == ma, ob = kb[0] == mb;
#pragma unroll
        for (int e = 0; e < 7; ++e) { ka[e] = oa ? ka[e + 1] : ka[e]; kb[e] = ob ? kb[e + 1] : kb[e]; }
        ka[7] = oa ? 0u : ka[7]; kb[7] = ob ? 0u : kb[7];
        ra = (l16 == it) ? ma : ra; rb = (l16 == it) ? mb : rb;
    }
}
struct SelP { const float* SC; int* ESEL; float* EGATE; int last; };
__device__ __forceinline__ void select_token(const _Float16* srow, int lane, int (&eidx)[2], float (&egate)[2]) {
    const int row = lane >> 4, l16 = lane & 15, rbase = lane & 48;
    const int i1 = (int)((0x3332222211111111ull >> (4 * l16)) & 15ull), j1 = (int)((0x2104321076543210ull >> (4 * l16)) & 15ull), i2 = (int)((0xdcba987766554443ull >> (4 * l16)) & 15ull), j2 = (int)((0x0000001010102103ull >> (4 * l16)) & 15ull);
#pragma unroll
    for (int G = 0; G < 2; ++G) {
                const _Float16* hrow = srow + (4 * G + row) * 256;
                unsigned recA, recB; top16_rows2(hrow, hrow + 128, l16, recA, recB);
                const float va = key2f(recA & ~127u), vb = key2f(recB & ~127u);
                const float a0 = bpermf(rbase, va), a1 = bpermf(rbase + i1, va), b1 = bpermf(rbase + j1, vb), a2 = bpermf(rbase + i2, va), b2 = bpermf(rbase + j2, vb), a3 = bpermf(rbase + 14 + (l16 & 1), va), b0 = bpermf(rbase, vb);
                unsigned ck[4];
                ck[0] = (f2key(a0 + vb) & ~255u) | (unsigned)l16; ck[1] = (f2key(a1 + b1) & ~255u) | (unsigned)(16 * i1 + j1); ck[2] = (f2key(a2 + b2) & ~255u) | (unsigned)(16 * i2 + j2);
                ck[3] = (l16 < 2) ? ((f2key(a3 + b0) & ~255u) | (unsigned)(16 * (14 + l16))) : 0u;
                SEL_CE(ck[0], ck[1]); SEL_CE(ck[2], ck[3]); SEL_CE(ck[0], ck[2]); SEL_CE(ck[1], ck[3]); SEL_CE(ck[1], ck[2]);
                unsigned rec = 0u;
#pragma unroll
                for (int it = 0; it < 16; ++it) {
                    const unsigned mh = row_umax(ck[0]); const bool own = ck[0] == mh;
                    ck[0] = own ? ck[1] : ck[0]; ck[1] = own ? ck[2] : ck[1]; ck[2] = own ? ck[3] : ck[2]; ck[3] = own ? 0u : ck[3];
                    rec = (l16 == it) ? mh : rec;
                }
                const float ts = key2f(rec & ~255u), tmax = bpermf(rbase, ts);
                const float ev = __expf(ts - tmax), esum = red16(ev);
                const int ci = (int)((rec >> 4) & 15u), cj = (int)(rec & 15u);
                const int expert = bpermi(rbase + ci, (int)(recA & 127u)) * 128 + bpermi(rbase + cj, (int)(recB & 127u));
                eidx[G] = expert; egate[G] = ev / esum;
    }
}
struct PeerP { const _Float16* SC; const float* nmod; const float* ng; bf16* Hout;   const int* ESEL; const float* EGATE; const bf16* H; const unsigned char* PU; const unsigned char* PV; const float* SU; const float* SV; bf16* X; const float* mod;   const float* fin_g; float* out; int last; int dry; };
__device__ __forceinline__ void peer_phase(Frame& F, const PeerP& P) {
    const int gw = F.vcu * NWAVES + F.wave, NGW = F.G * NWAVES, lane = F.lane;
    float pr_s2 = 0.f, pr_d2 = 0.f, pr_tg = 0.f, pr_n = 0.f;
    int m0 = gw; while (m0 < MALL && P.last && (m0 % TPB) < CTXL) m0 += NGW;
    v4u ph0 = {0u, 0u, 0u, 0u}, ph1 = ph0, ph2 = ph0, ph3 = ph0;
    if (m0 < MALL) { const bf16* hp = P.H + (size_t)m0 * DM + lane * 32; ph0 = *(const GAS v4u*)hp; ph1 = *(const GAS v4u*)(hp + 8); ph2 = *(const GAS v4u*)(hp + 16); ph3 = *(const GAS v4u*)(hp + 24); }
    for (int m = m0, mn = 0; m < MALL; m = mn) {
        mn = m + NGW; while (mn < MALL && P.last && (mn % TPB) < CTXL) mn += NGW;
        const int b = m / TPB, tp = m - b * TPB;
        const int mr = tp < CTXL ? 2 : b;
        const int emask_ = (P.dry & 2) ? 1023 : 0x7fffffff;
        int eidx[2]; float egate[2]; select_token(P.SC + (size_t)m * DM, lane, eidx, egate);
        eidx[0] &= emask_; eidx[1] &= emask_;
        typedef int v8i __attribute__((ext_vector_type(8)));
        LAS unsigned char* hq = F.lds + F.wave * 4096;
        { const v4u hv[4] = {ph0, ph1, ph2, ph3}; v4u o[2];
#pragma unroll
          for (int j = 0; j < 4; ++j) { int w0 = 0, w1 = 0;
              w0 = __builtin_amdgcn_cvt_pk_fp8_f32(bflo(hv[j].x), bfhi(hv[j].x), w0, false); w0 = __builtin_amdgcn_cvt_pk_fp8_f32(bflo(hv[j].y), bfhi(hv[j].y), w0, true);
              w1 = __builtin_amdgcn_cvt_pk_fp8_f32(bflo(hv[j].z), bfhi(hv[j].z), w1, false); w1 = __builtin_amdgcn_cvt_pk_fp8_f32(bflo(hv[j].w), bfhi(hv[j].w), w1, true);
              o[j >> 1][2 * (j & 1)] = (unsigned)w0; o[j >> 1][2 * (j & 1) + 1] = (unsigned)w1; }
          *(LAS v4u*)(hq + lane * 32) = o[0]; *(LAS v4u*)(hq + lane * 32 + 16) = o[1];
          unsigned z_ = 0u; asm volatile("" : "+v"(z_));
          if (lane < 2) *(LAS v4u*)(hq + 2048 + lane * 16) = (v4u){z_, z_, z_, z_}; }
        const int li = lane & 15, kb = lane >> 4;
        int rowoff[8];
#pragma unroll
        for (int g = 0; g < 8; ++g) rowoff[g] = bpermi(16 * (g & 3) + li, eidx[g >> 2]) * (DM / 2) + 16 * kb;
        f32x4 dacc[8];
#pragma unroll
        for (int g = 0; g < 8; ++g) dacc[g] = (f32x4){0.f, 0.f, 0.f, 0.f};
        const unsigned hb = (li == 0) ? (unsigned)(16 * kb) : 2048u;
        const unsigned hb2 = (li == 0) ? 64u : 16u;
        const unsigned hstep = (li == 0) ? 128u : 0u;
        v4u ua[8], ub[8];
#pragma unroll
        for (int g = 0; g < 8; ++g) ua[g] = *(const GAS v4u*)(P.PU + (unsigned)rowoff[g]);
#pragma unroll 1
        for (int s = 0; s < ((P.dry & 4) ? 2 : 16); s += 2) {
#pragma unroll
            for (int g = 0; g < 8; ++g) ub[g] = *(const GAS v4u*)(P.PU + (unsigned)(rowoff[g] + 64 * (s + 1)));
            { const v4u b0 = *(const LAS v4u*)(hq + hb + hstep * s), b1 = *(const LAS v4u*)(hq + hb + hstep * s + hb2);
              const v8i bf = {(int)b0.x, (int)b0.y, (int)b0.z, (int)b0.w, (int)b1.x, (int)b1.y, (int)b1.z, (int)b1.w};
#pragma unroll
              for (int g = 0; g < 8; ++g) { const v8i af = {(int)ua[g].x, (int)ua[g].y, (int)ua[g].z, (int)ua[g].w, 0, 0, 0, 0};
                  dacc[g] = __builtin_amdgcn_mfma_scale_f32_16x16x128_f8f6f4(af, bf, dacc[g], 4, 0, 0, 0x7f7f7f7f, 0, 0x7f7f7f7f); } }
            if (s + 2 < 16) {
#pragma unroll
                for (int g = 0; g < 8; ++g) ua[g] = *(const GAS v4u*)(P.PU + (unsigned)(rowoff[g] + 64 * (s + 2))); }
            { const v4u b0 = *(const LAS v4u*)(hq + hb + hstep * (s + 1)), b1 = *(const LAS v4u*)(hq + hb + hstep * (s + 1) + hb2);
              const v8i bf = {(int)b0.x, (int)b0.y, (int)b0.z, (int)b0.w, (int)b1.x, (int)b1.y, (int)b1.z, (int)b1.w};
#pragma unroll
              for (int g = 0; g < 8; ++g) { const v8i af = {(int)ub[g].x, (int)ub[g].y, (int)ub[g].z, (int)ub[g].w, 0, 0, 0, 0};
                  dacc[g] = __builtin_amdgcn_mfma_scale_f32_16x16x128_f8f6f4(af, bf, dacc[g], 4, 0, 0, 0x7f7f7f7f, 0, 0x7f7f7f7f); } }
        }
        float coef[2];
#pragma unroll
        for (int sl = 0; sl < 2; ++sl) { float mydot = 0.f;
#pragma unroll
            for (int g4 = 0; g4 < 4; ++g4)
#pragma unroll
                for (int r = 0; r < 4; ++r) { const float t = bpermf(16 * ((lane >> 2) & 3), dacc[4 * sl + g4][r]); if ((lane >> 4) == g4 && (lane & 3) == r) mydot = t; }
            mydot *= P.SU[eidx[sl]];
            if (DBG_PROBE == 4) {
                float ref = 0.f;
                for (int e = 0; e < 64; ++e) { const int ex = __builtin_amdgcn_readlane(eidx[sl], e); const v4u uu = *(const GAS v4u*)(P.PU + (size_t)ex * (DM / 2) + lane * 16); float s1 = 0.f;
                    const v4u hv2[4] = {*(const GAS v4u*)(P.H + (size_t)m * DM + lane * 32), *(const GAS v4u*)(P.H + (size_t)m * DM + lane * 32 + 8), *(const GAS v4u*)(P.H + (size_t)m * DM + lane * 32 + 16), *(const GAS v4u*)(P.H + (size_t)m * DM + lane * 32 + 24)};
#pragma unroll
                    for (int d = 0; d < 4; ++d) { const unsigned w = uu[d]; const unsigned hw[4] = {hv2[d].x, hv2[d].y, hv2[d].z, hv2[d].w};
                        f32x2 x = __builtin_amdgcn_cvt_scalef32_pk_f32_fp4(w, 1.0f, 0); s1 += x.x * bflo(hw[0]) + x.y * bfhi(hw[0]); x = __builtin_amdgcn_cvt_scalef32_pk_f32_fp4(w, 1.0f, 1); s1 += x.x * bflo(hw[1]) + x.y * bfhi(hw[1]);
                        x = __builtin_amdgcn_cvt_scalef32_pk_f32_fp4(w, 1.0f, 2); s1 += x.x * bflo(hw[2]) + x.y * bfhi(hw[2]); x = __builtin_amdgcn_cvt_scalef32_pk_f32_fp4(w, 1.0f, 3); s1 += x.x * bflo(hw[3]) + x.y * bfhi(hw[3]); }
                    const float tot = wave_sum_u(s1) * P.SU[ex]; if (lane == e) ref = tot; }
                pr_s2 = fmaxf(pr_s2, wave_max_u(fabsf(mydot - ref) / (fabsf(ref) + 0.25f))); pr_n = 1.f; }
            coef[sl] = egate[sl] * 0.5f * mydot * (1.0f + erff(mydot * 0.70710678f));
            if ((DBG_SKIP & 16) && sl == 0) coef[sl] = 0.f;
            if ((DBG_SKIP & 32) && sl == 1) coef[sl] = 0.f;
        }
        const float coefs[2] = {coef[0] * P.SV[eidx[0]], coef[1] * P.SV[eidx[1]]};
        f32x2 acc2[16];
#pragma unroll
        for (int i = 0; i < 16; ++i) acc2[i] = (f32x2){0.f, 0.f};
#define PEER_LOADV(U, C, e0_) do { const int e1_ = (e0_); const int ev_ = (e1_ & 64) ? eidx[1] : eidx[0]; const int cv_ = __builtin_bit_cast(int, (e1_ & 64) ? coefs[1] : coefs[0]); \
            _Pragma("unroll") for (int q = 0; q < 8; ++q) { const int ex = __builtin_amdgcn_readlane(ev_, (e1_ & 63) + q); U[q] = *(const GAS v4u*)(P.PV + (size_t)ex * (DM / 2) + lane * 16); \
            C[q] = __builtin_bit_cast(float, __builtin_amdgcn_readlane(cv_, (e1_ & 63) + q)); } } while (0)
#define PEER_AXPY(U, C) do { if (P.dry & 32) { _Pragma("unroll") for (int q = 0; q < 8; ++q) _Pragma("unroll") for (int d = 0; d < 4; ++d) acc2[d].x += __builtin_bit_cast(float, U[q][d] & 0x3fffffffu) * C[q]; } else \
            _Pragma("unroll") for (int q = 0; q < 8; ++q) _Pragma("unroll") for (int d = 0; d < 4; ++d) { const unsigned w = U[q][d]; \
            acc2[4 * d + 0] = __builtin_amdgcn_cvt_scalef32_pk_f32_fp4(w, 1.0f, 0) * C[q] + acc2[4 * d + 0]; acc2[4 * d + 1] = __builtin_amdgcn_cvt_scalef32_pk_f32_fp4(w, 1.0f, 1) * C[q] + acc2[4 * d + 1]; \
            acc2[4 * d + 2] = __builtin_amdgcn_cvt_scalef32_pk_f32_fp4(w, 1.0f, 2) * C[q] + acc2[4 * d + 2]; acc2[4 * d + 3] = __builtin_amdgcn_cvt_scalef32_pk_f32_fp4(w, 1.0f, 3) * C[q] + acc2[4 * d + 3]; } } while (0)
        if (mn < MALL) {
            const bf16* hp = P.H + (size_t)mn * DM + lane * 32; ph0 = *(const GAS v4u*)hp; ph1 = *(const GAS v4u*)(hp + 8); ph2 = *(const GAS v4u*)(hp + 16); ph3 = *(const GAS v4u*)(hp + 24); }
        v4u xpre[4];
        { const bf16* xr0 = P.X + (size_t)m * DM + lane * 32;
#pragma unroll
          for (int hq = 0; hq < 4; ++hq) xpre[hq] = *(const GAS v4u*)(xr0 + hq * 8); }
        {
            v4u ua[8], ub[8]; float ca[8], cb[8];
            PEER_LOADV(ua, ca, 0);
#pragma unroll 1
            for (int it = 0; it < ((P.dry & 8) ? 2 : 8); ++it) {
                PEER_LOADV(ub, cb, 16 * it + 8); PEER_AXPY(ua, ca);
                if (it < 7) PEER_LOADV(ua, ca, 16 * it + 16);
                PEER_AXPY(ub, cb);
            }
        }
#undef PEER_LOADV
#undef PEER_AXPY
        float acc[32];
#pragma unroll
        for (int i = 0; i < 16; ++i) { acc[2 * i] = acc2[i].x; acc[2 * i + 1] = acc2[i].y; }
        if (P.dry) { float sm_ = 0.f;
#pragma unroll
            for (int i = 0; i < 32; ++i) sm_ += acc[i];
            if (sm_ == 1.2345e-30f) P.X[lane] = sm_;
            if (!(P.dry & 16)) continue; }
        if (DBG_SKIP & 1) {
#pragma unroll
            for (int i = 0; i < 32; ++i) acc[i] = 0.f; }
        if (((DBG_SKIP & 64) && !P.last) || ((DBG_SKIP & 128) && P.last)) {
#pragma unroll
            for (int i = 0; i < 32; ++i) acc[i] = 0.f; }
        if (DBG_SKIP & 8) {
#pragma unroll
            for (int i = 0; i < 32; ++i) acc[i] = -acc[i]; }
        int m_l = m, lane_l = lane; asm volatile("" : "+v"(m_l), "+v"(lane_l));
        const int b_l = m_l / TPB, tp_l = m_l - b_l * TPB, mr_l = tp_l < CTXL ? 2 : b_l;
        bf16* xr = (P.dry ? (bf16*)(F.ws + 760 * MiB) : P.X) + (size_t)m_l * DM + lane_l * 32; const float* g2 = P.mod + (size_t)mr_l * 12288 + 5 * DM + lane_l * 32;
        float ss = 0.f;
#pragma unroll
        for (int hq = 0; hq < 4; ++hq) { const int c = hq * 8; float xf[8]; unpack8(xpre[hq], xf);
            const f32x4 g0 = *(const GAS f32x4*)(g2 + c), g1 = *(const GAS f32x4*)(g2 + c + 4);
#pragma unroll
            for (int e = 0; e < 8; ++e) { const float xv = xf[e] + (e < 4 ? g0[e & 3] : g1[e & 3]) * acc[8 * hq + e]; ss += xv * xv; acc[8 * hq + e] = xv; xf[e] = xv; }
            if (!P.last) *(GAS v4u*)(xr + c) = pack8f(xf); }
        if (!P.last) {
            const float rs = rsqrtf(wave_sum(ss) * (1.f / DM) + NORM_EPS); const float* sh = P.nmod + (size_t)mr_l * 12288 + lane_l * 32; const float* sc = sh + DM; const float* ngp = P.ng + lane_l * 32;
            bf16* ho = (P.dry ? (bf16*)(F.ws + 892 * MiB) : P.Hout) + (size_t)m_l * DM + lane_l * 32;
#pragma unroll
            for (int hq = 0; hq < 4; ++hq) { const int c = hq * 8; float y[8];
                const f32x4 n0 = *(const GAS f32x4*)(ngp + c), n1 = *(const GAS f32x4*)(ngp + c + 4), s0 = *(const GAS f32x4*)(sc + c), s1 = *(const GAS f32x4*)(sc + c + 4), h0 = *(const GAS f32x4*)(sh + c), h1 = *(const GAS f32x4*)(sh + c + 4);
#pragma unroll
                for (int e = 0; e < 4; ++e) { y[e] = acc[8 * hq + e] * rs * n0[e] * (1.0f + s0[e]) + h0[e]; y[4 + e] = acc[8 * hq + 4 + e] * rs * n1[e] * (1.0f + s1[e]) + h1[e]; }
                *(GAS v4u*)(ho + c) = pack8f(y); } }
        if (P.last) { const float rs = rsqrtf(wave_sum(ss) * (1.f / DM) + NORM_EPS); float* orow = P.out + ((size_t)b_l * SEQ + (tp_l - CTXL)) * DM + lane_l * 32; const float* fgp = P.fin_g + lane_l * 32;
#pragma unroll
            for (int hq = 0; hq < 8; ++hq) { const int c = hq * 4; const f32x4 fg = *(const GAS f32x4*)(fgp + c);
                f32x4 o;
#pragma unroll
                for (int e = 0; e < 4; ++e) o[e] = acc[4 * hq + e] * rs * fg[e];
                *(GAS f32x4*)(orow + c) = o; } }
    }
    if (DBG_PROBE && DBG_PROBE != 5 && !P.last && lane == 0) { float* pp = (float*)(F.ws + WS_CTL + CTL_PROBE_OFF) + gw * 4; pp[0] = pr_s2; pp[1] = pr_d2; pp[2] = pr_tg; pp[3] = pr_n; }
}


constexpr int PH_PER_LAYER = 12, NPHASE = 1 + NLAYER * PH_PER_LAYER;
#ifndef ONLY_PHASE
#define ONLY_PHASE -1
#endif
#define T0() (wave_s == 0 && pg8::opaque_lane() == 0)
#define PH_ON(k) (ONLY_PHASE < 0 || ONLY_PHASE == (k))
#define GEMM_CALL(EPI, SCHED, g, S, E) pg8::gemm_phase<EPI, SCHED, true, true>(F.lds, g, S, E, wave_s)
#define GEMM_CALL_NA(EPI, SCHED, g, S, E) pg8::gemm_phase<EPI, SCHED, false, true>(F.lds, g, S, E, wave_s)

__device__ __forceinline__ const float* karg(int i) {
    asm volatile("" : "+s"(i));
    const __attribute__((address_space(4))) unsigned long long* ka = (const __attribute__((address_space(4))) unsigned long long*)__builtin_amdgcn_kernarg_segment_ptr();
    return (const float*)ka[i];
}
__global__ void __launch_bounds__(NWAVES * 64, 2) mk_fwd(Args args) {
    extern __shared__ __attribute__((aligned(16))) unsigned char lds[];
    Frame F;
    F.lds = (LAS unsigned char*)lds; F.ws = args.ws;
    const int wave_s = __builtin_amdgcn_readfirstlane((int)threadIdx.x >> 6);
    F.tid = threadIdx.x; F.lane = F.tid & 63; F.wave = wave_s;
    F.G = gridDim.x; { const int bx = blockIdx.x; F.vcu = (F.G % 8 == 0) ? (bx % 8) * (F.G / 8) + bx / 8 : bx; }
    unsigned char* ws = args.ws;
    volatile LAS unsigned* MISC = (volatile LAS unsigned*)(F.lds + MISC_OFF);
    for (int u = F.tid; u < (LDS_BYTES - LDSCTL_OFF) / 4; u += NWAVES * 64) ((LAS unsigned*)(F.lds + LDSCTL_OFF))[u] = 0u;
    __syncthreads();
    const int lo = args.ph_lo, hi = args.ph_hi;
    XcdBarrier bar; bar.bar = (unsigned*)(ws + WS_CTL) + CW_BAR; bar.x = 0; bar.st = nullptr;
    if (hi - lo > 1) bar = xcd_barrier_post((unsigned*)(ws + WS_CTL) + CW_BAR, MISC + 8, T0());
#define IN(k) (lo <= (k) && (k) < hi)
#define REFRAME() do { const int lz_ = pg8::opaque_lane(); F.lane = lz_; F.tid = wave_s * 64 + lz_; F.wave = wave_s; ws = (unsigned char*)karg(34); F.ws = ws; { int g_ = (int)gridDim.x, b_ = (int)blockIdx.x; asm volatile("" : "+s"(g_), "+s"(b_)); bx = b_; F.G = g_; F.vcu = ((g_ & 7) == 0) ? (b_ & 7) * (g_ >> 3) + (b_ >> 3) : b_; } } while (0)
#define SEAM(k) do { if (IN((k) + 1)) xcd_barrier(bar, T0()); } while (0)
#define XBUF ((bf16*)(ws + WS_X))
#define HBUF ((bf16*)(ws + WS_H))
#define MODP ((const float*)(ws + WS_CTL + CTL_MOD_OFF) + (size_t)l * 3 * 12288)
    int bx = (int)blockIdx.x;

    for (int rep_ = 0; rep_ < ((DBG_REPEAT == 100) ? 2 : 1); ++rep_) if (PH_ON(100) && IN(0)) { REFRAME(); if (rep_) xcd_barrier(bar, T0()); p0_prologue(F, 0, (MK_N_LAUNCHES == 1) ? 1 : NLAYER, F.vcu, F.G); SEAM(0); if (DBG_REPEAT == 200) { for (int i_ = 0; i_ < 32; ++i_) xcd_barrier(bar, T0()); } }

    for (int l = 0; l < NLAYER; ++l) {
        const int base = 1 + l * PH_PER_LAYER;
        const int last = (l == NLAYER - 1);
        for (int rep_ = 0; rep_ < ((DBG_REPEAT == 0) ? 2 : 1); ++rep_) if (PH_ON(0) && IN(base + 0) && l == 0) { REFRAME(); if (rep_) xcd_barrier(bar, T0()); modnorm_phase(F, nullptr, karg(6) + (size_t)l * DM, MODP, 0, HBUF, 0, karg(0), karg(2)); SEAM(base + 0); }
        for (int rep_ = 0; rep_ < ((DBG_REPEAT == 1) ? 2 : 1); ++rep_) if (PH_ON(1) && IN(base + 1)) { REFRAME(); if (rep_) xcd_barrier(bar, T0());
            pg8::Gemm g{HBUF, (const bf16*)(ws + WS_WINA) + (size_t)l * INA_P * DM, MALL, INA_P, DM}; pg8::RowOrder S; S.init_rows(0, INA_P, F.G, bx);
            pg8::EpiStoreBf16 E{(bf16*)(ws + WS_PA), INA_P};
            GEMM_CALL(pg8::EpiStoreBf16, pg8::RowOrder, g, S, E);
            SEAM(base + 1); }
        for (int rep_ = 0; rep_ < ((DBG_REPEAT == 2) ? 2 : 1); ++rep_) if (PH_ON(2) && IN(base + 2)) { REFRAME(); if (rep_) xcd_barrier(bar, T0());
            FeatP P;
            P.PA = (const bf16*)(ws + WS_PA); P.mu = karg(9) + (size_t)l * RWC; P.w0 = karg(10) + (size_t)l * 2 * RW; P.a0 = karg(12) + (size_t)l * 2 * RW;
            P.k_k = karg(15) + (size_t)l * RW; P.k_a = karg(16) + (size_t)l * RW; P.r_k = karg(17) + (size_t)l * RW;
            P.WUP = (const bf16*)(ws + WS_WUP) + (size_t)l * 2 * RW * 64; P.AUP = (const bf16*)(ws + WS_AUP) + (size_t)l * 2 * RW * 64; P.GUP = (const bf16*)(ws + WS_GUP) + (size_t)l * 2 * RW * 32;
            P.qnorm = karg(20) + (size_t)l * 512; P.kvnorm = karg(22) + (size_t)l * 256; P.rope = (const f32x2*)(ws + WS_ROPE);
            P.RI = (bf16*)(ws + WS_RI); P.GG = (bf16*)(ws + WS_GG); P.BON = (float*)(ws + WS_BON); P.QN = (bf16*)(ws + WS_QN); P.KVN = (bf16*)(ws + WS_KVN); P.K = (bf16*)(ws + WS_K);
            features_phase(F, P);
            SEAM(base + 2); }
        for (int rep_ = 0; rep_ < ((DBG_REPEAT == 3) ? 2 : 1); ++rep_) if (PH_ON(3) && IN(base + 3)) { REFRAME(); if (rep_) xcd_barrier(bar, T0());
            { pg8::Gemm g{(const bf16*)(ws + WS_QN), (const bf16*)(ws + WS_WUQ) + (size_t)l * NQ * 512, MALL, NQ, 512};
              pg8::EpiQ E{(bf16*)(ws + WS_Q), (const f32x2*)(ws + WS_ROPE), 0.14724444f};
              pg8::RowOrder S; S.init_rows(last, NQ, F.G, bx); GEMM_CALL_NA(pg8::EpiQ, pg8::RowOrder, g, S, E); }
            { pg8::Gemm g{(const bf16*)(ws + WS_KVN), (const bf16*)(ws + WS_WUKV) + (size_t)l * NKV * 256, MALL, NKV, 256}; pg8::RowOrder S; S.init_rows(0, NKV, F.G, bx);
              pg8::EpiKV E{(bf16*)(ws + WS_K), (bf16*)(ws + WS_V)};
              GEMM_CALL_NA(pg8::EpiKV, pg8::RowOrder, g, S, E); }
            SEAM(base + 3); }
        for (int rep_ = 0; rep_ < ((DBG_REPEAT == 4) ? 2 : 1); ++rep_) if (PH_ON(4) && IN(base + 4)) { REFRAME(); if (rep_) xcd_barrier(bar, T0());
            ScanCvt C; C.pu = karg(30) + (size_t)l * NEXP * DM; C.pv = karg(31) + (size_t)l * NEXP * DM; C.PU8 = ws + WS_P4; C.PV8 = ws + WS_P4 + (size_t)NEXP * (DM / 2); C.SU = (float*)(ws + WS_P4S); C.SV = (float*)(ws + WS_P4S) + NEXP; C.wl = (MK_N_LAUNCHES == 1 && l + 1 < NLAYER && F.G == 256) ? l + 1 : -1;
            scan_phase(F, (const bf16*)(ws + WS_RI), (bf16*)(ws + WS_Y), C); SEAM(base + 4); }
        for (int rep_ = 0; rep_ < ((DBG_REPEAT == 5) ? 2 : 1); ++rep_) if (PH_ON(5) && IN(base + 5)) { REFRAME(); if (rep_) xcd_barrier(bar, T0());
            attn_phase(F, (const bf16*)(ws + WS_Q), (const bf16*)(ws + WS_K), (const bf16*)(ws + WS_V), (bf16*)(ws + WS_YB), !last);
            readout_phase(F, (const bf16*)(ws + WS_Y), (const bf16*)(ws + WS_GG), (const float*)(ws + WS_BON), (const bf16*)(ws + WS_RI), karg(18) + (size_t)l * RW, karg(19) + (size_t)l * RW, (bf16*)(ws + WS_YA));
            SEAM(base + 5); }
        for (int rep_ = 0; rep_ < ((DBG_REPEAT == 6) ? 2 : 1); ++rep_) if (PH_ON(6) && IN(base + 6)) { REFRAME(); if (rep_) xcd_barrier(bar, T0());
            bf16* T1 = (bf16*)(ws + WS_T1); bf16* T2 = (bf16*)(ws + WS_T2);
            const pg8::Gemm g1{HBUF, (const bf16*)(ws + WS_WGA) + (size_t)l * DM * DM, MALL, DM, DM}, g2{(const bf16*)(ws + WS_YA), (const bf16*)(ws + WS_WA) + (size_t)l * DM * RW, MALL, DM, RW};
            const pg8::Gemm g3{HBUF, (const bf16*)(ws + WS_WGB) + (size_t)l * DM * DM, MALL, DM, DM}, g4{(const bf16*)(ws + WS_YB), (const bf16*)(ws + WS_WB) + (size_t)l * DM * RW, MALL, DM, RW};
            const pg8::EpiGate E1{T1, DM, karg(8) + (size_t)l * 2 * DM}, E3{T2, DM, karg(8) + (size_t)l * 2 * DM + DM};
            const pg8::EpiMulAdd E2{T1, T1, nullptr, DM}, E4{T1, T2, T1, DM};
            const bool split = CTX_SPLIT && !last && F.G >= 128;
            pg8::RowOrder S; S.init_rows(last || split, DM, F.G, bx);
            GEMM_CALL(pg8::EpiGate, pg8::RowOrder, g1, S, E1); GEMM_CALL(pg8::EpiMulAdd, pg8::RowOrder, g2, S, E2); GEMM_CALL(pg8::EpiGate, pg8::RowOrder, g3, S, E3); GEMM_CALL(pg8::EpiMulAdd, pg8::RowOrder, g4, S, E4);
            if (split) {
                pg8::CtxOrder Sg, Sp; Sg.u0 = (bx < 32) ? (bx & 15) : -1; Sp.u0 = (bx >= 32 && bx < 64) ? (bx & 15) : -1;
                const bool second = (bx & 16) != 0;
                const pg8::Gemm gg = second ? g3 : g1, gp = second ? g4 : g2;
                const pg8::EpiGate EG = second ? E3 : E1;
                const pg8::EpiCtxF32 EP{(float*)(ws + (second ? WS_CB : WS_CA)), DM};
                GEMM_CALL(pg8::EpiGate, pg8::CtxOrder, gg, Sg, EG); GEMM_CALL(pg8::EpiCtxF32, pg8::CtxOrder, gp, Sp, EP); }
            if (MK_N_LAUNCHES == 1 && l == 0 && rep_ == 0) { __syncthreads();
                const int late = split ? 64 : (F.G > 32) ? 16 : 0; p0_prologue(F, 1, NLAYER, (bx >= late) ? bx - late : -1, F.G - late, (F.G == 256) ? 0 : 1); }
            SEAM(base + 6); }
        for (int rep_ = 0; rep_ < ((DBG_REPEAT == 7) ? 2 : 1); ++rep_) if (PH_ON(7) && IN(base + 7)) { REFRAME(); if (rep_) xcd_barrier(bar, T0());
            if (CTX_SPLIT && !last && F.G >= 128 && rep_ == 0) {
                bf16* T1 = (bf16*)(ws + WS_T1); const bf16* T2 = (const bf16*)(ws + WS_T2); const float* CA = (const float*)(ws + WS_CA); const float* CB = (const float*)(ws + WS_CB);
                for (int e = bx * (NWAVES * 64) + F.tid; e < 512 * (DM / 8); e += F.G * (NWAVES * 64)) { const int r = e >> 8, c0 = (e & 255) * 8; const size_t go = (size_t)((r < 256) ? r : 33 * 256 + (r - 256)) * DM + c0;
                    const v4u ga = *(const GAS v4u*)(T1 + go), gb = *(const GAS v4u*)(T2 + go);
                    const f32x4 a0 = *(const GAS f32x4*)(CA + (size_t)r * DM + c0), a1 = *(const GAS f32x4*)(CA + (size_t)r * DM + c0 + 4), b0 = *(const GAS f32x4*)(CB + (size_t)r * DM + c0), b1 = *(const GAS f32x4*)(CB + (size_t)r * DM + c0 + 4);
                    v4u o;
                    o.x = pk2(bflo(ga.x) * a0[0] + bflo(gb.x) * b0[0], bfhi(ga.x) * a0[1] + bfhi(gb.x) * b0[1]); o.y = pk2(bflo(ga.y) * a0[2] + bflo(gb.y) * b0[2], bfhi(ga.y) * a0[3] + bfhi(gb.y) * b0[3]);
                    o.z = pk2(bflo(ga.z) * a1[0] + bflo(gb.z) * b1[0], bfhi(ga.z) * a1[1] + bfhi(gb.z) * b1[1]); o.w = pk2(bflo(ga.w) * a1[2] + bflo(gb.w) * b1[2], bfhi(ga.w) * a1[3] + bfhi(gb.w) * b1[3]);
                    *(GAS v4u*)(T1 + go) = o; }
                xcd_barrier(bar, T0()); }
            const pg8::Gemm g{(const bf16*)(ws + WS_T1), (const bf16*)(ws + WS_WO) + (size_t)l * DM * DM, MALL, DM, DM};
            const pg8::EpiResid E{XBUF, MODP + 2 * DM, l == 0 ? karg(0) : nullptr, l == 0 ? karg(2) : nullptr};
            pg8::RowOrder S; S.init_rows(last, DM, F.G, bx); GEMM_CALL(pg8::EpiResid, pg8::RowOrder, g, S, E);
            SEAM(base + 7); }
        for (int rep_ = 0; rep_ < ((DBG_REPEAT == 8) ? 2 : 1); ++rep_) if (PH_ON(8) && IN(base + 8)) { REFRAME(); if (rep_) xcd_barrier(bar, T0());
            modnorm_phase_bf(F, XBUF, karg(27) + (size_t)l * DM, MODP, 3, HBUF, last);
            SEAM(base + 8); }
        for (int rep_ = 0; rep_ < ((DBG_REPEAT == 9) ? 2 : 1); ++rep_) if (PH_ON(9) && IN(base + 9)) { REFRAME(); if (rep_) xcd_barrier(bar, T0());
            const pg8::Gemm g{HBUF, (const bf16*)(ws + WS_WQK) + (size_t)l * DM * DM, MALL, DM, DM};
            const pg8::EpiF16 E{(_Float16*)(ws + WS_SC), DM};
            pg8::RowOrder S; S.init_rows(last, DM, F.G, bx); GEMM_CALL(pg8::EpiF16, pg8::RowOrder, g, S, E);
            SEAM(base + 9); }
        for (int rep_ = 0; rep_ < ((DBG_REPEAT == 11) ? 2 : 1); ++rep_) if (PH_ON(11) && IN(base + 11)) { REFRAME(); if (rep_) xcd_barrier(bar, T0());
            PeerP P; P.SC = (const _Float16*)(ws + WS_SC); P.nmod = MODP + 3 * 12288; P.ng = karg(6) + (size_t)(l + 1) * DM; P.Hout = HBUF; P.ESEL = (const int*)(ws + WS_T1); P.EGATE = (const float*)(ws + WS_T1 + 16 * MiB); P.H = HBUF; P.PU = ws + WS_P4; P.PV = ws + WS_P4 + (size_t)NEXP * (DM / 2); P.SU = (const float*)(ws + WS_P4S); P.SV = (const float*)(ws + WS_P4S) + NEXP; P.X = XBUF; P.mod = MODP; P.fin_g = karg(32); P.out = (float*)karg(33); P.last = last; P.dry = (DBG_REPEAT == 11 && rep_ == 0) ? DBG_DRY : 0;
            peer_phase(F, P);
            SEAM(base + 11); }
    }
#undef IN
#undef SEAM
#undef XBUF
#undef HBUF
#undef MODP
}

__device__ __forceinline__ float mx_a_val(int i, int k) { const int c = (i * 131 + k * 17 + (k >> 3) * 5) & 15; const float mag[8] = {0.f, .5f, 1.f, 1.5f, 2.f, 3.f, 4.f, 6.f}; return (c & 8) ? -mag[c & 7] : mag[c & 7]; }
__device__ __forceinline__ int mx_a_code(int i, int k) { return (i * 131 + k * 17 + (k >> 3) * 5) & 15; }
__device__ __forceinline__ float mx_b_val(int k, int j) { return (float)(((k * 7 + j * 13 + (k >> 4)) % 9) - 4); }
__device__ __forceinline__ int mx_kmap(int hyp, int kb, int e) { const int h = hyp % 3; return h == 0 ? 32 * kb + e : h == 1 ? 32 * (e >> 3) + 8 * kb + (e & 7) : 64 * (e >> 4) + 16 * kb + (e & 15); }
__global__ void __launch_bounds__(512) dbg_fill(const float* pp, float* o) {
    __shared__ float vsh;
    float v = 0.f;
    if (DBG_PROBE == 5) {
        if (threadIdx.x < 64) { typedef int v8i __attribute__((ext_vector_type(8))); typedef float f4 __attribute__((ext_vector_type(4)));
            const int lane = threadIdx.x, i = lane & 15, kb = lane >> 4; float code = 0.f;
            for (int hyp = 0; hyp < 18; ++hyp) { const int nibswap = hyp / 9, ha = hyp % 3, hb2 = (hyp / 3) % 3;
                unsigned aw[4] = {0u, 0u, 0u, 0u}; int bw[8] = {0, 0, 0, 0, 0, 0, 0, 0};
                for (int e = 0; e < 32; ++e) { const int k = mx_kmap(ha, kb, e); const unsigned c = (unsigned)mx_a_code(i, k); const int pos = nibswap ? (e ^ 1) : e; aw[pos >> 3] |= c << (4 * (pos & 7)); }
                for (int q = 0; q < 8; ++q) { int w = 0; const float f0 = mx_b_val(mx_kmap(hb2, kb, 4 * q + 0), i), f1 = mx_b_val(mx_kmap(hb2, kb, 4 * q + 1), i), f2 = mx_b_val(mx_kmap(hb2, kb, 4 * q + 2), i), f3 = mx_b_val(mx_kmap(hb2, kb, 4 * q + 3), i);
                    w = __builtin_amdgcn_cvt_pk_fp8_f32(f0, f1, w, false); w = __builtin_amdgcn_cvt_pk_fp8_f32(f2, f3, w, true); bw[q] = w; }
                const v8i af = {(int)aw[0], (int)aw[1], (int)aw[2], (int)aw[3], 0, 0, 0, 0}, bf = {bw[0], bw[1], bw[2], bw[3], bw[4], bw[5], bw[6], bw[7]};
                f4 d = {0.f, 0.f, 0.f, 0.f};
                d = __builtin_amdgcn_mfma_scale_f32_16x16x128_f8f6f4(af, bf, d, 4, 0, 0, 0x7f7f7f7f, 0, 0x7f7f7f7f);
                int bad = 0;
                for (int r = 0; r < 4; ++r) { const int row = 4 * kb + r, col = i; float ex = 0.f; for (int k = 0; k < 128; ++k) ex += mx_a_val(row, k) * mx_b_val(k, col); bad += (d[r] != ex); }
                if (__ballot(bad != 0) == 0ull && code == 0.f) code = (float)(hyp + 1); }
            for (int t = 0; t < 2; ++t) {
                int aw[8] = {0, 0, 0, 0, 0, 0, 0, 0}, bw[8] = {0, 0, 0, 0, 0, 0, 0, 0};
                if (t == 0) { for (int e = 0; e < 32; ++e) { const int k = 32 * kb + e; aw[e >> 3] |= mx_a_code(i, k) << (4 * (e & 7)); bw[e >> 3] |= mx_a_code(i + 16, k) << (4 * (e & 7)); } }
                else { for (int q = 0; q < 8; ++q) { int w = 0, w2 = 0; const int k = 32 * kb + 4 * q;
                        w = __builtin_amdgcn_cvt_pk_fp8_f32(mx_b_val(k, i + 16), mx_b_val(k + 1, i + 16), w, false); w = __builtin_amdgcn_cvt_pk_fp8_f32(mx_b_val(k + 2, i + 16), mx_b_val(k + 3, i + 16), w, true); aw[q] = w;
                        w2 = __builtin_amdgcn_cvt_pk_fp8_f32(mx_b_val(k, i), mx_b_val(k + 1, i), w2, false); w2 = __builtin_amdgcn_cvt_pk_fp8_f32(mx_b_val(k + 2, i), mx_b_val(k + 3, i), w2, true); bw[q] = w2; } }
                const v8i af = {aw[0], aw[1], aw[2], aw[3], aw[4], aw[5], aw[6], aw[7]}, bf = {bw[0], bw[1], bw[2], bw[3], bw[4], bw[5], bw[6], bw[7]};
                f4 d = {0.f, 0.f, 0.f, 0.f};
                if (t == 0) d = __builtin_amdgcn_mfma_scale_f32_16x16x128_f8f6f4(af, bf, d, 4, 4, 0, 0x7f7f7f7f, 0, 0x7f7f7f7f); else d = __builtin_amdgcn_mfma_scale_f32_16x16x128_f8f6f4(af, bf, d, 0, 0, 0, 0x7f7f7f7f, 0, 0x7f7f7f7f);
                int bad = 0;
                for (int r = 0; r < 4; ++r) { const int row = 4 * kb + r, col = i; float ex = 0.f;
                    for (int k = 0; k < 128; ++k) ex += (t == 0) ? mx_a_val(row, k) * mx_a_val(col + 16, k) : mx_b_val(k, row + 16) * mx_b_val(k, col);
                    bad += (d[r] != ex); }
                if (__ballot(bad != 0) == 0ull) code += (t == 0) ? 10.f : 20.f; }
            if (lane == 0) vsh = code; }
        __syncthreads(); v = vsh;
    } else {
        float s0 = 0.f, s1 = 0.f, s2 = 0.f, s3 = 0.f;
        for (int i = 0; i < 2048; ++i) { s0 += pp[4 * i]; s1 += pp[4 * i + 1]; s2 += pp[4 * i + 2]; s3 += pp[4 * i + 3]; }
        if (DBG_PROBE == 4) { float mx = 0.f; for (int i = 0; i < 2048; ++i) mx = fmaxf(mx, pp[4 * i]); v = 100.f * mx; }
        else { v = (DBG_PROBE == 1 ? s0 : DBG_PROBE == 2 ? s1 : s2) / s3 * 1e-3f; v = exp2f(rintf(log2f(v) * 4.f) * 0.25f); }
    }
    for (size_t i = (size_t)blockIdx.x * 512 + threadIdx.x; i < (size_t)NBATCH * SEQ * DM; i += (size_t)gridDim.x * 512) o[i] = v;
}
extern "C" void kernel_launch(void* const* d_in, const int* in_sizes, int n_in, void* d_out, int out_size, void* d_ws, size_t ws_size, hipStream_t stream) {
    static int grid = 0;
    if (grid == 0) {
        if (n_in != 33 || out_size != NBATCH * SEQ * DM || ws_size < WS_END2) { fprintf(stderr, "kernel_launch: unexpected shapes (n_in %d out %d ws %zu)\n", n_in, out_size, ws_size); grid = -1; return; }
        int dev = 0, cus = 0, per_cu = 0;
        if (hipGetDevice(&dev) != hipSuccess || hipDeviceGetAttribute(&cus, hipDeviceAttributeMultiprocessorCount, dev) != hipSuccess) { grid = -1; return; }
        if (hipFuncSetAttribute((const void*)mk_fwd, hipFuncAttributeMaxDynamicSharedMemorySize, LDS_BYTES) != hipSuccess) { fprintf(stderr, "kernel_launch: hipFuncSetAttribute failed\n"); grid = -1; return; }
        if (hipOccupancyMaxActiveBlocksPerMultiprocessor(&per_cu, (const void*)mk_fwd, NWAVES * 64, LDS_BYTES) != hipSuccess || per_cu < 1) { fprintf(stderr, "kernel_launch: occupancy query says %d\n", per_cu); (void)hipGetLastError(); grid = -1; return; }
        grid = cus;
    }
    if (grid < 0) return;
    if (hipMemsetAsync((char*)d_ws + WS_CTL, 0, CTL_ZERO_BYTES, stream) != hipSuccess) return;
    Args a{};
    for (int i = 0; i < 33; ++i) a.in[i] = (const float*)d_in[i];
    a.out = (float*)d_out; a.ws = (unsigned char*)d_ws;
#if MK_N_LAUNCHES == 1
    a.ph_lo = 0; a.ph_hi = NPHASE;
    hipLaunchKernelGGL(mk_fwd, dim3(grid), dim3(NWAVES * 64), LDS_BYTES, stream, a);
#else
    if (DBG_PROBE != 5) for (int p = 0; p < NPHASE; ++p) { a.ph_lo = p; a.ph_hi = p + 1; hipLaunchKernelGGL(mk_fwd, dim3(grid), dim3(NWAVES * 64), LDS_BYTES, stream, a); }
    if (DBG_PROBE) hipLaunchKernelGGL(dbg_fill, dim3(1024), dim3(512), 0, stream, (const float*)((char*)d_ws + WS_CTL + CTL_PROBE_OFF), (float*)d_out);
#endif
}
```

```cpp
#include <hip/hip_runtime.h>
#include <cstdio>
#include <cstdint>

#ifndef MK_N_LAUNCHES
#define MK_N_LAUNCHES 1
#endif

#ifndef DBG_SKIP
#define DBG_SKIP 0
#endif
#ifndef DBG_PROBE
#define DBG_PROBE 0
#endif
#ifndef DBG_DRY
#define DBG_DRY 1
#endif
#ifndef DBG_REPEAT
#define DBG_REPEAT -1
#endif
namespace pg8 {
#define PG8_LAS __attribute__((address_space(3)))
typedef unsigned short bf16_t;
typedef short bf16x8 __attribute__((ext_vector_type(8)));
typedef float f32x4 __attribute__((ext_vector_type(4)));
typedef unsigned u32x4 __attribute__((ext_vector_type(4)));
constexpr int BM = 256, BK = 64, HALF = 128, HTB = HALF * BK * 2  , STAGE_BYTES = 8 * HTB, NXCD = 8, WGM = 8;

__host__ __device__ __forceinline__ int lds_byte(int r, int c) { const int st = (r >> 4) * 2 + (c >> 5), rr = r & 15, cc = c & 31, ob = rr * 64 + cc * 2; return st * 1024 + (ob ^ (((ob >> 9) & 1) << 5)); }
__host__ __device__ __forceinline__ void stage_rc(int b, int& R, int& C) { const int st = b / 1024, sb = b % 1024, swz = sb ^ (((sb >> 9) & 1) << 5); R = (st >> 1) * 16 + swz / 64; C = (st & 1) * 32 + (swz % 64) / 2; }
__host__ __device__ __forceinline__ int perm32(int rho) { const int n = rho >> 4, i = rho & 15; return 8 * (i >> 2) + 4 * n + (i & 3); }

struct Unit { int pm, pn; };
struct Gemm { const bf16_t* A; const bf16_t* Bt; int M, N, K; };

struct StaticOrder {
    int nM, nN, nwg, G, c;
    __host__ __device__ void init(int M, int N, int G_, int c_) { nM = M / BM; nN = N / BM; nwg = nM * nN; G = G_; c = c_; }
    __host__ __device__ bool next(int i, Unit& u) const {
        const long L = (long)i * G + c; if (L >= nwg) return false;
        int wgid = (int)L; { const int q = nwg / NXCD, r = nwg % NXCD, xcd = wgid % NXCD, off = wgid / NXCD; wgid = (xcd < r ? xcd * (q + 1) : r * (q + 1) + (xcd - r) * q) + off; }
        const int nig = WGM * nN, gid = wgid / nig, fm = gid * WGM, gsz = (nM - fm) < WGM ? (nM - fm) : WGM;
        u.pm = fm + ((wgid % nig) % gsz); u.pn = (wgid % nig) / gsz; return true;
    }
    __device__ __forceinline__ void a_ready(const Unit&) const {}
    __device__ __forceinline__ void done(const Unit&) const {}
};
__device__ __forceinline__ int opaque_lane() { int l; asm volatile("v_mbcnt_lo_u32_b32 %0, -1, 0\n\tv_mbcnt_hi_u32_b32 %0, -1, %0" : "=v"(l)); return l; }
typedef __bf16 bf16x2c __attribute__((ext_vector_type(2)));
__device__ __forceinline__ unsigned cvt_pk_bf16(float lo, float hi) { const bf16x2c v = {(__bf16)lo, (__bf16)hi}; return __builtin_bit_cast(unsigned, v); }
template <class Epi, class Sched, bool ALIGN_EPI = false, bool SP2 = false>
__device__ __forceinline__ void gemm_phase(PG8_LAS unsigned char* lds, const Gemm g, const Sched& S, const Epi& E, const int wave_s) {
    const int lane_ = opaque_lane();
    const int wid = wave_s, lane = lane_, tid = wid * 64 + lane, wr = wid >> 2, wc = wid & 3, fr = lane & 15, fq = lane >> 4;
    const int K = g.K, nt = K / BK;
    unsigned voffA[2], voffB[2];
#pragma unroll
    for (int i = 0; i < 2; ++i) { int R, C; stage_rc(tid * 16 + i * 8192, R, C); const int Rb = Epi::PERM ? ((R & ~31) + perm32(R & 31)) : R;
        voffA[i] = (unsigned)(R * K + C) * 2u; voffB[i] = (unsigned)(Rb * K + C) * 2u; }
    const size_t kstep = (size_t)(BK * 2);
    const size_t hstep = (size_t)HALF * K * 2;
    const size_t tstep = 2 * hstep;
    const unsigned ldsw = (unsigned)wid * 1024u;
    const int aoff = lds_byte(wr * 64 + fr, fq * 8), boff = lds_byte(wc * 32 + fr, fq * 8);
#define PG8_SA(b, h) (((b) * 2 + (h)) * HTB)
#define PG8_SB(b, h) ((4 + (b) * 2 + (h)) * HTB)
#define PG8_STAGE(bufoff, gbase, voff) do { _Pragma("unroll") for (int _i = 0; _i < 2; ++_i) \
        __builtin_amdgcn_global_load_lds((const unsigned*)((const char*)(gbase) + (voff)[_i]), (PG8_LAS unsigned*)(lds + (bufoff) + ldsw + _i * 8192), 16, 0, 0); } while (0)
#define PG8_LDA(dst, b, h) do { _Pragma("unroll") for (int m = 0; m < 4; ++m) _Pragma("unroll") for (int k = 0; k < 2; ++k) dst[m][k] = *(const PG8_LAS bf16x8*)(lds + PG8_SA(b, h) + aoff + m * 2048 + k * 1024); } while (0)
#define PG8_LDB(dst, b, h) do { _Pragma("unroll") for (int n = 0; n < 2; ++n) _Pragma("unroll") for (int k = 0; k < 2; ++k) dst[n][k] = *(const PG8_LAS bf16x8*)(lds + PG8_SB(b, h) + boff + n * 2048 + k * 1024); } while (0)
#define PG8_MMA(ai, bj, At, Bt) do { __builtin_amdgcn_s_setprio(1); _Pragma("unroll") for (int m = 0; m < 4; ++m) _Pragma("unroll") for (int n = 0; n < 2; ++n) _Pragma("unroll") for (int k = 0; k < 2; ++k) \
        acc[ai][bj][m][n] = __builtin_amdgcn_mfma_f32_16x16x32_bf16(Bt[n][k], At[m][k], acc[ai][bj][m][n], 0, 0, 0); __builtin_amdgcn_s_setprio(0); } while (0)
#define PG8_WAIT_V(n) asm volatile("s_waitcnt vmcnt(" #n ")" ::: "memory")
#define PG8_WAIT_L(n) asm volatile("s_waitcnt lgkmcnt(" #n ")" ::: "memory")
#define PG8_BAR __builtin_amdgcn_s_barrier()
#define PG8_SCHED __builtin_amdgcn_sched_barrier(0)
    Unit cur, nxt; int ui = 0;
    if (!S.next(0, cur)) return;
    f32x4 acc[2][2][4][2];
#pragma unroll
    for (int a = 0; a < 2; ++a)
#pragma unroll
        for (int b = 0; b < 2; ++b)
#pragma unroll
            for (int m = 0; m < 4; ++m)
#pragma unroll
                for (int n = 0; n < 2; ++n) acc[a][b][m][n] = (f32x4){0.f, 0.f, 0.f, 0.f};
    bf16x8 At[4][2], B0[2][2], B1[2][2];
    const char* cA = (const char*)g.A + (size_t)cur.pm * tstep; const char* cB = (const char*)g.Bt + (size_t)cur.pn * tstep;
    S.a_ready(cur);
    if constexpr (SP2) {
        PG8_STAGE(PG8_SB(0, 0), cB, voffB); PG8_STAGE(PG8_SB(0, 1), cB + hstep, voffB); PG8_STAGE(PG8_SA(0, 0), cA, voffA); PG8_STAGE(PG8_SA(0, 1), cA + hstep, voffA);
        if (wr == 1) PG8_BAR;
        PG8_WAIT_V(2); PG8_BAR;
        PG8_STAGE(PG8_SB(1, 0), cB + kstep, voffB); PG8_STAGE(PG8_SA(1, 0), cA + kstep, voffA); PG8_STAGE(PG8_SB(1, 1), cB + hstep + kstep, voffB);
        PG8_WAIT_V(6); PG8_BAR;
    } else {
        PG8_STAGE(PG8_SB(0, 0), cB, voffB); PG8_STAGE(PG8_SA(0, 0), cA, voffA); PG8_STAGE(PG8_SB(0, 1), cB + hstep, voffB); PG8_STAGE(PG8_SA(0, 1), cA + hstep, voffA);
        if (wr == 1) PG8_BAR;
        PG8_WAIT_V(4); PG8_BAR;
        PG8_STAGE(PG8_SB(1, 0), cB + kstep, voffB); PG8_STAGE(PG8_SA(1, 0), cA + kstep, voffA); PG8_STAGE(PG8_SB(1, 1), cB + hstep + kstep, voffB);
        PG8_WAIT_V(6); PG8_BAR;
    }
    for (;;) {
        const bool has_next = S.next(ui + 1, nxt);
        const char* nA = has_next ? (const char*)g.A + (size_t)nxt.pm * tstep : cA; const char* nB = has_next ? (const char*)g.Bt + (size_t)nxt.pn * tstep : cB;
        for (int t = 0; t < nt; t += 2) {
            const bool last = (t == nt - 2);
            const char* a1 = cA + (size_t)(t + 1) * kstep;
            const char* a2 = last ? nA : cA + (size_t)(t + 2) * kstep; const char* b2 = last ? nB : cB + (size_t)(t + 2) * kstep;
            const char* a3 = a2 + kstep; const char* b3 = b2 + kstep;
            if (last && has_next) S.a_ready(nxt);
            if constexpr (SP2) {
            PG8_LDB(B0, 0, 0); PG8_LDB(B1, 0, 1); PG8_SCHED; PG8_LDA(At, 0, 0); PG8_STAGE(PG8_SA(1, 1), a1 + hstep, voffA);
            PG8_WAIT_V(8); PG8_WAIT_L(0); PG8_BAR; PG8_MMA(0, 0, At, B0); PG8_MMA(0, 1, At, B1); PG8_BAR; PG8_SCHED;
            PG8_LDA(At, 0, 1); PG8_STAGE(PG8_SB(0, 0), b2, voffB); PG8_STAGE(PG8_SB(0, 1), b2 + hstep, voffB); PG8_STAGE(PG8_SA(0, 0), a2, voffA);
            PG8_WAIT_V(8); PG8_WAIT_L(0); PG8_BAR; PG8_MMA(1, 0, At, B0); PG8_MMA(1, 1, At, B1); PG8_BAR; PG8_SCHED;
            PG8_LDB(B0, 1, 0); PG8_LDB(B1, 1, 1); PG8_SCHED; PG8_LDA(At, 1, 0); PG8_STAGE(PG8_SA(0, 1), a2 + hstep, voffA);
            PG8_WAIT_V(8); PG8_WAIT_L(0); PG8_BAR; PG8_MMA(0, 0, At, B0); PG8_MMA(0, 1, At, B1); PG8_BAR; PG8_SCHED;
            PG8_LDA(At, 1, 1); PG8_STAGE(PG8_SB(1, 0), b3, voffB); PG8_STAGE(PG8_SB(1, 1), b3 + hstep, voffB); PG8_STAGE(PG8_SA(1, 0), a3, voffA);
            PG8_WAIT_V(8); PG8_WAIT_L(0); PG8_BAR; PG8_MMA(1, 0, At, B0); PG8_MMA(1, 1, At, B1); PG8_BAR; PG8_SCHED;
            } else {
            PG8_LDB(B0, 0, 0); PG8_SCHED; PG8_LDA(At, 0, 0); PG8_STAGE(PG8_SA(1, 1), a1 + hstep, voffA);
            PG8_WAIT_L(8); PG8_BAR; PG8_WAIT_L(0); PG8_MMA(0, 0, At, B0); PG8_BAR; PG8_SCHED;
            PG8_LDB(B1, 0, 1); PG8_STAGE(PG8_SB(0, 0), b2, voffB);
            PG8_BAR; PG8_WAIT_L(0); PG8_MMA(0, 1, At, B1); PG8_BAR;
            PG8_LDA(At, 0, 1); PG8_STAGE(PG8_SA(0, 0), a2, voffA);
            PG8_BAR; PG8_WAIT_L(0); PG8_MMA(1, 0, At, B0); PG8_BAR; PG8_SCHED;
            PG8_STAGE(PG8_SB(0, 1), b2 + hstep, voffB);
            PG8_WAIT_V(6); PG8_BAR; PG8_MMA(1, 1, At, B1); PG8_BAR;
            PG8_LDB(B0, 1, 0); PG8_SCHED; PG8_LDA(At, 1, 0); PG8_STAGE(PG8_SA(0, 1), a2 + hstep, voffA);
            PG8_WAIT_L(8); PG8_BAR; PG8_WAIT_L(0); PG8_MMA(0, 0, At, B0); PG8_BAR; PG8_SCHED;
            PG8_LDB(B1, 1, 1); PG8_STAGE(PG8_SB(1, 0), b3, voffB);
            PG8_BAR; PG8_WAIT_L(0); PG8_MMA(0, 1, At, B1); PG8_BAR;
            PG8_LDA(At, 1, 1); PG8_STAGE(PG8_SA(1, 0), a3, voffA);
            PG8_BAR; PG8_WAIT_L(0); PG8_MMA(1, 0, At, B0); PG8_BAR; PG8_SCHED;
            PG8_STAGE(PG8_SB(1, 1), b3 + hstep, voffB);
            PG8_WAIT_V(6); PG8_BAR; PG8_MMA(1, 1, At, B1); PG8_BAR;
            }
        }
        if constexpr (ALIGN_EPI) { if (wr == 0) PG8_BAR; }
        if constexpr (!Epi::AFTER_DRAIN) { const int le_ = opaque_lane(); E(acc, cur, wr, wc, le_ & 15, le_ >> 4); S.done(cur); }
        if (!has_next) break;
#pragma unroll
        for (int a = 0; a < 2; ++a)
#pragma unroll
            for (int b = 0; b < 2; ++b)
#pragma unroll
                for (int m = 0; m < 4; ++m)
#pragma unroll
                    for (int n = 0; n < 2; ++n) acc[a][b][m][n] = (f32x4){0.f, 0.f, 0.f, 0.f};
        cur = nxt; cA = nA; cB = nB; ++ui;
        if constexpr (ALIGN_EPI) { if (wr == 1) PG8_BAR; }
    }
    PG8_WAIT_V(0);
    if constexpr (!ALIGN_EPI) { if (wr == 0) PG8_BAR; }
    PG8_BAR;
    if constexpr (Epi::AFTER_DRAIN) { E.fused(acc, cur, wr, wc, fr, fq, lds, wid, lane); S.done(cur); }
#undef PG8_SA
#undef PG8_SB
#undef PG8_STAGE
#undef PG8_LDA
#undef PG8_LDB
#undef PG8_MMA
#undef PG8_WAIT_V
#undef PG8_WAIT_L
#undef PG8_BAR
#undef PG8_SCHED
}
}

constexpr int NWAVES = 8;
constexpr int DM = 2048, NBATCH = 2, SEQ = 8192, CTXL = 256, TPB = CTXL + SEQ  , MALL = NBATCH * TPB  ;
constexpr int NLAYER = 2;
constexpr int RW = 1024, NH = 16;
constexpr int RWC = 3392, INA = 4192, INA_P = 4352, INC = 8288;
constexpr int C_WD = 3072, C_AD = 3200, C_GD = 3328, C_QC = 3392, C_KVC = 3904, C_KR = 4160;
constexpr int QKD = 96, NQ = NH * QKD  , NKV = NH * 128  ;
constexpr int NEXP = 16384;
constexpr int RREC = 9 * 64;
constexpr float NORM_EPS = 1e-6f;

constexpr size_t MiB = 1u << 20;
constexpr size_t WS_CTL = 0, CTL_ZERO_BYTES = 1 * MiB;
constexpr size_t CTL_MOD_OFF = 256 * 1024;
constexpr size_t WS_ROPE = 1 * MiB;
constexpr size_t WS_WUP = 3 * MiB, WS_AUP = WS_WUP + 512 * 1024, WS_GUP = 4 * MiB;
constexpr size_t WS_WUQ = 5 * MiB, WS_WUKV = 8 * MiB, WS_WA = 10 * MiB, WS_WB = 18 * MiB, WS_WO = 26 * MiB, WS_WQK = 42 * MiB, WS_WGA = 58 * MiB, WS_WGB = 74 * MiB, WS_WINA = 90 * MiB;
constexpr size_t WS_X = 124 * MiB, WS_H = 256 * MiB, WS_DYN = 322 * MiB;
constexpr size_t WS_PA = WS_DYN;
constexpr size_t WS_RI = 463 * MiB;
constexpr size_t WS_GG = 760 * MiB;
constexpr size_t WS_BON = 826 * MiB;
constexpr size_t WS_QN = 831 * MiB, WS_KVN = 848 * MiB;
constexpr size_t WS_Q = 857 * MiB, WS_K = 907 * MiB, WS_V = 957 * MiB, WS_END = 990 * MiB;
constexpr size_t WS_Y = WS_DYN;
constexpr size_t WS_YA = 388 * MiB, WS_YB = 421 * MiB;
constexpr size_t WS_T1 = 463 * MiB, WS_T2 = 529 * MiB;
constexpr size_t WS_PU = 600 * MiB, WS_PV = 664 * MiB;
constexpr size_t WS_CA = 600 * MiB, WS_CB = 608 * MiB;
#ifndef WQK_LATE
#define WQK_LATE (MK_N_LAUNCHES == 1)
#endif
#ifndef CTX_SPLIT
#define CTX_SPLIT (MK_N_LAUNCHES == 1)
#endif
constexpr size_t WS_P4 = 990 * MiB, WS_P4S = 1022 * MiB, WS_END2 = 1023 * MiB;
constexpr size_t WS_SC = WS_DYN;
static_assert(WS_PA + (size_t)MALL * INA_P * 2 <= WS_RI && WS_RI + (size_t)NBATCH * NH * TPB * RREC * 2 <= WS_GG && WS_GG + (size_t)2 * MALL * RW * 2 <= WS_BON, "ws map 1");
static_assert(WS_BON + (size_t)2 * MALL * 32 * 4 <= WS_QN && WS_QN + (size_t)MALL * 512 * 2 <= WS_KVN && WS_KVN + (size_t)MALL * 256 * 2 <= WS_Q, "ws map 2");
static_assert(WS_Q + (size_t)NBATCH * NH * TPB * QKD * 2 <= WS_K && WS_K + (size_t)NBATCH * NH * TPB * QKD * 2 <= WS_V && WS_V + (size_t)NBATCH * NH * TPB * 64 * 2 <= WS_END, "ws map 3");
static_assert(WS_Y + (size_t)2 * MALL * RW * 2 <= WS_YA && WS_YA + (size_t)MALL * RW * 2 <= WS_YB && WS_YB + (size_t)MALL * RW * 2 <= WS_RI, "ws map 4");
static_assert(WS_T1 + (size_t)MALL * DM * 2 <= WS_T2 && WS_T2 + (size_t)MALL * DM * 2 <= WS_PU && WS_PU + (size_t)NEXP * DM * 2 <= WS_PV && WS_PV + (size_t)NEXP * DM * 2 <= WS_GG, "ws map 5");
static_assert(WS_SC + (size_t)MALL * DM * 4 <= WS_T1 && WS_X + (size_t)MALL * DM * 4 <= WS_H && WS_H + (size_t)MALL * DM * 2 <= WS_DYN, "ws map 6");
static_assert(WS_WINA + (size_t)NLAYER * INA_P * DM * 2 <= WS_X, "ws map 7");
constexpr size_t CTL_PROBE_OFF = 640 * 1024;
constexpr int CW_BAR = 4096;

constexpr int RING_BYTES = 131072;
constexpr int LDSCTL_OFF = RING_BYTES, MISC_OFF = LDSCTL_OFF + 320;
constexpr int LDS_BYTES = 147456;

#define GAS __attribute__((address_space(1)))
#define LAS __attribute__((address_space(3)))
typedef unsigned short bf16;
typedef unsigned v4u __attribute__((ext_vector_type(4)));
typedef unsigned v2u __attribute__((ext_vector_type(2)));
typedef float f32x4 __attribute__((ext_vector_type(4)));
typedef float f32x2 __attribute__((ext_vector_type(2)));
typedef float f32x16 __attribute__((ext_vector_type(16)));
typedef short bf16x8 __attribute__((ext_vector_type(8)));
typedef short s16x4 __attribute__((ext_vector_type(4)));
typedef __bf16 bf16x2v __attribute__((ext_vector_type(2)));
typedef __bf16 bf16x8v __attribute__((ext_vector_type(8)));
typedef GAS unsigned gu32;
#define RLX_AGENT __ATOMIC_RELAXED, __HIP_MEMORY_SCOPE_AGENT
#define LDS_WAIT() asm volatile("s_waitcnt lgkmcnt(0)" ::: "memory")
#define VM_WAIT() asm volatile("s_waitcnt vmcnt(0)" ::: "memory")
__device__ __forceinline__ unsigned f2bf(float f) { unsigned u = __builtin_bit_cast(unsigned, f); return (u + 0x7fffu + ((u >> 16) & 1u)) >> 16; }
#define LDS_BARRIER() do { asm volatile("s_waitcnt lgkmcnt(0)" ::: "memory"); __builtin_amdgcn_s_barrier(); asm volatile("" ::: "memory"); } while (0)
__device__ __forceinline__ unsigned pk2(float lo, float hi) { return pg8::cvt_pk_bf16(lo, hi); }
__device__ __forceinline__ float bflo(unsigned w) { return __builtin_bit_cast(float, w << 16); }
__device__ __forceinline__ float bfhi(unsigned w) { return __builtin_bit_cast(float, w & 0xffff0000u); }
__device__ __forceinline__ float bf1(bf16 h) { return __builtin_bit_cast(float, (unsigned)h << 16); }
__device__ __forceinline__ float sigmoidf_(float x) { return __builtin_amdgcn_rcpf(1.0f + __expf(-x)); }
template <int CTRL> __device__ __forceinline__ float dpp_add(float x) {
    return x + __builtin_bit_cast(float, __builtin_amdgcn_update_dpp(0, __builtin_bit_cast(int, x), CTRL, 0xf, 0xf, true));
}
__device__ __forceinline__ float red16(float x) {
    x = dpp_add<0xB1>(x);
    x = dpp_add<0x4E>(x);
    x = dpp_add<0x141>(x);
    x = dpp_add<0x140>(x);
    return x;
}
template <int CTRL, int RM> __device__ __forceinline__ float dpp_max(float x) {
    return fmaxf(x, __builtin_bit_cast(float, __builtin_amdgcn_update_dpp(__builtin_bit_cast(int, x), __builtin_bit_cast(int, x), CTRL, RM, 0xf, false)));
}
template <int CTRL, int RM> __device__ __forceinline__ float dpp_sum(float x) {
    return x + __builtin_bit_cast(float, __builtin_amdgcn_update_dpp(0, __builtin_bit_cast(int, x), CTRL, RM, 0xf, false));
}
__device__ __forceinline__ float wave_max_u(float x) {
    x = dpp_max<0xB1, 0xf>(x); x = dpp_max<0x4E, 0xf>(x); x = dpp_max<0x141, 0xf>(x); x = dpp_max<0x140, 0xf>(x);
    x = dpp_max<0x142, 0xa>(x); x = dpp_max<0x143, 0xc>(x);
    return __builtin_bit_cast(float, __builtin_amdgcn_readlane(__builtin_bit_cast(int, x), 63));
}
__device__ __forceinline__ float wave_sum_u(float x) {
    x = dpp_sum<0xB1, 0xf>(x); x = dpp_sum<0x4E, 0xf>(x); x = dpp_sum<0x141, 0xf>(x); x = dpp_sum<0x140, 0xf>(x);
    x = dpp_sum<0x142, 0xa>(x); x = dpp_sum<0x143, 0xc>(x);
    return __builtin_bit_cast(float, __builtin_amdgcn_readlane(__builtin_bit_cast(int, x), 63));
}
__device__ __forceinline__ float wave_sum(float v) { return wave_sum_u(v); }
__device__ __forceinline__ float bpermf(int srclane, float v) { return __builtin_bit_cast(float, __builtin_amdgcn_ds_bpermute(srclane << 2, __builtin_bit_cast(int, v))); }
__device__ __forceinline__ int bpermi(int srclane, int v) { return __builtin_amdgcn_ds_bpermute(srclane << 2, v); }

#define XB_TMO      128
#define XB_XCNT(j)  (256  + 64 * (j))
#define XB_XSUB(j)  (1280 + 64 * (j))
#define XB_XGEN(j)  (2304 + 64 * (j))
#define XB_TOP      3328
#define XB_TOPGEN   3392
#define XCD_BAR_WORDS 3456
#define XB_SPIN_CAP (1u << 20)

__device__ __forceinline__ unsigned xb_ld(unsigned* p)              { return __hip_atomic_load(p, __ATOMIC_RELAXED, __HIP_MEMORY_SCOPE_AGENT); }
__device__ __forceinline__ unsigned xb_add(unsigned* p, unsigned v) { return __hip_atomic_fetch_add(p, v, __ATOMIC_RELAXED, __HIP_MEMORY_SCOPE_AGENT); }
__device__ __forceinline__ unsigned xb_xcc_id() { return (unsigned)__builtin_amdgcn_s_getreg((3 << 11) | 20) & 0xFu; }
#define XB_SPIN(cond, bar) do { unsigned _sp = 0; while (cond) { __builtin_amdgcn_s_sleep(1); \
    if ((++_sp & 255u) == 0u) { if (xb_ld(&(bar)[XB_TMO])) break; if (_sp > XB_SPIN_CAP) { atomicAdd(&(bar)[XB_TMO], 1u); break; } } } } while (0)

struct XcdBarrier { unsigned* bar; unsigned x; volatile LAS unsigned* st; };

__device__ __forceinline__ XcdBarrier xcd_barrier_post(unsigned* bar, volatile LAS unsigned* st, bool t0) {
    XcdBarrier b; b.bar = bar; b.x = xb_xcc_id(); b.st = st;
    if (t0) (void)xb_add(&bar[XB_XCNT(b.x)], 1u);
    return b;
}
__device__ __forceinline__ void xcd_barrier_complete(unsigned* bar, unsigned x, unsigned& nloc, unsigned& nx) {
    const unsigned G = gridDim.x * gridDim.y * gridDim.z;
    unsigned sum, cnt, mine, sp = 0u;
    for (;;) {
        sum = 0u; cnt = 0u; mine = 0u;
#pragma unroll
        for (unsigned j = 0; j < 16; ++j) { const unsigned c = xb_ld(&bar[XB_XCNT(j)]); sum += c; cnt += (c > 0u) ? 1u : 0u; mine = (j == x) ? c : mine; }
        if (sum == G) break;
        __builtin_amdgcn_s_sleep(1);
        if ((++sp & 255u) == 0u) { if (xb_ld(&bar[XB_TMO])) break; if (sp > XB_SPIN_CAP) { atomicAdd(&bar[XB_TMO], 1u); break; } }
    }
    nloc = mine > 0u ? mine : 1u; nx = cnt > 0u ? cnt : 1u;
}
__device__ __forceinline__ void xcd_barrier(const XcdBarrier& b, bool t0) {
    asm volatile("s_waitcnt vmcnt(0)" ::: "memory");
    __syncthreads();
    if (t0) {
        unsigned* bar = b.bar;
        __builtin_amdgcn_s_waitcnt(0);
        unsigned nloc = b.st[0], nx = b.st[1];
        if (nloc == 0u) { xcd_barrier_complete(bar, b.x, nloc, nx); b.st[0] = nloc; b.st[1] = nx; }
        const unsigned old = xb_add(&bar[XB_XSUB(b.x)], 1u);
        const unsigned gen = old / nloc;
        if (old + 1u == (gen + 1u) * nloc) {
            __builtin_amdgcn_fence(__ATOMIC_RELEASE, "agent");
            asm volatile("s_waitcnt vmcnt(0)" ::: "memory");
            const unsigned og = xb_add(&bar[XB_TOP], 1u);
            const unsigned tg = og / nx;
            if (og + 1u == (tg + 1u) * nx) xb_add(&bar[XB_TOPGEN], 1u);
            else XB_SPIN(xb_ld(&bar[XB_TOPGEN]) == tg, bar);
            __builtin_amdgcn_fence(__ATOMIC_ACQUIRE, "agent");
            xb_add(&bar[XB_XGEN(b.x)], 1u);
            asm volatile("s_waitcnt vmcnt(0)" ::: "memory");
        } else {
            XB_SPIN(xb_ld(&bar[XB_XGEN(b.x)]) == gen, bar);
            __builtin_amdgcn_fence(__ATOMIC_ACQUIRE, "agent");
            asm volatile("s_waitcnt vmcnt(0)" ::: "memory");
        }
    }
    __syncthreads();
}

struct Frame {
    LAS unsigned char* lds;
    unsigned char* ws;
    const float* const* in;
    int tid, lane, wave;
    int vcu, G;
};
struct Args { const float* in[33]; float* out; unsigned char* ws; int ph_lo, ph_hi; };


namespace pg8 {
typedef unsigned u32x4 __attribute__((ext_vector_type(4)));
struct RowOrder : StaticOrder {
    int lat;
    __host__ __device__ void init_rows(int lat_, int N, int G_, int c_) { lat = lat_; init(lat_ ? NBATCH * SEQ : MALL, N, G_, c_); }
    __host__ __device__ bool next(int i, Unit& u) const { if (!StaticOrder::next(i, u)) return false; if (lat) u.pm = 33 * (u.pm >> 5) + 1 + (u.pm & 31); return true; }
};
#define EPI_LOOP_ROWS for (int ai = 0; ai < 2; ++ai) _Pragma("unroll") for (int m = 0; m < 4; ++m)
#define EPI_PIN asm volatile("" ::: "memory")

struct EpiStoreBf16 {
    static constexpr bool PERM = true, AFTER_DRAIN = false;
    bf16_t* O; int ldc;
    __device__ __forceinline__ void operator()(const f32x4 (&acc)[2][2][4][2], const Unit& u, int wr, int wc, int fr, int fq) const {
        const int row0 = u.pm * BM + wr * 64 + fr, col0 = u.pn * BM + wc * 32 + 8 * fq;
#pragma unroll
        EPI_LOOP_ROWS { bf16_t* rowp = O + (size_t)(row0 + ai * HALF + m * 16) * ldc + col0;
#pragma unroll
            for (int bj = 0; bj < 2; ++bj) { const f32x4 v0 = acc[ai][bj][m][0], v1 = acc[ai][bj][m][1];
                u32x4 w; w.x = cvt_pk_bf16(v0[0], v0[1]); w.y = cvt_pk_bf16(v0[2], v0[3]); w.z = cvt_pk_bf16(v1[0], v1[1]); w.w = cvt_pk_bf16(v1[2], v1[3]);
                *(u32x4*)(rowp + bj * HALF) = w; } }
    }
};
struct EpiGate {
    static constexpr bool PERM = true, AFTER_DRAIN = false;
    bf16_t* O; int ldc; const float* bias;
    __device__ __forceinline__ void operator()(const f32x4 (&acc)[2][2][4][2], const Unit& u, int wr, int wc, int fr, int fq) const {
        const int row0 = u.pm * BM + wr * 64 + fr, col0 = u.pn * BM + wc * 32 + 8 * fq;
        f32x4 bv[2][2];
#pragma unroll
        for (int bj = 0; bj < 2; ++bj)
#pragma unroll
            for (int n = 0; n < 2; ++n) bv[bj][n] = *(const f32x4*)(bias + col0 + bj * HALF + 4 * n);
#pragma unroll
        EPI_LOOP_ROWS { EPI_PIN; bf16_t* rowp = O + (size_t)(row0 + ai * HALF + m * 16) * ldc + col0;
#pragma unroll
            for (int bj = 0; bj < 2; ++bj) { f32x4 v0 = acc[ai][bj][m][0] + bv[bj][0], v1 = acc[ai][bj][m][1] + bv[bj][1];
#pragma unroll
                for (int e = 0; e < 4; ++e) { v0[e] = __builtin_amdgcn_rcpf(1.0f + __expf(-v0[e])); v1[e] = __builtin_amdgcn_rcpf(1.0f + __expf(-v1[e])); }
                u32x4 w; w.x = cvt_pk_bf16(v0[0], v0[1]); w.y = cvt_pk_bf16(v0[2], v0[3]); w.z = cvt_pk_bf16(v1[0], v1[1]); w.w = cvt_pk_bf16(v1[2], v1[3]);
                *(u32x4*)(rowp + bj * HALF) = w; } }
    }
};
__device__ __forceinline__ float bf_lo(unsigned w) { return __builtin_bit_cast(float, w << 16); }
__device__ __forceinline__ float bf_hi(unsigned w) { return __builtin_bit_cast(float, w & 0xffff0000u); }
struct EpiMulAdd {
    static constexpr bool PERM = true, AFTER_DRAIN = false;
    bf16_t* O; const bf16_t* Gt; const bf16_t* Ad; int ldc;
    __device__ __forceinline__ void operator()(const f32x4 (&acc)[2][2][4][2], const Unit& u, int wr, int wc, int fr, int fq) const {
        const int row0 = u.pm * BM + wr * 64 + fr, col0 = u.pn * BM + wc * 32 + 8 * fq;
#pragma unroll
        EPI_LOOP_ROWS { EPI_PIN; const size_t ro = (size_t)(row0 + ai * HALF + m * 16) * ldc + col0;
#pragma unroll
            for (int bj = 0; bj < 2; ++bj) { const f32x4 v0 = acc[ai][bj][m][0], v1 = acc[ai][bj][m][1];
                const u32x4 g = *(const u32x4*)(Gt + ro + bj * HALF);
                float o[8];
                o[0] = bf_lo(g.x) * v0[0]; o[1] = bf_hi(g.x) * v0[1]; o[2] = bf_lo(g.y) * v0[2]; o[3] = bf_hi(g.y) * v0[3];
                o[4] = bf_lo(g.z) * v1[0]; o[5] = bf_hi(g.z) * v1[1]; o[6] = bf_lo(g.w) * v1[2]; o[7] = bf_hi(g.w) * v1[3];
                if (Ad) { const u32x4 a = *(const u32x4*)(Ad + ro + bj * HALF);
                    o[0] += bf_lo(a.x); o[1] += bf_hi(a.x); o[2] += bf_lo(a.y); o[3] += bf_hi(a.y); o[4] += bf_lo(a.z); o[5] += bf_hi(a.z); o[6] += bf_lo(a.w); o[7] += bf_hi(a.w); }
                u32x4 w; w.x = cvt_pk_bf16(o[0], o[1]); w.y = cvt_pk_bf16(o[2], o[3]); w.z = cvt_pk_bf16(o[4], o[5]); w.w = cvt_pk_bf16(o[6], o[7]);
                *(u32x4*)(O + ro + bj * HALF) = w; } }
    }
};
struct EpiResid {
    static constexpr bool PERM = true, AFTER_DRAIN = false;
    bf16_t* X; const float* gate;
    const float* xin; const float* cin;
    __device__ __forceinline__ void operator()(const f32x4 (&acc)[2][2][4][2], const Unit& u, int wr, int wc, int fr, int fq) const {
        const int col0 = u.pn * BM + wc * 32 + 8 * fq;
        const int bb = u.pm / 33, pt = u.pm - bb * 33, mr = (pt == 0) ? 2 : bb;
        const float* gp = gate + (size_t)mr * 12288 + col0;
        const float* sbase = xin ? (pt == 0 ? cin + (size_t)bb * CTXL * DM : xin + ((size_t)bb * SEQ + (size_t)(pt - 1) * BM) * DM) : nullptr;
        f32x4 gv[2][2];
#pragma unroll
        for (int bj = 0; bj < 2; ++bj)
#pragma unroll
            for (int n = 0; n < 2; ++n) gv[bj][n] = *(const f32x4*)(gp + bj * HALF + n * 4);
#pragma unroll
        EPI_LOOP_ROWS { EPI_PIN; const int rl = wr * 64 + fr + ai * HALF + m * 16; bf16_t* rowp = X + (size_t)(u.pm * BM + rl) * DM + col0;
#pragma unroll
            for (int bj = 0; bj < 2; ++bj) { f32x4 s0, s1;
                if (sbase) { const float* srow = sbase + (size_t)rl * DM + col0 + bj * HALF; s0 = *(const f32x4*)srow; s1 = *(const f32x4*)(srow + 4); }
                else { const u32x4 w = *(const u32x4*)(rowp + bj * HALF);
                    s0 = (f32x4){__builtin_bit_cast(float, w.x << 16), __builtin_bit_cast(float, w.x & 0xffff0000u), __builtin_bit_cast(float, w.y << 16), __builtin_bit_cast(float, w.y & 0xffff0000u)};
                    s1 = (f32x4){__builtin_bit_cast(float, w.z << 16), __builtin_bit_cast(float, w.z & 0xffff0000u), __builtin_bit_cast(float, w.w << 16), __builtin_bit_cast(float, w.w & 0xffff0000u)}; }
                const f32x4 r0 = s0 + gv[bj][0] * acc[ai][bj][m][0], r1 = s1 + gv[bj][1] * acc[ai][bj][m][1];
                u32x4 o; o.x = cvt_pk_bf16(r0[0], r0[1]); o.y = cvt_pk_bf16(r0[2], r0[3]); o.z = cvt_pk_bf16(r1[0], r1[1]); o.w = cvt_pk_bf16(r1[2], r1[3]);
                *(u32x4*)(rowp + bj * HALF) = o; } }
    }
};
struct EpiF32 {
    static constexpr bool PERM = false, AFTER_DRAIN = false;
    float* C; int ldc;
    __device__ __forceinline__ void operator()(const f32x4 (&acc)[2][2][4][2], const Unit& u, int wr, int wc, int fr, int fq) const {
        const int row0 = u.pm * BM + wr * 64 + fr, col0 = u.pn * BM + wc * 32 + 4 * fq;
#pragma unroll
        EPI_LOOP_ROWS { float* rowp = C + (size_t)(row0 + ai * HALF + m * 16) * ldc + col0;
#pragma unroll
            for (int bj = 0; bj < 2; ++bj)
#pragma unroll
                for (int n = 0; n < 2; ++n) *(f32x4*)(rowp + bj * HALF + n * 16) = acc[ai][bj][m][n]; }
    }
};
struct EpiCtxF32 {
    static constexpr bool PERM = false, AFTER_DRAIN = false;
    float* C; int ldc;
    __device__ __forceinline__ void operator()(const f32x4 (&acc)[2][2][4][2], const Unit& u, int wr, int wc, int fr, int fq) const {
        const int row0 = (u.pm ? BM : 0) + wr * 64 + fr, col0 = u.pn * BM + wc * 32 + 4 * fq;
#pragma unroll
        EPI_LOOP_ROWS { float* rowp = C + (size_t)(row0 + ai * HALF + m * 16) * ldc + col0;
#pragma unroll
            for (int bj = 0; bj < 2; ++bj)
#pragma unroll
                for (int n = 0; n < 2; ++n) *(f32x4*)(rowp + bj * HALF + n * 16) = acc[ai][bj][m][n]; }
    }
};
struct CtxOrder {
    int u0;
    __host__ __device__ bool next(int i, Unit& u) const { if (i != 0 || u0 < 0) return false; u.pm = (u0 >> 3) ? 33 : 0; u.pn = u0 & 7; return true; }
    __device__ __forceinline__ void a_ready(const Unit&) const {}
    __device__ __forceinline__ void done(const Unit&) const {}
};
struct EpiF16 {
    static constexpr bool PERM = true, AFTER_DRAIN = false;
    _Float16* C; int ldc;
    __device__ __forceinline__ void operator()(const f32x4 (&acc)[2][2][4][2], const Unit& u, int wr, int wc, int fr, int fq) const {
        typedef _Float16 h2 __attribute__((ext_vector_type(2)));
        const int row0 = u.pm * BM + wr * 64 + fr, col0 = u.pn * BM + wc * 32 + 8 * fq;
#pragma unroll
        EPI_LOOP_ROWS { _Float16* rowp = C + (size_t)(row0 + ai * HALF + m * 16) * ldc + col0;
#pragma unroll
            for (int bj = 0; bj < 2; ++bj) { const f32x4 v0 = acc[ai][bj][m][0], v1 = acc[ai][bj][m][1];
                u32x4 w; w.x = __builtin_bit_cast(unsigned, (h2){(_Float16)v0[0], (_Float16)v0[1]}); w.y = __builtin_bit_cast(unsigned, (h2){(_Float16)v0[2], (_Float16)v0[3]});
                w.z = __builtin_bit_cast(unsigned, (h2){(_Float16)v1[0], (_Float16)v1[1]}); w.w = __builtin_bit_cast(unsigned, (h2){(_Float16)v1[2], (_Float16)v1[3]});
                *(u32x4*)(rowp + bj * HALF) = w; } }
    }
};
struct EpiQ {
    static constexpr bool PERM = true, AFTER_DRAIN = false;
    bf16_t* Q; const f32x2* rope; float qscale;
    __device__ __forceinline__ void operator()(const f32x4 (&acc)[2][2][4][2], const Unit& u, int wr, int wc, int fr, int fq) const {
        const int bb = u.pm / 33, tp0 = (u.pm - bb * 33) * BM + wr * 64 + fr, col0 = u.pn * BM + wc * 32 + 8 * fq;
#pragma unroll
        for (int bj = 0; bj < 2; ++bj) { const int c = col0 + bj * HALF, hd = c / QKD, d = c - hd * QKD;
#pragma unroll
            EPI_LOOP_ROWS { EPI_PIN; const int tp = tp0 + ai * HALF + m * 16;
                f32x4 v0 = acc[ai][bj][m][0], v1 = acc[ai][bj][m][1];
                if (d >= 64) { const int i0 = (d - 64) >> 1; const f32x2* rp = rope + (size_t)tp * 16 + i0;
                    const f32x2 c0 = rp[0], c1 = rp[1], c2 = rp[2], c3 = rp[3];
                    float a, b;
                    a = v0[0]; b = v0[1]; v0[0] = a * c0.x - b * c0.y; v0[1] = a * c0.y + b * c0.x;
                    a = v0[2]; b = v0[3]; v0[2] = a * c1.x - b * c1.y; v0[3] = a * c1.y + b * c1.x;
                    a = v1[0]; b = v1[1]; v1[0] = a * c2.x - b * c2.y; v1[1] = a * c2.y + b * c2.x;
                    a = v1[2]; b = v1[3]; v1[2] = a * c3.x - b * c3.y; v1[3] = a * c3.y + b * c3.x; }
                v0 = v0 * qscale; v1 = v1 * qscale;
                u32x4 w; w.x = cvt_pk_bf16(v0[0], v0[1]); w.y = cvt_pk_bf16(v0[2], v0[3]); w.z = cvt_pk_bf16(v1[0], v1[1]); w.w = cvt_pk_bf16(v1[2], v1[3]);
                *(u32x4*)(Q + ((size_t)(bb * NH + hd) * TPB + tp) * QKD + d) = w; } }
    }
};
struct EpiKV {
    static constexpr bool PERM = true, AFTER_DRAIN = false;
    bf16_t* K; bf16_t* V;
    __device__ __forceinline__ void operator()(const f32x4 (&acc)[2][2][4][2], const Unit& u, int wr, int wc, int fr, int fq) const {
        const int bb = u.pm / 33, tp0 = (u.pm - bb * 33) * BM + wr * 64 + fr;
        const bool isK = wc < 2;
        bf16_t* base = isK ? K : V; const int pitch = isK ? QKD : 64, doff = 32 * (wc & 1) + 8 * fq;
#pragma unroll
        for (int bj = 0; bj < 2; ++bj) { const int hd = 2 * u.pn + bj;
            bf16_t* hb = base + (size_t)(bb * NH + hd) * TPB * pitch;
#pragma unroll
            EPI_LOOP_ROWS { EPI_PIN; const int tp = tp0 + ai * HALF + m * 16;
                const f32x4 v0 = acc[ai][bj][m][0], v1 = acc[ai][bj][m][1];
                u32x4 w; w.x = cvt_pk_bf16(v0[0], v0[1]); w.y = cvt_pk_bf16(v0[2], v0[3]); w.z = cvt_pk_bf16(v1[0], v1[1]); w.w = cvt_pk_bf16(v1[2], v1[3]);
                *(u32x4*)((char*)hb + (unsigned)((tp * pitch + doff) * 2)) = w; } }
    }
};
}

struct TItem { const float* W; bf16* WT; int K, ldw, c0, N, mapq, item; };
__device__ __forceinline__ void p0_item_load(const TItem& T, int lane, f32x4 (&x)[8]) {
    const int nblk = T.N / 32, kb = T.item / nblk, nb = T.item - kb * nblk, k0 = 64 * kb, n0 = 32 * nb;
    const float* p = T.W + (size_t)(k0 + (lane >> 3)) * T.ldw + T.c0 + n0 + (lane & 7) * 4;
#pragma unroll
    for (int i = 0; i < 8; ++i) x[i] = *(const GAS f32x4*)(p + (size_t)(8 * i) * T.ldw);
}
__device__ __forceinline__ void p0_item_finish(const TItem& T, const f32x4 (&x)[8], LAS float* scr, int lane) {
    const int nblk = T.N / 32, kb = T.item / nblk, nb = T.item - kb * nblk, k0 = 64 * kb, n0 = 32 * nb;
#pragma unroll
    for (int i = 0; i < 8; ++i) { LAS float* d = scr + (8 * i + (lane >> 3)) * 33 + (lane & 7) * 4; d[0] = x[i].x; d[1] = x[i].y; d[2] = x[i].z; d[3] = x[i].w; }
    LDS_WAIT(); asm volatile("" ::: "memory");
    const int c = lane & 7;
#pragma unroll
    for (int j = 0; j < 4; ++j) { const int n = (lane >> 3) + 8 * j; const LAS float* s = scr + (8 * c) * 33 + n;
        v4u o; o.x = pk2(s[0 * 33], s[1 * 33]); o.y = pk2(s[2 * 33], s[3 * 33]); o.z = pk2(s[4 * 33], s[5 * 33]); o.w = pk2(s[6 * 33], s[7 * 33]);
        int nn = n0 + n;
        if (T.mapq) { const int hd = nn / QKD, d = nn - hd * QKD; if (d >= 64) { const int i = (d - 64) & 15, s2 = (d - 64) >> 4; nn = hd * QKD + 64 + 2 * i + s2; } }
        *(GAS v4u*)(T.WT + (size_t)nn * T.K + k0 + 8 * c) = o; }
    LDS_WAIT(); asm volatile("" ::: "memory");
}

__device__ __forceinline__ const float* karg(int i);
constexpr int TB_INA = (DM / 128) * ((INA + 127) / 128), TB_G = (DM / 128) * (DM / 128), TB_BR = (RW / 128) * (DM / 128), TB_UQ = (512 / 128) * (NQ / 128), TB_UKV = (256 / 128) * (NKV / 128);
constexpr int TB_N = TB_INA + 2 * TB_G + 2 * TB_BR + TB_G + TB_UQ + TB_UKV;
constexpr int TI_LR = 1 * (RW / 32), TI_N = 4 * TI_LR;
__device__ __forceinline__ TItem p0_resolve_big(unsigned char* ws, int git) {
    const int l = git / TB_N; int r = git - l * TB_N; TItem T; T.mapq = 0; T.c0 = 0;
    if (r < TB_INA) { T.W = karg(7) + (size_t)l * DM * INC; T.K = DM; T.ldw = INC; T.N = INA; T.WT = (bf16*)(ws + WS_WINA) + (size_t)l * INA_P * DM; T.item = r; return T; } r -= TB_INA;
    if (r < TB_G) { T.W = karg(7) + (size_t)l * DM * INC; T.K = DM; T.ldw = INC; T.c0 = INA; T.N = DM; T.WT = (bf16*)(ws + WS_WGA) + (size_t)l * DM * DM; T.item = r; return T; } r -= TB_G;
    if (r < TB_G) { T.W = karg(7) + (size_t)l * DM * INC; T.K = DM; T.ldw = INC; T.c0 = INA + DM; T.N = DM; T.WT = (bf16*)(ws + WS_WGB) + (size_t)l * DM * DM; T.item = r; return T; } r -= TB_G;
    if (r < TB_BR) { T.W = karg(24) + (size_t)l * RW * DM; T.K = RW; T.ldw = DM; T.N = DM; T.WT = (bf16*)(ws + WS_WA) + (size_t)l * DM * RW; T.item = r; return T; } r -= TB_BR;
    if (r < TB_BR) { T.W = karg(25) + (size_t)l * RW * DM; T.K = RW; T.ldw = DM; T.N = DM; T.WT = (bf16*)(ws + WS_WB) + (size_t)l * DM * RW; T.item = r; return T; } r -= TB_BR;
    if (r < TB_G) { T.W = karg(26) + (size_t)l * DM * DM; T.K = DM; T.ldw = DM; T.N = DM; T.WT = (bf16*)(ws + WS_WO) + (size_t)l * DM * DM; T.item = r; return T; } r -= TB_G;
    if (r < TB_UQ) { T.W = karg(21) + (size_t)l * 512 * NQ; T.K = 512; T.ldw = NQ; T.N = NQ; T.WT = (bf16*)(ws + WS_WUQ) + (size_t)l * NQ * 512; T.item = r; T.mapq = 1; return T; } r -= TB_UQ;
    { T.W = karg(23) + (size_t)l * 256 * NKV; T.K = 256; T.ldw = NKV; T.N = NKV; T.WT = (bf16*)(ws + WS_WUKV) + (size_t)l * NKV * 256; T.item = r; return T; }
}
__device__ __forceinline__ void p0_big_load(const TItem& T, int tid, f32x4 (&x)[8]) {
    const int nblk = (T.N + 127) / 128, kb = T.item / nblk, nb = T.item - kb * nblk, k0 = 128 * kb, col = 128 * nb + (tid & 31) * 4;
    const float* p = T.W + (size_t)(k0 + (tid >> 5)) * T.ldw + T.c0 + col; const bool ok = col < T.N;
#pragma unroll
    for (int i = 0; i < 8; ++i) x[i] = ok ? *(const GAS f32x4*)(p + (size_t)(16 * i) * T.ldw) : (f32x4){0.f, 0.f, 0.f, 0.f};
}
__device__ __forceinline__ void p0_big_finish(const TItem& T, const f32x4 (&x)[8], LAS float* tile, int tid) {
    const int nblk = (T.N + 127) / 128, kb = T.item / nblk, nb = T.item - kb * nblk, k0 = 128 * kb, n0 = 128 * nb;
    __syncthreads();
#pragma unroll
    for (int i = 0; i < 8; ++i) *(LAS f32x4*)(tile + ((tid >> 5) + 16 * i) * 132 + (tid & 31) * 4) = x[i];
    __syncthreads();
    const int n = tid & 127, cg = tid >> 7; int nn = n0 + n;
    if (nn < T.N) {
        if (T.mapq) { const int hd = nn / QKD, d = nn - hd * QKD; if (d >= 64) { const int i = (d - 64) & 15, s2 = (d - 64) >> 4; nn = hd * QKD + 64 + 2 * i + s2; } }
#pragma unroll
        for (int c = 0; c < 4; ++c) { const LAS float* s = tile + (32 * cg + 8 * c) * 132 + n;
            v4u o; o.x = pk2(s[0 * 132], s[1 * 132]); o.y = pk2(s[2 * 132], s[3 * 132]); o.z = pk2(s[4 * 132], s[5 * 132]); o.w = pk2(s[6 * 132], s[7 * 132]);
            *(GAS v4u*)(T.WT + (size_t)nn * T.K + k0 + 32 * cg + 8 * c) = o; } }
}
__device__ __forceinline__ TItem p0_resolve(unsigned char* ws, int git) {
    const int l = git / TI_N; int r = git - l * TI_N; TItem T; T.mapq = 0; T.c0 = 0;
    const int which = r / TI_LR, d = which & 1, isa = which >> 1; r -= which * TI_LR;
    T.W = (isa ? karg(13) : karg(11)) + (size_t)(l * 2 + d) * 64 * RW; T.K = 64; T.ldw = RW; T.N = RW; T.WT = (bf16*)(ws + (isa ? WS_AUP : WS_WUP)) + (size_t)(l * 2 + d) * RW * 64; T.item = r; return T;
}
constexpr int NWI_INA = (DM / 64) * (INA / 32), NWI_G = (DM / 64) * (DM / 32), NWI_BR = (RW / 64) * (DM / 32), NWI_UQ = (512 / 64) * (NQ / 32), NWI_UKV = (256 / 64) * (NKV / 32);
constexpr int NW_ITEMS = NWI_INA + 2 * NWI_G + 2 * NWI_BR + NWI_G + NWI_UQ + NWI_UKV + TI_N;
__device__ __forceinline__ TItem p0_resolve_wave(unsigned char* ws, int l, int r) {
    TItem T; T.mapq = 0; T.c0 = 0;
    if (r < NWI_INA) { T.W = karg(7) + (size_t)l * DM * INC; T.K = DM; T.ldw = INC; T.N = INA; T.WT = (bf16*)(ws + WS_WINA) + (size_t)l * INA_P * DM; T.item = r; return T; } r -= NWI_INA;
    if (r < NWI_G) { T.W = karg(7) + (size_t)l * DM * INC; T.K = DM; T.ldw = INC; T.c0 = INA; T.N = DM; T.WT = (bf16*)(ws + WS_WGA) + (size_t)l * DM * DM; T.item = r; return T; } r -= NWI_G;
    if (r < NWI_G) { T.W = karg(7) + (size_t)l * DM * INC; T.K = DM; T.ldw = INC; T.c0 = INA + DM; T.N = DM; T.WT = (bf16*)(ws + WS_WGB) + (size_t)l * DM * DM; T.item = r; return T; } r -= NWI_G;
    if (r < NWI_BR) { T.W = karg(24) + (size_t)l * RW * DM; T.K = RW; T.ldw = DM; T.N = DM; T.WT = (bf16*)(ws + WS_WA) + (size_t)l * DM * RW; T.item = r; return T; } r -= NWI_BR;
    if (r < NWI_BR) { T.W = karg(25) + (size_t)l * RW * DM; T.K = RW; T.ldw = DM; T.N = DM; T.WT = (bf16*)(ws + WS_WB) + (size_t)l * DM * RW; T.item = r; return T; } r -= NWI_BR;
    if (r < NWI_G) { T.W = karg(26) + (size_t)l * DM * DM; T.K = DM; T.ldw = DM; T.N = DM; T.WT = (bf16*)(ws + WS_WO) + (size_t)l * DM * DM; T.item = r; return T; } r -= NWI_G;
    if (r < NWI_UQ) { T.W = karg(21) + (size_t)l * 512 * NQ; T.K = 512; T.ldw = NQ; T.N = NQ; T.WT = (bf16*)(ws + WS_WUQ) + (size_t)l * NQ * 512; T.item = r; T.mapq = 1; return T; } r -= NWI_UQ;
    if (r < NWI_UKV) { T.W = karg(23) + (size_t)l * 256 * NKV; T.K = 256; T.ldw = NKV; T.N = NKV; T.WT = (bf16*)(ws + WS_WUKV) + (size_t)l * NKV * 256; T.item = r; return T; } r -= NWI_UKV;
    return p0_resolve(ws, l * TI_N + r);
}
__device__ __forceinline__ void p0_prologue(Frame& F, int l_lo, int l_hi, int svcu, int sG, int with_tr = 1, int parts = 3) {
    LAS float* scr = (LAS float*)(F.lds + F.wave * 16384);
    const int gw = svcu * NWAVES + F.wave, NGW = sG * NWAVES;
    unsigned char* ws = F.ws;
    if (parts & 1) for (int rp_ = 0; rp_ < (DBG_REPEAT == 102 ? 2 : 1); ++rp_)
    { float* modw = (float*)(ws + WS_CTL + CTL_MOD_OFF); const float* adaw = karg(4); const float* adab = karg(5); const float* cin = karg(1); const float* cctx = karg(3);
      LAS float* SIL = (LAS float*)F.lds;
      LAS f32x2* part = (LAS f32x2*)(F.lds + 32768);
      if (svcu >= 0 && l_lo * 96 + svcu < l_hi * 96) {
          for (int i = F.tid; i < 3 * DM; i += 512) { const int r = i >> 11, k = i & 2047; const float c = r < 2 ? cin[r * DM + k] : cctx[k]; SIL[i] = c / (1.f + __expf(-c)); }
          __syncthreads(); }
      if (svcu >= 0) for (int uu = l_lo * 96 + svcu; uu < l_hi * 96; uu += sG) { const int cb = uu % 96, l = uu / 96;
          const int n0 = cb * 128 + F.lane * 2; const float* aw = adaw + (size_t)l * DM * 12288 + n0;
          f32x2 a0 = {0, 0}, a1 = a0, a2 = a0;
#pragma unroll 1
          for (int k0 = F.wave * 256; k0 < F.wave * 256 + 256; k0 += 16) { f32x2 w[16];
#pragma unroll
              for (int j = 0; j < 16; ++j) w[j] = *(const GAS f32x2*)(aw + (size_t)(k0 + j) * 12288);
#pragma unroll
              for (int j = 0; j < 16; ++j) { a0 = a0 + w[j] * SIL[k0 + j]; a1 = a1 + w[j] * SIL[DM + k0 + j]; a2 = a2 + w[j] * SIL[2 * DM + k0 + j]; } }
          __syncthreads();
          part[(F.wave * 3 + 0) * 64 + F.lane] = a0; part[(F.wave * 3 + 1) * 64 + F.lane] = a1; part[(F.wave * 3 + 2) * 64 + F.lane] = a2;
          __syncthreads();
          if (F.wave < 3) { f32x2 s = *(const GAS f32x2*)(adab + (size_t)l * 12288 + n0);
#pragma unroll
              for (int w8 = 0; w8 < 8; ++w8) s = s + part[(w8 * 3 + F.wave) * 64 + F.lane];
              *(GAS f32x2*)(modw + ((size_t)l * 3 + F.wave) * 12288 + n0) = s; }
          __syncthreads(); } }
    if (with_tr && (parts & 1)) for (int rp_ = 0; rp_ < (DBG_REPEAT == 101 ? 2 : 1); ++rp_)
    { unsigned* ctr = (unsigned*)(ws + WS_CTL) + 2048 + 64 * rp_ + 128 * l_lo; LAS float* tile = (LAS float*)F.lds; LAS int* slot = (LAS int*)(F.lds + 128 * 132 * 4);
#define P0_GRAB(dst) do { __syncthreads(); if (F.tid == 0) *slot = (int)__hip_atomic_fetch_add(ctr, 1u, __ATOMIC_RELAXED, __HIP_MEMORY_SCOPE_AGENT); __syncthreads(); dst = *slot; } while (0)
      const int it_end = l_hi * TB_N;
      int it; P0_GRAB(it); it += l_lo * TB_N; f32x4 xa[8], xb[8]; TItem T, Tn;
      if (it < it_end) { T = p0_resolve_big(ws, it); p0_big_load(T, F.tid, xa); }
      while (it < it_end) { int itn; P0_GRAB(itn); itn += l_lo * TB_N; const bool more = itn < it_end;
          if (more) { Tn = p0_resolve_big(ws, itn); p0_big_load(Tn, F.tid, xb); }
          p0_big_finish(T, xa, tile, F.tid);
          if (more) { T = Tn;
#pragma unroll
              for (int i = 0; i < 8; ++i) xa[i] = xb[i]; }
          it = itn; }
#undef P0_GRAB
      __syncthreads();
      if (svcu >= 0) for (int itw = l_lo * TI_N + gw; itw < l_hi * TI_N; itw += NGW) { f32x4 xw[8]; const TItem Tw = p0_resolve(ws, itw); p0_item_load(Tw, F.lane, xw); p0_item_finish(Tw, xw, scr, F.lane); }
    }
    const int gt = gw * 64 + F.lane, NGT = NGW * 64;
    const int sv1 = (parts & 1) ? svcu : -1;
    { const float* gup = karg(14);
    if (sv1 >= 0) for (int i = l_lo * 2 * 32 * RW + gt; i < l_hi * 2 * 32 * RW; i += NGT) { const int ch = i & 1023, r = (i >> 10) & 31, ld = i >> 15;
        ((bf16*)(ws + WS_GUP))[((size_t)ld * RW + ch) * 32 + r] = (bf16)f2bf(gup[i]); } }
    if (sv1 >= 0) for (int i = l_lo * ((INA_P - INA) * DM / 8) + gt; i < l_hi * ((INA_P - INA) * DM / 8); i += NGT) { const int l = i / ((INA_P - INA) * DM / 8), r = i - l * ((INA_P - INA) * DM / 8);
        v4u z_ = {0u, 0u, 0u, 0u}; asm volatile("" : "+v"(z_));
        ((GAS v4u*)((bf16*)(ws + WS_WINA) + ((size_t)l * INA_P + INA) * DM))[r] = z_; }
    { f32x2* rt = (f32x2*)(ws + WS_ROPE);
      if (l_lo == 0 && sv1 >= 0) for (int i = gt; i < TPB * 16; i += NGT) { const int tp = i >> 4, k = i & 15; f32x2 o = {1.f, 0.f};
          if (tp >= CTXL) { const int t = tp - CTXL, row = t >> 6, col = t & 63, j = k & 7; const float fr = powf(10000.0f, -(float)j / 8.0f);
              const float ang = (float)(k < 8 ? row : col) * fr; o.x = cosf(ang); o.y = sinf(ang); }
          rt[i] = o; } }
    if (parts & 2) for (int rp_ = 0; rp_ < (DBG_REPEAT == 103 ? 2 : 1); ++rp_)
    { LAS float* KEY = (LAS float*)F.lds;
      LAS float* WQT = (LAS float*)(F.lds + 65536);
      const float* pkeys = karg(29); const float* pwq = karg(28);
      __syncthreads();
      if (svcu >= 0) for (int uu = l_lo * 512 + svcu; uu < l_hi * 512; uu += sG) { const int kb = uu & 31, hp = (uu >> 5) & 15, l = uu >> 9;
          const GAS f32x4* ksrc = (const GAS f32x4*)(pkeys + ((size_t)l * 16 + hp) * 16384);
          for (int i = F.tid; i < 4096; i += 512) ((LAS f32x4*)KEY)[i] = ksrc[i];
          for (int i = F.tid; i < 2048; i += 512) { const int kk = i >> 5, d4 = i & 31;
              *(LAS f32x4*)(WQT + kk * 132 + d4 * 4) = *(const GAS f32x4*)(pwq + ((size_t)l * DM + kb * 64 + kk) * DM + hp * 128 + d4 * 4); }
          __syncthreads();
          const int kq = F.tid & 15, keyq = F.tid >> 4;
          float acc[4][4];
#pragma unroll
          for (int j = 0; j < 4; ++j)
#pragma unroll
              for (int i = 0; i < 4; ++i) acc[j][i] = 0.f;
          for (int d = 0; d < 128; d += 4) { f32x4 w[4], q[4];
#pragma unroll
              for (int i = 0; i < 4; ++i) w[i] = *(LAS f32x4*)(WQT + (kq + 16 * i) * 132 + d);
#pragma unroll
              for (int j = 0; j < 4; ++j) q[j] = *(LAS f32x4*)(KEY + (4 * keyq + j) * 128 + d);
#pragma unroll
              for (int j = 0; j < 4; ++j)
#pragma unroll
                  for (int i = 0; i < 4; ++i) acc[j][i] += q[j].x * w[i].x + q[j].y * w[i].y + q[j].z * w[i].z + q[j].w * w[i].w; }
          bf16* dst = (bf16*)(ws + WS_WQK) + ((size_t)l * DM + hp * 128 + 4 * keyq) * DM + kb * 64 + kq;
#pragma unroll
          for (int j = 0; j < 4; ++j)
#pragma unroll
              for (int i = 0; i < 4; ++i) dst[(size_t)j * DM + 16 * i] = (bf16)f2bf(acc[j][i]);
          __syncthreads(); } }
}

__device__ __forceinline__ const float* modnorm_src(int m, const float* X, const float* xin, const float* cin) {
    const int b = m / TPB, tp = m - b * TPB;
    return xin ? (tp < CTXL ? cin + ((size_t)b * CTXL + tp) * DM : xin + ((size_t)b * SEQ + (tp - CTXL)) * DM) : X + (size_t)m * DM;
}
__device__ __forceinline__ void modnorm_phase_bf(Frame& F, const bf16* X, const float* g, const float* mod  , int chunk_sh, bf16* H, int skip_ctx) {
    const int gw = F.vcu * NWAVES + F.wave, NGW = F.G * NWAVES;
    int m = gw; while (m < MALL && skip_ctx && (m % TPB) < CTXL) m += NGW;
    v4u v[4]; f32x4 ga[8], sb[8]; int mr_cur = -1;
    if (m < MALL) { const GAS v4u* xr = (const GAS v4u*)(X + (size_t)m * DM) + F.lane;
#pragma unroll
        for (int j = 0; j < 4; ++j) v[j] = xr[64 * j]; }
    while (m < MALL) {
        int mn = m + NGW; while (mn < MALL && skip_ctx && (mn % TPB) < CTXL) mn += NGW;
        v4u nv[4];
        if (mn < MALL) { const GAS v4u* xr = (const GAS v4u*)(X + (size_t)mn * DM) + F.lane;
#pragma unroll
            for (int j = 0; j < 4; ++j) nv[j] = xr[64 * j]; }
        const int b = m / TPB, tp = m - b * TPB, mr = tp < CTXL ? 2 : b;
        if (mr != mr_cur) { mr_cur = mr; const float* sh = mod + (size_t)mr * 12288 + chunk_sh * DM; const float* sc = sh + DM;
#pragma unroll
            for (int q = 0; q < 8; ++q) { const int c = (F.lane + 64 * (q >> 1)) * 8 + 4 * (q & 1); const f32x4 gg = *(const GAS f32x4*)(g + c), s1 = *(const GAS f32x4*)(sc + c); ga[q] = gg * (s1 + 1.0f); sb[q] = *(const GAS f32x4*)(sh + c); } }
        float x[4][8]; float s = 0.f;
#pragma unroll
        for (int j = 0; j < 4; ++j) { x[j][0] = bflo(v[j].x); x[j][1] = bfhi(v[j].x); x[j][2] = bflo(v[j].y); x[j][3] = bfhi(v[j].y); x[j][4] = bflo(v[j].z); x[j][5] = bfhi(v[j].z); x[j][6] = bflo(v[j].w); x[j][7] = bfhi(v[j].w);
#pragma unroll
            for (int e = 0; e < 8; ++e) s += x[j][e] * x[j][e]; }
        const float rs = rsqrtf(wave_sum(s) * (1.f / DM) + NORM_EPS);
        GAS v4u* o8 = (GAS v4u*)(H + (size_t)m * DM) + F.lane;
#pragma unroll
        for (int j = 0; j < 4; ++j) { float y[8];
#pragma unroll
            for (int e = 0; e < 8; ++e) y[e] = (x[j][e] * rs) * ga[2 * j + (e >> 2)][e & 3] + sb[2 * j + (e >> 2)][e & 3];
            v4u o; o.x = pk2(y[0], y[1]); o.y = pk2(y[2], y[3]); o.z = pk2(y[4], y[5]); o.w = pk2(y[6], y[7]); o8[64 * j] = o; }
#pragma unroll
        for (int j = 0; j < 4; ++j) v[j] = nv[j];
        m = mn;
    }
}
__device__ __forceinline__ void modnorm_phase(Frame& F, const float* X, const float* g, const float* mod  , int chunk_sh, bf16* H, int skip_ctx, const float* xin = nullptr, const float* cin = nullptr) {
    const int gw = F.vcu * NWAVES + F.wave, NGW = F.G * NWAVES;
    int m = gw; while (m < MALL && skip_ctx && (m % TPB) < CTXL) m += NGW;
    f32x4 v[8], ga[8], sb[8]; int mr_cur = -1;
    if (m < MALL) { const GAS f32x4* xr = (const GAS f32x4*)modnorm_src(m, X, xin, cin) + F.lane;
#pragma unroll
        for (int j = 0; j < 8; ++j) v[j] = xr[64 * j]; }
    while (m < MALL) {
        int mn = m + NGW; while (mn < MALL && skip_ctx && (mn % TPB) < CTXL) mn += NGW;
        f32x4 nv[8];
        if (mn < MALL) { const GAS f32x4* xr = (const GAS f32x4*)modnorm_src(mn, X, xin, cin) + F.lane;
#pragma unroll
            for (int j = 0; j < 8; ++j) nv[j] = xr[64 * j]; }
        const int b = m / TPB, tp = m - b * TPB, mr = tp < CTXL ? 2 : b;
        if (mr != mr_cur) { mr_cur = mr; const float* sh = mod + (size_t)mr * 12288 + chunk_sh * DM; const float* sc = sh + DM;
#pragma unroll
            for (int j = 0; j < 8; ++j) { const int c = (F.lane + 64 * j) * 4; const f32x4 gg = *(const GAS f32x4*)(g + c), s1 = *(const GAS f32x4*)(sc + c); ga[j] = gg * (s1 + 1.0f); sb[j] = *(const GAS f32x4*)(sh + c); } }
        float s = 0.f;
#pragma unroll
        for (int j = 0; j < 8; ++j) s += (v[j].x * v[j].x + v[j].y * v[j].y) + (v[j].z * v[j].z + v[j].w * v[j].w);
        const float rs = rsqrtf(wave_sum(s) * (1.f / DM) + NORM_EPS);
        GAS v2u* o8 = (GAS v2u*)(H + (size_t)m * DM) + F.lane;
#pragma unroll
        for (int j = 0; j < 8; ++j) { const f32x4 y = (v[j] * rs) * ga[j] + sb[j];
            v2u o; o.x = pk2(y.x, y.y); o.y = pk2(y.z, y.w); o8[64 * j] = o; }
#pragma unroll
        for (int j = 0; j < 8; ++j) v[j] = nv[j];
        m = mn;
    }
}

typedef float f32x4v __attribute__((ext_vector_type(4)));
#define MFMA16(a, b, c) __builtin_amdgcn_mfma_f32_16x16x32_bf16((a), (b), (c), 0, 0, 0)
#define MFMA32(a, b, c) __builtin_amdgcn_mfma_f32_32x32x16_bf16((a), (b), (c), 0, 0, 0)

struct FeatP {
    const bf16* PA; const float* mu; const float* w0; const float* a0; const float* k_k; const float* k_a; const float* r_k;
    const bf16* WUP; const bf16* AUP; const bf16* GUP;
    const float* qnorm; const float* kvnorm; const f32x2* rope;
    bf16* RI; bf16* GG; float* BON; bf16* QN; bf16* KVN; bf16* K;
};
__device__ __forceinline__ f32x4 ld4bf(const bf16* p) { const v2u w = *(const GAS v2u*)p; return (f32x4){bflo(w.x), bfhi(w.x), bflo(w.y), bfhi(w.y)}; }
__device__ __forceinline__ f32x4 mix4(const bf16* PA, int m, int c, bool hp, bool hn, const float* mu) {
    const f32x4 pc = ld4bf(PA + (size_t)m * INA_P + c);
    f32x4 pp = {0, 0, 0, 0}, pn = {0, 0, 0, 0};
    if (hp) pp = ld4bf(PA + (size_t)(m - 1) * INA_P + c);
    if (hn) pn = ld4bf(PA + (size_t)(m + 1) * INA_P + c);
    const f32x4 mm = *(const GAS f32x4*)(mu + c);
    return pc + ((pp + pn) * 0.5f - pc) * mm;
}
__device__ __forceinline__ void unpack8(const v4u w, float (&x)[8]) { x[0] = bflo(w.x); x[1] = bfhi(w.x); x[2] = bflo(w.y); x[3] = bfhi(w.y); x[4] = bflo(w.z); x[5] = bfhi(w.z); x[6] = bflo(w.w); x[7] = bfhi(w.w); }
__device__ __forceinline__ v4u pack8f(const float (&x)[8]) { v4u o; o.x = pk2(x[0], x[1]); o.y = pk2(x[2], x[3]); o.z = pk2(x[4], x[5]); o.w = pk2(x[6], x[7]); return o; }
__device__ __forceinline__ void mix8(const bf16* rowc, bool hp, bool hn, const float (&mu)[8], float (&o)[8]) {
    const v4u zc = {0u, 0u, 0u, 0u};
    const v4u wc = *(const GAS v4u*)rowc, wp = hp ? *(const GAS v4u*)(rowc - INA_P) : zc, wn = hn ? *(const GAS v4u*)(rowc + INA_P) : zc;
    float c[8], p[8], n[8]; unpack8(wc, c); unpack8(wp, p); unpack8(wn, n);
#pragma unroll
    for (int e = 0; e < 8; ++e) o[e] = c[e] + (0.5f * (p[e] + n[e]) - c[e]) * mu[e];
}
struct Raw3 { v4u c, p, n; };
__device__ __forceinline__ Raw3 load3(const bf16* rowc, bool hp, bool hn) { const v4u zc = {0u, 0u, 0u, 0u}; Raw3 r; r.c = *(const GAS v4u*)rowc; r.p = hp ? *(const GAS v4u*)(rowc - INA_P) : zc; r.n = hn ? *(const GAS v4u*)(rowc + INA_P) : zc; return r; }
__device__ __forceinline__ void mix8r(const Raw3& w, const float (&mu)[8], float (&o)[8]) {
    float c[8], p[8], n[8]; unpack8(w.c, c); unpack8(w.p, p); unpack8(w.n, n);
#pragma unroll
    for (int e = 0; e < 8; ++e) o[e] = c[e] + (0.5f * (p[e] + n[e]) - c[e]) * mu[e];
}
__device__ __forceinline__ void features_phase(Frame& F, const FeatP& P) {
    constexpr int LAP = 328;
    LAS bf16* LA = (LAS bf16*)F.lds;
    LAS float* SSQ = (LAS float*)(F.lds + 10752);
    LAS float* PRM = (LAS float*)(F.lds + 12288);
    const int lane = F.lane, w = F.wave, tk = lane & 15, q4 = lane >> 4;
    constexpr int NTILE = MALL / 16, NTG = 64;
    for (int su = F.vcu; su < 4 * NTG; su += F.G) {
        const int cg = su & 3, tg = su >> 2, cw = 256 * cg + 32 * w, ch8 = cw + 8 * q4, hd = 4 * cg + (w >> 1);
        __syncthreads();
        for (int i = F.tid; i < 2560; i += 512) { const int prm = i >> 8, c = (i & 255) + 256 * cg; float v;
            switch (prm) { case 0: v = P.k_k[c]; break; case 1: v = P.k_a[c]; break; case 2: v = P.r_k[c]; break; case 3: v = P.w0[c]; break; case 4: v = P.w0[RW + c]; break;
                           case 5: v = P.a0[c]; break; case 6: v = P.a0[RW + c]; break; case 7: v = P.mu[c]; break; case 8: v = P.mu[RW + c]; break; default: v = P.mu[2 * RW + c]; break; }
            PRM[i] = v; }
        bf16x8 fw[2][2][2], fa[2][2][2], fg[2][2];
        { const int chA = cw + 8 * (tk >> 2) + (tk & 3);
#pragma unroll
          for (int d = 0; d < 2; ++d)
#pragma unroll
              for (int t = 0; t < 2; ++t) {
#pragma unroll
                  for (int ks = 0; ks < 2; ++ks) { fw[d][t][ks] = *(const GAS bf16x8*)(P.WUP + ((size_t)d * RW + chA + 4 * t) * 64 + ks * 32 + q4 * 8); fa[d][t][ks] = *(const GAS bf16x8*)(P.AUP + ((size_t)d * RW + chA + 4 * t) * 64 + ks * 32 + q4 * 8); }
                  fg[d][t] = *(const GAS bf16x8*)(P.GUP + ((size_t)d * RW + chA + 4 * t) * 32 + q4 * 8); } }
        for (int tt = tg; tt < NTILE; tt += NTG) {
            const int m0 = tt * 16;
            const int m = m0 + tk, b = m / TPB, tp = m - b * TPB;
            const bool hp = (tp != 0) && (tp != CTXL), hn = (tp != CTXL - 1) && (tp != TPB - 1);
            const bf16* rowp = P.PA + (size_t)m * INA_P + ch8;
            const Raw3 rawk = load3(rowp + RW, hp, hn), rawr = load3(rowp, hp, hn), rawv = load3(rowp + 2 * RW, hp, hn);
            LDS_BARRIER();
            for (int it = F.tid; it < 640; it += 512) { const int tkk = it / 40, c8 = (it - tkk * 40) * 8, c = C_WD + c8, m = m0 + tkk, tp = m % TPB;
                const bool hp = (tp != 0) && (tp != CTXL), hn = (tp != CTXL - 1) && (tp != TPB - 1);
                float mu[8], v[8];
                { const f32x4 a = *(const GAS f32x4*)(P.mu + c), b2 = *(const GAS f32x4*)(P.mu + c + 4); mu[0] = a.x; mu[1] = a.y; mu[2] = a.z; mu[3] = a.w; mu[4] = b2.x; mu[5] = b2.y; mu[6] = b2.z; mu[7] = b2.w; }
                mix8(P.PA + (size_t)m * INA_P + c, hp, hn, mu, v);
#pragma unroll
                for (int e = 0; e < 8; ++e) { if (c < C_AD) v[e] = 1.0f - 2.0f * __builtin_amdgcn_rcpf(1.0f + __expf(2.0f * v[e])); else if (c >= C_GD) v[e] = sigmoidf_(v[e]); }
                *(LAS v4u*)(LA + tkk * LAP + c8) = pack8f(v); }
            if ((tt & 3) == cg) {
#pragma unroll
                for (int t2 = 0; t2 < 2; ++t2) { const int m = m0 + 2 * w + t2, b = m / TPB, tp = m - b * TPB; const bf16* row = P.PA + (size_t)m * INA_P;
                    { float x[8]; unpack8(*(const GAS v4u*)(row + C_QC + lane * 8), x); float s = 0.f;
#pragma unroll
                      for (int e = 0; e < 8; ++e) s += x[e] * x[e];
                      const float rs = rsqrtf(wave_sum(s) * (1.f / 512.f) + NORM_EPS);
#pragma unroll
                      for (int e = 0; e < 8; ++e) x[e] = x[e] * rs * P.qnorm[lane * 8 + e];
                      *(GAS v4u*)(P.QN + (size_t)m * 512 + lane * 8) = pack8f(x); }
                    { const v2u q = *(const GAS v2u*)(row + C_KVC + lane * 4);
                      float x[4] = {bflo(q.x), bfhi(q.x), bflo(q.y), bfhi(q.y)}; float s = 0.f;
#pragma unroll
                      for (int e = 0; e < 4; ++e) s += x[e] * x[e];
                      const float rs = rsqrtf(wave_sum(s) * (1.f / 256.f) + NORM_EPS);
#pragma unroll
                      for (int e = 0; e < 4; ++e) x[e] = x[e] * rs * P.kvnorm[lane * 4 + e];
                      v2u o; o.x = pk2(x[0], x[1]); o.y = pk2(x[2], x[3]);
                      *(GAS v2u*)(P.KVN + (size_t)m * 256 + lane * 4) = o; }
                    if (lane < 16) { const float x1 = bf1(row[C_KR + lane]), x2 = bf1(row[C_KR + 16 + lane]); const f32x2 cs = P.rope[(size_t)tp * 16 + lane];
                        const unsigned o = pk2(x1 * cs.x - x2 * cs.y, x1 * cs.y + x2 * cs.x);
#pragma unroll
                        for (int h2 = 0; h2 < NH; ++h2) *(GAS unsigned*)(P.K + ((size_t)(b * NH + h2) * TPB + tp) * QKD + 64 + 2 * lane) = o; } } }
            const int pc = 32 * w + 8 * q4;
            float prm[8], kmx[8], kx[8];
#pragma unroll
            for (int e = 0; e < 8; ++e) prm[e] = PRM[8 * 256 + pc + e];
            mix8r(rawk, prm, kmx);
            { float s = 0.f;
#pragma unroll
              for (int e = 0; e < 8; ++e) { kx[e] = kmx[e] * PRM[0 * 256 + pc + e]; s += kx[e] * kx[e]; }
              s += bpermf(lane ^ 16, s); s += bpermf(lane ^ 32, s);
              if (q4 == 0) SSQ[tk * 8 + w] = s; }
            __syncthreads();
            const float rsn = rsqrtf(SSQ[tk * 8 + w] + SSQ[tk * 8 + (w ^ 1)] + 1e-12f);
            f32x4 cw_[2][2], ca_[2][2], cg_[2][2];
#pragma unroll
            for (int d = 0; d < 2; ++d) {
                const bf16x8 bg = *(const LAS bf16x8*)(LA + tk * LAP + 256 + d * 32 + q4 * 8);
                bf16x8 bw[2], ba[2];
#pragma unroll
                for (int ks = 0; ks < 2; ++ks) { bw[ks] = *(const LAS bf16x8*)(LA + tk * LAP + d * 64 + ks * 32 + q4 * 8); ba[ks] = *(const LAS bf16x8*)(LA + tk * LAP + 128 + d * 64 + ks * 32 + q4 * 8); }
#pragma unroll
                for (int t = 0; t < 2; ++t) { f32x4 z = {0, 0, 0, 0};
                    cw_[d][t] = MFMA16(fw[d][t][1], bw[1], MFMA16(fw[d][t][0], bw[0], z));
                    ca_[d][t] = MFMA16(fa[d][t][1], ba[1], MFMA16(fa[d][t][0], ba[0], z));
                    cg_[d][t] = MFMA16(fg[d][t], bg, z); } }
            float r8[8], v8[8], kk8[8];
#pragma unroll
            for (int e = 0; e < 8; ++e) prm[e] = PRM[7 * 256 + pc + e];
            mix8r(rawr, prm, r8);
#pragma unroll
            for (int e = 0; e < 8; ++e) prm[e] = PRM[9 * 256 + pc + e];
            mix8r(rawv, prm, v8);
#pragma unroll
            for (int e = 0; e < 8; ++e) kk8[e] = kx[e] * rsn;
            bf16* rec = P.RI + ((size_t)(b * NH + hd) * TPB + tp) * RREC + (ch8 & 63);
            *(GAS v4u*)(rec) = pack8f(r8); *(GAS v4u*)(rec + 64) = pack8f(kk8); *(GAS v4u*)(rec + 128) = pack8f(v8);
#pragma unroll
            for (int d = 0; d < 2; ++d) {
                float ld[8], ke[8], bb[8], gg[8]; float bs = 0.f;
#pragma unroll
                for (int e = 0; e < 8; ++e) { const int t = e >> 2, r = e & 3;
                    ld[e] = -0.60653066f * sigmoidf_(PRM[(3 + d) * 256 + pc + e] + cw_[d][t][r]);
                    const float aa = sigmoidf_(PRM[(5 + d) * 256 + pc + e] + ca_[d][t][r]);
                    ke[e] = kmx[e] * (1.0f + (aa - 1.0f) * PRM[1 * 256 + pc + e]); bb[e] = kk8[e] * aa; gg[e] = cg_[d][t][r];
                    bs += r8[e] * ke[e] * PRM[2 * 256 + pc + e]; }
                *(GAS v4u*)(rec + (3 + 3 * d) * 64) = pack8f(ld); *(GAS v4u*)(rec + (4 + 3 * d) * 64) = pack8f(bb); *(GAS v4u*)(rec + (5 + 3 * d) * 64) = pack8f(ke);
                *(GAS v4u*)(P.GG + ((size_t)d * MALL + m) * RW + ch8) = pack8f(gg);
                bs += bpermf(lane ^ 16, bs); bs += bpermf(lane ^ 32, bs);
                if (q4 == 0) P.BON[((size_t)d * MALL + m) * 32 + 2 * hd + (w & 1)] = bs; }
        }
    }
}

__device__ __forceinline__ void cvt_row_load(f32x4 (&x)[8], const float* src) {
#pragma unroll
    for (int q = 0; q < 8; ++q) x[q] = *(const GAS f32x4*)(src + q * 4);
}
__device__ __forceinline__ void cvt_row_store(const f32x4 (&x)[8], unsigned char* dst, float* scale_slot, int lane) {
    float am = 0.f;
#pragma unroll
    for (int q = 0; q < 8; ++q) am = fmaxf(am, fmaxf(fmaxf(fabsf(x[q].x), fabsf(x[q].y)), fmaxf(fabsf(x[q].z), fabsf(x[q].w))));
    am = fmaxf(wave_max_u(am), 1e-30f);
    const float g = 6.0f / am, inv = am * (1.0f / 6.0f);
    v4u o;
#pragma unroll
    for (int q = 0; q < 4; ++q) { unsigned w = 0u;
        w = __builtin_amdgcn_cvt_scalef32_pk_fp4_f32(w, x[2 * q].x * g, x[2 * q].y * g, 1.0f, 0);
        w = __builtin_amdgcn_cvt_scalef32_pk_fp4_f32(w, x[2 * q].z * g, x[2 * q].w * g, 1.0f, 1);
        w = __builtin_amdgcn_cvt_scalef32_pk_fp4_f32(w, x[2 * q + 1].x * g, x[2 * q + 1].y * g, 1.0f, 2);
        w = __builtin_amdgcn_cvt_scalef32_pk_fp4_f32(w, x[2 * q + 1].z * g, x[2 * q + 1].w * g, 1.0f, 3);
        o[q] = w; }
    *(GAS v4u*)dst = o;
    if (lane == 0) *scale_slot = inv;
}
struct ScanCvt { const float* pu; const float* pv; unsigned char* PU8; unsigned char* PV8; float* SU; float* SV; int wl; };
constexpr int SCH = 32;
constexpr int SSTEP = 6 * 64;
__device__ __forceinline__ int scan_tp(int dir, int s) { return dir == 0 ? s : (s < CTXL ? (CTXL - 1 - s) : (TPB - 1 - (s - CTXL))); }
__device__ __forceinline__ void scan_load(v4u (&rg)[6], const bf16* RIh, int dir, int chunk, int htid) {
    const int tp = scan_tp(dir, chunk * SCH + (htid >> 3));
    const bf16* rec = RIh + (size_t)tp * RREC + (htid & 7) * 8;
#pragma unroll
    for (int i = 0; i < 3; ++i) rg[i] = *(const GAS v4u*)(rec + i * 64);
    rec += (3 + 3 * dir) * 64;
#pragma unroll
    for (int i = 0; i < 3; ++i) rg[3 + i] = *(const GAS v4u*)(rec + i * 64);
}
__device__ __forceinline__ void scan_store(const v4u (&rg)[6], LAS float* buf, int htid) {
    LAS float* d0 = buf + (htid >> 3) * SSTEP + (htid & 7) * 8;
#pragma unroll
    for (int i = 0; i < 6; ++i) { constexpr int SLOT[6] = {4, 0, 5, 2, 1, 3};
        const v4u wv = rg[i];
        f32x4 lo = {bflo(wv.x), bfhi(wv.x), bflo(wv.y), bfhi(wv.y)}, hi = {bflo(wv.z), bfhi(wv.z), bflo(wv.w), bfhi(wv.w)};
        if (i == 3) {
#pragma unroll
            for (int e = 0; e < 4; ++e) { lo[e] = __expf(lo[e]); hi[e] = __expf(hi[e]); } }
        LAS float* d = d0 + SLOT[i] * 64;
        *(LAS f32x4*)d = lo; *(LAS f32x4*)(d + 4) = hi; }
}
__device__ __forceinline__ void scan_phase(Frame& F, const bf16* RI, bf16* Y, const ScanCvt& C) {
    LAS float* bufs = (LAS float*)F.lds;
    constexpr int NCH = TPB / SCH;
    for (int uu = F.vcu; uu < NBATCH * NH * 2 * 4; uu += F.G) {
        const int rg = uu & 3, dir = (uu >> 2) & 1, hd = (uu >> 3) & 15, b = uu >> 7;
        const bf16* RIh = RI + (size_t)(b * NH + hd) * TPB * RREC;
        const int htid = F.tid - 256;
        v4u ra[6], rb[6];
        f32x4 xw[8];
        LAS float* wscr = (LAS float*)(F.lds + (((F.wave & 3) == 3) ? LDSCTL_OFF + 4096 : 98304 + (F.wave & 3) * 8448));
        f32x4 xc[8];
        __syncthreads();
        if (F.wave >= 4) { scan_load(rb, RIh, dir, 0, htid); scan_load(ra, RIh, dir, 1, htid); scan_store(rb, bufs, htid); scan_load(rb, RIh, dir, 2, htid); }
        __syncthreads();
        const int j = F.lane & 15, rowl = F.lane >> 4, row = rg * 16 + (F.wave & 3) * 4 + rowl;
        f32x2 S01 = {0.f, 0.f}, S23 = {0.f, 0.f};
        bf16* yb = Y + ((size_t)dir * MALL + (size_t)b * TPB) * RW + hd * 64 + row;
        for (int c = 0; c < NCH; ++c) {
            LAS float* cur = bufs + (c & 1) * (SCH * SSTEP);
            if (F.wave >= 4) {
                if (c + 1 < NCH) {
                    if ((c & 1) == 0) { scan_store(ra, bufs + (SCH * SSTEP), htid); if (c + 3 < NCH) scan_load(ra, RIh, dir, c + 3, htid); }
                    else { scan_store(rb, bufs, htid); if (c + 3 < NCH) scan_load(rb, RIh, dir, c + 3, htid); }  }
                if (C.wl >= 0 && (c & 3) == 2) { const int wi = uu * 4 + (F.wave - 4) + 1024 * (c >> 3);
                    if (wi < NW_ITEMS) { const TItem Tw = p0_resolve_wave(F.ws, C.wl, wi); if ((c & 7) == 2) p0_item_load(Tw, F.lane, xw); else p0_item_finish(Tw, xw, wscr, F.lane); } }
                if ((c & 3) == 0 && (c >> 3) < 32) { const int r = uu * 4 + (F.wave - 4) + 1024 * (c >> 3);
                    if ((c & 7) == 0) cvt_row_load(xc, ((r >= NEXP) ? C.pv + (size_t)(r - NEXP) * DM : C.pu + (size_t)r * DM) + F.lane * 32);
                    else cvt_row_store(xc, ((r >= NEXP) ? C.PV8 + (size_t)(r - NEXP) * (DM / 2) : C.PU8 + (size_t)r * (DM / 2)) + F.lane * 16, (r >= NEXP) ? C.SV + (r - NEXP) : C.SU + r, F.lane); } }
            else {
#pragma unroll
                for (int h16 = 0; h16 < 2; ++h16) {
                    const LAS float* sp = cur + (h16 * 16) * SSTEP;
                    f32x4 kk = *(const LAS f32x4*)(sp + 4 * j), bb = *(const LAS f32x4*)(sp + 64 + 4 * j), ww = *(const LAS f32x4*)(sp + 128 + 4 * j),
                          ke = *(const LAS f32x4*)(sp + 192 + 4 * j), rr = *(const LAS f32x4*)(sp + 256 + 4 * j);
                    float ykeep = 0.f, ypart; f32x2 u2, t2, vv; vv.x = sp[320 + row];
#define SCAN_DPP(r, ctl) "v_add_f32_dpp " r ", " r ", " r " " ctl " row_mask:0xf bank_mask:0xf bound_ctrl:1\n\t"
#define SCAN_MAIN(SEL) asm volatile( \
                        "v_pk_mul_f32 v[242:243], %[kexy], %[vv] op_sel_hi:[1,0]\n\t" \
                        "v_add_f32 v246, v250, v251\n\t" \
                        "v_add_f32_dpp v248, %[yp], %[yp] quad_perm:[1,0,3,2] row_mask:0xf bank_mask:0xf bound_ctrl:1\n\t" \
                        "v_pk_mul_f32 v[244:245], %[kezw], %[vv] op_sel_hi:[1,0]\n\t" \
                        SCAN_DPP("v246", "quad_perm:[1,0,3,2]") SCAN_DPP("v248", "quad_perm:[2,3,0,1]") \
                        "v_pk_fma_f32 %[s01], %[s01], %[wwxy], v[242:243]\n\t" \
                        SCAN_DPP("v246", "quad_perm:[2,3,0,1]") SCAN_DPP("v248", "row_half_mirror") \
                        "v_pk_fma_f32 %[s23], %[s23], %[wwzw], v[244:245]\n\t" \
                        SCAN_DPP("v246", "row_half_mirror") SCAN_DPP("v248", "row_mirror") \
                        SEL "\n\t" \
                        SCAN_DPP("v246", "row_mirror") \
                        "v_pk_fma_f32 %[s01], %[bbxy], v[246:247], %[s01] op_sel_hi:[1,0,1] neg_lo:[0,1,0] neg_hi:[0,1,0]\n\t" \
                        "v_pk_fma_f32 %[s23], %[bbzw], v[246:247], %[s23] op_sel_hi:[1,0,1] neg_lo:[0,1,0] neg_hi:[0,1,0]\n\t" \
                        "v_pk_mul_f32 v[252:253], %[s01], %[rrxy]" \
                        : [s01] "+v"(S01), [s23] "+v"(S23), [yk] "+v"(ykeep), "={v[252:253]}"(u2) \
                        : [kexy] "v"(ke.xy), [kezw] "v"(ke.zw), [vv] "v"(vv), [wwxy] "v"(ww.xy), [wwzw] "v"(ww.zw), [bbxy] "v"(bb.xy), [bbzw] "v"(bb.zw), [rrxy] "v"(rr.xy), [yp] "v"(ypart), [msk] "s"(msk), "{v[250:251]}"(t2) \
                        : "v242", "v243", "v244", "v245", "v246", "v247", "v248")
                    asm volatile("v_pk_mul_f32 v[250:251], %[s01], %[kxy]\n\tv_mov_b32 %[yp], 0\n\tv_pk_fma_f32 v[250:251], %[s23], %[kzw], v[250:251]"
                                 : "=&{v[250:251]}"(t2), [yp] "=&v"(ypart) : [s01] "v"(S01), [s23] "v"(S23), [kxy] "v"(kk.xy), [kzw] "v"(kk.zw));
#pragma unroll
                    for (int st = 0; st < 16; ++st) {
                        f32x4 nkk = kk, nbb = bb, nww = ww, nke = ke, nrr = rr; f32x2 nvv = vv;
                        const LAS float* sn = sp + (st + 1) * SSTEP;
                        if (st + 1 < 16) { nkk = *(const LAS f32x4*)(sn + 4 * j); nke = *(const LAS f32x4*)(sn + 192 + 4 * j); nvv.x = sn[320 + row]; nww = *(const LAS f32x4*)(sn + 128 + 4 * j); nbb = *(const LAS f32x4*)(sn + 64 + 4 * j);
                            nrr = *(const LAS f32x4*)(sn + 256 + 4 * j); }
                        const unsigned long long msk = 0x0001000100010001ull << ((st + 15) & 15);
                        if (st > 0) SCAN_MAIN("v_cndmask_b32_e64 %[yk], %[yk], v248, %[msk]"); else SCAN_MAIN("s_nop 0");
                        if (st + 1 < 16)
                            asm volatile("v_pk_mul_f32 v[250:251], %[s01], %[kxy]\n\tv_pk_fma_f32 v[252:253], %[s23], %[rrzw], v[252:253]\n\tv_pk_fma_f32 v[250:251], %[s23], %[kzw], v[250:251]\n\tv_add_f32 %[yp], v252, v253"
                                         : "=&{v[250:251]}"(t2), "={v[252:253]}"(u2), [yp] "=&v"(ypart) : [s01] "v"(S01), [s23] "v"(S23), [kxy] "v"(nkk.xy), [kzw] "v"(nkk.zw), [rrzw] "v"(rr.zw), "1"(u2));
                        else
                            asm volatile("s_nop 0\n\tv_pk_fma_f32 v[252:253], %[s23], %[rrzw], v[252:253]" : "={v[252:253]}"(u2) : [s23] "v"(S23), [rrzw] "v"(rr.zw), "0"(u2));
                        kk = nkk; bb = nbb; ww = nww; ke = nke; rr = nrr; vv = nvv;
                        __builtin_amdgcn_sched_barrier(0);
                    }
#undef SCAN_MAIN
#undef SCAN_DPP
                    { const float y = red16(u2.x + u2.y); ykeep = (j == 15) ? y : ykeep; }
                    const int tp = scan_tp(dir, c * SCH + h16 * 16 + j);
                    *(GAS bf16*)(yb + (size_t)tp * RW) = (bf16)f2bf(ykeep);
                }
            }
            __syncthreads();
        }
    }
}

constexpr int AKP = 208, AVP = 192;
constexpr int ATILE = 64 * AKP + 64 * AVP;
__device__ __forceinline__ bf16x8 pack8(const f32x16& x, int s) {
    v4u p; p.x = pk2(x[8 * s + 0], x[8 * s + 1]); p.y = pk2(x[8 * s + 2], x[8 * s + 3]); p.z = pk2(x[8 * s + 4], x[8 * s + 5]); p.w = pk2(x[8 * s + 6], x[8 * s + 7]);
    return __builtin_bit_cast(bf16x8, p);
}
__device__ __forceinline__ void attn_phase(Frame& F, const bf16* Q, const bf16* K, const bf16* V, bf16* YB, int with_ctx) {
    const int lane = F.lane, half = lane >> 5, l31 = lane & 31, l16 = lane & 15, g1 = (lane >> 4) & 1;
    const int nunits = NBATCH * NH * 32 + (with_ctx ? NBATCH * NH : 0);
    for (int uu = F.vcu; uu < nunits; uu += F.G) {
        int bh, q0, nkt;
        if (uu < NBATCH * NH * 32) { bh = uu >> 5; q0 = CTXL + (uu & 31) * 256; nkt = TPB / 64; } else { bh = uu - NBATCH * NH * 32; q0 = 0; nkt = CTXL / 64; }
        const bf16* Kh = K + (size_t)bh * TPB * QKD; const bf16* Vh = V + (size_t)bh * TPB * 64; const bf16* Qh = Q + (size_t)bh * TPB * QKD;
        const int tq = q0 + F.wave * 32 + l31;
        bf16x8 qf[6];
#pragma unroll
        for (int ks = 0; ks < 6; ++ks) qf[ks] = *(const GAS bf16x8*)(Qh + (size_t)tq * QKD + 16 * ks + 8 * half);
        f32x16 o0, o1;
#pragma unroll
        for (int i = 0; i < 16; ++i) { o0[i] = 0.f; o1[i] = 0.f; }
        float l_run = 0.f;
        f32x16 cinit;
#pragma unroll
        for (int i = 0; i < 16; ++i) cinit[i] = 0.f;
        asm volatile("" : "+v"(cinit));
        const int kc1 = F.tid + 512; const bool k1ok = kc1 < 768;
        const unsigned kd0 = (unsigned)((F.tid / 12) * AKP + (F.tid % 12) * 16), kd1 = (unsigned)((kc1 / 12) * AKP + (kc1 % 12) * 16), vd = (unsigned)(64 * AKP + (F.tid >> 3) * AVP + (F.tid & 7) * 16);
        v4u kr0, kr1 = {0, 0, 0, 0}, vr;
        kr0 = *(const GAS v4u*)(Kh + (size_t)F.tid * 8); if (k1ok) kr1 = *(const GAS v4u*)(Kh + (size_t)kc1 * 8); vr = *(const GAS v4u*)(Vh + (size_t)F.tid * 8);
        __syncthreads();
        *(LAS v4u*)(F.lds + kd0) = kr0; if (k1ok) *(LAS v4u*)(F.lds + kd1) = kr1; *(LAS v4u*)(F.lds + vd) = vr;
        if (nkt > 1) { const bf16* kn = Kh + (size_t)64 * QKD; const bf16* vn = Vh + (size_t)64 * 64;
            kr0 = *(const GAS v4u*)(kn + (size_t)F.tid * 8); if (k1ok) kr1 = *(const GAS v4u*)(kn + (size_t)kc1 * 8); vr = *(const GAS v4u*)(vn + (size_t)F.tid * 8);
            *(LAS v4u*)(F.lds + ATILE + kd0) = kr0; if (k1ok) *(LAS v4u*)(F.lds + ATILE + kd1) = kr1; *(LAS v4u*)(F.lds + ATILE + vd) = vr; }
        __syncthreads();
        bf16x8 ka[6], kb2[6];
#pragma unroll
        for (int ks = 0; ks < 6; ++ks) { ka[ks] = *(const LAS bf16x8*)(F.lds + l31 * AKP + (16 * ks + 8 * half) * 2); kb2[ks] = *(const LAS bf16x8*)(F.lds + (32 + l31) * AKP + (16 * ks + 8 * half) * 2); }
        int bc = 0, bn = ATILE, bw = 2 * ATILE;
        for (int kt = 0; kt < nkt; ++kt) {
            const bool more = kt + 1 < nkt, more2 = kt + 2 < nkt;
            if (more2) { const bf16* kn = Kh + (size_t)(kt + 2) * 64 * QKD; const bf16* vn = Vh + (size_t)(kt + 2) * 64 * 64;
                kr0 = *(const GAS v4u*)(kn + (size_t)F.tid * 8); if (k1ok) kr1 = *(const GAS v4u*)(kn + (size_t)kc1 * 8); vr = *(const GAS v4u*)(vn + (size_t)F.tid * 8); }
            LAS unsigned char* Kb = F.lds + bc; LAS unsigned char* Vb = Kb + 64 * AKP;
            f32x16 s0, s1;
            { s0 = MFMA32(ka[0], qf[0], cinit);
#pragma unroll
              for (int ks = 1; ks < 6; ++ks) s0 = MFMA32(ka[ks], qf[ks], s0);
              s1 = MFMA32(kb2[0], qf[0], cinit);
#pragma unroll
              for (int ks = 1; ks < 6; ++ks) s1 = MFMA32(kb2[ks], qf[ks], s1);
              __builtin_amdgcn_sched_group_barrier(0x8, 12, 0); }
            bf16x8 va[2][2][2];
#pragma unroll
            for (int t = 0; t < 2; ++t)
#pragma unroll
                for (int s = 0; s < 2; ++s) { const int kb = 32 * t + 16 * s + 4 * half + (l16 >> 2);
#pragma unroll
                    for (int dvt = 0; dvt < 2; ++dvt) { const LAS unsigned char* vp = Vb + kb * AVP + (32 * dvt + 16 * g1 + 4 * (l16 & 3)) * 2;
                        const s16x4 lo = __builtin_amdgcn_ds_read_tr16_b64_v4i16((LAS s16x4*)vp), hi = __builtin_amdgcn_ds_read_tr16_b64_v4i16((LAS s16x4*)(vp + 8 * AVP));
                        va[t][s][dvt] = __builtin_shufflevector(lo, hi, 0, 1, 2, 3, 4, 5, 6, 7); } }
            __builtin_amdgcn_sched_group_barrier(0x100, 16, 0);
            if (more) { const LAS unsigned char* Kn = F.lds + bn;
#pragma unroll
                for (int ks = 0; ks < 6; ++ks) { ka[ks] = *(const LAS bf16x8*)(Kn + l31 * AKP + (16 * ks + 8 * half) * 2); kb2[ks] = *(const LAS bf16x8*)(Kn + (32 + l31) * AKP + (16 * ks + 8 * half) * 2); } }
            float mx = s0[0];
#pragma unroll
            for (int i = 1; i < 16; ++i) mx = fmaxf(mx, s0[i]);
#pragma unroll
            for (int i = 0; i < 16; ++i) mx = fmaxf(mx, s1[i]);
            if (kt == 0 || __any(mx > 8.0f)) {
                mx = fmaxf(mx, bpermf(lane ^ 32, mx));
                const float d = (kt == 0) ? mx : fmaxf(mx, 0.f), alpha = (kt == 0) ? 1.0f : __builtin_amdgcn_exp2f(-d);
                l_run *= alpha;
#pragma unroll
                for (int i = 0; i < 16; ++i) { o0[i] *= alpha; o1[i] *= alpha; s0[i] -= d; s1[i] -= d; cinit[i] -= d; }
                asm volatile("" : "+v"(cinit));
            }
#pragma unroll
            for (int i = 0; i < 16; ++i) { s0[i] = __builtin_amdgcn_exp2f(s0[i]); s1[i] = __builtin_amdgcn_exp2f(s1[i]); }
            float ps = 0.f;
#pragma unroll
            for (int i = 0; i < 16; ++i) ps += s0[i] + s1[i];
            l_run += ps;
            { bf16x8 pf[2][2];
#pragma unroll
              for (int t = 0; t < 2; ++t)
#pragma unroll
                  for (int s = 0; s < 2; ++s) pf[t][s] = pack8(t == 0 ? s0 : s1, s);
#pragma unroll
              for (int t = 0; t < 2; ++t)
#pragma unroll
                  for (int s = 0; s < 2; ++s) { o0 = MFMA32(va[t][s][0], pf[t][s], o0); o1 = MFMA32(va[t][s][1], pf[t][s], o1); } }
            if (more2) { LAS unsigned char* nb = F.lds + bw;
                *(LAS v4u*)(nb + kd0) = kr0; if (k1ok) *(LAS v4u*)(nb + kd1) = kr1; *(LAS v4u*)(nb + vd) = vr; }
            __syncthreads();
            { const int t_ = bc; bc = bn; bn = bw; bw = t_; }
        }
        const float linv = (DBG_SKIP & 4) ? 0.f : 1.0f / (l_run + bpermf(lane ^ 32, l_run));
        const int b = bh >> 4, hd = bh & 15;
        bf16* op = YB + ((size_t)b * TPB + tq) * RW + hd * 64 + 4 * half;
#pragma unroll
        for (int g = 0; g < 4; ++g) {
            v2u w; w.x = pk2(o0[4 * g] * linv, o0[4 * g + 1] * linv); w.y = pk2(o0[4 * g + 2] * linv, o0[4 * g + 3] * linv); *(GAS v2u*)(op + 8 * g) = w;
            w.x = pk2(o1[4 * g] * linv, o1[4 * g + 1] * linv); w.y = pk2(o1[4 * g + 2] * linv, o1[4 * g + 3] * linv); *(GAS v2u*)(op + 32 + 8 * g) = w; }
    }
}

struct RoRaw { v4u va, vc, ya[2], yc[2], ga[2], gc[2]; float b0[2], b1[2]; };
__device__ __forceinline__ void readout_load(RoRaw& r, int m, int lane, const bf16* Y, const bf16* GG, const float* BON, const bf16* RI) {
    const int hd = lane >> 2, ch0 = hd * 64 + (lane & 3) * 16, b = m / TPB, tp = m - b * TPB;
    const bf16* rec = RI + ((size_t)(b * NH + hd) * TPB + tp) * RREC + 128 + (lane & 3) * 16;
    r.va = *(const GAS v4u*)rec; r.vc = *(const GAS v4u*)(rec + 8);
#pragma unroll
    for (int d = 0; d < 2; ++d) { const bf16* yp = Y + ((size_t)d * MALL + m) * RW + ch0; const bf16* gp = GG + ((size_t)d * MALL + m) * RW + ch0;
        r.ya[d] = *(const GAS v4u*)yp; r.yc[d] = *(const GAS v4u*)(yp + 8); r.ga[d] = *(const GAS v4u*)gp; r.gc[d] = *(const GAS v4u*)(gp + 8);
        r.b0[d] = BON[((size_t)d * MALL + m) * 32 + 2 * hd]; r.b1[d] = BON[((size_t)d * MALL + m) * 32 + 2 * hd + 1]; }
}
__device__ __forceinline__ void readout_phase(Frame& F, const bf16* Y, const bf16* GG, const float* BON, const bf16* RI, const float* ln_w, const float* ln_b, bf16* YA) {
    const int gw = F.vcu * NWAVES + F.wave, NGW = F.G * NWAVES, lane = F.lane, hd = lane >> 2, ch0 = hd * 64 + (lane & 3) * 16;
    RoRaw cur, nxt;
    if (gw < MALL) readout_load(cur, gw, lane, Y, GG, BON, RI);
    for (int m = gw; m < MALL; m += NGW) {
        if (m + NGW < MALL) readout_load(nxt, m + NGW, lane, Y, GG, BON, RI);
        float vv[16], out[16];
        unpack8(cur.va, *(float(*)[8])&vv[0]); unpack8(cur.vc, *(float(*)[8])&vv[8]);
#pragma unroll
        for (int e = 0; e < 16; ++e) out[e] = 0.f;
#pragma unroll
        for (int d = 0; d < 2; ++d) {
            float y[16], g[16];
            unpack8(cur.ya[d], *(float(*)[8])&y[0]); unpack8(cur.yc[d], *(float(*)[8])&y[8]); unpack8(cur.ga[d], *(float(*)[8])&g[0]); unpack8(cur.gc[d], *(float(*)[8])&g[8]);
            float s = 0.f;
#pragma unroll
            for (int e = 0; e < 16; ++e) s += y[e];
            s = dpp_add<0xB1>(s); s = dpp_add<0x4E>(s);
            const float mean = s * (1.f / 64.f); float q = 0.f;
#pragma unroll
            for (int e = 0; e < 16; ++e) { y[e] -= mean; q += y[e] * y[e]; }
            q = dpp_add<0xB1>(q); q = dpp_add<0x4E>(q);
            const float rstd = rsqrtf(q * (1.f / 64.f) + 64e-5f), bon = cur.b0[d] + cur.b1[d];
#pragma unroll
            for (int e = 0; e < 16; ++e) out[e] += (y[e] * rstd * ln_w[ch0 + e] + ln_b[ch0 + e] + bon * vv[e]) * g[e];
        }
        if (DBG_SKIP & 2) {
#pragma unroll
            for (int e = 0; e < 16; ++e) out[e] = 0.f; }
        v4u o0, o1;
        o0.x = pk2(out[0], out[1]); o0.y = pk2(out[2], out[3]); o0.z = pk2(out[4], out[5]); o0.w = pk2(out[6], out[7]);
        o1.x = pk2(out[8], out[9]); o1.y = pk2(out[10], out[11]); o1.z = pk2(out[12], out[13]); o1.w = pk2(out[14], out[15]);
        *(GAS v4u*)(YA + (size_t)m * RW + ch0) = o0; *(GAS v4u*)(YA + (size_t)m * RW + ch0 + 8) = o1;
        cur = nxt;
    }
}


__device__ __forceinline__ unsigned f2key(float f) { const unsigned u = __builtin_bit_cast(unsigned, f); return (u & 0x80000000u) ? ~u : (u | 0x80000000u); }
__device__ __forceinline__ float key2f(unsigned k) { const unsigned u = (k & 0x80000000u) ? (k & 0x7fffffffu) : ~k; return __builtin_bit_cast(float, u); }
template <int CTRL, int RM> __device__ __forceinline__ unsigned dpp_umax(unsigned x) {
    const unsigned y = (unsigned)__builtin_amdgcn_update_dpp(0, (int)x, CTRL, RM, 0xf, false); return x > y ? x : y; }
__device__ __forceinline__ unsigned row_umax(unsigned x) { x = dpp_umax<0xB1, 0xf>(x); x = dpp_umax<0x4E, 0xf>(x); x = dpp_umax<0x141, 0xf>(x); x = dpp_umax<0x140, 0xf>(x); return x; }
#define SEL_CE(a_, b_) do { const unsigned hi_ = (a_) > (b_) ? (a_) : (b_), lo_ = (a_) > (b_) ? (b_) : (a_); (a_) = hi_; (b_) = lo_; } while (0)
__device__ __forceinline__ void sel_keys8(unsigned (&k)[8], const _Float16* p, int id0) {
    typedef _Float16 h8 __attribute__((ext_vector_type(8)));
    const h8 hv = *(const GAS h8*)p;
    const f32x4 v0 = {(float)hv[0], (float)hv[1], (float)hv[2], (float)hv[3]}, v1 = {(float)hv[4], (float)hv[5], (float)hv[6], (float)hv[7]};
    k[0] = (f2key(v0.x) & ~127u) | (unsigned)(id0 + 0); k[1] = (f2key(v0.y) & ~127u) | (unsigned)(id0 + 1); k[2] = (f2key(v0.z) & ~127u) | (unsigned)(id0 + 2); k[3] = (f2key(v0.w) & ~127u) | (unsigned)(id0 + 3);
    k[4] = (f2key(v1.x) & ~127u) | (unsigned)(id0 + 4); k[5] = (f2key(v1.y) & ~127u) | (unsigned)(id0 + 5); k[6] = (f2key(v1.z) & ~127u) | (unsigned)(id0 + 6); k[7] = (f2key(v1.w) & ~127u) | (unsigned)(id0 + 7);
    SEL_CE(k[0], k[1]); SEL_CE(k[2], k[3]); SEL_CE(k[4], k[5]); SEL_CE(k[6], k[7]); SEL_CE(k[0], k[2]); SEL_CE(k[1], k[3]); SEL_CE(k[4], k[6]); SEL_CE(k[5], k[7]); SEL_CE(k[1], k[2]); SEL_CE(k[5], k[6]);
    SEL_CE(k[0], k[4]); SEL_CE(k[1], k[5]); SEL_CE(k[2], k[6]); SEL_CE(k[3], k[7]); SEL_CE(k[2], k[4]); SEL_CE(k[3], k[5]); SEL_CE(k[1], k[2]); SEL_CE(k[3], k[4]); SEL_CE(k[5], k[6]);
}
__device__ __forceinline__ void top16_rows2(const _Float16* pa, const _Float16* pb, int l16, unsigned& ra, unsigned& rb) {
    unsigned ka[8], kb[8]; sel_keys8(ka, pa + 8 * l16, 8 * l16); sel_keys8(kb, pb + 8 * l16, 8 * l16);
    ra = 0u; rb = 0u;
#pragma unroll
    for (int it = 0; it < 16; ++it) {
        const unsigned ma = row_umax(ka[0]), mb = row_umax(kb[0]); const bool oa = ka[0] == ma, ob = kb[0] == mb;
#pragma unroll
        for (int e = 0; e < 7; ++e) { ka[e] = oa ? ka[e + 1] : ka[e]; kb[e] = ob ? kb[e + 1] : kb[e]; }
        ka[7] = oa ? 0u : ka[7]; kb[7] = ob ? 0u : kb[7];
        ra = (l16 == it) ? ma : ra; rb = (l16 == it) ? mb : rb;
    }
}
struct SelP { const float* SC; int* ESEL; float* EGATE; int last; };
__device__ __forceinline__ void select_token(const _Float16* srow, int lane, int (&eidx)[2], float (&egate)[2]) {
    const int row = lane >> 4, l16 = lane & 15, rbase = lane & 48;
    const int i1 = (int)((0x3332222211111111ull >> (4 * l16)) & 15ull), j1 = (int)((0x2104321076543210ull >> (4 * l16)) & 15ull), i2 = (int)((0xdcba987766554443ull >> (4 * l16)) & 15ull), j2 = (int)((0x0000001010102103ull >> (4 * l16)) & 15ull);
#pragma unroll
    for (int G = 0; G < 2; ++G) {
                const _Float16* hrow = srow + (4 * G + row) * 256;
                unsigned recA, recB; top16_rows2(hrow, hrow + 128, l16, recA, recB);
                const float va = key2f(recA & ~127u), vb = key2f(recB & ~127u);
                const float a0 = bpermf(rbase, va), a1 = bpermf(rbase + i1, va), b1 = bpermf(rbase + j1, vb), a2 = bpermf(rbase + i2, va), b2 = bpermf(rbase + j2, vb), a3 = bpermf(rbase + 14 + (l16 & 1), va), b0 = bpermf(rbase, vb);
                unsigned ck[4];
                ck[0] = (f2key(a0 + vb) & ~255u) | (unsigned)l16; ck[1] = (f2key(a1 + b1) & ~255u) | (unsigned)(16 * i1 + j1); ck[2] = (f2key(a2 + b2) & ~255u) | (unsigned)(16 * i2 + j2);
                ck[3] = (l16 < 2) ? ((f2key(a3 + b0) & ~255u) | (unsigned)(16 * (14 + l16))) : 0u;
                SEL_CE(ck[0], ck[1]); SEL_CE(ck[2], ck[3]); SEL_CE(ck[0], ck[2]); SEL_CE(ck[1], ck[3]); SEL_CE(ck[1], ck[2]);
                unsigned rec = 0u;
#pragma unroll
                for (int it = 0; it < 16; ++it) {
                    const unsigned mh = row_umax(ck[0]); const bool own = ck[0] == mh;
                    ck[0] = own ? ck[1] : ck[0]; ck[1] = own ? ck[2] : ck[1]; ck[2] = own ? ck[3] : ck[2]; ck[3] = own ? 0u : ck[3];
                    rec = (l16 == it) ? mh : rec;
                }
                const float ts = key2f(rec & ~255u), tmax = bpermf(rbase, ts);
                const float ev = __expf(ts - tmax), esum = red16(ev);
                const int ci = (int)((rec >> 4) & 15u), cj = (int)(rec & 15u);
                const int expert = bpermi(rbase + ci, (int)(recA & 127u)) * 128 + bpermi(rbase + cj, (int)(recB & 127u));
                eidx[G] = expert; egate[G] = ev / esum;
    }
}
struct PeerP { const _Float16* SC; const float* nmod; const float* ng; bf16* Hout;   const int* ESEL; const float* EGATE; const bf16* H; const unsigned char* PU; const unsigned char* PV; const float* SU; const float* SV; bf16* X; const float* mod;   const float* fin_g; float* out; int last; int dry; };
__device__ __forceinline__ void peer_phase(Frame& F, const PeerP& P) {
    const int gw = F.vcu * NWAVES + F.wave, NGW = F.G * NWAVES, lane = F.lane;
    float pr_s2 = 0.f, pr_d2 = 0.f, pr_tg = 0.f, pr_n = 0.f;
    int m0 = gw; while (m0 < MALL && P.last && (m0 % TPB) < CTXL) m0 += NGW;
    v4u ph0 = {0u, 0u, 0u, 0u}, ph1 = ph0, ph2 = ph0, ph3 = ph0;
    if (m0 < MALL) { const bf16* hp = P.H + (size_t)m0 * DM + lane * 32; ph0 = *(const GAS v4u*)hp; ph1 = *(const GAS v4u*)(hp + 8); ph2 = *(const GAS v4u*)(hp + 16); ph3 = *(const GAS v4u*)(hp + 24); }
    for (int m = m0, mn = 0; m < MALL; m = mn) {
        mn = m + NGW; while (mn < MALL && P.last && (mn % TPB) < CTXL) mn += NGW;
        const int b = m / TPB, tp = m - b * TPB;
        const int mr = tp < CTXL ? 2 : b;
        const int emask_ = (P.dry & 2) ? 1023 : 0x7fffffff;
        int eidx[2]; float egate[2]; select_token(P.SC + (size_t)m * DM, lane, eidx, egate);
        eidx[0] &= emask_; eidx[1] &= emask_;
        typedef int v8i __attribute__((ext_vector_type(8)));
        LAS unsigned char* hq = F.lds + F.wave * 4096;
        { const v4u hv[4] = {ph0, ph1, ph2, ph3}; v4u o[2];
#pragma unroll
          for (int j = 0; j < 4; ++j) { int w0 = 0, w1 = 0;
              w0 = __builtin_amdgcn_cvt_pk_fp8_f32(bflo(hv[j].x), bfhi(hv[j].x), w0, false); w0 = __builtin_amdgcn_cvt_pk_fp8_f32(bflo(hv[j].y), bfhi(hv[j].y), w0, true);
              w1 = __builtin_amdgcn_cvt_pk_fp8_f32(bflo(hv[j].z), bfhi(hv[j].z), w1, false); w1 = __builtin_amdgcn_cvt_pk_fp8_f32(bflo(hv[j].w), bfhi(hv[j].w), w1, true);
              o[j >> 1][2 * (j & 1)] = (unsigned)w0; o[j >> 1][2 * (j & 1) + 1] = (unsigned)w1; }
          *(LAS v4u*)(hq + lane * 32) = o[0]; *(LAS v4u*)(hq + lane * 32 + 16) = o[1];
          unsigned z_ = 0u; asm volatile("" : "+v"(z_));
          if (lane < 2) *(LAS v4u*)(hq + 2048 + lane * 16) = (v4u){z_, z_, z_, z_}; }
        const int li = lane & 15, kb = lane >> 4;
        int rowoff[8];
#pragma unroll
        for (int g = 0; g < 8; ++g) rowoff[g] = bpermi(16 * (g & 3) + li, eidx[g >> 2]) * (DM / 2) + 16 * kb;
        f32x4 dacc[8];
#pragma unroll
        for (int g = 0; g < 8; ++g) dacc[g] = (f32x4){0.f, 0.f, 0.f, 0.f};
        const unsigned hb = (li == 0) ? (unsigned)(16 * kb) : 2048u;
        const unsigned hb2 = (li == 0) ? 64u : 16u;
        const unsigned hstep = (li == 0) ? 128u : 0u;
        v4u ua[8], ub[8];
#pragma unroll
        for (int g = 0; g < 8; ++g) ua[g] = *(const GAS v4u*)(P.PU + (unsigned)rowoff[g]);
#pragma unroll 1
        for (int s = 0; s < ((P.dry & 4) ? 2 : 16); s += 2) {
#pragma unroll
            for (int g = 0; g < 8; ++g) ub[g] = *(const GAS v4u*)(P.PU + (unsigned)(rowoff[g] + 64 * (s + 1)));
            { const v4u b0 = *(const LAS v4u*)(hq + hb + hstep * s), b1 = *(const LAS v4u*)(hq + hb + hstep * s + hb2);
              const v8i bf = {(int)b0.x, (int)b0.y, (int)b0.z, (int)b0.w, (int)b1.x, (int)b1.y, (int)b1.z, (int)b1.w};
#pragma unroll
              for (int g = 0; g < 8; ++g) { const v8i af = {(int)ua[g].x, (int)ua[g].y, (int)ua[g].z, (int)ua[g].w, 0, 0, 0, 0};
                  dacc[g] = __builtin_amdgcn_mfma_scale_f32_16x16x128_f8f6f4(af, bf, dacc[g], 4, 0, 0, 0x7f7f7f7f, 0, 0x7f7f7f7f); } }
            if (s + 2 < 16) {
#pragma unroll
                for (int g = 0; g < 8; ++g) ua[g] = *(const GAS v4u*)(P.PU + (unsigned)(rowoff[g] + 64 * (s + 2))); }
            { const v4u b0 = *(const LAS v4u*)(hq + hb + hstep * (s + 1)), b1 = *(const LAS v4u*)(hq + hb + hstep * (s + 1) + hb2);
              const v8i bf = {(int)b0.x, (int)b0.y, (int)b0.z, (int)b0.w, (int)b1.x, (int)b1.y, (int)b1.z, (int)b1.w};
#pragma unroll
              for (int g = 0; g < 8; ++g) { const v8i af = {(int)ub[g].x, (int)ub[g].y, (int)ub[g].z, (int)ub[g].w, 0, 0, 0, 0};
                  dacc[g] = __builtin_amdgcn_mfma_scale_f32_16x16x128_f8f6f4(af, bf, dacc[g], 4, 0, 0, 0x7f7f7f7f, 0, 0x7f7f7f7f); } }
        }
        float coef[2];
#pragma unroll
        for (int sl = 0; sl < 2; ++sl) { float mydot = 0.f;
#pragma unroll
            for (int g4 = 0; g4 < 4; ++g4)
#pragma unroll
                for (int r = 0; r < 4; ++r) { const float t = bpermf(16 * ((lane >> 2) & 3), dacc[4 * sl + g4][r]); if ((lane >> 4) == g4 && (lane & 3) == r) mydot = t; }
            mydot *= P.SU[eidx[sl]];
            if (DBG_PROBE == 4) {
                float ref = 0.f;
                for (int e = 0; e < 64; ++e) { const int ex = __builtin_amdgcn_readlane(eidx[sl], e); const v4u uu = *(const GAS v4u*)(P.PU + (size_t)ex * (DM / 2) + lane * 16); float s1 = 0.f;
                    const v4u hv2[4] = {*(const GAS v4u*)(P.H + (size_t)m * DM + lane * 32), *(const GAS v4u*)(P.H + (size_t)m * DM + lane * 32 + 8), *(const GAS v4u*)(P.H + (size_t)m * DM + lane * 32 + 16), *(const GAS v4u*)(P.H + (size_t)m * DM + lane * 32 + 24)};
#pragma unroll
                    for (int d = 0; d < 4; ++d) { const unsigned w = uu[d]; const unsigned hw[4] = {hv2[d].x, hv2[d].y, hv2[d].z, hv2[d].w};
                        f32x2 x = __builtin_amdgcn_cvt_scalef32_pk_f32_fp4(w, 1.0f, 0); s1 += x.x * bflo(hw[0]) + x.y * bfhi(hw[0]); x = __builtin_amdgcn_cvt_scalef32_pk_f32_fp4(w, 1.0f, 1); s1 += x.x * bflo(hw[1]) + x.y * bfhi(hw[1]);
                        x = __builtin_amdgcn_cvt_scalef32_pk_f32_fp4(w, 1.0f, 2); s1 += x.x * bflo(hw[2]) + x.y * bfhi(hw[2]); x = __builtin_amdgcn_cvt_scalef32_pk_f32_fp4(w, 1.0f, 3); s1 += x.x * bflo(hw[3]) + x.y * bfhi(hw[3]); }
                    const float tot = wave_sum_u(s1) * P.SU[ex]; if (lane == e) ref = tot; }
                pr_s2 = fmaxf(pr_s2, wave_max_u(fabsf(mydot - ref) / (fabsf(ref) + 0.25f))); pr_n = 1.f; }
            coef[sl] = egate[sl] * 0.5f * mydot * (1.0f + erff(mydot * 0.70710678f));
            if ((DBG_SKIP & 16) && sl == 0) coef[sl] = 0.f;
            if ((DBG_SKIP & 32) && sl == 1) coef[sl] = 0.f;
        }
        const float coefs[2] = {coef[0] * P.SV[eidx[0]], coef[1] * P.SV[eidx[1]]};
        f32x2 acc2[16];
#pragma unroll
        for (int i = 0; i < 16; ++i) acc2[i] = (f32x2){0.f, 0.f};
#define PEER_LOADV(U, C, e0_) do { const int e1_ = (e0_); const int ev_ = (e1_ & 64) ? eidx[1] : eidx[0]; const int cv_ = __builtin_bit_cast(int, (e1_ & 64) ? coefs[1] : coefs[0]); \
            _Pragma("unroll") for (int q = 0; q < 8; ++q) { const int ex = __builtin_amdgcn_readlane(ev_, (e1_ & 63) + q); U[q] = *(const GAS v4u*)(P.PV + (size_t)ex * (DM / 2) + lane * 16); \
            C[q] = __builtin_bit_cast(float, __builtin_amdgcn_readlane(cv_, (e1_ & 63) + q)); } } while (0)
#define PEER_AXPY(U, C) do { if (P.dry & 32) { _Pragma("unroll") for (int q = 0; q < 8; ++q) _Pragma("unroll") for (int d = 0; d < 4; ++d) acc2[d].x += __builtin_bit_cast(float, U[q][d] & 0x3fffffffu) * C[q]; } else \
            _Pragma("unroll") for (int q = 0; q < 8; ++q) _Pragma("unroll") for (int d = 0; d < 4; ++d) { const unsigned w = U[q][d]; \
            acc2[4 * d + 0] = __builtin_amdgcn_cvt_scalef32_pk_f32_fp4(w, 1.0f, 0) * C[q] + acc2[4 * d + 0]; acc2[4 * d + 1] = __builtin_amdgcn_cvt_scalef32_pk_f32_fp4(w, 1.0f, 1) * C[q] + acc2[4 * d + 1]; \
            acc2[4 * d + 2] = __builtin_amdgcn_cvt_scalef32_pk_f32_fp4(w, 1.0f, 2) * C[q] + acc2[4 * d + 2]; acc2[4 * d + 3] = __builtin_amdgcn_cvt_scalef32_pk_f32_fp4(w, 1.0f, 3) * C[q] + acc2[4 * d + 3]; } } while (0)
        if (mn < MALL) {
            const bf16* hp = P.H + (size_t)mn * DM + lane * 32; ph0 = *(const GAS v4u*)hp; ph1 = *(const GAS v4u*)(hp + 8); ph2 = *(const GAS v4u*)(hp + 16); ph3 = *(const GAS v4u*)(hp + 24); }
        v4u xpre[4];
        { const bf16* xr0 = P.X + (size_t)m * DM + lane * 32;
#pragma unroll
          for (int hq = 0; hq < 4; ++hq) xpre[hq] = *(const GAS v4u*)(xr0 + hq * 8); }
        {
            v4u ua[8], ub[8]; float ca[8], cb[8];
            PEER_LOADV(ua, ca, 0);
#pragma unroll 1
            for (int it = 0; it < ((P.dry & 8) ? 2 : 8); ++it) {
                PEER_LOADV(ub, cb, 16 * it + 8); PEER_AXPY(ua, ca);
                if (it < 7) PEER_LOADV(ua, ca, 16 * it + 16);
                PEER_AXPY(ub, cb);
            }
        }
#undef PEER_LOADV
#undef PEER_AXPY
        float acc[32];
#pragma unroll
        for (int i = 0; i < 16; ++i) { acc[2 * i] = acc2[i].x; acc[2 * i + 1] = acc2[i].y; }
        if (P.dry) { float sm_ = 0.f;
#pragma unroll
            for (int i = 0; i < 32; ++i) sm_ += acc[i];
            if (sm_ == 1.2345e-30f) P.X[lane] = sm_;
            if (!(P.dry & 16)) continue; }
        if (DBG_SKIP & 1) {
#pragma unroll
            for (int i = 0; i < 32; ++i) acc[i] = 0.f; }
        if (((DBG_SKIP & 64) && !P.last) || ((DBG_SKIP & 128) && P.last)) {
#pragma unroll
            for (int i = 0; i < 32; ++i) acc[i] = 0.f; }
        if (DBG_SKIP & 8) {
#pragma unroll
            for (int i = 0; i < 32; ++i) acc[i] = -acc[i]; }
        int m_l = m, lane_l = lane; asm volatile("" : "+v"(m_l), "+v"(lane_l));
        const int b_l = m_l / TPB, tp_l = m_l - b_l * TPB, mr_l = tp_l < CTXL ? 2 : b_l;
        bf16* xr = (P.dry ? (bf16*)(F.ws + 760 * MiB) : P.X) + (size_t)m_l * DM + lane_l * 32; const float* g2 = P.mod + (size_t)mr_l * 12288 + 5 * DM + lane_l * 32;
        float ss = 0.f;
#pragma unroll
        for (int hq = 0; hq < 4; ++hq) { const int c = hq * 8; float xf[8]; unpack8(xpre[hq], xf);
            const f32x4 g0 = *(const GAS f32x4*)(g2 + c), g1 = *(const GAS f32x4*)(g2 + c + 4);
#pragma unroll
            for (int e = 0; e < 8; ++e) { const float xv = xf[e] + (e < 4 ? g0[e & 3] : g1[e & 3]) * acc[8 * hq + e]; ss += xv * xv; acc[8 * hq + e] = xv; xf[e] = xv; }
            if (!P.last) *(GAS v4u*)(xr + c) = pack8f(xf); }
        if (!P.last) {
            const float rs = rsqrtf(wave_sum(ss) * (1.f / DM) + NORM_EPS); const float* sh = P.nmod + (size_t)mr_l * 12288 + lane_l * 32; const float* sc = sh + DM; const float* ngp = P.ng + lane_l * 32;
            bf16* ho = (P.dry ? (bf16*)(F.ws + 892 * MiB) : P.Hout) + (size_t)m_l * DM + lane_l * 32;
#pragma unroll
            for (int hq = 0; hq < 4; ++hq) { const int c = hq * 8; float y[8];
                const f32x4 n0 = *(const GAS f32x4*)(ngp + c), n1 = *(const GAS f32x4*)(ngp + c + 4), s0 = *(const GAS f32x4*)(sc + c), s1 = *(const GAS f32x4*)(sc + c + 4), h0 = *(const GAS f32x4*)(sh + c), h1 = *(const GAS f32x4*)(sh + c + 4);
#pragma unroll
                for (int e = 0; e < 4; ++e) { y[e] = acc[8 * hq + e] * rs * n0[e] * (1.0f + s0[e]) + h0[e]; y[4 + e] = acc[8 * hq + 4 + e] * rs * n1[e] * (1.0f + s1[e]) + h1[e]; }
                *(GAS v4u*)(ho + c) = pack8f(y); } }
        if (P.last) { const float rs = rsqrtf(wave_sum(ss) * (1.f / DM) + NORM_EPS); float* orow = P.out + ((size_t)b_l * SEQ + (tp_l - CTXL)) * DM + lane_l * 32; const float* fgp = P.fin_g + lane_l * 32;
#pragma unroll
            for (int hq = 0; hq < 8; ++hq) { const int c = hq * 4; const f32x4 fg = *(const GAS f32x4*)(fgp + c);
                f32x4 o;
#pragma unroll
                for (int e = 0; e < 4; ++e) o[e] = acc[4 * hq + e] * rs * fg[e];
                *(GAS f32x4*)(orow + c) = o; } }
    }
    if (DBG_PROBE && DBG_PROBE != 5 && !P.last && lane == 0) { float* pp = (float*)(F.ws + WS_CTL + CTL_PROBE_OFF) + gw * 4; pp[0] = pr_s2; pp[1] = pr_d2; pp[2] = pr_tg; pp[3] = pr_n; }
}


constexpr int PH_PER_LAYER = 12, NPHASE = 1 + NLAYER * PH_PER_LAYER;
#ifndef ONLY_PHASE
#define ONLY_PHASE -1
#endif
#define T0() (wave_s == 0 && pg8::opaque_lane() == 0)
#define PH_ON(k) (ONLY_PHASE < 0 || ONLY_PHASE == (k))
#define GEMM_CALL(EPI, SCHED, g, S, E) pg8::gemm_phase<EPI, SCHED, true, true>(F.lds, g, S, E, wave_s)
#define GEMM_CALL_NA(EPI, SCHED, g, S, E) pg8::gemm_phase<EPI, SCHED, false, true>(F.lds, g, S, E, wave_s)

__device__ __forceinline__ const float* karg(int i) {
    asm volatile("" : "+s"(i));
    const __attribute__((address_space(4))) unsigned long long* ka = (const __attribute__((address_space(4))) unsigned long long*)__builtin_amdgcn_kernarg_segment_ptr();
    return (const float*)ka[i];
}
__global__ void __launch_bounds__(NWAVES * 64, 2) mk_fwd(Args args) {
    extern __shared__ __attribute__((aligned(16))) unsigned char lds[];
    Frame F;
    F.lds = (LAS unsigned char*)lds; F.ws = args.ws;
    const int wave_s = __builtin_amdgcn_readfirstlane((int)threadIdx.x >> 6);
    F.tid = threadIdx.x; F.lane = F.tid & 63; F.wave = wave_s;
    F.G = gridDim.x; { const int bx = blockIdx.x; F.vcu = (F.G % 8 == 0) ? (bx % 8) * (F.G / 8) + bx / 8 : bx; }
    unsigned char* ws = args.ws;
    volatile LAS unsigned* MISC = (volatile LAS unsigned*)(F.lds + MISC_OFF);
    for (int u = F.tid; u < (LDS_BYTES - LDSCTL_OFF) / 4; u += NWAVES * 64) ((LAS unsigned*)(F.lds + LDSCTL_OFF))[u] = 0u;
    __syncthreads();
    const int lo = args.ph_lo, hi = args.ph_hi;
    XcdBarrier bar; bar.bar = (unsigned*)(ws + WS_CTL) + CW_BAR; bar.x = 0; bar.st = nullptr;
    if (hi - lo > 1) bar = xcd_barrier_post((unsigned*)(ws + WS_CTL) + CW_BAR, MISC + 8, T0());
#define IN(k) (lo <= (k) && (k) < hi)
#define REFRAME() do { const int lz_ = pg8::opaque_lane(); F.lane = lz_; F.tid = wave_s * 64 + lz_; F.wave = wave_s; ws = (unsigned char*)karg(34); F.ws = ws; { int g_ = (int)gridDim.x, b_ = (int)blockIdx.x; asm volatile("" : "+s"(g_), "+s"(b_)); bx = b_; F.G = g_; F.vcu = ((g_ & 7) == 0) ? (b_ & 7) * (g_ >> 3) + (b_ >> 3) : b_; } } while (0)
#define SEAM(k) do { if (IN((k) + 1)) xcd_barrier(bar, T0()); } while (0)
#define XBUF ((bf16*)(ws + WS_X))
#define HBUF ((bf16*)(ws + WS_H))
#define MODP ((const float*)(ws + WS_CTL + CTL_MOD_OFF) + (size_t)l * 3 * 12288)
    int bx = (int)blockIdx.x;

    for (int rep_ = 0; rep_ < ((DBG_REPEAT == 100) ? 2 : 1); ++rep_) if (PH_ON(100) && IN(0)) { REFRAME(); if (rep_) xcd_barrier(bar, T0()); p0_prologue(F, 0, (MK_N_LAUNCHES == 1) ? 1 : NLAYER, F.vcu, F.G, 1, (WQK_LATE && F.G == 256) ? 1 : 3); SEAM(0); if (DBG_REPEAT == 200) { for (int i_ = 0; i_ < 32; ++i_) xcd_barrier(bar, T0()); } }

    for (int l = 0; l < NLAYER; ++l) {
        const int base = 1 + l * PH_PER_LAYER;
        const int last = (l == NLAYER - 1);
        for (int rep_ = 0; rep_ < ((DBG_REPEAT == 0) ? 2 : 1); ++rep_) if (PH_ON(0) && IN(base + 0) && l == 0) { REFRAME(); if (rep_) xcd_barrier(bar, T0()); modnorm_phase(F, nullptr, karg(6) + (size_t)l * DM, MODP, 0, HBUF, 0, karg(0), karg(2)); SEAM(base + 0); }
        for (int rep_ = 0; rep_ < ((DBG_REPEAT == 1) ? 2 : 1); ++rep_) if (PH_ON(1) && IN(base + 1)) { REFRAME(); if (rep_) xcd_barrier(bar, T0());
            pg8::Gemm g{HBUF, (const bf16*)(ws + WS_WINA) + (size_t)l * INA_P * DM, MALL, INA_P, DM}; pg8::RowOrder S; S.init_rows(0, INA_P, F.G, bx);
            pg8::EpiStoreBf16 E{(bf16*)(ws + WS_PA), INA_P};
            GEMM_CALL(pg8::EpiStoreBf16, pg8::RowOrder, g, S, E);
            if (WQK_LATE && l == 0 && F.G == 256 && rep_ == 0) { __syncthreads(); p0_prologue(F, 0, 1, (bx >= 98) ? bx - 98 : -1, F.G - 98, 0, 2); }
            SEAM(base + 1); }
        for (int rep_ = 0; rep_ < ((DBG_REPEAT == 2) ? 2 : 1); ++rep_) if (PH_ON(2) && IN(base + 2)) { REFRAME(); if (rep_) xcd_barrier(bar, T0());
            FeatP P;
            P.PA = (const bf16*)(ws + WS_PA); P.mu = karg(9) + (size_t)l * RWC; P.w0 = karg(10) + (size_t)l * 2 * RW; P.a0 = karg(12) + (size_t)l * 2 * RW;
            P.k_k = karg(15) + (size_t)l * RW; P.k_a = karg(16) + (size_t)l * RW; P.r_k = karg(17) + (size_t)l * RW;
            P.WUP = (const bf16*)(ws + WS_WUP) + (size_t)l * 2 * RW * 64; P.AUP = (const bf16*)(ws + WS_AUP) + (size_t)l * 2 * RW * 64; P.GUP = (const bf16*)(ws + WS_GUP) + (size_t)l * 2 * RW * 32;
            P.qnorm = karg(20) + (size_t)l * 512; P.kvnorm = karg(22) + (size_t)l * 256; P.rope = (const f32x2*)(ws + WS_ROPE);
            P.RI = (bf16*)(ws + WS_RI); P.GG = (bf16*)(ws + WS_GG); P.BON = (float*)(ws + WS_BON); P.QN = (bf16*)(ws + WS_QN); P.KVN = (bf16*)(ws + WS_KVN); P.K = (bf16*)(ws + WS_K);
            features_phase(F, P);
            SEAM(base + 2); }
        for (int rep_ = 0; rep_ < ((DBG_REPEAT == 3) ? 2 : 1); ++rep_) if (PH_ON(3) && IN(base + 3)) { REFRAME(); if (rep_) xcd_barrier(bar, T0());
            { pg8::Gemm g{(const bf16*)(ws + WS_QN), (const bf16*)(ws + WS_WUQ) + (size_t)l * NQ * 512, MALL, NQ, 512};
              pg8::EpiQ E{(bf16*)(ws + WS_Q), (const f32x2*)(ws + WS_ROPE), 0.14724444f};
              pg8::RowOrder S; S.init_rows(last, NQ, F.G, bx); GEMM_CALL_NA(pg8::EpiQ, pg8::RowOrder, g, S, E); }
            { pg8::Gemm g{(const bf16*)(ws + WS_KVN), (const bf16*)(ws + WS_WUKV) + (size_t)l * NKV * 256, MALL, NKV, 256}; pg8::RowOrder S; S.init_rows(0, NKV, F.G, bx);
              pg8::EpiKV E{(bf16*)(ws + WS_K), (bf16*)(ws + WS_V)};
              GEMM_CALL_NA(pg8::EpiKV, pg8::RowOrder, g, S, E); }
            SEAM(base + 3); }
        for (int rep_ = 0; rep_ < ((DBG_REPEAT == 4) ? 2 : 1); ++rep_) if (PH_ON(4) && IN(base + 4)) { REFRAME(); if (rep_) xcd_barrier(bar, T0());
            ScanCvt C; C.pu = karg(30) + (size_t)l * NEXP * DM; C.pv = karg(31) + (size_t)l * NEXP * DM; C.PU8 = ws + WS_P4; C.PV8 = ws + WS_P4 + (size_t)NEXP * (DM / 2); C.SU = (float*)(ws + WS_P4S); C.SV = (float*)(ws + WS_P4S) + NEXP; C.wl = (MK_N_LAUNCHES == 1 && l + 1 < NLAYER && F.G == 256) ? l + 1 : -1;
            scan_phase(F, (const bf16*)(ws + WS_RI), (bf16*)(ws + WS_Y), C); SEAM(base + 4); }
        for (int rep_ = 0; rep_ < ((DBG_REPEAT == 5) ? 2 : 1); ++rep_) if (PH_ON(5) && IN(base + 5)) { REFRAME(); if (rep_) xcd_barrier(bar, T0());
            attn_phase(F, (const bf16*)(ws + WS_Q), (const bf16*)(ws + WS_K), (const bf16*)(ws + WS_V), (bf16*)(ws + WS_YB), !last);
            readout_phase(F, (const bf16*)(ws + WS_Y), (const bf16*)(ws + WS_GG), (const float*)(ws + WS_BON), (const bf16*)(ws + WS_RI), karg(18) + (size_t)l * RW, karg(19) + (size_t)l * RW, (bf16*)(ws + WS_YA));
            SEAM(base + 5); }
        for (int rep_ = 0; rep_ < ((DBG_REPEAT == 6) ? 2 : 1); ++rep_) if (PH_ON(6) && IN(base + 6)) { REFRAME(); if (rep_) xcd_barrier(bar, T0());
            bf16* T1 = (bf16*)(ws + WS_T1); bf16* T2 = (bf16*)(ws + WS_T2);
            const pg8::Gemm g1{HBUF, (const bf16*)(ws + WS_WGA) + (size_t)l * DM * DM, MALL, DM, DM}, g2{(const bf16*)(ws + WS_YA), (const bf16*)(ws + WS_WA) + (size_t)l * DM * RW, MALL, DM, RW};
            const pg8::Gemm g3{HBUF, (const bf16*)(ws + WS_WGB) + (size_t)l * DM * DM, MALL, DM, DM}, g4{(const bf16*)(ws + WS_YB), (const bf16*)(ws + WS_WB) + (size_t)l * DM * RW, MALL, DM, RW};
            const pg8::EpiGate E1{T1, DM, karg(8) + (size_t)l * 2 * DM}, E3{T2, DM, karg(8) + (size_t)l * 2 * DM + DM};
            const pg8::EpiMulAdd E2{T1, T1, nullptr, DM}, E4{T1, T2, T1, DM};
            const bool split = CTX_SPLIT && !last && F.G >= 128;
            pg8::RowOrder S; S.init_rows(last || split, DM, F.G, bx);
            GEMM_CALL(pg8::EpiGate, pg8::RowOrder, g1, S, E1); GEMM_CALL(pg8::EpiMulAdd, pg8::RowOrder, g2, S, E2); GEMM_CALL(pg8::EpiGate, pg8::RowOrder, g3, S, E3); GEMM_CALL(pg8::EpiMulAdd, pg8::RowOrder, g4, S, E4);
            if (split) {
                pg8::CtxOrder Sg, Sp; Sg.u0 = (bx < 32) ? (bx & 15) : -1; Sp.u0 = (bx >= 32 && bx < 64) ? (bx & 15) : -1;
                const bool second = (bx & 16) != 0;
                const pg8::Gemm gg = second ? g3 : g1, gp = second ? g4 : g2;
                const pg8::EpiGate EG = second ? E3 : E1;
                const pg8::EpiCtxF32 EP{(float*)(ws + (second ? WS_CB : WS_CA)), DM};
                GEMM_CALL(pg8::EpiGate, pg8::CtxOrder, gg, Sg, EG); GEMM_CALL(pg8::EpiCtxF32, pg8::CtxOrder, gp, Sp, EP); }
            if (MK_N_LAUNCHES == 1 && l == 0 && rep_ == 0) { __syncthreads();
                const int late = split ? 64 : (F.G > 32) ? 16 : 0; p0_prologue(F, 1, NLAYER, (bx >= late) ? bx - late : -1, F.G - late, (F.G == 256) ? 0 : 1); }
            SEAM(base + 6); }
        for (int rep_ = 0; rep_ < ((DBG_REPEAT == 7) ? 2 : 1); ++rep_) if (PH_ON(7) && IN(base + 7)) { REFRAME(); if (rep_) xcd_barrier(bar, T0());
            if (CTX_SPLIT && !last && F.G >= 128 && rep_ == 0) {
                bf16* T1 = (bf16*)(ws + WS_T1); const bf16* T2 = (const bf16*)(ws + WS_T2); const float* CA = (const float*)(ws + WS_CA); const float* CB = (const float*)(ws + WS_CB);
                for (int e = bx * (NWAVES * 64) + F.tid; e < 512 * (DM / 8); e += F.G * (NWAVES * 64)) { const int r = e >> 8, c0 = (e & 255) * 8; const size_t go = (size_t)((r < 256) ? r : 33 * 256 + (r - 256)) * DM + c0;
                    const v4u ga = *(const GAS v4u*)(T1 + go), gb = *(const GAS v4u*)(T2 + go);
                    const f32x4 a0 = *(const GAS f32x4*)(CA + (size_t)r * DM + c0), a1 = *(const GAS f32x4*)(CA + (size_t)r * DM + c0 + 4), b0 = *(const GAS f32x4*)(CB + (size_t)r * DM + c0), b1 = *(const GAS f32x4*)(CB + (size_t)r * DM + c0 + 4);
                    v4u o;
                    o.x = pk2(bflo(ga.x) * a0[0] + bflo(gb.x) * b0[0], bfhi(ga.x) * a0[1] + bfhi(gb.x) * b0[1]); o.y = pk2(bflo(ga.y) * a0[2] + bflo(gb.y) * b0[2], bfhi(ga.y) * a0[3] + bfhi(gb.y) * b0[3]);
                    o.z = pk2(bflo(ga.z) * a1[0] + bflo(gb.z) * b1[0], bfhi(ga.z) * a1[1] + bfhi(gb.z) * b1[1]); o.w = pk2(bflo(ga.w) * a1[2] + bflo(gb.w) * b1[2], bfhi(ga.w) * a1[3] + bfhi(gb.w) * b1[3]);
                    *(GAS v4u*)(T1 + go) = o; }
                xcd_barrier(bar, T0()); }
            const pg8::Gemm g{(const bf16*)(ws + WS_T1), (const bf16*)(ws + WS_WO) + (size_t)l * DM * DM, MALL, DM, DM};
            const pg8::EpiResid E{XBUF, MODP + 2 * DM, l == 0 ? karg(0) : nullptr, l == 0 ? karg(2) : nullptr};
            pg8::RowOrder S; S.init_rows(last, DM, F.G, bx); GEMM_CALL(pg8::EpiResid, pg8::RowOrder, g, S, E);
            SEAM(base + 7); }
        for (int rep_ = 0; rep_ < ((DBG_REPEAT == 8) ? 2 : 1); ++rep_) if (PH_ON(8) && IN(base + 8)) { REFRAME(); if (rep_) xcd_barrier(bar, T0());
            modnorm_phase_bf(F, XBUF, karg(27) + (size_t)l * DM, MODP, 3, HBUF, last);
            SEAM(base + 8); }
        for (int rep_ = 0; rep_ < ((DBG_REPEAT == 9) ? 2 : 1); ++rep_) if (PH_ON(9) && IN(base + 9)) { REFRAME(); if (rep_) xcd_barrier(bar, T0());
            const pg8::Gemm g{HBUF, (const bf16*)(ws + WS_WQK) + (size_t)l * DM * DM, MALL, DM, DM};
            const pg8::EpiF16 E{(_Float16*)(ws + WS_SC), DM};
            pg8::RowOrder S; S.init_rows(last, DM, F.G, bx); GEMM_CALL(pg8::EpiF16, pg8::RowOrder, g, S, E);
            SEAM(base + 9); }
        for (int rep_ = 0; rep_ < ((DBG_REPEAT == 11) ? 2 : 1); ++rep_) if (PH_ON(11) && IN(base + 11)) { REFRAME(); if (rep_) xcd_barrier(bar, T0());
            PeerP P; P.SC = (const _Float16*)(ws + WS_SC); P.nmod = MODP + 3 * 12288; P.ng = karg(6) + (size_t)(l + 1) * DM; P.Hout = HBUF; P.ESEL = (const int*)(ws + WS_T1); P.EGATE = (const float*)(ws + WS_T1 + 16 * MiB); P.H = HBUF; P.PU = ws + WS_P4; P.PV = ws + WS_P4 + (size_t)NEXP * (DM / 2); P.SU = (const float*)(ws + WS_P4S); P.SV = (const float*)(ws + WS_P4S) + NEXP; P.X = XBUF; P.mod = MODP; P.fin_g = karg(32); P.out = (float*)karg(33); P.last = last; P.dry = (DBG_REPEAT == 11 && rep_ == 0) ? DBG_DRY : 0;
            peer_phase(F, P);
            SEAM(base + 11); }
    }
#undef IN
#undef SEAM
#undef XBUF
#undef HBUF
#undef MODP
}

__device__ __forceinline__ float mx_a_val(int i, int k) { const int c = (i * 131 + k * 17 + (k >> 3) * 5) & 15; const float mag[8] = {0.f, .5f, 1.f, 1.5f, 2.f, 3.f, 4.f, 6.f}; return (c & 8) ? -mag[c & 7] : mag[c & 7]; }
__device__ __forceinline__ int mx_a_code(int i, int k) { return (i * 131 + k * 17 + (k >> 3) * 5) & 15; }
__device__ __forceinline__ float mx_b_val(int k, int j) { return (float)(((k * 7 + j * 13 + (k >> 4)) % 9) - 4); }
__device__ __forceinline__ int mx_kmap(int hyp, int kb, int e) { const int h = hyp % 3; return h == 0 ? 32 * kb + e : h == 1 ? 32 * (e >> 3) + 8 * kb + (e & 7) : 64 * (e >> 4) + 16 * kb + (e & 15); }
__global__ void __launch_bounds__(512) dbg_fill(const float* pp, float* o) {
    __shared__ float vsh;
    float v = 0.f;
    if (DBG_PROBE == 5) {
        if (threadIdx.x < 64) { typedef int v8i __attribute__((ext_vector_type(8))); typedef float f4 __attribute__((ext_vector_type(4)));
            const int lane = threadIdx.x, i = lane & 15, kb = lane >> 4; float code = 0.f;
            for (int hyp = 0; hyp < 18; ++hyp) { const int nibswap = hyp / 9, ha = hyp % 3, hb2 = (hyp / 3) % 3;
                unsigned aw[4] = {0u, 0u, 0u, 0u}; int bw[8] = {0, 0, 0, 0, 0, 0, 0, 0};
                for (int e = 0; e < 32; ++e) { const int k = mx_kmap(ha, kb, e); const unsigned c = (unsigned)mx_a_code(i, k); const int pos = nibswap ? (e ^ 1) : e; aw[pos >> 3] |= c << (4 * (pos & 7)); }
                for (int q = 0; q < 8; ++q) { int w = 0; const float f0 = mx_b_val(mx_kmap(hb2, kb, 4 * q + 0), i), f1 = mx_b_val(mx_kmap(hb2, kb, 4 * q + 1), i), f2 = mx_b_val(mx_kmap(hb2, kb, 4 * q + 2), i), f3 = mx_b_val(mx_kmap(hb2, kb, 4 * q + 3), i);
                    w = __builtin_amdgcn_cvt_pk_fp8_f32(f0, f1, w, false); w = __builtin_amdgcn_cvt_pk_fp8_f32(f2, f3, w, true); bw[q] = w; }
                const v8i af = {(int)aw[0], (int)aw[1], (int)aw[2], (int)aw[3], 0, 0, 0, 0}, bf = {bw[0], bw[1], bw[2], bw[3], bw[4], bw[5], bw[6], bw[7]};
                f4 d = {0.f, 0.f, 0.f, 0.f};
                d = __builtin_amdgcn_mfma_scale_f32_16x16x128_f8f6f4(af, bf, d, 4, 0, 0, 0x7f7f7f7f, 0, 0x7f7f7f7f);
                int bad = 0;
                for (int r = 0; r < 4; ++r) { const int row = 4 * kb + r, col = i; float ex = 0.f; for (int k = 0; k < 128; ++k) ex += mx_a_val(row, k) * mx_b_val(k, col); bad += (d[r] != ex); }
                if (__ballot(bad != 0) == 0ull && code == 0.f) code = (float)(hyp + 1); }
            for (int t = 0; t < 2; ++t) {
                int aw[8] = {0, 0, 0, 0, 0, 0, 0, 0}, bw[8] = {0, 0, 0, 0, 0, 0, 0, 0};
                if (t == 0) { for (int e = 0; e < 32; ++e) { const int k = 32 * kb + e; aw[e >> 3] |= mx_a_code(i, k) << (4 * (e & 7)); bw[e >> 3] |= mx_a_code(i + 16, k) << (4 * (e & 7)); } }
                else { for (int q = 0; q < 8; ++q) { int w = 0, w2 = 0; const int k = 32 * kb + 4 * q;
                        w = __builtin_amdgcn_cvt_pk_fp8_f32(mx_b_val(k, i + 16), mx_b_val(k + 1, i + 16), w, false); w = __builtin_amdgcn_cvt_pk_fp8_f32(mx_b_val(k + 2, i + 16), mx_b_val(k + 3, i + 16), w, true); aw[q] = w;
                        w2 = __builtin_amdgcn_cvt_pk_fp8_f32(mx_b_val(k, i), mx_b_val(k + 1, i), w2, false); w2 = __builtin_amdgcn_cvt_pk_fp8_f32(mx_b_val(k + 2, i), mx_b_val(k + 3, i), w2, true); bw[q] = w2; } }
                const v8i af = {aw[0], aw[1], aw[2], aw[3], aw[4], aw[5], aw[6], aw[7]}, bf = {bw[0], bw[1], bw[2], bw[3], bw[4], bw[5], bw[6], bw[7]};
                f4 d = {0.f, 0.f, 0.f, 0.f};
                if (t == 0) d = __builtin_amdgcn_mfma_scale_f32_16x16x128_f8f6f4(af, bf, d, 4, 4, 0, 0x7f7f7f7f, 0, 0x7f7f7f7f); else d = __builtin_amdgcn_mfma_scale_f32_16x16x128_f8f6f4(af, bf, d, 0, 0, 0, 0x7f7f7f7f, 0, 0x7f7f7f7f);
                int bad = 0;
                for (int r = 0; r < 4; ++r) { const int row = 4 * kb + r, col = i; float ex = 0.f;
                    for (int k = 0; k < 128; ++k) ex += (t == 0) ? mx_a_val(row, k) * mx_a_val(col + 16, k) : mx_b_val(k, row + 16) * mx_b_val(k, col);
                    bad += (d[r] != ex); }
                if (__ballot(bad != 0) == 0ull) code += (t == 0) ? 10.f : 20.f; }
            if (lane == 0) vsh = code; }
        __syncthreads(); v = vsh;
    } else {
        float s0 = 0.f, s1 = 0.f, s2 = 0.f, s3 = 0.f;
        for (int i = 0; i < 2048; ++i) { s0 += pp[4 * i]; s1 += pp[4 * i + 1]; s2 += pp[4 * i + 2]; s3 += pp[4 * i + 3]; }
        if (DBG_PROBE == 4) { float mx = 0.f; for (int i = 0; i < 2048; ++i) mx = fmaxf(mx, pp[4 * i]); v = 100.f * mx; }
        else { v = (DBG_PROBE == 1 ? s0 : DBG_PROBE == 2 ? s1 : s2) / s3 * 1e-3f; v = exp2f(rintf(log2f(v) * 4.f) * 0.25f); }
    }
    for (size_t i = (size_t)blockIdx.x * 512 + threadIdx.x; i < (size_t)NBATCH * SEQ * DM; i += (size_t)gridDim.x * 512) o[i] = v;
}
extern "C" void kernel_launch(void* const* d_in, const int* in_sizes, int n_in, void* d_out, int out_size, void* d_ws, size_t ws_size, hipStream_t stream) {
    static int grid = 0;
    if (grid == 0) {
        if (n_in != 33 || out_size != NBATCH * SEQ * DM || ws_size < WS_END2) { fprintf(stderr, "kernel_launch: unexpected shapes (n_in %d out %d ws %zu)\n", n_in, out_size, ws_size); grid = -1; return; }
        int dev = 0, cus = 0, per_cu = 0;
        if (hipGetDevice(&dev) != hipSuccess || hipDeviceGetAttribute(&cus, hipDeviceAttributeMultiprocessorCount, dev) != hipSuccess) { grid = -1; return; }
        if (hipFuncSetAttribute((const void*)mk_fwd, hipFuncAttributeMaxDynamicSharedMemorySize, LDS_BYTES) != hipSuccess) { fprintf(stderr, "kernel_launch: hipFuncSetAttribute failed\n"); grid = -1; return; }
        if (hipOccupancyMaxActiveBlocksPerMultiprocessor(&per_cu, (const void*)mk_fwd, NWAVES * 64, LDS_BYTES) != hipSuccess || per_cu < 1) { fprintf(stderr, "kernel_launch: occupancy query says %d\n", per_cu); (void)hipGetLastError(); grid = -1; return; }
        grid = cus;
    }
    if (grid < 0) return;
    if (hipMemsetAsync((char*)d_ws + WS_CTL, 0, CTL_ZERO_BYTES, stream) != hipSuccess) return;
    Args a{};
    for (int i = 0; i < 33; ++i) a.in[i] = (const float*)d_in[i];
    a.out = (float*)d_out; a.ws = (unsigned char*)d_ws;
#if MK_N_LAUNCHES == 1
    a.ph_lo = 0; a.ph_hi = NPHASE;
    hipLaunchKernelGGL(mk_fwd, dim3(grid), dim3(NWAVES * 64), LDS_BYTES, stream, a);
#else
    if (DBG_PROBE != 5) for (int p = 0; p < NPHASE; ++p) { a.ph_lo = p; a.ph_hi = p + 1; hipLaunchKernelGGL(mk_fwd, dim3(grid), dim3(NWAVES * 64), LDS_BYTES, stream, a); }
    if (DBG_PROBE) hipLaunchKernelGGL(dbg_fill, dim3(1024), dim3(512), 0, stream, (const float*)((char*)d_ws + WS_CTL + CTL_PROBE_OFF), (float*)d_out);
#endif
}
```
